# Optimizing an MI355X kernel written in HIP

```python
import math
import jax, jax.numpy as jnp
from jax import lax
import numpy as np

D_MODEL = 2048
BATCH = 4
SEQ = 8192
DEPTH = 4
DEC_BATCH = 8
DEC_SEQ = 16
PAST_LEN = 2048

CHUNK = 64
N_A = DEPTH // 2
N_B = DEPTH - N_A
HEAD_DIM = 128
MIX_WIDTH = D_MODEL
MEM_HEADS = 4
MEM_LEN = 256
MEM_WIDTH = MEM_HEADS * HEAD_DIM
MAIN_WIDTH = MIX_WIDTH - MEM_WIDTH
GLA_HEADS = 4
GLA_DV = MAIN_WIDTH // GLA_HEADS
GLA_DK = GLA_DV // 2
GLA_KW = GLA_HEADS * GLA_DK
GLA_LOWRANK = 16
GLA_TAU = 16.0
SB_HEADS = MAIN_WIDTH // HEAD_DIM
SB_BLOCK = 128
D_FF = ((8 * D_MODEL // 3 + 255) // 256) * 256
IN_A = 2 * GLA_KW + 2 * MAIN_WIDTH + GLA_LOWRANK + MEM_WIDTH
IN_B = MAIN_WIDTH + MEM_WIDTH
SPLIT_A = (GLA_KW, 2 * GLA_KW, 2 * GLA_KW + MAIN_WIDTH, 2 * GLA_KW + 2 * MAIN_WIDTH,
           2 * GLA_KW + 2 * MAIN_WIDTH + GLA_LOWRANK)
DN_ALPHA = (2 * DEPTH) ** 0.25
DN_BETA = (8 * DEPTH) ** -0.25
LN_EPS = 1e-5
RMS_EPS = 1e-6
SB_SCALE = HEAD_DIM ** -0.5
MEM_SCALE = HEAD_DIM ** -0.5

kernel_name = "yoco_gla_stickbreaking_stream_step"


def layer_norm(x, g, b):
    xf = x.astype(jnp.float32)
    mu = xf.mean(-1, keepdims=True)
    var = jnp.square(xf - mu).mean(-1, keepdims=True)
    return ((xf - mu) * lax.rsqrt(var + LN_EPS)).astype(x.dtype) * g + b


def rms_norm(x, g):
    xf = x.astype(jnp.float32)
    r = lax.rsqrt(jnp.mean(xf * xf, -1, keepdims=True) + RMS_EPS)
    return (xf * r).astype(x.dtype) * g


def gla_scan(q, k, v, log_a, s0):
    B, L, H, DK = q.shape
    DV = v.shape[-1]
    C = CHUNK if L % CHUNK == 0 else L
    n = L // C

    def to_blocks(t):
        return t.reshape(B, n, C, H, t.shape[-1]).transpose(1, 0, 3, 2, 4).astype(jnp.float32)

    qc, kc, vc, ac = to_blocks(q), to_blocks(k), to_blocks(v), to_blocks(log_a)
    causal = jnp.tril(jnp.ones((C, C), bool))[:, :, None]

    def step(S, inp):
        qb, kb, vb, ab = inp
        bcum = jnp.cumsum(ab, axis=2)
        diff = bcum[:, :, :, None, :] - bcum[:, :, None, :, :]
        decay = jnp.exp(jnp.where(causal, diff, -jnp.inf))
        att = jnp.einsum('bhid,bhijd,bhjd->bhij', qb, decay, kb)
        o = (jnp.einsum('bhij,bhjv->bhiv', att, vb)
             + jnp.einsum('bhid,bhdv->bhiv', qb * jnp.exp(bcum), S))
        b_last = bcum[:, :, -1:, :]
        S = (S * jnp.exp(b_last)[:, :, 0, :, None]
             + jnp.einsum('bhjd,bhjv->bhdv', kb * jnp.exp(b_last - bcum), vb))
        return S, o

    S, o = lax.scan(step, s0.astype(jnp.float32), (qc, kc, vc, ac))
    o = o.transpose(1, 0, 3, 2, 4).reshape(B, L, H, DV)
    return o.astype(v.dtype), S.astype(v.dtype)


def gla_mixer(h, w_in, w_lr2, b_gate, g_norm, s0):
    B, L, _ = h.shape
    q, k, v, g, lr, qm = jnp.split(h @ w_in, SPLIT_A, axis=-1)
    q = q.reshape(B, L, GLA_HEADS, GLA_DK) * (GLA_DK ** -0.5)
    k = k.reshape(B, L, GLA_HEADS, GLA_DK)
    v = v.reshape(B, L, GLA_HEADS, GLA_DV)
    log_a = (jax.nn.log_sigmoid((lr @ w_lr2 + b_gate).astype(jnp.float32)) / GLA_TAU)
    log_a = log_a.reshape(B, L, GLA_HEADS, GLA_DK)
    o, S = gla_scan(q, k, v, log_a, s0)
    o = rms_norm(o, g_norm) * jax.nn.silu(g.reshape(B, L, GLA_HEADS, GLA_DV))
    return o.reshape(B, L, MAIN_WIDTH), qm.reshape(B, L, MEM_HEADS, HEAD_DIM), S


def sb_block(q, k, v, q_pos, k_pos):
    z = jnp.einsum('bqhd,bkhd->bhqk', q, k).astype(jnp.float32) * SB_SCALE
    mask = k_pos[None, :] < q_pos[:, None]
    log_beta = jax.nn.log_sigmoid(z)
    log_1mb = jnp.where(mask, log_beta - z, 0.0)
    tail = lax.cumsum(log_1mb, axis=3, reverse=True) - log_1mb
    w = jnp.where(mask, jnp.exp(log_beta + tail), 0.0)
    return jnp.einsum('bhqk,bkhd->bqhd', w, v.astype(jnp.float32)).astype(q.dtype)


def sb_prompt(q, k, v):
    B, L, H, D = q.shape
    nb = L // SB_BLOCK
    qb = q.reshape(B, nb, SB_BLOCK, H, D).transpose(1, 0, 2, 3, 4)
    pos = jnp.arange(L)
    qpos = pos.reshape(nb, SB_BLOCK)
    o = lax.map(lambda a: sb_block(a[0], k, v, a[1], pos), (qb, qpos))
    return o.transpose(1, 0, 2, 3, 4).reshape(B, L, H, D)


def mem_kv(mem, w):
    B, M, _ = mem.shape
    kv = (mem @ w).reshape(B, M, 2, MEM_HEADS, HEAD_DIM)
    return kv[:, :, 0], kv[:, :, 1]


def shared_kv(h, w):
    B, L, _ = h.shape
    kv = (h @ w).reshape(B, L, 2, SB_HEADS, HEAD_DIM)
    return kv[:, :, 0], kv[:, :, 1]


def mem_attend(qm, mk, mv):
    B, L = qm.shape[:2]
    s = jnp.einsum('blhd,bmhd->bhlm', qm, mk).astype(jnp.float32) * MEM_SCALE
    p = jax.nn.softmax(s, axis=-1)
    o = jnp.einsum('bhlm,bmhd->blhd', p, mv.astype(jnp.float32)).astype(qm.dtype)
    return o.reshape(B, L, MEM_WIDTH)


def finish_layer(x, o_main, o_mem, w_o, ln1_g, ln1_b, ln2_g, ln2_b, w_ffn_in, w_ffn_out):
    mix = jnp.concatenate([o_main, o_mem], axis=-1) @ w_o
    x = layer_norm(DN_ALPHA * x + mix, ln1_g, ln1_b)
    gt, up = jnp.split(x @ w_ffn_in, 2, axis=-1)
    return layer_norm(DN_ALPHA * x + (jax.nn.silu(gt) * up) @ w_ffn_out, ln2_g, ln2_b)


def setup_inputs(seed: int = 0) -> dict:
    key = jax.random.key(seed)
    ks = jax.random.split(key, 24)

    def nrm(k, shape, s=1.0):
        return jax.random.normal(k, shape, jnp.float32) * s

    return {
        "x_prompt": nrm(ks[0], (BATCH, SEQ, D_MODEL)),
        "x_sample": nrm(ks[1], (DEC_BATCH, DEC_SEQ, D_MODEL)),
        "mem_prompt": nrm(ks[2], (BATCH, MEM_LEN, D_MODEL)),
        "state_gla": nrm(ks[3], (N_A, DEC_BATCH, GLA_HEADS, GLA_DK, GLA_DV), 0.5),
        "cache_sb_k": nrm(ks[4], (DEC_BATCH, PAST_LEN, SB_HEADS, HEAD_DIM)),
        "cache_sb_v": nrm(ks[5], (DEC_BATCH, PAST_LEN, SB_HEADS, HEAD_DIM)),
        "cache_mem_k": nrm(ks[6], (DEPTH, DEC_BATCH, MEM_LEN, MEM_HEADS, HEAD_DIM)),
        "cache_mem_v": nrm(ks[7], (DEPTH, DEC_BATCH, MEM_LEN, MEM_HEADS, HEAD_DIM)),
        "w_in_a": nrm(ks[8], (N_A, D_MODEL, IN_A), D_MODEL ** -0.5),
        "w_gate_lr": nrm(ks[9], (N_A, GLA_LOWRANK, GLA_KW), GLA_LOWRANK ** -0.5),
        "b_gate": nrm(ks[10], (N_A, GLA_KW), 0.1),
        "gla_norm_g": 1.0 + nrm(ks[11], (N_A, GLA_DV), 0.02),
        "w_in_b": nrm(ks[12], (N_B, D_MODEL, IN_B), D_MODEL ** -0.5),
        "w_kv_shared": nrm(ks[13], (D_MODEL, 2 * MAIN_WIDTH), D_MODEL ** -0.5),
        "w_mem_kv": nrm(ks[14], (DEPTH, D_MODEL, 2 * MEM_WIDTH), D_MODEL ** -0.5),
        "w_o": nrm(ks[15], (DEPTH, MIX_WIDTH, D_MODEL), MIX_WIDTH ** -0.5 * DN_BETA),
        "ln1_g": 1.0 + nrm(ks[16], (DEPTH, D_MODEL), 0.02),
        "ln1_b": nrm(ks[17], (DEPTH, D_MODEL), 0.02),
        "ln2_g": 1.0 + nrm(ks[18], (DEPTH, D_MODEL), 0.02),
        "ln2_b": nrm(ks[19], (DEPTH, D_MODEL), 0.02),
        "w_ffn_in": nrm(ks[20], (DEPTH, D_MODEL, 2 * D_FF), D_MODEL ** -0.5),
        "w_ffn_out": nrm(ks[21], (DEPTH, D_FF, D_MODEL), D_FF ** -0.5 * DN_BETA),
    }


def reference(x_prompt, x_sample, mem_prompt, state_gla, cache_sb_k, cache_sb_v,
              cache_mem_k, cache_mem_v, w_in_a, w_gate_lr, b_gate, gla_norm_g, w_in_b,
              w_kv_shared, w_mem_kv, w_o, ln1_g, ln1_b, ln2_g, ln2_b, w_ffn_in, w_ffn_out):
    xp, xs = x_prompt, x_sample
    Bp, Lp, _ = xp.shape
    Bs, Ls, _ = xs.shape
    s_zero = jnp.zeros((Bp, GLA_HEADS, GLA_DK, GLA_DV), xp.dtype)
    q_pos_s = PAST_LEN + jnp.arange(Ls)
    k_pos_s = jnp.arange(PAST_LEN + Ls)
    gla_p, gla_s, mk_list, mv_list = [], [], [], []
    for l in range(DEPTH):
        mk_p, mv_p = mem_kv(mem_prompt, w_mem_kv[l])
        mk_list.append(mk_p)
        mv_list.append(mv_p)
        if l < N_A:
            op, qmp, sp = gla_mixer(xp, w_in_a[l], w_gate_lr[l], b_gate[l], gla_norm_g[l], s_zero)
            os_, qms, ss = gla_mixer(xs, w_in_a[l], w_gate_lr[l], b_gate[l], gla_norm_g[l], state_gla[l])
            gla_p.append(sp)
            gla_s.append(ss)
        else:
            if l == N_A:
                sb_k_prompt, sb_v_prompt = shared_kv(xp, w_kv_shared)
                sb_k_sample, sb_v_sample = shared_kv(xs, w_kv_shared)
                k_all = jnp.concatenate([cache_sb_k, sb_k_sample], axis=1)
                v_all = jnp.concatenate([cache_sb_v, sb_v_sample], axis=1)
            j = l - N_A
            pp = xp @ w_in_b[j]
            ps = xs @ w_in_b[j]
            qp = pp[..., :MAIN_WIDTH].reshape(Bp, Lp, SB_HEADS, HEAD_DIM)
            qmp = pp[..., MAIN_WIDTH:].reshape(Bp, Lp, MEM_HEADS, HEAD_DIM)
            qs = ps[..., :MAIN_WIDTH].reshape(Bs, Ls, SB_HEADS, HEAD_DIM)
            qms = ps[..., MAIN_WIDTH:].reshape(Bs, Ls, MEM_HEADS, HEAD_DIM)
            op = sb_prompt(qp, sb_k_prompt, sb_v_prompt).reshape(Bp, Lp, MAIN_WIDTH)
            os_ = sb_block(qs, k_all, v_all, q_pos_s, k_pos_s).reshape(Bs, Ls, MAIN_WIDTH)
        omp = mem_attend(qmp, mk_p, mv_p)
        oms = mem_attend(qms, cache_mem_k[l], cache_mem_v[l])
        xp = finish_layer(xp, op, omp, w_o[l], ln1_g[l], ln1_b[l], ln2_g[l], ln2_b[l],
                          w_ffn_in[l], w_ffn_out[l])
        xs = finish_layer(xs, os_, oms, w_o[l], ln1_g[l], ln1_b[l], ln2_g[l], ln2_b[l],
                          w_ffn_in[l], w_ffn_out[l])
    gla_state_prompt = jnp.stack(gla_p, axis=0)
    gla_state_sample = jnp.stack(gla_s, axis=0)
    mem_k_prompt = jnp.stack(mk_list, axis=0)
    mem_v_prompt = jnp.stack(mv_list, axis=0)
    return (xp, xs, gla_state_prompt, gla_state_sample, sb_k_prompt, sb_v_prompt,
            sb_k_sample, sb_v_sample, mem_k_prompt, mem_v_prompt)
```

```cpp
#include <hip/hip_runtime.h>
#include <cstdio>
#include <cstdint>
namespace pg8 {
#define PG8_LAS __attribute__((address_space(3)))
typedef unsigned short bf16_t;
typedef short bf16x8 __attribute__((ext_vector_type(8)));
typedef float f32x4 __attribute__((ext_vector_type(4)));
typedef unsigned u32x4 __attribute__((ext_vector_type(4)));
constexpr int BM = 256, BK = 64, HALF = 128, HTB = HALF * BK * 2  , STAGE_BYTES = 8 * HTB, NXCD = 8, WGM = 8;

__host__ __device__ __forceinline__ int lds_byte(int r, int c) { const int st = (r >> 4) * 2 + (c >> 5), rr = r & 15, cc = c & 31, ob = rr * 64 + cc * 2; return st * 1024 + (ob ^ (((ob >> 9) & 1) << 5)); }
__host__ __device__ __forceinline__ void stage_rc(int b, int& R, int& C) { const int st = b / 1024, sb = b % 1024, swz = sb ^ (((sb >> 9) & 1) << 5); R = (st >> 1) * 16 + swz / 64; C = (st & 1) * 32 + (swz % 64) / 2; }
__host__ __device__ __forceinline__ int perm32(int rho) { const int n = rho >> 4, i = rho & 15; return 8 * (i >> 2) + 4 * n + (i & 3); }

struct Unit { int pm, pn; };
struct Gemm { const bf16_t* A; const bf16_t* Bt; int M, N, K; };

struct StaticOrder {
    int nM, nN, nwg, G, c;
    __host__ __device__ void init(int M, int N, int G_, int c_) { nM = M / BM; nN = N / BM; nwg = nM * nN; G = G_; c = c_; }
    __host__ __device__ bool next(int i, Unit& u) const {
        const long L = (long)i * G + c; if (L >= nwg) return false;
        int wgid = (int)L; { const int q = nwg / NXCD, r = nwg % NXCD, xcd = wgid % NXCD, off = wgid / NXCD; wgid = (xcd < r ? xcd * (q + 1) : r * (q + 1) + (xcd - r) * q) + off; }
        const int nig = WGM * nN, gid = wgid / nig, fm = gid * WGM, gsz = (nM - fm) < WGM ? (nM - fm) : WGM;
        u.pm = fm + ((wgid % nig) % gsz); u.pn = (wgid % nig) / gsz; return true;
    }
    __device__ __forceinline__ void a_ready(const Unit&) const {}
    __device__ __forceinline__ void done(const Unit&) const {}
};
__device__ __forceinline__ unsigned cvt_pk_bf16(float lo, float hi) { unsigned r; asm volatile("v_cvt_pk_bf16_f32 %0, %1, %2" : "=v"(r) : "v"(lo), "v"(hi)); return r; }
typedef float f32x2 __attribute__((ext_vector_type(2)));
typedef unsigned u32x2 __attribute__((ext_vector_type(2)));
__device__ __forceinline__ float bflo(unsigned w) { return __builtin_bit_cast(float, w << 16); }
__device__ __forceinline__ float bfhi(unsigned w) { return __builtin_bit_cast(float, w & 0xffff0000u); }
struct EpiBf16 {
    static constexpr bool PERM = true, AFTER_DRAIN = false;
    bf16_t* O; int ldc;
    __device__ __forceinline__ void operator()(const f32x4 (&acc)[2][2][4][2], const Unit& u, int wr, int wc, int fr, int fq) const {
        const int row0 = u.pm * BM + wr * 64 + fr, col0 = u.pn * BM + wc * 32 + 8 * fq;
#pragma unroll
        for (int ai = 0; ai < 2; ++ai)
#pragma unroll
            for (int m = 0; m < 4; ++m) { bf16_t* rowp = O + (size_t)(row0 + ai * HALF + m * 16) * ldc + col0;
#pragma unroll
                for (int bj = 0; bj < 2; ++bj) { const f32x4 v0 = acc[ai][bj][m][0], v1 = acc[ai][bj][m][1];
                    u32x4 w; w.x = cvt_pk_bf16(v0[0], v0[1]); w.y = cvt_pk_bf16(v0[2], v0[3]); w.z = cvt_pk_bf16(v1[0], v1[1]); w.w = cvt_pk_bf16(v1[2], v1[3]);
                    *(u32x4*)(rowp + bj * HALF) = w; } }
    }
};
struct EpiSwiGLU {
    static constexpr bool PERM = true, AFTER_DRAIN = false;
    bf16_t* Hh; int ldh;
    __device__ __forceinline__ float swi(float g, float up) const { return g * __builtin_amdgcn_rcpf(1.0f + __expf(-g)) * up; }
    __device__ __forceinline__ void operator()(const f32x4 (&acc)[2][2][4][2], const Unit& u, int wr, int wc, int fr, int fq) const {
        const int row0 = u.pm * BM + wr * 64 + fr, col0 = u.pn * HALF + wc * 32 + 8 * fq;
#pragma unroll
        for (int ai = 0; ai < 2; ++ai)
#pragma unroll
            for (int m = 0; m < 4; ++m) { bf16_t* rowp = Hh + (size_t)(row0 + ai * HALF + m * 16) * ldh + col0;
                const f32x4 g0 = acc[ai][0][m][0], g1 = acc[ai][0][m][1], u0 = acc[ai][1][m][0], u1 = acc[ai][1][m][1];
                u32x4 w; w.x = cvt_pk_bf16(swi(g0[0], u0[0]), swi(g0[1], u0[1])); w.y = cvt_pk_bf16(swi(g0[2], u0[2]), swi(g0[3], u0[3]));
                w.z = cvt_pk_bf16(swi(g1[0], u1[0]), swi(g1[1], u1[1])); w.w = cvt_pk_bf16(swi(g1[2], u1[2]), swi(g1[3], u1[3]));
                *(u32x4*)rowp = w; }
    }
};
struct EpiRes {
    static constexpr bool PERM = false, AFTER_DRAIN = false;
    float* Y; const bf16_t* X; int ldc; float alpha;
    __device__ __forceinline__ void operator()(const f32x4 (&acc)[2][2][4][2], const Unit& u, int wr, int wc, int fr, int fq) const {
        const int row0 = u.pm * BM + wr * 64 + fr, col0 = u.pn * BM + wc * 32 + 4 * fq;
#pragma unroll
        for (int ai = 0; ai < 2; ++ai)
#pragma unroll
            for (int m = 0; m < 4; ++m) { const size_t ro = (size_t)(row0 + ai * HALF + m * 16) * ldc + col0;
#pragma unroll
                for (int bj = 0; bj < 2; ++bj)
#pragma unroll
                    for (int n = 0; n < 2; ++n) { const size_t o = ro + bj * HALF + n * 16; const u32x2 xv = *(const u32x2*)(X + o);
                        f32x4 r; r[0] = alpha * bflo(xv.x); r[1] = alpha * bfhi(xv.x); r[2] = alpha * bflo(xv.y); r[3] = alpha * bfhi(xv.y);
                        *(f32x4*)(Y + o) = r + acc[ai][bj][m][n]; } }
    }
};
struct EpiKV {
    static constexpr bool PERM = false, AFTER_DRAIN = false;
    float *okp, *ovp, *oks, *ovs; bf16_t *kpb, *vpb, *ksb, *vsb;
    __device__ __forceinline__ void operator()(const f32x4 (&acc)[2][2][4][2], const Unit& u, int wr, int wc, int fr, int fq) const {
        const bool isv = u.pn >= 6; const int colt = (u.pn - (isv ? 6 : 0)) * BM + wc * 32 + 4 * fq, row0 = u.pm * BM + wr * 64 + fr;
        float* op = isv ? ovp : okp; float* os = isv ? ovs : oks; bf16_t* bp = isv ? vpb : kpb; bf16_t* bs = isv ? vsb : ksb;
#pragma unroll
        for (int ai = 0; ai < 2; ++ai)
#pragma unroll
            for (int m = 0; m < 4; ++m) { const int row = row0 + ai * HALF + m * 16; float* fd; bf16_t* bd;
                if (row < 32768) { fd = op + (size_t)row * 1536; bd = bp + (size_t)row * 1536; }
                else if (row < 32896) { const int i = row - 32768; fd = os + (size_t)i * 1536; bd = bs + (size_t)((i >> 4) * 2064 + 2048 + (i & 15)) * 1536; }
                else continue;
#pragma unroll
                for (int bj = 0; bj < 2; ++bj)
#pragma unroll
                    for (int n = 0; n < 2; ++n) { const int c = colt + bj * HALF + n * 16; const f32x4 v = acc[ai][bj][m][n];
                        *(f32x4*)(fd + c) = v; u32x2 w; w.x = cvt_pk_bf16(v[0], v[1]); w.y = cvt_pk_bf16(v[2], v[3]); *(u32x2*)(bd + c) = w; } }
    }
};
struct EpiMemKV {
    static constexpr bool PERM = false, AFTER_DRAIN = false;
    float *ok, *ov; bf16_t *kb, *vb;
    __device__ __forceinline__ void operator()(const f32x4 (&acc)[2][2][4][2], const Unit& u, int wr, int wc, int fr, int fq) const {
        const int l = u.pn >> 2, kv = (u.pn >> 1) & 1, hd0 = (u.pn & 1) * BM + wc * 32 + 4 * fq, row0 = u.pm * BM + wr * 64 + fr;
        float* fo = kv ? ov : ok; bf16_t* bo = kv ? vb : kb;
#pragma unroll
        for (int ai = 0; ai < 2; ++ai)
#pragma unroll
            for (int m = 0; m < 4; ++m) { const int row = row0 + ai * HALF + m * 16, b = row >> 8, mm = row & 255;
                float* fd = fo + (size_t)(l * 1024 + row) * 512; bf16_t* bd = bo + (size_t)((l * 12 + b) * 256 + mm) * 512;
#pragma unroll
                for (int bj = 0; bj < 2; ++bj)
#pragma unroll
                    for (int n = 0; n < 2; ++n) { const int c = hd0 + bj * HALF + n * 16; const f32x4 v = acc[ai][bj][m][n];
                        *(f32x4*)(fd + c) = v; u32x2 w; w.x = cvt_pk_bf16(v[0], v[1]); w.y = cvt_pk_bf16(v[2], v[3]); *(u32x2*)(bd + c) = w; } }
    }
};
template <class Epi, class Sched, bool ALIGN_EPI = false, bool SP2 = false>
__device__ __forceinline__ void gemm_phase(PG8_LAS unsigned char* lds, const Gemm g, const Sched& S, const Epi& E) {
    int tid_ = threadIdx.x; asm volatile("" : "+v"(tid_));
    const int tid = tid_, wid = __builtin_amdgcn_readfirstlane(tid >> 6), lane = tid & 63, wr = wid >> 2, wc = wid & 3, fr = lane & 15, fq = lane >> 4;
    const int K = g.K, nt = K / BK;
    unsigned voffA[2], voffB[2];
#pragma unroll
    for (int i = 0; i < 2; ++i) { int R, C; stage_rc(tid * 16 + i * 8192, R, C); const int Rb = Epi::PERM ? ((R & ~31) + perm32(R & 31)) : R;
        voffA[i] = (unsigned)(R * K + C) * 2u; voffB[i] = (unsigned)(Rb * K + C) * 2u; }
    const size_t kstep = (size_t)(BK * 2);
    const size_t hstep = (size_t)HALF * K * 2;
    const size_t tstep = 2 * hstep;
    const unsigned ldsw = (unsigned)wid * 1024u;
    const int aoff = lds_byte(wr * 64 + fr, fq * 8), boff = lds_byte(wc * 32 + fr, fq * 8);
#define PG8_SA(b, h) (((b) * 2 + (h)) * HTB)
#define PG8_SB(b, h) ((4 + (b) * 2 + (h)) * HTB)
#define PG8_STAGE(bufoff, gbase, voff) do { _Pragma("unroll") for (int _i = 0; _i < 2; ++_i) \
        __builtin_amdgcn_global_load_lds((const unsigned*)((const char*)(gbase) + (voff)[_i]), (PG8_LAS unsigned*)(lds + (bufoff) + ldsw + _i * 8192), 16, 0, 0); } while (0)
#define PG8_LDA(dst, b, h) do { _Pragma("unroll") for (int m = 0; m < 4; ++m) _Pragma("unroll") for (int k = 0; k < 2; ++k) dst[m][k] = *(const PG8_LAS bf16x8*)(lds + PG8_SA(b, h) + aoff + m * 2048 + k * 1024); } while (0)
#define PG8_LDB(dst, b, h) do { _Pragma("unroll") for (int n = 0; n < 2; ++n) _Pragma("unroll") for (int k = 0; k < 2; ++k) dst[n][k] = *(const PG8_LAS bf16x8*)(lds + PG8_SB(b, h) + boff + n * 2048 + k * 1024); } while (0)
#define PG8_MMA(ai, bj, At, Bt) do { __builtin_amdgcn_s_setprio(1); _Pragma("unroll") for (int m = 0; m < 4; ++m) _Pragma("unroll") for (int n = 0; n < 2; ++n) _Pragma("unroll") for (int k = 0; k < 2; ++k) \
        acc[ai][bj][m][n] = __builtin_amdgcn_mfma_f32_16x16x32_bf16(Bt[n][k], At[m][k], acc[ai][bj][m][n], 0, 0, 0); __builtin_amdgcn_s_setprio(0); } while (0)
#define PG8_WAIT_V(n) asm volatile("s_waitcnt vmcnt(" #n ")" ::: "memory")
#define PG8_WAIT_L(n) asm volatile("s_waitcnt lgkmcnt(" #n ")" ::: "memory")
#define PG8_BAR __builtin_amdgcn_s_barrier()
#define PG8_SCHED __builtin_amdgcn_sched_barrier(0)
    Unit cur, nxt; int ui = 0;
    if (!S.next(0, cur)) return;
    f32x4 acc[2][2][4][2];
#pragma unroll
    for (int a = 0; a < 2; ++a)
#pragma unroll
        for (int b = 0; b < 2; ++b)
#pragma unroll
            for (int m = 0; m < 4; ++m)
#pragma unroll
                for (int n = 0; n < 2; ++n) acc[a][b][m][n] = (f32x4){0.f, 0.f, 0.f, 0.f};
    bf16x8 At[4][2], B0[2][2], B1[2][2];
    const char* cA = (const char*)g.A + (size_t)cur.pm * tstep; const char* cB = (const char*)g.Bt + (size_t)cur.pn * tstep;
    S.a_ready(cur);
    if constexpr (SP2) {
        PG8_STAGE(PG8_SB(0, 0), cB, voffB); PG8_STAGE(PG8_SB(0, 1), cB + hstep, voffB); PG8_STAGE(PG8_SA(0, 0), cA, voffA); PG8_STAGE(PG8_SA(0, 1), cA + hstep, voffA);
        if (wr == 1) PG8_BAR;
        PG8_WAIT_V(2); PG8_BAR;
        PG8_STAGE(PG8_SB(1, 0), cB + kstep, voffB); PG8_STAGE(PG8_SA(1, 0), cA + kstep, voffA); PG8_STAGE(PG8_SB(1, 1), cB + hstep + kstep, voffB);
        PG8_WAIT_V(6); PG8_BAR;
    } else {
        PG8_STAGE(PG8_SB(0, 0), cB, voffB); PG8_STAGE(PG8_SA(0, 0), cA, voffA); PG8_STAGE(PG8_SB(0, 1), cB + hstep, voffB); PG8_STAGE(PG8_SA(0, 1), cA + hstep, voffA);
        if (wr == 1) PG8_BAR;
        PG8_WAIT_V(4); PG8_BAR;
        PG8_STAGE(PG8_SB(1, 0), cB + kstep, voffB); PG8_STAGE(PG8_SA(1, 0), cA + kstep, voffA); PG8_STAGE(PG8_SB(1, 1), cB + hstep + kstep, voffB);
        PG8_WAIT_V(6); PG8_BAR;
    }
    for (;;) {
        const bool has_next = S.next(ui + 1, nxt);
        const char* nA = has_next ? (const char*)g.A + (size_t)nxt.pm * tstep : cA; const char* nB = has_next ? (const char*)g.Bt + (size_t)nxt.pn * tstep : cB;
        for (int t = 0; t < nt; t += 2) {
            const bool last = (t == nt - 2);
            const char* a1 = cA + (size_t)(t + 1) * kstep;
            const char* a2 = last ? nA : cA + (size_t)(t + 2) * kstep; const char* b2 = last ? nB : cB + (size_t)(t + 2) * kstep;
            const char* a3 = a2 + kstep; const char* b3 = b2 + kstep;
            if (last && has_next) S.a_ready(nxt);
            if constexpr (SP2) {
            PG8_LDB(B0, 0, 0); PG8_LDB(B1, 0, 1); PG8_SCHED; PG8_LDA(At, 0, 0); PG8_STAGE(PG8_SA(1, 1), a1 + hstep, voffA);
            PG8_WAIT_V(8); PG8_WAIT_L(0); PG8_BAR; PG8_MMA(0, 0, At, B0); PG8_MMA(0, 1, At, B1); PG8_BAR; PG8_SCHED;
            PG8_LDA(At, 0, 1); PG8_STAGE(PG8_SB(0, 0), b2, voffB); PG8_STAGE(PG8_SB(0, 1), b2 + hstep, voffB); PG8_STAGE(PG8_SA(0, 0), a2, voffA);
            PG8_WAIT_V(8); PG8_WAIT_L(0); PG8_BAR; PG8_MMA(1, 0, At, B0); PG8_MMA(1, 1, At, B1); PG8_BAR; PG8_SCHED;
            PG8_LDB(B0, 1, 0); PG8_LDB(B1, 1, 1); PG8_SCHED; PG8_LDA(At, 1, 0); PG8_STAGE(PG8_SA(0, 1), a2 + hstep, voffA);
            PG8_WAIT_V(8); PG8_WAIT_L(0); PG8_BAR; PG8_MMA(0, 0, At, B0); PG8_MMA(0, 1, At, B1); PG8_BAR; PG8_SCHED;
            PG8_LDA(At, 1, 1); PG8_STAGE(PG8_SB(1, 0), b3, voffB); PG8_STAGE(PG8_SB(1, 1), b3 + hstep, voffB); PG8_STAGE(PG8_SA(1, 0), a3, voffA);
            PG8_WAIT_V(8); PG8_WAIT_L(0); PG8_BAR; PG8_MMA(1, 0, At, B0); PG8_MMA(1, 1, At, B1); PG8_BAR; PG8_SCHED;
            } else {
            PG8_LDB(B0, 0, 0); PG8_SCHED; PG8_LDA(At, 0, 0); PG8_STAGE(PG8_SA(1, 1), a1 + hstep, voffA);
            PG8_WAIT_L(8); PG8_BAR; PG8_WAIT_L(0); PG8_MMA(0, 0, At, B0); PG8_BAR; PG8_SCHED;
            PG8_LDB(B1, 0, 1); PG8_STAGE(PG8_SB(0, 0), b2, voffB);
            PG8_BAR; PG8_WAIT_L(0); PG8_MMA(0, 1, At, B1); PG8_BAR;
            PG8_LDA(At, 0, 1); PG8_STAGE(PG8_SA(0, 0), a2, voffA);
            PG8_BAR; PG8_WAIT_L(0); PG8_MMA(1, 0, At, B0); PG8_BAR; PG8_SCHED;
            PG8_STAGE(PG8_SB(0, 1), b2 + hstep, voffB);
            PG8_WAIT_V(6); PG8_BAR; PG8_MMA(1, 1, At, B1); PG8_BAR;
            PG8_LDB(B0, 1, 0); PG8_SCHED; PG8_LDA(At, 1, 0); PG8_STAGE(PG8_SA(0, 1), a2 + hstep, voffA);
            PG8_WAIT_L(8); PG8_BAR; PG8_WAIT_L(0); PG8_MMA(0, 0, At, B0); PG8_BAR; PG8_SCHED;
            PG8_LDB(B1, 1, 1); PG8_STAGE(PG8_SB(1, 0), b3, voffB);
            PG8_BAR; PG8_WAIT_L(0); PG8_MMA(0, 1, At, B1); PG8_BAR;
            PG8_LDA(At, 1, 1); PG8_STAGE(PG8_SA(1, 0), a3, voffA);
            PG8_BAR; PG8_WAIT_L(0); PG8_MMA(1, 0, At, B0); PG8_BAR; PG8_SCHED;
            PG8_STAGE(PG8_SB(1, 1), b3 + hstep, voffB);
            PG8_WAIT_V(6); PG8_BAR; PG8_MMA(1, 1, At, B1); PG8_BAR;
            }
        }
        if constexpr (ALIGN_EPI) { if (wr == 0) PG8_BAR; }
        if constexpr (!Epi::AFTER_DRAIN) { E(acc, cur, wr, wc, fr, fq); S.done(cur); }
        if (!has_next) break;
#pragma unroll
        for (int a = 0; a < 2; ++a)
#pragma unroll
            for (int b = 0; b < 2; ++b)
#pragma unroll
                for (int m = 0; m < 4; ++m)
#pragma unroll
                    for (int n = 0; n < 2; ++n) acc[a][b][m][n] = (f32x4){0.f, 0.f, 0.f, 0.f};
        cur = nxt; cA = nA; cB = nB; ++ui;
        if constexpr (ALIGN_EPI) { if (wr == 1) PG8_BAR; }
    }
    PG8_WAIT_V(0);
    if constexpr (!ALIGN_EPI) { if (wr == 0) PG8_BAR; }
    PG8_BAR;
    if constexpr (Epi::AFTER_DRAIN) { E.fused(acc, cur, wr, wc, fr, fq, lds, wid, lane); S.done(cur); }
#undef PG8_SA
#undef PG8_SB
#undef PG8_STAGE
#undef PG8_LDA
#undef PG8_LDB
#undef PG8_MMA
#undef PG8_WAIT_V
#undef PG8_WAIT_L
#undef PG8_BAR
#undef PG8_SCHED
}
}
#define GAS __attribute__((address_space(1)))
#define LAS __attribute__((address_space(3)))
typedef unsigned short bf16;
typedef unsigned v4u __attribute__((ext_vector_type(4)));
typedef float f32x4 __attribute__((ext_vector_type(4)));
typedef short bf16x8 __attribute__((ext_vector_type(8)));
typedef GAS unsigned gu32;
typedef GAS unsigned long long gu64;
#define RLX_AGENT __ATOMIC_RELAXED, __HIP_MEMORY_SCOPE_AGENT
#define LDS_WAIT() asm volatile("s_waitcnt lgkmcnt(0)" ::: "memory")
#define VM_WAIT() asm volatile("s_waitcnt vmcnt(0)" ::: "memory")
__device__ __forceinline__ unsigned long long rt() { return __builtin_amdgcn_s_memrealtime(); }
__device__ __forceinline__ unsigned f2bf(float f) { unsigned u = __builtin_bit_cast(unsigned, f); return (u + 0x7fffu + ((u >> 16) & 1u)) >> 16; }
__device__ __forceinline__ unsigned pk2(float lo, float hi) { return f2bf(lo) | (f2bf(hi) << 16); }
#define XB_TMO      128
#define XB_XCNT(j)  (256  + 64 * (j))
#define XB_XSUB(j)  (1280 + 64 * (j))
#define XB_XGEN(j)  (2304 + 64 * (j))
#define XB_TOP      3328
#define XB_TOPGEN   3392
#define XCD_BAR_WORDS 3456
#define XB_SPIN_CAP (1u << 18)

__device__ __forceinline__ unsigned xb_ld(unsigned* p)              { return __hip_atomic_load(p, __ATOMIC_RELAXED, __HIP_MEMORY_SCOPE_AGENT); }
__device__ __forceinline__ unsigned xb_add(unsigned* p, unsigned v) { return __hip_atomic_fetch_add(p, v, __ATOMIC_RELAXED, __HIP_MEMORY_SCOPE_AGENT); }
__device__ __forceinline__ unsigned xb_xcc_id() { return (unsigned)__builtin_amdgcn_s_getreg((3 << 11) | 20) & 0xFu; }
#define XB_SPIN(cond, bar) do { unsigned _sp = 0; while (cond) { __builtin_amdgcn_s_sleep(1); \
    if ((++_sp & 255u) == 0u) { if (xb_ld(&(bar)[XB_TMO])) break; if (_sp > XB_SPIN_CAP) { atomicAdd(&(bar)[XB_TMO], 1u); break; } } } } while (0)

struct XcdBarrier {
    unsigned* bar; unsigned x;
    volatile LAS unsigned* st;
};

__device__ __forceinline__ XcdBarrier xcd_barrier_post(unsigned* bar, volatile LAS unsigned* st) {
    XcdBarrier b; b.bar = bar; b.x = xb_xcc_id(); b.st = st;
    if (threadIdx.x == 0) (void)xb_add(&bar[XB_XCNT(b.x)], 1u);
    return b;
}
__device__ __forceinline__ void xcd_barrier_complete(unsigned* bar, unsigned x, unsigned& nloc, unsigned& nx) {
    const unsigned G = gridDim.x * gridDim.y * gridDim.z;
    unsigned sum, cnt, mine, sp = 0u;
    for (;;) {
        sum = 0u; cnt = 0u; mine = 0u;
#pragma unroll
        for (unsigned j = 0; j < 16; ++j) { const unsigned c = xb_ld(&bar[XB_XCNT(j)]); sum += c; cnt += (c > 0u) ? 1u : 0u; mine = (j == x) ? c : mine; }
        if (sum == G) break;
        __builtin_amdgcn_s_sleep(1);
        if ((++sp & 255u) == 0u) { if (xb_ld(&bar[XB_TMO])) break; if (sp > XB_SPIN_CAP) { atomicAdd(&bar[XB_TMO], 1u); break; } }
    }
    nloc = mine > 0u ? mine : 1u; nx = cnt > 0u ? cnt : 1u;
}

__device__ __forceinline__ void xcd_barrier(const XcdBarrier& b) {
    asm volatile("s_waitcnt vmcnt(0)" ::: "memory");
    __syncthreads();
    if (threadIdx.x == 0) {
        unsigned* bar = b.bar;
        __builtin_amdgcn_s_waitcnt(0);
        unsigned nloc = b.st[0], nx = b.st[1];
        if (nloc == 0u) { xcd_barrier_complete(bar, b.x, nloc, nx); b.st[0] = nloc; b.st[1] = nx; }
        const unsigned old = xb_add(&bar[XB_XSUB(b.x)], 1u);
        const unsigned gen = old / nloc;
        if (old + 1u == (gen + 1u) * nloc) {
            __builtin_amdgcn_fence(__ATOMIC_RELEASE, "agent");
            asm volatile("s_waitcnt vmcnt(0)" ::: "memory");
            const unsigned og = xb_add(&bar[XB_TOP], 1u);
            const unsigned tg = og / nx;
            if (og + 1u == (tg + 1u) * nx) xb_add(&bar[XB_TOPGEN], 1u);
            else XB_SPIN(xb_ld(&bar[XB_TOPGEN]) == tg, bar);
            __builtin_amdgcn_fence(__ATOMIC_ACQUIRE, "agent");
            xb_add(&bar[XB_XGEN(b.x)], 1u);
            asm volatile("s_waitcnt vmcnt(0)" ::: "memory");
        } else {
            XB_SPIN(xb_ld(&bar[XB_XGEN(b.x)]) == gen, bar);
            __builtin_amdgcn_fence(__ATOMIC_ACQUIRE, "agent");
            asm volatile("s_waitcnt vmcnt(0)" ::: "memory");
        }
    }
    __syncthreads();
}
constexpr int NWAVES = 8;
constexpr int D = 2048, SEQ = 8192, MP = 32768, MS = 128, MR = 32896, MT = 33024;
constexpr int DFF = 5632, NA = 5376, NBQ = 2048, NKV = 3072;
constexpr int CQ = 0, CK = 768, CV = 1536, CG = 3072, CQM = 4608, CLR = 5120;
constexpr float DN_ALPHA = 1.6817928305074292f, LN_EPS = 1e-5f, RMS_EPS = 1e-6f;
constexpr float GLA_QSCALE = 0.07216878364870323f, HD_SCALE = 0.08838834764831845f;
constexpr size_t MiB = 1u << 20;
constexpr size_t WS_CTL = 0, CTL_ZERO_BYTES = 1 * MiB;
constexpr size_t WS_WIN = 1 * MiB, WS_WO = 22 * MiB, WS_WFI = 30 * MiB, WS_WFO = 74 * MiB, WS_WMEM = 96 * MiB, WS_MEMX = 112 * MiB, WS_MEMK = 116 * MiB, WS_MEMV = 128 * MiB;
constexpr size_t WS_X = 140 * MiB, WS_Y = 269 * MiB, WS_R1 = 527 * MiB, WS_OCAT = 882 * MiB, WS_SBKS = 1011 * MiB, WS_SBVS = 1060 * MiB, WS_END = 1109 * MiB;
static_assert(WS_WIN + (size_t)NA * D * 2 <= WS_WO && WS_WFI + (size_t)2 * DFF * D * 2 <= WS_WFO && WS_WFO + (size_t)D * DFF * 2 <= WS_WMEM, "weights map");
static_assert(WS_X + (size_t)MT * D * 2 <= WS_Y && WS_Y + (size_t)MT * D * 4 <= WS_R1 && WS_R1 + (size_t)MT * DFF * 2 <= WS_OCAT && WS_OCAT + (size_t)MT * D * 2 <= WS_SBKS, "activation map");
static_assert(WS_SBKS + (size_t)8 * 2064 * 1536 * 2 <= WS_SBVS && WS_SBVS + (size_t)8 * 2064 * 1536 * 2 <= WS_END, "sb sample map");
constexpr size_t O_YP = 0, O_YS = 67108864, O_GSP = 67371008, O_GSS = 69730304, O_SKP = 74448896, O_SVP = 124780544, O_SKS = 175112192, O_SVS = 175308800, O_MKP = 175505408, O_MVP = 177602560, O_END = 179699712;
constexpr int CW_BAR = 4096;
constexpr int RING_OFF = 0, RING_BYTES = 131072, LDSCTL_OFF = RING_BYTES, MISC_OFF = LDSCTL_OFF + 320, LDS_BYTES = 147456;

struct Args { const float* in[22]; float* out; unsigned char* ws; int ph_lo, ph_hi; };
struct Frame {
    LAS unsigned char* lds; volatile LAS unsigned* MISC; gu32* ctl;
    int tid, lane, wave, G, gw, NGW;
};
__device__ __forceinline__ float bf2f(bf16 h) { return __builtin_bit_cast(float, (unsigned)h << 16); }
__device__ __forceinline__ float wave_sum(float v) {
#pragma unroll
    for (int o = 1; o < 64; o <<= 1) v += __shfl_xor(v, o);
    return v;
}
__device__ __forceinline__ float wave_max(float v) {
#pragma unroll
    for (int o = 1; o < 64; o <<= 1) v = fmaxf(v, __shfl_xor(v, o));
    return v;
}
__device__ __forceinline__ void cvt_row(const float* src, bf16* dst, int n, int lane) {
    for (int j = lane * 4; j < n; j += 256) {
        f32x4 v = src ? *(const f32x4*)(src + j) : (f32x4){0.f, 0.f, 0.f, 0.f};
        unsigned long long w = (unsigned long long)pk2(v.x, v.y) | ((unsigned long long)pk2(v.z, v.w) << 32);
        *(unsigned long long*)(dst + j) = w;
    }
}
struct MapId { __device__ __forceinline__ int operator()(int n) const { return n; } };
struct MapInA { __device__ __forceinline__ int operator()(int n) const { return n < 4608 ? n : (n < 5120 ? n + 16 : (n < 5136 ? n - 512 : -1)); } };
struct MapFfn { __device__ __forceinline__ int operator()(int n) const { const int t = n >> 8, r = n & 255; return r < 128 ? 128 * t + r : DFF + 128 * t + (r - 128); } };
template <class Map>
__device__ __forceinline__ void wt_convert(const Frame& F, int lane, const float* W, int K, int Nsrc, bf16* WT, int Ndst, Map map) {
    LAS float* scr = (LAS float*)(F.lds + RING_OFF + F.wave * 16384);
    const int nblk = Ndst / 32, nitems = (K / 64) * nblk;
    for (int it = F.gw; it < nitems; it += F.NGW) {
        const int kb = it / nblk, nb = it % nblk, k0 = 64 * kb, n0 = 32 * nb;
        const int sc = map(n0 + (lane & 31));
#pragma unroll 8
        for (int i = 0; i < 32; ++i) { const int kk = 2 * i + (lane >> 5); scr[kk * 33 + (lane & 31)] = sc >= 0 ? W[(size_t)(k0 + kk) * Nsrc + sc] : 0.f; }
        LDS_WAIT(); asm volatile("" ::: "memory");
        const int c = lane & 7;
#pragma unroll
        for (int j = 0; j < 4; ++j) { const int n = (lane >> 3) + 8 * j; const LAS float* s = scr + (8 * c) * 33 + n;
            v4u o; o.x = pk2(s[0 * 33], s[1 * 33]); o.y = pk2(s[2 * 33], s[3 * 33]); o.z = pk2(s[4 * 33], s[5 * 33]); o.w = pk2(s[6 * 33], s[7 * 33]);
            *(GAS v4u*)(WT + (size_t)(n0 + n) * K + k0 + 8 * c) = o; }
        LDS_WAIT(); asm volatile("" ::: "memory");
    }
}
__device__ __forceinline__ float softplus_f(float z) { return fmaxf(z, 0.f) + log1pf(__expf(-fabsf(z))); }

#ifndef PH_MASK
#define PH_MASK 0xFFFF
#endif
__global__ void __launch_bounds__(NWAVES * 64, 2) mega(Args args) {
    extern __shared__ __attribute__((aligned(16))) unsigned char lds[];
    Frame F;
    F.lds = (LAS unsigned char*)lds; F.MISC = (volatile LAS unsigned*)(F.lds + MISC_OFF);
    F.tid = threadIdx.x; F.lane = F.tid & 63; F.wave = __builtin_amdgcn_readfirstlane(F.tid >> 6);
    F.G = gridDim.x; F.gw = blockIdx.x * NWAVES + F.wave; F.NGW = F.G * NWAVES;
    unsigned char* ws = args.ws; float* out = args.out;
    F.ctl = (gu32*)(ws + WS_CTL);
    for (int u = F.tid; u < (LDS_BYTES - LDSCTL_OFF) / 4; u += NWAVES * 64) ((LAS unsigned*)(F.lds + LDSCTL_OFF))[u] = 0u;
    __syncthreads();
    XcdBarrier bar = xcd_barrier_post((unsigned*)(F.ctl + CW_BAR), F.MISC + 8);
    const int lo = args.ph_lo, hi = args.ph_hi; int ph = 0;
    const float* x_prompt = args.in[0]; const float* x_sample = args.in[1]; const float* mem_prompt = args.in[2]; const float* state_gla = args.in[3];
    const float* cache_sb_k = args.in[4]; const float* cache_sb_v = args.in[5]; const float* cache_mem_k = args.in[6]; const float* cache_mem_v = args.in[7];
    const float* w_in_a = args.in[8]; const float* w_gate_lr = args.in[9]; const float* b_gate = args.in[10]; const float* gla_norm_g = args.in[11];
    const float* w_in_b = args.in[12]; const float* w_kv_shared = args.in[13]; const float* w_mem_kv = args.in[14]; const float* w_o = args.in[15];
    const float* ln1_g = args.in[16]; const float* ln1_b = args.in[17]; const float* ln2_g = args.in[18]; const float* ln2_b = args.in[19];
    const float* w_ffn_in = args.in[20]; const float* w_ffn_out = args.in[21];
    bf16* WIN = (bf16*)(ws + WS_WIN); bf16* WO = (bf16*)(ws + WS_WO); bf16* WFI = (bf16*)(ws + WS_WFI); bf16* WFO = (bf16*)(ws + WS_WFO); bf16* WMEM = (bf16*)(ws + WS_WMEM);
    bf16* MEMX = (bf16*)(ws + WS_MEMX); bf16* MEMK = (bf16*)(ws + WS_MEMK); bf16* MEMV = (bf16*)(ws + WS_MEMV);
    bf16* X = (bf16*)(ws + WS_X); float* Y = (float*)(ws + WS_Y); bf16* PROJ = (bf16*)(ws + WS_R1); bf16* HB = (bf16*)(ws + WS_R1); bf16* OCAT = (bf16*)(ws + WS_OCAT);
    bf16* SBKS = (bf16*)(ws + WS_SBKS); bf16* SBVS = (bf16*)(ws + WS_SBVS);
    bf16* KPB = (bf16*)(out + O_YP); bf16* VPB = KPB + (size_t)MP * 1536;
    float* GATE = Y;

#define PHASE_BEGIN(cond) if (cond) { if (lo <= ph && ph < hi) { if (ph > lo) xcd_barrier(bar); int tid_ = threadIdx.x; asm volatile("" : "+v"(tid_)); const int tid = tid_, lane = tid_ & 63; (void)tid; (void)lane;
#define PHASE_END } ++ph; }

    PHASE_BEGIN(true)
#if (PH_MASK >> 0) & 1
        for (int r = F.gw; r < MT; r += F.NGW) cvt_row(r < MP ? x_prompt + (size_t)r * D : (r < MR ? x_sample + (size_t)(r - MP) * D : nullptr), X + (size_t)r * D, D, lane);
        for (int r = F.gw; r < 1024; r += F.NGW) cvt_row(mem_prompt + (size_t)r * D, MEMX + (size_t)r * D, D, lane);
        for (int r = F.gw; r < 4 * 8 * 256; r += F.NGW) { const int l = r >> 11, b = (r >> 8) & 7, m = r & 255; const size_t dst = (size_t)((l * 12 + 4 + b) * 256 + m) * 512;
            cvt_row(cache_mem_k + (size_t)r * 512, MEMK + dst, 512, lane); cvt_row(cache_mem_v + (size_t)r * 512, MEMV + dst, 512, lane); }
        for (int r = F.gw; r < 8 * 2048; r += F.NGW) { const int b = r >> 11, s = r & 2047; const size_t dst = (size_t)(b * 2064 + s) * 1536;
            cvt_row(cache_sb_k + (size_t)r * 1536, SBKS + dst, 1536, lane); cvt_row(cache_sb_v + (size_t)r * 1536, SBVS + dst, 1536, lane); }
        for (int l = 0; l < 4; ++l) wt_convert(F, lane, w_mem_kv + (size_t)l * D * 1024, D, 1024, WMEM + (size_t)l * 1024 * D, 1024, MapId());
    #endif
        PHASE_END
    PHASE_BEGIN(true)
#if (PH_MASK >> 1) & 1
        pg8::Gemm g{MEMX, WMEM, 1024, 4096, D}; pg8::StaticOrder S; S.init(1024, 4096, F.G, (int)blockIdx.x);
        pg8::EpiMemKV E{out + O_MKP, out + O_MVP, MEMK, MEMV};
        pg8::gemm_phase<pg8::EpiMemKV, pg8::StaticOrder, true, true>(F.lds + RING_OFF, g, S, E);
    #endif
        PHASE_END

    for (int l = 0; l < 4; ++l) {
        const bool LA = l < 2;
        PHASE_BEGIN(true)
#if (PH_MASK >> 2) & 1
            if (LA) wt_convert(F, lane, w_in_a + (size_t)l * D * 5136, D, 5136, WIN, NA, MapInA());
            else { wt_convert(F, lane, w_in_b + (size_t)(l - 2) * D * NBQ, D, NBQ, WIN, NBQ, MapId()); if (l == 2) wt_convert(F, lane, w_kv_shared, D, NKV, WIN + (size_t)NBQ * D, NKV, MapId()); }
            wt_convert(F, lane, w_o + (size_t)l * D * D, D, D, WO, D, MapId());
            wt_convert(F, lane, w_ffn_in + (size_t)l * D * 2 * DFF, D, 2 * DFF, WFI, 2 * DFF, MapFfn());
            wt_convert(F, lane, w_ffn_out + (size_t)l * DFF * D, DFF, D, WFO, D, MapId());
        #endif
        PHASE_END
        const int ldp = LA ? NA : NBQ;
        PHASE_BEGIN(true)
#if (PH_MASK >> 3) & 1
            { pg8::Gemm g{X, WIN, MT, ldp, D}; pg8::StaticOrder S; S.init(MT, ldp, F.G, (int)blockIdx.x); pg8::EpiBf16 E{PROJ, ldp};
              pg8::gemm_phase<pg8::EpiBf16, pg8::StaticOrder, true, true>(F.lds + RING_OFF, g, S, E); }
            if (l == 2) { pg8::Gemm g{X, WIN + (size_t)NBQ * D, MT, NKV, D}; pg8::StaticOrder S; S.init(MT, NKV, F.G, (int)blockIdx.x);
              pg8::EpiKV E{out + O_SKP, out + O_SVP, out + O_SKS, out + O_SVS, KPB, VPB, SBKS, SBVS};
              pg8::gemm_phase<pg8::EpiKV, pg8::StaticOrder, true, true>(F.lds + RING_OFF, g, S, E); }
        #endif
        PHASE_END
        PHASE_BEGIN(LA)
#if (PH_MASK >> 4) & 1
            const float* w2 = w_gate_lr + (size_t)l * 16 * 768; const float* bg = b_gate + (size_t)l * 768;
            for (size_t idx = (size_t)blockIdx.x * 512 + tid; idx < (size_t)MR * 768; idx += (size_t)F.G * 512) {
                const int row = (int)(idx / 768), c = (int)(idx % 768); const bf16* lr = PROJ + (size_t)row * NA + CLR; float xg = bg[c];
#pragma unroll
                for (int r = 0; r < 16; ++r) xg += bf2f(lr[r]) * w2[r * 768 + c];
                GATE[idx] = __expf(-softplus_f(-xg) * (1.0f / 16.0f));
            }
        #endif
        PHASE_END
        PHASE_BEGIN(true)
#if (PH_MASK >> 5) & 1
            LAS float* sc = (LAS float*)(F.lds + RING_OFF + F.wave * 16384);
            if (LA) {
                const int v32 = lane & 31, hh = lane >> 5;
                for (int item = F.gw; item < 576; item += F.NGW) {
                    int b, h, vb, row0, T; const float* s0; float* sout;
                    if (item < 192) { const int bh = item / 12; vb = item % 12; b = bh >> 2; h = bh & 3; row0 = b * SEQ; T = SEQ; s0 = nullptr; sout = out + O_GSP + (size_t)((l * 4 + b) * 4 + h) * 192 * 384; }
                    else { const int it = item - 192, bh = it / 12; vb = it % 12; b = bh >> 2; h = bh & 3; row0 = MP + b * 16; T = 16; s0 = state_gla + (size_t)((l * 8 + b) * 4 + h) * 192 * 384; sout = out + O_GSS + (size_t)((l * 8 + b) * 4 + h) * 192 * 384; }
                    const int v = vb * 32 + v32;
                    float S[96];
#pragma unroll
                    for (int i = 0; i < 96; ++i) S[i] = s0 ? s0[(size_t)(hh * 96 + i) * 384 + v] : 0.f;
                    float nq[3], nk[3], na[3], nv;
                    { const bf16* pr = PROJ + (size_t)row0 * NA; const float* ga = GATE + (size_t)row0 * 768 + h * 192;
#pragma unroll
                      for (int j = 0; j < 3; ++j) { const int d = lane + 64 * j; nq[j] = bf2f(pr[CQ + h * 192 + d]) * GLA_QSCALE; nk[j] = bf2f(pr[CK + h * 192 + d]); na[j] = ga[d]; }
                      nv = bf2f(pr[CV + h * 384 + v]); }
                    for (int t = 0; t < T; ++t) {
                        const int row = row0 + t;
#pragma unroll
                        for (int j = 0; j < 3; ++j) { const int d = lane + 64 * j; sc[d] = nq[j]; sc[192 + d] = nk[j]; sc[384 + d] = na[j]; }
                        const float vv = nv;
                        if (t + 1 < T) { const bf16* pr = PROJ + (size_t)(row + 1) * NA; const float* ga = GATE + (size_t)(row + 1) * 768 + h * 192;
#pragma unroll
                          for (int j = 0; j < 3; ++j) { const int d = lane + 64 * j; nq[j] = bf2f(pr[CQ + h * 192 + d]) * GLA_QSCALE; nk[j] = bf2f(pr[CK + h * 192 + d]); na[j] = ga[d]; }
                          nv = bf2f(pr[CV + h * 384 + v]); }
                        LDS_WAIT(); asm volatile("" ::: "memory");
                        float o = 0.f;
#pragma unroll
                        for (int i4 = 0; i4 < 24; ++i4) { const f32x4 q4 = *(const LAS f32x4*)(sc + hh * 96 + 4 * i4), k4 = *(const LAS f32x4*)(sc + 192 + hh * 96 + 4 * i4), a4 = *(const LAS f32x4*)(sc + 384 + hh * 96 + 4 * i4);
#pragma unroll
                            for (int e = 0; e < 4; ++e) { S[4 * i4 + e] = a4[e] * S[4 * i4 + e] + k4[e] * vv; o += q4[e] * S[4 * i4 + e]; } }
                        o += __shfl_xor(o, 32);
                        if (hh == 0) OCAT[(size_t)row * D + h * 384 + v] = (bf16)f2bf(o);
                        LDS_WAIT(); asm volatile("" ::: "memory");
                    }
#pragma unroll
                    for (int i = 0; i < 96; ++i) sout[(size_t)(hh * 96 + i) * 384 + v] = S[i];
                }
            } else {
                const int NPI = 4 * 12 * SEQ, NSI = 8 * 12 * 16;
                for (int it = F.gw; it < NPI + NSI; it += F.NGW) {
                    int h, nk, qrow; const bf16 *Kb, *Vb;
                    if (it < NPI) { const int t = it % SEQ, bh = it / SEQ, b = bh / 12; h = bh % 12; Kb = KPB + (size_t)(b * SEQ) * 1536 + h * 128; Vb = VPB + (size_t)(b * SEQ) * 1536 + h * 128; nk = t; qrow = b * SEQ + t; }
                    else { const int i2 = it - NPI, t = i2 % 16, bh = i2 / 16, b = bh / 12; h = bh % 12; Kb = SBKS + (size_t)(b * 2064) * 1536 + h * 128; Vb = SBVS + (size_t)(b * 2064) * 1536 + h * 128; nk = 2048 + t; qrow = MP + b * 16 + t; }
                    { const unsigned qw = *(const unsigned*)(PROJ + (size_t)qrow * NBQ + h * 128 + 2 * lane); sc[2 * lane] = pg8::bflo(qw) * HD_SCALE; sc[2 * lane + 1] = pg8::bfhi(qw) * HD_SCALE; }
                    LDS_WAIT(); asm volatile("" ::: "memory");
                    float o0 = 0.f, o1 = 0.f, carry = 0.f;
                    if (nk > 0) for (int s_lo = ((nk - 1) >> 6) << 6; s_lo >= 0; s_lo -= 64) {
                        const int s = s_lo + lane; const bool valid = s < nk; const bf16* kr = Kb + (size_t)(valid ? s : nk - 1) * 1536;
                        float z = 0.f;
#pragma unroll
                        for (int d8 = 0; d8 < 16; ++d8) { const v4u kw = *(const v4u*)(kr + 8 * d8); const f32x4 qa = *(const LAS f32x4*)(sc + 8 * d8), qb = *(const LAS f32x4*)(sc + 8 * d8 + 4);
                            z += pg8::bflo(kw.x) * qa[0] + pg8::bfhi(kw.x) * qa[1] + pg8::bflo(kw.y) * qa[2] + pg8::bfhi(kw.y) * qa[3] + pg8::bflo(kw.z) * qb[0] + pg8::bfhi(kw.z) * qb[1] + pg8::bflo(kw.w) * qb[2] + pg8::bfhi(kw.w) * qb[3]; }
                        const float sp = softplus_f(z), l1 = valid ? -sp : 0.f, lb = z - sp;
                        float xs = l1;
#pragma unroll
                        for (int off = 1; off < 64; off <<= 1) { const float y = __shfl_down(xs, off); if (lane + off < 64) xs += y; }
                        const float tail = carry + (xs - l1), w = valid ? __expf(lb + tail) : 0.f;
                        carry += __shfl(xs, 0);
                        for (int j = 0; j < 64; ++j) { const float wj = __builtin_bit_cast(float, __builtin_amdgcn_readlane(__builtin_bit_cast(int, w), j)); const int sj = s_lo + j < nk ? s_lo + j : nk - 1;
                            const unsigned vw = *(const unsigned*)(Vb + (size_t)sj * 1536 + 2 * lane); o0 += wj * pg8::bflo(vw); o1 += wj * pg8::bfhi(vw); }
                        if (carry < -104.f) break;
                    }
                    *(unsigned*)(OCAT + (size_t)qrow * D + h * 128 + 2 * lane) = pk2(o0, o1);
                    LDS_WAIT(); asm volatile("" ::: "memory");
                }
            }
            { const int cqm = LA ? CQM : 1536;
              for (int it = F.gw; it < MR * 4; it += F.NGW) {
                const int row = it >> 2, h = it & 3, bb = row < MP ? row / SEQ : 4 + ((row - MP) >> 4);
                const bf16* Kb = MEMK + (size_t)((l * 12 + bb) * 256) * 512 + h * 128; const bf16* Vb = MEMV + (size_t)((l * 12 + bb) * 256) * 512 + h * 128;
                { const unsigned qw = *(const unsigned*)(PROJ + (size_t)row * ldp + cqm + h * 128 + 2 * lane); sc[2 * lane] = pg8::bflo(qw) * HD_SCALE; sc[2 * lane + 1] = pg8::bfhi(qw) * HD_SCALE; }
                LDS_WAIT(); asm volatile("" ::: "memory");
                float s4[4];
#pragma unroll
                for (int i = 0; i < 4; ++i) { const bf16* kr = Kb + (size_t)(lane + 64 * i) * 512; float z = 0.f;
#pragma unroll
                    for (int d8 = 0; d8 < 16; ++d8) { const v4u kw = *(const v4u*)(kr + 8 * d8); const f32x4 qa = *(const LAS f32x4*)(sc + 8 * d8), qb = *(const LAS f32x4*)(sc + 8 * d8 + 4);
                        z += pg8::bflo(kw.x) * qa[0] + pg8::bfhi(kw.x) * qa[1] + pg8::bflo(kw.y) * qa[2] + pg8::bfhi(kw.y) * qa[3] + pg8::bflo(kw.z) * qb[0] + pg8::bfhi(kw.z) * qb[1] + pg8::bflo(kw.w) * qb[2] + pg8::bfhi(kw.w) * qb[3]; }
                    s4[i] = z; }
                const float mx = wave_max(fmaxf(fmaxf(s4[0], s4[1]), fmaxf(s4[2], s4[3])));
                float ps = 0.f;
#pragma unroll
                for (int i = 0; i < 4; ++i) { s4[i] = __expf(s4[i] - mx); ps += s4[i]; }
                const float inv = 1.0f / wave_sum(ps);
                float o0 = 0.f, o1 = 0.f;
#pragma unroll
                for (int i = 0; i < 4; ++i)
                    for (int j = 0; j < 64; ++j) { const float pj = __builtin_bit_cast(float, __builtin_amdgcn_readlane(__builtin_bit_cast(int, s4[i]), j));
                        const unsigned vw = *(const unsigned*)(Vb + (size_t)(64 * i + j) * 512 + 2 * lane); o0 += pj * pg8::bflo(vw); o1 += pj * pg8::bfhi(vw); }
                *(unsigned*)(OCAT + (size_t)row * D + 1536 + h * 128 + 2 * lane) = pk2(o0 * inv, o1 * inv);
                LDS_WAIT(); asm volatile("" ::: "memory");
              } }
        #endif
        PHASE_END
        PHASE_BEGIN(LA)
#if (PH_MASK >> 6) & 1
            const float* gn = gla_norm_g + (size_t)l * 384;
            for (int row = F.gw; row < MR; row += F.NGW) {
#pragma unroll
                for (int h = 0; h < 4; ++h) { bf16* op = OCAT + (size_t)row * D + h * 384; const bf16* gp = PROJ + (size_t)row * NA + CG + h * 384;
                    float ov[6]; float ss = 0.f;
#pragma unroll
                    for (int j = 0; j < 3; ++j) { const unsigned w = *(const unsigned*)(op + 2 * lane + 128 * j); ov[2 * j] = pg8::bflo(w); ov[2 * j + 1] = pg8::bfhi(w); ss += ov[2 * j] * ov[2 * j] + ov[2 * j + 1] * ov[2 * j + 1]; }
                    const float r = 1.0f / sqrtf(wave_sum(ss) * (1.0f / 384.0f) + RMS_EPS);
#pragma unroll
                    for (int j = 0; j < 3; ++j) { const int c = 2 * lane + 128 * j; const unsigned gw2 = *(const unsigned*)(gp + c); const float g0 = pg8::bflo(gw2), g1 = pg8::bfhi(gw2);
                        const float r0 = ov[2 * j] * r * gn[c] * (g0 / (1.0f + __expf(-g0))), r1 = ov[2 * j + 1] * r * gn[c + 1] * (g1 / (1.0f + __expf(-g1)));
                        *(unsigned*)(op + c) = pk2(r0, r1); } }
            }
        #endif
        PHASE_END
        PHASE_BEGIN(true)
#if (PH_MASK >> 7) & 1
            pg8::Gemm g{OCAT, WO, MT, D, D}; pg8::StaticOrder S; S.init(MT, D, F.G, (int)blockIdx.x); pg8::EpiRes E{Y, X, D, DN_ALPHA};
            pg8::gemm_phase<pg8::EpiRes, pg8::StaticOrder, true, true>(F.lds + RING_OFF, g, S, E);
        #endif
        PHASE_END
        PHASE_BEGIN(true)
#if (PH_MASK >> 8) & 1
            const float* gg = ln1_g + (size_t)l * D; const float* bb = ln1_b + (size_t)l * D;
            for (int row = F.gw; row < MR; row += F.NGW) {
                const f32x4* yr = (const f32x4*)(Y + (size_t)row * D) + lane; f32x4 v[8]; float s = 0.f;
#pragma unroll
                for (int j = 0; j < 8; ++j) { v[j] = yr[64 * j]; s += (v[j].x + v[j].y) + (v[j].z + v[j].w); }
                const float mean = wave_sum(s) * (1.f / D); float s2 = 0.f;
#pragma unroll
                for (int j = 0; j < 8; ++j) { v[j] = v[j] - mean; s2 += (v[j].x * v[j].x + v[j].y * v[j].y) + (v[j].z * v[j].z + v[j].w * v[j].w); }
                const float rstd = 1.f / sqrtf(wave_sum(s2) * (1.f / D) + LN_EPS);
                unsigned long long* o8 = (unsigned long long*)(X + (size_t)row * D) + lane;
#pragma unroll
                for (int j = 0; j < 8; ++j) { const f32x4 g4 = *((const f32x4*)gg + lane + 64 * j), b4 = *((const f32x4*)bb + lane + 64 * j); const f32x4 r = v[j] * rstd * g4 + b4;
                    o8[64 * j] = (unsigned long long)pk2(r.x, r.y) | ((unsigned long long)pk2(r.z, r.w) << 32); }
            }
        #endif
        PHASE_END
        PHASE_BEGIN(true)
#if (PH_MASK >> 9) & 1
            pg8::Gemm g{X, WFI, MT, 2 * DFF, D}; pg8::StaticOrder S; S.init(MT, 2 * DFF, F.G, (int)blockIdx.x); pg8::EpiSwiGLU E{HB, DFF};
            pg8::gemm_phase<pg8::EpiSwiGLU, pg8::StaticOrder, true, true>(F.lds + RING_OFF, g, S, E);
        #endif
        PHASE_END
        PHASE_BEGIN(true)
#if (PH_MASK >> 10) & 1
            pg8::Gemm g{HB, WFO, MT, D, DFF}; pg8::StaticOrder S; S.init(MT, D, F.G, (int)blockIdx.x); pg8::EpiRes E{Y, X, D, DN_ALPHA};
            pg8::gemm_phase<pg8::EpiRes, pg8::StaticOrder, true, true>(F.lds + RING_OFF, g, S, E);
        #endif
        PHASE_END
        PHASE_BEGIN(true)
#if (PH_MASK >> 11) & 1
            const float* gg = ln2_g + (size_t)l * D; const float* bb = ln2_b + (size_t)l * D;
            for (int row = F.gw; row < MR; row += F.NGW) {
                const f32x4* yr = (const f32x4*)(Y + (size_t)row * D) + lane; f32x4 v[8]; float s = 0.f;
#pragma unroll
                for (int j = 0; j < 8; ++j) { v[j] = yr[64 * j]; s += (v[j].x + v[j].y) + (v[j].z + v[j].w); }
                const float mean = wave_sum(s) * (1.f / D); float s2 = 0.f;
#pragma unroll
                for (int j = 0; j < 8; ++j) { v[j] = v[j] - mean; s2 += (v[j].x * v[j].x + v[j].y * v[j].y) + (v[j].z * v[j].z + v[j].w * v[j].w); }
                const float rstd = 1.f / sqrtf(wave_sum(s2) * (1.f / D) + LN_EPS);
                if (l == 3) { f32x4* of = (f32x4*)(row < MP ? out + O_YP + (size_t)row * D : out + O_YS + (size_t)(row - MP) * D) + lane;
#pragma unroll
                    for (int j = 0; j < 8; ++j) { const f32x4 g4 = *((const f32x4*)gg + lane + 64 * j), b4 = *((const f32x4*)bb + lane + 64 * j); of[64 * j] = v[j] * rstd * g4 + b4; } }
                else { unsigned long long* o8 = (unsigned long long*)(X + (size_t)row * D) + lane;
#pragma unroll
                    for (int j = 0; j < 8; ++j) { const f32x4 g4 = *((const f32x4*)gg + lane + 64 * j), b4 = *((const f32x4*)bb + lane + 64 * j); const f32x4 r = v[j] * rstd * g4 + b4;
                        o8[64 * j] = (unsigned long long)pk2(r.x, r.y) | ((unsigned long long)pk2(r.z, r.w) << 32); } }
            }
        #endif
        PHASE_END
    }
#undef PHASE_BEGIN
#undef PHASE_END
}

#ifndef MK_PER_PHASE
#define MK_PER_PHASE 0
#endif
constexpr int N_PHASES = 2 + 2 * 10 + 2 * 8;
extern "C" void kernel_launch(void* const* d_in, const int* in_sizes, int n_in, void* d_out, int out_size, void* d_ws, size_t ws_size, hipStream_t stream) {
    static int grid = 0;
    if (grid == 0) {
        if (n_in != 22 || in_sizes[0] != MP * D || (size_t)out_size != O_END || ws_size < WS_END) { fprintf(stderr, "kernel_launch: unexpected shapes (n_in %d, in0 %d, out %d, ws %zu); nothing launched\n", n_in, n_in > 0 ? in_sizes[0] : -1, out_size, ws_size); grid = -1; return; }
        int dev = 0, cus = 0, per_cu = 0;
        if (hipGetDevice(&dev) != hipSuccess || hipDeviceGetAttribute(&cus, hipDeviceAttributeMultiprocessorCount, dev) != hipSuccess) { grid = -1; return; }
        if (hipFuncSetAttribute((const void*)mega, hipFuncAttributeMaxDynamicSharedMemorySize, LDS_BYTES) != hipSuccess) { fprintf(stderr, "kernel_launch: hipFuncSetAttribute failed\n"); grid = -1; return; }
        if (hipOccupancyMaxActiveBlocksPerMultiprocessor(&per_cu, (const void*)mega, NWAVES * 64, LDS_BYTES) != hipSuccess || per_cu < 1) fprintf(stderr, "kernel_launch: occupancy query reports %d\n", per_cu);
        (void)hipGetLastError();
        grid = cus;
    }
    if (grid < 0) return;
    if (hipMemsetAsync((char*)d_ws + WS_CTL, 0, CTL_ZERO_BYTES, stream) != hipSuccess) return;
    Args a{};
    for (int i = 0; i < 22; ++i) a.in[i] = (const float*)d_in[i];
    a.out = (float*)d_out; a.ws = (unsigned char*)d_ws;
#if MK_PER_PHASE
    for (int p = 0; p < N_PHASES; ++p) { a.ph_lo = p; a.ph_hi = p + 1; hipLaunchKernelGGL(mega, dim3(grid), dim3(NWAVES * 64), LDS_BYTES, stream, a); }
#else
    a.ph_lo = 0; a.ph_hi = N_PHASES; hipLaunchKernelGGL(mega, dim3(grid), dim3(NWAVES * 64), LDS_BYTES, stream, a);
#endif
}
```

```cpp
#include <hip/hip_runtime.h>
#include <cstdio>
#include <cstdint>
namespace pg8 {
#define PG8_LAS __attribute__((address_space(3)))
typedef unsigned short bf16_t;
typedef short bf16x8 __attribute__((ext_vector_type(8)));
typedef float f32x4 __attribute__((ext_vector_type(4)));
typedef unsigned u32x4 __attribute__((ext_vector_type(4)));
constexpr int BM = 256, BK = 64, HALF = 128, HTB = HALF * BK * 2  , STAGE_BYTES = 8 * HTB, NXCD = 8, WGM = 8;

__host__ __device__ __forceinline__ int lds_byte(int r, int c) { const int st = (r >> 4) * 2 + (c >> 5), rr = r & 15, cc = c & 31, ob = rr * 64 + cc * 2; return st * 1024 + (ob ^ (((ob >> 9) & 1) << 5)); }
__host__ __device__ __forceinline__ void stage_rc(int b, int& R, int& C) { const int st = b / 1024, sb = b % 1024, swz = sb ^ (((sb >> 9) & 1) << 5); R = (st >> 1) * 16 + swz / 64; C = (st & 1) * 32 + (swz % 64) / 2; }
__host__ __device__ __forceinline__ int perm32(int rho) { const int n = rho >> 4, i = rho & 15; return 8 * (i >> 2) + 4 * n + (i & 3); }

struct Unit { int pm, pn; };
struct Gemm { const bf16_t* A; const bf16_t* Bt; int M, N, K; };

struct StaticOrder {
    int nM, nN, nwg, G, c;
    __host__ __device__ void init(int M, int N, int G_, int c_) { nM = M / BM; nN = N / BM; nwg = nM * nN; G = G_; c = c_; }
    __host__ __device__ bool next(int i, Unit& u) const {
        const long L = (long)i * G + c; if (L >= nwg) return false;
        int wgid = (int)L; { const int q = nwg / NXCD, r = nwg % NXCD, xcd = wgid % NXCD, off = wgid / NXCD; wgid = (xcd < r ? xcd * (q + 1) : r * (q + 1) + (xcd - r) * q) + off; }
        const int nig = WGM * nN, gid = wgid / nig, fm = gid * WGM, gsz = (nM - fm) < WGM ? (nM - fm) : WGM;
        u.pm = fm + ((wgid % nig) % gsz); u.pn = (wgid % nig) / gsz; return true;
    }
    __device__ __forceinline__ void a_ready(const Unit&) const {}
    __device__ __forceinline__ void done(const Unit&) const {}
};
__device__ __forceinline__ unsigned cvt_pk_bf16(float lo, float hi) { unsigned r; asm volatile("v_cvt_pk_bf16_f32 %0, %1, %2" : "=v"(r) : "v"(lo), "v"(hi)); return r; }
typedef float f32x2 __attribute__((ext_vector_type(2)));
typedef unsigned u32x2 __attribute__((ext_vector_type(2)));
__device__ __forceinline__ float bflo(unsigned w) { return __builtin_bit_cast(float, w << 16); }
__device__ __forceinline__ float bfhi(unsigned w) { return __builtin_bit_cast(float, w & 0xffff0000u); }
struct EpiBf16 {
    static constexpr bool PERM = true, AFTER_DRAIN = false;
    bf16_t* O; int ldc;
    __device__ __forceinline__ void operator()(const f32x4 (&acc)[2][2][4][2], const Unit& u, int wr, int wc, int fr, int fq) const {
        const int row0 = u.pm * BM + wr * 64 + fr, col0 = u.pn * BM + wc * 32 + 8 * fq;
#pragma unroll
        for (int ai = 0; ai < 2; ++ai)
#pragma unroll
            for (int m = 0; m < 4; ++m) { bf16_t* rowp = O + (size_t)(row0 + ai * HALF + m * 16) * ldc + col0;
#pragma unroll
                for (int bj = 0; bj < 2; ++bj) { const f32x4 v0 = acc[ai][bj][m][0], v1 = acc[ai][bj][m][1];
                    u32x4 w; w.x = cvt_pk_bf16(v0[0], v0[1]); w.y = cvt_pk_bf16(v0[2], v0[3]); w.z = cvt_pk_bf16(v1[0], v1[1]); w.w = cvt_pk_bf16(v1[2], v1[3]);
                    *(u32x4*)(rowp + bj * HALF) = w; } }
    }
};
struct EpiSwiGLU {
    static constexpr bool PERM = true, AFTER_DRAIN = false;
    bf16_t* Hh; int ldh;
    __device__ __forceinline__ float swi(float g, float up) const { return g * __builtin_amdgcn_rcpf(1.0f + __expf(-g)) * up; }
    __device__ __forceinline__ void operator()(const f32x4 (&acc)[2][2][4][2], const Unit& u, int wr, int wc, int fr, int fq) const {
        const int row0 = u.pm * BM + wr * 64 + fr, col0 = u.pn * HALF + wc * 32 + 8 * fq;
#pragma unroll
        for (int ai = 0; ai < 2; ++ai)
#pragma unroll
            for (int m = 0; m < 4; ++m) { bf16_t* rowp = Hh + (size_t)(row0 + ai * HALF + m * 16) * ldh + col0;
                const f32x4 g0 = acc[ai][0][m][0], g1 = acc[ai][0][m][1], u0 = acc[ai][1][m][0], u1 = acc[ai][1][m][1];
                u32x4 w; w.x = cvt_pk_bf16(swi(g0[0], u0[0]), swi(g0[1], u0[1])); w.y = cvt_pk_bf16(swi(g0[2], u0[2]), swi(g0[3], u0[3]));
                w.z = cvt_pk_bf16(swi(g1[0], u1[0]), swi(g1[1], u1[1])); w.w = cvt_pk_bf16(swi(g1[2], u1[2]), swi(g1[3], u1[3]));
                *(u32x4*)rowp = w; }
    }
};
struct EpiRes {
    static constexpr bool PERM = false, AFTER_DRAIN = false;
    float* Y; const bf16_t* X; int ldc; float alpha;
    __device__ __forceinline__ void operator()(const f32x4 (&acc)[2][2][4][2], const Unit& u, int wr, int wc, int fr, int fq) const {
        const int row0 = u.pm * BM + wr * 64 + fr, col0 = u.pn * BM + wc * 32 + 4 * fq;
#pragma unroll
        for (int ai = 0; ai < 2; ++ai)
#pragma unroll
            for (int m = 0; m < 4; ++m) { const size_t ro = (size_t)(row0 + ai * HALF + m * 16) * ldc + col0;
#pragma unroll
                for (int bj = 0; bj < 2; ++bj)
#pragma unroll
                    for (int n = 0; n < 2; ++n) { const size_t o = ro + bj * HALF + n * 16; const u32x2 xv = *(const u32x2*)(X + o);
                        f32x4 r; r[0] = alpha * bflo(xv.x); r[1] = alpha * bfhi(xv.x); r[2] = alpha * bflo(xv.y); r[3] = alpha * bfhi(xv.y);
                        *(f32x4*)(Y + o) = r + acc[ai][bj][m][n]; } }
    }
};
struct EpiKV {
    static constexpr bool PERM = false, AFTER_DRAIN = false;
    float *okp, *ovp, *oks, *ovs; bf16_t *kpb, *vpb, *ksb, *vsb;
    __device__ __forceinline__ void operator()(const f32x4 (&acc)[2][2][4][2], const Unit& u, int wr, int wc, int fr, int fq) const {
        const bool isv = u.pn >= 6; const int colt = (u.pn - (isv ? 6 : 0)) * BM + wc * 32 + 4 * fq, row0 = u.pm * BM + wr * 64 + fr;
        float* op = isv ? ovp : okp; float* os = isv ? ovs : oks; bf16_t* bp = isv ? vpb : kpb; bf16_t* bs = isv ? vsb : ksb;
#pragma unroll
        for (int ai = 0; ai < 2; ++ai)
#pragma unroll
            for (int m = 0; m < 4; ++m) { const int row = row0 + ai * HALF + m * 16; float* fd; bf16_t* bd;
                bf16_t* vt; size_t vld;
                if (row < 32768) { fd = op + (size_t)row * 1536; bd = bp + (size_t)row * 1536; vt = vpb + (size_t)((row >> 13) * 1536) * 8192 + (row & 8191); vld = 8192; }
                else if (row < 32896) { const int i = row - 32768; fd = os + (size_t)i * 1536; bd = bs + (size_t)((i >> 4) * 2064 + 2048 + (i & 15)) * 1536; vt = vsb + (size_t)((i >> 4) * 1536) * 2080 + 2048 + (i & 15); vld = 2080; }
                else continue;
#pragma unroll
                for (int bj = 0; bj < 2; ++bj)
#pragma unroll
                    for (int n = 0; n < 2; ++n) { const int c = colt + bj * HALF + n * 16; const f32x4 v = acc[ai][bj][m][n];
                        *(f32x4*)(fd + c) = v; const unsigned w0 = cvt_pk_bf16(v[0], v[1]), w1 = cvt_pk_bf16(v[2], v[3]);
                        if (!isv) { u32x2 w; w.x = w0; w.y = w1; *(u32x2*)(bd + c) = w; }
                        else { vt[(size_t)c * vld] = (bf16_t)w0; vt[(size_t)(c + 1) * vld] = (bf16_t)(w0 >> 16); vt[(size_t)(c + 2) * vld] = (bf16_t)w1; vt[(size_t)(c + 3) * vld] = (bf16_t)(w1 >> 16); } } }
    }
};
struct EpiMemKV {
    static constexpr bool PERM = false, AFTER_DRAIN = false;
    float *ok, *ov; bf16_t *kb, *vb;
    __device__ __forceinline__ void operator()(const f32x4 (&acc)[2][2][4][2], const Unit& u, int wr, int wc, int fr, int fq) const {
        const int l = u.pn >> 2, kv = (u.pn >> 1) & 1, hd0 = (u.pn & 1) * BM + wc * 32 + 4 * fq, row0 = u.pm * BM + wr * 64 + fr;
        float* fo = kv ? ov : ok; bf16_t* bo = kv ? vb : kb;
#pragma unroll
        for (int ai = 0; ai < 2; ++ai)
#pragma unroll
            for (int m = 0; m < 4; ++m) { const int row = row0 + ai * HALF + m * 16, b = row >> 8, mm = row & 255;
                float* fd = fo + (size_t)(l * 1024 + row) * 512; bf16_t* bd = bo + (size_t)((l * 12 + b) * 256 + mm) * 512;
#pragma unroll
                for (int bj = 0; bj < 2; ++bj)
#pragma unroll
                    for (int n = 0; n < 2; ++n) { const int c = hd0 + bj * HALF + n * 16; const f32x4 v = acc[ai][bj][m][n];
                        *(f32x4*)(fd + c) = v; const unsigned w0 = cvt_pk_bf16(v[0], v[1]), w1 = cvt_pk_bf16(v[2], v[3]);
                        if (!kv) { u32x2 w; w.x = w0; w.y = w1; *(u32x2*)(bd + c) = w; }
                        else { bf16_t* vt = vb + (size_t)((l * 12 + b) * 512 + c) * 256 + mm;
                            vt[0] = (bf16_t)w0; vt[256] = (bf16_t)(w0 >> 16); vt[512] = (bf16_t)w1; vt[768] = (bf16_t)(w1 >> 16); } } }
    }
};
template <class Epi, class Sched, bool ALIGN_EPI = false, bool SP2 = false>
__device__ __forceinline__ void gemm_phase(PG8_LAS unsigned char* lds, const Gemm g, const Sched& S, const Epi& E) {
    int tid_ = threadIdx.x; asm volatile("" : "+v"(tid_));
    const int tid = tid_, wid = __builtin_amdgcn_readfirstlane(tid >> 6), lane = tid & 63, wr = wid >> 2, wc = wid & 3, fr = lane & 15, fq = lane >> 4;
    const int K = g.K, nt = K / BK;
    unsigned voffA[2], voffB[2];
#pragma unroll
    for (int i = 0; i < 2; ++i) { int R, C; stage_rc(tid * 16 + i * 8192, R, C); const int Rb = Epi::PERM ? ((R & ~31) + perm32(R & 31)) : R;
        voffA[i] = (unsigned)(R * K + C) * 2u; voffB[i] = (unsigned)(Rb * K + C) * 2u; }
    const size_t kstep = (size_t)(BK * 2);
    const size_t hstep = (size_t)HALF * K * 2;
    const size_t tstep = 2 * hstep;
    const unsigned ldsw = (unsigned)wid * 1024u;
    const int aoff = lds_byte(wr * 64 + fr, fq * 8), boff = lds_byte(wc * 32 + fr, fq * 8);
#define PG8_SA(b, h) (((b) * 2 + (h)) * HTB)
#define PG8_SB(b, h) ((4 + (b) * 2 + (h)) * HTB)
#define PG8_STAGE(bufoff, gbase, voff) do { _Pragma("unroll") for (int _i = 0; _i < 2; ++_i) \
        __builtin_amdgcn_global_load_lds((const unsigned*)((const char*)(gbase) + (voff)[_i]), (PG8_LAS unsigned*)(lds + (bufoff) + ldsw + _i * 8192), 16, 0, 0); } while (0)
#define PG8_LDA(dst, b, h) do { _Pragma("unroll") for (int m = 0; m < 4; ++m) _Pragma("unroll") for (int k = 0; k < 2; ++k) dst[m][k] = *(const PG8_LAS bf16x8*)(lds + PG8_SA(b, h) + aoff + m * 2048 + k * 1024); } while (0)
#define PG8_LDB(dst, b, h) do { _Pragma("unroll") for (int n = 0; n < 2; ++n) _Pragma("unroll") for (int k = 0; k < 2; ++k) dst[n][k] = *(const PG8_LAS bf16x8*)(lds + PG8_SB(b, h) + boff + n * 2048 + k * 1024); } while (0)
#define PG8_MMA(ai, bj, At, Bt) do { __builtin_amdgcn_s_setprio(1); _Pragma("unroll") for (int m = 0; m < 4; ++m) _Pragma("unroll") for (int n = 0; n < 2; ++n) _Pragma("unroll") for (int k = 0; k < 2; ++k) \
        acc[ai][bj][m][n] = __builtin_amdgcn_mfma_f32_16x16x32_bf16(Bt[n][k], At[m][k], acc[ai][bj][m][n], 0, 0, 0); __builtin_amdgcn_s_setprio(0); } while (0)
#define PG8_WAIT_V(n) asm volatile("s_waitcnt vmcnt(" #n ")" ::: "memory")
#define PG8_WAIT_L(n) asm volatile("s_waitcnt lgkmcnt(" #n ")" ::: "memory")
#define PG8_BAR __builtin_amdgcn_s_barrier()
#define PG8_SCHED __builtin_amdgcn_sched_barrier(0)
    Unit cur, nxt; int ui = 0;
    if (!S.next(0, cur)) return;
    f32x4 acc[2][2][4][2];
#pragma unroll
    for (int a = 0; a < 2; ++a)
#pragma unroll
        for (int b = 0; b < 2; ++b)
#pragma unroll
            for (int m = 0; m < 4; ++m)
#pragma unroll
                for (int n = 0; n < 2; ++n) acc[a][b][m][n] = (f32x4){0.f, 0.f, 0.f, 0.f};
    bf16x8 At[4][2], B0[2][2], B1[2][2];
    const char* cA = (const char*)g.A + (size_t)cur.pm * tstep; const char* cB = (const char*)g.Bt + (size_t)cur.pn * tstep;
    S.a_ready(cur);
    if constexpr (SP2) {
        PG8_STAGE(PG8_SB(0, 0), cB, voffB); PG8_STAGE(PG8_SB(0, 1), cB + hstep, voffB); PG8_STAGE(PG8_SA(0, 0), cA, voffA); PG8_STAGE(PG8_SA(0, 1), cA + hstep, voffA);
        if (wr == 1) PG8_BAR;
        PG8_WAIT_V(2); PG8_BAR;
        PG8_STAGE(PG8_SB(1, 0), cB + kstep, voffB); PG8_STAGE(PG8_SA(1, 0), cA + kstep, voffA); PG8_STAGE(PG8_SB(1, 1), cB + hstep + kstep, voffB);
        PG8_WAIT_V(6); PG8_BAR;
    } else {
        PG8_STAGE(PG8_SB(0, 0), cB, voffB); PG8_STAGE(PG8_SA(0, 0), cA, voffA); PG8_STAGE(PG8_SB(0, 1), cB + hstep, voffB); PG8_STAGE(PG8_SA(0, 1), cA + hstep, voffA);
        if (wr == 1) PG8_BAR;
        PG8_WAIT_V(4); PG8_BAR;
        PG8_STAGE(PG8_SB(1, 0), cB + kstep, voffB); PG8_STAGE(PG8_SA(1, 0), cA + kstep, voffA); PG8_STAGE(PG8_SB(1, 1), cB + hstep + kstep, voffB);
        PG8_WAIT_V(6); PG8_BAR;
    }
    for (;;) {
        const bool has_next = S.next(ui + 1, nxt);
        const char* nA = has_next ? (const char*)g.A + (size_t)nxt.pm * tstep : cA; const char* nB = has_next ? (const char*)g.Bt + (size_t)nxt.pn * tstep : cB;
        for (int t = 0; t < nt; t += 2) {
            const bool last = (t == nt - 2);
            const char* a1 = cA + (size_t)(t + 1) * kstep;
            const char* a2 = last ? nA : cA + (size_t)(t + 2) * kstep; const char* b2 = last ? nB : cB + (size_t)(t + 2) * kstep;
            const char* a3 = a2 + kstep; const char* b3 = b2 + kstep;
            if (last && has_next) S.a_ready(nxt);
            if constexpr (SP2) {
            PG8_LDB(B0, 0, 0); PG8_LDB(B1, 0, 1); PG8_SCHED; PG8_LDA(At, 0, 0); PG8_STAGE(PG8_SA(1, 1), a1 + hstep, voffA);
            PG8_WAIT_V(8); PG8_WAIT_L(0); PG8_BAR; PG8_MMA(0, 0, At, B0); PG8_MMA(0, 1, At, B1); PG8_BAR; PG8_SCHED;
            PG8_LDA(At, 0, 1); PG8_STAGE(PG8_SB(0, 0), b2, voffB); PG8_STAGE(PG8_SB(0, 1), b2 + hstep, voffB); PG8_STAGE(PG8_SA(0, 0), a2, voffA);
            PG8_WAIT_V(8); PG8_WAIT_L(0); PG8_BAR; PG8_MMA(1, 0, At, B0); PG8_MMA(1, 1, At, B1); PG8_BAR; PG8_SCHED;
            PG8_LDB(B0, 1, 0); PG8_LDB(B1, 1, 1); PG8_SCHED; PG8_LDA(At, 1, 0); PG8_STAGE(PG8_SA(0, 1), a2 + hstep, voffA);
            PG8_WAIT_V(8); PG8_WAIT_L(0); PG8_BAR; PG8_MMA(0, 0, At, B0); PG8_MMA(0, 1, At, B1); PG8_BAR; PG8_SCHED;
            PG8_LDA(At, 1, 1); PG8_STAGE(PG8_SB(1, 0), b3, voffB); PG8_STAGE(PG8_SB(1, 1), b3 + hstep, voffB); PG8_STAGE(PG8_SA(1, 0), a3, voffA);
            PG8_WAIT_V(8); PG8_WAIT_L(0); PG8_BAR; PG8_MMA(1, 0, At, B0); PG8_MMA(1, 1, At, B1); PG8_BAR; PG8_SCHED;
            } else {
            PG8_LDB(B0, 0, 0); PG8_SCHED; PG8_LDA(At, 0, 0); PG8_STAGE(PG8_SA(1, 1), a1 + hstep, voffA);
            PG8_WAIT_L(8); PG8_BAR; PG8_WAIT_L(0); PG8_MMA(0, 0, At, B0); PG8_BAR; PG8_SCHED;
            PG8_LDB(B1, 0, 1); PG8_STAGE(PG8_SB(0, 0), b2, voffB);
            PG8_BAR; PG8_WAIT_L(0); PG8_MMA(0, 1, At, B1); PG8_BAR;
            PG8_LDA(At, 0, 1); PG8_STAGE(PG8_SA(0, 0), a2, voffA);
            PG8_BAR; PG8_WAIT_L(0); PG8_MMA(1, 0, At, B0); PG8_BAR; PG8_SCHED;
            PG8_STAGE(PG8_SB(0, 1), b2 + hstep, voffB);
            PG8_WAIT_V(6); PG8_BAR; PG8_MMA(1, 1, At, B1); PG8_BAR;
            PG8_LDB(B0, 1, 0); PG8_SCHED; PG8_LDA(At, 1, 0); PG8_STAGE(PG8_SA(0, 1), a2 + hstep, voffA);
            PG8_WAIT_L(8); PG8_BAR; PG8_WAIT_L(0); PG8_MMA(0, 0, At, B0); PG8_BAR; PG8_SCHED;
            PG8_LDB(B1, 1, 1); PG8_STAGE(PG8_SB(1, 0), b3, voffB);
            PG8_BAR; PG8_WAIT_L(0); PG8_MMA(0, 1, At, B1); PG8_BAR;
            PG8_LDA(At, 1, 1); PG8_STAGE(PG8_SA(1, 0), a3, voffA);
            PG8_BAR; PG8_WAIT_L(0); PG8_MMA(1, 0, At, B0); PG8_BAR; PG8_SCHED;
            PG8_STAGE(PG8_SB(1, 1), b3 + hstep, voffB);
            PG8_WAIT_V(6); PG8_BAR; PG8_MMA(1, 1, At, B1); PG8_BAR;
            }
        }
        if constexpr (ALIGN_EPI) { if (wr == 0) PG8_BAR; }
        if constexpr (!Epi::AFTER_DRAIN) { E(acc, cur, wr, wc, fr, fq); S.done(cur); }
        if (!has_next) break;
#pragma unroll
        for (int a = 0; a < 2; ++a)
#pragma unroll
            for (int b = 0; b < 2; ++b)
#pragma unroll
                for (int m = 0; m < 4; ++m)
#pragma unroll
                    for (int n = 0; n < 2; ++n) acc[a][b][m][n] = (f32x4){0.f, 0.f, 0.f, 0.f};
        cur = nxt; cA = nA; cB = nB; ++ui;
        if constexpr (ALIGN_EPI) { if (wr == 1) PG8_BAR; }
    }
    PG8_WAIT_V(0);
    if constexpr (!ALIGN_EPI) { if (wr == 0) PG8_BAR; }
    PG8_BAR;
    if constexpr (Epi::AFTER_DRAIN) { E.fused(acc, cur, wr, wc, fr, fq, lds, wid, lane); S.done(cur); }
#undef PG8_SA
#undef PG8_SB
#undef PG8_STAGE
#undef PG8_LDA
#undef PG8_LDB
#undef PG8_MMA
#undef PG8_WAIT_V
#undef PG8_WAIT_L
#undef PG8_BAR
#undef PG8_SCHED
}
}
#define GAS __attribute__((address_space(1)))
#define LAS __attribute__((address_space(3)))
typedef unsigned short bf16;
typedef unsigned v4u __attribute__((ext_vector_type(4)));
typedef float f32x4 __attribute__((ext_vector_type(4)));
typedef short bf16x8 __attribute__((ext_vector_type(8)));
typedef GAS unsigned gu32;
typedef GAS unsigned long long gu64;
#define RLX_AGENT __ATOMIC_RELAXED, __HIP_MEMORY_SCOPE_AGENT
#define LDS_WAIT() asm volatile("s_waitcnt lgkmcnt(0)" ::: "memory")
#define VM_WAIT() asm volatile("s_waitcnt vmcnt(0)" ::: "memory")
__device__ __forceinline__ unsigned long long rt() { return __builtin_amdgcn_s_memrealtime(); }
__device__ __forceinline__ unsigned f2bf(float f) { unsigned u = __builtin_bit_cast(unsigned, f); return (u + 0x7fffu + ((u >> 16) & 1u)) >> 16; }
__device__ __forceinline__ unsigned pk2(float lo, float hi) { return f2bf(lo) | (f2bf(hi) << 16); }
#define XB_TMO      128
#define XB_XCNT(j)  (256  + 64 * (j))
#define XB_XSUB(j)  (1280 + 64 * (j))
#define XB_XGEN(j)  (2304 + 64 * (j))
#define XB_TOP      3328
#define XB_TOPGEN   3392
#define XCD_BAR_WORDS 3456
#define XB_SPIN_CAP (1u << 18)

__device__ __forceinline__ unsigned xb_ld(unsigned* p)              { return __hip_atomic_load(p, __ATOMIC_RELAXED, __HIP_MEMORY_SCOPE_AGENT); }
__device__ __forceinline__ unsigned xb_add(unsigned* p, unsigned v) { return __hip_atomic_fetch_add(p, v, __ATOMIC_RELAXED, __HIP_MEMORY_SCOPE_AGENT); }
__device__ __forceinline__ unsigned xb_xcc_id() { return (unsigned)__builtin_amdgcn_s_getreg((3 << 11) | 20) & 0xFu; }
#define XB_SPIN(cond, bar) do { unsigned _sp = 0; while (cond) { __builtin_amdgcn_s_sleep(1); \
    if ((++_sp & 255u) == 0u) { if (xb_ld(&(bar)[XB_TMO])) break; if (_sp > XB_SPIN_CAP) { atomicAdd(&(bar)[XB_TMO], 1u); break; } } } } while (0)

struct XcdBarrier {
    unsigned* bar; unsigned x;
    volatile LAS unsigned* st;
};

__device__ __forceinline__ XcdBarrier xcd_barrier_post(unsigned* bar, volatile LAS unsigned* st) {
    XcdBarrier b; b.bar = bar; b.x = xb_xcc_id(); b.st = st;
    if (threadIdx.x == 0) (void)xb_add(&bar[XB_XCNT(b.x)], 1u);
    return b;
}
__device__ __forceinline__ void xcd_barrier_complete(unsigned* bar, unsigned x, unsigned& nloc, unsigned& nx) {
    const unsigned G = gridDim.x * gridDim.y * gridDim.z;
    unsigned sum, cnt, mine, sp = 0u;
    for (;;) {
        sum = 0u; cnt = 0u; mine = 0u;
#pragma unroll
        for (unsigned j = 0; j < 16; ++j) { const unsigned c = xb_ld(&bar[XB_XCNT(j)]); sum += c; cnt += (c > 0u) ? 1u : 0u; mine = (j == x) ? c : mine; }
        if (sum == G) break;
        __builtin_amdgcn_s_sleep(1);
        if ((++sp & 255u) == 0u) { if (xb_ld(&bar[XB_TMO])) break; if (sp > XB_SPIN_CAP) { atomicAdd(&bar[XB_TMO], 1u); break; } }
    }
    nloc = mine > 0u ? mine : 1u; nx = cnt > 0u ? cnt : 1u;
}

__device__ __forceinline__ void xcd_barrier(const XcdBarrier& b) {
    asm volatile("s_waitcnt vmcnt(0)" ::: "memory");
    __syncthreads();
    if (threadIdx.x == 0) {
        unsigned* bar = b.bar;
        __builtin_amdgcn_s_waitcnt(0);
        unsigned nloc = b.st[0], nx = b.st[1];
        if (nloc == 0u) { xcd_barrier_complete(bar, b.x, nloc, nx); b.st[0] = nloc; b.st[1] = nx; }
        const unsigned old = xb_add(&bar[XB_XSUB(b.x)], 1u);
        const unsigned gen = old / nloc;
        if (old + 1u == (gen + 1u) * nloc) {
            __builtin_amdgcn_fence(__ATOMIC_RELEASE, "agent");
            asm volatile("s_waitcnt vmcnt(0)" ::: "memory");
            const unsigned og = xb_add(&bar[XB_TOP], 1u);
            const unsigned tg = og / nx;
            if (og + 1u == (tg + 1u) * nx) xb_add(&bar[XB_TOPGEN], 1u);
            else XB_SPIN(xb_ld(&bar[XB_TOPGEN]) == tg, bar);
            __builtin_amdgcn_fence(__ATOMIC_ACQUIRE, "agent");
            xb_add(&bar[XB_XGEN(b.x)], 1u);
            asm volatile("s_waitcnt vmcnt(0)" ::: "memory");
        } else {
            XB_SPIN(xb_ld(&bar[XB_XGEN(b.x)]) == gen, bar);
            __builtin_amdgcn_fence(__ATOMIC_ACQUIRE, "agent");
            asm volatile("s_waitcnt vmcnt(0)" ::: "memory");
        }
    }
    __syncthreads();
}
constexpr int NWAVES = 8;
constexpr int D = 2048, SEQ = 8192, MP = 32768, MS = 128, MR = 32896, MT = 33024;
constexpr int DFF = 5632, NA = 5376, NBQ = 2048, NKV = 3072;
constexpr int CQ = 0, CK = 768, CV = 1536, CG = 3072, CQM = 4608, CLR = 5120;
constexpr float DN_ALPHA = 1.6817928305074292f, LN_EPS = 1e-5f, RMS_EPS = 1e-6f;
constexpr float GLA_QSCALE = 0.07216878364870323f, HD_SCALE = 0.08838834764831845f;
constexpr size_t MiB = 1u << 20;
constexpr size_t WS_CTL = 0, CTL_ZERO_BYTES = 1 * MiB;
constexpr size_t WS_WIN = 1 * MiB, WS_WO = 22 * MiB, WS_WFI = 30 * MiB, WS_WFO = 74 * MiB, WS_WMEM = 96 * MiB, WS_MEMX = 112 * MiB, WS_MEMK = 116 * MiB, WS_MEMV = 128 * MiB;
constexpr size_t WS_X = 140 * MiB, WS_Y = 269 * MiB, WS_R1 = 527 * MiB, WS_OCAT = 882 * MiB, WS_SBKS = 1011 * MiB, WS_SBVS = 1060 * MiB, WS_END = 1109 * MiB;
static_assert(WS_WIN + (size_t)NA * D * 2 <= WS_WO && WS_WFI + (size_t)2 * DFF * D * 2 <= WS_WFO && WS_WFO + (size_t)D * DFF * 2 <= WS_WMEM, "weights map");
static_assert(WS_X + (size_t)MT * D * 2 <= WS_Y && WS_Y + (size_t)MT * D * 4 <= WS_R1 && WS_R1 + (size_t)MT * DFF * 2 <= WS_OCAT && WS_OCAT + (size_t)MT * D * 2 <= WS_SBKS, "activation map");
static_assert(WS_SBKS + (size_t)8 * 2064 * 1536 * 2 <= WS_SBVS && WS_SBVS + (size_t)8 * 2064 * 1536 * 2 <= WS_END, "sb sample map");
constexpr size_t O_YP = 0, O_YS = 67108864, O_GSP = 67371008, O_GSS = 69730304, O_SKP = 74448896, O_SVP = 124780544, O_SKS = 175112192, O_SVS = 175308800, O_MKP = 175505408, O_MVP = 177602560, O_END = 179699712;
constexpr int CW_BAR = 4096;
constexpr int RING_OFF = 0, RING_BYTES = 131072, LDSCTL_OFF = RING_BYTES, MISC_OFF = LDSCTL_OFF + 320, LDS_BYTES = 147456;

struct Args { const float* in[22]; float* out; unsigned char* ws; int ph_lo, ph_hi; };
struct Frame {
    LAS unsigned char* lds; volatile LAS unsigned* MISC; gu32* ctl;
    int tid, lane, wave, G, gw, NGW;
};
__device__ __forceinline__ float bf2f(bf16 h) { return __builtin_bit_cast(float, (unsigned)h << 16); }
__device__ __forceinline__ float wave_sum(float v) {
#pragma unroll
    for (int o = 1; o < 64; o <<= 1) v += __shfl_xor(v, o);
    return v;
}
__device__ __forceinline__ float wave_max(float v) {
#pragma unroll
    for (int o = 1; o < 64; o <<= 1) v = fmaxf(v, __shfl_xor(v, o));
    return v;
}
__device__ __forceinline__ void cvt_row(const float* src, bf16* dst, int n, int lane) {
    for (int j = lane * 4; j < n; j += 256) {
        f32x4 v = src ? *(const f32x4*)(src + j) : (f32x4){0.f, 0.f, 0.f, 0.f};
        unsigned long long w = (unsigned long long)pk2(v.x, v.y) | ((unsigned long long)pk2(v.z, v.w) << 32);
        *(unsigned long long*)(dst + j) = w;
    }
}
struct MapId { __device__ __forceinline__ int operator()(int n) const { return n; } };
struct MapInA { __device__ __forceinline__ int operator()(int n) const { return n < 4608 ? n : (n < 5120 ? n + 16 : (n < 5136 ? n - 512 : -1)); } };
struct MapFfn { __device__ __forceinline__ int operator()(int n) const { const int t = n >> 8, r = n & 255; return r < 128 ? 128 * t + r : DFF + 128 * t + (r - 128); } };
template <class Map>
__device__ __forceinline__ void wt_convert(const Frame& F, int lane, const float* W, int K, int Nsrc, bf16* WT, int Ndst, Map map) {
    LAS float* scr = (LAS float*)(F.lds + RING_OFF + F.wave * 16384);
    const int nblk = Ndst / 32, nitems = (K / 64) * nblk;
    for (int it = F.gw; it < nitems; it += F.NGW) {
        const int kb = it / nblk, nb = it % nblk, k0 = 64 * kb, n0 = 32 * nb;
        const int sc = map(n0 + (lane & 31));
#pragma unroll 8
        for (int i = 0; i < 32; ++i) { const int kk = 2 * i + (lane >> 5); scr[kk * 33 + (lane & 31)] = sc >= 0 ? W[(size_t)(k0 + kk) * Nsrc + sc] : 0.f; }
        LDS_WAIT(); asm volatile("" ::: "memory");
        const int c = lane & 7;
#pragma unroll
        for (int j = 0; j < 4; ++j) { const int n = (lane >> 3) + 8 * j; const LAS float* s = scr + (8 * c) * 33 + n;
            v4u o; o.x = pk2(s[0 * 33], s[1 * 33]); o.y = pk2(s[2 * 33], s[3 * 33]); o.z = pk2(s[4 * 33], s[5 * 33]); o.w = pk2(s[6 * 33], s[7 * 33]);
            *(GAS v4u*)(WT + (size_t)(n0 + n) * K + k0 + 8 * c) = o; }
        LDS_WAIT(); asm volatile("" ::: "memory");
    }
}
__device__ __forceinline__ float softplus_f(float z) { return fmaxf(z, 0.f) + log1pf(__expf(-fabsf(z))); }

typedef short s16x4 __attribute__((ext_vector_type(4)));
typedef pg8::u32x2 u32x2;
typedef float f32x16 __attribute__((ext_vector_type(16)));
typedef __bf16 bf16x2_t __attribute__((ext_vector_type(2)));
typedef float f32x2_t __attribute__((ext_vector_type(2)));
__device__ __forceinline__ unsigned cvt2(float lo, float hi) { const f32x2_t v = {lo, hi}; const bf16x2_t b = __builtin_convertvector(v, bf16x2_t); return __builtin_bit_cast(unsigned, b); }
__device__ __forceinline__ bf16x8 pack8(const f32x4 a, const f32x4 b) { v4u p; p.x = cvt2(a[0], a[1]); p.y = cvt2(a[2], a[3]); p.z = cvt2(b[0], b[1]); p.w = cvt2(b[2], b[3]); return __builtin_bit_cast(bf16x8, p); }
__device__ __forceinline__ bf16x8 ld2x8(const bf16* p0, const bf16* p1) { const s16x4 a = *(const s16x4*)p0, b = *(const s16x4*)p1; return __builtin_shufflevector(a, b, 0, 1, 2, 3, 4, 5, 6, 7); }
__device__ __forceinline__ bf16x8 ld16(const bf16* p) { return *(const bf16x8*)p; }
#define MFMA16(a, b, c) __builtin_amdgcn_mfma_f32_16x16x32_bf16((a), (b), (c), 0, 0, 0)
#define MFMA32(a, b, c) __builtin_amdgcn_mfma_f32_32x32x16_bf16((a), (b), (c), 0, 0, 0)

constexpr int PKG_Q = 0, PKG_K = 24576, PKG_KT = 49152, PKG_VT = 73728, PKG_G = 122880, PKG_BYTES = 123648, N_PKG = 2048 + 32;

__device__ __forceinline__ void gla_prep(int gw, int NGW, int lane, int l, const bf16* PROJ, const float* w_gate_lr, const float* b_gate, unsigned char* PKG) {
    const float* w2 = w_gate_lr + (size_t)l * 16 * 768; const float* bg = b_gate + (size_t)l * 768;
    for (int item = gw; item < N_PKG; item += NGW) {
        int h, row0, T;
        if (item < 2048) { const int bh = item >> 7, ch = item & 127; h = bh & 3; row0 = (bh >> 2) * SEQ + ch * 64; T = 64; }
        else { const int i2 = item - 2048; h = i2 & 3; row0 = MP + (i2 >> 2) * 16; T = 16; }
        unsigned char* pk = PKG + (size_t)item * PKG_BYTES;
        bf16* Qt = (bf16*)(pk + PKG_Q); bf16* Kt = (bf16*)(pk + PKG_K); bf16* KT = (bf16*)(pk + PKG_KT); bf16* VT = (bf16*)(pk + PKG_VT); float* Gp = (float*)(pk + PKG_G);
        float w2c[3][16], bgc[3], bc[3];
#pragma unroll
        for (int c = 0; c < 3; ++c) { const int d = h * 192 + lane + 64 * c; bgc[c] = bg[d]; bc[c] = 0.f;
#pragma unroll
            for (int r = 0; r < 16; ++r) w2c[c][r] = w2[r * 768 + d]; }
        for (int t8 = 0; t8 < 8; ++t8) {
            unsigned ktw[3][4];
#pragma unroll
            for (int tt = 0; tt < 8; ++tt) {
                const int t = 8 * t8 + tt; unsigned kb[3];
                if (t < T) {
                    const bf16* prow = PROJ + (size_t)(row0 + t) * NA;
                    const v4u l0 = *(const v4u*)(prow + CLR), l1 = *(const v4u*)(prow + CLR + 8);
                    float lr[16]; lr[0] = pg8::bflo(l0.x); lr[1] = pg8::bfhi(l0.x); lr[2] = pg8::bflo(l0.y); lr[3] = pg8::bfhi(l0.y); lr[4] = pg8::bflo(l0.z); lr[5] = pg8::bfhi(l0.z); lr[6] = pg8::bflo(l0.w); lr[7] = pg8::bfhi(l0.w);
                    lr[8] = pg8::bflo(l1.x); lr[9] = pg8::bfhi(l1.x); lr[10] = pg8::bflo(l1.y); lr[11] = pg8::bfhi(l1.y); lr[12] = pg8::bflo(l1.z); lr[13] = pg8::bfhi(l1.z); lr[14] = pg8::bflo(l1.w); lr[15] = pg8::bfhi(l1.w);
#pragma unroll
                    for (int c = 0; c < 3; ++c) { const int dl = lane + 64 * c; float xg = bgc[c];
#pragma unroll
                        for (int r = 0; r < 16; ++r) xg += lr[r] * w2c[c][r];
                        bc[c] += -softplus_f(-xg) * (1.0f / 16.0f);
                        const float eq = __expf(bc[c]), ek = __expf(-bc[c]);
                        const float q = bf2f(prow[CQ + h * 192 + dl]) * GLA_QSCALE * eq, k = bf2f(prow[CK + h * 192 + dl]) * ek;
                        kb[c] = f2bf(k); Qt[t * 192 + dl] = (bf16)f2bf(q); Kt[t * 192 + dl] = (bf16)kb[c]; }
                } else {
#pragma unroll
                    for (int c = 0; c < 3; ++c) { const int dl = lane + 64 * c; kb[c] = 0u; Qt[t * 192 + dl] = 0; Kt[t * 192 + dl] = 0; }
                }
#pragma unroll
                for (int c = 0; c < 3; ++c) { if (tt & 1) ktw[c][tt >> 1] |= kb[c] << 16; else ktw[c][tt >> 1] = kb[c]; }
            }
#pragma unroll
            for (int c = 0; c < 3; ++c) { v4u o; o.x = ktw[c][0]; o.y = ktw[c][1]; o.z = ktw[c][2]; o.w = ktw[c][3]; *(v4u*)(KT + (size_t)(lane + 64 * c) * 64 + 8 * t8) = o; }
        }
#pragma unroll
        for (int c = 0; c < 3; ++c) Gp[lane + 64 * c] = __expf(bc[c]);
        for (int t8 = 0; t8 < 8; ++t8) {
#pragma unroll
            for (int c2 = 0; c2 < 6; ++c2) { const int v = lane + 64 * c2; unsigned w[4];
#pragma unroll
                for (int tt = 0; tt < 8; ++tt) { const int t = 8 * t8 + tt; const unsigned vb = t < T ? (unsigned)PROJ[(size_t)(row0 + t) * NA + CV + h * 384 + v] : 0u;
                    if (tt & 1) w[tt >> 1] |= vb << 16; else w[tt >> 1] = vb; }
                v4u o; o.x = w[0]; o.y = w[1]; o.z = w[2]; o.w = w[3]; *(v4u*)(VT + (size_t)v * 64 + 8 * t8) = o; }
        }
    }
}

__device__ __forceinline__ void gla_chain(int c, int lane, int l, const unsigned char* PKG, const float* state_gla, bf16* OCAT, float* out) {
    const int fr = lane & 15, fq = lane >> 4;
    int h, vs, item0, nsteps, row0, nvalid; const float* s0; float* sout;
    if (c < 384) { const int bh = c / 24; vs = c % 24; h = bh & 3; item0 = bh * 128; nsteps = 128; row0 = (bh >> 2) * SEQ; nvalid = 64; s0 = nullptr; sout = out + O_GSP + (size_t)(l * 16 + bh) * 192 * 384; }
    else { const int c2 = c - 384, bh = c2 / 24; vs = c2 % 24; h = bh & 3; item0 = 2048 + bh; nsteps = 1; row0 = MP + (bh >> 2) * 16; nvalid = 16; s0 = state_gla + (size_t)(l * 32 + bh) * 192 * 384; sout = out + O_GSS + (size_t)(l * 32 + bh) * 192 * 384; }
    const int v0 = vs * 16;
    f32x4 S[12];
#pragma unroll
    for (int t = 0; t < 12; ++t)
#pragma unroll
        for (int jj = 0; jj < 4; ++jj) S[t][jj] = s0 ? s0[(size_t)(16 * t + 4 * fq + jj) * 384 + v0 + fr] : 0.f;
    for (int n = 0; n < nsteps; ++n) {
        const unsigned char* pk = PKG + (size_t)(item0 + n) * PKG_BYTES;
        const bf16* Qt = (const bf16*)(pk + PKG_Q); const bf16* Kt = (const bf16*)(pk + PKG_K); const bf16* KT = (const bf16*)(pk + PKG_KT);
        const bf16* VT = (const bf16*)(pk + PKG_VT) + (size_t)(v0 + fr) * 64; const float* Gp = (const float*)(pk + PKG_G);
        bf16x8 vt[2], Sb[6];
#pragma unroll
        for (int s2 = 0; s2 < 2; ++s2) vt[s2] = ld2x8(VT + 32 * s2 + 4 * fq, VT + 32 * s2 + 16 + 4 * fq);
#pragma unroll
        for (int s = 0; s < 6; ++s) Sb[s] = pack8(S[2 * s], S[2 * s + 1]);
#pragma unroll
        for (int it = 0; it < 4; ++it) {
            bf16x8 qf[6];
            const bf16* qr = Qt + (size_t)(16 * it + fr) * 192 + 4 * fq;
#pragma unroll
            for (int s = 0; s < 6; ++s) qf[s] = ld2x8(qr + 32 * s, qr + 32 * s + 16);
            f32x4 o = {0.f, 0.f, 0.f, 0.f};
#pragma unroll
            for (int s = 0; s < 6; ++s) o = MFMA16(Sb[s], qf[s], o);
            f32x4 at[4];
#pragma unroll
            for (int jt = 0; jt < 4; ++jt) { at[jt] = (f32x4){0.f, 0.f, 0.f, 0.f};
                if (jt <= it) { const bf16* kr = Kt + (size_t)(16 * jt + fr) * 192 + 4 * fq;
#pragma unroll
                    for (int s = 0; s < 6; ++s) at[jt] = MFMA16(ld2x8(kr + 32 * s, kr + 32 * s + 16), qf[s], at[jt]); } }
#pragma unroll
            for (int jj = 0; jj < 4; ++jj) if (4 * fq + jj > fr) at[it][jj] = 0.f;
            o = MFMA16(vt[0], pack8(at[0], at[1]), o);
            if (it >= 2) o = MFMA16(vt[1], pack8(at[2], at[3]), o);
            const int tl = 16 * it + fr;
            if (tl < nvalid) { u32x2 w; w.x = cvt2(o[0], o[1]); w.y = cvt2(o[2], o[3]); *(u32x2*)(OCAT + (size_t)(row0 + 64 * n + tl) * D + h * 384 + v0 + 4 * fq) = w; }
        }
#pragma unroll
        for (int t = 0; t < 12; ++t) { const bf16* kr = KT + (size_t)(16 * t + fr) * 64 + 4 * fq;
#pragma unroll
            for (int s2 = 0; s2 < 2; ++s2) S[t] = MFMA16(ld2x8(kr + 32 * s2, kr + 32 * s2 + 16), vt[s2], S[t]);
            S[t] = S[t] * *(const f32x4*)(Gp + 16 * t + 4 * fq); }
    }
#pragma unroll
    for (int t = 0; t < 12; ++t)
#pragma unroll
        for (int jj = 0; jj < 4; ++jj) sout[(size_t)(16 * t + 4 * fq + jj) * 384 + v0 + fr] = S[t][jj];
}

__device__ __forceinline__ void mem_attn(int item, int lane, int l, const bf16* PROJ, int ldp, int cqm, const bf16* MEMK, const bf16* MEMVT, bf16* OCAT) {
    const int fr = lane & 15, fq = lane >> 4, tile = item >> 2, h = item & 3, r0 = tile * 16;
    const int bb = r0 < MP ? r0 / SEQ : 4 + ((r0 - MP) >> 4);
    const bf16* Kb = MEMK + (size_t)((l * 12 + bb) * 256) * 512 + h * 128; const bf16* Vt = MEMVT + (size_t)(((l * 12 + bb) * 4 + h) * 128) * 256;
    bf16x8 qf[4];
#pragma unroll
    for (int s = 0; s < 4; ++s) qf[s] = ld16(PROJ + (size_t)(r0 + fr) * ldp + cqm + h * 128 + 32 * s + 8 * fq);
    f32x4 st[16];
#pragma unroll
    for (int mt = 0; mt < 16; ++mt) { st[mt] = (f32x4){0.f, 0.f, 0.f, 0.f}; const bf16* kr = Kb + (size_t)(16 * mt + fr) * 512 + 8 * fq;
#pragma unroll
        for (int s = 0; s < 4; ++s) st[mt] = MFMA16(ld16(kr + 32 * s), qf[s], st[mt]); }
    float mx = -3.0e38f;
#pragma unroll
    for (int mt = 0; mt < 16; ++mt) mx = fmaxf(mx, fmaxf(fmaxf(st[mt][0], st[mt][1]), fmaxf(st[mt][2], st[mt][3])));
    mx = fmaxf(mx, __shfl_xor(mx, 16)); mx = fmaxf(mx, __shfl_xor(mx, 32));
    float sum = 0.f;
#pragma unroll
    for (int mt = 0; mt < 16; ++mt)
#pragma unroll
        for (int jj = 0; jj < 4; ++jj) { const float p = __expf((st[mt][jj] - mx) * HD_SCALE); st[mt][jj] = p; sum += p; }
    sum += __shfl_xor(sum, 16); sum += __shfl_xor(sum, 32);
    const float inv = 1.0f / sum;
    bf16x8 pf[8];
#pragma unroll
    for (int s = 0; s < 8; ++s) pf[s] = pack8(st[2 * s], st[2 * s + 1]);
#pragma unroll
    for (int dt = 0; dt < 8; ++dt) { f32x4 o = {0.f, 0.f, 0.f, 0.f}; const bf16* vr = Vt + (size_t)(16 * dt + fr) * 256 + 4 * fq;
#pragma unroll
        for (int s = 0; s < 8; ++s) o = MFMA16(ld2x8(vr + 32 * s, vr + 32 * s + 16), pf[s], o);
        u32x2 w; w.x = cvt2(o[0] * inv, o[1] * inv); w.y = cvt2(o[2] * inv, o[3] * inv);
        *(u32x2*)(OCAT + (size_t)(r0 + fr) * D + 1536 + h * 128 + 16 * dt + 4 * fq) = w; }
}

__device__ __forceinline__ void sb_attn(int lane, const bf16* Kp, int ldk, const bf16* VTp, int ldvt, const bf16* Qp, int ldq, bf16* Op, int t0, int nq) {
    const int r = lane & 31, hh = lane >> 5;
    bf16x8 qf[8];
#pragma unroll
    for (int ks = 0; ks < 8; ++ks) qf[ks] = ld16(Qp + (size_t)r * ldq + 16 * ks + 8 * hh);
    f32x16 oacc[4];
#pragma unroll
    for (int dt = 0; dt < 4; ++dt)
#pragma unroll
        for (int i = 0; i < 16; ++i) oacc[dt][i] = 0.f;
    float carry = 0.f;
    for (int s0 = t0; s0 >= 0; s0 -= 32) {
        f32x16 st;
#pragma unroll
        for (int i = 0; i < 16; ++i) st[i] = 0.f;
        const bf16* kr = Kp + (size_t)(s0 + r) * ldk + 8 * hh;
#pragma unroll
        for (int ks = 0; ks < 8; ++ks) st = MFMA32(ld16(kr + 16 * ks), qf[ks], st);
        const bool diag = (s0 == t0);
        float l1[16], lb[16];
#pragma unroll
        for (int i = 0; i < 16; ++i) { const float z = st[i] * HD_SCALE, sp = softplus_f(z); lb[i] = z - sp; l1[i] = -sp;
            if (diag && !(((i & 3) + 8 * (i >> 2) + 4 * hh) < r)) { l1[i] = 0.f; lb[i] = -1.0e30f; } }
        float g[4], pgv[4];
#pragma unroll
        for (int m = 0; m < 4; ++m) { g[m] = (l1[4 * m] + l1[4 * m + 1]) + (l1[4 * m + 2] + l1[4 * m + 3]); pgv[m] = __shfl_xor(g[m], 32); }
        float R[4]; R[3] = 0.f; R[2] = g[3] + pgv[3]; R[1] = R[2] + g[2] + pgv[2]; R[0] = R[1] + g[1] + pgv[1];
        const float total = R[0] + g[0] + pgv[0];
        float w[16];
#pragma unroll
        for (int m = 0; m < 4; ++m) { const float suf = carry + R[m] + (hh == 0 ? pgv[m] : 0.f);
            const float t3 = suf, t2 = t3 + l1[4 * m + 3], t1 = t2 + l1[4 * m + 2], t0_ = t1 + l1[4 * m + 1];
            w[4 * m + 3] = __expf(lb[4 * m + 3] + t3); w[4 * m + 2] = __expf(lb[4 * m + 2] + t2); w[4 * m + 1] = __expf(lb[4 * m + 1] + t1); w[4 * m] = __expf(lb[4 * m] + t0_); }
        carry += total;
#pragma unroll
        for (int k2 = 0; k2 < 2; ++k2) {
            v4u p; p.x = cvt2(w[8 * k2], w[8 * k2 + 1]); p.y = cvt2(w[8 * k2 + 2], w[8 * k2 + 3]); p.z = cvt2(w[8 * k2 + 4], w[8 * k2 + 5]); p.w = cvt2(w[8 * k2 + 6], w[8 * k2 + 7]);
            const bf16x8 wf = __builtin_bit_cast(bf16x8, p);
#pragma unroll
            for (int dt = 0; dt < 4; ++dt) { const bf16* vr = VTp + (size_t)(32 * dt + r) * ldvt + s0 + 16 * k2 + 4 * hh; oacc[dt] = MFMA32(ld2x8(vr, vr + 8), wf, oacc[dt]); }
        }
        if (__all((r >= nq) || (carry < -104.f))) break;
    }
    if (r < nq) {
#pragma unroll
        for (int dt = 0; dt < 4; ++dt)
#pragma unroll
            for (int g4 = 0; g4 < 4; ++g4) { u32x2 wv; wv.x = cvt2(oacc[dt][4 * g4], oacc[dt][4 * g4 + 1]); wv.y = cvt2(oacc[dt][4 * g4 + 2], oacc[dt][4 * g4 + 3]);
                *(u32x2*)(Op + (size_t)r * D + 32 * dt + 8 * g4 + 4 * hh) = wv; }
    }
}
#ifndef PH_MASK
#define PH_MASK 0xFFFF
#endif
__global__ void __launch_bounds__(NWAVES * 64, 2) mega(Args args) {
    extern __shared__ __attribute__((aligned(16))) unsigned char lds[];
    Frame F;
    F.lds = (LAS unsigned char*)lds; F.MISC = (volatile LAS unsigned*)(F.lds + MISC_OFF);
    F.tid = threadIdx.x; F.lane = F.tid & 63; F.wave = __builtin_amdgcn_readfirstlane(F.tid >> 6);
    F.G = gridDim.x; F.gw = blockIdx.x * NWAVES + F.wave; F.NGW = F.G * NWAVES;
    unsigned char* ws = args.ws; float* out = args.out;
    F.ctl = (gu32*)(ws + WS_CTL);
    for (int u = F.tid; u < (LDS_BYTES - LDSCTL_OFF) / 4; u += NWAVES * 64) ((LAS unsigned*)(F.lds + LDSCTL_OFF))[u] = 0u;
    __syncthreads();
    XcdBarrier bar = xcd_barrier_post((unsigned*)(F.ctl + CW_BAR), F.MISC + 8);
    const int lo = args.ph_lo, hi = args.ph_hi; int ph = 0;
    const float* x_prompt = args.in[0]; const float* x_sample = args.in[1]; const float* mem_prompt = args.in[2]; const float* state_gla = args.in[3];
    const float* cache_sb_k = args.in[4]; const float* cache_sb_v = args.in[5]; const float* cache_mem_k = args.in[6]; const float* cache_mem_v = args.in[7];
    const float* w_in_a = args.in[8]; const float* w_gate_lr = args.in[9]; const float* b_gate = args.in[10]; const float* gla_norm_g = args.in[11];
    const float* w_in_b = args.in[12]; const float* w_kv_shared = args.in[13]; const float* w_mem_kv = args.in[14]; const float* w_o = args.in[15];
    const float* ln1_g = args.in[16]; const float* ln1_b = args.in[17]; const float* ln2_g = args.in[18]; const float* ln2_b = args.in[19];
    const float* w_ffn_in = args.in[20]; const float* w_ffn_out = args.in[21];
    bf16* WIN = (bf16*)(ws + WS_WIN); bf16* WO = (bf16*)(ws + WS_WO); bf16* WFI = (bf16*)(ws + WS_WFI); bf16* WFO = (bf16*)(ws + WS_WFO); bf16* WMEM = (bf16*)(ws + WS_WMEM);
    bf16* MEMX = (bf16*)(ws + WS_MEMX); bf16* MEMK = (bf16*)(ws + WS_MEMK); bf16* MEMV = (bf16*)(ws + WS_MEMV);
    bf16* X = (bf16*)(ws + WS_X); float* Y = (float*)(ws + WS_Y); bf16* PROJ = (bf16*)(ws + WS_R1); bf16* HB = (bf16*)(ws + WS_R1); bf16* OCAT = (bf16*)(ws + WS_OCAT);
    bf16* SBKS = (bf16*)(ws + WS_SBKS); bf16* SBVS = (bf16*)(ws + WS_SBVS);
    bf16* KPB = (bf16*)(out + O_YP); bf16* VPB = KPB + (size_t)MP * 1536;

#define PHASE_BEGIN(cond) if (cond) { if (lo <= ph && ph < hi) { if (ph > lo) xcd_barrier(bar); int tid_ = threadIdx.x; asm volatile("" : "+v"(tid_)); const int tid = tid_, lane = tid_ & 63; (void)tid; (void)lane;
#define PHASE_END } ++ph; }

    PHASE_BEGIN(true)
#if (PH_MASK >> 0) & 1
        for (int r = F.gw; r < MT; r += F.NGW) cvt_row(r < MP ? x_prompt + (size_t)r * D : (r < MR ? x_sample + (size_t)(r - MP) * D : nullptr), X + (size_t)r * D, D, lane);
        for (int r = F.gw; r < 1024; r += F.NGW) cvt_row(mem_prompt + (size_t)r * D, MEMX + (size_t)r * D, D, lane);
        for (int r = F.gw; r < 4 * 8 * 256; r += F.NGW) { const int l = r >> 11, b = (r >> 8) & 7, m = r & 255; const size_t dst = (size_t)((l * 12 + 4 + b) * 256 + m) * 512;
            cvt_row(cache_mem_k + (size_t)r * 512, MEMK + dst, 512, lane); }
        for (int it = F.gw; it < 512; it += F.NGW) { const int hdb = it & 3, mb = (it >> 2) & 3, b = (it >> 4) & 7, l = it >> 7, m = mb * 64 + lane;
            const float* src = cache_mem_v + (size_t)((l * 8 + b) * 256 + m) * 512 + hdb * 128; bf16* dst = MEMV + (size_t)((l * 12 + 4 + b) * 512 + hdb * 128) * 256 + m;
            for (int q4 = 0; q4 < 32; ++q4) { const f32x4 v = *(const f32x4*)(src + 4 * q4);
#pragma unroll
                for (int e = 0; e < 4; ++e) dst[(size_t)(4 * q4 + e) * 256] = (bf16)f2bf(v[e]); } }
        for (int r = F.gw; r < 8 * 2048; r += F.NGW) { const int b = r >> 11, s = r & 2047; const size_t dst = (size_t)(b * 2064 + s) * 1536;
            cvt_row(cache_sb_k + (size_t)r * 1536, SBKS + dst, 1536, lane); }
        for (int it = F.gw; it < 3072; it += F.NGW) { const int cb = it % 12, sb_ = (it / 12) & 31, b = it / 384, s = sb_ * 64 + lane;
            const float* src = cache_sb_v + (size_t)(b * 2048 + s) * 1536 + cb * 128; bf16* dst = SBVS + (size_t)(b * 1536 + cb * 128) * 2080 + s;
            for (int q4 = 0; q4 < 32; ++q4) { const f32x4 v = *(const f32x4*)(src + 4 * q4);
#pragma unroll
                for (int e = 0; e < 4; ++e) dst[(size_t)(4 * q4 + e) * 2080] = (bf16)f2bf(v[e]); } }
        for (int l = 0; l < 4; ++l) wt_convert(F, lane, w_mem_kv + (size_t)l * D * 1024, D, 1024, WMEM + (size_t)l * 1024 * D, 1024, MapId());
    #endif
        PHASE_END
    PHASE_BEGIN(true)
#if (PH_MASK >> 1) & 1
        pg8::Gemm g{MEMX, WMEM, 1024, 4096, D}; pg8::StaticOrder S; S.init(1024, 4096, F.G, (int)blockIdx.x);
        pg8::EpiMemKV E{out + O_MKP, out + O_MVP, MEMK, MEMV};
        pg8::gemm_phase<pg8::EpiMemKV, pg8::StaticOrder, true, true>(F.lds + RING_OFF, g, S, E);
    #endif
        PHASE_END

    for (int l = 0; l < 4; ++l) {
        const bool LA = l < 2;
        PHASE_BEGIN(true)
#if (PH_MASK >> 2) & 1
            if (LA) wt_convert(F, lane, w_in_a + (size_t)l * D * 5136, D, 5136, WIN, NA, MapInA());
            else { wt_convert(F, lane, w_in_b + (size_t)(l - 2) * D * NBQ, D, NBQ, WIN, NBQ, MapId()); if (l == 2) wt_convert(F, lane, w_kv_shared, D, NKV, WIN + (size_t)NBQ * D, NKV, MapId()); }
            wt_convert(F, lane, w_o + (size_t)l * D * D, D, D, WO, D, MapId());
            wt_convert(F, lane, w_ffn_in + (size_t)l * D * 2 * DFF, D, 2 * DFF, WFI, 2 * DFF, MapFfn());
            wt_convert(F, lane, w_ffn_out + (size_t)l * DFF * D, DFF, D, WFO, D, MapId());
        #endif
        PHASE_END
        const int ldp = LA ? NA : NBQ;
        PHASE_BEGIN(true)
#if (PH_MASK >> 3) & 1
            { pg8::Gemm g{X, WIN, MT, ldp, D}; pg8::StaticOrder S; S.init(MT, ldp, F.G, (int)blockIdx.x); pg8::EpiBf16 E{PROJ, ldp};
              pg8::gemm_phase<pg8::EpiBf16, pg8::StaticOrder, true, true>(F.lds + RING_OFF, g, S, E); }
            if (l == 2) { pg8::Gemm g{X, WIN + (size_t)NBQ * D, MT, NKV, D}; pg8::StaticOrder S; S.init(MT, NKV, F.G, (int)blockIdx.x);
              pg8::EpiKV E{out + O_SKP, out + O_SVP, out + O_SKS, out + O_SVS, KPB, VPB, SBKS, SBVS};
              pg8::gemm_phase<pg8::EpiKV, pg8::StaticOrder, true, true>(F.lds + RING_OFF, g, S, E); }
        #endif
        PHASE_END
        PHASE_BEGIN(LA)
#if (PH_MASK >> 4) & 1
            gla_prep(F.gw, F.NGW, lane, l, PROJ, w_gate_lr, b_gate, (unsigned char*)Y);
#endif
        PHASE_END
        PHASE_BEGIN(true)
#if (PH_MASK >> 5) & 1
            if (LA) {
                for (int c = (int)blockIdx.x + F.G * F.wave; c < 384 + 768; c += F.NGW) gla_chain(c, lane, l, (const unsigned char*)Y, state_gla, OCAT, out);
            } else {
                for (int u = F.gw; u < 12288 + 96; u += F.NGW) {
                    if (u < 12288) { const int bh = u >> 8, qb = u & 255, b = bh / 12, h = bh % 12, t0 = 32 * qb; const size_t qo = (size_t)(b * SEQ + t0) * D + h * 128;
                        sb_attn(lane, KPB + (size_t)(b * SEQ) * 1536 + h * 128, 1536, VPB + (size_t)(bh * 128) * SEQ, SEQ, PROJ + qo, NBQ, OCAT + qo, t0, 32); }
                    else { const int u2 = u - 12288, b = u2 / 12, h = u2 % 12; const size_t qo = (size_t)(MP + b * 16) * D + h * 128;
                        sb_attn(lane, SBKS + (size_t)(b * 2064) * 1536 + h * 128, 1536, SBVS + (size_t)(u2 * 128) * 2080, 2080, PROJ + qo, NBQ, OCAT + qo, 2048, 16); }
                }
            }
            for (int item = F.gw; item < (MR / 16) * 4; item += F.NGW) mem_attn(item, lane, l, PROJ, ldp, LA ? CQM : 1536, MEMK, MEMV, OCAT);
#endif
        PHASE_END
        PHASE_BEGIN(LA)
#if (PH_MASK >> 6) & 1
            const float* gn = gla_norm_g + (size_t)l * 384;
            for (int row = F.gw; row < MR; row += F.NGW) {
#pragma unroll
                for (int h = 0; h < 4; ++h) { bf16* op = OCAT + (size_t)row * D + h * 384; const bf16* gp = PROJ + (size_t)row * NA + CG + h * 384;
                    float ov[6]; float ss = 0.f;
#pragma unroll
                    for (int j = 0; j < 3; ++j) { const unsigned w = *(const unsigned*)(op + 2 * lane + 128 * j); ov[2 * j] = pg8::bflo(w); ov[2 * j + 1] = pg8::bfhi(w); ss += ov[2 * j] * ov[2 * j] + ov[2 * j + 1] * ov[2 * j + 1]; }
                    const float r = 1.0f / sqrtf(wave_sum(ss) * (1.0f / 384.0f) + RMS_EPS);
#pragma unroll
                    for (int j = 0; j < 3; ++j) { const int c = 2 * lane + 128 * j; const unsigned gw2 = *(const unsigned*)(gp + c); const float g0 = pg8::bflo(gw2), g1 = pg8::bfhi(gw2);
                        const float r0 = ov[2 * j] * r * gn[c] * (g0 / (1.0f + __expf(-g0))), r1 = ov[2 * j + 1] * r * gn[c + 1] * (g1 / (1.0f + __expf(-g1)));
                        *(unsigned*)(op + c) = pk2(r0, r1); } }
            }
        #endif
        PHASE_END
        PHASE_BEGIN(true)
#if (PH_MASK >> 7) & 1
            pg8::Gemm g{OCAT, WO, MT, D, D}; pg8::StaticOrder S; S.init(MT, D, F.G, (int)blockIdx.x); pg8::EpiRes E{Y, X, D, DN_ALPHA};
            pg8::gemm_phase<pg8::EpiRes, pg8::StaticOrder, true, true>(F.lds + RING_OFF, g, S, E);
        #endif
        PHASE_END
        PHASE_BEGIN(true)
#if (PH_MASK >> 8) & 1
            const float* gg = ln1_g + (size_t)l * D; const float* bb = ln1_b + (size_t)l * D;
            for (int row = F.gw; row < MR; row += F.NGW) {
                const f32x4* yr = (const f32x4*)(Y + (size_t)row * D) + lane; f32x4 v[8]; float s = 0.f;
#pragma unroll
                for (int j = 0; j < 8; ++j) { v[j] = yr[64 * j]; s += (v[j].x + v[j].y) + (v[j].z + v[j].w); }
                const float mean = wave_sum(s) * (1.f / D); float s2 = 0.f;
#pragma unroll
                for (int j = 0; j < 8; ++j) { v[j] = v[j] - mean; s2 += (v[j].x * v[j].x + v[j].y * v[j].y) + (v[j].z * v[j].z + v[j].w * v[j].w); }
                const float rstd = 1.f / sqrtf(wave_sum(s2) * (1.f / D) + LN_EPS);
                unsigned long long* o8 = (unsigned long long*)(X + (size_t)row * D) + lane;
#pragma unroll
                for (int j = 0; j < 8; ++j) { const f32x4 g4 = *((const f32x4*)gg + lane + 64 * j), b4 = *((const f32x4*)bb + lane + 64 * j); const f32x4 r = v[j] * rstd * g4 + b4;
                    o8[64 * j] = (unsigned long long)pk2(r.x, r.y) | ((unsigned long long)pk2(r.z, r.w) << 32); }
            }
        #endif
        PHASE_END
        PHASE_BEGIN(true)
#if (PH_MASK >> 9) & 1
            pg8::Gemm g{X, WFI, MT, 2 * DFF, D}; pg8::StaticOrder S; S.init(MT, 2 * DFF, F.G, (int)blockIdx.x); pg8::EpiSwiGLU E{HB, DFF};
            pg8::gemm_phase<pg8::EpiSwiGLU, pg8::StaticOrder, true, true>(F.lds + RING_OFF, g, S, E);
        #endif
        PHASE_END
        PHASE_BEGIN(true)
#if (PH_MASK >> 10) & 1
            pg8::Gemm g{HB, WFO, MT, D, DFF}; pg8::StaticOrder S; S.init(MT, D, F.G, (int)blockIdx.x); pg8::EpiRes E{Y, X, D, DN_ALPHA};
            pg8::gemm_phase<pg8::EpiRes, pg8::StaticOrder, true, true>(F.lds + RING_OFF, g, S, E);
        #endif
        PHASE_END
        PHASE_BEGIN(true)
#if (PH_MASK >> 11) & 1
            const float* gg = ln2_g + (size_t)l * D; const float* bb = ln2_b + (size_t)l * D;
            for (int row = F.gw; row < MR; row += F.NGW) {
                const f32x4* yr = (const f32x4*)(Y + (size_t)row * D) + lane; f32x4 v[8]; float s = 0.f;
#pragma unroll
                for (int j = 0; j < 8; ++j) { v[j] = yr[64 * j]; s += (v[j].x + v[j].y) + (v[j].z + v[j].w); }
                const float mean = wave_sum(s) * (1.f / D); float s2 = 0.f;
#pragma unroll
                for (int j = 0; j < 8; ++j) { v[j] = v[j] - mean; s2 += (v[j].x * v[j].x + v[j].y * v[j].y) + (v[j].z * v[j].z + v[j].w * v[j].w); }
                const float rstd = 1.f / sqrtf(wave_sum(s2) * (1.f / D) + LN_EPS);
                if (l == 3) { f32x4* of = (f32x4*)(row < MP ? out + O_YP + (size_t)row * D : out + O_YS + (size_t)(row - MP) * D) + lane;
#pragma unroll
                    for (int j = 0; j < 8; ++j) { const f32x4 g4 = *((const f32x4*)gg + lane + 64 * j), b4 = *((const f32x4*)bb + lane + 64 * j); of[64 * j] = v[j] * rstd * g4 + b4; } }
                else { unsigned long long* o8 = (unsigned long long*)(X + (size_t)row * D) + lane;
#pragma unroll
                    for (int j = 0; j < 8; ++j) { const f32x4 g4 = *((const f32x4*)gg + lane + 64 * j), b4 = *((const f32x4*)bb + lane + 64 * j); const f32x4 r = v[j] * rstd * g4 + b4;
                        o8[64 * j] = (unsigned long long)pk2(r.x, r.y) | ((unsigned long long)pk2(r.z, r.w) << 32); } }
            }
        #endif
        PHASE_END
    }
#undef PHASE_BEGIN
#undef PHASE_END
}

#ifndef MK_PER_PHASE
#define MK_PER_PHASE 0
#endif
constexpr int N_PHASES = 2 + 2 * 10 + 2 * 8;
extern "C" void kernel_launch(void* const* d_in, const int* in_sizes, int n_in, void* d_out, int out_size, void* d_ws, size_t ws_size, hipStream_t stream) {
    static int grid = 0;
    if (grid == 0) {
        if (n_in != 22 || in_sizes[0] != MP * D || (size_t)out_size != O_END || ws_size < WS_END) { fprintf(stderr, "kernel_launch: unexpected shapes (n_in %d, in0 %d, out %d, ws %zu); nothing launched\n", n_in, n_in > 0 ? in_sizes[0] : -1, out_size, ws_size); grid = -1; return; }
        int dev = 0, cus = 0, per_cu = 0;
        if (hipGetDevice(&dev) != hipSuccess || hipDeviceGetAttribute(&cus, hipDeviceAttributeMultiprocessorCount, dev) != hipSuccess) { grid = -1; return; }
        if (hipFuncSetAttribute((const void*)mega, hipFuncAttributeMaxDynamicSharedMemorySize, LDS_BYTES) != hipSuccess) { fprintf(stderr, "kernel_launch: hipFuncSetAttribute failed\n"); grid = -1; return; }
        if (hipOccupancyMaxActiveBlocksPerMultiprocessor(&per_cu, (const void*)mega, NWAVES * 64, LDS_BYTES) != hipSuccess || per_cu < 1) fprintf(stderr, "kernel_launch: occupancy query reports %d\n", per_cu);
        (void)hipGetLastError();
        grid = cus;
    }
    if (grid < 0) return;
    if (hipMemsetAsync((char*)d_ws + WS_CTL, 0, CTL_ZERO_BYTES, stream) != hipSuccess) return;
    Args a{};
    for (int i = 0; i < 22; ++i) a.in[i] = (const float*)d_in[i];
    a.out = (float*)d_out; a.ws = (unsigned char*)d_ws;
#if MK_PER_PHASE
    for (int p = 0; p < N_PHASES; ++p) { a.ph_lo = p; a.ph_hi = p + 1; hipLaunchKernelGGL(mega, dim3(grid), dim3(NWAVES * 64), LDS_BYTES, stream, a); }
#else
    a.ph_lo = 0; a.ph_hi = N_PHASES; hipLaunchKernelGGL(mega, dim3(grid), dim3(NWAVES * 64), LDS_BYTES, stream, a);
#endif
}
```

```cpp
#include <hip/hip_runtime.h>
#include <cstdio>
#include <cstdint>
namespace pg8 {
#define PG8_LAS __attribute__((address_space(3)))
typedef unsigned short bf16_t;
typedef short bf16x8 __attribute__((ext_vector_type(8)));
typedef float f32x4 __attribute__((ext_vector_type(4)));
typedef unsigned u32x4 __attribute__((ext_vector_type(4)));
constexpr int BM = 256, BK = 64, HALF = 128, HTB = HALF * BK * 2  , STAGE_BYTES = 8 * HTB, NXCD = 8, WGM = 8;

__host__ __device__ __forceinline__ int lds_byte(int r, int c) { const int st = (r >> 4) * 2 + (c >> 5), rr = r & 15, cc = c & 31, ob = rr * 64 + cc * 2; return st * 1024 + (ob ^ (((ob >> 9) & 1) << 5)); }
__host__ __device__ __forceinline__ void stage_rc(int b, int& R, int& C) { const int st = b / 1024, sb = b % 1024, swz = sb ^ (((sb >> 9) & 1) << 5); R = (st >> 1) * 16 + swz / 64; C = (st & 1) * 32 + (swz % 64) / 2; }
__host__ __device__ __forceinline__ int perm32(int rho) { const int n = rho >> 4, i = rho & 15; return 8 * (i >> 2) + 4 * n + (i & 3); }

struct Unit { int pm, pn; };
struct Gemm { const bf16_t* A; const bf16_t* Bt; int M, N, K; };

struct StaticOrder {
    int nM, nN, nwg, G, c;
    __host__ __device__ void init(int M, int N, int G_, int c_) { nM = M / BM; nN = N / BM; nwg = nM * nN; G = G_; c = c_; }
    __host__ __device__ bool next(int i, Unit& u) const {
        const long L = (long)i * G + c; if (L >= nwg) return false;
        int wgid = (int)L; { const int q = nwg / NXCD, r = nwg % NXCD, xcd = wgid % NXCD, off = wgid / NXCD; wgid = (xcd < r ? xcd * (q + 1) : r * (q + 1) + (xcd - r) * q) + off; }
        const int nig = WGM * nN, gid = wgid / nig, fm = gid * WGM, gsz = (nM - fm) < WGM ? (nM - fm) : WGM;
        u.pm = fm + ((wgid % nig) % gsz); u.pn = (wgid % nig) / gsz; return true;
    }
    __device__ __forceinline__ void a_ready(const Unit&) const {}
    __device__ __forceinline__ void done(const Unit&) const {}
};
__device__ __forceinline__ unsigned cvt_pk_bf16(float lo, float hi) { unsigned r; asm volatile("v_cvt_pk_bf16_f32 %0, %1, %2" : "=v"(r) : "v"(lo), "v"(hi)); return r; }
typedef float f32x2 __attribute__((ext_vector_type(2)));
typedef unsigned u32x2 __attribute__((ext_vector_type(2)));
__device__ __forceinline__ float bflo(unsigned w) { return __builtin_bit_cast(float, w << 16); }
__device__ __forceinline__ float bfhi(unsigned w) { return __builtin_bit_cast(float, w & 0xffff0000u); }
struct EpiBf16 {
    static constexpr bool PERM = true, AFTER_DRAIN = false;
    bf16_t* O; int ldc;
    __device__ __forceinline__ void operator()(const f32x4 (&acc)[2][2][4][2], const Unit& u, int wr, int wc, int fr, int fq) const {
        const int row0 = u.pm * BM + wr * 64 + fr, col0 = u.pn * BM + wc * 32 + 8 * fq;
#pragma unroll
        for (int ai = 0; ai < 2; ++ai)
#pragma unroll
            for (int m = 0; m < 4; ++m) { bf16_t* rowp = O + (size_t)(row0 + ai * HALF + m * 16) * ldc + col0;
#pragma unroll
                for (int bj = 0; bj < 2; ++bj) { const f32x4 v0 = acc[ai][bj][m][0], v1 = acc[ai][bj][m][1];
                    u32x4 w; w.x = cvt_pk_bf16(v0[0], v0[1]); w.y = cvt_pk_bf16(v0[2], v0[3]); w.z = cvt_pk_bf16(v1[0], v1[1]); w.w = cvt_pk_bf16(v1[2], v1[3]);
                    *(u32x4*)(rowp + bj * HALF) = w; } __builtin_amdgcn_sched_barrier(0); }
    }
};
struct EpiSwiGLU {
    static constexpr bool PERM = true, AFTER_DRAIN = false;
    bf16_t* Hh; int ldh;
    __device__ __forceinline__ float swi(float g, float up) const { return g * __builtin_amdgcn_rcpf(1.0f + __expf(-g)) * up; }
    __device__ __forceinline__ void operator()(const f32x4 (&acc)[2][2][4][2], const Unit& u, int wr, int wc, int fr, int fq) const {
        const int row0 = u.pm * BM + wr * 64 + fr, col0 = u.pn * HALF + wc * 32 + 8 * fq;
#pragma unroll
        for (int ai = 0; ai < 2; ++ai)
#pragma unroll
            for (int m = 0; m < 4; ++m) { bf16_t* rowp = Hh + (size_t)(row0 + ai * HALF + m * 16) * ldh + col0;
                const f32x4 g0 = acc[ai][0][m][0], g1 = acc[ai][0][m][1], u0 = acc[ai][1][m][0], u1 = acc[ai][1][m][1];
                u32x4 w; w.x = cvt_pk_bf16(swi(g0[0], u0[0]), swi(g0[1], u0[1])); w.y = cvt_pk_bf16(swi(g0[2], u0[2]), swi(g0[3], u0[3]));
                w.z = cvt_pk_bf16(swi(g1[0], u1[0]), swi(g1[1], u1[1])); w.w = cvt_pk_bf16(swi(g1[2], u1[2]), swi(g1[3], u1[3]));
                *(u32x4*)rowp = w; __builtin_amdgcn_sched_barrier(0); }
    }
};
struct EpiRes {
    static constexpr bool PERM = false, AFTER_DRAIN = false;
    float* Y; const bf16_t* X; int ldc; float alpha;
    __device__ __forceinline__ void operator()(const f32x4 (&acc)[2][2][4][2], const Unit& u, int wr, int wc, int fr, int fq) const {
        const int row0 = u.pm * BM + wr * 64 + fr, col0 = u.pn * BM + wc * 32 + 4 * fq;
#pragma unroll
        for (int ai = 0; ai < 2; ++ai)
#pragma unroll
            for (int m = 0; m < 4; ++m) { const size_t ro = (size_t)(row0 + ai * HALF + m * 16) * ldc + col0;
#pragma unroll
                for (int bj = 0; bj < 2; ++bj)
#pragma unroll
                    for (int n = 0; n < 2; ++n) { const size_t o = ro + bj * HALF + n * 16; const u32x2 xv = *(const u32x2*)(X + o);
                        f32x4 r; r[0] = alpha * bflo(xv.x); r[1] = alpha * bfhi(xv.x); r[2] = alpha * bflo(xv.y); r[3] = alpha * bfhi(xv.y);
                        *(f32x4*)(Y + o) = r + acc[ai][bj][m][n]; } __builtin_amdgcn_sched_barrier(0); }
    }
};
struct EpiKV {
    static constexpr bool PERM = false, AFTER_DRAIN = false;
    float *okp, *ovp, *oks, *ovs; bf16_t *kpb, *vpb, *ksb, *vsb;
    __device__ __forceinline__ void operator()(const f32x4 (&acc)[2][2][4][2], const Unit& u, int wr, int wc, int fr, int fq) const {
        const bool isv = u.pn >= 6; const int colt = (u.pn - (isv ? 6 : 0)) * BM + wc * 32 + 4 * fq, row0 = u.pm * BM + wr * 64 + fr;
        float* op = isv ? ovp : okp; float* os = isv ? ovs : oks; bf16_t* bp = isv ? vpb : kpb; bf16_t* bs = isv ? vsb : ksb;
#pragma unroll
        for (int ai = 0; ai < 2; ++ai)
#pragma unroll
            for (int m = 0; m < 4; ++m) { const int row = row0 + ai * HALF + m * 16; float* fd; bf16_t* bd;
                bf16_t* vt; size_t vld;
                if (row < 32768) { fd = op + (size_t)row * 1536; bd = bp + (size_t)row * 1536; vt = vpb + (size_t)((row >> 13) * 1536) * 8192 + (row & 8191); vld = 8192; }
                else if (row < 32896) { const int i = row - 32768; fd = os + (size_t)i * 1536; bd = bs + (size_t)((i >> 4) * 2064 + 2048 + (i & 15)) * 1536; vt = vsb + (size_t)((i >> 4) * 1536) * 2080 + 2048 + (i & 15); vld = 2080; }
                else continue;
#pragma unroll
                for (int bj = 0; bj < 2; ++bj)
#pragma unroll
                    for (int n = 0; n < 2; ++n) { const int c = colt + bj * HALF + n * 16; const f32x4 v = acc[ai][bj][m][n];
                        *(f32x4*)(fd + c) = v; const unsigned w0 = cvt_pk_bf16(v[0], v[1]), w1 = cvt_pk_bf16(v[2], v[3]);
                        if (!isv) { u32x2 w; w.x = w0; w.y = w1; *(u32x2*)(bd + c) = w; }
                        else { vt[(size_t)c * vld] = (bf16_t)w0; vt[(size_t)(c + 1) * vld] = (bf16_t)(w0 >> 16); vt[(size_t)(c + 2) * vld] = (bf16_t)w1; vt[(size_t)(c + 3) * vld] = (bf16_t)(w1 >> 16); } } }
    }
};
struct EpiMemKV {
    static constexpr bool PERM = false, AFTER_DRAIN = false;
    float *ok, *ov; bf16_t *kb, *vb;
    __device__ __forceinline__ void operator()(const f32x4 (&acc)[2][2][4][2], const Unit& u, int wr, int wc, int fr, int fq) const {
        const int l = u.pn >> 2, kv = (u.pn >> 1) & 1, hd0 = (u.pn & 1) * BM + wc * 32 + 4 * fq, row0 = u.pm * BM + wr * 64 + fr;
        float* fo = kv ? ov : ok; bf16_t* bo = kv ? vb : kb;
#pragma unroll
        for (int ai = 0; ai < 2; ++ai)
#pragma unroll
            for (int m = 0; m < 4; ++m) { const int row = row0 + ai * HALF + m * 16, b = row >> 8, mm = row & 255;
                float* fd = fo + (size_t)(l * 1024 + row) * 512; bf16_t* bd = bo + (size_t)((l * 12 + b) * 256 + mm) * 512;
#pragma unroll
                for (int bj = 0; bj < 2; ++bj)
#pragma unroll
                    for (int n = 0; n < 2; ++n) { const int c = hd0 + bj * HALF + n * 16; const f32x4 v = acc[ai][bj][m][n];
                        *(f32x4*)(fd + c) = v; const unsigned w0 = cvt_pk_bf16(v[0], v[1]), w1 = cvt_pk_bf16(v[2], v[3]);
                        if (!kv) { u32x2 w; w.x = w0; w.y = w1; *(u32x2*)(bd + c) = w; }
                        else { bf16_t* vt = vb + (size_t)((l * 12 + b) * 512 + c) * 256 + mm;
                            vt[0] = (bf16_t)w0; vt[256] = (bf16_t)(w0 >> 16); vt[512] = (bf16_t)w1; vt[768] = (bf16_t)(w1 >> 16); } } }
    }
};
template <class Epi, class Sched, bool ALIGN_EPI = false, bool SP2 = false>
__device__ __forceinline__ void gemm_phase(PG8_LAS unsigned char* lds, const Gemm g, const Sched& S, const Epi& E) {
    int tid_ = threadIdx.x; asm volatile("" : "+v"(tid_));
    const int tid = tid_, wid = __builtin_amdgcn_readfirstlane(tid >> 6), lane = tid & 63, wr = wid >> 2, wc = wid & 3, fr = lane & 15, fq = lane >> 4;
    const int K = g.K, nt = K / BK;
    unsigned voffA[2], voffB[2];
#pragma unroll
    for (int i = 0; i < 2; ++i) { int R, C; stage_rc(tid * 16 + i * 8192, R, C); const int Rb = Epi::PERM ? ((R & ~31) + perm32(R & 31)) : R;
        voffA[i] = (unsigned)(R * K + C) * 2u; voffB[i] = (unsigned)(Rb * K + C) * 2u; }
    const size_t kstep = (size_t)(BK * 2);
    const size_t hstep = (size_t)HALF * K * 2;
    const size_t tstep = 2 * hstep;
    const unsigned ldsw = (unsigned)wid * 1024u;
    const int aoff = lds_byte(wr * 64 + fr, fq * 8), boff = lds_byte(wc * 32 + fr, fq * 8);
#define PG8_SA(b, h) (((b) * 2 + (h)) * HTB)
#define PG8_SB(b, h) ((4 + (b) * 2 + (h)) * HTB)
#define PG8_STAGE(bufoff, gbase, voff) do { _Pragma("unroll") for (int _i = 0; _i < 2; ++_i) \
        __builtin_amdgcn_global_load_lds((const unsigned*)((const char*)(gbase) + (voff)[_i]), (PG8_LAS unsigned*)(lds + (bufoff) + ldsw + _i * 8192), 16, 0, 0); } while (0)
#define PG8_LDA(dst, b, h) do { _Pragma("unroll") for (int m = 0; m < 4; ++m) _Pragma("unroll") for (int k = 0; k < 2; ++k) dst[m][k] = *(const PG8_LAS bf16x8*)(lds + PG8_SA(b, h) + aoff + m * 2048 + k * 1024); } while (0)
#define PG8_LDB(dst, b, h) do { _Pragma("unroll") for (int n = 0; n < 2; ++n) _Pragma("unroll") for (int k = 0; k < 2; ++k) dst[n][k] = *(const PG8_LAS bf16x8*)(lds + PG8_SB(b, h) + boff + n * 2048 + k * 1024); } while (0)
#define PG8_MMA(ai, bj, At, Bt) do { __builtin_amdgcn_s_setprio(1); _Pragma("unroll") for (int m = 0; m < 4; ++m) _Pragma("unroll") for (int n = 0; n < 2; ++n) _Pragma("unroll") for (int k = 0; k < 2; ++k) \
        acc[ai][bj][m][n] = __builtin_amdgcn_mfma_f32_16x16x32_bf16(Bt[n][k], At[m][k], acc[ai][bj][m][n], 0, 0, 0); __builtin_amdgcn_s_setprio(0); } while (0)
#define PG8_WAIT_V(n) asm volatile("s_waitcnt vmcnt(" #n ")" ::: "memory")
#define PG8_WAIT_L(n) asm volatile("s_waitcnt lgkmcnt(" #n ")" ::: "memory")
#define PG8_BAR __builtin_amdgcn_s_barrier()
#define PG8_SCHED __builtin_amdgcn_sched_barrier(0)
    Unit cur, nxt; int ui = 0;
    if (!S.next(0, cur)) return;
    f32x4 acc[2][2][4][2];
#pragma unroll
    for (int a = 0; a < 2; ++a)
#pragma unroll
        for (int b = 0; b < 2; ++b)
#pragma unroll
            for (int m = 0; m < 4; ++m)
#pragma unroll
                for (int n = 0; n < 2; ++n) acc[a][b][m][n] = (f32x4){0.f, 0.f, 0.f, 0.f};
    bf16x8 At[4][2], B0[2][2], B1[2][2];
    const char* cA = (const char*)g.A + (size_t)cur.pm * tstep; const char* cB = (const char*)g.Bt + (size_t)cur.pn * tstep;
    S.a_ready(cur);
    if constexpr (SP2) {
        PG8_STAGE(PG8_SB(0, 0), cB, voffB); PG8_STAGE(PG8_SB(0, 1), cB + hstep, voffB); PG8_STAGE(PG8_SA(0, 0), cA, voffA); PG8_STAGE(PG8_SA(0, 1), cA + hstep, voffA);
        if (wr == 1) PG8_BAR;
        PG8_WAIT_V(2); PG8_BAR;
        PG8_STAGE(PG8_SB(1, 0), cB + kstep, voffB); PG8_STAGE(PG8_SA(1, 0), cA + kstep, voffA); PG8_STAGE(PG8_SB(1, 1), cB + hstep + kstep, voffB);
        PG8_WAIT_V(6); PG8_BAR;
    } else {
        PG8_STAGE(PG8_SB(0, 0), cB, voffB); PG8_STAGE(PG8_SA(0, 0), cA, voffA); PG8_STAGE(PG8_SB(0, 1), cB + hstep, voffB); PG8_STAGE(PG8_SA(0, 1), cA + hstep, voffA);
        if (wr == 1) PG8_BAR;
        PG8_WAIT_V(4); PG8_BAR;
        PG8_STAGE(PG8_SB(1, 0), cB + kstep, voffB); PG8_STAGE(PG8_SA(1, 0), cA + kstep, voffA); PG8_STAGE(PG8_SB(1, 1), cB + hstep + kstep, voffB);
        PG8_WAIT_V(6); PG8_BAR;
    }
    for (;;) {
        const bool has_next = S.next(ui + 1, nxt);
        const char* nA = has_next ? (const char*)g.A + (size_t)nxt.pm * tstep : cA; const char* nB = has_next ? (const char*)g.Bt + (size_t)nxt.pn * tstep : cB;
        for (int t = 0; t < nt; t += 2) {
            const bool last = (t == nt - 2);
            const char* a1 = cA + (size_t)(t + 1) * kstep;
            const char* a2 = last ? nA : cA + (size_t)(t + 2) * kstep; const char* b2 = last ? nB : cB + (size_t)(t + 2) * kstep;
            const char* a3 = a2 + kstep; const char* b3 = b2 + kstep;
            if (last && has_next) S.a_ready(nxt);
            if constexpr (SP2) {
            PG8_LDB(B0, 0, 0); PG8_LDB(B1, 0, 1); PG8_SCHED; PG8_LDA(At, 0, 0); PG8_STAGE(PG8_SA(1, 1), a1 + hstep, voffA);
            PG8_WAIT_V(8); PG8_WAIT_L(0); PG8_BAR; PG8_MMA(0, 0, At, B0); PG8_MMA(0, 1, At, B1); PG8_BAR; PG8_SCHED;
            PG8_LDA(At, 0, 1); PG8_STAGE(PG8_SB(0, 0), b2, voffB); PG8_STAGE(PG8_SB(0, 1), b2 + hstep, voffB); PG8_STAGE(PG8_SA(0, 0), a2, voffA);
            PG8_WAIT_V(8); PG8_WAIT_L(0); PG8_BAR; PG8_MMA(1, 0, At, B0); PG8_MMA(1, 1, At, B1); PG8_BAR; PG8_SCHED;
            PG8_LDB(B0, 1, 0); PG8_LDB(B1, 1, 1); PG8_SCHED; PG8_LDA(At, 1, 0); PG8_STAGE(PG8_SA(0, 1), a2 + hstep, voffA);
            PG8_WAIT_V(8); PG8_WAIT_L(0); PG8_BAR; PG8_MMA(0, 0, At, B0); PG8_MMA(0, 1, At, B1); PG8_BAR; PG8_SCHED;
            PG8_LDA(At, 1, 1); PG8_STAGE(PG8_SB(1, 0), b3, voffB); PG8_STAGE(PG8_SB(1, 1), b3 + hstep, voffB); PG8_STAGE(PG8_SA(1, 0), a3, voffA);
            PG8_WAIT_V(8); PG8_WAIT_L(0); PG8_BAR; PG8_MMA(1, 0, At, B0); PG8_MMA(1, 1, At, B1); PG8_BAR; PG8_SCHED;
            } else {
            PG8_LDB(B0, 0, 0); PG8_SCHED; PG8_LDA(At, 0, 0); PG8_STAGE(PG8_SA(1, 1), a1 + hstep, voffA);
            PG8_WAIT_L(8); PG8_BAR; PG8_WAIT_L(0); PG8_MMA(0, 0, At, B0); PG8_BAR; PG8_SCHED;
            PG8_LDB(B1, 0, 1); PG8_STAGE(PG8_SB(0, 0), b2, voffB);
            PG8_BAR; PG8_WAIT_L(0); PG8_MMA(0, 1, At, B1); PG8_BAR;
            PG8_LDA(At, 0, 1); PG8_STAGE(PG8_SA(0, 0), a2, voffA);
            PG8_BAR; PG8_WAIT_L(0); PG8_MMA(1, 0, At, B0); PG8_BAR; PG8_SCHED;
            PG8_STAGE(PG8_SB(0, 1), b2 + hstep, voffB);
            PG8_WAIT_V(6); PG8_BAR; PG8_MMA(1, 1, At, B1); PG8_BAR;
            PG8_LDB(B0, 1, 0); PG8_SCHED; PG8_LDA(At, 1, 0); PG8_STAGE(PG8_SA(0, 1), a2 + hstep, voffA);
            PG8_WAIT_L(8); PG8_BAR; PG8_WAIT_L(0); PG8_MMA(0, 0, At, B0); PG8_BAR; PG8_SCHED;
            PG8_LDB(B1, 1, 1); PG8_STAGE(PG8_SB(1, 0), b3, voffB);
            PG8_BAR; PG8_WAIT_L(0); PG8_MMA(0, 1, At, B1); PG8_BAR;
            PG8_LDA(At, 1, 1); PG8_STAGE(PG8_SA(1, 0), a3, voffA);
            PG8_BAR; PG8_WAIT_L(0); PG8_MMA(1, 0, At, B0); PG8_BAR; PG8_SCHED;
            PG8_STAGE(PG8_SB(1, 1), b3 + hstep, voffB);
            PG8_WAIT_V(6); PG8_BAR; PG8_MMA(1, 1, At, B1); PG8_BAR;
            }
        }
        if constexpr (ALIGN_EPI) { if (wr == 0) PG8_BAR; }
        if constexpr (!Epi::AFTER_DRAIN) { E(acc, cur, wr, wc, fr, fq); S.done(cur); }
        if (!has_next) break;
#pragma unroll
        for (int a = 0; a < 2; ++a)
#pragma unroll
            for (int b = 0; b < 2; ++b)
#pragma unroll
                for (int m = 0; m < 4; ++m)
#pragma unroll
                    for (int n = 0; n < 2; ++n) acc[a][b][m][n] = (f32x4){0.f, 0.f, 0.f, 0.f};
        cur = nxt; cA = nA; cB = nB; ++ui;
        if constexpr (ALIGN_EPI) { if (wr == 1) PG8_BAR; }
    }
    PG8_WAIT_V(0);
    if constexpr (!ALIGN_EPI) { if (wr == 0) PG8_BAR; }
    PG8_BAR;
    if constexpr (Epi::AFTER_DRAIN) { E.fused(acc, cur, wr, wc, fr, fq, lds, wid, lane); S.done(cur); }
#undef PG8_SA
#undef PG8_SB
#undef PG8_STAGE
#undef PG8_LDA
#undef PG8_LDB
#undef PG8_MMA
#undef PG8_WAIT_V
#undef PG8_WAIT_L
#undef PG8_BAR
#undef PG8_SCHED
}
}
#define GAS __attribute__((address_space(1)))
#define LAS __attribute__((address_space(3)))
typedef unsigned short bf16;
typedef unsigned v4u __attribute__((ext_vector_type(4)));
typedef float f32x4 __attribute__((ext_vector_type(4)));
typedef short bf16x8 __attribute__((ext_vector_type(8)));
typedef GAS unsigned gu32;
typedef GAS unsigned long long gu64;
#define RLX_AGENT __ATOMIC_RELAXED, __HIP_MEMORY_SCOPE_AGENT
#define LDS_WAIT() asm volatile("s_waitcnt lgkmcnt(0)" ::: "memory")
#define VM_WAIT() asm volatile("s_waitcnt vmcnt(0)" ::: "memory")
__device__ __forceinline__ unsigned long long rt() { return __builtin_amdgcn_s_memrealtime(); }
__device__ __forceinline__ unsigned f2bf(float f) { unsigned u = __builtin_bit_cast(unsigned, f); return (u + 0x7fffu + ((u >> 16) & 1u)) >> 16; }
__device__ __forceinline__ unsigned pk2(float lo, float hi) { return f2bf(lo) | (f2bf(hi) << 16); }
#define XB_TMO      128
#define XB_XCNT(j)  (256  + 64 * (j))
#define XB_XSUB(j)  (1280 + 64 * (j))
#define XB_XGEN(j)  (2304 + 64 * (j))
#define XB_TOP      3328
#define XB_TOPGEN   3392
#define XCD_BAR_WORDS 3456
#define XB_SPIN_CAP (1u << 18)

__device__ __forceinline__ unsigned xb_ld(unsigned* p)              { return __hip_atomic_load(p, __ATOMIC_RELAXED, __HIP_MEMORY_SCOPE_AGENT); }
__device__ __forceinline__ unsigned xb_add(unsigned* p, unsigned v) { return __hip_atomic_fetch_add(p, v, __ATOMIC_RELAXED, __HIP_MEMORY_SCOPE_AGENT); }
__device__ __forceinline__ unsigned xb_xcc_id() { return (unsigned)__builtin_amdgcn_s_getreg((3 << 11) | 20) & 0xFu; }
#define XB_SPIN(cond, bar) do { unsigned _sp = 0; while (cond) { __builtin_amdgcn_s_sleep(1); \
    if ((++_sp & 255u) == 0u) { if (xb_ld(&(bar)[XB_TMO])) break; if (_sp > XB_SPIN_CAP) { atomicAdd(&(bar)[XB_TMO], 1u); break; } } } } while (0)

struct XcdBarrier {
    unsigned* bar; unsigned x;
    volatile LAS unsigned* st;
};

__device__ __forceinline__ XcdBarrier xcd_barrier_post(unsigned* bar, volatile LAS unsigned* st) {
    XcdBarrier b; b.bar = bar; b.x = xb_xcc_id(); b.st = st;
    if (threadIdx.x == 0) (void)xb_add(&bar[XB_XCNT(b.x)], 1u);
    return b;
}
__device__ __forceinline__ void xcd_barrier_complete(unsigned* bar, unsigned x, unsigned& nloc, unsigned& nx) {
    const unsigned G = gridDim.x * gridDim.y * gridDim.z;
    unsigned sum, cnt, mine, sp = 0u;
    for (;;) {
        sum = 0u; cnt = 0u; mine = 0u;
#pragma unroll
        for (unsigned j = 0; j < 16; ++j) { const unsigned c = xb_ld(&bar[XB_XCNT(j)]); sum += c; cnt += (c > 0u) ? 1u : 0u; mine = (j == x) ? c : mine; }
        if (sum == G) break;
        __builtin_amdgcn_s_sleep(1);
        if ((++sp & 255u) == 0u) { if (xb_ld(&bar[XB_TMO])) break; if (sp > XB_SPIN_CAP) { atomicAdd(&bar[XB_TMO], 1u); break; } }
    }
    nloc = mine > 0u ? mine : 1u; nx = cnt > 0u ? cnt : 1u;
}

__device__ __forceinline__ void xcd_barrier(const XcdBarrier& b) {
    asm volatile("s_waitcnt vmcnt(0)" ::: "memory");
    __syncthreads();
    if (threadIdx.x == 0) {
        unsigned* bar = b.bar;
        __builtin_amdgcn_s_waitcnt(0);
        unsigned nloc = b.st[0], nx = b.st[1];
        if (nloc == 0u) { xcd_barrier_complete(bar, b.x, nloc, nx); b.st[0] = nloc; b.st[1] = nx; }
        const unsigned old = xb_add(&bar[XB_XSUB(b.x)], 1u);
        const unsigned gen = old / nloc;
        if (old + 1u == (gen + 1u) * nloc) {
            __builtin_amdgcn_fence(__ATOMIC_RELEASE, "agent");
            asm volatile("s_waitcnt vmcnt(0)" ::: "memory");
            const unsigned og = xb_add(&bar[XB_TOP], 1u);
            const unsigned tg = og / nx;
            if (og + 1u == (tg + 1u) * nx) xb_add(&bar[XB_TOPGEN], 1u);
            else XB_SPIN(xb_ld(&bar[XB_TOPGEN]) == tg, bar);
            __builtin_amdgcn_fence(__ATOMIC_ACQUIRE, "agent");
            xb_add(&bar[XB_XGEN(b.x)], 1u);
            asm volatile("s_waitcnt vmcnt(0)" ::: "memory");
        } else {
            XB_SPIN(xb_ld(&bar[XB_XGEN(b.x)]) == gen, bar);
            __builtin_amdgcn_fence(__ATOMIC_ACQUIRE, "agent");
            asm volatile("s_waitcnt vmcnt(0)" ::: "memory");
        }
    }
    __syncthreads();
}
constexpr int NWAVES = 8;
constexpr int D = 2048, SEQ = 8192, MP = 32768, MS = 128, MR = 32896, MT = 33024;
constexpr int DFF = 5632, NA = 5376, NBQ = 2048, NKV = 3072;
constexpr int CQ = 0, CK = 768, CV = 1536, CG = 3072, CQM = 4608, CLR = 5120;
constexpr float DN_ALPHA = 1.6817928305074292f, LN_EPS = 1e-5f, RMS_EPS = 1e-6f;
constexpr float GLA_QSCALE = 0.07216878364870323f, HD_SCALE = 0.08838834764831845f;
constexpr size_t MiB = 1u << 20;
constexpr size_t WS_CTL = 0, CTL_ZERO_BYTES = 1 * MiB;
constexpr size_t WS_WIN = 1 * MiB, WS_WO = 22 * MiB, WS_WFI = 30 * MiB, WS_WFO = 74 * MiB, WS_WMEM = 96 * MiB, WS_MEMX = 112 * MiB, WS_MEMK = 116 * MiB, WS_MEMV = 128 * MiB;
constexpr size_t WS_X = 140 * MiB, WS_Y = 269 * MiB, WS_R1 = 527 * MiB, WS_OCAT = 882 * MiB, WS_SBKS = 1011 * MiB, WS_SBVS = 1060 * MiB, WS_END = 1109 * MiB;
static_assert(WS_WIN + (size_t)NA * D * 2 <= WS_WO && WS_WFI + (size_t)2 * DFF * D * 2 <= WS_WFO && WS_WFO + (size_t)D * DFF * 2 <= WS_WMEM, "weights map");
static_assert(WS_X + (size_t)MT * D * 2 <= WS_Y && WS_Y + (size_t)MT * D * 4 <= WS_R1 && WS_R1 + (size_t)MT * DFF * 2 <= WS_OCAT && WS_OCAT + (size_t)MT * D * 2 <= WS_SBKS, "activation map");
static_assert(WS_SBKS + (size_t)8 * 2064 * 1536 * 2 <= WS_SBVS && WS_SBVS + (size_t)8 * 2064 * 1536 * 2 <= WS_END, "sb sample map");
constexpr size_t O_YP = 0, O_YS = 67108864, O_GSP = 67371008, O_GSS = 69730304, O_SKP = 74448896, O_SVP = 124780544, O_SKS = 175112192, O_SVS = 175308800, O_MKP = 175505408, O_MVP = 177602560, O_END = 179699712;
constexpr int CW_BAR = 4096;
constexpr int RING_OFF = 0, RING_BYTES = 131072, LDSCTL_OFF = RING_BYTES, MISC_OFF = LDSCTL_OFF + 320, LDS_BYTES = 147456;

struct Args { const float* in[22]; float* out_; unsigned char* ws_; int ph_lo, ph_hi; };
struct Frame {
    LAS unsigned char* lds; volatile LAS unsigned* MISC; gu32* ctl;
    int tid, lane, wave, G, gw, NGW;
};
__device__ __forceinline__ float bf2f(bf16 h) { return __builtin_bit_cast(float, (unsigned)h << 16); }
__device__ __forceinline__ float shx(float v, int lane, int m) { return __builtin_bit_cast(float, __builtin_amdgcn_ds_bpermute((lane ^ m) << 2, __builtin_bit_cast(int, v))); }
__device__ __forceinline__ float wave_sum(float v, int lane) {
#pragma unroll
    for (int o = 1; o < 64; o <<= 1) v += shx(v, lane, o);
    return v;
}
__device__ __forceinline__ float wave_max(float v, int lane) {
#pragma unroll
    for (int o = 1; o < 64; o <<= 1) v = fmaxf(v, shx(v, lane, o));
    return v;
}
__device__ __forceinline__ void cvt_row(const float* src, bf16* dst, int n, int lane) {
    for (int j = lane * 4; j < n; j += 256) {
        f32x4 v = src ? *(const f32x4*)(src + j) : (f32x4){0.f, 0.f, 0.f, 0.f};
        unsigned long long w = (unsigned long long)pk2(v.x, v.y) | ((unsigned long long)pk2(v.z, v.w) << 32);
        *(unsigned long long*)(dst + j) = w;
    }
}
struct MapId { __device__ __forceinline__ int operator()(int n) const { return n; } };
struct MapInA { __device__ __forceinline__ int operator()(int n) const { return n < 4608 ? n : (n < 5120 ? n + 16 : (n < 5136 ? n - 512 : -1)); } };
struct MapFfn { __device__ __forceinline__ int operator()(int n) const { const int t = n >> 8, r = n & 255; return r < 128 ? 128 * t + r : DFF + 128 * t + (r - 128); } };
template <class Map>
__device__ __forceinline__ void wt_convert(LAS unsigned char* ldsb, int wave, int gw, int NGW, int lane, const float* W, int K, int Nsrc, bf16* WT, int Ndst, Map map) {
    LAS float* scr = (LAS float*)(ldsb + RING_OFF + wave * 16384);
    const int nblk = Ndst / 32, nitems = (K / 64) * nblk;
    for (int it = gw; it < nitems; it += NGW) {
        const int kb = it / nblk, nb = it % nblk, k0 = 64 * kb, n0 = 32 * nb;
        const int sc = map(n0 + (lane & 31));
#pragma unroll 8
        for (int i = 0; i < 32; ++i) { const int kk = 2 * i + (lane >> 5); scr[kk * 33 + (lane & 31)] = sc >= 0 ? W[(size_t)(k0 + kk) * Nsrc + sc] : 0.f; }
        LDS_WAIT(); asm volatile("" ::: "memory");
        const int c = lane & 7;
#pragma unroll
        for (int j = 0; j < 4; ++j) { const int n = (lane >> 3) + 8 * j; const LAS float* s = scr + (8 * c) * 33 + n;
            v4u o; o.x = pk2(s[0 * 33], s[1 * 33]); o.y = pk2(s[2 * 33], s[3 * 33]); o.z = pk2(s[4 * 33], s[5 * 33]); o.w = pk2(s[6 * 33], s[7 * 33]);
            *(GAS v4u*)(WT + (size_t)(n0 + n) * K + k0 + 8 * c) = o; }
        LDS_WAIT(); asm volatile("" ::: "memory");
    }
}
__device__ __forceinline__ float softplus_f(float z) { return fmaxf(z, 0.f) + log1pf(__expf(-fabsf(z))); }

typedef short s16x4 __attribute__((ext_vector_type(4)));
typedef pg8::u32x2 u32x2;
typedef float f32x16 __attribute__((ext_vector_type(16)));
typedef __bf16 bf16x2_t __attribute__((ext_vector_type(2)));
typedef float f32x2_t __attribute__((ext_vector_type(2)));
__device__ __forceinline__ unsigned cvt2(float lo, float hi) { const f32x2_t v = {lo, hi}; const bf16x2_t b = __builtin_convertvector(v, bf16x2_t); return __builtin_bit_cast(unsigned, b); }
__device__ __forceinline__ bf16x8 pack8(const f32x4 a, const f32x4 b) { v4u p; p.x = cvt2(a[0], a[1]); p.y = cvt2(a[2], a[3]); p.z = cvt2(b[0], b[1]); p.w = cvt2(b[2], b[3]); return __builtin_bit_cast(bf16x8, p); }
__device__ __forceinline__ bf16x8 ld2x8(const bf16* p0, const bf16* p1) { const s16x4 a = *(const s16x4*)p0, b = *(const s16x4*)p1; return __builtin_shufflevector(a, b, 0, 1, 2, 3, 4, 5, 6, 7); }
__device__ __forceinline__ bf16x8 ld16(const bf16* p) { return *(const bf16x8*)p; }
#define MFMA16(a, b, c) __builtin_amdgcn_mfma_f32_16x16x32_bf16((a), (b), (c), 0, 0, 0)
#define MFMA32(a, b, c) __builtin_amdgcn_mfma_f32_32x32x16_bf16((a), (b), (c), 0, 0, 0)

constexpr int QIMG_LD = 200, KTIMG_LD = 68, PKG_Q = 0, PKG_KT = 25600, PKG_G = 51712, IMG_BYTES = 52480, PKG_K = 52480, PKG_VT = 77056, PKG_BYTES = 126208, N_PKG = 2048 + 32;
static_assert(64 * QIMG_LD * 2 == PKG_KT && PKG_KT + 192 * KTIMG_LD * 2 == PKG_G && PKG_G + 768 == IMG_BYTES && PKG_K + 24576 == PKG_VT && PKG_VT + 49152 == PKG_BYTES && IMG_BYTES % 16 == 0, "package map");

__device__ __forceinline__ float softplus_fast(float z) { return fmaxf(z, 0.f) + __logf(1.0f + __expf(-fabsf(z))); }
__device__ __forceinline__ void gla_prep(int bid, int G, int tid, int wave, LAS unsigned char* lds, int l, const bf16* PROJ, const float* w_gate_lr, const float* b_gate, unsigned char* PKG) {
    const int lane = tid & 63;
    const float* w2 = w_gate_lr + (size_t)l * 16 * 768; const float* bg = b_gate + (size_t)l * 768;
    LAS float* tot = (LAS float*)lds;
    for (int item = bid; item < N_PKG; item += G) {
        int h, row0, T;
        if (item < 2048) { const int bh = item >> 7, ch = item & 127; h = bh & 3; row0 = (bh >> 2) * SEQ + ch * 64; T = 64; }
        else { const int i2 = item - 2048; h = i2 & 3; row0 = MP + (i2 >> 2) * 16; T = 16; }
        unsigned char* pk = PKG + (size_t)item * PKG_BYTES;
        bf16* Qt = (bf16*)(pk + PKG_Q); bf16* Kt = (bf16*)(pk + PKG_K); bf16* KT = (bf16*)(pk + PKG_KT); bf16* VT = (bf16*)(pk + PKG_VT); float* Gp = (float*)(pk + PKG_G);
        float w2c[3][16], bgc[3];
#pragma unroll
        for (int c = 0; c < 3; ++c) { const int d = h * 192 + lane + 64 * c; bgc[c] = bg[d];
#pragma unroll
            for (int r = 0; r < 16; ++r) w2c[c][r] = w2[r * 768 + d]; }
        v4u l0[8], l1[8];
#pragma unroll
        for (int tt = 0; tt < 8; ++tt) { const int t = 8 * wave + tt; const bf16* prow = PROJ + (size_t)(row0 + (t < T ? t : T - 1)) * NA;
            l0[tt] = *(const v4u*)(prow + CLR); l1[tt] = *(const v4u*)(prow + CLR + 8); }
        float lc[8][3]; float run[3] = {0.f, 0.f, 0.f};
#pragma unroll
        for (int tt = 0; tt < 8; ++tt) { const bool ok = 8 * wave + tt < T;
            float lr[16]; lr[0] = pg8::bflo(l0[tt].x); lr[1] = pg8::bfhi(l0[tt].x); lr[2] = pg8::bflo(l0[tt].y); lr[3] = pg8::bfhi(l0[tt].y); lr[4] = pg8::bflo(l0[tt].z); lr[5] = pg8::bfhi(l0[tt].z); lr[6] = pg8::bflo(l0[tt].w); lr[7] = pg8::bfhi(l0[tt].w);
            lr[8] = pg8::bflo(l1[tt].x); lr[9] = pg8::bfhi(l1[tt].x); lr[10] = pg8::bflo(l1[tt].y); lr[11] = pg8::bfhi(l1[tt].y); lr[12] = pg8::bflo(l1[tt].z); lr[13] = pg8::bfhi(l1[tt].z); lr[14] = pg8::bflo(l1[tt].w); lr[15] = pg8::bfhi(l1[tt].w);
#pragma unroll
            for (int c = 0; c < 3; ++c) { float xg = bgc[c];
#pragma unroll
                for (int r = 0; r < 16; ++r) xg += lr[r] * w2c[c][r];
                run[c] += ok ? -softplus_fast(-xg) * (1.0f / 16.0f) : 0.f; lc[tt][c] = run[c]; } }
#pragma unroll
        for (int c = 0; c < 3; ++c) tot[wave * 192 + lane + 64 * c] = run[c];
        unsigned qv[8][3], kv[8][3];
#pragma unroll
        for (int tt = 0; tt < 8; ++tt) { const int t = 8 * wave + tt; const bf16* prow = PROJ + (size_t)(row0 + (t < T ? t : T - 1)) * NA + h * 192 + lane;
#pragma unroll
            for (int c = 0; c < 3; ++c) { qv[tt][c] = prow[CQ + 64 * c]; kv[tt][c] = prow[CK + 64 * c]; } }
        __syncthreads();
        float pre[3], all[3];
#pragma unroll
        for (int c = 0; c < 3; ++c) { pre[c] = 0.f; all[c] = 0.f;
#pragma unroll
            for (int w = 0; w < 8; ++w) { const float tv = tot[w * 192 + lane + 64 * c]; all[c] += tv; if (w < wave) pre[c] += tv; } }
        unsigned ktw[3][4];
#pragma unroll
        for (int tt = 0; tt < 8; ++tt) { const int t = 8 * wave + tt; const bool ok = t < T;
#pragma unroll
            for (int c = 0; c < 3; ++c) { const int dl = lane + 64 * c; const float bc = pre[c] + lc[tt][c]; const float eq = __expf(bc), ek = __expf(-bc);
                const unsigned qb = ok ? f2bf(bf2f((bf16)qv[tt][c]) * GLA_QSCALE * eq) : 0u, kb = ok ? f2bf(bf2f((bf16)kv[tt][c]) * ek) : 0u;
                Qt[t * QIMG_LD + dl] = (bf16)qb; Kt[t * 192 + dl] = (bf16)kb;
                if (tt & 1) ktw[c][tt >> 1] |= kb << 16; else ktw[c][tt >> 1] = kb; } }
#pragma unroll
        for (int c = 0; c < 3; ++c) { bf16* kp = KT + (size_t)(lane + 64 * c) * KTIMG_LD + 8 * wave; u32x2 o0, o1; o0.x = ktw[c][0]; o0.y = ktw[c][1]; o1.x = ktw[c][2]; o1.y = ktw[c][3]; *(u32x2*)kp = o0; *(u32x2*)(kp + 4) = o1; }
        if (wave == 0) {
#pragma unroll
            for (int c = 0; c < 3; ++c) Gp[lane + 64 * c] = __expf(all[c]); }
        unsigned vv[6][8];
#pragma unroll
        for (int tt = 0; tt < 8; ++tt) { const int t = 8 * wave + tt; const bf16* prow = PROJ + (size_t)(row0 + (t < T ? t : T - 1)) * NA + CV + h * 384 + lane;
#pragma unroll
            for (int c2 = 0; c2 < 6; ++c2) vv[c2][tt] = t < T ? (unsigned)prow[64 * c2] : 0u; }
#pragma unroll
        for (int c2 = 0; c2 < 6; ++c2) { v4u o; o.x = vv[c2][0] | (vv[c2][1] << 16); o.y = vv[c2][2] | (vv[c2][3] << 16); o.z = vv[c2][4] | (vv[c2][5] << 16); o.w = vv[c2][6] | (vv[c2][7] << 16);
            *(v4u*)(VT + (size_t)(lane + 64 * c2) * 64 + 8 * wave) = o; }
        __syncthreads();
    }
}

__device__ __forceinline__ void gla_intra(int item, int lane, const unsigned char* PKG, float* OINT) {
    const int fr = lane & 15, fq = lane >> 4;
    int h, row0, nvalid;
    if (item < 2048) { const int bh = item >> 7, ch = item & 127; h = bh & 3; row0 = (bh >> 2) * SEQ + ch * 64; nvalid = 64; }
    else { const int i2 = item - 2048; h = i2 & 3; row0 = MP + (i2 >> 2) * 16; nvalid = 16; }
    const unsigned char* pk = PKG + (size_t)item * PKG_BYTES;
    const bf16* Qt = (const bf16*)(pk + PKG_Q); const bf16* Kt = (const bf16*)(pk + PKG_K); const bf16* VT = (const bf16*)(pk + PKG_VT);
    bf16x8 pf0[4], pf1[2];
#pragma unroll
    for (int it = 0; it < 4; ++it) {
        bf16x8 qf[6];
#pragma unroll
        for (int s = 0; s < 6; ++s) qf[s] = ld16(Qt + (size_t)(16 * it + fr) * QIMG_LD + 32 * s + 8 * fq);
        f32x4 at[4];
#pragma unroll
        for (int jt = 0; jt < 4; ++jt) { at[jt] = (f32x4){0.f, 0.f, 0.f, 0.f};
            if (jt <= it) { const bf16* kr = Kt + (size_t)(16 * jt + fr) * 192 + 8 * fq;
#pragma unroll
                for (int s = 0; s < 6; ++s) at[jt] = MFMA16(ld16(kr + 32 * s), qf[s], at[jt]); } }
#pragma unroll
        for (int jj = 0; jj < 4; ++jj) if (4 * fq + jj > fr) at[it][jj] = 0.f;
        pf0[it] = pack8(at[0], at[1]); if (it >= 2) pf1[it - 2] = pack8(at[2], at[3]);
    }
    for (int vt_ = 0; vt_ < 24; ++vt_) {
        const bf16* vr = VT + (size_t)(16 * vt_ + fr) * 64 + 4 * fq;
        const bf16x8 va = ld2x8(vr, vr + 16), vb = ld2x8(vr + 32, vr + 48);
#pragma unroll
        for (int it = 0; it < 4; ++it) { f32x4 o = {0.f, 0.f, 0.f, 0.f};
            o = MFMA16(va, pf0[it], o); if (it >= 2) o = MFMA16(vb, pf1[it - 2], o);
            if (16 * it + fr < nvalid) *(f32x4*)(OINT + (size_t)(row0 + 16 * it + fr) * 1536 + h * 384 + 16 * vt_ + 4 * fq) = o; }
    }
}

__device__ __forceinline__ void gla_chain(int wc, int tid, int wave, LAS unsigned char* lds, int l, const unsigned char* PKG, const float* state_gla, float* OINT, float* out, bool dry = false) {
    const int lane = tid & 63, fr = lane & 15, fq = lane >> 4;
    int h, vb, item0, nsteps, row0, nvalid; const float* s0; float* sout;
    if (wc < 48) { const int bh = wc / 3; vb = wc % 3; h = bh & 3; item0 = bh * 128; nsteps = 128; row0 = (bh >> 2) * SEQ; nvalid = 64; s0 = nullptr; sout = out + O_GSP + (size_t)(l * 16 + bh) * 192 * 384; }
    else { const int c2 = wc - 48, bh = c2 / 3; vb = c2 % 3; h = bh & 3; item0 = 2048 + bh; nsteps = 1; row0 = MP + (bh >> 2) * 16; nvalid = 16; s0 = state_gla + (size_t)(l * 32 + bh) * 192 * 384; sout = out + O_GSS + (size_t)(l * 32 + bh) * 192 * 384; }
    const int v0 = vb * 128 + wave * 16;
    f32x4 S[12];
#pragma unroll
    for (int t = 0; t < 12; ++t)
#pragma unroll
        for (int jj = 0; jj < 4; ++jj) S[t][jj] = s0 ? s0[(size_t)(16 * t + 4 * fq + jj) * 384 + v0 + fr] : 0.f;
    v4u pre[7]; bf16x8 vt[2], vtn[2]; f32x4 oin[4];
    { const unsigned char* pk = PKG + (size_t)item0 * PKG_BYTES;
#pragma unroll
      for (int it = 0; it < 4; ++it) { const int tl = 16 * it + fr; oin[it] = tl < nvalid ? *(const f32x4*)(OINT + (size_t)(row0 + tl) * 1536 + h * 384 + v0 + 4 * fq) : (f32x4){0.f, 0.f, 0.f, 0.f}; }
#pragma unroll
      for (int k = 0; k < 7; ++k) { const int ch = tid + 512 * k; if (ch < IMG_BYTES / 16) pre[k] = *(const v4u*)(pk + (size_t)ch * 16); }
      const bf16* VT = (const bf16*)(pk + PKG_VT) + (size_t)(v0 + fr) * 64 + 4 * fq; vt[0] = ld2x8(VT, VT + 16); vt[1] = ld2x8(VT + 32, VT + 48);
#pragma unroll
      for (int k = 0; k < 7; ++k) { const int ch = tid + 512 * k; if (ch < IMG_BYTES / 16) *(LAS v4u*)(lds + (size_t)ch * 16) = pre[k]; }
      vtn[0] = vt[0]; vtn[1] = vt[1]; }
    __syncthreads();
    for (int n = 0; n < nsteps; ++n) {
        const LAS unsigned char* img = lds + (n & 1) * IMG_BYTES;
        const bool more = n + 1 < nsteps;
        if (more) { const unsigned char* pk = PKG + (size_t)(item0 + n + 1) * PKG_BYTES;
#pragma unroll
            for (int k = 0; k < 7; ++k) { const int ch = tid + 512 * k; if (ch < IMG_BYTES / 16) pre[k] = *(const v4u*)(pk + (size_t)ch * 16); }
            const bf16* VT = (const bf16*)(pk + PKG_VT) + (size_t)(v0 + fr) * 64 + 4 * fq; vtn[0] = ld2x8(VT, VT + 16); vtn[1] = ld2x8(VT + 32, VT + 48); }
        bf16x8 Sb[6];
#pragma unroll
        for (int s = 0; s < 6; ++s) Sb[s] = pack8(S[2 * s], S[2 * s + 1]);
#pragma unroll
        for (int it = 0; it < 4; ++it) {
            const LAS bf16* qr = (const LAS bf16*)(img + PKG_Q) + (16 * it + fr) * QIMG_LD + 4 * fq;
            f32x4 o = oin[it];
#pragma unroll
            for (int s = 0; s < 6; ++s) { const s16x4 a = *(const LAS s16x4*)(qr + 32 * s), b = *(const LAS s16x4*)(qr + 32 * s + 16);
                o = MFMA16(Sb[s], __builtin_shufflevector(a, b, 0, 1, 2, 3, 4, 5, 6, 7), o); }
            const int tl = 16 * it + fr;
            if (tl < nvalid && !dry) *(f32x4*)(OINT + (size_t)(row0 + 64 * n + tl) * 1536 + h * 384 + v0 + 4 * fq) = o;
            __builtin_amdgcn_sched_barrier(0);
        }
        if (more) {
#pragma unroll
            for (int it = 0; it < 4; ++it) oin[it] = *(const f32x4*)(OINT + (size_t)(row0 + 64 * (n + 1) + 16 * it + fr) * 1536 + h * 384 + v0 + 4 * fq); }
#pragma unroll
        for (int t = 0; t < 12; ++t) { const LAS bf16* kr = (const LAS bf16*)(img + PKG_KT) + (16 * t + fr) * KTIMG_LD + 4 * fq;
#pragma unroll
            for (int s2 = 0; s2 < 2; ++s2) { const s16x4 a = *(const LAS s16x4*)(kr + 32 * s2), b = *(const LAS s16x4*)(kr + 32 * s2 + 16);
                S[t] = MFMA16(__builtin_shufflevector(a, b, 0, 1, 2, 3, 4, 5, 6, 7), vt[s2], S[t]); }
            S[t] = S[t] * *(const LAS f32x4*)(img + PKG_G + (16 * t + 4 * fq) * 4); if (t & 1) __builtin_amdgcn_sched_barrier(0); }
        if (more) { LAS unsigned char* nimg = lds + ((n + 1) & 1) * IMG_BYTES;
#pragma unroll
            for (int k = 0; k < 7; ++k) { const int ch = tid + 512 * k; if (ch < IMG_BYTES / 16) *(LAS v4u*)(nimg + (size_t)ch * 16) = pre[k]; }
            vt[0] = vtn[0]; vt[1] = vtn[1]; }
        asm volatile("s_waitcnt lgkmcnt(0)" ::: "memory"); __builtin_amdgcn_s_barrier(); asm volatile("" ::: "memory");
    }
#pragma unroll
    for (int t = 0; t < 12; ++t)
#pragma unroll
        for (int jj = 0; jj < 4; ++jj) sout[(size_t)(16 * t + 4 * fq + jj) * 384 + v0 + fr] = S[t][jj];
}

__device__ __forceinline__ void mem_attn(int item, int lane, int l, const bf16* PROJ, int ldp, int cqm, const bf16* MEMK, const bf16* MEMVT, bf16* OCAT) {
    const int fr = lane & 15, fq = lane >> 4, tile = item >> 2, h = item & 3, r0 = tile * 16;
    const int bb = r0 < MP ? r0 / SEQ : 4 + ((r0 - MP) >> 4);
    const bf16* Kb = MEMK + (size_t)((l * 12 + bb) * 256) * 512 + h * 128; const bf16* Vt = MEMVT + (size_t)(((l * 12 + bb) * 4 + h) * 128) * 256;
    bf16x8 qf[4];
#pragma unroll
    for (int s = 0; s < 4; ++s) qf[s] = ld16(PROJ + (size_t)(r0 + fr) * ldp + cqm + h * 128 + 32 * s + 8 * fq);
    f32x4 st[16];
#pragma unroll
    for (int mt = 0; mt < 16; ++mt) { st[mt] = (f32x4){0.f, 0.f, 0.f, 0.f}; const bf16* kr = Kb + (size_t)(16 * mt + fr) * 512 + 8 * fq;
#pragma unroll
        for (int s = 0; s < 4; ++s) st[mt] = MFMA16(ld16(kr + 32 * s), qf[s], st[mt]); }
    float mx = -3.0e38f;
#pragma unroll
    for (int mt = 0; mt < 16; ++mt) mx = fmaxf(mx, fmaxf(fmaxf(st[mt][0], st[mt][1]), fmaxf(st[mt][2], st[mt][3])));
    mx = fmaxf(mx, shx(mx, lane, 16)); mx = fmaxf(mx, shx(mx, lane, 32));
    float sum = 0.f;
#pragma unroll
    for (int mt = 0; mt < 16; ++mt)
#pragma unroll
        for (int jj = 0; jj < 4; ++jj) { const float p = __expf((st[mt][jj] - mx) * HD_SCALE); st[mt][jj] = p; sum += p; }
    sum += shx(sum, lane, 16); sum += shx(sum, lane, 32);
    const float inv = 1.0f / sum;
    bf16x8 pf[8];
#pragma unroll
    for (int s = 0; s < 8; ++s) pf[s] = pack8(st[2 * s], st[2 * s + 1]);
#pragma unroll
    for (int dt = 0; dt < 8; ++dt) { f32x4 o = {0.f, 0.f, 0.f, 0.f}; const bf16* vr = Vt + (size_t)(16 * dt + fr) * 256 + 4 * fq;
#pragma unroll
        for (int s = 0; s < 8; ++s) o = MFMA16(ld2x8(vr + 32 * s, vr + 32 * s + 16), pf[s], o);
        u32x2 w; w.x = cvt2(o[0] * inv, o[1] * inv); w.y = cvt2(o[2] * inv, o[3] * inv);
        *(u32x2*)(OCAT + (size_t)(r0 + fr) * D + 1536 + h * 128 + 16 * dt + 4 * fq) = w; }
}

__device__ __forceinline__ void mem_attn_wg(int wi, int tid, int wave, LAS unsigned char* lds, int l, const bf16* PROJ, int ldp, int cqm, const bf16* MEMK, const bf16* MEMVT, bf16* OCAT) {
    const int lane = tid & 63, fr = lane & 15, fq = lane >> 4, bh = wi >> 4, sub = wi & 15, b = bh >> 2, h = bh & 3;
    const bf16* Kb = MEMK + (size_t)((l * 12 + b) * 256) * 512 + h * 128; const bf16* Vt = MEMVT + (size_t)(((l * 12 + b) * 4 + h) * 128) * 256;
#pragma unroll
    for (int k = 0; k < 8; ++k) { const int idx = tid + 512 * k, row = idx >> 4, c = idx & 15; *(LAS v4u*)(lds + row * 256 + ((c ^ (row & 15)) << 4)) = *(const v4u*)(Kb + (size_t)row * 512 + c * 8); }
#pragma unroll
    for (int k = 0; k < 8; ++k) { const int idx = tid + 512 * k, row = idx >> 5, c = idx & 31; *(LAS v4u*)(lds + 65536 + row * 512 + ((c ^ (2 * (row & 15))) << 4)) = *(const v4u*)(Vt + (size_t)row * 256 + c * 8); }
    __syncthreads();
    unsigned koff[4], voff[16];
#pragma unroll
    for (int s2 = 0; s2 < 4; ++s2) { koff[s2] = (unsigned)(fr * 256 + (((4 * s2 + fq) ^ fr) << 4)); asm volatile("" : "+v"(koff[s2])); }
#pragma unroll
    for (int s2 = 0; s2 < 8; ++s2) { const int p0 = 8 * s2 + fq, p1 = p0 + 4;
        voff[2 * s2] = (unsigned)(65536 + fr * 512 + ((((p0 >> 1) ^ (2 * fr)) << 4) | ((p0 & 1) << 3))); voff[2 * s2 + 1] = (unsigned)(65536 + fr * 512 + ((((p1 >> 1) ^ (2 * fr)) << 4) | ((p1 & 1) << 3)));
        asm volatile("" : "+v"(voff[2 * s2]), "+v"(voff[2 * s2 + 1])); }
#pragma unroll 1
    for (int blk = 0; blk < 4; ++blk) {
        const int r0 = b * SEQ + sub * 512 + blk * 128 + wave * 16;
        bf16x8 qf[4];
#pragma unroll
        for (int s = 0; s < 4; ++s) qf[s] = ld16(PROJ + (size_t)(r0 + fr) * ldp + cqm + h * 128 + 32 * s + 8 * fq);
        f32x4 st[16];
#pragma unroll
        for (int mt = 0; mt < 16; ++mt) { st[mt] = (f32x4){0.f, 0.f, 0.f, 0.f};
#pragma unroll
            for (int s = 0; s < 4; ++s) st[mt] = MFMA16(*(const LAS bf16x8*)(lds + koff[s] + mt * 4096), qf[s], st[mt]);
            if ((mt & 3) == 3) __builtin_amdgcn_sched_barrier(0); }
        float mx = -3.0e38f;
#pragma unroll
        for (int mt = 0; mt < 16; ++mt) mx = fmaxf(mx, fmaxf(fmaxf(st[mt][0], st[mt][1]), fmaxf(st[mt][2], st[mt][3])));
        mx = fmaxf(mx, shx(mx, lane, 16)); mx = fmaxf(mx, shx(mx, lane, 32));
        float sum = 0.f;
#pragma unroll
        for (int mt = 0; mt < 16; ++mt)
#pragma unroll
            for (int jj = 0; jj < 4; ++jj) { const float p = __expf((st[mt][jj] - mx) * HD_SCALE); st[mt][jj] = p; sum += p; }
        sum += shx(sum, lane, 16); sum += shx(sum, lane, 32);
        const float inv = 1.0f / sum;
        bf16x8 pf[8];
#pragma unroll
        for (int s = 0; s < 8; ++s) pf[s] = pack8(st[2 * s], st[2 * s + 1]);
#pragma unroll
        for (int dt = 0; dt < 8; ++dt) { f32x4 o = {0.f, 0.f, 0.f, 0.f};
#pragma unroll
            for (int s = 0; s < 8; ++s) { const s16x4 a = *(const LAS s16x4*)(lds + voff[2 * s] + dt * 8192), bb = *(const LAS s16x4*)(lds + voff[2 * s + 1] + dt * 8192);
                o = MFMA16(__builtin_shufflevector(a, bb, 0, 1, 2, 3, 4, 5, 6, 7), pf[s], o); }
            u32x2 w; w.x = cvt2(o[0] * inv, o[1] * inv); w.y = cvt2(o[2] * inv, o[3] * inv);
            *(u32x2*)(OCAT + (size_t)(r0 + fr) * D + 1536 + h * 128 + 16 * dt + 4 * fq) = w;
            if (dt & 1) __builtin_amdgcn_sched_barrier(0); }
    }
    __syncthreads();
}

__device__ __forceinline__ void sb_attn(int lane, LAS unsigned char* wlds, const bf16* Kp, int ldk, const bf16* VTp, int ldvt, const bf16* Qp, int ldq, bf16* Op, int t0, int nq) {
    const int r = lane & 31, hh = lane >> 5;
    LAS bf16x8* qs = (LAS bf16x8*)wlds + lane;
#pragma unroll
    for (int ks = 0; ks < 8; ++ks) qs[64 * ks] = ld16(Qp + (size_t)r * ldq + 16 * ks + 8 * hh);
    f32x16 oacc[4];
#pragma unroll
    for (int dt = 0; dt < 4; ++dt)
#pragma unroll
        for (int i = 0; i < 16; ++i) oacc[dt][i] = 0.f;
    float carry = 0.f;
    bf16x8 kf[8];
    { const bf16* kr = Kp + (size_t)(t0 + r) * ldk + 8 * hh;
#pragma unroll
      for (int ks = 0; ks < 8; ++ks) kf[ks] = ld16(kr + 16 * ks); }
    for (int s0 = t0; s0 >= 0; s0 -= 32) {
        bf16x8 vf[8];
#pragma unroll
        for (int k2 = 0; k2 < 2; ++k2)
#pragma unroll
            for (int dt = 0; dt < 4; ++dt) { const bf16* vr = VTp + (size_t)(32 * dt + r) * ldvt + s0 + 16 * k2 + 4 * hh; vf[4 * k2 + dt] = ld2x8(vr, vr + 8); }
        f32x16 st;
#pragma unroll
        for (int i = 0; i < 16; ++i) st[i] = 0.f;
#pragma unroll
        for (int ks = 0; ks < 8; ++ks) st = MFMA32(kf[ks], qs[64 * ks], st);
        { const int sn = s0 >= 32 ? s0 - 32 : 0; const bf16* kr = Kp + (size_t)(sn + r) * ldk + 8 * hh;
#pragma unroll
          for (int ks = 0; ks < 8; ++ks) kf[ks] = ld16(kr + 16 * ks); }
        const bool diag = (s0 == t0);
        float l1[16], lb[16];
#pragma unroll
        for (int i = 0; i < 16; ++i) { const float z = st[i] * HD_SCALE, sp = softplus_fast(z); lb[i] = z - sp; l1[i] = -sp;
            if (diag && !(((i & 3) + 8 * (i >> 2) + 4 * hh) < r)) { l1[i] = 0.f; lb[i] = -1.0e30f; } }
        float g[4], pgv[4];
#pragma unroll
        for (int m = 0; m < 4; ++m) { g[m] = (l1[4 * m] + l1[4 * m + 1]) + (l1[4 * m + 2] + l1[4 * m + 3]); pgv[m] = shx(g[m], lane, 32); }
        float R[4]; R[3] = 0.f; R[2] = g[3] + pgv[3]; R[1] = R[2] + g[2] + pgv[2]; R[0] = R[1] + g[1] + pgv[1];
        const float total = R[0] + g[0] + pgv[0];
#pragma unroll
        for (int m = 0; m < 4; ++m) { const float suf = carry + R[m] + (hh == 0 ? pgv[m] : 0.f);
            const float t3 = suf, t2 = t3 + l1[4 * m + 3], t1 = t2 + l1[4 * m + 2], t0_ = t1 + l1[4 * m + 1];
            lb[4 * m + 3] = __expf(lb[4 * m + 3] + t3); lb[4 * m + 2] = __expf(lb[4 * m + 2] + t2); lb[4 * m + 1] = __expf(lb[4 * m + 1] + t1); lb[4 * m] = __expf(lb[4 * m] + t0_); }
        carry += total;
#pragma unroll
        for (int k2 = 0; k2 < 2; ++k2) {
            v4u p; p.x = cvt2(lb[8 * k2], lb[8 * k2 + 1]); p.y = cvt2(lb[8 * k2 + 2], lb[8 * k2 + 3]); p.z = cvt2(lb[8 * k2 + 4], lb[8 * k2 + 5]); p.w = cvt2(lb[8 * k2 + 6], lb[8 * k2 + 7]);
            const bf16x8 wf = __builtin_bit_cast(bf16x8, p);
#pragma unroll
            for (int dt = 0; dt < 4; ++dt) oacc[dt] = MFMA32(vf[4 * k2 + dt], wf, oacc[dt]);
        }
        if (__all((r >= nq) || (carry < -104.f))) break;
    }
    if (r < nq) {
#pragma unroll
        for (int dt = 0; dt < 4; ++dt)
#pragma unroll
            for (int g4 = 0; g4 < 4; ++g4) { u32x2 wv; wv.x = cvt2(oacc[dt][4 * g4], oacc[dt][4 * g4 + 1]); wv.y = cvt2(oacc[dt][4 * g4 + 2], oacc[dt][4 * g4 + 3]);
                *(u32x2*)(Op + (size_t)r * D + 32 * dt + 8 * g4 + 4 * hh) = wv; }
    }
    asm volatile("s_waitcnt lgkmcnt(0)" ::: "memory");
}
#ifndef PH_MASK
#define PH_MASK 0xFFFF
#endif
__global__ void __launch_bounds__(NWAVES * 64, 2) mega(Args args) {
    extern __shared__ __attribute__((aligned(16))) unsigned char lds[];
    Frame F;
    F.lds = (LAS unsigned char*)lds; F.MISC = (volatile LAS unsigned*)(F.lds + MISC_OFF);
    F.tid = threadIdx.x; F.lane = F.tid & 63; F.wave = __builtin_amdgcn_readfirstlane(F.tid >> 6);
    F.G = gridDim.x; F.gw = blockIdx.x * NWAVES + F.wave; F.NGW = F.G * NWAVES;
    F.ctl = (gu32*)(args.ws_ + WS_CTL);
    for (int u = F.tid; u < (LDS_BYTES - LDSCTL_OFF) / 4; u += NWAVES * 64) ((LAS unsigned*)(F.lds + LDSCTL_OFF))[u] = 0u;
    __syncthreads();
    XcdBarrier bar = xcd_barrier_post((unsigned*)(F.ctl + CW_BAR), F.MISC + 8);
    const int lo = args.ph_lo, hi = args.ph_hi; int ph = 0;
#define KARGS ((const __attribute__((address_space(4))) Args*)__builtin_amdgcn_kernarg_segment_ptr())
#define ws (ka->ws_)
#define out (ka->out_)
#define x_prompt (ka->in[0])
#define x_sample (ka->in[1])
#define mem_prompt (ka->in[2])
#define state_gla (ka->in[3])
#define cache_sb_k (ka->in[4])
#define cache_sb_v (ka->in[5])
#define cache_mem_k (ka->in[6])
#define cache_mem_v (ka->in[7])
#define w_in_a (ka->in[8])
#define w_gate_lr (ka->in[9])
#define b_gate (ka->in[10])
#define gla_norm_g (ka->in[11])
#define w_in_b (ka->in[12])
#define w_kv_shared (ka->in[13])
#define w_mem_kv (ka->in[14])
#define w_o (ka->in[15])
#define ln1_g (ka->in[16])
#define ln1_b (ka->in[17])
#define ln2_g (ka->in[18])
#define ln2_b (ka->in[19])
#define w_ffn_in (ka->in[20])
#define w_ffn_out (ka->in[21])
#define WIN ((bf16*)(ws + WS_WIN))
#define WO ((bf16*)(ws + WS_WO))
#define WFI ((bf16*)(ws + WS_WFI))
#define WFO ((bf16*)(ws + WS_WFO))
#define WMEM ((bf16*)(ws + WS_WMEM))
#define MEMX ((bf16*)(ws + WS_MEMX))
#define MEMK ((bf16*)(ws + WS_MEMK))
#define MEMV ((bf16*)(ws + WS_MEMV))
#define X ((bf16*)(ws + WS_X))
#define Y ((float*)(ws + WS_Y))
#define PROJ ((bf16*)(ws + WS_R1))
#define HB ((bf16*)(ws + WS_R1))
#define OCAT ((bf16*)(ws + WS_OCAT))
#define SBKS ((bf16*)(ws + WS_SBKS))
#define SBVS ((bf16*)(ws + WS_SBVS))
#define OINT (out + O_YP)
#define KPB ((bf16*)(out + O_YP))
#define VPB (KPB + (size_t)MP * 1536)

#define PHASE_BEGIN(cond, cls) if (cond) { if (lo <= ph && ph < hi) { if (ph > lo) xcd_barrier(bar); DIAG_STAMP(cls); for (int rep_ = 0; rep_ < (((cls) == REP_CLS) ? 2 : 1); ++rep_) { const __attribute__((address_space(4))) Args* ka = KARGS; asm volatile("" : "+s"(ka)); int tid_ = threadIdx.x, G_ = gridDim.x, bid_ = blockIdx.x; asm volatile("" : "+v"(tid_), "+s"(G_), "+s"(bid_)); const int tid = tid_, lane = tid_ & 63, wave_ = __builtin_amdgcn_readfirstlane(tid_ >> 6), gw_ = bid_ * NWAVES + wave_, NGW_ = G_ * NWAVES; (void)tid; (void)lane; (void)gw_; (void)NGW_;
#define PHASE_END } } ++ph; }
#ifndef REP_CLS
#define REP_CLS (-1)
#endif
#if defined(DIAG_A)
#define DIAG_STAMP(cls) do { if (blockIdx.x == 0 && threadIdx.x == 0) { unsigned long long* dts = (unsigned long long*)(args.ws_ + 262144); dts[ph] = rt(); } } while (0)
#else
#define DIAG_STAMP(cls) do { } while (0)
#endif

    PHASE_BEGIN(true, 0)
        for (int r = gw_; r < MT; r += NGW_) cvt_row(r < MP ? x_prompt + (size_t)r * D : (r < MR ? x_sample + (size_t)(r - MP) * D : nullptr), X + (size_t)r * D, D, lane);
        for (int r = gw_; r < 1024; r += NGW_) cvt_row(mem_prompt + (size_t)r * D, MEMX + (size_t)r * D, D, lane);
        for (int r = gw_; r < 4 * 8 * 256; r += NGW_) { const int l = r >> 11, b = (r >> 8) & 7, m = r & 255; const size_t dst = (size_t)((l * 12 + 4 + b) * 256 + m) * 512;
            cvt_row(cache_mem_k + (size_t)r * 512, MEMK + dst, 512, lane); }
        for (int it = gw_; it < 512; it += NGW_) { const int hdb = it & 3, mb = (it >> 2) & 3, b = (it >> 4) & 7, l = it >> 7, m = mb * 64 + lane;
            const float* src = cache_mem_v + (size_t)((l * 8 + b) * 256 + m) * 512 + hdb * 128; bf16* dst = MEMV + (size_t)((l * 12 + 4 + b) * 512 + hdb * 128) * 256 + m;
            for (int q4 = 0; q4 < 32; ++q4) { const f32x4 v = *(const f32x4*)(src + 4 * q4);
#pragma unroll
                for (int e = 0; e < 4; ++e) dst[(size_t)(4 * q4 + e) * 256] = (bf16)f2bf(v[e]); } }
        for (int r = gw_; r < 8 * 2048; r += NGW_) { const int b = r >> 11, s = r & 2047; const size_t dst = (size_t)(b * 2064 + s) * 1536;
            cvt_row(cache_sb_k + (size_t)r * 1536, SBKS + dst, 1536, lane); }
        for (int it = gw_; it < 3072; it += NGW_) { const int cb = it % 12, sb_ = (it / 12) & 31, b = it / 384, s = sb_ * 64 + lane;
            const float* src = cache_sb_v + (size_t)(b * 2048 + s) * 1536 + cb * 128; bf16* dst = SBVS + (size_t)(b * 1536 + cb * 128) * 2080 + s;
            for (int q4 = 0; q4 < 32; ++q4) { const f32x4 v = *(const f32x4*)(src + 4 * q4);
#pragma unroll
                for (int e = 0; e < 4; ++e) dst[(size_t)(4 * q4 + e) * 2080] = (bf16)f2bf(v[e]); } }
        for (int l = 0; l < 4; ++l) wt_convert(F.lds, wave_, gw_, NGW_, lane, w_mem_kv + (size_t)l * D * 1024, D, 1024, WMEM + (size_t)l * 1024 * D, 1024, MapId());
    PHASE_END
    PHASE_BEGIN(true, 0)
        pg8::Gemm g{MEMX, WMEM, 1024, 4096, D}; pg8::StaticOrder S; S.init(1024, 4096, G_, bid_);
        pg8::EpiMemKV E{out + O_MKP, out + O_MVP, MEMK, MEMV};
        pg8::gemm_phase<pg8::EpiMemKV, pg8::StaticOrder, true, true>(F.lds + RING_OFF, g, S, E);
    PHASE_END

    for (int l = 0; l < 4; ++l) {
        const bool LA = l < 2;
        PHASE_BEGIN(true, 1)
            if (LA) wt_convert(F.lds, wave_, gw_, NGW_, lane, w_in_a + (size_t)l * D * 5136, D, 5136, WIN, NA, MapInA());
            else { wt_convert(F.lds, wave_, gw_, NGW_, lane, w_in_b + (size_t)(l - 2) * D * NBQ, D, NBQ, WIN, NBQ, MapId()); if (l == 2) wt_convert(F.lds, wave_, gw_, NGW_, lane, w_kv_shared, D, NKV, WIN + (size_t)NBQ * D, NKV, MapId()); }
            wt_convert(F.lds, wave_, gw_, NGW_, lane, w_o + (size_t)l * D * D, D, D, WO, D, MapId());
            wt_convert(F.lds, wave_, gw_, NGW_, lane, w_ffn_in + (size_t)l * D * 2 * DFF, D, 2 * DFF, WFI, 2 * DFF, MapFfn());
            wt_convert(F.lds, wave_, gw_, NGW_, lane, w_ffn_out + (size_t)l * DFF * D, DFF, D, WFO, D, MapId());
        PHASE_END
        const int ldp = LA ? NA : NBQ;
        PHASE_BEGIN(true, 2)
            { pg8::Gemm g{X, WIN, MT, ldp, D}; pg8::StaticOrder S; S.init(MT, ldp, G_, bid_); pg8::EpiBf16 E{PROJ, ldp};
              pg8::gemm_phase<pg8::EpiBf16, pg8::StaticOrder, true, true>(F.lds + RING_OFF, g, S, E); }
            if (l == 2) { pg8::Gemm g{X, WIN + (size_t)NBQ * D, MT, NKV, D}; pg8::StaticOrder S; S.init(MT, NKV, G_, bid_);
              pg8::EpiKV E{out + O_SKP, out + O_SVP, out + O_SKS, out + O_SVS, KPB, VPB, SBKS, SBVS};
              pg8::gemm_phase<pg8::EpiKV, pg8::StaticOrder, true, true>(F.lds + RING_OFF, g, S, E); }
        PHASE_END
        PHASE_BEGIN(LA, 3)
            gla_prep(bid_, G_, tid, wave_, F.lds + RING_OFF, l, PROJ, w_gate_lr, b_gate, (unsigned char*)Y);
        PHASE_END
        PHASE_BEGIN(true, (LA ? 4 : 11))
            if (LA) {
                for (int item = gw_; item < N_PKG; item += NGW_) gla_intra(item, lane, (const unsigned char*)Y, OINT);
            } else {
                for (int u = gw_; u < 12288 + 96; u += NGW_) {
                    if (u < 12288) { const int bh = u >> 8, qb = u & 255, b = bh / 12, h = bh % 12, t0 = 32 * qb; const size_t qo = (size_t)(b * SEQ + t0) * D + h * 128;
                        sb_attn(lane, F.lds + RING_OFF + wave_ * 16384, KPB + (size_t)(b * SEQ) * 1536 + h * 128, 1536, VPB + (size_t)(bh * 128) * SEQ, SEQ, PROJ + qo, NBQ, OCAT + qo, t0, 32); }
                    else { const int u2 = u - 12288, b = u2 / 12, h = u2 % 12; const size_t qo = (size_t)(MP + b * 16) * D + h * 128;
                        sb_attn(lane, F.lds + RING_OFF + wave_ * 16384, SBKS + (size_t)(b * 2064) * 1536 + h * 128, 1536, SBVS + (size_t)(u2 * 128) * 2080, 2080, PROJ + qo, NBQ, OCAT + qo, 2048, 16); }
                }
            }
            __syncthreads();
            for (int wi = bid_; wi < 256; wi += G_) mem_attn_wg(wi, tid, wave_, F.lds + RING_OFF, l, PROJ, ldp, LA ? CQM : 1536, MEMK, MEMV, OCAT);
            for (int it = gw_; it < 32; it += NGW_) mem_attn((2048 + (it >> 2)) * 4 + (it & 3), lane, l, PROJ, ldp, LA ? CQM : 1536, MEMK, MEMV, OCAT);
        PHASE_END
        PHASE_BEGIN(LA, 5)
            for (int wc = bid_; wc < 48 + 96; wc += G_) gla_chain(wc, tid, wave_, F.lds + RING_OFF, l, (const unsigned char*)Y, state_gla, OINT, out, REP_CLS == 5 && rep_ == 0);
        PHASE_END
        PHASE_BEGIN(LA, 6)
            const float* gn = gla_norm_g + (size_t)l * 384;
            for (int row = gw_; row < MR; row += NGW_) {
#pragma unroll
                for (int h = 0; h < 4; ++h) { bf16* op = OCAT + (size_t)row * D + h * 384; const bf16* gp = PROJ + (size_t)row * NA + CG + h * 384;
                    float ov[6]; float ss = 0.f;
#pragma unroll
                    for (int j = 0; j < 3; ++j) { const f32x2_t w = *(const f32x2_t*)(OINT + (size_t)row * 1536 + h * 384 + 2 * lane + 128 * j); ov[2 * j] = w.x; ov[2 * j + 1] = w.y; ss += ov[2 * j] * ov[2 * j] + ov[2 * j + 1] * ov[2 * j + 1]; }
                    const float r = 1.0f / sqrtf(wave_sum(ss, lane) * (1.0f / 384.0f) + RMS_EPS);
#pragma unroll
                    for (int j = 0; j < 3; ++j) { const int c = 2 * lane + 128 * j; const unsigned gw2 = *(const unsigned*)(gp + c); const float g0 = pg8::bflo(gw2), g1 = pg8::bfhi(gw2);
                        const float r0 = ov[2 * j] * r * gn[c] * (g0 / (1.0f + __expf(-g0))), r1 = ov[2 * j + 1] * r * gn[c + 1] * (g1 / (1.0f + __expf(-g1)));
                        *(unsigned*)(op + c) = pk2(r0, r1); } }
            }
        PHASE_END
        PHASE_BEGIN(true, 7)
            pg8::Gemm g{OCAT, WO, MT, D, D}; pg8::StaticOrder S; S.init(MT, D, G_, bid_); pg8::EpiRes E{Y, X, D, DN_ALPHA};
            pg8::gemm_phase<pg8::EpiRes, pg8::StaticOrder, true, true>(F.lds + RING_OFF, g, S, E);
        PHASE_END
        PHASE_BEGIN(true, 8)
            const float* gg = ln1_g + (size_t)l * D; const float* bb = ln1_b + (size_t)l * D;
            for (int row = gw_; row < MR; row += NGW_) {
                const f32x4* yr = (const f32x4*)(Y + (size_t)row * D) + lane; f32x4 v[8]; float s = 0.f;
#pragma unroll
                for (int j = 0; j < 8; ++j) { v[j] = yr[64 * j]; s += (v[j].x + v[j].y) + (v[j].z + v[j].w); }
                const float mean = wave_sum(s, lane) * (1.f / D); float s2 = 0.f;
#pragma unroll
                for (int j = 0; j < 8; ++j) { v[j] = v[j] - mean; s2 += (v[j].x * v[j].x + v[j].y * v[j].y) + (v[j].z * v[j].z + v[j].w * v[j].w); }
                const float rstd = 1.f / sqrtf(wave_sum(s2, lane) * (1.f / D) + LN_EPS);
                unsigned long long* o8 = (unsigned long long*)(X + (size_t)row * D) + lane;
#pragma unroll
                for (int j = 0; j < 8; ++j) { const f32x4 g4 = *((const f32x4*)gg + lane + 64 * j), b4 = *((const f32x4*)bb + lane + 64 * j); const f32x4 r = v[j] * rstd * g4 + b4;
                    o8[64 * j] = (unsigned long long)pk2(r.x, r.y) | ((unsigned long long)pk2(r.z, r.w) << 32); }
            }
        PHASE_END
        PHASE_BEGIN(true, 9)
            pg8::Gemm g{X, WFI, MT, 2 * DFF, D}; pg8::StaticOrder S; S.init(MT, 2 * DFF, G_, bid_); pg8::EpiSwiGLU E{HB, DFF};
            pg8::gemm_phase<pg8::EpiSwiGLU, pg8::StaticOrder, true, true>(F.lds + RING_OFF, g, S, E);
        PHASE_END
        PHASE_BEGIN(true, 10)
            pg8::Gemm g{HB, WFO, MT, D, DFF}; pg8::StaticOrder S; S.init(MT, D, G_, bid_); pg8::EpiRes E{Y, X, D, DN_ALPHA};
            pg8::gemm_phase<pg8::EpiRes, pg8::StaticOrder, true, true>(F.lds + RING_OFF, g, S, E);
        PHASE_END
        PHASE_BEGIN(true, 8)
            const float* gg = ln2_g + (size_t)l * D; const float* bb = ln2_b + (size_t)l * D;
            for (int row = gw_; row < MR; row += NGW_) {
                const f32x4* yr = (const f32x4*)(Y + (size_t)row * D) + lane; f32x4 v[8]; float s = 0.f;
#pragma unroll
                for (int j = 0; j < 8; ++j) { v[j] = yr[64 * j]; s += (v[j].x + v[j].y) + (v[j].z + v[j].w); }
                const float mean = wave_sum(s, lane) * (1.f / D); float s2 = 0.f;
#pragma unroll
                for (int j = 0; j < 8; ++j) { v[j] = v[j] - mean; s2 += (v[j].x * v[j].x + v[j].y * v[j].y) + (v[j].z * v[j].z + v[j].w * v[j].w); }
                const float rstd = 1.f / sqrtf(wave_sum(s2, lane) * (1.f / D) + LN_EPS);
                if (l == 3) { f32x4* of = (f32x4*)(row < MP ? out + O_YP + (size_t)row * D : out + O_YS + (size_t)(row - MP) * D) + lane;
#pragma unroll
                    for (int j = 0; j < 8; ++j) { const f32x4 g4 = *((const f32x4*)gg + lane + 64 * j), b4 = *((const f32x4*)bb + lane + 64 * j); of[64 * j] = v[j] * rstd * g4 + b4; } }
                else { unsigned long long* o8 = (unsigned long long*)(X + (size_t)row * D) + lane;
#pragma unroll
                    for (int j = 0; j < 8; ++j) { const f32x4 g4 = *((const f32x4*)gg + lane + 64 * j), b4 = *((const f32x4*)bb + lane + 64 * j); const f32x4 r = v[j] * rstd * g4 + b4;
                        o8[64 * j] = (unsigned long long)pk2(r.x, r.y) | ((unsigned long long)pk2(r.z, r.w) << 32); } }
            }
        PHASE_END
    }
#if defined(DIAG_A)
    if (blockIdx.x == 0 && threadIdx.x == 0) { unsigned long long* dts = (unsigned long long*)(args.ws_ + 262144); dts[ph] = rt(); dts[63] = (unsigned long long)ph; }
#endif
#undef ws
#undef out
#undef X
#undef Y
#undef PHASE_BEGIN
#undef PHASE_END
}

#if defined(DIAG_A)
__device__ const int diag_cls[40] = {0,0, 1,2,3,4,5,6,7,8,9,10,8, 1,2,3,4,5,6,7,8,9,10,8, 1,2,11,7,8,9,10,8, 1,2,11,7,8,9,10,8};
__global__ void diag_tail(float* o, const unsigned long long* dts) {
    __shared__ float dv[2];
    if (threadIdx.x == 0) { const int n = (int)dts[63]; unsigned long long sa = 0, sb = 0; for (int p = 0; p < n; ++p) { const unsigned long long d = dts[p + 1] - dts[p]; const int cl = diag_cls[p]; if (cl == DIAG_A) sa += d; if (cl == DIAG_B) sb += d; }
        dv[0] = (float)sa * 0.01f; dv[1] = (float)sb * 10.0f; }
    __syncthreads();
    for (int i = threadIdx.x; i < 262144; i += blockDim.x) o[O_YS + i] = dv[0];
    if (threadIdx.x == 0) o[O_YP] = dv[1];
}
#endif
#ifndef MK_PER_PHASE
#define MK_PER_PHASE 0
#endif
constexpr int N_PHASES = 2 + 2 * 11 + 2 * 8;
extern "C" void kernel_launch(void* const* d_in, const int* in_sizes, int n_in, void* d_out, int out_size, void* d_ws, size_t ws_size, hipStream_t stream) {
    static int grid = 0;
    if (grid == 0) {
        if (n_in != 22 || in_sizes[0] != MP * D || (size_t)out_size != O_END || ws_size < WS_END) { fprintf(stderr, "kernel_launch: unexpected shapes (n_in %d, in0 %d, out %d, ws %zu); nothing launched\n", n_in, n_in > 0 ? in_sizes[0] : -1, out_size, ws_size); grid = -1; return; }
        int dev = 0, cus = 0, per_cu = 0;
        if (hipGetDevice(&dev) != hipSuccess || hipDeviceGetAttribute(&cus, hipDeviceAttributeMultiprocessorCount, dev) != hipSuccess) { grid = -1; return; }
        if (hipFuncSetAttribute((const void*)mega, hipFuncAttributeMaxDynamicSharedMemorySize, LDS_BYTES) != hipSuccess) { fprintf(stderr, "kernel_launch: hipFuncSetAttribute failed\n"); grid = -1; return; }
        if (hipOccupancyMaxActiveBlocksPerMultiprocessor(&per_cu, (const void*)mega, NWAVES * 64, LDS_BYTES) != hipSuccess || per_cu < 1) fprintf(stderr, "kernel_launch: occupancy query reports %d\n", per_cu);
        (void)hipGetLastError();
        grid = cus;
    }
    if (grid < 0) return;
    if (hipMemsetAsync((char*)d_ws + WS_CTL, 0, CTL_ZERO_BYTES, stream) != hipSuccess) return;
    Args a{};
    for (int i = 0; i < 22; ++i) a.in[i] = (const float*)d_in[i];
    a.out_ = (float*)d_out; a.ws_ = (unsigned char*)d_ws;
#if MK_PER_PHASE
    for (int p = 0; p < N_PHASES; ++p) { a.ph_lo = p; a.ph_hi = p + 1; hipLaunchKernelGGL(mega, dim3(grid), dim3(NWAVES * 64), LDS_BYTES, stream, a); }
#else
    a.ph_lo = 0; a.ph_hi = N_PHASES; hipLaunchKernelGGL(mega, dim3(grid), dim3(NWAVES * 64), LDS_BYTES, stream, a);
#if defined(DIAG_A)
    hipLaunchKernelGGL(diag_tail, dim3(1), dim3(512), 0, stream, (float*)d_out, (const unsigned long long*)((unsigned char*)d_ws + 262144));
#endif
#endif
}
```

```cpp
#include <hip/hip_runtime.h>
#include <cstdio>
#include <cstdint>
namespace pg8 {
#define PG8_LAS __attribute__((address_space(3)))
typedef unsigned short bf16_t;
typedef short bf16x8 __attribute__((ext_vector_type(8)));
typedef float f32x4 __attribute__((ext_vector_type(4)));
typedef unsigned u32x4 __attribute__((ext_vector_type(4)));
constexpr int BM = 256, BK = 64, HALF = 128, HTB = HALF * BK * 2  , STAGE_BYTES = 8 * HTB, NXCD = 8, WGM = 8;

__host__ __device__ __forceinline__ int lds_byte(int r, int c) { const int st = (r >> 4) * 2 + (c >> 5), rr = r & 15, cc = c & 31, ob = rr * 64 + cc * 2; return st * 1024 + (ob ^ (((ob >> 9) & 1) << 5)); }
__host__ __device__ __forceinline__ void stage_rc(int b, int& R, int& C) { const int st = b / 1024, sb = b % 1024, swz = sb ^ (((sb >> 9) & 1) << 5); R = (st >> 1) * 16 + swz / 64; C = (st & 1) * 32 + (swz % 64) / 2; }
__host__ __device__ __forceinline__ int perm32(int rho) { const int n = rho >> 4, i = rho & 15; return 8 * (i >> 2) + 4 * n + (i & 3); }

struct Unit { int pm, pn; };
struct Gemm { const bf16_t* A; const bf16_t* Bt; int M, N, K; };

struct StaticOrder {
    int nM, nN, nwg, G, c;
    __host__ __device__ void init(int M, int N, int G_, int c_) { nM = M / BM; nN = N / BM; nwg = nM * nN; G = G_; c = c_; }
    __host__ __device__ bool next(int i, Unit& u) const {
        const long L = (long)i * G + c; if (L >= nwg) return false;
        int wgid = (int)L; { const int q = nwg / NXCD, r = nwg % NXCD, xcd = wgid % NXCD, off = wgid / NXCD; wgid = (xcd < r ? xcd * (q + 1) : r * (q + 1) + (xcd - r) * q) + off; }
        const int nig = WGM * nN, gid = wgid / nig, fm = gid * WGM, gsz = (nM - fm) < WGM ? (nM - fm) : WGM;
        u.pm = fm + ((wgid % nig) % gsz); u.pn = (wgid % nig) / gsz; return true;
    }
    __device__ __forceinline__ void a_ready(const Unit&) const {}
    __device__ __forceinline__ void done(const Unit&) const {}
};
__device__ __forceinline__ unsigned cvt_pk_bf16(float lo, float hi) { unsigned r; asm volatile("v_cvt_pk_bf16_f32 %0, %1, %2" : "=v"(r) : "v"(lo), "v"(hi)); return r; }
typedef float f32x2 __attribute__((ext_vector_type(2)));
typedef unsigned u32x2 __attribute__((ext_vector_type(2)));
__device__ __forceinline__ float bflo(unsigned w) { return __builtin_bit_cast(float, w << 16); }
__device__ __forceinline__ float bfhi(unsigned w) { return __builtin_bit_cast(float, w & 0xffff0000u); }
struct EpiBf16 {
    static constexpr bool PERM = true, AFTER_DRAIN = false;
    bf16_t* O; int ldc;
    __device__ __forceinline__ void operator()(const f32x4 (&acc)[2][2][4][2], const Unit& u, int wr, int wc, int fr, int fq) const {
        const int row0 = u.pm * BM + wr * 64 + fr, col0 = u.pn * BM + wc * 32 + 8 * fq;
#pragma unroll
        for (int ai = 0; ai < 2; ++ai)
#pragma unroll
            for (int m = 0; m < 4; ++m) { bf16_t* rowp = O + (size_t)(row0 + ai * HALF + m * 16) * ldc + col0;
#pragma unroll
                for (int bj = 0; bj < 2; ++bj) { const f32x4 v0 = acc[ai][bj][m][0], v1 = acc[ai][bj][m][1];
                    u32x4 w; w.x = cvt_pk_bf16(v0[0], v0[1]); w.y = cvt_pk_bf16(v0[2], v0[3]); w.z = cvt_pk_bf16(v1[0], v1[1]); w.w = cvt_pk_bf16(v1[2], v1[3]);
                    *(u32x4*)(rowp + bj * HALF) = w; } __builtin_amdgcn_sched_barrier(0); }
    }
};
struct EpiSwiGLU {
    static constexpr bool PERM = true, AFTER_DRAIN = false;
    bf16_t* Hh; int ldh;
    __device__ __forceinline__ float swi(float g, float up) const { return g * __builtin_amdgcn_rcpf(1.0f + __expf(-g)) * up; }
    __device__ __forceinline__ void operator()(const f32x4 (&acc)[2][2][4][2], const Unit& u, int wr, int wc, int fr, int fq) const {
        const int row0 = u.pm * BM + wr * 64 + fr, col0 = u.pn * HALF + wc * 32 + 8 * fq;
#pragma unroll
        for (int ai = 0; ai < 2; ++ai)
#pragma unroll
            for (int m = 0; m < 4; ++m) { bf16_t* rowp = Hh + (size_t)(row0 + ai * HALF + m * 16) * ldh + col0;
                const f32x4 g0 = acc[ai][0][m][0], g1 = acc[ai][0][m][1], u0 = acc[ai][1][m][0], u1 = acc[ai][1][m][1];
                u32x4 w; w.x = cvt_pk_bf16(swi(g0[0], u0[0]), swi(g0[1], u0[1])); w.y = cvt_pk_bf16(swi(g0[2], u0[2]), swi(g0[3], u0[3]));
                w.z = cvt_pk_bf16(swi(g1[0], u1[0]), swi(g1[1], u1[1])); w.w = cvt_pk_bf16(swi(g1[2], u1[2]), swi(g1[3], u1[3]));
                *(u32x4*)rowp = w; __builtin_amdgcn_sched_barrier(0); }
    }
};
struct EpiRes {
    static constexpr bool PERM = false, AFTER_DRAIN = false;
    float* Y; const bf16_t* X; int ldc; float alpha;
    __device__ __forceinline__ void operator()(const f32x4 (&acc)[2][2][4][2], const Unit& u, int wr, int wc, int fr, int fq) const {
        const int row0 = u.pm * BM + wr * 64 + fr, col0 = u.pn * BM + wc * 32 + 4 * fq;
#pragma unroll
        for (int ai = 0; ai < 2; ++ai)
#pragma unroll
            for (int m = 0; m < 4; ++m) { const size_t ro = (size_t)(row0 + ai * HALF + m * 16) * ldc + col0;
#pragma unroll
                for (int bj = 0; bj < 2; ++bj)
#pragma unroll
                    for (int n = 0; n < 2; ++n) { const size_t o = ro + bj * HALF + n * 16; const u32x2 xv = *(const u32x2*)(X + o);
                        f32x4 r; r[0] = alpha * bflo(xv.x); r[1] = alpha * bfhi(xv.x); r[2] = alpha * bflo(xv.y); r[3] = alpha * bfhi(xv.y);
                        *(f32x4*)(Y + o) = r + acc[ai][bj][m][n]; } __builtin_amdgcn_sched_barrier(0); }
    }
};
struct EpiKV {
    static constexpr bool PERM = false, AFTER_DRAIN = false;
    float *okp, *ovp, *oks, *ovs; bf16_t *kpb, *vpb, *ksb, *vsb;
    __device__ __forceinline__ void operator()(const f32x4 (&acc)[2][2][4][2], const Unit& u, int wr, int wc, int fr, int fq) const {
        const bool isv = u.pn >= 6; const int colt = (u.pn - (isv ? 6 : 0)) * BM + wc * 32 + 4 * fq, row0 = u.pm * BM + wr * 64 + fr;
        float* op = isv ? ovp : okp; float* os = isv ? ovs : oks; bf16_t* bp = isv ? vpb : kpb; bf16_t* bs = isv ? vsb : ksb;
#pragma unroll
        for (int ai = 0; ai < 2; ++ai)
#pragma unroll
            for (int m = 0; m < 4; ++m) { const int row = row0 + ai * HALF + m * 16; float* fd; bf16_t* bd;
                bf16_t* vt; size_t vld;
                if (row < 32768) { fd = op + (size_t)row * 1536; bd = bp + (size_t)row * 1536; vt = vpb + (size_t)((row >> 13) * 1536) * 8192 + (row & 8191); vld = 8192; }
                else if (row < 32896) { const int i = row - 32768; fd = os + (size_t)i * 1536; bd = bs + (size_t)((i >> 4) * 2064 + 2048 + (i & 15)) * 1536; vt = vsb + (size_t)((i >> 4) * 1536) * 2080 + 2048 + (i & 15); vld = 2080; }
                else continue;
#pragma unroll
                for (int bj = 0; bj < 2; ++bj)
#pragma unroll
                    for (int n = 0; n < 2; ++n) { const int c = colt + bj * HALF + n * 16; const f32x4 v = acc[ai][bj][m][n];
                        *(f32x4*)(fd + c) = v; const unsigned w0 = cvt_pk_bf16(v[0], v[1]), w1 = cvt_pk_bf16(v[2], v[3]);
                        if (!isv) { u32x2 w; w.x = w0; w.y = w1; *(u32x2*)(bd + c) = w; }
                        else { vt[(size_t)c * vld] = (bf16_t)w0; vt[(size_t)(c + 1) * vld] = (bf16_t)(w0 >> 16); vt[(size_t)(c + 2) * vld] = (bf16_t)w1; vt[(size_t)(c + 3) * vld] = (bf16_t)(w1 >> 16); } } }
    }
};
struct EpiMemKV {
    static constexpr bool PERM = false, AFTER_DRAIN = false;
    float *ok, *ov; bf16_t *kb, *vb;
    __device__ __forceinline__ void operator()(const f32x4 (&acc)[2][2][4][2], const Unit& u, int wr, int wc, int fr, int fq) const {
        const int l = u.pn >> 2, kv = (u.pn >> 1) & 1, hd0 = (u.pn & 1) * BM + wc * 32 + 4 * fq, row0 = u.pm * BM + wr * 64 + fr;
        float* fo = kv ? ov : ok; bf16_t* bo = kv ? vb : kb;
#pragma unroll
        for (int ai = 0; ai < 2; ++ai)
#pragma unroll
            for (int m = 0; m < 4; ++m) { const int row = row0 + ai * HALF + m * 16, b = row >> 8, mm = row & 255;
                float* fd = fo + (size_t)(l * 1024 + row) * 512; bf16_t* bd = bo + (size_t)((l * 12 + b) * 256 + mm) * 512;
#pragma unroll
                for (int bj = 0; bj < 2; ++bj)
#pragma unroll
                    for (int n = 0; n < 2; ++n) { const int c = hd0 + bj * HALF + n * 16; const f32x4 v = acc[ai][bj][m][n];
                        *(f32x4*)(fd + c) = v; const unsigned w0 = cvt_pk_bf16(v[0], v[1]), w1 = cvt_pk_bf16(v[2], v[3]);
                        if (!kv) { u32x2 w; w.x = w0; w.y = w1; *(u32x2*)(bd + c) = w; }
                        else { bf16_t* vt = vb + (size_t)((l * 12 + b) * 512 + c) * 256 + mm;
                            vt[0] = (bf16_t)w0; vt[256] = (bf16_t)(w0 >> 16); vt[512] = (bf16_t)w1; vt[768] = (bf16_t)(w1 >> 16); } } }
    }
};
template <class Epi, class Sched, bool ALIGN_EPI = false, bool SP2 = false>
__device__ __forceinline__ void gemm_phase(PG8_LAS unsigned char* lds, const Gemm g, const Sched& S, const Epi& E) {
    int tid_ = threadIdx.x; asm volatile("" : "+v"(tid_));
    const int tid = tid_, wid = __builtin_amdgcn_readfirstlane(tid >> 6), lane = tid & 63, wr = wid >> 2, wc = wid & 3, fr = lane & 15, fq = lane >> 4;
    const int K = g.K, nt = K / BK;
    unsigned voffA[2], voffB[2];
#pragma unroll
    for (int i = 0; i < 2; ++i) { int R, C; stage_rc(tid * 16 + i * 8192, R, C); const int Rb = Epi::PERM ? ((R & ~31) + perm32(R & 31)) : R;
        voffA[i] = (unsigned)(R * K + C) * 2u; voffB[i] = (unsigned)(Rb * K + C) * 2u; }
    const size_t kstep = (size_t)(BK * 2);
    const size_t hstep = (size_t)HALF * K * 2;
    const size_t tstep = 2 * hstep;
    const unsigned ldsw = (unsigned)wid * 1024u;
    const int aoff = lds_byte(wr * 64 + fr, fq * 8), boff = lds_byte(wc * 32 + fr, fq * 8);
#define PG8_SA(b, h) (((b) * 2 + (h)) * HTB)
#define PG8_SB(b, h) ((4 + (b) * 2 + (h)) * HTB)
#define PG8_STAGE(bufoff, gbase, voff) do { _Pragma("unroll") for (int _i = 0; _i < 2; ++_i) \
        __builtin_amdgcn_global_load_lds((const unsigned*)((const char*)(gbase) + (voff)[_i]), (PG8_LAS unsigned*)(lds + (bufoff) + ldsw + _i * 8192), 16, 0, 0); } while (0)
#define PG8_LDA(dst, b, h) do { _Pragma("unroll") for (int m = 0; m < 4; ++m) _Pragma("unroll") for (int k = 0; k < 2; ++k) dst[m][k] = *(const PG8_LAS bf16x8*)(lds + PG8_SA(b, h) + aoff + m * 2048 + k * 1024); } while (0)
#define PG8_LDB(dst, b, h) do { _Pragma("unroll") for (int n = 0; n < 2; ++n) _Pragma("unroll") for (int k = 0; k < 2; ++k) dst[n][k] = *(const PG8_LAS bf16x8*)(lds + PG8_SB(b, h) + boff + n * 2048 + k * 1024); } while (0)
#define PG8_MMA(ai, bj, At, Bt) do { __builtin_amdgcn_s_setprio(1); _Pragma("unroll") for (int m = 0; m < 4; ++m) _Pragma("unroll") for (int n = 0; n < 2; ++n) _Pragma("unroll") for (int k = 0; k < 2; ++k) \
        acc[ai][bj][m][n] = __builtin_amdgcn_mfma_f32_16x16x32_bf16(Bt[n][k], At[m][k], acc[ai][bj][m][n], 0, 0, 0); __builtin_amdgcn_s_setprio(0); } while (0)
#define PG8_WAIT_V(n) asm volatile("s_waitcnt vmcnt(" #n ")" ::: "memory")
#define PG8_WAIT_L(n) asm volatile("s_waitcnt lgkmcnt(" #n ")" ::: "memory")
#define PG8_BAR __builtin_amdgcn_s_barrier()
#define PG8_SCHED __builtin_amdgcn_sched_barrier(0)
    Unit cur, nxt; int ui = 0;
    if (!S.next(0, cur)) return;
    f32x4 acc[2][2][4][2];
#pragma unroll
    for (int a = 0; a < 2; ++a)
#pragma unroll
        for (int b = 0; b < 2; ++b)
#pragma unroll
            for (int m = 0; m < 4; ++m)
#pragma unroll
                for (int n = 0; n < 2; ++n) acc[a][b][m][n] = (f32x4){0.f, 0.f, 0.f, 0.f};
    bf16x8 At[4][2], B0[2][2], B1[2][2];
    const char* cA = (const char*)g.A + (size_t)cur.pm * tstep; const char* cB = (const char*)g.Bt + (size_t)cur.pn * tstep;
    S.a_ready(cur);
    if constexpr (SP2) {
        PG8_STAGE(PG8_SB(0, 0), cB, voffB); PG8_STAGE(PG8_SB(0, 1), cB + hstep, voffB); PG8_STAGE(PG8_SA(0, 0), cA, voffA); PG8_STAGE(PG8_SA(0, 1), cA + hstep, voffA);
        if (wr == 1) PG8_BAR;
        PG8_WAIT_V(2); PG8_BAR;
        PG8_STAGE(PG8_SB(1, 0), cB + kstep, voffB); PG8_STAGE(PG8_SA(1, 0), cA + kstep, voffA); PG8_STAGE(PG8_SB(1, 1), cB + hstep + kstep, voffB);
        PG8_WAIT_V(6); PG8_BAR;
    } else {
        PG8_STAGE(PG8_SB(0, 0), cB, voffB); PG8_STAGE(PG8_SA(0, 0), cA, voffA); PG8_STAGE(PG8_SB(0, 1), cB + hstep, voffB); PG8_STAGE(PG8_SA(0, 1), cA + hstep, voffA);
        if (wr == 1) PG8_BAR;
        PG8_WAIT_V(4); PG8_BAR;
        PG8_STAGE(PG8_SB(1, 0), cB + kstep, voffB); PG8_STAGE(PG8_SA(1, 0), cA + kstep, voffA); PG8_STAGE(PG8_SB(1, 1), cB + hstep + kstep, voffB);
        PG8_WAIT_V(6); PG8_BAR;
    }
    for (;;) {
        const bool has_next = S.next(ui + 1, nxt);
        const char* nA = has_next ? (const char*)g.A + (size_t)nxt.pm * tstep : cA; const char* nB = has_next ? (const char*)g.Bt + (size_t)nxt.pn * tstep : cB;
        for (int t = 0; t < nt; t += 2) {
            const bool last = (t == nt - 2);
            const char* a1 = cA + (size_t)(t + 1) * kstep;
            const char* a2 = last ? nA : cA + (size_t)(t + 2) * kstep; const char* b2 = last ? nB : cB + (size_t)(t + 2) * kstep;
            const char* a3 = a2 + kstep; const char* b3 = b2 + kstep;
            if (last && has_next) S.a_ready(nxt);
            if constexpr (SP2) {
            PG8_LDB(B0, 0, 0); PG8_LDB(B1, 0, 1); PG8_SCHED; PG8_LDA(At, 0, 0); PG8_STAGE(PG8_SA(1, 1), a1 + hstep, voffA);
            PG8_WAIT_V(8); PG8_WAIT_L(0); PG8_BAR; PG8_MMA(0, 0, At, B0); PG8_MMA(0, 1, At, B1); PG8_BAR; PG8_SCHED;
            PG8_LDA(At, 0, 1); PG8_STAGE(PG8_SB(0, 0), b2, voffB); PG8_STAGE(PG8_SB(0, 1), b2 + hstep, voffB); PG8_STAGE(PG8_SA(0, 0), a2, voffA);
            PG8_WAIT_V(8); PG8_WAIT_L(0); PG8_BAR; PG8_MMA(1, 0, At, B0); PG8_MMA(1, 1, At, B1); PG8_BAR; PG8_SCHED;
            PG8_LDB(B0, 1, 0); PG8_LDB(B1, 1, 1); PG8_SCHED; PG8_LDA(At, 1, 0); PG8_STAGE(PG8_SA(0, 1), a2 + hstep, voffA);
            PG8_WAIT_V(8); PG8_WAIT_L(0); PG8_BAR; PG8_MMA(0, 0, At, B0); PG8_MMA(0, 1, At, B1); PG8_BAR; PG8_SCHED;
            PG8_LDA(At, 1, 1); PG8_STAGE(PG8_SB(1, 0), b3, voffB); PG8_STAGE(PG8_SB(1, 1), b3 + hstep, voffB); PG8_STAGE(PG8_SA(1, 0), a3, voffA);
            PG8_WAIT_V(8); PG8_WAIT_L(0); PG8_BAR; PG8_MMA(1, 0, At, B0); PG8_MMA(1, 1, At, B1); PG8_BAR; PG8_SCHED;
            } else {
            PG8_LDB(B0, 0, 0); PG8_SCHED; PG8_LDA(At, 0, 0); PG8_STAGE(PG8_SA(1, 1), a1 + hstep, voffA);
            PG8_WAIT_L(8); PG8_BAR; PG8_WAIT_L(0); PG8_MMA(0, 0, At, B0); PG8_BAR; PG8_SCHED;
            PG8_LDB(B1, 0, 1); PG8_STAGE(PG8_SB(0, 0), b2, voffB);
            PG8_BAR; PG8_WAIT_L(0); PG8_MMA(0, 1, At, B1); PG8_BAR;
            PG8_LDA(At, 0, 1); PG8_STAGE(PG8_SA(0, 0), a2, voffA);
            PG8_BAR; PG8_WAIT_L(0); PG8_MMA(1, 0, At, B0); PG8_BAR; PG8_SCHED;
            PG8_STAGE(PG8_SB(0, 1), b2 + hstep, voffB);
            PG8_WAIT_V(6); PG8_BAR; PG8_MMA(1, 1, At, B1); PG8_BAR;
            PG8_LDB(B0, 1, 0); PG8_SCHED; PG8_LDA(At, 1, 0); PG8_STAGE(PG8_SA(0, 1), a2 + hstep, voffA);
            PG8_WAIT_L(8); PG8_BAR; PG8_WAIT_L(0); PG8_MMA(0, 0, At, B0); PG8_BAR; PG8_SCHED;
            PG8_LDB(B1, 1, 1); PG8_STAGE(PG8_SB(1, 0), b3, voffB);
            PG8_BAR; PG8_WAIT_L(0); PG8_MMA(0, 1, At, B1); PG8_BAR;
            PG8_LDA(At, 1, 1); PG8_STAGE(PG8_SA(1, 0), a3, voffA);
            PG8_BAR; PG8_WAIT_L(0); PG8_MMA(1, 0, At, B0); PG8_BAR; PG8_SCHED;
            PG8_STAGE(PG8_SB(1, 1), b3 + hstep, voffB);
            PG8_WAIT_V(6); PG8_BAR; PG8_MMA(1, 1, At, B1); PG8_BAR;
            }
        }
        if constexpr (ALIGN_EPI) { if (wr == 0) PG8_BAR; }
        if constexpr (!Epi::AFTER_DRAIN) { E(acc, cur, wr, wc, fr, fq); S.done(cur); }
        if (!has_next) break;
#pragma unroll
        for (int a = 0; a < 2; ++a)
#pragma unroll
            for (int b = 0; b < 2; ++b)
#pragma unroll
                for (int m = 0; m < 4; ++m)
#pragma unroll
                    for (int n = 0; n < 2; ++n) acc[a][b][m][n] = (f32x4){0.f, 0.f, 0.f, 0.f};
        cur = nxt; cA = nA; cB = nB; ++ui;
        if constexpr (ALIGN_EPI) { if (wr == 1) PG8_BAR; }
    }
    PG8_WAIT_V(0);
    if constexpr (!ALIGN_EPI) { if (wr == 0) PG8_BAR; }
    PG8_BAR;
    if constexpr (Epi::AFTER_DRAIN) { E.fused(acc, cur, wr, wc, fr, fq, lds, wid, lane); S.done(cur); }
#undef PG8_SA
#undef PG8_SB
#undef PG8_STAGE
#undef PG8_LDA
#undef PG8_LDB
#undef PG8_MMA
#undef PG8_WAIT_V
#undef PG8_WAIT_L
#undef PG8_BAR
#undef PG8_SCHED
}
}
#define GAS __attribute__((address_space(1)))
#define LAS __attribute__((address_space(3)))
typedef unsigned short bf16;
typedef unsigned v4u __attribute__((ext_vector_type(4)));
typedef float f32x4 __attribute__((ext_vector_type(4)));
typedef short bf16x8 __attribute__((ext_vector_type(8)));
typedef GAS unsigned gu32;
typedef GAS unsigned long long gu64;
#define RLX_AGENT __ATOMIC_RELAXED, __HIP_MEMORY_SCOPE_AGENT
#define LDS_WAIT() asm volatile("s_waitcnt lgkmcnt(0)" ::: "memory")
#define VM_WAIT() asm volatile("s_waitcnt vmcnt(0)" ::: "memory")
__device__ __forceinline__ unsigned long long rt() { return __builtin_amdgcn_s_memrealtime(); }
__device__ __forceinline__ unsigned f2bf(float f) { unsigned u = __builtin_bit_cast(unsigned, f); return (u + 0x7fffu + ((u >> 16) & 1u)) >> 16; }
__device__ __forceinline__ unsigned pk2(float lo, float hi) { return f2bf(lo) | (f2bf(hi) << 16); }
#define XB_TMO      128
#define XB_XCNT(j)  (256  + 64 * (j))
#define XB_XSUB(j)  (1280 + 64 * (j))
#define XB_XGEN(j)  (2304 + 64 * (j))
#define XB_TOP      3328
#define XB_TOPGEN   3392
#define XCD_BAR_WORDS 3456
#define XB_SPIN_CAP (1u << 18)

__device__ __forceinline__ unsigned xb_ld(unsigned* p)              { return __hip_atomic_load(p, __ATOMIC_RELAXED, __HIP_MEMORY_SCOPE_AGENT); }
__device__ __forceinline__ unsigned xb_add(unsigned* p, unsigned v) { return __hip_atomic_fetch_add(p, v, __ATOMIC_RELAXED, __HIP_MEMORY_SCOPE_AGENT); }
__device__ __forceinline__ unsigned xb_xcc_id() { return (unsigned)__builtin_amdgcn_s_getreg((3 << 11) | 20) & 0xFu; }
#define XB_SPIN(cond, bar) do { unsigned _sp = 0; while (cond) { __builtin_amdgcn_s_sleep(1); \
    if ((++_sp & 255u) == 0u) { if (xb_ld(&(bar)[XB_TMO])) break; if (_sp > XB_SPIN_CAP) { atomicAdd(&(bar)[XB_TMO], 1u); break; } } } } while (0)

struct XcdBarrier {
    unsigned* bar; unsigned x;
    volatile LAS unsigned* st;
};

__device__ __forceinline__ XcdBarrier xcd_barrier_post(unsigned* bar, volatile LAS unsigned* st) {
    XcdBarrier b; b.bar = bar; b.x = xb_xcc_id(); b.st = st;
    if (threadIdx.x == 0) (void)xb_add(&bar[XB_XCNT(b.x)], 1u);
    return b;
}
__device__ __forceinline__ void xcd_barrier_complete(unsigned* bar, unsigned x, unsigned& nloc, unsigned& nx) {
    const unsigned G = gridDim.x * gridDim.y * gridDim.z;
    unsigned sum, cnt, mine, sp = 0u;
    for (;;) {
        sum = 0u; cnt = 0u; mine = 0u;
#pragma unroll
        for (unsigned j = 0; j < 16; ++j) { const unsigned c = xb_ld(&bar[XB_XCNT(j)]); sum += c; cnt += (c > 0u) ? 1u : 0u; mine = (j == x) ? c : mine; }
        if (sum == G) break;
        __builtin_amdgcn_s_sleep(1);
        if ((++sp & 255u) == 0u) { if (xb_ld(&bar[XB_TMO])) break; if (sp > XB_SPIN_CAP) { atomicAdd(&bar[XB_TMO], 1u); break; } }
    }
    nloc = mine > 0u ? mine : 1u; nx = cnt > 0u ? cnt : 1u;
}

__device__ __forceinline__ void xcd_barrier(const XcdBarrier& b) {
    asm volatile("s_waitcnt vmcnt(0)" ::: "memory");
    __syncthreads();
    if (threadIdx.x == 0) {
        unsigned* bar = b.bar;
        __builtin_amdgcn_s_waitcnt(0);
        unsigned nloc = b.st[0], nx = b.st[1];
        if (nloc == 0u) { xcd_barrier_complete(bar, b.x, nloc, nx); b.st[0] = nloc; b.st[1] = nx; }
        const unsigned old = xb_add(&bar[XB_XSUB(b.x)], 1u);
        const unsigned gen = old / nloc;
        if (old + 1u == (gen + 1u) * nloc) {
            __builtin_amdgcn_fence(__ATOMIC_RELEASE, "agent");
            asm volatile("s_waitcnt vmcnt(0)" ::: "memory");
            const unsigned og = xb_add(&bar[XB_TOP], 1u);
            const unsigned tg = og / nx;
            if (og + 1u == (tg + 1u) * nx) xb_add(&bar[XB_TOPGEN], 1u);
            else XB_SPIN(xb_ld(&bar[XB_TOPGEN]) == tg, bar);
            __builtin_amdgcn_fence(__ATOMIC_ACQUIRE, "agent");
            xb_add(&bar[XB_XGEN(b.x)], 1u);
            asm volatile("s_waitcnt vmcnt(0)" ::: "memory");
        } else {
            XB_SPIN(xb_ld(&bar[XB_XGEN(b.x)]) == gen, bar);
            __builtin_amdgcn_fence(__ATOMIC_ACQUIRE, "agent");
            asm volatile("s_waitcnt vmcnt(0)" ::: "memory");
        }
    }
    __syncthreads();
}
constexpr int NWAVES = 8;
constexpr int D = 2048, SEQ = 8192, MP = 32768, MS = 128, MR = 32896, MT = 33024;
constexpr int DFF = 5632, NA = 5376, NBQ = 2048, NKV = 3072;
constexpr int CQ = 0, CK = 768, CV = 1536, CG = 3072, CQM = 4608, CLR = 5120;
constexpr float DN_ALPHA = 1.6817928305074292f, LN_EPS = 1e-5f, RMS_EPS = 1e-6f;
constexpr float GLA_QSCALE = 0.07216878364870323f, HD_SCALE = 0.08838834764831845f;
constexpr size_t MiB = 1u << 20;
constexpr size_t WS_CTL = 0, CTL_ZERO_BYTES = 1 * MiB;
constexpr size_t WS_WIN = 1 * MiB, WS_WO = 22 * MiB, WS_WFI = 30 * MiB, WS_WFO = 74 * MiB, WS_WMEM = 96 * MiB, WS_MEMX = 112 * MiB, WS_MEMK = 116 * MiB, WS_MEMV = 128 * MiB;
constexpr size_t WS_X = 140 * MiB, WS_Y = 269 * MiB, WS_R1 = 527 * MiB, WS_OCAT = 882 * MiB, WS_SBKS = 1011 * MiB, WS_SBVS = 1060 * MiB, WS_END = 1109 * MiB;
static_assert(WS_WIN + (size_t)NA * D * 2 <= WS_WO && WS_WFI + (size_t)2 * DFF * D * 2 <= WS_WFO && WS_WFO + (size_t)D * DFF * 2 <= WS_WMEM, "weights map");
static_assert(WS_X + (size_t)MT * D * 2 <= WS_Y && WS_Y + (size_t)MT * D * 4 <= WS_R1 && WS_R1 + (size_t)MT * DFF * 2 <= WS_OCAT && WS_OCAT + (size_t)MT * D * 2 <= WS_SBKS, "activation map");
static_assert(WS_SBKS + (size_t)8 * 2064 * 1536 * 2 <= WS_SBVS && WS_SBVS + (size_t)8 * 2064 * 1536 * 2 <= WS_END, "sb sample map");
constexpr size_t O_YP = 0, O_YS = 67108864, O_GSP = 67371008, O_GSS = 69730304, O_SKP = 74448896, O_SVP = 124780544, O_SKS = 175112192, O_SVS = 175308800, O_MKP = 175505408, O_MVP = 177602560, O_END = 179699712;
constexpr int CW_BAR = 4096;
constexpr int RING_OFF = 0, RING_BYTES = 131072, LDSCTL_OFF = RING_BYTES, MISC_OFF = LDSCTL_OFF + 320, LDS_BYTES = 147456;

struct Args { const float* in[22]; float* out_; unsigned char* ws_; int ph_lo, ph_hi; };
struct Frame {
    LAS unsigned char* lds; volatile LAS unsigned* MISC; gu32* ctl;
    int tid, lane, wave, G, gw, NGW;
};
__device__ __forceinline__ float bf2f(bf16 h) { return __builtin_bit_cast(float, (unsigned)h << 16); }
__device__ __forceinline__ float shx(float v, int lane, int m) { return __builtin_bit_cast(float, __builtin_amdgcn_ds_bpermute((lane ^ m) << 2, __builtin_bit_cast(int, v))); }
__device__ __forceinline__ float wave_sum(float v, int lane) {
#pragma unroll
    for (int o = 1; o < 64; o <<= 1) v += shx(v, lane, o);
    return v;
}
__device__ __forceinline__ float wave_max(float v, int lane) {
#pragma unroll
    for (int o = 1; o < 64; o <<= 1) v = fmaxf(v, shx(v, lane, o));
    return v;
}
__device__ __forceinline__ void cvt_row(const float* src, bf16* dst, int n, int lane) {
    for (int j = lane * 4; j < n; j += 256) {
        f32x4 v = src ? *(const f32x4*)(src + j) : (f32x4){0.f, 0.f, 0.f, 0.f};
        unsigned long long w = (unsigned long long)pk2(v.x, v.y) | ((unsigned long long)pk2(v.z, v.w) << 32);
        *(unsigned long long*)(dst + j) = w;
    }
}
struct MapId { __device__ __forceinline__ int operator()(int n) const { return n; } };
struct MapInA { __device__ __forceinline__ int operator()(int n) const { return n < 4608 ? n : (n < 5120 ? n + 16 : (n < 5136 ? n - 512 : -1)); } };
struct MapFfn { __device__ __forceinline__ int operator()(int n) const { const int t = n >> 8, r = n & 255; return r < 128 ? 128 * t + r : DFF + 128 * t + (r - 128); } };
template <class Map>
__device__ __forceinline__ void wt_convert(LAS unsigned char* ldsb, int wave, int gw, int NGW, int lane, const float* W, int K, int Nsrc, bf16* WT, int Ndst, Map map) {
    LAS float* scr = (LAS float*)(ldsb + RING_OFF + wave * 16384);
    const int nblk = Ndst / 32, nitems = (K / 64) * nblk;
    for (int it = gw; it < nitems; it += NGW) {
        const int kb = it / nblk, nb = it % nblk, k0 = 64 * kb, n0 = 32 * nb;
        const int sc = map(n0 + (lane & 31));
#pragma unroll 8
        for (int i = 0; i < 32; ++i) { const int kk = 2 * i + (lane >> 5); scr[kk * 33 + (lane & 31)] = sc >= 0 ? W[(size_t)(k0 + kk) * Nsrc + sc] : 0.f; }
        LDS_WAIT(); asm volatile("" ::: "memory");
        const int c = lane & 7;
#pragma unroll
        for (int j = 0; j < 4; ++j) { const int n = (lane >> 3) + 8 * j; const LAS float* s = scr + (8 * c) * 33 + n;
            v4u o; o.x = pk2(s[0 * 33], s[1 * 33]); o.y = pk2(s[2 * 33], s[3 * 33]); o.z = pk2(s[4 * 33], s[5 * 33]); o.w = pk2(s[6 * 33], s[7 * 33]);
            *(GAS v4u*)(WT + (size_t)(n0 + n) * K + k0 + 8 * c) = o; }
        LDS_WAIT(); asm volatile("" ::: "memory");
    }
}
__device__ __forceinline__ float softplus_f(float z) { return fmaxf(z, 0.f) + log1pf(__expf(-fabsf(z))); }

typedef short s16x4 __attribute__((ext_vector_type(4)));
typedef pg8::u32x2 u32x2;
typedef float f32x16 __attribute__((ext_vector_type(16)));
typedef __bf16 bf16x2_t __attribute__((ext_vector_type(2)));
typedef float f32x2_t __attribute__((ext_vector_type(2)));
__device__ __forceinline__ unsigned cvt2(float lo, float hi) { const f32x2_t v = {lo, hi}; const bf16x2_t b = __builtin_convertvector(v, bf16x2_t); return __builtin_bit_cast(unsigned, b); }
__device__ __forceinline__ bf16x8 pack8(const f32x4 a, const f32x4 b) { v4u p; p.x = cvt2(a[0], a[1]); p.y = cvt2(a[2], a[3]); p.z = cvt2(b[0], b[1]); p.w = cvt2(b[2], b[3]); return __builtin_bit_cast(bf16x8, p); }
__device__ __forceinline__ bf16x8 ld2x8(const bf16* p0, const bf16* p1) { const s16x4 a = *(const s16x4*)p0, b = *(const s16x4*)p1; return __builtin_shufflevector(a, b, 0, 1, 2, 3, 4, 5, 6, 7); }
__device__ __forceinline__ bf16x8 ld16(const bf16* p) { return *(const bf16x8*)p; }
#define MFMA16(a, b, c) __builtin_amdgcn_mfma_f32_16x16x32_bf16((a), (b), (c), 0, 0, 0)
#define MFMA32(a, b, c) __builtin_amdgcn_mfma_f32_32x32x16_bf16((a), (b), (c), 0, 0, 0)

constexpr int QIMG_LD = 200, KTIMG_LD = 68, PKG_Q = 0, PKG_KT = 25600, PKG_G = 51712, IMG_BYTES = 52480, PKG_K = 52480, PKG_VT = 77056, PKG_BYTES = 126208, N_PKG = 2048 + 32;
static_assert(64 * QIMG_LD * 2 == PKG_KT && PKG_KT + 192 * KTIMG_LD * 2 == PKG_G && PKG_G + 768 == IMG_BYTES && PKG_K + 24576 == PKG_VT && PKG_VT + 49152 == PKG_BYTES && IMG_BYTES % 16 == 0, "package map");

__device__ __forceinline__ float softplus_fast(float z) { return fmaxf(z, 0.f) + __logf(1.0f + __expf(-fabsf(z))); }
__device__ __forceinline__ void gla_prep(int bid, int G, int tid, int wave, LAS unsigned char* lds, int l, const bf16* PROJ, const float* w_gate_lr, const float* b_gate, unsigned char* PKG) {
    const int lane = tid & 63;
    const float* w2 = w_gate_lr + (size_t)l * 16 * 768; const float* bg = b_gate + (size_t)l * 768;
    LAS float* tot = (LAS float*)lds;
    for (int item = bid; item < N_PKG; item += G) {
        int h, row0, T;
        if (item < 2048) { const int bh = item >> 7, ch = item & 127; h = bh & 3; row0 = (bh >> 2) * SEQ + ch * 64; T = 64; }
        else { const int i2 = item - 2048; h = i2 & 3; row0 = MP + (i2 >> 2) * 16; T = 16; }
        unsigned char* pk = PKG + (size_t)item * PKG_BYTES;
        bf16* Qt = (bf16*)(pk + PKG_Q); bf16* Kt = (bf16*)(pk + PKG_K); bf16* KT = (bf16*)(pk + PKG_KT); bf16* VT = (bf16*)(pk + PKG_VT); float* Gp = (float*)(pk + PKG_G);
        float w2c[3][16], bgc[3];
#pragma unroll
        for (int c = 0; c < 3; ++c) { const int d = h * 192 + lane + 64 * c; bgc[c] = bg[d];
#pragma unroll
            for (int r = 0; r < 16; ++r) w2c[c][r] = w2[r * 768 + d]; }
        v4u l0[8], l1[8];
#pragma unroll
        for (int tt = 0; tt < 8; ++tt) { const int t = 8 * wave + tt; const bf16* prow = PROJ + (size_t)(row0 + (t < T ? t : T - 1)) * NA;
            l0[tt] = *(const v4u*)(prow + CLR); l1[tt] = *(const v4u*)(prow + CLR + 8); }
        float lc[8][3]; float run[3] = {0.f, 0.f, 0.f};
#pragma unroll
        for (int tt = 0; tt < 8; ++tt) { const bool ok = 8 * wave + tt < T;
            float lr[16]; lr[0] = pg8::bflo(l0[tt].x); lr[1] = pg8::bfhi(l0[tt].x); lr[2] = pg8::bflo(l0[tt].y); lr[3] = pg8::bfhi(l0[tt].y); lr[4] = pg8::bflo(l0[tt].z); lr[5] = pg8::bfhi(l0[tt].z); lr[6] = pg8::bflo(l0[tt].w); lr[7] = pg8::bfhi(l0[tt].w);
            lr[8] = pg8::bflo(l1[tt].x); lr[9] = pg8::bfhi(l1[tt].x); lr[10] = pg8::bflo(l1[tt].y); lr[11] = pg8::bfhi(l1[tt].y); lr[12] = pg8::bflo(l1[tt].z); lr[13] = pg8::bfhi(l1[tt].z); lr[14] = pg8::bflo(l1[tt].w); lr[15] = pg8::bfhi(l1[tt].w);
#pragma unroll
            for (int c = 0; c < 3; ++c) { float xg = bgc[c];
#pragma unroll
                for (int r = 0; r < 16; ++r) xg += lr[r] * w2c[c][r];
                run[c] += ok ? -softplus_fast(-xg) * (1.0f / 16.0f) : 0.f; lc[tt][c] = run[c]; } }
#pragma unroll
        for (int c = 0; c < 3; ++c) tot[wave * 192 + lane + 64 * c] = run[c];
        unsigned qv[8][3], kv[8][3];
#pragma unroll
        for (int tt = 0; tt < 8; ++tt) { const int t = 8 * wave + tt; const bf16* prow = PROJ + (size_t)(row0 + (t < T ? t : T - 1)) * NA + h * 192 + lane;
#pragma unroll
            for (int c = 0; c < 3; ++c) { qv[tt][c] = prow[CQ + 64 * c]; kv[tt][c] = prow[CK + 64 * c]; } }
        __syncthreads();
        float pre[3], all[3];
#pragma unroll
        for (int c = 0; c < 3; ++c) { pre[c] = 0.f; all[c] = 0.f;
#pragma unroll
            for (int w = 0; w < 8; ++w) { const float tv = tot[w * 192 + lane + 64 * c]; all[c] += tv; if (w < wave) pre[c] += tv; } }
        unsigned ktw[3][4];
#pragma unroll
        for (int tt = 0; tt < 8; ++tt) { const int t = 8 * wave + tt; const bool ok = t < T;
#pragma unroll
            for (int c = 0; c < 3; ++c) { const int dl = lane + 64 * c; const float bc = pre[c] + lc[tt][c]; const float eq = __expf(bc), ek = __expf(-bc);
                const unsigned qb = ok ? f2bf(bf2f((bf16)qv[tt][c]) * GLA_QSCALE * eq) : 0u, kb = ok ? f2bf(bf2f((bf16)kv[tt][c]) * ek) : 0u;
                Qt[t * QIMG_LD + dl] = (bf16)qb; Kt[t * 192 + dl] = (bf16)kb;
                if (tt & 1) ktw[c][tt >> 1] |= kb << 16; else ktw[c][tt >> 1] = kb; } }
#pragma unroll
        for (int c = 0; c < 3; ++c) { bf16* kp = KT + (size_t)(lane + 64 * c) * KTIMG_LD + 8 * wave; u32x2 o0, o1; o0.x = ktw[c][0]; o0.y = ktw[c][1]; o1.x = ktw[c][2]; o1.y = ktw[c][3]; *(u32x2*)kp = o0; *(u32x2*)(kp + 4) = o1; }
        if (wave == 0) {
#pragma unroll
            for (int c = 0; c < 3; ++c) Gp[lane + 64 * c] = __expf(all[c]); }
        unsigned vv[6][8];
#pragma unroll
        for (int tt = 0; tt < 8; ++tt) { const int t = 8 * wave + tt; const bf16* prow = PROJ + (size_t)(row0 + (t < T ? t : T - 1)) * NA + CV + h * 384 + lane;
#pragma unroll
            for (int c2 = 0; c2 < 6; ++c2) vv[c2][tt] = t < T ? (unsigned)prow[64 * c2] : 0u; }
#pragma unroll
        for (int c2 = 0; c2 < 6; ++c2) { v4u o; o.x = vv[c2][0] | (vv[c2][1] << 16); o.y = vv[c2][2] | (vv[c2][3] << 16); o.z = vv[c2][4] | (vv[c2][5] << 16); o.w = vv[c2][6] | (vv[c2][7] << 16);
            *(v4u*)(VT + (size_t)(lane + 64 * c2) * 64 + 8 * wave) = o; }
        __syncthreads();
    }
}

__device__ __forceinline__ void gla_intra(int item, int tid, int wave, LAS unsigned char* lds, const unsigned char* PKG, float* OINT) {
    const int lane = tid & 63, fr = lane & 15, fq = lane >> 4;
    int h, row0, nvalid;
    if (item < 2048) { const int bh = item >> 7, ch = item & 127; h = bh & 3; row0 = (bh >> 2) * SEQ + ch * 64; nvalid = 64; }
    else { const int i2 = item - 2048; h = i2 & 3; row0 = MP + (i2 >> 2) * 16; nvalid = 16; }
    const unsigned char* pk = PKG + (size_t)item * PKG_BYTES;
    const bf16* Qt = (const bf16*)(pk + PKG_Q); const bf16* Kt = (const bf16*)(pk + PKG_K); const bf16* VT = (const bf16*)(pk + PKG_VT);
    bf16x8 va[3], vb[3];
#pragma unroll
    for (int k = 0; k < 3; ++k) { const bf16* vr = VT + (size_t)(16 * (3 * wave + k) + fr) * 64 + 4 * fq; va[k] = ld2x8(vr, vr + 16); vb[k] = ld2x8(vr + 32, vr + 48); }
    constexpr int P_LD = 68;
    LAS bf16* P = (LAS bf16*)lds;
#pragma unroll
    for (int rep = 0; rep < 2; ++rep) {
        const int tl = wave + 8 * rep;
        if (tl < 10) {
            const int it = tl < 1 ? 0 : (tl < 3 ? 1 : (tl < 6 ? 2 : 3)), jt = tl - (it * (it + 1)) / 2;
            f32x4 at = {0.f, 0.f, 0.f, 0.f};
            const bf16* qr = Qt + (size_t)(16 * it + fr) * QIMG_LD + 8 * fq; const bf16* kr = Kt + (size_t)(16 * jt + fr) * 192 + 8 * fq;
#pragma unroll
            for (int s = 0; s < 6; ++s) at = MFMA16(ld16(kr + 32 * s), ld16(qr + 32 * s), at);
            if (it == jt) {
#pragma unroll
                for (int jj = 0; jj < 4; ++jj) if (4 * fq + jj > fr) at[jj] = 0.f; }
            u32x2 w; w.x = cvt2(at[0], at[1]); w.y = cvt2(at[2], at[3]);
            *(LAS u32x2*)(P + (16 * it + fr) * P_LD + 16 * jt + 4 * fq) = w;
        } else if (tl == 10 || tl == 11) {
            const int it = tl == 10 ? 0 : 2, jt = tl == 10 ? 1 : 3; u32x2 z; z.x = 0u; z.y = 0u;
            *(LAS u32x2*)(P + (16 * it + fr) * P_LD + 16 * jt + 4 * fq) = z;
        }
    }
    __syncthreads();
#pragma unroll
    for (int it = 0; it < 4; ++it) {
        if (16 * it >= nvalid) break;
        const LAS bf16* pr = P + (16 * it + fr) * P_LD + 4 * fq;
        const s16x4 a0 = *(const LAS s16x4*)pr, a1 = *(const LAS s16x4*)(pr + 16);
        const bf16x8 pf0 = __builtin_shufflevector(a0, a1, 0, 1, 2, 3, 4, 5, 6, 7); bf16x8 pf1 = pf0;
        if (it >= 2) { const s16x4 b0 = *(const LAS s16x4*)(pr + 32), b1 = *(const LAS s16x4*)(pr + 48); pf1 = __builtin_shufflevector(b0, b1, 0, 1, 2, 3, 4, 5, 6, 7); }
#pragma unroll
        for (int k = 0; k < 3; ++k) { f32x4 o = {0.f, 0.f, 0.f, 0.f};
            o = MFMA16(va[k], pf0, o); if (it >= 2) o = MFMA16(vb[k], pf1, o);
            *(f32x4*)(OINT + (size_t)(row0 + 16 * it + fr) * 1536 + h * 384 + 16 * (3 * wave + k) + 4 * fq) = o; }
    }
    __syncthreads();
}

template <int PASS>
__device__ __forceinline__ void gla_chain(int wc, int tid, int wave, LAS unsigned char* lds, int l, const unsigned char* PKG, const float* state_gla, float* OINT, float* out, float* SLOC, float* GSEG, bool dry = false) {
    const int lane = tid & 63, fr = lane & 15, fq = lane >> 4;
    int h, vb, bh, seg, item0, nsteps, row0, nvalid; const float* s0 = nullptr; float* sout = nullptr;
    if (PASS == 1) { bh = wc / 9; const int rem = wc % 9; vb = rem / 3; seg = rem % 3; h = bh & 3; item0 = bh * 128 + 32 * seg; nsteps = 32; row0 = 0; nvalid = 64; }
    else if (wc < 192) { bh = wc / 12; const int rem = wc % 12; vb = rem >> 2; seg = rem & 3; h = bh & 3; item0 = bh * 128 + 32 * seg; nsteps = 32; row0 = (bh >> 2) * SEQ + 2048 * seg; nvalid = 64;
        if (seg == 3) sout = out + O_GSP + (size_t)(l * 16 + bh) * 192 * 384; }
    else { const int c2 = wc - 192; bh = c2 / 3; vb = c2 % 3; seg = 0; h = bh & 3; item0 = 2048 + bh; nsteps = 1; row0 = MP + (bh >> 2) * 16; nvalid = 16; s0 = state_gla + (size_t)(l * 32 + bh) * 192 * 384; sout = out + O_GSS + (size_t)(l * 32 + bh) * 192 * 384; }
    const int v0 = vb * 128 + wave * 16;
#define GLA_WALK(p, step) do { (p) += (step); asm volatile("" : "+v"(p)); } while (0)
    f32x4 S[12];
    if (s0) { const float* p = s0 + (size_t)(4 * fq) * 384 + v0 + fr;
#pragma unroll
        for (int t = 0; t < 12; ++t) {
#pragma unroll
            for (int jj = 0; jj < 4; ++jj) { S[t][jj] = *p; GLA_WALK(p, 384); }
            GLA_WALK(p, 12 * 384); } }
    else {
#pragma unroll
        for (int t = 0; t < 12; ++t) S[t] = (f32x4){0.f, 0.f, 0.f, 0.f}; }
    if (PASS == 2 && wc < 192) {
        for (int j = 0; j < seg; ++j) { const float* gs = GSEG + (size_t)(bh * 3 + j) * 192 + 4 * fq; const float* p = SLOC + (size_t)((bh * 3 + vb) * 3 + j) * 192 * 128 + (size_t)(4 * fq) * 128 + wave * 16 + fr;
#pragma unroll
            for (int t = 0; t < 12; ++t) { const f32x4 g4 = *(const f32x4*)(gs + 16 * t);
#pragma unroll
                for (int jj = 0; jj < 4; ++jj) { S[t][jj] = g4[jj] * S[t][jj] + *p; GLA_WALK(p, 128); }
                GLA_WALK(p, 12 * 128); } }
    }
    f32x4 GP[PASS == 1 ? 12 : 1];
    if (PASS == 1) {
#pragma unroll
        for (int t = 0; t < 12; ++t) GP[t] = (f32x4){1.f, 1.f, 1.f, 1.f}; }
    constexpr int CH0 = PASS == 1 ? PKG_KT / 16 : 0, NCH = IMG_BYTES / 16, NLD = PASS == 1 ? 4 : 7;
    v4u pre[NLD]; bf16x8 vt[2], vtn[2]; f32x4 oin[4];
    { const unsigned char* pk = PKG + (size_t)item0 * PKG_BYTES;
      if (PASS == 2) {
#pragma unroll
        for (int it = 0; it < 4; ++it) { const int tl = 16 * it + fr; oin[it] = tl < nvalid ? *(const f32x4*)(OINT + (size_t)(row0 + tl) * 1536 + h * 384 + v0 + 4 * fq) : (f32x4){0.f, 0.f, 0.f, 0.f}; } }
#pragma unroll
      for (int k = 0; k < NLD; ++k) { const int ch = CH0 + tid + 512 * k; if (ch < NCH) pre[k] = *(const v4u*)(pk + (size_t)ch * 16); }
      const bf16* VT = (const bf16*)(pk + PKG_VT) + (size_t)(v0 + fr) * 64 + 4 * fq; vt[0] = ld2x8(VT, VT + 16); vt[1] = ld2x8(VT + 32, VT + 48);
#pragma unroll
      for (int k = 0; k < NLD; ++k) { const int ch = CH0 + tid + 512 * k; if (ch < NCH) *(LAS v4u*)(lds + (size_t)ch * 16) = pre[k]; }
      vtn[0] = vt[0]; vtn[1] = vt[1]; }
    __syncthreads();
    for (int n = 0; n < nsteps; ++n) {
        const LAS unsigned char* img = lds + (n & 1) * IMG_BYTES;
        const bool more = n + 1 < nsteps;
        if (more) { const unsigned char* pk = PKG + (size_t)(item0 + n + 1) * PKG_BYTES;
#pragma unroll
            for (int k = 0; k < NLD; ++k) { const int ch = CH0 + tid + 512 * k; if (ch < NCH) pre[k] = *(const v4u*)(pk + (size_t)ch * 16); }
            const bf16* VT = (const bf16*)(pk + PKG_VT) + (size_t)(v0 + fr) * 64 + 4 * fq; vtn[0] = ld2x8(VT, VT + 16); vtn[1] = ld2x8(VT + 32, VT + 48); }
        if (PASS == 2) {
            bf16x8 Sb[6];
#pragma unroll
            for (int s = 0; s < 6; ++s) Sb[s] = pack8(S[2 * s], S[2 * s + 1]);
#pragma unroll
            for (int it = 0; it < 4; ++it) {
                const LAS bf16* qr = (const LAS bf16*)(img + PKG_Q) + (16 * it + fr) * QIMG_LD + 4 * fq;
                f32x4 o = oin[it];
#pragma unroll
                for (int s = 0; s < 6; ++s) { const s16x4 a = *(const LAS s16x4*)(qr + 32 * s), b = *(const LAS s16x4*)(qr + 32 * s + 16);
                    o = MFMA16(Sb[s], __builtin_shufflevector(a, b, 0, 1, 2, 3, 4, 5, 6, 7), o); }
                const int tl = 16 * it + fr;
                if (tl < nvalid && !dry) *(f32x4*)(OINT + (size_t)(row0 + 64 * n + tl) * 1536 + h * 384 + v0 + 4 * fq) = o;
                __builtin_amdgcn_sched_barrier(0);
            }
            if (more) {
#pragma unroll
                for (int it = 0; it < 4; ++it) oin[it] = *(const f32x4*)(OINT + (size_t)(row0 + 64 * (n + 1) + 16 * it + fr) * 1536 + h * 384 + v0 + 4 * fq); }
        }
#pragma unroll
        for (int t = 0; t < 12; ++t) { const LAS bf16* kr = (const LAS bf16*)(img + PKG_KT) + (16 * t + fr) * KTIMG_LD + 4 * fq;
#pragma unroll
            for (int s2 = 0; s2 < 2; ++s2) { const s16x4 a = *(const LAS s16x4*)(kr + 32 * s2), b = *(const LAS s16x4*)(kr + 32 * s2 + 16);
                S[t] = MFMA16(__builtin_shufflevector(a, b, 0, 1, 2, 3, 4, 5, 6, 7), vt[s2], S[t]); }
            const f32x4 g4 = *(const LAS f32x4*)(img + PKG_G + (16 * t + 4 * fq) * 4);
            S[t] = S[t] * g4; if (PASS == 1) GP[t] = GP[t] * g4; if (t & 1) __builtin_amdgcn_sched_barrier(0); }
        if (more) { LAS unsigned char* nimg = lds + ((n + 1) & 1) * IMG_BYTES;
#pragma unroll
            for (int k = 0; k < NLD; ++k) { const int ch = CH0 + tid + 512 * k; if (ch < NCH) *(LAS v4u*)(nimg + (size_t)ch * 16) = pre[k]; }
            vt[0] = vtn[0]; vt[1] = vtn[1]; }
        asm volatile("s_waitcnt lgkmcnt(0)" ::: "memory"); __builtin_amdgcn_s_barrier(); asm volatile("" ::: "memory");
    }
    if (PASS == 1) {
        float* p = SLOC + (size_t)((bh * 3 + vb) * 3 + seg) * 192 * 128 + (size_t)(4 * fq) * 128 + wave * 16 + fr;
#pragma unroll
        for (int t = 0; t < 12; ++t) {
#pragma unroll
            for (int jj = 0; jj < 4; ++jj) { *p = S[t][jj]; GLA_WALK(p, 128); }
            GLA_WALK(p, 12 * 128); }
        if (vb == 0 && wave == 0 && fr == 0) { float* gs = GSEG + (size_t)(bh * 3 + seg) * 192;
#pragma unroll
            for (int t = 0; t < 12; ++t) *(f32x4*)(gs + 16 * t + 4 * fq) = GP[t]; }
    } else if (sout) {
        float* p = sout + (size_t)(4 * fq) * 384 + v0 + fr;
#pragma unroll
        for (int t = 0; t < 12; ++t) {
#pragma unroll
            for (int jj = 0; jj < 4; ++jj) { *p = S[t][jj]; GLA_WALK(p, 384); }
            GLA_WALK(p, 12 * 384); }
    }
#undef GLA_WALK
}

__device__ __forceinline__ void mem_attn(int item, int lane, int l, const bf16* PROJ, int ldp, int cqm, const bf16* MEMK, const bf16* MEMVT, bf16* OCAT) {
    const int fr = lane & 15, fq = lane >> 4, tile = item >> 2, h = item & 3, r0 = tile * 16;
    const int bb = r0 < MP ? r0 / SEQ : 4 + ((r0 - MP) >> 4);
    const bf16* Kb = MEMK + (size_t)((l * 12 + bb) * 256) * 512 + h * 128; const bf16* Vt = MEMVT + (size_t)(((l * 12 + bb) * 4 + h) * 128) * 256;
    bf16x8 qf[4];
#pragma unroll
    for (int s = 0; s < 4; ++s) qf[s] = ld16(PROJ + (size_t)(r0 + fr) * ldp + cqm + h * 128 + 32 * s + 8 * fq);
    f32x4 st[16];
#pragma unroll
    for (int mt = 0; mt < 16; ++mt) { st[mt] = (f32x4){0.f, 0.f, 0.f, 0.f}; const bf16* kr = Kb + (size_t)(16 * mt + fr) * 512 + 8 * fq;
#pragma unroll
        for (int s = 0; s < 4; ++s) st[mt] = MFMA16(ld16(kr + 32 * s), qf[s], st[mt]); }
    float mx = -3.0e38f;
#pragma unroll
    for (int mt = 0; mt < 16; ++mt) mx = fmaxf(mx, fmaxf(fmaxf(st[mt][0], st[mt][1]), fmaxf(st[mt][2], st[mt][3])));
    mx = fmaxf(mx, shx(mx, lane, 16)); mx = fmaxf(mx, shx(mx, lane, 32));
    float sum = 0.f;
#pragma unroll
    for (int mt = 0; mt < 16; ++mt)
#pragma unroll
        for (int jj = 0; jj < 4; ++jj) { const float p = __expf((st[mt][jj] - mx) * HD_SCALE); st[mt][jj] = p; sum += p; }
    sum += shx(sum, lane, 16); sum += shx(sum, lane, 32);
    const float inv = 1.0f / sum;
    bf16x8 pf[8];
#pragma unroll
    for (int s = 0; s < 8; ++s) pf[s] = pack8(st[2 * s], st[2 * s + 1]);
#pragma unroll
    for (int dt = 0; dt < 8; ++dt) { f32x4 o = {0.f, 0.f, 0.f, 0.f}; const bf16* vr = Vt + (size_t)(16 * dt + fr) * 256 + 4 * fq;
#pragma unroll
        for (int s = 0; s < 8; ++s) o = MFMA16(ld2x8(vr + 32 * s, vr + 32 * s + 16), pf[s], o);
        u32x2 w; w.x = cvt2(o[0] * inv, o[1] * inv); w.y = cvt2(o[2] * inv, o[3] * inv);
        *(u32x2*)(OCAT + (size_t)(r0 + fr) * D + 1536 + h * 128 + 16 * dt + 4 * fq) = w; }
}

__device__ __forceinline__ void mem_attn_wg(int wi, int tid, int wave, LAS unsigned char* lds, int l, const bf16* PROJ, int ldp, int cqm, const bf16* MEMK, const bf16* MEMVT, bf16* OCAT) {
    const bool smp = wi >= 256; const int lane = tid & 63, fr = lane & 15, fq = lane >> 4, bh = smp ? (wi - 256) : (wi >> 4), sub = wi & 15, b = smp ? 4 + (bh >> 2) : (bh >> 2), h = bh & 3;
    const bf16* Kb = MEMK + (size_t)((l * 12 + b) * 256) * 512 + h * 128; const bf16* Vt = MEMVT + (size_t)(((l * 12 + b) * 4 + h) * 128) * 256;
#pragma unroll
    for (int k = 0; k < 8; ++k) { const int idx = tid + 512 * k, row = idx >> 4, c = idx & 15; *(LAS v4u*)(lds + row * 256 + ((c ^ (row & 15)) << 4)) = *(const v4u*)(Kb + (size_t)row * 512 + c * 8); }
#pragma unroll
    for (int k = 0; k < 8; ++k) { const int idx = tid + 512 * k, row = idx >> 5, c = idx & 31; *(LAS v4u*)(lds + 65536 + row * 512 + ((c ^ (2 * (row & 15))) << 4)) = *(const v4u*)(Vt + (size_t)row * 256 + c * 8); }
    __syncthreads();
    unsigned koff[4], voff[16];
#pragma unroll
    for (int s2 = 0; s2 < 4; ++s2) { koff[s2] = (unsigned)(fr * 256 + (((4 * s2 + fq) ^ fr) << 4)); asm volatile("" : "+v"(koff[s2])); }
#pragma unroll
    for (int s2 = 0; s2 < 8; ++s2) { const int p0 = 8 * s2 + fq, p1 = p0 + 4;
        voff[2 * s2] = (unsigned)(65536 + fr * 512 + ((((p0 >> 1) ^ (2 * fr)) << 4) | ((p0 & 1) << 3))); voff[2 * s2 + 1] = (unsigned)(65536 + fr * 512 + ((((p1 >> 1) ^ (2 * fr)) << 4) | ((p1 & 1) << 3)));
        asm volatile("" : "+v"(voff[2 * s2]), "+v"(voff[2 * s2 + 1])); }
    const int nblk = smp ? (wave == 0 ? 1 : 0) : 4;
#pragma unroll 1
    for (int blk = 0; blk < nblk; ++blk) {
        const int r0 = smp ? MP + (b - 4) * 16 : b * SEQ + sub * 512 + blk * 128 + wave * 16;
        bf16x8 qf[4];
#pragma unroll
        for (int s = 0; s < 4; ++s) qf[s] = ld16(PROJ + (size_t)(r0 + fr) * ldp + cqm + h * 128 + 32 * s + 8 * fq);
        f32x4 st[16];
#pragma unroll
        for (int mt = 0; mt < 16; ++mt) { st[mt] = (f32x4){0.f, 0.f, 0.f, 0.f};
#pragma unroll
            for (int s = 0; s < 4; ++s) st[mt] = MFMA16(*(const LAS bf16x8*)(lds + koff[s] + mt * 4096), qf[s], st[mt]);
            if ((mt & 3) == 3) __builtin_amdgcn_sched_barrier(0); }
        float mx = -3.0e38f;
#pragma unroll
        for (int mt = 0; mt < 16; ++mt) mx = fmaxf(mx, fmaxf(fmaxf(st[mt][0], st[mt][1]), fmaxf(st[mt][2], st[mt][3])));
        mx = fmaxf(mx, shx(mx, lane, 16)); mx = fmaxf(mx, shx(mx, lane, 32));
        float sum = 0.f;
#pragma unroll
        for (int mt = 0; mt < 16; ++mt)
#pragma unroll
            for (int jj = 0; jj < 4; ++jj) { const float p = __expf((st[mt][jj] - mx) * HD_SCALE); st[mt][jj] = p; sum += p; }
        sum += shx(sum, lane, 16); sum += shx(sum, lane, 32);
        const float inv = 1.0f / sum;
        bf16x8 pf[8];
#pragma unroll
        for (int s = 0; s < 8; ++s) pf[s] = pack8(st[2 * s], st[2 * s + 1]);
#pragma unroll
        for (int dt = 0; dt < 8; ++dt) { f32x4 o = {0.f, 0.f, 0.f, 0.f};
#pragma unroll
            for (int s = 0; s < 8; ++s) { const s16x4 a = *(const LAS s16x4*)(lds + voff[2 * s] + dt * 8192), bb = *(const LAS s16x4*)(lds + voff[2 * s + 1] + dt * 8192);
                o = MFMA16(__builtin_shufflevector(a, bb, 0, 1, 2, 3, 4, 5, 6, 7), pf[s], o); }
            u32x2 w; w.x = cvt2(o[0] * inv, o[1] * inv); w.y = cvt2(o[2] * inv, o[3] * inv);
            *(u32x2*)(OCAT + (size_t)(r0 + fr) * D + 1536 + h * 128 + 16 * dt + 4 * fq) = w;
            if (dt & 1) __builtin_amdgcn_sched_barrier(0); }
    }
    __syncthreads();
}

__device__ __forceinline__ void sb_attn(int lane, LAS unsigned char* wlds, const bf16* Kp, int ldk, const bf16* VTp, int ldvt, const bf16* Qp, int ldq, bf16* Op, int t0, int nq) {
    const int r = lane & 31, hh = lane >> 5;
    LAS bf16x8* qs = (LAS bf16x8*)wlds + lane;
#pragma unroll
    for (int ks = 0; ks < 8; ++ks) qs[64 * ks] = ld16(Qp + (size_t)r * ldq + 16 * ks + 8 * hh);
    f32x16 oacc[4];
#pragma unroll
    for (int dt = 0; dt < 4; ++dt)
#pragma unroll
        for (int i = 0; i < 16; ++i) oacc[dt][i] = 0.f;
    float carry = 0.f;
    bf16x8 kf[8];
    { const bf16* kr = Kp + (size_t)(t0 + r) * ldk + 8 * hh;
#pragma unroll
      for (int ks = 0; ks < 8; ++ks) kf[ks] = ld16(kr + 16 * ks); }
    for (int s0 = t0; s0 >= 0; s0 -= 32) {
        bf16x8 vf[8];
#pragma unroll
        for (int k2 = 0; k2 < 2; ++k2)
#pragma unroll
            for (int dt = 0; dt < 4; ++dt) { const bf16* vr = VTp + (size_t)(32 * dt + r) * ldvt + s0 + 16 * k2 + 4 * hh; vf[4 * k2 + dt] = ld2x8(vr, vr + 8); }
        f32x16 st;
#pragma unroll
        for (int i = 0; i < 16; ++i) st[i] = 0.f;
#pragma unroll
        for (int ks = 0; ks < 8; ++ks) st = MFMA32(kf[ks], qs[64 * ks], st);
        { const int sn = s0 >= 32 ? s0 - 32 : 0; const bf16* kr = Kp + (size_t)(sn + r) * ldk + 8 * hh;
#pragma unroll
          for (int ks = 0; ks < 8; ++ks) kf[ks] = ld16(kr + 16 * ks); }
        const bool diag = (s0 == t0);
        float l1[16], lb[16];
#pragma unroll
        for (int i = 0; i < 16; ++i) { const float z = st[i] * HD_SCALE, sp = softplus_fast(z); lb[i] = z - sp; l1[i] = -sp;
            if (diag && !(((i & 3) + 8 * (i >> 2) + 4 * hh) < r)) { l1[i] = 0.f; lb[i] = -1.0e30f; } }
        float g[4], pgv[4];
#pragma unroll
        for (int m = 0; m < 4; ++m) { g[m] = (l1[4 * m] + l1[4 * m + 1]) + (l1[4 * m + 2] + l1[4 * m + 3]); pgv[m] = shx(g[m], lane, 32); }
        float R[4]; R[3] = 0.f; R[2] = g[3] + pgv[3]; R[1] = R[2] + g[2] + pgv[2]; R[0] = R[1] + g[1] + pgv[1];
        const float total = R[0] + g[0] + pgv[0];
#pragma unroll
        for (int m = 0; m < 4; ++m) { const float suf = carry + R[m] + (hh == 0 ? pgv[m] : 0.f);
            const float t3 = suf, t2 = t3 + l1[4 * m + 3], t1 = t2 + l1[4 * m + 2], t0_ = t1 + l1[4 * m + 1];
            lb[4 * m + 3] = __expf(lb[4 * m + 3] + t3); lb[4 * m + 2] = __expf(lb[4 * m + 2] + t2); lb[4 * m + 1] = __expf(lb[4 * m + 1] + t1); lb[4 * m] = __expf(lb[4 * m] + t0_); }
        carry += total;
#pragma unroll
        for (int k2 = 0; k2 < 2; ++k2) {
            v4u p; p.x = cvt2(lb[8 * k2], lb[8 * k2 + 1]); p.y = cvt2(lb[8 * k2 + 2], lb[8 * k2 + 3]); p.z = cvt2(lb[8 * k2 + 4], lb[8 * k2 + 5]); p.w = cvt2(lb[8 * k2 + 6], lb[8 * k2 + 7]);
            const bf16x8 wf = __builtin_bit_cast(bf16x8, p);
#pragma unroll
            for (int dt = 0; dt < 4; ++dt) oacc[dt] = MFMA32(vf[4 * k2 + dt], wf, oacc[dt]);
        }
        if (__all((r >= nq) || (carry < -104.f))) break;
    }
    if (r < nq) {
#pragma unroll
        for (int dt = 0; dt < 4; ++dt)
#pragma unroll
            for (int g4 = 0; g4 < 4; ++g4) { u32x2 wv; wv.x = cvt2(oacc[dt][4 * g4], oacc[dt][4 * g4 + 1]); wv.y = cvt2(oacc[dt][4 * g4 + 2], oacc[dt][4 * g4 + 3]);
                *(u32x2*)(Op + (size_t)r * D + 32 * dt + 8 * g4 + 4 * hh) = wv; }
    }
    asm volatile("s_waitcnt lgkmcnt(0)" ::: "memory");
}
#ifndef PH_MASK
#define PH_MASK 0xFFFF
#endif
__global__ void __launch_bounds__(NWAVES * 64, 2) mega(Args args) {
    extern __shared__ __attribute__((aligned(16))) unsigned char lds[];
    Frame F;
    F.lds = (LAS unsigned char*)lds; F.MISC = (volatile LAS unsigned*)(F.lds + MISC_OFF);
    F.tid = threadIdx.x; F.lane = F.tid & 63; F.wave = __builtin_amdgcn_readfirstlane(F.tid >> 6);
    F.G = gridDim.x; F.gw = blockIdx.x * NWAVES + F.wave; F.NGW = F.G * NWAVES;
    F.ctl = (gu32*)(args.ws_ + WS_CTL);
    for (int u = F.tid; u < (LDS_BYTES - LDSCTL_OFF) / 4; u += NWAVES * 64) ((LAS unsigned*)(F.lds + LDSCTL_OFF))[u] = 0u;
    __syncthreads();
    XcdBarrier bar = xcd_barrier_post((unsigned*)(F.ctl + CW_BAR), F.MISC + 8);
    const int lo = args.ph_lo, hi = args.ph_hi; int ph = 0;
#define KARGS ((const __attribute__((address_space(4))) Args*)__builtin_amdgcn_kernarg_segment_ptr())
#define ws (ka->ws_)
#define out (ka->out_)
#define x_prompt (ka->in[0])
#define x_sample (ka->in[1])
#define mem_prompt (ka->in[2])
#define state_gla (ka->in[3])
#define cache_sb_k (ka->in[4])
#define cache_sb_v (ka->in[5])
#define cache_mem_k (ka->in[6])
#define cache_mem_v (ka->in[7])
#define w_in_a (ka->in[8])
#define w_gate_lr (ka->in[9])
#define b_gate (ka->in[10])
#define gla_norm_g (ka->in[11])
#define w_in_b (ka->in[12])
#define w_kv_shared (ka->in[13])
#define w_mem_kv (ka->in[14])
#define w_o (ka->in[15])
#define ln1_g (ka->in[16])
#define ln1_b (ka->in[17])
#define ln2_g (ka->in[18])
#define ln2_b (ka->in[19])
#define w_ffn_in (ka->in[20])
#define w_ffn_out (ka->in[21])
#define WIN ((bf16*)(ws + WS_WIN))
#define WO ((bf16*)(ws + WS_WO))
#define WFI ((bf16*)(ws + WS_WFI))
#define WFO ((bf16*)(ws + WS_WFO))
#define WMEM ((bf16*)(ws + WS_WMEM))
#define MEMX ((bf16*)(ws + WS_MEMX))
#define MEMK ((bf16*)(ws + WS_MEMK))
#define MEMV ((bf16*)(ws + WS_MEMV))
#define X ((bf16*)(ws + WS_X))
#define Y ((float*)(ws + WS_Y))
#define PROJ ((bf16*)(ws + WS_R1))
#define HB ((bf16*)(ws + WS_R1))
#define OCAT ((bf16*)(ws + WS_OCAT))
#define SBKS ((bf16*)(ws + WS_SBKS))
#define SBVS ((bf16*)(ws + WS_SBVS))
#define OINT (out + O_YP)
#define KPB ((bf16*)(out + O_YP))
#define VPB (KPB + (size_t)MP * 1536)

#define PHASE_BEGIN(cond, cls) if (cond) { if (lo <= ph && ph < hi) { if (ph > lo) xcd_barrier(bar); DIAG_STAMP(cls); for (int rep_ = 0; rep_ < (((cls) == REP_CLS) ? 2 : 1); ++rep_) { const __attribute__((address_space(4))) Args* ka = KARGS; asm volatile("" : "+s"(ka)); int tid_ = threadIdx.x, G_ = gridDim.x, bid_ = blockIdx.x; asm volatile("" : "+v"(tid_), "+s"(G_), "+s"(bid_)); const int tid = tid_, lane = tid_ & 63, wave_ = __builtin_amdgcn_readfirstlane(tid_ >> 6), gw_ = bid_ * NWAVES + wave_, NGW_ = G_ * NWAVES; (void)tid; (void)lane; (void)gw_; (void)NGW_;
#define PHASE_END } } ++ph; }
#ifndef REP_CLS
#define REP_CLS (-1)
#endif
#if defined(DIAG_A)
#define DIAG_STAMP(cls) do { if (blockIdx.x == 0 && threadIdx.x == 0) { unsigned long long* dts = (unsigned long long*)(args.ws_ + 262144); dts[ph] = rt(); } } while (0)
#else
#define DIAG_STAMP(cls) do { } while (0)
#endif

    PHASE_BEGIN(true, 0)
        for (int r = gw_; r < MT; r += NGW_) cvt_row(r < MP ? x_prompt + (size_t)r * D : (r < MR ? x_sample + (size_t)(r - MP) * D : nullptr), X + (size_t)r * D, D, lane);
        for (int r = gw_; r < 1024; r += NGW_) cvt_row(mem_prompt + (size_t)r * D, MEMX + (size_t)r * D, D, lane);
        for (int r = gw_; r < 4 * 8 * 256; r += NGW_) { const int l = r >> 11, b = (r >> 8) & 7, m = r & 255; const size_t dst = (size_t)((l * 12 + 4 + b) * 256 + m) * 512;
            cvt_row(cache_mem_k + (size_t)r * 512, MEMK + dst, 512, lane); }
        for (int it = gw_; it < 512; it += NGW_) { const int hdb = it & 3, mb = (it >> 2) & 3, b = (it >> 4) & 7, l = it >> 7, m = mb * 64 + lane;
            const float* src = cache_mem_v + (size_t)((l * 8 + b) * 256 + m) * 512 + hdb * 128; bf16* dst = MEMV + (size_t)((l * 12 + 4 + b) * 512 + hdb * 128) * 256 + m;
            for (int q4 = 0; q4 < 32; ++q4) { const f32x4 v = *(const f32x4*)(src + 4 * q4);
#pragma unroll
                for (int e = 0; e < 4; ++e) dst[(size_t)(4 * q4 + e) * 256] = (bf16)f2bf(v[e]); } }
        for (int r = gw_; r < 8 * 2048; r += NGW_) { const int b = r >> 11, s = r & 2047; const size_t dst = (size_t)(b * 2064 + s) * 1536;
            cvt_row(cache_sb_k + (size_t)r * 1536, SBKS + dst, 1536, lane); }
        for (int it = gw_; it < 3072; it += NGW_) { const int cb = it % 12, sb_ = (it / 12) & 31, b = it / 384, s = sb_ * 64 + lane;
            const float* src = cache_sb_v + (size_t)(b * 2048 + s) * 1536 + cb * 128; bf16* dst = SBVS + (size_t)(b * 1536 + cb * 128) * 2080 + s;
            for (int q4 = 0; q4 < 32; ++q4) { const f32x4 v = *(const f32x4*)(src + 4 * q4);
#pragma unroll
                for (int e = 0; e < 4; ++e) dst[(size_t)(4 * q4 + e) * 2080] = (bf16)f2bf(v[e]); } }
        for (int l = 0; l < 4; ++l) wt_convert(F.lds, wave_, gw_, NGW_, lane, w_mem_kv + (size_t)l * D * 1024, D, 1024, WMEM + (size_t)l * 1024 * D, 1024, MapId());
    PHASE_END
    PHASE_BEGIN(true, 0)
        pg8::Gemm g{MEMX, WMEM, 1024, 4096, D}; pg8::StaticOrder S; S.init(1024, 4096, G_, bid_);
        pg8::EpiMemKV E{out + O_MKP, out + O_MVP, MEMK, MEMV};
        pg8::gemm_phase<pg8::EpiMemKV, pg8::StaticOrder, true, true>(F.lds + RING_OFF, g, S, E);
    PHASE_END

    for (int l = 0; l < 4; ++l) {
        const bool LA = l < 2;
        PHASE_BEGIN(true, 1)
            if (LA) wt_convert(F.lds, wave_, gw_, NGW_, lane, w_in_a + (size_t)l * D * 5136, D, 5136, WIN, NA, MapInA());
            else { wt_convert(F.lds, wave_, gw_, NGW_, lane, w_in_b + (size_t)(l - 2) * D * NBQ, D, NBQ, WIN, NBQ, MapId()); if (l == 2) wt_convert(F.lds, wave_, gw_, NGW_, lane, w_kv_shared, D, NKV, WIN + (size_t)NBQ * D, NKV, MapId()); }
            wt_convert(F.lds, wave_, gw_, NGW_, lane, w_o + (size_t)l * D * D, D, D, WO, D, MapId());
            wt_convert(F.lds, wave_, gw_, NGW_, lane, w_ffn_in + (size_t)l * D * 2 * DFF, D, 2 * DFF, WFI, 2 * DFF, MapFfn());
            wt_convert(F.lds, wave_, gw_, NGW_, lane, w_ffn_out + (size_t)l * DFF * D, DFF, D, WFO, D, MapId());
        PHASE_END
        const int ldp = LA ? NA : NBQ;
        PHASE_BEGIN(true, 2)
            { pg8::Gemm g{X, WIN, MT, ldp, D}; pg8::StaticOrder S; S.init(MT, ldp, G_, bid_); pg8::EpiBf16 E{PROJ, ldp};
              pg8::gemm_phase<pg8::EpiBf16, pg8::StaticOrder, true, true>(F.lds + RING_OFF, g, S, E); }
            if (l == 2) { pg8::Gemm g{X, WIN + (size_t)NBQ * D, MT, NKV, D}; pg8::StaticOrder S; S.init(MT, NKV, G_, bid_);
              pg8::EpiKV E{out + O_SKP, out + O_SVP, out + O_SKS, out + O_SVS, KPB, VPB, SBKS, SBVS};
              pg8::gemm_phase<pg8::EpiKV, pg8::StaticOrder, true, true>(F.lds + RING_OFF, g, S, E); }
        PHASE_END
        PHASE_BEGIN(LA, 3)
            gla_prep(bid_, G_, tid, wave_, F.lds + RING_OFF, l, PROJ, w_gate_lr, b_gate, (unsigned char*)Y);
        PHASE_END
        PHASE_BEGIN(true, (LA ? 4 : 11))
            if (LA) {
                for (int item = bid_; item < N_PKG; item += G_) gla_intra(item, tid, wave_, F.lds + RING_OFF, (const unsigned char*)Y, OINT);
            } else {
                for (int u = gw_; u < 12288 + 96; u += NGW_) {
                    if (u < 12288) { const int bh = u >> 8, qb = u & 255, b = bh / 12, h = bh % 12, t0 = 32 * qb; const size_t qo = (size_t)(b * SEQ + t0) * D + h * 128;
                        sb_attn(lane, F.lds + RING_OFF + wave_ * 16384, KPB + (size_t)(b * SEQ) * 1536 + h * 128, 1536, VPB + (size_t)(bh * 128) * SEQ, SEQ, PROJ + qo, NBQ, OCAT + qo, t0, 32); }
                    else { const int u2 = u - 12288, b = u2 / 12, h = u2 % 12; const size_t qo = (size_t)(MP + b * 16) * D + h * 128;
                        sb_attn(lane, F.lds + RING_OFF + wave_ * 16384, SBKS + (size_t)(b * 2064) * 1536 + h * 128, 1536, SBVS + (size_t)(u2 * 128) * 2080, 2080, PROJ + qo, NBQ, OCAT + qo, 2048, 16); }
                }
            }
            __syncthreads();
            for (int wi = bid_; wi < 256 + 32; wi += G_) mem_attn_wg(wi, tid, wave_, F.lds + RING_OFF, l, PROJ, ldp, LA ? CQM : 1536, MEMK, MEMV, OCAT);
        PHASE_END
        PHASE_BEGIN(LA, 12)
            for (int wc = bid_; wc < 144; wc += G_) gla_chain<1>(wc, tid, wave_, F.lds + RING_OFF, l, (const unsigned char*)Y, state_gla, OINT, out, (float*)WMEM, (float*)MEMX);
        PHASE_END
        PHASE_BEGIN(LA, 5)
            for (int wc = bid_; wc < 192 + 96; wc += G_) gla_chain<2>(wc, tid, wave_, F.lds + RING_OFF, l, (const unsigned char*)Y, state_gla, OINT, out, (float*)WMEM, (float*)MEMX, REP_CLS == 5 && rep_ == 0);
        PHASE_END
        PHASE_BEGIN(LA, 6)
            const float* gn = gla_norm_g + (size_t)l * 384;
            for (int row = gw_; row < MR; row += NGW_) {
#pragma unroll
                for (int h = 0; h < 4; ++h) { bf16* op = OCAT + (size_t)row * D + h * 384; const bf16* gp = PROJ + (size_t)row * NA + CG + h * 384;
                    float ov[6]; float ss = 0.f;
#pragma unroll
                    for (int j = 0; j < 3; ++j) { const f32x2_t w = *(const f32x2_t*)(OINT + (size_t)row * 1536 + h * 384 + 2 * lane + 128 * j); ov[2 * j] = w.x; ov[2 * j + 1] = w.y; ss += ov[2 * j] * ov[2 * j] + ov[2 * j + 1] * ov[2 * j + 1]; }
                    const float r = 1.0f / sqrtf(wave_sum(ss, lane) * (1.0f / 384.0f) + RMS_EPS);
#pragma unroll
                    for (int j = 0; j < 3; ++j) { const int c = 2 * lane + 128 * j; const unsigned gw2 = *(const unsigned*)(gp + c); const float g0 = pg8::bflo(gw2), g1 = pg8::bfhi(gw2);
                        const float r0 = ov[2 * j] * r * gn[c] * (g0 / (1.0f + __expf(-g0))), r1 = ov[2 * j + 1] * r * gn[c + 1] * (g1 / (1.0f + __expf(-g1)));
                        *(unsigned*)(op + c) = pk2(r0, r1); } }
            }
        PHASE_END
        PHASE_BEGIN(true, 7)
            pg8::Gemm g{OCAT, WO, MT, D, D}; pg8::StaticOrder S; S.init(MT, D, G_, bid_); pg8::EpiRes E{Y, X, D, DN_ALPHA};
            pg8::gemm_phase<pg8::EpiRes, pg8::StaticOrder, true, true>(F.lds + RING_OFF, g, S, E);
        PHASE_END
        PHASE_BEGIN(true, 8)
            const float* gg = ln1_g + (size_t)l * D; const float* bb = ln1_b + (size_t)l * D;
            for (int row = gw_; row < MR; row += NGW_) {
                const f32x4* yr = (const f32x4*)(Y + (size_t)row * D) + lane; f32x4 v[8]; float s = 0.f;
#pragma unroll
                for (int j = 0; j < 8; ++j) { v[j] = yr[64 * j]; s += (v[j].x + v[j].y) + (v[j].z + v[j].w); }
                const float mean = wave_sum(s, lane) * (1.f / D); float s2 = 0.f;
#pragma unroll
                for (int j = 0; j < 8; ++j) { v[j] = v[j] - mean; s2 += (v[j].x * v[j].x + v[j].y * v[j].y) + (v[j].z * v[j].z + v[j].w * v[j].w); }
                const float rstd = 1.f / sqrtf(wave_sum(s2, lane) * (1.f / D) + LN_EPS);
                unsigned long long* o8 = (unsigned long long*)(X + (size_t)row * D) + lane;
#pragma unroll
                for (int j = 0; j < 8; ++j) { const f32x4 g4 = *((const f32x4*)gg + lane + 64 * j), b4 = *((const f32x4*)bb + lane + 64 * j); const f32x4 r = v[j] * rstd * g4 + b4;
                    o8[64 * j] = (unsigned long long)pk2(r.x, r.y) | ((unsigned long long)pk2(r.z, r.w) << 32); }
            }
        PHASE_END
        PHASE_BEGIN(true, 9)
            pg8::Gemm g{X, WFI, MT, 2 * DFF, D}; pg8::StaticOrder S; S.init(MT, 2 * DFF, G_, bid_); pg8::EpiSwiGLU E{HB, DFF};
            pg8::gemm_phase<pg8::EpiSwiGLU, pg8::StaticOrder, true, true>(F.lds + RING_OFF, g, S, E);
        PHASE_END
        PHASE_BEGIN(true, 10)
            pg8::Gemm g{HB, WFO, MT, D, DFF}; pg8::StaticOrder S; S.init(MT, D, G_, bid_); pg8::EpiRes E{Y, X, D, DN_ALPHA};
            pg8::gemm_phase<pg8::EpiRes, pg8::StaticOrder, true, true>(F.lds + RING_OFF, g, S, E);
        PHASE_END
        PHASE_BEGIN(true, 8)
            const float* gg = ln2_g + (size_t)l * D; const float* bb = ln2_b + (size_t)l * D;
            for (int row = gw_; row < MR; row += NGW_) {
                const f32x4* yr = (const f32x4*)(Y + (size_t)row * D) + lane; f32x4 v[8]; float s = 0.f;
#pragma unroll
                for (int j = 0; j < 8; ++j) { v[j] = yr[64 * j]; s += (v[j].x + v[j].y) + (v[j].z + v[j].w); }
                const float mean = wave_sum(s, lane) * (1.f / D); float s2 = 0.f;
#pragma unroll
                for (int j = 0; j < 8; ++j) { v[j] = v[j] - mean; s2 += (v[j].x * v[j].x + v[j].y * v[j].y) + (v[j].z * v[j].z + v[j].w * v[j].w); }
                const float rstd = 1.f / sqrtf(wave_sum(s2, lane) * (1.f / D) + LN_EPS);
                if (l == 3) { f32x4* of = (f32x4*)(row < MP ? out + O_YP + (size_t)row * D : out + O_YS + (size_t)(row - MP) * D) + lane;
#pragma unroll
                    for (int j = 0; j < 8; ++j) { const f32x4 g4 = *((const f32x4*)gg + lane + 64 * j), b4 = *((const f32x4*)bb + lane + 64 * j); of[64 * j] = v[j] * rstd * g4 + b4; } }
                else { unsigned long long* o8 = (unsigned long long*)(X + (size_t)row * D) + lane;
#pragma unroll
                    for (int j = 0; j < 8; ++j) { const f32x4 g4 = *((const f32x4*)gg + lane + 64 * j), b4 = *((const f32x4*)bb + lane + 64 * j); const f32x4 r = v[j] * rstd * g4 + b4;
                        o8[64 * j] = (unsigned long long)pk2(r.x, r.y) | ((unsigned long long)pk2(r.z, r.w) << 32); } }
            }
        PHASE_END
    }
#if defined(DIAG_A)
    if (blockIdx.x == 0 && threadIdx.x == 0) { unsigned long long* dts = (unsigned long long*)(args.ws_ + 262144); dts[ph] = rt(); dts[63] = (unsigned long long)ph; }
#endif
#undef ws
#undef out
#undef X
#undef Y
#undef PHASE_BEGIN
#undef PHASE_END
}

#if defined(DIAG_A)
__device__ const int diag_cls[40] = {0,0, 1,2,3,4,5,6,7,8,9,10,8, 1,2,3,4,5,6,7,8,9,10,8, 1,2,11,7,8,9,10,8, 1,2,11,7,8,9,10,8};
__global__ void diag_tail(float* o, const unsigned long long* dts) {
    __shared__ float dv[2];
    if (threadIdx.x == 0) { const int n = (int)dts[63]; unsigned long long sa = 0, sb = 0; for (int p = 0; p < n; ++p) { const unsigned long long d = dts[p + 1] - dts[p]; const int cl = diag_cls[p]; if (cl == DIAG_A) sa += d; if (cl == DIAG_B) sb += d; }
        dv[0] = (float)sa * 0.01f; dv[1] = (float)sb * 10.0f; }
    __syncthreads();
    for (int i = threadIdx.x; i < 262144; i += blockDim.x) o[O_YS + i] = dv[0];
    if (threadIdx.x == 0) o[O_YP] = dv[1];
}
#endif
#ifndef MK_PER_PHASE
#define MK_PER_PHASE 0
#endif
constexpr int N_PHASES = 2 + 2 * 12 + 2 * 8;
extern "C" void kernel_launch(void* const* d_in, const int* in_sizes, int n_in, void* d_out, int out_size, void* d_ws, size_t ws_size, hipStream_t stream) {
    static int grid = 0;
    if (grid == 0) {
        if (n_in != 22 || in_sizes[0] != MP * D || (size_t)out_size != O_END || ws_size < WS_END) { fprintf(stderr, "kernel_launch: unexpected shapes (n_in %d, in0 %d, out %d, ws %zu); nothing launched\n", n_in, n_in > 0 ? in_sizes[0] : -1, out_size, ws_size); grid = -1; return; }
        int dev = 0, cus = 0, per_cu = 0;
        if (hipGetDevice(&dev) != hipSuccess || hipDeviceGetAttribute(&cus, hipDeviceAttributeMultiprocessorCount, dev) != hipSuccess) { grid = -1; return; }
        if (hipFuncSetAttribute((const void*)mega, hipFuncAttributeMaxDynamicSharedMemorySize, LDS_BYTES) != hipSuccess) { fprintf(stderr, "kernel_launch: hipFuncSetAttribute failed\n"); grid = -1; return; }
        if (hipOccupancyMaxActiveBlocksPerMultiprocessor(&per_cu, (const void*)mega, NWAVES * 64, LDS_BYTES) != hipSuccess || per_cu < 1) fprintf(stderr, "kernel_launch: occupancy query reports %d\n", per_cu);
        (void)hipGetLastError();
        grid = cus;
    }
    if (grid < 0) return;
    if (hipMemsetAsync((char*)d_ws + WS_CTL, 0, CTL_ZERO_BYTES, stream) != hipSuccess) return;
    Args a{};
    for (int i = 0; i < 22; ++i) a.in[i] = (const float*)d_in[i];
    a.out_ = (float*)d_out; a.ws_ = (unsigned char*)d_ws;
#if MK_PER_PHASE
    for (int p = 0; p < N_PHASES; ++p) { a.ph_lo = p; a.ph_hi = p + 1; hipLaunchKernelGGL(mega, dim3(grid), dim3(NWAVES * 64), LDS_BYTES, stream, a); }
#else
    a.ph_lo = 0; a.ph_hi = N_PHASES; hipLaunchKernelGGL(mega, dim3(grid), dim3(NWAVES * 64), LDS_BYTES, stream, a);
#if defined(DIAG_A)
    hipLaunchKernelGGL(diag_tail, dim3(1), dim3(512), 0, stream, (float*)d_out, (const unsigned long long*)((unsigned char*)d_ws + 262144));
#endif
#endif
}
```

```cpp
#include <hip/hip_runtime.h>
#include <cstdio>
#include <cstdint>
namespace pg8 {
#define PG8_LAS __attribute__((address_space(3)))
typedef unsigned short bf16_t;
typedef short bf16x8 __attribute__((ext_vector_type(8)));
typedef float f32x4 __attribute__((ext_vector_type(4)));
typedef unsigned u32x4 __attribute__((ext_vector_type(4)));
constexpr int BM = 256, BK = 64, HALF = 128, HTB = HALF * BK * 2  , STAGE_BYTES = 8 * HTB, NXCD = 8, WGM = 8;

__host__ __device__ __forceinline__ int lds_byte(int r, int c) { const int st = (r >> 4) * 2 + (c >> 5), rr = r & 15, cc = c & 31, ob = rr * 64 + cc * 2; return st * 1024 + (ob ^ (((ob >> 9) & 1) << 5)); }
__host__ __device__ __forceinline__ void stage_rc(int b, int& R, int& C) { const int st = b / 1024, sb = b % 1024, swz = sb ^ (((sb >> 9) & 1) << 5); R = (st >> 1) * 16 + swz / 64; C = (st & 1) * 32 + (swz % 64) / 2; }
__host__ __device__ __forceinline__ int perm32(int rho) { const int n = rho >> 4, i = rho & 15; return 8 * (i >> 2) + 4 * n + (i & 3); }

struct Unit { int pm, pn; };
struct Gemm { const bf16_t* A; const bf16_t* Bt; int M, N, K; };

struct StaticOrder {
    int nM, nN, nwg, G, c;
    __host__ __device__ void init(int M, int N, int G_, int c_) { nM = M / BM; nN = N / BM; nwg = nM * nN; G = G_; c = c_; }
    __host__ __device__ bool next(int i, Unit& u) const {
        const long L = (long)i * G + c; if (L >= nwg) return false;
        int wgid = (int)L; { const int q = nwg / NXCD, r = nwg % NXCD, xcd = wgid % NXCD, off = wgid / NXCD; wgid = (xcd < r ? xcd * (q + 1) : r * (q + 1) + (xcd - r) * q) + off; }
        const int nig = WGM * nN, gid = wgid / nig, fm = gid * WGM, gsz = (nM - fm) < WGM ? (nM - fm) : WGM;
        u.pm = fm + ((wgid % nig) % gsz); u.pn = (wgid % nig) / gsz; return true;
    }
    __device__ __forceinline__ void a_ready(const Unit&) const {}
    __device__ __forceinline__ void done(const Unit&) const {}
};
__device__ __forceinline__ unsigned cvt_pk_bf16(float lo, float hi) { unsigned r; asm volatile("v_cvt_pk_bf16_f32 %0, %1, %2" : "=v"(r) : "v"(lo), "v"(hi)); return r; }
typedef float f32x2 __attribute__((ext_vector_type(2)));
typedef unsigned u32x2 __attribute__((ext_vector_type(2)));
__device__ __forceinline__ float bflo(unsigned w) { return __builtin_bit_cast(float, w << 16); }
__device__ __forceinline__ float bfhi(unsigned w) { return __builtin_bit_cast(float, w & 0xffff0000u); }
struct EpiBf16 {
    static constexpr bool PERM = true, AFTER_DRAIN = false;
    bf16_t* O; int ldc;
    __device__ __forceinline__ void operator()(const f32x4 (&acc)[2][2][4][2], const Unit& u, int wr, int wc, int fr, int fq) const {
        const int row0 = u.pm * BM + wr * 64 + fr, col0 = u.pn * BM + wc * 32 + 8 * fq;
#pragma unroll
        for (int ai = 0; ai < 2; ++ai)
#pragma unroll
            for (int m = 0; m < 4; ++m) { bf16_t* rowp = O + (size_t)(row0 + ai * HALF + m * 16) * ldc + col0;
#pragma unroll
                for (int bj = 0; bj < 2; ++bj) { const f32x4 v0 = acc[ai][bj][m][0], v1 = acc[ai][bj][m][1];
                    u32x4 w; w.x = cvt_pk_bf16(v0[0], v0[1]); w.y = cvt_pk_bf16(v0[2], v0[3]); w.z = cvt_pk_bf16(v1[0], v1[1]); w.w = cvt_pk_bf16(v1[2], v1[3]);
                    *(u32x4*)(rowp + bj * HALF) = w; } __builtin_amdgcn_sched_barrier(0); }
    }
};
struct EpiSwiGLU {
    static constexpr bool PERM = true, AFTER_DRAIN = false;
    bf16_t* Hh; int ldh;
    __device__ __forceinline__ float swi(float g, float up) const { return g * __builtin_amdgcn_rcpf(1.0f + __expf(-g)) * up; }
    __device__ __forceinline__ void operator()(const f32x4 (&acc)[2][2][4][2], const Unit& u, int wr, int wc, int fr, int fq) const {
        const int row0 = u.pm * BM + wr * 64 + fr, col0 = u.pn * HALF + wc * 32 + 8 * fq;
#pragma unroll
        for (int ai = 0; ai < 2; ++ai)
#pragma unroll
            for (int m = 0; m < 4; ++m) { bf16_t* rowp = Hh + (size_t)(row0 + ai * HALF + m * 16) * ldh + col0;
                const f32x4 g0 = acc[ai][0][m][0], g1 = acc[ai][0][m][1], u0 = acc[ai][1][m][0], u1 = acc[ai][1][m][1];
                u32x4 w; w.x = cvt_pk_bf16(swi(g0[0], u0[0]), swi(g0[1], u0[1])); w.y = cvt_pk_bf16(swi(g0[2], u0[2]), swi(g0[3], u0[3]));
                w.z = cvt_pk_bf16(swi(g1[0], u1[0]), swi(g1[1], u1[1])); w.w = cvt_pk_bf16(swi(g1[2], u1[2]), swi(g1[3], u1[3]));
                *(u32x4*)rowp = w; __builtin_amdgcn_sched_barrier(0); }
    }
};
struct EpiRes {
    static constexpr bool PERM = false, AFTER_DRAIN = false;
    float* Y; const bf16_t* X; int ldc; float alpha;
    __device__ __forceinline__ void operator()(const f32x4 (&acc)[2][2][4][2], const Unit& u, int wr, int wc, int fr, int fq) const {
        const int row0 = u.pm * BM + wr * 64 + fr, col0 = u.pn * BM + wc * 32 + 4 * fq;
#pragma unroll
        for (int ai = 0; ai < 2; ++ai)
#pragma unroll
            for (int m = 0; m < 4; ++m) { const size_t ro = (size_t)(row0 + ai * HALF + m * 16) * ldc + col0;
#pragma unroll
                for (int bj = 0; bj < 2; ++bj)
#pragma unroll
                    for (int n = 0; n < 2; ++n) { const size_t o = ro + bj * HALF + n * 16; const u32x2 xv = *(const u32x2*)(X + o);
                        f32x4 r; r[0] = alpha * bflo(xv.x); r[1] = alpha * bfhi(xv.x); r[2] = alpha * bflo(xv.y); r[3] = alpha * bfhi(xv.y);
                        *(f32x4*)(Y + o) = r + acc[ai][bj][m][n]; } __builtin_amdgcn_sched_barrier(0); }
    }
};
struct EpiKV {
    static constexpr bool PERM = false, AFTER_DRAIN = false;
    float *okp, *ovp, *oks, *ovs; bf16_t *kpb, *vpb, *ksb, *vsb;
    __device__ __forceinline__ void operator()(const f32x4 (&acc)[2][2][4][2], const Unit& u, int wr, int wc, int fr, int fq) const {
        const bool isv = u.pn >= 6; const int colt = (u.pn - (isv ? 6 : 0)) * BM + wc * 32 + 4 * fq, row0 = u.pm * BM + wr * 64 + fr;
        float* op = isv ? ovp : okp; float* os = isv ? ovs : oks; bf16_t* bp = isv ? vpb : kpb; bf16_t* bs = isv ? vsb : ksb;
#pragma unroll
        for (int ai = 0; ai < 2; ++ai)
#pragma unroll
            for (int m = 0; m < 4; ++m) { const int row = row0 + ai * HALF + m * 16; float* fd; bf16_t* bd;
                bf16_t* vt; size_t vld;
                if (row < 32768) { fd = op + (size_t)row * 1536; bd = bp + (size_t)row * 1536; vt = vpb + (size_t)((row >> 13) * 1536) * 8192 + (row & 8191); vld = 8192; }
                else if (row < 32896) { const int i = row - 32768; fd = os + (size_t)i * 1536; bd = bs + (size_t)((i >> 4) * 2064 + 2048 + (i & 15)) * 1536; vt = vsb + (size_t)((i >> 4) * 1536) * 2080 + 2048 + (i & 15); vld = 2080; }
                else continue;
#pragma unroll
                for (int bj = 0; bj < 2; ++bj)
#pragma unroll
                    for (int n = 0; n < 2; ++n) { const int c = colt + bj * HALF + n * 16; const f32x4 v = acc[ai][bj][m][n];
                        *(f32x4*)(fd + c) = v; const unsigned w0 = cvt_pk_bf16(v[0], v[1]), w1 = cvt_pk_bf16(v[2], v[3]);
                        if (!isv) { u32x2 w; w.x = w0; w.y = w1; *(u32x2*)(bd + c) = w; }
                        else { vt[(size_t)c * vld] = (bf16_t)w0; vt[(size_t)(c + 1) * vld] = (bf16_t)(w0 >> 16); vt[(size_t)(c + 2) * vld] = (bf16_t)w1; vt[(size_t)(c + 3) * vld] = (bf16_t)(w1 >> 16); } } }
    }
};
struct EpiMemKV {
    static constexpr bool PERM = false, AFTER_DRAIN = false;
    float *ok, *ov; bf16_t *kb, *vb;
    __device__ __forceinline__ void operator()(const f32x4 (&acc)[2][2][4][2], const Unit& u, int wr, int wc, int fr, int fq) const {
        const int l = u.pn >> 2, kv = (u.pn >> 1) & 1, hd0 = (u.pn & 1) * BM + wc * 32 + 4 * fq, row0 = u.pm * BM + wr * 64 + fr;
        float* fo = kv ? ov : ok; bf16_t* bo = kv ? vb : kb;
#pragma unroll
        for (int ai = 0; ai < 2; ++ai)
#pragma unroll
            for (int m = 0; m < 4; ++m) { const int row = row0 + ai * HALF + m * 16, b = row >> 8, mm = row & 255;
                float* fd = fo + (size_t)(l * 1024 + row) * 512; bf16_t* bd = bo + (size_t)((l * 12 + b) * 256 + mm) * 512;
#pragma unroll
                for (int bj = 0; bj < 2; ++bj)
#pragma unroll
                    for (int n = 0; n < 2; ++n) { const int c = hd0 + bj * HALF + n * 16; const f32x4 v = acc[ai][bj][m][n];
                        *(f32x4*)(fd + c) = v; const unsigned w0 = cvt_pk_bf16(v[0], v[1]), w1 = cvt_pk_bf16(v[2], v[3]);
                        if (!kv) { u32x2 w; w.x = w0; w.y = w1; *(u32x2*)(bd + c) = w; }
                        else { bf16_t* vt = vb + (size_t)((l * 12 + b) * 512 + c) * 256 + mm;
                            vt[0] = (bf16_t)w0; vt[256] = (bf16_t)(w0 >> 16); vt[512] = (bf16_t)w1; vt[768] = (bf16_t)(w1 >> 16); } } }
    }
};
template <class Epi, class Sched, bool ALIGN_EPI = false, bool SP2 = false>
__device__ __forceinline__ void gemm_phase(PG8_LAS unsigned char* lds, const Gemm g, const Sched& S, const Epi& E, int tid_in) {
    int tid_ = tid_in; asm volatile("" : "+v"(tid_));
    const int tid = tid_, wid = __builtin_amdgcn_readfirstlane(tid >> 6), lane = tid & 63, wr = wid >> 2, wc = wid & 3, fr = lane & 15, fq = lane >> 4;
    const int K = g.K, nt = K / BK;
    unsigned voffA[2], voffB[2];
#pragma unroll
    for (int i = 0; i < 2; ++i) { int R, C; stage_rc(tid * 16 + i * 8192, R, C); const int Rb = Epi::PERM ? ((R & ~31) + perm32(R & 31)) : R;
        voffA[i] = (unsigned)(R * K + C) * 2u; voffB[i] = (unsigned)(Rb * K + C) * 2u; }
    const size_t kstep = (size_t)(BK * 2);
    const size_t hstep = (size_t)HALF * K * 2;
    const size_t tstep = 2 * hstep;
    const unsigned ldsw = (unsigned)wid * 1024u;
    const int aoff = lds_byte(wr * 64 + fr, fq * 8), boff = lds_byte(wc * 32 + fr, fq * 8);
#define PG8_SA(b, h) (((b) * 2 + (h)) * HTB)
#define PG8_SB(b, h) ((4 + (b) * 2 + (h)) * HTB)
#define PG8_STAGE(bufoff, gbase, voff) do { _Pragma("unroll") for (int _i = 0; _i < 2; ++_i) \
        __builtin_amdgcn_global_load_lds((const unsigned*)((const char*)(gbase) + (voff)[_i]), (PG8_LAS unsigned*)(lds + (bufoff) + ldsw + _i * 8192), 16, 0, 0); } while (0)
#define PG8_LDA(dst, b, h) do { _Pragma("unroll") for (int m = 0; m < 4; ++m) _Pragma("unroll") for (int k = 0; k < 2; ++k) dst[m][k] = *(const PG8_LAS bf16x8*)(lds + PG8_SA(b, h) + aoff + m * 2048 + k * 1024); } while (0)
#define PG8_LDB(dst, b, h) do { _Pragma("unroll") for (int n = 0; n < 2; ++n) _Pragma("unroll") for (int k = 0; k < 2; ++k) dst[n][k] = *(const PG8_LAS bf16x8*)(lds + PG8_SB(b, h) + boff + n * 2048 + k * 1024); } while (0)
#define PG8_MMA(ai, bj, At, Bt) do { __builtin_amdgcn_s_setprio(1); _Pragma("unroll") for (int m = 0; m < 4; ++m) _Pragma("unroll") for (int n = 0; n < 2; ++n) _Pragma("unroll") for (int k = 0; k < 2; ++k) \
        acc[ai][bj][m][n] = __builtin_amdgcn_mfma_f32_16x16x32_bf16(Bt[n][k], At[m][k], acc[ai][bj][m][n], 0, 0, 0); __builtin_amdgcn_s_setprio(0); } while (0)
#define PG8_WAIT_V(n) asm volatile("s_waitcnt vmcnt(" #n ")" ::: "memory")
#define PG8_WAIT_L(n) asm volatile("s_waitcnt lgkmcnt(" #n ")" ::: "memory")
#define PG8_BAR __builtin_amdgcn_s_barrier()
#define PG8_SCHED __builtin_amdgcn_sched_barrier(0)
    Unit cur, nxt; int ui = 0;
    if (!S.next(0, cur)) return;
    f32x4 acc[2][2][4][2];
#pragma unroll
    for (int a = 0; a < 2; ++a)
#pragma unroll
        for (int b = 0; b < 2; ++b)
#pragma unroll
            for (int m = 0; m < 4; ++m)
#pragma unroll
                for (int n = 0; n < 2; ++n) acc[a][b][m][n] = (f32x4){0.f, 0.f, 0.f, 0.f};
    bf16x8 At[4][2], B0[2][2], B1[2][2];
    const char* cA = (const char*)g.A + (size_t)cur.pm * tstep; const char* cB = (const char*)g.Bt + (size_t)cur.pn * tstep;
    S.a_ready(cur);
    if constexpr (SP2) {
        PG8_STAGE(PG8_SB(0, 0), cB, voffB); PG8_STAGE(PG8_SB(0, 1), cB + hstep, voffB); PG8_STAGE(PG8_SA(0, 0), cA, voffA); PG8_STAGE(PG8_SA(0, 1), cA + hstep, voffA);
        if (wr == 1) PG8_BAR;
        PG8_WAIT_V(2); PG8_BAR;
        PG8_STAGE(PG8_SB(1, 0), cB + kstep, voffB); PG8_STAGE(PG8_SA(1, 0), cA + kstep, voffA); PG8_STAGE(PG8_SB(1, 1), cB + hstep + kstep, voffB);
        PG8_WAIT_V(6); PG8_BAR;
    } else {
        PG8_STAGE(PG8_SB(0, 0), cB, voffB); PG8_STAGE(PG8_SA(0, 0), cA, voffA); PG8_STAGE(PG8_SB(0, 1), cB + hstep, voffB); PG8_STAGE(PG8_SA(0, 1), cA + hstep, voffA);
        if (wr == 1) PG8_BAR;
        PG8_WAIT_V(4); PG8_BAR;
        PG8_STAGE(PG8_SB(1, 0), cB + kstep, voffB); PG8_STAGE(PG8_SA(1, 0), cA + kstep, voffA); PG8_STAGE(PG8_SB(1, 1), cB + hstep + kstep, voffB);
        PG8_WAIT_V(6); PG8_BAR;
    }
    for (;;) {
        const bool has_next = S.next(ui + 1, nxt);
        const char* nA = has_next ? (const char*)g.A + (size_t)nxt.pm * tstep : cA; const char* nB = has_next ? (const char*)g.Bt + (size_t)nxt.pn * tstep : cB;
        for (int t = 0; t < nt; t += 2) {
            const bool last = (t == nt - 2);
            const char* a1 = cA + (size_t)(t + 1) * kstep;
            const char* a2 = last ? nA : cA + (size_t)(t + 2) * kstep; const char* b2 = last ? nB : cB + (size_t)(t + 2) * kstep;
            const char* a3 = a2 + kstep; const char* b3 = b2 + kstep;
            if (last && has_next) S.a_ready(nxt);
            if constexpr (SP2) {
            PG8_LDB(B0, 0, 0); PG8_LDB(B1, 0, 1); PG8_SCHED; PG8_LDA(At, 0, 0); PG8_STAGE(PG8_SA(1, 1), a1 + hstep, voffA);
            PG8_WAIT_V(8); PG8_WAIT_L(0); PG8_BAR; PG8_MMA(0, 0, At, B0); PG8_MMA(0, 1, At, B1); PG8_BAR; PG8_SCHED;
            PG8_LDA(At, 0, 1); PG8_STAGE(PG8_SB(0, 0), b2, voffB); PG8_STAGE(PG8_SB(0, 1), b2 + hstep, voffB); PG8_STAGE(PG8_SA(0, 0), a2, voffA);
            PG8_WAIT_V(8); PG8_WAIT_L(0); PG8_BAR; PG8_MMA(1, 0, At, B0); PG8_MMA(1, 1, At, B1); PG8_BAR; PG8_SCHED;
            PG8_LDB(B0, 1, 0); PG8_LDB(B1, 1, 1); PG8_SCHED; PG8_LDA(At, 1, 0); PG8_STAGE(PG8_SA(0, 1), a2 + hstep, voffA);
            PG8_WAIT_V(8); PG8_WAIT_L(0); PG8_BAR; PG8_MMA(0, 0, At, B0); PG8_MMA(0, 1, At, B1); PG8_BAR; PG8_SCHED;
            PG8_LDA(At, 1, 1); PG8_STAGE(PG8_SB(1, 0), b3, voffB); PG8_STAGE(PG8_SB(1, 1), b3 + hstep, voffB); PG8_STAGE(PG8_SA(1, 0), a3, voffA);
            PG8_WAIT_V(8); PG8_WAIT_L(0); PG8_BAR; PG8_MMA(1, 0, At, B0); PG8_MMA(1, 1, At, B1); PG8_BAR; PG8_SCHED;
            } else {
            PG8_LDB(B0, 0, 0); PG8_SCHED; PG8_LDA(At, 0, 0); PG8_STAGE(PG8_SA(1, 1), a1 + hstep, voffA);
            PG8_WAIT_L(8); PG8_BAR; PG8_WAIT_L(0); PG8_MMA(0, 0, At, B0); PG8_BAR; PG8_SCHED;
            PG8_LDB(B1, 0, 1); PG8_STAGE(PG8_SB(0, 0), b2, voffB);
            PG8_BAR; PG8_WAIT_L(0); PG8_MMA(0, 1, At, B1); PG8_BAR;
            PG8_LDA(At, 0, 1); PG8_STAGE(PG8_SA(0, 0), a2, voffA);
            PG8_BAR; PG8_WAIT_L(0); PG8_MMA(1, 0, At, B0); PG8_BAR; PG8_SCHED;
            PG8_STAGE(PG8_SB(0, 1), b2 + hstep, voffB);
            PG8_WAIT_V(6); PG8_BAR; PG8_MMA(1, 1, At, B1); PG8_BAR;
            PG8_LDB(B0, 1, 0); PG8_SCHED; PG8_LDA(At, 1, 0); PG8_STAGE(PG8_SA(0, 1), a2 + hstep, voffA);
            PG8_WAIT_L(8); PG8_BAR; PG8_WAIT_L(0); PG8_MMA(0, 0, At, B0); PG8_BAR; PG8_SCHED;
            PG8_LDB(B1, 1, 1); PG8_STAGE(PG8_SB(1, 0), b3, voffB);
            PG8_BAR; PG8_WAIT_L(0); PG8_MMA(0, 1, At, B1); PG8_BAR;
            PG8_LDA(At, 1, 1); PG8_STAGE(PG8_SA(1, 0), a3, voffA);
            PG8_BAR; PG8_WAIT_L(0); PG8_MMA(1, 0, At, B0); PG8_BAR; PG8_SCHED;
            PG8_STAGE(PG8_SB(1, 1), b3 + hstep, voffB);
            PG8_WAIT_V(6); PG8_BAR; PG8_MMA(1, 1, At, B1); PG8_BAR;
            }
        }
        if constexpr (ALIGN_EPI) { if (wr == 0) PG8_BAR; }
        if constexpr (!Epi::AFTER_DRAIN) { E(acc, cur, wr, wc, fr, fq); S.done(cur); }
        if (!has_next) break;
#pragma unroll
        for (int a = 0; a < 2; ++a)
#pragma unroll
            for (int b = 0; b < 2; ++b)
#pragma unroll
                for (int m = 0; m < 4; ++m)
#pragma unroll
                    for (int n = 0; n < 2; ++n) acc[a][b][m][n] = (f32x4){0.f, 0.f, 0.f, 0.f};
        cur = nxt; cA = nA; cB = nB; ++ui;
        if constexpr (ALIGN_EPI) { if (wr == 1) PG8_BAR; }
    }
    PG8_WAIT_V(0);
    if constexpr (!ALIGN_EPI) { if (wr == 0) PG8_BAR; }
    PG8_BAR;
    if constexpr (Epi::AFTER_DRAIN) { E.fused(acc, cur, wr, wc, fr, fq, lds, wid, lane); S.done(cur); }
#undef PG8_SA
#undef PG8_SB
#undef PG8_STAGE
#undef PG8_LDA
#undef PG8_LDB
#undef PG8_MMA
#undef PG8_WAIT_V
#undef PG8_WAIT_L
#undef PG8_BAR
#undef PG8_SCHED
}
}
#define GAS __attribute__((address_space(1)))
#define LAS __attribute__((address_space(3)))
typedef unsigned short bf16;
typedef unsigned v4u __attribute__((ext_vector_type(4)));
typedef float f32x4 __attribute__((ext_vector_type(4)));
typedef short bf16x8 __attribute__((ext_vector_type(8)));
typedef GAS unsigned gu32;
typedef GAS unsigned long long gu64;
#define RLX_AGENT __ATOMIC_RELAXED, __HIP_MEMORY_SCOPE_AGENT
#define LDS_WAIT() asm volatile("s_waitcnt lgkmcnt(0)" ::: "memory")
#define VM_WAIT() asm volatile("s_waitcnt vmcnt(0)" ::: "memory")
__device__ __forceinline__ unsigned long long rt() { return __builtin_amdgcn_s_memrealtime(); }
__device__ __forceinline__ unsigned f2bf(float f) { unsigned u = __builtin_bit_cast(unsigned, f); return (u + 0x7fffu + ((u >> 16) & 1u)) >> 16; }
__device__ __forceinline__ unsigned pk2(float lo, float hi) { return f2bf(lo) | (f2bf(hi) << 16); }
#define XB_TMO      128
#define XB_XCNT(j)  (256  + 64 * (j))
#define XB_XSUB(j)  (1280 + 64 * (j))
#define XB_XGEN(j)  (2304 + 64 * (j))
#define XB_TOP      3328
#define XB_TOPGEN   3392
#define XCD_BAR_WORDS 3456
#define XB_SPIN_CAP (1u << 18)

__device__ __forceinline__ unsigned xb_ld(unsigned* p)              { return __hip_atomic_load(p, __ATOMIC_RELAXED, __HIP_MEMORY_SCOPE_AGENT); }
__device__ __forceinline__ unsigned xb_add(unsigned* p, unsigned v) { return __hip_atomic_fetch_add(p, v, __ATOMIC_RELAXED, __HIP_MEMORY_SCOPE_AGENT); }
__device__ __forceinline__ unsigned xb_xcc_id() { return (unsigned)__builtin_amdgcn_s_getreg((3 << 11) | 20) & 0xFu; }
#define XB_SPIN(cond, bar) do { unsigned _sp = 0; while (cond) { __builtin_amdgcn_s_sleep(1); \
    if ((++_sp & 255u) == 0u) { if (xb_ld(&(bar)[XB_TMO])) break; if (_sp > XB_SPIN_CAP) { atomicAdd(&(bar)[XB_TMO], 1u); break; } } } } while (0)

struct XcdBarrier {
    unsigned* bar; unsigned x;
    volatile LAS unsigned* st;
};

__device__ __forceinline__ XcdBarrier xcd_barrier_post(unsigned* bar, volatile LAS unsigned* st) {
    XcdBarrier b; b.bar = bar; b.x = xb_xcc_id(); b.st = st;
    if (threadIdx.x == 0) (void)xb_add(&bar[XB_XCNT(b.x)], 1u);
    return b;
}
__device__ __forceinline__ void xcd_barrier_complete(unsigned* bar, unsigned x, unsigned& nloc, unsigned& nx) {
    const unsigned G = gridDim.x * gridDim.y * gridDim.z;
    unsigned sum, cnt, mine, sp = 0u;
    for (;;) {
        sum = 0u; cnt = 0u; mine = 0u;
#pragma unroll
        for (unsigned j = 0; j < 16; ++j) { const unsigned c = xb_ld(&bar[XB_XCNT(j)]); sum += c; cnt += (c > 0u) ? 1u : 0u; mine = (j == x) ? c : mine; }
        if (sum == G) break;
        __builtin_amdgcn_s_sleep(1);
        if ((++sp & 255u) == 0u) { if (xb_ld(&bar[XB_TMO])) break; if (sp > XB_SPIN_CAP) { atomicAdd(&bar[XB_TMO], 1u); break; } }
    }
    nloc = mine > 0u ? mine : 1u; nx = cnt > 0u ? cnt : 1u;
}

__device__ __forceinline__ void xcd_barrier(const XcdBarrier& b) {
    asm volatile("s_waitcnt vmcnt(0)" ::: "memory");
    __syncthreads();
    if (threadIdx.x == 0) {
        unsigned* bar = b.bar;
        __builtin_amdgcn_s_waitcnt(0);
        unsigned nloc = b.st[0], nx = b.st[1];
        if (nloc == 0u) { xcd_barrier_complete(bar, b.x, nloc, nx); b.st[0] = nloc; b.st[1] = nx; }
        const unsigned old = xb_add(&bar[XB_XSUB(b.x)], 1u);
        const unsigned gen = old / nloc;
        if (old + 1u == (gen + 1u) * nloc) {
            __builtin_amdgcn_fence(__ATOMIC_RELEASE, "agent");
            asm volatile("s_waitcnt vmcnt(0)" ::: "memory");
            const unsigned og = xb_add(&bar[XB_TOP], 1u);
            const unsigned tg = og / nx;
            if (og + 1u == (tg + 1u) * nx) xb_add(&bar[XB_TOPGEN], 1u);
            else XB_SPIN(xb_ld(&bar[XB_TOPGEN]) == tg, bar);
            __builtin_amdgcn_fence(__ATOMIC_ACQUIRE, "agent");
            xb_add(&bar[XB_XGEN(b.x)], 1u);
            asm volatile("s_waitcnt vmcnt(0)" ::: "memory");
        } else {
            XB_SPIN(xb_ld(&bar[XB_XGEN(b.x)]) == gen, bar);
            __builtin_amdgcn_fence(__ATOMIC_ACQUIRE, "agent");
            asm volatile("s_waitcnt vmcnt(0)" ::: "memory");
        }
    }
    __syncthreads();
}
constexpr int NWAVES = 8;
constexpr int D = 2048, SEQ = 8192, MP = 32768, MS = 128, MR = 32896, MT = 33024;
constexpr int DFF = 5632, NA = 5376, NBQ = 2048, NKV = 3072;
constexpr int CQ = 0, CK = 768, CV = 1536, CG = 3072, CQM = 4608, CLR = 5120;
constexpr float DN_ALPHA = 1.6817928305074292f, LN_EPS = 1e-5f, RMS_EPS = 1e-6f;
constexpr float GLA_QSCALE = 0.07216878364870323f, HD_SCALE = 0.08838834764831845f;
constexpr size_t MiB = 1u << 20;
constexpr size_t WS_CTL = 0, CTL_ZERO_BYTES = 1 * MiB;
constexpr size_t WS_WIN = 1 * MiB, WS_WO = 22 * MiB, WS_WFI = 30 * MiB, WS_WFO = 74 * MiB, WS_WMEM = 96 * MiB, WS_MEMX = 112 * MiB, WS_MEMK = 116 * MiB, WS_MEMV = 128 * MiB;
constexpr size_t WS_X = 140 * MiB, WS_Y = 269 * MiB, WS_R1 = 527 * MiB, WS_OCAT = 882 * MiB, WS_SBKS = 1011 * MiB, WS_SBVS = 1060 * MiB, WS_END = 1109 * MiB;
static_assert(WS_WIN + (size_t)NA * D * 2 <= WS_WO && WS_WFI + (size_t)2 * DFF * D * 2 <= WS_WFO && WS_WFO + (size_t)D * DFF * 2 <= WS_WMEM, "weights map");
static_assert(WS_X + (size_t)MT * D * 2 <= WS_Y && WS_Y + (size_t)MT * D * 4 <= WS_R1 && WS_R1 + (size_t)MT * DFF * 2 <= WS_OCAT && WS_OCAT + (size_t)MT * D * 2 <= WS_SBKS, "activation map");
static_assert(WS_SBKS + (size_t)8 * 2064 * 1536 * 2 <= WS_SBVS && WS_SBVS + (size_t)8 * 2064 * 1536 * 2 <= WS_END, "sb sample map");
constexpr size_t O_YP = 0, O_YS = 67108864, O_GSP = 67371008, O_GSS = 69730304, O_SKP = 74448896, O_SVP = 124780544, O_SKS = 175112192, O_SVS = 175308800, O_MKP = 175505408, O_MVP = 177602560, O_END = 179699712;
constexpr int CW_BAR = 4096;
constexpr int RING_OFF = 0, RING_BYTES = 131072, LDSCTL_OFF = RING_BYTES, MISC_OFF = LDSCTL_OFF + 320, LDS_BYTES = 147456;

struct Args { const float* in[22]; float* out_; unsigned char* ws_; int ph_lo, ph_hi; };
struct Frame {
    LAS unsigned char* lds; volatile LAS unsigned* MISC; gu32* ctl;
    int tid, lane, wave, G, gw, NGW;
};
__device__ __forceinline__ float bf2f(bf16 h) { return __builtin_bit_cast(float, (unsigned)h << 16); }
__device__ __forceinline__ float shx(float v, int lane, int m) { return __builtin_bit_cast(float, __builtin_amdgcn_ds_bpermute((lane ^ m) << 2, __builtin_bit_cast(int, v))); }
__device__ __forceinline__ float wave_sum(float v, int lane) {
#pragma unroll
    for (int o = 1; o < 64; o <<= 1) v += shx(v, lane, o);
    return v;
}
__device__ __forceinline__ float wave_max(float v, int lane) {
#pragma unroll
    for (int o = 1; o < 64; o <<= 1) v = fmaxf(v, shx(v, lane, o));
    return v;
}
__device__ __forceinline__ void cvt_row(const float* src, bf16* dst, int n, int lane) {
    for (int j = lane * 4; j < n; j += 256) {
        f32x4 v = src ? *(const f32x4*)(src + j) : (f32x4){0.f, 0.f, 0.f, 0.f};
        unsigned long long w = (unsigned long long)pk2(v.x, v.y) | ((unsigned long long)pk2(v.z, v.w) << 32);
        *(unsigned long long*)(dst + j) = w;
    }
}
struct MapId { __device__ __forceinline__ int operator()(int n) const { return n; } };
struct MapInA { __device__ __forceinline__ int operator()(int n) const { return n < 4608 ? n : (n < 5120 ? n + 16 : (n < 5136 ? n - 512 : -1)); } };
struct MapFfn { __device__ __forceinline__ int operator()(int n) const { const int t = n >> 8, r = n & 255; return r < 128 ? 128 * t + r : DFF + 128 * t + (r - 128); } };
template <class Map>
__device__ __forceinline__ void wt_convert(LAS unsigned char* ldsb, int wave, int gw, int NGW, int lane, const float* W, int K, int Nsrc, bf16* WT, int Ndst, Map map) {
    LAS float* scr = (LAS float*)(ldsb + RING_OFF + wave * 16384);
    const int nblk = Ndst / 32, nitems = (K / 64) * nblk;
    for (int it = gw; it < nitems; it += NGW) {
        const int kb = it / nblk, nb = it % nblk, k0 = 64 * kb, n0 = 32 * nb;
        const int sc = map(n0 + (lane & 31));
#pragma unroll 8
        for (int i = 0; i < 32; ++i) { const int kk = 2 * i + (lane >> 5); scr[kk * 33 + (lane & 31)] = sc >= 0 ? W[(size_t)(k0 + kk) * Nsrc + sc] : 0.f; }
        LDS_WAIT(); asm volatile("" ::: "memory");
        const int c = lane & 7;
#pragma unroll
        for (int j = 0; j < 4; ++j) { const int n = (lane >> 3) + 8 * j; const LAS float* s = scr + (8 * c) * 33 + n;
            v4u o; o.x = pk2(s[0 * 33], s[1 * 33]); o.y = pk2(s[2 * 33], s[3 * 33]); o.z = pk2(s[4 * 33], s[5 * 33]); o.w = pk2(s[6 * 33], s[7 * 33]);
            *(GAS v4u*)(WT + (size_t)(n0 + n) * K + k0 + 8 * c) = o; }
        LDS_WAIT(); asm volatile("" ::: "memory");
    }
}
__device__ __forceinline__ float softplus_f(float z) { return fmaxf(z, 0.f) + log1pf(__expf(-fabsf(z))); }

typedef short s16x4 __attribute__((ext_vector_type(4)));
typedef pg8::u32x2 u32x2;
typedef float f32x16 __attribute__((ext_vector_type(16)));
typedef __bf16 bf16x2_t __attribute__((ext_vector_type(2)));
typedef float f32x2_t __attribute__((ext_vector_type(2)));
__device__ __forceinline__ unsigned cvt2(float lo, float hi) { const f32x2_t v = {lo, hi}; const bf16x2_t b = __builtin_convertvector(v, bf16x2_t); return __builtin_bit_cast(unsigned, b); }
__device__ __forceinline__ bf16x8 pack8(const f32x4 a, const f32x4 b) { v4u p; p.x = cvt2(a[0], a[1]); p.y = cvt2(a[2], a[3]); p.z = cvt2(b[0], b[1]); p.w = cvt2(b[2], b[3]); return __builtin_bit_cast(bf16x8, p); }
__device__ __forceinline__ bf16x8 ld2x8(const bf16* p0, const bf16* p1) { const s16x4 a = *(const s16x4*)p0, b = *(const s16x4*)p1; return __builtin_shufflevector(a, b, 0, 1, 2, 3, 4, 5, 6, 7); }
__device__ __forceinline__ bf16x8 ld16(const bf16* p) { return *(const bf16x8*)p; }
#define MFMA16(a, b, c) __builtin_amdgcn_mfma_f32_16x16x32_bf16((a), (b), (c), 0, 0, 0)
#define MFMA32(a, b, c) __builtin_amdgcn_mfma_f32_32x32x16_bf16((a), (b), (c), 0, 0, 0)

constexpr int QIMG_LD = 200, KTIMG_LD = 68, PKG_Q = 0, PKG_KT = 25600, PKG_G = 51712, IMG_BYTES = 52480, PKG_K = 52480, PKG_VT = 77056, PKG_BYTES = 126208, N_PKG = 2048 + 32;
static_assert(64 * QIMG_LD * 2 == PKG_KT && PKG_KT + 192 * KTIMG_LD * 2 == PKG_G && PKG_G + 768 == IMG_BYTES && PKG_K + 24576 == PKG_VT && PKG_VT + 49152 == PKG_BYTES && IMG_BYTES % 16 == 0, "package map");

__device__ __forceinline__ float softplus_fast(float z) { return fmaxf(z, 0.f) + __logf(1.0f + __expf(-fabsf(z))); }
__device__ __forceinline__ void gla_prep(int bid, int G, int tid, int wave, LAS unsigned char* lds, int l, const bf16* PROJ, const float* w_gate_lr, const float* b_gate, unsigned char* PKG) {
    const int lane = tid & 63;
    const float* w2 = w_gate_lr + (size_t)l * 16 * 768; const float* bg = b_gate + (size_t)l * 768;
    LAS float* tot = (LAS float*)lds;
    for (int item = bid; item < N_PKG; item += G) {
        int h, row0, T;
        if (item < 2048) { const int bh = item >> 7, ch = item & 127; h = bh & 3; row0 = (bh >> 2) * SEQ + ch * 64; T = 64; }
        else { const int i2 = item - 2048; h = i2 & 3; row0 = MP + (i2 >> 2) * 16; T = 16; }
        unsigned char* pk = PKG + (size_t)item * PKG_BYTES;
        bf16* Qt = (bf16*)(pk + PKG_Q); bf16* Kt = (bf16*)(pk + PKG_K); bf16* KT = (bf16*)(pk + PKG_KT); bf16* VT = (bf16*)(pk + PKG_VT); float* Gp = (float*)(pk + PKG_G);
        float w2c[3][16], bgc[3];
#pragma unroll
        for (int c = 0; c < 3; ++c) { const int d = h * 192 + lane + 64 * c; bgc[c] = bg[d];
#pragma unroll
            for (int r = 0; r < 16; ++r) w2c[c][r] = w2[r * 768 + d]; }
        v4u l0[8], l1[8];
#pragma unroll
        for (int tt = 0; tt < 8; ++tt) { const int t = 8 * wave + tt; const bf16* prow = PROJ + (size_t)(row0 + (t < T ? t : T - 1)) * NA;
            l0[tt] = *(const v4u*)(prow + CLR); l1[tt] = *(const v4u*)(prow + CLR + 8); }
        float lc[8][3]; float run[3] = {0.f, 0.f, 0.f};
#pragma unroll
        for (int tt = 0; tt < 8; ++tt) { const bool ok = 8 * wave + tt < T;
            float lr[16]; lr[0] = pg8::bflo(l0[tt].x); lr[1] = pg8::bfhi(l0[tt].x); lr[2] = pg8::bflo(l0[tt].y); lr[3] = pg8::bfhi(l0[tt].y); lr[4] = pg8::bflo(l0[tt].z); lr[5] = pg8::bfhi(l0[tt].z); lr[6] = pg8::bflo(l0[tt].w); lr[7] = pg8::bfhi(l0[tt].w);
            lr[8] = pg8::bflo(l1[tt].x); lr[9] = pg8::bfhi(l1[tt].x); lr[10] = pg8::bflo(l1[tt].y); lr[11] = pg8::bfhi(l1[tt].y); lr[12] = pg8::bflo(l1[tt].z); lr[13] = pg8::bfhi(l1[tt].z); lr[14] = pg8::bflo(l1[tt].w); lr[15] = pg8::bfhi(l1[tt].w);
#pragma unroll
            for (int c = 0; c < 3; ++c) { float xg = bgc[c];
#pragma unroll
                for (int r = 0; r < 16; ++r) xg += lr[r] * w2c[c][r];
                run[c] += ok ? -softplus_fast(-xg) * (1.0f / 16.0f) : 0.f; lc[tt][c] = run[c]; } }
#pragma unroll
        for (int c = 0; c < 3; ++c) tot[wave * 192 + lane + 64 * c] = run[c];
        unsigned qv[8][3], kv[8][3];
#pragma unroll
        for (int tt = 0; tt < 8; ++tt) { const int t = 8 * wave + tt; const bf16* prow = PROJ + (size_t)(row0 + (t < T ? t : T - 1)) * NA + h * 192 + lane;
#pragma unroll
            for (int c = 0; c < 3; ++c) { qv[tt][c] = prow[CQ + 64 * c]; kv[tt][c] = prow[CK + 64 * c]; } }
        __syncthreads();
        float pre[3], all[3];
#pragma unroll
        for (int c = 0; c < 3; ++c) { pre[c] = 0.f; all[c] = 0.f;
#pragma unroll
            for (int w = 0; w < 8; ++w) { const float tv = tot[w * 192 + lane + 64 * c]; all[c] += tv; if (w < wave) pre[c] += tv; } }
        unsigned ktw[3][4];
#pragma unroll
        for (int tt = 0; tt < 8; ++tt) { const int t = 8 * wave + tt; const bool ok = t < T;
#pragma unroll
            for (int c = 0; c < 3; ++c) { const int dl = lane + 64 * c; const float bc = pre[c] + lc[tt][c]; const float eq = __expf(bc), ek = __expf(-bc);
                const unsigned qb = ok ? f2bf(bf2f((bf16)qv[tt][c]) * GLA_QSCALE * eq) : 0u, kb = ok ? f2bf(bf2f((bf16)kv[tt][c]) * ek) : 0u;
                Qt[t * QIMG_LD + dl] = (bf16)qb; Kt[t * 192 + dl] = (bf16)kb;
                if (tt & 1) ktw[c][tt >> 1] |= kb << 16; else ktw[c][tt >> 1] = kb; } }
#pragma unroll
        for (int c = 0; c < 3; ++c) { bf16* kp = KT + (size_t)(lane + 64 * c) * KTIMG_LD + 8 * wave; u32x2 o0, o1; o0.x = ktw[c][0]; o0.y = ktw[c][1]; o1.x = ktw[c][2]; o1.y = ktw[c][3]; *(u32x2*)kp = o0; *(u32x2*)(kp + 4) = o1; }
        if (wave == 0) {
#pragma unroll
            for (int c = 0; c < 3; ++c) Gp[lane + 64 * c] = __expf(all[c]); }
        unsigned vv[6][8];
#pragma unroll
        for (int tt = 0; tt < 8; ++tt) { const int t = 8 * wave + tt; const bf16* prow = PROJ + (size_t)(row0 + (t < T ? t : T - 1)) * NA + CV + h * 384 + lane;
#pragma unroll
            for (int c2 = 0; c2 < 6; ++c2) vv[c2][tt] = t < T ? (unsigned)prow[64 * c2] : 0u; }
#pragma unroll
        for (int c2 = 0; c2 < 6; ++c2) { v4u o; o.x = vv[c2][0] | (vv[c2][1] << 16); o.y = vv[c2][2] | (vv[c2][3] << 16); o.z = vv[c2][4] | (vv[c2][5] << 16); o.w = vv[c2][6] | (vv[c2][7] << 16);
            *(v4u*)(VT + (size_t)(lane + 64 * c2) * 64 + 8 * wave) = o; }
        __syncthreads();
    }
}

__device__ __forceinline__ void gla_intra(int item, int tid, int wave, LAS unsigned char* lds, const unsigned char* PKG, float* OINT) {
    const int lane = tid & 63, fr = lane & 15, fq = lane >> 4;
    int h, row0, nvalid;
    if (item < 2048) { const int bh = item >> 7, ch = item & 127; h = bh & 3; row0 = (bh >> 2) * SEQ + ch * 64; nvalid = 64; }
    else { const int i2 = item - 2048; h = i2 & 3; row0 = MP + (i2 >> 2) * 16; nvalid = 16; }
    const unsigned char* pk = PKG + (size_t)item * PKG_BYTES;
    const bf16* Qt = (const bf16*)(pk + PKG_Q); const bf16* Kt = (const bf16*)(pk + PKG_K); const bf16* VT = (const bf16*)(pk + PKG_VT);
    bf16x8 va[3], vb[3];
#pragma unroll
    for (int k = 0; k < 3; ++k) { const bf16* vr = VT + (size_t)(16 * (3 * wave + k) + fr) * 64 + 4 * fq; va[k] = ld2x8(vr, vr + 16); vb[k] = ld2x8(vr + 32, vr + 48); }
    constexpr int P_LD = 68;
    LAS bf16* P = (LAS bf16*)lds;
#pragma unroll
    for (int rep = 0; rep < 2; ++rep) {
        const int tl = wave + 8 * rep;
        if (tl < 10) {
            const int it = tl < 1 ? 0 : (tl < 3 ? 1 : (tl < 6 ? 2 : 3)), jt = tl - (it * (it + 1)) / 2;
            f32x4 at = {0.f, 0.f, 0.f, 0.f};
            const bf16* qr = Qt + (size_t)(16 * it + fr) * QIMG_LD + 8 * fq; const bf16* kr = Kt + (size_t)(16 * jt + fr) * 192 + 8 * fq;
#pragma unroll
            for (int s = 0; s < 6; ++s) at = MFMA16(ld16(kr + 32 * s), ld16(qr + 32 * s), at);
            if (it == jt) {
#pragma unroll
                for (int jj = 0; jj < 4; ++jj) if (4 * fq + jj > fr) at[jj] = 0.f; }
            u32x2 w; w.x = cvt2(at[0], at[1]); w.y = cvt2(at[2], at[3]);
            *(LAS u32x2*)(P + (16 * it + fr) * P_LD + 16 * jt + 4 * fq) = w;
        } else if (tl == 10 || tl == 11) {
            const int it = tl == 10 ? 0 : 2, jt = tl == 10 ? 1 : 3; u32x2 z; z.x = 0u; z.y = 0u;
            *(LAS u32x2*)(P + (16 * it + fr) * P_LD + 16 * jt + 4 * fq) = z;
        }
    }
    __syncthreads();
#pragma unroll
    for (int it = 0; it < 4; ++it) {
        if (16 * it >= nvalid) break;
        const LAS bf16* pr = P + (16 * it + fr) * P_LD + 4 * fq;
        const s16x4 a0 = *(const LAS s16x4*)pr, a1 = *(const LAS s16x4*)(pr + 16);
        const bf16x8 pf0 = __builtin_shufflevector(a0, a1, 0, 1, 2, 3, 4, 5, 6, 7); bf16x8 pf1 = pf0;
        if (it >= 2) { const s16x4 b0 = *(const LAS s16x4*)(pr + 32), b1 = *(const LAS s16x4*)(pr + 48); pf1 = __builtin_shufflevector(b0, b1, 0, 1, 2, 3, 4, 5, 6, 7); }
#pragma unroll
        for (int k = 0; k < 3; ++k) { f32x4 o = {0.f, 0.f, 0.f, 0.f};
            o = MFMA16(va[k], pf0, o); if (it >= 2) o = MFMA16(vb[k], pf1, o);
            *(f32x4*)(OINT + (size_t)(row0 + 16 * it + fr) * 1536 + h * 384 + 16 * (3 * wave + k) + 4 * fq) = o; }
    }
    __syncthreads();
}

template <int PASS>
__device__ __forceinline__ void gla_chain(int wc, int tid, int wave, LAS unsigned char* lds, int l, const unsigned char* PKG, const float* state_gla, float* OINT, float* out, float* SLOC, float* GSEG, bool dry = false) {
    const int lane = tid & 63, fr = lane & 15, fq = lane >> 4;
    int h, vb, bh, seg, item0, nsteps, row0, nvalid; const float* s0 = nullptr; float* sout = nullptr;
    if (PASS == 1) { bh = wc / 9; const int rem = wc % 9; vb = rem / 3; seg = rem % 3; h = bh & 3; item0 = bh * 128 + 32 * seg; nsteps = 32; row0 = 0; nvalid = 64; }
    else if (wc < 192) { bh = wc / 12; const int rem = wc % 12; vb = rem >> 2; seg = rem & 3; h = bh & 3; item0 = bh * 128 + 32 * seg; nsteps = 32; row0 = (bh >> 2) * SEQ + 2048 * seg; nvalid = 64;
        if (seg == 3) sout = out + O_GSP + (size_t)(l * 16 + bh) * 192 * 384; }
    else { const int c2 = wc - 192; bh = c2 / 3; vb = c2 % 3; seg = 0; h = bh & 3; item0 = 2048 + bh; nsteps = 1; row0 = MP + (bh >> 2) * 16; nvalid = 16; s0 = state_gla + (size_t)(l * 32 + bh) * 192 * 384; sout = out + O_GSS + (size_t)(l * 32 + bh) * 192 * 384; }
    const int v0 = vb * 128 + wave * 16;
#define GLA_WALK(p, step) do { (p) += (step); asm volatile("" : "+v"(p)); } while (0)
    f32x4 S[12];
    if (s0) { const float* p = s0 + (size_t)(4 * fq) * 384 + v0 + fr;
#pragma unroll
        for (int t = 0; t < 12; ++t) {
#pragma unroll
            for (int jj = 0; jj < 4; ++jj) { S[t][jj] = *p; GLA_WALK(p, 384); }
            GLA_WALK(p, 12 * 384); } }
    else {
#pragma unroll
        for (int t = 0; t < 12; ++t) S[t] = (f32x4){0.f, 0.f, 0.f, 0.f}; }
    if (PASS == 2 && wc < 192) {
        for (int j = 0; j < seg; ++j) { const float* gs = GSEG + (size_t)(bh * 3 + j) * 192 + 4 * fq; const float* p = SLOC + (size_t)((bh * 3 + vb) * 3 + j) * 192 * 128 + (size_t)(4 * fq) * 128 + wave * 16 + fr;
#pragma unroll
            for (int t = 0; t < 12; ++t) { const f32x4 g4 = *(const f32x4*)(gs + 16 * t);
#pragma unroll
                for (int jj = 0; jj < 4; ++jj) { S[t][jj] = g4[jj] * S[t][jj] + *p; GLA_WALK(p, 128); }
                GLA_WALK(p, 12 * 128); } }
    }
    f32x4 GP[PASS == 1 ? 12 : 1];
    if (PASS == 1) {
#pragma unroll
        for (int t = 0; t < 12; ++t) GP[t] = (f32x4){1.f, 1.f, 1.f, 1.f}; }
    constexpr int CH0 = PASS == 1 ? PKG_KT / 16 : 0, NCH = IMG_BYTES / 16, NLD = PASS == 1 ? 4 : 7;
    v4u pre[NLD]; bf16x8 vt[2], vtn[2]; f32x4 oin[4];
    { const unsigned char* pk = PKG + (size_t)item0 * PKG_BYTES;
      if (PASS == 2) {
#pragma unroll
        for (int it = 0; it < 4; ++it) { const int tl = 16 * it + fr; oin[it] = tl < nvalid ? *(const f32x4*)(OINT + (size_t)(row0 + tl) * 1536 + h * 384 + v0 + 4 * fq) : (f32x4){0.f, 0.f, 0.f, 0.f}; } }
#pragma unroll
      for (int k = 0; k < NLD; ++k) { const int ch = CH0 + tid + 512 * k; if (ch < NCH) pre[k] = *(const v4u*)(pk + (size_t)ch * 16); }
      const bf16* VT = (const bf16*)(pk + PKG_VT) + (size_t)(v0 + fr) * 64 + 4 * fq; vt[0] = ld2x8(VT, VT + 16); vt[1] = ld2x8(VT + 32, VT + 48);
#pragma unroll
      for (int k = 0; k < NLD; ++k) { const int ch = CH0 + tid + 512 * k; if (ch < NCH) *(LAS v4u*)(lds + (size_t)ch * 16) = pre[k]; }
      vtn[0] = vt[0]; vtn[1] = vt[1]; }
    __syncthreads();
    for (int n = 0; n < nsteps; ++n) {
        const LAS unsigned char* img = lds + (n & 1) * IMG_BYTES;
        const bool more = n + 1 < nsteps;
        if (more) { const unsigned char* pk = PKG + (size_t)(item0 + n + 1) * PKG_BYTES;
#pragma unroll
            for (int k = 0; k < NLD; ++k) { const int ch = CH0 + tid + 512 * k; if (ch < NCH) pre[k] = *(const v4u*)(pk + (size_t)ch * 16); }
            const bf16* VT = (const bf16*)(pk + PKG_VT) + (size_t)(v0 + fr) * 64 + 4 * fq; vtn[0] = ld2x8(VT, VT + 16); vtn[1] = ld2x8(VT + 32, VT + 48); }
        if (PASS == 2) {
            bf16x8 Sb[6];
#pragma unroll
            for (int s = 0; s < 6; ++s) Sb[s] = pack8(S[2 * s], S[2 * s + 1]);
#pragma unroll
            for (int it = 0; it < 4; ++it) {
                const LAS bf16* qr = (const LAS bf16*)(img + PKG_Q) + (16 * it + fr) * QIMG_LD + 4 * fq;
                f32x4 o = oin[it];
#pragma unroll
                for (int s = 0; s < 6; ++s) { const s16x4 a = *(const LAS s16x4*)(qr + 32 * s), b = *(const LAS s16x4*)(qr + 32 * s + 16);
                    o = MFMA16(Sb[s], __builtin_shufflevector(a, b, 0, 1, 2, 3, 4, 5, 6, 7), o); }
                const int tl = 16 * it + fr;
                if (tl < nvalid && !dry) *(f32x4*)(OINT + (size_t)(row0 + 64 * n + tl) * 1536 + h * 384 + v0 + 4 * fq) = o;
                __builtin_amdgcn_sched_barrier(0);
            }
            if (more) {
#pragma unroll
                for (int it = 0; it < 4; ++it) oin[it] = *(const f32x4*)(OINT + (size_t)(row0 + 64 * (n + 1) + 16 * it + fr) * 1536 + h * 384 + v0 + 4 * fq); }
        }
#pragma unroll
        for (int t = 0; t < 12; ++t) { const LAS bf16* kr = (const LAS bf16*)(img + PKG_KT) + (16 * t + fr) * KTIMG_LD + 4 * fq;
#pragma unroll
            for (int s2 = 0; s2 < 2; ++s2) { const s16x4 a = *(const LAS s16x4*)(kr + 32 * s2), b = *(const LAS s16x4*)(kr + 32 * s2 + 16);
                S[t] = MFMA16(__builtin_shufflevector(a, b, 0, 1, 2, 3, 4, 5, 6, 7), vt[s2], S[t]); }
            const f32x4 g4 = *(const LAS f32x4*)(img + PKG_G + (16 * t + 4 * fq) * 4);
            S[t] = S[t] * g4; if (PASS == 1) GP[t] = GP[t] * g4; if (t & 1) __builtin_amdgcn_sched_barrier(0); }
        if (more) { LAS unsigned char* nimg = lds + ((n + 1) & 1) * IMG_BYTES;
#pragma unroll
            for (int k = 0; k < NLD; ++k) { const int ch = CH0 + tid + 512 * k; if (ch < NCH) *(LAS v4u*)(nimg + (size_t)ch * 16) = pre[k]; }
            vt[0] = vtn[0]; vt[1] = vtn[1]; }
        asm volatile("s_waitcnt lgkmcnt(0)" ::: "memory"); __builtin_amdgcn_s_barrier(); asm volatile("" ::: "memory");
    }
    if (PASS == 1) {
        float* p = SLOC + (size_t)((bh * 3 + vb) * 3 + seg) * 192 * 128 + (size_t)(4 * fq) * 128 + wave * 16 + fr;
#pragma unroll
        for (int t = 0; t < 12; ++t) {
#pragma unroll
            for (int jj = 0; jj < 4; ++jj) { *p = S[t][jj]; GLA_WALK(p, 128); }
            GLA_WALK(p, 12 * 128); }
        if (vb == 0 && wave == 0 && fr == 0) { float* gs = GSEG + (size_t)(bh * 3 + seg) * 192;
#pragma unroll
            for (int t = 0; t < 12; ++t) *(f32x4*)(gs + 16 * t + 4 * fq) = GP[t]; }
    } else if (sout) {
        float* p = sout + (size_t)(4 * fq) * 384 + v0 + fr;
#pragma unroll
        for (int t = 0; t < 12; ++t) {
#pragma unroll
            for (int jj = 0; jj < 4; ++jj) { *p = S[t][jj]; GLA_WALK(p, 384); }
            GLA_WALK(p, 12 * 384); }
    }
#undef GLA_WALK
}

__device__ __forceinline__ void mem_attn(int item, int lane, int l, const bf16* PROJ, int ldp, int cqm, const bf16* MEMK, const bf16* MEMVT, bf16* OCAT) {
    const int fr = lane & 15, fq = lane >> 4, tile = item >> 2, h = item & 3, r0 = tile * 16;
    const int bb = r0 < MP ? r0 / SEQ : 4 + ((r0 - MP) >> 4);
    const bf16* Kb = MEMK + (size_t)((l * 12 + bb) * 256) * 512 + h * 128; const bf16* Vt = MEMVT + (size_t)(((l * 12 + bb) * 4 + h) * 128) * 256;
    bf16x8 qf[4];
#pragma unroll
    for (int s = 0; s < 4; ++s) qf[s] = ld16(PROJ + (size_t)(r0 + fr) * ldp + cqm + h * 128 + 32 * s + 8 * fq);
    f32x4 st[16];
#pragma unroll
    for (int mt = 0; mt < 16; ++mt) { st[mt] = (f32x4){0.f, 0.f, 0.f, 0.f}; const bf16* kr = Kb + (size_t)(16 * mt + fr) * 512 + 8 * fq;
#pragma unroll
        for (int s = 0; s < 4; ++s) st[mt] = MFMA16(ld16(kr + 32 * s), qf[s], st[mt]); }
    float mx = -3.0e38f;
#pragma unroll
    for (int mt = 0; mt < 16; ++mt) mx = fmaxf(mx, fmaxf(fmaxf(st[mt][0], st[mt][1]), fmaxf(st[mt][2], st[mt][3])));
    mx = fmaxf(mx, shx(mx, lane, 16)); mx = fmaxf(mx, shx(mx, lane, 32));
    float sum = 0.f;
#pragma unroll
    for (int mt = 0; mt < 16; ++mt)
#pragma unroll
        for (int jj = 0; jj < 4; ++jj) { const float p = __expf((st[mt][jj] - mx) * HD_SCALE); st[mt][jj] = p; sum += p; }
    sum += shx(sum, lane, 16); sum += shx(sum, lane, 32);
    const float inv = 1.0f / sum;
    bf16x8 pf[8];
#pragma unroll
    for (int s = 0; s < 8; ++s) pf[s] = pack8(st[2 * s], st[2 * s + 1]);
#pragma unroll
    for (int dt = 0; dt < 8; ++dt) { f32x4 o = {0.f, 0.f, 0.f, 0.f}; const bf16* vr = Vt + (size_t)(16 * dt + fr) * 256 + 4 * fq;
#pragma unroll
        for (int s = 0; s < 8; ++s) o = MFMA16(ld2x8(vr + 32 * s, vr + 32 * s + 16), pf[s], o);
        u32x2 w; w.x = cvt2(o[0] * inv, o[1] * inv); w.y = cvt2(o[2] * inv, o[3] * inv);
        *(u32x2*)(OCAT + (size_t)(r0 + fr) * D + 1536 + h * 128 + 16 * dt + 4 * fq) = w; }
}

__device__ __forceinline__ void mem_attn_wg(int wi, int tid, int wave, LAS unsigned char* lds, int l, const bf16* PROJ, int ldp, int cqm, const bf16* MEMK, const bf16* MEMVT, bf16* OCAT) {
    const bool smp = wi >= 256; const int lane = tid & 63, fr = lane & 15, fq = lane >> 4, bh = smp ? (wi - 256) : (wi >> 4), sub = wi & 15, b = smp ? 4 + (bh >> 2) : (bh >> 2), h = bh & 3;
    const bf16* Kb = MEMK + (size_t)((l * 12 + b) * 256) * 512 + h * 128; const bf16* Vt = MEMVT + (size_t)(((l * 12 + b) * 4 + h) * 128) * 256;
#pragma unroll
    for (int k = 0; k < 8; ++k) { const int idx = tid + 512 * k, row = idx >> 4, c = idx & 15; *(LAS v4u*)(lds + row * 256 + ((c ^ (row & 15)) << 4)) = *(const v4u*)(Kb + (size_t)row * 512 + c * 8); }
#pragma unroll
    for (int k = 0; k < 8; ++k) { const int idx = tid + 512 * k, row = idx >> 5, c = idx & 31; *(LAS v4u*)(lds + 65536 + row * 512 + ((c ^ (2 * (row & 15))) << 4)) = *(const v4u*)(Vt + (size_t)row * 256 + c * 8); }
    __syncthreads();
    unsigned koff[4], voff[16];
#pragma unroll
    for (int s2 = 0; s2 < 4; ++s2) { koff[s2] = (unsigned)(fr * 256 + (((4 * s2 + fq) ^ fr) << 4)); asm volatile("" : "+v"(koff[s2])); }
#pragma unroll
    for (int s2 = 0; s2 < 8; ++s2) { const int p0 = 8 * s2 + fq, p1 = p0 + 4;
        voff[2 * s2] = (unsigned)(65536 + fr * 512 + ((((p0 >> 1) ^ (2 * fr)) << 4) | ((p0 & 1) << 3))); voff[2 * s2 + 1] = (unsigned)(65536 + fr * 512 + ((((p1 >> 1) ^ (2 * fr)) << 4) | ((p1 & 1) << 3)));
        asm volatile("" : "+v"(voff[2 * s2]), "+v"(voff[2 * s2 + 1])); }
    const int nblk = smp ? (wave == 0 ? 1 : 0) : 4;
#pragma unroll 1
    for (int blk = 0; blk < nblk; ++blk) {
        const int r0 = smp ? MP + (b - 4) * 16 : b * SEQ + sub * 512 + blk * 128 + wave * 16;
        bf16x8 qf[4];
#pragma unroll
        for (int s = 0; s < 4; ++s) qf[s] = ld16(PROJ + (size_t)(r0 + fr) * ldp + cqm + h * 128 + 32 * s + 8 * fq);
        f32x4 st[16];
#pragma unroll
        for (int mt = 0; mt < 16; ++mt) { st[mt] = (f32x4){0.f, 0.f, 0.f, 0.f};
#pragma unroll
            for (int s = 0; s < 4; ++s) st[mt] = MFMA16(*(const LAS bf16x8*)(lds + koff[s] + mt * 4096), qf[s], st[mt]);
            if ((mt & 3) == 3) __builtin_amdgcn_sched_barrier(0); }
        float mx = -3.0e38f;
#pragma unroll
        for (int mt = 0; mt < 16; ++mt) mx = fmaxf(mx, fmaxf(fmaxf(st[mt][0], st[mt][1]), fmaxf(st[mt][2], st[mt][3])));
        mx = fmaxf(mx, shx(mx, lane, 16)); mx = fmaxf(mx, shx(mx, lane, 32));
        float sum = 0.f;
#pragma unroll
        for (int mt = 0; mt < 16; ++mt)
#pragma unroll
            for (int jj = 0; jj < 4; ++jj) { const float p = __expf((st[mt][jj] - mx) * HD_SCALE); st[mt][jj] = p; sum += p; }
        sum += shx(sum, lane, 16); sum += shx(sum, lane, 32);
        const float inv = 1.0f / sum;
        bf16x8 pf[8];
#pragma unroll
        for (int s = 0; s < 8; ++s) pf[s] = pack8(st[2 * s], st[2 * s + 1]);
#pragma unroll
        for (int dt = 0; dt < 8; ++dt) { f32x4 o = {0.f, 0.f, 0.f, 0.f};
#pragma unroll
            for (int s = 0; s < 8; ++s) { const s16x4 a = *(const LAS s16x4*)(lds + voff[2 * s] + dt * 8192), bb = *(const LAS s16x4*)(lds + voff[2 * s + 1] + dt * 8192);
                o = MFMA16(__builtin_shufflevector(a, bb, 0, 1, 2, 3, 4, 5, 6, 7), pf[s], o); }
            u32x2 w; w.x = cvt2(o[0] * inv, o[1] * inv); w.y = cvt2(o[2] * inv, o[3] * inv);
            *(u32x2*)(OCAT + (size_t)(r0 + fr) * D + 1536 + h * 128 + 16 * dt + 4 * fq) = w;
            if (dt & 1) __builtin_amdgcn_sched_barrier(0); }
    }
    __syncthreads();
}

__device__ __forceinline__ void sb_attn(int lane, LAS unsigned char* wlds, const bf16* Kp, int ldk, const bf16* VTp, int ldvt, const bf16* Qp, int ldq, bf16* Op, int t0, int nq) {
    const int r = lane & 31, hh = lane >> 5;
    LAS bf16x8* qs = (LAS bf16x8*)wlds + lane;
#pragma unroll
    for (int ks = 0; ks < 8; ++ks) qs[64 * ks] = ld16(Qp + (size_t)r * ldq + 16 * ks + 8 * hh);
    f32x16 oacc[4];
#pragma unroll
    for (int dt = 0; dt < 4; ++dt)
#pragma unroll
        for (int i = 0; i < 16; ++i) oacc[dt][i] = 0.f;
    float carry = 0.f;
    bf16x8 kf[8];
    { const bf16* kr = Kp + (size_t)(t0 + r) * ldk + 8 * hh;
#pragma unroll
      for (int ks = 0; ks < 8; ++ks) kf[ks] = ld16(kr + 16 * ks); }
    for (int s0 = t0; s0 >= 0; s0 -= 32) {
        bf16x8 vf[8];
#pragma unroll
        for (int k2 = 0; k2 < 2; ++k2)
#pragma unroll
            for (int dt = 0; dt < 4; ++dt) { const bf16* vr = VTp + (size_t)(32 * dt + r) * ldvt + s0 + 16 * k2 + 4 * hh; vf[4 * k2 + dt] = ld2x8(vr, vr + 8); }
        f32x16 st;
#pragma unroll
        for (int i = 0; i < 16; ++i) st[i] = 0.f;
#pragma unroll
        for (int ks = 0; ks < 8; ++ks) st = MFMA32(kf[ks], qs[64 * ks], st);
        { const int sn = s0 >= 32 ? s0 - 32 : 0; const bf16* kr = Kp + (size_t)(sn + r) * ldk + 8 * hh;
#pragma unroll
          for (int ks = 0; ks < 8; ++ks) kf[ks] = ld16(kr + 16 * ks); }
        const bool diag = (s0 == t0);
        float l1[16], lb[16];
#pragma unroll
        for (int i = 0; i < 16; ++i) { const float z = st[i] * HD_SCALE, sp = softplus_fast(z); lb[i] = z - sp; l1[i] = -sp;
            if (diag && !(((i & 3) + 8 * (i >> 2) + 4 * hh) < r)) { l1[i] = 0.f; lb[i] = -1.0e30f; } }
        float g[4], pgv[4];
#pragma unroll
        for (int m = 0; m < 4; ++m) { g[m] = (l1[4 * m] + l1[4 * m + 1]) + (l1[4 * m + 2] + l1[4 * m + 3]); pgv[m] = shx(g[m], lane, 32); }
        float R[4]; R[3] = 0.f; R[2] = g[3] + pgv[3]; R[1] = R[2] + g[2] + pgv[2]; R[0] = R[1] + g[1] + pgv[1];
        const float total = R[0] + g[0] + pgv[0];
#pragma unroll
        for (int m = 0; m < 4; ++m) { const float suf = carry + R[m] + (hh == 0 ? pgv[m] : 0.f);
            const float t3 = suf, t2 = t3 + l1[4 * m + 3], t1 = t2 + l1[4 * m + 2], t0_ = t1 + l1[4 * m + 1];
            lb[4 * m + 3] = __expf(lb[4 * m + 3] + t3); lb[4 * m + 2] = __expf(lb[4 * m + 2] + t2); lb[4 * m + 1] = __expf(lb[4 * m + 1] + t1); lb[4 * m] = __expf(lb[4 * m] + t0_); }
        carry += total;
#pragma unroll
        for (int k2 = 0; k2 < 2; ++k2) {
            v4u p; p.x = cvt2(lb[8 * k2], lb[8 * k2 + 1]); p.y = cvt2(lb[8 * k2 + 2], lb[8 * k2 + 3]); p.z = cvt2(lb[8 * k2 + 4], lb[8 * k2 + 5]); p.w = cvt2(lb[8 * k2 + 6], lb[8 * k2 + 7]);
            const bf16x8 wf = __builtin_bit_cast(bf16x8, p);
#pragma unroll
            for (int dt = 0; dt < 4; ++dt) oacc[dt] = MFMA32(vf[4 * k2 + dt], wf, oacc[dt]);
        }
        if (__all((r >= nq) || (carry < -104.f))) break;
    }
    if (r < nq) {
#pragma unroll
        for (int dt = 0; dt < 4; ++dt)
#pragma unroll
            for (int g4 = 0; g4 < 4; ++g4) { u32x2 wv; wv.x = cvt2(oacc[dt][4 * g4], oacc[dt][4 * g4 + 1]); wv.y = cvt2(oacc[dt][4 * g4 + 2], oacc[dt][4 * g4 + 3]);
                *(u32x2*)(Op + (size_t)r * D + 32 * dt + 8 * g4 + 4 * hh) = wv; }
    }
    asm volatile("s_waitcnt lgkmcnt(0)" ::: "memory");
}

struct SkBf16 { bf16* O; int ldc;
    __device__ __forceinline__ int brow(int unit, int nb) const { return 32 * unit + 16 * nb; }
    __device__ __forceinline__ void store(int unit, const f32x4 a0, const f32x4 a1, int m, int fq) const { bf16* p = O + (size_t)(MP + m) * ldc + 32 * unit + 4 * fq;
        u32x2 w; w.x = cvt2(a0[0], a0[1]); w.y = cvt2(a0[2], a0[3]); *(u32x2*)p = w; w.x = cvt2(a1[0], a1[1]); w.y = cvt2(a1[2], a1[3]); *(u32x2*)(p + 16) = w; } };
struct SkRes { float* Yp; const bf16* Xp; float alpha;
    __device__ __forceinline__ int brow(int unit, int nb) const { return 32 * unit + 16 * nb; }
    __device__ __forceinline__ void one(size_t o, const f32x4 a) const { const u32x2 xv = *(const u32x2*)(Xp + o);
        f32x4 r; r[0] = alpha * pg8::bflo(xv.x); r[1] = alpha * pg8::bfhi(xv.x); r[2] = alpha * pg8::bflo(xv.y); r[3] = alpha * pg8::bfhi(xv.y); *(f32x4*)(Yp + o) = r + a; }
    __device__ __forceinline__ void store(int unit, const f32x4 a0, const f32x4 a1, int m, int fq) const { const size_t o = (size_t)(MP + m) * D + 32 * unit + 4 * fq; one(o, a0); one(o + 16, a1); } };
struct SkKV { float *oks, *ovs; bf16 *ksb, *vsb;
    __device__ __forceinline__ int brow(int unit, int nb) const { return 32 * unit + 16 * nb; }
    __device__ __forceinline__ void one(int col, const f32x4 a, int m) const { const bool isv = col >= 1536; const int c = col - (isv ? 1536 : 0), b = m >> 4, t = m & 15;
        *(f32x4*)((isv ? ovs : oks) + (size_t)m * 1536 + c) = a; const unsigned w0 = cvt2(a[0], a[1]), w1 = cvt2(a[2], a[3]);
        if (!isv) { u32x2 w; w.x = w0; w.y = w1; *(u32x2*)(ksb + (size_t)(b * 2064 + 2048 + t) * 1536 + c) = w; }
        else { bf16* vt = vsb + (size_t)(b * 1536 + c) * 2080 + 2048 + t; vt[0] = (bf16)w0; vt[2080] = (bf16)(w0 >> 16); vt[4160] = (bf16)w1; vt[6240] = (bf16)(w1 >> 16); } }
    __device__ __forceinline__ void store(int unit, const f32x4 a0, const f32x4 a1, int m, int fq) const { one(32 * unit + 4 * fq, a0, m); one(32 * unit + 16 + 4 * fq, a1, m); } };
struct SkSwiGLU { bf16* Hb;
    __device__ __forceinline__ int brow(int unit, int nb) const { const int c0 = 16 * unit; return (c0 >> 7) * 256 + (c0 & 127) + 128 * nb; }
    __device__ __forceinline__ void store(int unit, const f32x4 g, const f32x4 u, int m, int fq) const { float hv[4];
#pragma unroll
        for (int j = 0; j < 4; ++j) hv[j] = g[j] * __builtin_amdgcn_rcpf(1.0f + __expf(-g[j])) * u[j];
        u32x2 w; w.x = cvt2(hv[0], hv[1]); w.y = cvt2(hv[2], hv[3]); *(u32x2*)(Hb + (size_t)(MP + m) * DFF + 16 * unit + 4 * fq) = w; } };
template <class Epi>
__device__ __forceinline__ void skinny_gemm(int bid, int G, int tid, int wave, LAS unsigned char* lds, const bf16* A, int lda, const bf16* Bt, int K, int nunits, const Epi& E) {
    const int lane = tid & 63, fr = lane & 15, fq = lane >> 4, kw = K >> 3, nst = kw >> 5;
    const bf16* ap = A + (size_t)fr * lda + wave * kw + 8 * fq;
    LAS f32x4* red = (LAS f32x4*)lds;
    for (int unit = bid; unit < nunits; unit += G) {
        const bf16* bp0 = Bt + (size_t)(E.brow(unit, 0) + fr) * K + wave * kw + 8 * fq; const bf16* bp1 = Bt + (size_t)(E.brow(unit, 1) + fr) * K + wave * kw + 8 * fq;
        f32x4 acc[2][8];
#pragma unroll
        for (int nb = 0; nb < 2; ++nb)
#pragma unroll
            for (int rt = 0; rt < 8; ++rt) acc[nb][rt] = (f32x4){0.f, 0.f, 0.f, 0.f};
        bf16x8 a0[8], a1[8], b0[2], b1[2];
#define SK_LOAD(af, bfr, st) do { _Pragma("unroll") for (int rt = 0; rt < 8; ++rt) af[rt] = ld16(ap + (size_t)(16 * rt) * lda + 32 * (st)); bfr[0] = ld16(bp0 + 32 * (st)); bfr[1] = ld16(bp1 + 32 * (st)); } while (0)
#define SK_MMA(af, bfr) do { _Pragma("unroll") for (int rt = 0; rt < 8; ++rt) { acc[0][rt] = MFMA16(bfr[0], af[rt], acc[0][rt]); acc[1][rt] = MFMA16(bfr[1], af[rt], acc[1][rt]); } } while (0)
        SK_LOAD(a0, b0, 0);
#pragma unroll 1
        for (int st = 0; st < nst; st += 2) {
            if (st + 1 < nst) SK_LOAD(a1, b1, st + 1);
            __builtin_amdgcn_sched_barrier(0);
            SK_MMA(a0, b0);
            __builtin_amdgcn_sched_barrier(0);
            if (st + 2 < nst) SK_LOAD(a0, b0, st + 2);
            __builtin_amdgcn_sched_barrier(0);
            if (st + 1 < nst) SK_MMA(a1, b1);
            __builtin_amdgcn_sched_barrier(0);
        }
#undef SK_LOAD
#undef SK_MMA
#pragma unroll
        for (int nb = 0; nb < 2; ++nb)
#pragma unroll
            for (int rt = 0; rt < 8; ++rt) red[((wave * 2 + nb) * 8 + rt) * 64 + lane] = acc[nb][rt];
        __syncthreads();
        f32x4 s0 = {0.f, 0.f, 0.f, 0.f}, s1 = {0.f, 0.f, 0.f, 0.f};
#pragma unroll
        for (int ws = 0; ws < 8; ++ws) { s0 = s0 + red[((ws * 2 + 0) * 8 + wave) * 64 + lane]; s1 = s1 + red[((ws * 2 + 1) * 8 + wave) * 64 + lane]; }
        E.store(unit, s0, s1, 16 * wave + fr, fq);
        __syncthreads();
    }
}
#ifndef PH_MASK
#define PH_MASK 0xFFFF
#endif
__global__ void __launch_bounds__(NWAVES * 64, 2) mega(Args args) {
    extern __shared__ __attribute__((aligned(16))) unsigned char lds[];
    Frame F;
    F.lds = (LAS unsigned char*)lds; F.MISC = (volatile LAS unsigned*)(F.lds + MISC_OFF);
    F.tid = threadIdx.x; F.lane = F.tid & 63; F.wave = __builtin_amdgcn_readfirstlane(F.tid >> 6);
    F.G = gridDim.x; F.gw = blockIdx.x * NWAVES + F.wave; F.NGW = F.G * NWAVES;
    F.ctl = (gu32*)(args.ws_ + WS_CTL);
    for (int u = F.tid; u < (LDS_BYTES - LDSCTL_OFF) / 4; u += NWAVES * 64) ((LAS unsigned*)(F.lds + LDSCTL_OFF))[u] = 0u;
    __syncthreads();
    XcdBarrier bar = xcd_barrier_post((unsigned*)(F.ctl + CW_BAR), F.MISC + 8);
    const int lo = args.ph_lo, hi = args.ph_hi; int ph = 0;
#define KARGS ((const __attribute__((address_space(4))) Args*)__builtin_amdgcn_kernarg_segment_ptr())
#define ws (ka->ws_)
#define out (ka->out_)
#define x_prompt (ka->in[0])
#define x_sample (ka->in[1])
#define mem_prompt (ka->in[2])
#define state_gla (ka->in[3])
#define cache_sb_k (ka->in[4])
#define cache_sb_v (ka->in[5])
#define cache_mem_k (ka->in[6])
#define cache_mem_v (ka->in[7])
#define w_in_a (ka->in[8])
#define w_gate_lr (ka->in[9])
#define b_gate (ka->in[10])
#define gla_norm_g (ka->in[11])
#define w_in_b (ka->in[12])
#define w_kv_shared (ka->in[13])
#define w_mem_kv (ka->in[14])
#define w_o (ka->in[15])
#define ln1_g (ka->in[16])
#define ln1_b (ka->in[17])
#define ln2_g (ka->in[18])
#define ln2_b (ka->in[19])
#define w_ffn_in (ka->in[20])
#define w_ffn_out (ka->in[21])
#define WIN ((bf16*)(ws + WS_WIN))
#define WO ((bf16*)(ws + WS_WO))
#define WFI ((bf16*)(ws + WS_WFI))
#define WFO ((bf16*)(ws + WS_WFO))
#define WMEM ((bf16*)(ws + WS_WMEM))
#define MEMX ((bf16*)(ws + WS_MEMX))
#define MEMK ((bf16*)(ws + WS_MEMK))
#define MEMV ((bf16*)(ws + WS_MEMV))
#define X ((bf16*)(ws + WS_X))
#define Y ((float*)(ws + WS_Y))
#define PROJ ((bf16*)(ws + WS_R1))
#define HB ((bf16*)(ws + WS_R1))
#define OCAT ((bf16*)(ws + WS_OCAT))
#define SBKS ((bf16*)(ws + WS_SBKS))
#define SBVS ((bf16*)(ws + WS_SBVS))
#define OINT (out + O_YP)
#define KPB ((bf16*)(out + O_YP))
#define VPB (KPB + (size_t)MP * 1536)

#define PHASE_BEGIN(cond, cls) if (cond) { if (lo <= ph && ph < hi) { if (ph > lo) xcd_barrier(bar); DIAG_STAMP(cls); for (int rep_ = 0; rep_ < (((cls) == REP_CLS) ? 2 : 1); ++rep_) { const __attribute__((address_space(4))) Args* ka = KARGS; asm volatile("" : "+s"(ka)); int z_ = 0, G_ = gridDim.x, bid_ = blockIdx.x, wave_ = F.wave; asm volatile("" : "+s"(z_), "+s"(G_), "+s"(bid_), "+s"(wave_)); const int lane = (int)__builtin_amdgcn_mbcnt_hi(~0u, __builtin_amdgcn_mbcnt_lo(~0u, (unsigned)z_)), tid = wave_ * 64 + lane, gw_ = bid_ * NWAVES + wave_, NGW_ = G_ * NWAVES;     (void)tid; (void)lane; (void)gw_; (void)NGW_;
#define PHASE_END } } ++ph; }
#ifndef REP_CLS
#define REP_CLS (-1)
#endif
#ifndef SK_REP
#define SK_REP 1
#endif
#if defined(DIAG_A)
#define DIAG_STAMP(cls) do { if (blockIdx.x == 0 && threadIdx.x == 0) { unsigned long long* dts = (unsigned long long*)(args.ws_ + 262144); dts[ph] = rt(); } } while (0)
#else
#define DIAG_STAMP(cls) do { } while (0)
#endif

    PHASE_BEGIN(true, 0)
        for (int r = gw_; r < MT; r += NGW_) cvt_row(r < MP ? x_prompt + (size_t)r * D : (r < MR ? x_sample + (size_t)(r - MP) * D : nullptr), X + (size_t)r * D, D, lane);
        for (int r = gw_; r < 1024; r += NGW_) cvt_row(mem_prompt + (size_t)r * D, MEMX + (size_t)r * D, D, lane);
        for (int r = gw_; r < 4 * 8 * 256; r += NGW_) { const int l = r >> 11, b = (r >> 8) & 7, m = r & 255; const size_t dst = (size_t)((l * 12 + 4 + b) * 256 + m) * 512;
            cvt_row(cache_mem_k + (size_t)r * 512, MEMK + dst, 512, lane); }
        for (int it = gw_; it < 512; it += NGW_) { const int hdb = it & 3, mb = (it >> 2) & 3, b = (it >> 4) & 7, l = it >> 7, m = mb * 64 + lane;
            const float* src = cache_mem_v + (size_t)((l * 8 + b) * 256 + m) * 512 + hdb * 128; bf16* dst = MEMV + (size_t)((l * 12 + 4 + b) * 512 + hdb * 128) * 256 + m;
            for (int q4 = 0; q4 < 32; ++q4) { const f32x4 v = *(const f32x4*)(src + 4 * q4);
#pragma unroll
                for (int e = 0; e < 4; ++e) dst[(size_t)(4 * q4 + e) * 256] = (bf16)f2bf(v[e]); } }
        for (int r = gw_; r < 8 * 2048; r += NGW_) { const int b = r >> 11, s = r & 2047; const size_t dst = (size_t)(b * 2064 + s) * 1536;
            cvt_row(cache_sb_k + (size_t)r * 1536, SBKS + dst, 1536, lane); }
        for (int it = gw_; it < 3072; it += NGW_) { const int cb = it % 12, sb_ = (it / 12) & 31, b = it / 384, s = sb_ * 64 + lane;
            const float* src = cache_sb_v + (size_t)(b * 2048 + s) * 1536 + cb * 128; bf16* dst = SBVS + (size_t)(b * 1536 + cb * 128) * 2080 + s;
            for (int q4 = 0; q4 < 32; ++q4) { const f32x4 v = *(const f32x4*)(src + 4 * q4);
#pragma unroll
                for (int e = 0; e < 4; ++e) dst[(size_t)(4 * q4 + e) * 2080] = (bf16)f2bf(v[e]); } }
        for (int l = 0; l < 4; ++l) wt_convert(F.lds, wave_, gw_, NGW_, lane, w_mem_kv + (size_t)l * D * 1024, D, 1024, WMEM + (size_t)l * 1024 * D, 1024, MapId());
    PHASE_END
    PHASE_BEGIN(true, 0)
        pg8::Gemm g{MEMX, WMEM, 1024, 4096, D}; pg8::StaticOrder S; S.init(1024, 4096, G_, bid_);
        pg8::EpiMemKV E{out + O_MKP, out + O_MVP, MEMK, MEMV};
        pg8::gemm_phase<pg8::EpiMemKV, pg8::StaticOrder, true, true>(F.lds + RING_OFF, g, S, E, tid);
    PHASE_END

    for (int l = 0; l < 4; ++l) {
        const bool LA = l < 2;
        PHASE_BEGIN(true, 1)
            if (LA) wt_convert(F.lds, wave_, gw_, NGW_, lane, w_in_a + (size_t)l * D * 5136, D, 5136, WIN, NA, MapInA());
            else { wt_convert(F.lds, wave_, gw_, NGW_, lane, w_in_b + (size_t)(l - 2) * D * NBQ, D, NBQ, WIN, NBQ, MapId()); if (l == 2) wt_convert(F.lds, wave_, gw_, NGW_, lane, w_kv_shared, D, NKV, WIN + (size_t)NBQ * D, NKV, MapId()); }
            wt_convert(F.lds, wave_, gw_, NGW_, lane, w_o + (size_t)l * D * D, D, D, WO, D, MapId());
            wt_convert(F.lds, wave_, gw_, NGW_, lane, w_ffn_in + (size_t)l * D * 2 * DFF, D, 2 * DFF, WFI, 2 * DFF, MapFfn());
            wt_convert(F.lds, wave_, gw_, NGW_, lane, w_ffn_out + (size_t)l * DFF * D, DFF, D, WFO, D, MapId());
        PHASE_END
        const int ldp = LA ? NA : NBQ;
        PHASE_BEGIN(true, 2)
            { pg8::Gemm g{X, WIN, MP, ldp, D}; pg8::StaticOrder S; S.init(MP, ldp, G_, bid_); pg8::EpiBf16 E{PROJ, ldp};
              pg8::gemm_phase<pg8::EpiBf16, pg8::StaticOrder, true, true>(F.lds + RING_OFF, g, S, E, tid); }
            if (l == 2) { pg8::Gemm g{X, WIN + (size_t)NBQ * D, MP, NKV, D}; pg8::StaticOrder S; S.init(MP, NKV, G_, bid_);
              pg8::EpiKV E{out + O_SKP, out + O_SVP, out + O_SKS, out + O_SVS, KPB, VPB, SBKS, SBVS};
              pg8::gemm_phase<pg8::EpiKV, pg8::StaticOrder, true, true>(F.lds + RING_OFF, g, S, E, tid); }
            for (int skr = 0; skr < SK_REP; ++skr) { SkBf16 E{PROJ, ldp}; skinny_gemm(bid_, G_, tid, wave_, F.lds + RING_OFF, X + (size_t)MP * D, D, WIN, D, ldp / 32, E); }
            for (int skr = 0; skr < SK_REP; ++skr) if (l == 2) { SkKV E{out + O_SKS, out + O_SVS, SBKS, SBVS}; skinny_gemm(bid_, G_, tid, wave_, F.lds + RING_OFF, X + (size_t)MP * D, D, WIN + (size_t)NBQ * D, D, NKV / 32, E); }
        PHASE_END
        PHASE_BEGIN(LA, 3)
            gla_prep(bid_, G_, tid, wave_, F.lds + RING_OFF, l, PROJ, w_gate_lr, b_gate, (unsigned char*)Y);
        PHASE_END
        PHASE_BEGIN(true, (LA ? 4 : 11))
            if (LA) {
                for (int item = bid_; item < N_PKG; item += G_) gla_intra(item, tid, wave_, F.lds + RING_OFF, (const unsigned char*)Y, OINT);
            } else {
                for (int u = gw_; u < 12288 + 96; u += NGW_) {
                    if (u < 12288) { const int bh = u >> 8, qb = u & 255, b = bh / 12, h = bh % 12, t0 = 32 * qb; const size_t qo = (size_t)(b * SEQ + t0) * D + h * 128;
                        sb_attn(lane, F.lds + RING_OFF + wave_ * 16384, KPB + (size_t)(b * SEQ) * 1536 + h * 128, 1536, VPB + (size_t)(bh * 128) * SEQ, SEQ, PROJ + qo, NBQ, OCAT + qo, t0, 32); }
                    else { const int u2 = u - 12288, b = u2 / 12, h = u2 % 12; const size_t qo = (size_t)(MP + b * 16) * D + h * 128;
                        sb_attn(lane, F.lds + RING_OFF + wave_ * 16384, SBKS + (size_t)(b * 2064) * 1536 + h * 128, 1536, SBVS + (size_t)(u2 * 128) * 2080, 2080, PROJ + qo, NBQ, OCAT + qo, 2048, 16); }
                }
            }
            __syncthreads();
            for (int wi = bid_; wi < 256 + 32; wi += G_) mem_attn_wg(wi, tid, wave_, F.lds + RING_OFF, l, PROJ, ldp, LA ? CQM : 1536, MEMK, MEMV, OCAT);
        PHASE_END
        PHASE_BEGIN(LA, 12)
            for (int wc = bid_; wc < 144; wc += G_) gla_chain<1>(wc, tid, wave_, F.lds + RING_OFF, l, (const unsigned char*)Y, state_gla, OINT, out, (float*)WMEM, (float*)MEMX);
        PHASE_END
        PHASE_BEGIN(LA, 5)
            for (int wc = bid_; wc < 192 + 96; wc += G_) gla_chain<2>(wc, tid, wave_, F.lds + RING_OFF, l, (const unsigned char*)Y, state_gla, OINT, out, (float*)WMEM, (float*)MEMX, REP_CLS == 5 && rep_ == 0);
        PHASE_END
        PHASE_BEGIN(LA, 6)
            const float* gn = gla_norm_g + (size_t)l * 384;
            for (int row = gw_; row < MR; row += NGW_) {
#pragma unroll
                for (int h = 0; h < 4; ++h) { bf16* op = OCAT + (size_t)row * D + h * 384; const bf16* gp = PROJ + (size_t)row * NA + CG + h * 384;
                    float ov[6]; float ss = 0.f;
#pragma unroll
                    for (int j = 0; j < 3; ++j) { const f32x2_t w = *(const f32x2_t*)(OINT + (size_t)row * 1536 + h * 384 + 2 * lane + 128 * j); ov[2 * j] = w.x; ov[2 * j + 1] = w.y; ss += ov[2 * j] * ov[2 * j] + ov[2 * j + 1] * ov[2 * j + 1]; }
                    const float r = 1.0f / sqrtf(wave_sum(ss, lane) * (1.0f / 384.0f) + RMS_EPS);
#pragma unroll
                    for (int j = 0; j < 3; ++j) { const int c = 2 * lane + 128 * j; const unsigned gw2 = *(const unsigned*)(gp + c); const float g0 = pg8::bflo(gw2), g1 = pg8::bfhi(gw2);
                        const float r0 = ov[2 * j] * r * gn[c] * (g0 / (1.0f + __expf(-g0))), r1 = ov[2 * j + 1] * r * gn[c + 1] * (g1 / (1.0f + __expf(-g1)));
                        *(unsigned*)(op + c) = pk2(r0, r1); } }
            }
        PHASE_END
        PHASE_BEGIN(true, 7)
            pg8::Gemm g{OCAT, WO, MP, D, D}; pg8::StaticOrder S; S.init(MP, D, G_, bid_); pg8::EpiRes E{Y, X, D, DN_ALPHA};
            pg8::gemm_phase<pg8::EpiRes, pg8::StaticOrder, true, true>(F.lds + RING_OFF, g, S, E, tid);
            for (int skr = 0; skr < SK_REP; ++skr) { SkRes Es{Y, X, DN_ALPHA}; skinny_gemm(bid_, G_, tid, wave_, F.lds + RING_OFF, OCAT + (size_t)MP * D, D, WO, D, D / 32, Es); }
        PHASE_END
        PHASE_BEGIN(true, 8)
            const float* gg = ln1_g + (size_t)l * D; const float* bb = ln1_b + (size_t)l * D;
            for (int row = gw_; row < MR; row += NGW_) {
                const f32x4* yr = (const f32x4*)(Y + (size_t)row * D) + lane; f32x4 v[8]; float s = 0.f;
#pragma unroll
                for (int j = 0; j < 8; ++j) { v[j] = yr[64 * j]; s += (v[j].x + v[j].y) + (v[j].z + v[j].w); }
                const float mean = wave_sum(s, lane) * (1.f / D); float s2 = 0.f;
#pragma unroll
                for (int j = 0; j < 8; ++j) { v[j] = v[j] - mean; s2 += (v[j].x * v[j].x + v[j].y * v[j].y) + (v[j].z * v[j].z + v[j].w * v[j].w); }
                const float rstd = 1.f / sqrtf(wave_sum(s2, lane) * (1.f / D) + LN_EPS);
                unsigned long long* o8 = (unsigned long long*)(X + (size_t)row * D) + lane;
#pragma unroll
                for (int j = 0; j < 8; ++j) { const f32x4 g4 = *((const f32x4*)gg + lane + 64 * j), b4 = *((const f32x4*)bb + lane + 64 * j); const f32x4 r = v[j] * rstd * g4 + b4;
                    o8[64 * j] = (unsigned long long)pk2(r.x, r.y) | ((unsigned long long)pk2(r.z, r.w) << 32); }
            }
        PHASE_END
        PHASE_BEGIN(true, 9)
            pg8::Gemm g{X, WFI, MP, 2 * DFF, D}; pg8::StaticOrder S; S.init(MP, 2 * DFF, G_, bid_); pg8::EpiSwiGLU E{HB, DFF};
            pg8::gemm_phase<pg8::EpiSwiGLU, pg8::StaticOrder, true, true>(F.lds + RING_OFF, g, S, E, tid);
            for (int skr = 0; skr < SK_REP; ++skr) { SkSwiGLU Es{HB}; skinny_gemm(bid_, G_, tid, wave_, F.lds + RING_OFF, X + (size_t)MP * D, D, WFI, D, DFF / 16, Es); }
        PHASE_END
        PHASE_BEGIN(true, 10)
            pg8::Gemm g{HB, WFO, MP, D, DFF}; pg8::StaticOrder S; S.init(MP, D, G_, bid_); pg8::EpiRes E{Y, X, D, DN_ALPHA};
            pg8::gemm_phase<pg8::EpiRes, pg8::StaticOrder, true, true>(F.lds + RING_OFF, g, S, E, tid);
            for (int skr = 0; skr < SK_REP; ++skr) { SkRes Es{Y, X, DN_ALPHA}; skinny_gemm(bid_, G_, tid, wave_, F.lds + RING_OFF, HB + (size_t)MP * DFF, DFF, WFO, DFF, D / 32, Es); }
        PHASE_END
        PHASE_BEGIN(true, 8)
            const float* gg = ln2_g + (size_t)l * D; const float* bb = ln2_b + (size_t)l * D;
            for (int row = gw_; row < MR; row += NGW_) {
                const f32x4* yr = (const f32x4*)(Y + (size_t)row * D) + lane; f32x4 v[8]; float s = 0.f;
#pragma unroll
                for (int j = 0; j < 8; ++j) { v[j] = yr[64 * j]; s += (v[j].x + v[j].y) + (v[j].z + v[j].w); }
                const float mean = wave_sum(s, lane) * (1.f / D); float s2 = 0.f;
#pragma unroll
                for (int j = 0; j < 8; ++j) { v[j] = v[j] - mean; s2 += (v[j].x * v[j].x + v[j].y * v[j].y) + (v[j].z * v[j].z + v[j].w * v[j].w); }
                const float rstd = 1.f / sqrtf(wave_sum(s2, lane) * (1.f / D) + LN_EPS);
                if (l == 3) { f32x4* of = (f32x4*)(row < MP ? out + O_YP + (size_t)row * D : out + O_YS + (size_t)(row - MP) * D) + lane;
#pragma unroll
                    for (int j = 0; j < 8; ++j) { const f32x4 g4 = *((const f32x4*)gg + lane + 64 * j), b4 = *((const f32x4*)bb + lane + 64 * j); of[64 * j] = v[j] * rstd * g4 + b4; } }
                else { unsigned long long* o8 = (unsigned long long*)(X + (size_t)row * D) + lane;
#pragma unroll
                    for (int j = 0; j < 8; ++j) { const f32x4 g4 = *((const f32x4*)gg + lane + 64 * j), b4 = *((const f32x4*)bb + lane + 64 * j); const f32x4 r = v[j] * rstd * g4 + b4;
                        o8[64 * j] = (unsigned long long)pk2(r.x, r.y) | ((unsigned long long)pk2(r.z, r.w) << 32); } }
            }
        PHASE_END
    }
#if defined(DIAG_A)
    if (blockIdx.x == 0 && threadIdx.x == 0) { unsigned long long* dts = (unsigned long long*)(args.ws_ + 262144); dts[ph] = rt(); dts[63] = (unsigned long long)ph; }
#endif
#undef ws
#undef out
#undef X
#undef Y
#undef PHASE_BEGIN
#undef PHASE_END
}

#if defined(DIAG_A)
__device__ const int diag_cls[40] = {0,0, 1,2,3,4,5,6,7,8,9,10,8, 1,2,3,4,5,6,7,8,9,10,8, 1,2,11,7,8,9,10,8, 1,2,11,7,8,9,10,8};
__global__ void diag_tail(float* o, const unsigned long long* dts) {
    __shared__ float dv[2];
    if (threadIdx.x == 0) { const int n = (int)dts[63]; unsigned long long sa = 0, sb = 0; for (int p = 0; p < n; ++p) { const unsigned long long d = dts[p + 1] - dts[p]; const int cl = diag_cls[p]; if (cl == DIAG_A) sa += d; if (cl == DIAG_B) sb += d; }
        dv[0] = (float)sa * 0.01f; dv[1] = (float)sb * 10.0f; }
    __syncthreads();
    for (int i = threadIdx.x; i < 262144; i += blockDim.x) o[O_YS + i] = dv[0];
    if (threadIdx.x == 0) o[O_YP] = dv[1];
}
#endif
#ifndef MK_PER_PHASE
#define MK_PER_PHASE 0
#endif
constexpr int N_PHASES = 2 + 2 * 12 + 2 * 8;
extern "C" void kernel_launch(void* const* d_in, const int* in_sizes, int n_in, void* d_out, int out_size, void* d_ws, size_t ws_size, hipStream_t stream) {
    static int grid = 0;
    if (grid == 0) {
        if (n_in != 22 || in_sizes[0] != MP * D || (size_t)out_size != O_END || ws_size < WS_END) { fprintf(stderr, "kernel_launch: unexpected shapes (n_in %d, in0 %d, out %d, ws %zu); nothing launched\n", n_in, n_in > 0 ? in_sizes[0] : -1, out_size, ws_size); grid = -1; return; }
        int dev = 0, cus = 0, per_cu = 0;
        if (hipGetDevice(&dev) != hipSuccess || hipDeviceGetAttribute(&cus, hipDeviceAttributeMultiprocessorCount, dev) != hipSuccess) { grid = -1; return; }
        if (hipFuncSetAttribute((const void*)mega, hipFuncAttributeMaxDynamicSharedMemorySize, LDS_BYTES) != hipSuccess) { fprintf(stderr, "kernel_launch: hipFuncSetAttribute failed\n"); grid = -1; return; }
        if (hipOccupancyMaxActiveBlocksPerMultiprocessor(&per_cu, (const void*)mega, NWAVES * 64, LDS_BYTES) != hipSuccess || per_cu < 1) fprintf(stderr, "kernel_launch: occupancy query reports %d\n", per_cu);
        (void)hipGetLastError();
        grid = cus;
    }
    if (grid < 0) return;
    if (hipMemsetAsync((char*)d_ws + WS_CTL, 0, CTL_ZERO_BYTES, stream) != hipSuccess) return;
    Args a{};
    for (int i = 0; i < 22; ++i) a.in[i] = (const float*)d_in[i];
    a.out_ = (float*)d_out; a.ws_ = (unsigned char*)d_ws;
#if MK_PER_PHASE
    for (int p = 0; p < N_PHASES; ++p) { a.ph_lo = p; a.ph_hi = p + 1; hipLaunchKernelGGL(mega, dim3(grid), dim3(NWAVES * 64), LDS_BYTES, stream, a); }
#else
    a.ph_lo = 0; a.ph_hi = N_PHASES; hipLaunchKernelGGL(mega, dim3(grid), dim3(NWAVES * 64), LDS_BYTES, stream, a);
#if defined(DIAG_A)
    hipLaunchKernelGGL(diag_tail, dim3(1), dim3(512), 0, stream, (float*)d_out, (const unsigned long long*)((unsigned char*)d_ws + 262144));
#endif
#endif
}
```

```cpp
#include <hip/hip_runtime.h>
#include <cstdio>
#include <cstdint>
namespace pg8 {
#define PG8_LAS __attribute__((address_space(3)))
typedef unsigned short bf16_t;
typedef short bf16x8 __attribute__((ext_vector_type(8)));
typedef float f32x4 __attribute__((ext_vector_type(4)));
typedef unsigned u32x4 __attribute__((ext_vector_type(4)));
constexpr int BM = 256, BK = 64, HALF = 128, HTB = HALF * BK * 2  , STAGE_BYTES = 8 * HTB, NXCD = 8, WGM = 8;

__host__ __device__ __forceinline__ int lds_byte(int r, int c) { const int st = (r >> 4) * 2 + (c >> 5), rr = r & 15, cc = c & 31, ob = rr * 64 + cc * 2; return st * 1024 + (ob ^ (((ob >> 9) & 1) << 5)); }
__host__ __device__ __forceinline__ void stage_rc(int b, int& R, int& C) { const int st = b / 1024, sb = b % 1024, swz = sb ^ (((sb >> 9) & 1) << 5); R = (st >> 1) * 16 + swz / 64; C = (st & 1) * 32 + (swz % 64) / 2; }
__host__ __device__ __forceinline__ int perm32(int rho) { const int n = rho >> 4, i = rho & 15; return 8 * (i >> 2) + 4 * n + (i & 3); }

struct Unit { int pm, pn; };
struct Gemm { const bf16_t* A; const bf16_t* Bt; int M, N, K; };

struct StaticOrder {
    int nM, nN, nwg, G, c;
    __host__ __device__ void init(int M, int N, int G_, int c_) { nM = M / BM; nN = N / BM; nwg = nM * nN; G = G_; c = c_; }
    __host__ __device__ bool next(int i, Unit& u) const {
        const long L = (long)i * G + c; if (L >= nwg) return false;
        int wgid = (int)L; { const int q = nwg / NXCD, r = nwg % NXCD, xcd = wgid % NXCD, off = wgid / NXCD; wgid = (xcd < r ? xcd * (q + 1) : r * (q + 1) + (xcd - r) * q) + off; }
        const int nig = WGM * nN, gid = wgid / nig, fm = gid * WGM, gsz = (nM - fm) < WGM ? (nM - fm) : WGM;
        u.pm = fm + ((wgid % nig) % gsz); u.pn = (wgid % nig) / gsz; return true;
    }
    __device__ __forceinline__ void a_ready(const Unit&) const {}
    __device__ __forceinline__ void done(const Unit&) const {}
};
__device__ __forceinline__ unsigned cvt_pk_bf16(float lo, float hi) { unsigned r; asm volatile("v_cvt_pk_bf16_f32 %0, %1, %2" : "=v"(r) : "v"(lo), "v"(hi)); return r; }
typedef float f32x2 __attribute__((ext_vector_type(2)));
typedef unsigned u32x2 __attribute__((ext_vector_type(2)));
__device__ __forceinline__ float bflo(unsigned w) { return __builtin_bit_cast(float, w << 16); }
__device__ __forceinline__ float bfhi(unsigned w) { return __builtin_bit_cast(float, w & 0xffff0000u); }
struct EpiBf16 {
    static constexpr bool PERM = true, AFTER_DRAIN = false;
    bf16_t* O; int ldc;
    __device__ __forceinline__ void operator()(const f32x4 (&acc)[2][2][4][2], const Unit& u, int wr, int wc, int fr, int fq) const {
        const int row0 = u.pm * BM + wr * 64 + fr, col0 = u.pn * BM + wc * 32 + 8 * fq;
#pragma unroll
        for (int ai = 0; ai < 2; ++ai)
#pragma unroll
            for (int m = 0; m < 4; ++m) { bf16_t* rowp = O + (size_t)(row0 + ai * HALF + m * 16) * ldc + col0;
#pragma unroll
                for (int bj = 0; bj < 2; ++bj) { const f32x4 v0 = acc[ai][bj][m][0], v1 = acc[ai][bj][m][1];
                    u32x4 w; w.x = cvt_pk_bf16(v0[0], v0[1]); w.y = cvt_pk_bf16(v0[2], v0[3]); w.z = cvt_pk_bf16(v1[0], v1[1]); w.w = cvt_pk_bf16(v1[2], v1[3]);
                    *(u32x4*)(rowp + bj * HALF) = w; } __builtin_amdgcn_sched_barrier(0); }
    }
};
struct EpiSwiGLU {
    static constexpr bool PERM = true, AFTER_DRAIN = false;
    bf16_t* Hh; int ldh;
    __device__ __forceinline__ float swi(float g, float up) const { return g * __builtin_amdgcn_rcpf(1.0f + __expf(-g)) * up; }
    __device__ __forceinline__ void operator()(const f32x4 (&acc)[2][2][4][2], const Unit& u, int wr, int wc, int fr, int fq) const {
        const int row0 = u.pm * BM + wr * 64 + fr, col0 = u.pn * HALF + wc * 32 + 8 * fq;
#pragma unroll
        for (int ai = 0; ai < 2; ++ai)
#pragma unroll
            for (int m = 0; m < 4; ++m) { bf16_t* rowp = Hh + (size_t)(row0 + ai * HALF + m * 16) * ldh + col0;
                const f32x4 g0 = acc[ai][0][m][0], g1 = acc[ai][0][m][1], u0 = acc[ai][1][m][0], u1 = acc[ai][1][m][1];
                u32x4 w; w.x = cvt_pk_bf16(swi(g0[0], u0[0]), swi(g0[1], u0[1])); w.y = cvt_pk_bf16(swi(g0[2], u0[2]), swi(g0[3], u0[3]));
                w.z = cvt_pk_bf16(swi(g1[0], u1[0]), swi(g1[1], u1[1])); w.w = cvt_pk_bf16(swi(g1[2], u1[2]), swi(g1[3], u1[3]));
                *(u32x4*)rowp = w; __builtin_amdgcn_sched_barrier(0); }
    }
};
struct EpiRes {
    static constexpr bool PERM = false, AFTER_DRAIN = false;
    bf16_t* Y; const bf16_t* X; int ldc; float alpha;
    __device__ __forceinline__ void operator()(const f32x4 (&acc)[2][2][4][2], const Unit& u, int wr, int wc, int fr, int fq) const {
        const int row0 = u.pm * BM + wr * 64 + fr, col0 = u.pn * BM + wc * 32 + 4 * fq;
#pragma unroll
        for (int ai = 0; ai < 2; ++ai)
#pragma unroll
            for (int m = 0; m < 4; ++m) { const size_t ro = (size_t)(row0 + ai * HALF + m * 16) * ldc + col0;
#pragma unroll
                for (int bj = 0; bj < 2; ++bj)
#pragma unroll
                    for (int n = 0; n < 2; ++n) { const size_t o = ro + bj * HALF + n * 16; const u32x2 xv = *(const u32x2*)(X + o);
                        f32x4 r; r[0] = alpha * bflo(xv.x); r[1] = alpha * bfhi(xv.x); r[2] = alpha * bflo(xv.y); r[3] = alpha * bfhi(xv.y);
                        r = r + acc[ai][bj][m][n]; u32x2 w; w.x = cvt_pk_bf16(r[0], r[1]); w.y = cvt_pk_bf16(r[2], r[3]); *(u32x2*)(Y + o) = w; } __builtin_amdgcn_sched_barrier(0); }
    }
};
struct EpiKV {
    static constexpr bool PERM = false, AFTER_DRAIN = false;
    float *okp, *ovp, *oks, *ovs; bf16_t *kpb, *vpb, *ksb, *vsb;
    __device__ __forceinline__ void operator()(const f32x4 (&acc)[2][2][4][2], const Unit& u, int wr, int wc, int fr, int fq) const {
        const bool isv = u.pn >= 6; const int colt = (u.pn - (isv ? 6 : 0)) * BM + wc * 32 + 4 * fq, row0 = u.pm * BM + wr * 64 + fr;
        float* op = isv ? ovp : okp;
#pragma unroll
        for (int ai = 0; ai < 2; ++ai)
#pragma unroll
            for (int m = 0; m < 4; ++m) { const int row = row0 + ai * HALF + m * 16; float* fd;
                if (row < 32768) { fd = op + (size_t)row * 1536; } else continue;
                const int bq = row >> 13, sq = row & 8191;
#pragma unroll
                for (int bj = 0; bj < 2; ++bj)
#pragma unroll
                    for (int n = 0; n < 2; ++n) { const int c = colt + bj * HALF + n * 16; const f32x4 v = acc[ai][bj][m][n];
                        *(f32x4*)(fd + c) = v; const unsigned w0 = cvt_pk_bf16(v[0], v[1]), w1 = cvt_pk_bf16(v[2], v[3]);
                        const int hq = c >> 7, dq = c & 127;
                        if (!isv) { u32x2 w; w.x = w0; w.y = w1; *(u32x2*)(kpb + ((size_t)(bq * 12 + hq) * 8192 + sq) * 128 + dq) = w; }
                        else { bf16_t* vt = vpb + ((size_t)(bq * 12 + hq) * 256 + (sq >> 5)) * 4096 + dq * 32 + (sq & 31); vt[0] = (bf16_t)w0; vt[32] = (bf16_t)(w0 >> 16); vt[64] = (bf16_t)w1; vt[96] = (bf16_t)(w1 >> 16); } } }
    }
};
struct EpiMemKV {
    static constexpr bool PERM = false, AFTER_DRAIN = false;
    float *ok, *ov; bf16_t *kb, *vb;
    __device__ __forceinline__ void operator()(const f32x4 (&acc)[2][2][4][2], const Unit& u, int wr, int wc, int fr, int fq) const {
        const int l = u.pn >> 2, kv = (u.pn >> 1) & 1, hd0 = (u.pn & 1) * BM + wc * 32 + 4 * fq, row0 = u.pm * BM + wr * 64 + fr;
        float* fo = kv ? ov : ok; bf16_t* bo = kv ? vb : kb;
#pragma unroll
        for (int ai = 0; ai < 2; ++ai)
#pragma unroll
            for (int m = 0; m < 4; ++m) { const int row = row0 + ai * HALF + m * 16, b = row >> 8, mm = row & 255;
                float* fd = fo + (size_t)(l * 1024 + row) * 512; bf16_t* bd = bo + (size_t)((l * 12 + b) * 256 + mm) * 512;
#pragma unroll
                for (int bj = 0; bj < 2; ++bj)
#pragma unroll
                    for (int n = 0; n < 2; ++n) { const int c = hd0 + bj * HALF + n * 16; const f32x4 v = acc[ai][bj][m][n];
                        *(f32x4*)(fd + c) = v; const unsigned w0 = cvt_pk_bf16(v[0], v[1]), w1 = cvt_pk_bf16(v[2], v[3]);
                        if (!kv) { u32x2 w; w.x = w0; w.y = w1; *(u32x2*)(bd + c) = w; }
                        else { bf16_t* vt = vb + (size_t)((l * 12 + b) * 512 + c) * 256 + mm;
                            vt[0] = (bf16_t)w0; vt[256] = (bf16_t)(w0 >> 16); vt[512] = (bf16_t)w1; vt[768] = (bf16_t)(w1 >> 16); } } }
    }
};
template <class Epi, class Sched, bool ALIGN_EPI = false, bool SP2 = false>
__device__ __forceinline__ void gemm_phase(PG8_LAS unsigned char* lds, const Gemm g, const Sched& S, const Epi& E, int tid_in) {
    int tid_ = tid_in; asm volatile("" : "+v"(tid_));
    const int tid = tid_, wid = __builtin_amdgcn_readfirstlane(tid >> 6), lane = tid & 63, wr = wid >> 2, wc = wid & 3, fr = lane & 15, fq = lane >> 4;
    const int K = g.K, nt = K / BK;
    unsigned voffA[2], voffB[2];
#pragma unroll
    for (int i = 0; i < 2; ++i) { int R, C; stage_rc(tid * 16 + i * 8192, R, C); const int Rb = Epi::PERM ? ((R & ~31) + perm32(R & 31)) : R;
        voffA[i] = (unsigned)(R * K + C) * 2u; voffB[i] = (unsigned)(Rb * K + C) * 2u; }
    const size_t kstep = (size_t)(BK * 2);
    const size_t hstep = (size_t)HALF * K * 2;
    const size_t tstep = 2 * hstep;
    const unsigned ldsw = (unsigned)wid * 1024u;
    const int aoff = lds_byte(wr * 64 + fr, fq * 8), boff = lds_byte(wc * 32 + fr, fq * 8);
#define PG8_SA(b, h) (((b) * 2 + (h)) * HTB)
#define PG8_SB(b, h) ((4 + (b) * 2 + (h)) * HTB)
#define PG8_STAGE(bufoff, gbase, voff) do { _Pragma("unroll") for (int _i = 0; _i < 2; ++_i) \
        __builtin_amdgcn_global_load_lds((const unsigned*)((const char*)(gbase) + (voff)[_i]), (PG8_LAS unsigned*)(lds + (bufoff) + ldsw + _i * 8192), 16, 0, 0); } while (0)
#define PG8_LDA(dst, b, h) do { _Pragma("unroll") for (int m = 0; m < 4; ++m) _Pragma("unroll") for (int k = 0; k < 2; ++k) dst[m][k] = *(const PG8_LAS bf16x8*)(lds + PG8_SA(b, h) + aoff + m * 2048 + k * 1024); } while (0)
#define PG8_LDB(dst, b, h) do { _Pragma("unroll") for (int n = 0; n < 2; ++n) _Pragma("unroll") for (int k = 0; k < 2; ++k) dst[n][k] = *(const PG8_LAS bf16x8*)(lds + PG8_SB(b, h) + boff + n * 2048 + k * 1024); } while (0)
#define PG8_MMA(ai, bj, At, Bt) do { __builtin_amdgcn_s_setprio(1); _Pragma("unroll") for (int m = 0; m < 4; ++m) _Pragma("unroll") for (int n = 0; n < 2; ++n) _Pragma("unroll") for (int k = 0; k < 2; ++k) \
        acc[ai][bj][m][n] = __builtin_amdgcn_mfma_f32_16x16x32_bf16(Bt[n][k], At[m][k], acc[ai][bj][m][n], 0, 0, 0); __builtin_amdgcn_s_setprio(0); } while (0)
#define PG8_WAIT_V(n) asm volatile("s_waitcnt vmcnt(" #n ")" ::: "memory")
#define PG8_WAIT_L(n) asm volatile("s_waitcnt lgkmcnt(" #n ")" ::: "memory")
#define PG8_BAR __builtin_amdgcn_s_barrier()
#define PG8_SCHED __builtin_amdgcn_sched_barrier(0)
    Unit cur, nxt; int ui = 0;
    if (!S.next(0, cur)) return;
    f32x4 acc[2][2][4][2];
#pragma unroll
    for (int a = 0; a < 2; ++a)
#pragma unroll
        for (int b = 0; b < 2; ++b)
#pragma unroll
            for (int m = 0; m < 4; ++m)
#pragma unroll
                for (int n = 0; n < 2; ++n) acc[a][b][m][n] = (f32x4){0.f, 0.f, 0.f, 0.f};
    bf16x8 At[4][2], B0[2][2], B1[2][2];
    const char* cA = (const char*)g.A + (size_t)cur.pm * tstep; const char* cB = (const char*)g.Bt + (size_t)cur.pn * tstep;
    S.a_ready(cur);
    if constexpr (SP2) {
        PG8_STAGE(PG8_SB(0, 0), cB, voffB); PG8_STAGE(PG8_SB(0, 1), cB + hstep, voffB); PG8_STAGE(PG8_SA(0, 0), cA, voffA); PG8_STAGE(PG8_SA(0, 1), cA + hstep, voffA);
        if (wr == 1) PG8_BAR;
        PG8_WAIT_V(2); PG8_BAR;
        PG8_STAGE(PG8_SB(1, 0), cB + kstep, voffB); PG8_STAGE(PG8_SA(1, 0), cA + kstep, voffA); PG8_STAGE(PG8_SB(1, 1), cB + hstep + kstep, voffB);
        PG8_WAIT_V(6); PG8_BAR;
    } else {
        PG8_STAGE(PG8_SB(0, 0), cB, voffB); PG8_STAGE(PG8_SA(0, 0), cA, voffA); PG8_STAGE(PG8_SB(0, 1), cB + hstep, voffB); PG8_STAGE(PG8_SA(0, 1), cA + hstep, voffA);
        if (wr == 1) PG8_BAR;
        PG8_WAIT_V(4); PG8_BAR;
        PG8_STAGE(PG8_SB(1, 0), cB + kstep, voffB); PG8_STAGE(PG8_SA(1, 0), cA + kstep, voffA); PG8_STAGE(PG8_SB(1, 1), cB + hstep + kstep, voffB);
        PG8_WAIT_V(6); PG8_BAR;
    }
    for (;;) {
        const bool has_next = S.next(ui + 1, nxt);
        const char* nA = has_next ? (const char*)g.A + (size_t)nxt.pm * tstep : cA; const char* nB = has_next ? (const char*)g.Bt + (size_t)nxt.pn * tstep : cB;
        for (int t = 0; t < nt; t += 2) {
            const bool last = (t == nt - 2);
            const char* a1 = cA + (size_t)(t + 1) * kstep;
            const char* a2 = last ? nA : cA + (size_t)(t + 2) * kstep; const char* b2 = last ? nB : cB + (size_t)(t + 2) * kstep;
            const char* a3 = a2 + kstep; const char* b3 = b2 + kstep;
            if (last && has_next) S.a_ready(nxt);
            if constexpr (SP2) {
            PG8_LDB(B0, 0, 0); PG8_LDB(B1, 0, 1); PG8_SCHED; PG8_LDA(At, 0, 0); PG8_STAGE(PG8_SA(1, 1), a1 + hstep, voffA);
            PG8_WAIT_V(8); PG8_WAIT_L(0); PG8_BAR; PG8_MMA(0, 0, At, B0); PG8_MMA(0, 1, At, B1); PG8_BAR; PG8_SCHED;
            PG8_LDA(At, 0, 1); PG8_STAGE(PG8_SB(0, 0), b2, voffB); PG8_STAGE(PG8_SB(0, 1), b2 + hstep, voffB); PG8_STAGE(PG8_SA(0, 0), a2, voffA);
            PG8_WAIT_V(8); PG8_WAIT_L(0); PG8_BAR; PG8_MMA(1, 0, At, B0); PG8_MMA(1, 1, At, B1); PG8_BAR; PG8_SCHED;
            PG8_LDB(B0, 1, 0); PG8_LDB(B1, 1, 1); PG8_SCHED; PG8_LDA(At, 1, 0); PG8_STAGE(PG8_SA(0, 1), a2 + hstep, voffA);
            PG8_WAIT_V(8); PG8_WAIT_L(0); PG8_BAR; PG8_MMA(0, 0, At, B0); PG8_MMA(0, 1, At, B1); PG8_BAR; PG8_SCHED;
            PG8_LDA(At, 1, 1); PG8_STAGE(PG8_SB(1, 0), b3, voffB); PG8_STAGE(PG8_SB(1, 1), b3 + hstep, voffB); PG8_STAGE(PG8_SA(1, 0), a3, voffA);
            PG8_WAIT_V(8); PG8_WAIT_L(0); PG8_BAR; PG8_MMA(1, 0, At, B0); PG8_MMA(1, 1, At, B1); PG8_BAR; PG8_SCHED;
            } else {
            PG8_LDB(B0, 0, 0); PG8_SCHED; PG8_LDA(At, 0, 0); PG8_STAGE(PG8_SA(1, 1), a1 + hstep, voffA);
            PG8_WAIT_L(8); PG8_BAR; PG8_WAIT_L(0); PG8_MMA(0, 0, At, B0); PG8_BAR; PG8_SCHED;
            PG8_LDB(B1, 0, 1); PG8_STAGE(PG8_SB(0, 0), b2, voffB);
            PG8_BAR; PG8_WAIT_L(0); PG8_MMA(0, 1, At, B1); PG8_BAR;
            PG8_LDA(At, 0, 1); PG8_STAGE(PG8_SA(0, 0), a2, voffA);
            PG8_BAR; PG8_WAIT_L(0); PG8_MMA(1, 0, At, B0); PG8_BAR; PG8_SCHED;
            PG8_STAGE(PG8_SB(0, 1), b2 + hstep, voffB);
            PG8_WAIT_V(6); PG8_BAR; PG8_MMA(1, 1, At, B1); PG8_BAR;
            PG8_LDB(B0, 1, 0); PG8_SCHED; PG8_LDA(At, 1, 0); PG8_STAGE(PG8_SA(0, 1), a2 + hstep, voffA);
            PG8_WAIT_L(8); PG8_BAR; PG8_WAIT_L(0); PG8_MMA(0, 0, At, B0); PG8_BAR; PG8_SCHED;
            PG8_LDB(B1, 1, 1); PG8_STAGE(PG8_SB(1, 0), b3, voffB);
            PG8_BAR; PG8_WAIT_L(0); PG8_MMA(0, 1, At, B1); PG8_BAR;
            PG8_LDA(At, 1, 1); PG8_STAGE(PG8_SA(1, 0), a3, voffA);
            PG8_BAR; PG8_WAIT_L(0); PG8_MMA(1, 0, At, B0); PG8_BAR; PG8_SCHED;
            PG8_STAGE(PG8_SB(1, 1), b3 + hstep, voffB);
            PG8_WAIT_V(6); PG8_BAR; PG8_MMA(1, 1, At, B1); PG8_BAR;
            }
        }
        if constexpr (ALIGN_EPI) { if (wr == 0) PG8_BAR; }
        if constexpr (!Epi::AFTER_DRAIN) { E(acc, cur, wr, wc, fr, fq); S.done(cur); }
        if (!has_next) break;
#pragma unroll
        for (int a = 0; a < 2; ++a)
#pragma unroll
            for (int b = 0; b < 2; ++b)
#pragma unroll
                for (int m = 0; m < 4; ++m)
#pragma unroll
                    for (int n = 0; n < 2; ++n) acc[a][b][m][n] = (f32x4){0.f, 0.f, 0.f, 0.f};
        cur = nxt; cA = nA; cB = nB; ++ui;
        if constexpr (ALIGN_EPI) { if (wr == 1) PG8_BAR; }
    }
    PG8_WAIT_V(0);
    if constexpr (!ALIGN_EPI) { if (wr == 0) PG8_BAR; }
    PG8_BAR;
    if constexpr (Epi::AFTER_DRAIN) { E.fused(acc, cur, wr, wc, fr, fq, lds, wid, lane); S.done(cur); }
#undef PG8_SA
#undef PG8_SB
#undef PG8_STAGE
#undef PG8_LDA
#undef PG8_LDB
#undef PG8_MMA
#undef PG8_WAIT_V
#undef PG8_WAIT_L
#undef PG8_BAR
#undef PG8_SCHED
}
}
#define GAS __attribute__((address_space(1)))
#define LAS __attribute__((address_space(3)))
typedef unsigned short bf16;
typedef unsigned v4u __attribute__((ext_vector_type(4)));
typedef float f32x4 __attribute__((ext_vector_type(4)));
typedef short bf16x8 __attribute__((ext_vector_type(8)));
typedef GAS unsigned gu32;
typedef GAS unsigned long long gu64;
#define RLX_AGENT __ATOMIC_RELAXED, __HIP_MEMORY_SCOPE_AGENT
#define LDS_WAIT() asm volatile("s_waitcnt lgkmcnt(0)" ::: "memory")
#define VM_WAIT() asm volatile("s_waitcnt vmcnt(0)" ::: "memory")
__device__ __forceinline__ unsigned long long rt() { return __builtin_amdgcn_s_memrealtime(); }
__device__ __forceinline__ unsigned f2bf(float f) { unsigned u = __builtin_bit_cast(unsigned, f); return (u + 0x7fffu + ((u >> 16) & 1u)) >> 16; }
__device__ __forceinline__ unsigned pk2(float lo, float hi) { return f2bf(lo) | (f2bf(hi) << 16); }
#define XB_TMO      128
#define XB_XCNT(j)  (256  + 64 * (j))
#define XB_XSUB(j)  (1280 + 64 * (j))
#define XB_XGEN(j)  (2304 + 64 * (j))
#define XB_TOP      3328
#define XB_TOPGEN   3392
#define XCD_BAR_WORDS 3456
#define XB_SPIN_CAP (1u << 18)

__device__ __forceinline__ unsigned xb_ld(unsigned* p)              { return __hip_atomic_load(p, __ATOMIC_RELAXED, __HIP_MEMORY_SCOPE_AGENT); }
__device__ __forceinline__ unsigned xb_add(unsigned* p, unsigned v) { return __hip_atomic_fetch_add(p, v, __ATOMIC_RELAXED, __HIP_MEMORY_SCOPE_AGENT); }
__device__ __forceinline__ unsigned xb_xcc_id() { return (unsigned)__builtin_amdgcn_s_getreg((3 << 11) | 20) & 0xFu; }
#define XB_SPIN(cond, bar) do { unsigned _sp = 0; while (cond) { __builtin_amdgcn_s_sleep(1); \
    if ((++_sp & 255u) == 0u) { if (xb_ld(&(bar)[XB_TMO])) break; if (_sp > XB_SPIN_CAP) { atomicAdd(&(bar)[XB_TMO], 1u); break; } } } } while (0)

struct XcdBarrier {
    unsigned* bar; unsigned x;
    volatile LAS unsigned* st;
};

__device__ __forceinline__ XcdBarrier xcd_barrier_post(unsigned* bar, volatile LAS unsigned* st) {
    XcdBarrier b; b.bar = bar; b.x = xb_xcc_id(); b.st = st;
    if (threadIdx.x == 0) (void)xb_add(&bar[XB_XCNT(b.x)], 1u);
    return b;
}
__device__ __forceinline__ void xcd_barrier_complete(unsigned* bar, unsigned x, unsigned& nloc, unsigned& nx) {
    const unsigned G = gridDim.x * gridDim.y * gridDim.z;
    unsigned sum, cnt, mine, sp = 0u;
    for (;;) {
        sum = 0u; cnt = 0u; mine = 0u;
#pragma unroll
        for (unsigned j = 0; j < 16; ++j) { const unsigned c = xb_ld(&bar[XB_XCNT(j)]); sum += c; cnt += (c > 0u) ? 1u : 0u; mine = (j == x) ? c : mine; }
        if (sum == G) break;
        __builtin_amdgcn_s_sleep(1);
        if ((++sp & 255u) == 0u) { if (xb_ld(&bar[XB_TMO])) break; if (sp > XB_SPIN_CAP) { atomicAdd(&bar[XB_TMO], 1u); break; } }
    }
    nloc = mine > 0u ? mine : 1u; nx = cnt > 0u ? cnt : 1u;
}

__device__ __forceinline__ void xcd_barrier(const XcdBarrier& b) {
    asm volatile("s_waitcnt vmcnt(0)" ::: "memory");
    __syncthreads();
    if (threadIdx.x == 0) {
        unsigned* bar = b.bar;
        __builtin_amdgcn_s_waitcnt(0);
        unsigned nloc = b.st[0], nx = b.st[1];
        if (nloc == 0u) { xcd_barrier_complete(bar, b.x, nloc, nx); b.st[0] = nloc; b.st[1] = nx; }
        const unsigned old = xb_add(&bar[XB_XSUB(b.x)], 1u);
        const unsigned gen = old / nloc;
        if (old + 1u == (gen + 1u) * nloc) {
            __builtin_amdgcn_fence(__ATOMIC_RELEASE, "agent");
            asm volatile("s_waitcnt vmcnt(0)" ::: "memory");
            const unsigned og = xb_add(&bar[XB_TOP], 1u);
            const unsigned tg = og / nx;
            if (og + 1u == (tg + 1u) * nx) xb_add(&bar[XB_TOPGEN], 1u);
            else XB_SPIN(xb_ld(&bar[XB_TOPGEN]) == tg, bar);
            __builtin_amdgcn_fence(__ATOMIC_ACQUIRE, "agent");
            xb_add(&bar[XB_XGEN(b.x)], 1u);
            asm volatile("s_waitcnt vmcnt(0)" ::: "memory");
        } else {
            XB_SPIN(xb_ld(&bar[XB_XGEN(b.x)]) == gen, bar);
            __builtin_amdgcn_fence(__ATOMIC_ACQUIRE, "agent");
            asm volatile("s_waitcnt vmcnt(0)" ::: "memory");
        }
    }
    __syncthreads();
}
constexpr int NWAVES = 8;
constexpr int D = 2048, SEQ = 8192, MP = 32768, MS = 128, MR = 32896, MT = 33024;
constexpr int DFF = 5632, NA = 5376, NBQ = 2048, NKV = 3072;
constexpr int CQ = 0, CK = 768, CV = 1536, CG = 3072, CQM = 4608, CLR = 5120;
constexpr float DN_ALPHA = 1.6817928305074292f, LN_EPS = 1e-5f, RMS_EPS = 1e-6f;
constexpr float GLA_QSCALE = 0.07216878364870323f, HD_SCALE = 0.08838834764831845f;
constexpr size_t MiB = 1u << 20;
constexpr size_t WS_CTL = 0, CTL_ZERO_BYTES = 1 * MiB;
constexpr size_t WS_WIN = 1 * MiB, WS_WO = 22 * MiB, WS_WFI = 30 * MiB, WS_WFO = 74 * MiB, WS_WMEM = 96 * MiB, WS_MEMX = 112 * MiB, WS_MEMK = 116 * MiB, WS_MEMV = 128 * MiB;
constexpr size_t WS_X = 140 * MiB, WS_Y = 269 * MiB, WS_R1 = 527 * MiB, WS_OCAT = 882 * MiB, WS_SBKS = 1011 * MiB, WS_SBVS = 1060 * MiB, WS_END = 1109 * MiB;
static_assert(WS_WIN + (size_t)NA * D * 2 <= WS_WO && WS_WFI + (size_t)2 * DFF * D * 2 <= WS_WFO && WS_WFO + (size_t)D * DFF * 2 <= WS_WMEM, "weights map");
static_assert(WS_X + (size_t)MT * D * 2 <= WS_Y && WS_Y + (size_t)MT * D * 4 <= WS_R1 && WS_R1 + (size_t)MT * DFF * 2 <= WS_OCAT && WS_OCAT + (size_t)MT * D * 2 <= WS_SBKS, "activation map");
static_assert(WS_SBKS + (size_t)8 * 2064 * 1536 * 2 <= WS_SBVS && WS_SBVS + (size_t)8 * 2064 * 1536 * 2 <= WS_END, "sb sample map");
constexpr size_t O_YP = 0, O_YS = 67108864, O_GSP = 67371008, O_GSS = 69730304, O_SKP = 74448896, O_SVP = 124780544, O_SKS = 175112192, O_SVS = 175308800, O_MKP = 175505408, O_MVP = 177602560, O_END = 179699712;
constexpr int CW_BAR = 4096;
constexpr int RING_OFF = 0, RING_BYTES = 131072, LDSCTL_OFF = RING_BYTES, MISC_OFF = LDSCTL_OFF + 320, LDS_BYTES = 147456;

struct Args { const float* in[22]; float* out_; unsigned char* ws_; int ph_lo, ph_hi; };
struct Frame {
    LAS unsigned char* lds; volatile LAS unsigned* MISC; gu32* ctl;
    int tid, lane, wave, G, gw, NGW;
};
__device__ __forceinline__ float bf2f(bf16 h) { return __builtin_bit_cast(float, (unsigned)h << 16); }
__device__ __forceinline__ float shx(float v, int lane, int m) { return __builtin_bit_cast(float, __builtin_amdgcn_ds_bpermute((lane ^ m) << 2, __builtin_bit_cast(int, v))); }
__device__ __forceinline__ float wave_sum(float v, int lane) {
#pragma unroll
    for (int o = 1; o < 64; o <<= 1) v += shx(v, lane, o);
    return v;
}
__device__ __forceinline__ float wave_max(float v, int lane) {
#pragma unroll
    for (int o = 1; o < 64; o <<= 1) v = fmaxf(v, shx(v, lane, o));
    return v;
}
__device__ __forceinline__ void cvt_row(const float* src, bf16* dst, int n, int lane) {
    for (int j = lane * 4; j < n; j += 256) {
        f32x4 v = src ? *(const f32x4*)(src + j) : (f32x4){0.f, 0.f, 0.f, 0.f};
        unsigned long long w = (unsigned long long)pk2(v.x, v.y) | ((unsigned long long)pk2(v.z, v.w) << 32);
        *(unsigned long long*)(dst + j) = w;
    }
}
struct MapId { __device__ __forceinline__ int operator()(int n) const { return n; } };
struct MapInA { __device__ __forceinline__ int operator()(int n) const { return n < 4608 ? n : (n < 5120 ? n + 16 : (n < 5136 ? n - 512 : -1)); } };
struct MapFfn { __device__ __forceinline__ int operator()(int n) const { const int t = n >> 8, r = n & 255; return r < 128 ? 128 * t + r : DFF + 128 * t + (r - 128); } };
template <class Map>
__device__ __forceinline__ void wt_convert(LAS unsigned char* ldsb, int wave, int gw, int NGW, int lane, const float* W, int K, int Nsrc, bf16* WT, int Ndst, Map map) {
    LAS float* scr = (LAS float*)(ldsb + RING_OFF + wave * 16384);
    const int nblk = Ndst / 32, nitems = (K / 64) * nblk;
    for (int it = gw; it < nitems; it += NGW) {
        const int kb = it / nblk, nb = it % nblk, k0 = 64 * kb, n0 = 32 * nb;
        const int sc = map(n0 + (lane & 31));
#pragma unroll 8
        for (int i = 0; i < 32; ++i) { const int kk = 2 * i + (lane >> 5); scr[kk * 33 + (lane & 31)] = sc >= 0 ? W[(size_t)(k0 + kk) * Nsrc + sc] : 0.f; }
        LDS_WAIT(); asm volatile("" ::: "memory");
        const int c = lane & 7;
#pragma unroll
        for (int j = 0; j < 4; ++j) { const int n = (lane >> 3) + 8 * j; const LAS float* s = scr + (8 * c) * 33 + n;
            v4u o; o.x = pk2(s[0 * 33], s[1 * 33]); o.y = pk2(s[2 * 33], s[3 * 33]); o.z = pk2(s[4 * 33], s[5 * 33]); o.w = pk2(s[6 * 33], s[7 * 33]);
            *(GAS v4u*)(WT + (size_t)(n0 + n) * K + k0 + 8 * c) = o; }
        LDS_WAIT(); asm volatile("" ::: "memory");
    }
}
__device__ __forceinline__ float softplus_f(float z) { return fmaxf(z, 0.f) + log1pf(__expf(-fabsf(z))); }

typedef short s16x4 __attribute__((ext_vector_type(4)));
typedef pg8::u32x2 u32x2;
typedef float f32x16 __attribute__((ext_vector_type(16)));
typedef __bf16 bf16x2_t __attribute__((ext_vector_type(2)));
typedef float f32x2_t __attribute__((ext_vector_type(2)));
__device__ __forceinline__ unsigned cvt2(float lo, float hi) { const f32x2_t v = {lo, hi}; const bf16x2_t b = __builtin_convertvector(v, bf16x2_t); return __builtin_bit_cast(unsigned, b); }
__device__ __forceinline__ bf16x8 pack8(const f32x4 a, const f32x4 b) { v4u p; p.x = cvt2(a[0], a[1]); p.y = cvt2(a[2], a[3]); p.z = cvt2(b[0], b[1]); p.w = cvt2(b[2], b[3]); return __builtin_bit_cast(bf16x8, p); }
__device__ __forceinline__ bf16x8 ld2x8(const bf16* p0, const bf16* p1) { const s16x4 a = *(const s16x4*)p0, b = *(const s16x4*)p1; return __builtin_shufflevector(a, b, 0, 1, 2, 3, 4, 5, 6, 7); }
__device__ __forceinline__ bf16x8 ld16(const bf16* p) { return *(const bf16x8*)p; }
#define MFMA16(a, b, c) __builtin_amdgcn_mfma_f32_16x16x32_bf16((a), (b), (c), 0, 0, 0)
#define MFMA32(a, b, c) __builtin_amdgcn_mfma_f32_32x32x16_bf16((a), (b), (c), 0, 0, 0)

constexpr int QIMG_LD = 200, KTIMG_LD = 68, PKG_Q = 0, PKG_KT = 25600, PKG_G = 51712, IMG_BYTES = 52480, PKG_K = 52480, PKG_VT = 77056, PKG_BYTES = 126208, N_PKG = 2048 + 32;
static_assert(64 * QIMG_LD * 2 == PKG_KT && PKG_KT + 192 * KTIMG_LD * 2 == PKG_G && PKG_G + 768 == IMG_BYTES && PKG_K + 24576 == PKG_VT && PKG_VT + 49152 == PKG_BYTES && IMG_BYTES % 16 == 0, "package map");

__device__ __forceinline__ float softplus_fast(float z) { return fmaxf(z, 0.f) + __logf(1.0f + __expf(-fabsf(z))); }
__device__ __forceinline__ void gla_prep(int bid, int G, int tid, int wave, LAS unsigned char* lds, int l, const bf16* PROJ, const float* w_gate_lr, const float* b_gate, unsigned char* PKG) {
    const int lane = tid & 63;
    const float* w2 = w_gate_lr + (size_t)l * 16 * 768; const float* bg = b_gate + (size_t)l * 768;
    LAS float* tot = (LAS float*)lds;
    for (int item = bid; item < N_PKG; item += G) {
        int h, row0, T;
        if (item < 2048) { const int bh = item >> 7, ch = item & 127; h = bh & 3; row0 = (bh >> 2) * SEQ + ch * 64; T = 64; }
        else { const int i2 = item - 2048; h = i2 & 3; row0 = MP + (i2 >> 2) * 16; T = 16; }
        unsigned char* pk = PKG + (size_t)item * PKG_BYTES;
        bf16* Qt = (bf16*)(pk + PKG_Q); bf16* Kt = (bf16*)(pk + PKG_K); bf16* KT = (bf16*)(pk + PKG_KT); bf16* VT = (bf16*)(pk + PKG_VT); float* Gp = (float*)(pk + PKG_G);
        float w2c[3][16], bgc[3];
#pragma unroll
        for (int c = 0; c < 3; ++c) { const int d = h * 192 + lane + 64 * c; bgc[c] = bg[d];
#pragma unroll
            for (int r = 0; r < 16; ++r) w2c[c][r] = w2[r * 768 + d]; }
        v4u l0[8], l1[8];
#pragma unroll
        for (int tt = 0; tt < 8; ++tt) { const int t = 8 * wave + tt; const bf16* prow = PROJ + (size_t)(row0 + (t < T ? t : T - 1)) * NA;
            l0[tt] = *(const v4u*)(prow + CLR); l1[tt] = *(const v4u*)(prow + CLR + 8); }
        float lc[8][3]; float run[3] = {0.f, 0.f, 0.f};
#pragma unroll
        for (int tt = 0; tt < 8; ++tt) { const bool ok = 8 * wave + tt < T;
            float lr[16]; lr[0] = pg8::bflo(l0[tt].x); lr[1] = pg8::bfhi(l0[tt].x); lr[2] = pg8::bflo(l0[tt].y); lr[3] = pg8::bfhi(l0[tt].y); lr[4] = pg8::bflo(l0[tt].z); lr[5] = pg8::bfhi(l0[tt].z); lr[6] = pg8::bflo(l0[tt].w); lr[7] = pg8::bfhi(l0[tt].w);
            lr[8] = pg8::bflo(l1[tt].x); lr[9] = pg8::bfhi(l1[tt].x); lr[10] = pg8::bflo(l1[tt].y); lr[11] = pg8::bfhi(l1[tt].y); lr[12] = pg8::bflo(l1[tt].z); lr[13] = pg8::bfhi(l1[tt].z); lr[14] = pg8::bflo(l1[tt].w); lr[15] = pg8::bfhi(l1[tt].w);
#pragma unroll
            for (int c = 0; c < 3; ++c) { float xg = bgc[c];
#pragma unroll
                for (int r = 0; r < 16; ++r) xg += lr[r] * w2c[c][r];
                run[c] += ok ? -softplus_fast(-xg) * (1.0f / 16.0f) : 0.f; lc[tt][c] = run[c]; } }
#pragma unroll
        for (int c = 0; c < 3; ++c) tot[wave * 192 + lane + 64 * c] = run[c];
        unsigned qv[8][3], kv[8][3];
#pragma unroll
        for (int tt = 0; tt < 8; ++tt) { const int t = 8 * wave + tt; const bf16* prow = PROJ + (size_t)(row0 + (t < T ? t : T - 1)) * NA + h * 192 + lane;
#pragma unroll
            for (int c = 0; c < 3; ++c) { qv[tt][c] = prow[CQ + 64 * c]; kv[tt][c] = prow[CK + 64 * c]; } }
        __syncthreads();
        float pre[3], all[3];
#pragma unroll
        for (int c = 0; c < 3; ++c) { pre[c] = 0.f; all[c] = 0.f;
#pragma unroll
            for (int w = 0; w < 8; ++w) { const float tv = tot[w * 192 + lane + 64 * c]; all[c] += tv; if (w < wave) pre[c] += tv; } }
        unsigned ktw[3][4];
#pragma unroll
        for (int tt = 0; tt < 8; ++tt) { const int t = 8 * wave + tt; const bool ok = t < T;
#pragma unroll
            for (int c = 0; c < 3; ++c) { const int dl = lane + 64 * c; const float bc = pre[c] + lc[tt][c]; const float eq = __expf(bc), ek = __expf(-bc);
                const unsigned qb = ok ? f2bf(bf2f((bf16)qv[tt][c]) * GLA_QSCALE * eq) : 0u, kb = ok ? f2bf(bf2f((bf16)kv[tt][c]) * ek) : 0u;
                Qt[t * QIMG_LD + dl] = (bf16)qb; Kt[t * 192 + dl] = (bf16)kb;
                if (tt & 1) ktw[c][tt >> 1] |= kb << 16; else ktw[c][tt >> 1] = kb; } }
#pragma unroll
        for (int c = 0; c < 3; ++c) { bf16* kp = KT + (size_t)(lane + 64 * c) * KTIMG_LD + 8 * wave; u32x2 o0, o1; o0.x = ktw[c][0]; o0.y = ktw[c][1]; o1.x = ktw[c][2]; o1.y = ktw[c][3]; *(u32x2*)kp = o0; *(u32x2*)(kp + 4) = o1; }
        if (wave == 0) {
#pragma unroll
            for (int c = 0; c < 3; ++c) Gp[lane + 64 * c] = __expf(all[c]); }
        unsigned vv[6][8];
#pragma unroll
        for (int tt = 0; tt < 8; ++tt) { const int t = 8 * wave + tt; const bf16* prow = PROJ + (size_t)(row0 + (t < T ? t : T - 1)) * NA + CV + h * 384 + lane;
#pragma unroll
            for (int c2 = 0; c2 < 6; ++c2) vv[c2][tt] = t < T ? (unsigned)prow[64 * c2] : 0u; }
#pragma unroll
        for (int c2 = 0; c2 < 6; ++c2) { v4u o; o.x = vv[c2][0] | (vv[c2][1] << 16); o.y = vv[c2][2] | (vv[c2][3] << 16); o.z = vv[c2][4] | (vv[c2][5] << 16); o.w = vv[c2][6] | (vv[c2][7] << 16);
            *(v4u*)(VT + (size_t)(lane + 64 * c2) * 64 + 8 * wave) = o; }
        __syncthreads();
    }
}

__device__ __forceinline__ void gla_intra(int item, int tid, int wave, LAS unsigned char* lds, const unsigned char* PKG, float* OINT) {
    const int lane = tid & 63, fr = lane & 15, fq = lane >> 4;
    int h, row0, nvalid;
    if (item < 2048) { const int bh = item >> 7, ch = item & 127; h = bh & 3; row0 = (bh >> 2) * SEQ + ch * 64; nvalid = 64; }
    else { const int i2 = item - 2048; h = i2 & 3; row0 = MP + (i2 >> 2) * 16; nvalid = 16; }
    const unsigned char* pk = PKG + (size_t)item * PKG_BYTES;
    const bf16* Qt = (const bf16*)(pk + PKG_Q); const bf16* Kt = (const bf16*)(pk + PKG_K); const bf16* VT = (const bf16*)(pk + PKG_VT);
    bf16x8 va[3], vb[3];
#pragma unroll
    for (int k = 0; k < 3; ++k) { const bf16* vr = VT + (size_t)(16 * (3 * wave + k) + fr) * 64 + 4 * fq; va[k] = ld2x8(vr, vr + 16); vb[k] = ld2x8(vr + 32, vr + 48); }
    constexpr int P_LD = 68;
    LAS bf16* P = (LAS bf16*)lds;
#pragma unroll
    for (int rep = 0; rep < 2; ++rep) {
        const int tl = wave + 8 * rep;
        if (tl < 10) {
            const int it = tl < 1 ? 0 : (tl < 3 ? 1 : (tl < 6 ? 2 : 3)), jt = tl - (it * (it + 1)) / 2;
            f32x4 at = {0.f, 0.f, 0.f, 0.f};
            const bf16* qr = Qt + (size_t)(16 * it + fr) * QIMG_LD + 8 * fq; const bf16* kr = Kt + (size_t)(16 * jt + fr) * 192 + 8 * fq;
#pragma unroll
            for (int s = 0; s < 6; ++s) at = MFMA16(ld16(kr + 32 * s), ld16(qr + 32 * s), at);
            if (it == jt) {
#pragma unroll
                for (int jj = 0; jj < 4; ++jj) if (4 * fq + jj > fr) at[jj] = 0.f; }
            u32x2 w; w.x = cvt2(at[0], at[1]); w.y = cvt2(at[2], at[3]);
            *(LAS u32x2*)(P + (16 * it + fr) * P_LD + 16 * jt + 4 * fq) = w;
        } else if (tl == 10 || tl == 11) {
            const int it = tl == 10 ? 0 : 2, jt = tl == 10 ? 1 : 3; u32x2 z; z.x = 0u; z.y = 0u;
            *(LAS u32x2*)(P + (16 * it + fr) * P_LD + 16 * jt + 4 * fq) = z;
        }
    }
    __syncthreads();
#pragma unroll
    for (int it = 0; it < 4; ++it) {
        if (16 * it >= nvalid) break;
        const LAS bf16* pr = P + (16 * it + fr) * P_LD + 4 * fq;
        const s16x4 a0 = *(const LAS s16x4*)pr, a1 = *(const LAS s16x4*)(pr + 16);
        const bf16x8 pf0 = __builtin_shufflevector(a0, a1, 0, 1, 2, 3, 4, 5, 6, 7); bf16x8 pf1 = pf0;
        if (it >= 2) { const s16x4 b0 = *(const LAS s16x4*)(pr + 32), b1 = *(const LAS s16x4*)(pr + 48); pf1 = __builtin_shufflevector(b0, b1, 0, 1, 2, 3, 4, 5, 6, 7); }
#pragma unroll
        for (int k = 0; k < 3; ++k) { f32x4 o = {0.f, 0.f, 0.f, 0.f};
            o = MFMA16(va[k], pf0, o); if (it >= 2) o = MFMA16(vb[k], pf1, o);
            *(f32x4*)(OINT + (size_t)(row0 + 16 * it + fr) * 1536 + h * 384 + 16 * (3 * wave + k) + 4 * fq) = o; }
    }
    __syncthreads();
}

template <int PASS>
__device__ __forceinline__ void gla_chain(int wc, int tid, int wave, LAS unsigned char* lds, int l, const unsigned char* PKG, const float* state_gla, float* OINT, float* out, float* SLOC, float* GSEG, bool dry = false) {
    const int lane = tid & 63, fr = lane & 15, fq = lane >> 4;
    int h, vb, bh, seg, item0, nsteps, row0, nvalid; const float* s0 = nullptr; float* sout = nullptr;
    if (PASS == 1) { bh = wc / 9; const int rem = wc % 9; vb = rem / 3; seg = rem % 3; h = bh & 3; item0 = bh * 128 + 32 * seg; nsteps = 32; row0 = 0; nvalid = 64; }
    else if (wc < 192) { bh = wc / 12; const int rem = wc % 12; vb = rem >> 2; seg = rem & 3; h = bh & 3; item0 = bh * 128 + 32 * seg; nsteps = 32; row0 = (bh >> 2) * SEQ + 2048 * seg; nvalid = 64;
        if (seg == 3) sout = out + O_GSP + (size_t)(l * 16 + bh) * 192 * 384; }
    else { const int c2 = wc - 192; bh = c2 / 3; vb = c2 % 3; seg = 0; h = bh & 3; item0 = 2048 + bh; nsteps = 1; row0 = MP + (bh >> 2) * 16; nvalid = 16; s0 = state_gla + (size_t)(l * 32 + bh) * 192 * 384; sout = out + O_GSS + (size_t)(l * 32 + bh) * 192 * 384; }
    const int v0 = vb * 128 + wave * 16;
#define GLA_WALK(p, step) do { (p) += (step); asm volatile("" : "+v"(p)); } while (0)
    f32x4 S[12];
    if (s0) { const float* p = s0 + (size_t)(4 * fq) * 384 + v0 + fr;
#pragma unroll
        for (int t = 0; t < 12; ++t) {
#pragma unroll
            for (int jj = 0; jj < 4; ++jj) { S[t][jj] = *p; GLA_WALK(p, 384); }
            GLA_WALK(p, 12 * 384); } }
    else {
#pragma unroll
        for (int t = 0; t < 12; ++t) S[t] = (f32x4){0.f, 0.f, 0.f, 0.f}; }
    if (PASS == 2 && wc < 192) {
        for (int j = 0; j < seg; ++j) { const float* gs = GSEG + (size_t)(bh * 3 + j) * 192 + 4 * fq; const float* p = SLOC + (size_t)((bh * 3 + vb) * 3 + j) * 192 * 128 + (size_t)(4 * fq) * 128 + wave * 16 + fr;
#pragma unroll
            for (int t = 0; t < 12; ++t) { const f32x4 g4 = *(const f32x4*)(gs + 16 * t);
#pragma unroll
                for (int jj = 0; jj < 4; ++jj) { S[t][jj] = g4[jj] * S[t][jj] + *p; GLA_WALK(p, 128); }
                GLA_WALK(p, 12 * 128); } }
    }
    f32x4 GP[PASS == 1 ? 12 : 1];
    if (PASS == 1) {
#pragma unroll
        for (int t = 0; t < 12; ++t) GP[t] = (f32x4){1.f, 1.f, 1.f, 1.f}; }
    constexpr int CH0 = PASS == 1 ? PKG_KT / 16 : 0, NCH = IMG_BYTES / 16, NLD = PASS == 1 ? 4 : 7;
    v4u pre[NLD]; bf16x8 vt[2], vtn[2]; f32x4 oin[4];
    { const unsigned char* pk = PKG + (size_t)item0 * PKG_BYTES;
      if (PASS == 2) {
#pragma unroll
        for (int it = 0; it < 4; ++it) { const int tl = 16 * it + fr; oin[it] = tl < nvalid ? *(const f32x4*)(OINT + (size_t)(row0 + tl) * 1536 + h * 384 + v0 + 4 * fq) : (f32x4){0.f, 0.f, 0.f, 0.f}; } }
#pragma unroll
      for (int k = 0; k < NLD; ++k) { const int ch = CH0 + tid + 512 * k; if (ch < NCH) pre[k] = *(const v4u*)(pk + (size_t)ch * 16); }
      const bf16* VT = (const bf16*)(pk + PKG_VT) + (size_t)(v0 + fr) * 64 + 4 * fq; vt[0] = ld2x8(VT, VT + 16); vt[1] = ld2x8(VT + 32, VT + 48);
#pragma unroll
      for (int k = 0; k < NLD; ++k) { const int ch = CH0 + tid + 512 * k; if (ch < NCH) *(LAS v4u*)(lds + (size_t)ch * 16) = pre[k]; }
      vtn[0] = vt[0]; vtn[1] = vt[1]; }
    __syncthreads();
    for (int n = 0; n < nsteps; ++n) {
        const LAS unsigned char* img = lds + (n & 1) * IMG_BYTES;
        const bool more = n + 1 < nsteps;
        if (more) { const unsigned char* pk = PKG + (size_t)(item0 + n + 1) * PKG_BYTES;
#pragma unroll
            for (int k = 0; k < NLD; ++k) { const int ch = CH0 + tid + 512 * k; if (ch < NCH) pre[k] = *(const v4u*)(pk + (size_t)ch * 16); }
            const bf16* VT = (const bf16*)(pk + PKG_VT) + (size_t)(v0 + fr) * 64 + 4 * fq; vtn[0] = ld2x8(VT, VT + 16); vtn[1] = ld2x8(VT + 32, VT + 48); }
        if (PASS == 2) {
            bf16x8 Sb[6];
#pragma unroll
            for (int s = 0; s < 6; ++s) Sb[s] = pack8(S[2 * s], S[2 * s + 1]);
#pragma unroll
            for (int it = 0; it < 4; ++it) {
                const LAS bf16* qr = (const LAS bf16*)(img + PKG_Q) + (16 * it + fr) * QIMG_LD + 4 * fq;
                f32x4 o = oin[it];
#pragma unroll
                for (int s = 0; s < 6; ++s) { const s16x4 a = *(const LAS s16x4*)(qr + 32 * s), b = *(const LAS s16x4*)(qr + 32 * s + 16);
                    o = MFMA16(Sb[s], __builtin_shufflevector(a, b, 0, 1, 2, 3, 4, 5, 6, 7), o); }
                const int tl = 16 * it + fr;
                if (tl < nvalid && !dry) *(f32x4*)(OINT + (size_t)(row0 + 64 * n + tl) * 1536 + h * 384 + v0 + 4 * fq) = o;
                __builtin_amdgcn_sched_barrier(0);
            }
            if (more) {
#pragma unroll
                for (int it = 0; it < 4; ++it) oin[it] = *(const f32x4*)(OINT + (size_t)(row0 + 64 * (n + 1) + 16 * it + fr) * 1536 + h * 384 + v0 + 4 * fq); }
        }
#pragma unroll
        for (int t = 0; t < 12; ++t) { const LAS bf16* kr = (const LAS bf16*)(img + PKG_KT) + (16 * t + fr) * KTIMG_LD + 4 * fq;
#pragma unroll
            for (int s2 = 0; s2 < 2; ++s2) { const s16x4 a = *(const LAS s16x4*)(kr + 32 * s2), b = *(const LAS s16x4*)(kr + 32 * s2 + 16);
                S[t] = MFMA16(__builtin_shufflevector(a, b, 0, 1, 2, 3, 4, 5, 6, 7), vt[s2], S[t]); }
            const f32x4 g4 = *(const LAS f32x4*)(img + PKG_G + (16 * t + 4 * fq) * 4);
            S[t] = S[t] * g4; if (PASS == 1) GP[t] = GP[t] * g4; if (t & 1) __builtin_amdgcn_sched_barrier(0); }
        if (more) { LAS unsigned char* nimg = lds + ((n + 1) & 1) * IMG_BYTES;
#pragma unroll
            for (int k = 0; k < NLD; ++k) { const int ch = CH0 + tid + 512 * k; if (ch < NCH) *(LAS v4u*)(nimg + (size_t)ch * 16) = pre[k]; }
            vt[0] = vtn[0]; vt[1] = vtn[1]; }
        asm volatile("s_waitcnt lgkmcnt(0)" ::: "memory"); __builtin_amdgcn_s_barrier(); asm volatile("" ::: "memory");
    }
    if (PASS == 1) {
        float* p = SLOC + (size_t)((bh * 3 + vb) * 3 + seg) * 192 * 128 + (size_t)(4 * fq) * 128 + wave * 16 + fr;
#pragma unroll
        for (int t = 0; t < 12; ++t) {
#pragma unroll
            for (int jj = 0; jj < 4; ++jj) { *p = S[t][jj]; GLA_WALK(p, 128); }
            GLA_WALK(p, 12 * 128); }
        if (vb == 0 && wave == 0 && fr == 0) { float* gs = GSEG + (size_t)(bh * 3 + seg) * 192;
#pragma unroll
            for (int t = 0; t < 12; ++t) *(f32x4*)(gs + 16 * t + 4 * fq) = GP[t]; }
    } else if (sout) {
        float* p = sout + (size_t)(4 * fq) * 384 + v0 + fr;
#pragma unroll
        for (int t = 0; t < 12; ++t) {
#pragma unroll
            for (int jj = 0; jj < 4; ++jj) { *p = S[t][jj]; GLA_WALK(p, 384); }
            GLA_WALK(p, 12 * 384); }
    }
#undef GLA_WALK
}

__device__ __forceinline__ void mem_attn(int item, int lane, int l, const bf16* PROJ, int ldp, int cqm, const bf16* MEMK, const bf16* MEMVT, bf16* OCAT) {
    const int fr = lane & 15, fq = lane >> 4, tile = item >> 2, h = item & 3, r0 = tile * 16;
    const int bb = r0 < MP ? r0 / SEQ : 4 + ((r0 - MP) >> 4);
    const bf16* Kb = MEMK + (size_t)((l * 12 + bb) * 256) * 512 + h * 128; const bf16* Vt = MEMVT + (size_t)(((l * 12 + bb) * 4 + h) * 128) * 256;
    bf16x8 qf[4];
#pragma unroll
    for (int s = 0; s < 4; ++s) qf[s] = ld16(PROJ + (size_t)(r0 + fr) * ldp + cqm + h * 128 + 32 * s + 8 * fq);
    f32x4 st[16];
#pragma unroll
    for (int mt = 0; mt < 16; ++mt) { st[mt] = (f32x4){0.f, 0.f, 0.f, 0.f}; const bf16* kr = Kb + (size_t)(16 * mt + fr) * 512 + 8 * fq;
#pragma unroll
        for (int s = 0; s < 4; ++s) st[mt] = MFMA16(ld16(kr + 32 * s), qf[s], st[mt]); }
    float mx = -3.0e38f;
#pragma unroll
    for (int mt = 0; mt < 16; ++mt) mx = fmaxf(mx, fmaxf(fmaxf(st[mt][0], st[mt][1]), fmaxf(st[mt][2], st[mt][3])));
    mx = fmaxf(mx, shx(mx, lane, 16)); mx = fmaxf(mx, shx(mx, lane, 32));
    float sum = 0.f;
#pragma unroll
    for (int mt = 0; mt < 16; ++mt)
#pragma unroll
        for (int jj = 0; jj < 4; ++jj) { const float p = __expf((st[mt][jj] - mx) * HD_SCALE); st[mt][jj] = p; sum += p; }
    sum += shx(sum, lane, 16); sum += shx(sum, lane, 32);
    const float inv = 1.0f / sum;
    bf16x8 pf[8];
#pragma unroll
    for (int s = 0; s < 8; ++s) pf[s] = pack8(st[2 * s], st[2 * s + 1]);
#pragma unroll
    for (int dt = 0; dt < 8; ++dt) { f32x4 o = {0.f, 0.f, 0.f, 0.f}; const bf16* vr = Vt + (size_t)(16 * dt + fr) * 256 + 4 * fq;
#pragma unroll
        for (int s = 0; s < 8; ++s) o = MFMA16(ld2x8(vr + 32 * s, vr + 32 * s + 16), pf[s], o);
        u32x2 w; w.x = cvt2(o[0] * inv, o[1] * inv); w.y = cvt2(o[2] * inv, o[3] * inv);
        *(u32x2*)(OCAT + (size_t)(r0 + fr) * D + 1536 + h * 128 + 16 * dt + 4 * fq) = w; }
}

__device__ __forceinline__ void mem_attn_wg(int wi, int tid, int wave, LAS unsigned char* lds, int l, const bf16* PROJ, int ldp, int cqm, const bf16* MEMK, const bf16* MEMVT, bf16* OCAT) {
    const bool smp = wi >= 256; const int lane = tid & 63, fr = lane & 15, fq = lane >> 4, bh = smp ? (wi - 256) : (wi >> 4), sub = wi & 15, b = smp ? 4 + (bh >> 2) : (bh >> 2), h = bh & 3;
    const bf16* Kb = MEMK + (size_t)((l * 12 + b) * 256) * 512 + h * 128; const bf16* Vt = MEMVT + (size_t)(((l * 12 + b) * 4 + h) * 128) * 256;
#pragma unroll
    for (int k = 0; k < 8; ++k) { const int idx = tid + 512 * k, row = idx >> 4, c = idx & 15; *(LAS v4u*)(lds + row * 256 + ((c ^ (row & 15)) << 4)) = *(const v4u*)(Kb + (size_t)row * 512 + c * 8); }
#pragma unroll
    for (int k = 0; k < 8; ++k) { const int idx = tid + 512 * k, row = idx >> 5, c = idx & 31; *(LAS v4u*)(lds + 65536 + row * 512 + ((c ^ (2 * (row & 15))) << 4)) = *(const v4u*)(Vt + (size_t)row * 256 + c * 8); }
    __syncthreads();
    unsigned koff[4], voff[16];
#pragma unroll
    for (int s2 = 0; s2 < 4; ++s2) { koff[s2] = (unsigned)(fr * 256 + (((4 * s2 + fq) ^ fr) << 4)); asm volatile("" : "+v"(koff[s2])); }
#pragma unroll
    for (int s2 = 0; s2 < 8; ++s2) { const int p0 = 8 * s2 + fq, p1 = p0 + 4;
        voff[2 * s2] = (unsigned)(65536 + fr * 512 + ((((p0 >> 1) ^ (2 * fr)) << 4) | ((p0 & 1) << 3))); voff[2 * s2 + 1] = (unsigned)(65536 + fr * 512 + ((((p1 >> 1) ^ (2 * fr)) << 4) | ((p1 & 1) << 3)));
        asm volatile("" : "+v"(voff[2 * s2]), "+v"(voff[2 * s2 + 1])); }
    const int nblk = smp ? (wave == 0 ? 1 : 0) : 4;
#pragma unroll 1
    for (int blk = 0; blk < nblk; ++blk) {
        const int r0 = smp ? MP + (b - 4) * 16 : b * SEQ + sub * 512 + blk * 128 + wave * 16;
        bf16x8 qf[4];
#pragma unroll
        for (int s = 0; s < 4; ++s) qf[s] = ld16(PROJ + (size_t)(r0 + fr) * ldp + cqm + h * 128 + 32 * s + 8 * fq);
        f32x4 st[16];
#pragma unroll
        for (int mt = 0; mt < 16; ++mt) { st[mt] = (f32x4){0.f, 0.f, 0.f, 0.f};
#pragma unroll
            for (int s = 0; s < 4; ++s) st[mt] = MFMA16(*(const LAS bf16x8*)(lds + koff[s] + mt * 4096), qf[s], st[mt]);
            if ((mt & 3) == 3) __builtin_amdgcn_sched_barrier(0); }
        float mx = -3.0e38f;
#pragma unroll
        for (int mt = 0; mt < 16; ++mt) mx = fmaxf(mx, fmaxf(fmaxf(st[mt][0], st[mt][1]), fmaxf(st[mt][2], st[mt][3])));
        mx = fmaxf(mx, shx(mx, lane, 16)); mx = fmaxf(mx, shx(mx, lane, 32));
        float sum = 0.f;
#pragma unroll
        for (int mt = 0; mt < 16; ++mt)
#pragma unroll
            for (int jj = 0; jj < 4; ++jj) { const float p = __expf((st[mt][jj] - mx) * HD_SCALE); st[mt][jj] = p; sum += p; }
        sum += shx(sum, lane, 16); sum += shx(sum, lane, 32);
        const float inv = 1.0f / sum;
        bf16x8 pf[8];
#pragma unroll
        for (int s = 0; s < 8; ++s) pf[s] = pack8(st[2 * s], st[2 * s + 1]);
#pragma unroll
        for (int dt = 0; dt < 8; ++dt) { f32x4 o = {0.f, 0.f, 0.f, 0.f};
#pragma unroll
            for (int s = 0; s < 8; ++s) { const s16x4 a = *(const LAS s16x4*)(lds + voff[2 * s] + dt * 8192), bb = *(const LAS s16x4*)(lds + voff[2 * s + 1] + dt * 8192);
                o = MFMA16(__builtin_shufflevector(a, bb, 0, 1, 2, 3, 4, 5, 6, 7), pf[s], o); }
            u32x2 w; w.x = cvt2(o[0] * inv, o[1] * inv); w.y = cvt2(o[2] * inv, o[3] * inv);
            *(u32x2*)(OCAT + (size_t)(r0 + fr) * D + 1536 + h * 128 + 16 * dt + 4 * fq) = w;
            if (dt & 1) __builtin_amdgcn_sched_barrier(0); }
    }
    __syncthreads();
}

__device__ __forceinline__ void sb_attn(int lane, LAS unsigned char* wlds, const bf16* Kp, int ldk, const bf16* VTp, int ldvt, const bf16* Qp, int ldq, bf16* Op, int t0, int nq) {
    const int r = lane & 31, hh = lane >> 5;
    LAS bf16x8* qs = (LAS bf16x8*)wlds + lane;
#pragma unroll
    for (int ks = 0; ks < 8; ++ks) qs[64 * ks] = ld16(Qp + (size_t)r * ldq + 16 * ks + 8 * hh);
    f32x16 oacc[4];
#pragma unroll
    for (int dt = 0; dt < 4; ++dt)
#pragma unroll
        for (int i = 0; i < 16; ++i) oacc[dt][i] = 0.f;
    float carry = 0.f;
    bf16x8 kf[8];
    { const bf16* kr = Kp + (size_t)(t0 + r) * ldk + 8 * hh;
#pragma unroll
      for (int ks = 0; ks < 8; ++ks) kf[ks] = ld16(kr + 16 * ks); }
    for (int s0 = t0; s0 >= 0; s0 -= 32) {
        bf16x8 vf[8];
#pragma unroll
        for (int k2 = 0; k2 < 2; ++k2)
#pragma unroll
            for (int dt = 0; dt < 4; ++dt) { const bf16* vr = VTp + (size_t)(s0 >> 5) * 4096 + (32 * dt + r) * 32 + 16 * k2 + 4 * hh; vf[4 * k2 + dt] = ld2x8(vr, vr + 8); }
        f32x16 st;
#pragma unroll
        for (int i = 0; i < 16; ++i) st[i] = 0.f;
#pragma unroll
        for (int ks = 0; ks < 8; ++ks) st = MFMA32(kf[ks], qs[64 * ks], st);
        { const int sn = s0 >= 32 ? s0 - 32 : 0; const bf16* kr = Kp + (size_t)(sn + r) * ldk + 8 * hh;
#pragma unroll
          for (int ks = 0; ks < 8; ++ks) kf[ks] = ld16(kr + 16 * ks); }
        const bool diag = (s0 == t0);
        float l1[16], lb[16];
#pragma unroll
        for (int i = 0; i < 16; ++i) { const float z = st[i] * HD_SCALE, sp = softplus_fast(z); lb[i] = z - sp; l1[i] = -sp;
            if (diag && !(((i & 3) + 8 * (i >> 2) + 4 * hh) < r)) { l1[i] = 0.f; lb[i] = -1.0e30f; } }
        float g[4], pgv[4];
#pragma unroll
        for (int m = 0; m < 4; ++m) { g[m] = (l1[4 * m] + l1[4 * m + 1]) + (l1[4 * m + 2] + l1[4 * m + 3]); pgv[m] = shx(g[m], lane, 32); }
        float R[4]; R[3] = 0.f; R[2] = g[3] + pgv[3]; R[1] = R[2] + g[2] + pgv[2]; R[0] = R[1] + g[1] + pgv[1];
        const float total = R[0] + g[0] + pgv[0];
#pragma unroll
        for (int m = 0; m < 4; ++m) { const float suf = carry + R[m] + (hh == 0 ? pgv[m] : 0.f);
            const float t3 = suf, t2 = t3 + l1[4 * m + 3], t1 = t2 + l1[4 * m + 2], t0_ = t1 + l1[4 * m + 1];
            lb[4 * m + 3] = __expf(lb[4 * m + 3] + t3); lb[4 * m + 2] = __expf(lb[4 * m + 2] + t2); lb[4 * m + 1] = __expf(lb[4 * m + 1] + t1); lb[4 * m] = __expf(lb[4 * m] + t0_); }
        carry += total;
#pragma unroll
        for (int k2 = 0; k2 < 2; ++k2) {
            v4u p; p.x = cvt2(lb[8 * k2], lb[8 * k2 + 1]); p.y = cvt2(lb[8 * k2 + 2], lb[8 * k2 + 3]); p.z = cvt2(lb[8 * k2 + 4], lb[8 * k2 + 5]); p.w = cvt2(lb[8 * k2 + 6], lb[8 * k2 + 7]);
            const bf16x8 wf = __builtin_bit_cast(bf16x8, p);
#pragma unroll
            for (int dt = 0; dt < 4; ++dt) oacc[dt] = MFMA32(vf[4 * k2 + dt], wf, oacc[dt]);
        }
        if (__all((r >= nq) || (carry < -104.f))) break;
    }
    if (r < nq) {
#pragma unroll
        for (int dt = 0; dt < 4; ++dt)
#pragma unroll
            for (int g4 = 0; g4 < 4; ++g4) { u32x2 wv; wv.x = cvt2(oacc[dt][4 * g4], oacc[dt][4 * g4 + 1]); wv.y = cvt2(oacc[dt][4 * g4 + 2], oacc[dt][4 * g4 + 3]);
                *(u32x2*)(Op + (size_t)r * D + 32 * dt + 8 * g4 + 4 * hh) = wv; }
    }
    asm volatile("s_waitcnt lgkmcnt(0)" ::: "memory");
}

struct SkBf16 { bf16* O; int ldc;
    __device__ __forceinline__ int brow(int unit, int nb) const { return 32 * unit + 16 * nb; }
    __device__ __forceinline__ void store(int unit, const f32x4 a0, const f32x4 a1, int m, int fq) const { bf16* p = O + (size_t)(MP + m) * ldc + 32 * unit + 4 * fq;
        u32x2 w; w.x = cvt2(a0[0], a0[1]); w.y = cvt2(a0[2], a0[3]); *(u32x2*)p = w; w.x = cvt2(a1[0], a1[1]); w.y = cvt2(a1[2], a1[3]); *(u32x2*)(p + 16) = w; } };
struct SkRes { bf16* Yp; const bf16* Xp; float alpha;
    __device__ __forceinline__ int brow(int unit, int nb) const { return 32 * unit + 16 * nb; }
    __device__ __forceinline__ void one(size_t o, const f32x4 a) const { const u32x2 xv = *(const u32x2*)(Xp + o);
        f32x4 r; r[0] = alpha * pg8::bflo(xv.x); r[1] = alpha * pg8::bfhi(xv.x); r[2] = alpha * pg8::bflo(xv.y); r[3] = alpha * pg8::bfhi(xv.y); r = r + a; u32x2 w; w.x = cvt2(r[0], r[1]); w.y = cvt2(r[2], r[3]); *(u32x2*)(Yp + o) = w; }
    __device__ __forceinline__ void store(int unit, const f32x4 a0, const f32x4 a1, int m, int fq) const { const size_t o = (size_t)(MP + m) * D + 32 * unit + 4 * fq; one(o, a0); one(o + 16, a1); } };
struct SkKV { float *oks, *ovs; bf16 *ksb, *vsb;
    __device__ __forceinline__ int brow(int unit, int nb) const { return 32 * unit + 16 * nb; }
    __device__ __forceinline__ void one(int col, const f32x4 a, int m) const { const bool isv = col >= 1536; const int c = col - (isv ? 1536 : 0), b = m >> 4, t = m & 15;
        *(f32x4*)((isv ? ovs : oks) + (size_t)m * 1536 + c) = a; const unsigned w0 = cvt2(a[0], a[1]), w1 = cvt2(a[2], a[3]);
        const int hh_ = c >> 7, dd = c & 127;
        if (!isv) { u32x2 w; w.x = w0; w.y = w1; *(u32x2*)(ksb + ((size_t)(b * 12 + hh_) * 2080 + 2048 + t) * 128 + dd) = w; }
        else { bf16* vt = vsb + ((size_t)(b * 12 + hh_) * 65 + 64) * 4096 + dd * 32 + t; vt[0] = (bf16)w0; vt[32] = (bf16)(w0 >> 16); vt[64] = (bf16)w1; vt[96] = (bf16)(w1 >> 16); } }
    __device__ __forceinline__ void store(int unit, const f32x4 a0, const f32x4 a1, int m, int fq) const { one(32 * unit + 4 * fq, a0, m); one(32 * unit + 16 + 4 * fq, a1, m); } };
struct SkSwiGLU { bf16* Hb;
    __device__ __forceinline__ int brow(int unit, int nb) const { const int c0 = 16 * unit; return (c0 >> 7) * 256 + (c0 & 127) + 128 * nb; }
    __device__ __forceinline__ void store(int unit, const f32x4 g, const f32x4 u, int m, int fq) const { float hv[4];
#pragma unroll
        for (int j = 0; j < 4; ++j) hv[j] = g[j] * __builtin_amdgcn_rcpf(1.0f + __expf(-g[j])) * u[j];
        u32x2 w; w.x = cvt2(hv[0], hv[1]); w.y = cvt2(hv[2], hv[3]); *(u32x2*)(Hb + (size_t)(MP + m) * DFF + 16 * unit + 4 * fq) = w; } };
template <class Epi>
__device__ __forceinline__ void skinny_gemm(int bid, int G, int tid, int wave, LAS unsigned char* lds, const bf16* A, int lda, const bf16* Bt, int K, int nunits, const Epi& E) {
    const int lane = tid & 63, fr = lane & 15, fq = lane >> 4, kw = K >> 3, nst = kw >> 5;
    const bf16* ap = A + (size_t)fr * lda + wave * kw + 8 * fq;
    LAS f32x4* red = (LAS f32x4*)lds;
    for (int unit = bid; unit < nunits; unit += G) {
        const bf16* bp0 = Bt + (size_t)(E.brow(unit, 0) + fr) * K + wave * kw + 8 * fq; const bf16* bp1 = Bt + (size_t)(E.brow(unit, 1) + fr) * K + wave * kw + 8 * fq;
        f32x4 acc[2][8];
#pragma unroll
        for (int nb = 0; nb < 2; ++nb)
#pragma unroll
            for (int rt = 0; rt < 8; ++rt) acc[nb][rt] = (f32x4){0.f, 0.f, 0.f, 0.f};
        bf16x8 a0[8], a1[8], b0[2], b1[2];
#define SK_LOAD(af, bfr, st) do { _Pragma("unroll") for (int rt = 0; rt < 8; ++rt) af[rt] = ld16(ap + (size_t)(16 * rt) * lda + 32 * (st)); bfr[0] = ld16(bp0 + 32 * (st)); bfr[1] = ld16(bp1 + 32 * (st)); } while (0)
#define SK_MMA(af, bfr) do { _Pragma("unroll") for (int rt = 0; rt < 8; ++rt) { acc[0][rt] = MFMA16(bfr[0], af[rt], acc[0][rt]); acc[1][rt] = MFMA16(bfr[1], af[rt], acc[1][rt]); } } while (0)
        SK_LOAD(a0, b0, 0);
#pragma unroll 1
        for (int st = 0; st < nst; st += 2) {
            if (st + 1 < nst) SK_LOAD(a1, b1, st + 1);
            __builtin_amdgcn_sched_barrier(0);
            SK_MMA(a0, b0);
            __builtin_amdgcn_sched_barrier(0);
            if (st + 2 < nst) SK_LOAD(a0, b0, st + 2);
            __builtin_amdgcn_sched_barrier(0);
            if (st + 1 < nst) SK_MMA(a1, b1);
            __builtin_amdgcn_sched_barrier(0);
        }
#undef SK_LOAD
#undef SK_MMA
#pragma unroll
        for (int nb = 0; nb < 2; ++nb)
#pragma unroll
            for (int rt = 0; rt < 8; ++rt) red[((wave * 2 + nb) * 8 + rt) * 64 + lane] = acc[nb][rt];
        __syncthreads();
        f32x4 s0 = {0.f, 0.f, 0.f, 0.f}, s1 = {0.f, 0.f, 0.f, 0.f};
#pragma unroll
        for (int ws = 0; ws < 8; ++ws) { s0 = s0 + red[((ws * 2 + 0) * 8 + wave) * 64 + lane]; s1 = s1 + red[((ws * 2 + 1) * 8 + wave) * 64 + lane]; }
        E.store(unit, s0, s1, 16 * wave + fr, fq);
        __syncthreads();
    }
}
#ifndef PH_MASK
#define PH_MASK 0xFFFF
#endif
__global__ void __launch_bounds__(NWAVES * 64, 2) mega(Args args) {
    extern __shared__ __attribute__((aligned(16))) unsigned char lds[];
    Frame F;
    F.lds = (LAS unsigned char*)lds; F.MISC = (volatile LAS unsigned*)(F.lds + MISC_OFF);
    F.tid = threadIdx.x; F.lane = F.tid & 63; F.wave = __builtin_amdgcn_readfirstlane(F.tid >> 6);
    F.G = gridDim.x; F.gw = blockIdx.x * NWAVES + F.wave; F.NGW = F.G * NWAVES;
    F.ctl = (gu32*)(args.ws_ + WS_CTL);
    for (int u = F.tid; u < (LDS_BYTES - LDSCTL_OFF) / 4; u += NWAVES * 64) ((LAS unsigned*)(F.lds + LDSCTL_OFF))[u] = 0u;
    __syncthreads();
    XcdBarrier bar = xcd_barrier_post((unsigned*)(F.ctl + CW_BAR), F.MISC + 8);
    const int lo = args.ph_lo, hi = args.ph_hi; int ph = 0;
#define KARGS ((const __attribute__((address_space(4))) Args*)__builtin_amdgcn_kernarg_segment_ptr())
#define ws (ka->ws_)
#define out (ka->out_)
#define x_prompt (ka->in[0])
#define x_sample (ka->in[1])
#define mem_prompt (ka->in[2])
#define state_gla (ka->in[3])
#define cache_sb_k (ka->in[4])
#define cache_sb_v (ka->in[5])
#define cache_mem_k (ka->in[6])
#define cache_mem_v (ka->in[7])
#define w_in_a (ka->in[8])
#define w_gate_lr (ka->in[9])
#define b_gate (ka->in[10])
#define gla_norm_g (ka->in[11])
#define w_in_b (ka->in[12])
#define w_kv_shared (ka->in[13])
#define w_mem_kv (ka->in[14])
#define w_o (ka->in[15])
#define ln1_g (ka->in[16])
#define ln1_b (ka->in[17])
#define ln2_g (ka->in[18])
#define ln2_b (ka->in[19])
#define w_ffn_in (ka->in[20])
#define w_ffn_out (ka->in[21])
#define WIN ((bf16*)(ws + WS_WIN))
#define WO ((bf16*)(ws + WS_WO))
#define WFI ((bf16*)(ws + WS_WFI))
#define WFO ((bf16*)(ws + WS_WFO))
#define WMEM ((bf16*)(ws + WS_WMEM))
#define MEMX ((bf16*)(ws + WS_MEMX))
#define MEMK ((bf16*)(ws + WS_MEMK))
#define MEMV ((bf16*)(ws + WS_MEMV))
#define X ((bf16*)(ws + WS_X))
#define Y ((float*)(ws + WS_Y))
#define YB ((bf16*)(ws + WS_Y))
#define PROJ ((bf16*)(ws + WS_R1))
#define HB ((bf16*)(ws + WS_R1))
#define OCAT ((bf16*)(ws + WS_OCAT))
#define SBKS ((bf16*)(ws + WS_SBKS))
#define SBVS ((bf16*)(ws + WS_SBVS))
#define OINT (out + O_YP)
#define KPB ((bf16*)(out + O_YP))
#define VPB (KPB + (size_t)MP * 1536)

#define PHASE_BEGIN(cond, cls) if (cond) { if (lo <= ph && ph < hi) { if (ph > lo) xcd_barrier(bar); DIAG_STAMP(cls); for (int rep_ = 0; rep_ < (((cls) == REP_CLS) ? 2 : 1); ++rep_) { const __attribute__((address_space(4))) Args* ka = KARGS; asm volatile("" : "+s"(ka)); int z_ = 0, G_ = gridDim.x, bid_ = blockIdx.x, wave_ = F.wave; asm volatile("" : "+s"(z_), "+s"(G_), "+s"(bid_), "+s"(wave_)); const int lane = (int)__builtin_amdgcn_mbcnt_hi(~0u, __builtin_amdgcn_mbcnt_lo(~0u, (unsigned)z_)), tid = wave_ * 64 + lane, gw_ = bid_ * NWAVES + wave_, NGW_ = G_ * NWAVES;     (void)tid; (void)lane; (void)gw_; (void)NGW_;
#define PHASE_END } } ++ph; }
#ifndef REP_CLS
#define REP_CLS (-1)
#endif
#ifndef SK_REP
#define SK_REP 1
#endif
#ifndef SB_REP
#define SB_REP 1
#endif
#if defined(DIAG_A)
#define DIAG_STAMP(cls) do { if (blockIdx.x == 0 && threadIdx.x == 0) { unsigned long long* dts = (unsigned long long*)(args.ws_ + 262144); dts[ph] = rt(); } } while (0)
#else
#define DIAG_STAMP(cls) do { } while (0)
#endif

    PHASE_BEGIN(true, 0)
        for (int r = gw_; r < MT; r += NGW_) cvt_row(r < MP ? x_prompt + (size_t)r * D : (r < MR ? x_sample + (size_t)(r - MP) * D : nullptr), X + (size_t)r * D, D, lane);
        for (int r = gw_; r < 1024; r += NGW_) cvt_row(mem_prompt + (size_t)r * D, MEMX + (size_t)r * D, D, lane);
        for (int r = gw_; r < 4 * 8 * 256; r += NGW_) { const int l = r >> 11, b = (r >> 8) & 7, m = r & 255; const size_t dst = (size_t)((l * 12 + 4 + b) * 256 + m) * 512;
            cvt_row(cache_mem_k + (size_t)r * 512, MEMK + dst, 512, lane); }
        for (int it = gw_; it < 512; it += NGW_) { const int hdb = it & 3, mb = (it >> 2) & 3, b = (it >> 4) & 7, l = it >> 7, m = mb * 64 + lane;
            const float* src = cache_mem_v + (size_t)((l * 8 + b) * 256 + m) * 512 + hdb * 128; bf16* dst = MEMV + (size_t)((l * 12 + 4 + b) * 512 + hdb * 128) * 256 + m;
            for (int q4 = 0; q4 < 32; ++q4) { const f32x4 v = *(const f32x4*)(src + 4 * q4);
#pragma unroll
                for (int e = 0; e < 4; ++e) dst[(size_t)(4 * q4 + e) * 256] = (bf16)f2bf(v[e]); } }
        for (int r = gw_; r < 8 * 2048; r += NGW_) { const int b = r >> 11, s = r & 2047; const float* src = cache_sb_k + (size_t)r * 1536;
            for (int j = lane * 4; j < 1536; j += 256) { const f32x4 v = *(const f32x4*)(src + j);
                *(unsigned long long*)(SBKS + ((size_t)(b * 12 + (j >> 7)) * 2080 + s) * 128 + (j & 127)) = (unsigned long long)pk2(v.x, v.y) | ((unsigned long long)pk2(v.z, v.w) << 32); } }
        for (int it = gw_; it < 3072; it += NGW_) { const int cb = it % 12, sb_ = (it / 12) & 31, b = it / 384, s = sb_ * 64 + lane;
            const float* src = cache_sb_v + (size_t)(b * 2048 + s) * 1536 + cb * 128; bf16* dst = SBVS + ((size_t)(b * 12 + cb) * 65 + (s >> 5)) * 4096 + (s & 31);
            for (int q4 = 0; q4 < 32; ++q4) { const f32x4 v = *(const f32x4*)(src + 4 * q4);
#pragma unroll
                for (int e = 0; e < 4; ++e) dst[(4 * q4 + e) * 32] = (bf16)f2bf(v[e]); } }
        for (int l = 0; l < 4; ++l) wt_convert(F.lds, wave_, gw_, NGW_, lane, w_mem_kv + (size_t)l * D * 1024, D, 1024, WMEM + (size_t)l * 1024 * D, 1024, MapId());
    PHASE_END
    PHASE_BEGIN(true, 0)
        pg8::Gemm g{MEMX, WMEM, 1024, 4096, D}; pg8::StaticOrder S; S.init(1024, 4096, G_, bid_);
        pg8::EpiMemKV E{out + O_MKP, out + O_MVP, MEMK, MEMV};
        pg8::gemm_phase<pg8::EpiMemKV, pg8::StaticOrder, true, true>(F.lds + RING_OFF, g, S, E, tid);
    PHASE_END

    for (int l = 0; l < 4; ++l) {
        const bool LA = l < 2;
        PHASE_BEGIN(true, 1)
            if (LA) wt_convert(F.lds, wave_, gw_, NGW_, lane, w_in_a + (size_t)l * D * 5136, D, 5136, WIN, NA, MapInA());
            else { wt_convert(F.lds, wave_, gw_, NGW_, lane, w_in_b + (size_t)(l - 2) * D * NBQ, D, NBQ, WIN, NBQ, MapId()); if (l == 2) wt_convert(F.lds, wave_, gw_, NGW_, lane, w_kv_shared, D, NKV, WIN + (size_t)NBQ * D, NKV, MapId()); }
            wt_convert(F.lds, wave_, gw_, NGW_, lane, w_o + (size_t)l * D * D, D, D, WO, D, MapId());
            wt_convert(F.lds, wave_, gw_, NGW_, lane, w_ffn_in + (size_t)l * D * 2 * DFF, D, 2 * DFF, WFI, 2 * DFF, MapFfn());
            wt_convert(F.lds, wave_, gw_, NGW_, lane, w_ffn_out + (size_t)l * DFF * D, DFF, D, WFO, D, MapId());
        PHASE_END
        const int ldp = LA ? NA : NBQ;
        PHASE_BEGIN(true, 2)
            { pg8::Gemm g{X, WIN, MP, ldp, D}; pg8::StaticOrder S; S.init(MP, ldp, G_, bid_); pg8::EpiBf16 E{PROJ, ldp};
              pg8::gemm_phase<pg8::EpiBf16, pg8::StaticOrder, true, true>(F.lds + RING_OFF, g, S, E, tid); }
            if (l == 2) { pg8::Gemm g{X, WIN + (size_t)NBQ * D, MP, NKV, D}; pg8::StaticOrder S; S.init(MP, NKV, G_, bid_);
              pg8::EpiKV E{out + O_SKP, out + O_SVP, out + O_SKS, out + O_SVS, KPB, VPB, SBKS, SBVS};
              pg8::gemm_phase<pg8::EpiKV, pg8::StaticOrder, true, true>(F.lds + RING_OFF, g, S, E, tid); }
            for (int skr = 0; skr < SK_REP; ++skr) { SkBf16 E{PROJ, ldp}; skinny_gemm(bid_, G_, tid, wave_, F.lds + RING_OFF, X + (size_t)MP * D, D, WIN, D, ldp / 32, E); }
            for (int skr = 0; skr < SK_REP; ++skr) if (l == 2) { SkKV E{out + O_SKS, out + O_SVS, SBKS, SBVS}; skinny_gemm(bid_, G_, tid, wave_, F.lds + RING_OFF, X + (size_t)MP * D, D, WIN + (size_t)NBQ * D, D, NKV / 32, E); }
        PHASE_END
        PHASE_BEGIN(LA, 3)
            gla_prep(bid_, G_, tid, wave_, F.lds + RING_OFF, l, PROJ, w_gate_lr, b_gate, (unsigned char*)Y);
        PHASE_END
        PHASE_BEGIN(true, (LA ? 4 : 11))
            if (LA) {
                for (int item = bid_; item < N_PKG; item += G_) gla_intra(item, tid, wave_, F.lds + RING_OFF, (const unsigned char*)Y, OINT);
            } else {
                for (int sbr = 0; sbr < SB_REP; ++sbr)
                for (int u = gw_; u < 12288 + 96; u += NGW_) {
                    if (u < 12288) { const int bh = u >> 8, qb = u & 255, b = bh / 12, h = bh % 12, t0 = 32 * qb; const size_t qo = (size_t)(b * SEQ + t0) * D + h * 128;
                        sb_attn(lane, F.lds + RING_OFF + wave_ * 16384, KPB + (size_t)bh * SEQ * 128, 128, VPB + (size_t)bh * SEQ * 128, 0, PROJ + qo, NBQ, OCAT + qo, t0, 32); }
                    else { const int u2 = u - 12288, b = u2 / 12, h = u2 % 12; const size_t qo = (size_t)(MP + b * 16) * D + h * 128;
                        sb_attn(lane, F.lds + RING_OFF + wave_ * 16384, SBKS + (size_t)u2 * 2080 * 128, 128, SBVS + (size_t)u2 * 65 * 4096, 0, PROJ + qo, NBQ, OCAT + qo, 2048, 16); }
                }
            }
            __syncthreads();
            for (int wi = bid_; wi < 256 + 32; wi += G_) mem_attn_wg(wi, tid, wave_, F.lds + RING_OFF, l, PROJ, ldp, LA ? CQM : 1536, MEMK, MEMV, OCAT);
        PHASE_END
        PHASE_BEGIN(LA, 12)
            for (int wc = bid_; wc < 144; wc += G_) gla_chain<1>(wc, tid, wave_, F.lds + RING_OFF, l, (const unsigned char*)Y, state_gla, OINT, out, (float*)WMEM, (float*)MEMX);
        PHASE_END
        PHASE_BEGIN(LA, 5)
            for (int wc = bid_; wc < 192 + 96; wc += G_) gla_chain<2>(wc, tid, wave_, F.lds + RING_OFF, l, (const unsigned char*)Y, state_gla, OINT, out, (float*)WMEM, (float*)MEMX, REP_CLS == 5 && rep_ == 0);
        PHASE_END
        PHASE_BEGIN(LA, 6)
            const float* gn = gla_norm_g + (size_t)l * 384;
            for (int row = gw_; row < MR; row += NGW_) {
#pragma unroll
                for (int h = 0; h < 4; ++h) { bf16* op = OCAT + (size_t)row * D + h * 384; const bf16* gp = PROJ + (size_t)row * NA + CG + h * 384;
                    float ov[6]; float ss = 0.f;
#pragma unroll
                    for (int j = 0; j < 3; ++j) { const f32x2_t w = *(const f32x2_t*)(OINT + (size_t)row * 1536 + h * 384 + 2 * lane + 128 * j); ov[2 * j] = w.x; ov[2 * j + 1] = w.y; ss += ov[2 * j] * ov[2 * j] + ov[2 * j + 1] * ov[2 * j + 1]; }
                    const float r = 1.0f / sqrtf(wave_sum(ss, lane) * (1.0f / 384.0f) + RMS_EPS);
#pragma unroll
                    for (int j = 0; j < 3; ++j) { const int c = 2 * lane + 128 * j; const unsigned gw2 = *(const unsigned*)(gp + c); const float g0 = pg8::bflo(gw2), g1 = pg8::bfhi(gw2);
                        const float r0 = ov[2 * j] * r * gn[c] * (g0 / (1.0f + __expf(-g0))), r1 = ov[2 * j + 1] * r * gn[c + 1] * (g1 / (1.0f + __expf(-g1)));
                        *(unsigned*)(op + c) = pk2(r0, r1); } }
            }
        PHASE_END
        PHASE_BEGIN(true, 7)
            pg8::Gemm g{OCAT, WO, MP, D, D}; pg8::StaticOrder S; S.init(MP, D, G_, bid_); pg8::EpiRes E{YB, X, D, DN_ALPHA};
            pg8::gemm_phase<pg8::EpiRes, pg8::StaticOrder, true, true>(F.lds + RING_OFF, g, S, E, tid);
            for (int skr = 0; skr < SK_REP; ++skr) { SkRes Es{YB, X, DN_ALPHA}; skinny_gemm(bid_, G_, tid, wave_, F.lds + RING_OFF, OCAT + (size_t)MP * D, D, WO, D, D / 32, Es); }
        PHASE_END
        PHASE_BEGIN(true, 8)
            const float* gg = ln1_g + (size_t)l * D; const float* bb = ln1_b + (size_t)l * D;
            for (int row = gw_; row < MR; row += NGW_) {
                const v4u* yr = (const v4u*)(YB + (size_t)row * D) + lane; float v[4][8]; float s = 0.f;
#pragma unroll
                for (int j = 0; j < 4; ++j) { const v4u w = yr[64 * j]; v[j][0] = pg8::bflo(w.x); v[j][1] = pg8::bfhi(w.x); v[j][2] = pg8::bflo(w.y); v[j][3] = pg8::bfhi(w.y); v[j][4] = pg8::bflo(w.z); v[j][5] = pg8::bfhi(w.z); v[j][6] = pg8::bflo(w.w); v[j][7] = pg8::bfhi(w.w);
                    s += ((v[j][0] + v[j][1]) + (v[j][2] + v[j][3])) + ((v[j][4] + v[j][5]) + (v[j][6] + v[j][7])); }
                const float mean = wave_sum(s, lane) * (1.f / D); float s2 = 0.f;
#pragma unroll
                for (int j = 0; j < 4; ++j)
#pragma unroll
                    for (int i = 0; i < 8; ++i) { v[j][i] -= mean; s2 += v[j][i] * v[j][i]; }
                const float rstd = 1.f / sqrtf(wave_sum(s2, lane) * (1.f / D) + LN_EPS);
                {
#pragma unroll
                    for (int j = 0; j < 4; ++j) { const int e0 = (lane + 64 * j) * 8; const f32x4 g0 = *(const f32x4*)(gg + e0), g1 = *(const f32x4*)(gg + e0 + 4), b0 = *(const f32x4*)(bb + e0), b1 = *(const f32x4*)(bb + e0 + 4);
                        v4u o; o.x = pk2(v[j][0] * rstd * g0[0] + b0[0], v[j][1] * rstd * g0[1] + b0[1]); o.y = pk2(v[j][2] * rstd * g0[2] + b0[2], v[j][3] * rstd * g0[3] + b0[3]);
                        o.z = pk2(v[j][4] * rstd * g1[0] + b1[0], v[j][5] * rstd * g1[1] + b1[1]); o.w = pk2(v[j][6] * rstd * g1[2] + b1[2], v[j][7] * rstd * g1[3] + b1[3]);
                        *(v4u*)(X + (size_t)row * D + e0) = o; } }
            }
        PHASE_END
        PHASE_BEGIN(true, 9)
            pg8::Gemm g{X, WFI, MP, 2 * DFF, D}; pg8::StaticOrder S; S.init(MP, 2 * DFF, G_, bid_); pg8::EpiSwiGLU E{HB, DFF};
            pg8::gemm_phase<pg8::EpiSwiGLU, pg8::StaticOrder, true, true>(F.lds + RING_OFF, g, S, E, tid);
            for (int skr = 0; skr < SK_REP; ++skr) { SkSwiGLU Es{HB}; skinny_gemm(bid_, G_, tid, wave_, F.lds + RING_OFF, X + (size_t)MP * D, D, WFI, D, DFF / 16, Es); }
        PHASE_END
        PHASE_BEGIN(true, 10)
            pg8::Gemm g{HB, WFO, MP, D, DFF}; pg8::StaticOrder S; S.init(MP, D, G_, bid_); pg8::EpiRes E{YB, X, D, DN_ALPHA};
            pg8::gemm_phase<pg8::EpiRes, pg8::StaticOrder, true, true>(F.lds + RING_OFF, g, S, E, tid);
            for (int skr = 0; skr < SK_REP; ++skr) { SkRes Es{YB, X, DN_ALPHA}; skinny_gemm(bid_, G_, tid, wave_, F.lds + RING_OFF, HB + (size_t)MP * DFF, DFF, WFO, DFF, D / 32, Es); }
        PHASE_END
        PHASE_BEGIN(true, 8)
            const float* gg = ln2_g + (size_t)l * D; const float* bb = ln2_b + (size_t)l * D;
            for (int row = gw_; row < MR; row += NGW_) {
                const v4u* yr = (const v4u*)(YB + (size_t)row * D) + lane; float v[4][8]; float s = 0.f;
#pragma unroll
                for (int j = 0; j < 4; ++j) { const v4u w = yr[64 * j]; v[j][0] = pg8::bflo(w.x); v[j][1] = pg8::bfhi(w.x); v[j][2] = pg8::bflo(w.y); v[j][3] = pg8::bfhi(w.y); v[j][4] = pg8::bflo(w.z); v[j][5] = pg8::bfhi(w.z); v[j][6] = pg8::bflo(w.w); v[j][7] = pg8::bfhi(w.w);
                    s += ((v[j][0] + v[j][1]) + (v[j][2] + v[j][3])) + ((v[j][4] + v[j][5]) + (v[j][6] + v[j][7])); }
                const float mean = wave_sum(s, lane) * (1.f / D); float s2 = 0.f;
#pragma unroll
                for (int j = 0; j < 4; ++j)
#pragma unroll
                    for (int i = 0; i < 8; ++i) { v[j][i] -= mean; s2 += v[j][i] * v[j][i]; }
                const float rstd = 1.f / sqrtf(wave_sum(s2, lane) * (1.f / D) + LN_EPS);
                if (l == 3) { float* of = (row < MP ? out + O_YP + (size_t)row * D : out + O_YS + (size_t)(row - MP) * D);
#pragma unroll
                    for (int j = 0; j < 4; ++j) { const int e0 = (lane + 64 * j) * 8; const f32x4 g0 = *(const f32x4*)(gg + e0), g1 = *(const f32x4*)(gg + e0 + 4), b0 = *(const f32x4*)(bb + e0), b1 = *(const f32x4*)(bb + e0 + 4);
                        f32x4 r0, r1;
#pragma unroll
                        for (int i = 0; i < 4; ++i) { r0[i] = v[j][i] * rstd * g0[i] + b0[i]; r1[i] = v[j][4 + i] * rstd * g1[i] + b1[i]; }
                        *(f32x4*)(of + e0) = r0; *(f32x4*)(of + e0 + 4) = r1; } }
                else {
#pragma unroll
                    for (int j = 0; j < 4; ++j) { const int e0 = (lane + 64 * j) * 8; const f32x4 g0 = *(const f32x4*)(gg + e0), g1 = *(const f32x4*)(gg + e0 + 4), b0 = *(const f32x4*)(bb + e0), b1 = *(const f32x4*)(bb + e0 + 4);
                        v4u o; o.x = pk2(v[j][0] * rstd * g0[0] + b0[0], v[j][1] * rstd * g0[1] + b0[1]); o.y = pk2(v[j][2] * rstd * g0[2] + b0[2], v[j][3] * rstd * g0[3] + b0[3]);
                        o.z = pk2(v[j][4] * rstd * g1[0] + b1[0], v[j][5] * rstd * g1[1] + b1[1]); o.w = pk2(v[j][6] * rstd * g1[2] + b1[2], v[j][7] * rstd * g1[3] + b1[3]);
                        *(v4u*)(X + (size_t)row * D + e0) = o; } }
            }
        PHASE_END
    }
#if defined(DIAG_A)
    if (blockIdx.x == 0 && threadIdx.x == 0) { unsigned long long* dts = (unsigned long long*)(args.ws_ + 262144); dts[ph] = rt(); dts[63] = (unsigned long long)ph; }
#endif
#undef ws
#undef out
#undef X
#undef Y
#undef YB
#undef PHASE_BEGIN
#undef PHASE_END
}

#if defined(DIAG_A)
__device__ const int diag_cls[40] = {0,0, 1,2,3,4,5,6,7,8,9,10,8, 1,2,3,4,5,6,7,8,9,10,8, 1,2,11,7,8,9,10,8, 1,2,11,7,8,9,10,8};
__global__ void diag_tail(float* o, const unsigned long long* dts) {
    __shared__ float dv[2];
    if (threadIdx.x == 0) { const int n = (int)dts[63]; unsigned long long sa = 0, sb = 0; for (int p = 0; p < n; ++p) { const unsigned long long d = dts[p + 1] - dts[p]; const int cl = diag_cls[p]; if (cl == DIAG_A) sa += d; if (cl == DIAG_B) sb += d; }
        dv[0] = (float)sa * 0.01f; dv[1] = (float)sb * 10.0f; }
    __syncthreads();
    for (int i = threadIdx.x; i < 262144; i += blockDim.x) o[O_YS + i] = dv[0];
    if (threadIdx.x == 0) o[O_YP] = dv[1];
}
#endif
#ifndef MK_PER_PHASE
#define MK_PER_PHASE 0
#endif
constexpr int N_PHASES = 2 + 2 * 12 + 2 * 8;
extern "C" void kernel_launch(void* const* d_in, const int* in_sizes, int n_in, void* d_out, int out_size, void* d_ws, size_t ws_size, hipStream_t stream) {
    static int grid = 0;
    if (grid == 0) {
        if (n_in != 22 || in_sizes[0] != MP * D || (size_t)out_size != O_END || ws_size < WS_END) { fprintf(stderr, "kernel_launch: unexpected shapes (n_in %d, in0 %d, out %d, ws %zu); nothing launched\n", n_in, n_in > 0 ? in_sizes[0] : -1, out_size, ws_size); grid = -1; return; }
        int dev = 0, cus = 0, per_cu = 0;
        if (hipGetDevice(&dev) != hipSuccess || hipDeviceGetAttribute(&cus, hipDeviceAttributeMultiprocessorCount, dev) != hipSuccess) { grid = -1; return; }
        if (hipFuncSetAttribute((const void*)mega, hipFuncAttributeMaxDynamicSharedMemorySize, LDS_BYTES) != hipSuccess) { fprintf(stderr, "kernel_launch: hipFuncSetAttribute failed\n"); grid = -1; return; }
        if (hipOccupancyMaxActiveBlocksPerMultiprocessor(&per_cu, (const void*)mega, NWAVES * 64, LDS_BYTES) != hipSuccess || per_cu < 1) fprintf(stderr, "kernel_launch: occupancy query reports %d\n", per_cu);
        (void)hipGetLastError();
        grid = cus;
    }
    if (grid < 0) return;
    if (hipMemsetAsync((char*)d_ws + WS_CTL, 0, CTL_ZERO_BYTES, stream) != hipSuccess) return;
    Args a{};
    for (int i = 0; i < 22; ++i) a.in[i] = (const float*)d_in[i];
    a.out_ = (float*)d_out; a.ws_ = (unsigned char*)d_ws;
#if MK_PER_PHASE
    for (int p = 0; p < N_PHASES; ++p) { a.ph_lo = p; a.ph_hi = p + 1; hipLaunchKernelGGL(mega, dim3(grid), dim3(NWAVES * 64), LDS_BYTES, stream, a); }
#else
    a.ph_lo = 0; a.ph_hi = N_PHASES; hipLaunchKernelGGL(mega, dim3(grid), dim3(NWAVES * 64), LDS_BYTES, stream, a);
#if defined(DIAG_A)
    hipLaunchKernelGGL(diag_tail, dim3(1), dim3(512), 0, stream, (float*)d_out, (const unsigned long long*)((unsigned char*)d_ws + 262144));
#endif
#endif
}
```

```cpp
#include <hip/hip_runtime.h>
#include <cstdio>
#include <cstdint>
namespace pg8 {
#define PG8_LAS __attribute__((address_space(3)))
typedef unsigned short bf16_t;
typedef short bf16x8 __attribute__((ext_vector_type(8)));
typedef float f32x4 __attribute__((ext_vector_type(4)));
typedef unsigned u32x4 __attribute__((ext_vector_type(4)));
constexpr int BM = 256, BK = 64, HALF = 128, HTB = HALF * BK * 2  , STAGE_BYTES = 8 * HTB, NXCD = 8, WGM = 8;

__host__ __device__ __forceinline__ int lds_byte(int r, int c) { const int st = (r >> 4) * 2 + (c >> 5), rr = r & 15, cc = c & 31, ob = rr * 64 + cc * 2; return st * 1024 + (ob ^ (((ob >> 9) & 1) << 5)); }
__host__ __device__ __forceinline__ void stage_rc(int b, int& R, int& C) { const int st = b / 1024, sb = b % 1024, swz = sb ^ (((sb >> 9) & 1) << 5); R = (st >> 1) * 16 + swz / 64; C = (st & 1) * 32 + (swz % 64) / 2; }
__host__ __device__ __forceinline__ int perm32(int rho) { const int n = rho >> 4, i = rho & 15; return 8 * (i >> 2) + 4 * n + (i & 3); }

struct Unit { int pm, pn; };
struct Gemm { const bf16_t* A; const bf16_t* Bt; int M, N, K; };

struct StaticOrder {
    int nM, nN, nwg, G, c;
    __host__ __device__ void init(int M, int N, int G_, int c_) { nM = M / BM; nN = N / BM; nwg = nM * nN; G = G_; c = c_; }
    __host__ __device__ bool next(int i, Unit& u) const {
        const long L = (long)i * G + c; if (L >= nwg) return false;
        int wgid = (int)L; { const int q = nwg / NXCD, r = nwg % NXCD, xcd = wgid % NXCD, off = wgid / NXCD; wgid = (xcd < r ? xcd * (q + 1) : r * (q + 1) + (xcd - r) * q) + off; }
        const int nig = WGM * nN, gid = wgid / nig, fm = gid * WGM, gsz = (nM - fm) < WGM ? (nM - fm) : WGM;
        u.pm = fm + ((wgid % nig) % gsz); u.pn = (wgid % nig) / gsz; return true;
    }
    __device__ __forceinline__ void a_ready(const Unit&) const {}
    __device__ __forceinline__ void done(const Unit&) const {}
};
__device__ __forceinline__ unsigned cvt_pk_bf16(float lo, float hi) { unsigned r; asm volatile("v_cvt_pk_bf16_f32 %0, %1, %2" : "=v"(r) : "v"(lo), "v"(hi)); return r; }
typedef float f32x2 __attribute__((ext_vector_type(2)));
typedef unsigned u32x2 __attribute__((ext_vector_type(2)));
__device__ __forceinline__ float bflo(unsigned w) { return __builtin_bit_cast(float, w << 16); }
__device__ __forceinline__ float bfhi(unsigned w) { return __builtin_bit_cast(float, w & 0xffff0000u); }
struct EpiBf16 {
    static constexpr bool PERM = true, AFTER_DRAIN = false;
    bf16_t* O; int ldc;
    __device__ __forceinline__ void operator()(const f32x4 (&acc)[2][2][4][2], const Unit& u, int wr, int wc, int fr, int fq) const {
        const int row0 = u.pm * BM + wr * 64 + fr, col0 = u.pn * BM + wc * 32 + 8 * fq;
#pragma unroll
        for (int ai = 0; ai < 2; ++ai)
#pragma unroll
            for (int m = 0; m < 4; ++m) { bf16_t* rowp = O + (size_t)(row0 + ai * HALF + m * 16) * ldc + col0;
#pragma unroll
                for (int bj = 0; bj < 2; ++bj) { const f32x4 v0 = acc[ai][bj][m][0], v1 = acc[ai][bj][m][1];
                    u32x4 w; w.x = cvt_pk_bf16(v0[0], v0[1]); w.y = cvt_pk_bf16(v0[2], v0[3]); w.z = cvt_pk_bf16(v1[0], v1[1]); w.w = cvt_pk_bf16(v1[2], v1[3]);
                    *(u32x4*)(rowp + bj * HALF) = w; } __builtin_amdgcn_sched_barrier(0); }
    }
};
struct EpiSwiGLU {
    static constexpr bool PERM = true, AFTER_DRAIN = false;
    bf16_t* Hh; int ldh;
    __device__ __forceinline__ float swi(float g, float up) const { return g * __builtin_amdgcn_rcpf(1.0f + __expf(-g)) * up; }
    __device__ __forceinline__ void operator()(const f32x4 (&acc)[2][2][4][2], const Unit& u, int wr, int wc, int fr, int fq) const {
        const int row0 = u.pm * BM + wr * 64 + fr, col0 = u.pn * HALF + wc * 32 + 8 * fq;
#pragma unroll
        for (int ai = 0; ai < 2; ++ai)
#pragma unroll
            for (int m = 0; m < 4; ++m) { bf16_t* rowp = Hh + (size_t)(row0 + ai * HALF + m * 16) * ldh + col0;
                const f32x4 g0 = acc[ai][0][m][0], g1 = acc[ai][0][m][1], u0 = acc[ai][1][m][0], u1 = acc[ai][1][m][1];
                u32x4 w; w.x = cvt_pk_bf16(swi(g0[0], u0[0]), swi(g0[1], u0[1])); w.y = cvt_pk_bf16(swi(g0[2], u0[2]), swi(g0[3], u0[3]));
                w.z = cvt_pk_bf16(swi(g1[0], u1[0]), swi(g1[1], u1[1])); w.w = cvt_pk_bf16(swi(g1[2], u1[2]), swi(g1[3], u1[3]));
                *(u32x4*)rowp = w; __builtin_amdgcn_sched_barrier(0); }
    }
};
struct EpiRes {
    static constexpr bool PERM = false, AFTER_DRAIN = false;
    bf16_t* Y; const bf16_t* X; int ldc; float alpha;
    __device__ __forceinline__ void operator()(const f32x4 (&acc)[2][2][4][2], const Unit& u, int wr, int wc, int fr, int fq) const {
        const int row0 = u.pm * BM + wr * 64 + fr, col0 = u.pn * BM + wc * 32 + 4 * fq;
#pragma unroll
        for (int ai = 0; ai < 2; ++ai)
#pragma unroll
            for (int m = 0; m < 4; ++m) { const size_t ro = (size_t)(row0 + ai * HALF + m * 16) * ldc + col0;
#pragma unroll
                for (int bj = 0; bj < 2; ++bj)
#pragma unroll
                    for (int n = 0; n < 2; ++n) { const size_t o = ro + bj * HALF + n * 16; const u32x2 xv = *(const u32x2*)(X + o);
                        f32x4 r; r[0] = alpha * bflo(xv.x); r[1] = alpha * bfhi(xv.x); r[2] = alpha * bflo(xv.y); r[3] = alpha * bfhi(xv.y);
                        r = r + acc[ai][bj][m][n]; u32x2 w; w.x = cvt_pk_bf16(r[0], r[1]); w.y = cvt_pk_bf16(r[2], r[3]); *(u32x2*)(Y + o) = w; } __builtin_amdgcn_sched_barrier(0); }
    }
};
struct EpiKV {
    static constexpr bool PERM = false, AFTER_DRAIN = false;
    float *okp, *ovp, *oks, *ovs; bf16_t *kpb, *vpb, *ksb, *vsb;
    __device__ __forceinline__ void operator()(const f32x4 (&acc)[2][2][4][2], const Unit& u, int wr, int wc, int fr, int fq) const {
        const bool isv = u.pn >= 6; const int colt = (u.pn - (isv ? 6 : 0)) * BM + wc * 32 + 4 * fq, row0 = u.pm * BM + wr * 64 + fr;
        float* op = isv ? ovp : okp;
#pragma unroll
        for (int ai = 0; ai < 2; ++ai)
#pragma unroll
            for (int m = 0; m < 4; ++m) { const int row = row0 + ai * HALF + m * 16; float* fd;
                if (row < 32768) { fd = op + (size_t)row * 1536; } else continue;
                const int bq = row >> 13, sq = row & 8191;
#pragma unroll
                for (int bj = 0; bj < 2; ++bj)
#pragma unroll
                    for (int n = 0; n < 2; ++n) { const int c = colt + bj * HALF + n * 16; const f32x4 v = acc[ai][bj][m][n];
                        *(f32x4*)(fd + c) = v; const unsigned w0 = cvt_pk_bf16(v[0], v[1]), w1 = cvt_pk_bf16(v[2], v[3]);
                        const int hq = c >> 7, dq = c & 127;
                        if (!isv) { u32x2 w; w.x = w0; w.y = w1; *(u32x2*)(kpb + ((size_t)(bq * 12 + hq) * 8192 + sq) * 128 + dq) = w; }
                        else { bf16_t* vt = vpb + ((size_t)(bq * 12 + hq) * 256 + (sq >> 5)) * 4096 + dq * 32 + (sq & 31); vt[0] = (bf16_t)w0; vt[32] = (bf16_t)(w0 >> 16); vt[64] = (bf16_t)w1; vt[96] = (bf16_t)(w1 >> 16); } } }
    }
};
struct EpiMemKV {
    static constexpr bool PERM = false, AFTER_DRAIN = false;
    float *ok, *ov; bf16_t *kb, *vb;
    __device__ __forceinline__ void operator()(const f32x4 (&acc)[2][2][4][2], const Unit& u, int wr, int wc, int fr, int fq) const {
        const int l = u.pn >> 2, kv = (u.pn >> 1) & 1, hd0 = (u.pn & 1) * BM + wc * 32 + 4 * fq, row0 = u.pm * BM + wr * 64 + fr;
        float* fo = kv ? ov : ok; bf16_t* bo = kv ? vb : kb;
#pragma unroll
        for (int ai = 0; ai < 2; ++ai)
#pragma unroll
            for (int m = 0; m < 4; ++m) { const int row = row0 + ai * HALF + m * 16, b = row >> 8, mm = row & 255;
                float* fd = fo + (size_t)(l * 1024 + row) * 512; bf16_t* bd = bo + (size_t)((l * 12 + b) * 256 + mm) * 512;
#pragma unroll
                for (int bj = 0; bj < 2; ++bj)
#pragma unroll
                    for (int n = 0; n < 2; ++n) { const int c = hd0 + bj * HALF + n * 16; const f32x4 v = acc[ai][bj][m][n];
                        *(f32x4*)(fd + c) = v; const unsigned w0 = cvt_pk_bf16(v[0], v[1]), w1 = cvt_pk_bf16(v[2], v[3]);
                        if (!kv) { u32x2 w; w.x = w0; w.y = w1; *(u32x2*)(bd + c) = w; }
                        else { bf16_t* vt = vb + (size_t)((l * 12 + b) * 512 + c) * 256 + mm;
                            vt[0] = (bf16_t)w0; vt[256] = (bf16_t)(w0 >> 16); vt[512] = (bf16_t)w1; vt[768] = (bf16_t)(w1 >> 16); } } }
    }
};
template <class Epi, class Sched, bool ALIGN_EPI = false, bool SP2 = false>
__device__ __forceinline__ void gemm_phase(PG8_LAS unsigned char* lds, const Gemm g, const Sched& S, const Epi& E, int tid_in) {
    int tid_ = tid_in; asm volatile("" : "+v"(tid_));
    const int tid = tid_, wid = __builtin_amdgcn_readfirstlane(tid >> 6), lane = tid & 63, wr = wid >> 2, wc = wid & 3, fr = lane & 15, fq = lane >> 4;
    const int K = g.K, nt = K / BK;
    unsigned voffA[2], voffB[2];
#pragma unroll
    for (int i = 0; i < 2; ++i) { int R, C; stage_rc(tid * 16 + i * 8192, R, C); const int Rb = Epi::PERM ? ((R & ~31) + perm32(R & 31)) : R;
        voffA[i] = (unsigned)(R * K + C) * 2u; voffB[i] = (unsigned)(Rb * K + C) * 2u; }
    const size_t kstep = (size_t)(BK * 2);
    const size_t hstep = (size_t)HALF * K * 2;
    const size_t tstep = 2 * hstep;
    const unsigned ldsw = (unsigned)wid * 1024u;
    const int aoff = lds_byte(wr * 64 + fr, fq * 8), boff = lds_byte(wc * 32 + fr, fq * 8);
#define PG8_SA(b, h) (((b) * 2 + (h)) * HTB)
#define PG8_SB(b, h) ((4 + (b) * 2 + (h)) * HTB)
#define PG8_STAGE(bufoff, gbase, voff) do { _Pragma("unroll") for (int _i = 0; _i < 2; ++_i) \
        __builtin_amdgcn_global_load_lds((const unsigned*)((const char*)(gbase) + (voff)[_i]), (PG8_LAS unsigned*)(lds + (bufoff) + ldsw + _i * 8192), 16, 0, 0); } while (0)
#define PG8_LDA(dst, b, h) do { _Pragma("unroll") for (int m = 0; m < 4; ++m) _Pragma("unroll") for (int k = 0; k < 2; ++k) dst[m][k] = *(const PG8_LAS bf16x8*)(lds + PG8_SA(b, h) + aoff + m * 2048 + k * 1024); } while (0)
#define PG8_LDB(dst, b, h) do { _Pragma("unroll") for (int n = 0; n < 2; ++n) _Pragma("unroll") for (int k = 0; k < 2; ++k) dst[n][k] = *(const PG8_LAS bf16x8*)(lds + PG8_SB(b, h) + boff + n * 2048 + k * 1024); } while (0)
#define PG8_MMA(ai, bj, At, Bt) do { __builtin_amdgcn_s_setprio(1); _Pragma("unroll") for (int m = 0; m < 4; ++m) _Pragma("unroll") for (int n = 0; n < 2; ++n) _Pragma("unroll") for (int k = 0; k < 2; ++k) \
        acc[ai][bj][m][n] = __builtin_amdgcn_mfma_f32_16x16x32_bf16(Bt[n][k], At[m][k], acc[ai][bj][m][n], 0, 0, 0); __builtin_amdgcn_s_setprio(0); } while (0)
#define PG8_WAIT_V(n) asm volatile("s_waitcnt vmcnt(" #n ")" ::: "memory")
#define PG8_WAIT_L(n) asm volatile("s_waitcnt lgkmcnt(" #n ")" ::: "memory")
#define PG8_BAR __builtin_amdgcn_s_barrier()
#define PG8_SCHED __builtin_amdgcn_sched_barrier(0)
    Unit cur, nxt; int ui = 0;
    if (!S.next(0, cur)) return;
    f32x4 acc[2][2][4][2];
#pragma unroll
    for (int a = 0; a < 2; ++a)
#pragma unroll
        for (int b = 0; b < 2; ++b)
#pragma unroll
            for (int m = 0; m < 4; ++m)
#pragma unroll
                for (int n = 0; n < 2; ++n) acc[a][b][m][n] = (f32x4){0.f, 0.f, 0.f, 0.f};
    bf16x8 At[4][2], B0[2][2], B1[2][2];
    const char* cA = (const char*)g.A + (size_t)cur.pm * tstep; const char* cB = (const char*)g.Bt + (size_t)cur.pn * tstep;
    S.a_ready(cur);
    if constexpr (SP2) {
        PG8_STAGE(PG8_SB(0, 0), cB, voffB); PG8_STAGE(PG8_SB(0, 1), cB + hstep, voffB); PG8_STAGE(PG8_SA(0, 0), cA, voffA); PG8_STAGE(PG8_SA(0, 1), cA + hstep, voffA);
        if (wr == 1) PG8_BAR;
        PG8_WAIT_V(2); PG8_BAR;
        PG8_STAGE(PG8_SB(1, 0), cB + kstep, voffB); PG8_STAGE(PG8_SA(1, 0), cA + kstep, voffA); PG8_STAGE(PG8_SB(1, 1), cB + hstep + kstep, voffB);
        PG8_WAIT_V(6); PG8_BAR;
    } else {
        PG8_STAGE(PG8_SB(0, 0), cB, voffB); PG8_STAGE(PG8_SA(0, 0), cA, voffA); PG8_STAGE(PG8_SB(0, 1), cB + hstep, voffB); PG8_STAGE(PG8_SA(0, 1), cA + hstep, voffA);
        if (wr == 1) PG8_BAR;
        PG8_WAIT_V(4); PG8_BAR;
        PG8_STAGE(PG8_SB(1, 0), cB + kstep, voffB); PG8_STAGE(PG8_SA(1, 0), cA + kstep, voffA); PG8_STAGE(PG8_SB(1, 1), cB + hstep + kstep, voffB);
        PG8_WAIT_V(6); PG8_BAR;
    }
    for (;;) {
        const bool has_next = S.next(ui + 1, nxt);
        const char* nA = has_next ? (const char*)g.A + (size_t)nxt.pm * tstep : cA; const char* nB = has_next ? (const char*)g.Bt + (size_t)nxt.pn * tstep : cB;
        for (int t = 0; t < nt; t += 2) {
            const bool last = (t == nt - 2);
            const char* a1 = cA + (size_t)(t + 1) * kstep;
            const char* a2 = last ? nA : cA + (size_t)(t + 2) * kstep; const char* b2 = last ? nB : cB + (size_t)(t + 2) * kstep;
            const char* a3 = a2 + kstep; const char* b3 = b2 + kstep;
            if (last && has_next) S.a_ready(nxt);
            if constexpr (SP2) {
            PG8_LDB(B0, 0, 0); PG8_LDB(B1, 0, 1); PG8_SCHED; PG8_LDA(At, 0, 0); PG8_STAGE(PG8_SA(1, 1), a1 + hstep, voffA);
            PG8_WAIT_V(8); PG8_WAIT_L(0); PG8_BAR; PG8_MMA(0, 0, At, B0); PG8_MMA(0, 1, At, B1); PG8_BAR; PG8_SCHED;
            PG8_LDA(At, 0, 1); PG8_STAGE(PG8_SB(0, 0), b2, voffB); PG8_STAGE(PG8_SB(0, 1), b2 + hstep, voffB); PG8_STAGE(PG8_SA(0, 0), a2, voffA);
            PG8_WAIT_V(8); PG8_WAIT_L(0); PG8_BAR; PG8_MMA(1, 0, At, B0); PG8_MMA(1, 1, At, B1); PG8_BAR; PG8_SCHED;
            PG8_LDB(B0, 1, 0); PG8_LDB(B1, 1, 1); PG8_SCHED; PG8_LDA(At, 1, 0); PG8_STAGE(PG8_SA(0, 1), a2 + hstep, voffA);
            PG8_WAIT_V(8); PG8_WAIT_L(0); PG8_BAR; PG8_MMA(0, 0, At, B0); PG8_MMA(0, 1, At, B1); PG8_BAR; PG8_SCHED;
            PG8_LDA(At, 1, 1); PG8_STAGE(PG8_SB(1, 0), b3, voffB); PG8_STAGE(PG8_SB(1, 1), b3 + hstep, voffB); PG8_STAGE(PG8_SA(1, 0), a3, voffA);
            PG8_WAIT_V(8); PG8_WAIT_L(0); PG8_BAR; PG8_MMA(1, 0, At, B0); PG8_MMA(1, 1, At, B1); PG8_BAR; PG8_SCHED;
            } else {
            PG8_LDB(B0, 0, 0); PG8_SCHED; PG8_LDA(At, 0, 0); PG8_STAGE(PG8_SA(1, 1), a1 + hstep, voffA);
            PG8_WAIT_L(8); PG8_BAR; PG8_WAIT_L(0); PG8_MMA(0, 0, At, B0); PG8_BAR; PG8_SCHED;
            PG8_LDB(B1, 0, 1); PG8_STAGE(PG8_SB(0, 0), b2, voffB);
            PG8_BAR; PG8_WAIT_L(0); PG8_MMA(0, 1, At, B1); PG8_BAR;
            PG8_LDA(At, 0, 1); PG8_STAGE(PG8_SA(0, 0), a2, voffA);
            PG8_BAR; PG8_WAIT_L(0); PG8_MMA(1, 0, At, B0); PG8_BAR; PG8_SCHED;
            PG8_STAGE(PG8_SB(0, 1), b2 + hstep, voffB);
            PG8_WAIT_V(6); PG8_BAR; PG8_MMA(1, 1, At, B1); PG8_BAR;
            PG8_LDB(B0, 1, 0); PG8_SCHED; PG8_LDA(At, 1, 0); PG8_STAGE(PG8_SA(0, 1), a2 + hstep, voffA);
            PG8_WAIT_L(8); PG8_BAR; PG8_WAIT_L(0); PG8_MMA(0, 0, At, B0); PG8_BAR; PG8_SCHED;
            PG8_LDB(B1, 1, 1); PG8_STAGE(PG8_SB(1, 0), b3, voffB);
            PG8_BAR; PG8_WAIT_L(0); PG8_MMA(0, 1, At, B1); PG8_BAR;
            PG8_LDA(At, 1, 1); PG8_STAGE(PG8_SA(1, 0), a3, voffA);
            PG8_BAR; PG8_WAIT_L(0); PG8_MMA(1, 0, At, B0); PG8_BAR; PG8_SCHED;
            PG8_STAGE(PG8_SB(1, 1), b3 + hstep, voffB);
            PG8_WAIT_V(6); PG8_BAR; PG8_MMA(1, 1, At, B1); PG8_BAR;
            }
        }
        if constexpr (ALIGN_EPI) { if (wr == 0) PG8_BAR; }
        if constexpr (!Epi::AFTER_DRAIN) { E(acc, cur, wr, wc, fr, fq); S.done(cur); }
        if (!has_next) break;
#pragma unroll
        for (int a = 0; a < 2; ++a)
#pragma unroll
            for (int b = 0; b < 2; ++b)
#pragma unroll
                for (int m = 0; m < 4; ++m)
#pragma unroll
                    for (int n = 0; n < 2; ++n) acc[a][b][m][n] = (f32x4){0.f, 0.f, 0.f, 0.f};
        cur = nxt; cA = nA; cB = nB; ++ui;
        if constexpr (ALIGN_EPI) { if (wr == 1) PG8_BAR; }
    }
    PG8_WAIT_V(0);
    if constexpr (!ALIGN_EPI) { if (wr == 0) PG8_BAR; }
    PG8_BAR;
    if constexpr (Epi::AFTER_DRAIN) { E.fused(acc, cur, wr, wc, fr, fq, lds, wid, lane); S.done(cur); }
#undef PG8_SA
#undef PG8_SB
#undef PG8_STAGE
#undef PG8_LDA
#undef PG8_LDB
#undef PG8_MMA
#undef PG8_WAIT_V
#undef PG8_WAIT_L
#undef PG8_BAR
#undef PG8_SCHED
}
}
#define GAS __attribute__((address_space(1)))
#define LAS __attribute__((address_space(3)))
typedef unsigned short bf16;
typedef unsigned v4u __attribute__((ext_vector_type(4)));
typedef float f32x4 __attribute__((ext_vector_type(4)));
typedef short bf16x8 __attribute__((ext_vector_type(8)));
typedef GAS unsigned gu32;
typedef GAS unsigned long long gu64;
#define RLX_AGENT __ATOMIC_RELAXED, __HIP_MEMORY_SCOPE_AGENT
#define LDS_WAIT() asm volatile("s_waitcnt lgkmcnt(0)" ::: "memory")
#define VM_WAIT() asm volatile("s_waitcnt vmcnt(0)" ::: "memory")
__device__ __forceinline__ unsigned long long rt() { return __builtin_amdgcn_s_memrealtime(); }
__device__ __forceinline__ unsigned f2bf(float f) { unsigned u = __builtin_bit_cast(unsigned, f); return (u + 0x7fffu + ((u >> 16) & 1u)) >> 16; }
__device__ __forceinline__ unsigned pk2(float lo, float hi) { return f2bf(lo) | (f2bf(hi) << 16); }
#define XB_TMO      128
#define XB_XCNT(j)  (256  + 64 * (j))
#define XB_XSUB(j)  (1280 + 64 * (j))
#define XB_XGEN(j)  (2304 + 64 * (j))
#define XB_TOP      3328
#define XB_TOPGEN   3392
#define XCD_BAR_WORDS 3456
#define XB_SPIN_CAP (1u << 18)

__device__ __forceinline__ unsigned xb_ld(unsigned* p)              { return __hip_atomic_load(p, __ATOMIC_RELAXED, __HIP_MEMORY_SCOPE_AGENT); }
__device__ __forceinline__ unsigned xb_add(unsigned* p, unsigned v) { return __hip_atomic_fetch_add(p, v, __ATOMIC_RELAXED, __HIP_MEMORY_SCOPE_AGENT); }
__device__ __forceinline__ unsigned xb_xcc_id() { return (unsigned)__builtin_amdgcn_s_getreg((3 << 11) | 20) & 0xFu; }
#define XB_SPIN(cond, bar) do { unsigned _sp = 0; while (cond) { __builtin_amdgcn_s_sleep(1); \
    if ((++_sp & 255u) == 0u) { if (xb_ld(&(bar)[XB_TMO])) break; if (_sp > XB_SPIN_CAP) { atomicAdd(&(bar)[XB_TMO], 1u); break; } } } } while (0)

struct XcdBarrier {
    unsigned* bar; unsigned x;
    volatile LAS unsigned* st;
};

__device__ __forceinline__ XcdBarrier xcd_barrier_post(unsigned* bar, volatile LAS unsigned* st) {
    XcdBarrier b; b.bar = bar; b.x = xb_xcc_id(); b.st = st;
    if (threadIdx.x == 0) (void)xb_add(&bar[XB_XCNT(b.x)], 1u);
    return b;
}
__device__ __forceinline__ void xcd_barrier_complete(unsigned* bar, unsigned x, unsigned& nloc, unsigned& nx) {
    const unsigned G = gridDim.x * gridDim.y * gridDim.z;
    unsigned sum, cnt, mine, sp = 0u;
    for (;;) {
        sum = 0u; cnt = 0u; mine = 0u;
#pragma unroll
        for (unsigned j = 0; j < 16; ++j) { const unsigned c = xb_ld(&bar[XB_XCNT(j)]); sum += c; cnt += (c > 0u) ? 1u : 0u; mine = (j == x) ? c : mine; }
        if (sum == G) break;
        __builtin_amdgcn_s_sleep(1);
        if ((++sp & 255u) == 0u) { if (xb_ld(&bar[XB_TMO])) break; if (sp > XB_SPIN_CAP) { atomicAdd(&bar[XB_TMO], 1u); break; } }
    }
    nloc = mine > 0u ? mine : 1u; nx = cnt > 0u ? cnt : 1u;
}

__device__ __forceinline__ void xcd_barrier(const XcdBarrier& b) {
    asm volatile("s_waitcnt vmcnt(0)" ::: "memory");
    __syncthreads();
    if (threadIdx.x == 0) {
        unsigned* bar = b.bar;
        __builtin_amdgcn_s_waitcnt(0);
        unsigned nloc = b.st[0], nx = b.st[1];
        if (nloc == 0u) { xcd_barrier_complete(bar, b.x, nloc, nx); b.st[0] = nloc; b.st[1] = nx; }
        const unsigned old = xb_add(&bar[XB_XSUB(b.x)], 1u);
        const unsigned gen = old / nloc;
        if (old + 1u == (gen + 1u) * nloc) {
            __builtin_amdgcn_fence(__ATOMIC_RELEASE, "agent");
            asm volatile("s_waitcnt vmcnt(0)" ::: "memory");
            const unsigned og = xb_add(&bar[XB_TOP], 1u);
            const unsigned tg = og / nx;
            if (og + 1u == (tg + 1u) * nx) xb_add(&bar[XB_TOPGEN], 1u);
            else XB_SPIN(xb_ld(&bar[XB_TOPGEN]) == tg, bar);
            __builtin_amdgcn_fence(__ATOMIC_ACQUIRE, "agent");
            xb_add(&bar[XB_XGEN(b.x)], 1u);
            asm volatile("s_waitcnt vmcnt(0)" ::: "memory");
        } else {
            XB_SPIN(xb_ld(&bar[XB_XGEN(b.x)]) == gen, bar);
            __builtin_amdgcn_fence(__ATOMIC_ACQUIRE, "agent");
            asm volatile("s_waitcnt vmcnt(0)" ::: "memory");
        }
    }
    __syncthreads();
}
constexpr int NWAVES = 8;
constexpr int D = 2048, SEQ = 8192, MP = 32768, MS = 128, MR = 32896, MT = 33024;
constexpr int DFF = 5632, NA = 5376, NBQ = 2048, NKV = 3072;
constexpr int CQ = 0, CK = 768, CV = 1536, CG = 3072, CQM = 4608, CLR = 5120;
constexpr float DN_ALPHA = 1.6817928305074292f, LN_EPS = 1e-5f, RMS_EPS = 1e-6f;
constexpr float GLA_QSCALE = 0.07216878364870323f, HD_SCALE = 0.08838834764831845f;
constexpr size_t MiB = 1u << 20;
constexpr size_t WS_CTL = 0, CTL_ZERO_BYTES = 1 * MiB;
constexpr size_t WS_WIN = 1 * MiB, WS_WO = 22 * MiB, WS_WFI = 30 * MiB, WS_WFO = 74 * MiB, WS_WMEM = 96 * MiB, WS_MEMX = 112 * MiB, WS_MEMK = 116 * MiB, WS_MEMV = 128 * MiB;
constexpr size_t WS_X = 140 * MiB, WS_Y = 269 * MiB, WS_R1 = 527 * MiB, WS_OCAT = 882 * MiB, WS_SBKS = 1011 * MiB, WS_SBVS = 1060 * MiB, WS_END = 1109 * MiB;
static_assert(WS_WIN + (size_t)NA * D * 2 <= WS_WO && WS_WFI + (size_t)2 * DFF * D * 2 <= WS_WFO && WS_WFO + (size_t)D * DFF * 2 <= WS_WMEM, "weights map");
static_assert(WS_X + (size_t)MT * D * 2 <= WS_Y && WS_Y + (size_t)MT * D * 4 <= WS_R1 && WS_R1 + (size_t)MT * DFF * 2 <= WS_OCAT && WS_OCAT + (size_t)MT * D * 2 <= WS_SBKS, "activation map");
static_assert(WS_SBKS + (size_t)8 * 2064 * 1536 * 2 <= WS_SBVS && WS_SBVS + (size_t)8 * 2064 * 1536 * 2 <= WS_END, "sb sample map");
constexpr size_t O_YP = 0, O_YS = 67108864, O_GSP = 67371008, O_GSS = 69730304, O_SKP = 74448896, O_SVP = 124780544, O_SKS = 175112192, O_SVS = 175308800, O_MKP = 175505408, O_MVP = 177602560, O_END = 179699712;
constexpr int CW_BAR = 4096;
constexpr int RING_OFF = 0, RING_BYTES = 131072, LDSCTL_OFF = RING_BYTES, MISC_OFF = LDSCTL_OFF + 320, LDS_BYTES = 147456;

struct Args { const float* in[22]; float* out_; unsigned char* ws_; int ph_lo, ph_hi; };
struct Frame {
    LAS unsigned char* lds; volatile LAS unsigned* MISC; gu32* ctl;
    int tid, lane, wave, G, gw, NGW;
};
__device__ __forceinline__ float bf2f(bf16 h) { return __builtin_bit_cast(float, (unsigned)h << 16); }
__device__ __forceinline__ float shx(float v, int lane, int m) { return __builtin_bit_cast(float, __builtin_amdgcn_ds_bpermute((lane ^ m) << 2, __builtin_bit_cast(int, v))); }
__device__ __forceinline__ float wave_sum(float v, int lane) {
#pragma unroll
    for (int o = 1; o < 64; o <<= 1) v += shx(v, lane, o);
    return v;
}
__device__ __forceinline__ float wave_max(float v, int lane) {
#pragma unroll
    for (int o = 1; o < 64; o <<= 1) v = fmaxf(v, shx(v, lane, o));
    return v;
}
__device__ __forceinline__ void cvt_row(const float* src, bf16* dst, int n, int lane) {
    for (int j = lane * 4; j < n; j += 256) {
        f32x4 v = src ? *(const f32x4*)(src + j) : (f32x4){0.f, 0.f, 0.f, 0.f};
        unsigned long long w = (unsigned long long)pk2(v.x, v.y) | ((unsigned long long)pk2(v.z, v.w) << 32);
        *(unsigned long long*)(dst + j) = w;
    }
}
template <bool FINAL>
__device__ __forceinline__ void ln_two_rows(int lane, const bf16* y0, const bf16* y1, const float* gg, const float* bb, bf16* x0, bf16* x1, float* of0, float* of1) {
    v4u w[2][4];
#pragma unroll
    for (int j = 0; j < 4; ++j) { w[0][j] = ((const v4u*)y0)[lane + 64 * j]; w[1][j] = ((const v4u*)y1)[lane + 64 * j]; }
    float v[2][4][8]; float s[2] = {0.f, 0.f};
#pragma unroll
    for (int r = 0; r < 2; ++r)
#pragma unroll
        for (int j = 0; j < 4; ++j) { const v4u q = w[r][j]; v[r][j][0] = pg8::bflo(q.x); v[r][j][1] = pg8::bfhi(q.x); v[r][j][2] = pg8::bflo(q.y); v[r][j][3] = pg8::bfhi(q.y); v[r][j][4] = pg8::bflo(q.z); v[r][j][5] = pg8::bfhi(q.z); v[r][j][6] = pg8::bflo(q.w); v[r][j][7] = pg8::bfhi(q.w);
            s[r] += ((v[r][j][0] + v[r][j][1]) + (v[r][j][2] + v[r][j][3])) + ((v[r][j][4] + v[r][j][5]) + (v[r][j][6] + v[r][j][7])); }
    const float m0 = wave_sum(s[0], lane) * (1.f / D), m1 = wave_sum(s[1], lane) * (1.f / D); float q0 = 0.f, q1 = 0.f;
#pragma unroll
    for (int j = 0; j < 4; ++j)
#pragma unroll
        for (int i = 0; i < 8; ++i) { v[0][j][i] -= m0; q0 += v[0][j][i] * v[0][j][i]; v[1][j][i] -= m1; q1 += v[1][j][i] * v[1][j][i]; }
    const float rs[2] = {1.f / sqrtf(wave_sum(q0, lane) * (1.f / D) + LN_EPS), 1.f / sqrtf(wave_sum(q1, lane) * (1.f / D) + LN_EPS)};
#pragma unroll
    for (int j = 0; j < 4; ++j) { const int e0 = (lane + 64 * j) * 8; const f32x4 g0 = *(const f32x4*)(gg + e0), g1 = *(const f32x4*)(gg + e0 + 4), b0 = *(const f32x4*)(bb + e0), b1 = *(const f32x4*)(bb + e0 + 4);
#pragma unroll
        for (int r = 0; r < 2; ++r) { float o[8];
#pragma unroll
            for (int i = 0; i < 4; ++i) { o[i] = v[r][j][i] * rs[r] * g0[i] + b0[i]; o[4 + i] = v[r][j][4 + i] * rs[r] * g1[i] + b1[i]; }
            if (FINAL) { float* of = r ? of1 : of0; *(f32x4*)(of + e0) = (f32x4){o[0], o[1], o[2], o[3]}; *(f32x4*)(of + e0 + 4) = (f32x4){o[4], o[5], o[6], o[7]}; }
            else { v4u p; p.x = pk2(o[0], o[1]); p.y = pk2(o[2], o[3]); p.z = pk2(o[4], o[5]); p.w = pk2(o[6], o[7]); *(v4u*)((r ? x1 : x0) + e0) = p; } } }
}
struct MapId { __device__ __forceinline__ int operator()(int n) const { return n; } };
struct MapInA { __device__ __forceinline__ int operator()(int n) const { return n < 4608 ? n : (n < 5120 ? n + 16 : (n < 5136 ? n - 512 : -1)); } };
struct MapFfn { __device__ __forceinline__ int operator()(int n) const { const int t = n >> 8, r = n & 255; return r < 128 ? 128 * t + r : DFF + 128 * t + (r - 128); } };
template <class Map>
__device__ __forceinline__ void wt_convert(LAS unsigned char* ldsb, int wave, int gw, int NGW, int lane, const float* W, int K, int Nsrc, bf16* WT, int Ndst, Map map) {
    LAS float* scr = (LAS float*)(ldsb + RING_OFF + wave * 16384);
    const int nblk = Ndst / 64, nitems = (K / 64) * nblk, nq = lane & 15, kq = lane >> 4;
    for (int it = gw; it < nitems; it += NGW) {
        const int kb = it / nblk, nb = it % nblk, k0 = 64 * kb, n0 = 64 * nb;
        const int sc0 = map(n0 + 4 * nq), sc3 = map(n0 + 4 * nq + 3);
        const bool contig = sc0 >= 0 && sc3 == sc0 + 3;
        f32x4 v[16];
#pragma unroll
        for (int i = 0; i < 16; ++i) { const int kk = 4 * i + kq;
            if (contig) v[i] = *(const f32x4*)(W + (size_t)(k0 + kk) * Nsrc + sc0);
            else {
#pragma unroll
                for (int e = 0; e < 4; ++e) { const int sc = map(n0 + 4 * nq + e); v[i][e] = sc >= 0 ? W[(size_t)(k0 + kk) * Nsrc + sc] : 0.f; } } }
#pragma unroll
        for (int i = 0; i < 16; ++i) { const int kk = 4 * i + kq;
#pragma unroll
            for (int e = 0; e < 4; ++e) { const int n = 4 * nq + e; scr[n * 64 + (kk ^ n)] = v[i][e]; } }
        LDS_WAIT(); asm volatile("" ::: "memory");
        const int c = lane & 7;
#pragma unroll
        for (int j = 0; j < 8; ++j) { const int n = (lane >> 3) + 8 * j; const LAS float* s = scr + n * 64;
#define SWZ(i) s[(8 * c + (i)) ^ n]
            v4u o; o.x = pk2(SWZ(0), SWZ(1)); o.y = pk2(SWZ(2), SWZ(3)); o.z = pk2(SWZ(4), SWZ(5)); o.w = pk2(SWZ(6), SWZ(7));
#undef SWZ
            *(GAS v4u*)(WT + (size_t)(n0 + n) * K + k0 + 8 * c) = o; }
        LDS_WAIT(); asm volatile("" ::: "memory");
    }
}
__device__ __forceinline__ float softplus_f(float z) { return fmaxf(z, 0.f) + log1pf(__expf(-fabsf(z))); }

typedef short s16x4 __attribute__((ext_vector_type(4)));
typedef pg8::u32x2 u32x2;
typedef float f32x16 __attribute__((ext_vector_type(16)));
typedef __bf16 bf16x2_t __attribute__((ext_vector_type(2)));
typedef float f32x2_t __attribute__((ext_vector_type(2)));
__device__ __forceinline__ unsigned cvt2(float lo, float hi) { const f32x2_t v = {lo, hi}; const bf16x2_t b = __builtin_convertvector(v, bf16x2_t); return __builtin_bit_cast(unsigned, b); }
__device__ __forceinline__ bf16x8 pack8(const f32x4 a, const f32x4 b) { v4u p; p.x = cvt2(a[0], a[1]); p.y = cvt2(a[2], a[3]); p.z = cvt2(b[0], b[1]); p.w = cvt2(b[2], b[3]); return __builtin_bit_cast(bf16x8, p); }
__device__ __forceinline__ bf16x8 ld2x8(const bf16* p0, const bf16* p1) { const s16x4 a = *(const s16x4*)p0, b = *(const s16x4*)p1; return __builtin_shufflevector(a, b, 0, 1, 2, 3, 4, 5, 6, 7); }
__device__ __forceinline__ bf16x8 ld16(const bf16* p) { return *(const bf16x8*)p; }
#define MFMA16(a, b, c) __builtin_amdgcn_mfma_f32_16x16x32_bf16((a), (b), (c), 0, 0, 0)
#define MFMA32(a, b, c) __builtin_amdgcn_mfma_f32_32x32x16_bf16((a), (b), (c), 0, 0, 0)

constexpr int QIMG_LD = 200, KTIMG_LD = 68, PKG_Q = 0, PKG_KT = 25600, PKG_G = 51712, IMG_BYTES = 52480, PKG_K = 52480, PKG_VT = 77056, PKG_BYTES = 126208, N_PKG = 2048 + 32;
static_assert(64 * QIMG_LD * 2 == PKG_KT && PKG_KT + 192 * KTIMG_LD * 2 == PKG_G && PKG_G + 768 == IMG_BYTES && PKG_K + 24576 == PKG_VT && PKG_VT + 49152 == PKG_BYTES && IMG_BYTES % 16 == 0, "package map");

__device__ __forceinline__ float softplus_fast(float z) { return fmaxf(z, 0.f) + __logf(1.0f + __expf(-fabsf(z))); }
__device__ __forceinline__ void gla_prep(int bid, int G, int tid, int wave, LAS unsigned char* lds, int l, const bf16* PROJ, const float* w_gate_lr, const float* b_gate, unsigned char* PKG) {
    const int lane = tid & 63;
    const float* w2 = w_gate_lr + (size_t)l * 16 * 768; const float* bg = b_gate + (size_t)l * 768;
    LAS float* tot = (LAS float*)lds;
    for (int item = bid; item < N_PKG; item += G) {
        int h, row0, T;
        if (item < 2048) { const int bh = item >> 7, ch = item & 127; h = bh & 3; row0 = (bh >> 2) * SEQ + ch * 64; T = 64; }
        else { const int i2 = item - 2048; h = i2 & 3; row0 = MP + (i2 >> 2) * 16; T = 16; }
        unsigned char* pk = PKG + (size_t)item * PKG_BYTES;
        bf16* Qt = (bf16*)(pk + PKG_Q); bf16* Kt = (bf16*)(pk + PKG_K); bf16* KT = (bf16*)(pk + PKG_KT); bf16* VT = (bf16*)(pk + PKG_VT); float* Gp = (float*)(pk + PKG_G);
        float w2c[3][16], bgc[3];
#pragma unroll
        for (int c = 0; c < 3; ++c) { const int d = h * 192 + lane + 64 * c; bgc[c] = bg[d];
#pragma unroll
            for (int r = 0; r < 16; ++r) w2c[c][r] = w2[r * 768 + d]; }
        v4u l0[8], l1[8];
#pragma unroll
        for (int tt = 0; tt < 8; ++tt) { const int t = 8 * wave + tt; const bf16* prow = PROJ + (size_t)(row0 + (t < T ? t : T - 1)) * NA;
            l0[tt] = *(const v4u*)(prow + CLR); l1[tt] = *(const v4u*)(prow + CLR + 8); }
        float lc[8][3]; float run[3] = {0.f, 0.f, 0.f};
#pragma unroll
        for (int tt = 0; tt < 8; ++tt) { const bool ok = 8 * wave + tt < T;
            float lr[16]; lr[0] = pg8::bflo(l0[tt].x); lr[1] = pg8::bfhi(l0[tt].x); lr[2] = pg8::bflo(l0[tt].y); lr[3] = pg8::bfhi(l0[tt].y); lr[4] = pg8::bflo(l0[tt].z); lr[5] = pg8::bfhi(l0[tt].z); lr[6] = pg8::bflo(l0[tt].w); lr[7] = pg8::bfhi(l0[tt].w);
            lr[8] = pg8::bflo(l1[tt].x); lr[9] = pg8::bfhi(l1[tt].x); lr[10] = pg8::bflo(l1[tt].y); lr[11] = pg8::bfhi(l1[tt].y); lr[12] = pg8::bflo(l1[tt].z); lr[13] = pg8::bfhi(l1[tt].z); lr[14] = pg8::bflo(l1[tt].w); lr[15] = pg8::bfhi(l1[tt].w);
#pragma unroll
            for (int c = 0; c < 3; ++c) { float xg = bgc[c];
#pragma unroll
                for (int r = 0; r < 16; ++r) xg += lr[r] * w2c[c][r];
                run[c] += ok ? -softplus_fast(-xg) * (1.0f / 16.0f) : 0.f; lc[tt][c] = run[c]; } }
#pragma unroll
        for (int c = 0; c < 3; ++c) tot[wave * 192 + lane + 64 * c] = run[c];
        unsigned qv[8][3], kv[8][3];
#pragma unroll
        for (int tt = 0; tt < 8; ++tt) { const int t = 8 * wave + tt; const bf16* prow = PROJ + (size_t)(row0 + (t < T ? t : T - 1)) * NA + h * 192 + lane;
#pragma unroll
            for (int c = 0; c < 3; ++c) { qv[tt][c] = prow[CQ + 64 * c]; kv[tt][c] = prow[CK + 64 * c]; } }
        __syncthreads();
        float pre[3], all[3];
#pragma unroll
        for (int c = 0; c < 3; ++c) { pre[c] = 0.f; all[c] = 0.f;
#pragma unroll
            for (int w = 0; w < 8; ++w) { const float tv = tot[w * 192 + lane + 64 * c]; all[c] += tv; if (w < wave) pre[c] += tv; } }
        unsigned ktw[3][4];
#pragma unroll
        for (int tt = 0; tt < 8; ++tt) { const int t = 8 * wave + tt; const bool ok = t < T;
#pragma unroll
            for (int c = 0; c < 3; ++c) { const int dl = lane + 64 * c; const float bc = pre[c] + lc[tt][c]; const float eq = __expf(bc), ek = __expf(-bc);
                const unsigned qb = ok ? f2bf(bf2f((bf16)qv[tt][c]) * GLA_QSCALE * eq) : 0u, kb = ok ? f2bf(bf2f((bf16)kv[tt][c]) * ek) : 0u;
                Qt[t * QIMG_LD + dl] = (bf16)qb; Kt[t * 192 + dl] = (bf16)kb;
                if (tt & 1) ktw[c][tt >> 1] |= kb << 16; else ktw[c][tt >> 1] = kb; } }
#pragma unroll
        for (int c = 0; c < 3; ++c) { bf16* kp = KT + (size_t)(lane + 64 * c) * KTIMG_LD + 8 * wave; u32x2 o0, o1; o0.x = ktw[c][0]; o0.y = ktw[c][1]; o1.x = ktw[c][2]; o1.y = ktw[c][3]; *(u32x2*)kp = o0; *(u32x2*)(kp + 4) = o1; }
        if (wave == 0) {
#pragma unroll
            for (int c = 0; c < 3; ++c) Gp[lane + 64 * c] = __expf(all[c]); }
        unsigned vv[6][8];
#pragma unroll
        for (int tt = 0; tt < 8; ++tt) { const int t = 8 * wave + tt; const bf16* prow = PROJ + (size_t)(row0 + (t < T ? t : T - 1)) * NA + CV + h * 384 + lane;
#pragma unroll
            for (int c2 = 0; c2 < 6; ++c2) vv[c2][tt] = t < T ? (unsigned)prow[64 * c2] : 0u; }
#pragma unroll
        for (int c2 = 0; c2 < 6; ++c2) { v4u o; o.x = vv[c2][0] | (vv[c2][1] << 16); o.y = vv[c2][2] | (vv[c2][3] << 16); o.z = vv[c2][4] | (vv[c2][5] << 16); o.w = vv[c2][6] | (vv[c2][7] << 16);
            *(v4u*)(VT + (size_t)(lane + 64 * c2) * 64 + 8 * wave) = o; }
        __syncthreads();
    }
}

__device__ __forceinline__ void gla_intra(int item, int tid, int wave, LAS unsigned char* lds, const unsigned char* PKG, float* OINT) {
    const int lane = tid & 63, fr = lane & 15, fq = lane >> 4;
    int h, row0, nvalid;
    if (item < 2048) { const int bh = item >> 7, ch = item & 127; h = bh & 3; row0 = (bh >> 2) * SEQ + ch * 64; nvalid = 64; }
    else { const int i2 = item - 2048; h = i2 & 3; row0 = MP + (i2 >> 2) * 16; nvalid = 16; }
    const unsigned char* pk = PKG + (size_t)item * PKG_BYTES;
    const bf16* Qt = (const bf16*)(pk + PKG_Q); const bf16* Kt = (const bf16*)(pk + PKG_K); const bf16* VT = (const bf16*)(pk + PKG_VT);
    bf16x8 va[3], vb[3];
#pragma unroll
    for (int k = 0; k < 3; ++k) { const bf16* vr = VT + (size_t)(16 * (3 * wave + k) + fr) * 64 + 4 * fq; va[k] = ld2x8(vr, vr + 16); vb[k] = ld2x8(vr + 32, vr + 48); }
    constexpr int P_LD = 68;
    LAS bf16* P = (LAS bf16*)lds;
#pragma unroll
    for (int rep = 0; rep < 2; ++rep) {
        const int tl = wave + 8 * rep;
        if (tl < 10) {
            const int it = tl < 1 ? 0 : (tl < 3 ? 1 : (tl < 6 ? 2 : 3)), jt = tl - (it * (it + 1)) / 2;
            f32x4 at = {0.f, 0.f, 0.f, 0.f};
            const bf16* qr = Qt + (size_t)(16 * it + fr) * QIMG_LD + 8 * fq; const bf16* kr = Kt + (size_t)(16 * jt + fr) * 192 + 8 * fq;
#pragma unroll
            for (int s = 0; s < 6; ++s) at = MFMA16(ld16(kr + 32 * s), ld16(qr + 32 * s), at);
            if (it == jt) {
#pragma unroll
                for (int jj = 0; jj < 4; ++jj) if (4 * fq + jj > fr) at[jj] = 0.f; }
            u32x2 w; w.x = cvt2(at[0], at[1]); w.y = cvt2(at[2], at[3]);
            *(LAS u32x2*)(P + (16 * it + fr) * P_LD + 16 * jt + 4 * fq) = w;
        } else if (tl == 10 || tl == 11) {
            const int it = tl == 10 ? 0 : 2, jt = tl == 10 ? 1 : 3; u32x2 z; z.x = 0u; z.y = 0u;
            *(LAS u32x2*)(P + (16 * it + fr) * P_LD + 16 * jt + 4 * fq) = z;
        }
    }
    __syncthreads();
#pragma unroll
    for (int it = 0; it < 4; ++it) {
        if (16 * it >= nvalid) break;
        const LAS bf16* pr = P + (16 * it + fr) * P_LD + 4 * fq;
        const s16x4 a0 = *(const LAS s16x4*)pr, a1 = *(const LAS s16x4*)(pr + 16);
        const bf16x8 pf0 = __builtin_shufflevector(a0, a1, 0, 1, 2, 3, 4, 5, 6, 7); bf16x8 pf1 = pf0;
        if (it >= 2) { const s16x4 b0 = *(const LAS s16x4*)(pr + 32), b1 = *(const LAS s16x4*)(pr + 48); pf1 = __builtin_shufflevector(b0, b1, 0, 1, 2, 3, 4, 5, 6, 7); }
#pragma unroll
        for (int k = 0; k < 3; ++k) { f32x4 o = {0.f, 0.f, 0.f, 0.f};
            o = MFMA16(va[k], pf0, o); if (it >= 2) o = MFMA16(vb[k], pf1, o);
            *(f32x4*)(OINT + (size_t)(row0 + 16 * it + fr) * 1536 + h * 384 + 16 * (3 * wave + k) + 4 * fq) = o; }
    }
    __syncthreads();
}

template <int PASS>
__device__ __forceinline__ void gla_chain(int wc, int tid, int wave, LAS unsigned char* lds, int l, const unsigned char* PKG, const float* state_gla, float* OINT, float* out, float* SLOC, float* GSEG, bool dry = false) {
    const int lane = tid & 63, fr = lane & 15, fq = lane >> 4;
    int h, vb, bh, seg, item0, nsteps, row0, nvalid; const float* s0 = nullptr; float* sout = nullptr;
    if (PASS == 1) { bh = wc / 9; const int rem = wc % 9; vb = rem / 3; seg = rem % 3; h = bh & 3; item0 = bh * 128 + 32 * seg; nsteps = 32; row0 = 0; nvalid = 64; }
    else if (wc < 192) { bh = wc / 12; const int rem = wc % 12; vb = rem >> 2; seg = rem & 3; h = bh & 3; item0 = bh * 128 + 32 * seg; nsteps = 32; row0 = (bh >> 2) * SEQ + 2048 * seg; nvalid = 64;
        if (seg == 3) sout = out + O_GSP + (size_t)(l * 16 + bh) * 192 * 384; }
    else { const int c2 = wc - 192; bh = c2 / 3; vb = c2 % 3; seg = 0; h = bh & 3; item0 = 2048 + bh; nsteps = 1; row0 = MP + (bh >> 2) * 16; nvalid = 16; s0 = state_gla + (size_t)(l * 32 + bh) * 192 * 384; sout = out + O_GSS + (size_t)(l * 32 + bh) * 192 * 384; }
    const int v0 = vb * 128 + wave * 16;
#define GLA_WALK(p, step) do { (p) += (step); asm volatile("" : "+v"(p)); } while (0)
    f32x4 S[12];
    if (s0) { const float* p = s0 + (size_t)(4 * fq) * 384 + v0 + fr;
#pragma unroll
        for (int t = 0; t < 12; ++t) {
#pragma unroll
            for (int jj = 0; jj < 4; ++jj) { S[t][jj] = *p; GLA_WALK(p, 384); }
            GLA_WALK(p, 12 * 384); } }
    else {
#pragma unroll
        for (int t = 0; t < 12; ++t) S[t] = (f32x4){0.f, 0.f, 0.f, 0.f}; }
    if (PASS == 2 && wc < 192) {
        for (int j = 0; j < seg; ++j) { const float* gs = GSEG + (size_t)(bh * 3 + j) * 192 + 4 * fq; const float* p = SLOC + (size_t)((bh * 3 + vb) * 3 + j) * 192 * 128 + (size_t)(4 * fq) * 128 + wave * 16 + fr;
#pragma unroll
            for (int t = 0; t < 12; ++t) { const f32x4 g4 = *(const f32x4*)(gs + 16 * t);
#pragma unroll
                for (int jj = 0; jj < 4; ++jj) { S[t][jj] = g4[jj] * S[t][jj] + *p; GLA_WALK(p, 128); }
                GLA_WALK(p, 12 * 128); } }
    }
    f32x4 GP[PASS == 1 ? 12 : 1];
    if (PASS == 1) {
#pragma unroll
        for (int t = 0; t < 12; ++t) GP[t] = (f32x4){1.f, 1.f, 1.f, 1.f}; }
    constexpr int CH0 = PASS == 1 ? PKG_KT / 16 : 0, NCH = IMG_BYTES / 16, NLD = PASS == 1 ? 4 : 7;
    v4u pre[NLD]; bf16x8 vt[2], vtn[2]; f32x4 oin[4];
    { const unsigned char* pk = PKG + (size_t)item0 * PKG_BYTES;
      if (PASS == 2) {
#pragma unroll
        for (int it = 0; it < 4; ++it) { const int tl = 16 * it + fr; oin[it] = tl < nvalid ? *(const f32x4*)(OINT + (size_t)(row0 + tl) * 1536 + h * 384 + v0 + 4 * fq) : (f32x4){0.f, 0.f, 0.f, 0.f}; } }
#pragma unroll
      for (int k = 0; k < NLD; ++k) { const int ch = CH0 + tid + 512 * k; if (ch < NCH) pre[k] = *(const v4u*)(pk + (size_t)ch * 16); }
      const bf16* VT = (const bf16*)(pk + PKG_VT) + (size_t)(v0 + fr) * 64 + 4 * fq; vt[0] = ld2x8(VT, VT + 16); vt[1] = ld2x8(VT + 32, VT + 48);
#pragma unroll
      for (int k = 0; k < NLD; ++k) { const int ch = CH0 + tid + 512 * k; if (ch < NCH) *(LAS v4u*)(lds + (size_t)ch * 16) = pre[k]; }
      vtn[0] = vt[0]; vtn[1] = vt[1]; }
    __syncthreads();
    for (int n = 0; n < nsteps; ++n) {
        const LAS unsigned char* img = lds + (n & 1) * IMG_BYTES;
        const bool more = n + 1 < nsteps;
        if (more) { const unsigned char* pk = PKG + (size_t)(item0 + n + 1) * PKG_BYTES;
#pragma unroll
            for (int k = 0; k < NLD; ++k) { const int ch = CH0 + tid + 512 * k; if (ch < NCH) pre[k] = *(const v4u*)(pk + (size_t)ch * 16); }
            const bf16* VT = (const bf16*)(pk + PKG_VT) + (size_t)(v0 + fr) * 64 + 4 * fq; vtn[0] = ld2x8(VT, VT + 16); vtn[1] = ld2x8(VT + 32, VT + 48); }
        if (PASS == 2) {
            bf16x8 Sb[6];
#pragma unroll
            for (int s = 0; s < 6; ++s) Sb[s] = pack8(S[2 * s], S[2 * s + 1]);
#pragma unroll
            for (int it = 0; it < 4; ++it) {
                const LAS bf16* qr = (const LAS bf16*)(img + PKG_Q) + (16 * it + fr) * QIMG_LD + 4 * fq;
                f32x4 o = oin[it];
#pragma unroll
                for (int s = 0; s < 6; ++s) { const s16x4 a = *(const LAS s16x4*)(qr + 32 * s), b = *(const LAS s16x4*)(qr + 32 * s + 16);
                    o = MFMA16(Sb[s], __builtin_shufflevector(a, b, 0, 1, 2, 3, 4, 5, 6, 7), o); }
                const int tl = 16 * it + fr;
                if (tl < nvalid && !dry) *(f32x4*)(OINT + (size_t)(row0 + 64 * n + tl) * 1536 + h * 384 + v0 + 4 * fq) = o;
                __builtin_amdgcn_sched_barrier(0);
            }
            if (more) {
#pragma unroll
                for (int it = 0; it < 4; ++it) oin[it] = *(const f32x4*)(OINT + (size_t)(row0 + 64 * (n + 1) + 16 * it + fr) * 1536 + h * 384 + v0 + 4 * fq); }
        }
#pragma unroll
        for (int t = 0; t < 12; ++t) { const LAS bf16* kr = (const LAS bf16*)(img + PKG_KT) + (16 * t + fr) * KTIMG_LD + 4 * fq;
#pragma unroll
            for (int s2 = 0; s2 < 2; ++s2) { const s16x4 a = *(const LAS s16x4*)(kr + 32 * s2), b = *(const LAS s16x4*)(kr + 32 * s2 + 16);
                S[t] = MFMA16(__builtin_shufflevector(a, b, 0, 1, 2, 3, 4, 5, 6, 7), vt[s2], S[t]); }
            const f32x4 g4 = *(const LAS f32x4*)(img + PKG_G + (16 * t + 4 * fq) * 4);
            S[t] = S[t] * g4; if (PASS == 1) GP[t] = GP[t] * g4; if (t & 1) __builtin_amdgcn_sched_barrier(0); }
        if (more) { LAS unsigned char* nimg = lds + ((n + 1) & 1) * IMG_BYTES;
#pragma unroll
            for (int k = 0; k < NLD; ++k) { const int ch = CH0 + tid + 512 * k; if (ch < NCH) *(LAS v4u*)(nimg + (size_t)ch * 16) = pre[k]; }
            vt[0] = vtn[0]; vt[1] = vtn[1]; }
        asm volatile("s_waitcnt lgkmcnt(0)" ::: "memory"); __builtin_amdgcn_s_barrier(); asm volatile("" ::: "memory");
    }
    if (PASS == 1) {
        float* p = SLOC + (size_t)((bh * 3 + vb) * 3 + seg) * 192 * 128 + (size_t)(4 * fq) * 128 + wave * 16 + fr;
#pragma unroll
        for (int t = 0; t < 12; ++t) {
#pragma unroll
            for (int jj = 0; jj < 4; ++jj) { *p = S[t][jj]; GLA_WALK(p, 128); }
            GLA_WALK(p, 12 * 128); }
        if (vb == 0 && wave == 0 && fr == 0) { float* gs = GSEG + (size_t)(bh * 3 + seg) * 192;
#pragma unroll
            for (int t = 0; t < 12; ++t) *(f32x4*)(gs + 16 * t + 4 * fq) = GP[t]; }
    } else if (sout) {
        float* p = sout + (size_t)(4 * fq) * 384 + v0 + fr;
#pragma unroll
        for (int t = 0; t < 12; ++t) {
#pragma unroll
            for (int jj = 0; jj < 4; ++jj) { *p = S[t][jj]; GLA_WALK(p, 384); }
            GLA_WALK(p, 12 * 384); }
    }
#undef GLA_WALK
}

__device__ __forceinline__ void mem_attn(int item, int lane, int l, const bf16* PROJ, int ldp, int cqm, const bf16* MEMK, const bf16* MEMVT, bf16* OCAT) {
    const int fr = lane & 15, fq = lane >> 4, tile = item >> 2, h = item & 3, r0 = tile * 16;
    const int bb = r0 < MP ? r0 / SEQ : 4 + ((r0 - MP) >> 4);
    const bf16* Kb = MEMK + (size_t)((l * 12 + bb) * 256) * 512 + h * 128; const bf16* Vt = MEMVT + (size_t)(((l * 12 + bb) * 4 + h) * 128) * 256;
    bf16x8 qf[4];
#pragma unroll
    for (int s = 0; s < 4; ++s) qf[s] = ld16(PROJ + (size_t)(r0 + fr) * ldp + cqm + h * 128 + 32 * s + 8 * fq);
    f32x4 st[16];
#pragma unroll
    for (int mt = 0; mt < 16; ++mt) { st[mt] = (f32x4){0.f, 0.f, 0.f, 0.f}; const bf16* kr = Kb + (size_t)(16 * mt + fr) * 512 + 8 * fq;
#pragma unroll
        for (int s = 0; s < 4; ++s) st[mt] = MFMA16(ld16(kr + 32 * s), qf[s], st[mt]); }
    float mx = -3.0e38f;
#pragma unroll
    for (int mt = 0; mt < 16; ++mt) mx = fmaxf(mx, fmaxf(fmaxf(st[mt][0], st[mt][1]), fmaxf(st[mt][2], st[mt][3])));
    mx = fmaxf(mx, shx(mx, lane, 16)); mx = fmaxf(mx, shx(mx, lane, 32));
    float sum = 0.f;
#pragma unroll
    for (int mt = 0; mt < 16; ++mt)
#pragma unroll
        for (int jj = 0; jj < 4; ++jj) { const float p = __expf((st[mt][jj] - mx) * HD_SCALE); st[mt][jj] = p; sum += p; }
    sum += shx(sum, lane, 16); sum += shx(sum, lane, 32);
    const float inv = 1.0f / sum;
    bf16x8 pf[8];
#pragma unroll
    for (int s = 0; s < 8; ++s) pf[s] = pack8(st[2 * s], st[2 * s + 1]);
#pragma unroll
    for (int dt = 0; dt < 8; ++dt) { f32x4 o = {0.f, 0.f, 0.f, 0.f}; const bf16* vr = Vt + (size_t)(16 * dt + fr) * 256 + 4 * fq;
#pragma unroll
        for (int s = 0; s < 8; ++s) o = MFMA16(ld2x8(vr + 32 * s, vr + 32 * s + 16), pf[s], o);
        u32x2 w; w.x = cvt2(o[0] * inv, o[1] * inv); w.y = cvt2(o[2] * inv, o[3] * inv);
        *(u32x2*)(OCAT + (size_t)(r0 + fr) * D + 1536 + h * 128 + 16 * dt + 4 * fq) = w; }
}

__device__ __forceinline__ void mem_attn_wg(int wi, int tid, int wave, LAS unsigned char* lds, int l, const bf16* PROJ, int ldp, int cqm, const bf16* MEMK, const bf16* MEMVT, bf16* OCAT) {
    const bool smp = wi >= 256; const int lane = tid & 63, fr = lane & 15, fq = lane >> 4, bh = smp ? (wi - 256) : (wi >> 4), sub = wi & 15, b = smp ? 4 + (bh >> 2) : (bh >> 2), h = bh & 3;
    const bf16* Kb = MEMK + (size_t)((l * 12 + b) * 256) * 512 + h * 128; const bf16* Vt = MEMVT + (size_t)(((l * 12 + b) * 4 + h) * 128) * 256;
#pragma unroll
    for (int k = 0; k < 8; ++k) { const int idx = tid + 512 * k, row = idx >> 4, c = idx & 15; *(LAS v4u*)(lds + row * 256 + ((c ^ (row & 15)) << 4)) = *(const v4u*)(Kb + (size_t)row * 512 + c * 8); }
#pragma unroll
    for (int k = 0; k < 8; ++k) { const int idx = tid + 512 * k, row = idx >> 5, c = idx & 31; *(LAS v4u*)(lds + 65536 + row * 512 + ((c ^ (2 * (row & 15))) << 4)) = *(const v4u*)(Vt + (size_t)row * 256 + c * 8); }
    __syncthreads();
    unsigned koff[4], voff[16];
#pragma unroll
    for (int s2 = 0; s2 < 4; ++s2) { koff[s2] = (unsigned)(fr * 256 + (((4 * s2 + fq) ^ fr) << 4)); asm volatile("" : "+v"(koff[s2])); }
#pragma unroll
    for (int s2 = 0; s2 < 8; ++s2) { const int p0 = 8 * s2 + fq, p1 = p0 + 4;
        voff[2 * s2] = (unsigned)(65536 + fr * 512 + ((((p0 >> 1) ^ (2 * fr)) << 4) | ((p0 & 1) << 3))); voff[2 * s2 + 1] = (unsigned)(65536 + fr * 512 + ((((p1 >> 1) ^ (2 * fr)) << 4) | ((p1 & 1) << 3)));
        asm volatile("" : "+v"(voff[2 * s2]), "+v"(voff[2 * s2 + 1])); }
    const int nblk = smp ? (wave == 0 ? 1 : 0) : 4;
#pragma unroll 1
    for (int blk = 0; blk < nblk; ++blk) {
        const int r0 = smp ? MP + (b - 4) * 16 : b * SEQ + sub * 512 + blk * 128 + wave * 16;
        bf16x8 qf[4];
#pragma unroll
        for (int s = 0; s < 4; ++s) qf[s] = ld16(PROJ + (size_t)(r0 + fr) * ldp + cqm + h * 128 + 32 * s + 8 * fq);
        f32x4 st[16];
#pragma unroll
        for (int mt = 0; mt < 16; ++mt) { st[mt] = (f32x4){0.f, 0.f, 0.f, 0.f};
#pragma unroll
            for (int s = 0; s < 4; ++s) st[mt] = MFMA16(*(const LAS bf16x8*)(lds + koff[s] + mt * 4096), qf[s], st[mt]);
            if ((mt & 3) == 3) __builtin_amdgcn_sched_barrier(0); }
        float mx = -3.0e38f;
#pragma unroll
        for (int mt = 0; mt < 16; ++mt) mx = fmaxf(mx, fmaxf(fmaxf(st[mt][0], st[mt][1]), fmaxf(st[mt][2], st[mt][3])));
        mx = fmaxf(mx, shx(mx, lane, 16)); mx = fmaxf(mx, shx(mx, lane, 32));
        float sum = 0.f;
#pragma unroll
        for (int mt = 0; mt < 16; ++mt)
#pragma unroll
            for (int jj = 0; jj < 4; ++jj) { const float p = __expf((st[mt][jj] - mx) * HD_SCALE); st[mt][jj] = p; sum += p; }
        sum += shx(sum, lane, 16); sum += shx(sum, lane, 32);
        const float inv = 1.0f / sum;
        bf16x8 pf[8];
#pragma unroll
        for (int s = 0; s < 8; ++s) pf[s] = pack8(st[2 * s], st[2 * s + 1]);
#pragma unroll
        for (int dt = 0; dt < 8; ++dt) { f32x4 o = {0.f, 0.f, 0.f, 0.f};
#pragma unroll
            for (int s = 0; s < 8; ++s) { const s16x4 a = *(const LAS s16x4*)(lds + voff[2 * s] + dt * 8192), bb = *(const LAS s16x4*)(lds + voff[2 * s + 1] + dt * 8192);
                o = MFMA16(__builtin_shufflevector(a, bb, 0, 1, 2, 3, 4, 5, 6, 7), pf[s], o); }
            u32x2 w; w.x = cvt2(o[0] * inv, o[1] * inv); w.y = cvt2(o[2] * inv, o[3] * inv);
            *(u32x2*)(OCAT + (size_t)(r0 + fr) * D + 1536 + h * 128 + 16 * dt + 4 * fq) = w;
            if (dt & 1) __builtin_amdgcn_sched_barrier(0); }
    }
    __syncthreads();
}

__device__ __forceinline__ void sb_attn(int lane, LAS unsigned char* wlds, const bf16* Kp, int ldk, const bf16* VTp, int ldvt, const bf16* Qp, int ldq, bf16* Op, int t0, int nq) {
    const int r = lane & 31, hh = lane >> 5;
    LAS bf16x8* qs = (LAS bf16x8*)wlds + lane;
#pragma unroll
    for (int ks = 0; ks < 8; ++ks) qs[64 * ks] = ld16(Qp + (size_t)r * ldq + 16 * ks + 8 * hh);
    f32x16 oacc[4];
#pragma unroll
    for (int dt = 0; dt < 4; ++dt)
#pragma unroll
        for (int i = 0; i < 16; ++i) oacc[dt][i] = 0.f;
    float carry = 0.f;
    bf16x8 kf[8];
    { const bf16* kr = Kp + (size_t)(t0 + r) * ldk + 8 * hh;
#pragma unroll
      for (int ks = 0; ks < 8; ++ks) kf[ks] = ld16(kr + 16 * ks); }
    for (int s0 = t0; s0 >= 0; s0 -= 32) {
        bf16x8 vf[8];
#pragma unroll
        for (int k2 = 0; k2 < 2; ++k2)
#pragma unroll
            for (int dt = 0; dt < 4; ++dt) { const bf16* vr = VTp + (size_t)(s0 >> 5) * 4096 + (32 * dt + r) * 32 + 16 * k2 + 4 * hh; vf[4 * k2 + dt] = ld2x8(vr, vr + 8); }
        f32x16 st;
#pragma unroll
        for (int i = 0; i < 16; ++i) st[i] = 0.f;
#pragma unroll
        for (int ks = 0; ks < 8; ++ks) st = MFMA32(kf[ks], qs[64 * ks], st);
        { const int sn = s0 >= 32 ? s0 - 32 : 0; const bf16* kr = Kp + (size_t)(sn + r) * ldk + 8 * hh;
#pragma unroll
          for (int ks = 0; ks < 8; ++ks) kf[ks] = ld16(kr + 16 * ks); }
        const bool diag = (s0 == t0);
        float l1[16], lb[16];
#pragma unroll
        for (int i = 0; i < 16; ++i) { const float z = st[i] * HD_SCALE, sp = softplus_fast(z); lb[i] = z - sp; l1[i] = -sp;
            if (diag && !(((i & 3) + 8 * (i >> 2) + 4 * hh) < r)) { l1[i] = 0.f; lb[i] = -1.0e30f; } }
        float g[4], pgv[4];
#pragma unroll
        for (int m = 0; m < 4; ++m) { g[m] = (l1[4 * m] + l1[4 * m + 1]) + (l1[4 * m + 2] + l1[4 * m + 3]); pgv[m] = shx(g[m], lane, 32); }
        float R[4]; R[3] = 0.f; R[2] = g[3] + pgv[3]; R[1] = R[2] + g[2] + pgv[2]; R[0] = R[1] + g[1] + pgv[1];
        const float total = R[0] + g[0] + pgv[0];
#pragma unroll
        for (int m = 0; m < 4; ++m) { const float suf = carry + R[m] + (hh == 0 ? pgv[m] : 0.f);
            const float t3 = suf, t2 = t3 + l1[4 * m + 3], t1 = t2 + l1[4 * m + 2], t0_ = t1 + l1[4 * m + 1];
            lb[4 * m + 3] = __expf(lb[4 * m + 3] + t3); lb[4 * m + 2] = __expf(lb[4 * m + 2] + t2); lb[4 * m + 1] = __expf(lb[4 * m + 1] + t1); lb[4 * m] = __expf(lb[4 * m] + t0_); }
        carry += total;
#pragma unroll
        for (int k2 = 0; k2 < 2; ++k2) {
            v4u p; p.x = cvt2(lb[8 * k2], lb[8 * k2 + 1]); p.y = cvt2(lb[8 * k2 + 2], lb[8 * k2 + 3]); p.z = cvt2(lb[8 * k2 + 4], lb[8 * k2 + 5]); p.w = cvt2(lb[8 * k2 + 6], lb[8 * k2 + 7]);
            const bf16x8 wf = __builtin_bit_cast(bf16x8, p);
#pragma unroll
            for (int dt = 0; dt < 4; ++dt) oacc[dt] = MFMA32(vf[4 * k2 + dt], wf, oacc[dt]);
        }
        if (__all((r >= nq) || (carry < -104.f))) break;
    }
    if (r < nq) {
#pragma unroll
        for (int dt = 0; dt < 4; ++dt)
#pragma unroll
            for (int g4 = 0; g4 < 4; ++g4) { u32x2 wv; wv.x = cvt2(oacc[dt][4 * g4], oacc[dt][4 * g4 + 1]); wv.y = cvt2(oacc[dt][4 * g4 + 2], oacc[dt][4 * g4 + 3]);
                *(u32x2*)(Op + (size_t)r * D + 32 * dt + 8 * g4 + 4 * hh) = wv; }
    }
    asm volatile("s_waitcnt lgkmcnt(0)" ::: "memory");
}

struct SkBf16 { bf16* O; int ldc;
    __device__ __forceinline__ int brow(int unit, int nb) const { return 32 * unit + 16 * nb; }
    __device__ __forceinline__ void store(int unit, const f32x4 a0, const f32x4 a1, int m, int fq) const { bf16* p = O + (size_t)(MP + m) * ldc + 32 * unit + 4 * fq;
        u32x2 w; w.x = cvt2(a0[0], a0[1]); w.y = cvt2(a0[2], a0[3]); *(u32x2*)p = w; w.x = cvt2(a1[0], a1[1]); w.y = cvt2(a1[2], a1[3]); *(u32x2*)(p + 16) = w; } };
struct SkRes { bf16* Yp; const bf16* Xp; float alpha;
    __device__ __forceinline__ int brow(int unit, int nb) const { return 32 * unit + 16 * nb; }
    __device__ __forceinline__ void one(size_t o, const f32x4 a) const { const u32x2 xv = *(const u32x2*)(Xp + o);
        f32x4 r; r[0] = alpha * pg8::bflo(xv.x); r[1] = alpha * pg8::bfhi(xv.x); r[2] = alpha * pg8::bflo(xv.y); r[3] = alpha * pg8::bfhi(xv.y); r = r + a; u32x2 w; w.x = cvt2(r[0], r[1]); w.y = cvt2(r[2], r[3]); *(u32x2*)(Yp + o) = w; }
    __device__ __forceinline__ void store(int unit, const f32x4 a0, const f32x4 a1, int m, int fq) const { const size_t o = (size_t)(MP + m) * D + 32 * unit + 4 * fq; one(o, a0); one(o + 16, a1); } };
struct SkKV { float *oks, *ovs; bf16 *ksb, *vsb;
    __device__ __forceinline__ int brow(int unit, int nb) const { return 32 * unit + 16 * nb; }
    __device__ __forceinline__ void one(int col, const f32x4 a, int m) const { const bool isv = col >= 1536; const int c = col - (isv ? 1536 : 0), b = m >> 4, t = m & 15;
        *(f32x4*)((isv ? ovs : oks) + (size_t)m * 1536 + c) = a; const unsigned w0 = cvt2(a[0], a[1]), w1 = cvt2(a[2], a[3]);
        const int hh_ = c >> 7, dd = c & 127;
        if (!isv) { u32x2 w; w.x = w0; w.y = w1; *(u32x2*)(ksb + ((size_t)(b * 12 + hh_) * 2080 + 2048 + t) * 128 + dd) = w; }
        else { bf16* vt = vsb + ((size_t)(b * 12 + hh_) * 65 + 64) * 4096 + dd * 32 + t; vt[0] = (bf16)w0; vt[32] = (bf16)(w0 >> 16); vt[64] = (bf16)w1; vt[96] = (bf16)(w1 >> 16); } }
    __device__ __forceinline__ void store(int unit, const f32x4 a0, const f32x4 a1, int m, int fq) const { one(32 * unit + 4 * fq, a0, m); one(32 * unit + 16 + 4 * fq, a1, m); } };
struct SkSwiGLU { bf16* Hb;
    __device__ __forceinline__ int brow(int unit, int nb) const { const int c0 = 16 * unit; return (c0 >> 7) * 256 + (c0 & 127) + 128 * nb; }
    __device__ __forceinline__ void store(int unit, const f32x4 g, const f32x4 u, int m, int fq) const { float hv[4];
#pragma unroll
        for (int j = 0; j < 4; ++j) hv[j] = g[j] * __builtin_amdgcn_rcpf(1.0f + __expf(-g[j])) * u[j];
        u32x2 w; w.x = cvt2(hv[0], hv[1]); w.y = cvt2(hv[2], hv[3]); *(u32x2*)(Hb + (size_t)(MP + m) * DFF + 16 * unit + 4 * fq) = w; } };
template <class Epi>
__device__ __forceinline__ void skinny_gemm(int bid, int G, int tid, int wave, LAS unsigned char* lds, const bf16* A, int lda, const bf16* Bt, int K, int nunits, const Epi& E) {
    const int lane = tid & 63, fr = lane & 15, fq = lane >> 4, kw = K >> 3, nst = kw >> 5;
    const bf16* ap = A + (size_t)fr * lda + wave * kw + 8 * fq;
    LAS f32x4* red = (LAS f32x4*)lds;
    for (int unit = bid; unit < nunits; unit += G) {
        const bf16* bp0 = Bt + (size_t)(E.brow(unit, 0) + fr) * K + wave * kw + 8 * fq; const bf16* bp1 = Bt + (size_t)(E.brow(unit, 1) + fr) * K + wave * kw + 8 * fq;
        f32x4 acc[2][8];
#pragma unroll
        for (int nb = 0; nb < 2; ++nb)
#pragma unroll
            for (int rt = 0; rt < 8; ++rt) acc[nb][rt] = (f32x4){0.f, 0.f, 0.f, 0.f};
        bf16x8 a0[8], a1[8], b0[2], b1[2];
#define SK_LOAD(af, bfr, st) do { _Pragma("unroll") for (int rt = 0; rt < 8; ++rt) af[rt] = ld16(ap + (size_t)(16 * rt) * lda + 32 * (st)); bfr[0] = ld16(bp0 + 32 * (st)); bfr[1] = ld16(bp1 + 32 * (st)); } while (0)
#define SK_MMA(af, bfr) do { _Pragma("unroll") for (int rt = 0; rt < 8; ++rt) { acc[0][rt] = MFMA16(bfr[0], af[rt], acc[0][rt]); acc[1][rt] = MFMA16(bfr[1], af[rt], acc[1][rt]); } } while (0)
        SK_LOAD(a0, b0, 0);
#pragma unroll 1
        for (int st = 0; st < nst; st += 2) {
            if (st + 1 < nst) SK_LOAD(a1, b1, st + 1);
            __builtin_amdgcn_sched_barrier(0);
            SK_MMA(a0, b0);
            __builtin_amdgcn_sched_barrier(0);
            if (st + 2 < nst) SK_LOAD(a0, b0, st + 2);
            __builtin_amdgcn_sched_barrier(0);
            if (st + 1 < nst) SK_MMA(a1, b1);
            __builtin_amdgcn_sched_barrier(0);
        }
#undef SK_LOAD
#undef SK_MMA
#pragma unroll
        for (int nb = 0; nb < 2; ++nb)
#pragma unroll
            for (int rt = 0; rt < 8; ++rt) red[((wave * 2 + nb) * 8 + rt) * 64 + lane] = acc[nb][rt];
        __syncthreads();
        f32x4 s0 = {0.f, 0.f, 0.f, 0.f}, s1 = {0.f, 0.f, 0.f, 0.f};
#pragma unroll
        for (int ws = 0; ws < 8; ++ws) { s0 = s0 + red[((ws * 2 + 0) * 8 + wave) * 64 + lane]; s1 = s1 + red[((ws * 2 + 1) * 8 + wave) * 64 + lane]; }
        E.store(unit, s0, s1, 16 * wave + fr, fq);
        __syncthreads();
    }
}
#ifndef PH_MASK
#define PH_MASK 0xFFFF
#endif
__global__ void __launch_bounds__(NWAVES * 64, 2) mega(Args args) {
    extern __shared__ __attribute__((aligned(16))) unsigned char lds[];
    Frame F;
    F.lds = (LAS unsigned char*)lds; F.MISC = (volatile LAS unsigned*)(F.lds + MISC_OFF);
    F.tid = threadIdx.x; F.lane = F.tid & 63; F.wave = __builtin_amdgcn_readfirstlane(F.tid >> 6);
    F.G = gridDim.x; F.gw = blockIdx.x * NWAVES + F.wave; F.NGW = F.G * NWAVES;
    F.ctl = (gu32*)(args.ws_ + WS_CTL);
    for (int u = F.tid; u < (LDS_BYTES - LDSCTL_OFF) / 4; u += NWAVES * 64) ((LAS unsigned*)(F.lds + LDSCTL_OFF))[u] = 0u;
    __syncthreads();
    XcdBarrier bar = xcd_barrier_post((unsigned*)(F.ctl + CW_BAR), F.MISC + 8);
    const int lo = args.ph_lo, hi = args.ph_hi; int ph = 0;
#define KARGS ((const __attribute__((address_space(4))) Args*)__builtin_amdgcn_kernarg_segment_ptr())
#define ws (ka->ws_)
#define out (ka->out_)
#define x_prompt (ka->in[0])
#define x_sample (ka->in[1])
#define mem_prompt (ka->in[2])
#define state_gla (ka->in[3])
#define cache_sb_k (ka->in[4])
#define cache_sb_v (ka->in[5])
#define cache_mem_k (ka->in[6])
#define cache_mem_v (ka->in[7])
#define w_in_a (ka->in[8])
#define w_gate_lr (ka->in[9])
#define b_gate (ka->in[10])
#define gla_norm_g (ka->in[11])
#define w_in_b (ka->in[12])
#define w_kv_shared (ka->in[13])
#define w_mem_kv (ka->in[14])
#define w_o (ka->in[15])
#define ln1_g (ka->in[16])
#define ln1_b (ka->in[17])
#define ln2_g (ka->in[18])
#define ln2_b (ka->in[19])
#define w_ffn_in (ka->in[20])
#define w_ffn_out (ka->in[21])
#define WIN ((bf16*)(ws + WS_WIN))
#define WO ((bf16*)(ws + WS_WO))
#define WFI ((bf16*)(ws + WS_WFI))
#define WFO ((bf16*)(ws + WS_WFO))
#define WMEM ((bf16*)(ws + WS_WMEM))
#define MEMX ((bf16*)(ws + WS_MEMX))
#define MEMK ((bf16*)(ws + WS_MEMK))
#define MEMV ((bf16*)(ws + WS_MEMV))
#define X ((bf16*)(ws + WS_X))
#define Y ((float*)(ws + WS_Y))
#define YB ((bf16*)(ws + WS_Y))
#define PROJ ((bf16*)(ws + WS_R1))
#define HB ((bf16*)(ws + WS_R1))
#define OCAT ((bf16*)(ws + WS_OCAT))
#define SBKS ((bf16*)(ws + WS_SBKS))
#define SBVS ((bf16*)(ws + WS_SBVS))
#define OINT (out + O_YP)
#define KPB ((bf16*)(out + O_YP))
#define VPB (KPB + (size_t)MP * 1536)

#define PHASE_BEGIN(cond, cls) if (cond) { if (lo <= ph && ph < hi) { if (ph > lo) xcd_barrier(bar); DIAG_STAMP(cls); for (int rep_ = 0; rep_ < (((cls) == REP_CLS) ? 2 : 1); ++rep_) { const __attribute__((address_space(4))) Args* ka = KARGS; asm volatile("" : "+s"(ka)); int z_ = 0, G_ = gridDim.x, bid_ = blockIdx.x, wave_ = F.wave; asm volatile("" : "+s"(z_), "+s"(G_), "+s"(bid_), "+s"(wave_)); const int lane = (int)__builtin_amdgcn_mbcnt_hi(~0u, __builtin_amdgcn_mbcnt_lo(~0u, (unsigned)z_)), tid = wave_ * 64 + lane, gw_ = bid_ * NWAVES + wave_, NGW_ = G_ * NWAVES;     (void)tid; (void)lane; (void)gw_; (void)NGW_;
#define PHASE_END } } ++ph; }
#ifndef REP_CLS
#define REP_CLS (-1)
#endif
#ifndef SK_REP
#define SK_REP 1
#endif
#ifndef SB_REP
#define SB_REP 1
#endif
#if defined(DIAG_A)
#define DIAG_STAMP(cls) do { if (blockIdx.x == 0 && threadIdx.x == 0) { unsigned long long* dts = (unsigned long long*)(args.ws_ + 262144); dts[ph] = rt(); } } while (0)
#else
#define DIAG_STAMP(cls) do { } while (0)
#endif

#define CONVERT_WEIGHTS(LL) do { const int ll_ = (LL); \
            if (ll_ < 2) wt_convert(F.lds, wave_, gw_, NGW_, lane, w_in_a + (size_t)ll_ * D * 5136, D, 5136, WIN, NA, MapInA()); \
            else { wt_convert(F.lds, wave_, gw_, NGW_, lane, w_in_b + (size_t)(ll_ - 2) * D * NBQ, D, NBQ, WIN, NBQ, MapId()); if (ll_ == 2) wt_convert(F.lds, wave_, gw_, NGW_, lane, w_kv_shared, D, NKV, WIN + (size_t)NBQ * D, NKV, MapId()); } \
            wt_convert(F.lds, wave_, gw_, NGW_, lane, w_o + (size_t)ll_ * D * D, D, D, WO, D, MapId()); \
            wt_convert(F.lds, wave_, gw_, NGW_, lane, w_ffn_in + (size_t)ll_ * D * 2 * DFF, D, 2 * DFF, WFI, 2 * DFF, MapFfn()); \
            wt_convert(F.lds, wave_, gw_, NGW_, lane, w_ffn_out + (size_t)ll_ * DFF * D, DFF, D, WFO, D, MapId()); } while (0)
    PHASE_BEGIN(true, 0)
        for (int r = gw_; r < MT; r += NGW_) cvt_row(r < MP ? x_prompt + (size_t)r * D : (r < MR ? x_sample + (size_t)(r - MP) * D : nullptr), X + (size_t)r * D, D, lane);
        for (int r = gw_; r < 1024; r += NGW_) cvt_row(mem_prompt + (size_t)r * D, MEMX + (size_t)r * D, D, lane);
        for (int r = gw_; r < 4 * 8 * 256; r += NGW_) { const int l = r >> 11, b = (r >> 8) & 7, m = r & 255; const size_t dst = (size_t)((l * 12 + 4 + b) * 256 + m) * 512;
            cvt_row(cache_mem_k + (size_t)r * 512, MEMK + dst, 512, lane); }
        for (int it = gw_; it < 512; it += NGW_) { const int hdb = it & 3, mb = (it >> 2) & 3, b = (it >> 4) & 7, l = it >> 7, m = mb * 64 + lane;
            const float* src = cache_mem_v + (size_t)((l * 8 + b) * 256 + m) * 512 + hdb * 128; bf16* dst = MEMV + (size_t)((l * 12 + 4 + b) * 512 + hdb * 128) * 256 + m;
            for (int q4 = 0; q4 < 32; ++q4) { const f32x4 v = *(const f32x4*)(src + 4 * q4);
#pragma unroll
                for (int e = 0; e < 4; ++e) dst[(size_t)(4 * q4 + e) * 256] = (bf16)f2bf(v[e]); } }
        for (int r = gw_; r < 8 * 2048; r += NGW_) { const int b = r >> 11, s = r & 2047; const float* src = cache_sb_k + (size_t)r * 1536;
            for (int j = lane * 4; j < 1536; j += 256) { const f32x4 v = *(const f32x4*)(src + j);
                *(unsigned long long*)(SBKS + ((size_t)(b * 12 + (j >> 7)) * 2080 + s) * 128 + (j & 127)) = (unsigned long long)pk2(v.x, v.y) | ((unsigned long long)pk2(v.z, v.w) << 32); } }
        for (int it = gw_; it < 3072; it += NGW_) { const int cb = it % 12, sb_ = (it / 12) & 31, b = it / 384, s = sb_ * 64 + lane;
            const float* src = cache_sb_v + (size_t)(b * 2048 + s) * 1536 + cb * 128; bf16* dst = SBVS + ((size_t)(b * 12 + cb) * 65 + (s >> 5)) * 4096 + (s & 31);
            for (int q4 = 0; q4 < 32; ++q4) { const f32x4 v = *(const f32x4*)(src + 4 * q4);
#pragma unroll
                for (int e = 0; e < 4; ++e) dst[(4 * q4 + e) * 32] = (bf16)f2bf(v[e]); } }
        for (int l = 0; l < 4; ++l) wt_convert(F.lds, wave_, gw_, NGW_, lane, w_mem_kv + (size_t)l * D * 1024, D, 1024, WMEM + (size_t)l * 1024 * D, 1024, MapId());
        CONVERT_WEIGHTS(0);
    PHASE_END
    PHASE_BEGIN(true, 0)
        pg8::Gemm g{MEMX, WMEM, 1024, 4096, D}; pg8::StaticOrder S; S.init(1024, 4096, G_, bid_);
        pg8::EpiMemKV E{out + O_MKP, out + O_MVP, MEMK, MEMV};
        pg8::gemm_phase<pg8::EpiMemKV, pg8::StaticOrder, true, true>(F.lds + RING_OFF, g, S, E, tid);
    PHASE_END

    for (int l = 0; l < 4; ++l) {
        const bool LA = l < 2;
        const int ldp = LA ? NA : NBQ;
        PHASE_BEGIN(true, 2)
            { pg8::Gemm g{X, WIN, MP, ldp, D}; pg8::StaticOrder S; S.init(MP, ldp, G_, bid_); pg8::EpiBf16 E{PROJ, ldp};
              pg8::gemm_phase<pg8::EpiBf16, pg8::StaticOrder, true, true>(F.lds + RING_OFF, g, S, E, tid); }
            if (l == 2) { pg8::Gemm g{X, WIN + (size_t)NBQ * D, MP, NKV, D}; pg8::StaticOrder S; S.init(MP, NKV, G_, bid_);
              pg8::EpiKV E{out + O_SKP, out + O_SVP, out + O_SKS, out + O_SVS, KPB, VPB, SBKS, SBVS};
              pg8::gemm_phase<pg8::EpiKV, pg8::StaticOrder, true, true>(F.lds + RING_OFF, g, S, E, tid); }
            for (int skr = 0; skr < SK_REP; ++skr) { SkBf16 E{PROJ, ldp}; skinny_gemm(bid_, G_, tid, wave_, F.lds + RING_OFF, X + (size_t)MP * D, D, WIN, D, ldp / 32, E); }
            for (int skr = 0; skr < SK_REP; ++skr) if (l == 2) { SkKV E{out + O_SKS, out + O_SVS, SBKS, SBVS}; skinny_gemm(bid_, G_, tid, wave_, F.lds + RING_OFF, X + (size_t)MP * D, D, WIN + (size_t)NBQ * D, D, NKV / 32, E); }
        PHASE_END
        PHASE_BEGIN(LA, 3)
            gla_prep(bid_, G_, tid, wave_, F.lds + RING_OFF, l, PROJ, w_gate_lr, b_gate, (unsigned char*)Y);
        PHASE_END
        PHASE_BEGIN(true, (LA ? 4 : 11))
            if (LA) {
                for (int item = bid_; item < N_PKG; item += G_) gla_intra(item, tid, wave_, F.lds + RING_OFF, (const unsigned char*)Y, OINT);
            } else {
                for (int sbr = 0; sbr < SB_REP; ++sbr)
                for (int u = gw_; u < 12288 + 96; u += NGW_) {
                    if (u < 12288) { const int bh = u >> 8, qb = u & 255, b = bh / 12, h = bh % 12, t0 = 32 * qb; const size_t qo = (size_t)(b * SEQ + t0) * D + h * 128;
                        sb_attn(lane, F.lds + RING_OFF + wave_ * 16384, KPB + (size_t)bh * SEQ * 128, 128, VPB + (size_t)bh * SEQ * 128, 0, PROJ + qo, NBQ, OCAT + qo, t0, 32); }
                    else { const int u2 = u - 12288, b = u2 / 12, h = u2 % 12; const size_t qo = (size_t)(MP + b * 16) * D + h * 128;
                        sb_attn(lane, F.lds + RING_OFF + wave_ * 16384, SBKS + (size_t)u2 * 2080 * 128, 128, SBVS + (size_t)u2 * 65 * 4096, 0, PROJ + qo, NBQ, OCAT + qo, 2048, 16); }
                }
            }
            __syncthreads();
            for (int wi = bid_; wi < 256 + 32; wi += G_) mem_attn_wg(wi, tid, wave_, F.lds + RING_OFF, l, PROJ, ldp, LA ? CQM : 1536, MEMK, MEMV, OCAT);
        PHASE_END
        PHASE_BEGIN(LA, 12)
            for (int wc = bid_; wc < 144; wc += G_) gla_chain<1>(wc, tid, wave_, F.lds + RING_OFF, l, (const unsigned char*)Y, state_gla, OINT, out, (float*)WMEM, (float*)MEMX);
        PHASE_END
        PHASE_BEGIN(LA, 5)
            for (int wc = bid_; wc < 192 + 96; wc += G_) gla_chain<2>(wc, tid, wave_, F.lds + RING_OFF, l, (const unsigned char*)Y, state_gla, OINT, out, (float*)WMEM, (float*)MEMX, REP_CLS == 5 && rep_ == 0);
        PHASE_END
        PHASE_BEGIN(LA, 6)
            const float* gn = gla_norm_g + (size_t)l * 384;
            for (int row = gw_; row < MR; row += NGW_) {
                const float* op = OINT + (size_t)row * 1536 + 24 * lane; const bf16* gp = PROJ + (size_t)row * NA + CG + 24 * lane; const float* gnp = gn + 24 * (lane & 15);
                f32x4 ov[6]; v4u gv[3]; float ss = 0.f;
#pragma unroll
                for (int j = 0; j < 6; ++j) { ov[j] = *(const f32x4*)(op + 4 * j); ss += (ov[j].x * ov[j].x + ov[j].y * ov[j].y) + (ov[j].z * ov[j].z + ov[j].w * ov[j].w); }
#pragma unroll
                for (int j = 0; j < 3; ++j) gv[j] = *(const v4u*)(gp + 8 * j);
                ss += shx(ss, lane, 1); ss += shx(ss, lane, 2); ss += shx(ss, lane, 4); ss += shx(ss, lane, 8);
                const float r = 1.0f / sqrtf(ss * (1.0f / 384.0f) + RMS_EPS);
#pragma unroll
                for (int j = 0; j < 3; ++j) { const f32x4 n0 = *(const f32x4*)(gnp + 8 * j), n1 = *(const f32x4*)(gnp + 8 * j + 4); const f32x4 a = ov[2 * j], b = ov[2 * j + 1];
                    float gt[8]; gt[0] = pg8::bflo(gv[j].x); gt[1] = pg8::bfhi(gv[j].x); gt[2] = pg8::bflo(gv[j].y); gt[3] = pg8::bfhi(gv[j].y); gt[4] = pg8::bflo(gv[j].z); gt[5] = pg8::bfhi(gv[j].z); gt[6] = pg8::bflo(gv[j].w); gt[7] = pg8::bfhi(gv[j].w);
                    float o8[8];
#pragma unroll
                    for (int i = 0; i < 4; ++i) { o8[i] = a[i] * r * n0[i] * (gt[i] * __builtin_amdgcn_rcpf(1.0f + __expf(-gt[i]))); o8[4 + i] = b[i] * r * n1[i] * (gt[4 + i] * __builtin_amdgcn_rcpf(1.0f + __expf(-gt[4 + i]))); }
                    v4u o; o.x = pk2(o8[0], o8[1]); o.y = pk2(o8[2], o8[3]); o.z = pk2(o8[4], o8[5]); o.w = pk2(o8[6], o8[7]);
                    *(v4u*)(OCAT + (size_t)row * D + 24 * lane + 8 * j) = o; }
            }
        PHASE_END
        PHASE_BEGIN(true, 7)
            pg8::Gemm g{OCAT, WO, MP, D, D}; pg8::StaticOrder S; S.init(MP, D, G_, bid_); pg8::EpiRes E{YB, X, D, DN_ALPHA};
            pg8::gemm_phase<pg8::EpiRes, pg8::StaticOrder, true, true>(F.lds + RING_OFF, g, S, E, tid);
            for (int skr = 0; skr < SK_REP; ++skr) { SkRes Es{YB, X, DN_ALPHA}; skinny_gemm(bid_, G_, tid, wave_, F.lds + RING_OFF, OCAT + (size_t)MP * D, D, WO, D, D / 32, Es); }
        PHASE_END
        PHASE_BEGIN(true, 8)
            const float* gg = ln1_g + (size_t)l * D; const float* bb = ln1_b + (size_t)l * D;
            for (int row = 2 * gw_; row < MR; row += 2 * NGW_) ln_two_rows<false>(lane, YB + (size_t)row * D, YB + (size_t)(row + 1) * D, gg, bb, X + (size_t)row * D, X + (size_t)(row + 1) * D, nullptr, nullptr);
        PHASE_END
        PHASE_BEGIN(true, 9)
            pg8::Gemm g{X, WFI, MP, 2 * DFF, D}; pg8::StaticOrder S; S.init(MP, 2 * DFF, G_, bid_); pg8::EpiSwiGLU E{HB, DFF};
            pg8::gemm_phase<pg8::EpiSwiGLU, pg8::StaticOrder, true, true>(F.lds + RING_OFF, g, S, E, tid);
            for (int skr = 0; skr < SK_REP; ++skr) { SkSwiGLU Es{HB}; skinny_gemm(bid_, G_, tid, wave_, F.lds + RING_OFF, X + (size_t)MP * D, D, WFI, D, DFF / 16, Es); }
        PHASE_END
        PHASE_BEGIN(true, 10)
            pg8::Gemm g{HB, WFO, MP, D, DFF}; pg8::StaticOrder S; S.init(MP, D, G_, bid_); pg8::EpiRes E{YB, X, D, DN_ALPHA};
            pg8::gemm_phase<pg8::EpiRes, pg8::StaticOrder, true, true>(F.lds + RING_OFF, g, S, E, tid);
            for (int skr = 0; skr < SK_REP; ++skr) { SkRes Es{YB, X, DN_ALPHA}; skinny_gemm(bid_, G_, tid, wave_, F.lds + RING_OFF, HB + (size_t)MP * DFF, DFF, WFO, DFF, D / 32, Es); }
        PHASE_END
        PHASE_BEGIN(true, 8)
            if (l < 3) CONVERT_WEIGHTS(l + 1);
            const float* gg = ln2_g + (size_t)l * D; const float* bb = ln2_b + (size_t)l * D;
            if (l == 3) { for (int row = 2 * gw_; row < MR; row += 2 * NGW_) { float* of = row < MP ? out + O_YP + (size_t)row * D : out + O_YS + (size_t)(row - MP) * D;
                ln_two_rows<true>(lane, YB + (size_t)row * D, YB + (size_t)(row + 1) * D, gg, bb, nullptr, nullptr, of, of + D); } }
            else for (int row = 2 * gw_; row < MR; row += 2 * NGW_) ln_two_rows<false>(lane, YB + (size_t)row * D, YB + (size_t)(row + 1) * D, gg, bb, X + (size_t)row * D, X + (size_t)(row + 1) * D, nullptr, nullptr);
        PHASE_END
    }
#if defined(DIAG_A)
    if (blockIdx.x == 0 && threadIdx.x == 0) { unsigned long long* dts = (unsigned long long*)(args.ws_ + 262144); dts[ph] = rt(); dts[63] = (unsigned long long)ph; }
#endif
#undef ws
#undef out
#undef X
#undef Y
#undef YB
#undef CONVERT_WEIGHTS
#undef PHASE_BEGIN
#undef PHASE_END
}

#if defined(DIAG_A)
__device__ const int diag_cls[40] = {0,0, 1,2,3,4,5,6,7,8,9,10,8, 1,2,3,4,5,6,7,8,9,10,8, 1,2,11,7,8,9,10,8, 1,2,11,7,8,9,10,8};
__global__ void diag_tail(float* o, const unsigned long long* dts) {
    __shared__ float dv[2];
    if (threadIdx.x == 0) { const int n = (int)dts[63]; unsigned long long sa = 0, sb = 0; for (int p = 0; p < n; ++p) { const unsigned long long d = dts[p + 1] - dts[p]; const int cl = diag_cls[p]; if (cl == DIAG_A) sa += d; if (cl == DIAG_B) sb += d; }
        dv[0] = (float)sa * 0.01f; dv[1] = (float)sb * 10.0f; }
    __syncthreads();
    for (int i = threadIdx.x; i < 262144; i += blockDim.x) o[O_YS + i] = dv[0];
    if (threadIdx.x == 0) o[O_YP] = dv[1];
}
#endif
#ifndef MK_PER_PHASE
#define MK_PER_PHASE 0
#endif
constexpr int N_PHASES = 2 + 2 * 11 + 2 * 7;
extern "C" void kernel_launch(void* const* d_in, const int* in_sizes, int n_in, void* d_out, int out_size, void* d_ws, size_t ws_size, hipStream_t stream) {
    static int grid = 0;
    if (grid == 0) {
        if (n_in != 22 || in_sizes[0] != MP * D || (size_t)out_size != O_END || ws_size < WS_END) { fprintf(stderr, "kernel_launch: unexpected shapes (n_in %d, in0 %d, out %d, ws %zu); nothing launched\n", n_in, n_in > 0 ? in_sizes[0] : -1, out_size, ws_size); grid = -1; return; }
        int dev = 0, cus = 0, per_cu = 0;
        if (hipGetDevice(&dev) != hipSuccess || hipDeviceGetAttribute(&cus, hipDeviceAttributeMultiprocessorCount, dev) != hipSuccess) { grid = -1; return; }
        if (hipFuncSetAttribute((const void*)mega, hipFuncAttributeMaxDynamicSharedMemorySize, LDS_BYTES) != hipSuccess) { fprintf(stderr, "kernel_launch: hipFuncSetAttribute failed\n"); grid = -1; return; }
        if (hipOccupancyMaxActiveBlocksPerMultiprocessor(&per_cu, (const void*)mega, NWAVES * 64, LDS_BYTES) != hipSuccess || per_cu < 1) fprintf(stderr, "kernel_launch: occupancy query reports %d\n", per_cu);
        (void)hipGetLastError();
        grid = cus;
    }
    if (grid < 0) return;
    if (hipMemsetAsync((char*)d_ws + WS_CTL, 0, CTL_ZERO_BYTES, stream) != hipSuccess) return;
    Args a{};
    for (int i = 0; i < 22; ++i) a.in[i] = (const float*)d_in[i];
    a.out_ = (float*)d_out; a.ws_ = (unsigned char*)d_ws;
#if MK_PER_PHASE
    for (int p = 0; p < N_PHASES; ++p) { a.ph_lo = p; a.ph_hi = p + 1; hipLaunchKernelGGL(mega, dim3(grid), dim3(NWAVES * 64), LDS_BYTES, stream, a); }
#else
    a.ph_lo = 0; a.ph_hi = N_PHASES; hipLaunchKernelGGL(mega, dim3(grid), dim3(NWAVES * 64), LDS_BYTES, stream, a);
#if defined(DIAG_A)
    hipLaunchKernelGGL(diag_tail, dim3(1), dim3(512), 0, stream, (float*)d_out, (const unsigned long long*)((unsigned char*)d_ws + 262144));
#endif
#endif
}
```

```cpp
#include <hip/hip_runtime.h>
#include <cstdio>
#include <cstdint>
namespace pg8 {
#define PG8_LAS __attribute__((address_space(3)))
typedef unsigned short bf16_t;
typedef short bf16x8 __attribute__((ext_vector_type(8)));
typedef float f32x4 __attribute__((ext_vector_type(4)));
typedef unsigned u32x4 __attribute__((ext_vector_type(4)));
constexpr int BM = 256, BK = 64, HALF = 128, HTB = HALF * BK * 2  , STAGE_BYTES = 8 * HTB, NXCD = 8, WGM = 8;

__host__ __device__ __forceinline__ int lds_byte(int r, int c) { const int st = (r >> 4) * 2 + (c >> 5), rr = r & 15, cc = c & 31, ob = rr * 64 + cc * 2; return st * 1024 + (ob ^ (((ob >> 9) & 1) << 5)); }
__host__ __device__ __forceinline__ void stage_rc(int b, int& R, int& C) { const int st = b / 1024, sb = b % 1024, swz = sb ^ (((sb >> 9) & 1) << 5); R = (st >> 1) * 16 + swz / 64; C = (st & 1) * 32 + (swz % 64) / 2; }
__host__ __device__ __forceinline__ int perm32(int rho) { const int n = rho >> 4, i = rho & 15; return 8 * (i >> 2) + 4 * n + (i & 3); }

struct Unit { int pm, pn; };
struct Gemm { const bf16_t* A; const bf16_t* Bt; int M, N, K; };

struct StaticOrder {
    int nM, nN, nwg, G, c;
    __host__ __device__ void init(int M, int N, int G_, int c_) { nM = M / BM; nN = N / BM; nwg = nM * nN; G = G_; c = c_; }
    __host__ __device__ bool next(int i, Unit& u) const {
        const long L = (long)i * G + c; if (L >= nwg) return false;
        int wgid = (int)L; { const int q = nwg / NXCD, r = nwg % NXCD, xcd = wgid % NXCD, off = wgid / NXCD; wgid = (xcd < r ? xcd * (q + 1) : r * (q + 1) + (xcd - r) * q) + off; }
        const int nig = WGM * nN, gid = wgid / nig, fm = gid * WGM, gsz = (nM - fm) < WGM ? (nM - fm) : WGM;
        u.pm = fm + ((wgid % nig) % gsz); u.pn = (wgid % nig) / gsz; return true;
    }
    __device__ __forceinline__ void a_ready(const Unit&) const {}
    __device__ __forceinline__ void done(const Unit&) const {}
};
__device__ __forceinline__ unsigned cvt_pk_bf16(float lo, float hi) { unsigned r; asm volatile("v_cvt_pk_bf16_f32 %0, %1, %2" : "=v"(r) : "v"(lo), "v"(hi)); return r; }
typedef float f32x2 __attribute__((ext_vector_type(2)));
typedef unsigned u32x2 __attribute__((ext_vector_type(2)));
__device__ __forceinline__ float bflo(unsigned w) { return __builtin_bit_cast(float, w << 16); }
__device__ __forceinline__ float bfhi(unsigned w) { return __builtin_bit_cast(float, w & 0xffff0000u); }
struct EpiBf16 {
    static constexpr bool PERM = true, AFTER_DRAIN = false;
    bf16_t* O; int ldc;
    __device__ __forceinline__ void operator()(const f32x4 (&acc)[2][2][4][2], const Unit& u, int wr, int wc, int fr, int fq) const {
        const int row0 = u.pm * BM + wr * 64 + fr, col0 = u.pn * BM + wc * 32 + 8 * fq;
#pragma unroll
        for (int ai = 0; ai < 2; ++ai)
#pragma unroll
            for (int m = 0; m < 4; ++m) { bf16_t* rowp = O + (size_t)(row0 + ai * HALF + m * 16) * ldc + col0;
#pragma unroll
                for (int bj = 0; bj < 2; ++bj) { const f32x4 v0 = acc[ai][bj][m][0], v1 = acc[ai][bj][m][1];
                    u32x4 w; w.x = cvt_pk_bf16(v0[0], v0[1]); w.y = cvt_pk_bf16(v0[2], v0[3]); w.z = cvt_pk_bf16(v1[0], v1[1]); w.w = cvt_pk_bf16(v1[2], v1[3]);
                    *(u32x4*)(rowp + bj * HALF) = w; } }
    }
};
struct EpiSwiGLU {
    static constexpr bool PERM = true, AFTER_DRAIN = false;
    bf16_t* Hh; int ldh;
    __device__ __forceinline__ float swi(float g, float up) const { return g * __builtin_amdgcn_rcpf(1.0f + __expf(-g)) * up; }
    __device__ __forceinline__ void operator()(const f32x4 (&acc)[2][2][4][2], const Unit& u, int wr, int wc, int fr, int fq) const {
        const int row0 = u.pm * BM + wr * 64 + fr, col0 = u.pn * HALF + wc * 32 + 8 * fq;
#pragma unroll
        for (int ai = 0; ai < 2; ++ai)
#pragma unroll
            for (int m = 0; m < 4; ++m) { bf16_t* rowp = Hh + (size_t)(row0 + ai * HALF + m * 16) * ldh + col0;
                const f32x4 g0 = acc[ai][0][m][0], g1 = acc[ai][0][m][1], u0 = acc[ai][1][m][0], u1 = acc[ai][1][m][1];
                u32x4 w; w.x = cvt_pk_bf16(swi(g0[0], u0[0]), swi(g0[1], u0[1])); w.y = cvt_pk_bf16(swi(g0[2], u0[2]), swi(g0[3], u0[3]));
                w.z = cvt_pk_bf16(swi(g1[0], u1[0]), swi(g1[1], u1[1])); w.w = cvt_pk_bf16(swi(g1[2], u1[2]), swi(g1[3], u1[3]));
                *(u32x4*)rowp = w; }
    }
};
struct EpiRes {
    static constexpr bool PERM = true, AFTER_DRAIN = false;
    bf16_t* Y; const bf16_t* X; int ldc; float alpha;
    __device__ __forceinline__ void operator()(const f32x4 (&acc)[2][2][4][2], const Unit& u, int wr, int wc, int fr, int fq) const {
        const int row0 = u.pm * BM + wr * 64 + fr, col0 = u.pn * BM + wc * 32 + 8 * fq;
        u32x4 xv[2][4][2];
#pragma unroll
        for (int ai = 0; ai < 2; ++ai)
#pragma unroll
            for (int m = 0; m < 4; ++m)
#pragma unroll
                for (int bj = 0; bj < 2; ++bj) xv[ai][m][bj] = *(const u32x4*)(X + (size_t)(row0 + ai * HALF + m * 16) * ldc + col0 + bj * HALF);
#pragma unroll
        for (int ai = 0; ai < 2; ++ai)
#pragma unroll
            for (int m = 0; m < 4; ++m) { const size_t ro = (size_t)(row0 + ai * HALF + m * 16) * ldc + col0;
#pragma unroll
                for (int bj = 0; bj < 2; ++bj) { const u32x4 x4 = xv[ai][m][bj]; const f32x4 a0 = acc[ai][bj][m][0], a1 = acc[ai][bj][m][1];
                    u32x4 w; w.x = cvt_pk_bf16(alpha * bflo(x4.x) + a0[0], alpha * bfhi(x4.x) + a0[1]); w.y = cvt_pk_bf16(alpha * bflo(x4.y) + a0[2], alpha * bfhi(x4.y) + a0[3]);
                    w.z = cvt_pk_bf16(alpha * bflo(x4.z) + a1[0], alpha * bfhi(x4.z) + a1[1]); w.w = cvt_pk_bf16(alpha * bflo(x4.w) + a1[2], alpha * bfhi(x4.w) + a1[3]);
                    *(u32x4*)(Y + ro + bj * HALF) = w; } }
    }
};
struct EpiKV {
    static constexpr bool PERM = false, AFTER_DRAIN = false;
    float *okp, *ovp, *oks, *ovs; bf16_t *kpb, *vpb, *ksb, *vsb;
    __device__ __forceinline__ void operator()(const f32x4 (&acc)[2][2][4][2], const Unit& u, int wr, int wc, int fr, int fq) const {
        const bool isv = u.pn >= 6; const int colt = (u.pn - (isv ? 6 : 0)) * BM + wc * 32 + 4 * fq, row0 = u.pm * BM + wr * 64 + fr;
        float* op = isv ? ovp : okp;
#pragma unroll
        for (int ai = 0; ai < 2; ++ai)
#pragma unroll
            for (int m = 0; m < 4; ++m) { const int row = row0 + ai * HALF + m * 16; float* fd;
                if (row < 32768) { fd = op + (size_t)row * 1536; } else continue;
                const int bq = row >> 13, sq = row & 8191;
#pragma unroll
                for (int bj = 0; bj < 2; ++bj)
#pragma unroll
                    for (int n = 0; n < 2; ++n) { const int c = colt + bj * HALF + n * 16; const f32x4 v = acc[ai][bj][m][n];
                        *(f32x4*)(fd + c) = v; const unsigned w0 = cvt_pk_bf16(v[0], v[1]), w1 = cvt_pk_bf16(v[2], v[3]);
                        const int hq = c >> 7, dq = c & 127;
                        if (!isv) { u32x2 w; w.x = w0; w.y = w1; *(u32x2*)(kpb + ((size_t)(bq * 12 + hq) * 8192 + sq) * 128 + dq) = w; }
                        else { bf16_t* vt = vpb + ((size_t)(bq * 12 + hq) * 256 + (sq >> 5)) * 4096 + dq * 32 + (sq & 31); vt[0] = (bf16_t)w0; vt[32] = (bf16_t)(w0 >> 16); vt[64] = (bf16_t)w1; vt[96] = (bf16_t)(w1 >> 16); } } }
    }
};
struct EpiMemKV {
    static constexpr bool PERM = false, AFTER_DRAIN = false;
    float *ok, *ov; bf16_t *kb, *vb;
    __device__ __forceinline__ void operator()(const f32x4 (&acc)[2][2][4][2], const Unit& u, int wr, int wc, int fr, int fq) const {
        const int l = u.pn >> 2, kv = (u.pn >> 1) & 1, hd0 = (u.pn & 1) * BM + wc * 32 + 4 * fq, row0 = u.pm * BM + wr * 64 + fr;
        float* fo = kv ? ov : ok; bf16_t* bo = kv ? vb : kb;
#pragma unroll
        for (int ai = 0; ai < 2; ++ai)
#pragma unroll
            for (int m = 0; m < 4; ++m) { const int row = row0 + ai * HALF + m * 16, b = row >> 8, mm = row & 255;
                float* fd = fo + (size_t)(l * 1024 + row) * 512; bf16_t* bd = bo + (size_t)((l * 12 + b) * 256 + mm) * 512;
#pragma unroll
                for (int bj = 0; bj < 2; ++bj)
#pragma unroll
                    for (int n = 0; n < 2; ++n) { const int c = hd0 + bj * HALF + n * 16; const f32x4 v = acc[ai][bj][m][n];
                        *(f32x4*)(fd + c) = v; const unsigned w0 = cvt_pk_bf16(v[0], v[1]), w1 = cvt_pk_bf16(v[2], v[3]);
                        if (!kv) { u32x2 w; w.x = w0; w.y = w1; *(u32x2*)(bd + c) = w; }
                        else { bf16_t* vt = vb + (size_t)((l * 12 + b) * 512 + c) * 256 + mm;
                            vt[0] = (bf16_t)w0; vt[256] = (bf16_t)(w0 >> 16); vt[512] = (bf16_t)w1; vt[768] = (bf16_t)(w1 >> 16); } } }
    }
};
template <class Epi, class Sched, bool ALIGN_EPI = false, bool SP2 = false>
__device__ __forceinline__ void gemm_phase(PG8_LAS unsigned char* lds, const Gemm g, const Sched& S, const Epi& E, int tid_in) {
    int tid_ = tid_in; asm volatile("" : "+v"(tid_));
    const int tid = tid_, wid = __builtin_amdgcn_readfirstlane(tid >> 6), lane = tid & 63, wr = wid >> 2, wc = wid & 3, fr = lane & 15, fq = lane >> 4;
    const int K = g.K, nt = K / BK;
    unsigned voffA[2], voffB[2];
#pragma unroll
    for (int i = 0; i < 2; ++i) { int R, C; stage_rc(tid * 16 + i * 8192, R, C); const int Rb = Epi::PERM ? ((R & ~31) + perm32(R & 31)) : R;
        voffA[i] = (unsigned)(R * K + C) * 2u; voffB[i] = (unsigned)(Rb * K + C) * 2u; }
    const size_t kstep = (size_t)(BK * 2);
    const size_t hstep = (size_t)HALF * K * 2;
    const size_t tstep = 2 * hstep;
    const unsigned ldsw = (unsigned)wid * 1024u;
    const int aoff = lds_byte(wr * 64 + fr, fq * 8), boff = lds_byte(wc * 32 + fr, fq * 8);
#define PG8_SA(b, h) (((b) * 2 + (h)) * HTB)
#define PG8_SB(b, h) ((4 + (b) * 2 + (h)) * HTB)
#define PG8_STAGE(bufoff, gbase, voff) do { _Pragma("unroll") for (int _i = 0; _i < 2; ++_i) \
        __builtin_amdgcn_global_load_lds((const unsigned*)((const char*)(gbase) + (voff)[_i]), (PG8_LAS unsigned*)(lds + (bufoff) + ldsw + _i * 8192), 16, 0, 0); } while (0)
#define PG8_LDA(dst, b, h) do { _Pragma("unroll") for (int m = 0; m < 4; ++m) _Pragma("unroll") for (int k = 0; k < 2; ++k) dst[m][k] = *(const PG8_LAS bf16x8*)(lds + PG8_SA(b, h) + aoff + m * 2048 + k * 1024); } while (0)
#define PG8_LDB(dst, b, h) do { _Pragma("unroll") for (int n = 0; n < 2; ++n) _Pragma("unroll") for (int k = 0; k < 2; ++k) dst[n][k] = *(const PG8_LAS bf16x8*)(lds + PG8_SB(b, h) + boff + n * 2048 + k * 1024); } while (0)
#define PG8_MMA(ai, bj, At, Bt) do { __builtin_amdgcn_s_setprio(1); _Pragma("unroll") for (int m = 0; m < 4; ++m) _Pragma("unroll") for (int n = 0; n < 2; ++n) _Pragma("unroll") for (int k = 0; k < 2; ++k) \
        acc[ai][bj][m][n] = __builtin_amdgcn_mfma_f32_16x16x32_bf16(Bt[n][k], At[m][k], acc[ai][bj][m][n], 0, 0, 0); __builtin_amdgcn_s_setprio(0); } while (0)
#define PG8_WAIT_V(n) asm volatile("s_waitcnt vmcnt(" #n ")" ::: "memory")
#define PG8_WAIT_L(n) asm volatile("s_waitcnt lgkmcnt(" #n ")" ::: "memory")
#define PG8_BAR __builtin_amdgcn_s_barrier()
#define PG8_SCHED __builtin_amdgcn_sched_barrier(0)
    Unit cur, nxt; int ui = 0;
    if (!S.next(0, cur)) return;
    f32x4 acc[2][2][4][2];
#pragma unroll
    for (int a = 0; a < 2; ++a)
#pragma unroll
        for (int b = 0; b < 2; ++b)
#pragma unroll
            for (int m = 0; m < 4; ++m)
#pragma unroll
                for (int n = 0; n < 2; ++n) acc[a][b][m][n] = (f32x4){0.f, 0.f, 0.f, 0.f};
    bf16x8 At[4][2], B0[2][2], B1[2][2];
    const char* cA = (const char*)g.A + (size_t)cur.pm * tstep; const char* cB = (const char*)g.Bt + (size_t)cur.pn * tstep;
    S.a_ready(cur);
    if constexpr (SP2) {
        PG8_STAGE(PG8_SB(0, 0), cB, voffB); PG8_STAGE(PG8_SB(0, 1), cB + hstep, voffB); PG8_STAGE(PG8_SA(0, 0), cA, voffA); PG8_STAGE(PG8_SA(0, 1), cA + hstep, voffA);
        if (wr == 1) PG8_BAR;
        PG8_WAIT_V(2); PG8_BAR;
        PG8_STAGE(PG8_SB(1, 0), cB + kstep, voffB); PG8_STAGE(PG8_SA(1, 0), cA + kstep, voffA); PG8_STAGE(PG8_SB(1, 1), cB + hstep + kstep, voffB);
        PG8_WAIT_V(6); PG8_BAR;
    } else {
        PG8_STAGE(PG8_SB(0, 0), cB, voffB); PG8_STAGE(PG8_SA(0, 0), cA, voffA); PG8_STAGE(PG8_SB(0, 1), cB + hstep, voffB); PG8_STAGE(PG8_SA(0, 1), cA + hstep, voffA);
        if (wr == 1) PG8_BAR;
        PG8_WAIT_V(4); PG8_BAR;
        PG8_STAGE(PG8_SB(1, 0), cB + kstep, voffB); PG8_STAGE(PG8_SA(1, 0), cA + kstep, voffA); PG8_STAGE(PG8_SB(1, 1), cB + hstep + kstep, voffB);
        PG8_WAIT_V(6); PG8_BAR;
    }
    for (;;) {
        const bool has_next = S.next(ui + 1, nxt);
        const char* nA = has_next ? (const char*)g.A + (size_t)nxt.pm * tstep : cA; const char* nB = has_next ? (const char*)g.Bt + (size_t)nxt.pn * tstep : cB;
        for (int t = 0; t < nt; t += 2) {
            const bool last = (t == nt - 2);
            const char* a1 = cA + (size_t)(t + 1) * kstep;
            const char* a2 = last ? nA : cA + (size_t)(t + 2) * kstep; const char* b2 = last ? nB : cB + (size_t)(t + 2) * kstep;
            const char* a3 = a2 + kstep; const char* b3 = b2 + kstep;
            if (last && has_next) S.a_ready(nxt);
            if constexpr (SP2) {
            PG8_LDB(B0, 0, 0); PG8_LDB(B1, 0, 1); PG8_SCHED; PG8_LDA(At, 0, 0); PG8_STAGE(PG8_SA(1, 1), a1 + hstep, voffA);
            PG8_WAIT_V(8); PG8_WAIT_L(0); PG8_BAR; PG8_MMA(0, 0, At, B0); PG8_MMA(0, 1, At, B1); PG8_BAR; PG8_SCHED;
            PG8_LDA(At, 0, 1); PG8_STAGE(PG8_SB(0, 0), b2, voffB); PG8_STAGE(PG8_SB(0, 1), b2 + hstep, voffB); PG8_STAGE(PG8_SA(0, 0), a2, voffA);
            PG8_WAIT_V(8); PG8_WAIT_L(0); PG8_BAR; PG8_MMA(1, 0, At, B0); PG8_MMA(1, 1, At, B1); PG8_BAR; PG8_SCHED;
            PG8_LDB(B0, 1, 0); PG8_LDB(B1, 1, 1); PG8_SCHED; PG8_LDA(At, 1, 0); PG8_STAGE(PG8_SA(0, 1), a2 + hstep, voffA);
            PG8_WAIT_V(8); PG8_WAIT_L(0); PG8_BAR; PG8_MMA(0, 0, At, B0); PG8_MMA(0, 1, At, B1); PG8_BAR; PG8_SCHED;
            PG8_LDA(At, 1, 1); PG8_STAGE(PG8_SB(1, 0), b3, voffB); PG8_STAGE(PG8_SB(1, 1), b3 + hstep, voffB); PG8_STAGE(PG8_SA(1, 0), a3, voffA);
            PG8_WAIT_V(8); PG8_WAIT_L(0); PG8_BAR; PG8_MMA(1, 0, At, B0); PG8_MMA(1, 1, At, B1); PG8_BAR; PG8_SCHED;
            } else {
            PG8_LDB(B0, 0, 0); PG8_SCHED; PG8_LDA(At, 0, 0); PG8_STAGE(PG8_SA(1, 1), a1 + hstep, voffA);
            PG8_WAIT_L(8); PG8_BAR; PG8_WAIT_L(0); PG8_MMA(0, 0, At, B0); PG8_BAR; PG8_SCHED;
            PG8_LDB(B1, 0, 1); PG8_STAGE(PG8_SB(0, 0), b2, voffB);
            PG8_BAR; PG8_WAIT_L(0); PG8_MMA(0, 1, At, B1); PG8_BAR;
            PG8_LDA(At, 0, 1); PG8_STAGE(PG8_SA(0, 0), a2, voffA);
            PG8_BAR; PG8_WAIT_L(0); PG8_MMA(1, 0, At, B0); PG8_BAR; PG8_SCHED;
            PG8_STAGE(PG8_SB(0, 1), b2 + hstep, voffB);
            PG8_WAIT_V(6); PG8_BAR; PG8_MMA(1, 1, At, B1); PG8_BAR;
            PG8_LDB(B0, 1, 0); PG8_SCHED; PG8_LDA(At, 1, 0); PG8_STAGE(PG8_SA(0, 1), a2 + hstep, voffA);
            PG8_WAIT_L(8); PG8_BAR; PG8_WAIT_L(0); PG8_MMA(0, 0, At, B0); PG8_BAR; PG8_SCHED;
            PG8_LDB(B1, 1, 1); PG8_STAGE(PG8_SB(1, 0), b3, voffB);
            PG8_BAR; PG8_WAIT_L(0); PG8_MMA(0, 1, At, B1); PG8_BAR;
            PG8_LDA(At, 1, 1); PG8_STAGE(PG8_SA(1, 0), a3, voffA);
            PG8_BAR; PG8_WAIT_L(0); PG8_MMA(1, 0, At, B0); PG8_BAR; PG8_SCHED;
            PG8_STAGE(PG8_SB(1, 1), b3 + hstep, voffB);
            PG8_WAIT_V(6); PG8_BAR; PG8_MMA(1, 1, At, B1); PG8_BAR;
            }
        }
        if constexpr (ALIGN_EPI) { if (wr == 0) PG8_BAR; }
        if constexpr (!Epi::AFTER_DRAIN) { E(acc, cur, wr, wc, fr, fq); S.done(cur); }
        if (!has_next) break;
#pragma unroll
        for (int a = 0; a < 2; ++a)
#pragma unroll
            for (int b = 0; b < 2; ++b)
#pragma unroll
                for (int m = 0; m < 4; ++m)
#pragma unroll
                    for (int n = 0; n < 2; ++n) acc[a][b][m][n] = (f32x4){0.f, 0.f, 0.f, 0.f};
        cur = nxt; cA = nA; cB = nB; ++ui;
        if constexpr (ALIGN_EPI) { if (wr == 1) PG8_BAR; }
    }
    PG8_WAIT_V(0);
    if constexpr (!ALIGN_EPI) { if (wr == 0) PG8_BAR; }
    PG8_BAR;
    if constexpr (Epi::AFTER_DRAIN) { E.fused(acc, cur, wr, wc, fr, fq, lds, wid, lane); S.done(cur); }
#undef PG8_SA
#undef PG8_SB
#undef PG8_STAGE
#undef PG8_LDA
#undef PG8_LDB
#undef PG8_MMA
#undef PG8_WAIT_V
#undef PG8_WAIT_L
#undef PG8_BAR
#undef PG8_SCHED
}
}
#define GAS __attribute__((address_space(1)))
#define LAS __attribute__((address_space(3)))
typedef unsigned short bf16;
typedef unsigned v4u __attribute__((ext_vector_type(4)));
typedef float f32x4 __attribute__((ext_vector_type(4)));
typedef short bf16x8 __attribute__((ext_vector_type(8)));
typedef GAS unsigned gu32;
typedef GAS unsigned long long gu64;
#define RLX_AGENT __ATOMIC_RELAXED, __HIP_MEMORY_SCOPE_AGENT
#define LDS_WAIT() asm volatile("s_waitcnt lgkmcnt(0)" ::: "memory")
#define VM_WAIT() asm volatile("s_waitcnt vmcnt(0)" ::: "memory")
__device__ __forceinline__ unsigned long long rt() { return __builtin_amdgcn_s_memrealtime(); }
__device__ __forceinline__ unsigned f2bf(float f) { unsigned u = __builtin_bit_cast(unsigned, f); return (u + 0x7fffu + ((u >> 16) & 1u)) >> 16; }
__device__ __forceinline__ unsigned pk2(float lo, float hi) { return f2bf(lo) | (f2bf(hi) << 16); }
#define XB_TMO      128
#define XB_XCNT(j)  (256  + 64 * (j))
#define XB_XSUB(j)  (1280 + 64 * (j))
#define XB_XGEN(j)  (2304 + 64 * (j))
#define XB_TOP      3328
#define XB_TOPGEN   3392
#define XCD_BAR_WORDS 3456
#define XB_SPIN_CAP (1u << 18)

__device__ __forceinline__ unsigned xb_ld(unsigned* p)              { return __hip_atomic_load(p, __ATOMIC_RELAXED, __HIP_MEMORY_SCOPE_AGENT); }
__device__ __forceinline__ unsigned xb_add(unsigned* p, unsigned v) { return __hip_atomic_fetch_add(p, v, __ATOMIC_RELAXED, __HIP_MEMORY_SCOPE_AGENT); }
__device__ __forceinline__ unsigned xb_xcc_id() { return (unsigned)__builtin_amdgcn_s_getreg((3 << 11) | 20) & 0xFu; }
#define XB_SPIN(cond, bar) do { unsigned _sp = 0; while (cond) { __builtin_amdgcn_s_sleep(1); \
    if ((++_sp & 255u) == 0u) { if (xb_ld(&(bar)[XB_TMO])) break; if (_sp > XB_SPIN_CAP) { atomicAdd(&(bar)[XB_TMO], 1u); break; } } } } while (0)

struct XcdBarrier {
    unsigned* bar; unsigned x;
    volatile LAS unsigned* st;
};

__device__ __forceinline__ XcdBarrier xcd_barrier_post(unsigned* bar, volatile LAS unsigned* st) {
    XcdBarrier b; b.bar = bar; b.x = xb_xcc_id(); b.st = st;
    if (threadIdx.x == 0) (void)xb_add(&bar[XB_XCNT(b.x)], 1u);
    return b;
}
__device__ __forceinline__ void xcd_barrier_complete(unsigned* bar, unsigned x, unsigned& nloc, unsigned& nx) {
    const unsigned G = gridDim.x * gridDim.y * gridDim.z;
    unsigned sum, cnt, mine, sp = 0u;
    for (;;) {
        sum = 0u; cnt = 0u; mine = 0u;
#pragma unroll
        for (unsigned j = 0; j < 16; ++j) { const unsigned c = xb_ld(&bar[XB_XCNT(j)]); sum += c; cnt += (c > 0u) ? 1u : 0u; mine = (j == x) ? c : mine; }
        if (sum == G) break;
        __builtin_amdgcn_s_sleep(1);
        if ((++sp & 255u) == 0u) { if (xb_ld(&bar[XB_TMO])) break; if (sp > XB_SPIN_CAP) { atomicAdd(&bar[XB_TMO], 1u); break; } }
    }
    nloc = mine > 0u ? mine : 1u; nx = cnt > 0u ? cnt : 1u;
}

__device__ __forceinline__ void xcd_barrier(const XcdBarrier& b) {
    asm volatile("s_waitcnt vmcnt(0)" ::: "memory");
    __syncthreads();
    if (threadIdx.x == 0) {
        unsigned* bar = b.bar;
        __builtin_amdgcn_s_waitcnt(0);
        unsigned nloc = b.st[0], nx = b.st[1];
        if (nloc == 0u) { xcd_barrier_complete(bar, b.x, nloc, nx); b.st[0] = nloc; b.st[1] = nx; }
        const unsigned old = xb_add(&bar[XB_XSUB(b.x)], 1u);
        const unsigned gen = old / nloc;
        if (old + 1u == (gen + 1u) * nloc) {
            __builtin_amdgcn_fence(__ATOMIC_RELEASE, "agent");
            asm volatile("s_waitcnt vmcnt(0)" ::: "memory");
            const unsigned og = xb_add(&bar[XB_TOP], 1u);
            const unsigned tg = og / nx;
            if (og + 1u == (tg + 1u) * nx) xb_add(&bar[XB_TOPGEN], 1u);
            else XB_SPIN(xb_ld(&bar[XB_TOPGEN]) == tg, bar);
            __builtin_amdgcn_fence(__ATOMIC_ACQUIRE, "agent");
            xb_add(&bar[XB_XGEN(b.x)], 1u);
            asm volatile("s_waitcnt vmcnt(0)" ::: "memory");
        } else {
            XB_SPIN(xb_ld(&bar[XB_XGEN(b.x)]) == gen, bar);
            __builtin_amdgcn_fence(__ATOMIC_ACQUIRE, "agent");
            asm volatile("s_waitcnt vmcnt(0)" ::: "memory");
        }
    }
    __syncthreads();
}
constexpr int NWAVES = 8;
constexpr int D = 2048, SEQ = 8192, MP = 32768, MS = 128, MR = 32896, MT = 33024;
constexpr int DFF = 5632, NA = 5376, NBQ = 2048, NKV = 3072;
constexpr int CQ = 0, CK = 768, CV = 1536, CG = 3072, CQM = 4608, CLR = 5120;
constexpr float DN_ALPHA = 1.6817928305074292f, LN_EPS = 1e-5f, RMS_EPS = 1e-6f;
constexpr float GLA_QSCALE = 0.07216878364870323f, HD_SCALE = 0.08838834764831845f;
constexpr size_t MiB = 1u << 20;
constexpr size_t WS_CTL = 0, CTL_ZERO_BYTES = 1 * MiB;
constexpr size_t WS_WIN = 1 * MiB, WS_WO = 22 * MiB, WS_WFI = 30 * MiB, WS_WFO = 74 * MiB, WS_WMEM = 96 * MiB, WS_MEMX = 112 * MiB, WS_MEMK = 116 * MiB, WS_MEMV = 128 * MiB;
constexpr size_t WS_X = 140 * MiB, WS_Y = 269 * MiB, WS_R1 = 527 * MiB, WS_OCAT = 882 * MiB, WS_SBKS = 1011 * MiB, WS_SBVS = 1060 * MiB, WS_END = 1109 * MiB;
static_assert(WS_WIN + (size_t)NA * D * 2 <= WS_WO && WS_WFI + (size_t)2 * DFF * D * 2 <= WS_WFO && WS_WFO + (size_t)D * DFF * 2 <= WS_WMEM, "weights map");
static_assert(WS_X + (size_t)MT * D * 2 <= WS_Y && WS_Y + (size_t)MT * D * 4 <= WS_R1 && WS_R1 + (size_t)MT * DFF * 2 <= WS_OCAT && WS_OCAT + (size_t)MT * D * 2 <= WS_SBKS, "activation map");
static_assert(WS_SBKS + (size_t)8 * 2064 * 1536 * 2 <= WS_SBVS && WS_SBVS + (size_t)8 * 2064 * 1536 * 2 <= WS_END, "sb sample map");
constexpr size_t O_YP = 0, O_YS = 67108864, O_GSP = 67371008, O_GSS = 69730304, O_SKP = 74448896, O_SVP = 124780544, O_SKS = 175112192, O_SVS = 175308800, O_MKP = 175505408, O_MVP = 177602560, O_END = 179699712;
constexpr int CW_BAR = 4096;
constexpr int RING_OFF = 0, RING_BYTES = 131072, LDSCTL_OFF = RING_BYTES, MISC_OFF = LDSCTL_OFF + 320, LDS_BYTES = 147456;

struct Args { const float* in[22]; float* out_; unsigned char* ws_; int ph_lo, ph_hi; };
struct Frame {
    LAS unsigned char* lds; volatile LAS unsigned* MISC; gu32* ctl;
    int tid, lane, wave, G, gw, NGW;
};
__device__ __forceinline__ float bf2f(bf16 h) { return __builtin_bit_cast(float, (unsigned)h << 16); }
__device__ __forceinline__ float shx(float v, int lane, int m) { return __builtin_bit_cast(float, __builtin_amdgcn_ds_bpermute((lane ^ m) << 2, __builtin_bit_cast(int, v))); }
__device__ __forceinline__ float wave_sum(float v, int lane) {
#pragma unroll
    for (int o = 1; o < 64; o <<= 1) v += shx(v, lane, o);
    return v;
}
__device__ __forceinline__ float wave_max(float v, int lane) {
#pragma unroll
    for (int o = 1; o < 64; o <<= 1) v = fmaxf(v, shx(v, lane, o));
    return v;
}
__device__ __forceinline__ void cvt_row(const float* src, bf16* dst, int n, int lane) {
    for (int j = lane * 4; j < n; j += 256) {
        f32x4 v = src ? *(const f32x4*)(src + j) : (f32x4){0.f, 0.f, 0.f, 0.f};
        unsigned long long w = (unsigned long long)pk2(v.x, v.y) | ((unsigned long long)pk2(v.z, v.w) << 32);
        *(unsigned long long*)(dst + j) = w;
    }
}
template <bool FINAL>
__device__ __forceinline__ void ln_two_rows(int lane, const bf16* y0, const bf16* y1, const float* gg, const float* bb, bf16* x0, bf16* x1, float* of0, float* of1) {
    v4u w[2][4];
#pragma unroll
    for (int j = 0; j < 4; ++j) { w[0][j] = ((const v4u*)y0)[lane + 64 * j]; w[1][j] = ((const v4u*)y1)[lane + 64 * j]; }
    float v[2][4][8]; float s[2] = {0.f, 0.f};
#pragma unroll
    for (int r = 0; r < 2; ++r)
#pragma unroll
        for (int j = 0; j < 4; ++j) { const v4u q = w[r][j]; v[r][j][0] = pg8::bflo(q.x); v[r][j][1] = pg8::bfhi(q.x); v[r][j][2] = pg8::bflo(q.y); v[r][j][3] = pg8::bfhi(q.y); v[r][j][4] = pg8::bflo(q.z); v[r][j][5] = pg8::bfhi(q.z); v[r][j][6] = pg8::bflo(q.w); v[r][j][7] = pg8::bfhi(q.w);
            s[r] += ((v[r][j][0] + v[r][j][1]) + (v[r][j][2] + v[r][j][3])) + ((v[r][j][4] + v[r][j][5]) + (v[r][j][6] + v[r][j][7])); }
    const float m0 = wave_sum(s[0], lane) * (1.f / D), m1 = wave_sum(s[1], lane) * (1.f / D); float q0 = 0.f, q1 = 0.f;
#pragma unroll
    for (int j = 0; j < 4; ++j)
#pragma unroll
        for (int i = 0; i < 8; ++i) { v[0][j][i] -= m0; q0 += v[0][j][i] * v[0][j][i]; v[1][j][i] -= m1; q1 += v[1][j][i] * v[1][j][i]; }
    const float rs[2] = {1.f / sqrtf(wave_sum(q0, lane) * (1.f / D) + LN_EPS), 1.f / sqrtf(wave_sum(q1, lane) * (1.f / D) + LN_EPS)};
#pragma unroll
    for (int j = 0; j < 4; ++j) { const int e0 = (lane + 64 * j) * 8; const f32x4 g0 = *(const f32x4*)(gg + e0), g1 = *(const f32x4*)(gg + e0 + 4), b0 = *(const f32x4*)(bb + e0), b1 = *(const f32x4*)(bb + e0 + 4);
#pragma unroll
        for (int r = 0; r < 2; ++r) { float o[8];
#pragma unroll
            for (int i = 0; i < 4; ++i) { o[i] = v[r][j][i] * rs[r] * g0[i] + b0[i]; o[4 + i] = v[r][j][4 + i] * rs[r] * g1[i] + b1[i]; }
            if (FINAL) { float* of = r ? of1 : of0; *(f32x4*)(of + e0) = (f32x4){o[0], o[1], o[2], o[3]}; *(f32x4*)(of + e0 + 4) = (f32x4){o[4], o[5], o[6], o[7]}; }
            else { v4u p; p.x = pk2(o[0], o[1]); p.y = pk2(o[2], o[3]); p.z = pk2(o[4], o[5]); p.w = pk2(o[6], o[7]); *(v4u*)((r ? x1 : x0) + e0) = p; } } }
}
struct MapId { __device__ __forceinline__ int operator()(int n) const { return n; } };
struct MapInA { __device__ __forceinline__ int operator()(int n) const { return n < 4608 ? n : (n < 5120 ? n + 16 : (n < 5136 ? n - 512 : -1)); } };
struct MapFfn { __device__ __forceinline__ int operator()(int n) const { const int t = n >> 8, r = n & 255; return r < 128 ? 128 * t + r : DFF + 128 * t + (r - 128); } };
template <class Map>
__device__ __forceinline__ void wt_convert(LAS unsigned char* ldsb, int wave, int gw, int NGW, int lane, const float* W, int K, int Nsrc, bf16* WT, int Ndst, Map map) {
    LAS float* scr = (LAS float*)(ldsb + RING_OFF + wave * 16384);
    const int nblk = Ndst / 64, nitems = (K / 64) * nblk, nq = lane & 15, kq = lane >> 4;
    for (int it = gw; it < nitems; it += NGW) {
        const int kb = it / nblk, nb = it % nblk, k0 = 64 * kb, n0 = 64 * nb;
        const int sc0 = map(n0 + 4 * nq), sc3 = map(n0 + 4 * nq + 3);
        const bool contig = sc0 >= 0 && sc3 == sc0 + 3;
        f32x4 v[16];
#pragma unroll
        for (int i = 0; i < 16; ++i) { const int kk = 4 * i + kq;
            if (contig) v[i] = *(const f32x4*)(W + (size_t)(k0 + kk) * Nsrc + sc0);
            else {
#pragma unroll
                for (int e = 0; e < 4; ++e) { const int sc = map(n0 + 4 * nq + e); v[i][e] = sc >= 0 ? W[(size_t)(k0 + kk) * Nsrc + sc] : 0.f; } } }
#pragma unroll
        for (int i = 0; i < 16; ++i) { const int kk = 4 * i + kq;
#pragma unroll
            for (int e = 0; e < 4; ++e) { const int n = 4 * nq + e; scr[n * 64 + (kk ^ n)] = v[i][e]; } }
        LDS_WAIT(); asm volatile("" ::: "memory");
        const int c = lane & 7;
#pragma unroll
        for (int j = 0; j < 8; ++j) { const int n = (lane >> 3) + 8 * j; const LAS float* s = scr + n * 64;
#define SWZ(i) s[(8 * c + (i)) ^ n]
            v4u o; o.x = pk2(SWZ(0), SWZ(1)); o.y = pk2(SWZ(2), SWZ(3)); o.z = pk2(SWZ(4), SWZ(5)); o.w = pk2(SWZ(6), SWZ(7));
#undef SWZ
            *(GAS v4u*)(WT + (size_t)(n0 + n) * K + k0 + 8 * c) = o; }
        LDS_WAIT(); asm volatile("" ::: "memory");
    }
}
__device__ __forceinline__ float softplus_f(float z) { return fmaxf(z, 0.f) + log1pf(__expf(-fabsf(z))); }

typedef short s16x4 __attribute__((ext_vector_type(4)));
typedef pg8::u32x2 u32x2;
typedef float f32x16 __attribute__((ext_vector_type(16)));
typedef __bf16 bf16x2_t __attribute__((ext_vector_type(2)));
typedef float f32x2_t __attribute__((ext_vector_type(2)));
__device__ __forceinline__ unsigned cvt2(float lo, float hi) { const f32x2_t v = {lo, hi}; const bf16x2_t b = __builtin_convertvector(v, bf16x2_t); return __builtin_bit_cast(unsigned, b); }
__device__ __forceinline__ bf16x8 pack8(const f32x4 a, const f32x4 b) { v4u p; p.x = cvt2(a[0], a[1]); p.y = cvt2(a[2], a[3]); p.z = cvt2(b[0], b[1]); p.w = cvt2(b[2], b[3]); return __builtin_bit_cast(bf16x8, p); }
__device__ __forceinline__ bf16x8 ld2x8(const bf16* p0, const bf16* p1) { const s16x4 a = *(const s16x4*)p0, b = *(const s16x4*)p1; return __builtin_shufflevector(a, b, 0, 1, 2, 3, 4, 5, 6, 7); }
__device__ __forceinline__ bf16x8 ld16(const bf16* p) { return *(const bf16x8*)p; }
#define MFMA16(a, b, c) __builtin_amdgcn_mfma_f32_16x16x32_bf16((a), (b), (c), 0, 0, 0)
#define MFMA32(a, b, c) __builtin_amdgcn_mfma_f32_32x32x16_bf16((a), (b), (c), 0, 0, 0)

constexpr int QIMG_LD = 200, KTIMG_LD = 68, PKG_Q = 0, PKG_KT = 25600, PKG_G = 51712, IMG_BYTES = 52480, PKG_K = 52480, PKG_VT = 77056, PKG_BYTES = 126208, N_PKG = 2048 + 32;
static_assert(64 * QIMG_LD * 2 == PKG_KT && PKG_KT + 192 * KTIMG_LD * 2 == PKG_G && PKG_G + 768 == IMG_BYTES && PKG_K + 24576 == PKG_VT && PKG_VT + 49152 == PKG_BYTES && IMG_BYTES % 16 == 0, "package map");

__device__ __forceinline__ float softplus_fast(float z) { return fmaxf(z, 0.f) + __logf(1.0f + __expf(-fabsf(z))); }
__device__ __forceinline__ void gla_prep(int bid, int G, int tid, int wave, LAS unsigned char* lds, int l, const bf16* PROJ, const float* w_gate_lr, const float* b_gate, unsigned char* PKG) {
    const int lane = tid & 63;
    const float* w2 = w_gate_lr + (size_t)l * 16 * 768; const float* bg = b_gate + (size_t)l * 768;
    LAS float* tot = (LAS float*)lds;
    for (int item = bid; item < N_PKG; item += G) {
        int h, row0, T;
        if (item < 2048) { const int bh = item >> 7, ch = item & 127; h = bh & 3; row0 = (bh >> 2) * SEQ + ch * 64; T = 64; }
        else { const int i2 = item - 2048; h = i2 & 3; row0 = MP + (i2 >> 2) * 16; T = 16; }
        unsigned char* pk = PKG + (size_t)item * PKG_BYTES;
        bf16* Qt = (bf16*)(pk + PKG_Q); bf16* Kt = (bf16*)(pk + PKG_K); bf16* KT = (bf16*)(pk + PKG_KT); bf16* VT = (bf16*)(pk + PKG_VT); float* Gp = (float*)(pk + PKG_G);
        float w2c[3][16], bgc[3];
#pragma unroll
        for (int c = 0; c < 3; ++c) { const int d = h * 192 + lane + 64 * c; bgc[c] = bg[d];
#pragma unroll
            for (int r = 0; r < 16; ++r) w2c[c][r] = w2[r * 768 + d]; }
        v4u l0[8], l1[8];
#pragma unroll
        for (int tt = 0; tt < 8; ++tt) { const int t = 8 * wave + tt; const bf16* prow = PROJ + (size_t)(row0 + (t < T ? t : T - 1)) * NA;
            l0[tt] = *(const v4u*)(prow + CLR); l1[tt] = *(const v4u*)(prow + CLR + 8); }
        float lc[8][3]; float run[3] = {0.f, 0.f, 0.f};
#pragma unroll
        for (int tt = 0; tt < 8; ++tt) { const bool ok = 8 * wave + tt < T;
            float lr[16]; lr[0] = pg8::bflo(l0[tt].x); lr[1] = pg8::bfhi(l0[tt].x); lr[2] = pg8::bflo(l0[tt].y); lr[3] = pg8::bfhi(l0[tt].y); lr[4] = pg8::bflo(l0[tt].z); lr[5] = pg8::bfhi(l0[tt].z); lr[6] = pg8::bflo(l0[tt].w); lr[7] = pg8::bfhi(l0[tt].w);
            lr[8] = pg8::bflo(l1[tt].x); lr[9] = pg8::bfhi(l1[tt].x); lr[10] = pg8::bflo(l1[tt].y); lr[11] = pg8::bfhi(l1[tt].y); lr[12] = pg8::bflo(l1[tt].z); lr[13] = pg8::bfhi(l1[tt].z); lr[14] = pg8::bflo(l1[tt].w); lr[15] = pg8::bfhi(l1[tt].w);
#pragma unroll
            for (int c = 0; c < 3; ++c) { float xg = bgc[c];
#pragma unroll
                for (int r = 0; r < 16; ++r) xg += lr[r] * w2c[c][r];
                run[c] += ok ? -softplus_fast(-xg) * (1.0f / 16.0f) : 0.f; lc[tt][c] = run[c]; } }
#pragma unroll
        for (int c = 0; c < 3; ++c) tot[wave * 192 + lane + 64 * c] = run[c];
        unsigned qv[8][3], kv[8][3];
#pragma unroll
        for (int tt = 0; tt < 8; ++tt) { const int t = 8 * wave + tt; const bf16* prow = PROJ + (size_t)(row0 + (t < T ? t : T - 1)) * NA + h * 192 + lane;
#pragma unroll
            for (int c = 0; c < 3; ++c) { qv[tt][c] = prow[CQ + 64 * c]; kv[tt][c] = prow[CK + 64 * c]; } }
        __syncthreads();
        float pre[3], all[3];
#pragma unroll
        for (int c = 0; c < 3; ++c) { pre[c] = 0.f; all[c] = 0.f;
#pragma unroll
            for (int w = 0; w < 8; ++w) { const float tv = tot[w * 192 + lane + 64 * c]; all[c] += tv; if (w < wave) pre[c] += tv; } }
        unsigned ktw[3][4];
#pragma unroll
        for (int tt = 0; tt < 8; ++tt) { const int t = 8 * wave + tt; const bool ok = t < T;
#pragma unroll
            for (int c = 0; c < 3; ++c) { const int dl = lane + 64 * c; const float bc = pre[c] + lc[tt][c]; const float eq = __expf(bc), ek = __expf(-bc);
                const unsigned qb = ok ? f2bf(bf2f((bf16)qv[tt][c]) * GLA_QSCALE * eq) : 0u, kb = ok ? f2bf(bf2f((bf16)kv[tt][c]) * ek) : 0u;
                Qt[t * QIMG_LD + dl] = (bf16)qb; Kt[t * 192 + dl] = (bf16)kb;
                if (tt & 1) ktw[c][tt >> 1] |= kb << 16; else ktw[c][tt >> 1] = kb; } }
#pragma unroll
        for (int c = 0; c < 3; ++c) { bf16* kp = KT + (size_t)(lane + 64 * c) * KTIMG_LD + 8 * wave; u32x2 o0, o1; o0.x = ktw[c][0]; o0.y = ktw[c][1]; o1.x = ktw[c][2]; o1.y = ktw[c][3]; *(u32x2*)kp = o0; *(u32x2*)(kp + 4) = o1; }
        if (wave == 0) {
#pragma unroll
            for (int c = 0; c < 3; ++c) Gp[lane + 64 * c] = __expf(all[c]); }
        unsigned vv[6][8];
#pragma unroll
        for (int tt = 0; tt < 8; ++tt) { const int t = 8 * wave + tt; const bf16* prow = PROJ + (size_t)(row0 + (t < T ? t : T - 1)) * NA + CV + h * 384 + lane;
#pragma unroll
            for (int c2 = 0; c2 < 6; ++c2) vv[c2][tt] = t < T ? (unsigned)prow[64 * c2] : 0u; }
#pragma unroll
        for (int c2 = 0; c2 < 6; ++c2) { v4u o; o.x = vv[c2][0] | (vv[c2][1] << 16); o.y = vv[c2][2] | (vv[c2][3] << 16); o.z = vv[c2][4] | (vv[c2][5] << 16); o.w = vv[c2][6] | (vv[c2][7] << 16);
            *(v4u*)(VT + (size_t)(lane + 64 * c2) * 64 + 8 * wave) = o; }
        __syncthreads();
    }
}

__device__ __forceinline__ void gla_intra(int item, int tid, int wave, LAS unsigned char* lds, const unsigned char* PKG, float* OINT) {
    const int lane = tid & 63, fr = lane & 15, fq = lane >> 4;
    int h, row0, nvalid;
    if (item < 2048) { const int bh = item >> 7, ch = item & 127; h = bh & 3; row0 = (bh >> 2) * SEQ + ch * 64; nvalid = 64; }
    else { const int i2 = item - 2048; h = i2 & 3; row0 = MP + (i2 >> 2) * 16; nvalid = 16; }
    const unsigned char* pk = PKG + (size_t)item * PKG_BYTES;
    const bf16* Qt = (const bf16*)(pk + PKG_Q); const bf16* Kt = (const bf16*)(pk + PKG_K); const bf16* VT = (const bf16*)(pk + PKG_VT);
    bf16x8 va[3], vb[3];
#pragma unroll
    for (int k = 0; k < 3; ++k) { const bf16* vr = VT + (size_t)(16 * (3 * wave + k) + fr) * 64 + 4 * fq; va[k] = ld2x8(vr, vr + 16); vb[k] = ld2x8(vr + 32, vr + 48); }
    constexpr int P_LD = 68;
    LAS bf16* P = (LAS bf16*)lds;
#pragma unroll
    for (int rep = 0; rep < 2; ++rep) {
        const int tl = wave + 8 * rep;
        if (tl < 10) {
            const int it = tl < 1 ? 0 : (tl < 3 ? 1 : (tl < 6 ? 2 : 3)), jt = tl - (it * (it + 1)) / 2;
            f32x4 at = {0.f, 0.f, 0.f, 0.f};
            const bf16* qr = Qt + (size_t)(16 * it + fr) * QIMG_LD + 8 * fq; const bf16* kr = Kt + (size_t)(16 * jt + fr) * 192 + 8 * fq;
#pragma unroll
            for (int s = 0; s < 6; ++s) at = MFMA16(ld16(kr + 32 * s), ld16(qr + 32 * s), at);
            if (it == jt) {
#pragma unroll
                for (int jj = 0; jj < 4; ++jj) if (4 * fq + jj > fr) at[jj] = 0.f; }
            u32x2 w; w.x = cvt2(at[0], at[1]); w.y = cvt2(at[2], at[3]);
            *(LAS u32x2*)(P + (16 * it + fr) * P_LD + 16 * jt + 4 * fq) = w;
        } else if (tl == 10 || tl == 11) {
            const int it = tl == 10 ? 0 : 2, jt = tl == 10 ? 1 : 3; u32x2 z; z.x = 0u; z.y = 0u;
            *(LAS u32x2*)(P + (16 * it + fr) * P_LD + 16 * jt + 4 * fq) = z;
        }
    }
    __syncthreads();
#pragma unroll
    for (int it = 0; it < 4; ++it) {
        if (16 * it >= nvalid) break;
        const LAS bf16* pr = P + (16 * it + fr) * P_LD + 4 * fq;
        const s16x4 a0 = *(const LAS s16x4*)pr, a1 = *(const LAS s16x4*)(pr + 16);
        const bf16x8 pf0 = __builtin_shufflevector(a0, a1, 0, 1, 2, 3, 4, 5, 6, 7); bf16x8 pf1 = pf0;
        if (it >= 2) { const s16x4 b0 = *(const LAS s16x4*)(pr + 32), b1 = *(const LAS s16x4*)(pr + 48); pf1 = __builtin_shufflevector(b0, b1, 0, 1, 2, 3, 4, 5, 6, 7); }
#pragma unroll
        for (int k = 0; k < 3; ++k) { f32x4 o = {0.f, 0.f, 0.f, 0.f};
            o = MFMA16(va[k], pf0, o); if (it >= 2) o = MFMA16(vb[k], pf1, o);
            *(f32x4*)(OINT + (size_t)(row0 + 16 * it + fr) * 1536 + h * 384 + 16 * (3 * wave + k) + 4 * fq) = o; }
    }
    __syncthreads();
}

template <int PASS>
__device__ __forceinline__ void gla_chain(int wc, int tid, int wave, LAS unsigned char* lds, int l, const unsigned char* PKG, const float* state_gla, float* OINT, float* out, float* SLOC, float* GSEG, bool dry = false) {
    const int lane = tid & 63, fr = lane & 15, fq = lane >> 4;
    int h, vb, bh, seg, item0, nsteps, row0, nvalid; const float* s0 = nullptr; float* sout = nullptr;
    if (PASS == 1) { bh = wc / 9; const int rem = wc % 9; vb = rem / 3; seg = rem % 3; h = bh & 3; item0 = bh * 128 + 32 * seg; nsteps = 32; row0 = 0; nvalid = 64; }
    else if (wc < 192) { bh = wc / 12; const int rem = wc % 12; vb = rem >> 2; seg = rem & 3; h = bh & 3; item0 = bh * 128 + 32 * seg; nsteps = 32; row0 = (bh >> 2) * SEQ + 2048 * seg; nvalid = 64;
        if (seg == 3) sout = out + O_GSP + (size_t)(l * 16 + bh) * 192 * 384; }
    else { const int c2 = wc - 192; bh = c2 / 3; vb = c2 % 3; seg = 0; h = bh & 3; item0 = 2048 + bh; nsteps = 1; row0 = MP + (bh >> 2) * 16; nvalid = 16; s0 = state_gla + (size_t)(l * 32 + bh) * 192 * 384; sout = out + O_GSS + (size_t)(l * 32 + bh) * 192 * 384; }
    const int v0 = vb * 128 + wave * 16;
#define GLA_WALK(p, step) do { (p) += (step); asm volatile("" : "+v"(p)); } while (0)
    f32x4 S[12];
    if (s0) { const float* p = s0 + (size_t)(4 * fq) * 384 + v0 + fr;
#pragma unroll
        for (int t = 0; t < 12; ++t) {
#pragma unroll
            for (int jj = 0; jj < 4; ++jj) { S[t][jj] = *p; GLA_WALK(p, 384); }
            GLA_WALK(p, 12 * 384); } }
    else {
#pragma unroll
        for (int t = 0; t < 12; ++t) S[t] = (f32x4){0.f, 0.f, 0.f, 0.f}; }
    if (PASS == 2 && wc < 192) {
        for (int j = 0; j < seg; ++j) { const float* gs = GSEG + (size_t)(bh * 3 + j) * 192 + 4 * fq; const float* p = SLOC + (size_t)((bh * 3 + vb) * 3 + j) * 192 * 128 + (size_t)(4 * fq) * 128 + wave * 16 + fr;
#pragma unroll
            for (int t = 0; t < 12; ++t) { const f32x4 g4 = *(const f32x4*)(gs + 16 * t);
#pragma unroll
                for (int jj = 0; jj < 4; ++jj) { S[t][jj] = g4[jj] * S[t][jj] + *p; GLA_WALK(p, 128); }
                GLA_WALK(p, 12 * 128); } }
    }
    f32x4 GP[PASS == 1 ? 12 : 1];
    if (PASS == 1) {
#pragma unroll
        for (int t = 0; t < 12; ++t) GP[t] = (f32x4){1.f, 1.f, 1.f, 1.f}; }
    constexpr int CH0 = PASS == 1 ? PKG_KT / 16 : 0, NCH = IMG_BYTES / 16, NLD = PASS == 1 ? 4 : 7;
    v4u pre[NLD]; bf16x8 vt[2], vtn[2]; f32x4 oin[4];
    { const unsigned char* pk = PKG + (size_t)item0 * PKG_BYTES;
      if (PASS == 2) {
#pragma unroll
        for (int it = 0; it < 4; ++it) { const int tl = 16 * it + fr; oin[it] = tl < nvalid ? *(const f32x4*)(OINT + (size_t)(row0 + tl) * 1536 + h * 384 + v0 + 4 * fq) : (f32x4){0.f, 0.f, 0.f, 0.f}; } }
#pragma unroll
      for (int k = 0; k < NLD; ++k) { const int ch = CH0 + tid + 512 * k; if (ch < NCH) pre[k] = *(const v4u*)(pk + (size_t)ch * 16); }
      const bf16* VT = (const bf16*)(pk + PKG_VT) + (size_t)(v0 + fr) * 64 + 4 * fq; vt[0] = ld2x8(VT, VT + 16); vt[1] = ld2x8(VT + 32, VT + 48);
#pragma unroll
      for (int k = 0; k < NLD; ++k) { const int ch = CH0 + tid + 512 * k; if (ch < NCH) *(LAS v4u*)(lds + (size_t)ch * 16) = pre[k]; }
      vtn[0] = vt[0]; vtn[1] = vt[1]; }
    __syncthreads();
    for (int n = 0; n < nsteps; ++n) {
        const LAS unsigned char* img = lds + (n & 1) * IMG_BYTES;
        const bool more = n + 1 < nsteps;
        if (more) { const unsigned char* pk = PKG + (size_t)(item0 + n + 1) * PKG_BYTES;
#pragma unroll
            for (int k = 0; k < NLD; ++k) { const int ch = CH0 + tid + 512 * k; if (ch < NCH) pre[k] = *(const v4u*)(pk + (size_t)ch * 16); }
            const bf16* VT = (const bf16*)(pk + PKG_VT) + (size_t)(v0 + fr) * 64 + 4 * fq; vtn[0] = ld2x8(VT, VT + 16); vtn[1] = ld2x8(VT + 32, VT + 48); }
        if (PASS == 2) {
            bf16x8 Sb[6];
#pragma unroll
            for (int s = 0; s < 6; ++s) Sb[s] = pack8(S[2 * s], S[2 * s + 1]);
#pragma unroll
            for (int it = 0; it < 4; ++it) {
                const LAS bf16* qr = (const LAS bf16*)(img + PKG_Q) + (16 * it + fr) * QIMG_LD + 4 * fq;
                f32x4 o = oin[it];
#pragma unroll
                for (int s = 0; s < 6; ++s) { const s16x4 a = *(const LAS s16x4*)(qr + 32 * s), b = *(const LAS s16x4*)(qr + 32 * s + 16);
                    o = MFMA16(Sb[s], __builtin_shufflevector(a, b, 0, 1, 2, 3, 4, 5, 6, 7), o); }
                const int tl = 16 * it + fr;
                if (tl < nvalid && !dry) *(f32x4*)(OINT + (size_t)(row0 + 64 * n + tl) * 1536 + h * 384 + v0 + 4 * fq) = o;
                __builtin_amdgcn_sched_barrier(0);
            }
            if (more) {
#pragma unroll
                for (int it = 0; it < 4; ++it) oin[it] = *(const f32x4*)(OINT + (size_t)(row0 + 64 * (n + 1) + 16 * it + fr) * 1536 + h * 384 + v0 + 4 * fq); }
        }
#pragma unroll
        for (int t = 0; t < 12; ++t) { const LAS bf16* kr = (const LAS bf16*)(img + PKG_KT) + (16 * t + fr) * KTIMG_LD + 4 * fq;
#pragma unroll
            for (int s2 = 0; s2 < 2; ++s2) { const s16x4 a = *(const LAS s16x4*)(kr + 32 * s2), b = *(const LAS s16x4*)(kr + 32 * s2 + 16);
                S[t] = MFMA16(__builtin_shufflevector(a, b, 0, 1, 2, 3, 4, 5, 6, 7), vt[s2], S[t]); }
            const f32x4 g4 = *(const LAS f32x4*)(img + PKG_G + (16 * t + 4 * fq) * 4);
            S[t] = S[t] * g4; if (PASS == 1) GP[t] = GP[t] * g4; if (t & 1) __builtin_amdgcn_sched_barrier(0); }
        if (more) { LAS unsigned char* nimg = lds + ((n + 1) & 1) * IMG_BYTES;
#pragma unroll
            for (int k = 0; k < NLD; ++k) { const int ch = CH0 + tid + 512 * k; if (ch < NCH) *(LAS v4u*)(nimg + (size_t)ch * 16) = pre[k]; }
            vt[0] = vtn[0]; vt[1] = vtn[1]; }
        asm volatile("s_waitcnt lgkmcnt(0)" ::: "memory"); __builtin_amdgcn_s_barrier(); asm volatile("" ::: "memory");
    }
    if (PASS == 1) {
        float* p = SLOC + (size_t)((bh * 3 + vb) * 3 + seg) * 192 * 128 + (size_t)(4 * fq) * 128 + wave * 16 + fr;
#pragma unroll
        for (int t = 0; t < 12; ++t) {
#pragma unroll
            for (int jj = 0; jj < 4; ++jj) { *p = S[t][jj]; GLA_WALK(p, 128); }
            GLA_WALK(p, 12 * 128); }
        if (vb == 0 && wave == 0 && fr == 0) { float* gs = GSEG + (size_t)(bh * 3 + seg) * 192;
#pragma unroll
            for (int t = 0; t < 12; ++t) *(f32x4*)(gs + 16 * t + 4 * fq) = GP[t]; }
    } else if (sout) {
        float* p = sout + (size_t)(4 * fq) * 384 + v0 + fr;
#pragma unroll
        for (int t = 0; t < 12; ++t) {
#pragma unroll
            for (int jj = 0; jj < 4; ++jj) { *p = S[t][jj]; GLA_WALK(p, 384); }
            GLA_WALK(p, 12 * 384); }
    }
#undef GLA_WALK
}

__device__ __forceinline__ void mem_attn(int item, int lane, int l, const bf16* PROJ, int ldp, int cqm, const bf16* MEMK, const bf16* MEMVT, bf16* OCAT) {
    const int fr = lane & 15, fq = lane >> 4, tile = item >> 2, h = item & 3, r0 = tile * 16;
    const int bb = r0 < MP ? r0 / SEQ : 4 + ((r0 - MP) >> 4);
    const bf16* Kb = MEMK + (size_t)((l * 12 + bb) * 256) * 512 + h * 128; const bf16* Vt = MEMVT + (size_t)(((l * 12 + bb) * 4 + h) * 128) * 256;
    bf16x8 qf[4];
#pragma unroll
    for (int s = 0; s < 4; ++s) qf[s] = ld16(PROJ + (size_t)(r0 + fr) * ldp + cqm + h * 128 + 32 * s + 8 * fq);
    f32x4 st[16];
#pragma unroll
    for (int mt = 0; mt < 16; ++mt) { st[mt] = (f32x4){0.f, 0.f, 0.f, 0.f}; const bf16* kr = Kb + (size_t)(16 * mt + fr) * 512 + 8 * fq;
#pragma unroll
        for (int s = 0; s < 4; ++s) st[mt] = MFMA16(ld16(kr + 32 * s), qf[s], st[mt]); }
    float mx = -3.0e38f;
#pragma unroll
    for (int mt = 0; mt < 16; ++mt) mx = fmaxf(mx, fmaxf(fmaxf(st[mt][0], st[mt][1]), fmaxf(st[mt][2], st[mt][3])));
    mx = fmaxf(mx, shx(mx, lane, 16)); mx = fmaxf(mx, shx(mx, lane, 32));
    float sum = 0.f;
#pragma unroll
    for (int mt = 0; mt < 16; ++mt)
#pragma unroll
        for (int jj = 0; jj < 4; ++jj) { const float p = __expf((st[mt][jj] - mx) * HD_SCALE); st[mt][jj] = p; sum += p; }
    sum += shx(sum, lane, 16); sum += shx(sum, lane, 32);
    const float inv = 1.0f / sum;
    bf16x8 pf[8];
#pragma unroll
    for (int s = 0; s < 8; ++s) pf[s] = pack8(st[2 * s], st[2 * s + 1]);
#pragma unroll
    for (int dt = 0; dt < 8; ++dt) { f32x4 o = {0.f, 0.f, 0.f, 0.f}; const bf16* vr = Vt + (size_t)(16 * dt + fr) * 256 + 4 * fq;
#pragma unroll
        for (int s = 0; s < 8; ++s) o = MFMA16(ld2x8(vr + 32 * s, vr + 32 * s + 16), pf[s], o);
        u32x2 w; w.x = cvt2(o[0] * inv, o[1] * inv); w.y = cvt2(o[2] * inv, o[3] * inv);
        *(u32x2*)(OCAT + (size_t)(r0 + fr) * D + 1536 + h * 128 + 16 * dt + 4 * fq) = w; }
}

__device__ __forceinline__ void mem_attn_wg(int wi, int tid, int wave, LAS unsigned char* lds, int l, const bf16* PROJ, int ldp, int cqm, const bf16* MEMK, const bf16* MEMVT, bf16* OCAT) {
    const bool smp = wi >= 256; const int lane = tid & 63, fr = lane & 15, fq = lane >> 4, bh = smp ? (wi - 256) : (wi >> 4), sub = wi & 15, b = smp ? 4 + (bh >> 2) : (bh >> 2), h = bh & 3;
    const bf16* Kb = MEMK + (size_t)((l * 12 + b) * 256) * 512 + h * 128; const bf16* Vt = MEMVT + (size_t)(((l * 12 + b) * 4 + h) * 128) * 256;
#pragma unroll
    for (int k = 0; k < 8; ++k) { const int idx = tid + 512 * k, row = idx >> 4, c = idx & 15; *(LAS v4u*)(lds + row * 256 + ((c ^ (row & 15)) << 4)) = *(const v4u*)(Kb + (size_t)row * 512 + c * 8); }
#pragma unroll
    for (int k = 0; k < 8; ++k) { const int idx = tid + 512 * k, row = idx >> 5, c = idx & 31; *(LAS v4u*)(lds + 65536 + row * 512 + ((c ^ (2 * (row & 15))) << 4)) = *(const v4u*)(Vt + (size_t)row * 256 + c * 8); }
    __syncthreads();
    unsigned koff[4], voff[16];
#pragma unroll
    for (int s2 = 0; s2 < 4; ++s2) { koff[s2] = (unsigned)(fr * 256 + (((4 * s2 + fq) ^ fr) << 4)); asm volatile("" : "+v"(koff[s2])); }
#pragma unroll
    for (int s2 = 0; s2 < 8; ++s2) { const int p0 = 8 * s2 + fq, p1 = p0 + 4;
        voff[2 * s2] = (unsigned)(65536 + fr * 512 + ((((p0 >> 1) ^ (2 * fr)) << 4) | ((p0 & 1) << 3))); voff[2 * s2 + 1] = (unsigned)(65536 + fr * 512 + ((((p1 >> 1) ^ (2 * fr)) << 4) | ((p1 & 1) << 3)));
        asm volatile("" : "+v"(voff[2 * s2]), "+v"(voff[2 * s2 + 1])); }
    const int nblk = smp ? (wave == 0 ? 1 : 0) : 4;
#pragma unroll 1
    for (int blk = 0; blk < nblk; ++blk) {
        const int r0 = smp ? MP + (b - 4) * 16 : b * SEQ + sub * 512 + blk * 128 + wave * 16;
        bf16x8 qf[4];
#pragma unroll
        for (int s = 0; s < 4; ++s) qf[s] = ld16(PROJ + (size_t)(r0 + fr) * ldp + cqm + h * 128 + 32 * s + 8 * fq);
        f32x4 st[16];
#pragma unroll
        for (int mt = 0; mt < 16; ++mt) { st[mt] = (f32x4){0.f, 0.f, 0.f, 0.f};
#pragma unroll
            for (int s = 0; s < 4; ++s) st[mt] = MFMA16(*(const LAS bf16x8*)(lds + koff[s] + mt * 4096), qf[s], st[mt]);
            if ((mt & 3) == 3) __builtin_amdgcn_sched_barrier(0); }
        float mx = -3.0e38f;
#pragma unroll
        for (int mt = 0; mt < 16; ++mt) mx = fmaxf(mx, fmaxf(fmaxf(st[mt][0], st[mt][1]), fmaxf(st[mt][2], st[mt][3])));
        mx = fmaxf(mx, shx(mx, lane, 16)); mx = fmaxf(mx, shx(mx, lane, 32));
        float sum = 0.f;
#pragma unroll
        for (int mt = 0; mt < 16; ++mt)
#pragma unroll
            for (int jj = 0; jj < 4; ++jj) { const float p = __expf((st[mt][jj] - mx) * HD_SCALE); st[mt][jj] = p; sum += p; }
        sum += shx(sum, lane, 16); sum += shx(sum, lane, 32);
        const float inv = 1.0f / sum;
        bf16x8 pf[8];
#pragma unroll
        for (int s = 0; s < 8; ++s) pf[s] = pack8(st[2 * s], st[2 * s + 1]);
#pragma unroll
        for (int dt = 0; dt < 8; ++dt) { f32x4 o = {0.f, 0.f, 0.f, 0.f};
#pragma unroll
            for (int s = 0; s < 8; ++s) { const s16x4 a = *(const LAS s16x4*)(lds + voff[2 * s] + dt * 8192), bb = *(const LAS s16x4*)(lds + voff[2 * s + 1] + dt * 8192);
                o = MFMA16(__builtin_shufflevector(a, bb, 0, 1, 2, 3, 4, 5, 6, 7), pf[s], o); }
            u32x2 w; w.x = cvt2(o[0] * inv, o[1] * inv); w.y = cvt2(o[2] * inv, o[3] * inv);
            *(u32x2*)(OCAT + (size_t)(r0 + fr) * D + 1536 + h * 128 + 16 * dt + 4 * fq) = w;
            if (dt & 1) __builtin_amdgcn_sched_barrier(0); }
    }
    __syncthreads();
}

__device__ __forceinline__ void sb_attn(int lane, LAS unsigned char* wlds, const bf16* Kp, int ldk, const bf16* VTp, int ldvt, const bf16* Qp, int ldq, bf16* Op, int t0, int nq) {
    const int r = lane & 31, hh = lane >> 5;
    LAS bf16x8* qs = (LAS bf16x8*)wlds + lane;
#pragma unroll
    for (int ks = 0; ks < 8; ++ks) qs[64 * ks] = ld16(Qp + (size_t)r * ldq + 16 * ks + 8 * hh);
    f32x16 oacc[4];
#pragma unroll
    for (int dt = 0; dt < 4; ++dt)
#pragma unroll
        for (int i = 0; i < 16; ++i) oacc[dt][i] = 0.f;
    float carry = 0.f;
    bf16x8 kf[8];
    { const bf16* kr = Kp + (size_t)(t0 + r) * ldk + 8 * hh;
#pragma unroll
      for (int ks = 0; ks < 8; ++ks) kf[ks] = ld16(kr + 16 * ks); }
    for (int s0 = t0; s0 >= 0; s0 -= 32) {
        bf16x8 vf[8];
#pragma unroll
        for (int k2 = 0; k2 < 2; ++k2)
#pragma unroll
            for (int dt = 0; dt < 4; ++dt) { const bf16* vr = VTp + (size_t)(s0 >> 5) * 4096 + (32 * dt + r) * 32 + 16 * k2 + 4 * hh; vf[4 * k2 + dt] = ld2x8(vr, vr + 8); }
        f32x16 st;
#pragma unroll
        for (int i = 0; i < 16; ++i) st[i] = 0.f;
#pragma unroll
        for (int ks = 0; ks < 8; ++ks) st = MFMA32(kf[ks], qs[64 * ks], st);
        { const int sn = s0 >= 32 ? s0 - 32 : 0; const bf16* kr = Kp + (size_t)(sn + r) * ldk + 8 * hh;
#pragma unroll
          for (int ks = 0; ks < 8; ++ks) kf[ks] = ld16(kr + 16 * ks); }
        const bool diag = (s0 == t0);
        float l1[16], lb[16];
#pragma unroll
        for (int i = 0; i < 16; ++i) { const float z = st[i] * HD_SCALE, sp = softplus_fast(z); lb[i] = z - sp; l1[i] = -sp;
            if (diag && !(((i & 3) + 8 * (i >> 2) + 4 * hh) < r)) { l1[i] = 0.f; lb[i] = -1.0e30f; } }
        float g[4], pgv[4];
#pragma unroll
        for (int m = 0; m < 4; ++m) { g[m] = (l1[4 * m] + l1[4 * m + 1]) + (l1[4 * m + 2] + l1[4 * m + 3]); pgv[m] = shx(g[m], lane, 32); }
        float R[4]; R[3] = 0.f; R[2] = g[3] + pgv[3]; R[1] = R[2] + g[2] + pgv[2]; R[0] = R[1] + g[1] + pgv[1];
        const float total = R[0] + g[0] + pgv[0];
#pragma unroll
        for (int m = 0; m < 4; ++m) { const float suf = carry + R[m] + (hh == 0 ? pgv[m] : 0.f);
            const float t3 = suf, t2 = t3 + l1[4 * m + 3], t1 = t2 + l1[4 * m + 2], t0_ = t1 + l1[4 * m + 1];
            lb[4 * m + 3] = __expf(lb[4 * m + 3] + t3); lb[4 * m + 2] = __expf(lb[4 * m + 2] + t2); lb[4 * m + 1] = __expf(lb[4 * m + 1] + t1); lb[4 * m] = __expf(lb[4 * m] + t0_); }
        carry += total;
#pragma unroll
        for (int k2 = 0; k2 < 2; ++k2) {
            v4u p; p.x = cvt2(lb[8 * k2], lb[8 * k2 + 1]); p.y = cvt2(lb[8 * k2 + 2], lb[8 * k2 + 3]); p.z = cvt2(lb[8 * k2 + 4], lb[8 * k2 + 5]); p.w = cvt2(lb[8 * k2 + 6], lb[8 * k2 + 7]);
            const bf16x8 wf = __builtin_bit_cast(bf16x8, p);
#pragma unroll
            for (int dt = 0; dt < 4; ++dt) oacc[dt] = MFMA32(vf[4 * k2 + dt], wf, oacc[dt]);
        }
        if (__all((r >= nq) || (carry < -104.f))) break;
    }
    if (r < nq) {
#pragma unroll
        for (int dt = 0; dt < 4; ++dt)
#pragma unroll
            for (int g4 = 0; g4 < 4; ++g4) { u32x2 wv; wv.x = cvt2(oacc[dt][4 * g4], oacc[dt][4 * g4 + 1]); wv.y = cvt2(oacc[dt][4 * g4 + 2], oacc[dt][4 * g4 + 3]);
                *(u32x2*)(Op + (size_t)r * D + 32 * dt + 8 * g4 + 4 * hh) = wv; }
    }
    asm volatile("s_waitcnt lgkmcnt(0)" ::: "memory");
}

struct SkBf16 { bf16* O; int ldc;
    __device__ __forceinline__ int brow(int unit, int nb) const { return 32 * unit + 16 * nb; }
    __device__ __forceinline__ void store(int unit, const f32x4 a0, const f32x4 a1, int m, int fq) const { bf16* p = O + (size_t)(MP + m) * ldc + 32 * unit + 4 * fq;
        u32x2 w; w.x = cvt2(a0[0], a0[1]); w.y = cvt2(a0[2], a0[3]); *(u32x2*)p = w; w.x = cvt2(a1[0], a1[1]); w.y = cvt2(a1[2], a1[3]); *(u32x2*)(p + 16) = w; } };
struct SkRes { bf16* Yp; const bf16* Xp; float alpha;
    __device__ __forceinline__ int brow(int unit, int nb) const { return 32 * unit + 16 * nb; }
    __device__ __forceinline__ void one(size_t o, const f32x4 a) const { const u32x2 xv = *(const u32x2*)(Xp + o);
        f32x4 r; r[0] = alpha * pg8::bflo(xv.x); r[1] = alpha * pg8::bfhi(xv.x); r[2] = alpha * pg8::bflo(xv.y); r[3] = alpha * pg8::bfhi(xv.y); r = r + a; u32x2 w; w.x = cvt2(r[0], r[1]); w.y = cvt2(r[2], r[3]); *(u32x2*)(Yp + o) = w; }
    __device__ __forceinline__ void store(int unit, const f32x4 a0, const f32x4 a1, int m, int fq) const { const size_t o = (size_t)(MP + m) * D + 32 * unit + 4 * fq; one(o, a0); one(o + 16, a1); } };
struct SkKV { float *oks, *ovs; bf16 *ksb, *vsb;
    __device__ __forceinline__ int brow(int unit, int nb) const { return 32 * unit + 16 * nb; }
    __device__ __forceinline__ void one(int col, const f32x4 a, int m) const { const bool isv = col >= 1536; const int c = col - (isv ? 1536 : 0), b = m >> 4, t = m & 15;
        *(f32x4*)((isv ? ovs : oks) + (size_t)m * 1536 + c) = a; const unsigned w0 = cvt2(a[0], a[1]), w1 = cvt2(a[2], a[3]);
        const int hh_ = c >> 7, dd = c & 127;
        if (!isv) { u32x2 w; w.x = w0; w.y = w1; *(u32x2*)(ksb + ((size_t)(b * 12 + hh_) * 2080 + 2048 + t) * 128 + dd) = w; }
        else { bf16* vt = vsb + ((size_t)(b * 12 + hh_) * 65 + 64) * 4096 + dd * 32 + t; vt[0] = (bf16)w0; vt[32] = (bf16)(w0 >> 16); vt[64] = (bf16)w1; vt[96] = (bf16)(w1 >> 16); } }
    __device__ __forceinline__ void store(int unit, const f32x4 a0, const f32x4 a1, int m, int fq) const { one(32 * unit + 4 * fq, a0, m); one(32 * unit + 16 + 4 * fq, a1, m); } };
struct SkSwiGLU { bf16* Hb;
    __device__ __forceinline__ int brow(int unit, int nb) const { const int c0 = 16 * unit; return (c0 >> 7) * 256 + (c0 & 127) + 128 * nb; }
    __device__ __forceinline__ void store(int unit, const f32x4 g, const f32x4 u, int m, int fq) const { float hv[4];
#pragma unroll
        for (int j = 0; j < 4; ++j) hv[j] = g[j] * __builtin_amdgcn_rcpf(1.0f + __expf(-g[j])) * u[j];
        u32x2 w; w.x = cvt2(hv[0], hv[1]); w.y = cvt2(hv[2], hv[3]); *(u32x2*)(Hb + (size_t)(MP + m) * DFF + 16 * unit + 4 * fq) = w; } };
template <class Epi>
__device__ __forceinline__ void skinny_gemm(int bid, int G, int tid, int wave, LAS unsigned char* lds, const bf16* A, int lda, const bf16* Bt, int K, int nunits, const Epi& E) {
    const int lane = tid & 63, fr = lane & 15, fq = lane >> 4, kw = K >> 3, nst = kw >> 5;
    const bf16* ap = A + (size_t)fr * lda + wave * kw + 8 * fq;
    LAS f32x4* red = (LAS f32x4*)lds;
    for (int unit = bid; unit < nunits; unit += G) {
        const bf16* bp0 = Bt + (size_t)(E.brow(unit, 0) + fr) * K + wave * kw + 8 * fq; const bf16* bp1 = Bt + (size_t)(E.brow(unit, 1) + fr) * K + wave * kw + 8 * fq;
        f32x4 acc[2][8];
#pragma unroll
        for (int nb = 0; nb < 2; ++nb)
#pragma unroll
            for (int rt = 0; rt < 8; ++rt) acc[nb][rt] = (f32x4){0.f, 0.f, 0.f, 0.f};
        bf16x8 a0[8], a1[8], a2[8], b0[2], b1[2], b2[2];
#define SK_LOAD(af, bfr, st) do { _Pragma("unroll") for (int rt = 0; rt < 8; ++rt) af[rt] = ld16(ap + (size_t)(16 * rt) * lda + 32 * (st)); bfr[0] = ld16(bp0 + 32 * (st)); bfr[1] = ld16(bp1 + 32 * (st)); } while (0)
#define SK_MMA(af, bfr) do { _Pragma("unroll") for (int rt = 0; rt < 8; ++rt) { acc[0][rt] = MFMA16(bfr[0], af[rt], acc[0][rt]); acc[1][rt] = MFMA16(bfr[1], af[rt], acc[1][rt]); } } while (0)
        SK_LOAD(a0, b0, 0); SK_LOAD(a1, b1, 1);
#pragma unroll 1
        for (int st = 0; st < nst; st += 3) {
            if (st + 2 < nst) SK_LOAD(a2, b2, st + 2);
            __builtin_amdgcn_sched_barrier(0);
            SK_MMA(a0, b0);
            __builtin_amdgcn_sched_barrier(0);
            if (st + 3 < nst) SK_LOAD(a0, b0, st + 3);
            __builtin_amdgcn_sched_barrier(0);
            if (st + 1 < nst) SK_MMA(a1, b1);
            __builtin_amdgcn_sched_barrier(0);
            if (st + 4 < nst) SK_LOAD(a1, b1, st + 4);
            __builtin_amdgcn_sched_barrier(0);
            if (st + 2 < nst) SK_MMA(a2, b2);
            __builtin_amdgcn_sched_barrier(0);
        }
#undef SK_LOAD
#undef SK_MMA
#pragma unroll
        for (int nb = 0; nb < 2; ++nb)
#pragma unroll
            for (int rt = 0; rt < 8; ++rt) red[((wave * 2 + nb) * 8 + rt) * 64 + lane] = acc[nb][rt];
        __syncthreads();
        f32x4 s0 = {0.f, 0.f, 0.f, 0.f}, s1 = {0.f, 0.f, 0.f, 0.f};
#pragma unroll
        for (int ws = 0; ws < 8; ++ws) { s0 = s0 + red[((ws * 2 + 0) * 8 + wave) * 64 + lane]; s1 = s1 + red[((ws * 2 + 1) * 8 + wave) * 64 + lane]; }
        E.store(unit, s0, s1, 16 * wave + fr, fq);
        __syncthreads();
    }
}
#ifndef PH_MASK
#define PH_MASK 0xFFFF
#endif
__global__ void __launch_bounds__(NWAVES * 64, 2) mega(Args args) {
    extern __shared__ __attribute__((aligned(16))) unsigned char lds[];
    Frame F;
    F.lds = (LAS unsigned char*)lds; F.MISC = (volatile LAS unsigned*)(F.lds + MISC_OFF);
    F.tid = threadIdx.x; F.lane = F.tid & 63; F.wave = __builtin_amdgcn_readfirstlane(F.tid >> 6);
    F.G = gridDim.x; F.gw = blockIdx.x * NWAVES + F.wave; F.NGW = F.G * NWAVES;
    F.ctl = (gu32*)(args.ws_ + WS_CTL);
    for (int u = F.tid; u < (LDS_BYTES - LDSCTL_OFF) / 4; u += NWAVES * 64) ((LAS unsigned*)(F.lds + LDSCTL_OFF))[u] = 0u;
    __syncthreads();
    XcdBarrier bar = xcd_barrier_post((unsigned*)(F.ctl + CW_BAR), F.MISC + 8);
    const int lo = args.ph_lo, hi = args.ph_hi; int ph = 0;
#define KARGS ((const __attribute__((address_space(4))) Args*)__builtin_amdgcn_kernarg_segment_ptr())
#define ws (ka->ws_)
#define out (ka->out_)
#define x_prompt (ka->in[0])
#define x_sample (ka->in[1])
#define mem_prompt (ka->in[2])
#define state_gla (ka->in[3])
#define cache_sb_k (ka->in[4])
#define cache_sb_v (ka->in[5])
#define cache_mem_k (ka->in[6])
#define cache_mem_v (ka->in[7])
#define w_in_a (ka->in[8])
#define w_gate_lr (ka->in[9])
#define b_gate (ka->in[10])
#define gla_norm_g (ka->in[11])
#define w_in_b (ka->in[12])
#define w_kv_shared (ka->in[13])
#define w_mem_kv (ka->in[14])
#define w_o (ka->in[15])
#define ln1_g (ka->in[16])
#define ln1_b (ka->in[17])
#define ln2_g (ka->in[18])
#define ln2_b (ka->in[19])
#define w_ffn_in (ka->in[20])
#define w_ffn_out (ka->in[21])
#define WIN ((bf16*)(ws + WS_WIN))
#define WO ((bf16*)(ws + WS_WO))
#define WFI ((bf16*)(ws + WS_WFI))
#define WFO ((bf16*)(ws + WS_WFO))
#define WMEM ((bf16*)(ws + WS_WMEM))
#define MEMX ((bf16*)(ws + WS_MEMX))
#define MEMK ((bf16*)(ws + WS_MEMK))
#define MEMV ((bf16*)(ws + WS_MEMV))
#define X ((bf16*)(ws + WS_X))
#define Y ((float*)(ws + WS_Y))
#define YB ((bf16*)(ws + WS_Y))
#define PROJ ((bf16*)(ws + WS_R1))
#define HB ((bf16*)(ws + WS_R1))
#define OCAT ((bf16*)(ws + WS_OCAT))
#define SBKS ((bf16*)(ws + WS_SBKS))
#define SBVS ((bf16*)(ws + WS_SBVS))
#define OINT (out + O_YP)
#define KPB ((bf16*)(out + O_YP))
#define VPB (KPB + (size_t)MP * 1536)

#define PHASE_BEGIN(cond, cls) if (cond) { if (lo <= ph && ph < hi) { if (ph > lo) xcd_barrier(bar); DIAG_STAMP(cls); for (int rep_ = 0; rep_ < (((cls) == REP_CLS) ? 2 : 1); ++rep_) { const __attribute__((address_space(4))) Args* ka = KARGS; asm volatile("" : "+s"(ka)); int z_ = 0, G_ = gridDim.x, bid_ = blockIdx.x, wave_ = F.wave; asm volatile("" : "+s"(z_), "+s"(G_), "+s"(bid_), "+s"(wave_)); const int lane = (int)__builtin_amdgcn_mbcnt_hi(~0u, __builtin_amdgcn_mbcnt_lo(~0u, (unsigned)z_)), tid = wave_ * 64 + lane, gw_ = bid_ * NWAVES + wave_, NGW_ = G_ * NWAVES;     (void)tid; (void)lane; (void)gw_; (void)NGW_;
#define PHASE_END } } ++ph; }
#ifndef REP_CLS
#define REP_CLS (-1)
#endif
#ifndef SK_REP
#define SK_REP 1
#endif
#ifndef STAG
#define STAG 0
#endif
#ifndef SB_REP
#define SB_REP 1
#endif
#if defined(DIAG_A)
#define DIAG_STAMP(cls) do { if (blockIdx.x == 0 && threadIdx.x == 0) { unsigned long long* dts = (unsigned long long*)(args.ws_ + 262144); dts[ph] = rt(); } } while (0)
#else
#define DIAG_STAMP(cls) do { } while (0)
#endif

#define CONVERT_WEIGHTS(LL) do { const int ll_ = (LL); \
            if (ll_ < 2) wt_convert(F.lds, wave_, gw_, NGW_, lane, w_in_a + (size_t)ll_ * D * 5136, D, 5136, WIN, NA, MapInA()); \
            else { wt_convert(F.lds, wave_, gw_, NGW_, lane, w_in_b + (size_t)(ll_ - 2) * D * NBQ, D, NBQ, WIN, NBQ, MapId()); if (ll_ == 2) wt_convert(F.lds, wave_, gw_, NGW_, lane, w_kv_shared, D, NKV, WIN + (size_t)NBQ * D, NKV, MapId()); } \
            wt_convert(F.lds, wave_, gw_, NGW_, lane, w_o + (size_t)ll_ * D * D, D, D, WO, D, MapId()); \
            wt_convert(F.lds, wave_, gw_, NGW_, lane, w_ffn_in + (size_t)ll_ * D * 2 * DFF, D, 2 * DFF, WFI, 2 * DFF, MapFfn()); \
            wt_convert(F.lds, wave_, gw_, NGW_, lane, w_ffn_out + (size_t)ll_ * DFF * D, DFF, D, WFO, D, MapId()); } while (0)
    PHASE_BEGIN(true, 0)
        for (int r = gw_; r < MT; r += NGW_) cvt_row(r < MP ? x_prompt + (size_t)r * D : (r < MR ? x_sample + (size_t)(r - MP) * D : nullptr), X + (size_t)r * D, D, lane);
        for (int r = gw_; r < 1024; r += NGW_) cvt_row(mem_prompt + (size_t)r * D, MEMX + (size_t)r * D, D, lane);
        for (int r = gw_; r < 4 * 8 * 256; r += NGW_) { const int l = r >> 11, b = (r >> 8) & 7, m = r & 255; const size_t dst = (size_t)((l * 12 + 4 + b) * 256 + m) * 512;
            cvt_row(cache_mem_k + (size_t)r * 512, MEMK + dst, 512, lane); }
        for (int it = gw_; it < 512; it += NGW_) { const int hdb = it & 3, mb = (it >> 2) & 3, b = (it >> 4) & 7, l = it >> 7, m = mb * 64 + lane;
            const float* src = cache_mem_v + (size_t)((l * 8 + b) * 256 + m) * 512 + hdb * 128; bf16* dst = MEMV + (size_t)((l * 12 + 4 + b) * 512 + hdb * 128) * 256 + m;
            for (int q4 = 0; q4 < 32; ++q4) { const f32x4 v = *(const f32x4*)(src + 4 * q4);
#pragma unroll
                for (int e = 0; e < 4; ++e) dst[(size_t)(4 * q4 + e) * 256] = (bf16)f2bf(v[e]); } }
        for (int r = gw_; r < 8 * 2048; r += NGW_) { const int b = r >> 11, s = r & 2047; const float* src = cache_sb_k + (size_t)r * 1536;
            for (int j = lane * 4; j < 1536; j += 256) { const f32x4 v = *(const f32x4*)(src + j);
                *(unsigned long long*)(SBKS + ((size_t)(b * 12 + (j >> 7)) * 2080 + s) * 128 + (j & 127)) = (unsigned long long)pk2(v.x, v.y) | ((unsigned long long)pk2(v.z, v.w) << 32); } }
        for (int it = gw_; it < 3072; it += NGW_) { const int cb = it % 12, sb_ = (it / 12) & 31, b = it / 384, s = sb_ * 64 + lane;
            const float* src = cache_sb_v + (size_t)(b * 2048 + s) * 1536 + cb * 128; bf16* dst = SBVS + ((size_t)(b * 12 + cb) * 65 + (s >> 5)) * 4096 + (s & 31);
            for (int q4 = 0; q4 < 32; ++q4) { const f32x4 v = *(const f32x4*)(src + 4 * q4);
#pragma unroll
                for (int e = 0; e < 4; ++e) dst[(4 * q4 + e) * 32] = (bf16)f2bf(v[e]); } }
        for (int l = 0; l < 4; ++l) wt_convert(F.lds, wave_, gw_, NGW_, lane, w_mem_kv + (size_t)l * D * 1024, D, 1024, WMEM + (size_t)l * 1024 * D, 1024, MapId());
        CONVERT_WEIGHTS(0);
    PHASE_END
    PHASE_BEGIN(true, 0)
        pg8::Gemm g{MEMX, WMEM, 1024, 4096, D}; pg8::StaticOrder S; S.init(1024, 4096, G_, bid_);
        pg8::EpiMemKV E{out + O_MKP, out + O_MVP, MEMK, MEMV};
        pg8::gemm_phase<pg8::EpiMemKV, pg8::StaticOrder, true, true>(F.lds + RING_OFF, g, S, E, tid);
    PHASE_END

    for (int l = 0; l < 4; ++l) {
        const bool LA = l < 2;
        const int ldp = LA ? NA : NBQ;
        PHASE_BEGIN(true, 2)
            if (bid_ & 1) { { SkBf16 E{PROJ, ldp}; skinny_gemm(bid_, G_, tid, wave_, F.lds + RING_OFF, X + (size_t)MP * D, D, WIN, D, ldp / 32, E); }
                if (l == 2) { SkKV E{out + O_SKS, out + O_SVS, SBKS, SBVS}; skinny_gemm(bid_, G_, tid, wave_, F.lds + RING_OFF, X + (size_t)MP * D, D, WIN + (size_t)NBQ * D, D, NKV / 32, E); } }
            { pg8::Gemm g{X, WIN, MP, ldp, D}; pg8::StaticOrder S; S.init(MP, ldp, G_, bid_); pg8::EpiBf16 E{PROJ, ldp};
              pg8::gemm_phase<pg8::EpiBf16, pg8::StaticOrder, true, true>(F.lds + RING_OFF, g, S, E, tid); }
            if (l == 2) { pg8::Gemm g{X, WIN + (size_t)NBQ * D, MP, NKV, D}; pg8::StaticOrder S; S.init(MP, NKV, G_, bid_);
              pg8::EpiKV E{out + O_SKP, out + O_SVP, out + O_SKS, out + O_SVS, KPB, VPB, SBKS, SBVS};
              pg8::gemm_phase<pg8::EpiKV, pg8::StaticOrder, true, true>(F.lds + RING_OFF, g, S, E, tid); }
            if (!(bid_ & 1))
            for (int skr = 0; skr < SK_REP; ++skr) { SkBf16 E{PROJ, ldp}; skinny_gemm(bid_, G_, tid, wave_, F.lds + RING_OFF, X + (size_t)MP * D, D, WIN, D, ldp / 32, E); }
            if (!(bid_ & 1))
            for (int skr = 0; skr < SK_REP; ++skr) if (l == 2) { SkKV E{out + O_SKS, out + O_SVS, SBKS, SBVS}; skinny_gemm(bid_, G_, tid, wave_, F.lds + RING_OFF, X + (size_t)MP * D, D, WIN + (size_t)NBQ * D, D, NKV / 32, E); }
        PHASE_END
        PHASE_BEGIN(LA, 3)
            gla_prep(bid_, G_, tid, wave_, F.lds + RING_OFF, l, PROJ, w_gate_lr, b_gate, (unsigned char*)Y);
        PHASE_END
        PHASE_BEGIN(true, (LA ? 4 : 11))
            if (LA) {
                for (int item = bid_; item < N_PKG; item += G_) gla_intra(item, tid, wave_, F.lds + RING_OFF, (const unsigned char*)Y, OINT);
            } else {
                for (int sbr = 0; sbr < SB_REP; ++sbr)
                for (int u = gw_; u < 12288 + 96; u += NGW_) {
                    if (u < 12288) { const int bh = u >> 8, qb = u & 255, b = bh / 12, h = bh % 12, t0 = 32 * qb; const size_t qo = (size_t)(b * SEQ + t0) * D + h * 128;
                        sb_attn(lane, F.lds + RING_OFF + wave_ * 16384, KPB + (size_t)bh * SEQ * 128, 128, VPB + (size_t)bh * SEQ * 128, 0, PROJ + qo, NBQ, OCAT + qo, t0, 32); }
                    else { const int u2 = u - 12288, b = u2 / 12, h = u2 % 12; const size_t qo = (size_t)(MP + b * 16) * D + h * 128;
                        sb_attn(lane, F.lds + RING_OFF + wave_ * 16384, SBKS + (size_t)u2 * 2080 * 128, 128, SBVS + (size_t)u2 * 65 * 4096, 0, PROJ + qo, NBQ, OCAT + qo, 2048, 16); }
                }
            }
            __syncthreads();
            for (int wi = bid_; wi < 256 + 32; wi += G_) mem_attn_wg(wi, tid, wave_, F.lds + RING_OFF, l, PROJ, ldp, LA ? CQM : 1536, MEMK, MEMV, OCAT);
        PHASE_END
        PHASE_BEGIN(LA, 12)
            for (int wc = bid_; wc < 144; wc += G_) gla_chain<1>(wc, tid, wave_, F.lds + RING_OFF, l, (const unsigned char*)Y, state_gla, OINT, out, (float*)WMEM, (float*)MEMX);
        PHASE_END
        PHASE_BEGIN(LA, 5)
            for (int wc = bid_; wc < 192 + 96; wc += G_) gla_chain<2>(wc, tid, wave_, F.lds + RING_OFF, l, (const unsigned char*)Y, state_gla, OINT, out, (float*)WMEM, (float*)MEMX, REP_CLS == 5 && rep_ == 0);
        PHASE_END
        PHASE_BEGIN(LA, 6)
            const float* gn = gla_norm_g + (size_t)l * 384;
            for (int row = gw_; row < MR; row += NGW_) {
                const float* op = OINT + (size_t)row * 1536 + 24 * lane; const bf16* gp = PROJ + (size_t)row * NA + CG + 24 * lane; const float* gnp = gn + 24 * (lane & 15);
                f32x4 ov[6]; v4u gv[3]; float ss = 0.f;
#pragma unroll
                for (int j = 0; j < 6; ++j) { ov[j] = *(const f32x4*)(op + 4 * j); ss += (ov[j].x * ov[j].x + ov[j].y * ov[j].y) + (ov[j].z * ov[j].z + ov[j].w * ov[j].w); }
#pragma unroll
                for (int j = 0; j < 3; ++j) gv[j] = *(const v4u*)(gp + 8 * j);
                ss += shx(ss, lane, 1); ss += shx(ss, lane, 2); ss += shx(ss, lane, 4); ss += shx(ss, lane, 8);
                const float r = 1.0f / sqrtf(ss * (1.0f / 384.0f) + RMS_EPS);
#pragma unroll
                for (int j = 0; j < 3; ++j) { const f32x4 n0 = *(const f32x4*)(gnp + 8 * j), n1 = *(const f32x4*)(gnp + 8 * j + 4); const f32x4 a = ov[2 * j], b = ov[2 * j + 1];
                    float gt[8]; gt[0] = pg8::bflo(gv[j].x); gt[1] = pg8::bfhi(gv[j].x); gt[2] = pg8::bflo(gv[j].y); gt[3] = pg8::bfhi(gv[j].y); gt[4] = pg8::bflo(gv[j].z); gt[5] = pg8::bfhi(gv[j].z); gt[6] = pg8::bflo(gv[j].w); gt[7] = pg8::bfhi(gv[j].w);
                    float o8[8];
#pragma unroll
                    for (int i = 0; i < 4; ++i) { o8[i] = a[i] * r * n0[i] * (gt[i] * __builtin_amdgcn_rcpf(1.0f + __expf(-gt[i]))); o8[4 + i] = b[i] * r * n1[i] * (gt[4 + i] * __builtin_amdgcn_rcpf(1.0f + __expf(-gt[4 + i]))); }
                    v4u o; o.x = pk2(o8[0], o8[1]); o.y = pk2(o8[2], o8[3]); o.z = pk2(o8[4], o8[5]); o.w = pk2(o8[6], o8[7]);
                    *(v4u*)(OCAT + (size_t)row * D + 24 * lane + 8 * j) = o; }
            }
        PHASE_END
        PHASE_BEGIN(true, 7)
            if (bid_ & 1) { SkRes Es{YB, X, DN_ALPHA}; skinny_gemm(bid_, G_, tid, wave_, F.lds + RING_OFF, OCAT + (size_t)MP * D, D, WO, D, D / 32, Es); }
            pg8::Gemm g{OCAT, WO, MP, D, D}; pg8::StaticOrder S; S.init(MP, D, G_, bid_); pg8::EpiRes E{YB, X, D, DN_ALPHA};
            pg8::gemm_phase<pg8::EpiRes, pg8::StaticOrder, true, true>(F.lds + RING_OFF, g, S, E, tid);
            if (!(bid_ & 1))
            for (int skr = 0; skr < SK_REP; ++skr) { SkRes Es{YB, X, DN_ALPHA}; skinny_gemm(bid_, G_, tid, wave_, F.lds + RING_OFF, OCAT + (size_t)MP * D, D, WO, D, D / 32, Es); }
        PHASE_END
        PHASE_BEGIN(true, 8)
            const float* gg = ln1_g + (size_t)l * D; const float* bb = ln1_b + (size_t)l * D;
            for (int row = 2 * gw_; row < MR; row += 2 * NGW_) ln_two_rows<false>(lane, YB + (size_t)row * D, YB + (size_t)(row + 1) * D, gg, bb, X + (size_t)row * D, X + (size_t)(row + 1) * D, nullptr, nullptr);
        PHASE_END
        PHASE_BEGIN(true, 9)
            for (int dl = 0; dl < 3 * STAG * (bid_ >> 1 & 3); ++dl) __builtin_amdgcn_s_sleep(127);
            if (bid_ & 1) { SkSwiGLU Es{HB}; skinny_gemm(bid_, G_, tid, wave_, F.lds + RING_OFF, X + (size_t)MP * D, D, WFI, D, DFF / 16, Es); }
            pg8::Gemm g{X, WFI, MP, 2 * DFF, D}; pg8::StaticOrder S; S.init(MP, 2 * DFF, G_, bid_); pg8::EpiSwiGLU E{HB, DFF};
            pg8::gemm_phase<pg8::EpiSwiGLU, pg8::StaticOrder, true, true>(F.lds + RING_OFF, g, S, E, tid);
            if (!(bid_ & 1))
            for (int skr = 0; skr < SK_REP; ++skr) { SkSwiGLU Es{HB}; skinny_gemm(bid_, G_, tid, wave_, F.lds + RING_OFF, X + (size_t)MP * D, D, WFI, D, DFF / 16, Es); }
        PHASE_END
        PHASE_BEGIN(true, 10)
            if (bid_ & 1) { SkRes Es{YB, X, DN_ALPHA}; skinny_gemm(bid_, G_, tid, wave_, F.lds + RING_OFF, HB + (size_t)MP * DFF, DFF, WFO, DFF, D / 32, Es); }
            pg8::Gemm g{HB, WFO, MP, D, DFF}; pg8::StaticOrder S; S.init(MP, D, G_, bid_); pg8::EpiRes E{YB, X, D, DN_ALPHA};
            pg8::gemm_phase<pg8::EpiRes, pg8::StaticOrder, true, true>(F.lds + RING_OFF, g, S, E, tid);
            if (!(bid_ & 1))
            for (int skr = 0; skr < SK_REP; ++skr) { SkRes Es{YB, X, DN_ALPHA}; skinny_gemm(bid_, G_, tid, wave_, F.lds + RING_OFF, HB + (size_t)MP * DFF, DFF, WFO, DFF, D / 32, Es); }
        PHASE_END
        PHASE_BEGIN(true, 8)
            if (l < 3) CONVERT_WEIGHTS(l + 1);
            const float* gg = ln2_g + (size_t)l * D; const float* bb = ln2_b + (size_t)l * D;
            if (l == 3) { for (int row = 2 * gw_; row < MR; row += 2 * NGW_) { float* of = row < MP ? out + O_YP + (size_t)row * D : out + O_YS + (size_t)(row - MP) * D;
                ln_two_rows<true>(lane, YB + (size_t)row * D, YB + (size_t)(row + 1) * D, gg, bb, nullptr, nullptr, of, of + D); } }
            else for (int row = 2 * gw_; row < MR; row += 2 * NGW_) ln_two_rows<false>(lane, YB + (size_t)row * D, YB + (size_t)(row + 1) * D, gg, bb, X + (size_t)row * D, X + (size_t)(row + 1) * D, nullptr, nullptr);
        PHASE_END
    }
#if defined(DIAG_A)
    if (blockIdx.x == 0 && threadIdx.x == 0) { unsigned long long* dts = (unsigned long long*)(args.ws_ + 262144); dts[ph] = rt(); dts[63] = (unsigned long long)ph; }
#endif
#undef ws
#undef out
#undef X
#undef Y
#undef YB
#undef CONVERT_WEIGHTS
#undef PHASE_BEGIN
#undef PHASE_END
}

#if defined(DIAG_A)
__device__ const int diag_cls[40] = {0,0, 1,2,3,4,5,6,7,8,9,10,8, 1,2,3,4,5,6,7,8,9,10,8, 1,2,11,7,8,9,10,8, 1,2,11,7,8,9,10,8};
__global__ void diag_tail(float* o, const unsigned long long* dts) {
    __shared__ float dv[2];
    if (threadIdx.x == 0) { const int n = (int)dts[63]; unsigned long long sa = 0, sb = 0; for (int p = 0; p < n; ++p) { const unsigned long long d = dts[p + 1] - dts[p]; const int cl = diag_cls[p]; if (cl == DIAG_A) sa += d; if (cl == DIAG_B) sb += d; }
        dv[0] = (float)sa * 0.01f; dv[1] = (float)sb * 10.0f; }
    __syncthreads();
    for (int i = threadIdx.x; i < 262144; i += blockDim.x) o[O_YS + i] = dv[0];
    if (threadIdx.x == 0) o[O_YP] = dv[1];
}
#endif
#ifndef MK_PER_PHASE
#define MK_PER_PHASE 0
#endif
constexpr int N_PHASES = 2 + 2 * 11 + 2 * 7;
extern "C" void kernel_launch(void* const* d_in, const int* in_sizes, int n_in, void* d_out, int out_size, void* d_ws, size_t ws_size, hipStream_t stream) {
    static int grid = 0;
    if (grid == 0) {
        if (n_in != 22 || in_sizes[0] != MP * D || (size_t)out_size != O_END || ws_size < WS_END) { fprintf(stderr, "kernel_launch: unexpected shapes (n_in %d, in0 %d, out %d, ws %zu); nothing launched\n", n_in, n_in > 0 ? in_sizes[0] : -1, out_size, ws_size); grid = -1; return; }
        int dev = 0, cus = 0, per_cu = 0;
        if (hipGetDevice(&dev) != hipSuccess || hipDeviceGetAttribute(&cus, hipDeviceAttributeMultiprocessorCount, dev) != hipSuccess) { grid = -1; return; }
        if (hipFuncSetAttribute((const void*)mega, hipFuncAttributeMaxDynamicSharedMemorySize, LDS_BYTES) != hipSuccess) { fprintf(stderr, "kernel_launch: hipFuncSetAttribute failed\n"); grid = -1; return; }
        if (hipOccupancyMaxActiveBlocksPerMultiprocessor(&per_cu, (const void*)mega, NWAVES * 64, LDS_BYTES) != hipSuccess || per_cu < 1) fprintf(stderr, "kernel_launch: occupancy query reports %d\n", per_cu);
        (void)hipGetLastError();
        grid = cus;
    }
    if (grid < 0) return;
    if (hipMemsetAsync((char*)d_ws + WS_CTL, 0, CTL_ZERO_BYTES, stream) != hipSuccess) return;
    Args a{};
    for (int i = 0; i < 22; ++i) a.in[i] = (const float*)d_in[i];
    a.out_ = (float*)d_out; a.ws_ = (unsigned char*)d_ws;
#if MK_PER_PHASE
    for (int p = 0; p < N_PHASES; ++p) { a.ph_lo = p; a.ph_hi = p + 1; hipLaunchKernelGGL(mega, dim3(grid), dim3(NWAVES * 64), LDS_BYTES, stream, a); }
#else
    a.ph_lo = 0; a.ph_hi = N_PHASES; hipLaunchKernelGGL(mega, dim3(grid), dim3(NWAVES * 64), LDS_BYTES, stream, a);
#if defined(DIAG_A)
    hipLaunchKernelGGL(diag_tail, dim3(1), dim3(512), 0, stream, (float*)d_out, (const unsigned long long*)((unsigned char*)d_ws + 262144));
#endif
#endif
}
```

```cpp
#include <hip/hip_runtime.h>
#include <cstdio>
#include <cstdint>
namespace pg8 {
#define PG8_LAS __attribute__((address_space(3)))
typedef unsigned short bf16_t;
typedef short bf16x8 __attribute__((ext_vector_type(8)));
typedef float f32x4 __attribute__((ext_vector_type(4)));
typedef unsigned u32x4 __attribute__((ext_vector_type(4)));
constexpr int BM = 256, BK = 64, HALF = 128, HTB = HALF * BK * 2  , STAGE_BYTES = 8 * HTB, NXCD = 8, WGM = 8;

__host__ __device__ __forceinline__ int lds_byte(int r, int c) { const int st = (r >> 4) * 2 + (c >> 5), rr = r & 15, cc = c & 31, ob = rr * 64 + cc * 2; return st * 1024 + (ob ^ (((ob >> 9) & 1) << 5)); }
__host__ __device__ __forceinline__ void stage_rc(int b, int& R, int& C) { const int st = b / 1024, sb = b % 1024, swz = sb ^ (((sb >> 9) & 1) << 5); R = (st >> 1) * 16 + swz / 64; C = (st & 1) * 32 + (swz % 64) / 2; }
__host__ __device__ __forceinline__ int perm32(int rho) { const int n = rho >> 4, i = rho & 15; return 8 * (i >> 2) + 4 * n + (i & 3); }

struct Unit { int pm, pn; };
struct Gemm { const bf16_t* A; const bf16_t* Bt; int M, N, K; };

struct StaticOrder {
    int nM, nN, nwg, G, c;
    __host__ __device__ void init(int M, int N, int G_, int c_) { nM = M / BM; nN = N / BM; nwg = nM * nN; G = G_; c = c_; }
    __host__ __device__ bool next(int i, Unit& u) const {
        const long L = (long)i * G + c; if (L >= nwg) return false;
        int wgid = (int)L; { const int q = nwg / NXCD, r = nwg % NXCD, xcd = wgid % NXCD, off = wgid / NXCD; wgid = (xcd < r ? xcd * (q + 1) : r * (q + 1) + (xcd - r) * q) + off; }
        const int nig = WGM * nN, gid = wgid / nig, fm = gid * WGM, gsz = (nM - fm) < WGM ? (nM - fm) : WGM;
        u.pm = fm + ((wgid % nig) % gsz); u.pn = (wgid % nig) / gsz; return true;
    }
    __device__ __forceinline__ void a_ready(const Unit&) const {}
    __device__ __forceinline__ void done(const Unit&) const {}
};
__device__ __forceinline__ unsigned cvt_pk_bf16(float lo, float hi) { unsigned r; asm volatile("v_cvt_pk_bf16_f32 %0, %1, %2" : "=v"(r) : "v"(lo), "v"(hi)); return r; }
typedef float f32x2 __attribute__((ext_vector_type(2)));
typedef unsigned u32x2 __attribute__((ext_vector_type(2)));
__device__ __forceinline__ float bflo(unsigned w) { return __builtin_bit_cast(float, w << 16); }
__device__ __forceinline__ float bfhi(unsigned w) { return __builtin_bit_cast(float, w & 0xffff0000u); }
struct EpiBf16 {
    static constexpr bool PERM = true, AFTER_DRAIN = false;
    bf16_t* O; int ldc;
    __device__ __forceinline__ void operator()(const f32x4 (&acc)[2][2][4][2], const Unit& u, int wr, int wc, int fr, int fq) const {
        const int row0 = u.pm * BM + wr * 64 + fr, col0 = u.pn * BM + wc * 32 + 8 * fq;
#pragma unroll
        for (int ai = 0; ai < 2; ++ai)
#pragma unroll
            for (int m = 0; m < 4; ++m) { bf16_t* rowp = O + (size_t)(row0 + ai * HALF + m * 16) * ldc + col0;
#pragma unroll
                for (int bj = 0; bj < 2; ++bj) { const f32x4 v0 = acc[ai][bj][m][0], v1 = acc[ai][bj][m][1];
                    u32x4 w; w.x = cvt_pk_bf16(v0[0], v0[1]); w.y = cvt_pk_bf16(v0[2], v0[3]); w.z = cvt_pk_bf16(v1[0], v1[1]); w.w = cvt_pk_bf16(v1[2], v1[3]);
                    *(u32x4*)(rowp + bj * HALF) = w; } }
    }
};
struct EpiSwiGLU {
    static constexpr bool PERM = true, AFTER_DRAIN = false;
    bf16_t* Hh; int ldh;
    __device__ __forceinline__ float swi(float g, float up) const { return g * __builtin_amdgcn_rcpf(1.0f + __expf(-g)) * up; }
    __device__ __forceinline__ void operator()(const f32x4 (&acc)[2][2][4][2], const Unit& u, int wr, int wc, int fr, int fq) const {
        const int row0 = u.pm * BM + wr * 64 + fr, col0 = u.pn * HALF + wc * 32 + 8 * fq;
#pragma unroll
        for (int ai = 0; ai < 2; ++ai)
#pragma unroll
            for (int m = 0; m < 4; ++m) { bf16_t* rowp = Hh + (size_t)(row0 + ai * HALF + m * 16) * ldh + col0;
                const f32x4 g0 = acc[ai][0][m][0], g1 = acc[ai][0][m][1], u0 = acc[ai][1][m][0], u1 = acc[ai][1][m][1];
                u32x4 w; w.x = cvt_pk_bf16(swi(g0[0], u0[0]), swi(g0[1], u0[1])); w.y = cvt_pk_bf16(swi(g0[2], u0[2]), swi(g0[3], u0[3]));
                w.z = cvt_pk_bf16(swi(g1[0], u1[0]), swi(g1[1], u1[1])); w.w = cvt_pk_bf16(swi(g1[2], u1[2]), swi(g1[3], u1[3]));
                *(u32x4*)rowp = w; }
    }
};
struct EpiRes {
    static constexpr bool PERM = true, AFTER_DRAIN = false;
    bf16_t* Y; const bf16_t* X; int ldc; float alpha;
    __device__ __forceinline__ void operator()(const f32x4 (&acc)[2][2][4][2], const Unit& u, int wr, int wc, int fr, int fq) const {
        const int row0 = u.pm * BM + wr * 64 + fr, col0 = u.pn * BM + wc * 32 + 8 * fq;
        u32x4 xv[2][4][2];
#pragma unroll
        for (int ai = 0; ai < 2; ++ai)
#pragma unroll
            for (int m = 0; m < 4; ++m)
#pragma unroll
                for (int bj = 0; bj < 2; ++bj) xv[ai][m][bj] = *(const u32x4*)(X + (size_t)(row0 + ai * HALF + m * 16) * ldc + col0 + bj * HALF);
#pragma unroll
        for (int ai = 0; ai < 2; ++ai)
#pragma unroll
            for (int m = 0; m < 4; ++m) { const size_t ro = (size_t)(row0 + ai * HALF + m * 16) * ldc + col0;
#pragma unroll
                for (int bj = 0; bj < 2; ++bj) { const u32x4 x4 = xv[ai][m][bj]; const f32x4 a0 = acc[ai][bj][m][0], a1 = acc[ai][bj][m][1];
                    u32x4 w; w.x = cvt_pk_bf16(alpha * bflo(x4.x) + a0[0], alpha * bfhi(x4.x) + a0[1]); w.y = cvt_pk_bf16(alpha * bflo(x4.y) + a0[2], alpha * bfhi(x4.y) + a0[3]);
                    w.z = cvt_pk_bf16(alpha * bflo(x4.z) + a1[0], alpha * bfhi(x4.z) + a1[1]); w.w = cvt_pk_bf16(alpha * bflo(x4.w) + a1[2], alpha * bfhi(x4.w) + a1[3]);
                    *(u32x4*)(Y + ro + bj * HALF) = w; } }
    }
};
struct EpiKV {
    static constexpr bool PERM = false, AFTER_DRAIN = false;
    float *okp, *ovp, *oks, *ovs; bf16_t *kpb, *vpb, *ksb, *vsb;
    __device__ __forceinline__ void operator()(const f32x4 (&acc)[2][2][4][2], const Unit& u, int wr, int wc, int fr, int fq) const {
        const bool isv = u.pn >= 6; const int colt = (u.pn - (isv ? 6 : 0)) * BM + wc * 32 + 4 * fq, row0 = u.pm * BM + wr * 64 + fr;
        float* op = isv ? ovp : okp;
#pragma unroll
        for (int ai = 0; ai < 2; ++ai)
#pragma unroll
            for (int m = 0; m < 4; ++m) { const int row = row0 + ai * HALF + m * 16; float* fd;
                if (row < 32768) { fd = op + (size_t)row * 1536; } else continue;
                const int bq = row >> 13, sq = row & 8191;
#pragma unroll
                for (int bj = 0; bj < 2; ++bj)
#pragma unroll
                    for (int n = 0; n < 2; ++n) { const int c = colt + bj * HALF + n * 16; const f32x4 v = acc[ai][bj][m][n];
                        *(f32x4*)(fd + c) = v; const unsigned w0 = cvt_pk_bf16(v[0], v[1]), w1 = cvt_pk_bf16(v[2], v[3]);
                        const int hq = c >> 7, dq = c & 127;
                        if (!isv) { u32x2 w; w.x = w0; w.y = w1; *(u32x2*)(kpb + ((size_t)(bq * 12 + hq) * 8192 + sq) * 128 + dq) = w; }
                        else { bf16_t* vt = vpb + ((size_t)(bq * 12 + hq) * 256 + (sq >> 5)) * 4096 + dq * 32 + (sq & 31); vt[0] = (bf16_t)w0; vt[32] = (bf16_t)(w0 >> 16); vt[64] = (bf16_t)w1; vt[96] = (bf16_t)(w1 >> 16); } } }
    }
};
struct EpiMemKV {
    static constexpr bool PERM = false, AFTER_DRAIN = false;
    float *ok, *ov; bf16_t *kb, *vb;
    __device__ __forceinline__ void operator()(const f32x4 (&acc)[2][2][4][2], const Unit& u, int wr, int wc, int fr, int fq) const {
        const int l = u.pn >> 2, kv = (u.pn >> 1) & 1, hd0 = (u.pn & 1) * BM + wc * 32 + 4 * fq, row0 = u.pm * BM + wr * 64 + fr;
        float* fo = kv ? ov : ok; bf16_t* bo = kv ? vb : kb;
#pragma unroll
        for (int ai = 0; ai < 2; ++ai)
#pragma unroll
            for (int m = 0; m < 4; ++m) { const int row = row0 + ai * HALF + m * 16, b = row >> 8, mm = row & 255;
                float* fd = fo + (size_t)(l * 1024 + row) * 512; bf16_t* bd = bo + (size_t)((l * 12 + b) * 256 + mm) * 512;
#pragma unroll
                for (int bj = 0; bj < 2; ++bj)
#pragma unroll
                    for (int n = 0; n < 2; ++n) { const int c = hd0 + bj * HALF + n * 16; const f32x4 v = acc[ai][bj][m][n];
                        *(f32x4*)(fd + c) = v; const unsigned w0 = cvt_pk_bf16(v[0], v[1]), w1 = cvt_pk_bf16(v[2], v[3]);
                        if (!kv) { u32x2 w; w.x = w0; w.y = w1; *(u32x2*)(bd + c) = w; }
                        else { bf16_t* vt = vb + (size_t)((l * 12 + b) * 512 + c) * 256 + mm;
                            vt[0] = (bf16_t)w0; vt[256] = (bf16_t)(w0 >> 16); vt[512] = (bf16_t)w1; vt[768] = (bf16_t)(w1 >> 16); } } }
    }
};
template <class Epi, class Sched, bool ALIGN_EPI = false, bool SP2 = false>
__device__ __forceinline__ void gemm_phase(PG8_LAS unsigned char* lds, const Gemm g, const Sched& S, const Epi& E, int tid_in) {
    int tid_ = tid_in; asm volatile("" : "+v"(tid_));
    const int tid = tid_, wid = __builtin_amdgcn_readfirstlane(tid >> 6), lane = tid & 63, wr = wid >> 2, wc = wid & 3, fr = lane & 15, fq = lane >> 4;
    const int K = g.K, nt = K / BK;
    unsigned voffA[2], voffB[2];
#pragma unroll
    for (int i = 0; i < 2; ++i) { int R, C; stage_rc(tid * 16 + i * 8192, R, C); const int Rb = Epi::PERM ? ((R & ~31) + perm32(R & 31)) : R;
        voffA[i] = (unsigned)(R * K + C) * 2u; voffB[i] = (unsigned)(Rb * K + C) * 2u; }
    const size_t kstep = (size_t)(BK * 2);
    const size_t hstep = (size_t)HALF * K * 2;
    const size_t tstep = 2 * hstep;
    const unsigned ldsw = (unsigned)wid * 1024u;
    const int aoff = lds_byte(wr * 64 + fr, fq * 8), boff = lds_byte(wc * 32 + fr, fq * 8);
#define PG8_SA(b, h) (((b) * 2 + (h)) * HTB)
#define PG8_SB(b, h) ((4 + (b) * 2 + (h)) * HTB)
#define PG8_STAGE(bufoff, gbase, voff) do { _Pragma("unroll") for (int _i = 0; _i < 2; ++_i) \
        __builtin_amdgcn_global_load_lds((const unsigned*)((const char*)(gbase) + (voff)[_i]), (PG8_LAS unsigned*)(lds + (bufoff) + ldsw + _i * 8192), 16, 0, 0); } while (0)
#define PG8_LDA(dst, b, h) do { _Pragma("unroll") for (int m = 0; m < 4; ++m) _Pragma("unroll") for (int k = 0; k < 2; ++k) dst[m][k] = *(const PG8_LAS bf16x8*)(lds + PG8_SA(b, h) + aoff + m * 2048 + k * 1024); } while (0)
#define PG8_LDB(dst, b, h) do { _Pragma("unroll") for (int n = 0; n < 2; ++n) _Pragma("unroll") for (int k = 0; k < 2; ++k) dst[n][k] = *(const PG8_LAS bf16x8*)(lds + PG8_SB(b, h) + boff + n * 2048 + k * 1024); } while (0)
#define PG8_MMA(ai, bj, At, Bt) do { __builtin_amdgcn_s_setprio(1); _Pragma("unroll") for (int m = 0; m < 4; ++m) _Pragma("unroll") for (int n = 0; n < 2; ++n) _Pragma("unroll") for (int k = 0; k < 2; ++k) \
        acc[ai][bj][m][n] = __builtin_amdgcn_mfma_f32_16x16x32_bf16(Bt[n][k], At[m][k], acc[ai][bj][m][n], 0, 0, 0); __builtin_amdgcn_s_setprio(0); } while (0)
#define PG8_WAIT_V(n) asm volatile("s_waitcnt vmcnt(" #n ")" ::: "memory")
#define PG8_WAIT_L(n) asm volatile("s_waitcnt lgkmcnt(" #n ")" ::: "memory")
#define PG8_BAR __builtin_amdgcn_s_barrier()
#define PG8_SCHED __builtin_amdgcn_sched_barrier(0)
    Unit cur, nxt; int ui = 0;
    if (!S.next(0, cur)) return;
    f32x4 acc[2][2][4][2];
#pragma unroll
    for (int a = 0; a < 2; ++a)
#pragma unroll
        for (int b = 0; b < 2; ++b)
#pragma unroll
            for (int m = 0; m < 4; ++m)
#pragma unroll
                for (int n = 0; n < 2; ++n) acc[a][b][m][n] = (f32x4){0.f, 0.f, 0.f, 0.f};
    bf16x8 At[4][2], B0[2][2], B1[2][2];
    const char* cA = (const char*)g.A + (size_t)cur.pm * tstep; const char* cB = (const char*)g.Bt + (size_t)cur.pn * tstep;
    S.a_ready(cur);
    if constexpr (SP2) {
        PG8_STAGE(PG8_SB(0, 0), cB, voffB); PG8_STAGE(PG8_SB(0, 1), cB + hstep, voffB); PG8_STAGE(PG8_SA(0, 0), cA, voffA); PG8_STAGE(PG8_SA(0, 1), cA + hstep, voffA);
        if (wr == 1) PG8_BAR;
        PG8_WAIT_V(2); PG8_BAR;
        PG8_STAGE(PG8_SB(1, 0), cB + kstep, voffB); PG8_STAGE(PG8_SA(1, 0), cA + kstep, voffA); PG8_STAGE(PG8_SB(1, 1), cB + hstep + kstep, voffB);
        PG8_WAIT_V(6); PG8_BAR;
    } else {
        PG8_STAGE(PG8_SB(0, 0), cB, voffB); PG8_STAGE(PG8_SA(0, 0), cA, voffA); PG8_STAGE(PG8_SB(0, 1), cB + hstep, voffB); PG8_STAGE(PG8_SA(0, 1), cA + hstep, voffA);
        if (wr == 1) PG8_BAR;
        PG8_WAIT_V(4); PG8_BAR;
        PG8_STAGE(PG8_SB(1, 0), cB + kstep, voffB); PG8_STAGE(PG8_SA(1, 0), cA + kstep, voffA); PG8_STAGE(PG8_SB(1, 1), cB + hstep + kstep, voffB);
        PG8_WAIT_V(6); PG8_BAR;
    }
    for (;;) {
        const bool has_next = S.next(ui + 1, nxt);
        const char* nA = has_next ? (const char*)g.A + (size_t)nxt.pm * tstep : cA; const char* nB = has_next ? (const char*)g.Bt + (size_t)nxt.pn * tstep : cB;
        for (int t = 0; t < nt; t += 2) {
            const bool last = (t == nt - 2);
            const char* a1 = cA + (size_t)(t + 1) * kstep;
            const char* a2 = last ? nA : cA + (size_t)(t + 2) * kstep; const char* b2 = last ? nB : cB + (size_t)(t + 2) * kstep;
            const char* a3 = a2 + kstep; const char* b3 = b2 + kstep;
            if (last && has_next) S.a_ready(nxt);
            if constexpr (SP2) {
            PG8_LDB(B0, 0, 0); PG8_LDB(B1, 0, 1); PG8_SCHED; PG8_LDA(At, 0, 0); PG8_STAGE(PG8_SA(1, 1), a1 + hstep, voffA);
            PG8_WAIT_V(8); PG8_WAIT_L(0); PG8_BAR; PG8_MMA(0, 0, At, B0); PG8_MMA(0, 1, At, B1); PG8_BAR; PG8_SCHED;
            PG8_LDA(At, 0, 1); PG8_STAGE(PG8_SB(0, 0), b2, voffB); PG8_STAGE(PG8_SB(0, 1), b2 + hstep, voffB); PG8_STAGE(PG8_SA(0, 0), a2, voffA);
            PG8_WAIT_V(8); PG8_WAIT_L(0); PG8_BAR; PG8_MMA(1, 0, At, B0); PG8_MMA(1, 1, At, B1); PG8_BAR; PG8_SCHED;
            PG8_LDB(B0, 1, 0); PG8_LDB(B1, 1, 1); PG8_SCHED; PG8_LDA(At, 1, 0); PG8_STAGE(PG8_SA(0, 1), a2 + hstep, voffA);
            PG8_WAIT_V(8); PG8_WAIT_L(0); PG8_BAR; PG8_MMA(0, 0, At, B0); PG8_MMA(0, 1, At, B1); PG8_BAR; PG8_SCHED;
            PG8_LDA(At, 1, 1); PG8_STAGE(PG8_SB(1, 0), b3, voffB); PG8_STAGE(PG8_SB(1, 1), b3 + hstep, voffB); PG8_STAGE(PG8_SA(1, 0), a3, voffA);
            PG8_WAIT_V(8); PG8_WAIT_L(0); PG8_BAR; PG8_MMA(1, 0, At, B0); PG8_MMA(1, 1, At, B1); PG8_BAR; PG8_SCHED;
            } else {
            PG8_LDB(B0, 0, 0); PG8_SCHED; PG8_LDA(At, 0, 0); PG8_STAGE(PG8_SA(1, 1), a1 + hstep, voffA);
            PG8_WAIT_L(8); PG8_BAR; PG8_WAIT_L(0); PG8_MMA(0, 0, At, B0); PG8_BAR; PG8_SCHED;
            PG8_LDB(B1, 0, 1); PG8_STAGE(PG8_SB(0, 0), b2, voffB);
            PG8_BAR; PG8_WAIT_L(0); PG8_MMA(0, 1, At, B1); PG8_BAR;
            PG8_LDA(At, 0, 1); PG8_STAGE(PG8_SA(0, 0), a2, voffA);
            PG8_BAR; PG8_WAIT_L(0); PG8_MMA(1, 0, At, B0); PG8_BAR; PG8_SCHED;
            PG8_STAGE(PG8_SB(0, 1), b2 + hstep, voffB);
            PG8_WAIT_V(6); PG8_BAR; PG8_MMA(1, 1, At, B1); PG8_BAR;
            PG8_LDB(B0, 1, 0); PG8_SCHED; PG8_LDA(At, 1, 0); PG8_STAGE(PG8_SA(0, 1), a2 + hstep, voffA);
            PG8_WAIT_L(8); PG8_BAR; PG8_WAIT_L(0); PG8_MMA(0, 0, At, B0); PG8_BAR; PG8_SCHED;
            PG8_LDB(B1, 1, 1); PG8_STAGE(PG8_SB(1, 0), b3, voffB);
            PG8_BAR; PG8_WAIT_L(0); PG8_MMA(0, 1, At, B1); PG8_BAR;
            PG8_LDA(At, 1, 1); PG8_STAGE(PG8_SA(1, 0), a3, voffA);
            PG8_BAR; PG8_WAIT_L(0); PG8_MMA(1, 0, At, B0); PG8_BAR; PG8_SCHED;
            PG8_STAGE(PG8_SB(1, 1), b3 + hstep, voffB);
            PG8_WAIT_V(6); PG8_BAR; PG8_MMA(1, 1, At, B1); PG8_BAR;
            }
        }
        if constexpr (ALIGN_EPI) { if (wr == 0) PG8_BAR; }
        if constexpr (!Epi::AFTER_DRAIN) { E(acc, cur, wr, wc, fr, fq); S.done(cur); }
        if (!has_next) break;
#pragma unroll
        for (int a = 0; a < 2; ++a)
#pragma unroll
            for (int b = 0; b < 2; ++b)
#pragma unroll
                for (int m = 0; m < 4; ++m)
#pragma unroll
                    for (int n = 0; n < 2; ++n) acc[a][b][m][n] = (f32x4){0.f, 0.f, 0.f, 0.f};
        cur = nxt; cA = nA; cB = nB; ++ui;
        if constexpr (ALIGN_EPI) { if (wr == 1) PG8_BAR; }
    }
    PG8_WAIT_V(0);
    if constexpr (!ALIGN_EPI) { if (wr == 0) PG8_BAR; }
    PG8_BAR;
    if constexpr (Epi::AFTER_DRAIN) { E.fused(acc, cur, wr, wc, fr, fq, lds, wid, lane); S.done(cur); }
#undef PG8_SA
#undef PG8_SB
#undef PG8_STAGE
#undef PG8_LDA
#undef PG8_LDB
#undef PG8_MMA
#undef PG8_WAIT_V
#undef PG8_WAIT_L
#undef PG8_BAR
#undef PG8_SCHED
}
}
#define GAS __attribute__((address_space(1)))
#define LAS __attribute__((address_space(3)))
typedef unsigned short bf16;
typedef unsigned v4u __attribute__((ext_vector_type(4)));
typedef float f32x4 __attribute__((ext_vector_type(4)));
typedef short bf16x8 __attribute__((ext_vector_type(8)));
typedef GAS unsigned gu32;
typedef GAS unsigned long long gu64;
#define RLX_AGENT __ATOMIC_RELAXED, __HIP_MEMORY_SCOPE_AGENT
#define LDS_WAIT() asm volatile("s_waitcnt lgkmcnt(0)" ::: "memory")
#define VM_WAIT() asm volatile("s_waitcnt vmcnt(0)" ::: "memory")
__device__ __forceinline__ unsigned long long rt() { return __builtin_amdgcn_s_memrealtime(); }
__device__ __forceinline__ unsigned f2bf(float f) { unsigned u = __builtin_bit_cast(unsigned, f); return (u + 0x7fffu + ((u >> 16) & 1u)) >> 16; }
__device__ __forceinline__ unsigned pk2(float lo, float hi) { return f2bf(lo) | (f2bf(hi) << 16); }
#define XB_TMO      128
#define XB_XCNT(j)  (256  + 64 * (j))
#define XB_XSUB(j)  (1280 + 64 * (j))
#define XB_XGEN(j)  (2304 + 64 * (j))
#define XB_TOP      3328
#define XB_TOPGEN   3392
#define XCD_BAR_WORDS 3456
#define XB_SPIN_CAP (1u << 18)

__device__ __forceinline__ unsigned xb_ld(unsigned* p)              { return __hip_atomic_load(p, __ATOMIC_RELAXED, __HIP_MEMORY_SCOPE_AGENT); }
__device__ __forceinline__ unsigned xb_add(unsigned* p, unsigned v) { return __hip_atomic_fetch_add(p, v, __ATOMIC_RELAXED, __HIP_MEMORY_SCOPE_AGENT); }
__device__ __forceinline__ unsigned xb_xcc_id() { return (unsigned)__builtin_amdgcn_s_getreg((3 << 11) | 20) & 0xFu; }
#define XB_SPIN(cond, bar) do { unsigned _sp = 0; while (cond) { __builtin_amdgcn_s_sleep(1); \
    if ((++_sp & 255u) == 0u) { if (xb_ld(&(bar)[XB_TMO])) break; if (_sp > XB_SPIN_CAP) { atomicAdd(&(bar)[XB_TMO], 1u); break; } } } } while (0)

struct XcdBarrier {
    unsigned* bar; unsigned x;
    volatile LAS unsigned* st;
};

__device__ __forceinline__ XcdBarrier xcd_barrier_post(unsigned* bar, volatile LAS unsigned* st) {
    XcdBarrier b; b.bar = bar; b.x = xb_xcc_id(); b.st = st;
    if (threadIdx.x == 0) (void)xb_add(&bar[XB_XCNT(b.x)], 1u);
    return b;
}
__device__ __forceinline__ void xcd_barrier_complete(unsigned* bar, unsigned x, unsigned& nloc, unsigned& nx) {
    const unsigned G = gridDim.x * gridDim.y * gridDim.z;
    unsigned sum, cnt, mine, sp = 0u;
    for (;;) {
        sum = 0u; cnt = 0u; mine = 0u;
#pragma unroll
        for (unsigned j = 0; j < 16; ++j) { const unsigned c = xb_ld(&bar[XB_XCNT(j)]); sum += c; cnt += (c > 0u) ? 1u : 0u; mine = (j == x) ? c : mine; }
        if (sum == G) break;
        __builtin_amdgcn_s_sleep(1);
        if ((++sp & 255u) == 0u) { if (xb_ld(&bar[XB_TMO])) break; if (sp > XB_SPIN_CAP) { atomicAdd(&bar[XB_TMO], 1u); break; } }
    }
    nloc = mine > 0u ? mine : 1u; nx = cnt > 0u ? cnt : 1u;
}

__device__ __forceinline__ void xcd_barrier(const XcdBarrier& b) {
    asm volatile("s_waitcnt vmcnt(0)" ::: "memory");
    __syncthreads();
    if (threadIdx.x == 0) {
        unsigned* bar = b.bar;
        __builtin_amdgcn_s_waitcnt(0);
        unsigned nloc = b.st[0], nx = b.st[1];
        if (nloc == 0u) { xcd_barrier_complete(bar, b.x, nloc, nx); b.st[0] = nloc; b.st[1] = nx; }
        const unsigned old = xb_add(&bar[XB_XSUB(b.x)], 1u);
        const unsigned gen = old / nloc;
        if (old + 1u == (gen + 1u) * nloc) {
            __builtin_amdgcn_fence(__ATOMIC_RELEASE, "agent");
            asm volatile("s_waitcnt vmcnt(0)" ::: "memory");
            const unsigned og = xb_add(&bar[XB_TOP], 1u);
            const unsigned tg = og / nx;
            if (og + 1u == (tg + 1u) * nx) xb_add(&bar[XB_TOPGEN], 1u);
            else XB_SPIN(xb_ld(&bar[XB_TOPGEN]) == tg, bar);
            __builtin_amdgcn_fence(__ATOMIC_ACQUIRE, "agent");
            xb_add(&bar[XB_XGEN(b.x)], 1u);
            asm volatile("s_waitcnt vmcnt(0)" ::: "memory");
        } else {
            XB_SPIN(xb_ld(&bar[XB_XGEN(b.x)]) == gen, bar);
            __builtin_amdgcn_fence(__ATOMIC_ACQUIRE, "agent");
            asm volatile("s_waitcnt vmcnt(0)" ::: "memory");
        }
    }
    __syncthreads();
}
constexpr int NWAVES = 8;
constexpr int D = 2048, SEQ = 8192, MP = 32768, MS = 128, MR = 32896, MT = 33024;
constexpr int DFF = 5632, NA = 5376, NBQ = 2048, NKV = 3072;
constexpr int CQ = 0, CK = 768, CV = 1536, CG = 3072, CQM = 4608, CLR = 5120;
constexpr float DN_ALPHA = 1.6817928305074292f, LN_EPS = 1e-5f, RMS_EPS = 1e-6f;
constexpr float GLA_QSCALE = 0.07216878364870323f, HD_SCALE = 0.08838834764831845f;
constexpr size_t MiB = 1u << 20;
constexpr size_t WS_CTL = 0, CTL_ZERO_BYTES = 1 * MiB;
constexpr size_t WS_WIN = 1 * MiB, WS_WO = 22 * MiB, WS_WFI = 30 * MiB, WS_WFO = 74 * MiB, WS_WMEM = 96 * MiB, WS_MEMX = 112 * MiB, WS_MEMK = 116 * MiB, WS_MEMV = 128 * MiB;
constexpr size_t WS_X = 140 * MiB, WS_Y = 269 * MiB, WS_R1 = 527 * MiB, WS_OCAT = 882 * MiB, WS_SBKS = 1011 * MiB, WS_SBVS = 1060 * MiB, WS_END = 1109 * MiB;
static_assert(WS_WIN + (size_t)NA * D * 2 <= WS_WO && WS_WFI + (size_t)2 * DFF * D * 2 <= WS_WFO && WS_WFO + (size_t)D * DFF * 2 <= WS_WMEM, "weights map");
static_assert(WS_X + (size_t)MT * D * 2 <= WS_Y && WS_Y + (size_t)MT * D * 4 <= WS_R1 && WS_R1 + (size_t)MT * DFF * 2 <= WS_OCAT && WS_OCAT + (size_t)MT * D * 2 <= WS_SBKS, "activation map");
static_assert(WS_SBKS + (size_t)8 * 2064 * 1536 * 2 <= WS_SBVS && WS_SBVS + (size_t)8 * 2064 * 1536 * 2 <= WS_END, "sb sample map");
constexpr size_t O_YP = 0, O_YS = 67108864, O_GSP = 67371008, O_GSS = 69730304, O_SKP = 74448896, O_SVP = 124780544, O_SKS = 175112192, O_SVS = 175308800, O_MKP = 175505408, O_MVP = 177602560, O_END = 179699712;
constexpr int CW_BAR = 4096;
constexpr int RING_OFF = 0, RING_BYTES = 131072, LDSCTL_OFF = RING_BYTES, MISC_OFF = LDSCTL_OFF + 320, LDS_BYTES = 147456;

struct Args { const float* in[22]; float* out_; unsigned char* ws_; int ph_lo, ph_hi; };
struct Frame {
    LAS unsigned char* lds; volatile LAS unsigned* MISC; gu32* ctl;
    int tid, lane, wave, G, gw, NGW;
};
__device__ __forceinline__ float bf2f(bf16 h) { return __builtin_bit_cast(float, (unsigned)h << 16); }
__device__ __forceinline__ float shx(float v, int lane, int m) { return __builtin_bit_cast(float, __builtin_amdgcn_ds_bpermute((lane ^ m) << 2, __builtin_bit_cast(int, v))); }
__device__ __forceinline__ float wave_sum(float v, int lane) {
#pragma unroll
    for (int o = 1; o < 64; o <<= 1) v += shx(v, lane, o);
    return v;
}
__device__ __forceinline__ float wave_max(float v, int lane) {
#pragma unroll
    for (int o = 1; o < 64; o <<= 1) v = fmaxf(v, shx(v, lane, o));
    return v;
}
__device__ __forceinline__ void cvt_row(const float* src, bf16* dst, int n, int lane) {
    for (int j = lane * 4; j < n; j += 256) {
        f32x4 v = src ? *(const f32x4*)(src + j) : (f32x4){0.f, 0.f, 0.f, 0.f};
        unsigned long long w = (unsigned long long)pk2(v.x, v.y) | ((unsigned long long)pk2(v.z, v.w) << 32);
        *(unsigned long long*)(dst + j) = w;
    }
}
__device__ __forceinline__ int fresh_lane() { int z = 0; asm volatile("" : "+s"(z)); return (int)__builtin_amdgcn_mbcnt_hi(~0u, __builtin_amdgcn_mbcnt_lo(~0u, (unsigned)z)); }
#define FRESH_TID() (wave_ * 64 + fresh_lane())
template <bool FINAL>
__device__ __forceinline__ void ln_two_rows(int lane, const bf16* y0, const bf16* y1, const float* gg, const float* bb, bf16* x0, bf16* x1, float* of0, float* of1) {
    v4u w[2][4];
#pragma unroll
    for (int j = 0; j < 4; ++j) { w[0][j] = ((const v4u*)y0)[lane + 64 * j]; w[1][j] = ((const v4u*)y1)[lane + 64 * j]; }
    float v[2][4][8]; float s[2] = {0.f, 0.f};
#pragma unroll
    for (int r = 0; r < 2; ++r)
#pragma unroll
        for (int j = 0; j < 4; ++j) { const v4u q = w[r][j]; v[r][j][0] = pg8::bflo(q.x); v[r][j][1] = pg8::bfhi(q.x); v[r][j][2] = pg8::bflo(q.y); v[r][j][3] = pg8::bfhi(q.y); v[r][j][4] = pg8::bflo(q.z); v[r][j][5] = pg8::bfhi(q.z); v[r][j][6] = pg8::bflo(q.w); v[r][j][7] = pg8::bfhi(q.w);
            s[r] += ((v[r][j][0] + v[r][j][1]) + (v[r][j][2] + v[r][j][3])) + ((v[r][j][4] + v[r][j][5]) + (v[r][j][6] + v[r][j][7])); }
    const float m0 = wave_sum(s[0], lane) * (1.f / D), m1 = wave_sum(s[1], lane) * (1.f / D); float q0 = 0.f, q1 = 0.f;
#pragma unroll
    for (int j = 0; j < 4; ++j)
#pragma unroll
        for (int i = 0; i < 8; ++i) { v[0][j][i] -= m0; q0 += v[0][j][i] * v[0][j][i]; v[1][j][i] -= m1; q1 += v[1][j][i] * v[1][j][i]; }
    const float rs[2] = {1.f / sqrtf(wave_sum(q0, lane) * (1.f / D) + LN_EPS), 1.f / sqrtf(wave_sum(q1, lane) * (1.f / D) + LN_EPS)};
#pragma unroll
    for (int j = 0; j < 4; ++j) { const int e0 = (lane + 64 * j) * 8; const f32x4 g0 = *(const f32x4*)(gg + e0), g1 = *(const f32x4*)(gg + e0 + 4), b0 = *(const f32x4*)(bb + e0), b1 = *(const f32x4*)(bb + e0 + 4);
#pragma unroll
        for (int r = 0; r < 2; ++r) { float o[8];
#pragma unroll
            for (int i = 0; i < 4; ++i) { o[i] = v[r][j][i] * rs[r] * g0[i] + b0[i]; o[4 + i] = v[r][j][4 + i] * rs[r] * g1[i] + b1[i]; }
            if (FINAL) { float* of = r ? of1 : of0; *(f32x4*)(of + e0) = (f32x4){o[0], o[1], o[2], o[3]}; *(f32x4*)(of + e0 + 4) = (f32x4){o[4], o[5], o[6], o[7]}; }
            else { v4u p; p.x = pk2(o[0], o[1]); p.y = pk2(o[2], o[3]); p.z = pk2(o[4], o[5]); p.w = pk2(o[6], o[7]); *(v4u*)((r ? x1 : x0) + e0) = p; } } }
}
struct MapId { __device__ __forceinline__ int operator()(int n) const { return n; } };
struct MapInA { __device__ __forceinline__ int operator()(int n) const { return n < 4608 ? n : (n < 5120 ? n + 16 : (n < 5136 ? n - 512 : -1)); } };
struct MapFfn { __device__ __forceinline__ int operator()(int n) const { const int t = n >> 8, r = n & 255; return r < 128 ? 128 * t + r : DFF + 128 * t + (r - 128); } };
template <class Map>
__device__ __forceinline__ void wt_convert(LAS unsigned char* ldsb, int wave, int gw, int NGW, int lane, const float* W, int K, int Nsrc, bf16* WT, int Ndst, Map map) {
    LAS float* scr = (LAS float*)(ldsb + RING_OFF + wave * 16384);
    const int nblk = Ndst / 64, nitems = (K / 64) * nblk, nq = lane & 15, kq = lane >> 4;
    for (int it = gw; it < nitems; it += NGW) {
        const int kb = it / nblk, nb = it % nblk, k0 = 64 * kb, n0 = 64 * nb;
        const int sc0 = map(n0 + 4 * nq), sc3 = map(n0 + 4 * nq + 3);
        const bool contig = sc0 >= 0 && sc3 == sc0 + 3;
        f32x4 v[16];
#pragma unroll
        for (int i = 0; i < 16; ++i) { const int kk = 4 * i + kq;
            if (contig) v[i] = *(const f32x4*)(W + (size_t)(k0 + kk) * Nsrc + sc0);
            else {
#pragma unroll
                for (int e = 0; e < 4; ++e) { const int sc = map(n0 + 4 * nq + e); v[i][e] = sc >= 0 ? W[(size_t)(k0 + kk) * Nsrc + sc] : 0.f; } } }
#pragma unroll
        for (int i = 0; i < 16; ++i) { const int kk = 4 * i + kq;
#pragma unroll
            for (int e = 0; e < 4; ++e) { const int n = 4 * nq + e; scr[n * 64 + (kk ^ n)] = v[i][e]; } }
        LDS_WAIT(); asm volatile("" ::: "memory");
        const int c = lane & 7;
#pragma unroll
        for (int j = 0; j < 8; ++j) { const int n = (lane >> 3) + 8 * j; const LAS float* s = scr + n * 64;
#define SWZ(i) s[(8 * c + (i)) ^ n]
            v4u o; o.x = pk2(SWZ(0), SWZ(1)); o.y = pk2(SWZ(2), SWZ(3)); o.z = pk2(SWZ(4), SWZ(5)); o.w = pk2(SWZ(6), SWZ(7));
#undef SWZ
            *(GAS v4u*)(WT + (size_t)(n0 + n) * K + k0 + 8 * c) = o; }
        LDS_WAIT(); asm volatile("" ::: "memory");
    }
}
__device__ __forceinline__ float softplus_f(float z) { return fmaxf(z, 0.f) + log1pf(__expf(-fabsf(z))); }

typedef short s16x4 __attribute__((ext_vector_type(4)));
typedef pg8::u32x2 u32x2;
typedef float f32x16 __attribute__((ext_vector_type(16)));
typedef __bf16 bf16x2_t __attribute__((ext_vector_type(2)));
typedef float f32x2_t __attribute__((ext_vector_type(2)));
__device__ __forceinline__ unsigned cvt2(float lo, float hi) { const f32x2_t v = {lo, hi}; const bf16x2_t b = __builtin_convertvector(v, bf16x2_t); return __builtin_bit_cast(unsigned, b); }
__device__ __forceinline__ bf16x8 pack8(const f32x4 a, const f32x4 b) { v4u p; p.x = cvt2(a[0], a[1]); p.y = cvt2(a[2], a[3]); p.z = cvt2(b[0], b[1]); p.w = cvt2(b[2], b[3]); return __builtin_bit_cast(bf16x8, p); }
__device__ __forceinline__ bf16x8 ld2x8(const bf16* p0, const bf16* p1) { const s16x4 a = *(const s16x4*)p0, b = *(const s16x4*)p1; return __builtin_shufflevector(a, b, 0, 1, 2, 3, 4, 5, 6, 7); }
__device__ __forceinline__ bf16x8 ld16(const bf16* p) { return *(const bf16x8*)p; }
#define MFMA16(a, b, c) __builtin_amdgcn_mfma_f32_16x16x32_bf16((a), (b), (c), 0, 0, 0)
#define MFMA32(a, b, c) __builtin_amdgcn_mfma_f32_32x32x16_bf16((a), (b), (c), 0, 0, 0)

constexpr int QIMG_LD = 200, KTIMG_LD = 68, PKG_Q = 0, PKG_KT = 25600, PKG_G = 51712, IMG_BYTES = 52480, PKG_K = 52480, PKG_VT = 77056, PKG_BYTES = 126208, N_PKG = 2048 + 32;
static_assert(64 * QIMG_LD * 2 == PKG_KT && PKG_KT + 192 * KTIMG_LD * 2 == PKG_G && PKG_G + 768 == IMG_BYTES && PKG_K + 24576 == PKG_VT && PKG_VT + 49152 == PKG_BYTES && IMG_BYTES % 16 == 0, "package map");

__device__ __forceinline__ float softplus_fast(float z) { return fmaxf(z, 0.f) + __logf(1.0f + __expf(-fabsf(z))); }
constexpr int GL_TOT = 0, GL_Q = 6144, GL_K = GL_Q + 64 * QIMG_LD * 2, GL_V = GL_K + 64 * QIMG_LD * 2, VL_LD = 68, GL_P = GL_V + 384 * VL_LD * 2, P_LD = 68, GL_END = GL_P + 64 * P_LD * 2;
static_assert(GL_END <= RING_BYTES && GL_Q % 16 == 0 && GL_K % 16 == 0 && GL_V % 8 == 0 && GL_P % 8 == 0, "gla_prep_intra LDS map");
__device__ __forceinline__ void gla_prep_intra(int bid, int G, int tid, int wave, LAS unsigned char* lds, int l, const bf16* PROJ, const float* w_gate_lr, const float* b_gate, unsigned char* PKG, float* OINT) {
    const int lane = tid & 63, fr = lane & 15, fq = lane >> 4;
    const float* w2 = w_gate_lr + (size_t)l * 16 * 768; const float* bg = b_gate + (size_t)l * 768;
    LAS float* tot = (LAS float*)(lds + GL_TOT);
    LAS bf16* QL = (LAS bf16*)(lds + GL_Q); LAS bf16* KL = (LAS bf16*)(lds + GL_K); LAS bf16* VL = (LAS bf16*)(lds + GL_V); LAS bf16* P = (LAS bf16*)(lds + GL_P);
    float w2c[3][16], bgc[3]; int cur_h = -1;
    for (int j = 0;; ++j) {
        int item;
        if (G == 256) { if (j < 8) item = ((((j >> 1) << 2) | (bid & 3)) << 7) | ((bid >> 2) + 64 * (j & 1)); else if (j == 8 && bid < 32) item = 2048 + bid; else break; }
        else { item = bid + j * G; if (item >= N_PKG) break; }
        int h, row0, T;
        if (item < 2048) { const int bh = item >> 7, ch = item & 127; h = bh & 3; row0 = (bh >> 2) * SEQ + ch * 64; T = 64; }
        else { const int i2 = item - 2048; h = i2 & 3; row0 = MP + (i2 >> 2) * 16; T = 16; }
        unsigned char* pk = PKG + (size_t)item * PKG_BYTES;
        bf16* Qt = (bf16*)(pk + PKG_Q); bf16* KT = (bf16*)(pk + PKG_KT); bf16* VT = (bf16*)(pk + PKG_VT); float* Gp = (float*)(pk + PKG_G);
        if (h != cur_h) { cur_h = h;
#pragma unroll
            for (int c = 0; c < 3; ++c) { const int d = h * 192 + lane + 64 * c; bgc[c] = bg[d];
#pragma unroll
                for (int r = 0; r < 16; ++r) w2c[c][r] = w2[r * 768 + d]; } }
        v4u l0[8], l1[8];
#pragma unroll
        for (int tt = 0; tt < 8; ++tt) { const int t = 8 * wave + tt; const bf16* prow = PROJ + (size_t)(row0 + (t < T ? t : T - 1)) * NA;
            l0[tt] = *(const v4u*)(prow + CLR); l1[tt] = *(const v4u*)(prow + CLR + 8); }
        float lc[8][3]; float run[3] = {0.f, 0.f, 0.f};
#pragma unroll
        for (int tt = 0; tt < 8; ++tt) { const bool ok = 8 * wave + tt < T;
            float lr[16]; lr[0] = pg8::bflo(l0[tt].x); lr[1] = pg8::bfhi(l0[tt].x); lr[2] = pg8::bflo(l0[tt].y); lr[3] = pg8::bfhi(l0[tt].y); lr[4] = pg8::bflo(l0[tt].z); lr[5] = pg8::bfhi(l0[tt].z); lr[6] = pg8::bflo(l0[tt].w); lr[7] = pg8::bfhi(l0[tt].w);
            lr[8] = pg8::bflo(l1[tt].x); lr[9] = pg8::bfhi(l1[tt].x); lr[10] = pg8::bflo(l1[tt].y); lr[11] = pg8::bfhi(l1[tt].y); lr[12] = pg8::bflo(l1[tt].z); lr[13] = pg8::bfhi(l1[tt].z); lr[14] = pg8::bflo(l1[tt].w); lr[15] = pg8::bfhi(l1[tt].w);
#pragma unroll
            for (int c = 0; c < 3; ++c) { float xg = bgc[c];
#pragma unroll
                for (int r = 0; r < 16; ++r) xg += lr[r] * w2c[c][r];
                run[c] += ok ? -softplus_fast(-xg) * (1.0f / 16.0f) : 0.f; lc[tt][c] = run[c]; } }
#pragma unroll
        for (int c = 0; c < 3; ++c) tot[wave * 192 + lane + 64 * c] = run[c];
        unsigned qv[8][3], kv[8][3];
#pragma unroll
        for (int tt = 0; tt < 8; ++tt) { const int t = 8 * wave + tt; const bf16* prow = PROJ + (size_t)(row0 + (t < T ? t : T - 1)) * NA + h * 192 + lane;
#pragma unroll
            for (int c = 0; c < 3; ++c) { qv[tt][c] = prow[CQ + 64 * c]; kv[tt][c] = prow[CK + 64 * c]; } }
        __syncthreads();
        float pre[3], all[3];
#pragma unroll
        for (int c = 0; c < 3; ++c) { pre[c] = 0.f; all[c] = 0.f;
#pragma unroll
            for (int w = 0; w < 8; ++w) { const float tv = tot[w * 192 + lane + 64 * c]; all[c] += tv; if (w < wave) pre[c] += tv; } }
        unsigned ktw[3][4];
#pragma unroll
        for (int tt = 0; tt < 8; ++tt) { const int t = 8 * wave + tt; const bool ok = t < T;
#pragma unroll
            for (int c = 0; c < 3; ++c) { const int dl = lane + 64 * c; const float bc = pre[c] + lc[tt][c]; const float eq = __expf(bc), ek = __expf(-bc);
                const unsigned qb = ok ? f2bf(bf2f((bf16)qv[tt][c]) * GLA_QSCALE * eq) : 0u, kb = ok ? f2bf(bf2f((bf16)kv[tt][c]) * ek) : 0u;
                Qt[t * QIMG_LD + dl] = (bf16)qb; QL[t * QIMG_LD + dl] = (bf16)qb; KL[t * QIMG_LD + dl] = (bf16)kb;
                if (tt & 1) ktw[c][tt >> 1] |= kb << 16; else ktw[c][tt >> 1] = kb; } }
#pragma unroll
        for (int c = 0; c < 3; ++c) { bf16* kp = KT + (size_t)(lane + 64 * c) * KTIMG_LD + 8 * wave; u32x2 o0, o1; o0.x = ktw[c][0]; o0.y = ktw[c][1]; o1.x = ktw[c][2]; o1.y = ktw[c][3]; *(u32x2*)kp = o0; *(u32x2*)(kp + 4) = o1; }
        if (wave == 0) {
#pragma unroll
            for (int c = 0; c < 3; ++c) Gp[lane + 64 * c] = __expf(all[c]); }
        unsigned vv[6][8];
#pragma unroll
        for (int tt = 0; tt < 8; ++tt) { const int t = 8 * wave + tt; const bf16* prow = PROJ + (size_t)(row0 + (t < T ? t : T - 1)) * NA + CV + h * 384 + lane;
#pragma unroll
            for (int c2 = 0; c2 < 6; ++c2) vv[c2][tt] = prow[64 * c2]; }
#pragma unroll
        for (int c2 = 0; c2 < 6; ++c2) { const bool ok0 = 8 * wave < T;
            u32x2 o0, o1; o0.x = ok0 ? vv[c2][0] | (vv[c2][1] << 16) : 0u; o0.y = ok0 ? vv[c2][2] | (vv[c2][3] << 16) : 0u; o1.x = ok0 ? vv[c2][4] | (vv[c2][5] << 16) : 0u; o1.y = ok0 ? vv[c2][6] | (vv[c2][7] << 16) : 0u;
            v4u o; o.x = o0.x; o.y = o0.y; o.z = o1.x; o.w = o1.y; *(v4u*)(VT + (size_t)(lane + 64 * c2) * 64 + 8 * wave) = o;
            LAS bf16* vl = VL + (lane + 64 * c2) * VL_LD + 8 * wave; *(LAS u32x2*)vl = o0; *(LAS u32x2*)(vl + 4) = o1; }
        __syncthreads();
        const int nvalid = T;
        bf16x8 va[3], vb[3];
#pragma unroll
        for (int k = 0; k < 3; ++k) { const LAS bf16* vr = VL + (16 * (3 * wave + k) + fr) * VL_LD + 4 * fq;
            const s16x4 x0 = *(const LAS s16x4*)vr, x1 = *(const LAS s16x4*)(vr + 16), x2 = *(const LAS s16x4*)(vr + 32), x3 = *(const LAS s16x4*)(vr + 48);
            va[k] = __builtin_shufflevector(x0, x1, 0, 1, 2, 3, 4, 5, 6, 7); vb[k] = __builtin_shufflevector(x2, x3, 0, 1, 2, 3, 4, 5, 6, 7); }
#pragma unroll
        for (int rep = 0; rep < 2; ++rep) {
            const int tl = wave + 8 * rep;
            if (tl < 10) {
                const int it = tl < 1 ? 0 : (tl < 3 ? 1 : (tl < 6 ? 2 : 3)), jt = tl - (it * (it + 1)) / 2;
                f32x4 at = {0.f, 0.f, 0.f, 0.f};
                const LAS bf16* qr = QL + (16 * it + fr) * QIMG_LD + 8 * fq; const LAS bf16* kr = KL + (16 * jt + fr) * QIMG_LD + 8 * fq;
#pragma unroll
                for (int s = 0; s < 6; ++s) at = MFMA16(*(const LAS bf16x8*)(kr + 32 * s), *(const LAS bf16x8*)(qr + 32 * s), at);
                if (it == jt) {
#pragma unroll
                    for (int jj = 0; jj < 4; ++jj) if (4 * fq + jj > fr) at[jj] = 0.f; }
                u32x2 w; w.x = cvt2(at[0], at[1]); w.y = cvt2(at[2], at[3]);
                *(LAS u32x2*)(P + (16 * it + fr) * P_LD + 16 * jt + 4 * fq) = w;
            } else if (tl == 10 || tl == 11) {
                const int it = tl == 10 ? 0 : 2, jt = tl == 10 ? 1 : 3; unsigned zz = 0u; asm volatile("" : "+v"(zz)); u32x2 z; z.x = zz; z.y = zz;
                *(LAS u32x2*)(P + (16 * it + fr) * P_LD + 16 * jt + 4 * fq) = z;
            }
        }
        __syncthreads();
#pragma unroll
        for (int it = 0; it < 4; ++it) {
            if (16 * it >= nvalid) break;
            const LAS bf16* pr = P + (16 * it + fr) * P_LD + 4 * fq;
            const s16x4 a0 = *(const LAS s16x4*)pr, a1 = *(const LAS s16x4*)(pr + 16);
            const bf16x8 pf0 = __builtin_shufflevector(a0, a1, 0, 1, 2, 3, 4, 5, 6, 7); bf16x8 pf1 = pf0;
            if (it >= 2) { const s16x4 b0 = *(const LAS s16x4*)(pr + 32), b1 = *(const LAS s16x4*)(pr + 48); pf1 = __builtin_shufflevector(b0, b1, 0, 1, 2, 3, 4, 5, 6, 7); }
#pragma unroll
            for (int k = 0; k < 3; ++k) { f32x4 o = {0.f, 0.f, 0.f, 0.f};
                o = MFMA16(va[k], pf0, o); if (it >= 2) o = MFMA16(vb[k], pf1, o);
                *(f32x4*)(OINT + (size_t)(row0 + 16 * it + fr) * 1536 + h * 384 + 16 * (3 * wave + k) + 4 * fq) = o; }
        }
        __syncthreads();
    }
}

template <int PASS>
__device__ __forceinline__ void gla_chain(int wc, int tid, int wave, LAS unsigned char* lds, int l, const unsigned char* PKG, const float* state_gla, float* OINT, float* out, float* SLOC, float* GSEG, bool dry = false) {
    const int lane = tid & 63, fr = lane & 15, fq = lane >> 4;
    int h, vb, bh, seg, item0, nsteps, row0, nvalid; const float* s0 = nullptr; float* sout = nullptr;
    if (PASS == 1) { bh = wc / 9; const int rem = wc % 9; vb = rem / 3; seg = rem % 3; h = bh & 3; item0 = bh * 128 + 32 * seg; nsteps = 32; row0 = 0; nvalid = 64; }
    else if (wc < 192) { bh = wc / 12; const int rem = wc % 12; vb = rem >> 2; seg = rem & 3; h = bh & 3; item0 = bh * 128 + 32 * seg; nsteps = 32; row0 = (bh >> 2) * SEQ + 2048 * seg; nvalid = 64;
        if (seg == 3) sout = out + O_GSP + (size_t)(l * 16 + bh) * 192 * 384; }
    else { const int c2 = wc - 192; bh = c2 / 3; vb = c2 % 3; seg = 0; h = bh & 3; item0 = 2048 + bh; nsteps = 1; row0 = MP + (bh >> 2) * 16; nvalid = 16; s0 = state_gla + (size_t)(l * 32 + bh) * 192 * 384; sout = out + O_GSS + (size_t)(l * 32 + bh) * 192 * 384; }
    const int v0 = vb * 128 + wave * 16;
#define GLA_WALK(p, step) do { (p) += (step); asm volatile("" : "+v"(p)); } while (0)
    f32x4 S[12];
    if (s0) { const float* p = s0 + (size_t)(4 * fq) * 384 + v0 + fr;
#pragma unroll
        for (int t = 0; t < 12; ++t) {
#pragma unroll
            for (int jj = 0; jj < 4; ++jj) { S[t][jj] = *p; GLA_WALK(p, 384); }
            GLA_WALK(p, 12 * 384); } }
    else {
#pragma unroll
        for (int t = 0; t < 12; ++t) S[t] = (f32x4){0.f, 0.f, 0.f, 0.f}; }
    if (PASS == 2 && wc < 192) {
        for (int j = 0; j < seg; ++j) { const float* gs = GSEG + (size_t)(bh * 3 + j) * 192 + 4 * fq; const float* p = SLOC + (size_t)((bh * 3 + vb) * 3 + j) * 192 * 128 + (size_t)(4 * fq) * 128 + wave * 16 + fr;
#pragma unroll
            for (int t = 0; t < 12; ++t) { const f32x4 g4 = *(const f32x4*)(gs + 16 * t);
#pragma unroll
                for (int jj = 0; jj < 4; ++jj) { S[t][jj] = g4[jj] * S[t][jj] + *p; GLA_WALK(p, 128); }
                GLA_WALK(p, 12 * 128); } }
    }
    f32x4 GP[PASS == 1 ? 12 : 1];
    if (PASS == 1) {
#pragma unroll
        for (int t = 0; t < 12; ++t) GP[t] = (f32x4){1.f, 1.f, 1.f, 1.f}; }
    constexpr int CH0 = PASS == 1 ? PKG_KT / 16 : 0, NCH = IMG_BYTES / 16, NLD = PASS == 1 ? 4 : 7;
    v4u pre[NLD]; bf16x8 vt[2], vtn[2]; f32x4 oin[4];
    { const unsigned char* pk = PKG + (size_t)item0 * PKG_BYTES;
      if (PASS == 2) {
#pragma unroll
        for (int it = 0; it < 4; ++it) { const int tl = 16 * it + fr; oin[it] = tl < nvalid ? *(const f32x4*)(OINT + (size_t)(row0 + tl) * 1536 + h * 384 + v0 + 4 * fq) : (f32x4){0.f, 0.f, 0.f, 0.f}; } }
#pragma unroll
      for (int k = 0; k < NLD; ++k) { const int ch = CH0 + tid + 512 * k; if (ch < NCH) pre[k] = *(const v4u*)(pk + (size_t)ch * 16); }
      const bf16* VT = (const bf16*)(pk + PKG_VT) + (size_t)(v0 + fr) * 64 + 4 * fq; vt[0] = ld2x8(VT, VT + 16); vt[1] = ld2x8(VT + 32, VT + 48);
#pragma unroll
      for (int k = 0; k < NLD; ++k) { const int ch = CH0 + tid + 512 * k; if (ch < NCH) *(LAS v4u*)(lds + (size_t)ch * 16) = pre[k]; }
      vtn[0] = vt[0]; vtn[1] = vt[1]; }
    __syncthreads();
    for (int n = 0; n < nsteps; ++n) {
        const LAS unsigned char* img = lds + (n & 1) * IMG_BYTES;
        const bool more = n + 1 < nsteps;
        if (more) { const unsigned char* pk = PKG + (size_t)(item0 + n + 1) * PKG_BYTES;
#pragma unroll
            for (int k = 0; k < NLD; ++k) { const int ch = CH0 + tid + 512 * k; if (ch < NCH) pre[k] = *(const v4u*)(pk + (size_t)ch * 16); }
            const bf16* VT = (const bf16*)(pk + PKG_VT) + (size_t)(v0 + fr) * 64 + 4 * fq; vtn[0] = ld2x8(VT, VT + 16); vtn[1] = ld2x8(VT + 32, VT + 48); }
        if (PASS == 2) {
            bf16x8 Sb[6];
#pragma unroll
            for (int s = 0; s < 6; ++s) Sb[s] = pack8(S[2 * s], S[2 * s + 1]);
#pragma unroll
            for (int it = 0; it < 4; ++it) {
                const LAS bf16* qr = (const LAS bf16*)(img + PKG_Q) + (16 * it + fr) * QIMG_LD + 4 * fq;
                f32x4 o = oin[it];
#pragma unroll
                for (int s = 0; s < 6; ++s) { const s16x4 a = *(const LAS s16x4*)(qr + 32 * s), b = *(const LAS s16x4*)(qr + 32 * s + 16);
                    o = MFMA16(Sb[s], __builtin_shufflevector(a, b, 0, 1, 2, 3, 4, 5, 6, 7), o); }
                const int tl = 16 * it + fr;
                if (tl < nvalid && !dry) *(f32x4*)(OINT + (size_t)(row0 + 64 * n + tl) * 1536 + h * 384 + v0 + 4 * fq) = o;
                __builtin_amdgcn_sched_barrier(0);
            }
            if (more) {
#pragma unroll
                for (int it = 0; it < 4; ++it) oin[it] = *(const f32x4*)(OINT + (size_t)(row0 + 64 * (n + 1) + 16 * it + fr) * 1536 + h * 384 + v0 + 4 * fq); }
        }
#pragma unroll
        for (int t = 0; t < 12; ++t) { const LAS bf16* kr = (const LAS bf16*)(img + PKG_KT) + (16 * t + fr) * KTIMG_LD + 4 * fq;
#pragma unroll
            for (int s2 = 0; s2 < 2; ++s2) { const s16x4 a = *(const LAS s16x4*)(kr + 32 * s2), b = *(const LAS s16x4*)(kr + 32 * s2 + 16);
                S[t] = MFMA16(__builtin_shufflevector(a, b, 0, 1, 2, 3, 4, 5, 6, 7), vt[s2], S[t]); }
            const f32x4 g4 = *(const LAS f32x4*)(img + PKG_G + (16 * t + 4 * fq) * 4);
            S[t] = S[t] * g4; if (PASS == 1) GP[t] = GP[t] * g4; if (t & 1) __builtin_amdgcn_sched_barrier(0); }
        if (more) { LAS unsigned char* nimg = lds + ((n + 1) & 1) * IMG_BYTES;
#pragma unroll
            for (int k = 0; k < NLD; ++k) { const int ch = CH0 + tid + 512 * k; if (ch < NCH) *(LAS v4u*)(nimg + (size_t)ch * 16) = pre[k]; }
            vt[0] = vtn[0]; vt[1] = vtn[1]; }
        asm volatile("s_waitcnt lgkmcnt(0)" ::: "memory"); __builtin_amdgcn_s_barrier(); asm volatile("" ::: "memory");
    }
    if (PASS == 1) {
        float* p = SLOC + (size_t)((bh * 3 + vb) * 3 + seg) * 192 * 128 + (size_t)(4 * fq) * 128 + wave * 16 + fr;
#pragma unroll
        for (int t = 0; t < 12; ++t) {
#pragma unroll
            for (int jj = 0; jj < 4; ++jj) { *p = S[t][jj]; GLA_WALK(p, 128); }
            GLA_WALK(p, 12 * 128); }
        if (vb == 0 && wave == 0 && fr == 0) { float* gs = GSEG + (size_t)(bh * 3 + seg) * 192;
#pragma unroll
            for (int t = 0; t < 12; ++t) *(f32x4*)(gs + 16 * t + 4 * fq) = GP[t]; }
    } else if (sout) {
        float* p = sout + (size_t)(4 * fq) * 384 + v0 + fr;
#pragma unroll
        for (int t = 0; t < 12; ++t) {
#pragma unroll
            for (int jj = 0; jj < 4; ++jj) { *p = S[t][jj]; GLA_WALK(p, 384); }
            GLA_WALK(p, 12 * 384); }
    }
#undef GLA_WALK
}

__device__ __forceinline__ void mem_attn(int item, int lane, int l, const bf16* PROJ, int ldp, int cqm, const bf16* MEMK, const bf16* MEMVT, bf16* OCAT) {
    const int fr = lane & 15, fq = lane >> 4, tile = item >> 2, h = item & 3, r0 = tile * 16;
    const int bb = r0 < MP ? r0 / SEQ : 4 + ((r0 - MP) >> 4);
    const bf16* Kb = MEMK + (size_t)((l * 12 + bb) * 256) * 512 + h * 128; const bf16* Vt = MEMVT + (size_t)(((l * 12 + bb) * 4 + h) * 128) * 256;
    bf16x8 qf[4];
#pragma unroll
    for (int s = 0; s < 4; ++s) qf[s] = ld16(PROJ + (size_t)(r0 + fr) * ldp + cqm + h * 128 + 32 * s + 8 * fq);
    f32x4 st[16];
#pragma unroll
    for (int mt = 0; mt < 16; ++mt) { st[mt] = (f32x4){0.f, 0.f, 0.f, 0.f}; const bf16* kr = Kb + (size_t)(16 * mt + fr) * 512 + 8 * fq;
#pragma unroll
        for (int s = 0; s < 4; ++s) st[mt] = MFMA16(ld16(kr + 32 * s), qf[s], st[mt]); }
    float mx = -3.0e38f;
#pragma unroll
    for (int mt = 0; mt < 16; ++mt) mx = fmaxf(mx, fmaxf(fmaxf(st[mt][0], st[mt][1]), fmaxf(st[mt][2], st[mt][3])));
    mx = fmaxf(mx, shx(mx, lane, 16)); mx = fmaxf(mx, shx(mx, lane, 32));
    float sum = 0.f;
#pragma unroll
    for (int mt = 0; mt < 16; ++mt)
#pragma unroll
        for (int jj = 0; jj < 4; ++jj) { const float p = __expf((st[mt][jj] - mx) * HD_SCALE); st[mt][jj] = p; sum += p; }
    sum += shx(sum, lane, 16); sum += shx(sum, lane, 32);
    const float inv = 1.0f / sum;
    bf16x8 pf[8];
#pragma unroll
    for (int s = 0; s < 8; ++s) pf[s] = pack8(st[2 * s], st[2 * s + 1]);
#pragma unroll
    for (int dt = 0; dt < 8; ++dt) { f32x4 o = {0.f, 0.f, 0.f, 0.f}; const bf16* vr = Vt + (size_t)(16 * dt + fr) * 256 + 4 * fq;
#pragma unroll
        for (int s = 0; s < 8; ++s) o = MFMA16(ld2x8(vr + 32 * s, vr + 32 * s + 16), pf[s], o);
        u32x2 w; w.x = cvt2(o[0] * inv, o[1] * inv); w.y = cvt2(o[2] * inv, o[3] * inv);
        *(u32x2*)(OCAT + (size_t)(r0 + fr) * D + 1536 + h * 128 + 16 * dt + 4 * fq) = w; }
}

__device__ __forceinline__ void mem_attn_wg(int wi, int tid, int wave, LAS unsigned char* lds, int l, const bf16* PROJ, int ldp, int cqm, const bf16* MEMK, const bf16* MEMVT, bf16* OCAT) {
    const bool smp = wi >= 256; const int lane = tid & 63, fr = lane & 15, fq = lane >> 4, bh = smp ? (wi - 256) : (wi >> 4), sub = wi & 15, b = smp ? 4 + (bh >> 2) : (bh >> 2), h = bh & 3;
    const bf16* Kb = MEMK + (size_t)((l * 12 + b) * 256) * 512 + h * 128; const bf16* Vt = MEMVT + (size_t)(((l * 12 + b) * 4 + h) * 128) * 256;
#pragma unroll
    for (int k = 0; k < 8; ++k) { const int idx = tid + 512 * k, row = idx >> 4, c = idx & 15; *(LAS v4u*)(lds + row * 256 + ((c ^ (row & 15)) << 4)) = *(const v4u*)(Kb + (size_t)row * 512 + c * 8); }
#pragma unroll
    for (int k = 0; k < 8; ++k) { const int idx = tid + 512 * k, row = idx >> 5, c = idx & 31; *(LAS v4u*)(lds + 65536 + row * 512 + ((c ^ (2 * (row & 15))) << 4)) = *(const v4u*)(Vt + (size_t)row * 256 + c * 8); }
    __syncthreads();
    unsigned koff[4], voff[16];
#pragma unroll
    for (int s2 = 0; s2 < 4; ++s2) { koff[s2] = (unsigned)(fr * 256 + (((4 * s2 + fq) ^ fr) << 4)); asm volatile("" : "+v"(koff[s2])); }
#pragma unroll
    for (int s2 = 0; s2 < 8; ++s2) { const int p0 = 8 * s2 + fq, p1 = p0 + 4;
        voff[2 * s2] = (unsigned)(65536 + fr * 512 + ((((p0 >> 1) ^ (2 * fr)) << 4) | ((p0 & 1) << 3))); voff[2 * s2 + 1] = (unsigned)(65536 + fr * 512 + ((((p1 >> 1) ^ (2 * fr)) << 4) | ((p1 & 1) << 3)));
        asm volatile("" : "+v"(voff[2 * s2]), "+v"(voff[2 * s2 + 1])); }
    const int nblk = smp ? (wave == 0 ? 1 : 0) : 4;
#pragma unroll 1
    for (int blk = 0; blk < nblk; ++blk) {
        const int r0 = smp ? MP + (b - 4) * 16 : b * SEQ + sub * 512 + blk * 128 + wave * 16;
        bf16x8 qf[4];
#pragma unroll
        for (int s = 0; s < 4; ++s) qf[s] = ld16(PROJ + (size_t)(r0 + fr) * ldp + cqm + h * 128 + 32 * s + 8 * fq);
        f32x4 st[16];
#pragma unroll
        for (int mt = 0; mt < 16; ++mt) { st[mt] = (f32x4){0.f, 0.f, 0.f, 0.f};
#pragma unroll
            for (int s = 0; s < 4; ++s) st[mt] = MFMA16(*(const LAS bf16x8*)(lds + koff[s] + mt * 4096), qf[s], st[mt]);
            if ((mt & 3) == 3) __builtin_amdgcn_sched_barrier(0); }
        float mx = -3.0e38f;
#pragma unroll
        for (int mt = 0; mt < 16; ++mt) mx = fmaxf(mx, fmaxf(fmaxf(st[mt][0], st[mt][1]), fmaxf(st[mt][2], st[mt][3])));
        mx = fmaxf(mx, shx(mx, lane, 16)); mx = fmaxf(mx, shx(mx, lane, 32));
        float sum = 0.f;
#pragma unroll
        for (int mt = 0; mt < 16; ++mt)
#pragma unroll
            for (int jj = 0; jj < 4; ++jj) { const float p = __expf((st[mt][jj] - mx) * HD_SCALE); st[mt][jj] = p; sum += p; }
        sum += shx(sum, lane, 16); sum += shx(sum, lane, 32);
        const float inv = 1.0f / sum;
        bf16x8 pf[8];
#pragma unroll
        for (int s = 0; s < 8; ++s) pf[s] = pack8(st[2 * s], st[2 * s + 1]);
#pragma unroll
        for (int dt = 0; dt < 8; ++dt) { f32x4 o = {0.f, 0.f, 0.f, 0.f};
#pragma unroll
            for (int s = 0; s < 8; ++s) { const s16x4 a = *(const LAS s16x4*)(lds + voff[2 * s] + dt * 8192), bb = *(const LAS s16x4*)(lds + voff[2 * s + 1] + dt * 8192);
                o = MFMA16(__builtin_shufflevector(a, bb, 0, 1, 2, 3, 4, 5, 6, 7), pf[s], o); }
            u32x2 w; w.x = cvt2(o[0] * inv, o[1] * inv); w.y = cvt2(o[2] * inv, o[3] * inv);
            *(u32x2*)(OCAT + (size_t)(r0 + fr) * D + 1536 + h * 128 + 16 * dt + 4 * fq) = w;
            if (dt & 1) __builtin_amdgcn_sched_barrier(0); }
    }
    __syncthreads();
}

__device__ __forceinline__ void sb_attn(int lane, LAS unsigned char* wlds, const bf16* Kp, int ldk, const bf16* VTp, int ldvt, const bf16* Qp, int ldq, bf16* Op, int t0, int nq) {
    const int r = lane & 31, hh = lane >> 5;
    LAS bf16x8* qs = (LAS bf16x8*)wlds + lane;
#pragma unroll
    for (int ks = 0; ks < 8; ++ks) qs[64 * ks] = ld16(Qp + (size_t)r * ldq + 16 * ks + 8 * hh);
    f32x16 oacc[4];
#pragma unroll
    for (int dt = 0; dt < 4; ++dt)
#pragma unroll
        for (int i = 0; i < 16; ++i) oacc[dt][i] = 0.f;
    float carry = 1.f;
    bf16x8 kf[8];
    { const bf16* kr = Kp + (size_t)(t0 + r) * ldk + 8 * hh;
#pragma unroll
      for (int ks = 0; ks < 8; ++ks) kf[ks] = ld16(kr + 16 * ks); }
    for (int s0 = t0; s0 >= 0; s0 -= 32) {
        bf16x8 vf[8];
#pragma unroll
        for (int k2 = 0; k2 < 2; ++k2)
#pragma unroll
            for (int dt = 0; dt < 4; ++dt) { const bf16* vr = VTp + (size_t)(s0 >> 5) * 4096 + (32 * dt + r) * 32 + 16 * k2 + 4 * hh; vf[4 * k2 + dt] = ld2x8(vr, vr + 8); }
        f32x16 st;
#pragma unroll
        for (int i = 0; i < 16; ++i) st[i] = 0.f;
#pragma unroll
        for (int ks = 0; ks < 8; ++ks) st = MFMA32(kf[ks], qs[64 * ks], st);
        { const int sn = s0 >= 32 ? s0 - 32 : 0; const bf16* kr = Kp + (size_t)(sn + r) * ldk + 8 * hh;
#pragma unroll
          for (int ks = 0; ks < 8; ++ks) kf[ks] = ld16(kr + 16 * ks); }
        const bool diag = (s0 == t0);
        float lb[16], om[16];
#pragma unroll
        for (int i = 0; i < 16; ++i) { const float z = st[i] * HD_SCALE, e = __expf(-fabsf(z)), rr = __builtin_amdgcn_rcpf(1.0f + e), er = e * rr;
            lb[i] = z >= 0.f ? rr : er; om[i] = z >= 0.f ? er : rr;
            if (diag && !(((i & 3) + 8 * (i >> 2) + 4 * hh) < r)) { lb[i] = 0.f; om[i] = 1.f; } }
        float g[4], pgv[4];
#pragma unroll
        for (int m = 0; m < 4; ++m) { g[m] = (om[4 * m] * om[4 * m + 1]) * (om[4 * m + 2] * om[4 * m + 3]); pgv[m] = shx(g[m], lane, 32); }
        float R[4]; R[3] = 1.f; R[2] = g[3] * pgv[3]; R[1] = R[2] * (g[2] * pgv[2]); R[0] = R[1] * (g[1] * pgv[1]);
        const float total = R[0] * (g[0] * pgv[0]);
#pragma unroll
        for (int m = 0; m < 4; ++m) { const float suf = carry * R[m] * (hh == 0 ? pgv[m] : 1.f);
            const float t3 = suf, t2 = t3 * om[4 * m + 3], t1 = t2 * om[4 * m + 2], t0_ = t1 * om[4 * m + 1];
            lb[4 * m + 3] *= t3; lb[4 * m + 2] *= t2; lb[4 * m + 1] *= t1; lb[4 * m] *= t0_; }
        carry *= total;
#pragma unroll
        for (int k2 = 0; k2 < 2; ++k2) {
            v4u p; p.x = cvt2(lb[8 * k2], lb[8 * k2 + 1]); p.y = cvt2(lb[8 * k2 + 2], lb[8 * k2 + 3]); p.z = cvt2(lb[8 * k2 + 4], lb[8 * k2 + 5]); p.w = cvt2(lb[8 * k2 + 6], lb[8 * k2 + 7]);
            const bf16x8 wf = __builtin_bit_cast(bf16x8, p);
#pragma unroll
            for (int dt = 0; dt < 4; ++dt) oacc[dt] = MFMA32(vf[4 * k2 + dt], wf, oacc[dt]);
        }
        if (__all((r >= nq) || (carry < 1.0e-37f))) break;
    }
    if (r < nq) {
#pragma unroll
        for (int dt = 0; dt < 4; ++dt)
#pragma unroll
            for (int g4 = 0; g4 < 4; ++g4) { u32x2 wv; wv.x = cvt2(oacc[dt][4 * g4], oacc[dt][4 * g4 + 1]); wv.y = cvt2(oacc[dt][4 * g4 + 2], oacc[dt][4 * g4 + 3]);
                *(u32x2*)(Op + (size_t)r * D + 32 * dt + 8 * g4 + 4 * hh) = wv; }
    }
    asm volatile("s_waitcnt lgkmcnt(0)" ::: "memory");
}

struct SkBf16 { bf16* O; int ldc;
    __device__ __forceinline__ int brow(int unit, int nb) const { return 32 * unit + 16 * nb; }
    __device__ __forceinline__ void store(int unit, const f32x4 a0, const f32x4 a1, int m, int fq) const { bf16* p = O + (size_t)(MP + m) * ldc + 32 * unit + 4 * fq;
        u32x2 w; w.x = cvt2(a0[0], a0[1]); w.y = cvt2(a0[2], a0[3]); *(u32x2*)p = w; w.x = cvt2(a1[0], a1[1]); w.y = cvt2(a1[2], a1[3]); *(u32x2*)(p + 16) = w; } };
struct SkRes { bf16* Yp; const bf16* Xp; float alpha;
    __device__ __forceinline__ int brow(int unit, int nb) const { return 32 * unit + 16 * nb; }
    __device__ __forceinline__ void one(size_t o, const f32x4 a) const { const u32x2 xv = *(const u32x2*)(Xp + o);
        f32x4 r; r[0] = alpha * pg8::bflo(xv.x); r[1] = alpha * pg8::bfhi(xv.x); r[2] = alpha * pg8::bflo(xv.y); r[3] = alpha * pg8::bfhi(xv.y); r = r + a; u32x2 w; w.x = cvt2(r[0], r[1]); w.y = cvt2(r[2], r[3]); *(u32x2*)(Yp + o) = w; }
    __device__ __forceinline__ void store(int unit, const f32x4 a0, const f32x4 a1, int m, int fq) const { const size_t o = (size_t)(MP + m) * D + 32 * unit + 4 * fq; one(o, a0); one(o + 16, a1); } };
struct SkKV { float *oks, *ovs; bf16 *ksb, *vsb;
    __device__ __forceinline__ int brow(int unit, int nb) const { return 32 * unit + 16 * nb; }
    __device__ __forceinline__ void one(int col, const f32x4 a, int m) const { const bool isv = col >= 1536; const int c = col - (isv ? 1536 : 0), b = m >> 4, t = m & 15;
        *(f32x4*)((isv ? ovs : oks) + (size_t)m * 1536 + c) = a; const unsigned w0 = cvt2(a[0], a[1]), w1 = cvt2(a[2], a[3]);
        const int hh_ = c >> 7, dd = c & 127;
        if (!isv) { u32x2 w; w.x = w0; w.y = w1; *(u32x2*)(ksb + ((size_t)(b * 12 + hh_) * 2080 + 2048 + t) * 128 + dd) = w; }
        else { bf16* vt = vsb + ((size_t)(b * 12 + hh_) * 65 + 64) * 4096 + dd * 32 + t; vt[0] = (bf16)w0; vt[32] = (bf16)(w0 >> 16); vt[64] = (bf16)w1; vt[96] = (bf16)(w1 >> 16); } }
    __device__ __forceinline__ void store(int unit, const f32x4 a0, const f32x4 a1, int m, int fq) const { one(32 * unit + 4 * fq, a0, m); one(32 * unit + 16 + 4 * fq, a1, m); } };
struct SkSwiGLU { bf16* Hb;
    __device__ __forceinline__ int brow(int unit, int nb) const { const int c0 = 16 * unit; return (c0 >> 7) * 256 + (c0 & 127) + 128 * nb; }
    __device__ __forceinline__ void store(int unit, const f32x4 g, const f32x4 u, int m, int fq) const { float hv[4];
#pragma unroll
        for (int j = 0; j < 4; ++j) hv[j] = g[j] * __builtin_amdgcn_rcpf(1.0f + __expf(-g[j])) * u[j];
        u32x2 w; w.x = cvt2(hv[0], hv[1]); w.y = cvt2(hv[2], hv[3]); *(u32x2*)(Hb + (size_t)(MP + m) * DFF + 16 * unit + 4 * fq) = w; } };
template <class Epi>
__device__ __forceinline__ void skinny_gemm(int bid, int G, int tid, int wave, LAS unsigned char* lds, const bf16* A, int lda, const bf16* Bt, int K, int nunits, const Epi& E) {
    const int lane = tid & 63, fr = lane & 15, fq = lane >> 4, kw = K >> 3, nst = kw >> 5;
    const bf16* ap = A + (size_t)fr * lda + wave * kw + 8 * fq;
    LAS f32x4* red = (LAS f32x4*)lds;
    for (int unit = bid; unit < nunits; unit += G) {
        const bf16* bp0 = Bt + (size_t)(E.brow(unit, 0) + fr) * K + wave * kw + 8 * fq; const bf16* bp1 = Bt + (size_t)(E.brow(unit, 1) + fr) * K + wave * kw + 8 * fq;
        f32x4 acc[2][8];
#pragma unroll
        for (int nb = 0; nb < 2; ++nb)
#pragma unroll
            for (int rt = 0; rt < 8; ++rt) acc[nb][rt] = (f32x4){0.f, 0.f, 0.f, 0.f};
        bf16x8 a0[8], a1[8], a2[8], b0[2], b1[2], b2[2];
#define SK_LOAD(af, bfr, st) do { _Pragma("unroll") for (int rt = 0; rt < 8; ++rt) af[rt] = ld16(ap + (size_t)(16 * rt) * lda + 32 * (st)); bfr[0] = ld16(bp0 + 32 * (st)); bfr[1] = ld16(bp1 + 32 * (st)); } while (0)
#define SK_MMA(af, bfr) do { _Pragma("unroll") for (int rt = 0; rt < 8; ++rt) { acc[0][rt] = MFMA16(bfr[0], af[rt], acc[0][rt]); acc[1][rt] = MFMA16(bfr[1], af[rt], acc[1][rt]); } } while (0)
        SK_LOAD(a0, b0, 0); SK_LOAD(a1, b1, 1);
#pragma unroll 1
        for (int st = 0; st < nst; st += 3) {
            if (st + 2 < nst) SK_LOAD(a2, b2, st + 2);
            __builtin_amdgcn_sched_barrier(0);
            SK_MMA(a0, b0);
            __builtin_amdgcn_sched_barrier(0);
            if (st + 3 < nst) SK_LOAD(a0, b0, st + 3);
            __builtin_amdgcn_sched_barrier(0);
            if (st + 1 < nst) SK_MMA(a1, b1);
            __builtin_amdgcn_sched_barrier(0);
            if (st + 4 < nst) SK_LOAD(a1, b1, st + 4);
            __builtin_amdgcn_sched_barrier(0);
            if (st + 2 < nst) SK_MMA(a2, b2);
            __builtin_amdgcn_sched_barrier(0);
        }
#undef SK_LOAD
#undef SK_MMA
#pragma unroll
        for (int nb = 0; nb < 2; ++nb)
#pragma unroll
            for (int rt = 0; rt < 8; ++rt) red[((wave * 2 + nb) * 8 + rt) * 64 + lane] = acc[nb][rt];
        __syncthreads();
        f32x4 s0 = {0.f, 0.f, 0.f, 0.f}, s1 = {0.f, 0.f, 0.f, 0.f};
#pragma unroll
        for (int ws = 0; ws < 8; ++ws) { s0 = s0 + red[((ws * 2 + 0) * 8 + wave) * 64 + lane]; s1 = s1 + red[((ws * 2 + 1) * 8 + wave) * 64 + lane]; }
        E.store(unit, s0, s1, 16 * wave + fr, fq);
        __syncthreads();
    }
}
#ifndef PH_MASK
#define PH_MASK 0xFFFF
#endif
__global__ void __launch_bounds__(NWAVES * 64, 2) mega(Args args) {
    extern __shared__ __attribute__((aligned(16))) unsigned char lds[];
    Frame F;
    F.lds = (LAS unsigned char*)lds; F.MISC = (volatile LAS unsigned*)(F.lds + MISC_OFF);
    F.tid = threadIdx.x; F.lane = F.tid & 63; F.wave = __builtin_amdgcn_readfirstlane(F.tid >> 6);
    F.G = gridDim.x; F.gw = blockIdx.x * NWAVES + F.wave; F.NGW = F.G * NWAVES;
    F.ctl = (gu32*)(args.ws_ + WS_CTL);
    for (int u = F.tid; u < (LDS_BYTES - LDSCTL_OFF) / 4; u += NWAVES * 64) ((LAS unsigned*)(F.lds + LDSCTL_OFF))[u] = 0u;
    __syncthreads();
    XcdBarrier bar = xcd_barrier_post((unsigned*)(F.ctl + CW_BAR), F.MISC + 8);
    const int lo = args.ph_lo, hi = args.ph_hi; int ph = 0;
#define KARGS ((const __attribute__((address_space(4))) Args*)__builtin_amdgcn_kernarg_segment_ptr())
#define ws (ka->ws_)
#define out (ka->out_)
#define x_prompt (ka->in[0])
#define x_sample (ka->in[1])
#define mem_prompt (ka->in[2])
#define state_gla (ka->in[3])
#define cache_sb_k (ka->in[4])
#define cache_sb_v (ka->in[5])
#define cache_mem_k (ka->in[6])
#define cache_mem_v (ka->in[7])
#define w_in_a (ka->in[8])
#define w_gate_lr (ka->in[9])
#define b_gate (ka->in[10])
#define gla_norm_g (ka->in[11])
#define w_in_b (ka->in[12])
#define w_kv_shared (ka->in[13])
#define w_mem_kv (ka->in[14])
#define w_o (ka->in[15])
#define ln1_g (ka->in[16])
#define ln1_b (ka->in[17])
#define ln2_g (ka->in[18])
#define ln2_b (ka->in[19])
#define w_ffn_in (ka->in[20])
#define w_ffn_out (ka->in[21])
#define WIN ((bf16*)(ws + WS_WIN))
#define WO ((bf16*)(ws + WS_WO))
#define WFI ((bf16*)(ws + WS_WFI))
#define WFO ((bf16*)(ws + WS_WFO))
#define WMEM ((bf16*)(ws + WS_WMEM))
#define MEMX ((bf16*)(ws + WS_MEMX))
#define MEMK ((bf16*)(ws + WS_MEMK))
#define MEMV ((bf16*)(ws + WS_MEMV))
#define X ((bf16*)(ws + WS_X))
#define Y ((float*)(ws + WS_Y))
#define YB ((bf16*)(ws + WS_Y))
#define PROJ ((bf16*)(ws + WS_R1))
#define HB ((bf16*)(ws + WS_R1))
#define OCAT ((bf16*)(ws + WS_OCAT))
#define SBKS ((bf16*)(ws + WS_SBKS))
#define SBVS ((bf16*)(ws + WS_SBVS))
#define OINT (out + O_YP)
#define KPB ((bf16*)(out + O_YP))
#define VPB (KPB + (size_t)MP * 1536)

#define PHASE_BEGIN(cond, cls) if (cond) { if (lo <= ph && ph < hi) { if (ph > lo) { xcd_barrier(bar); if (BAR_REP > 1) xcd_barrier(bar); } DIAG_STAMP(cls); for (int rep_ = 0; rep_ < (((cls) == REP_CLS) ? 2 : 1); ++rep_) { const __attribute__((address_space(4))) Args* ka = KARGS; asm volatile("" : "+s"(ka)); int z_ = 0, G_ = gridDim.x, bid_ = blockIdx.x, wave_ = F.wave; asm volatile("" : "+s"(z_), "+s"(G_), "+s"(bid_), "+s"(wave_)); const int lane = (int)__builtin_amdgcn_mbcnt_hi(~0u, __builtin_amdgcn_mbcnt_lo(~0u, (unsigned)z_)), tid = wave_ * 64 + lane, gw_ = bid_ * NWAVES + wave_, NGW_ = G_ * NWAVES;     (void)tid; (void)lane; (void)gw_; (void)NGW_;
#define PHASE_END } } ++ph; }
#ifndef REP_CLS
#define REP_CLS (-1)
#endif
#ifndef SK_REP
#define SK_REP 1
#endif
#ifndef BAR_REP
#define BAR_REP 1
#endif
#ifndef STAG
#define STAG 0
#endif
#ifndef SB_REP
#define SB_REP 1
#endif
#if defined(DIAG_A)
#define DIAG_STAMP(cls) do { if (blockIdx.x == 0 && threadIdx.x == 0) { unsigned long long* dts = (unsigned long long*)(args.ws_ + 262144); dts[ph] = rt(); } } while (0)
#else
#define DIAG_STAMP(cls) do { } while (0)
#endif

#define CONVERT_WEIGHTS(LL) do { const int ll_ = (LL); \
            if (ll_ < 2) wt_convert(F.lds, wave_, gw_, NGW_, lane, w_in_a + (size_t)ll_ * D * 5136, D, 5136, WIN, NA, MapInA()); \
            else { wt_convert(F.lds, wave_, gw_, NGW_, lane, w_in_b + (size_t)(ll_ - 2) * D * NBQ, D, NBQ, WIN, NBQ, MapId()); if (ll_ == 2) wt_convert(F.lds, wave_, gw_, NGW_, lane, w_kv_shared, D, NKV, WIN + (size_t)NBQ * D, NKV, MapId()); } \
            wt_convert(F.lds, wave_, gw_, NGW_, lane, w_o + (size_t)ll_ * D * D, D, D, WO, D, MapId()); \
            wt_convert(F.lds, wave_, gw_, NGW_, lane, w_ffn_in + (size_t)ll_ * D * 2 * DFF, D, 2 * DFF, WFI, 2 * DFF, MapFfn()); \
            wt_convert(F.lds, wave_, gw_, NGW_, lane, w_ffn_out + (size_t)ll_ * DFF * D, DFF, D, WFO, D, MapId()); } while (0)
    PHASE_BEGIN(true, 0)
        for (int r = gw_; r < MT; r += NGW_) cvt_row(r < MP ? x_prompt + (size_t)r * D : (r < MR ? x_sample + (size_t)(r - MP) * D : nullptr), X + (size_t)r * D, D, lane);
        for (int r = gw_; r < 1024; r += NGW_) cvt_row(mem_prompt + (size_t)r * D, MEMX + (size_t)r * D, D, lane);
        for (int r = gw_; r < 4 * 8 * 256; r += NGW_) { const int l = r >> 11, b = (r >> 8) & 7, m = r & 255; const size_t dst = (size_t)((l * 12 + 4 + b) * 256 + m) * 512;
            cvt_row(cache_mem_k + (size_t)r * 512, MEMK + dst, 512, lane); }
        for (int it = gw_; it < 512; it += NGW_) { const int hdb = it & 3, mb = (it >> 2) & 3, b = (it >> 4) & 7, l = it >> 7, m = mb * 64 + lane;
            const float* src = cache_mem_v + (size_t)((l * 8 + b) * 256 + m) * 512 + hdb * 128; bf16* dst = MEMV + (size_t)((l * 12 + 4 + b) * 512 + hdb * 128) * 256 + m;
            for (int q4 = 0; q4 < 32; ++q4) { const f32x4 v = *(const f32x4*)(src + 4 * q4);
#pragma unroll
                for (int e = 0; e < 4; ++e) dst[(size_t)(4 * q4 + e) * 256] = (bf16)f2bf(v[e]); } }
        for (int r = gw_; r < 8 * 2048; r += NGW_) { const int b = r >> 11, s = r & 2047; const float* src = cache_sb_k + (size_t)r * 1536;
            for (int j = lane * 4; j < 1536; j += 256) { const f32x4 v = *(const f32x4*)(src + j);
                *(unsigned long long*)(SBKS + ((size_t)(b * 12 + (j >> 7)) * 2080 + s) * 128 + (j & 127)) = (unsigned long long)pk2(v.x, v.y) | ((unsigned long long)pk2(v.z, v.w) << 32); } }
        for (int it = gw_; it < 3072; it += NGW_) { const int cb = it % 12, sb_ = (it / 12) & 31, b = it / 384, s = sb_ * 64 + lane;
            const float* src = cache_sb_v + (size_t)(b * 2048 + s) * 1536 + cb * 128; bf16* dst = SBVS + ((size_t)(b * 12 + cb) * 65 + (s >> 5)) * 4096 + (s & 31);
            for (int q4 = 0; q4 < 32; ++q4) { const f32x4 v = *(const f32x4*)(src + 4 * q4);
#pragma unroll
                for (int e = 0; e < 4; ++e) dst[(4 * q4 + e) * 32] = (bf16)f2bf(v[e]); } }
        for (int l = 0; l < 4; ++l) wt_convert(F.lds, wave_, gw_, NGW_, lane, w_mem_kv + (size_t)l * D * 1024, D, 1024, WMEM + (size_t)l * 1024 * D, 1024, MapId());
        CONVERT_WEIGHTS(0);
    PHASE_END
    PHASE_BEGIN(true, 0)
        pg8::Gemm g{MEMX, WMEM, 1024, 4096, D}; pg8::StaticOrder S; S.init(1024, 4096, G_, bid_);
        pg8::EpiMemKV E{out + O_MKP, out + O_MVP, MEMK, MEMV};
        pg8::gemm_phase<pg8::EpiMemKV, pg8::StaticOrder, true, true>(F.lds + RING_OFF, g, S, E, FRESH_TID());
    PHASE_END

    for (int l = 0; l < 4; ++l) {
        const bool LA = l < 2;
        const int ldp = LA ? NA : NBQ;
        PHASE_BEGIN(true, 2)
            if (!LA && (bid_ & 1)) { { SkBf16 E{PROJ, ldp}; skinny_gemm(bid_, G_, FRESH_TID(), wave_, F.lds + RING_OFF, X + (size_t)MP * D, D, WIN, D, ldp / 32, E); }
                if (l == 2) { SkKV E{out + O_SKS, out + O_SVS, SBKS, SBVS}; skinny_gemm(bid_, G_, FRESH_TID(), wave_, F.lds + RING_OFF, X + (size_t)MP * D, D, WIN + (size_t)NBQ * D, D, NKV / 32, E); } }
            { pg8::Gemm g{X, WIN, MP, ldp, D}; pg8::StaticOrder S; S.init(MP, ldp, G_, bid_); pg8::EpiBf16 E{PROJ, ldp};
              pg8::gemm_phase<pg8::EpiBf16, pg8::StaticOrder, true, true>(F.lds + RING_OFF, g, S, E, FRESH_TID()); }
            if (l == 2) { pg8::Gemm g{X, WIN + (size_t)NBQ * D, MP, NKV, D}; pg8::StaticOrder S; S.init(MP, NKV, G_, bid_);
              pg8::EpiKV E{out + O_SKP, out + O_SVP, out + O_SKS, out + O_SVS, KPB, VPB, SBKS, SBVS};
              pg8::gemm_phase<pg8::EpiKV, pg8::StaticOrder, true, true>(F.lds + RING_OFF, g, S, E, FRESH_TID()); }
            if (LA) { if (bid_ >= (G_ >> 1)) { SkBf16 E{PROJ, ldp}; skinny_gemm(bid_ - (G_ >> 1), G_ >> 1, FRESH_TID(), wave_, F.lds + RING_OFF, X + (size_t)MP * D, D, WIN, D, ldp / 32, E); } }
            else if (!(bid_ & 1))
            for (int skr = 0; skr < SK_REP; ++skr) { SkBf16 E{PROJ, ldp}; skinny_gemm(bid_, G_, FRESH_TID(), wave_, F.lds + RING_OFF, X + (size_t)MP * D, D, WIN, D, ldp / 32, E); }
            if (!(bid_ & 1))
            for (int skr = 0; skr < SK_REP; ++skr) if (l == 2) { SkKV E{out + O_SKS, out + O_SVS, SBKS, SBVS}; skinny_gemm(bid_, G_, FRESH_TID(), wave_, F.lds + RING_OFF, X + (size_t)MP * D, D, WIN + (size_t)NBQ * D, D, NKV / 32, E); }
        PHASE_END
        PHASE_BEGIN(LA, 3)
            gla_prep_intra(bid_, G_, tid, wave_, F.lds + RING_OFF, l, PROJ, w_gate_lr, b_gate, (unsigned char*)Y, OINT);
        PHASE_END
        PHASE_BEGIN(!LA, 11)
            {
                for (int sbr = 0; sbr < SB_REP; ++sbr)
                for (int u = gw_; u < 12288 + 96; u += NGW_) {
                    if (u < 12288) { const int bh = u >> 8, qb = u & 255, b = bh / 12, h = bh % 12, t0 = 32 * qb; const size_t qo = (size_t)(b * SEQ + t0) * D + h * 128;
                        sb_attn(lane, F.lds + RING_OFF + wave_ * 16384, KPB + (size_t)bh * SEQ * 128, 128, VPB + (size_t)bh * SEQ * 128, 0, PROJ + qo, NBQ, OCAT + qo, t0, 32); }
                    else { const int u2 = u - 12288, b = u2 / 12, h = u2 % 12; const size_t qo = (size_t)(MP + b * 16) * D + h * 128;
                        sb_attn(lane, F.lds + RING_OFF + wave_ * 16384, SBKS + (size_t)u2 * 2080 * 128, 128, SBVS + (size_t)u2 * 65 * 4096, 0, PROJ + qo, NBQ, OCAT + qo, 2048, 16); }
                }
            }
            __syncthreads();
            for (int wi = bid_; wi < 256 + 32; wi += G_) mem_attn_wg(wi, FRESH_TID(), wave_, F.lds + RING_OFF, l, PROJ, ldp, LA ? CQM : 1536, MEMK, MEMV, OCAT);
        PHASE_END
        PHASE_BEGIN(LA, 12)
            { const int mb = G_ > 144 ? bid_ - 144 : bid_, nmem = G_ > 144 ? G_ - 144 : G_;
              if (mb >= 0) for (int wi = mb; wi < 256 + 32; wi += nmem) mem_attn_wg(wi, FRESH_TID(), wave_, F.lds + RING_OFF, l, PROJ, ldp, CQM, MEMK, MEMV, OCAT); }
            for (int wc = bid_; wc < 144; wc += G_) gla_chain<1>(wc, FRESH_TID(), wave_, F.lds + RING_OFF, l, (const unsigned char*)Y, state_gla, OINT, out, (float*)WMEM, (float*)MEMX);
        PHASE_END
        PHASE_BEGIN(LA, 5)
            for (int wc = bid_; wc < 192 + 96; wc += G_) gla_chain<2>(wc, FRESH_TID(), wave_, F.lds + RING_OFF, l, (const unsigned char*)Y, state_gla, OINT, out, (float*)WMEM, (float*)MEMX, REP_CLS == 5 && rep_ == 0);
        PHASE_END
        PHASE_BEGIN(LA, 6)
            const float* gn = gla_norm_g + (size_t)l * 384;
            for (int row = gw_; row < MR; row += NGW_) {
                const float* op = OINT + (size_t)row * 1536 + 24 * lane; const bf16* gp = PROJ + (size_t)row * NA + CG + 24 * lane; const float* gnp = gn + 24 * (lane & 15);
                f32x4 ov[6]; v4u gv[3]; float ss = 0.f;
#pragma unroll
                for (int j = 0; j < 6; ++j) { ov[j] = *(const f32x4*)(op + 4 * j); ss += (ov[j].x * ov[j].x + ov[j].y * ov[j].y) + (ov[j].z * ov[j].z + ov[j].w * ov[j].w); }
#pragma unroll
                for (int j = 0; j < 3; ++j) gv[j] = *(const v4u*)(gp + 8 * j);
                ss += shx(ss, lane, 1); ss += shx(ss, lane, 2); ss += shx(ss, lane, 4); ss += shx(ss, lane, 8);
                const float r = 1.0f / sqrtf(ss * (1.0f / 384.0f) + RMS_EPS);
#pragma unroll
                for (int j = 0; j < 3; ++j) { const f32x4 n0 = *(const f32x4*)(gnp + 8 * j), n1 = *(const f32x4*)(gnp + 8 * j + 4); const f32x4 a = ov[2 * j], b = ov[2 * j + 1];
                    float gt[8]; gt[0] = pg8::bflo(gv[j].x); gt[1] = pg8::bfhi(gv[j].x); gt[2] = pg8::bflo(gv[j].y); gt[3] = pg8::bfhi(gv[j].y); gt[4] = pg8::bflo(gv[j].z); gt[5] = pg8::bfhi(gv[j].z); gt[6] = pg8::bflo(gv[j].w); gt[7] = pg8::bfhi(gv[j].w);
                    float o8[8];
#pragma unroll
                    for (int i = 0; i < 4; ++i) { o8[i] = a[i] * r * n0[i] * (gt[i] * __builtin_amdgcn_rcpf(1.0f + __expf(-gt[i]))); o8[4 + i] = b[i] * r * n1[i] * (gt[4 + i] * __builtin_amdgcn_rcpf(1.0f + __expf(-gt[4 + i]))); }
                    v4u o; o.x = pk2(o8[0], o8[1]); o.y = pk2(o8[2], o8[3]); o.z = pk2(o8[4], o8[5]); o.w = pk2(o8[6], o8[7]);
                    *(v4u*)(OCAT + (size_t)row * D + 24 * lane + 8 * j) = o; }
            }
        PHASE_END
        PHASE_BEGIN(true, 7)
            if (bid_ & 1) { SkRes Es{YB, X, DN_ALPHA}; skinny_gemm(bid_, G_, FRESH_TID(), wave_, F.lds + RING_OFF, OCAT + (size_t)MP * D, D, WO, D, D / 32, Es); }
            pg8::Gemm g{OCAT, WO, MP, D, D}; pg8::StaticOrder S; S.init(MP, D, G_, bid_); pg8::EpiRes E{YB, X, D, DN_ALPHA};
            pg8::gemm_phase<pg8::EpiRes, pg8::StaticOrder, true, true>(F.lds + RING_OFF, g, S, E, FRESH_TID());
            if (!(bid_ & 1))
            for (int skr = 0; skr < SK_REP; ++skr) { SkRes Es{YB, X, DN_ALPHA}; skinny_gemm(bid_, G_, FRESH_TID(), wave_, F.lds + RING_OFF, OCAT + (size_t)MP * D, D, WO, D, D / 32, Es); }
        PHASE_END
        PHASE_BEGIN(true, 8)
            const float* gg = ln1_g + (size_t)l * D; const float* bb = ln1_b + (size_t)l * D;
            for (int row = 2 * gw_; row < MR; row += 2 * NGW_) ln_two_rows<false>(lane, YB + (size_t)row * D, YB + (size_t)(row + 1) * D, gg, bb, X + (size_t)row * D, X + (size_t)(row + 1) * D, nullptr, nullptr);
        PHASE_END
        PHASE_BEGIN(true, 9)
            for (int dl = 0; dl < 3 * STAG * (bid_ >> 1 & 3); ++dl) __builtin_amdgcn_s_sleep(127);
            if (bid_ & 1) { SkSwiGLU Es{HB}; skinny_gemm(bid_, G_, FRESH_TID(), wave_, F.lds + RING_OFF, X + (size_t)MP * D, D, WFI, D, DFF / 16, Es); }
            pg8::Gemm g{X, WFI, MP, 2 * DFF, D}; pg8::StaticOrder S; S.init(MP, 2 * DFF, G_, bid_); pg8::EpiSwiGLU E{HB, DFF};
            pg8::gemm_phase<pg8::EpiSwiGLU, pg8::StaticOrder, true, true>(F.lds + RING_OFF, g, S, E, FRESH_TID());
            if (!(bid_ & 1))
            for (int skr = 0; skr < SK_REP; ++skr) { SkSwiGLU Es{HB}; skinny_gemm(bid_, G_, FRESH_TID(), wave_, F.lds + RING_OFF, X + (size_t)MP * D, D, WFI, D, DFF / 16, Es); }
        PHASE_END
        PHASE_BEGIN(true, 10)
            if (bid_ & 1) { SkRes Es{YB, X, DN_ALPHA}; skinny_gemm(bid_, G_, FRESH_TID(), wave_, F.lds + RING_OFF, HB + (size_t)MP * DFF, DFF, WFO, DFF, D / 32, Es); }
            pg8::Gemm g{HB, WFO, MP, D, DFF}; pg8::StaticOrder S; S.init(MP, D, G_, bid_); pg8::EpiRes E{YB, X, D, DN_ALPHA};
            pg8::gemm_phase<pg8::EpiRes, pg8::StaticOrder, true, true>(F.lds + RING_OFF, g, S, E, FRESH_TID());
            if (!(bid_ & 1))
            for (int skr = 0; skr < SK_REP; ++skr) { SkRes Es{YB, X, DN_ALPHA}; skinny_gemm(bid_, G_, FRESH_TID(), wave_, F.lds + RING_OFF, HB + (size_t)MP * DFF, DFF, WFO, DFF, D / 32, Es); }
        PHASE_END
        PHASE_BEGIN(true, 8)
            if (l < 3) CONVERT_WEIGHTS(l + 1);
            const float* gg = ln2_g + (size_t)l * D; const float* bb = ln2_b + (size_t)l * D;
            if (l == 3) { for (int row = 2 * gw_; row < MR; row += 2 * NGW_) { float* of = row < MP ? out + O_YP + (size_t)row * D : out + O_YS + (size_t)(row - MP) * D;
                ln_two_rows<true>(lane, YB + (size_t)row * D, YB + (size_t)(row + 1) * D, gg, bb, nullptr, nullptr, of, of + D); } }
            else for (int row = 2 * gw_; row < MR; row += 2 * NGW_) ln_two_rows<false>(lane, YB + (size_t)row * D, YB + (size_t)(row + 1) * D, gg, bb, X + (size_t)row * D, X + (size_t)(row + 1) * D, nullptr, nullptr);
        PHASE_END
    }
#if defined(DIAG_A)
    if (blockIdx.x == 0 && threadIdx.x == 0) { unsigned long long* dts = (unsigned long long*)(args.ws_ + 262144); dts[ph] = rt(); dts[63] = (unsigned long long)ph; }
#endif
#undef ws
#undef out
#undef X
#undef Y
#undef YB
#undef CONVERT_WEIGHTS
#undef PHASE_BEGIN
#undef PHASE_END
}

#if defined(DIAG_A)
__device__ const int diag_cls[40] = {0,0, 1,2,3,4,5,6,7,8,9,10,8, 1,2,3,4,5,6,7,8,9,10,8, 1,2,11,7,8,9,10,8, 1,2,11,7,8,9,10,8};
__global__ void diag_tail(float* o, const unsigned long long* dts) {
    __shared__ float dv[2];
    if (threadIdx.x == 0) { const int n = (int)dts[63]; unsigned long long sa = 0, sb = 0; for (int p = 0; p < n; ++p) { const unsigned long long d = dts[p + 1] - dts[p]; const int cl = diag_cls[p]; if (cl == DIAG_A) sa += d; if (cl == DIAG_B) sb += d; }
        dv[0] = (float)sa * 0.01f; dv[1] = (float)sb * 10.0f; }
    __syncthreads();
    for (int i = threadIdx.x; i < 262144; i += blockDim.x) o[O_YS + i] = dv[0];
    if (threadIdx.x == 0) o[O_YP] = dv[1];
}
#endif
#ifndef MK_PER_PHASE
#define MK_PER_PHASE 0
#endif
constexpr int N_PHASES = 2 + 2 * 10 + 2 * 7;
extern "C" void kernel_launch(void* const* d_in, const int* in_sizes, int n_in, void* d_out, int out_size, void* d_ws, size_t ws_size, hipStream_t stream) {
    static int grid = 0;
    if (grid == 0) {
        if (n_in != 22 || in_sizes[0] != MP * D || (size_t)out_size != O_END || ws_size < WS_END) { fprintf(stderr, "kernel_launch: unexpected shapes (n_in %d, in0 %d, out %d, ws %zu); nothing launched\n", n_in, n_in > 0 ? in_sizes[0] : -1, out_size, ws_size); grid = -1; return; }
        int dev = 0, cus = 0, per_cu = 0;
        if (hipGetDevice(&dev) != hipSuccess || hipDeviceGetAttribute(&cus, hipDeviceAttributeMultiprocessorCount, dev) != hipSuccess) { grid = -1; return; }
        if (hipFuncSetAttribute((const void*)mega, hipFuncAttributeMaxDynamicSharedMemorySize, LDS_BYTES) != hipSuccess) { fprintf(stderr, "kernel_launch: hipFuncSetAttribute failed\n"); grid = -1; return; }
        if (hipOccupancyMaxActiveBlocksPerMultiprocessor(&per_cu, (const void*)mega, NWAVES * 64, LDS_BYTES) != hipSuccess || per_cu < 1) fprintf(stderr, "kernel_launch: occupancy query reports %d\n", per_cu);
        (void)hipGetLastError();
        grid = cus;
    }
    if (grid < 0) return;
    if (hipMemsetAsync((char*)d_ws + WS_CTL, 0, CTL_ZERO_BYTES, stream) != hipSuccess) return;
    Args a{};
    for (int i = 0; i < 22; ++i) a.in[i] = (const float*)d_in[i];
    a.out_ = (float*)d_out; a.ws_ = (unsigned char*)d_ws;
#if MK_PER_PHASE
    for (int p = 0; p < N_PHASES; ++p) { a.ph_lo = p; a.ph_hi = p + 1; hipLaunchKernelGGL(mega, dim3(grid), dim3(NWAVES * 64), LDS_BYTES, stream, a); }
#else
    a.ph_lo = 0; a.ph_hi = N_PHASES; hipLaunchKernelGGL(mega, dim3(grid), dim3(NWAVES * 64), LDS_BYTES, stream, a);
#if defined(DIAG_A)
    hipLaunchKernelGGL(diag_tail, dim3(1), dim3(512), 0, stream, (float*)d_out, (const unsigned long long*)((unsigned char*)d_ws + 262144));
#endif
#endif
}
```

```cpp
#include <hip/hip_runtime.h>
#include <cstdio>
#include <cstdint>
namespace pg8 {
#define PG8_LAS __attribute__((address_space(3)))
typedef unsigned short bf16_t;
typedef short bf16x8 __attribute__((ext_vector_type(8)));
typedef float f32x4 __attribute__((ext_vector_type(4)));
typedef unsigned u32x4 __attribute__((ext_vector_type(4)));
constexpr int BM = 256, BK = 64, HALF = 128, HTB = HALF * BK * 2  , STAGE_BYTES = 8 * HTB, NXCD = 8, WGM = 8;

__host__ __device__ __forceinline__ int lds_byte(int r, int c) { const int st = (r >> 4) * 2 + (c >> 5), rr = r & 15, cc = c & 31, ob = rr * 64 + cc * 2; return st * 1024 + (ob ^ (((ob >> 9) & 1) << 5)); }
__host__ __device__ __forceinline__ void stage_rc(int b, int& R, int& C) { const int st = b / 1024, sb = b % 1024, swz = sb ^ (((sb >> 9) & 1) << 5); R = (st >> 1) * 16 + swz / 64; C = (st & 1) * 32 + (swz % 64) / 2; }
__host__ __device__ __forceinline__ int perm32(int rho) { const int n = rho >> 4, i = rho & 15; return 8 * (i >> 2) + 4 * n + (i & 3); }

struct Unit { int pm, pn; };
struct Gemm { const bf16_t* A; const bf16_t* Bt; int M, N, K; };

struct StaticOrder {
    int nM, nN, nwg, G, c;
    __host__ __device__ void init(int M, int N, int G_, int c_) { nM = M / BM; nN = N / BM; nwg = nM * nN; G = G_; c = c_; }
    __host__ __device__ bool next(int i, Unit& u) const {
        const long L = (long)i * G + c; if (L >= nwg) return false;
        int wgid = (int)L; { const int q = nwg / NXCD, r = nwg % NXCD, xcd = wgid % NXCD, off = wgid / NXCD; wgid = (xcd < r ? xcd * (q + 1) : r * (q + 1) + (xcd - r) * q) + off; }
        const int nig = WGM * nN, gid = wgid / nig, fm = gid * WGM, gsz = (nM - fm) < WGM ? (nM - fm) : WGM;
        u.pm = fm + ((wgid % nig) % gsz); u.pn = (wgid % nig) / gsz; return true;
    }
    __device__ __forceinline__ void a_ready(const Unit&) const {}
    __device__ __forceinline__ void done(const Unit&) const {}
};
__device__ __forceinline__ unsigned cvt_pk_bf16(float lo, float hi) { unsigned r; asm volatile("v_cvt_pk_bf16_f32 %0, %1, %2" : "=v"(r) : "v"(lo), "v"(hi)); return r; }
typedef float f32x2 __attribute__((ext_vector_type(2)));
typedef unsigned u32x2 __attribute__((ext_vector_type(2)));
__host__ __device__ __forceinline__ int vtf_d(int d) { return (d >> 5) * 1024 + (d & 31) * 8; }
__host__ __device__ __forceinline__ int vtf_k(int ks) { return (ks >> 4) * 512 + ((ks >> 2) & 1) * 256 + (ks & 3) + 4 * ((ks >> 3) & 1); }
__device__ __forceinline__ float bflo(unsigned w) { return __builtin_bit_cast(float, w << 16); }
__device__ __forceinline__ float bfhi(unsigned w) { return __builtin_bit_cast(float, w & 0xffff0000u); }
struct EpiBf16 {
    static constexpr bool PERM = true, AFTER_DRAIN = false;
    bf16_t* O; int ldc;
    __device__ __forceinline__ void operator()(const f32x4 (&acc)[2][2][4][2], const Unit& u, int wr, int wc, int fr, int fq) const {
        const int row0 = u.pm * BM + wr * 64 + fr, col0 = u.pn * BM + wc * 32 + 8 * fq;
#pragma unroll
        for (int ai = 0; ai < 2; ++ai)
#pragma unroll
            for (int m = 0; m < 4; ++m) { bf16_t* rowp = O + (size_t)(row0 + ai * HALF + m * 16) * ldc + col0;
#pragma unroll
                for (int bj = 0; bj < 2; ++bj) { const f32x4 v0 = acc[ai][bj][m][0], v1 = acc[ai][bj][m][1];
                    u32x4 w; w.x = cvt_pk_bf16(v0[0], v0[1]); w.y = cvt_pk_bf16(v0[2], v0[3]); w.z = cvt_pk_bf16(v1[0], v1[1]); w.w = cvt_pk_bf16(v1[2], v1[3]);
                    *(u32x4*)(rowp + bj * HALF) = w; } }
    }
};
struct EpiSwiGLU {
    static constexpr bool PERM = true, AFTER_DRAIN = false;
    bf16_t* Hh; int ldh;
    __device__ __forceinline__ float swi(float g, float up) const { return g * __builtin_amdgcn_rcpf(1.0f + __expf(-g)) * up; }
    __device__ __forceinline__ void operator()(const f32x4 (&acc)[2][2][4][2], const Unit& u, int wr, int wc, int fr, int fq) const {
        const int row0 = u.pm * BM + wr * 64 + fr, col0 = u.pn * HALF + wc * 32 + 8 * fq;
#pragma unroll
        for (int ai = 0; ai < 2; ++ai)
#pragma unroll
            for (int m = 0; m < 4; ++m) { bf16_t* rowp = Hh + (size_t)(row0 + ai * HALF + m * 16) * ldh + col0;
                const f32x4 g0 = acc[ai][0][m][0], g1 = acc[ai][0][m][1], u0 = acc[ai][1][m][0], u1 = acc[ai][1][m][1];
                u32x4 w; w.x = cvt_pk_bf16(swi(g0[0], u0[0]), swi(g0[1], u0[1])); w.y = cvt_pk_bf16(swi(g0[2], u0[2]), swi(g0[3], u0[3]));
                w.z = cvt_pk_bf16(swi(g1[0], u1[0]), swi(g1[1], u1[1])); w.w = cvt_pk_bf16(swi(g1[2], u1[2]), swi(g1[3], u1[3]));
                *(u32x4*)rowp = w; }
    }
};
struct EpiRes {
    static constexpr bool PERM = true, AFTER_DRAIN = false;
    bf16_t* Y; const bf16_t* X; int ldc; float alpha;
    __device__ __forceinline__ void operator()(const f32x4 (&acc)[2][2][4][2], const Unit& u, int wr, int wc, int fr, int fq) const {
        const int row0 = u.pm * BM + wr * 64 + fr, col0 = u.pn * BM + wc * 32 + 8 * fq;
        u32x4 xv[2][4][2];
#pragma unroll
        for (int ai = 0; ai < 2; ++ai)
#pragma unroll
            for (int m = 0; m < 4; ++m)
#pragma unroll
                for (int bj = 0; bj < 2; ++bj) xv[ai][m][bj] = *(const u32x4*)(X + (size_t)(row0 + ai * HALF + m * 16) * ldc + col0 + bj * HALF);
#pragma unroll
        for (int ai = 0; ai < 2; ++ai)
#pragma unroll
            for (int m = 0; m < 4; ++m) { const size_t ro = (size_t)(row0 + ai * HALF + m * 16) * ldc + col0;
#pragma unroll
                for (int bj = 0; bj < 2; ++bj) { const u32x4 x4 = xv[ai][m][bj]; const f32x4 a0 = acc[ai][bj][m][0], a1 = acc[ai][bj][m][1];
                    u32x4 w; w.x = cvt_pk_bf16(alpha * bflo(x4.x) + a0[0], alpha * bfhi(x4.x) + a0[1]); w.y = cvt_pk_bf16(alpha * bflo(x4.y) + a0[2], alpha * bfhi(x4.y) + a0[3]);
                    w.z = cvt_pk_bf16(alpha * bflo(x4.z) + a1[0], alpha * bfhi(x4.z) + a1[1]); w.w = cvt_pk_bf16(alpha * bflo(x4.w) + a1[2], alpha * bfhi(x4.w) + a1[3]);
                    *(u32x4*)(Y + ro + bj * HALF) = w; } }
    }
};
struct EpiKV {
    static constexpr bool PERM = false, AFTER_DRAIN = false;
    float *okp, *ovp, *oks, *ovs; bf16_t *kpb, *vpb, *ksb, *vsb;
    __device__ __forceinline__ void operator()(const f32x4 (&acc)[2][2][4][2], const Unit& u, int wr, int wc, int fr, int fq) const {
        const bool isv = u.pn >= 6; const int colt = (u.pn - (isv ? 6 : 0)) * BM + wc * 32 + 4 * fq, row0 = u.pm * BM + wr * 64 + fr;
        float* op = isv ? ovp : okp;
#pragma unroll
        for (int ai = 0; ai < 2; ++ai)
#pragma unroll
            for (int m = 0; m < 4; ++m) { const int row = row0 + ai * HALF + m * 16; float* fd;
                if (row < 32768) { fd = op + (size_t)row * 1536; } else continue;
                const int bq = row >> 13, sq = row & 8191;
#pragma unroll
                for (int bj = 0; bj < 2; ++bj)
#pragma unroll
                    for (int n = 0; n < 2; ++n) { const int c = colt + bj * HALF + n * 16; const f32x4 v = acc[ai][bj][m][n];
                        *(f32x4*)(fd + c) = v; const unsigned w0 = cvt_pk_bf16(v[0], v[1]), w1 = cvt_pk_bf16(v[2], v[3]);
                        const int hq = c >> 7, dq = c & 127;
                        if (!isv) { u32x2 w; w.x = w0; w.y = w1; *(u32x2*)(kpb + ((size_t)(bq * 12 + hq) * 8192 + sq) * 128 + dq) = w; }
                        else { bf16_t* vt = vpb + ((size_t)(bq * 12 + hq) * 256 + (sq >> 5)) * 4096 + vtf_d(dq) + vtf_k(sq & 31); vt[0] = (bf16_t)w0; vt[8] = (bf16_t)(w0 >> 16); vt[16] = (bf16_t)w1; vt[24] = (bf16_t)(w1 >> 16); } } }
    }
};
struct EpiMemKV {
    static constexpr bool PERM = false, AFTER_DRAIN = false;
    float *ok, *ov; bf16_t *kb, *vb;
    __device__ __forceinline__ void operator()(const f32x4 (&acc)[2][2][4][2], const Unit& u, int wr, int wc, int fr, int fq) const {
        const int l = u.pn >> 2, kv = (u.pn >> 1) & 1, hd0 = (u.pn & 1) * BM + wc * 32 + 4 * fq, row0 = u.pm * BM + wr * 64 + fr;
        float* fo = kv ? ov : ok; bf16_t* bo = kv ? vb : kb;
#pragma unroll
        for (int ai = 0; ai < 2; ++ai)
#pragma unroll
            for (int m = 0; m < 4; ++m) { const int row = row0 + ai * HALF + m * 16, b = row >> 8, mm = row & 255;
                float* fd = fo + (size_t)(l * 1024 + row) * 512; bf16_t* bd = bo + (size_t)((l * 12 + b) * 256 + mm) * 512;
#pragma unroll
                for (int bj = 0; bj < 2; ++bj)
#pragma unroll
                    for (int n = 0; n < 2; ++n) { const int c = hd0 + bj * HALF + n * 16; const f32x4 v = acc[ai][bj][m][n];
                        *(f32x4*)(fd + c) = v; const unsigned w0 = cvt_pk_bf16(v[0], v[1]), w1 = cvt_pk_bf16(v[2], v[3]);
                        if (!kv) { u32x2 w; w.x = w0; w.y = w1; *(u32x2*)(bd + c) = w; }
                        else { bf16_t* vt = vb + (size_t)((l * 12 + b) * 512 + c) * 256 + mm;
                            vt[0] = (bf16_t)w0; vt[256] = (bf16_t)(w0 >> 16); vt[512] = (bf16_t)w1; vt[768] = (bf16_t)(w1 >> 16); } } }
    }
};
template <class Epi, class Sched, bool ALIGN_EPI = false, bool SP2 = false>
__device__ __forceinline__ void gemm_phase(PG8_LAS unsigned char* lds, const Gemm g, const Sched& S, const Epi& E, int tid_in) {
    int tid_ = tid_in; asm volatile("" : "+v"(tid_));
    const int tid = tid_, wid = __builtin_amdgcn_readfirstlane(tid >> 6), lane = tid & 63, wr = wid >> 2, wc = wid & 3, fr = lane & 15, fq = lane >> 4;
    const int K = g.K, nt = K / BK;
    unsigned voffA[2], voffB[2];
#pragma unroll
    for (int i = 0; i < 2; ++i) { int R, C; stage_rc(tid * 16 + i * 8192, R, C); const int Rb = Epi::PERM ? ((R & ~31) + perm32(R & 31)) : R;
        voffA[i] = (unsigned)(R * K + C) * 2u; voffB[i] = (unsigned)(Rb * K + C) * 2u; }
    const size_t kstep = (size_t)(BK * 2);
    const size_t hstep = (size_t)HALF * K * 2;
    const size_t tstep = 2 * hstep;
    const unsigned ldsw = (unsigned)wid * 1024u;
    const int aoff = lds_byte(wr * 64 + fr, fq * 8), boff = lds_byte(wc * 32 + fr, fq * 8);
#define PG8_SA(b, h) (((b) * 2 + (h)) * HTB)
#define PG8_SB(b, h) ((4 + (b) * 2 + (h)) * HTB)
#define PG8_STAGE(bufoff, gbase, voff) do { _Pragma("unroll") for (int _i = 0; _i < 2; ++_i) \
        __builtin_amdgcn_global_load_lds((const unsigned*)((const char*)(gbase) + (voff)[_i]), (PG8_LAS unsigned*)(lds + (bufoff) + ldsw + _i * 8192), 16, 0, 0); } while (0)
#define PG8_LDA(dst, b, h) do { _Pragma("unroll") for (int m = 0; m < 4; ++m) _Pragma("unroll") for (int k = 0; k < 2; ++k) dst[m][k] = *(const PG8_LAS bf16x8*)(lds + PG8_SA(b, h) + aoff + m * 2048 + k * 1024); } while (0)
#define PG8_LDB(dst, b, h) do { _Pragma("unroll") for (int n = 0; n < 2; ++n) _Pragma("unroll") for (int k = 0; k < 2; ++k) dst[n][k] = *(const PG8_LAS bf16x8*)(lds + PG8_SB(b, h) + boff + n * 2048 + k * 1024); } while (0)
#define PG8_MMA(ai, bj, At, Bt) do { __builtin_amdgcn_s_setprio(1); _Pragma("unroll") for (int m = 0; m < 4; ++m) _Pragma("unroll") for (int n = 0; n < 2; ++n) _Pragma("unroll") for (int k = 0; k < 2; ++k) \
        acc[ai][bj][m][n] = __builtin_amdgcn_mfma_f32_16x16x32_bf16(Bt[n][k], At[m][k], acc[ai][bj][m][n], 0, 0, 0); __builtin_amdgcn_s_setprio(0); } while (0)
#define PG8_WAIT_V(n) asm volatile("s_waitcnt vmcnt(" #n ")" ::: "memory")
#define PG8_WAIT_L(n) asm volatile("s_waitcnt lgkmcnt(" #n ")" ::: "memory")
#define PG8_BAR __builtin_amdgcn_s_barrier()
#define PG8_SCHED __builtin_amdgcn_sched_barrier(0)
    Unit cur, nxt; int ui = 0;
    if (!S.next(0, cur)) return;
    f32x4 acc[2][2][4][2];
#pragma unroll
    for (int a = 0; a < 2; ++a)
#pragma unroll
        for (int b = 0; b < 2; ++b)
#pragma unroll
            for (int m = 0; m < 4; ++m)
#pragma unroll
                for (int n = 0; n < 2; ++n) acc[a][b][m][n] = (f32x4){0.f, 0.f, 0.f, 0.f};
    bf16x8 At[4][2], B0[2][2], B1[2][2];
    const char* cA = (const char*)g.A + (size_t)cur.pm * tstep; const char* cB = (const char*)g.Bt + (size_t)cur.pn * tstep;
    S.a_ready(cur);
    if constexpr (SP2) {
        PG8_STAGE(PG8_SB(0, 0), cB, voffB); PG8_STAGE(PG8_SB(0, 1), cB + hstep, voffB); PG8_STAGE(PG8_SA(0, 0), cA, voffA); PG8_STAGE(PG8_SA(0, 1), cA + hstep, voffA);
        if (wr == 1) PG8_BAR;
        PG8_WAIT_V(2); PG8_BAR;
        PG8_STAGE(PG8_SB(1, 0), cB + kstep, voffB); PG8_STAGE(PG8_SA(1, 0), cA + kstep, voffA); PG8_STAGE(PG8_SB(1, 1), cB + hstep + kstep, voffB);
        PG8_WAIT_V(6); PG8_BAR;
    } else {
        PG8_STAGE(PG8_SB(0, 0), cB, voffB); PG8_STAGE(PG8_SA(0, 0), cA, voffA); PG8_STAGE(PG8_SB(0, 1), cB + hstep, voffB); PG8_STAGE(PG8_SA(0, 1), cA + hstep, voffA);
        if (wr == 1) PG8_BAR;
        PG8_WAIT_V(4); PG8_BAR;
        PG8_STAGE(PG8_SB(1, 0), cB + kstep, voffB); PG8_STAGE(PG8_SA(1, 0), cA + kstep, voffA); PG8_STAGE(PG8_SB(1, 1), cB + hstep + kstep, voffB);
        PG8_WAIT_V(6); PG8_BAR;
    }
    for (;;) {
        const bool has_next = S.next(ui + 1, nxt);
        const char* nA = has_next ? (const char*)g.A + (size_t)nxt.pm * tstep : cA; const char* nB = has_next ? (const char*)g.Bt + (size_t)nxt.pn * tstep : cB;
        for (int t = 0; t < nt; t += 2) {
            const bool last = (t == nt - 2);
            const char* a1 = cA + (size_t)(t + 1) * kstep;
            const char* a2 = last ? nA : cA + (size_t)(t + 2) * kstep; const char* b2 = last ? nB : cB + (size_t)(t + 2) * kstep;
            const char* a3 = a2 + kstep; const char* b3 = b2 + kstep;
            if (last && has_next) S.a_ready(nxt);
            if constexpr (SP2) {
            PG8_LDB(B0, 0, 0); PG8_LDB(B1, 0, 1); PG8_SCHED; PG8_LDA(At, 0, 0); PG8_STAGE(PG8_SA(1, 1), a1 + hstep, voffA);
            PG8_WAIT_V(8); PG8_WAIT_L(0); PG8_BAR; PG8_MMA(0, 0, At, B0); PG8_MMA(0, 1, At, B1); PG8_BAR; PG8_SCHED;
            PG8_LDA(At, 0, 1); PG8_STAGE(PG8_SB(0, 0), b2, voffB); PG8_STAGE(PG8_SB(0, 1), b2 + hstep, voffB); PG8_STAGE(PG8_SA(0, 0), a2, voffA);
            PG8_WAIT_V(8); PG8_WAIT_L(0); PG8_BAR; PG8_MMA(1, 0, At, B0); PG8_MMA(1, 1, At, B1); PG8_BAR; PG8_SCHED;
            PG8_LDB(B0, 1, 0); PG8_LDB(B1, 1, 1); PG8_SCHED; PG8_LDA(At, 1, 0); PG8_STAGE(PG8_SA(0, 1), a2 + hstep, voffA);
            PG8_WAIT_V(8); PG8_WAIT_L(0); PG8_BAR; PG8_MMA(0, 0, At, B0); PG8_MMA(0, 1, At, B1); PG8_BAR; PG8_SCHED;
            PG8_LDA(At, 1, 1); PG8_STAGE(PG8_SB(1, 0), b3, voffB); PG8_STAGE(PG8_SB(1, 1), b3 + hstep, voffB); PG8_STAGE(PG8_SA(1, 0), a3, voffA);
            PG8_WAIT_V(8); PG8_WAIT_L(0); PG8_BAR; PG8_MMA(1, 0, At, B0); PG8_MMA(1, 1, At, B1); PG8_BAR; PG8_SCHED;
            } else {
            PG8_LDB(B0, 0, 0); PG8_SCHED; PG8_LDA(At, 0, 0); PG8_STAGE(PG8_SA(1, 1), a1 + hstep, voffA);
            PG8_WAIT_L(8); PG8_BAR; PG8_WAIT_L(0); PG8_MMA(0, 0, At, B0); PG8_BAR; PG8_SCHED;
            PG8_LDB(B1, 0, 1); PG8_STAGE(PG8_SB(0, 0), b2, voffB);
            PG8_BAR; PG8_WAIT_L(0); PG8_MMA(0, 1, At, B1); PG8_BAR;
            PG8_LDA(At, 0, 1); PG8_STAGE(PG8_SA(0, 0), a2, voffA);
            PG8_BAR; PG8_WAIT_L(0); PG8_MMA(1, 0, At, B0); PG8_BAR; PG8_SCHED;
            PG8_STAGE(PG8_SB(0, 1), b2 + hstep, voffB);
            PG8_WAIT_V(6); PG8_BAR; PG8_MMA(1, 1, At, B1); PG8_BAR;
            PG8_LDB(B0, 1, 0); PG8_SCHED; PG8_LDA(At, 1, 0); PG8_STAGE(PG8_SA(0, 1), a2 + hstep, voffA);
            PG8_WAIT_L(8); PG8_BAR; PG8_WAIT_L(0); PG8_MMA(0, 0, At, B0); PG8_BAR; PG8_SCHED;
            PG8_LDB(B1, 1, 1); PG8_STAGE(PG8_SB(1, 0), b3, voffB);
            PG8_BAR; PG8_WAIT_L(0); PG8_MMA(0, 1, At, B1); PG8_BAR;
            PG8_LDA(At, 1, 1); PG8_STAGE(PG8_SA(1, 0), a3, voffA);
            PG8_BAR; PG8_WAIT_L(0); PG8_MMA(1, 0, At, B0); PG8_BAR; PG8_SCHED;
            PG8_STAGE(PG8_SB(1, 1), b3 + hstep, voffB);
            PG8_WAIT_V(6); PG8_BAR; PG8_MMA(1, 1, At, B1); PG8_BAR;
            }
        }
        if constexpr (ALIGN_EPI) { if (wr == 0) PG8_BAR; }
        if constexpr (!Epi::AFTER_DRAIN) { E(acc, cur, wr, wc, fr, fq); S.done(cur); }
        if (!has_next) break;
#pragma unroll
        for (int a = 0; a < 2; ++a)
#pragma unroll
            for (int b = 0; b < 2; ++b)
#pragma unroll
                for (int m = 0; m < 4; ++m)
#pragma unroll
                    for (int n = 0; n < 2; ++n) acc[a][b][m][n] = (f32x4){0.f, 0.f, 0.f, 0.f};
        cur = nxt; cA = nA; cB = nB; ++ui;
        if constexpr (ALIGN_EPI) { if (wr == 1) PG8_BAR; }
    }
    PG8_WAIT_V(0);
    if constexpr (!ALIGN_EPI) { if (wr == 0) PG8_BAR; }
    PG8_BAR;
    if constexpr (Epi::AFTER_DRAIN) { E.fused(acc, cur, wr, wc, fr, fq, lds, wid, lane); S.done(cur); }
#undef PG8_SA
#undef PG8_SB
#undef PG8_STAGE
#undef PG8_LDA
#undef PG8_LDB
#undef PG8_MMA
#undef PG8_WAIT_V
#undef PG8_WAIT_L
#undef PG8_BAR
#undef PG8_SCHED
}
}
#define GAS __attribute__((address_space(1)))
#define LAS __attribute__((address_space(3)))
typedef unsigned short bf16;
typedef unsigned v4u __attribute__((ext_vector_type(4)));
typedef float f32x4 __attribute__((ext_vector_type(4)));
typedef short bf16x8 __attribute__((ext_vector_type(8)));
typedef GAS unsigned gu32;
typedef GAS unsigned long long gu64;
#define RLX_AGENT __ATOMIC_RELAXED, __HIP_MEMORY_SCOPE_AGENT
#define LDS_WAIT() asm volatile("s_waitcnt lgkmcnt(0)" ::: "memory")
#define VM_WAIT() asm volatile("s_waitcnt vmcnt(0)" ::: "memory")
__device__ __forceinline__ unsigned long long rt() { return __builtin_amdgcn_s_memrealtime(); }
__device__ __forceinline__ unsigned f2bf(float f) { unsigned u = __builtin_bit_cast(unsigned, f); return (u + 0x7fffu + ((u >> 16) & 1u)) >> 16; }
__device__ __forceinline__ unsigned pk2(float lo, float hi) { return f2bf(lo) | (f2bf(hi) << 16); }
#define XB_TMO      128
#define XB_XCNT(j)  (256  + 64 * (j))
#define XB_XSUB(j)  (1280 + 64 * (j))
#define XB_XGEN(j)  (2304 + 64 * (j))
#define XB_TOP      3328
#define XB_TOPGEN   3392
#define XCD_BAR_WORDS 3456
#define XB_SPIN_CAP (1u << 18)

__device__ __forceinline__ unsigned xb_ld(unsigned* p)              { return __hip_atomic_load(p, __ATOMIC_RELAXED, __HIP_MEMORY_SCOPE_AGENT); }
__device__ __forceinline__ unsigned xb_add(unsigned* p, unsigned v) { return __hip_atomic_fetch_add(p, v, __ATOMIC_RELAXED, __HIP_MEMORY_SCOPE_AGENT); }
__device__ __forceinline__ unsigned xb_xcc_id() { return (unsigned)__builtin_amdgcn_s_getreg((3 << 11) | 20) & 0xFu; }
#define XB_SPIN(cond, bar) do { unsigned _sp = 0; while (cond) { __builtin_amdgcn_s_sleep(1); \
    if ((++_sp & 255u) == 0u) { if (xb_ld(&(bar)[XB_TMO])) break; if (_sp > XB_SPIN_CAP) { atomicAdd(&(bar)[XB_TMO], 1u); break; } } } } while (0)

struct XcdBarrier {
    unsigned* bar; unsigned x;
    volatile LAS unsigned* st;
};

__device__ __forceinline__ XcdBarrier xcd_barrier_post(unsigned* bar, volatile LAS unsigned* st) {
    XcdBarrier b; b.bar = bar; b.x = xb_xcc_id(); b.st = st;
    if (threadIdx.x == 0) (void)xb_add(&bar[XB_XCNT(b.x)], 1u);
    return b;
}
__device__ __forceinline__ void xcd_barrier_complete(unsigned* bar, unsigned x, unsigned& nloc, unsigned& nx) {
    const unsigned G = gridDim.x * gridDim.y * gridDim.z;
    unsigned sum, cnt, mine, sp = 0u;
    for (;;) {
        sum = 0u; cnt = 0u; mine = 0u;
#pragma unroll
        for (unsigned j = 0; j < 16; ++j) { const unsigned c = xb_ld(&bar[XB_XCNT(j)]); sum += c; cnt += (c > 0u) ? 1u : 0u; mine = (j == x) ? c : mine; }
        if (sum == G) break;
        __builtin_amdgcn_s_sleep(1);
        if ((++sp & 255u) == 0u) { if (xb_ld(&bar[XB_TMO])) break; if (sp > XB_SPIN_CAP) { atomicAdd(&bar[XB_TMO], 1u); break; } }
    }
    nloc = mine > 0u ? mine : 1u; nx = cnt > 0u ? cnt : 1u;
}

__device__ __forceinline__ void xcd_barrier(const XcdBarrier& b) {
    asm volatile("s_waitcnt vmcnt(0)" ::: "memory");
    __syncthreads();
    if (threadIdx.x == 0) {
        unsigned* bar = b.bar;
        __builtin_amdgcn_s_waitcnt(0);
        unsigned nloc = b.st[0], nx = b.st[1];
        if (nloc == 0u) { xcd_barrier_complete(bar, b.x, nloc, nx); b.st[0] = nloc; b.st[1] = nx; }
        const unsigned old = xb_add(&bar[XB_XSUB(b.x)], 1u);
        const unsigned gen = old / nloc;
        if (old + 1u == (gen + 1u) * nloc) {
            __builtin_amdgcn_fence(__ATOMIC_RELEASE, "agent");
            asm volatile("s_waitcnt vmcnt(0)" ::: "memory");
            const unsigned og = xb_add(&bar[XB_TOP], 1u);
            const unsigned tg = og / nx;
            if (og + 1u == (tg + 1u) * nx) xb_add(&bar[XB_TOPGEN], 1u);
            else XB_SPIN(xb_ld(&bar[XB_TOPGEN]) == tg, bar);
            __builtin_amdgcn_fence(__ATOMIC_ACQUIRE, "agent");
            xb_add(&bar[XB_XGEN(b.x)], 1u);
            asm volatile("s_waitcnt vmcnt(0)" ::: "memory");
        } else {
            XB_SPIN(xb_ld(&bar[XB_XGEN(b.x)]) == gen, bar);
            __builtin_amdgcn_fence(__ATOMIC_ACQUIRE, "agent");
            asm volatile("s_waitcnt vmcnt(0)" ::: "memory");
        }
    }
    __syncthreads();
}
constexpr int NWAVES = 8;
constexpr int D = 2048, SEQ = 8192, MP = 32768, MS = 128, MR = 32896, MT = 33024;
constexpr int DFF = 5632, NA = 5376, NBQ = 2048, NKV = 3072;
constexpr int CQ = 0, CK = 768, CV = 1536, CG = 3072, CQM = 4608, CLR = 5120;
constexpr float DN_ALPHA = 1.6817928305074292f, LN_EPS = 1e-5f, RMS_EPS = 1e-6f;
constexpr float GLA_QSCALE = 0.07216878364870323f, HD_SCALE = 0.08838834764831845f;
constexpr size_t MiB = 1u << 20;
constexpr size_t WS_CTL = 0, CTL_ZERO_BYTES = 1 * MiB;
constexpr size_t WS_WIN = 1 * MiB, WS_WO = 22 * MiB, WS_WFI = 30 * MiB, WS_WFO = 74 * MiB, WS_WMEM = 96 * MiB, WS_MEMX = 112 * MiB, WS_MEMK = 116 * MiB, WS_MEMV = 128 * MiB;
constexpr size_t WS_X = 140 * MiB, WS_Y = 269 * MiB, WS_R1 = 527 * MiB, WS_OCAT = 882 * MiB, WS_SBKS = 1011 * MiB, WS_SBVS = 1060 * MiB, WS_END = 1109 * MiB;
static_assert(WS_WIN + (size_t)NA * D * 2 <= WS_WO && WS_WFI + (size_t)2 * DFF * D * 2 <= WS_WFO && WS_WFO + (size_t)D * DFF * 2 <= WS_WMEM, "weights map");
static_assert(WS_X + (size_t)MT * D * 2 <= WS_Y && WS_Y + (size_t)MT * D * 4 <= WS_R1 && WS_R1 + (size_t)MT * DFF * 2 <= WS_OCAT && WS_OCAT + (size_t)MT * D * 2 <= WS_SBKS, "activation map");
static_assert(WS_SBKS + (size_t)8 * 2064 * 1536 * 2 <= WS_SBVS && WS_SBVS + (size_t)8 * 2064 * 1536 * 2 <= WS_END, "sb sample map");
constexpr size_t O_YP = 0, O_YS = 67108864, O_GSP = 67371008, O_GSS = 69730304, O_SKP = 74448896, O_SVP = 124780544, O_SKS = 175112192, O_SVS = 175308800, O_MKP = 175505408, O_MVP = 177602560, O_END = 179699712;
constexpr int CW_BAR = 4096;
constexpr int RING_OFF = 0, RING_BYTES = 131072, LDSCTL_OFF = RING_BYTES, MISC_OFF = LDSCTL_OFF + 320, LDS_BYTES = 147456;

struct Args { const float* in[22]; float* out_; unsigned char* ws_; int ph_lo, ph_hi; };
struct Frame {
    LAS unsigned char* lds; volatile LAS unsigned* MISC; gu32* ctl;
    int tid, lane, wave, G, gw, NGW;
};
__device__ __forceinline__ float bf2f(bf16 h) { return __builtin_bit_cast(float, (unsigned)h << 16); }
__device__ __forceinline__ float shx(float v, int lane, int m) { return __builtin_bit_cast(float, __builtin_amdgcn_ds_bpermute((lane ^ m) << 2, __builtin_bit_cast(int, v))); }
__device__ __forceinline__ float wave_sum(float v, int lane) {
#pragma unroll
    for (int o = 1; o < 64; o <<= 1) v += shx(v, lane, o);
    return v;
}
__device__ __forceinline__ float wave_max(float v, int lane) {
#pragma unroll
    for (int o = 1; o < 64; o <<= 1) v = fmaxf(v, shx(v, lane, o));
    return v;
}
__device__ __forceinline__ void cvt_row(const float* src, bf16* dst, int n, int lane) {
    for (int j = lane * 4; j < n; j += 256) {
        f32x4 v = src ? *(const f32x4*)(src + j) : (f32x4){0.f, 0.f, 0.f, 0.f};
        unsigned long long w = (unsigned long long)pk2(v.x, v.y) | ((unsigned long long)pk2(v.z, v.w) << 32);
        *(unsigned long long*)(dst + j) = w;
    }
}
__device__ __forceinline__ int fresh_lane() { int z = 0; asm volatile("" : "+s"(z)); return (int)__builtin_amdgcn_mbcnt_hi(~0u, __builtin_amdgcn_mbcnt_lo(~0u, (unsigned)z)); }
#define FRESH_TID() (wave_ * 64 + fresh_lane())
template <bool FINAL>
__device__ __forceinline__ void ln_two_rows(int lane, const bf16* y0, const bf16* y1, const float* gg, const float* bb, bf16* x0, bf16* x1, float* of0, float* of1) {
    v4u w[2][4];
#pragma unroll
    for (int j = 0; j < 4; ++j) { w[0][j] = ((const v4u*)y0)[lane + 64 * j]; w[1][j] = ((const v4u*)y1)[lane + 64 * j]; }
    float v[2][4][8]; float s[2] = {0.f, 0.f};
#pragma unroll
    for (int r = 0; r < 2; ++r)
#pragma unroll
        for (int j = 0; j < 4; ++j) { const v4u q = w[r][j]; v[r][j][0] = pg8::bflo(q.x); v[r][j][1] = pg8::bfhi(q.x); v[r][j][2] = pg8::bflo(q.y); v[r][j][3] = pg8::bfhi(q.y); v[r][j][4] = pg8::bflo(q.z); v[r][j][5] = pg8::bfhi(q.z); v[r][j][6] = pg8::bflo(q.w); v[r][j][7] = pg8::bfhi(q.w);
            s[r] += ((v[r][j][0] + v[r][j][1]) + (v[r][j][2] + v[r][j][3])) + ((v[r][j][4] + v[r][j][5]) + (v[r][j][6] + v[r][j][7])); }
    const float m0 = wave_sum(s[0], lane) * (1.f / D), m1 = wave_sum(s[1], lane) * (1.f / D); float q0 = 0.f, q1 = 0.f;
#pragma unroll
    for (int j = 0; j < 4; ++j)
#pragma unroll
        for (int i = 0; i < 8; ++i) { v[0][j][i] -= m0; q0 += v[0][j][i] * v[0][j][i]; v[1][j][i] -= m1; q1 += v[1][j][i] * v[1][j][i]; }
    const float rs[2] = {1.f / sqrtf(wave_sum(q0, lane) * (1.f / D) + LN_EPS), 1.f / sqrtf(wave_sum(q1, lane) * (1.f / D) + LN_EPS)};
#pragma unroll
    for (int j = 0; j < 4; ++j) { const int e0 = (lane + 64 * j) * 8; const f32x4 g0 = *(const f32x4*)(gg + e0), g1 = *(const f32x4*)(gg + e0 + 4), b0 = *(const f32x4*)(bb + e0), b1 = *(const f32x4*)(bb + e0 + 4);
#pragma unroll
        for (int r = 0; r < 2; ++r) { float o[8];
#pragma unroll
            for (int i = 0; i < 4; ++i) { o[i] = v[r][j][i] * rs[r] * g0[i] + b0[i]; o[4 + i] = v[r][j][4 + i] * rs[r] * g1[i] + b1[i]; }
            if (FINAL) { float* of = r ? of1 : of0; *(f32x4*)(of + e0) = (f32x4){o[0], o[1], o[2], o[3]}; *(f32x4*)(of + e0 + 4) = (f32x4){o[4], o[5], o[6], o[7]}; }
            else { v4u p; p.x = pk2(o[0], o[1]); p.y = pk2(o[2], o[3]); p.z = pk2(o[4], o[5]); p.w = pk2(o[6], o[7]); *(v4u*)((r ? x1 : x0) + e0) = p; } } }
}
struct MapId { __device__ __forceinline__ int operator()(int n) const { return n; } };
struct MapInA { __device__ __forceinline__ int operator()(int n) const { return n < 4608 ? n : (n < 5120 ? n + 16 : (n < 5136 ? n - 512 : -1)); } };
struct MapFfn { __device__ __forceinline__ int operator()(int n) const { const int t = n >> 8, r = n & 255; return r < 128 ? 128 * t + r : DFF + 128 * t + (r - 128); } };
template <class Map>
__device__ __forceinline__ void wt_convert(LAS unsigned char* ldsb, int wave, int gw, int NGW, int lane, const float* W, int K, int Nsrc, bf16* WT, int Ndst, Map map) {
    LAS float* scr = (LAS float*)(ldsb + RING_OFF + wave * 16384);
    const int nblk = Ndst / 64, nitems = (K / 64) * nblk, nq = lane & 15, kq = lane >> 4;
    for (int it = gw; it < nitems; it += NGW) {
        const int kb = it / nblk, nb = it % nblk, k0 = 64 * kb, n0 = 64 * nb;
        const int sc0 = map(n0 + 4 * nq), sc3 = map(n0 + 4 * nq + 3);
        const bool contig = sc0 >= 0 && sc3 == sc0 + 3;
        f32x4 v[16];
#pragma unroll
        for (int i = 0; i < 16; ++i) { const int kk = 4 * i + kq;
            if (contig) v[i] = *(const f32x4*)(W + (size_t)(k0 + kk) * Nsrc + sc0);
            else {
#pragma unroll
                for (int e = 0; e < 4; ++e) { const int sc = map(n0 + 4 * nq + e); v[i][e] = sc >= 0 ? W[(size_t)(k0 + kk) * Nsrc + sc] : 0.f; } } }
#pragma unroll
        for (int i = 0; i < 16; ++i) { const int kk = 4 * i + kq;
#pragma unroll
            for (int e = 0; e < 4; ++e) { const int n = 4 * nq + e; scr[n * 64 + (kk ^ n)] = v[i][e]; } }
        LDS_WAIT(); asm volatile("" ::: "memory");
        const int c = lane & 7;
#pragma unroll
        for (int j = 0; j < 8; ++j) { const int n = (lane >> 3) + 8 * j; const LAS float* s = scr + n * 64;
#define SWZ(i) s[(8 * c + (i)) ^ n]
            v4u o; o.x = pk2(SWZ(0), SWZ(1)); o.y = pk2(SWZ(2), SWZ(3)); o.z = pk2(SWZ(4), SWZ(5)); o.w = pk2(SWZ(6), SWZ(7));
#undef SWZ
            *(GAS v4u*)(WT + (size_t)(n0 + n) * K + k0 + 8 * c) = o; }
        LDS_WAIT(); asm volatile("" ::: "memory");
    }
}
__device__ __forceinline__ float softplus_f(float z) { return fmaxf(z, 0.f) + log1pf(__expf(-fabsf(z))); }

typedef short s16x4 __attribute__((ext_vector_type(4)));
typedef pg8::u32x2 u32x2;
typedef float f32x16 __attribute__((ext_vector_type(16)));
typedef __bf16 bf16x2_t __attribute__((ext_vector_type(2)));
typedef float f32x2_t __attribute__((ext_vector_type(2)));
__device__ __forceinline__ unsigned cvt2(float lo, float hi) { const f32x2_t v = {lo, hi}; const bf16x2_t b = __builtin_convertvector(v, bf16x2_t); return __builtin_bit_cast(unsigned, b); }
__device__ __forceinline__ bf16x8 pack8(const f32x4 a, const f32x4 b) { v4u p; p.x = cvt2(a[0], a[1]); p.y = cvt2(a[2], a[3]); p.z = cvt2(b[0], b[1]); p.w = cvt2(b[2], b[3]); return __builtin_bit_cast(bf16x8, p); }
__device__ __forceinline__ bf16x8 ld2x8(const bf16* p0, const bf16* p1) { const s16x4 a = *(const s16x4*)p0, b = *(const s16x4*)p1; return __builtin_shufflevector(a, b, 0, 1, 2, 3, 4, 5, 6, 7); }
__device__ __forceinline__ bf16x8 ld16(const bf16* p) { return *(const bf16x8*)p; }
#define MFMA16(a, b, c) __builtin_amdgcn_mfma_f32_16x16x32_bf16((a), (b), (c), 0, 0, 0)
#define MFMA32(a, b, c) __builtin_amdgcn_mfma_f32_32x32x16_bf16((a), (b), (c), 0, 0, 0)

constexpr int QIMG_LD = 200, KTIMG_LD = 68, PKG_Q = 0, PKG_KT = 25600, PKG_G = 51712, IMG_BYTES = 52480, PKG_K = 52480, PKG_VT = 77056, PKG_BYTES = 126208, N_PKG = 2048 + 32;
static_assert(64 * QIMG_LD * 2 == PKG_KT && PKG_KT + 192 * KTIMG_LD * 2 == PKG_G && PKG_G + 768 == IMG_BYTES && PKG_K + 24576 == PKG_VT && PKG_VT + 49152 == PKG_BYTES && IMG_BYTES % 16 == 0, "package map");

__device__ __forceinline__ float softplus_fast(float z) { return fmaxf(z, 0.f) + __logf(1.0f + __expf(-fabsf(z))); }
constexpr int GL_TOT = 0, GL_Q = 6144, GL_K = GL_Q + 64 * QIMG_LD * 2, GL_V = GL_K + 64 * QIMG_LD * 2, VL_LD = 68, GL_P = GL_V + 384 * VL_LD * 2, P_LD = 68, GL_END = GL_P + 64 * P_LD * 2;
static_assert(GL_END <= RING_BYTES && GL_Q % 16 == 0 && GL_K % 16 == 0 && GL_V % 8 == 0 && GL_P % 8 == 0, "gla_prep_intra LDS map");
__device__ __forceinline__ void gla_prep_intra(int bid, int G, int tid, int wave, LAS unsigned char* lds, int l, const bf16* PROJ, const float* w_gate_lr, const float* b_gate, unsigned char* PKG, float* OINT) {
    const int lane = tid & 63, fr = lane & 15, fq = lane >> 4;
    const float* w2 = w_gate_lr + (size_t)l * 16 * 768; const float* bg = b_gate + (size_t)l * 768;
    LAS float* tot = (LAS float*)(lds + GL_TOT);
    LAS bf16* QL = (LAS bf16*)(lds + GL_Q); LAS bf16* KL = (LAS bf16*)(lds + GL_K); LAS bf16* VL = (LAS bf16*)(lds + GL_V); LAS bf16* P = (LAS bf16*)(lds + GL_P);
    float w2c[3][16], bgc[3]; int cur_h = -1;
    for (int j = 0;; ++j) {
        int item;
        if (G == 256) { if (j < 8) item = ((((j >> 1) << 2) | (bid & 3)) << 7) | ((bid >> 2) + 64 * (j & 1)); else if (j == 8 && bid < 32) item = 2048 + bid; else break; }
        else { item = bid + j * G; if (item >= N_PKG) break; }
        int h, row0, T;
        if (item < 2048) { const int bh = item >> 7, ch = item & 127; h = bh & 3; row0 = (bh >> 2) * SEQ + ch * 64; T = 64; }
        else { const int i2 = item - 2048; h = i2 & 3; row0 = MP + (i2 >> 2) * 16; T = 16; }
        unsigned char* pk = PKG + (size_t)item * PKG_BYTES;
        bf16* Qt = (bf16*)(pk + PKG_Q); bf16* KT = (bf16*)(pk + PKG_KT); bf16* VT = (bf16*)(pk + PKG_VT); float* Gp = (float*)(pk + PKG_G);
        if (h != cur_h) { cur_h = h;
#pragma unroll
            for (int c = 0; c < 3; ++c) { const int d = h * 192 + lane + 64 * c; bgc[c] = bg[d];
#pragma unroll
                for (int r = 0; r < 16; ++r) w2c[c][r] = w2[r * 768 + d]; } }
        v4u l0[8], l1[8];
#pragma unroll
        for (int tt = 0; tt < 8; ++tt) { const int t = 8 * wave + tt; const bf16* prow = PROJ + (size_t)(row0 + (t < T ? t : T - 1)) * NA;
            l0[tt] = *(const v4u*)(prow + CLR); l1[tt] = *(const v4u*)(prow + CLR + 8); }
        float lc[8][3]; float run[3] = {0.f, 0.f, 0.f};
#pragma unroll
        for (int tt = 0; tt < 8; ++tt) { const bool ok = 8 * wave + tt < T;
            float lr[16]; lr[0] = pg8::bflo(l0[tt].x); lr[1] = pg8::bfhi(l0[tt].x); lr[2] = pg8::bflo(l0[tt].y); lr[3] = pg8::bfhi(l0[tt].y); lr[4] = pg8::bflo(l0[tt].z); lr[5] = pg8::bfhi(l0[tt].z); lr[6] = pg8::bflo(l0[tt].w); lr[7] = pg8::bfhi(l0[tt].w);
            lr[8] = pg8::bflo(l1[tt].x); lr[9] = pg8::bfhi(l1[tt].x); lr[10] = pg8::bflo(l1[tt].y); lr[11] = pg8::bfhi(l1[tt].y); lr[12] = pg8::bflo(l1[tt].z); lr[13] = pg8::bfhi(l1[tt].z); lr[14] = pg8::bflo(l1[tt].w); lr[15] = pg8::bfhi(l1[tt].w);
#pragma unroll
            for (int c = 0; c < 3; ++c) { float xg = bgc[c];
#pragma unroll
                for (int r = 0; r < 16; ++r) xg += lr[r] * w2c[c][r];
                run[c] += ok ? -softplus_fast(-xg) * (1.0f / 16.0f) : 0.f; lc[tt][c] = run[c]; } }
#pragma unroll
        for (int c = 0; c < 3; ++c) tot[wave * 192 + lane + 64 * c] = run[c];
        unsigned qv[8][3], kv[8][3];
#pragma unroll
        for (int tt = 0; tt < 8; ++tt) { const int t = 8 * wave + tt; const bf16* prow = PROJ + (size_t)(row0 + (t < T ? t : T - 1)) * NA + h * 192 + lane;
#pragma unroll
            for (int c = 0; c < 3; ++c) { qv[tt][c] = prow[CQ + 64 * c]; kv[tt][c] = prow[CK + 64 * c]; } }
        __syncthreads();
        float pre[3], all[3];
#pragma unroll
        for (int c = 0; c < 3; ++c) { pre[c] = 0.f; all[c] = 0.f;
#pragma unroll
            for (int w = 0; w < 8; ++w) { const float tv = tot[w * 192 + lane + 64 * c]; all[c] += tv; if (w < wave) pre[c] += tv; } }
        unsigned ktw[3][4];
#pragma unroll
        for (int tt = 0; tt < 8; ++tt) { const int t = 8 * wave + tt; const bool ok = t < T;
#pragma unroll
            for (int c = 0; c < 3; ++c) { const int dl = lane + 64 * c; const float bc = pre[c] + lc[tt][c]; const float eq = __expf(bc), ek = __expf(-bc);
                const unsigned qb = ok ? f2bf(bf2f((bf16)qv[tt][c]) * GLA_QSCALE * eq) : 0u, kb = ok ? f2bf(bf2f((bf16)kv[tt][c]) * ek) : 0u;
                Qt[t * QIMG_LD + dl] = (bf16)qb; QL[t * QIMG_LD + dl] = (bf16)qb; KL[t * QIMG_LD + dl] = (bf16)kb;
                if (tt & 1) ktw[c][tt >> 1] |= kb << 16; else ktw[c][tt >> 1] = kb; } }
#pragma unroll
        for (int c = 0; c < 3; ++c) { bf16* kp = KT + (size_t)(lane + 64 * c) * KTIMG_LD + 8 * wave; u32x2 o0, o1; o0.x = ktw[c][0]; o0.y = ktw[c][1]; o1.x = ktw[c][2]; o1.y = ktw[c][3]; *(u32x2*)kp = o0; *(u32x2*)(kp + 4) = o1; }
        if (wave == 0) {
#pragma unroll
            for (int c = 0; c < 3; ++c) Gp[lane + 64 * c] = __expf(all[c]); }
        unsigned vv[6][8];
#pragma unroll
        for (int tt = 0; tt < 8; ++tt) { const int t = 8 * wave + tt; const bf16* prow = PROJ + (size_t)(row0 + (t < T ? t : T - 1)) * NA + CV + h * 384 + lane;
#pragma unroll
            for (int c2 = 0; c2 < 6; ++c2) vv[c2][tt] = prow[64 * c2]; }
#pragma unroll
        for (int c2 = 0; c2 < 6; ++c2) { const bool ok0 = 8 * wave < T;
            u32x2 o0, o1; o0.x = ok0 ? vv[c2][0] | (vv[c2][1] << 16) : 0u; o0.y = ok0 ? vv[c2][2] | (vv[c2][3] << 16) : 0u; o1.x = ok0 ? vv[c2][4] | (vv[c2][5] << 16) : 0u; o1.y = ok0 ? vv[c2][6] | (vv[c2][7] << 16) : 0u;
            v4u o; o.x = o0.x; o.y = o0.y; o.z = o1.x; o.w = o1.y; *(v4u*)(VT + (size_t)(lane + 64 * c2) * 64 + 8 * wave) = o;
            LAS bf16* vl = VL + (lane + 64 * c2) * VL_LD + 8 * wave; *(LAS u32x2*)vl = o0; *(LAS u32x2*)(vl + 4) = o1; }
        __syncthreads();
        const int nvalid = T;
        bf16x8 va[3], vb[3];
#pragma unroll
        for (int k = 0; k < 3; ++k) { const LAS bf16* vr = VL + (16 * (3 * wave + k) + fr) * VL_LD + 4 * fq;
            const s16x4 x0 = *(const LAS s16x4*)vr, x1 = *(const LAS s16x4*)(vr + 16), x2 = *(const LAS s16x4*)(vr + 32), x3 = *(const LAS s16x4*)(vr + 48);
            va[k] = __builtin_shufflevector(x0, x1, 0, 1, 2, 3, 4, 5, 6, 7); vb[k] = __builtin_shufflevector(x2, x3, 0, 1, 2, 3, 4, 5, 6, 7); }
#pragma unroll
        for (int rep = 0; rep < 2; ++rep) {
            const int tl = wave + 8 * rep;
            if (tl < 10) {
                const int it = tl < 1 ? 0 : (tl < 3 ? 1 : (tl < 6 ? 2 : 3)), jt = tl - (it * (it + 1)) / 2;
                f32x4 at = {0.f, 0.f, 0.f, 0.f};
                const LAS bf16* qr = QL + (16 * it + fr) * QIMG_LD + 8 * fq; const LAS bf16* kr = KL + (16 * jt + fr) * QIMG_LD + 8 * fq;
#pragma unroll
                for (int s = 0; s < 6; ++s) at = MFMA16(*(const LAS bf16x8*)(kr + 32 * s), *(const LAS bf16x8*)(qr + 32 * s), at);
                if (it == jt) {
#pragma unroll
                    for (int jj = 0; jj < 4; ++jj) if (4 * fq + jj > fr) at[jj] = 0.f; }
                u32x2 w; w.x = cvt2(at[0], at[1]); w.y = cvt2(at[2], at[3]);
                *(LAS u32x2*)(P + (16 * it + fr) * P_LD + 16 * jt + 4 * fq) = w;
            } else if (tl == 10 || tl == 11) {
                const int it = tl == 10 ? 0 : 2, jt = tl == 10 ? 1 : 3; unsigned zz = 0u; asm volatile("" : "+v"(zz)); u32x2 z; z.x = zz; z.y = zz;
                *(LAS u32x2*)(P + (16 * it + fr) * P_LD + 16 * jt + 4 * fq) = z;
            }
        }
        __syncthreads();
#pragma unroll
        for (int it = 0; it < 4; ++it) {
            if (16 * it >= nvalid) break;
            const LAS bf16* pr = P + (16 * it + fr) * P_LD + 4 * fq;
            const s16x4 a0 = *(const LAS s16x4*)pr, a1 = *(const LAS s16x4*)(pr + 16);
            const bf16x8 pf0 = __builtin_shufflevector(a0, a1, 0, 1, 2, 3, 4, 5, 6, 7); bf16x8 pf1 = pf0;
            if (it >= 2) { const s16x4 b0 = *(const LAS s16x4*)(pr + 32), b1 = *(const LAS s16x4*)(pr + 48); pf1 = __builtin_shufflevector(b0, b1, 0, 1, 2, 3, 4, 5, 6, 7); }
#pragma unroll
            for (int k = 0; k < 3; ++k) { f32x4 o = {0.f, 0.f, 0.f, 0.f};
                o = MFMA16(va[k], pf0, o); if (it >= 2) o = MFMA16(vb[k], pf1, o);
                *(f32x4*)(OINT + (size_t)(row0 + 16 * it + fr) * 1536 + h * 384 + 16 * (3 * wave + k) + 4 * fq) = o; }
        }
        __syncthreads();
    }
}

template <int PASS>
__device__ __forceinline__ void gla_chain(int wc, int tid, int wave, LAS unsigned char* lds, int l, const unsigned char* PKG, const float* state_gla, float* OINT, float* out, float* SLOC, float* GSEG, bool dry = false) {
    const int lane = tid & 63, fr = lane & 15, fq = lane >> 4;
    int h, vb, bh, seg, item0, nsteps, row0, nvalid; const float* s0 = nullptr; float* sout = nullptr;
    if (PASS == 1) { bh = wc / 9; const int rem = wc % 9; vb = rem / 3; seg = rem % 3; h = bh & 3; item0 = bh * 128 + 32 * seg; nsteps = 32; row0 = 0; nvalid = 64; }
    else if (wc < 192) { bh = wc / 12; const int rem = wc % 12; vb = rem >> 2; seg = rem & 3; h = bh & 3; item0 = bh * 128 + 32 * seg; nsteps = 32; row0 = (bh >> 2) * SEQ + 2048 * seg; nvalid = 64;
        if (seg == 3) sout = out + O_GSP + (size_t)(l * 16 + bh) * 192 * 384; }
    else { const int c2 = wc - 192; bh = c2 / 3; vb = c2 % 3; seg = 0; h = bh & 3; item0 = 2048 + bh; nsteps = 1; row0 = MP + (bh >> 2) * 16; nvalid = 16; s0 = state_gla + (size_t)(l * 32 + bh) * 192 * 384; sout = out + O_GSS + (size_t)(l * 32 + bh) * 192 * 384; }
    const int v0 = vb * 128 + wave * 16;
#define GLA_WALK(p, step) do { (p) += (step); asm volatile("" : "+v"(p)); } while (0)
    f32x4 S[12];
    if (s0) { const float* p = s0 + (size_t)(4 * fq) * 384 + v0 + fr;
#pragma unroll
        for (int t = 0; t < 12; ++t) {
#pragma unroll
            for (int jj = 0; jj < 4; ++jj) { S[t][jj] = *p; GLA_WALK(p, 384); }
            GLA_WALK(p, 12 * 384); } }
    else {
#pragma unroll
        for (int t = 0; t < 12; ++t) S[t] = (f32x4){0.f, 0.f, 0.f, 0.f}; }
    if (PASS == 2 && wc < 192) {
        for (int j = 0; j < seg; ++j) { const float* gs = GSEG + (size_t)(bh * 3 + j) * 192 + 4 * fq; const float* p = SLOC + (size_t)((bh * 3 + vb) * 3 + j) * 192 * 128 + (size_t)(4 * fq) * 128 + wave * 16 + fr;
#pragma unroll
            for (int t = 0; t < 12; ++t) { const f32x4 g4 = *(const f32x4*)(gs + 16 * t);
#pragma unroll
                for (int jj = 0; jj < 4; ++jj) { S[t][jj] = g4[jj] * S[t][jj] + *p; GLA_WALK(p, 128); }
                GLA_WALK(p, 12 * 128); } }
    }
    f32x4 GP[PASS == 1 ? 12 : 1];
    if (PASS == 1) {
#pragma unroll
        for (int t = 0; t < 12; ++t) GP[t] = (f32x4){1.f, 1.f, 1.f, 1.f}; }
    constexpr int CH0 = PASS == 1 ? PKG_KT / 16 : 0, NCH = IMG_BYTES / 16, NLD = PASS == 1 ? 4 : 7;
    v4u pre[NLD]; bf16x8 vt[2], vtn[2]; f32x4 oin[4];
    { const unsigned char* pk = PKG + (size_t)item0 * PKG_BYTES;
      if (PASS == 2) {
#pragma unroll
        for (int it = 0; it < 4; ++it) { const int tl = 16 * it + fr; oin[it] = tl < nvalid ? *(const f32x4*)(OINT + (size_t)(row0 + tl) * 1536 + h * 384 + v0 + 4 * fq) : (f32x4){0.f, 0.f, 0.f, 0.f}; } }
#pragma unroll
      for (int k = 0; k < NLD; ++k) { const int ch = CH0 + tid + 512 * k; if (ch < NCH) pre[k] = *(const v4u*)(pk + (size_t)ch * 16); }
      const bf16* VT = (const bf16*)(pk + PKG_VT) + (size_t)(v0 + fr) * 64 + 4 * fq; vt[0] = ld2x8(VT, VT + 16); vt[1] = ld2x8(VT + 32, VT + 48);
#pragma unroll
      for (int k = 0; k < NLD; ++k) { const int ch = CH0 + tid + 512 * k; if (ch < NCH) *(LAS v4u*)(lds + (size_t)ch * 16) = pre[k]; }
      vtn[0] = vt[0]; vtn[1] = vt[1]; }
    __syncthreads();
    for (int n = 0; n < nsteps; ++n) {
        const LAS unsigned char* img = lds + (n & 1) * IMG_BYTES;
        const bool more = n + 1 < nsteps;
        if (more) { const unsigned char* pk = PKG + (size_t)(item0 + n + 1) * PKG_BYTES;
#pragma unroll
            for (int k = 0; k < NLD; ++k) { const int ch = CH0 + tid + 512 * k; if (ch < NCH) pre[k] = *(const v4u*)(pk + (size_t)ch * 16); }
            const bf16* VT = (const bf16*)(pk + PKG_VT) + (size_t)(v0 + fr) * 64 + 4 * fq; vtn[0] = ld2x8(VT, VT + 16); vtn[1] = ld2x8(VT + 32, VT + 48); }
        if (PASS == 2) {
            bf16x8 Sb[6];
#pragma unroll
            for (int s = 0; s < 6; ++s) Sb[s] = pack8(S[2 * s], S[2 * s + 1]);
#pragma unroll
            for (int it = 0; it < 4; ++it) {
                const LAS bf16* qr = (const LAS bf16*)(img + PKG_Q) + (16 * it + fr) * QIMG_LD + 4 * fq;
                f32x4 o = oin[it];
#pragma unroll
                for (int s = 0; s < 6; ++s) { const s16x4 a = *(const LAS s16x4*)(qr + 32 * s), b = *(const LAS s16x4*)(qr + 32 * s + 16);
                    o = MFMA16(Sb[s], __builtin_shufflevector(a, b, 0, 1, 2, 3, 4, 5, 6, 7), o); }
                const int tl = 16 * it + fr;
                if (tl < nvalid && !dry) *(f32x4*)(OINT + (size_t)(row0 + 64 * n + tl) * 1536 + h * 384 + v0 + 4 * fq) = o;
                __builtin_amdgcn_sched_barrier(0);
            }
            if (more) {
#pragma unroll
                for (int it = 0; it < 4; ++it) oin[it] = *(const f32x4*)(OINT + (size_t)(row0 + 64 * (n + 1) + 16 * it + fr) * 1536 + h * 384 + v0 + 4 * fq); }
        }
#pragma unroll
        for (int t = 0; t < 12; ++t) { const LAS bf16* kr = (const LAS bf16*)(img + PKG_KT) + (16 * t + fr) * KTIMG_LD + 4 * fq;
#pragma unroll
            for (int s2 = 0; s2 < 2; ++s2) { const s16x4 a = *(const LAS s16x4*)(kr + 32 * s2), b = *(const LAS s16x4*)(kr + 32 * s2 + 16);
                S[t] = MFMA16(__builtin_shufflevector(a, b, 0, 1, 2, 3, 4, 5, 6, 7), vt[s2], S[t]); }
            const f32x4 g4 = *(const LAS f32x4*)(img + PKG_G + (16 * t + 4 * fq) * 4);
            S[t] = S[t] * g4; if (PASS == 1) GP[t] = GP[t] * g4; if (t & 1) __builtin_amdgcn_sched_barrier(0); }
        if (more) { LAS unsigned char* nimg = lds + ((n + 1) & 1) * IMG_BYTES;
#pragma unroll
            for (int k = 0; k < NLD; ++k) { const int ch = CH0 + tid + 512 * k; if (ch < NCH) *(LAS v4u*)(nimg + (size_t)ch * 16) = pre[k]; }
            vt[0] = vtn[0]; vt[1] = vtn[1]; }
        asm volatile("s_waitcnt lgkmcnt(0)" ::: "memory"); __builtin_amdgcn_s_barrier(); asm volatile("" ::: "memory");
    }
    if (PASS == 1) {
        float* p = SLOC + (size_t)((bh * 3 + vb) * 3 + seg) * 192 * 128 + (size_t)(4 * fq) * 128 + wave * 16 + fr;
#pragma unroll
        for (int t = 0; t < 12; ++t) {
#pragma unroll
            for (int jj = 0; jj < 4; ++jj) { *p = S[t][jj]; GLA_WALK(p, 128); }
            GLA_WALK(p, 12 * 128); }
        if (vb == 0 && wave == 0 && fr == 0) { float* gs = GSEG + (size_t)(bh * 3 + seg) * 192;
#pragma unroll
            for (int t = 0; t < 12; ++t) *(f32x4*)(gs + 16 * t + 4 * fq) = GP[t]; }
    } else if (sout) {
        float* p = sout + (size_t)(4 * fq) * 384 + v0 + fr;
#pragma unroll
        for (int t = 0; t < 12; ++t) {
#pragma unroll
            for (int jj = 0; jj < 4; ++jj) { *p = S[t][jj]; GLA_WALK(p, 384); }
            GLA_WALK(p, 12 * 384); }
    }
#undef GLA_WALK
}

__device__ __forceinline__ void mem_attn(int item, int lane, int l, const bf16* PROJ, int ldp, int cqm, const bf16* MEMK, const bf16* MEMVT, bf16* OCAT) {
    const int fr = lane & 15, fq = lane >> 4, tile = item >> 2, h = item & 3, r0 = tile * 16;
    const int bb = r0 < MP ? r0 / SEQ : 4 + ((r0 - MP) >> 4);
    const bf16* Kb = MEMK + (size_t)((l * 12 + bb) * 256) * 512 + h * 128; const bf16* Vt = MEMVT + (size_t)(((l * 12 + bb) * 4 + h) * 128) * 256;
    bf16x8 qf[4];
#pragma unroll
    for (int s = 0; s < 4; ++s) qf[s] = ld16(PROJ + (size_t)(r0 + fr) * ldp + cqm + h * 128 + 32 * s + 8 * fq);
    f32x4 st[16];
#pragma unroll
    for (int mt = 0; mt < 16; ++mt) { st[mt] = (f32x4){0.f, 0.f, 0.f, 0.f}; const bf16* kr = Kb + (size_t)(16 * mt + fr) * 512 + 8 * fq;
#pragma unroll
        for (int s = 0; s < 4; ++s) st[mt] = MFMA16(ld16(kr + 32 * s), qf[s], st[mt]); }
    float mx = -3.0e38f;
#pragma unroll
    for (int mt = 0; mt < 16; ++mt) mx = fmaxf(mx, fmaxf(fmaxf(st[mt][0], st[mt][1]), fmaxf(st[mt][2], st[mt][3])));
    mx = fmaxf(mx, shx(mx, lane, 16)); mx = fmaxf(mx, shx(mx, lane, 32));
    float sum = 0.f;
#pragma unroll
    for (int mt = 0; mt < 16; ++mt)
#pragma unroll
        for (int jj = 0; jj < 4; ++jj) { const float p = __expf((st[mt][jj] - mx) * HD_SCALE); st[mt][jj] = p; sum += p; }
    sum += shx(sum, lane, 16); sum += shx(sum, lane, 32);
    const float inv = 1.0f / sum;
    bf16x8 pf[8];
#pragma unroll
    for (int s = 0; s < 8; ++s) pf[s] = pack8(st[2 * s], st[2 * s + 1]);
#pragma unroll
    for (int dt = 0; dt < 8; ++dt) { f32x4 o = {0.f, 0.f, 0.f, 0.f}; const bf16* vr = Vt + (size_t)(16 * dt + fr) * 256 + 4 * fq;
#pragma unroll
        for (int s = 0; s < 8; ++s) o = MFMA16(ld2x8(vr + 32 * s, vr + 32 * s + 16), pf[s], o);
        u32x2 w; w.x = cvt2(o[0] * inv, o[1] * inv); w.y = cvt2(o[2] * inv, o[3] * inv);
        *(u32x2*)(OCAT + (size_t)(r0 + fr) * D + 1536 + h * 128 + 16 * dt + 4 * fq) = w; }
}

__device__ __forceinline__ void mem_attn_wg(int wi, int tid, int wave, LAS unsigned char* lds, int l, const bf16* PROJ, int ldp, int cqm, const bf16* MEMK, const bf16* MEMVT, bf16* OCAT) {
    const bool smp = wi >= 256; const int lane = tid & 63, fr = lane & 15, fq = lane >> 4, bh = smp ? (wi - 256) : (wi >> 4), sub = wi & 15, b = smp ? 4 + (bh >> 2) : (bh >> 2), h = bh & 3;
    const bf16* Kb = MEMK + (size_t)((l * 12 + b) * 256) * 512 + h * 128; const bf16* Vt = MEMVT + (size_t)(((l * 12 + b) * 4 + h) * 128) * 256;
#pragma unroll
    for (int k = 0; k < 8; ++k) { const int idx = tid + 512 * k, row = idx >> 4, c = idx & 15; *(LAS v4u*)(lds + row * 256 + ((c ^ (row & 15)) << 4)) = *(const v4u*)(Kb + (size_t)row * 512 + c * 8); }
#pragma unroll
    for (int k = 0; k < 8; ++k) { const int idx = tid + 512 * k, row = idx >> 5, c = idx & 31; *(LAS v4u*)(lds + 65536 + row * 512 + ((c ^ (2 * (row & 15))) << 4)) = *(const v4u*)(Vt + (size_t)row * 256 + c * 8); }
    __syncthreads();
    unsigned koff[4], voff[16];
#pragma unroll
    for (int s2 = 0; s2 < 4; ++s2) { koff[s2] = (unsigned)(fr * 256 + (((4 * s2 + fq) ^ fr) << 4)); asm volatile("" : "+v"(koff[s2])); }
#pragma unroll
    for (int s2 = 0; s2 < 8; ++s2) { const int p0 = 8 * s2 + fq, p1 = p0 + 4;
        voff[2 * s2] = (unsigned)(65536 + fr * 512 + ((((p0 >> 1) ^ (2 * fr)) << 4) | ((p0 & 1) << 3))); voff[2 * s2 + 1] = (unsigned)(65536 + fr * 512 + ((((p1 >> 1) ^ (2 * fr)) << 4) | ((p1 & 1) << 3)));
        asm volatile("" : "+v"(voff[2 * s2]), "+v"(voff[2 * s2 + 1])); }
    const int nblk = smp ? (wave == 0 ? 1 : 0) : 4;
#pragma unroll 1
    for (int blk = 0; blk < nblk; ++blk) {
        const int r0 = smp ? MP + (b - 4) * 16 : b * SEQ + sub * 512 + blk * 128 + wave * 16;
        bf16x8 qf[4];
#pragma unroll
        for (int s = 0; s < 4; ++s) qf[s] = ld16(PROJ + (size_t)(r0 + fr) * ldp + cqm + h * 128 + 32 * s + 8 * fq);
        f32x4 st[16];
#pragma unroll
        for (int mt = 0; mt < 16; ++mt) { st[mt] = (f32x4){0.f, 0.f, 0.f, 0.f};
#pragma unroll
            for (int s = 0; s < 4; ++s) st[mt] = MFMA16(*(const LAS bf16x8*)(lds + koff[s] + mt * 4096), qf[s], st[mt]);
            if ((mt & 3) == 3) __builtin_amdgcn_sched_barrier(0); }
        float mx = -3.0e38f;
#pragma unroll
        for (int mt = 0; mt < 16; ++mt) mx = fmaxf(mx, fmaxf(fmaxf(st[mt][0], st[mt][1]), fmaxf(st[mt][2], st[mt][3])));
        mx = fmaxf(mx, shx(mx, lane, 16)); mx = fmaxf(mx, shx(mx, lane, 32));
        float sum = 0.f;
#pragma unroll
        for (int mt = 0; mt < 16; ++mt)
#pragma unroll
            for (int jj = 0; jj < 4; ++jj) { const float p = __expf((st[mt][jj] - mx) * HD_SCALE); st[mt][jj] = p; sum += p; }
        sum += shx(sum, lane, 16); sum += shx(sum, lane, 32);
        const float inv = 1.0f / sum;
        bf16x8 pf[8];
#pragma unroll
        for (int s = 0; s < 8; ++s) pf[s] = pack8(st[2 * s], st[2 * s + 1]);
#pragma unroll
        for (int dt = 0; dt < 8; ++dt) { f32x4 o = {0.f, 0.f, 0.f, 0.f};
#pragma unroll
            for (int s = 0; s < 8; ++s) { const s16x4 a = *(const LAS s16x4*)(lds + voff[2 * s] + dt * 8192), bb = *(const LAS s16x4*)(lds + voff[2 * s + 1] + dt * 8192);
                o = MFMA16(__builtin_shufflevector(a, bb, 0, 1, 2, 3, 4, 5, 6, 7), pf[s], o); }
            u32x2 w; w.x = cvt2(o[0] * inv, o[1] * inv); w.y = cvt2(o[2] * inv, o[3] * inv);
            *(u32x2*)(OCAT + (size_t)(r0 + fr) * D + 1536 + h * 128 + 16 * dt + 4 * fq) = w;
            if (dt & 1) __builtin_amdgcn_sched_barrier(0); }
    }
    __syncthreads();
}

template <int MODE = 0>
__device__ __forceinline__ void sb_attn(int lane, LAS unsigned char* wlds, const bf16* Kp, int ldk, const bf16* VTp, int ldvt, const bf16* Qp, int ldq, bf16* Op, int t0, int nq) {
    const int r = lane & 31, hh = lane >> 5;
    LAS bf16x8* qs = (LAS bf16x8*)wlds + lane;
#pragma unroll
    for (int ks = 0; ks < 8; ++ks) qs[64 * ks] = ld16(Qp + (size_t)r * ldq + 16 * ks + 8 * hh);
    f32x16 oacc[4];
#pragma unroll
    for (int dt = 0; dt < 4; ++dt)
#pragma unroll
        for (int i = 0; i < 16; ++i) oacc[dt][i] = 0.f;
    float carry = 1.f;
    bf16x8 kf[8];
    { const bf16* kr = Kp + (size_t)(t0 + r) * ldk + 8 * hh;
#pragma unroll
      for (int ks = 0; ks < 8; ++ks) kf[ks] = ld16(kr + 16 * ks); }
    for (int s0 = t0; s0 >= 0; s0 -= 32) {
        bf16x8 vf[8];
#pragma unroll
        for (int k2 = 0; k2 < 2; ++k2)
#pragma unroll
            for (int dt = 0; dt < 4; ++dt) vf[4 * k2 + dt] = MODE == 3 ? qs[64 * dt] : ld16(VTp + (size_t)(s0 >> 5) * 4096 + ((dt * 2 + k2) * 64 + lane) * 8);
        f32x16 st;
#pragma unroll
        for (int i = 0; i < 16; ++i) st[i] = 0.f;
#pragma unroll
        for (int ks = 0; ks < 8; ++ks) st = MFMA32(kf[ks], qs[64 * ks], st);
        { const int sn = s0 >= 32 ? s0 - 32 : 0; const bf16* kr = Kp + (size_t)(sn + r) * ldk + 8 * hh;
#pragma unroll
          for (int ks = 0; ks < 8; ++ks) kf[ks] = ld16(kr + 16 * ks); }
        const bool diag = (s0 == t0);
        float lb[16], om[16];
#pragma unroll
        for (int i = 0; i < 16; ++i) { const float z = st[i] * HD_SCALE, e = __expf(-fabsf(z)), rr = __builtin_amdgcn_rcpf(1.0f + e), er = e * rr;
            lb[i] = z >= 0.f ? rr : er; om[i] = z >= 0.f ? er : rr;
            if (diag && !(((i & 3) + 8 * (i >> 2) + 4 * hh) < r)) { lb[i] = 0.f; om[i] = 1.f; } }
        float g[4], pgv[4];
#pragma unroll
        for (int m = 0; m < 4; ++m) { g[m] = (om[4 * m] * om[4 * m + 1]) * (om[4 * m + 2] * om[4 * m + 3]); pgv[m] = shx(g[m], lane, 32); }
        float R[4]; R[3] = 1.f; R[2] = g[3] * pgv[3]; R[1] = R[2] * (g[2] * pgv[2]); R[0] = R[1] * (g[1] * pgv[1]);
        const float total = R[0] * (g[0] * pgv[0]);
#pragma unroll
        for (int m = 0; m < 4; ++m) { const float suf = carry * R[m] * (hh == 0 ? pgv[m] : 1.f);
            const float t3 = suf, t2 = t3 * om[4 * m + 3], t1 = t2 * om[4 * m + 2], t0_ = t1 * om[4 * m + 1];
            lb[4 * m + 3] *= t3; lb[4 * m + 2] *= t2; lb[4 * m + 1] *= t1; lb[4 * m] *= t0_; }
        carry *= total;
#pragma unroll
        for (int k2 = 0; k2 < 2; ++k2) {
            v4u p; p.x = cvt2(lb[8 * k2], lb[8 * k2 + 1]); p.y = cvt2(lb[8 * k2 + 2], lb[8 * k2 + 3]); p.z = cvt2(lb[8 * k2 + 4], lb[8 * k2 + 5]); p.w = cvt2(lb[8 * k2 + 6], lb[8 * k2 + 7]);
            const bf16x8 wf = __builtin_bit_cast(bf16x8, p);
#pragma unroll
            for (int dt = 0; dt < 4; ++dt) { if (MODE != 3) oacc[dt] = MFMA32(vf[4 * k2 + dt], wf, oacc[dt]); else oacc[dt][0] += __builtin_bit_cast(float, (int)wf[0]) + __builtin_bit_cast(float, (int)vf[4 * k2 + dt][0]); }
        }
        if (MODE == 2 || __all((r >= nq) || (carry < 1.0e-37f))) break;
    }
    if (MODE != 0) { float sdry = 0.f;
#pragma unroll
        for (int dt = 0; dt < 4; ++dt)
#pragma unroll
            for (int i = 0; i < 16; ++i) sdry += oacc[dt][i];
        if (sdry == 1.2345e33f) Op[0] = 0; }
    else if (r < nq) {
#pragma unroll
        for (int dt = 0; dt < 4; ++dt)
#pragma unroll
            for (int g4 = 0; g4 < 4; ++g4) { u32x2 wv; wv.x = cvt2(oacc[dt][4 * g4], oacc[dt][4 * g4 + 1]); wv.y = cvt2(oacc[dt][4 * g4 + 2], oacc[dt][4 * g4 + 3]);
                *(u32x2*)(Op + (size_t)r * D + 32 * dt + 8 * g4 + 4 * hh) = wv; }
    }
    asm volatile("s_waitcnt lgkmcnt(0)" ::: "memory");
}

struct SkBf16 { bf16* O; int ldc;
    __device__ __forceinline__ int brow(int unit, int nb) const { return 32 * unit + 16 * nb; }
    __device__ __forceinline__ void store(int unit, const f32x4 a0, const f32x4 a1, int m, int fq) const { bf16* p = O + (size_t)(MP + m) * ldc + 32 * unit + 4 * fq;
        u32x2 w; w.x = cvt2(a0[0], a0[1]); w.y = cvt2(a0[2], a0[3]); *(u32x2*)p = w; w.x = cvt2(a1[0], a1[1]); w.y = cvt2(a1[2], a1[3]); *(u32x2*)(p + 16) = w; } };
struct SkRes { bf16* Yp; const bf16* Xp; float alpha;
    __device__ __forceinline__ int brow(int unit, int nb) const { return 32 * unit + 16 * nb; }
    __device__ __forceinline__ void one(size_t o, const f32x4 a) const { const u32x2 xv = *(const u32x2*)(Xp + o);
        f32x4 r; r[0] = alpha * pg8::bflo(xv.x); r[1] = alpha * pg8::bfhi(xv.x); r[2] = alpha * pg8::bflo(xv.y); r[3] = alpha * pg8::bfhi(xv.y); r = r + a; u32x2 w; w.x = cvt2(r[0], r[1]); w.y = cvt2(r[2], r[3]); *(u32x2*)(Yp + o) = w; }
    __device__ __forceinline__ void store(int unit, const f32x4 a0, const f32x4 a1, int m, int fq) const { const size_t o = (size_t)(MP + m) * D + 32 * unit + 4 * fq; one(o, a0); one(o + 16, a1); } };
struct SkKV { float *oks, *ovs; bf16 *ksb, *vsb;
    __device__ __forceinline__ int brow(int unit, int nb) const { return 32 * unit + 16 * nb; }
    __device__ __forceinline__ void one(int col, const f32x4 a, int m) const { const bool isv = col >= 1536; const int c = col - (isv ? 1536 : 0), b = m >> 4, t = m & 15;
        *(f32x4*)((isv ? ovs : oks) + (size_t)m * 1536 + c) = a; const unsigned w0 = cvt2(a[0], a[1]), w1 = cvt2(a[2], a[3]);
        const int hh_ = c >> 7, dd = c & 127;
        if (!isv) { u32x2 w; w.x = w0; w.y = w1; *(u32x2*)(ksb + ((size_t)(b * 12 + hh_) * 2080 + 2048 + t) * 128 + dd) = w; }
        else { bf16* vt = vsb + ((size_t)(b * 12 + hh_) * 65 + 64) * 4096 + pg8::vtf_d(dd) + pg8::vtf_k(t); vt[0] = (bf16)w0; vt[8] = (bf16)(w0 >> 16); vt[16] = (bf16)w1; vt[24] = (bf16)(w1 >> 16); } }
    __device__ __forceinline__ void store(int unit, const f32x4 a0, const f32x4 a1, int m, int fq) const { one(32 * unit + 4 * fq, a0, m); one(32 * unit + 16 + 4 * fq, a1, m); } };
struct SkSwiGLU { bf16* Hb;
    __device__ __forceinline__ int brow(int unit, int nb) const { const int c0 = 16 * unit; return (c0 >> 7) * 256 + (c0 & 127) + 128 * nb; }
    __device__ __forceinline__ void store(int unit, const f32x4 g, const f32x4 u, int m, int fq) const { float hv[4];
#pragma unroll
        for (int j = 0; j < 4; ++j) hv[j] = g[j] * __builtin_amdgcn_rcpf(1.0f + __expf(-g[j])) * u[j];
        u32x2 w; w.x = cvt2(hv[0], hv[1]); w.y = cvt2(hv[2], hv[3]); *(u32x2*)(Hb + (size_t)(MP + m) * DFF + 16 * unit + 4 * fq) = w; } };
template <class Epi>
__device__ __forceinline__ void skinny_gemm(int bid, int G, int tid, int wave, LAS unsigned char* lds, const bf16* A, int lda, const bf16* Bt, int K, int nunits, const Epi& E) {
    const int lane = tid & 63, fr = lane & 15, fq = lane >> 4, kw = K >> 3, nst = kw >> 5;
    const bf16* ap = A + (size_t)fr * lda + wave * kw + 8 * fq;
    LAS f32x4* red = (LAS f32x4*)lds;
    for (int unit = bid; unit < nunits; unit += G) {
        const bf16* bp0 = Bt + (size_t)(E.brow(unit, 0) + fr) * K + wave * kw + 8 * fq; const bf16* bp1 = Bt + (size_t)(E.brow(unit, 1) + fr) * K + wave * kw + 8 * fq;
        f32x4 acc[2][8];
#pragma unroll
        for (int nb = 0; nb < 2; ++nb)
#pragma unroll
            for (int rt = 0; rt < 8; ++rt) acc[nb][rt] = (f32x4){0.f, 0.f, 0.f, 0.f};
        bf16x8 a0[8], a1[8], a2[8], b0[2], b1[2], b2[2];
#define SK_LOAD(af, bfr, st) do { _Pragma("unroll") for (int rt = 0; rt < 8; ++rt) af[rt] = ld16(ap + (size_t)(16 * rt) * lda + 32 * (st)); bfr[0] = ld16(bp0 + 32 * (st)); bfr[1] = ld16(bp1 + 32 * (st)); } while (0)
#define SK_MMA(af, bfr) do { _Pragma("unroll") for (int rt = 0; rt < 8; ++rt) { acc[0][rt] = MFMA16(bfr[0], af[rt], acc[0][rt]); acc[1][rt] = MFMA16(bfr[1], af[rt], acc[1][rt]); } } while (0)
        SK_LOAD(a0, b0, 0); SK_LOAD(a1, b1, 1);
#pragma unroll 1
        for (int st = 0; st < nst; st += 3) {
            if (st + 2 < nst) SK_LOAD(a2, b2, st + 2);
            __builtin_amdgcn_sched_barrier(0);
            SK_MMA(a0, b0);
            __builtin_amdgcn_sched_barrier(0);
            if (st + 3 < nst) SK_LOAD(a0, b0, st + 3);
            __builtin_amdgcn_sched_barrier(0);
            if (st + 1 < nst) SK_MMA(a1, b1);
            __builtin_amdgcn_sched_barrier(0);
            if (st + 4 < nst) SK_LOAD(a1, b1, st + 4);
            __builtin_amdgcn_sched_barrier(0);
            if (st + 2 < nst) SK_MMA(a2, b2);
            __builtin_amdgcn_sched_barrier(0);
        }
#undef SK_LOAD
#undef SK_MMA
#pragma unroll
        for (int nb = 0; nb < 2; ++nb)
#pragma unroll
            for (int rt = 0; rt < 8; ++rt) red[((wave * 2 + nb) * 8 + rt) * 64 + lane] = acc[nb][rt];
        __syncthreads();
        f32x4 s0 = {0.f, 0.f, 0.f, 0.f}, s1 = {0.f, 0.f, 0.f, 0.f};
#pragma unroll
        for (int ws = 0; ws < 8; ++ws) { s0 = s0 + red[((ws * 2 + 0) * 8 + wave) * 64 + lane]; s1 = s1 + red[((ws * 2 + 1) * 8 + wave) * 64 + lane]; }
        E.store(unit, s0, s1, 16 * wave + fr, fq);
        __syncthreads();
    }
}
#ifndef PH_MASK
#define PH_MASK 0xFFFF
#endif
__global__ void __launch_bounds__(NWAVES * 64, 2) mega(Args args) {
    extern __shared__ __attribute__((aligned(16))) unsigned char lds[];
    Frame F;
    F.lds = (LAS unsigned char*)lds; F.MISC = (volatile LAS unsigned*)(F.lds + MISC_OFF);
    F.tid = threadIdx.x; F.lane = F.tid & 63; F.wave = __builtin_amdgcn_readfirstlane(F.tid >> 6);
    F.G = gridDim.x; F.gw = blockIdx.x * NWAVES + F.wave; F.NGW = F.G * NWAVES;
    F.ctl = (gu32*)(args.ws_ + WS_CTL);
    for (int u = F.tid; u < (LDS_BYTES - LDSCTL_OFF) / 4; u += NWAVES * 64) ((LAS unsigned*)(F.lds + LDSCTL_OFF))[u] = 0u;
    __syncthreads();
    XcdBarrier bar = xcd_barrier_post((unsigned*)(F.ctl + CW_BAR), F.MISC + 8);
    const int lo = args.ph_lo, hi = args.ph_hi; int ph = 0;
#define KARGS ((const __attribute__((address_space(4))) Args*)__builtin_amdgcn_kernarg_segment_ptr())
#define ws (ka->ws_)
#define out (ka->out_)
#define x_prompt (ka->in[0])
#define x_sample (ka->in[1])
#define mem_prompt (ka->in[2])
#define state_gla (ka->in[3])
#define cache_sb_k (ka->in[4])
#define cache_sb_v (ka->in[5])
#define cache_mem_k (ka->in[6])
#define cache_mem_v (ka->in[7])
#define w_in_a (ka->in[8])
#define w_gate_lr (ka->in[9])
#define b_gate (ka->in[10])
#define gla_norm_g (ka->in[11])
#define w_in_b (ka->in[12])
#define w_kv_shared (ka->in[13])
#define w_mem_kv (ka->in[14])
#define w_o (ka->in[15])
#define ln1_g (ka->in[16])
#define ln1_b (ka->in[17])
#define ln2_g (ka->in[18])
#define ln2_b (ka->in[19])
#define w_ffn_in (ka->in[20])
#define w_ffn_out (ka->in[21])
#define WIN ((bf16*)(ws + WS_WIN))
#define WO ((bf16*)(ws + WS_WO))
#define WFI ((bf16*)(ws + WS_WFI))
#define WFO ((bf16*)(ws + WS_WFO))
#define WMEM ((bf16*)(ws + WS_WMEM))
#define MEMX ((bf16*)(ws + WS_MEMX))
#define MEMK ((bf16*)(ws + WS_MEMK))
#define MEMV ((bf16*)(ws + WS_MEMV))
#define X ((bf16*)(ws + WS_X))
#define Y ((float*)(ws + WS_Y))
#define YB ((bf16*)(ws + WS_Y))
#define PROJ ((bf16*)(ws + WS_R1))
#define HB ((bf16*)(ws + WS_R1))
#define OCAT ((bf16*)(ws + WS_OCAT))
#define SBKS ((bf16*)(ws + WS_SBKS))
#define SBVS ((bf16*)(ws + WS_SBVS))
#define OINT (out + O_YP)
#define KPB ((bf16*)(out + O_YP))
#define VPB (KPB + (size_t)MP * 1536)

#define PHASE_BEGIN(cond, cls) if (cond) { if (lo <= ph && ph < hi) { if (ph > lo) { xcd_barrier(bar); if (BAR_REP > 1) xcd_barrier(bar); } DIAG_STAMP(cls); for (int rep_ = 0; rep_ < (((cls) == REP_CLS) ? 2 : 1); ++rep_) { const __attribute__((address_space(4))) Args* ka = KARGS; asm volatile("" : "+s"(ka)); int z_ = 0, G_ = gridDim.x, bid_ = blockIdx.x, wave_ = F.wave; asm volatile("" : "+s"(z_), "+s"(G_), "+s"(bid_), "+s"(wave_)); const int lane = (int)__builtin_amdgcn_mbcnt_hi(~0u, __builtin_amdgcn_mbcnt_lo(~0u, (unsigned)z_)), tid = wave_ * 64 + lane, gw_ = bid_ * NWAVES + wave_, NGW_ = G_ * NWAVES;     (void)tid; (void)lane; (void)gw_; (void)NGW_;
#define PHASE_END } } ++ph; }
#ifndef REP_CLS
#define REP_CLS (-1)
#endif
#ifndef SK_REP
#define SK_REP 1
#endif
#ifndef MEM_REP
#define MEM_REP 1
#endif
#ifndef BAR_REP
#define BAR_REP 1
#endif
#ifndef STAG
#define STAG 0
#endif
#ifndef SB_REP
#define SB_REP 1
#endif
#if defined(DIAG_A)
#define DIAG_STAMP(cls) do { if (blockIdx.x == 0 && threadIdx.x == 0) { unsigned long long* dts = (unsigned long long*)(args.ws_ + 262144); dts[ph] = rt(); } } while (0)
#else
#define DIAG_STAMP(cls) do { } while (0)
#endif

#define CONVERT_WEIGHTS(LL) do { const int ll_ = (LL); \
            if (ll_ < 2) wt_convert(F.lds, wave_, gw_, NGW_, lane, w_in_a + (size_t)ll_ * D * 5136, D, 5136, WIN, NA, MapInA()); \
            else { wt_convert(F.lds, wave_, gw_, NGW_, lane, w_in_b + (size_t)(ll_ - 2) * D * NBQ, D, NBQ, WIN, NBQ, MapId()); if (ll_ == 2) wt_convert(F.lds, wave_, gw_, NGW_, lane, w_kv_shared, D, NKV, WIN + (size_t)NBQ * D, NKV, MapId()); } \
            wt_convert(F.lds, wave_, gw_, NGW_, lane, w_o + (size_t)ll_ * D * D, D, D, WO, D, MapId()); \
            wt_convert(F.lds, wave_, gw_, NGW_, lane, w_ffn_in + (size_t)ll_ * D * 2 * DFF, D, 2 * DFF, WFI, 2 * DFF, MapFfn()); \
            wt_convert(F.lds, wave_, gw_, NGW_, lane, w_ffn_out + (size_t)ll_ * DFF * D, DFF, D, WFO, D, MapId()); } while (0)
    PHASE_BEGIN(true, 0)
        for (int r = gw_; r < MT; r += NGW_) cvt_row(r < MP ? x_prompt + (size_t)r * D : (r < MR ? x_sample + (size_t)(r - MP) * D : nullptr), X + (size_t)r * D, D, lane);
        for (int r = gw_; r < 1024; r += NGW_) cvt_row(mem_prompt + (size_t)r * D, MEMX + (size_t)r * D, D, lane);
        for (int r = gw_; r < 4 * 8 * 256; r += NGW_) { const int l = r >> 11, b = (r >> 8) & 7, m = r & 255; const size_t dst = (size_t)((l * 12 + 4 + b) * 256 + m) * 512;
            cvt_row(cache_mem_k + (size_t)r * 512, MEMK + dst, 512, lane); }
        for (int it = gw_; it < 512; it += NGW_) { const int hdb = it & 3, mb = (it >> 2) & 3, b = (it >> 4) & 7, l = it >> 7, m = mb * 64 + lane;
            const float* src = cache_mem_v + (size_t)((l * 8 + b) * 256 + m) * 512 + hdb * 128; bf16* dst = MEMV + (size_t)((l * 12 + 4 + b) * 512 + hdb * 128) * 256 + m;
            for (int q4 = 0; q4 < 32; ++q4) { const f32x4 v = *(const f32x4*)(src + 4 * q4);
#pragma unroll
                for (int e = 0; e < 4; ++e) dst[(size_t)(4 * q4 + e) * 256] = (bf16)f2bf(v[e]); } }
        for (int r = gw_; r < 8 * 2048; r += NGW_) { const int b = r >> 11, s = r & 2047; const float* src = cache_sb_k + (size_t)r * 1536;
            for (int j = lane * 4; j < 1536; j += 256) { const f32x4 v = *(const f32x4*)(src + j);
                *(unsigned long long*)(SBKS + ((size_t)(b * 12 + (j >> 7)) * 2080 + s) * 128 + (j & 127)) = (unsigned long long)pk2(v.x, v.y) | ((unsigned long long)pk2(v.z, v.w) << 32); } }
        for (int it = gw_; it < 3072; it += NGW_) { const int cb = it % 12, sb_ = (it / 12) & 31, b = it / 384, s = sb_ * 64 + lane;
            const float* src = cache_sb_v + (size_t)(b * 2048 + s) * 1536 + cb * 128; bf16* dst = SBVS + ((size_t)(b * 12 + cb) * 65 + (s >> 5)) * 4096 + pg8::vtf_k(s & 31);
            for (int q4 = 0; q4 < 32; ++q4) { const f32x4 v = *(const f32x4*)(src + 4 * q4);
#pragma unroll
                for (int e = 0; e < 4; ++e) dst[pg8::vtf_d(4 * q4 + e)] = (bf16)f2bf(v[e]); } }
        for (int l = 0; l < 4; ++l) wt_convert(F.lds, wave_, gw_, NGW_, lane, w_mem_kv + (size_t)l * D * 1024, D, 1024, WMEM + (size_t)l * 1024 * D, 1024, MapId());
        CONVERT_WEIGHTS(0);
    PHASE_END
    for (int l = 0; l < 4; ++l) {
        const bool LA = l < 2;
        const int ldp = LA ? NA : NBQ;
        PHASE_BEGIN(true, 2)
            if (!LA && (bid_ & 1)) { { SkBf16 E{PROJ, ldp}; skinny_gemm(bid_, G_, FRESH_TID(), wave_, F.lds + RING_OFF, X + (size_t)MP * D, D, WIN, D, ldp / 32, E); }
                if (l == 2) { SkKV E{out + O_SKS, out + O_SVS, SBKS, SBVS}; skinny_gemm(bid_, G_, FRESH_TID(), wave_, F.lds + RING_OFF, X + (size_t)MP * D, D, WIN + (size_t)NBQ * D, D, NKV / 32, E); } }
            { pg8::Gemm g{X, WIN, MP, ldp, D}; pg8::StaticOrder S; S.init(MP, ldp, G_, bid_); pg8::EpiBf16 E{PROJ, ldp};
              pg8::gemm_phase<pg8::EpiBf16, pg8::StaticOrder, true, true>(F.lds + RING_OFF, g, S, E, FRESH_TID()); }
            if (l == 0 && bid_ >= (G_ >> 1) && bid_ < (G_ >> 1) + 64) { pg8::Gemm g{MEMX, WMEM, 1024, 4096, D}; pg8::StaticOrder S; S.init(1024, 4096, 64, bid_ - (G_ >> 1));
              pg8::EpiMemKV E{out + O_MKP, out + O_MVP, MEMK, MEMV};
              pg8::gemm_phase<pg8::EpiMemKV, pg8::StaticOrder, true, true>(F.lds + RING_OFF, g, S, E, FRESH_TID()); }
            if (l == 2) { pg8::Gemm g{X, WIN + (size_t)NBQ * D, MP, NKV, D}; pg8::StaticOrder S; S.init(MP, NKV, G_, bid_);
              pg8::EpiKV E{out + O_SKP, out + O_SVP, out + O_SKS, out + O_SVS, KPB, VPB, SBKS, SBVS};
              pg8::gemm_phase<pg8::EpiKV, pg8::StaticOrder, true, true>(F.lds + RING_OFF, g, S, E, FRESH_TID()); }
            if (LA) { if (bid_ >= (G_ >> 1)) { SkBf16 E{PROJ, ldp}; skinny_gemm(bid_ - (G_ >> 1), G_ >> 1, FRESH_TID(), wave_, F.lds + RING_OFF, X + (size_t)MP * D, D, WIN, D, ldp / 32, E); } }
            else if (!(bid_ & 1))
            for (int skr = 0; skr < SK_REP; ++skr) { SkBf16 E{PROJ, ldp}; skinny_gemm(bid_, G_, FRESH_TID(), wave_, F.lds + RING_OFF, X + (size_t)MP * D, D, WIN, D, ldp / 32, E); }
            if (!(bid_ & 1))
            for (int skr = 0; skr < SK_REP; ++skr) if (l == 2) { SkKV E{out + O_SKS, out + O_SVS, SBKS, SBVS}; skinny_gemm(bid_, G_, FRESH_TID(), wave_, F.lds + RING_OFF, X + (size_t)MP * D, D, WIN + (size_t)NBQ * D, D, NKV / 32, E); }
        PHASE_END
        PHASE_BEGIN(LA, 3)
            gla_prep_intra(bid_, G_, tid, wave_, F.lds + RING_OFF, l, PROJ, w_gate_lr, b_gate, (unsigned char*)Y, OINT);
        PHASE_END
        PHASE_BEGIN(!LA, 11)
            {
#if defined(SB_MODE)
                for (int u = gw_; u < 12288; u += NGW_) { const int bh = u >> 8, qb = u & 255, b = bh / 12, h = bh % 12, t0 = 32 * qb; const size_t qo = (size_t)(b * SEQ + t0) * D + h * 128;
                    sb_attn<SB_MODE>(lane, F.lds + RING_OFF + wave_ * 16384, KPB + (size_t)bh * SEQ * 128, 128, VPB + (size_t)bh * SEQ * 128, 0, PROJ + qo, NBQ, OCAT + qo, t0, 32); }
#endif
                for (int sbr = 0; sbr < SB_REP; ++sbr)
                for (int u = gw_; u < 12288 + 96; u += NGW_) {
                    if (u < 12288) { const int bh = u >> 8, qb = u & 255, b = bh / 12, h = bh % 12, t0 = 32 * qb; const size_t qo = (size_t)(b * SEQ + t0) * D + h * 128;
                        sb_attn(lane, F.lds + RING_OFF + wave_ * 16384, KPB + (size_t)bh * SEQ * 128, 128, VPB + (size_t)bh * SEQ * 128, 0, PROJ + qo, NBQ, OCAT + qo, t0, 32); }
                    else { const int u2 = u - 12288, b = u2 / 12, h = u2 % 12; const size_t qo = (size_t)(MP + b * 16) * D + h * 128;
                        sb_attn(lane, F.lds + RING_OFF + wave_ * 16384, SBKS + (size_t)u2 * 2080 * 128, 128, SBVS + (size_t)u2 * 65 * 4096, 0, PROJ + qo, NBQ, OCAT + qo, 2048, 16); }
                }
            }
            __syncthreads();
            for (int mr = 0; mr < MEM_REP; ++mr)
            for (int wi = bid_; wi < 256 + 32; wi += G_) mem_attn_wg(wi, FRESH_TID(), wave_, F.lds + RING_OFF, l, PROJ, ldp, LA ? CQM : 1536, MEMK, MEMV, OCAT);
        PHASE_END
        PHASE_BEGIN(LA, 12)
            { const int mb = G_ > 144 ? bid_ - 144 : bid_, nmem = G_ > 144 ? G_ - 144 : G_;
              if (mb >= 0) for (int wi = mb; wi < 256 + 32; wi += nmem) mem_attn_wg(wi, FRESH_TID(), wave_, F.lds + RING_OFF, l, PROJ, ldp, CQM, MEMK, MEMV, OCAT); }
            for (int wc = bid_; wc < 144; wc += G_) gla_chain<1>(wc, FRESH_TID(), wave_, F.lds + RING_OFF, l, (const unsigned char*)Y, state_gla, OINT, out, (float*)WMEM, (float*)MEMX);
        PHASE_END
        PHASE_BEGIN(LA, 5)
            for (int wc = bid_; wc < 192 + 96; wc += G_) gla_chain<2>(wc, FRESH_TID(), wave_, F.lds + RING_OFF, l, (const unsigned char*)Y, state_gla, OINT, out, (float*)WMEM, (float*)MEMX, REP_CLS == 5 && rep_ == 0);
        PHASE_END
        PHASE_BEGIN(LA, 6)
            const float* gn = gla_norm_g + (size_t)l * 384;
            for (int row = gw_; row < MR; row += NGW_) {
                const float* op = OINT + (size_t)row * 1536 + 24 * lane; const bf16* gp = PROJ + (size_t)row * NA + CG + 24 * lane; const float* gnp = gn + 24 * (lane & 15);
                f32x4 ov[6]; v4u gv[3]; float ss = 0.f;
#pragma unroll
                for (int j = 0; j < 6; ++j) { ov[j] = *(const f32x4*)(op + 4 * j); ss += (ov[j].x * ov[j].x + ov[j].y * ov[j].y) + (ov[j].z * ov[j].z + ov[j].w * ov[j].w); }
#pragma unroll
                for (int j = 0; j < 3; ++j) gv[j] = *(const v4u*)(gp + 8 * j);
                ss += shx(ss, lane, 1); ss += shx(ss, lane, 2); ss += shx(ss, lane, 4); ss += shx(ss, lane, 8);
                const float r = 1.0f / sqrtf(ss * (1.0f / 384.0f) + RMS_EPS);
#pragma unroll
                for (int j = 0; j < 3; ++j) { const f32x4 n0 = *(const f32x4*)(gnp + 8 * j), n1 = *(const f32x4*)(gnp + 8 * j + 4); const f32x4 a = ov[2 * j], b = ov[2 * j + 1];
                    float gt[8]; gt[0] = pg8::bflo(gv[j].x); gt[1] = pg8::bfhi(gv[j].x); gt[2] = pg8::bflo(gv[j].y); gt[3] = pg8::bfhi(gv[j].y); gt[4] = pg8::bflo(gv[j].z); gt[5] = pg8::bfhi(gv[j].z); gt[6] = pg8::bflo(gv[j].w); gt[7] = pg8::bfhi(gv[j].w);
                    float o8[8];
#pragma unroll
                    for (int i = 0; i < 4; ++i) { o8[i] = a[i] * r * n0[i] * (gt[i] * __builtin_amdgcn_rcpf(1.0f + __expf(-gt[i]))); o8[4 + i] = b[i] * r * n1[i] * (gt[4 + i] * __builtin_amdgcn_rcpf(1.0f + __expf(-gt[4 + i]))); }
                    v4u o; o.x = pk2(o8[0], o8[1]); o.y = pk2(o8[2], o8[3]); o.z = pk2(o8[4], o8[5]); o.w = pk2(o8[6], o8[7]);
                    *(v4u*)(OCAT + (size_t)row * D + 24 * lane + 8 * j) = o; }
            }
        PHASE_END
        PHASE_BEGIN(true, 7)
            if (bid_ & 1) { SkRes Es{YB, X, DN_ALPHA}; skinny_gemm(bid_, G_, FRESH_TID(), wave_, F.lds + RING_OFF, OCAT + (size_t)MP * D, D, WO, D, D / 32, Es); }
            pg8::Gemm g{OCAT, WO, MP, D, D}; pg8::StaticOrder S; S.init(MP, D, G_, bid_); pg8::EpiRes E{YB, X, D, DN_ALPHA};
            pg8::gemm_phase<pg8::EpiRes, pg8::StaticOrder, true, true>(F.lds + RING_OFF, g, S, E, FRESH_TID());
            if (!(bid_ & 1))
            for (int skr = 0; skr < SK_REP; ++skr) { SkRes Es{YB, X, DN_ALPHA}; skinny_gemm(bid_, G_, FRESH_TID(), wave_, F.lds + RING_OFF, OCAT + (size_t)MP * D, D, WO, D, D / 32, Es); }
        PHASE_END
        PHASE_BEGIN(true, 8)
            const float* gg = ln1_g + (size_t)l * D; const float* bb = ln1_b + (size_t)l * D;
            for (int row = 2 * gw_; row < MR; row += 2 * NGW_) ln_two_rows<false>(lane, YB + (size_t)row * D, YB + (size_t)(row + 1) * D, gg, bb, X + (size_t)row * D, X + (size_t)(row + 1) * D, nullptr, nullptr);
        PHASE_END
        PHASE_BEGIN(true, 9)
            for (int dl = 0; dl < 3 * STAG * (bid_ >> 1 & 3); ++dl) __builtin_amdgcn_s_sleep(127);
            if (bid_ & 1) { SkSwiGLU Es{HB}; skinny_gemm(bid_, G_, FRESH_TID(), wave_, F.lds + RING_OFF, X + (size_t)MP * D, D, WFI, D, DFF / 16, Es); }
            pg8::Gemm g{X, WFI, MP, 2 * DFF, D}; pg8::StaticOrder S; S.init(MP, 2 * DFF, G_, bid_); pg8::EpiSwiGLU E{HB, DFF};
            pg8::gemm_phase<pg8::EpiSwiGLU, pg8::StaticOrder, true, true>(F.lds + RING_OFF, g, S, E, FRESH_TID());
            if (!(bid_ & 1))
            for (int skr = 0; skr < SK_REP; ++skr) { SkSwiGLU Es{HB}; skinny_gemm(bid_, G_, FRESH_TID(), wave_, F.lds + RING_OFF, X + (size_t)MP * D, D, WFI, D, DFF / 16, Es); }
        PHASE_END
        PHASE_BEGIN(true, 10)
            if (bid_ & 1) { SkRes Es{YB, X, DN_ALPHA}; skinny_gemm(bid_, G_, FRESH_TID(), wave_, F.lds + RING_OFF, HB + (size_t)MP * DFF, DFF, WFO, DFF, D / 32, Es); }
            pg8::Gemm g{HB, WFO, MP, D, DFF}; pg8::StaticOrder S; S.init(MP, D, G_, bid_); pg8::EpiRes E{YB, X, D, DN_ALPHA};
            pg8::gemm_phase<pg8::EpiRes, pg8::StaticOrder, true, true>(F.lds + RING_OFF, g, S, E, FRESH_TID());
            if (!(bid_ & 1))
            for (int skr = 0; skr < SK_REP; ++skr) { SkRes Es{YB, X, DN_ALPHA}; skinny_gemm(bid_, G_, FRESH_TID(), wave_, F.lds + RING_OFF, HB + (size_t)MP * DFF, DFF, WFO, DFF, D / 32, Es); }
        PHASE_END
        PHASE_BEGIN(true, 8)
            if (l < 3) CONVERT_WEIGHTS(l + 1);
            const float* gg = ln2_g + (size_t)l * D; const float* bb = ln2_b + (size_t)l * D;
            if (l == 3) { for (int row = 2 * gw_; row < MR; row += 2 * NGW_) { float* of = row < MP ? out + O_YP + (size_t)row * D : out + O_YS + (size_t)(row - MP) * D;
                ln_two_rows<true>(lane, YB + (size_t)row * D, YB + (size_t)(row + 1) * D, gg, bb, nullptr, nullptr, of, of + D); } }
            else for (int row = 2 * gw_; row < MR; row += 2 * NGW_) ln_two_rows<false>(lane, YB + (size_t)row * D, YB + (size_t)(row + 1) * D, gg, bb, X + (size_t)row * D, X + (size_t)(row + 1) * D, nullptr, nullptr);
        PHASE_END
    }
#if defined(DIAG_A)
    if (blockIdx.x == 0 && threadIdx.x == 0) { unsigned long long* dts = (unsigned long long*)(args.ws_ + 262144); dts[ph] = rt(); dts[63] = (unsigned long long)ph; }
#endif
#undef ws
#undef out
#undef X
#undef Y
#undef YB
#undef CONVERT_WEIGHTS
#undef PHASE_BEGIN
#undef PHASE_END
}

#if defined(DIAG_A)
__device__ const int diag_cls[40] = {0,0, 1,2,3,4,5,6,7,8,9,10,8, 1,2,3,4,5,6,7,8,9,10,8, 1,2,11,7,8,9,10,8, 1,2,11,7,8,9,10,8};
__global__ void diag_tail(float* o, const unsigned long long* dts) {
    __shared__ float dv[2];
    if (threadIdx.x == 0) { const int n = (int)dts[63]; unsigned long long sa = 0, sb = 0; for (int p = 0; p < n; ++p) { const unsigned long long d = dts[p + 1] - dts[p]; const int cl = diag_cls[p]; if (cl == DIAG_A) sa += d; if (cl == DIAG_B) sb += d; }
        dv[0] = (float)sa * 0.01f; dv[1] = (float)sb * 10.0f; }
    __syncthreads();
    for (int i = threadIdx.x; i < 262144; i += blockDim.x) o[O_YS + i] = dv[0];
    if (threadIdx.x == 0) o[O_YP] = dv[1];
}
#endif
#ifndef MK_PER_PHASE
#define MK_PER_PHASE 0
#endif
constexpr int N_PHASES = 1 + 2 * 10 + 2 * 7;
extern "C" void kernel_launch(void* const* d_in, const int* in_sizes, int n_in, void* d_out, int out_size, void* d_ws, size_t ws_size, hipStream_t stream) {
    static int grid = 0;
    if (grid == 0) {
        if (n_in != 22 || in_sizes[0] != MP * D || (size_t)out_size != O_END || ws_size < WS_END) { fprintf(stderr, "kernel_launch: unexpected shapes (n_in %d, in0 %d, out %d, ws %zu); nothing launched\n", n_in, n_in > 0 ? in_sizes[0] : -1, out_size, ws_size); grid = -1; return; }
        int dev = 0, cus = 0, per_cu = 0;
        if (hipGetDevice(&dev) != hipSuccess || hipDeviceGetAttribute(&cus, hipDeviceAttributeMultiprocessorCount, dev) != hipSuccess) { grid = -1; return; }
        if (hipFuncSetAttribute((const void*)mega, hipFuncAttributeMaxDynamicSharedMemorySize, LDS_BYTES) != hipSuccess) { fprintf(stderr, "kernel_launch: hipFuncSetAttribute failed\n"); grid = -1; return; }
        if (hipOccupancyMaxActiveBlocksPerMultiprocessor(&per_cu, (const void*)mega, NWAVES * 64, LDS_BYTES) != hipSuccess || per_cu < 1) fprintf(stderr, "kernel_launch: occupancy query reports %d\n", per_cu);
        (void)hipGetLastError();
        grid = cus;
    }
    if (grid < 0) return;
    if (hipMemsetAsync((char*)d_ws + WS_CTL, 0, CTL_ZERO_BYTES, stream) != hipSuccess) return;
    Args a{};
    for (int i = 0; i < 22; ++i) a.in[i] = (const float*)d_in[i];
    a.out_ = (float*)d_out; a.ws_ = (unsigned char*)d_ws;
#if MK_PER_PHASE
    for (int p = 0; p < N_PHASES; ++p) { a.ph_lo = p; a.ph_hi = p + 1; hipLaunchKernelGGL(mega, dim3(grid), dim3(NWAVES * 64), LDS_BYTES, stream, a); }
#else
    a.ph_lo = 0; a.ph_hi = N_PHASES; hipLaunchKernelGGL(mega, dim3(grid), dim3(NWAVES * 64), LDS_BYTES, stream, a);
#if defined(DIAG_A)
    hipLaunchKernelGGL(diag_tail, dim3(1), dim3(512), 0, stream, (float*)d_out, (const unsigned long long*)((unsigned char*)d_ws + 262144));
#endif
#endif
}
```

```cpp
#include <hip/hip_runtime.h>
#include <cstdio>
#include <cstdint>
namespace pg8 {
#define PG8_LAS __attribute__((address_space(3)))
typedef unsigned short bf16_t;
typedef short bf16x8 __attribute__((ext_vector_type(8)));
typedef float f32x4 __attribute__((ext_vector_type(4)));
typedef unsigned u32x4 __attribute__((ext_vector_type(4)));
constexpr int BM = 256, BK = 64, HALF = 128, HTB = HALF * BK * 2  , STAGE_BYTES = 8 * HTB, NXCD = 8, WGM = 4;

__host__ __device__ __forceinline__ int lds_byte(int r, int c) { const int st = (r >> 4) * 2 + (c >> 5), rr = r & 15, cc = c & 31, ob = rr * 64 + cc * 2; return st * 1024 + (ob ^ (((ob >> 9) & 1) << 5)); }
__host__ __device__ __forceinline__ void stage_rc(int b, int& R, int& C) { const int st = b / 1024, sb = b % 1024, swz = sb ^ (((sb >> 9) & 1) << 5); R = (st >> 1) * 16 + swz / 64; C = (st & 1) * 32 + (swz % 64) / 2; }
__host__ __device__ __forceinline__ int perm32(int rho) { const int n = rho >> 4, i = rho & 15; return 8 * (i >> 2) + 4 * n + (i & 3); }

struct Unit { int pm, pn; };
struct Gemm { const bf16_t* A; const bf16_t* Bt; int M, N, K; };

struct StaticOrder {
    int nM, nN, nwg, G, c;
    __host__ __device__ void init(int M, int N, int G_, int c_) { nM = M / BM; nN = N / BM; nwg = nM * nN; G = G_; c = c_; }
    __host__ __device__ bool next(int i, Unit& u) const {
        const long L = (long)i * G + c; if (L >= nwg) return false;
        int wgid = (int)L; { const int q = nwg / NXCD, r = nwg % NXCD, xcd = wgid % NXCD, off = wgid / NXCD; wgid = (xcd < r ? xcd * (q + 1) : r * (q + 1) + (xcd - r) * q) + off; }
        const int nig = WGM * nN, gid = wgid / nig, fm = gid * WGM, gsz = (nM - fm) < WGM ? (nM - fm) : WGM;
        u.pm = fm + ((wgid % nig) % gsz); u.pn = (wgid % nig) / gsz; return true;
    }
    __device__ __forceinline__ void a_ready(const Unit&) const {}
    __device__ __forceinline__ void done(const Unit&) const {}
};
__device__ __forceinline__ unsigned cvt_pk_bf16(float lo, float hi) { unsigned r; asm volatile("v_cvt_pk_bf16_f32 %0, %1, %2" : "=v"(r) : "v"(lo), "v"(hi)); return r; }
typedef float f32x2 __attribute__((ext_vector_type(2)));
typedef unsigned u32x2 __attribute__((ext_vector_type(2)));
__host__ __device__ __forceinline__ int vtf_d(int d) { return (d >> 5) * 1024 + (d & 31) * 8; }
__host__ __device__ __forceinline__ int vtf_k(int ks) { return (ks >> 4) * 512 + ((ks >> 2) & 1) * 256 + (ks & 3) + 4 * ((ks >> 3) & 1); }
__device__ __forceinline__ float bflo(unsigned w) { return __builtin_bit_cast(float, w << 16); }
__device__ __forceinline__ float bfhi(unsigned w) { return __builtin_bit_cast(float, w & 0xffff0000u); }
struct EpiBf16 {
    static constexpr bool PERM = true, AFTER_DRAIN = false;
    bf16_t* O; int ldc;
    __device__ __forceinline__ void operator()(const f32x4 (&acc)[2][2][4][2], const Unit& u, int wr, int wc, int fr, int fq) const {
        const int row0 = u.pm * BM + wr * 64 + fr, col0 = u.pn * BM + wc * 32 + 8 * fq;
#pragma unroll
        for (int ai = 0; ai < 2; ++ai)
#pragma unroll
            for (int m = 0; m < 4; ++m) { bf16_t* rowp = O + (size_t)(row0 + ai * HALF + m * 16) * ldc + col0;
#pragma unroll
                for (int bj = 0; bj < 2; ++bj) { const f32x4 v0 = acc[ai][bj][m][0], v1 = acc[ai][bj][m][1];
                    u32x4 w; w.x = cvt_pk_bf16(v0[0], v0[1]); w.y = cvt_pk_bf16(v0[2], v0[3]); w.z = cvt_pk_bf16(v1[0], v1[1]); w.w = cvt_pk_bf16(v1[2], v1[3]);
                    *(u32x4*)(rowp + bj * HALF) = w; } }
    }
};
struct EpiSwiGLU {
    static constexpr bool PERM = true, AFTER_DRAIN = false;
    bf16_t* Hh; int ldh;
    __device__ __forceinline__ float swi(float g, float up) const { return g * __builtin_amdgcn_rcpf(1.0f + __expf(-g)) * up; }
    __device__ __forceinline__ void operator()(const f32x4 (&acc)[2][2][4][2], const Unit& u, int wr, int wc, int fr, int fq) const {
        const int row0 = u.pm * BM + wr * 64 + fr, col0 = u.pn * HALF + wc * 32 + 8 * fq;
#pragma unroll
        for (int ai = 0; ai < 2; ++ai)
#pragma unroll
            for (int m = 0; m < 4; ++m) { bf16_t* rowp = Hh + (size_t)(row0 + ai * HALF + m * 16) * ldh + col0;
                const f32x4 g0 = acc[ai][0][m][0], g1 = acc[ai][0][m][1], u0 = acc[ai][1][m][0], u1 = acc[ai][1][m][1];
                u32x4 w; w.x = cvt_pk_bf16(swi(g0[0], u0[0]), swi(g0[1], u0[1])); w.y = cvt_pk_bf16(swi(g0[2], u0[2]), swi(g0[3], u0[3]));
                w.z = cvt_pk_bf16(swi(g1[0], u1[0]), swi(g1[1], u1[1])); w.w = cvt_pk_bf16(swi(g1[2], u1[2]), swi(g1[3], u1[3]));
                *(u32x4*)rowp = w; }
    }
};
struct EpiRes {
    static constexpr bool PERM = true, AFTER_DRAIN = false;
    bf16_t* Y; const bf16_t* X; int ldc; float alpha;
    __device__ __forceinline__ void operator()(const f32x4 (&acc)[2][2][4][2], const Unit& u, int wr, int wc, int fr, int fq) const {
        const int row0 = u.pm * BM + wr * 64 + fr, col0 = u.pn * BM + wc * 32 + 8 * fq;
        u32x4 xv[2][4][2];
#pragma unroll
        for (int ai = 0; ai < 2; ++ai)
#pragma unroll
            for (int m = 0; m < 4; ++m)
#pragma unroll
                for (int bj = 0; bj < 2; ++bj) xv[ai][m][bj] = *(const u32x4*)(X + (size_t)(row0 + ai * HALF + m * 16) * ldc + col0 + bj * HALF);
#pragma unroll
        for (int ai = 0; ai < 2; ++ai)
#pragma unroll
            for (int m = 0; m < 4; ++m) { const size_t ro = (size_t)(row0 + ai * HALF + m * 16) * ldc + col0;
#pragma unroll
                for (int bj = 0; bj < 2; ++bj) { const u32x4 x4 = xv[ai][m][bj]; const f32x4 a0 = acc[ai][bj][m][0], a1 = acc[ai][bj][m][1];
                    u32x4 w; w.x = cvt_pk_bf16(alpha * bflo(x4.x) + a0[0], alpha * bfhi(x4.x) + a0[1]); w.y = cvt_pk_bf16(alpha * bflo(x4.y) + a0[2], alpha * bfhi(x4.y) + a0[3]);
                    w.z = cvt_pk_bf16(alpha * bflo(x4.z) + a1[0], alpha * bfhi(x4.z) + a1[1]); w.w = cvt_pk_bf16(alpha * bflo(x4.w) + a1[2], alpha * bfhi(x4.w) + a1[3]);
                    *(u32x4*)(Y + ro + bj * HALF) = w; } }
    }
};
struct EpiKV {
    static constexpr bool PERM = false, AFTER_DRAIN = false;
    float *okp, *ovp, *oks, *ovs; bf16_t *kpb, *vpb, *ksb, *vsb;
    __device__ __forceinline__ void operator()(const f32x4 (&acc)[2][2][4][2], const Unit& u, int wr, int wc, int fr, int fq) const {
        const bool isv = u.pn >= 6; const int colt = (u.pn - (isv ? 6 : 0)) * BM + wc * 32 + 4 * fq, row0 = u.pm * BM + wr * 64 + fr;
        float* op = isv ? ovp : okp;
#pragma unroll
        for (int ai = 0; ai < 2; ++ai)
#pragma unroll
            for (int m = 0; m < 4; ++m) { const int row = row0 + ai * HALF + m * 16; float* fd;
                if (row < 32768) { fd = op + (size_t)row * 1536; } else continue;
                const int bq = row >> 13, sq = row & 8191;
#pragma unroll
                for (int bj = 0; bj < 2; ++bj)
#pragma unroll
                    for (int n = 0; n < 2; ++n) { const int c = colt + bj * HALF + n * 16; const f32x4 v = acc[ai][bj][m][n];
                        *(f32x4*)(fd + c) = v; const unsigned w0 = cvt_pk_bf16(v[0], v[1]), w1 = cvt_pk_bf16(v[2], v[3]);
                        const int hq = c >> 7, dq = c & 127;
                        if (!isv) { u32x2 w; w.x = w0; w.y = w1; *(u32x2*)(kpb + ((size_t)(bq * 12 + hq) * 8192 + sq) * 128 + dq) = w; }
                        else { bf16_t* vt = vpb + ((size_t)(bq * 12 + hq) * 256 + (sq >> 5)) * 4096 + vtf_d(dq) + vtf_k(sq & 31); vt[0] = (bf16_t)w0; vt[8] = (bf16_t)(w0 >> 16); vt[16] = (bf16_t)w1; vt[24] = (bf16_t)(w1 >> 16); } } }
    }
};
struct EpiMemKV {
    static constexpr bool PERM = false, AFTER_DRAIN = false;
    float *ok, *ov; bf16_t *kb, *vb;
    __device__ __forceinline__ void operator()(const f32x4 (&acc)[2][2][4][2], const Unit& u, int wr, int wc, int fr, int fq) const {
        const int l = u.pn >> 2, kv = (u.pn >> 1) & 1, hd0 = (u.pn & 1) * BM + wc * 32 + 4 * fq, row0 = u.pm * BM + wr * 64 + fr;
        float* fo = kv ? ov : ok; bf16_t* bo = kv ? vb : kb;
#pragma unroll
        for (int ai = 0; ai < 2; ++ai)
#pragma unroll
            for (int m = 0; m < 4; ++m) { const int row = row0 + ai * HALF + m * 16, b = row >> 8, mm = row & 255;
                float* fd = fo + (size_t)(l * 1024 + row) * 512; bf16_t* bd = bo + (size_t)((l * 12 + b) * 256 + mm) * 512;
#pragma unroll
                for (int bj = 0; bj < 2; ++bj)
#pragma unroll
                    for (int n = 0; n < 2; ++n) { const int c = hd0 + bj * HALF + n * 16; const f32x4 v = acc[ai][bj][m][n];
                        *(f32x4*)(fd + c) = v; const unsigned w0 = cvt_pk_bf16(v[0], v[1]), w1 = cvt_pk_bf16(v[2], v[3]);
                        if (!kv) { u32x2 w; w.x = w0; w.y = w1; *(u32x2*)(bd + c) = w; }
                        else { bf16_t* vt = vb + (size_t)((l * 12 + b) * 512 + c) * 256 + mm;
                            vt[0] = (bf16_t)w0; vt[256] = (bf16_t)(w0 >> 16); vt[512] = (bf16_t)w1; vt[768] = (bf16_t)(w1 >> 16); } } }
    }
};
template <class Epi, class Sched, bool ALIGN_EPI = false, bool SP2 = false>
__device__ __forceinline__ void gemm_phase(PG8_LAS unsigned char* lds, const Gemm g, const Sched& S, const Epi& E, int tid_in) {
    int tid_ = tid_in; asm volatile("" : "+v"(tid_));
    const int tid = tid_, wid = __builtin_amdgcn_readfirstlane(tid >> 6), lane = tid & 63, wr = wid >> 2, wc = wid & 3, fr = lane & 15, fq = lane >> 4;
    const int K = g.K, nt = K / BK;
    unsigned voffA[2], voffB[2];
#pragma unroll
    for (int i = 0; i < 2; ++i) { int R, C; stage_rc(tid * 16 + i * 8192, R, C); const int Rb = Epi::PERM ? ((R & ~31) + perm32(R & 31)) : R;
        voffA[i] = (unsigned)(R * K + C) * 2u; voffB[i] = (unsigned)(Rb * K + C) * 2u; }
    const size_t kstep = (size_t)(BK * 2);
    const size_t hstep = (size_t)HALF * K * 2;
    const size_t tstep = 2 * hstep;
    const unsigned ldsw = (unsigned)wid * 1024u;
    const int aoff = lds_byte(wr * 64 + fr, fq * 8), boff = lds_byte(wc * 32 + fr, fq * 8);
#define PG8_SA(b, h) (((b) * 2 + (h)) * HTB)
#define PG8_SB(b, h) ((4 + (b) * 2 + (h)) * HTB)
#define PG8_STAGE(bufoff, gbase, voff) do { _Pragma("unroll") for (int _i = 0; _i < 2; ++_i) \
        __builtin_amdgcn_global_load_lds((const unsigned*)((const char*)(gbase) + (voff)[_i]), (PG8_LAS unsigned*)(lds + (bufoff) + ldsw + _i * 8192), 16, 0, 0); } while (0)
#define PG8_LDA(dst, b, h) do { _Pragma("unroll") for (int m = 0; m < 4; ++m) _Pragma("unroll") for (int k = 0; k < 2; ++k) dst[m][k] = *(const PG8_LAS bf16x8*)(lds + PG8_SA(b, h) + aoff + m * 2048 + k * 1024); } while (0)
#define PG8_LDB(dst, b, h) do { _Pragma("unroll") for (int n = 0; n < 2; ++n) _Pragma("unroll") for (int k = 0; k < 2; ++k) dst[n][k] = *(const PG8_LAS bf16x8*)(lds + PG8_SB(b, h) + boff + n * 2048 + k * 1024); } while (0)
#define PG8_MMA(ai, bj, At, Bt) do { __builtin_amdgcn_s_setprio(1); _Pragma("unroll") for (int m = 0; m < 4; ++m) _Pragma("unroll") for (int n = 0; n < 2; ++n) _Pragma("unroll") for (int k = 0; k < 2; ++k) \
        acc[ai][bj][m][n] = __builtin_amdgcn_mfma_f32_16x16x32_bf16(Bt[n][k], At[m][k], acc[ai][bj][m][n], 0, 0, 0); __builtin_amdgcn_s_setprio(0); } while (0)
#define PG8_WAIT_V(n) asm volatile("s_waitcnt vmcnt(" #n ")" ::: "memory")
#define PG8_WAIT_L(n) asm volatile("s_waitcnt lgkmcnt(" #n ")" ::: "memory")
#define PG8_BAR __builtin_amdgcn_s_barrier()
#define PG8_SCHED __builtin_amdgcn_sched_barrier(0)
    Unit cur, nxt; int ui = 0;
    if (!S.next(0, cur)) return;
    f32x4 acc[2][2][4][2];
#pragma unroll
    for (int a = 0; a < 2; ++a)
#pragma unroll
        for (int b = 0; b < 2; ++b)
#pragma unroll
            for (int m = 0; m < 4; ++m)
#pragma unroll
                for (int n = 0; n < 2; ++n) acc[a][b][m][n] = (f32x4){0.f, 0.f, 0.f, 0.f};
    bf16x8 At[4][2], B0[2][2], B1[2][2];
    const char* cA = (const char*)g.A + (size_t)cur.pm * tstep; const char* cB = (const char*)g.Bt + (size_t)cur.pn * tstep;
    S.a_ready(cur);
    if constexpr (SP2) {
        PG8_STAGE(PG8_SB(0, 0), cB, voffB); PG8_STAGE(PG8_SB(0, 1), cB + hstep, voffB); PG8_STAGE(PG8_SA(0, 0), cA, voffA); PG8_STAGE(PG8_SA(0, 1), cA + hstep, voffA);
        if (wr == 1) PG8_BAR;
        PG8_WAIT_V(2); PG8_BAR;
        PG8_STAGE(PG8_SB(1, 0), cB + kstep, voffB); PG8_STAGE(PG8_SA(1, 0), cA + kstep, voffA); PG8_STAGE(PG8_SB(1, 1), cB + hstep + kstep, voffB);
        PG8_WAIT_V(6); PG8_BAR;
    } else {
        PG8_STAGE(PG8_SB(0, 0), cB, voffB); PG8_STAGE(PG8_SA(0, 0), cA, voffA); PG8_STAGE(PG8_SB(0, 1), cB + hstep, voffB); PG8_STAGE(PG8_SA(0, 1), cA + hstep, voffA);
        if (wr == 1) PG8_BAR;
        PG8_WAIT_V(4); PG8_BAR;
        PG8_STAGE(PG8_SB(1, 0), cB + kstep, voffB); PG8_STAGE(PG8_SA(1, 0), cA + kstep, voffA); PG8_STAGE(PG8_SB(1, 1), cB + hstep + kstep, voffB);
        PG8_WAIT_V(6); PG8_BAR;
    }
    for (;;) {
        const bool has_next = S.next(ui + 1, nxt);
        const char* nA = has_next ? (const char*)g.A + (size_t)nxt.pm * tstep : cA; const char* nB = has_next ? (const char*)g.Bt + (size_t)nxt.pn * tstep : cB;
        for (int t = 0; t < nt; t += 2) {
            const bool last = (t == nt - 2);
            const char* a1 = cA + (size_t)(t + 1) * kstep;
            const char* a2 = last ? nA : cA + (size_t)(t + 2) * kstep; const char* b2 = last ? nB : cB + (size_t)(t + 2) * kstep;
            const char* a3 = a2 + kstep; const char* b3 = b2 + kstep;
            if (last && has_next) S.a_ready(nxt);
            if constexpr (SP2) {
            PG8_LDB(B0, 0, 0); PG8_LDB(B1, 0, 1); PG8_SCHED; PG8_LDA(At, 0, 0); PG8_STAGE(PG8_SA(1, 1), a1 + hstep, voffA);
            PG8_WAIT_V(8); PG8_WAIT_L(0); PG8_BAR; PG8_MMA(0, 0, At, B0); PG8_MMA(0, 1, At, B1); PG8_BAR; PG8_SCHED;
            PG8_LDA(At, 0, 1); PG8_STAGE(PG8_SB(0, 0), b2, voffB); PG8_STAGE(PG8_SB(0, 1), b2 + hstep, voffB); PG8_STAGE(PG8_SA(0, 0), a2, voffA);
            PG8_WAIT_V(8); PG8_WAIT_L(0); PG8_BAR; PG8_MMA(1, 0, At, B0); PG8_MMA(1, 1, At, B1); PG8_BAR; PG8_SCHED;
            PG8_LDB(B0, 1, 0); PG8_LDB(B1, 1, 1); PG8_SCHED; PG8_LDA(At, 1, 0); PG8_STAGE(PG8_SA(0, 1), a2 + hstep, voffA);
            PG8_WAIT_V(8); PG8_WAIT_L(0); PG8_BAR; PG8_MMA(0, 0, At, B0); PG8_MMA(0, 1, At, B1); PG8_BAR; PG8_SCHED;
            PG8_LDA(At, 1, 1); PG8_STAGE(PG8_SB(1, 0), b3, voffB); PG8_STAGE(PG8_SB(1, 1), b3 + hstep, voffB); PG8_STAGE(PG8_SA(1, 0), a3, voffA);
            PG8_WAIT_V(8); PG8_WAIT_L(0); PG8_BAR; PG8_MMA(1, 0, At, B0); PG8_MMA(1, 1, At, B1); PG8_BAR; PG8_SCHED;
            } else {
            PG8_LDB(B0, 0, 0); PG8_SCHED; PG8_LDA(At, 0, 0); PG8_STAGE(PG8_SA(1, 1), a1 + hstep, voffA);
            PG8_WAIT_L(8); PG8_BAR; PG8_WAIT_L(0); PG8_MMA(0, 0, At, B0); PG8_BAR; PG8_SCHED;
            PG8_LDB(B1, 0, 1); PG8_STAGE(PG8_SB(0, 0), b2, voffB);
            PG8_BAR; PG8_WAIT_L(0); PG8_MMA(0, 1, At, B1); PG8_BAR;
            PG8_LDA(At, 0, 1); PG8_STAGE(PG8_SA(0, 0), a2, voffA);
            PG8_BAR; PG8_WAIT_L(0); PG8_MMA(1, 0, At, B0); PG8_BAR; PG8_SCHED;
            PG8_STAGE(PG8_SB(0, 1), b2 + hstep, voffB);
            PG8_WAIT_V(6); PG8_BAR; PG8_MMA(1, 1, At, B1); PG8_BAR;
            PG8_LDB(B0, 1, 0); PG8_SCHED; PG8_LDA(At, 1, 0); PG8_STAGE(PG8_SA(0, 1), a2 + hstep, voffA);
            PG8_WAIT_L(8); PG8_BAR; PG8_WAIT_L(0); PG8_MMA(0, 0, At, B0); PG8_BAR; PG8_SCHED;
            PG8_LDB(B1, 1, 1); PG8_STAGE(PG8_SB(1, 0), b3, voffB);
            PG8_BAR; PG8_WAIT_L(0); PG8_MMA(0, 1, At, B1); PG8_BAR;
            PG8_LDA(At, 1, 1); PG8_STAGE(PG8_SA(1, 0), a3, voffA);
            PG8_BAR; PG8_WAIT_L(0); PG8_MMA(1, 0, At, B0); PG8_BAR; PG8_SCHED;
            PG8_STAGE(PG8_SB(1, 1), b3 + hstep, voffB);
            PG8_WAIT_V(6); PG8_BAR; PG8_MMA(1, 1, At, B1); PG8_BAR;
            }
        }
        if constexpr (ALIGN_EPI) { if (wr == 0) PG8_BAR; }
        if constexpr (!Epi::AFTER_DRAIN) { E(acc, cur, wr, wc, fr, fq); S.done(cur); }
        if (!has_next) break;
#pragma unroll
        for (int a = 0; a < 2; ++a)
#pragma unroll
            for (int b = 0; b < 2; ++b)
#pragma unroll
                for (int m = 0; m < 4; ++m)
#pragma unroll
                    for (int n = 0; n < 2; ++n) acc[a][b][m][n] = (f32x4){0.f, 0.f, 0.f, 0.f};
        cur = nxt; cA = nA; cB = nB; ++ui;
        if constexpr (ALIGN_EPI) { if (wr == 1) PG8_BAR; }
    }
    PG8_WAIT_V(0);
    if constexpr (!ALIGN_EPI) { if (wr == 0) PG8_BAR; }
    PG8_BAR;
    if constexpr (Epi::AFTER_DRAIN) { E.fused(acc, cur, wr, wc, fr, fq, lds, wid, lane); S.done(cur); }
#undef PG8_SA
#undef PG8_SB
#undef PG8_STAGE
#undef PG8_LDA
#undef PG8_LDB
#undef PG8_MMA
#undef PG8_WAIT_V
#undef PG8_WAIT_L
#undef PG8_BAR
#undef PG8_SCHED
}
}
#define GAS __attribute__((address_space(1)))
#define LAS __attribute__((address_space(3)))
typedef unsigned short bf16;
typedef unsigned v4u __attribute__((ext_vector_type(4)));
typedef float f32x4 __attribute__((ext_vector_type(4)));
typedef short bf16x8 __attribute__((ext_vector_type(8)));
typedef GAS unsigned gu32;
typedef GAS unsigned long long gu64;
#define RLX_AGENT __ATOMIC_RELAXED, __HIP_MEMORY_SCOPE_AGENT
#define LDS_WAIT() asm volatile("s_waitcnt lgkmcnt(0)" ::: "memory")
#define VM_WAIT() asm volatile("s_waitcnt vmcnt(0)" ::: "memory")
__device__ __forceinline__ unsigned long long rt() { return __builtin_amdgcn_s_memrealtime(); }
__device__ __forceinline__ unsigned f2bf(float f) { unsigned u = __builtin_bit_cast(unsigned, f); return (u + 0x7fffu + ((u >> 16) & 1u)) >> 16; }
__device__ __forceinline__ unsigned pk2(float lo, float hi) { return f2bf(lo) | (f2bf(hi) << 16); }
#define XB_TMO      128
#define XB_XCNT(j)  (256  + 64 * (j))
#define XB_XSUB(j)  (1280 + 64 * (j))
#define XB_XGEN(j)  (2304 + 64 * (j))
#define XB_TOP      3328
#define XB_TOPGEN   3392
#define XCD_BAR_WORDS 3456
#define XB_SPIN_CAP (1u << 18)

__device__ __forceinline__ unsigned xb_ld(unsigned* p)              { return __hip_atomic_load(p, __ATOMIC_RELAXED, __HIP_MEMORY_SCOPE_AGENT); }
__device__ __forceinline__ unsigned xb_add(unsigned* p, unsigned v) { return __hip_atomic_fetch_add(p, v, __ATOMIC_RELAXED, __HIP_MEMORY_SCOPE_AGENT); }
__device__ __forceinline__ unsigned xb_xcc_id() { return (unsigned)__builtin_amdgcn_s_getreg((3 << 11) | 20) & 0xFu; }
#define XB_SPIN(cond, bar) do { unsigned _sp = 0; while (cond) { __builtin_amdgcn_s_sleep(1); \
    if ((++_sp & 255u) == 0u) { if (xb_ld(&(bar)[XB_TMO])) break; if (_sp > XB_SPIN_CAP) { atomicAdd(&(bar)[XB_TMO], 1u); break; } } } } while (0)

struct XcdBarrier {
    unsigned* bar; unsigned x;
    volatile LAS unsigned* st;
};

__device__ __forceinline__ XcdBarrier xcd_barrier_post(unsigned* bar, volatile LAS unsigned* st) {
    XcdBarrier b; b.bar = bar; b.x = xb_xcc_id(); b.st = st;
    if (threadIdx.x == 0) (void)xb_add(&bar[XB_XCNT(b.x)], 1u);
    return b;
}
__device__ __forceinline__ void xcd_barrier_complete(unsigned* bar, unsigned x, unsigned& nloc, unsigned& nx) {
    const unsigned G = gridDim.x * gridDim.y * gridDim.z;
    unsigned sum, cnt, mine, sp = 0u;
    for (;;) {
        sum = 0u; cnt = 0u; mine = 0u;
#pragma unroll
        for (unsigned j = 0; j < 16; ++j) { const unsigned c = xb_ld(&bar[XB_XCNT(j)]); sum += c; cnt += (c > 0u) ? 1u : 0u; mine = (j == x) ? c : mine; }
        if (sum == G) break;
        __builtin_amdgcn_s_sleep(1);
        if ((++sp & 255u) == 0u) { if (xb_ld(&bar[XB_TMO])) break; if (sp > XB_SPIN_CAP) { atomicAdd(&bar[XB_TMO], 1u); break; } }
    }
    nloc = mine > 0u ? mine : 1u; nx = cnt > 0u ? cnt : 1u;
}

__device__ __forceinline__ void xcd_barrier(const XcdBarrier& b) {
    asm volatile("s_waitcnt vmcnt(0)" ::: "memory");
    __syncthreads();
    if (threadIdx.x == 0) {
        unsigned* bar = b.bar;
        __builtin_amdgcn_s_waitcnt(0);
        unsigned nloc = b.st[0], nx = b.st[1];
        if (nloc == 0u) { xcd_barrier_complete(bar, b.x, nloc, nx); b.st[0] = nloc; b.st[1] = nx; }
        const unsigned old = xb_add(&bar[XB_XSUB(b.x)], 1u);
        const unsigned gen = old / nloc;
        if (old + 1u == (gen + 1u) * nloc) {
            __builtin_amdgcn_fence(__ATOMIC_RELEASE, "agent");
            asm volatile("s_waitcnt vmcnt(0)" ::: "memory");
            const unsigned og = xb_add(&bar[XB_TOP], 1u);
            const unsigned tg = og / nx;
            if (og + 1u == (tg + 1u) * nx) xb_add(&bar[XB_TOPGEN], 1u);
            else XB_SPIN(xb_ld(&bar[XB_TOPGEN]) == tg, bar);
            __builtin_amdgcn_fence(__ATOMIC_ACQUIRE, "agent");
            xb_add(&bar[XB_XGEN(b.x)], 1u);
            asm volatile("s_waitcnt vmcnt(0)" ::: "memory");
        } else {
            XB_SPIN(xb_ld(&bar[XB_XGEN(b.x)]) == gen, bar);
            __builtin_amdgcn_fence(__ATOMIC_ACQUIRE, "agent");
            asm volatile("s_waitcnt vmcnt(0)" ::: "memory");
        }
    }
    __syncthreads();
}
constexpr int NWAVES = 8;
constexpr int D = 2048, SEQ = 8192, MP = 32768, MS = 128, MR = 32896, MT = 33024;
constexpr int DFF = 5632, NA = 5376, NBQ = 2048, NKV = 3072;
constexpr int CQ = 0, CK = 768, CV = 1536, CG = 3072, CQM = 4608, CLR = 5120;
constexpr float DN_ALPHA = 1.6817928305074292f, LN_EPS = 1e-5f, RMS_EPS = 1e-6f;
constexpr float GLA_QSCALE = 0.07216878364870323f, HD_SCALE = 0.08838834764831845f;
constexpr size_t MiB = 1u << 20;
constexpr size_t WS_CTL = 0, CTL_ZERO_BYTES = 1 * MiB;
constexpr size_t WS_WIN = 1 * MiB, WS_WO = 22 * MiB, WS_WFI = 30 * MiB, WS_WFO = 74 * MiB, WS_WMEM = 96 * MiB, WS_MEMX = 112 * MiB, WS_MEMK = 116 * MiB, WS_MEMV = 128 * MiB;
constexpr size_t WS_X = 140 * MiB, WS_Y = 269 * MiB, WS_R1 = 527 * MiB, WS_OCAT = 882 * MiB, WS_SBKS = 1011 * MiB, WS_SBVS = 1060 * MiB, WS_END = 1109 * MiB;
static_assert(WS_WIN + (size_t)NA * D * 2 <= WS_WO && WS_WFI + (size_t)2 * DFF * D * 2 <= WS_WFO && WS_WFO + (size_t)D * DFF * 2 <= WS_WMEM, "weights map");
static_assert(WS_X + (size_t)MT * D * 2 <= WS_Y && WS_Y + (size_t)MT * D * 4 <= WS_R1 && WS_R1 + (size_t)MT * DFF * 2 <= WS_OCAT && WS_OCAT + (size_t)MT * D * 2 <= WS_SBKS, "activation map");
static_assert(WS_SBKS + (size_t)8 * 2064 * 1536 * 2 <= WS_SBVS && WS_SBVS + (size_t)8 * 2064 * 1536 * 2 <= WS_END, "sb sample map");
constexpr size_t O_YP = 0, O_YS = 67108864, O_GSP = 67371008, O_GSS = 69730304, O_SKP = 74448896, O_SVP = 124780544, O_SKS = 175112192, O_SVS = 175308800, O_MKP = 175505408, O_MVP = 177602560, O_END = 179699712;
constexpr int CW_BAR = 4096;
constexpr int RING_OFF = 0, RING_BYTES = 131072, LDSCTL_OFF = RING_BYTES, MISC_OFF = LDSCTL_OFF + 320, LDS_BYTES = 147456;

struct Args { const float* in[22]; float* out_; unsigned char* ws_; int ph_lo, ph_hi; };
struct Frame {
    LAS unsigned char* lds; volatile LAS unsigned* MISC; gu32* ctl;
    int tid, lane, wave, G, gw, NGW;
};
__device__ __forceinline__ float bf2f(bf16 h) { return __builtin_bit_cast(float, (unsigned)h << 16); }
__device__ __forceinline__ float shx(float v, int lane, int m) { return __builtin_bit_cast(float, __builtin_amdgcn_ds_bpermute((lane ^ m) << 2, __builtin_bit_cast(int, v))); }
__device__ __forceinline__ float wave_sum(float v, int lane) {
#pragma unroll
    for (int o = 1; o < 64; o <<= 1) v += shx(v, lane, o);
    return v;
}
__device__ __forceinline__ float wave_max(float v, int lane) {
#pragma unroll
    for (int o = 1; o < 64; o <<= 1) v = fmaxf(v, shx(v, lane, o));
    return v;
}
__device__ __forceinline__ void cvt_row(const float* src, bf16* dst, int n, int lane) {
    for (int j = lane * 4; j < n; j += 256) {
        f32x4 v = src ? *(const f32x4*)(src + j) : (f32x4){0.f, 0.f, 0.f, 0.f};
        unsigned long long w = (unsigned long long)pk2(v.x, v.y) | ((unsigned long long)pk2(v.z, v.w) << 32);
        *(unsigned long long*)(dst + j) = w;
    }
}
__device__ __forceinline__ int fresh_lane() { int z = 0; asm volatile("" : "+s"(z)); return (int)__builtin_amdgcn_mbcnt_hi(~0u, __builtin_amdgcn_mbcnt_lo(~0u, (unsigned)z)); }
#define FRESH_TID() (wave_ * 64 + fresh_lane())
template <bool FINAL>
__device__ __forceinline__ void ln_two_rows(int lane, const bf16* y0, const bf16* y1, const float* gg, const float* bb, bf16* x0, bf16* x1, float* of0, float* of1) {
    v4u w[2][4];
#pragma unroll
    for (int j = 0; j < 4; ++j) { w[0][j] = ((const v4u*)y0)[lane + 64 * j]; w[1][j] = ((const v4u*)y1)[lane + 64 * j]; }
    float v[2][4][8]; float s[2] = {0.f, 0.f};
#pragma unroll
    for (int r = 0; r < 2; ++r)
#pragma unroll
        for (int j = 0; j < 4; ++j) { const v4u q = w[r][j]; v[r][j][0] = pg8::bflo(q.x); v[r][j][1] = pg8::bfhi(q.x); v[r][j][2] = pg8::bflo(q.y); v[r][j][3] = pg8::bfhi(q.y); v[r][j][4] = pg8::bflo(q.z); v[r][j][5] = pg8::bfhi(q.z); v[r][j][6] = pg8::bflo(q.w); v[r][j][7] = pg8::bfhi(q.w);
            s[r] += ((v[r][j][0] + v[r][j][1]) + (v[r][j][2] + v[r][j][3])) + ((v[r][j][4] + v[r][j][5]) + (v[r][j][6] + v[r][j][7])); }
    const float m0 = wave_sum(s[0], lane) * (1.f / D), m1 = wave_sum(s[1], lane) * (1.f / D); float q0 = 0.f, q1 = 0.f;
#pragma unroll
    for (int j = 0; j < 4; ++j)
#pragma unroll
        for (int i = 0; i < 8; ++i) { v[0][j][i] -= m0; q0 += v[0][j][i] * v[0][j][i]; v[1][j][i] -= m1; q1 += v[1][j][i] * v[1][j][i]; }
    const float rs[2] = {1.f / sqrtf(wave_sum(q0, lane) * (1.f / D) + LN_EPS), 1.f / sqrtf(wave_sum(q1, lane) * (1.f / D) + LN_EPS)};
#pragma unroll
    for (int j = 0; j < 4; ++j) { const int e0 = (lane + 64 * j) * 8; const f32x4 g0 = *(const f32x4*)(gg + e0), g1 = *(const f32x4*)(gg + e0 + 4), b0 = *(const f32x4*)(bb + e0), b1 = *(const f32x4*)(bb + e0 + 4);
#pragma unroll
        for (int r = 0; r < 2; ++r) { float o[8];
#pragma unroll
            for (int i = 0; i < 4; ++i) { o[i] = v[r][j][i] * rs[r] * g0[i] + b0[i]; o[4 + i] = v[r][j][4 + i] * rs[r] * g1[i] + b1[i]; }
            if (FINAL) { float* of = r ? of1 : of0; *(f32x4*)(of + e0) = (f32x4){o[0], o[1], o[2], o[3]}; *(f32x4*)(of + e0 + 4) = (f32x4){o[4], o[5], o[6], o[7]}; }
            else { v4u p; p.x = pk2(o[0], o[1]); p.y = pk2(o[2], o[3]); p.z = pk2(o[4], o[5]); p.w = pk2(o[6], o[7]); *(v4u*)((r ? x1 : x0) + e0) = p; } } }
}
struct MapId { __device__ __forceinline__ int operator()(int n) const { return n; } };
struct MapInA { __device__ __forceinline__ int operator()(int n) const { return n < 4608 ? n : (n < 5120 ? n + 16 : (n < 5136 ? n - 512 : -1)); } };
struct MapFfn { __device__ __forceinline__ int operator()(int n) const { const int t = n >> 8, r = n & 255; return r < 128 ? 128 * t + r : DFF + 128 * t + (r - 128); } };
template <class Map>
__device__ __forceinline__ void wt_convert(LAS unsigned char* ldsb, int wave, int gw, int NGW, int lane, const float* W, int K, int Nsrc, bf16* WT, int Ndst, Map map) {
    LAS float* scr = (LAS float*)(ldsb + RING_OFF + wave * 16384);
    const int nblk = Ndst / 64, nitems = (K / 64) * nblk, nq = lane & 15, kq = lane >> 4;
    for (int it = gw; it < nitems; it += NGW) {
        const int kb = it / nblk, nb = it % nblk, k0 = 64 * kb, n0 = 64 * nb;
        const int sc0 = map(n0 + 4 * nq), sc3 = map(n0 + 4 * nq + 3);
        const bool contig = sc0 >= 0 && sc3 == sc0 + 3;
        f32x4 v[16];
#pragma unroll
        for (int i = 0; i < 16; ++i) { const int kk = 4 * i + kq;
            if (contig) v[i] = *(const f32x4*)(W + (size_t)(k0 + kk) * Nsrc + sc0);
            else {
#pragma unroll
                for (int e = 0; e < 4; ++e) { const int sc = map(n0 + 4 * nq + e); v[i][e] = sc >= 0 ? W[(size_t)(k0 + kk) * Nsrc + sc] : 0.f; } } }
#pragma unroll
        for (int i = 0; i < 16; ++i) { const int kk = 4 * i + kq;
#pragma unroll
            for (int e = 0; e < 4; ++e) { const int n = 4 * nq + e; scr[n * 64 + (kk ^ n)] = v[i][e]; } }
        LDS_WAIT(); asm volatile("" ::: "memory");
        const int c = lane & 7;
#pragma unroll
        for (int j = 0; j < 8; ++j) { const int n = (lane >> 3) + 8 * j; const LAS float* s = scr + n * 64;
#define SWZ(i) s[(8 * c + (i)) ^ n]
            v4u o; o.x = pk2(SWZ(0), SWZ(1)); o.y = pk2(SWZ(2), SWZ(3)); o.z = pk2(SWZ(4), SWZ(5)); o.w = pk2(SWZ(6), SWZ(7));
#undef SWZ
            *(GAS v4u*)(WT + (size_t)(n0 + n) * K + k0 + 8 * c) = o; }
        LDS_WAIT(); asm volatile("" ::: "memory");
    }
}
__device__ __forceinline__ float softplus_f(float z) { return fmaxf(z, 0.f) + log1pf(__expf(-fabsf(z))); }

typedef short s16x4 __attribute__((ext_vector_type(4)));
typedef pg8::u32x2 u32x2;
typedef float f32x16 __attribute__((ext_vector_type(16)));
typedef __bf16 bf16x2_t __attribute__((ext_vector_type(2)));
typedef float f32x2_t __attribute__((ext_vector_type(2)));
__device__ __forceinline__ unsigned cvt2(float lo, float hi) { const f32x2_t v = {lo, hi}; const bf16x2_t b = __builtin_convertvector(v, bf16x2_t); return __builtin_bit_cast(unsigned, b); }
__device__ __forceinline__ bf16x8 pack8(const f32x4 a, const f32x4 b) { v4u p; p.x = cvt2(a[0], a[1]); p.y = cvt2(a[2], a[3]); p.z = cvt2(b[0], b[1]); p.w = cvt2(b[2], b[3]); return __builtin_bit_cast(bf16x8, p); }
__device__ __forceinline__ bf16x8 ld2x8(const bf16* p0, const bf16* p1) { const s16x4 a = *(const s16x4*)p0, b = *(const s16x4*)p1; return __builtin_shufflevector(a, b, 0, 1, 2, 3, 4, 5, 6, 7); }
__device__ __forceinline__ bf16x8 ld16(const bf16* p) { return *(const bf16x8*)p; }
#define MFMA16(a, b, c) __builtin_amdgcn_mfma_f32_16x16x32_bf16((a), (b), (c), 0, 0, 0)
#define MFMA32(a, b, c) __builtin_amdgcn_mfma_f32_32x32x16_bf16((a), (b), (c), 0, 0, 0)

constexpr int QIMG_LD = 200, KTIMG_LD = 68, PKG_Q = 0, PKG_KT = 25600, PKG_G = 51712, IMG_BYTES = 52480, PKG_K = 52480, PKG_VT = 77056, PKG_BYTES = 126208, N_PKG = 2048 + 32;
static_assert(64 * QIMG_LD * 2 == PKG_KT && PKG_KT + 192 * KTIMG_LD * 2 == PKG_G && PKG_G + 768 == IMG_BYTES && PKG_K + 24576 == PKG_VT && PKG_VT + 49152 == PKG_BYTES && IMG_BYTES % 16 == 0, "package map");

__device__ __forceinline__ float softplus_fast(float z) { return fmaxf(z, 0.f) + __logf(1.0f + __expf(-fabsf(z))); }
constexpr int GL_TOT = 0, GL_Q = 6144, GL_K = GL_Q + 64 * QIMG_LD * 2, GL_V = GL_K + 64 * QIMG_LD * 2, VL_LD = 68, GL_P = GL_V + 384 * VL_LD * 2, P_LD = 68, GL_END = GL_P + 64 * P_LD * 2;
static_assert(GL_END <= RING_BYTES && GL_Q % 16 == 0 && GL_K % 16 == 0 && GL_V % 8 == 0 && GL_P % 8 == 0, "gla_prep_intra LDS map");
__device__ __forceinline__ void gla_prep_intra(int bid, int G, int tid, int wave, LAS unsigned char* lds, int l, const bf16* PROJ, const float* w_gate_lr, const float* b_gate, unsigned char* PKG, float* OINT) {
    const int lane = tid & 63, fr = lane & 15, fq = lane >> 4;
    const float* w2 = w_gate_lr + (size_t)l * 16 * 768; const float* bg = b_gate + (size_t)l * 768;
    LAS float* tot = (LAS float*)(lds + GL_TOT);
    LAS bf16* QL = (LAS bf16*)(lds + GL_Q); LAS bf16* KL = (LAS bf16*)(lds + GL_K); LAS bf16* VL = (LAS bf16*)(lds + GL_V); LAS bf16* P = (LAS bf16*)(lds + GL_P);
    float w2c[3][16], bgc[3]; int cur_h = -1;
    for (int j = 0;; ++j) {
        int item;
        if (G == 256) { if (j < 8) item = ((((j >> 1) << 2) | (bid & 3)) << 7) | ((bid >> 2) + 64 * (j & 1)); else if (j == 8 && bid < 32) item = 2048 + bid; else break; }
        else { item = bid + j * G; if (item >= N_PKG) break; }
        int h, row0, T;
        if (item < 2048) { const int bh = item >> 7, ch = item & 127; h = bh & 3; row0 = (bh >> 2) * SEQ + ch * 64; T = 64; }
        else { const int i2 = item - 2048; h = i2 & 3; row0 = MP + (i2 >> 2) * 16; T = 16; }
        unsigned char* pk = PKG + (size_t)item * PKG_BYTES;
        bf16* Qt = (bf16*)(pk + PKG_Q); bf16* KT = (bf16*)(pk + PKG_KT); bf16* VT = (bf16*)(pk + PKG_VT); float* Gp = (float*)(pk + PKG_G);
        if (h != cur_h) { cur_h = h;
#pragma unroll
            for (int c = 0; c < 3; ++c) { const int d = h * 192 + lane + 64 * c; bgc[c] = bg[d];
#pragma unroll
                for (int r = 0; r < 16; ++r) w2c[c][r] = w2[r * 768 + d]; } }
        v4u l0[8], l1[8];
#pragma unroll
        for (int tt = 0; tt < 8; ++tt) { const int t = 8 * wave + tt; const bf16* prow = PROJ + (size_t)(row0 + (t < T ? t : T - 1)) * NA;
            l0[tt] = *(const v4u*)(prow + CLR); l1[tt] = *(const v4u*)(prow + CLR + 8); }
        float lc[8][3]; float run[3] = {0.f, 0.f, 0.f};
#pragma unroll
        for (int tt = 0; tt < 8; ++tt) { const bool ok = 8 * wave + tt < T;
            float lr[16]; lr[0] = pg8::bflo(l0[tt].x); lr[1] = pg8::bfhi(l0[tt].x); lr[2] = pg8::bflo(l0[tt].y); lr[3] = pg8::bfhi(l0[tt].y); lr[4] = pg8::bflo(l0[tt].z); lr[5] = pg8::bfhi(l0[tt].z); lr[6] = pg8::bflo(l0[tt].w); lr[7] = pg8::bfhi(l0[tt].w);
            lr[8] = pg8::bflo(l1[tt].x); lr[9] = pg8::bfhi(l1[tt].x); lr[10] = pg8::bflo(l1[tt].y); lr[11] = pg8::bfhi(l1[tt].y); lr[12] = pg8::bflo(l1[tt].z); lr[13] = pg8::bfhi(l1[tt].z); lr[14] = pg8::bflo(l1[tt].w); lr[15] = pg8::bfhi(l1[tt].w);
#pragma unroll
            for (int c = 0; c < 3; ++c) { float xg = bgc[c];
#pragma unroll
                for (int r = 0; r < 16; ++r) xg += lr[r] * w2c[c][r];
                run[c] += ok ? -softplus_fast(-xg) * (1.0f / 16.0f) : 0.f; lc[tt][c] = run[c]; } }
#pragma unroll
        for (int c = 0; c < 3; ++c) tot[wave * 192 + lane + 64 * c] = run[c];
        unsigned qv[8][3], kv[8][3];
#pragma unroll
        for (int tt = 0; tt < 8; ++tt) { const int t = 8 * wave + tt; const bf16* prow = PROJ + (size_t)(row0 + (t < T ? t : T - 1)) * NA + h * 192 + lane;
#pragma unroll
            for (int c = 0; c < 3; ++c) { qv[tt][c] = prow[CQ + 64 * c]; kv[tt][c] = prow[CK + 64 * c]; } }
        __syncthreads();
        float pre[3], all[3];
#pragma unroll
        for (int c = 0; c < 3; ++c) { pre[c] = 0.f; all[c] = 0.f;
#pragma unroll
            for (int w = 0; w < 8; ++w) { const float tv = tot[w * 192 + lane + 64 * c]; all[c] += tv; if (w < wave) pre[c] += tv; } }
        unsigned ktw[3][4];
#pragma unroll
        for (int tt = 0; tt < 8; ++tt) { const int t = 8 * wave + tt; const bool ok = t < T;
#pragma unroll
            for (int c = 0; c < 3; ++c) { const int dl = lane + 64 * c; const float bc = pre[c] + lc[tt][c]; const float eq = __expf(bc), ek = __expf(-bc);
                const unsigned qb = ok ? f2bf(bf2f((bf16)qv[tt][c]) * GLA_QSCALE * eq) : 0u, kb = ok ? f2bf(bf2f((bf16)kv[tt][c]) * ek) : 0u;
                Qt[t * QIMG_LD + dl] = (bf16)qb; QL[t * QIMG_LD + dl] = (bf16)qb; KL[t * QIMG_LD + dl] = (bf16)kb;
                if (tt & 1) ktw[c][tt >> 1] |= kb << 16; else ktw[c][tt >> 1] = kb; } }
#pragma unroll
        for (int c = 0; c < 3; ++c) { bf16* kp = KT + (size_t)(lane + 64 * c) * KTIMG_LD + 8 * wave; u32x2 o0, o1; o0.x = ktw[c][0]; o0.y = ktw[c][1]; o1.x = ktw[c][2]; o1.y = ktw[c][3]; *(u32x2*)kp = o0; *(u32x2*)(kp + 4) = o1; }
        if (wave == 0) {
#pragma unroll
            for (int c = 0; c < 3; ++c) Gp[lane + 64 * c] = __expf(all[c]); }
        unsigned vv[6][8];
#pragma unroll
        for (int tt = 0; tt < 8; ++tt) { const int t = 8 * wave + tt; const bf16* prow = PROJ + (size_t)(row0 + (t < T ? t : T - 1)) * NA + CV + h * 384 + lane;
#pragma unroll
            for (int c2 = 0; c2 < 6; ++c2) vv[c2][tt] = prow[64 * c2]; }
#pragma unroll
        for (int c2 = 0; c2 < 6; ++c2) { const bool ok0 = 8 * wave < T;
            u32x2 o0, o1; o0.x = ok0 ? vv[c2][0] | (vv[c2][1] << 16) : 0u; o0.y = ok0 ? vv[c2][2] | (vv[c2][3] << 16) : 0u; o1.x = ok0 ? vv[c2][4] | (vv[c2][5] << 16) : 0u; o1.y = ok0 ? vv[c2][6] | (vv[c2][7] << 16) : 0u;
            v4u o; o.x = o0.x; o.y = o0.y; o.z = o1.x; o.w = o1.y; *(v4u*)(VT + (size_t)(lane + 64 * c2) * 64 + 8 * wave) = o;
            LAS bf16* vl = VL + (lane + 64 * c2) * VL_LD + 8 * wave; *(LAS u32x2*)vl = o0; *(LAS u32x2*)(vl + 4) = o1; }
        __syncthreads();
        const int nvalid = T;
        bf16x8 va[3], vb[3];
#pragma unroll
        for (int k = 0; k < 3; ++k) { const LAS bf16* vr = VL + (16 * (3 * wave + k) + fr) * VL_LD + 4 * fq;
            const s16x4 x0 = *(const LAS s16x4*)vr, x1 = *(const LAS s16x4*)(vr + 16), x2 = *(const LAS s16x4*)(vr + 32), x3 = *(const LAS s16x4*)(vr + 48);
            va[k] = __builtin_shufflevector(x0, x1, 0, 1, 2, 3, 4, 5, 6, 7); vb[k] = __builtin_shufflevector(x2, x3, 0, 1, 2, 3, 4, 5, 6, 7); }
#pragma unroll
        for (int rep = 0; rep < 2; ++rep) {
            const int tl = wave + 8 * rep;
            if (tl < 10) {
                const int it = tl < 1 ? 0 : (tl < 3 ? 1 : (tl < 6 ? 2 : 3)), jt = tl - (it * (it + 1)) / 2;
                f32x4 at = {0.f, 0.f, 0.f, 0.f};
                const LAS bf16* qr = QL + (16 * it + fr) * QIMG_LD + 8 * fq; const LAS bf16* kr = KL + (16 * jt + fr) * QIMG_LD + 8 * fq;
#pragma unroll
                for (int s = 0; s < 6; ++s) at = MFMA16(*(const LAS bf16x8*)(kr + 32 * s), *(const LAS bf16x8*)(qr + 32 * s), at);
                if (it == jt) {
#pragma unroll
                    for (int jj = 0; jj < 4; ++jj) if (4 * fq + jj > fr) at[jj] = 0.f; }
                u32x2 w; w.x = cvt2(at[0], at[1]); w.y = cvt2(at[2], at[3]);
                *(LAS u32x2*)(P + (16 * it + fr) * P_LD + 16 * jt + 4 * fq) = w;
            } else if (tl == 10 || tl == 11) {
                const int it = tl == 10 ? 0 : 2, jt = tl == 10 ? 1 : 3; unsigned zz = 0u; asm volatile("" : "+v"(zz)); u32x2 z; z.x = zz; z.y = zz;
                *(LAS u32x2*)(P + (16 * it + fr) * P_LD + 16 * jt + 4 * fq) = z;
            }
        }
        __syncthreads();
#pragma unroll
        for (int it = 0; it < 4; ++it) {
            if (16 * it >= nvalid) break;
            const LAS bf16* pr = P + (16 * it + fr) * P_LD + 4 * fq;
            const s16x4 a0 = *(const LAS s16x4*)pr, a1 = *(const LAS s16x4*)(pr + 16);
            const bf16x8 pf0 = __builtin_shufflevector(a0, a1, 0, 1, 2, 3, 4, 5, 6, 7); bf16x8 pf1 = pf0;
            if (it >= 2) { const s16x4 b0 = *(const LAS s16x4*)(pr + 32), b1 = *(const LAS s16x4*)(pr + 48); pf1 = __builtin_shufflevector(b0, b1, 0, 1, 2, 3, 4, 5, 6, 7); }
#pragma unroll
            for (int k = 0; k < 3; ++k) { f32x4 o = {0.f, 0.f, 0.f, 0.f};
                o = MFMA16(va[k], pf0, o); if (it >= 2) o = MFMA16(vb[k], pf1, o);
                *(f32x4*)(OINT + (size_t)(row0 + 16 * it + fr) * 1536 + h * 384 + 16 * (3 * wave + k) + 4 * fq) = o; }
        }
        __syncthreads();
    }
}

template <int PASS>
__device__ __forceinline__ void gla_chain(int wc, int tid, int wave, LAS unsigned char* lds, int l, const unsigned char* PKG, const float* state_gla, float* OINT, float* out, float* SLOC, float* GSEG, bool dry = false) {
    const int lane = tid & 63, fr = lane & 15, fq = lane >> 4;
    int h, vb, bh, seg, item0, nsteps, row0, nvalid; const float* s0 = nullptr; float* sout = nullptr;
    if (PASS == 1) { bh = wc / 9; const int rem = wc % 9; vb = rem / 3; seg = rem % 3; h = bh & 3; item0 = bh * 128 + 32 * seg; nsteps = 32; row0 = 0; nvalid = 64; }
    else if (wc < 192) { bh = wc / 12; const int rem = wc % 12; vb = rem >> 2; seg = rem & 3; h = bh & 3; item0 = bh * 128 + 32 * seg; nsteps = 32; row0 = (bh >> 2) * SEQ + 2048 * seg; nvalid = 64;
        if (seg == 3) sout = out + O_GSP + (size_t)(l * 16 + bh) * 192 * 384; }
    else { const int c2 = wc - 192; bh = c2 / 3; vb = c2 % 3; seg = 0; h = bh & 3; item0 = 2048 + bh; nsteps = 1; row0 = MP + (bh >> 2) * 16; nvalid = 16; s0 = state_gla + (size_t)(l * 32 + bh) * 192 * 384; sout = out + O_GSS + (size_t)(l * 32 + bh) * 192 * 384; }
    const int v0 = vb * 128 + wave * 16;
#define GLA_WALK(p, step) do { (p) += (step); asm volatile("" : "+v"(p)); } while (0)
    f32x4 S[12];
    if (s0) { const float* p = s0 + (size_t)(4 * fq) * 384 + v0 + fr;
#pragma unroll
        for (int t = 0; t < 12; ++t) {
#pragma unroll
            for (int jj = 0; jj < 4; ++jj) { S[t][jj] = *p; GLA_WALK(p, 384); }
            GLA_WALK(p, 12 * 384); } }
    else {
#pragma unroll
        for (int t = 0; t < 12; ++t) S[t] = (f32x4){0.f, 0.f, 0.f, 0.f}; }
    if (PASS == 2 && wc < 192) {
        for (int j = 0; j < seg; ++j) { const float* gs = GSEG + (size_t)(bh * 3 + j) * 192 + 4 * fq; const float* p = SLOC + (size_t)((bh * 3 + vb) * 3 + j) * 192 * 128 + (size_t)(4 * fq) * 128 + wave * 16 + fr;
#pragma unroll
            for (int t = 0; t < 12; ++t) { const f32x4 g4 = *(const f32x4*)(gs + 16 * t);
#pragma unroll
                for (int jj = 0; jj < 4; ++jj) { S[t][jj] = g4[jj] * S[t][jj] + *p; GLA_WALK(p, 128); }
                GLA_WALK(p, 12 * 128); } }
    }
    f32x4 GP[PASS == 1 ? 12 : 1];
    if (PASS == 1) {
#pragma unroll
        for (int t = 0; t < 12; ++t) GP[t] = (f32x4){1.f, 1.f, 1.f, 1.f}; }
    constexpr int CH0 = PASS == 1 ? PKG_KT / 16 : 0, NCH = IMG_BYTES / 16, NLD = PASS == 1 ? 4 : 7;
    v4u pre[NLD]; bf16x8 vt[2], vtn[2]; f32x4 oin[4];
    { const unsigned char* pk = PKG + (size_t)item0 * PKG_BYTES;
      if (PASS == 2) {
#pragma unroll
        for (int it = 0; it < 4; ++it) { const int tl = 16 * it + fr; oin[it] = tl < nvalid ? *(const f32x4*)(OINT + (size_t)(row0 + tl) * 1536 + h * 384 + v0 + 4 * fq) : (f32x4){0.f, 0.f, 0.f, 0.f}; } }
#pragma unroll
      for (int k = 0; k < NLD; ++k) { const int ch = CH0 + tid + 512 * k; if (ch < NCH) pre[k] = *(const v4u*)(pk + (size_t)ch * 16); }
      const bf16* VT = (const bf16*)(pk + PKG_VT) + (size_t)(v0 + fr) * 64 + 4 * fq; vt[0] = ld2x8(VT, VT + 16); vt[1] = ld2x8(VT + 32, VT + 48);
#pragma unroll
      for (int k = 0; k < NLD; ++k) { const int ch = CH0 + tid + 512 * k; if (ch < NCH) *(LAS v4u*)(lds + (size_t)ch * 16) = pre[k]; }
      vtn[0] = vt[0]; vtn[1] = vt[1]; }
    __syncthreads();
    for (int n = 0; n < nsteps; ++n) {
        const LAS unsigned char* img = lds + (n & 1) * IMG_BYTES;
        const bool more = n + 1 < nsteps;
        if (more) { const unsigned char* pk = PKG + (size_t)(item0 + n + 1) * PKG_BYTES;
#pragma unroll
            for (int k = 0; k < NLD; ++k) { const int ch = CH0 + tid + 512 * k; if (ch < NCH) pre[k] = *(const v4u*)(pk + (size_t)ch * 16); }
            const bf16* VT = (const bf16*)(pk + PKG_VT) + (size_t)(v0 + fr) * 64 + 4 * fq; vtn[0] = ld2x8(VT, VT + 16); vtn[1] = ld2x8(VT + 32, VT + 48); }
        if (PASS == 2) {
            bf16x8 Sb[6];
#pragma unroll
            for (int s = 0; s < 6; ++s) Sb[s] = pack8(S[2 * s], S[2 * s + 1]);
#pragma unroll
            for (int it = 0; it < 4; ++it) {
                const LAS bf16* qr = (const LAS bf16*)(img + PKG_Q) + (16 * it + fr) * QIMG_LD + 4 * fq;
                f32x4 o = oin[it];
#pragma unroll
                for (int s = 0; s < 6; ++s) { const s16x4 a = *(const LAS s16x4*)(qr + 32 * s), b = *(const LAS s16x4*)(qr + 32 * s + 16);
                    o = MFMA16(Sb[s], __builtin_shufflevector(a, b, 0, 1, 2, 3, 4, 5, 6, 7), o); }
                const int tl = 16 * it + fr;
                if (tl < nvalid && !dry) *(f32x4*)(OINT + (size_t)(row0 + 64 * n + tl) * 1536 + h * 384 + v0 + 4 * fq) = o;
                __builtin_amdgcn_sched_barrier(0);
            }
            if (more) {
#pragma unroll
                for (int it = 0; it < 4; ++it) oin[it] = *(const f32x4*)(OINT + (size_t)(row0 + 64 * (n + 1) + 16 * it + fr) * 1536 + h * 384 + v0 + 4 * fq); }
        }
#pragma unroll
        for (int t = 0; t < 12; ++t) { const LAS bf16* kr = (const LAS bf16*)(img + PKG_KT) + (16 * t + fr) * KTIMG_LD + 4 * fq;
#pragma unroll
            for (int s2 = 0; s2 < 2; ++s2) { const s16x4 a = *(const LAS s16x4*)(kr + 32 * s2), b = *(const LAS s16x4*)(kr + 32 * s2 + 16);
                S[t] = MFMA16(__builtin_shufflevector(a, b, 0, 1, 2, 3, 4, 5, 6, 7), vt[s2], S[t]); }
            const f32x4 g4 = *(const LAS f32x4*)(img + PKG_G + (16 * t + 4 * fq) * 4);
            S[t] = S[t] * g4; if (PASS == 1) GP[t] = GP[t] * g4; if (t & 1) __builtin_amdgcn_sched_barrier(0); }
        if (more) { LAS unsigned char* nimg = lds + ((n + 1) & 1) * IMG_BYTES;
#pragma unroll
            for (int k = 0; k < NLD; ++k) { const int ch = CH0 + tid + 512 * k; if (ch < NCH) *(LAS v4u*)(nimg + (size_t)ch * 16) = pre[k]; }
            vt[0] = vtn[0]; vt[1] = vtn[1]; }
        asm volatile("s_waitcnt lgkmcnt(0)" ::: "memory"); __builtin_amdgcn_s_barrier(); asm volatile("" ::: "memory");
    }
    if (PASS == 1) {
        float* p = SLOC + (size_t)((bh * 3 + vb) * 3 + seg) * 192 * 128 + (size_t)(4 * fq) * 128 + wave * 16 + fr;
#pragma unroll
        for (int t = 0; t < 12; ++t) {
#pragma unroll
            for (int jj = 0; jj < 4; ++jj) { *p = S[t][jj]; GLA_WALK(p, 128); }
            GLA_WALK(p, 12 * 128); }
        if (vb == 0 && wave == 0 && fr == 0) { float* gs = GSEG + (size_t)(bh * 3 + seg) * 192;
#pragma unroll
            for (int t = 0; t < 12; ++t) *(f32x4*)(gs + 16 * t + 4 * fq) = GP[t]; }
    } else if (sout) {
        float* p = sout + (size_t)(4 * fq) * 384 + v0 + fr;
#pragma unroll
        for (int t = 0; t < 12; ++t) {
#pragma unroll
            for (int jj = 0; jj < 4; ++jj) { *p = S[t][jj]; GLA_WALK(p, 384); }
            GLA_WALK(p, 12 * 384); }
    }
#undef GLA_WALK
}

__device__ __forceinline__ void mem_attn(int item, int lane, int l, const bf16* PROJ, int ldp, int cqm, const bf16* MEMK, const bf16* MEMVT, bf16* OCAT) {
    const int fr = lane & 15, fq = lane >> 4, tile = item >> 2, h = item & 3, r0 = tile * 16;
    const int bb = r0 < MP ? r0 / SEQ : 4 + ((r0 - MP) >> 4);
    const bf16* Kb = MEMK + (size_t)((l * 12 + bb) * 256) * 512 + h * 128; const bf16* Vt = MEMVT + (size_t)(((l * 12 + bb) * 4 + h) * 128) * 256;
    bf16x8 qf[4];
#pragma unroll
    for (int s = 0; s < 4; ++s) qf[s] = ld16(PROJ + (size_t)(r0 + fr) * ldp + cqm + h * 128 + 32 * s + 8 * fq);
    f32x4 st[16];
#pragma unroll
    for (int mt = 0; mt < 16; ++mt) { st[mt] = (f32x4){0.f, 0.f, 0.f, 0.f}; const bf16* kr = Kb + (size_t)(16 * mt + fr) * 512 + 8 * fq;
#pragma unroll
        for (int s = 0; s < 4; ++s) st[mt] = MFMA16(ld16(kr + 32 * s), qf[s], st[mt]); }
    float mx = -3.0e38f;
#pragma unroll
    for (int mt = 0; mt < 16; ++mt) mx = fmaxf(mx, fmaxf(fmaxf(st[mt][0], st[mt][1]), fmaxf(st[mt][2], st[mt][3])));
    mx = fmaxf(mx, shx(mx, lane, 16)); mx = fmaxf(mx, shx(mx, lane, 32));
    float sum = 0.f;
#pragma unroll
    for (int mt = 0; mt < 16; ++mt)
#pragma unroll
        for (int jj = 0; jj < 4; ++jj) { const float p = __expf((st[mt][jj] - mx) * HD_SCALE); st[mt][jj] = p; sum += p; }
    sum += shx(sum, lane, 16); sum += shx(sum, lane, 32);
    const float inv = 1.0f / sum;
    bf16x8 pf[8];
#pragma unroll
    for (int s = 0; s < 8; ++s) pf[s] = pack8(st[2 * s], st[2 * s + 1]);
#pragma unroll
    for (int dt = 0; dt < 8; ++dt) { f32x4 o = {0.f, 0.f, 0.f, 0.f}; const bf16* vr = Vt + (size_t)(16 * dt + fr) * 256 + 4 * fq;
#pragma unroll
        for (int s = 0; s < 8; ++s) o = MFMA16(ld2x8(vr + 32 * s, vr + 32 * s + 16), pf[s], o);
        u32x2 w; w.x = cvt2(o[0] * inv, o[1] * inv); w.y = cvt2(o[2] * inv, o[3] * inv);
        *(u32x2*)(OCAT + (size_t)(r0 + fr) * D + 1536 + h * 128 + 16 * dt + 4 * fq) = w; }
}

__device__ __forceinline__ void mem_attn_wg(int wi, int tid, int wave, LAS unsigned char* lds, int l, const bf16* PROJ, int ldp, int cqm, const bf16* MEMK, const bf16* MEMVT, bf16* OCAT) {
    const bool smp = wi >= 256; const int lane = tid & 63, fr = lane & 15, fq = lane >> 4, bh = smp ? (wi - 256) : (wi >> 4), sub = wi & 15, b = smp ? 4 + (bh >> 2) : (bh >> 2), h = bh & 3;
    const bf16* Kb = MEMK + (size_t)((l * 12 + b) * 256) * 512 + h * 128; const bf16* Vt = MEMVT + (size_t)(((l * 12 + b) * 4 + h) * 128) * 256;
#pragma unroll
    for (int k = 0; k < 8; ++k) { const int idx = tid + 512 * k, row = idx >> 4, c = idx & 15; *(LAS v4u*)(lds + row * 256 + ((c ^ (row & 15)) << 4)) = *(const v4u*)(Kb + (size_t)row * 512 + c * 8); }
#pragma unroll
    for (int k = 0; k < 8; ++k) { const int idx = tid + 512 * k, row = idx >> 5, c = idx & 31; *(LAS v4u*)(lds + 65536 + row * 512 + ((c ^ (2 * (row & 15))) << 4)) = *(const v4u*)(Vt + (size_t)row * 256 + c * 8); }
    __syncthreads();
    unsigned koff[4], voff[16];
#pragma unroll
    for (int s2 = 0; s2 < 4; ++s2) { koff[s2] = (unsigned)(fr * 256 + (((4 * s2 + fq) ^ fr) << 4)); asm volatile("" : "+v"(koff[s2])); }
#pragma unroll
    for (int s2 = 0; s2 < 8; ++s2) { const int p0 = 8 * s2 + fq, p1 = p0 + 4;
        voff[2 * s2] = (unsigned)(65536 + fr * 512 + ((((p0 >> 1) ^ (2 * fr)) << 4) | ((p0 & 1) << 3))); voff[2 * s2 + 1] = (unsigned)(65536 + fr * 512 + ((((p1 >> 1) ^ (2 * fr)) << 4) | ((p1 & 1) << 3)));
        asm volatile("" : "+v"(voff[2 * s2]), "+v"(voff[2 * s2 + 1])); }
    const int nblk = smp ? (wave == 0 ? 1 : 0) : 4;
#pragma unroll 1
    for (int blk = 0; blk < nblk; ++blk) {
        const int r0 = smp ? MP + (b - 4) * 16 : b * SEQ + sub * 512 + blk * 128 + wave * 16;
        bf16x8 qf[4];
#pragma unroll
        for (int s = 0; s < 4; ++s) qf[s] = ld16(PROJ + (size_t)(r0 + fr) * ldp + cqm + h * 128 + 32 * s + 8 * fq);
        f32x4 st[16];
#pragma unroll
        for (int mt = 0; mt < 16; ++mt) { st[mt] = (f32x4){0.f, 0.f, 0.f, 0.f};
#pragma unroll
            for (int s = 0; s < 4; ++s) st[mt] = MFMA16(*(const LAS bf16x8*)(lds + koff[s] + mt * 4096), qf[s], st[mt]);
            if ((mt & 3) == 3) __builtin_amdgcn_sched_barrier(0); }
        float mx = -3.0e38f;
#pragma unroll
        for (int mt = 0; mt < 16; ++mt) mx = fmaxf(mx, fmaxf(fmaxf(st[mt][0], st[mt][1]), fmaxf(st[mt][2], st[mt][3])));
        mx = fmaxf(mx, shx(mx, lane, 16)); mx = fmaxf(mx, shx(mx, lane, 32));
        float sum = 0.f;
#pragma unroll
        for (int mt = 0; mt < 16; ++mt)
#pragma unroll
            for (int jj = 0; jj < 4; ++jj) { const float p = __expf((st[mt][jj] - mx) * HD_SCALE); st[mt][jj] = p; sum += p; }
        sum += shx(sum, lane, 16); sum += shx(sum, lane, 32);
        const float inv = 1.0f / sum;
        bf16x8 pf[8];
#pragma unroll
        for (int s = 0; s < 8; ++s) pf[s] = pack8(st[2 * s], st[2 * s + 1]);
#pragma unroll
        for (int dt = 0; dt < 8; ++dt) { f32x4 o = {0.f, 0.f, 0.f, 0.f};
#pragma unroll
            for (int s = 0; s < 8; ++s) { const s16x4 a = *(const LAS s16x4*)(lds + voff[2 * s] + dt * 8192), bb = *(const LAS s16x4*)(lds + voff[2 * s + 1] + dt * 8192);
                o = MFMA16(__builtin_shufflevector(a, bb, 0, 1, 2, 3, 4, 5, 6, 7), pf[s], o); }
            u32x2 w; w.x = cvt2(o[0] * inv, o[1] * inv); w.y = cvt2(o[2] * inv, o[3] * inv);
            *(u32x2*)(OCAT + (size_t)(r0 + fr) * D + 1536 + h * 128 + 16 * dt + 4 * fq) = w;
            if (dt & 1) __builtin_amdgcn_sched_barrier(0); }
    }
    __syncthreads();
}

template <int MODE = 0>
__device__ __forceinline__ void sb_attn(int lane, LAS unsigned char* wlds, const bf16* Kp, int ldk, const bf16* VTp, int ldvt, const bf16* Qp, int ldq, bf16* Op, int t0, int nq) {
    const int r = lane & 31, hh = lane >> 5;
    LAS bf16x8* qs = (LAS bf16x8*)wlds + lane;
#pragma unroll
    for (int ks = 0; ks < 8; ++ks) qs[64 * ks] = ld16(Qp + (size_t)r * ldq + 16 * ks + 8 * hh);
    f32x16 oacc[4];
#pragma unroll
    for (int dt = 0; dt < 4; ++dt)
#pragma unroll
        for (int i = 0; i < 16; ++i) oacc[dt][i] = 0.f;
    float carry = 1.f;
    bf16x8 kf[8];
    { const bf16* kr = Kp + (size_t)(t0 + r) * ldk + 8 * hh;
#pragma unroll
      for (int ks = 0; ks < 8; ++ks) kf[ks] = ld16(kr + 16 * ks); }
    for (int s0 = t0; s0 >= 0; s0 -= 32) {
        bf16x8 vf[8];
#pragma unroll
        for (int k2 = 0; k2 < 2; ++k2)
#pragma unroll
            for (int dt = 0; dt < 4; ++dt) vf[4 * k2 + dt] = MODE == 3 ? qs[64 * dt] : ld16(VTp + (size_t)(s0 >> 5) * 4096 + ((dt * 2 + k2) * 64 + lane) * 8);
        f32x16 st;
#pragma unroll
        for (int i = 0; i < 16; ++i) st[i] = 0.f;
#pragma unroll
        for (int ks = 0; ks < 8; ++ks) st = MFMA32(kf[ks], qs[64 * ks], st);
        { const int sn = s0 >= 32 ? s0 - 32 : 0; const bf16* kr = Kp + (size_t)(sn + r) * ldk + 8 * hh;
#pragma unroll
          for (int ks = 0; ks < 8; ++ks) kf[ks] = ld16(kr + 16 * ks); }
        const bool diag = (s0 == t0);
        float lb[16], om[16];
#pragma unroll
        for (int i = 0; i < 16; ++i) { const float z = st[i] * HD_SCALE, e = __expf(-fabsf(z)), rr = __builtin_amdgcn_rcpf(1.0f + e), er = e * rr;
            lb[i] = z >= 0.f ? rr : er; om[i] = z >= 0.f ? er : rr;
            if (diag && !(((i & 3) + 8 * (i >> 2) + 4 * hh) < r)) { lb[i] = 0.f; om[i] = 1.f; } }
        float g[4], pgv[4];
#pragma unroll
        for (int m = 0; m < 4; ++m) { g[m] = (om[4 * m] * om[4 * m + 1]) * (om[4 * m + 2] * om[4 * m + 3]); pgv[m] = shx(g[m], lane, 32); }
        float R[4]; R[3] = 1.f; R[2] = g[3] * pgv[3]; R[1] = R[2] * (g[2] * pgv[2]); R[0] = R[1] * (g[1] * pgv[1]);
        const float total = R[0] * (g[0] * pgv[0]);
#pragma unroll
        for (int m = 0; m < 4; ++m) { const float suf = carry * R[m] * (hh == 0 ? pgv[m] : 1.f);
            const float t3 = suf, t2 = t3 * om[4 * m + 3], t1 = t2 * om[4 * m + 2], t0_ = t1 * om[4 * m + 1];
            lb[4 * m + 3] *= t3; lb[4 * m + 2] *= t2; lb[4 * m + 1] *= t1; lb[4 * m] *= t0_; }
        carry *= total;
#pragma unroll
        for (int k2 = 0; k2 < 2; ++k2) {
            v4u p; p.x = cvt2(lb[8 * k2], lb[8 * k2 + 1]); p.y = cvt2(lb[8 * k2 + 2], lb[8 * k2 + 3]); p.z = cvt2(lb[8 * k2 + 4], lb[8 * k2 + 5]); p.w = cvt2(lb[8 * k2 + 6], lb[8 * k2 + 7]);
            const bf16x8 wf = __builtin_bit_cast(bf16x8, p);
#pragma unroll
            for (int dt = 0; dt < 4; ++dt) { if (MODE != 3) oacc[dt] = MFMA32(vf[4 * k2 + dt], wf, oacc[dt]); else oacc[dt][0] += __builtin_bit_cast(float, (int)wf[0]) + __builtin_bit_cast(float, (int)vf[4 * k2 + dt][0]); }
        }
        if (MODE == 2 || __all((r >= nq) || (carry < 1.0e-37f))) break;
    }
    if (MODE != 0) { float sdry = 0.f;
#pragma unroll
        for (int dt = 0; dt < 4; ++dt)
#pragma unroll
            for (int i = 0; i < 16; ++i) sdry += oacc[dt][i];
        if (sdry == 1.2345e33f) Op[0] = 0; }
    else if (r < nq) {
#pragma unroll
        for (int dt = 0; dt < 4; ++dt)
#pragma unroll
            for (int g4 = 0; g4 < 4; ++g4) { u32x2 wv; wv.x = cvt2(oacc[dt][4 * g4], oacc[dt][4 * g4 + 1]); wv.y = cvt2(oacc[dt][4 * g4 + 2], oacc[dt][4 * g4 + 3]);
                *(u32x2*)(Op + (size_t)r * D + 32 * dt + 8 * g4 + 4 * hh) = wv; }
    }
    asm volatile("s_waitcnt lgkmcnt(0)" ::: "memory");
}

struct SkBf16 { bf16* O; int ldc;
    __device__ __forceinline__ int brow(int unit, int nb) const { return 32 * unit + 16 * nb; }
    __device__ __forceinline__ void store(int unit, const f32x4 a0, const f32x4 a1, int m, int fq) const { bf16* p = O + (size_t)(MP + m) * ldc + 32 * unit + 4 * fq;
        u32x2 w; w.x = cvt2(a0[0], a0[1]); w.y = cvt2(a0[2], a0[3]); *(u32x2*)p = w; w.x = cvt2(a1[0], a1[1]); w.y = cvt2(a1[2], a1[3]); *(u32x2*)(p + 16) = w; } };
struct SkRes { bf16* Yp; const bf16* Xp; float alpha;
    __device__ __forceinline__ int brow(int unit, int nb) const { return 32 * unit + 16 * nb; }
    __device__ __forceinline__ void one(size_t o, const f32x4 a) const { const u32x2 xv = *(const u32x2*)(Xp + o);
        f32x4 r; r[0] = alpha * pg8::bflo(xv.x); r[1] = alpha * pg8::bfhi(xv.x); r[2] = alpha * pg8::bflo(xv.y); r[3] = alpha * pg8::bfhi(xv.y); r = r + a; u32x2 w; w.x = cvt2(r[0], r[1]); w.y = cvt2(r[2], r[3]); *(u32x2*)(Yp + o) = w; }
    __device__ __forceinline__ void store(int unit, const f32x4 a0, const f32x4 a1, int m, int fq) const { const size_t o = (size_t)(MP + m) * D + 32 * unit + 4 * fq; one(o, a0); one(o + 16, a1); } };
struct SkKV { float *oks, *ovs; bf16 *ksb, *vsb;
    __device__ __forceinline__ int brow(int unit, int nb) const { return 32 * unit + 16 * nb; }
    __device__ __forceinline__ void one(int col, const f32x4 a, int m) const { const bool isv = col >= 1536; const int c = col - (isv ? 1536 : 0), b = m >> 4, t = m & 15;
        *(f32x4*)((isv ? ovs : oks) + (size_t)m * 1536 + c) = a; const unsigned w0 = cvt2(a[0], a[1]), w1 = cvt2(a[2], a[3]);
        const int hh_ = c >> 7, dd = c & 127;
        if (!isv) { u32x2 w; w.x = w0; w.y = w1; *(u32x2*)(ksb + ((size_t)(b * 12 + hh_) * 2080 + 2048 + t) * 128 + dd) = w; }
        else { bf16* vt = vsb + ((size_t)(b * 12 + hh_) * 65 + 64) * 4096 + pg8::vtf_d(dd) + pg8::vtf_k(t); vt[0] = (bf16)w0; vt[8] = (bf16)(w0 >> 16); vt[16] = (bf16)w1; vt[24] = (bf16)(w1 >> 16); } }
    __device__ __forceinline__ void store(int unit, const f32x4 a0, const f32x4 a1, int m, int fq) const { one(32 * unit + 4 * fq, a0, m); one(32 * unit + 16 + 4 * fq, a1, m); } };
struct SkSwiGLU { bf16* Hb;
    __device__ __forceinline__ int brow(int unit, int nb) const { const int c0 = 16 * unit; return (c0 >> 7) * 256 + (c0 & 127) + 128 * nb; }
    __device__ __forceinline__ void store(int unit, const f32x4 g, const f32x4 u, int m, int fq) const { float hv[4];
#pragma unroll
        for (int j = 0; j < 4; ++j) hv[j] = g[j] * __builtin_amdgcn_rcpf(1.0f + __expf(-g[j])) * u[j];
        u32x2 w; w.x = cvt2(hv[0], hv[1]); w.y = cvt2(hv[2], hv[3]); *(u32x2*)(Hb + (size_t)(MP + m) * DFF + 16 * unit + 4 * fq) = w; } };
template <class Epi>
__device__ __forceinline__ void skinny_gemm(int bid, int G, int tid, int wave, LAS unsigned char* lds, const bf16* A, int lda, const bf16* Bt, int K, int nunits, const Epi& E) {
    const int lane = tid & 63, fr = lane & 15, fq = lane >> 4, kw = K >> 3, nst = kw >> 5;
    const bf16* ap = A + (size_t)fr * lda + wave * kw + 8 * fq;
    LAS f32x4* red = (LAS f32x4*)lds;
    for (int unit = bid; unit < nunits; unit += G) {
        const bf16* bp0 = Bt + (size_t)(E.brow(unit, 0) + fr) * K + wave * kw + 8 * fq; const bf16* bp1 = Bt + (size_t)(E.brow(unit, 1) + fr) * K + wave * kw + 8 * fq;
        f32x4 acc[2][8];
#pragma unroll
        for (int nb = 0; nb < 2; ++nb)
#pragma unroll
            for (int rt = 0; rt < 8; ++rt) acc[nb][rt] = (f32x4){0.f, 0.f, 0.f, 0.f};
        bf16x8 a0[8], a1[8], a2[8], b0[2], b1[2], b2[2];
#define SK_LOAD(af, bfr, st) do { _Pragma("unroll") for (int rt = 0; rt < 8; ++rt) af[rt] = ld16(ap + (size_t)(16 * rt) * lda + 32 * (st)); bfr[0] = ld16(bp0 + 32 * (st)); bfr[1] = ld16(bp1 + 32 * (st)); } while (0)
#define SK_MMA(af, bfr) do { _Pragma("unroll") for (int rt = 0; rt < 8; ++rt) { acc[0][rt] = MFMA16(bfr[0], af[rt], acc[0][rt]); acc[1][rt] = MFMA16(bfr[1], af[rt], acc[1][rt]); } } while (0)
        SK_LOAD(a0, b0, 0); SK_LOAD(a1, b1, 1);
#pragma unroll 1
        for (int st = 0; st < nst; st += 3) {
            if (st + 2 < nst) SK_LOAD(a2, b2, st + 2);
            __builtin_amdgcn_sched_barrier(0);
            SK_MMA(a0, b0);
            __builtin_amdgcn_sched_barrier(0);
            if (st + 3 < nst) SK_LOAD(a0, b0, st + 3);
            __builtin_amdgcn_sched_barrier(0);
            if (st + 1 < nst) SK_MMA(a1, b1);
            __builtin_amdgcn_sched_barrier(0);
            if (st + 4 < nst) SK_LOAD(a1, b1, st + 4);
            __builtin_amdgcn_sched_barrier(0);
            if (st + 2 < nst) SK_MMA(a2, b2);
            __builtin_amdgcn_sched_barrier(0);
        }
#undef SK_LOAD
#undef SK_MMA
#pragma unroll
        for (int nb = 0; nb < 2; ++nb)
#pragma unroll
            for (int rt = 0; rt < 8; ++rt) red[((wave * 2 + nb) * 8 + rt) * 64 + lane] = acc[nb][rt];
        __syncthreads();
        f32x4 s0 = {0.f, 0.f, 0.f, 0.f}, s1 = {0.f, 0.f, 0.f, 0.f};
#pragma unroll
        for (int ws = 0; ws < 8; ++ws) { s0 = s0 + red[((ws * 2 + 0) * 8 + wave) * 64 + lane]; s1 = s1 + red[((ws * 2 + 1) * 8 + wave) * 64 + lane]; }
        E.store(unit, s0, s1, 16 * wave + fr, fq);
        __syncthreads();
    }
}
#ifndef PH_MASK
#define PH_MASK 0xFFFF
#endif
__global__ void __launch_bounds__(NWAVES * 64, 2) mega(Args args) {
    extern __shared__ __attribute__((aligned(16))) unsigned char lds[];
    Frame F;
    F.lds = (LAS unsigned char*)lds; F.MISC = (volatile LAS unsigned*)(F.lds + MISC_OFF);
    F.tid = threadIdx.x; F.lane = F.tid & 63; F.wave = __builtin_amdgcn_readfirstlane(F.tid >> 6);
    F.G = gridDim.x; F.gw = blockIdx.x * NWAVES + F.wave; F.NGW = F.G * NWAVES;
    F.ctl = (gu32*)(args.ws_ + WS_CTL);
    for (int u = F.tid; u < (LDS_BYTES - LDSCTL_OFF) / 4; u += NWAVES * 64) ((LAS unsigned*)(F.lds + LDSCTL_OFF))[u] = 0u;
    __syncthreads();
    XcdBarrier bar = xcd_barrier_post((unsigned*)(F.ctl + CW_BAR), F.MISC + 8);
    const int lo = args.ph_lo, hi = args.ph_hi; int ph = 0;
#define KARGS ((const __attribute__((address_space(4))) Args*)__builtin_amdgcn_kernarg_segment_ptr())
#define ws (ka->ws_)
#define out (ka->out_)
#define x_prompt (ka->in[0])
#define x_sample (ka->in[1])
#define mem_prompt (ka->in[2])
#define state_gla (ka->in[3])
#define cache_sb_k (ka->in[4])
#define cache_sb_v (ka->in[5])
#define cache_mem_k (ka->in[6])
#define cache_mem_v (ka->in[7])
#define w_in_a (ka->in[8])
#define w_gate_lr (ka->in[9])
#define b_gate (ka->in[10])
#define gla_norm_g (ka->in[11])
#define w_in_b (ka->in[12])
#define w_kv_shared (ka->in[13])
#define w_mem_kv (ka->in[14])
#define w_o (ka->in[15])
#define ln1_g (ka->in[16])
#define ln1_b (ka->in[17])
#define ln2_g (ka->in[18])
#define ln2_b (ka->in[19])
#define w_ffn_in (ka->in[20])
#define w_ffn_out (ka->in[21])
#define WIN ((bf16*)(ws + WS_WIN))
#define WO ((bf16*)(ws + WS_WO))
#define WFI ((bf16*)(ws + WS_WFI))
#define WFO ((bf16*)(ws + WS_WFO))
#define WMEM ((bf16*)(ws + WS_WMEM))
#define MEMX ((bf16*)(ws + WS_MEMX))
#define MEMK ((bf16*)(ws + WS_MEMK))
#define MEMV ((bf16*)(ws + WS_MEMV))
#define X ((bf16*)(ws + WS_X))
#define Y ((float*)(ws + WS_Y))
#define YB ((bf16*)(ws + WS_Y))
#define PROJ ((bf16*)(ws + WS_R1))
#define HB ((bf16*)(ws + WS_R1))
#define OCAT ((bf16*)(ws + WS_OCAT))
#define SBKS ((bf16*)(ws + WS_SBKS))
#define SBVS ((bf16*)(ws + WS_SBVS))
#define OINT (out + O_YP)
#define KPB ((bf16*)(out + O_YP))
#define VPB (KPB + (size_t)MP * 1536)

#define PHASE_BEGIN(cond, cls) if (cond) { if (lo <= ph && ph < hi) { if (ph > lo) { xcd_barrier(bar); if (BAR_REP > 1) xcd_barrier(bar); } DIAG_STAMP(cls); for (int rep_ = 0; rep_ < (((cls) == REP_CLS) ? 2 : 1); ++rep_) { const __attribute__((address_space(4))) Args* ka = KARGS; asm volatile("" : "+s"(ka)); int z_ = 0, G_ = gridDim.x, bid_ = blockIdx.x, wave_ = F.wave; asm volatile("" : "+s"(z_), "+s"(G_), "+s"(bid_), "+s"(wave_)); const int lane = (int)__builtin_amdgcn_mbcnt_hi(~0u, __builtin_amdgcn_mbcnt_lo(~0u, (unsigned)z_)), tid = wave_ * 64 + lane, gw_ = bid_ * NWAVES + wave_, NGW_ = G_ * NWAVES;     (void)tid; (void)lane; (void)gw_; (void)NGW_;
#define PHASE_END } } ++ph; }
#ifndef REP_CLS
#define REP_CLS (-1)
#endif
#ifndef SK_REP
#define SK_REP 1
#endif
#ifndef MEM_REP
#define MEM_REP 1
#endif
#ifndef BAR_REP
#define BAR_REP 1
#endif
#ifndef STAG
#define STAG 0
#endif
#ifndef SB_REP
#define SB_REP 1
#endif
#if defined(DIAG_A)
#define DIAG_STAMP(cls) do { if (blockIdx.x == 0 && threadIdx.x == 0) { unsigned long long* dts = (unsigned long long*)(args.ws_ + 262144); dts[ph] = rt(); } } while (0)
#else
#define DIAG_STAMP(cls) do { } while (0)
#endif

#define CONVERT_WEIGHTS(LL) do { const int ll_ = (LL); \
            if (ll_ < 2) wt_convert(F.lds, wave_, gw_, NGW_, lane, w_in_a + (size_t)ll_ * D * 5136, D, 5136, WIN, NA, MapInA()); \
            else { wt_convert(F.lds, wave_, gw_, NGW_, lane, w_in_b + (size_t)(ll_ - 2) * D * NBQ, D, NBQ, WIN, NBQ, MapId()); if (ll_ == 2) wt_convert(F.lds, wave_, gw_, NGW_, lane, w_kv_shared, D, NKV, WIN + (size_t)NBQ * D, NKV, MapId()); } \
            wt_convert(F.lds, wave_, gw_, NGW_, lane, w_o + (size_t)ll_ * D * D, D, D, WO, D, MapId()); \
            wt_convert(F.lds, wave_, gw_, NGW_, lane, w_ffn_in + (size_t)ll_ * D * 2 * DFF, D, 2 * DFF, WFI, 2 * DFF, MapFfn()); \
            wt_convert(F.lds, wave_, gw_, NGW_, lane, w_ffn_out + (size_t)ll_ * DFF * D, DFF, D, WFO, D, MapId()); } while (0)
    PHASE_BEGIN(true, 0)
        for (int r = gw_; r < MT; r += NGW_) cvt_row(r < MP ? x_prompt + (size_t)r * D : (r < MR ? x_sample + (size_t)(r - MP) * D : nullptr), X + (size_t)r * D, D, lane);
        for (int r = gw_; r < 1024; r += NGW_) cvt_row(mem_prompt + (size_t)r * D, MEMX + (size_t)r * D, D, lane);
        for (int r = gw_; r < 4 * 8 * 256; r += NGW_) { const int l = r >> 11, b = (r >> 8) & 7, m = r & 255; const size_t dst = (size_t)((l * 12 + 4 + b) * 256 + m) * 512;
            cvt_row(cache_mem_k + (size_t)r * 512, MEMK + dst, 512, lane); }
        for (int it = gw_; it < 512; it += NGW_) { const int hdb = it & 3, mb = (it >> 2) & 3, b = (it >> 4) & 7, l = it >> 7, m = mb * 64 + lane;
            const float* src = cache_mem_v + (size_t)((l * 8 + b) * 256 + m) * 512 + hdb * 128; bf16* dst = MEMV + (size_t)((l * 12 + 4 + b) * 512 + hdb * 128) * 256 + m;
            for (int q4 = 0; q4 < 32; ++q4) { const f32x4 v = *(const f32x4*)(src + 4 * q4);
#pragma unroll
                for (int e = 0; e < 4; ++e) dst[(size_t)(4 * q4 + e) * 256] = (bf16)f2bf(v[e]); } }
        for (int r = gw_; r < 8 * 2048; r += NGW_) { const int b = r >> 11, s = r & 2047; const float* src = cache_sb_k + (size_t)r * 1536;
            for (int j = lane * 4; j < 1536; j += 256) { const f32x4 v = *(const f32x4*)(src + j);
                *(unsigned long long*)(SBKS + ((size_t)(b * 12 + (j >> 7)) * 2080 + s) * 128 + (j & 127)) = (unsigned long long)pk2(v.x, v.y) | ((unsigned long long)pk2(v.z, v.w) << 32); } }
        for (int it = gw_; it < 3072; it += NGW_) { const int cb = it % 12, sb_ = (it / 12) & 31, b = it / 384, s = sb_ * 64 + lane;
            const float* src = cache_sb_v + (size_t)(b * 2048 + s) * 1536 + cb * 128; bf16* dst = SBVS + ((size_t)(b * 12 + cb) * 65 + (s >> 5)) * 4096 + pg8::vtf_k(s & 31);
            for (int q4 = 0; q4 < 32; ++q4) { const f32x4 v = *(const f32x4*)(src + 4 * q4);
#pragma unroll
                for (int e = 0; e < 4; ++e) dst[pg8::vtf_d(4 * q4 + e)] = (bf16)f2bf(v[e]); } }
        for (int l = 0; l < 4; ++l) wt_convert(F.lds, wave_, gw_, NGW_, lane, w_mem_kv + (size_t)l * D * 1024, D, 1024, WMEM + (size_t)l * 1024 * D, 1024, MapId());
        CONVERT_WEIGHTS(0);
    PHASE_END
    for (int l = 0; l < 4; ++l) {
        const bool LA = l < 2;
        const int ldp = LA ? NA : NBQ;
        PHASE_BEGIN(true, 2)
            if (!LA && (bid_ & 1)) { { SkBf16 E{PROJ, ldp}; skinny_gemm(bid_, G_, FRESH_TID(), wave_, F.lds + RING_OFF, X + (size_t)MP * D, D, WIN, D, ldp / 32, E); }
                if (l == 2) { SkKV E{out + O_SKS, out + O_SVS, SBKS, SBVS}; skinny_gemm(bid_, G_, FRESH_TID(), wave_, F.lds + RING_OFF, X + (size_t)MP * D, D, WIN + (size_t)NBQ * D, D, NKV / 32, E); } }
            { pg8::Gemm g{X, WIN, MP, ldp, D}; pg8::StaticOrder S; S.init(MP, ldp, G_, bid_); pg8::EpiBf16 E{PROJ, ldp};
              pg8::gemm_phase<pg8::EpiBf16, pg8::StaticOrder, true, true>(F.lds + RING_OFF, g, S, E, FRESH_TID()); }
            if (l == 0 && bid_ >= (G_ >> 1) && bid_ < (G_ >> 1) + 64) { pg8::Gemm g{MEMX, WMEM, 1024, 4096, D}; pg8::StaticOrder S; S.init(1024, 4096, 64, bid_ - (G_ >> 1));
              pg8::EpiMemKV E{out + O_MKP, out + O_MVP, MEMK, MEMV};
              pg8::gemm_phase<pg8::EpiMemKV, pg8::StaticOrder, true, true>(F.lds + RING_OFF, g, S, E, FRESH_TID()); }
            if (l == 2) { pg8::Gemm g{X, WIN + (size_t)NBQ * D, MP, NKV, D}; pg8::StaticOrder S; S.init(MP, NKV, G_, bid_);
              pg8::EpiKV E{out + O_SKP, out + O_SVP, out + O_SKS, out + O_SVS, KPB, VPB, SBKS, SBVS};
              pg8::gemm_phase<pg8::EpiKV, pg8::StaticOrder, true, true>(F.lds + RING_OFF, g, S, E, FRESH_TID()); }
            if (LA) { if (bid_ >= (G_ >> 1)) { SkBf16 E{PROJ, ldp}; skinny_gemm(bid_ - (G_ >> 1), G_ >> 1, FRESH_TID(), wave_, F.lds + RING_OFF, X + (size_t)MP * D, D, WIN, D, ldp / 32, E); } }
            else if (!(bid_ & 1))
            for (int skr = 0; skr < SK_REP; ++skr) { SkBf16 E{PROJ, ldp}; skinny_gemm(bid_, G_, FRESH_TID(), wave_, F.lds + RING_OFF, X + (size_t)MP * D, D, WIN, D, ldp / 32, E); }
            if (!(bid_ & 1))
            for (int skr = 0; skr < SK_REP; ++skr) if (l == 2) { SkKV E{out + O_SKS, out + O_SVS, SBKS, SBVS}; skinny_gemm(bid_, G_, FRESH_TID(), wave_, F.lds + RING_OFF, X + (size_t)MP * D, D, WIN + (size_t)NBQ * D, D, NKV / 32, E); }
        PHASE_END
        PHASE_BEGIN(LA, 3)
            gla_prep_intra(bid_, G_, tid, wave_, F.lds + RING_OFF, l, PROJ, w_gate_lr, b_gate, (unsigned char*)Y, OINT);
        PHASE_END
        PHASE_BEGIN(!LA, 11)
            {
#if defined(SB_MODE)
                for (int u = gw_; u < 12288; u += NGW_) { const int bh = u >> 8, qb = u & 255, b = bh / 12, h = bh % 12, t0 = 32 * qb; const size_t qo = (size_t)(b * SEQ + t0) * D + h * 128;
                    sb_attn<SB_MODE>(lane, F.lds + RING_OFF + wave_ * 16384, KPB + (size_t)bh * SEQ * 128, 128, VPB + (size_t)bh * SEQ * 128, 0, PROJ + qo, NBQ, OCAT + qo, t0, 32); }
#endif
                for (int sbr = 0; sbr < SB_REP; ++sbr)
                for (int u = gw_; u < 12288 + 96; u += NGW_) {
                    if (u < 12288) { const int bh = u >> 8, qb = u & 255, b = bh / 12, h = bh % 12, t0 = 32 * qb; const size_t qo = (size_t)(b * SEQ + t0) * D + h * 128;
                        sb_attn(lane, F.lds + RING_OFF + wave_ * 16384, KPB + (size_t)bh * SEQ * 128, 128, VPB + (size_t)bh * SEQ * 128, 0, PROJ + qo, NBQ, OCAT + qo, t0, 32); }
                    else { const int u2 = u - 12288, b = u2 / 12, h = u2 % 12; const size_t qo = (size_t)(MP + b * 16) * D + h * 128;
                        sb_attn(lane, F.lds + RING_OFF + wave_ * 16384, SBKS + (size_t)u2 * 2080 * 128, 128, SBVS + (size_t)u2 * 65 * 4096, 0, PROJ + qo, NBQ, OCAT + qo, 2048, 16); }
                }
            }
            __syncthreads();
            for (int mr = 0; mr < MEM_REP; ++mr)
            for (int wi = bid_; wi < 256 + 32; wi += G_) mem_attn_wg(wi, FRESH_TID(), wave_, F.lds + RING_OFF, l, PROJ, ldp, LA ? CQM : 1536, MEMK, MEMV, OCAT);
        PHASE_END
        PHASE_BEGIN(LA, 12)
            { const int mb = G_ > 144 ? bid_ - 144 : bid_, nmem = G_ > 144 ? G_ - 144 : G_;
              if (mb >= 0) for (int wi = mb; wi < 256 + 32; wi += nmem) mem_attn_wg(wi, FRESH_TID(), wave_, F.lds + RING_OFF, l, PROJ, ldp, CQM, MEMK, MEMV, OCAT); }
            for (int wc = bid_; wc < 144; wc += G_) gla_chain<1>(wc, FRESH_TID(), wave_, F.lds + RING_OFF, l, (const unsigned char*)Y, state_gla, OINT, out, (float*)WMEM, (float*)MEMX);
        PHASE_END
        PHASE_BEGIN(LA, 5)
            for (int wc = bid_; wc < 192 + 96; wc += G_) gla_chain<2>(wc, FRESH_TID(), wave_, F.lds + RING_OFF, l, (const unsigned char*)Y, state_gla, OINT, out, (float*)WMEM, (float*)MEMX, REP_CLS == 5 && rep_ == 0);
        PHASE_END
        PHASE_BEGIN(LA, 6)
            const float* gn = gla_norm_g + (size_t)l * 384;
            for (int row = gw_; row < MR; row += NGW_) {
                const float* op = OINT + (size_t)row * 1536 + 24 * lane; const bf16* gp = PROJ + (size_t)row * NA + CG + 24 * lane; const float* gnp = gn + 24 * (lane & 15);
                f32x4 ov[6]; v4u gv[3]; float ss = 0.f;
#pragma unroll
                for (int j = 0; j < 6; ++j) { ov[j] = *(const f32x4*)(op + 4 * j); ss += (ov[j].x * ov[j].x + ov[j].y * ov[j].y) + (ov[j].z * ov[j].z + ov[j].w * ov[j].w); }
#pragma unroll
                for (int j = 0; j < 3; ++j) gv[j] = *(const v4u*)(gp + 8 * j);
                ss += shx(ss, lane, 1); ss += shx(ss, lane, 2); ss += shx(ss, lane, 4); ss += shx(ss, lane, 8);
                const float r = 1.0f / sqrtf(ss * (1.0f / 384.0f) + RMS_EPS);
#pragma unroll
                for (int j = 0; j < 3; ++j) { const f32x4 n0 = *(const f32x4*)(gnp + 8 * j), n1 = *(const f32x4*)(gnp + 8 * j + 4); const f32x4 a = ov[2 * j], b = ov[2 * j + 1];
                    float gt[8]; gt[0] = pg8::bflo(gv[j].x); gt[1] = pg8::bfhi(gv[j].x); gt[2] = pg8::bflo(gv[j].y); gt[3] = pg8::bfhi(gv[j].y); gt[4] = pg8::bflo(gv[j].z); gt[5] = pg8::bfhi(gv[j].z); gt[6] = pg8::bflo(gv[j].w); gt[7] = pg8::bfhi(gv[j].w);
                    float o8[8];
#pragma unroll
                    for (int i = 0; i < 4; ++i) { o8[i] = a[i] * r * n0[i] * (gt[i] * __builtin_amdgcn_rcpf(1.0f + __expf(-gt[i]))); o8[4 + i] = b[i] * r * n1[i] * (gt[4 + i] * __builtin_amdgcn_rcpf(1.0f + __expf(-gt[4 + i]))); }
                    v4u o; o.x = pk2(o8[0], o8[1]); o.y = pk2(o8[2], o8[3]); o.z = pk2(o8[4], o8[5]); o.w = pk2(o8[6], o8[7]);
                    *(v4u*)(OCAT + (size_t)row * D + 24 * lane + 8 * j) = o; }
            }
        PHASE_END
        PHASE_BEGIN(true, 7)
            if (bid_ & 1) { SkRes Es{YB, X, DN_ALPHA}; skinny_gemm(bid_, G_, FRESH_TID(), wave_, F.lds + RING_OFF, OCAT + (size_t)MP * D, D, WO, D, D / 32, Es); }
            pg8::Gemm g{OCAT, WO, MP, D, D}; pg8::StaticOrder S; S.init(MP, D, G_, bid_); pg8::EpiRes E{YB, X, D, DN_ALPHA};
            pg8::gemm_phase<pg8::EpiRes, pg8::StaticOrder, true, true>(F.lds + RING_OFF, g, S, E, FRESH_TID());
            if (!(bid_ & 1))
            for (int skr = 0; skr < SK_REP; ++skr) { SkRes Es{YB, X, DN_ALPHA}; skinny_gemm(bid_, G_, FRESH_TID(), wave_, F.lds + RING_OFF, OCAT + (size_t)MP * D, D, WO, D, D / 32, Es); }
        PHASE_END
        PHASE_BEGIN(true, 8)
            const float* gg = ln1_g + (size_t)l * D; const float* bb = ln1_b + (size_t)l * D;
            for (int row = 2 * gw_; row < MR; row += 2 * NGW_) ln_two_rows<false>(lane, YB + (size_t)row * D, YB + (size_t)(row + 1) * D, gg, bb, X + (size_t)row * D, X + (size_t)(row + 1) * D, nullptr, nullptr);
        PHASE_END
        PHASE_BEGIN(true, 9)
            for (int dl = 0; dl < 3 * STAG * (bid_ >> 1 & 3); ++dl) __builtin_amdgcn_s_sleep(127);
            if (bid_ & 1) { SkSwiGLU Es{HB}; skinny_gemm(bid_, G_, FRESH_TID(), wave_, F.lds + RING_OFF, X + (size_t)MP * D, D, WFI, D, DFF / 16, Es); }
            pg8::Gemm g{X, WFI, MP, 2 * DFF, D}; pg8::StaticOrder S; S.init(MP, 2 * DFF, G_, bid_); pg8::EpiSwiGLU E{HB, DFF};
            pg8::gemm_phase<pg8::EpiSwiGLU, pg8::StaticOrder, true, true>(F.lds + RING_OFF, g, S, E, FRESH_TID());
            if (!(bid_ & 1))
            for (int skr = 0; skr < SK_REP; ++skr) { SkSwiGLU Es{HB}; skinny_gemm(bid_, G_, FRESH_TID(), wave_, F.lds + RING_OFF, X + (size_t)MP * D, D, WFI, D, DFF / 16, Es); }
        PHASE_END
        PHASE_BEGIN(true, 10)
            if (bid_ & 1) { SkRes Es{YB, X, DN_ALPHA}; skinny_gemm(bid_, G_, FRESH_TID(), wave_, F.lds + RING_OFF, HB + (size_t)MP * DFF, DFF, WFO, DFF, D / 32, Es); }
            pg8::Gemm g{HB, WFO, MP, D, DFF}; pg8::StaticOrder S; S.init(MP, D, G_, bid_); pg8::EpiRes E{YB, X, D, DN_ALPHA};
            pg8::gemm_phase<pg8::EpiRes, pg8::StaticOrder, true, true>(F.lds + RING_OFF, g, S, E, FRESH_TID());
            if (!(bid_ & 1))
            for (int skr = 0; skr < SK_REP; ++skr) { SkRes Es{YB, X, DN_ALPHA}; skinny_gemm(bid_, G_, FRESH_TID(), wave_, F.lds + RING_OFF, HB + (size_t)MP * DFF, DFF, WFO, DFF, D / 32, Es); }
        PHASE_END
        PHASE_BEGIN(true, 8)
            if (l < 3) CONVERT_WEIGHTS(l + 1);
            const float* gg = ln2_g + (size_t)l * D; const float* bb = ln2_b + (size_t)l * D;
            if (l == 3) { for (int row = 2 * gw_; row < MR; row += 2 * NGW_) { float* of = row < MP ? out + O_YP + (size_t)row * D : out + O_YS + (size_t)(row - MP) * D;
                ln_two_rows<true>(lane, YB + (size_t)row * D, YB + (size_t)(row + 1) * D, gg, bb, nullptr, nullptr, of, of + D); } }
            else for (int row = 2 * gw_; row < MR; row += 2 * NGW_) ln_two_rows<false>(lane, YB + (size_t)row * D, YB + (size_t)(row + 1) * D, gg, bb, X + (size_t)row * D, X + (size_t)(row + 1) * D, nullptr, nullptr);
        PHASE_END
    }
#if defined(DIAG_A)
    if (blockIdx.x == 0 && threadIdx.x == 0) { unsigned long long* dts = (unsigned long long*)(args.ws_ + 262144); dts[ph] = rt(); dts[63] = (unsigned long long)ph; }
#endif
#undef ws
#undef out
#undef X
#undef Y
#undef YB
#undef CONVERT_WEIGHTS
#undef PHASE_BEGIN
#undef PHASE_END
}

#if defined(DIAG_A)
__device__ const int diag_cls[40] = {0,0, 1,2,3,4,5,6,7,8,9,10,8, 1,2,3,4,5,6,7,8,9,10,8, 1,2,11,7,8,9,10,8, 1,2,11,7,8,9,10,8};
__global__ void diag_tail(float* o, const unsigned long long* dts) {
    __shared__ float dv[2];
    if (threadIdx.x == 0) { const int n = (int)dts[63]; unsigned long long sa = 0, sb = 0; for (int p = 0; p < n; ++p) { const unsigned long long d = dts[p + 1] - dts[p]; const int cl = diag_cls[p]; if (cl == DIAG_A) sa += d; if (cl == DIAG_B) sb += d; }
        dv[0] = (float)sa * 0.01f; dv[1] = (float)sb * 10.0f; }
    __syncthreads();
    for (int i = threadIdx.x; i < 262144; i += blockDim.x) o[O_YS + i] = dv[0];
    if (threadIdx.x == 0) o[O_YP] = dv[1];
}
#endif
#ifndef MK_PER_PHASE
#define MK_PER_PHASE 0
#endif
constexpr int N_PHASES = 1 + 2 * 10 + 2 * 7;
extern "C" void kernel_launch(void* const* d_in, const int* in_sizes, int n_in, void* d_out, int out_size, void* d_ws, size_t ws_size, hipStream_t stream) {
    static int grid = 0;
    if (grid == 0) {
        if (n_in != 22 || in_sizes[0] != MP * D || (size_t)out_size != O_END || ws_size < WS_END) { fprintf(stderr, "kernel_launch: unexpected shapes (n_in %d, in0 %d, out %d, ws %zu); nothing launched\n", n_in, n_in > 0 ? in_sizes[0] : -1, out_size, ws_size); grid = -1; return; }
        int dev = 0, cus = 0, per_cu = 0;
        if (hipGetDevice(&dev) != hipSuccess || hipDeviceGetAttribute(&cus, hipDeviceAttributeMultiprocessorCount, dev) != hipSuccess) { grid = -1; return; }
        if (hipFuncSetAttribute((const void*)mega, hipFuncAttributeMaxDynamicSharedMemorySize, LDS_BYTES) != hipSuccess) { fprintf(stderr, "kernel_launch: hipFuncSetAttribute failed\n"); grid = -1; return; }
        if (hipOccupancyMaxActiveBlocksPerMultiprocessor(&per_cu, (const void*)mega, NWAVES * 64, LDS_BYTES) != hipSuccess || per_cu < 1) fprintf(stderr, "kernel_launch: occupancy query reports %d\n", per_cu);
        (void)hipGetLastError();
        grid = cus;
    }
    if (grid < 0) return;
    if (hipMemsetAsync((char*)d_ws + WS_CTL, 0, CTL_ZERO_BYTES, stream) != hipSuccess) return;
    Args a{};
    for (int i = 0; i < 22; ++i) a.in[i] = (const float*)d_in[i];
    a.out_ = (float*)d_out; a.ws_ = (unsigned char*)d_ws;
#if MK_PER_PHASE
    for (int p = 0; p < N_PHASES; ++p) { a.ph_lo = p; a.ph_hi = p + 1; hipLaunchKernelGGL(mega, dim3(grid), dim3(NWAVES * 64), LDS_BYTES, stream, a); }
#else
    a.ph_lo = 0; a.ph_hi = N_PHASES; hipLaunchKernelGGL(mega, dim3(grid), dim3(NWAVES * 64), LDS_BYTES, stream, a);
#if defined(DIAG_A)
    hipLaunchKernelGGL(diag_tail, dim3(1), dim3(512), 0, stream, (float*)d_out, (const unsigned long long*)((unsigned char*)d_ws + 262144));
#endif
#endif
}
```

```cpp
#include <hip/hip_runtime.h>
#include <cstdio>
#include <cstdint>
namespace pg8 {
#define PG8_LAS __attribute__((address_space(3)))
typedef unsigned short bf16_t;
typedef short bf16x8 __attribute__((ext_vector_type(8)));
typedef float f32x4 __attribute__((ext_vector_type(4)));
typedef unsigned u32x4 __attribute__((ext_vector_type(4)));
constexpr int BM = 256, BK = 64, HALF = 128, HTB = HALF * BK * 2  , STAGE_BYTES = 8 * HTB, NXCD = 8, WGM = 4;

__host__ __device__ __forceinline__ int lds_byte(int r, int c) { const int st = (r >> 4) * 2 + (c >> 5), rr = r & 15, cc = c & 31, ob = rr * 64 + cc * 2; return st * 1024 + (ob ^ (((ob >> 9) & 1) << 5)); }
__host__ __device__ __forceinline__ void stage_rc(int b, int& R, int& C) { const int st = b / 1024, sb = b % 1024, swz = sb ^ (((sb >> 9) & 1) << 5); R = (st >> 1) * 16 + swz / 64; C = (st & 1) * 32 + (swz % 64) / 2; }
__host__ __device__ __forceinline__ int perm32(int rho) { const int n = rho >> 4, i = rho & 15; return 8 * (i >> 2) + 4 * n + (i & 3); }

struct Unit { int pm, pn; };
struct Gemm { const bf16_t* A; const bf16_t* Bt; int M, N, K; };

struct StaticOrder {
    int nM, nN, nwg, G, c;
    __host__ __device__ void init(int M, int N, int G_, int c_) { nM = M / BM; nN = N / BM; nwg = nM * nN; G = G_; c = c_; }
    __host__ __device__ bool next(int i, Unit& u) const {
        const long L = (long)i * G + c; if (L >= nwg) return false;
        int wgid = (int)L; { const int q = nwg / NXCD, r = nwg % NXCD, xcd = wgid % NXCD, off = wgid / NXCD; wgid = (xcd < r ? xcd * (q + 1) : r * (q + 1) + (xcd - r) * q) + off; }
        const int nig = WGM * nN, gid = wgid / nig, fm = gid * WGM, gsz = (nM - fm) < WGM ? (nM - fm) : WGM;
        u.pm = fm + ((wgid % nig) % gsz); u.pn = (wgid % nig) / gsz; return true;
    }
    __device__ __forceinline__ void a_ready(const Unit&) const {}
    __device__ __forceinline__ void done(const Unit&) const {}
};
__device__ __forceinline__ unsigned cvt_pk_bf16(float lo, float hi) { unsigned r; asm volatile("v_cvt_pk_bf16_f32 %0, %1, %2" : "=v"(r) : "v"(lo), "v"(hi)); return r; }
typedef float f32x2 __attribute__((ext_vector_type(2)));
typedef unsigned u32x2 __attribute__((ext_vector_type(2)));
__host__ __device__ __forceinline__ int vtf_d(int d) { return (d >> 5) * 1024 + (d & 31) * 8; }
__host__ __device__ __forceinline__ int vtf_k(int ks) { return (ks >> 4) * 512 + ((ks >> 2) & 1) * 256 + (ks & 3) + 4 * ((ks >> 3) & 1); }
__device__ __forceinline__ float bflo(unsigned w) { return __builtin_bit_cast(float, w << 16); }
__device__ __forceinline__ float bfhi(unsigned w) { return __builtin_bit_cast(float, w & 0xffff0000u); }
struct EpiBf16 {
    static constexpr bool PERM = true, AFTER_DRAIN = false;
    bf16_t* O; int ldc;
    __device__ __forceinline__ void operator()(const f32x4 (&acc)[2][2][4][2], const Unit& u, int wr, int wc, int fr, int fq) const {
        const int row0 = u.pm * BM + wr * 64 + fr, col0 = u.pn * BM + wc * 32 + 8 * fq;
#pragma unroll
        for (int ai = 0; ai < 2; ++ai)
#pragma unroll
            for (int m = 0; m < 4; ++m) { bf16_t* rowp = O + (size_t)(row0 + ai * HALF + m * 16) * ldc + col0;
#pragma unroll
                for (int bj = 0; bj < 2; ++bj) { const f32x4 v0 = acc[ai][bj][m][0], v1 = acc[ai][bj][m][1];
                    u32x4 w; w.x = cvt_pk_bf16(v0[0], v0[1]); w.y = cvt_pk_bf16(v0[2], v0[3]); w.z = cvt_pk_bf16(v1[0], v1[1]); w.w = cvt_pk_bf16(v1[2], v1[3]);
                    *(u32x4*)(rowp + bj * HALF) = w; } }
    }
};
struct EpiSwiGLU {
    static constexpr bool PERM = true, AFTER_DRAIN = false;
    bf16_t* Hh; int ldh;
    __device__ __forceinline__ float swi(float g, float up) const { return g * __builtin_amdgcn_rcpf(1.0f + __expf(-g)) * up; }
    __device__ __forceinline__ void operator()(const f32x4 (&acc)[2][2][4][2], const Unit& u, int wr, int wc, int fr, int fq) const {
        const int row0 = u.pm * BM + wr * 64 + fr, col0 = u.pn * HALF + wc * 32 + 8 * fq;
#pragma unroll
        for (int ai = 0; ai < 2; ++ai)
#pragma unroll
            for (int m = 0; m < 4; ++m) { bf16_t* rowp = Hh + (size_t)(row0 + ai * HALF + m * 16) * ldh + col0;
                const f32x4 g0 = acc[ai][0][m][0], g1 = acc[ai][0][m][1], u0 = acc[ai][1][m][0], u1 = acc[ai][1][m][1];
                u32x4 w; w.x = cvt_pk_bf16(swi(g0[0], u0[0]), swi(g0[1], u0[1])); w.y = cvt_pk_bf16(swi(g0[2], u0[2]), swi(g0[3], u0[3]));
                w.z = cvt_pk_bf16(swi(g1[0], u1[0]), swi(g1[1], u1[1])); w.w = cvt_pk_bf16(swi(g1[2], u1[2]), swi(g1[3], u1[3]));
                *(u32x4*)rowp = w; }
    }
};
struct EpiRes {
    static constexpr bool PERM = true, AFTER_DRAIN = false;
    bf16_t* Y; const bf16_t* X; int ldc; float alpha;
    __device__ __forceinline__ void operator()(const f32x4 (&acc)[2][2][4][2], const Unit& u, int wr, int wc, int fr, int fq) const {
        const int row0 = u.pm * BM + wr * 64 + fr, col0 = u.pn * BM + wc * 32 + 8 * fq;
        u32x4 xv[2][4][2];
#pragma unroll
        for (int ai = 0; ai < 2; ++ai)
#pragma unroll
            for (int m = 0; m < 4; ++m)
#pragma unroll
                for (int bj = 0; bj < 2; ++bj) xv[ai][m][bj] = *(const u32x4*)(X + (size_t)(row0 + ai * HALF + m * 16) * ldc + col0 + bj * HALF);
#pragma unroll
        for (int ai = 0; ai < 2; ++ai)
#pragma unroll
            for (int m = 0; m < 4; ++m) { const size_t ro = (size_t)(row0 + ai * HALF + m * 16) * ldc + col0;
#pragma unroll
                for (int bj = 0; bj < 2; ++bj) { const u32x4 x4 = xv[ai][m][bj]; const f32x4 a0 = acc[ai][bj][m][0], a1 = acc[ai][bj][m][1];
                    u32x4 w; w.x = cvt_pk_bf16(alpha * bflo(x4.x) + a0[0], alpha * bfhi(x4.x) + a0[1]); w.y = cvt_pk_bf16(alpha * bflo(x4.y) + a0[2], alpha * bfhi(x4.y) + a0[3]);
                    w.z = cvt_pk_bf16(alpha * bflo(x4.z) + a1[0], alpha * bfhi(x4.z) + a1[1]); w.w = cvt_pk_bf16(alpha * bflo(x4.w) + a1[2], alpha * bfhi(x4.w) + a1[3]);
                    *(u32x4*)(Y + ro + bj * HALF) = w; } }
    }
};
struct EpiKV {
    static constexpr bool PERM = false, AFTER_DRAIN = false;
    float *okp, *ovp, *oks, *ovs; bf16_t *kpb, *vpb, *ksb, *vsb;
    __device__ __forceinline__ void operator()(const f32x4 (&acc)[2][2][4][2], const Unit& u, int wr, int wc, int fr, int fq) const {
        const bool isv = u.pn >= 6; const int colt = (u.pn - (isv ? 6 : 0)) * BM + wc * 32 + 4 * fq, row0 = u.pm * BM + wr * 64 + fr;
        float* op = isv ? ovp : okp;
#pragma unroll
        for (int ai = 0; ai < 2; ++ai)
#pragma unroll
            for (int m = 0; m < 4; ++m) { const int row = row0 + ai * HALF + m * 16; float* fd;
                if (row < 32768) { fd = op + (size_t)row * 1536; } else continue;
                const int bq = row >> 13, sq = row & 8191;
#pragma unroll
                for (int bj = 0; bj < 2; ++bj)
#pragma unroll
                    for (int n = 0; n < 2; ++n) { const int c = colt + bj * HALF + n * 16; const f32x4 v = acc[ai][bj][m][n];
                        *(f32x4*)(fd + c) = v; const unsigned w0 = cvt_pk_bf16(v[0], v[1]), w1 = cvt_pk_bf16(v[2], v[3]);
                        const int hq = c >> 7, dq = c & 127;
                        if (!isv) { u32x2 w; w.x = w0; w.y = w1; *(u32x2*)(kpb + ((size_t)(bq * 12 + hq) * 8192 + sq) * 128 + dq) = w; }
                        else { bf16_t* vt = vpb + ((size_t)(bq * 12 + hq) * 256 + (sq >> 5)) * 4096 + vtf_d(dq) + vtf_k(sq & 31); vt[0] = (bf16_t)w0; vt[8] = (bf16_t)(w0 >> 16); vt[16] = (bf16_t)w1; vt[24] = (bf16_t)(w1 >> 16); } } }
    }
};
struct EpiMemKV {
    static constexpr bool PERM = false, AFTER_DRAIN = false;
    float *ok, *ov; bf16_t *kb, *vb;
    __device__ __forceinline__ void operator()(const f32x4 (&acc)[2][2][4][2], const Unit& u, int wr, int wc, int fr, int fq) const {
        const int l = u.pn >> 2, kv = (u.pn >> 1) & 1, hd0 = (u.pn & 1) * BM + wc * 32 + 4 * fq, row0 = u.pm * BM + wr * 64 + fr;
        float* fo = kv ? ov : ok; bf16_t* bo = kv ? vb : kb;
#pragma unroll
        for (int ai = 0; ai < 2; ++ai)
#pragma unroll
            for (int m = 0; m < 4; ++m) { const int row = row0 + ai * HALF + m * 16, b = row >> 8, mm = row & 255;
                float* fd = fo + (size_t)(l * 1024 + row) * 512; bf16_t* bd = bo + (size_t)((l * 12 + b) * 256 + mm) * 512;
#pragma unroll
                for (int bj = 0; bj < 2; ++bj)
#pragma unroll
                    for (int n = 0; n < 2; ++n) { const int c = hd0 + bj * HALF + n * 16; const f32x4 v = acc[ai][bj][m][n];
                        *(f32x4*)(fd + c) = v; const unsigned w0 = cvt_pk_bf16(v[0], v[1]), w1 = cvt_pk_bf16(v[2], v[3]);
                        if (!kv) { u32x2 w; w.x = w0; w.y = w1; *(u32x2*)(bd + c) = w; }
                        else { bf16_t* vt = vb + (size_t)((l * 12 + b) * 512 + c) * 256 + mm;
                            vt[0] = (bf16_t)w0; vt[256] = (bf16_t)(w0 >> 16); vt[512] = (bf16_t)w1; vt[768] = (bf16_t)(w1 >> 16); } } }
    }
};
template <class Epi, class Sched, bool ALIGN_EPI = false, bool SP2 = false>
__device__ __forceinline__ void gemm_phase(PG8_LAS unsigned char* lds, const Gemm g, const Sched& S, const Epi& E, int tid_in) {
    int tid_ = tid_in; asm volatile("" : "+v"(tid_));
    const int tid = tid_, wid = __builtin_amdgcn_readfirstlane(tid >> 6), lane = tid & 63, wr = wid >> 2, wc = wid & 3, fr = lane & 15, fq = lane >> 4;
    const int K = g.K, nt = K / BK;
    unsigned voffA[2], voffB[2];
#pragma unroll
    for (int i = 0; i < 2; ++i) { int R, C; stage_rc(tid * 16 + i * 8192, R, C); const int Rb = Epi::PERM ? ((R & ~31) + perm32(R & 31)) : R;
        voffA[i] = (unsigned)(R * K + C) * 2u; voffB[i] = (unsigned)(Rb * K + C) * 2u; }
    const size_t kstep = (size_t)(BK * 2);
    const size_t hstep = (size_t)HALF * K * 2;
    const size_t tstep = 2 * hstep;
    const unsigned ldsw = (unsigned)wid * 1024u;
    const int aoff = lds_byte(wr * 64 + fr, fq * 8), boff = lds_byte(wc * 32 + fr, fq * 8);
#define PG8_SA(b, h) (((b) * 2 + (h)) * HTB)
#define PG8_SB(b, h) ((4 + (b) * 2 + (h)) * HTB)
#define PG8_STAGE_X(bufoff, gbase, voff, aux) do { _Pragma("unroll") for (int _i = 0; _i < 2; ++_i) \
        __builtin_amdgcn_global_load_lds((const unsigned*)((const char*)(gbase) + (voff)[_i]), (PG8_LAS unsigned*)(lds + (bufoff) + ldsw + _i * 8192), 16, 0, aux); } while (0)
#ifndef PG8_B_AUX
#define PG8_B_AUX 0
#endif
#define PG8_STAGE(bufoff, gbase, voff) PG8_STAGE_X(bufoff, gbase, voff, 0)
#define PG8_LDA(dst, b, h) do { _Pragma("unroll") for (int m = 0; m < 4; ++m) _Pragma("unroll") for (int k = 0; k < 2; ++k) dst[m][k] = *(const PG8_LAS bf16x8*)(lds + PG8_SA(b, h) + aoff + m * 2048 + k * 1024); } while (0)
#define PG8_LDB(dst, b, h) do { _Pragma("unroll") for (int n = 0; n < 2; ++n) _Pragma("unroll") for (int k = 0; k < 2; ++k) dst[n][k] = *(const PG8_LAS bf16x8*)(lds + PG8_SB(b, h) + boff + n * 2048 + k * 1024); } while (0)
#define PG8_MMA(ai, bj, At, Bt) do { __builtin_amdgcn_s_setprio(1); _Pragma("unroll") for (int m = 0; m < 4; ++m) _Pragma("unroll") for (int n = 0; n < 2; ++n) _Pragma("unroll") for (int k = 0; k < 2; ++k) \
        acc[ai][bj][m][n] = __builtin_amdgcn_mfma_f32_16x16x32_bf16(Bt[n][k], At[m][k], acc[ai][bj][m][n], 0, 0, 0); __builtin_amdgcn_s_setprio(0); } while (0)
#define PG8_WAIT_V(n) asm volatile("s_waitcnt vmcnt(" #n ")" ::: "memory")
#define PG8_WAIT_L(n) asm volatile("s_waitcnt lgkmcnt(" #n ")" ::: "memory")
#define PG8_BAR __builtin_amdgcn_s_barrier()
#define PG8_SCHED __builtin_amdgcn_sched_barrier(0)
    Unit cur, nxt; int ui = 0;
    if (!S.next(0, cur)) return;
    f32x4 acc[2][2][4][2];
#pragma unroll
    for (int a = 0; a < 2; ++a)
#pragma unroll
        for (int b = 0; b < 2; ++b)
#pragma unroll
            for (int m = 0; m < 4; ++m)
#pragma unroll
                for (int n = 0; n < 2; ++n) acc[a][b][m][n] = (f32x4){0.f, 0.f, 0.f, 0.f};
    bf16x8 At[4][2], B0[2][2], B1[2][2];
    const char* cA = (const char*)g.A + (size_t)cur.pm * tstep; const char* cB = (const char*)g.Bt + (size_t)cur.pn * tstep;
    S.a_ready(cur);
    if constexpr (SP2) {
        PG8_STAGE_X(PG8_SB(0, 0), cB, voffB, PG8_B_AUX); PG8_STAGE_X(PG8_SB(0, 1), cB + hstep, voffB, PG8_B_AUX); PG8_STAGE(PG8_SA(0, 0), cA, voffA); PG8_STAGE(PG8_SA(0, 1), cA + hstep, voffA);
        if (wr == 1) PG8_BAR;
        PG8_WAIT_V(2); PG8_BAR;
        PG8_STAGE_X(PG8_SB(1, 0), cB + kstep, voffB, PG8_B_AUX); PG8_STAGE(PG8_SA(1, 0), cA + kstep, voffA); PG8_STAGE_X(PG8_SB(1, 1), cB + hstep + kstep, voffB, PG8_B_AUX);
        PG8_WAIT_V(6); PG8_BAR;
    } else {
        PG8_STAGE_X(PG8_SB(0, 0), cB, voffB, PG8_B_AUX); PG8_STAGE(PG8_SA(0, 0), cA, voffA); PG8_STAGE_X(PG8_SB(0, 1), cB + hstep, voffB, PG8_B_AUX); PG8_STAGE(PG8_SA(0, 1), cA + hstep, voffA);
        if (wr == 1) PG8_BAR;
        PG8_WAIT_V(4); PG8_BAR;
        PG8_STAGE_X(PG8_SB(1, 0), cB + kstep, voffB, PG8_B_AUX); PG8_STAGE(PG8_SA(1, 0), cA + kstep, voffA); PG8_STAGE_X(PG8_SB(1, 1), cB + hstep + kstep, voffB, PG8_B_AUX);
        PG8_WAIT_V(6); PG8_BAR;
    }
    for (;;) {
        const bool has_next = S.next(ui + 1, nxt);
        const char* nA = has_next ? (const char*)g.A + (size_t)nxt.pm * tstep : cA; const char* nB = has_next ? (const char*)g.Bt + (size_t)nxt.pn * tstep : cB;
        for (int t = 0; t < nt; t += 2) {
            const bool last = (t == nt - 2);
            const char* a1 = cA + (size_t)(t + 1) * kstep;
            const char* a2 = last ? nA : cA + (size_t)(t + 2) * kstep; const char* b2 = last ? nB : cB + (size_t)(t + 2) * kstep;
            const char* a3 = a2 + kstep; const char* b3 = b2 + kstep;
            if (last && has_next) S.a_ready(nxt);
            if constexpr (SP2) {
            PG8_LDB(B0, 0, 0); PG8_LDB(B1, 0, 1); PG8_SCHED; PG8_LDA(At, 0, 0); PG8_STAGE(PG8_SA(1, 1), a1 + hstep, voffA);
            PG8_WAIT_V(8); PG8_WAIT_L(0); PG8_BAR; PG8_MMA(0, 0, At, B0); PG8_MMA(0, 1, At, B1); PG8_BAR; PG8_SCHED;
            PG8_LDA(At, 0, 1); PG8_STAGE_X(PG8_SB(0, 0), b2, voffB, PG8_B_AUX); PG8_STAGE_X(PG8_SB(0, 1), b2 + hstep, voffB, PG8_B_AUX); PG8_STAGE(PG8_SA(0, 0), a2, voffA);
            PG8_WAIT_V(8); PG8_WAIT_L(0); PG8_BAR; PG8_MMA(1, 0, At, B0); PG8_MMA(1, 1, At, B1); PG8_BAR; PG8_SCHED;
            PG8_LDB(B0, 1, 0); PG8_LDB(B1, 1, 1); PG8_SCHED; PG8_LDA(At, 1, 0); PG8_STAGE(PG8_SA(0, 1), a2 + hstep, voffA);
            PG8_WAIT_V(8); PG8_WAIT_L(0); PG8_BAR; PG8_MMA(0, 0, At, B0); PG8_MMA(0, 1, At, B1); PG8_BAR; PG8_SCHED;
            PG8_LDA(At, 1, 1); PG8_STAGE_X(PG8_SB(1, 0), b3, voffB, PG8_B_AUX); PG8_STAGE_X(PG8_SB(1, 1), b3 + hstep, voffB, PG8_B_AUX); PG8_STAGE(PG8_SA(1, 0), a3, voffA);
            PG8_WAIT_V(8); PG8_WAIT_L(0); PG8_BAR; PG8_MMA(1, 0, At, B0); PG8_MMA(1, 1, At, B1); PG8_BAR; PG8_SCHED;
            } else {
            PG8_LDB(B0, 0, 0); PG8_SCHED; PG8_LDA(At, 0, 0); PG8_STAGE(PG8_SA(1, 1), a1 + hstep, voffA);
            PG8_WAIT_L(8); PG8_BAR; PG8_WAIT_L(0); PG8_MMA(0, 0, At, B0); PG8_BAR; PG8_SCHED;
            PG8_LDB(B1, 0, 1); PG8_STAGE_X(PG8_SB(0, 0), b2, voffB, PG8_B_AUX);
            PG8_BAR; PG8_WAIT_L(0); PG8_MMA(0, 1, At, B1); PG8_BAR;
            PG8_LDA(At, 0, 1); PG8_STAGE(PG8_SA(0, 0), a2, voffA);
            PG8_BAR; PG8_WAIT_L(0); PG8_MMA(1, 0, At, B0); PG8_BAR; PG8_SCHED;
            PG8_STAGE_X(PG8_SB(0, 1), b2 + hstep, voffB, PG8_B_AUX);
            PG8_WAIT_V(6); PG8_BAR; PG8_MMA(1, 1, At, B1); PG8_BAR;
            PG8_LDB(B0, 1, 0); PG8_SCHED; PG8_LDA(At, 1, 0); PG8_STAGE(PG8_SA(0, 1), a2 + hstep, voffA);
            PG8_WAIT_L(8); PG8_BAR; PG8_WAIT_L(0); PG8_MMA(0, 0, At, B0); PG8_BAR; PG8_SCHED;
            PG8_LDB(B1, 1, 1); PG8_STAGE_X(PG8_SB(1, 0), b3, voffB, PG8_B_AUX);
            PG8_BAR; PG8_WAIT_L(0); PG8_MMA(0, 1, At, B1); PG8_BAR;
            PG8_LDA(At, 1, 1); PG8_STAGE(PG8_SA(1, 0), a3, voffA);
            PG8_BAR; PG8_WAIT_L(0); PG8_MMA(1, 0, At, B0); PG8_BAR; PG8_SCHED;
            PG8_STAGE_X(PG8_SB(1, 1), b3 + hstep, voffB, PG8_B_AUX);
            PG8_WAIT_V(6); PG8_BAR; PG8_MMA(1, 1, At, B1); PG8_BAR;
            }
        }
        if constexpr (ALIGN_EPI) { if (wr == 0) PG8_BAR; }
        if constexpr (!Epi::AFTER_DRAIN) { E(acc, cur, wr, wc, fr, fq); S.done(cur); }
        if (!has_next) break;
#pragma unroll
        for (int a = 0; a < 2; ++a)
#pragma unroll
            for (int b = 0; b < 2; ++b)
#pragma unroll
                for (int m = 0; m < 4; ++m)
#pragma unroll
                    for (int n = 0; n < 2; ++n) acc[a][b][m][n] = (f32x4){0.f, 0.f, 0.f, 0.f};
        cur = nxt; cA = nA; cB = nB; ++ui;
        if constexpr (ALIGN_EPI) { if (wr == 1) PG8_BAR; }
    }
    PG8_WAIT_V(0);
    if constexpr (!ALIGN_EPI) { if (wr == 0) PG8_BAR; }
    PG8_BAR;
    if constexpr (Epi::AFTER_DRAIN) { E.fused(acc, cur, wr, wc, fr, fq, lds, wid, lane); S.done(cur); }
#undef PG8_SA
#undef PG8_SB
#undef PG8_STAGE
#undef PG8_STAGE_X
#undef PG8_LDA
#undef PG8_LDB
#undef PG8_MMA
#undef PG8_WAIT_V
#undef PG8_WAIT_L
#undef PG8_BAR
#undef PG8_SCHED
}
}
#define GAS __attribute__((address_space(1)))
#define LAS __attribute__((address_space(3)))
typedef unsigned short bf16;
typedef unsigned v4u __attribute__((ext_vector_type(4)));
typedef float f32x4 __attribute__((ext_vector_type(4)));
typedef short bf16x8 __attribute__((ext_vector_type(8)));
typedef GAS unsigned gu32;
typedef GAS unsigned long long gu64;
#define RLX_AGENT __ATOMIC_RELAXED, __HIP_MEMORY_SCOPE_AGENT
#define LDS_WAIT() asm volatile("s_waitcnt lgkmcnt(0)" ::: "memory")
#define VM_WAIT() asm volatile("s_waitcnt vmcnt(0)" ::: "memory")
__device__ __forceinline__ unsigned long long rt() { return __builtin_amdgcn_s_memrealtime(); }
__device__ __forceinline__ unsigned f2bf(float f) { unsigned u = __builtin_bit_cast(unsigned, f); return (u + 0x7fffu + ((u >> 16) & 1u)) >> 16; }
__device__ __forceinline__ unsigned pk2(float lo, float hi) { return f2bf(lo) | (f2bf(hi) << 16); }
#define XB_TMO      128
#define XB_XCNT(j)  (256  + 64 * (j))
#define XB_XSUB(j)  (1280 + 64 * (j))
#define XB_XGEN(j)  (2304 + 64 * (j))
#define XB_TOP      3328
#define XB_TOPGEN   3392
#define XCD_BAR_WORDS 3456
#define XB_SPIN_CAP (1u << 18)

__device__ __forceinline__ unsigned xb_ld(unsigned* p)              { return __hip_atomic_load(p, __ATOMIC_RELAXED, __HIP_MEMORY_SCOPE_AGENT); }
__device__ __forceinline__ unsigned xb_add(unsigned* p, unsigned v) { return __hip_atomic_fetch_add(p, v, __ATOMIC_RELAXED, __HIP_MEMORY_SCOPE_AGENT); }
__device__ __forceinline__ unsigned xb_xcc_id() { return (unsigned)__builtin_amdgcn_s_getreg((3 << 11) | 20) & 0xFu; }
#define XB_SPIN(cond, bar) do { unsigned _sp = 0; while (cond) { __builtin_amdgcn_s_sleep(1); \
    if ((++_sp & 255u) == 0u) { if (xb_ld(&(bar)[XB_TMO])) break; if (_sp > XB_SPIN_CAP) { atomicAdd(&(bar)[XB_TMO], 1u); break; } } } } while (0)

struct XcdBarrier {
    unsigned* bar; unsigned x;
    volatile LAS unsigned* st;
};

__device__ __forceinline__ XcdBarrier xcd_barrier_post(unsigned* bar, volatile LAS unsigned* st) {
    XcdBarrier b; b.bar = bar; b.x = xb_xcc_id(); b.st = st;
    if (threadIdx.x == 0) (void)xb_add(&bar[XB_XCNT(b.x)], 1u);
    return b;
}
__device__ __forceinline__ void xcd_barrier_complete(unsigned* bar, unsigned x, unsigned& nloc, unsigned& nx) {
    const unsigned G = gridDim.x * gridDim.y * gridDim.z;
    unsigned sum, cnt, mine, sp = 0u;
    for (;;) {
        sum = 0u; cnt = 0u; mine = 0u;
#pragma unroll
        for (unsigned j = 0; j < 16; ++j) { const unsigned c = xb_ld(&bar[XB_XCNT(j)]); sum += c; cnt += (c > 0u) ? 1u : 0u; mine = (j == x) ? c : mine; }
        if (sum == G) break;
        __builtin_amdgcn_s_sleep(1);
        if ((++sp & 255u) == 0u) { if (xb_ld(&bar[XB_TMO])) break; if (sp > XB_SPIN_CAP) { atomicAdd(&bar[XB_TMO], 1u); break; } }
    }
    nloc = mine > 0u ? mine : 1u; nx = cnt > 0u ? cnt : 1u;
}

__device__ __forceinline__ void xcd_barrier(const XcdBarrier& b) {
    asm volatile("s_waitcnt vmcnt(0)" ::: "memory");
    __syncthreads();
    if (threadIdx.x == 0) {
        unsigned* bar = b.bar;
        __builtin_amdgcn_s_waitcnt(0);
        unsigned nloc = b.st[0], nx = b.st[1];
        if (nloc == 0u) { xcd_barrier_complete(bar, b.x, nloc, nx); b.st[0] = nloc; b.st[1] = nx; }
        const unsigned old = xb_add(&bar[XB_XSUB(b.x)], 1u);
        const unsigned gen = old / nloc;
        if (old + 1u == (gen + 1u) * nloc) {
            __builtin_amdgcn_fence(__ATOMIC_RELEASE, "agent");
            asm volatile("s_waitcnt vmcnt(0)" ::: "memory");
            const unsigned og = xb_add(&bar[XB_TOP], 1u);
            const unsigned tg = og / nx;
            if (og + 1u == (tg + 1u) * nx) xb_add(&bar[XB_TOPGEN], 1u);
            else XB_SPIN(xb_ld(&bar[XB_TOPGEN]) == tg, bar);
            __builtin_amdgcn_fence(__ATOMIC_ACQUIRE, "agent");
            xb_add(&bar[XB_XGEN(b.x)], 1u);
            asm volatile("s_waitcnt vmcnt(0)" ::: "memory");
        } else {
            XB_SPIN(xb_ld(&bar[XB_XGEN(b.x)]) == gen, bar);
            __builtin_amdgcn_fence(__ATOMIC_ACQUIRE, "agent");
            asm volatile("s_waitcnt vmcnt(0)" ::: "memory");
        }
    }
    __syncthreads();
}
constexpr int NWAVES = 8;
constexpr int D = 2048, SEQ = 8192, MP = 32768, MS = 128, MR = 32896, MT = 33024;
constexpr int DFF = 5632, NA = 5376, NBQ = 2048, NKV = 3072;
constexpr int CQ = 0, CK = 768, CV = 1536, CG = 3072, CQM = 4608, CLR = 5120;
constexpr float DN_ALPHA = 1.6817928305074292f, LN_EPS = 1e-5f, RMS_EPS = 1e-6f;
constexpr float GLA_QSCALE = 0.07216878364870323f, HD_SCALE = 0.08838834764831845f;
constexpr size_t MiB = 1u << 20;
constexpr size_t WS_CTL = 0, CTL_ZERO_BYTES = 1 * MiB;
constexpr size_t WS_WIN = 1 * MiB, WS_WO = 22 * MiB, WS_WFI = 30 * MiB, WS_WFO = 74 * MiB, WS_WMEM = 96 * MiB, WS_MEMX = 112 * MiB, WS_MEMK = 116 * MiB, WS_MEMV = 128 * MiB;
constexpr size_t WS_X = 140 * MiB, WS_Y = 269 * MiB, WS_R1 = 527 * MiB, WS_OCAT = 882 * MiB, WS_SBKS = 1011 * MiB, WS_SBVS = 1060 * MiB, WS_END = 1109 * MiB;
static_assert(WS_WIN + (size_t)NA * D * 2 <= WS_WO && WS_WFI + (size_t)2 * DFF * D * 2 <= WS_WFO && WS_WFO + (size_t)D * DFF * 2 <= WS_WMEM, "weights map");
static_assert(WS_X + (size_t)MT * D * 2 <= WS_Y && WS_Y + (size_t)MT * D * 4 <= WS_R1 && WS_R1 + (size_t)MT * DFF * 2 <= WS_OCAT && WS_OCAT + (size_t)MT * D * 2 <= WS_SBKS, "activation map");
static_assert(WS_SBKS + (size_t)8 * 2064 * 1536 * 2 <= WS_SBVS && WS_SBVS + (size_t)8 * 2064 * 1536 * 2 <= WS_END, "sb sample map");
constexpr size_t O_YP = 0, O_YS = 67108864, O_GSP = 67371008, O_GSS = 69730304, O_SKP = 74448896, O_SVP = 124780544, O_SKS = 175112192, O_SVS = 175308800, O_MKP = 175505408, O_MVP = 177602560, O_END = 179699712;
constexpr int CW_BAR = 4096;
constexpr int RING_OFF = 0, RING_BYTES = 131072, LDSCTL_OFF = RING_BYTES, MISC_OFF = LDSCTL_OFF + 320, LDS_BYTES = 147456;

struct Args { const float* in[22]; float* out_; unsigned char* ws_; int ph_lo, ph_hi; };
struct Frame {
    LAS unsigned char* lds; volatile LAS unsigned* MISC; gu32* ctl;
    int tid, lane, wave, G, gw, NGW;
};
__device__ __forceinline__ float bf2f(bf16 h) { return __builtin_bit_cast(float, (unsigned)h << 16); }
__device__ __forceinline__ float shx(float v, int lane, int m) { return __builtin_bit_cast(float, __builtin_amdgcn_ds_bpermute((lane ^ m) << 2, __builtin_bit_cast(int, v))); }
__device__ __forceinline__ float wave_sum(float v, int lane) {
#pragma unroll
    for (int o = 1; o < 64; o <<= 1) v += shx(v, lane, o);
    return v;
}
__device__ __forceinline__ float wave_max(float v, int lane) {
#pragma unroll
    for (int o = 1; o < 64; o <<= 1) v = fmaxf(v, shx(v, lane, o));
    return v;
}
__device__ __forceinline__ void cvt_row(const float* src, bf16* dst, int n, int lane) {
    for (int j = lane * 4; j < n; j += 256) {
        f32x4 v = src ? *(const f32x4*)(src + j) : (f32x4){0.f, 0.f, 0.f, 0.f};
        unsigned long long w = (unsigned long long)pk2(v.x, v.y) | ((unsigned long long)pk2(v.z, v.w) << 32);
        *(unsigned long long*)(dst + j) = w;
    }
}
template <int N>
__device__ __forceinline__ void cvt_rows2(const float* s0, const float* s1, bf16* d0, bf16* d1, int lane) {
    f32x4 v0[N / 256], v1[N / 256];
#pragma unroll
    for (int j = 0; j < N / 256; ++j) { v0[j] = s0 ? *(const f32x4*)(s0 + lane * 4 + 256 * j) : (f32x4){0.f, 0.f, 0.f, 0.f}; v1[j] = s1 ? *(const f32x4*)(s1 + lane * 4 + 256 * j) : (f32x4){0.f, 0.f, 0.f, 0.f}; }
#pragma unroll
    for (int j = 0; j < N / 256; ++j) {
        *(unsigned long long*)(d0 + lane * 4 + 256 * j) = (unsigned long long)pk2(v0[j].x, v0[j].y) | ((unsigned long long)pk2(v0[j].z, v0[j].w) << 32);
        *(unsigned long long*)(d1 + lane * 4 + 256 * j) = (unsigned long long)pk2(v1[j].x, v1[j].y) | ((unsigned long long)pk2(v1[j].z, v1[j].w) << 32); }
}
__device__ __forceinline__ int fresh_lane() { int z = 0; asm volatile("" : "+s"(z)); return (int)__builtin_amdgcn_mbcnt_hi(~0u, __builtin_amdgcn_mbcnt_lo(~0u, (unsigned)z)); }
#define FRESH_TID() (wave_ * 64 + fresh_lane())
template <bool FINAL>
__device__ __forceinline__ void ln_two_rows(int lane, const bf16* y0, const bf16* y1, const float* gg, const float* bb, bf16* x0, bf16* x1, float* of0, float* of1) {
    v4u w[2][4];
#pragma unroll
    for (int j = 0; j < 4; ++j) { w[0][j] = ((const v4u*)y0)[lane + 64 * j]; w[1][j] = ((const v4u*)y1)[lane + 64 * j]; }
    float v[2][4][8]; float s[2] = {0.f, 0.f};
#pragma unroll
    for (int r = 0; r < 2; ++r)
#pragma unroll
        for (int j = 0; j < 4; ++j) { const v4u q = w[r][j]; v[r][j][0] = pg8::bflo(q.x); v[r][j][1] = pg8::bfhi(q.x); v[r][j][2] = pg8::bflo(q.y); v[r][j][3] = pg8::bfhi(q.y); v[r][j][4] = pg8::bflo(q.z); v[r][j][5] = pg8::bfhi(q.z); v[r][j][6] = pg8::bflo(q.w); v[r][j][7] = pg8::bfhi(q.w);
            s[r] += ((v[r][j][0] + v[r][j][1]) + (v[r][j][2] + v[r][j][3])) + ((v[r][j][4] + v[r][j][5]) + (v[r][j][6] + v[r][j][7])); }
    const float m0 = wave_sum(s[0], lane) * (1.f / D), m1 = wave_sum(s[1], lane) * (1.f / D); float q0 = 0.f, q1 = 0.f;
#pragma unroll
    for (int j = 0; j < 4; ++j)
#pragma unroll
        for (int i = 0; i < 8; ++i) { v[0][j][i] -= m0; q0 += v[0][j][i] * v[0][j][i]; v[1][j][i] -= m1; q1 += v[1][j][i] * v[1][j][i]; }
    const float rs[2] = {1.f / sqrtf(wave_sum(q0, lane) * (1.f / D) + LN_EPS), 1.f / sqrtf(wave_sum(q1, lane) * (1.f / D) + LN_EPS)};
#pragma unroll
    for (int j = 0; j < 4; ++j) { const int e0 = (lane + 64 * j) * 8; const f32x4 g0 = *(const f32x4*)(gg + e0), g1 = *(const f32x4*)(gg + e0 + 4), b0 = *(const f32x4*)(bb + e0), b1 = *(const f32x4*)(bb + e0 + 4);
#pragma unroll
        for (int r = 0; r < 2; ++r) { float o[8];
#pragma unroll
            for (int i = 0; i < 4; ++i) { o[i] = v[r][j][i] * rs[r] * g0[i] + b0[i]; o[4 + i] = v[r][j][4 + i] * rs[r] * g1[i] + b1[i]; }
            if (FINAL) { float* of = r ? of1 : of0; *(f32x4*)(of + e0) = (f32x4){o[0], o[1], o[2], o[3]}; *(f32x4*)(of + e0 + 4) = (f32x4){o[4], o[5], o[6], o[7]}; }
            else { v4u p; p.x = pk2(o[0], o[1]); p.y = pk2(o[2], o[3]); p.z = pk2(o[4], o[5]); p.w = pk2(o[6], o[7]); *(v4u*)((r ? x1 : x0) + e0) = p; } } }
}
struct MapId { __device__ __forceinline__ int operator()(int n) const { return n; } };
struct MapInA { __device__ __forceinline__ int operator()(int n) const { return n < 4608 ? n : (n < 5120 ? n + 16 : (n < 5136 ? n - 512 : -1)); } };
struct MapFfn { __device__ __forceinline__ int operator()(int n) const { const int t = n >> 8, r = n & 255; return r < 128 ? 128 * t + r : DFF + 128 * t + (r - 128); } };
template <class Map>
__device__ __forceinline__ void wt_convert(LAS unsigned char* ldsb, int wave, int gw, int NGW, int lane, const float* W, int K, int Nsrc, bf16* WT, int Ndst, Map map) {
    LAS float* scr = (LAS float*)(ldsb + RING_OFF + wave * 16384);
    const int nblk = Ndst / 64, nitems = (K / 64) * nblk, nq = lane & 15, kq = lane >> 4;
    for (int it = gw; it < nitems; it += NGW) {
        const int kb = it / nblk, nb = it % nblk, k0 = 64 * kb, n0 = 64 * nb;
        const int sc0 = map(n0 + 4 * nq), sc3 = map(n0 + 4 * nq + 3);
        const bool contig = sc0 >= 0 && sc3 == sc0 + 3;
        f32x4 v[16];
#pragma unroll
        for (int i = 0; i < 16; ++i) { const int kk = 4 * i + kq;
            if (contig) v[i] = *(const f32x4*)(W + (size_t)(k0 + kk) * Nsrc + sc0);
            else {
#pragma unroll
                for (int e = 0; e < 4; ++e) { const int sc = map(n0 + 4 * nq + e); v[i][e] = sc >= 0 ? W[(size_t)(k0 + kk) * Nsrc + sc] : 0.f; } } }
#pragma unroll
        for (int i = 0; i < 16; ++i) { const int kk = 4 * i + kq;
#pragma unroll
            for (int e = 0; e < 4; ++e) { const int n = 4 * nq + e; scr[n * 64 + (kk ^ n)] = v[i][e]; } }
        LDS_WAIT(); asm volatile("" ::: "memory");
        const int c = lane & 7;
#pragma unroll
        for (int j = 0; j < 8; ++j) { const int n = (lane >> 3) + 8 * j; const LAS float* s = scr + n * 64;
#define SWZ(i) s[(8 * c + (i)) ^ n]
            v4u o; o.x = pk2(SWZ(0), SWZ(1)); o.y = pk2(SWZ(2), SWZ(3)); o.z = pk2(SWZ(4), SWZ(5)); o.w = pk2(SWZ(6), SWZ(7));
#undef SWZ
            *(GAS v4u*)(WT + (size_t)(n0 + n) * K + k0 + 8 * c) = o; }
        LDS_WAIT(); asm volatile("" ::: "memory");
    }
}
__device__ __forceinline__ float softplus_f(float z) { return fmaxf(z, 0.f) + log1pf(__expf(-fabsf(z))); }

typedef short s16x4 __attribute__((ext_vector_type(4)));
typedef pg8::u32x2 u32x2;
typedef float f32x16 __attribute__((ext_vector_type(16)));
typedef __bf16 bf16x2_t __attribute__((ext_vector_type(2)));
typedef float f32x2_t __attribute__((ext_vector_type(2)));
__device__ __forceinline__ unsigned cvt2(float lo, float hi) { const f32x2_t v = {lo, hi}; const bf16x2_t b = __builtin_convertvector(v, bf16x2_t); return __builtin_bit_cast(unsigned, b); }
__device__ __forceinline__ bf16x8 pack8(const f32x4 a, const f32x4 b) { v4u p; p.x = cvt2(a[0], a[1]); p.y = cvt2(a[2], a[3]); p.z = cvt2(b[0], b[1]); p.w = cvt2(b[2], b[3]); return __builtin_bit_cast(bf16x8, p); }
__device__ __forceinline__ bf16x8 ld2x8(const bf16* p0, const bf16* p1) { const s16x4 a = *(const s16x4*)p0, b = *(const s16x4*)p1; return __builtin_shufflevector(a, b, 0, 1, 2, 3, 4, 5, 6, 7); }
__device__ __forceinline__ bf16x8 ld16(const bf16* p) { return *(const bf16x8*)p; }
#define MFMA16(a, b, c) __builtin_amdgcn_mfma_f32_16x16x32_bf16((a), (b), (c), 0, 0, 0)
#define MFMA32(a, b, c) __builtin_amdgcn_mfma_f32_32x32x16_bf16((a), (b), (c), 0, 0, 0)

constexpr int QIMG_LD = 200, KTIMG_LD = 68, PKG_Q = 0, PKG_KT = 25600, PKG_G = 51712, IMG_BYTES = 52480, PKG_K = 52480, PKG_VT = 77056, PKG_BYTES = 126208, N_PKG = 2048 + 32;
static_assert(64 * QIMG_LD * 2 == PKG_KT && PKG_KT + 192 * KTIMG_LD * 2 == PKG_G && PKG_G + 768 == IMG_BYTES && PKG_K + 24576 == PKG_VT && PKG_VT + 49152 == PKG_BYTES && IMG_BYTES % 16 == 0, "package map");

__device__ __forceinline__ float softplus_fast(float z) { return fmaxf(z, 0.f) + __logf(1.0f + __expf(-fabsf(z))); }
constexpr int GL_TOT = 0, GL_Q = 6144, GL_K = GL_Q + 64 * QIMG_LD * 2, GL_V = GL_K + 64 * QIMG_LD * 2, VL_LD = 68, GL_P = GL_V + 384 * VL_LD * 2, P_LD = 68, GL_END = GL_P + 64 * P_LD * 2;
static_assert(GL_END <= RING_BYTES && GL_Q % 16 == 0 && GL_K % 16 == 0 && GL_V % 8 == 0 && GL_P % 8 == 0, "gla_prep_intra LDS map");
__device__ __forceinline__ void gla_prep_intra(int bid, int G, int tid, int wave, LAS unsigned char* lds, int l, const bf16* PROJ, const float* w_gate_lr, const float* b_gate, unsigned char* PKG, float* OINT) {
    const int lane = tid & 63, fr = lane & 15, fq = lane >> 4;
    const float* w2 = w_gate_lr + (size_t)l * 16 * 768; const float* bg = b_gate + (size_t)l * 768;
    LAS float* tot = (LAS float*)(lds + GL_TOT);
    LAS bf16* QL = (LAS bf16*)(lds + GL_Q); LAS bf16* KL = (LAS bf16*)(lds + GL_K); LAS bf16* VL = (LAS bf16*)(lds + GL_V); LAS bf16* P = (LAS bf16*)(lds + GL_P);
    float w2c[3][16], bgc[3]; int cur_h = -1;
    for (int j = 0;; ++j) {
        int item;
        if (G == 256) { if (j < 8) item = ((((j >> 1) << 2) | (bid & 3)) << 7) | ((bid >> 2) + 64 * (j & 1)); else if (j == 8 && bid < 32) item = 2048 + bid; else break; }
        else { item = bid + j * G; if (item >= N_PKG) break; }
        int h, row0, T;
        if (item < 2048) { const int bh = item >> 7, ch = item & 127; h = bh & 3; row0 = (bh >> 2) * SEQ + ch * 64; T = 64; }
        else { const int i2 = item - 2048; h = i2 & 3; row0 = MP + (i2 >> 2) * 16; T = 16; }
        unsigned char* pk = PKG + (size_t)item * PKG_BYTES;
        bf16* Qt = (bf16*)(pk + PKG_Q); bf16* KT = (bf16*)(pk + PKG_KT); bf16* VT = (bf16*)(pk + PKG_VT); float* Gp = (float*)(pk + PKG_G);
        if (h != cur_h) { cur_h = h;
#pragma unroll
            for (int c = 0; c < 3; ++c) { const int d = h * 192 + lane + 64 * c; bgc[c] = bg[d];
#pragma unroll
                for (int r = 0; r < 16; ++r) w2c[c][r] = w2[r * 768 + d]; } }
        v4u l0[8], l1[8];
#pragma unroll
        for (int tt = 0; tt < 8; ++tt) { const int t = 8 * wave + tt; const bf16* prow = PROJ + (size_t)(row0 + (t < T ? t : T - 1)) * NA;
            l0[tt] = *(const v4u*)(prow + CLR); l1[tt] = *(const v4u*)(prow + CLR + 8); }
        float lc[8][3]; float run[3] = {0.f, 0.f, 0.f};
#pragma unroll
        for (int tt = 0; tt < 8; ++tt) { const bool ok = 8 * wave + tt < T;
            float lr[16]; lr[0] = pg8::bflo(l0[tt].x); lr[1] = pg8::bfhi(l0[tt].x); lr[2] = pg8::bflo(l0[tt].y); lr[3] = pg8::bfhi(l0[tt].y); lr[4] = pg8::bflo(l0[tt].z); lr[5] = pg8::bfhi(l0[tt].z); lr[6] = pg8::bflo(l0[tt].w); lr[7] = pg8::bfhi(l0[tt].w);
            lr[8] = pg8::bflo(l1[tt].x); lr[9] = pg8::bfhi(l1[tt].x); lr[10] = pg8::bflo(l1[tt].y); lr[11] = pg8::bfhi(l1[tt].y); lr[12] = pg8::bflo(l1[tt].z); lr[13] = pg8::bfhi(l1[tt].z); lr[14] = pg8::bflo(l1[tt].w); lr[15] = pg8::bfhi(l1[tt].w);
#pragma unroll
            for (int c = 0; c < 3; ++c) { float xg = bgc[c];
#pragma unroll
                for (int r = 0; r < 16; ++r) xg += lr[r] * w2c[c][r];
                run[c] += ok ? -softplus_fast(-xg) * (1.0f / 16.0f) : 0.f; lc[tt][c] = run[c]; } }
#pragma unroll
        for (int c = 0; c < 3; ++c) tot[wave * 192 + lane + 64 * c] = run[c];
        unsigned qv[8][3], kv[8][3];
#pragma unroll
        for (int tt = 0; tt < 8; ++tt) { const int t = 8 * wave + tt; const bf16* prow = PROJ + (size_t)(row0 + (t < T ? t : T - 1)) * NA + h * 192 + lane;
#pragma unroll
            for (int c = 0; c < 3; ++c) { qv[tt][c] = prow[CQ + 64 * c]; kv[tt][c] = prow[CK + 64 * c]; } }
        __syncthreads();
        float pre[3], all[3];
#pragma unroll
        for (int c = 0; c < 3; ++c) { pre[c] = 0.f; all[c] = 0.f;
#pragma unroll
            for (int w = 0; w < 8; ++w) { const float tv = tot[w * 192 + lane + 64 * c]; all[c] += tv; if (w < wave) pre[c] += tv; } }
        unsigned ktw[3][4];
#pragma unroll
        for (int tt = 0; tt < 8; ++tt) { const int t = 8 * wave + tt; const bool ok = t < T;
#pragma unroll
            for (int c = 0; c < 3; ++c) { const int dl = lane + 64 * c; const float bc = pre[c] + lc[tt][c]; const float eq = __expf(bc), ek = __expf(-bc);
                const unsigned qb = ok ? f2bf(bf2f((bf16)qv[tt][c]) * GLA_QSCALE * eq) : 0u, kb = ok ? f2bf(bf2f((bf16)kv[tt][c]) * ek) : 0u;
                Qt[t * QIMG_LD + dl] = (bf16)qb; QL[t * QIMG_LD + dl] = (bf16)qb; KL[t * QIMG_LD + dl] = (bf16)kb;
                if (tt & 1) ktw[c][tt >> 1] |= kb << 16; else ktw[c][tt >> 1] = kb; } }
#pragma unroll
        for (int c = 0; c < 3; ++c) { bf16* kp = KT + (size_t)(lane + 64 * c) * KTIMG_LD + 8 * wave; u32x2 o0, o1; o0.x = ktw[c][0]; o0.y = ktw[c][1]; o1.x = ktw[c][2]; o1.y = ktw[c][3]; *(u32x2*)kp = o0; *(u32x2*)(kp + 4) = o1; }
        if (wave == 0) {
#pragma unroll
            for (int c = 0; c < 3; ++c) Gp[lane + 64 * c] = __expf(all[c]); }
        unsigned vv[6][8];
#pragma unroll
        for (int tt = 0; tt < 8; ++tt) { const int t = 8 * wave + tt; const bf16* prow = PROJ + (size_t)(row0 + (t < T ? t : T - 1)) * NA + CV + h * 384 + lane;
#pragma unroll
            for (int c2 = 0; c2 < 6; ++c2) vv[c2][tt] = prow[64 * c2]; }
#pragma unroll
        for (int c2 = 0; c2 < 6; ++c2) { const bool ok0 = 8 * wave < T;
            u32x2 o0, o1; o0.x = ok0 ? vv[c2][0] | (vv[c2][1] << 16) : 0u; o0.y = ok0 ? vv[c2][2] | (vv[c2][3] << 16) : 0u; o1.x = ok0 ? vv[c2][4] | (vv[c2][5] << 16) : 0u; o1.y = ok0 ? vv[c2][6] | (vv[c2][7] << 16) : 0u;
            v4u o; o.x = o0.x; o.y = o0.y; o.z = o1.x; o.w = o1.y; *(v4u*)(VT + (size_t)(lane + 64 * c2) * 64 + 8 * wave) = o;
            LAS bf16* vl = VL + (lane + 64 * c2) * VL_LD + 8 * wave; *(LAS u32x2*)vl = o0; *(LAS u32x2*)(vl + 4) = o1; }
        __syncthreads();
        const int nvalid = T;
        bf16x8 va[3], vb[3];
#pragma unroll
        for (int k = 0; k < 3; ++k) { const LAS bf16* vr = VL + (16 * (3 * wave + k) + fr) * VL_LD + 4 * fq;
            const s16x4 x0 = *(const LAS s16x4*)vr, x1 = *(const LAS s16x4*)(vr + 16), x2 = *(const LAS s16x4*)(vr + 32), x3 = *(const LAS s16x4*)(vr + 48);
            va[k] = __builtin_shufflevector(x0, x1, 0, 1, 2, 3, 4, 5, 6, 7); vb[k] = __builtin_shufflevector(x2, x3, 0, 1, 2, 3, 4, 5, 6, 7); }
#pragma unroll
        for (int rep = 0; rep < 2; ++rep) {
            const int tl = wave + 8 * rep;
            if (tl < 10) {
                const int it = tl < 1 ? 0 : (tl < 3 ? 1 : (tl < 6 ? 2 : 3)), jt = tl - (it * (it + 1)) / 2;
                f32x4 at = {0.f, 0.f, 0.f, 0.f};
                const LAS bf16* qr = QL + (16 * it + fr) * QIMG_LD + 8 * fq; const LAS bf16* kr = KL + (16 * jt + fr) * QIMG_LD + 8 * fq;
#pragma unroll
                for (int s = 0; s < 6; ++s) at = MFMA16(*(const LAS bf16x8*)(kr + 32 * s), *(const LAS bf16x8*)(qr + 32 * s), at);
                if (it == jt) {
#pragma unroll
                    for (int jj = 0; jj < 4; ++jj) if (4 * fq + jj > fr) at[jj] = 0.f; }
                u32x2 w; w.x = cvt2(at[0], at[1]); w.y = cvt2(at[2], at[3]);
                *(LAS u32x2*)(P + (16 * it + fr) * P_LD + 16 * jt + 4 * fq) = w;
            } else if (tl == 10 || tl == 11) {
                const int it = tl == 10 ? 0 : 2, jt = tl == 10 ? 1 : 3; unsigned zz = 0u; asm volatile("" : "+v"(zz)); u32x2 z; z.x = zz; z.y = zz;
                *(LAS u32x2*)(P + (16 * it + fr) * P_LD + 16 * jt + 4 * fq) = z;
            }
        }
        __syncthreads();
#pragma unroll
        for (int it = 0; it < 4; ++it) {
            if (16 * it >= nvalid) break;
            const LAS bf16* pr = P + (16 * it + fr) * P_LD + 4 * fq;
            const s16x4 a0 = *(const LAS s16x4*)pr, a1 = *(const LAS s16x4*)(pr + 16);
            const bf16x8 pf0 = __builtin_shufflevector(a0, a1, 0, 1, 2, 3, 4, 5, 6, 7); bf16x8 pf1 = pf0;
            if (it >= 2) { const s16x4 b0 = *(const LAS s16x4*)(pr + 32), b1 = *(const LAS s16x4*)(pr + 48); pf1 = __builtin_shufflevector(b0, b1, 0, 1, 2, 3, 4, 5, 6, 7); }
#pragma unroll
            for (int k = 0; k < 3; ++k) { f32x4 o = {0.f, 0.f, 0.f, 0.f};
                o = MFMA16(va[k], pf0, o); if (it >= 2) o = MFMA16(vb[k], pf1, o);
                *(f32x4*)(OINT + (size_t)(row0 + 16 * it + fr) * 1536 + h * 384 + 16 * (3 * wave + k) + 4 * fq) = o; }
        }
        __syncthreads();
    }
}

template <int PASS>
__device__ __forceinline__ void gla_chain(int wc, int tid, int wave, LAS unsigned char* lds, int l, const unsigned char* PKG, const float* state_gla, float* OINT, float* out, float* SLOC, float* GSEG, bool dry = false) {
    const int lane = tid & 63, fr = lane & 15, fq = lane >> 4;
    int h, vb, bh, seg, item0, nsteps, row0, nvalid; const float* s0 = nullptr; float* sout = nullptr;
    if (PASS == 1) { bh = wc / 9; const int rem = wc % 9; vb = rem / 3; seg = rem % 3; h = bh & 3; item0 = bh * 128 + 32 * seg; nsteps = 32; row0 = 0; nvalid = 64; }
    else if (wc < 192) { bh = wc / 12; const int rem = wc % 12; vb = rem >> 2; seg = rem & 3; h = bh & 3; item0 = bh * 128 + 32 * seg; nsteps = 32; row0 = (bh >> 2) * SEQ + 2048 * seg; nvalid = 64;
        if (seg == 3) sout = out + O_GSP + (size_t)(l * 16 + bh) * 192 * 384; }
    else { const int c2 = wc - 192; bh = c2 / 3; vb = c2 % 3; seg = 0; h = bh & 3; item0 = 2048 + bh; nsteps = 1; row0 = MP + (bh >> 2) * 16; nvalid = 16; s0 = state_gla + (size_t)(l * 32 + bh) * 192 * 384; sout = out + O_GSS + (size_t)(l * 32 + bh) * 192 * 384; }
    const int v0 = vb * 128 + wave * 16;
#define GLA_WALK(p, step) do { (p) += (step); asm volatile("" : "+v"(p)); } while (0)
    f32x4 S[12];
    if (s0) { const float* p = s0 + (size_t)(4 * fq) * 384 + v0 + fr;
#pragma unroll
        for (int t = 0; t < 12; ++t) {
#pragma unroll
            for (int jj = 0; jj < 4; ++jj) { S[t][jj] = *p; GLA_WALK(p, 384); }
            GLA_WALK(p, 12 * 384); } }
    else {
#pragma unroll
        for (int t = 0; t < 12; ++t) S[t] = (f32x4){0.f, 0.f, 0.f, 0.f}; }
    if (PASS == 2 && wc < 192) {
        for (int j = 0; j < seg; ++j) { const float* gs = GSEG + (size_t)(bh * 3 + j) * 192 + 4 * fq; const float* p = SLOC + (size_t)((bh * 3 + vb) * 3 + j) * 192 * 128 + (size_t)(4 * fq) * 128 + wave * 16 + fr;
#pragma unroll
            for (int t = 0; t < 12; ++t) { const f32x4 g4 = *(const f32x4*)(gs + 16 * t);
#pragma unroll
                for (int jj = 0; jj < 4; ++jj) { S[t][jj] = g4[jj] * S[t][jj] + *p; GLA_WALK(p, 128); }
                GLA_WALK(p, 12 * 128); } }
    }
    f32x4 GP[PASS == 1 ? 12 : 1];
    if (PASS == 1) {
#pragma unroll
        for (int t = 0; t < 12; ++t) GP[t] = (f32x4){1.f, 1.f, 1.f, 1.f}; }
    constexpr int CH0 = PASS == 1 ? PKG_KT / 16 : 0, NCH = IMG_BYTES / 16, NLD = PASS == 1 ? 4 : 7;
    v4u pre[NLD]; bf16x8 vt[2], vtn[2]; f32x4 oin[4];
    { const unsigned char* pk = PKG + (size_t)item0 * PKG_BYTES;
      if (PASS == 2) {
#pragma unroll
        for (int it = 0; it < 4; ++it) { const int tl = 16 * it + fr; oin[it] = tl < nvalid ? *(const f32x4*)(OINT + (size_t)(row0 + tl) * 1536 + h * 384 + v0 + 4 * fq) : (f32x4){0.f, 0.f, 0.f, 0.f}; } }
#pragma unroll
      for (int k = 0; k < NLD; ++k) { const int ch = CH0 + tid + 512 * k; if (ch < NCH) pre[k] = *(const v4u*)(pk + (size_t)ch * 16); }
      const bf16* VT = (const bf16*)(pk + PKG_VT) + (size_t)(v0 + fr) * 64 + 4 * fq; vt[0] = ld2x8(VT, VT + 16); vt[1] = ld2x8(VT + 32, VT + 48);
#pragma unroll
      for (int k = 0; k < NLD; ++k) { const int ch = CH0 + tid + 512 * k; if (ch < NCH) *(LAS v4u*)(lds + (size_t)ch * 16) = pre[k]; }
      vtn[0] = vt[0]; vtn[1] = vt[1]; }
    __syncthreads();
    for (int n = 0; n < nsteps; ++n) {
        const LAS unsigned char* img = lds + (n & 1) * IMG_BYTES;
        const bool more = n + 1 < nsteps;
        if (more) { const unsigned char* pk = PKG + (size_t)(item0 + n + 1) * PKG_BYTES;
#pragma unroll
            for (int k = 0; k < NLD; ++k) { const int ch = CH0 + tid + 512 * k; if (ch < NCH) pre[k] = *(const v4u*)(pk + (size_t)ch * 16); }
            const bf16* VT = (const bf16*)(pk + PKG_VT) + (size_t)(v0 + fr) * 64 + 4 * fq; vtn[0] = ld2x8(VT, VT + 16); vtn[1] = ld2x8(VT + 32, VT + 48); }
        if (PASS == 2) {
            bf16x8 Sb[6];
#pragma unroll
            for (int s = 0; s < 6; ++s) Sb[s] = pack8(S[2 * s], S[2 * s + 1]);
#pragma unroll
            for (int it = 0; it < 4; ++it) {
                const LAS bf16* qr = (const LAS bf16*)(img + PKG_Q) + (16 * it + fr) * QIMG_LD + 4 * fq;
                f32x4 o = oin[it];
#pragma unroll
                for (int s = 0; s < 6; ++s) { const s16x4 a = *(const LAS s16x4*)(qr + 32 * s), b = *(const LAS s16x4*)(qr + 32 * s + 16);
                    o = MFMA16(Sb[s], __builtin_shufflevector(a, b, 0, 1, 2, 3, 4, 5, 6, 7), o); }
                const int tl = 16 * it + fr;
                if (tl < nvalid && !dry) *(f32x4*)(OINT + (size_t)(row0 + 64 * n + tl) * 1536 + h * 384 + v0 + 4 * fq) = o;
                __builtin_amdgcn_sched_barrier(0);
            }
            if (more) {
#pragma unroll
                for (int it = 0; it < 4; ++it) oin[it] = *(const f32x4*)(OINT + (size_t)(row0 + 64 * (n + 1) + 16 * it + fr) * 1536 + h * 384 + v0 + 4 * fq); }
        }
#pragma unroll
        for (int t = 0; t < 12; ++t) { const LAS bf16* kr = (const LAS bf16*)(img + PKG_KT) + (16 * t + fr) * KTIMG_LD + 4 * fq;
#pragma unroll
            for (int s2 = 0; s2 < 2; ++s2) { const s16x4 a = *(const LAS s16x4*)(kr + 32 * s2), b = *(const LAS s16x4*)(kr + 32 * s2 + 16);
                S[t] = MFMA16(__builtin_shufflevector(a, b, 0, 1, 2, 3, 4, 5, 6, 7), vt[s2], S[t]); }
            const f32x4 g4 = *(const LAS f32x4*)(img + PKG_G + (16 * t + 4 * fq) * 4);
            S[t] = S[t] * g4; if (PASS == 1) GP[t] = GP[t] * g4; if ((t & 3) == 3) __builtin_amdgcn_sched_barrier(0); }
        if (more) { LAS unsigned char* nimg = lds + ((n + 1) & 1) * IMG_BYTES;
#pragma unroll
            for (int k = 0; k < NLD; ++k) { const int ch = CH0 + tid + 512 * k; if (ch < NCH) *(LAS v4u*)(nimg + (size_t)ch * 16) = pre[k]; }
            vt[0] = vtn[0]; vt[1] = vtn[1]; }
        asm volatile("s_waitcnt lgkmcnt(0)" ::: "memory"); __builtin_amdgcn_s_barrier(); asm volatile("" ::: "memory");
    }
    if (PASS == 1) {
        float* p = SLOC + (size_t)((bh * 3 + vb) * 3 + seg) * 192 * 128 + (size_t)(4 * fq) * 128 + wave * 16 + fr;
#pragma unroll
        for (int t = 0; t < 12; ++t) {
#pragma unroll
            for (int jj = 0; jj < 4; ++jj) { *p = S[t][jj]; GLA_WALK(p, 128); }
            GLA_WALK(p, 12 * 128); }
        if (vb == 0 && wave == 0 && fr == 0) { float* gs = GSEG + (size_t)(bh * 3 + seg) * 192;
#pragma unroll
            for (int t = 0; t < 12; ++t) *(f32x4*)(gs + 16 * t + 4 * fq) = GP[t]; }
    } else if (sout) {
        float* p = sout + (size_t)(4 * fq) * 384 + v0 + fr;
#pragma unroll
        for (int t = 0; t < 12; ++t) {
#pragma unroll
            for (int jj = 0; jj < 4; ++jj) { *p = S[t][jj]; GLA_WALK(p, 384); }
            GLA_WALK(p, 12 * 384); }
    }
#undef GLA_WALK
}

__device__ __forceinline__ void mem_attn(int item, int lane, int l, const bf16* PROJ, int ldp, int cqm, const bf16* MEMK, const bf16* MEMVT, bf16* OCAT) {
    const int fr = lane & 15, fq = lane >> 4, tile = item >> 2, h = item & 3, r0 = tile * 16;
    const int bb = r0 < MP ? r0 / SEQ : 4 + ((r0 - MP) >> 4);
    const bf16* Kb = MEMK + (size_t)((l * 12 + bb) * 256) * 512 + h * 128; const bf16* Vt = MEMVT + (size_t)(((l * 12 + bb) * 4 + h) * 128) * 256;
    bf16x8 qf[4];
#pragma unroll
    for (int s = 0; s < 4; ++s) qf[s] = ld16(PROJ + (size_t)(r0 + fr) * ldp + cqm + h * 128 + 32 * s + 8 * fq);
    f32x4 st[16];
#pragma unroll
    for (int mt = 0; mt < 16; ++mt) { st[mt] = (f32x4){0.f, 0.f, 0.f, 0.f}; const bf16* kr = Kb + (size_t)(16 * mt + fr) * 512 + 8 * fq;
#pragma unroll
        for (int s = 0; s < 4; ++s) st[mt] = MFMA16(ld16(kr + 32 * s), qf[s], st[mt]); }
    float mx = -3.0e38f;
#pragma unroll
    for (int mt = 0; mt < 16; ++mt) mx = fmaxf(mx, fmaxf(fmaxf(st[mt][0], st[mt][1]), fmaxf(st[mt][2], st[mt][3])));
    mx = fmaxf(mx, shx(mx, lane, 16)); mx = fmaxf(mx, shx(mx, lane, 32));
    float sum = 0.f;
#pragma unroll
    for (int mt = 0; mt < 16; ++mt)
#pragma unroll
        for (int jj = 0; jj < 4; ++jj) { const float p = __expf((st[mt][jj] - mx) * HD_SCALE); st[mt][jj] = p; sum += p; }
    sum += shx(sum, lane, 16); sum += shx(sum, lane, 32);
    const float inv = 1.0f / sum;
    bf16x8 pf[8];
#pragma unroll
    for (int s = 0; s < 8; ++s) pf[s] = pack8(st[2 * s], st[2 * s + 1]);
#pragma unroll
    for (int dt = 0; dt < 8; ++dt) { f32x4 o = {0.f, 0.f, 0.f, 0.f}; const bf16* vr = Vt + (size_t)(16 * dt + fr) * 256 + 4 * fq;
#pragma unroll
        for (int s = 0; s < 8; ++s) o = MFMA16(ld2x8(vr + 32 * s, vr + 32 * s + 16), pf[s], o);
        u32x2 w; w.x = cvt2(o[0] * inv, o[1] * inv); w.y = cvt2(o[2] * inv, o[3] * inv);
        *(u32x2*)(OCAT + (size_t)(r0 + fr) * D + 1536 + h * 128 + 16 * dt + 4 * fq) = w; }
}

__device__ __forceinline__ void mem_attn_wg(int wi, int tid, int wave, LAS unsigned char* lds, int l, const bf16* PROJ, int ldp, int cqm, const bf16* MEMK, const bf16* MEMVT, bf16* OCAT) {
    const bool smp = wi >= 256; const int lane = tid & 63, fr = lane & 15, fq = lane >> 4, bh = smp ? (wi - 256) : (wi >> 4), sub = wi & 15, b = smp ? 4 + (bh >> 2) : (bh >> 2), h = bh & 3;
    const bf16* Kb = MEMK + (size_t)((l * 12 + b) * 256) * 512 + h * 128; const bf16* Vt = MEMVT + (size_t)(((l * 12 + b) * 4 + h) * 128) * 256;
#pragma unroll
    for (int k = 0; k < 8; ++k) { const int idx = tid + 512 * k, row = idx >> 4, c = idx & 15; *(LAS v4u*)(lds + row * 256 + ((c ^ (row & 15)) << 4)) = *(const v4u*)(Kb + (size_t)row * 512 + c * 8); }
#pragma unroll
    for (int k = 0; k < 8; ++k) { const int idx = tid + 512 * k, row = idx >> 5, c = idx & 31; *(LAS v4u*)(lds + 65536 + row * 512 + ((c ^ (2 * (row & 15))) << 4)) = *(const v4u*)(Vt + (size_t)row * 256 + c * 8); }
    __syncthreads();
    unsigned koff[4], voff[16];
#pragma unroll
    for (int s2 = 0; s2 < 4; ++s2) { koff[s2] = (unsigned)(fr * 256 + (((4 * s2 + fq) ^ fr) << 4)); asm volatile("" : "+v"(koff[s2])); }
#pragma unroll
    for (int s2 = 0; s2 < 8; ++s2) { const int p0 = 8 * s2 + fq, p1 = p0 + 4;
        voff[2 * s2] = (unsigned)(65536 + fr * 512 + ((((p0 >> 1) ^ (2 * fr)) << 4) | ((p0 & 1) << 3))); voff[2 * s2 + 1] = (unsigned)(65536 + fr * 512 + ((((p1 >> 1) ^ (2 * fr)) << 4) | ((p1 & 1) << 3)));
        asm volatile("" : "+v"(voff[2 * s2]), "+v"(voff[2 * s2 + 1])); }
    const int nblk = smp ? (wave == 0 ? 1 : 0) : 4;
#pragma unroll 1
    for (int blk = 0; blk < nblk; ++blk) {
        const int r0 = smp ? MP + (b - 4) * 16 : b * SEQ + sub * 512 + blk * 128 + wave * 16;
        bf16x8 qf[4];
#pragma unroll
        for (int s = 0; s < 4; ++s) qf[s] = ld16(PROJ + (size_t)(r0 + fr) * ldp + cqm + h * 128 + 32 * s + 8 * fq);
        f32x4 st[16];
#pragma unroll
        for (int mt = 0; mt < 16; ++mt) { st[mt] = (f32x4){0.f, 0.f, 0.f, 0.f};
#pragma unroll
            for (int s = 0; s < 4; ++s) st[mt] = MFMA16(*(const LAS bf16x8*)(lds + koff[s] + mt * 4096), qf[s], st[mt]);
            if ((mt & 3) == 3) __builtin_amdgcn_sched_barrier(0); }
        float mx = -3.0e38f;
#pragma unroll
        for (int mt = 0; mt < 16; ++mt) mx = fmaxf(mx, fmaxf(fmaxf(st[mt][0], st[mt][1]), fmaxf(st[mt][2], st[mt][3])));
        mx = fmaxf(mx, shx(mx, lane, 16)); mx = fmaxf(mx, shx(mx, lane, 32));
        float sum = 0.f;
#pragma unroll
        for (int mt = 0; mt < 16; ++mt)
#pragma unroll
            for (int jj = 0; jj < 4; ++jj) { const float p = __expf((st[mt][jj] - mx) * HD_SCALE); st[mt][jj] = p; sum += p; }
        sum += shx(sum, lane, 16); sum += shx(sum, lane, 32);
        const float inv = 1.0f / sum;
        bf16x8 pf[8];
#pragma unroll
        for (int s = 0; s < 8; ++s) pf[s] = pack8(st[2 * s], st[2 * s + 1]);
#pragma unroll
        for (int dt = 0; dt < 8; ++dt) { f32x4 o = {0.f, 0.f, 0.f, 0.f};
#pragma unroll
            for (int s = 0; s < 8; ++s) { const s16x4 a = *(const LAS s16x4*)(lds + voff[2 * s] + dt * 8192), bb = *(const LAS s16x4*)(lds + voff[2 * s + 1] + dt * 8192);
                o = MFMA16(__builtin_shufflevector(a, bb, 0, 1, 2, 3, 4, 5, 6, 7), pf[s], o); }
            u32x2 w; w.x = cvt2(o[0] * inv, o[1] * inv); w.y = cvt2(o[2] * inv, o[3] * inv);
            *(u32x2*)(OCAT + (size_t)(r0 + fr) * D + 1536 + h * 128 + 16 * dt + 4 * fq) = w;
            if (dt & 1) __builtin_amdgcn_sched_barrier(0); }
    }
    __syncthreads();
}

template <int MODE = 0>
__device__ __forceinline__ void sb_attn(int lane, LAS unsigned char* wlds, const bf16* Kp, int ldk, const bf16* VTp, int ldvt, const bf16* Qp, int ldq, bf16* Op, int t0, int nq) {
    const int r = lane & 31, hh = lane >> 5;
    LAS bf16x8* qs = (LAS bf16x8*)wlds + lane;
#pragma unroll
    for (int ks = 0; ks < 8; ++ks) qs[64 * ks] = ld16(Qp + (size_t)r * ldq + 16 * ks + 8 * hh);
    f32x16 oacc[4];
#pragma unroll
    for (int dt = 0; dt < 4; ++dt)
#pragma unroll
        for (int i = 0; i < 16; ++i) oacc[dt][i] = 0.f;
    float carry = 1.f;
    bf16x8 kf[8];
    { const bf16* kr = Kp + (size_t)(t0 + r) * ldk + 8 * hh;
#pragma unroll
      for (int ks = 0; ks < 8; ++ks) kf[ks] = ld16(kr + 16 * ks); }
    for (int s0 = t0; s0 >= 0; s0 -= 32) {
        bf16x8 vf[8];
#pragma unroll
        for (int k2 = 0; k2 < 2; ++k2)
#pragma unroll
            for (int dt = 0; dt < 4; ++dt) vf[4 * k2 + dt] = MODE == 3 ? qs[64 * dt] : ld16(VTp + (size_t)(s0 >> 5) * 4096 + ((dt * 2 + k2) * 64 + lane) * 8);
        f32x16 st;
#pragma unroll
        for (int i = 0; i < 16; ++i) st[i] = 0.f;
#pragma unroll
        for (int ks = 0; ks < 8; ++ks) st = MFMA32(kf[ks], qs[64 * ks], st);
        { const int sn = s0 >= 32 ? s0 - 32 : 0; const bf16* kr = Kp + (size_t)(sn + r) * ldk + 8 * hh;
#pragma unroll
          for (int ks = 0; ks < 8; ++ks) kf[ks] = ld16(kr + 16 * ks); }
        const bool diag = (s0 == t0);
        float lb[16], om[16];
#pragma unroll
        for (int i = 0; i < 16; ++i) { const float z = st[i] * HD_SCALE, e = __expf(-fabsf(z)), rr = __builtin_amdgcn_rcpf(1.0f + e), er = e * rr;
            lb[i] = z >= 0.f ? rr : er; om[i] = z >= 0.f ? er : rr;
            if (diag && !(((i & 3) + 8 * (i >> 2) + 4 * hh) < r)) { lb[i] = 0.f; om[i] = 1.f; } }
        float g[4], pgv[4];
#pragma unroll
        for (int m = 0; m < 4; ++m) { g[m] = (om[4 * m] * om[4 * m + 1]) * (om[4 * m + 2] * om[4 * m + 3]); pgv[m] = shx(g[m], lane, 32); }
        float R[4]; R[3] = 1.f; R[2] = g[3] * pgv[3]; R[1] = R[2] * (g[2] * pgv[2]); R[0] = R[1] * (g[1] * pgv[1]);
        const float total = R[0] * (g[0] * pgv[0]);
#pragma unroll
        for (int m = 0; m < 4; ++m) { const float suf = carry * R[m] * (hh == 0 ? pgv[m] : 1.f);
            const float t3 = suf, t2 = t3 * om[4 * m + 3], t1 = t2 * om[4 * m + 2], t0_ = t1 * om[4 * m + 1];
            lb[4 * m + 3] *= t3; lb[4 * m + 2] *= t2; lb[4 * m + 1] *= t1; lb[4 * m] *= t0_; }
        carry *= total;
#pragma unroll
        for (int k2 = 0; k2 < 2; ++k2) {
            v4u p; p.x = cvt2(lb[8 * k2], lb[8 * k2 + 1]); p.y = cvt2(lb[8 * k2 + 2], lb[8 * k2 + 3]); p.z = cvt2(lb[8 * k2 + 4], lb[8 * k2 + 5]); p.w = cvt2(lb[8 * k2 + 6], lb[8 * k2 + 7]);
            const bf16x8 wf = __builtin_bit_cast(bf16x8, p);
#pragma unroll
            for (int dt = 0; dt < 4; ++dt) { if (MODE != 3) oacc[dt] = MFMA32(vf[4 * k2 + dt], wf, oacc[dt]); else oacc[dt][0] += __builtin_bit_cast(float, (int)wf[0]) + __builtin_bit_cast(float, (int)vf[4 * k2 + dt][0]); }
        }
        if (MODE == 2 || __all((r >= nq) || (carry < 1.0e-37f))) break;
    }
    if (MODE != 0) { float sdry = 0.f;
#pragma unroll
        for (int dt = 0; dt < 4; ++dt)
#pragma unroll
            for (int i = 0; i < 16; ++i) sdry += oacc[dt][i];
        if (sdry == 1.2345e33f) Op[0] = 0; }
    else if (r < nq) {
#pragma unroll
        for (int dt = 0; dt < 4; ++dt)
#pragma unroll
            for (int g4 = 0; g4 < 4; ++g4) { u32x2 wv; wv.x = cvt2(oacc[dt][4 * g4], oacc[dt][4 * g4 + 1]); wv.y = cvt2(oacc[dt][4 * g4 + 2], oacc[dt][4 * g4 + 3]);
                *(u32x2*)(Op + (size_t)r * D + 32 * dt + 8 * g4 + 4 * hh) = wv; }
    }
    asm volatile("s_waitcnt lgkmcnt(0)" ::: "memory");
}

struct SkBf16 { bf16* O; int ldc;
    __device__ __forceinline__ int brow(int unit, int nb) const { return 32 * unit + 16 * nb; }
    __device__ __forceinline__ void store(int unit, const f32x4 a0, const f32x4 a1, int m, int fq) const { bf16* p = O + (size_t)(MP + m) * ldc + 32 * unit + 4 * fq;
        u32x2 w; w.x = cvt2(a0[0], a0[1]); w.y = cvt2(a0[2], a0[3]); *(u32x2*)p = w; w.x = cvt2(a1[0], a1[1]); w.y = cvt2(a1[2], a1[3]); *(u32x2*)(p + 16) = w; } };
struct SkRes { bf16* Yp; const bf16* Xp; float alpha;
    __device__ __forceinline__ int brow(int unit, int nb) const { return 32 * unit + 16 * nb; }
    __device__ __forceinline__ void one(size_t o, const f32x4 a) const { const u32x2 xv = *(const u32x2*)(Xp + o);
        f32x4 r; r[0] = alpha * pg8::bflo(xv.x); r[1] = alpha * pg8::bfhi(xv.x); r[2] = alpha * pg8::bflo(xv.y); r[3] = alpha * pg8::bfhi(xv.y); r = r + a; u32x2 w; w.x = cvt2(r[0], r[1]); w.y = cvt2(r[2], r[3]); *(u32x2*)(Yp + o) = w; }
    __device__ __forceinline__ void store(int unit, const f32x4 a0, const f32x4 a1, int m, int fq) const { const size_t o = (size_t)(MP + m) * D + 32 * unit + 4 * fq; one(o, a0); one(o + 16, a1); } };
struct SkKV { float *oks, *ovs; bf16 *ksb, *vsb;
    __device__ __forceinline__ int brow(int unit, int nb) const { return 32 * unit + 16 * nb; }
    __device__ __forceinline__ void one(int col, const f32x4 a, int m) const { const bool isv = col >= 1536; const int c = col - (isv ? 1536 : 0), b = m >> 4, t = m & 15;
        *(f32x4*)((isv ? ovs : oks) + (size_t)m * 1536 + c) = a; const unsigned w0 = cvt2(a[0], a[1]), w1 = cvt2(a[2], a[3]);
        const int hh_ = c >> 7, dd = c & 127;
        if (!isv) { u32x2 w; w.x = w0; w.y = w1; *(u32x2*)(ksb + ((size_t)(b * 12 + hh_) * 2080 + 2048 + t) * 128 + dd) = w; }
        else { bf16* vt = vsb + ((size_t)(b * 12 + hh_) * 65 + 64) * 4096 + pg8::vtf_d(dd) + pg8::vtf_k(t); vt[0] = (bf16)w0; vt[8] = (bf16)(w0 >> 16); vt[16] = (bf16)w1; vt[24] = (bf16)(w1 >> 16); } }
    __device__ __forceinline__ void store(int unit, const f32x4 a0, const f32x4 a1, int m, int fq) const { one(32 * unit + 4 * fq, a0, m); one(32 * unit + 16 + 4 * fq, a1, m); } };
struct SkSwiGLU { bf16* Hb;
    __device__ __forceinline__ int brow(int unit, int nb) const { const int c0 = 16 * unit; return (c0 >> 7) * 256 + (c0 & 127) + 128 * nb; }
    __device__ __forceinline__ void store(int unit, const f32x4 g, const f32x4 u, int m, int fq) const { float hv[4];
#pragma unroll
        for (int j = 0; j < 4; ++j) hv[j] = g[j] * __builtin_amdgcn_rcpf(1.0f + __expf(-g[j])) * u[j];
        u32x2 w; w.x = cvt2(hv[0], hv[1]); w.y = cvt2(hv[2], hv[3]); *(u32x2*)(Hb + (size_t)(MP + m) * DFF + 16 * unit + 4 * fq) = w; } };
template <class Epi>
__device__ __forceinline__ void skinny_gemm(int bid, int G, int tid, int wave, LAS unsigned char* lds, const bf16* A, int lda, const bf16* Bt, int K, int nunits, const Epi& E) {
    const int lane = tid & 63, fr = lane & 15, fq = lane >> 4, kw = K >> 3, nst = kw >> 5;
    const bf16* ap = A + (size_t)fr * lda + wave * kw + 8 * fq;
    LAS f32x4* red = (LAS f32x4*)lds;
    for (int unit = bid; unit < nunits; unit += G) {
        const bf16* bp0 = Bt + (size_t)(E.brow(unit, 0) + fr) * K + wave * kw + 8 * fq; const bf16* bp1 = Bt + (size_t)(E.brow(unit, 1) + fr) * K + wave * kw + 8 * fq;
        f32x4 acc[2][8];
#pragma unroll
        for (int nb = 0; nb < 2; ++nb)
#pragma unroll
            for (int rt = 0; rt < 8; ++rt) acc[nb][rt] = (f32x4){0.f, 0.f, 0.f, 0.f};
        bf16x8 a0[8], a1[8], a2[8], b0[2], b1[2], b2[2];
#define SK_LOAD(af, bfr, st) do { _Pragma("unroll") for (int rt = 0; rt < 8; ++rt) af[rt] = ld16(ap + (size_t)(16 * rt) * lda + 32 * (st)); bfr[0] = ld16(bp0 + 32 * (st)); bfr[1] = ld16(bp1 + 32 * (st)); } while (0)
#define SK_MMA(af, bfr) do { _Pragma("unroll") for (int rt = 0; rt < 8; ++rt) { acc[0][rt] = MFMA16(bfr[0], af[rt], acc[0][rt]); acc[1][rt] = MFMA16(bfr[1], af[rt], acc[1][rt]); } } while (0)
        SK_LOAD(a0, b0, 0); SK_LOAD(a1, b1, 1);
#pragma unroll 1
        for (int st = 0; st < nst; st += 3) {
            if (st + 2 < nst) SK_LOAD(a2, b2, st + 2);
            __builtin_amdgcn_sched_barrier(0);
            SK_MMA(a0, b0);
            __builtin_amdgcn_sched_barrier(0);
            if (st + 3 < nst) SK_LOAD(a0, b0, st + 3);
            __builtin_amdgcn_sched_barrier(0);
            if (st + 1 < nst) SK_MMA(a1, b1);
            __builtin_amdgcn_sched_barrier(0);
            if (st + 4 < nst) SK_LOAD(a1, b1, st + 4);
            __builtin_amdgcn_sched_barrier(0);
            if (st + 2 < nst) SK_MMA(a2, b2);
            __builtin_amdgcn_sched_barrier(0);
        }
#undef SK_LOAD
#undef SK_MMA
#pragma unroll
        for (int nb = 0; nb < 2; ++nb)
#pragma unroll
            for (int rt = 0; rt < 8; ++rt) red[((wave * 2 + nb) * 8 + rt) * 64 + lane] = acc[nb][rt];
        __syncthreads();
        f32x4 s0 = {0.f, 0.f, 0.f, 0.f}, s1 = {0.f, 0.f, 0.f, 0.f};
#pragma unroll
        for (int ws = 0; ws < 8; ++ws) { s0 = s0 + red[((ws * 2 + 0) * 8 + wave) * 64 + lane]; s1 = s1 + red[((ws * 2 + 1) * 8 + wave) * 64 + lane]; }
        E.store(unit, s0, s1, 16 * wave + fr, fq);
        __syncthreads();
    }
}
#ifndef PH_MASK
#define PH_MASK 0xFFFF
#endif
__global__ void __launch_bounds__(NWAVES * 64, 2) mega(Args args) {
    extern __shared__ __attribute__((aligned(16))) unsigned char lds[];
    Frame F;
    F.lds = (LAS unsigned char*)lds; F.MISC = (volatile LAS unsigned*)(F.lds + MISC_OFF);
    F.tid = threadIdx.x; F.lane = F.tid & 63; F.wave = __builtin_amdgcn_readfirstlane(F.tid >> 6);
    F.G = gridDim.x; F.gw = blockIdx.x * NWAVES + F.wave; F.NGW = F.G * NWAVES;
    F.ctl = (gu32*)(args.ws_ + WS_CTL);
    for (int u = F.tid; u < (LDS_BYTES - LDSCTL_OFF) / 4; u += NWAVES * 64) ((LAS unsigned*)(F.lds + LDSCTL_OFF))[u] = 0u;
    __syncthreads();
    XcdBarrier bar = xcd_barrier_post((unsigned*)(F.ctl + CW_BAR), F.MISC + 8);
    const int lo = args.ph_lo, hi = args.ph_hi; int ph = 0;
#define KARGS ((const __attribute__((address_space(4))) Args*)__builtin_amdgcn_kernarg_segment_ptr())
#define ws (ka->ws_)
#define out (ka->out_)
#define x_prompt (ka->in[0])
#define x_sample (ka->in[1])
#define mem_prompt (ka->in[2])
#define state_gla (ka->in[3])
#define cache_sb_k (ka->in[4])
#define cache_sb_v (ka->in[5])
#define cache_mem_k (ka->in[6])
#define cache_mem_v (ka->in[7])
#define w_in_a (ka->in[8])
#define w_gate_lr (ka->in[9])
#define b_gate (ka->in[10])
#define gla_norm_g (ka->in[11])
#define w_in_b (ka->in[12])
#define w_kv_shared (ka->in[13])
#define w_mem_kv (ka->in[14])
#define w_o (ka->in[15])
#define ln1_g (ka->in[16])
#define ln1_b (ka->in[17])
#define ln2_g (ka->in[18])
#define ln2_b (ka->in[19])
#define w_ffn_in (ka->in[20])
#define w_ffn_out (ka->in[21])
#define WIN ((bf16*)(ws + WS_WIN))
#define WO ((bf16*)(ws + WS_WO))
#define WFI ((bf16*)(ws + WS_WFI))
#define WFO ((bf16*)(ws + WS_WFO))
#define WMEM ((bf16*)(ws + WS_WMEM))
#define MEMX ((bf16*)(ws + WS_MEMX))
#define MEMK ((bf16*)(ws + WS_MEMK))
#define MEMV ((bf16*)(ws + WS_MEMV))
#define X ((bf16*)(ws + WS_X))
#define Y ((float*)(ws + WS_Y))
#define YB ((bf16*)(ws + WS_Y))
#define PROJ ((bf16*)(ws + WS_R1))
#define HB ((bf16*)(ws + WS_R1))
#define OCAT ((bf16*)(ws + WS_OCAT))
#define SBKS ((bf16*)(ws + WS_SBKS))
#define SBVS ((bf16*)(ws + WS_SBVS))
#define OINT (out + O_YP)
#define KPB ((bf16*)(out + O_YP))
#define VPB (KPB + (size_t)MP * 1536)

#define PHASE_BEGIN(cond, cls) if (cond) { if (lo <= ph && ph < hi) { if (ph > lo) { xcd_barrier(bar); if (BAR_REP > 1) xcd_barrier(bar); } DIAG_STAMP(cls); for (int rep_ = 0; rep_ < (((cls) == REP_CLS) ? 2 : 1); ++rep_) { const __attribute__((address_space(4))) Args* ka = KARGS; asm volatile("" : "+s"(ka)); int z_ = 0, G_ = gridDim.x, bid_ = blockIdx.x, wave_ = F.wave; asm volatile("" : "+s"(z_), "+s"(G_), "+s"(bid_), "+s"(wave_)); const int lane = (int)__builtin_amdgcn_mbcnt_hi(~0u, __builtin_amdgcn_mbcnt_lo(~0u, (unsigned)z_)), tid = wave_ * 64 + lane, gw_ = bid_ * NWAVES + wave_, NGW_ = G_ * NWAVES;     (void)tid; (void)lane; (void)gw_; (void)NGW_;
#define PHASE_END } } ++ph; }
#ifndef REP_CLS
#define REP_CLS (-1)
#endif
#ifndef SK_REP
#define SK_REP 1
#endif
#ifndef MEM_REP
#define MEM_REP 1
#endif
#ifndef BAR_REP
#define BAR_REP 1
#endif
#ifndef STAG
#define STAG 0
#endif
#ifndef SB_REP
#define SB_REP 1
#endif
#if defined(DIAG_A)
#define DIAG_STAMP(cls) do { if (blockIdx.x == 0 && threadIdx.x == 0) { unsigned long long* dts = (unsigned long long*)(args.ws_ + 262144); dts[ph] = rt(); } } while (0)
#else
#define DIAG_STAMP(cls) do { } while (0)
#endif

#define CONVERT_WEIGHTS(LL) do { const int ll_ = (LL); \
            if (ll_ < 2) wt_convert(F.lds, wave_, gw_, NGW_, lane, w_in_a + (size_t)ll_ * D * 5136, D, 5136, WIN, NA, MapInA()); \
            else { wt_convert(F.lds, wave_, gw_, NGW_, lane, w_in_b + (size_t)(ll_ - 2) * D * NBQ, D, NBQ, WIN, NBQ, MapId()); if (ll_ == 2) wt_convert(F.lds, wave_, gw_, NGW_, lane, w_kv_shared, D, NKV, WIN + (size_t)NBQ * D, NKV, MapId()); } \
            wt_convert(F.lds, wave_, gw_, NGW_, lane, w_o + (size_t)ll_ * D * D, D, D, WO, D, MapId()); \
            wt_convert(F.lds, wave_, gw_, NGW_, lane, w_ffn_in + (size_t)ll_ * D * 2 * DFF, D, 2 * DFF, WFI, 2 * DFF, MapFfn()); \
            wt_convert(F.lds, wave_, gw_, NGW_, lane, w_ffn_out + (size_t)ll_ * DFF * D, DFF, D, WFO, D, MapId()); } while (0)
    PHASE_BEGIN(true, 0)
        for (int r = 2 * gw_; r < MT; r += 2 * NGW_) { const float* s0 = r < MP ? x_prompt + (size_t)r * D : (r < MR ? x_sample + (size_t)(r - MP) * D : nullptr);
            cvt_rows2<D>(s0, s0 ? s0 + D : nullptr, X + (size_t)r * D, X + (size_t)(r + 1) * D, lane); }
        for (int r = 2 * gw_; r < 1024; r += 2 * NGW_) cvt_rows2<D>(mem_prompt + (size_t)r * D, mem_prompt + (size_t)(r + 1) * D, MEMX + (size_t)r * D, MEMX + (size_t)(r + 1) * D, lane);
        for (int r = gw_; r < 4 * 8 * 256; r += NGW_) { const int l = r >> 11, b = (r >> 8) & 7, m = r & 255; const size_t dst = (size_t)((l * 12 + 4 + b) * 256 + m) * 512;
            cvt_row(cache_mem_k + (size_t)r * 512, MEMK + dst, 512, lane); }
        for (int it = gw_; it < 512; it += NGW_) { const int hdb = it & 3, mb = (it >> 2) & 3, b = (it >> 4) & 7, l = it >> 7, m = mb * 64 + lane;
            const float* src = cache_mem_v + (size_t)((l * 8 + b) * 256 + m) * 512 + hdb * 128; bf16* dst = MEMV + (size_t)((l * 12 + 4 + b) * 512 + hdb * 128) * 256 + m;
            for (int q4 = 0; q4 < 32; ++q4) { const f32x4 v = *(const f32x4*)(src + 4 * q4);
#pragma unroll
                for (int e = 0; e < 4; ++e) dst[(size_t)(4 * q4 + e) * 256] = (bf16)f2bf(v[e]); } }
        for (int r = gw_; r < 8 * 2048; r += NGW_) { const int b = r >> 11, s = r & 2047; const float* src = cache_sb_k + (size_t)r * 1536;
            f32x4 v[6];
#pragma unroll
            for (int q = 0; q < 6; ++q) v[q] = *(const f32x4*)(src + lane * 4 + 256 * q);
#pragma unroll
            for (int q = 0; q < 6; ++q) { const int j = lane * 4 + 256 * q;
                *(unsigned long long*)(SBKS + ((size_t)(b * 12 + (j >> 7)) * 2080 + s) * 128 + (j & 127)) = (unsigned long long)pk2(v[q].x, v[q].y) | ((unsigned long long)pk2(v[q].z, v[q].w) << 32); } }
        for (int it = gw_; it < 3072; it += NGW_) { const int cb = it % 12, sb_ = (it / 12) & 31, b = it / 384, s = sb_ * 64 + lane;
            const float* src = cache_sb_v + (size_t)(b * 2048 + s) * 1536 + cb * 128; bf16* dst = SBVS + ((size_t)(b * 12 + cb) * 65 + (s >> 5)) * 4096 + pg8::vtf_k(s & 31);
            for (int q8 = 0; q8 < 32; q8 += 8) { f32x4 v[8];
#pragma unroll
                for (int q = 0; q < 8; ++q) v[q] = *(const f32x4*)(src + 4 * (q8 + q));
#pragma unroll
                for (int q = 0; q < 8; ++q)
#pragma unroll
                    for (int e = 0; e < 4; ++e) dst[pg8::vtf_d(4 * (q8 + q) + e)] = (bf16)f2bf(v[q][e]); } }
        for (int l = 0; l < 4; ++l) wt_convert(F.lds, wave_, gw_, NGW_, lane, w_mem_kv + (size_t)l * D * 1024, D, 1024, WMEM + (size_t)l * 1024 * D, 1024, MapId());
        CONVERT_WEIGHTS(0);
    PHASE_END
    for (int l = 0; l < 4; ++l) {
        const bool LA = l < 2;
        const int ldp = LA ? NA : NBQ;
        PHASE_BEGIN(true, 2)
            if (!LA && (bid_ & 1)) { { SkBf16 E{PROJ, ldp}; skinny_gemm(bid_, G_, FRESH_TID(), wave_, F.lds + RING_OFF, X + (size_t)MP * D, D, WIN, D, ldp / 32, E); }
                if (l == 2) { SkKV E{out + O_SKS, out + O_SVS, SBKS, SBVS}; skinny_gemm(bid_, G_, FRESH_TID(), wave_, F.lds + RING_OFF, X + (size_t)MP * D, D, WIN + (size_t)NBQ * D, D, NKV / 32, E); } }
            { pg8::Gemm g{X, WIN, MP, ldp, D}; pg8::StaticOrder S; S.init(MP, ldp, G_, bid_); pg8::EpiBf16 E{PROJ, ldp};
              pg8::gemm_phase<pg8::EpiBf16, pg8::StaticOrder, true, true>(F.lds + RING_OFF, g, S, E, FRESH_TID()); }
            if (l == 0 && bid_ >= (G_ >> 1) && bid_ < (G_ >> 1) + 64) { pg8::Gemm g{MEMX, WMEM, 1024, 4096, D}; pg8::StaticOrder S; S.init(1024, 4096, 64, bid_ - (G_ >> 1));
              pg8::EpiMemKV E{out + O_MKP, out + O_MVP, MEMK, MEMV};
              pg8::gemm_phase<pg8::EpiMemKV, pg8::StaticOrder, true, true>(F.lds + RING_OFF, g, S, E, FRESH_TID()); }
            if (l == 2) { pg8::Gemm g{X, WIN + (size_t)NBQ * D, MP, NKV, D}; pg8::StaticOrder S; S.init(MP, NKV, G_, bid_);
              pg8::EpiKV E{out + O_SKP, out + O_SVP, out + O_SKS, out + O_SVS, KPB, VPB, SBKS, SBVS};
              pg8::gemm_phase<pg8::EpiKV, pg8::StaticOrder, true, true>(F.lds + RING_OFF, g, S, E, FRESH_TID()); }
            if (LA) { if (bid_ >= (G_ >> 1)) { SkBf16 E{PROJ, ldp}; skinny_gemm(bid_ - (G_ >> 1), G_ >> 1, FRESH_TID(), wave_, F.lds + RING_OFF, X + (size_t)MP * D, D, WIN, D, ldp / 32, E); } }
            else if (!(bid_ & 1))
            for (int skr = 0; skr < SK_REP; ++skr) { SkBf16 E{PROJ, ldp}; skinny_gemm(bid_, G_, FRESH_TID(), wave_, F.lds + RING_OFF, X + (size_t)MP * D, D, WIN, D, ldp / 32, E); }
            if (!(bid_ & 1))
            for (int skr = 0; skr < SK_REP; ++skr) if (l == 2) { SkKV E{out + O_SKS, out + O_SVS, SBKS, SBVS}; skinny_gemm(bid_, G_, FRESH_TID(), wave_, F.lds + RING_OFF, X + (size_t)MP * D, D, WIN + (size_t)NBQ * D, D, NKV / 32, E); }
        PHASE_END
        PHASE_BEGIN(LA, 3)
            gla_prep_intra(bid_, G_, tid, wave_, F.lds + RING_OFF, l, PROJ, w_gate_lr, b_gate, (unsigned char*)Y, OINT);
        PHASE_END
        PHASE_BEGIN(!LA, 11)
            {
#if defined(SB_MODE)
                for (int u = gw_; u < 12288; u += NGW_) { const int bh = u >> 8, qb = u & 255, b = bh / 12, h = bh % 12, t0 = 32 * qb; const size_t qo = (size_t)(b * SEQ + t0) * D + h * 128;
                    sb_attn<SB_MODE>(lane, F.lds + RING_OFF + wave_ * 16384, KPB + (size_t)bh * SEQ * 128, 128, VPB + (size_t)bh * SEQ * 128, 0, PROJ + qo, NBQ, OCAT + qo, t0, 32); }
#endif
                for (int sbr = 0; sbr < SB_REP; ++sbr)
                for (int u = gw_; u < 12288 + 96; u += NGW_) {
                    if (u < 12288) { const int bh = u >> 8, qb = u & 255, b = bh / 12, h = bh % 12, t0 = 32 * qb; const size_t qo = (size_t)(b * SEQ + t0) * D + h * 128;
                        sb_attn(lane, F.lds + RING_OFF + wave_ * 16384, KPB + (size_t)bh * SEQ * 128, 128, VPB + (size_t)bh * SEQ * 128, 0, PROJ + qo, NBQ, OCAT + qo, t0, 32); }
                    else { const int u2 = u - 12288, b = u2 / 12, h = u2 % 12; const size_t qo = (size_t)(MP + b * 16) * D + h * 128;
                        sb_attn(lane, F.lds + RING_OFF + wave_ * 16384, SBKS + (size_t)u2 * 2080 * 128, 128, SBVS + (size_t)u2 * 65 * 4096, 0, PROJ + qo, NBQ, OCAT + qo, 2048, 16); }
                }
            }
            __syncthreads();
            for (int mr = 0; mr < MEM_REP; ++mr)
            for (int wi = bid_; wi < 256 + 32; wi += G_) mem_attn_wg(wi, FRESH_TID(), wave_, F.lds + RING_OFF, l, PROJ, ldp, LA ? CQM : 1536, MEMK, MEMV, OCAT);
        PHASE_END
        PHASE_BEGIN(LA, 12)
            if (G_ == 256) { if (bid_ >= 144) { mem_attn_wg(bid_ - 144, FRESH_TID(), wave_, F.lds + RING_OFF, l, PROJ, ldp, CQM, MEMK, MEMV, OCAT); mem_attn_wg(bid_ - 144 + 112, FRESH_TID(), wave_, F.lds + RING_OFF, l, PROJ, ldp, CQM, MEMK, MEMV, OCAT); } }
            else for (int wi = bid_; wi < 256 + 32; wi += G_) mem_attn_wg(wi, FRESH_TID(), wave_, F.lds + RING_OFF, l, PROJ, ldp, CQM, MEMK, MEMV, OCAT);
            for (int wc = bid_; wc < 144; wc += G_) gla_chain<1>(wc, FRESH_TID(), wave_, F.lds + RING_OFF, l, (const unsigned char*)Y, state_gla, OINT, out, (float*)WMEM, (float*)MEMX);
            if (G_ == 256 && bid_ < 64) mem_attn_wg(224 + bid_, FRESH_TID(), wave_, F.lds + RING_OFF, l, PROJ, ldp, CQM, MEMK, MEMV, OCAT);
        PHASE_END
        PHASE_BEGIN(LA, 5)
            for (int wc = bid_; wc < 192 + 96; wc += G_) gla_chain<2>(wc, FRESH_TID(), wave_, F.lds + RING_OFF, l, (const unsigned char*)Y, state_gla, OINT, out, (float*)WMEM, (float*)MEMX, REP_CLS == 5 && rep_ == 0);
        PHASE_END
        PHASE_BEGIN(LA, 6)
            const float* gn = gla_norm_g + (size_t)l * 384;
            for (int row = gw_; row < MR; row += NGW_) {
                const float* op = OINT + (size_t)row * 1536 + 24 * lane; const bf16* gp = PROJ + (size_t)row * NA + CG + 24 * lane; const float* gnp = gn + 24 * (lane & 15);
                f32x4 ov[6]; v4u gv[3]; float ss = 0.f;
#pragma unroll
                for (int j = 0; j < 6; ++j) { ov[j] = *(const f32x4*)(op + 4 * j); ss += (ov[j].x * ov[j].x + ov[j].y * ov[j].y) + (ov[j].z * ov[j].z + ov[j].w * ov[j].w); }
#pragma unroll
                for (int j = 0; j < 3; ++j) gv[j] = *(const v4u*)(gp + 8 * j);
                ss += shx(ss, lane, 1); ss += shx(ss, lane, 2); ss += shx(ss, lane, 4); ss += shx(ss, lane, 8);
                const float r = 1.0f / sqrtf(ss * (1.0f / 384.0f) + RMS_EPS);
#pragma unroll
                for (int j = 0; j < 3; ++j) { const f32x4 n0 = *(const f32x4*)(gnp + 8 * j), n1 = *(const f32x4*)(gnp + 8 * j + 4); const f32x4 a = ov[2 * j], b = ov[2 * j + 1];
                    float gt[8]; gt[0] = pg8::bflo(gv[j].x); gt[1] = pg8::bfhi(gv[j].x); gt[2] = pg8::bflo(gv[j].y); gt[3] = pg8::bfhi(gv[j].y); gt[4] = pg8::bflo(gv[j].z); gt[5] = pg8::bfhi(gv[j].z); gt[6] = pg8::bflo(gv[j].w); gt[7] = pg8::bfhi(gv[j].w);
                    float o8[8];
#pragma unroll
                    for (int i = 0; i < 4; ++i) { o8[i] = a[i] * r * n0[i] * (gt[i] * __builtin_amdgcn_rcpf(1.0f + __expf(-gt[i]))); o8[4 + i] = b[i] * r * n1[i] * (gt[4 + i] * __builtin_amdgcn_rcpf(1.0f + __expf(-gt[4 + i]))); }
                    v4u o; o.x = pk2(o8[0], o8[1]); o.y = pk2(o8[2], o8[3]); o.z = pk2(o8[4], o8[5]); o.w = pk2(o8[6], o8[7]);
                    *(v4u*)(OCAT + (size_t)row * D + 24 * lane + 8 * j) = o; }
            }
        PHASE_END
        PHASE_BEGIN(true, 7)
            if (bid_ & 1) { SkRes Es{YB, X, DN_ALPHA}; skinny_gemm(bid_, G_, FRESH_TID(), wave_, F.lds + RING_OFF, OCAT + (size_t)MP * D, D, WO, D, D / 32, Es); }
            pg8::Gemm g{OCAT, WO, MP, D, D}; pg8::StaticOrder S; S.init(MP, D, G_, bid_); pg8::EpiRes E{YB, X, D, DN_ALPHA};
            pg8::gemm_phase<pg8::EpiRes, pg8::StaticOrder, true, true>(F.lds + RING_OFF, g, S, E, FRESH_TID());
            if (!(bid_ & 1))
            for (int skr = 0; skr < SK_REP; ++skr) { SkRes Es{YB, X, DN_ALPHA}; skinny_gemm(bid_, G_, FRESH_TID(), wave_, F.lds + RING_OFF, OCAT + (size_t)MP * D, D, WO, D, D / 32, Es); }
        PHASE_END
        PHASE_BEGIN(true, 8)
            const float* gg = ln1_g + (size_t)l * D; const float* bb = ln1_b + (size_t)l * D;
            for (int row = 2 * gw_; row < MR; row += 2 * NGW_) ln_two_rows<false>(lane, YB + (size_t)row * D, YB + (size_t)(row + 1) * D, gg, bb, X + (size_t)row * D, X + (size_t)(row + 1) * D, nullptr, nullptr);
        PHASE_END
        PHASE_BEGIN(true, 9)
            for (int dl = 0; dl < 3 * STAG * (bid_ >> 1 & 3); ++dl) __builtin_amdgcn_s_sleep(127);
            if (bid_ & 1) { SkSwiGLU Es{HB}; skinny_gemm(bid_, G_, FRESH_TID(), wave_, F.lds + RING_OFF, X + (size_t)MP * D, D, WFI, D, DFF / 16, Es); }
            pg8::Gemm g{X, WFI, MP, 2 * DFF, D}; pg8::StaticOrder S; S.init(MP, 2 * DFF, G_, bid_); pg8::EpiSwiGLU E{HB, DFF};
            pg8::gemm_phase<pg8::EpiSwiGLU, pg8::StaticOrder, true, true>(F.lds + RING_OFF, g, S, E, FRESH_TID());
            if (!(bid_ & 1))
            for (int skr = 0; skr < SK_REP; ++skr) { SkSwiGLU Es{HB}; skinny_gemm(bid_, G_, FRESH_TID(), wave_, F.lds + RING_OFF, X + (size_t)MP * D, D, WFI, D, DFF / 16, Es); }
        PHASE_END
        PHASE_BEGIN(true, 10)
            if (bid_ & 1) { SkRes Es{YB, X, DN_ALPHA}; skinny_gemm(bid_, G_, FRESH_TID(), wave_, F.lds + RING_OFF, HB + (size_t)MP * DFF, DFF, WFO, DFF, D / 32, Es); }
            pg8::Gemm g{HB, WFO, MP, D, DFF}; pg8::StaticOrder S; S.init(MP, D, G_, bid_); pg8::EpiRes E{YB, X, D, DN_ALPHA};
            pg8::gemm_phase<pg8::EpiRes, pg8::StaticOrder, true, true>(F.lds + RING_OFF, g, S, E, FRESH_TID());
            if (!(bid_ & 1))
            for (int skr = 0; skr < SK_REP; ++skr) { SkRes Es{YB, X, DN_ALPHA}; skinny_gemm(bid_, G_, FRESH_TID(), wave_, F.lds + RING_OFF, HB + (size_t)MP * DFF, DFF, WFO, DFF, D / 32, Es); }
        PHASE_END
        PHASE_BEGIN(true, 8)
            if (l < 3) CONVERT_WEIGHTS(l + 1);
            const float* gg = ln2_g + (size_t)l * D; const float* bb = ln2_b + (size_t)l * D;
            if (l == 3) { for (int row = 2 * gw_; row < MR; row += 2 * NGW_) { float* of = row < MP ? out + O_YP + (size_t)row * D : out + O_YS + (size_t)(row - MP) * D;
                ln_two_rows<true>(lane, YB + (size_t)row * D, YB + (size_t)(row + 1) * D, gg, bb, nullptr, nullptr, of, of + D); } }
            else for (int row = 2 * gw_; row < MR; row += 2 * NGW_) ln_two_rows<false>(lane, YB + (size_t)row * D, YB + (size_t)(row + 1) * D, gg, bb, X + (size_t)row * D, X + (size_t)(row + 1) * D, nullptr, nullptr);
        PHASE_END
    }
#if defined(DIAG_A)
    if (blockIdx.x == 0 && threadIdx.x == 0) { unsigned long long* dts = (unsigned long long*)(args.ws_ + 262144); dts[ph] = rt(); dts[63] = (unsigned long long)ph; }
#endif
#undef ws
#undef out
#undef X
#undef Y
#undef YB
#undef CONVERT_WEIGHTS
#undef PHASE_BEGIN
#undef PHASE_END
}

#if defined(DIAG_A)
__device__ const int diag_cls[40] = {0,0, 1,2,3,4,5,6,7,8,9,10,8, 1,2,3,4,5,6,7,8,9,10,8, 1,2,11,7,8,9,10,8, 1,2,11,7,8,9,10,8};
__global__ void diag_tail(float* o, const unsigned long long* dts) {
    __shared__ float dv[2];
    if (threadIdx.x == 0) { const int n = (int)dts[63]; unsigned long long sa = 0, sb = 0; for (int p = 0; p < n; ++p) { const unsigned long long d = dts[p + 1] - dts[p]; const int cl = diag_cls[p]; if (cl == DIAG_A) sa += d; if (cl == DIAG_B) sb += d; }
        dv[0] = (float)sa * 0.01f; dv[1] = (float)sb * 10.0f; }
    __syncthreads();
    for (int i = threadIdx.x; i < 262144; i += blockDim.x) o[O_YS + i] = dv[0];
    if (threadIdx.x == 0) o[O_YP] = dv[1];
}
#endif
#ifndef MK_PER_PHASE
#define MK_PER_PHASE 0
#endif
constexpr int N_PHASES = 1 + 2 * 10 + 2 * 7;
extern "C" void kernel_launch(void* const* d_in, const int* in_sizes, int n_in, void* d_out, int out_size, void* d_ws, size_t ws_size, hipStream_t stream) {
    static int grid = 0;
    if (grid == 0) {
        if (n_in != 22 || in_sizes[0] != MP * D || (size_t)out_size != O_END || ws_size < WS_END) { fprintf(stderr, "kernel_launch: unexpected shapes (n_in %d, in0 %d, out %d, ws %zu); nothing launched\n", n_in, n_in > 0 ? in_sizes[0] : -1, out_size, ws_size); grid = -1; return; }
        int dev = 0, cus = 0, per_cu = 0;
        if (hipGetDevice(&dev) != hipSuccess || hipDeviceGetAttribute(&cus, hipDeviceAttributeMultiprocessorCount, dev) != hipSuccess) { grid = -1; return; }
        if (hipFuncSetAttribute((const void*)mega, hipFuncAttributeMaxDynamicSharedMemorySize, LDS_BYTES) != hipSuccess) { fprintf(stderr, "kernel_launch: hipFuncSetAttribute failed\n"); grid = -1; return; }
        if (hipOccupancyMaxActiveBlocksPerMultiprocessor(&per_cu, (const void*)mega, NWAVES * 64, LDS_BYTES) != hipSuccess || per_cu < 1) fprintf(stderr, "kernel_launch: occupancy query reports %d\n", per_cu);
        (void)hipGetLastError();
        grid = cus;
    }
    if (grid < 0) return;
    if (hipMemsetAsync((char*)d_ws + WS_CTL, 0, CTL_ZERO_BYTES, stream) != hipSuccess) return;
    Args a{};
    for (int i = 0; i < 22; ++i) a.in[i] = (const float*)d_in[i];
    a.out_ = (float*)d_out; a.ws_ = (unsigned char*)d_ws;
#if MK_PER_PHASE
    for (int p = 0; p < N_PHASES; ++p) { a.ph_lo = p; a.ph_hi = p + 1; hipLaunchKernelGGL(mega, dim3(grid), dim3(NWAVES * 64), LDS_BYTES, stream, a); }
#else
    a.ph_lo = 0; a.ph_hi = N_PHASES; hipLaunchKernelGGL(mega, dim3(grid), dim3(NWAVES * 64), LDS_BYTES, stream, a);
#if defined(DIAG_A)
    hipLaunchKernelGGL(diag_tail, dim3(1), dim3(512), 0, stream, (float*)d_out, (const unsigned long long*)((unsigned char*)d_ws + 262144));
#endif
#endif
}
```

```cpp
#include <hip/hip_runtime.h>
#include <cstdio>
#include <cstdint>
namespace pg8 {
#define PG8_LAS __attribute__((address_space(3)))
typedef unsigned short bf16_t;
typedef short bf16x8 __attribute__((ext_vector_type(8)));
typedef float f32x4 __attribute__((ext_vector_type(4)));
typedef unsigned u32x4 __attribute__((ext_vector_type(4)));
constexpr int BM = 256, BK = 64, HALF = 128, HTB = HALF * BK * 2  , STAGE_BYTES = 8 * HTB, NXCD = 8, WGM = 4;

__host__ __device__ __forceinline__ int lds_byte(int r, int c) { const int st = (r >> 4) * 2 + (c >> 5), rr = r & 15, cc = c & 31, ob = rr * 64 + cc * 2; return st * 1024 + (ob ^ (((ob >> 9) & 1) << 5)); }
__host__ __device__ __forceinline__ void stage_rc(int b, int& R, int& C) { const int st = b / 1024, sb = b % 1024, swz = sb ^ (((sb >> 9) & 1) << 5); R = (st >> 1) * 16 + swz / 64; C = (st & 1) * 32 + (swz % 64) / 2; }
__host__ __device__ __forceinline__ int perm32(int rho) { const int n = rho >> 4, i = rho & 15; return 8 * (i >> 2) + 4 * n + (i & 3); }

struct Unit { int pm, pn; };
struct Gemm { const bf16_t* A; const bf16_t* Bt; int M, N, K; };

struct StaticOrder {
    int nM, nN, nwg, G, c;
    __host__ __device__ void init(int M, int N, int G_, int c_) { nM = M / BM; nN = N / BM; nwg = nM * nN; G = G_; c = c_; }
    __host__ __device__ bool next(int i, Unit& u) const {
        const long L = (long)i * G + c; if (L >= nwg) return false;
        int wgid = (int)L; { const int q = nwg / NXCD, r = nwg % NXCD, xcd = wgid % NXCD, off = wgid / NXCD; wgid = (xcd < r ? xcd * (q + 1) : r * (q + 1) + (xcd - r) * q) + off; }
        const int nig = WGM * nN, gid = wgid / nig, fm = gid * WGM, gsz = (nM - fm) < WGM ? (nM - fm) : WGM;
        u.pm = fm + ((wgid % nig) % gsz); u.pn = (wgid % nig) / gsz; return true;
    }
    __device__ __forceinline__ void a_ready(const Unit&) const {}
    __device__ __forceinline__ void done(const Unit&) const {}
};
__device__ __forceinline__ unsigned cvt_pk_bf16(float lo, float hi) { unsigned r; asm volatile("v_cvt_pk_bf16_f32 %0, %1, %2" : "=v"(r) : "v"(lo), "v"(hi)); return r; }
typedef float f32x2 __attribute__((ext_vector_type(2)));
typedef unsigned u32x2 __attribute__((ext_vector_type(2)));
__host__ __device__ __forceinline__ int vtf_d(int d) { return (d >> 5) * 1024 + (d & 31) * 8; }
__host__ __device__ __forceinline__ int vtf_k(int ks) { return (ks >> 4) * 512 + ((ks >> 2) & 1) * 256 + (ks & 3) + 4 * ((ks >> 3) & 1); }
__device__ __forceinline__ float bflo(unsigned w) { return __builtin_bit_cast(float, w << 16); }
__device__ __forceinline__ float bfhi(unsigned w) { return __builtin_bit_cast(float, w & 0xffff0000u); }
struct EpiBf16 {
    static constexpr bool PERM = true, AFTER_DRAIN = false;
    bf16_t* O; int ldc;
    __device__ __forceinline__ void operator()(const f32x4 (&acc)[2][2][4][2], const Unit& u, int wr, int wc, int fr, int fq) const {
        const int row0 = u.pm * BM + wr * 64 + fr, col0 = u.pn * BM + wc * 32 + 8 * fq;
#pragma unroll
        for (int ai = 0; ai < 2; ++ai)
#pragma unroll
            for (int m = 0; m < 4; ++m) { bf16_t* rowp = O + (size_t)(row0 + ai * HALF + m * 16) * ldc + col0;
#pragma unroll
                for (int bj = 0; bj < 2; ++bj) { const f32x4 v0 = acc[ai][bj][m][0], v1 = acc[ai][bj][m][1];
                    u32x4 w; w.x = cvt_pk_bf16(v0[0], v0[1]); w.y = cvt_pk_bf16(v0[2], v0[3]); w.z = cvt_pk_bf16(v1[0], v1[1]); w.w = cvt_pk_bf16(v1[2], v1[3]);
                    *(u32x4*)(rowp + bj * HALF) = w; } }
    }
};
struct EpiSwiGLU {
    static constexpr bool PERM = true, AFTER_DRAIN = false;
    bf16_t* Hh; int ldh;
    __device__ __forceinline__ float swi(float g, float up) const { return g * __builtin_amdgcn_rcpf(1.0f + __expf(-g)) * up; }
    __device__ __forceinline__ void operator()(const f32x4 (&acc)[2][2][4][2], const Unit& u, int wr, int wc, int fr, int fq) const {
        const int row0 = u.pm * BM + wr * 64 + fr, col0 = u.pn * HALF + wc * 32 + 8 * fq;
#pragma unroll
        for (int ai = 0; ai < 2; ++ai)
#pragma unroll
            for (int m = 0; m < 4; ++m) { bf16_t* rowp = Hh + (size_t)(row0 + ai * HALF + m * 16) * ldh + col0;
                const f32x4 g0 = acc[ai][0][m][0], g1 = acc[ai][0][m][1], u0 = acc[ai][1][m][0], u1 = acc[ai][1][m][1];
                u32x4 w; w.x = cvt_pk_bf16(swi(g0[0], u0[0]), swi(g0[1], u0[1])); w.y = cvt_pk_bf16(swi(g0[2], u0[2]), swi(g0[3], u0[3]));
                w.z = cvt_pk_bf16(swi(g1[0], u1[0]), swi(g1[1], u1[1])); w.w = cvt_pk_bf16(swi(g1[2], u1[2]), swi(g1[3], u1[3]));
                *(u32x4*)rowp = w; }
    }
};
struct EpiRes {
    static constexpr bool PERM = true, AFTER_DRAIN = false;
    bf16_t* Y; const bf16_t* X; int ldc; float alpha;
    __device__ __forceinline__ void operator()(const f32x4 (&acc)[2][2][4][2], const Unit& u, int wr, int wc, int fr, int fq) const {
        const int row0 = u.pm * BM + wr * 64 + fr, col0 = u.pn * BM + wc * 32 + 8 * fq;
        u32x4 xv[2][4][2];
#pragma unroll
        for (int ai = 0; ai < 2; ++ai)
#pragma unroll
            for (int m = 0; m < 4; ++m)
#pragma unroll
                for (int bj = 0; bj < 2; ++bj) xv[ai][m][bj] = *(const u32x4*)(X + (size_t)(row0 + ai * HALF + m * 16) * ldc + col0 + bj * HALF);
#pragma unroll
        for (int ai = 0; ai < 2; ++ai)
#pragma unroll
            for (int m = 0; m < 4; ++m) { const size_t ro = (size_t)(row0 + ai * HALF + m * 16) * ldc + col0;
#pragma unroll
                for (int bj = 0; bj < 2; ++bj) { const u32x4 x4 = xv[ai][m][bj]; const f32x4 a0 = acc[ai][bj][m][0], a1 = acc[ai][bj][m][1];
                    u32x4 w; w.x = cvt_pk_bf16(alpha * bflo(x4.x) + a0[0], alpha * bfhi(x4.x) + a0[1]); w.y = cvt_pk_bf16(alpha * bflo(x4.y) + a0[2], alpha * bfhi(x4.y) + a0[3]);
                    w.z = cvt_pk_bf16(alpha * bflo(x4.z) + a1[0], alpha * bfhi(x4.z) + a1[1]); w.w = cvt_pk_bf16(alpha * bflo(x4.w) + a1[2], alpha * bfhi(x4.w) + a1[3]);
                    *(u32x4*)(Y + ro + bj * HALF) = w; } }
    }
};
struct EpiKV {
    static constexpr bool PERM = false, AFTER_DRAIN = false;
    float *okp, *ovp, *oks, *ovs; bf16_t *kpb, *vpb, *ksb, *vsb;
    __device__ __forceinline__ void operator()(const f32x4 (&acc)[2][2][4][2], const Unit& u, int wr, int wc, int fr, int fq) const {
        const bool isv = u.pn >= 6; const int colt = (u.pn - (isv ? 6 : 0)) * BM + wc * 32 + 4 * fq, row0 = u.pm * BM + wr * 64 + fr;
        float* op = isv ? ovp : okp;
#pragma unroll
        for (int ai = 0; ai < 2; ++ai)
#pragma unroll
            for (int m = 0; m < 4; ++m) { const int row = row0 + ai * HALF + m * 16; float* fd;
                if (row < 32768) { fd = op + (size_t)row * 1536; } else continue;
                const int bq = row >> 13, sq = row & 8191;
#pragma unroll
                for (int bj = 0; bj < 2; ++bj)
#pragma unroll
                    for (int n = 0; n < 2; ++n) { const int c = colt + bj * HALF + n * 16; const f32x4 v = acc[ai][bj][m][n];
                        *(f32x4*)(fd + c) = v; const unsigned w0 = cvt_pk_bf16(v[0], v[1]), w1 = cvt_pk_bf16(v[2], v[3]);
                        const int hq = c >> 7, dq = c & 127;
                        if (!isv) { u32x2 w; w.x = w0; w.y = w1; *(u32x2*)(kpb + ((size_t)(bq * 12 + hq) * 8192 + sq) * 128 + dq) = w; }
                        else { bf16_t* vt = vpb + ((size_t)(bq * 12 + hq) * 256 + (sq >> 5)) * 4096 + vtf_d(dq) + vtf_k(sq & 31); vt[0] = (bf16_t)w0; vt[8] = (bf16_t)(w0 >> 16); vt[16] = (bf16_t)w1; vt[24] = (bf16_t)(w1 >> 16); } } }
    }
};
struct EpiMemKV {
    static constexpr bool PERM = false, AFTER_DRAIN = false;
    float *ok, *ov; bf16_t *kb, *vb;
    __device__ __forceinline__ void operator()(const f32x4 (&acc)[2][2][4][2], const Unit& u, int wr, int wc, int fr, int fq) const {
        const int l = u.pn >> 2, kv = (u.pn >> 1) & 1, hd0 = (u.pn & 1) * BM + wc * 32 + 4 * fq, row0 = u.pm * BM + wr * 64 + fr;
        float* fo = kv ? ov : ok; bf16_t* bo = kv ? vb : kb;
#pragma unroll
        for (int ai = 0; ai < 2; ++ai)
#pragma unroll
            for (int m = 0; m < 4; ++m) { const int row = row0 + ai * HALF + m * 16, b = row >> 8, mm = row & 255;
                float* fd = fo + (size_t)(l * 1024 + row) * 512; bf16_t* bd = bo + (size_t)((l * 12 + b) * 256 + mm) * 512;
#pragma unroll
                for (int bj = 0; bj < 2; ++bj)
#pragma unroll
                    for (int n = 0; n < 2; ++n) { const int c = hd0 + bj * HALF + n * 16; const f32x4 v = acc[ai][bj][m][n];
                        *(f32x4*)(fd + c) = v; const unsigned w0 = cvt_pk_bf16(v[0], v[1]), w1 = cvt_pk_bf16(v[2], v[3]);
                        if (!kv) { u32x2 w; w.x = w0; w.y = w1; *(u32x2*)(bd + c) = w; }
                        else { bf16_t* vt = vb + (size_t)((l * 12 + b) * 512 + c) * 256 + mm;
                            vt[0] = (bf16_t)w0; vt[256] = (bf16_t)(w0 >> 16); vt[512] = (bf16_t)w1; vt[768] = (bf16_t)(w1 >> 16); } } }
    }
};
template <class Epi, class Sched, bool ALIGN_EPI = false, bool SP2 = false>
__device__ __forceinline__ void gemm_phase(PG8_LAS unsigned char* lds, const Gemm g, const Sched& S, const Epi& E, int tid_in) {
    int tid_ = tid_in; asm volatile("" : "+v"(tid_));
    const int tid = tid_, wid = __builtin_amdgcn_readfirstlane(tid >> 6), lane = tid & 63, wr = wid >> 2, wc = wid & 3, fr = lane & 15, fq = lane >> 4;
    const int K = g.K, nt = K / BK;
    unsigned voffA[2], voffB[2];
#pragma unroll
    for (int i = 0; i < 2; ++i) { int R, C; stage_rc(tid * 16 + i * 8192, R, C); const int Rb = Epi::PERM ? ((R & ~31) + perm32(R & 31)) : R;
        voffA[i] = (unsigned)(R * K + C) * 2u; voffB[i] = (unsigned)(Rb * K + C) * 2u; }
    const size_t kstep = (size_t)(BK * 2);
    const size_t hstep = (size_t)HALF * K * 2;
    const size_t tstep = 2 * hstep;
    const unsigned ldsw = (unsigned)wid * 1024u;
    const int aoff = lds_byte(wr * 64 + fr, fq * 8), boff = lds_byte(wc * 32 + fr, fq * 8);
#define PG8_SA(b, h) (((b) * 2 + (h)) * HTB)
#define PG8_SB(b, h) ((4 + (b) * 2 + (h)) * HTB)
#define PG8_STAGE_X(bufoff, gbase, voff, aux) do { _Pragma("unroll") for (int _i = 0; _i < 2; ++_i) \
        __builtin_amdgcn_global_load_lds((const unsigned*)((const char*)(gbase) + (voff)[_i]), (PG8_LAS unsigned*)(lds + (bufoff) + ldsw + _i * 8192), 16, 0, aux); } while (0)
#ifndef PG8_B_AUX
#define PG8_B_AUX 0
#endif
#define PG8_STAGE(bufoff, gbase, voff) PG8_STAGE_X(bufoff, gbase, voff, 0)
#define PG8_LDA(dst, b, h) do { _Pragma("unroll") for (int m = 0; m < 4; ++m) _Pragma("unroll") for (int k = 0; k < 2; ++k) dst[m][k] = *(const PG8_LAS bf16x8*)(lds + PG8_SA(b, h) + aoff + m * 2048 + k * 1024); } while (0)
#define PG8_LDB(dst, b, h) do { _Pragma("unroll") for (int n = 0; n < 2; ++n) _Pragma("unroll") for (int k = 0; k < 2; ++k) dst[n][k] = *(const PG8_LAS bf16x8*)(lds + PG8_SB(b, h) + boff + n * 2048 + k * 1024); } while (0)
#define PG8_MMA(ai, bj, At, Bt) do { __builtin_amdgcn_s_setprio(1); _Pragma("unroll") for (int m = 0; m < 4; ++m) _Pragma("unroll") for (int n = 0; n < 2; ++n) _Pragma("unroll") for (int k = 0; k < 2; ++k) \
        acc[ai][bj][m][n] = __builtin_amdgcn_mfma_f32_16x16x32_bf16(Bt[n][k], At[m][k], acc[ai][bj][m][n], 0, 0, 0); __builtin_amdgcn_s_setprio(0); } while (0)
#define PG8_WAIT_V(n) asm volatile("s_waitcnt vmcnt(" #n ")" ::: "memory")
#define PG8_WAIT_L(n) asm volatile("s_waitcnt lgkmcnt(" #n ")" ::: "memory")
#define PG8_BAR __builtin_amdgcn_s_barrier()
#define PG8_SCHED __builtin_amdgcn_sched_barrier(0)
    Unit cur, nxt; int ui = 0;
    if (!S.next(0, cur)) return;
    f32x4 acc[2][2][4][2];
#pragma unroll
    for (int a = 0; a < 2; ++a)
#pragma unroll
        for (int b = 0; b < 2; ++b)
#pragma unroll
            for (int m = 0; m < 4; ++m)
#pragma unroll
                for (int n = 0; n < 2; ++n) acc[a][b][m][n] = (f32x4){0.f, 0.f, 0.f, 0.f};
    bf16x8 At[4][2], B0[2][2], B1[2][2];
    const char* cA = (const char*)g.A + (size_t)cur.pm * tstep; const char* cB = (const char*)g.Bt + (size_t)cur.pn * tstep;
    S.a_ready(cur);
    if constexpr (SP2) {
        PG8_STAGE_X(PG8_SB(0, 0), cB, voffB, PG8_B_AUX); PG8_STAGE_X(PG8_SB(0, 1), cB + hstep, voffB, PG8_B_AUX); PG8_STAGE(PG8_SA(0, 0), cA, voffA); PG8_STAGE(PG8_SA(0, 1), cA + hstep, voffA);
        if (wr == 1) PG8_BAR;
        PG8_WAIT_V(2); PG8_BAR;
        PG8_STAGE_X(PG8_SB(1, 0), cB + kstep, voffB, PG8_B_AUX); PG8_STAGE(PG8_SA(1, 0), cA + kstep, voffA); PG8_STAGE_X(PG8_SB(1, 1), cB + hstep + kstep, voffB, PG8_B_AUX);
        PG8_WAIT_V(6); PG8_BAR;
    } else {
        PG8_STAGE_X(PG8_SB(0, 0), cB, voffB, PG8_B_AUX); PG8_STAGE(PG8_SA(0, 0), cA, voffA); PG8_STAGE_X(PG8_SB(0, 1), cB + hstep, voffB, PG8_B_AUX); PG8_STAGE(PG8_SA(0, 1), cA + hstep, voffA);
        if (wr == 1) PG8_BAR;
        PG8_WAIT_V(4); PG8_BAR;
        PG8_STAGE_X(PG8_SB(1, 0), cB + kstep, voffB, PG8_B_AUX); PG8_STAGE(PG8_SA(1, 0), cA + kstep, voffA); PG8_STAGE_X(PG8_SB(1, 1), cB + hstep + kstep, voffB, PG8_B_AUX);
        PG8_WAIT_V(6); PG8_BAR;
    }
    for (;;) {
        const bool has_next = S.next(ui + 1, nxt);
        const char* nA = has_next ? (const char*)g.A + (size_t)nxt.pm * tstep : cA; const char* nB = has_next ? (const char*)g.Bt + (size_t)nxt.pn * tstep : cB;
        for (int t = 0; t < nt; t += 2) {
            const bool last = (t == nt - 2);
            const char* a1 = cA + (size_t)(t + 1) * kstep;
            const char* a2 = last ? nA : cA + (size_t)(t + 2) * kstep; const char* b2 = last ? nB : cB + (size_t)(t + 2) * kstep;
            const char* a3 = a2 + kstep; const char* b3 = b2 + kstep;
            if (last && has_next) S.a_ready(nxt);
            if constexpr (SP2) {
            PG8_LDB(B0, 0, 0); PG8_LDB(B1, 0, 1); PG8_SCHED; PG8_LDA(At, 0, 0); PG8_STAGE(PG8_SA(1, 1), a1 + hstep, voffA);
            PG8_WAIT_V(8); PG8_WAIT_L(0); PG8_BAR; PG8_MMA(0, 0, At, B0); PG8_MMA(0, 1, At, B1); PG8_BAR; PG8_SCHED;
            PG8_LDA(At, 0, 1); PG8_STAGE_X(PG8_SB(0, 0), b2, voffB, PG8_B_AUX); PG8_STAGE_X(PG8_SB(0, 1), b2 + hstep, voffB, PG8_B_AUX); PG8_STAGE(PG8_SA(0, 0), a2, voffA);
            PG8_WAIT_V(8); PG8_WAIT_L(0); PG8_BAR; PG8_MMA(1, 0, At, B0); PG8_MMA(1, 1, At, B1); PG8_BAR; PG8_SCHED;
            PG8_LDB(B0, 1, 0); PG8_LDB(B1, 1, 1); PG8_SCHED; PG8_LDA(At, 1, 0); PG8_STAGE(PG8_SA(0, 1), a2 + hstep, voffA);
            PG8_WAIT_V(8); PG8_WAIT_L(0); PG8_BAR; PG8_MMA(0, 0, At, B0); PG8_MMA(0, 1, At, B1); PG8_BAR; PG8_SCHED;
            PG8_LDA(At, 1, 1); PG8_STAGE_X(PG8_SB(1, 0), b3, voffB, PG8_B_AUX); PG8_STAGE_X(PG8_SB(1, 1), b3 + hstep, voffB, PG8_B_AUX); PG8_STAGE(PG8_SA(1, 0), a3, voffA);
            PG8_WAIT_V(8); PG8_WAIT_L(0); PG8_BAR; PG8_MMA(1, 0, At, B0); PG8_MMA(1, 1, At, B1); PG8_BAR; PG8_SCHED;
            } else {
            PG8_LDB(B0, 0, 0); PG8_SCHED; PG8_LDA(At, 0, 0); PG8_STAGE(PG8_SA(1, 1), a1 + hstep, voffA);
            PG8_WAIT_L(8); PG8_BAR; PG8_WAIT_L(0); PG8_MMA(0, 0, At, B0); PG8_BAR; PG8_SCHED;
            PG8_LDB(B1, 0, 1); PG8_STAGE_X(PG8_SB(0, 0), b2, voffB, PG8_B_AUX);
            PG8_BAR; PG8_WAIT_L(0); PG8_MMA(0, 1, At, B1); PG8_BAR;
            PG8_LDA(At, 0, 1); PG8_STAGE(PG8_SA(0, 0), a2, voffA);
            PG8_BAR; PG8_WAIT_L(0); PG8_MMA(1, 0, At, B0); PG8_BAR; PG8_SCHED;
            PG8_STAGE_X(PG8_SB(0, 1), b2 + hstep, voffB, PG8_B_AUX);
            PG8_WAIT_V(6); PG8_BAR; PG8_MMA(1, 1, At, B1); PG8_BAR;
            PG8_LDB(B0, 1, 0); PG8_SCHED; PG8_LDA(At, 1, 0); PG8_STAGE(PG8_SA(0, 1), a2 + hstep, voffA);
            PG8_WAIT_L(8); PG8_BAR; PG8_WAIT_L(0); PG8_MMA(0, 0, At, B0); PG8_BAR; PG8_SCHED;
            PG8_LDB(B1, 1, 1); PG8_STAGE_X(PG8_SB(1, 0), b3, voffB, PG8_B_AUX);
            PG8_BAR; PG8_WAIT_L(0); PG8_MMA(0, 1, At, B1); PG8_BAR;
            PG8_LDA(At, 1, 1); PG8_STAGE(PG8_SA(1, 0), a3, voffA);
            PG8_BAR; PG8_WAIT_L(0); PG8_MMA(1, 0, At, B0); PG8_BAR; PG8_SCHED;
            PG8_STAGE_X(PG8_SB(1, 1), b3 + hstep, voffB, PG8_B_AUX);
            PG8_WAIT_V(6); PG8_BAR; PG8_MMA(1, 1, At, B1); PG8_BAR;
            }
        }
        if constexpr (ALIGN_EPI) { if (wr == 0) PG8_BAR; }
        if constexpr (!Epi::AFTER_DRAIN) { E(acc, cur, wr, wc, fr, fq); S.done(cur); }
        if (!has_next) break;
#pragma unroll
        for (int a = 0; a < 2; ++a)
#pragma unroll
            for (int b = 0; b < 2; ++b)
#pragma unroll
                for (int m = 0; m < 4; ++m)
#pragma unroll
                    for (int n = 0; n < 2; ++n) acc[a][b][m][n] = (f32x4){0.f, 0.f, 0.f, 0.f};
        cur = nxt; cA = nA; cB = nB; ++ui;
        if constexpr (ALIGN_EPI) { if (wr == 1) PG8_BAR; }
    }
    PG8_WAIT_V(0);
    if constexpr (!ALIGN_EPI) { if (wr == 0) PG8_BAR; }
    PG8_BAR;
    if constexpr (Epi::AFTER_DRAIN) { E.fused(acc, cur, wr, wc, fr, fq, lds, wid, lane); S.done(cur); }
#undef PG8_SA
#undef PG8_SB
#undef PG8_STAGE
#undef PG8_STAGE_X
#undef PG8_LDA
#undef PG8_LDB
#undef PG8_MMA
#undef PG8_WAIT_V
#undef PG8_WAIT_L
#undef PG8_BAR
#undef PG8_SCHED
}
}
#define GAS __attribute__((address_space(1)))
#define LAS __attribute__((address_space(3)))
typedef unsigned short bf16;
typedef unsigned v4u __attribute__((ext_vector_type(4)));
typedef float f32x4 __attribute__((ext_vector_type(4)));
typedef short bf16x8 __attribute__((ext_vector_type(8)));
typedef GAS unsigned gu32;
typedef GAS unsigned long long gu64;
#define RLX_AGENT __ATOMIC_RELAXED, __HIP_MEMORY_SCOPE_AGENT
#define LDS_WAIT() asm volatile("s_waitcnt lgkmcnt(0)" ::: "memory")
#define VM_WAIT() asm volatile("s_waitcnt vmcnt(0)" ::: "memory")
__device__ __forceinline__ unsigned long long rt() { return __builtin_amdgcn_s_memrealtime(); }
__device__ __forceinline__ unsigned f2bf(float f) { unsigned u = __builtin_bit_cast(unsigned, f); return (u + 0x7fffu + ((u >> 16) & 1u)) >> 16; }
__device__ __forceinline__ unsigned pk2(float lo, float hi) { return f2bf(lo) | (f2bf(hi) << 16); }
#define XB_TMO      128
#define XB_XCNT(j)  (256  + 64 * (j))
#define XB_XSUB(j)  (1280 + 64 * (j))
#define XB_XGEN(j)  (2304 + 64 * (j))
#define XB_TOP      3328
#define XB_TOPGEN   3392
#define XCD_BAR_WORDS 3456
#define XB_SPIN_CAP (1u << 18)

__device__ __forceinline__ unsigned xb_ld(unsigned* p)              { return __hip_atomic_load(p, __ATOMIC_RELAXED, __HIP_MEMORY_SCOPE_AGENT); }
__device__ __forceinline__ unsigned xb_add(unsigned* p, unsigned v) { return __hip_atomic_fetch_add(p, v, __ATOMIC_RELAXED, __HIP_MEMORY_SCOPE_AGENT); }
__device__ __forceinline__ unsigned xb_xcc_id() { return (unsigned)__builtin_amdgcn_s_getreg((3 << 11) | 20) & 0xFu; }
#define XB_SPIN(cond, bar) do { unsigned _sp = 0; while (cond) { __builtin_amdgcn_s_sleep(1); \
    if ((++_sp & 255u) == 0u) { if (xb_ld(&(bar)[XB_TMO])) break; if (_sp > XB_SPIN_CAP) { atomicAdd(&(bar)[XB_TMO], 1u); break; } } } } while (0)

struct XcdBarrier {
    unsigned* bar; unsigned x;
    volatile LAS unsigned* st;
};

__device__ __forceinline__ XcdBarrier xcd_barrier_post(unsigned* bar, volatile LAS unsigned* st) {
    XcdBarrier b; b.bar = bar; b.x = xb_xcc_id(); b.st = st;
    if (threadIdx.x == 0) (void)xb_add(&bar[XB_XCNT(b.x)], 1u);
    return b;
}
__device__ __forceinline__ void xcd_barrier_complete(unsigned* bar, unsigned x, unsigned& nloc, unsigned& nx) {
    const unsigned G = gridDim.x * gridDim.y * gridDim.z;
    unsigned sum, cnt, mine, sp = 0u;
    for (;;) {
        sum = 0u; cnt = 0u; mine = 0u;
#pragma unroll
        for (unsigned j = 0; j < 16; ++j) { const unsigned c = xb_ld(&bar[XB_XCNT(j)]); sum += c; cnt += (c > 0u) ? 1u : 0u; mine = (j == x) ? c : mine; }
        if (sum == G) break;
        __builtin_amdgcn_s_sleep(1);
        if ((++sp & 255u) == 0u) { if (xb_ld(&bar[XB_TMO])) break; if (sp > XB_SPIN_CAP) { atomicAdd(&bar[XB_TMO], 1u); break; } }
    }
    nloc = mine > 0u ? mine : 1u; nx = cnt > 0u ? cnt : 1u;
}

__device__ __forceinline__ void xcd_barrier(const XcdBarrier& b) {
    asm volatile("s_waitcnt vmcnt(0)" ::: "memory");
    __syncthreads();
    if (threadIdx.x == 0) {
        unsigned* bar = b.bar;
        __builtin_amdgcn_s_waitcnt(0);
        unsigned nloc = b.st[0], nx = b.st[1];
        if (nloc == 0u) { xcd_barrier_complete(bar, b.x, nloc, nx); b.st[0] = nloc; b.st[1] = nx; }
        const unsigned old = xb_add(&bar[XB_XSUB(b.x)], 1u);
        const unsigned gen = old / nloc;
        if (old + 1u == (gen + 1u) * nloc) {
            __builtin_amdgcn_fence(__ATOMIC_RELEASE, "agent");
            asm volatile("s_waitcnt vmcnt(0)" ::: "memory");
            const unsigned og = xb_add(&bar[XB_TOP], 1u);
            const unsigned tg = og / nx;
            if (og + 1u == (tg + 1u) * nx) xb_add(&bar[XB_TOPGEN], 1u);
            else XB_SPIN(xb_ld(&bar[XB_TOPGEN]) == tg, bar);
            __builtin_amdgcn_fence(__ATOMIC_ACQUIRE, "agent");
            xb_add(&bar[XB_XGEN(b.x)], 1u);
            asm volatile("s_waitcnt vmcnt(0)" ::: "memory");
        } else {
            XB_SPIN(xb_ld(&bar[XB_XGEN(b.x)]) == gen, bar);
            __builtin_amdgcn_fence(__ATOMIC_ACQUIRE, "agent");
            asm volatile("s_waitcnt vmcnt(0)" ::: "memory");
        }
    }
    __syncthreads();
}
constexpr int NWAVES = 8;
constexpr int D = 2048, SEQ = 8192, MP = 32768, MS = 128, MR = 32896, MT = 33024;
constexpr int DFF = 5632, NA = 5376, NBQ = 2048, NKV = 3072;
constexpr int CQ = 0, CK = 768, CV = 1536, CG = 3072, CQM = 4608, CLR = 5120;
constexpr float DN_ALPHA = 1.6817928305074292f, LN_EPS = 1e-5f, RMS_EPS = 1e-6f;
constexpr float GLA_QSCALE = 0.07216878364870323f, HD_SCALE = 0.08838834764831845f;
constexpr size_t MiB = 1u << 20;
constexpr size_t WS_CTL = 0, CTL_ZERO_BYTES = 1 * MiB;
constexpr size_t WS_WIN = 1 * MiB, WS_WO = 22 * MiB, WS_WFI = 30 * MiB, WS_WFO = 74 * MiB, WS_WMEM = 96 * MiB, WS_MEMX = 112 * MiB, WS_MEMK = 116 * MiB, WS_MEMV = 128 * MiB;
constexpr size_t WS_X = 140 * MiB, WS_Y = 269 * MiB, WS_R1 = 527 * MiB, WS_OCAT = 882 * MiB, WS_SBKS = 1011 * MiB, WS_SBVS = 1060 * MiB, WS_END = 1109 * MiB;
static_assert(WS_WIN + (size_t)NA * D * 2 <= WS_WO && WS_WFI + (size_t)2 * DFF * D * 2 <= WS_WFO && WS_WFO + (size_t)D * DFF * 2 <= WS_WMEM, "weights map");
static_assert(WS_X + (size_t)MT * D * 2 <= WS_Y && WS_Y + (size_t)MT * D * 4 <= WS_R1 && WS_R1 + (size_t)MT * DFF * 2 <= WS_OCAT && WS_OCAT + (size_t)MT * D * 2 <= WS_SBKS, "activation map");
static_assert(WS_SBKS + (size_t)8 * 2064 * 1536 * 2 <= WS_SBVS && WS_SBVS + (size_t)8 * 2064 * 1536 * 2 <= WS_END, "sb sample map");
constexpr size_t O_YP = 0, O_YS = 67108864, O_GSP = 67371008, O_GSS = 69730304, O_SKP = 74448896, O_SVP = 124780544, O_SKS = 175112192, O_SVS = 175308800, O_MKP = 175505408, O_MVP = 177602560, O_END = 179699712;
constexpr int CW_BAR = 4096;
constexpr int RING_OFF = 0, RING_BYTES = 131072, LDSCTL_OFF = RING_BYTES, MISC_OFF = LDSCTL_OFF + 320, LDS_BYTES = 147456;

struct Args { const float* in[22]; float* out_; unsigned char* ws_; int ph_lo, ph_hi; };
struct Frame {
    LAS unsigned char* lds; volatile LAS unsigned* MISC; gu32* ctl;
    int tid, lane, wave, G, gw, NGW;
};
__device__ __forceinline__ float bf2f(bf16 h) { return __builtin_bit_cast(float, (unsigned)h << 16); }
__device__ __forceinline__ float shx(float v, int lane, int m) { return __builtin_bit_cast(float, __builtin_amdgcn_ds_bpermute((lane ^ m) << 2, __builtin_bit_cast(int, v))); }
__device__ __forceinline__ float wave_sum(float v, int lane) {
#pragma unroll
    for (int o = 1; o < 64; o <<= 1) v += shx(v, lane, o);
    return v;
}
__device__ __forceinline__ float wave_max(float v, int lane) {
#pragma unroll
    for (int o = 1; o < 64; o <<= 1) v = fmaxf(v, shx(v, lane, o));
    return v;
}
__device__ __forceinline__ void cvt_row(const float* src, bf16* dst, int n, int lane) {
    for (int j = lane * 4; j < n; j += 256) {
        f32x4 v = src ? *(const f32x4*)(src + j) : (f32x4){0.f, 0.f, 0.f, 0.f};
        unsigned long long w = (unsigned long long)pk2(v.x, v.y) | ((unsigned long long)pk2(v.z, v.w) << 32);
        *(unsigned long long*)(dst + j) = w;
    }
}
template <int N>
__device__ __forceinline__ void cvt_rows2(const float* s0, const float* s1, bf16* d0, bf16* d1, int lane) {
    f32x4 v0[N / 256], v1[N / 256];
#pragma unroll
    for (int j = 0; j < N / 256; ++j) { v0[j] = s0 ? *(const f32x4*)(s0 + lane * 4 + 256 * j) : (f32x4){0.f, 0.f, 0.f, 0.f}; v1[j] = s1 ? *(const f32x4*)(s1 + lane * 4 + 256 * j) : (f32x4){0.f, 0.f, 0.f, 0.f}; }
#pragma unroll
    for (int j = 0; j < N / 256; ++j) {
        *(unsigned long long*)(d0 + lane * 4 + 256 * j) = (unsigned long long)pk2(v0[j].x, v0[j].y) | ((unsigned long long)pk2(v0[j].z, v0[j].w) << 32);
        *(unsigned long long*)(d1 + lane * 4 + 256 * j) = (unsigned long long)pk2(v1[j].x, v1[j].y) | ((unsigned long long)pk2(v1[j].z, v1[j].w) << 32); }
}
__device__ __forceinline__ int fresh_lane() { int z = 0; asm volatile("" : "+s"(z)); return (int)__builtin_amdgcn_mbcnt_hi(~0u, __builtin_amdgcn_mbcnt_lo(~0u, (unsigned)z)); }
#define FRESH_TID() (wave_ * 64 + fresh_lane())
template <bool FINAL>
__device__ __forceinline__ void ln_two_rows(int lane, const bf16* y0, const bf16* y1, const float* gg, const float* bb, bf16* x0, bf16* x1, float* of0, float* of1) {
    v4u w[2][4];
#pragma unroll
    for (int j = 0; j < 4; ++j) { w[0][j] = ((const v4u*)y0)[lane + 64 * j]; w[1][j] = ((const v4u*)y1)[lane + 64 * j]; }
    float v[2][4][8]; float s[2] = {0.f, 0.f};
#pragma unroll
    for (int r = 0; r < 2; ++r)
#pragma unroll
        for (int j = 0; j < 4; ++j) { const v4u q = w[r][j]; v[r][j][0] = pg8::bflo(q.x); v[r][j][1] = pg8::bfhi(q.x); v[r][j][2] = pg8::bflo(q.y); v[r][j][3] = pg8::bfhi(q.y); v[r][j][4] = pg8::bflo(q.z); v[r][j][5] = pg8::bfhi(q.z); v[r][j][6] = pg8::bflo(q.w); v[r][j][7] = pg8::bfhi(q.w);
            s[r] += ((v[r][j][0] + v[r][j][1]) + (v[r][j][2] + v[r][j][3])) + ((v[r][j][4] + v[r][j][5]) + (v[r][j][6] + v[r][j][7])); }
    const float m0 = wave_sum(s[0], lane) * (1.f / D), m1 = wave_sum(s[1], lane) * (1.f / D); float q0 = 0.f, q1 = 0.f;
#pragma unroll
    for (int j = 0; j < 4; ++j)
#pragma unroll
        for (int i = 0; i < 8; ++i) { v[0][j][i] -= m0; q0 += v[0][j][i] * v[0][j][i]; v[1][j][i] -= m1; q1 += v[1][j][i] * v[1][j][i]; }
    const float rs[2] = {1.f / sqrtf(wave_sum(q0, lane) * (1.f / D) + LN_EPS), 1.f / sqrtf(wave_sum(q1, lane) * (1.f / D) + LN_EPS)};
#pragma unroll
    for (int j = 0; j < 4; ++j) { const int e0 = (lane + 64 * j) * 8; const f32x4 g0 = *(const f32x4*)(gg + e0), g1 = *(const f32x4*)(gg + e0 + 4), b0 = *(const f32x4*)(bb + e0), b1 = *(const f32x4*)(bb + e0 + 4);
#pragma unroll
        for (int r = 0; r < 2; ++r) { float o[8];
#pragma unroll
            for (int i = 0; i < 4; ++i) { o[i] = v[r][j][i] * rs[r] * g0[i] + b0[i]; o[4 + i] = v[r][j][4 + i] * rs[r] * g1[i] + b1[i]; }
            if (FINAL) { float* of = r ? of1 : of0; *(f32x4*)(of + e0) = (f32x4){o[0], o[1], o[2], o[3]}; *(f32x4*)(of + e0 + 4) = (f32x4){o[4], o[5], o[6], o[7]}; }
            else { v4u p; p.x = pk2(o[0], o[1]); p.y = pk2(o[2], o[3]); p.z = pk2(o[4], o[5]); p.w = pk2(o[6], o[7]); *(v4u*)((r ? x1 : x0) + e0) = p; } } }
}
struct MapId { __device__ __forceinline__ int operator()(int n) const { return n; } };
struct MapInA { __device__ __forceinline__ int operator()(int n) const { return n < 4608 ? n : (n < 5120 ? n + 16 : (n < 5136 ? n - 512 : -1)); } };
struct MapFfn { __device__ __forceinline__ int operator()(int n) const { const int t = n >> 8, r = n & 255; return r < 128 ? 128 * t + r : DFF + 128 * t + (r - 128); } };
template <class Map>
__device__ __forceinline__ void wt_convert(LAS unsigned char* ldsb, int wave, int gw, int NGW, int lane, const float* W, int K, int Nsrc, bf16* WT, int Ndst, Map map) {
    LAS float* scr = (LAS float*)(ldsb + RING_OFF + wave * 16384);
    const int nblk = Ndst / 64, nitems = (K / 64) * nblk, nq = lane & 15, kq = lane >> 4;
    for (int it = gw; it < nitems; it += NGW) {
        const int kb = it / nblk, nb = it % nblk, k0 = 64 * kb, n0 = 64 * nb;
        const int sc0 = map(n0 + 4 * nq), sc3 = map(n0 + 4 * nq + 3);
        const bool contig = sc0 >= 0 && sc3 == sc0 + 3;
        f32x4 v[16];
#pragma unroll
        for (int i = 0; i < 16; ++i) { const int kk = 4 * i + kq;
            if (contig) v[i] = *(const f32x4*)(W + (size_t)(k0 + kk) * Nsrc + sc0);
            else {
#pragma unroll
                for (int e = 0; e < 4; ++e) { const int sc = map(n0 + 4 * nq + e); v[i][e] = sc >= 0 ? W[(size_t)(k0 + kk) * Nsrc + sc] : 0.f; } } }
#pragma unroll
        for (int i = 0; i < 16; ++i) { const int kk = 4 * i + kq;
#pragma unroll
            for (int e = 0; e < 4; ++e) { const int n = 4 * nq + e; scr[n * 64 + (kk ^ n)] = v[i][e]; } }
        LDS_WAIT(); asm volatile("" ::: "memory");
        const int c = lane & 7;
#pragma unroll
        for (int j = 0; j < 8; ++j) { const int n = (lane >> 3) + 8 * j; const LAS float* s = scr + n * 64;
#define SWZ(i) s[(8 * c + (i)) ^ n]
            v4u o; o.x = pk2(SWZ(0), SWZ(1)); o.y = pk2(SWZ(2), SWZ(3)); o.z = pk2(SWZ(4), SWZ(5)); o.w = pk2(SWZ(6), SWZ(7));
#undef SWZ
            *(GAS v4u*)(WT + (size_t)(n0 + n) * K + k0 + 8 * c) = o; }
        LDS_WAIT(); asm volatile("" ::: "memory");
    }
}
__device__ __forceinline__ float softplus_f(float z) { return fmaxf(z, 0.f) + log1pf(__expf(-fabsf(z))); }

typedef short s16x4 __attribute__((ext_vector_type(4)));
typedef pg8::u32x2 u32x2;
typedef float f32x16 __attribute__((ext_vector_type(16)));
typedef __bf16 bf16x2_t __attribute__((ext_vector_type(2)));
typedef float f32x2_t __attribute__((ext_vector_type(2)));
__device__ __forceinline__ unsigned cvt2(float lo, float hi) { const f32x2_t v = {lo, hi}; const bf16x2_t b = __builtin_convertvector(v, bf16x2_t); return __builtin_bit_cast(unsigned, b); }
__device__ __forceinline__ bf16x8 pack8(const f32x4 a, const f32x4 b) { v4u p; p.x = cvt2(a[0], a[1]); p.y = cvt2(a[2], a[3]); p.z = cvt2(b[0], b[1]); p.w = cvt2(b[2], b[3]); return __builtin_bit_cast(bf16x8, p); }
__device__ __forceinline__ bf16x8 ld2x8(const bf16* p0, const bf16* p1) { const s16x4 a = *(const s16x4*)p0, b = *(const s16x4*)p1; return __builtin_shufflevector(a, b, 0, 1, 2, 3, 4, 5, 6, 7); }
__device__ __forceinline__ bf16x8 ld16(const bf16* p) { return *(const bf16x8*)p; }
#define MFMA16(a, b, c) __builtin_amdgcn_mfma_f32_16x16x32_bf16((a), (b), (c), 0, 0, 0)
#define MFMA32(a, b, c) __builtin_amdgcn_mfma_f32_32x32x16_bf16((a), (b), (c), 0, 0, 0)

constexpr int QIMG_LD = 200, KTIMG_LD = 68, PKG_Q = 0, PKG_KT = 25600, PKG_G = 51712, IMG_BYTES = 52480, PKG_K = 52480, PKG_VT = 77056, PKG_BYTES = 126208, N_PKG = 2048 + 32;
static_assert(64 * QIMG_LD * 2 == PKG_KT && PKG_KT + 192 * KTIMG_LD * 2 == PKG_G && PKG_G + 768 == IMG_BYTES && PKG_K + 24576 == PKG_VT && PKG_VT + 49152 == PKG_BYTES && IMG_BYTES % 16 == 0, "package map");

__device__ __forceinline__ float softplus_fast(float z) { return fmaxf(z, 0.f) + __logf(1.0f + __expf(-fabsf(z))); }
constexpr int GL_TOT = 0, GL_Q = 6144, GL_K = GL_Q + 64 * QIMG_LD * 2, GL_V = GL_K + 64 * QIMG_LD * 2, VL_LD = 68, GL_P = GL_V + 384 * VL_LD * 2, P_LD = 68, GL_END = GL_P + 64 * P_LD * 2;
static_assert(GL_END <= RING_BYTES && GL_Q % 16 == 0 && GL_K % 16 == 0 && GL_V % 8 == 0 && GL_P % 8 == 0, "gla_prep_intra LDS map");
__device__ __forceinline__ void gla_prep_intra(int bid, int G, int tid, int wave, LAS unsigned char* lds, int l, const bf16* PROJ, const float* w_gate_lr, const float* b_gate, unsigned char* PKG, float* OINT) {
    const int lane = tid & 63, fr = lane & 15, fq = lane >> 4;
    const float* w2 = w_gate_lr + (size_t)l * 16 * 768; const float* bg = b_gate + (size_t)l * 768;
    LAS float* tot = (LAS float*)(lds + GL_TOT);
    LAS bf16* QL = (LAS bf16*)(lds + GL_Q); LAS bf16* KL = (LAS bf16*)(lds + GL_K); LAS bf16* VL = (LAS bf16*)(lds + GL_V); LAS bf16* P = (LAS bf16*)(lds + GL_P);
    float w2c[3][16], bgc[3]; int cur_h = -1;
    for (int j = 0;; ++j) {
        int item;
        if (G == 256) { if (j < 8) item = ((((j >> 1) << 2) | (bid & 3)) << 7) | ((bid >> 2) + 64 * (j & 1)); else if (j == 8 && bid < 32) item = 2048 + bid; else break; }
        else { item = bid + j * G; if (item >= N_PKG) break; }
        int h, row0, T;
        if (item < 2048) { const int bh = item >> 7, ch = item & 127; h = bh & 3; row0 = (bh >> 2) * SEQ + ch * 64; T = 64; }
        else { const int i2 = item - 2048; h = i2 & 3; row0 = MP + (i2 >> 2) * 16; T = 16; }
        unsigned char* pk = PKG + (size_t)item * PKG_BYTES;
        bf16* Qt = (bf16*)(pk + PKG_Q); bf16* KT = (bf16*)(pk + PKG_KT); bf16* VT = (bf16*)(pk + PKG_VT); float* Gp = (float*)(pk + PKG_G);
        if (h != cur_h) { cur_h = h;
#pragma unroll
            for (int c = 0; c < 3; ++c) { const int d = h * 192 + lane + 64 * c; bgc[c] = bg[d];
#pragma unroll
                for (int r = 0; r < 16; ++r) w2c[c][r] = w2[r * 768 + d]; } }
        v4u l0[8], l1[8];
#pragma unroll
        for (int tt = 0; tt < 8; ++tt) { const int t = 8 * wave + tt; const bf16* prow = PROJ + (size_t)(row0 + (t < T ? t : T - 1)) * NA;
            l0[tt] = *(const v4u*)(prow + CLR); l1[tt] = *(const v4u*)(prow + CLR + 8); }
        float lc[8][3]; float run[3] = {0.f, 0.f, 0.f};
#pragma unroll
        for (int tt = 0; tt < 8; ++tt) { const bool ok = 8 * wave + tt < T;
            float lr[16]; lr[0] = pg8::bflo(l0[tt].x); lr[1] = pg8::bfhi(l0[tt].x); lr[2] = pg8::bflo(l0[tt].y); lr[3] = pg8::bfhi(l0[tt].y); lr[4] = pg8::bflo(l0[tt].z); lr[5] = pg8::bfhi(l0[tt].z); lr[6] = pg8::bflo(l0[tt].w); lr[7] = pg8::bfhi(l0[tt].w);
            lr[8] = pg8::bflo(l1[tt].x); lr[9] = pg8::bfhi(l1[tt].x); lr[10] = pg8::bflo(l1[tt].y); lr[11] = pg8::bfhi(l1[tt].y); lr[12] = pg8::bflo(l1[tt].z); lr[13] = pg8::bfhi(l1[tt].z); lr[14] = pg8::bflo(l1[tt].w); lr[15] = pg8::bfhi(l1[tt].w);
#pragma unroll
            for (int c = 0; c < 3; ++c) { float xg = bgc[c];
#pragma unroll
                for (int r = 0; r < 16; ++r) xg += lr[r] * w2c[c][r];
                run[c] += ok ? -softplus_fast(-xg) * (1.0f / 16.0f) : 0.f; lc[tt][c] = run[c]; } }
#pragma unroll
        for (int c = 0; c < 3; ++c) tot[wave * 192 + lane + 64 * c] = run[c];
        unsigned qv[8][3], kv[8][3];
#pragma unroll
        for (int tt = 0; tt < 8; ++tt) { const int t = 8 * wave + tt; const bf16* prow = PROJ + (size_t)(row0 + (t < T ? t : T - 1)) * NA + h * 192 + lane;
#pragma unroll
            for (int c = 0; c < 3; ++c) { qv[tt][c] = prow[CQ + 64 * c]; kv[tt][c] = prow[CK + 64 * c]; } }
        __syncthreads();
        float pre[3], all[3];
#pragma unroll
        for (int c = 0; c < 3; ++c) { pre[c] = 0.f; all[c] = 0.f;
#pragma unroll
            for (int w = 0; w < 8; ++w) { const float tv = tot[w * 192 + lane + 64 * c]; all[c] += tv; if (w < wave) pre[c] += tv; } }
        unsigned ktw[3][4];
#pragma unroll
        for (int tt = 0; tt < 8; ++tt) { const int t = 8 * wave + tt; const bool ok = t < T;
#pragma unroll
            for (int c = 0; c < 3; ++c) { const int dl = lane + 64 * c; const float bc = pre[c] + lc[tt][c]; const float eq = __expf(bc), ek = __expf(-bc);
                const unsigned qb = ok ? f2bf(bf2f((bf16)qv[tt][c]) * GLA_QSCALE * eq) : 0u, kb = ok ? f2bf(bf2f((bf16)kv[tt][c]) * ek) : 0u;
                Qt[t * QIMG_LD + dl] = (bf16)qb; QL[t * QIMG_LD + dl] = (bf16)qb; KL[t * QIMG_LD + dl] = (bf16)kb;
                if (tt & 1) ktw[c][tt >> 1] |= kb << 16; else ktw[c][tt >> 1] = kb; } }
#pragma unroll
        for (int c = 0; c < 3; ++c) { bf16* kp = KT + (size_t)(lane + 64 * c) * KTIMG_LD + 8 * wave; u32x2 o0, o1; o0.x = ktw[c][0]; o0.y = ktw[c][1]; o1.x = ktw[c][2]; o1.y = ktw[c][3]; *(u32x2*)kp = o0; *(u32x2*)(kp + 4) = o1; }
        if (wave == 0) {
#pragma unroll
            for (int c = 0; c < 3; ++c) Gp[lane + 64 * c] = __expf(all[c]); }
        unsigned vv[6][8];
#pragma unroll
        for (int tt = 0; tt < 8; ++tt) { const int t = 8 * wave + tt; const bf16* prow = PROJ + (size_t)(row0 + (t < T ? t : T - 1)) * NA + CV + h * 384 + lane;
#pragma unroll
            for (int c2 = 0; c2 < 6; ++c2) vv[c2][tt] = prow[64 * c2]; }
#pragma unroll
        for (int c2 = 0; c2 < 6; ++c2) { const bool ok0 = 8 * wave < T;
            u32x2 o0, o1; o0.x = ok0 ? vv[c2][0] | (vv[c2][1] << 16) : 0u; o0.y = ok0 ? vv[c2][2] | (vv[c2][3] << 16) : 0u; o1.x = ok0 ? vv[c2][4] | (vv[c2][5] << 16) : 0u; o1.y = ok0 ? vv[c2][6] | (vv[c2][7] << 16) : 0u;
            v4u o; o.x = o0.x; o.y = o0.y; o.z = o1.x; o.w = o1.y; *(v4u*)(VT + (size_t)(lane + 64 * c2) * 64 + 8 * wave) = o;
            LAS bf16* vl = VL + (lane + 64 * c2) * VL_LD + 8 * wave; *(LAS u32x2*)vl = o0; *(LAS u32x2*)(vl + 4) = o1; }
        __syncthreads();
        const int nvalid = T;
        bf16x8 va[3], vb[3];
#pragma unroll
        for (int k = 0; k < 3; ++k) { const LAS bf16* vr = VL + (16 * (3 * wave + k) + fr) * VL_LD + 4 * fq;
            const s16x4 x0 = *(const LAS s16x4*)vr, x1 = *(const LAS s16x4*)(vr + 16), x2 = *(const LAS s16x4*)(vr + 32), x3 = *(const LAS s16x4*)(vr + 48);
            va[k] = __builtin_shufflevector(x0, x1, 0, 1, 2, 3, 4, 5, 6, 7); vb[k] = __builtin_shufflevector(x2, x3, 0, 1, 2, 3, 4, 5, 6, 7); }
#pragma unroll
        for (int rep = 0; rep < 2; ++rep) {
            const int tl = wave + 8 * rep;
            if (tl < 10) {
                const int it = tl < 1 ? 0 : (tl < 3 ? 1 : (tl < 6 ? 2 : 3)), jt = tl - (it * (it + 1)) / 2;
                f32x4 at = {0.f, 0.f, 0.f, 0.f};
                const LAS bf16* qr = QL + (16 * it + fr) * QIMG_LD + 8 * fq; const LAS bf16* kr = KL + (16 * jt + fr) * QIMG_LD + 8 * fq;
#pragma unroll
                for (int s = 0; s < 6; ++s) at = MFMA16(*(const LAS bf16x8*)(kr + 32 * s), *(const LAS bf16x8*)(qr + 32 * s), at);
                if (it == jt) {
#pragma unroll
                    for (int jj = 0; jj < 4; ++jj) if (4 * fq + jj > fr) at[jj] = 0.f; }
                u32x2 w; w.x = cvt2(at[0], at[1]); w.y = cvt2(at[2], at[3]);
                *(LAS u32x2*)(P + (16 * it + fr) * P_LD + 16 * jt + 4 * fq) = w;
            } else if (tl == 10 || tl == 11) {
                const int it = tl == 10 ? 0 : 2, jt = tl == 10 ? 1 : 3; unsigned zz = 0u; asm volatile("" : "+v"(zz)); u32x2 z; z.x = zz; z.y = zz;
                *(LAS u32x2*)(P + (16 * it + fr) * P_LD + 16 * jt + 4 * fq) = z;
            }
        }
        __syncthreads();
#pragma unroll
        for (int it = 0; it < 4; ++it) {
            if (16 * it >= nvalid) break;
            const LAS bf16* pr = P + (16 * it + fr) * P_LD + 4 * fq;
            const s16x4 a0 = *(const LAS s16x4*)pr, a1 = *(const LAS s16x4*)(pr + 16);
            const bf16x8 pf0 = __builtin_shufflevector(a0, a1, 0, 1, 2, 3, 4, 5, 6, 7); bf16x8 pf1 = pf0;
            if (it >= 2) { const s16x4 b0 = *(const LAS s16x4*)(pr + 32), b1 = *(const LAS s16x4*)(pr + 48); pf1 = __builtin_shufflevector(b0, b1, 0, 1, 2, 3, 4, 5, 6, 7); }
#pragma unroll
            for (int k = 0; k < 3; ++k) { f32x4 o = {0.f, 0.f, 0.f, 0.f};
                o = MFMA16(va[k], pf0, o); if (it >= 2) o = MFMA16(vb[k], pf1, o);
                *(f32x4*)(OINT + (size_t)(row0 + 16 * it + fr) * 1536 + h * 384 + 16 * (3 * wave + k) + 4 * fq) = o; }
        }
        __syncthreads();
    }
}

template <int PASS>
__device__ __forceinline__ void gla_chain(int wc, int tid, int wave, LAS unsigned char* lds, int l, const unsigned char* PKG, const float* state_gla, float* OINT, float* out, float* SLOC, float* GSEG, bool dry = false) {
    const int lane = tid & 63, fr = lane & 15, fq = lane >> 4;
    int h, vb, bh, seg, item0, nsteps, row0, nvalid; const float* s0 = nullptr; float* sout = nullptr;
    if (PASS == 1) { bh = wc / 9; const int rem = wc % 9; vb = rem / 3; seg = rem % 3; h = bh & 3; item0 = bh * 128 + 32 * seg; nsteps = 32; row0 = 0; nvalid = 64; }
    else if (wc < 192) { bh = wc / 12; const int rem = wc % 12; vb = rem >> 2; seg = rem & 3; h = bh & 3; item0 = bh * 128 + 32 * seg; nsteps = 32; row0 = (bh >> 2) * SEQ + 2048 * seg; nvalid = 64;
        if (seg == 3) sout = out + O_GSP + (size_t)(l * 16 + bh) * 192 * 384; }
    else { const int c2 = wc - 192; bh = c2 / 3; vb = c2 % 3; seg = 0; h = bh & 3; item0 = 2048 + bh; nsteps = 1; row0 = MP + (bh >> 2) * 16; nvalid = 16; s0 = state_gla + (size_t)(l * 32 + bh) * 192 * 384; sout = out + O_GSS + (size_t)(l * 32 + bh) * 192 * 384; }
    const int v0 = vb * 128 + wave * 16;
#define GLA_WALK(p, step) do { (p) += (step); asm volatile("" : "+v"(p)); } while (0)
    f32x4 S[12];
    if (s0) { const float* p = s0 + (size_t)(4 * fq) * 384 + v0 + fr;
#pragma unroll
        for (int t = 0; t < 12; ++t) {
#pragma unroll
            for (int jj = 0; jj < 4; ++jj) { S[t][jj] = *p; GLA_WALK(p, 384); }
            GLA_WALK(p, 12 * 384); } }
    else {
#pragma unroll
        for (int t = 0; t < 12; ++t) S[t] = (f32x4){0.f, 0.f, 0.f, 0.f}; }
    if (PASS == 2 && wc < 192) {
        for (int j = 0; j < seg; ++j) { const float* gs = GSEG + (size_t)(bh * 3 + j) * 192 + 4 * fq; const float* p = SLOC + (size_t)((bh * 3 + vb) * 3 + j) * 192 * 128 + (size_t)(4 * fq) * 128 + wave * 16 + fr;
#pragma unroll
            for (int t = 0; t < 12; ++t) { const f32x4 g4 = *(const f32x4*)(gs + 16 * t);
#pragma unroll
                for (int jj = 0; jj < 4; ++jj) { S[t][jj] = g4[jj] * S[t][jj] + *p; GLA_WALK(p, 128); }
                GLA_WALK(p, 12 * 128); } }
    }
    f32x4 GP[PASS == 1 ? 12 : 1];
    if (PASS == 1) {
#pragma unroll
        for (int t = 0; t < 12; ++t) GP[t] = (f32x4){1.f, 1.f, 1.f, 1.f}; }
    constexpr int CH0 = PASS == 1 ? PKG_KT / 16 : 0, NCH = IMG_BYTES / 16, NLD = PASS == 1 ? 4 : 7;
    v4u pre[NLD]; bf16x8 vt[2], vtn[2]; f32x4 oin[4];
    { const unsigned char* pk = PKG + (size_t)item0 * PKG_BYTES;
      if (PASS == 2) {
#pragma unroll
        for (int it = 0; it < 4; ++it) { const int tl = 16 * it + fr; oin[it] = tl < nvalid ? *(const f32x4*)(OINT + (size_t)(row0 + tl) * 1536 + h * 384 + v0 + 4 * fq) : (f32x4){0.f, 0.f, 0.f, 0.f}; } }
#pragma unroll
      for (int k = 0; k < NLD; ++k) { const int ch = CH0 + tid + 512 * k; if (ch < NCH) pre[k] = *(const v4u*)(pk + (size_t)ch * 16); }
      const bf16* VT = (const bf16*)(pk + PKG_VT) + (size_t)(v0 + fr) * 64 + 4 * fq; vt[0] = ld2x8(VT, VT + 16); vt[1] = ld2x8(VT + 32, VT + 48);
#pragma unroll
      for (int k = 0; k < NLD; ++k) { const int ch = CH0 + tid + 512 * k; if (ch < NCH) *(LAS v4u*)(lds + (size_t)ch * 16) = pre[k]; }
      vtn[0] = vt[0]; vtn[1] = vt[1]; }
    __syncthreads();
    for (int n = 0; n < nsteps; ++n) {
        const LAS unsigned char* img = lds + (n & 1) * IMG_BYTES;
        const bool more = n + 1 < nsteps;
        if (more) { const unsigned char* pk = PKG + (size_t)(item0 + n + 1) * PKG_BYTES;
#pragma unroll
            for (int k = 0; k < NLD; ++k) { const int ch = CH0 + tid + 512 * k; if (ch < NCH) pre[k] = *(const v4u*)(pk + (size_t)ch * 16); }
            const bf16* VT = (const bf16*)(pk + PKG_VT) + (size_t)(v0 + fr) * 64 + 4 * fq; vtn[0] = ld2x8(VT, VT + 16); vtn[1] = ld2x8(VT + 32, VT + 48); }
        if (PASS == 2) {
            bf16x8 Sb[6];
#pragma unroll
            for (int s = 0; s < 6; ++s) Sb[s] = pack8(S[2 * s], S[2 * s + 1]);
#pragma unroll
            for (int it = 0; it < 4; ++it) {
                const LAS bf16* qr = (const LAS bf16*)(img + PKG_Q) + (16 * it + fr) * QIMG_LD + 4 * fq;
                f32x4 o = oin[it];
#pragma unroll
                for (int s = 0; s < 6; ++s) { const s16x4 a = *(const LAS s16x4*)(qr + 32 * s), b = *(const LAS s16x4*)(qr + 32 * s + 16);
                    o = MFMA16(Sb[s], __builtin_shufflevector(a, b, 0, 1, 2, 3, 4, 5, 6, 7), o); }
                const int tl = 16 * it + fr;
                if (tl < nvalid && !dry) *(f32x4*)(OINT + (size_t)(row0 + 64 * n + tl) * 1536 + h * 384 + v0 + 4 * fq) = o;
                __builtin_amdgcn_sched_barrier(0);
            }
            if (more) {
#pragma unroll
                for (int it = 0; it < 4; ++it) oin[it] = *(const f32x4*)(OINT + (size_t)(row0 + 64 * (n + 1) + 16 * it + fr) * 1536 + h * 384 + v0 + 4 * fq); }
        }
#pragma unroll
        for (int t = 0; t < 12; ++t) { const LAS bf16* kr = (const LAS bf16*)(img + PKG_KT) + (16 * t + fr) * KTIMG_LD + 4 * fq;
#pragma unroll
            for (int s2 = 0; s2 < 2; ++s2) { const s16x4 a = *(const LAS s16x4*)(kr + 32 * s2), b = *(const LAS s16x4*)(kr + 32 * s2 + 16);
                S[t] = MFMA16(__builtin_shufflevector(a, b, 0, 1, 2, 3, 4, 5, 6, 7), vt[s2], S[t]); }
            const f32x4 g4 = *(const LAS f32x4*)(img + PKG_G + (16 * t + 4 * fq) * 4);
            S[t] = S[t] * g4; if (PASS == 1) GP[t] = GP[t] * g4; if ((t & 3) == 3) __builtin_amdgcn_sched_barrier(0); }
        if (more) { LAS unsigned char* nimg = lds + ((n + 1) & 1) * IMG_BYTES;
#pragma unroll
            for (int k = 0; k < NLD; ++k) { const int ch = CH0 + tid + 512 * k; if (ch < NCH) *(LAS v4u*)(nimg + (size_t)ch * 16) = pre[k]; }
            vt[0] = vtn[0]; vt[1] = vtn[1]; }
        asm volatile("s_waitcnt lgkmcnt(0)" ::: "memory"); __builtin_amdgcn_s_barrier(); asm volatile("" ::: "memory");
    }
    if (PASS == 1) {
        float* p = SLOC + (size_t)((bh * 3 + vb) * 3 + seg) * 192 * 128 + (size_t)(4 * fq) * 128 + wave * 16 + fr;
#pragma unroll
        for (int t = 0; t < 12; ++t) {
#pragma unroll
            for (int jj = 0; jj < 4; ++jj) { *p = S[t][jj]; GLA_WALK(p, 128); }
            GLA_WALK(p, 12 * 128); }
        if (vb == 0 && wave == 0 && fr == 0) { float* gs = GSEG + (size_t)(bh * 3 + seg) * 192;
#pragma unroll
            for (int t = 0; t < 12; ++t) *(f32x4*)(gs + 16 * t + 4 * fq) = GP[t]; }
    } else if (sout) {
        float* p = sout + (size_t)(4 * fq) * 384 + v0 + fr;
#pragma unroll
        for (int t = 0; t < 12; ++t) {
#pragma unroll
            for (int jj = 0; jj < 4; ++jj) { *p = S[t][jj]; GLA_WALK(p, 384); }
            GLA_WALK(p, 12 * 384); }
    }
#undef GLA_WALK
}

__device__ __forceinline__ void mem_attn(int item, int lane, int l, const bf16* PROJ, int ldp, int cqm, const bf16* MEMK, const bf16* MEMVT, bf16* OCAT) {
    const int fr = lane & 15, fq = lane >> 4, tile = item >> 2, h = item & 3, r0 = tile * 16;
    const int bb = r0 < MP ? r0 / SEQ : 4 + ((r0 - MP) >> 4);
    const bf16* Kb = MEMK + (size_t)((l * 12 + bb) * 256) * 512 + h * 128; const bf16* Vt = MEMVT + (size_t)(((l * 12 + bb) * 4 + h) * 128) * 256;
    bf16x8 qf[4];
#pragma unroll
    for (int s = 0; s < 4; ++s) qf[s] = ld16(PROJ + (size_t)(r0 + fr) * ldp + cqm + h * 128 + 32 * s + 8 * fq);
    f32x4 st[16];
#pragma unroll
    for (int mt = 0; mt < 16; ++mt) { st[mt] = (f32x4){0.f, 0.f, 0.f, 0.f}; const bf16* kr = Kb + (size_t)(16 * mt + fr) * 512 + 8 * fq;
#pragma unroll
        for (int s = 0; s < 4; ++s) st[mt] = MFMA16(ld16(kr + 32 * s), qf[s], st[mt]); }
    float mx = -3.0e38f;
#pragma unroll
    for (int mt = 0; mt < 16; ++mt) mx = fmaxf(mx, fmaxf(fmaxf(st[mt][0], st[mt][1]), fmaxf(st[mt][2], st[mt][3])));
    mx = fmaxf(mx, shx(mx, lane, 16)); mx = fmaxf(mx, shx(mx, lane, 32));
    float sum = 0.f;
#pragma unroll
    for (int mt = 0; mt < 16; ++mt)
#pragma unroll
        for (int jj = 0; jj < 4; ++jj) { const float p = __expf((st[mt][jj] - mx) * HD_SCALE); st[mt][jj] = p; sum += p; }
    sum += shx(sum, lane, 16); sum += shx(sum, lane, 32);
    const float inv = 1.0f / sum;
    bf16x8 pf[8];
#pragma unroll
    for (int s = 0; s < 8; ++s) pf[s] = pack8(st[2 * s], st[2 * s + 1]);
#pragma unroll
    for (int dt = 0; dt < 8; ++dt) { f32x4 o = {0.f, 0.f, 0.f, 0.f}; const bf16* vr = Vt + (size_t)(16 * dt + fr) * 256 + 4 * fq;
#pragma unroll
        for (int s = 0; s < 8; ++s) o = MFMA16(ld2x8(vr + 32 * s, vr + 32 * s + 16), pf[s], o);
        u32x2 w; w.x = cvt2(o[0] * inv, o[1] * inv); w.y = cvt2(o[2] * inv, o[3] * inv);
        *(u32x2*)(OCAT + (size_t)(r0 + fr) * D + 1536 + h * 128 + 16 * dt + 4 * fq) = w; }
}

__device__ __forceinline__ void mem_attn_wg(int wi, int tid, int wave, LAS unsigned char* lds, int l, const bf16* PROJ, int ldp, int cqm, const bf16* MEMK, const bf16* MEMVT, bf16* OCAT) {
    const bool smp = wi >= 256; const int lane = tid & 63, fr = lane & 15, fq = lane >> 4, bh = smp ? (wi - 256) : (wi >> 4), sub = wi & 15, b = smp ? 4 + (bh >> 2) : (bh >> 2), h = bh & 3;
    const bf16* Kb = MEMK + (size_t)((l * 12 + b) * 256) * 512 + h * 128; const bf16* Vt = MEMVT + (size_t)(((l * 12 + b) * 4 + h) * 128) * 256;
#pragma unroll
    for (int k = 0; k < 8; ++k) { const int idx = tid + 512 * k, row = idx >> 4, c = idx & 15; *(LAS v4u*)(lds + row * 256 + ((c ^ (row & 15)) << 4)) = *(const v4u*)(Kb + (size_t)row * 512 + c * 8); }
#pragma unroll
    for (int k = 0; k < 8; ++k) { const int idx = tid + 512 * k, row = idx >> 5, c = idx & 31; *(LAS v4u*)(lds + 65536 + row * 512 + ((c ^ (2 * (row & 15))) << 4)) = *(const v4u*)(Vt + (size_t)row * 256 + c * 8); }
    __syncthreads();
    unsigned koff[4], voff[16];
#pragma unroll
    for (int s2 = 0; s2 < 4; ++s2) { koff[s2] = (unsigned)(fr * 256 + (((4 * s2 + fq) ^ fr) << 4)); asm volatile("" : "+v"(koff[s2])); }
#pragma unroll
    for (int s2 = 0; s2 < 8; ++s2) { const int p0 = 8 * s2 + fq, p1 = p0 + 4;
        voff[2 * s2] = (unsigned)(65536 + fr * 512 + ((((p0 >> 1) ^ (2 * fr)) << 4) | ((p0 & 1) << 3))); voff[2 * s2 + 1] = (unsigned)(65536 + fr * 512 + ((((p1 >> 1) ^ (2 * fr)) << 4) | ((p1 & 1) << 3)));
        asm volatile("" : "+v"(voff[2 * s2]), "+v"(voff[2 * s2 + 1])); }
    const int nblk = smp ? (wave == 0 ? 1 : 0) : 4;
#pragma unroll 1
    for (int blk = 0; blk < nblk; ++blk) {
        const int r0 = smp ? MP + (b - 4) * 16 : b * SEQ + sub * 512 + blk * 128 + wave * 16;
        bf16x8 qf[4];
#pragma unroll
        for (int s = 0; s < 4; ++s) qf[s] = ld16(PROJ + (size_t)(r0 + fr) * ldp + cqm + h * 128 + 32 * s + 8 * fq);
        f32x4 st[16];
#pragma unroll
        for (int mt = 0; mt < 16; ++mt) { st[mt] = (f32x4){0.f, 0.f, 0.f, 0.f};
#pragma unroll
            for (int s = 0; s < 4; ++s) st[mt] = MFMA16(*(const LAS bf16x8*)(lds + koff[s] + mt * 4096), qf[s], st[mt]);
            if ((mt & 3) == 3) __builtin_amdgcn_sched_barrier(0); }
        float mx = -3.0e38f;
#pragma unroll
        for (int mt = 0; mt < 16; ++mt) mx = fmaxf(mx, fmaxf(fmaxf(st[mt][0], st[mt][1]), fmaxf(st[mt][2], st[mt][3])));
        mx = fmaxf(mx, shx(mx, lane, 16)); mx = fmaxf(mx, shx(mx, lane, 32));
        float sum = 0.f;
#pragma unroll
        for (int mt = 0; mt < 16; ++mt)
#pragma unroll
            for (int jj = 0; jj < 4; ++jj) { const float p = __expf((st[mt][jj] - mx) * HD_SCALE); st[mt][jj] = p; sum += p; }
        sum += shx(sum, lane, 16); sum += shx(sum, lane, 32);
        const float inv = 1.0f / sum;
        bf16x8 pf[8];
#pragma unroll
        for (int s = 0; s < 8; ++s) pf[s] = pack8(st[2 * s], st[2 * s + 1]);
#pragma unroll
        for (int dt = 0; dt < 8; ++dt) { f32x4 o = {0.f, 0.f, 0.f, 0.f};
#pragma unroll
            for (int s = 0; s < 8; ++s) { const s16x4 a = *(const LAS s16x4*)(lds + voff[2 * s] + dt * 8192), bb = *(const LAS s16x4*)(lds + voff[2 * s + 1] + dt * 8192);
                o = MFMA16(__builtin_shufflevector(a, bb, 0, 1, 2, 3, 4, 5, 6, 7), pf[s], o); }
            u32x2 w; w.x = cvt2(o[0] * inv, o[1] * inv); w.y = cvt2(o[2] * inv, o[3] * inv);
            *(u32x2*)(OCAT + (size_t)(r0 + fr) * D + 1536 + h * 128 + 16 * dt + 4 * fq) = w;
            if (dt & 1) __builtin_amdgcn_sched_barrier(0); }
    }
    __syncthreads();
}

template <int MODE = 0>
__device__ __forceinline__ void sb_attn(int lane, LAS unsigned char* wlds, const bf16* Kp, int ldk, const bf16* VTp, int ldvt, const bf16* Qp, int ldq, bf16* Op, int t0, int nq) {
    const int r = lane & 31, hh = lane >> 5;
    LAS bf16x8* qs = (LAS bf16x8*)wlds + lane;
#pragma unroll
    for (int ks = 0; ks < 8; ++ks) qs[64 * ks] = ld16(Qp + (size_t)r * ldq + 16 * ks + 8 * hh);
    f32x16 oacc[4];
#pragma unroll
    for (int dt = 0; dt < 4; ++dt)
#pragma unroll
        for (int i = 0; i < 16; ++i) oacc[dt][i] = 0.f;
    float carry = 1.f;
    bf16x8 kf[8];
    { const bf16* kr = Kp + (size_t)(t0 + r) * ldk + 8 * hh;
#pragma unroll
      for (int ks = 0; ks < 8; ++ks) kf[ks] = ld16(kr + 16 * ks); }
    for (int s0 = t0; s0 >= 0; s0 -= 32) {
        bf16x8 vf[8];
#pragma unroll
        for (int k2 = 0; k2 < 2; ++k2)
#pragma unroll
            for (int dt = 0; dt < 4; ++dt) vf[4 * k2 + dt] = MODE == 3 ? qs[64 * dt] : ld16(VTp + (size_t)(s0 >> 5) * 4096 + ((dt * 2 + k2) * 64 + lane) * 8);
        f32x16 st;
#pragma unroll
        for (int i = 0; i < 16; ++i) st[i] = 0.f;
#pragma unroll
        for (int ks = 0; ks < 8; ++ks) st = MFMA32(kf[ks], qs[64 * ks], st);
        { const int sn = s0 >= 32 ? s0 - 32 : 0; const bf16* kr = Kp + (size_t)(sn + r) * ldk + 8 * hh;
#pragma unroll
          for (int ks = 0; ks < 8; ++ks) kf[ks] = ld16(kr + 16 * ks); }
        const bool diag = (s0 == t0);
        float lb[16], om[16];
#pragma unroll
        for (int i = 0; i < 16; ++i) { const float z = st[i] * HD_SCALE, e = __expf(-fabsf(z)), rr = __builtin_amdgcn_rcpf(1.0f + e), er = e * rr;
            lb[i] = z >= 0.f ? rr : er; om[i] = z >= 0.f ? er : rr;
            if (diag && !(((i & 3) + 8 * (i >> 2) + 4 * hh) < r)) { lb[i] = 0.f; om[i] = 1.f; } }
        float g[4], pgv[4];
#pragma unroll
        for (int m = 0; m < 4; ++m) { g[m] = (om[4 * m] * om[4 * m + 1]) * (om[4 * m + 2] * om[4 * m + 3]); pgv[m] = shx(g[m], lane, 32); }
        float R[4]; R[3] = 1.f; R[2] = g[3] * pgv[3]; R[1] = R[2] * (g[2] * pgv[2]); R[0] = R[1] * (g[1] * pgv[1]);
        const float total = R[0] * (g[0] * pgv[0]);
#pragma unroll
        for (int m = 0; m < 4; ++m) { const float suf = carry * R[m] * (hh == 0 ? pgv[m] : 1.f);
            const float t3 = suf, t2 = t3 * om[4 * m + 3], t1 = t2 * om[4 * m + 2], t0_ = t1 * om[4 * m + 1];
            lb[4 * m + 3] *= t3; lb[4 * m + 2] *= t2; lb[4 * m + 1] *= t1; lb[4 * m] *= t0_; }
        carry *= total;
#pragma unroll
        for (int k2 = 0; k2 < 2; ++k2) {
            v4u p; p.x = cvt2(lb[8 * k2], lb[8 * k2 + 1]); p.y = cvt2(lb[8 * k2 + 2], lb[8 * k2 + 3]); p.z = cvt2(lb[8 * k2 + 4], lb[8 * k2 + 5]); p.w = cvt2(lb[8 * k2 + 6], lb[8 * k2 + 7]);
            const bf16x8 wf = __builtin_bit_cast(bf16x8, p);
#pragma unroll
            for (int dt = 0; dt < 4; ++dt) { if (MODE != 3) oacc[dt] = MFMA32(vf[4 * k2 + dt], wf, oacc[dt]); else oacc[dt][0] += __builtin_bit_cast(float, (int)wf[0]) + __builtin_bit_cast(float, (int)vf[4 * k2 + dt][0]); }
        }
        if (MODE == 2 || __all((r >= nq) || (carry < 1.0e-37f))) break;
    }
    if (MODE != 0) { float sdry = 0.f;
#pragma unroll
        for (int dt = 0; dt < 4; ++dt)
#pragma unroll
            for (int i = 0; i < 16; ++i) sdry += oacc[dt][i];
        if (sdry == 1.2345e33f) Op[0] = 0; }
    else if (r < nq) {
#pragma unroll
        for (int dt = 0; dt < 4; ++dt)
#pragma unroll
            for (int g4 = 0; g4 < 4; ++g4) { u32x2 wv; wv.x = cvt2(oacc[dt][4 * g4], oacc[dt][4 * g4 + 1]); wv.y = cvt2(oacc[dt][4 * g4 + 2], oacc[dt][4 * g4 + 3]);
                *(u32x2*)(Op + (size_t)r * D + 32 * dt + 8 * g4 + 4 * hh) = wv; }
    }
    asm volatile("s_waitcnt lgkmcnt(0)" ::: "memory");
}

struct SkBf16 { bf16* O; int ldc;
    __device__ __forceinline__ int brow(int unit, int nb) const { return 32 * unit + 16 * nb; }
    __device__ __forceinline__ void store(int unit, const f32x4 a0, const f32x4 a1, int m, int fq) const { bf16* p = O + (size_t)(MP + m) * ldc + 32 * unit + 4 * fq;
        u32x2 w; w.x = cvt2(a0[0], a0[1]); w.y = cvt2(a0[2], a0[3]); *(u32x2*)p = w; w.x = cvt2(a1[0], a1[1]); w.y = cvt2(a1[2], a1[3]); *(u32x2*)(p + 16) = w; } };
struct SkRes { bf16* Yp; const bf16* Xp; float alpha;
    __device__ __forceinline__ int brow(int unit, int nb) const { return 32 * unit + 16 * nb; }
    __device__ __forceinline__ void one(size_t o, const f32x4 a) const { const u32x2 xv = *(const u32x2*)(Xp + o);
        f32x4 r; r[0] = alpha * pg8::bflo(xv.x); r[1] = alpha * pg8::bfhi(xv.x); r[2] = alpha * pg8::bflo(xv.y); r[3] = alpha * pg8::bfhi(xv.y); r = r + a; u32x2 w; w.x = cvt2(r[0], r[1]); w.y = cvt2(r[2], r[3]); *(u32x2*)(Yp + o) = w; }
    __device__ __forceinline__ void store(int unit, const f32x4 a0, const f32x4 a1, int m, int fq) const { const size_t o = (size_t)(MP + m) * D + 32 * unit + 4 * fq; one(o, a0); one(o + 16, a1); } };
struct SkKV { float *oks, *ovs; bf16 *ksb, *vsb;
    __device__ __forceinline__ int brow(int unit, int nb) const { return 32 * unit + 16 * nb; }
    __device__ __forceinline__ void one(int col, const f32x4 a, int m) const { const bool isv = col >= 1536; const int c = col - (isv ? 1536 : 0), b = m >> 4, t = m & 15;
        *(f32x4*)((isv ? ovs : oks) + (size_t)m * 1536 + c) = a; const unsigned w0 = cvt2(a[0], a[1]), w1 = cvt2(a[2], a[3]);
        const int hh_ = c >> 7, dd = c & 127;
        if (!isv) { u32x2 w; w.x = w0; w.y = w1; *(u32x2*)(ksb + ((size_t)(b * 12 + hh_) * 2080 + 2048 + t) * 128 + dd) = w; }
        else { bf16* vt = vsb + ((size_t)(b * 12 + hh_) * 65 + 64) * 4096 + pg8::vtf_d(dd) + pg8::vtf_k(t); vt[0] = (bf16)w0; vt[8] = (bf16)(w0 >> 16); vt[16] = (bf16)w1; vt[24] = (bf16)(w1 >> 16); } }
    __device__ __forceinline__ void store(int unit, const f32x4 a0, const f32x4 a1, int m, int fq) const { one(32 * unit + 4 * fq, a0, m); one(32 * unit + 16 + 4 * fq, a1, m); } };
struct SkSwiGLU { bf16* Hb;
    __device__ __forceinline__ int brow(int unit, int nb) const { const int c0 = 16 * unit; return (c0 >> 7) * 256 + (c0 & 127) + 128 * nb; }
    __device__ __forceinline__ void store(int unit, const f32x4 g, const f32x4 u, int m, int fq) const { float hv[4];
#pragma unroll
        for (int j = 0; j < 4; ++j) hv[j] = g[j] * __builtin_amdgcn_rcpf(1.0f + __expf(-g[j])) * u[j];
        u32x2 w; w.x = cvt2(hv[0], hv[1]); w.y = cvt2(hv[2], hv[3]); *(u32x2*)(Hb + (size_t)(MP + m) * DFF + 16 * unit + 4 * fq) = w; } };
template <class Epi>
__device__ __forceinline__ void skinny_gemm(int bid, int G, int tid, int wave, LAS unsigned char* lds, const bf16* A, int lda, const bf16* Bt, int K, int nunits, const Epi& E) {
    const int lane = tid & 63, fr = lane & 15, fq = lane >> 4, kw = K >> 3, nst = kw >> 5;
    LAS f32x4* red = (LAS f32x4*)lds;
    for (int item = bid; item < 4 * nunits; item += G) {
        const int unit = item >> 2, rg = item & 3;
        const bf16* ap = A + (size_t)(32 * rg + fr) * lda + wave * kw + 8 * fq;
        const bf16* bp0 = Bt + (size_t)(E.brow(unit, 0) + fr) * K + wave * kw + 8 * fq; const bf16* bp1 = Bt + (size_t)(E.brow(unit, 1) + fr) * K + wave * kw + 8 * fq;
        f32x4 acc[2][2];
#pragma unroll
        for (int nb = 0; nb < 2; ++nb)
#pragma unroll
            for (int rt = 0; rt < 2; ++rt) acc[nb][rt] = (f32x4){0.f, 0.f, 0.f, 0.f};
        bf16x8 a0[4][2], b0[4][2], a1[4][2], b1[4][2];
#define SK_LOAD(af, bfr, g) do { _Pragma("unroll") for (int q = 0; q < 4; ++q) { const int st = 4 * (g) + q; if (st < nst) { \
            af[q][0] = ld16(ap + 32 * st); af[q][1] = ld16(ap + (size_t)16 * lda + 32 * st); bfr[q][0] = ld16(bp0 + 32 * st); bfr[q][1] = ld16(bp1 + 32 * st); } } } while (0)
#define SK_MMA(af, bfr, g) do { _Pragma("unroll") for (int q = 0; q < 4; ++q) { if (4 * (g) + q < nst) { _Pragma("unroll") for (int rt = 0; rt < 2; ++rt) { \
            acc[0][rt] = MFMA16(bfr[q][0], af[q][rt], acc[0][rt]); acc[1][rt] = MFMA16(bfr[q][1], af[q][rt], acc[1][rt]); } } } } while (0)
        const int ng = (nst + 3) >> 2;
        SK_LOAD(a0, b0, 0);
#pragma unroll 1
        for (int g = 0; g < ng; g += 2) {
            if (g + 1 < ng) SK_LOAD(a1, b1, g + 1);
            __builtin_amdgcn_sched_barrier(0);
            SK_MMA(a0, b0, g);
            __builtin_amdgcn_sched_barrier(0);
            if (g + 2 < ng) SK_LOAD(a0, b0, g + 2);
            __builtin_amdgcn_sched_barrier(0);
            if (g + 1 < ng) SK_MMA(a1, b1, g + 1);
            __builtin_amdgcn_sched_barrier(0);
        }
#undef SK_LOAD
#undef SK_MMA
#pragma unroll
        for (int nb = 0; nb < 2; ++nb)
#pragma unroll
            for (int rt = 0; rt < 2; ++rt) red[((wave * 2 + nb) * 2 + rt) * 64 + lane] = acc[nb][rt];
        __syncthreads();
        if (wave < 2) {
            f32x4 s0 = {0.f, 0.f, 0.f, 0.f}, s1 = {0.f, 0.f, 0.f, 0.f};
#pragma unroll
            for (int ws = 0; ws < 8; ++ws) { s0 = s0 + red[((ws * 2 + 0) * 2 + wave) * 64 + lane]; s1 = s1 + red[((ws * 2 + 1) * 2 + wave) * 64 + lane]; }
            E.store(unit, s0, s1, 32 * rg + 16 * wave + fr, fq);
        }
        __syncthreads();
    }
}
#ifndef PH_MASK
#define PH_MASK 0xFFFF
#endif
__global__ void __launch_bounds__(NWAVES * 64, 2) mega(Args args) {
    extern __shared__ __attribute__((aligned(16))) unsigned char lds[];
    Frame F;
    F.lds = (LAS unsigned char*)lds; F.MISC = (volatile LAS unsigned*)(F.lds + MISC_OFF);
    F.tid = threadIdx.x; F.lane = F.tid & 63; F.wave = __builtin_amdgcn_readfirstlane(F.tid >> 6);
    F.G = gridDim.x; F.gw = blockIdx.x * NWAVES + F.wave; F.NGW = F.G * NWAVES;
    F.ctl = (gu32*)(args.ws_ + WS_CTL);
    for (int u = F.tid; u < (LDS_BYTES - LDSCTL_OFF) / 4; u += NWAVES * 64) ((LAS unsigned*)(F.lds + LDSCTL_OFF))[u] = 0u;
    __syncthreads();
    XcdBarrier bar = xcd_barrier_post((unsigned*)(F.ctl + CW_BAR), F.MISC + 8);
    const int lo = args.ph_lo, hi = args.ph_hi; int ph = 0;
#define KARGS ((const __attribute__((address_space(4))) Args*)__builtin_amdgcn_kernarg_segment_ptr())
#define ws (ka->ws_)
#define out (ka->out_)
#define x_prompt (ka->in[0])
#define x_sample (ka->in[1])
#define mem_prompt (ka->in[2])
#define state_gla (ka->in[3])
#define cache_sb_k (ka->in[4])
#define cache_sb_v (ka->in[5])
#define cache_mem_k (ka->in[6])
#define cache_mem_v (ka->in[7])
#define w_in_a (ka->in[8])
#define w_gate_lr (ka->in[9])
#define b_gate (ka->in[10])
#define gla_norm_g (ka->in[11])
#define w_in_b (ka->in[12])
#define w_kv_shared (ka->in[13])
#define w_mem_kv (ka->in[14])
#define w_o (ka->in[15])
#define ln1_g (ka->in[16])
#define ln1_b (ka->in[17])
#define ln2_g (ka->in[18])
#define ln2_b (ka->in[19])
#define w_ffn_in (ka->in[20])
#define w_ffn_out (ka->in[21])
#define WIN ((bf16*)(ws + WS_WIN))
#define WO ((bf16*)(ws + WS_WO))
#define WFI ((bf16*)(ws + WS_WFI))
#define WFO ((bf16*)(ws + WS_WFO))
#define WMEM ((bf16*)(ws + WS_WMEM))
#define MEMX ((bf16*)(ws + WS_MEMX))
#define MEMK ((bf16*)(ws + WS_MEMK))
#define MEMV ((bf16*)(ws + WS_MEMV))
#define X ((bf16*)(ws + WS_X))
#define Y ((float*)(ws + WS_Y))
#define YB ((bf16*)(ws + WS_Y))
#define PROJ ((bf16*)(ws + WS_R1))
#define HB ((bf16*)(ws + WS_R1))
#define OCAT ((bf16*)(ws + WS_OCAT))
#define SBKS ((bf16*)(ws + WS_SBKS))
#define SBVS ((bf16*)(ws + WS_SBVS))
#define OINT (out + O_YP)
#define KPB ((bf16*)(out + O_YP))
#define VPB (KPB + (size_t)MP * 1536)

#define PHASE_BEGIN(cond, cls) if (cond) { if (lo <= ph && ph < hi) { if (ph > lo) { xcd_barrier(bar); if (BAR_REP > 1) xcd_barrier(bar); } DIAG_STAMP(cls); for (int rep_ = 0; rep_ < (((cls) == REP_CLS) ? 2 : 1); ++rep_) { const __attribute__((address_space(4))) Args* ka = KARGS; asm volatile("" : "+s"(ka)); int z_ = 0, G_ = gridDim.x, bid_ = blockIdx.x, wave_ = F.wave; asm volatile("" : "+s"(z_), "+s"(G_), "+s"(bid_), "+s"(wave_)); const int lane = (int)__builtin_amdgcn_mbcnt_hi(~0u, __builtin_amdgcn_mbcnt_lo(~0u, (unsigned)z_)), tid = wave_ * 64 + lane, gw_ = bid_ * NWAVES + wave_, NGW_ = G_ * NWAVES;     (void)tid; (void)lane; (void)gw_; (void)NGW_;
#define PHASE_END } } ++ph; }
#ifndef REP_CLS
#define REP_CLS (-1)
#endif
#ifndef SK_REP
#define SK_REP 1
#endif
#ifndef MEM_REP
#define MEM_REP 1
#endif
#ifndef BAR_REP
#define BAR_REP 1
#endif
#ifndef STAG
#define STAG 0
#endif
#ifndef SB_REP
#define SB_REP 1
#endif
#if defined(DIAG_A)
#define DIAG_STAMP(cls) do { if (blockIdx.x == 0 && threadIdx.x == 0) { unsigned long long* dts = (unsigned long long*)(args.ws_ + 262144); dts[ph] = rt(); } } while (0)
#else
#define DIAG_STAMP(cls) do { } while (0)
#endif

#define CONVERT_WEIGHTS(LL) do { const int ll_ = (LL); \
            if (ll_ < 2) wt_convert(F.lds, wave_, gw_, NGW_, lane, w_in_a + (size_t)ll_ * D * 5136, D, 5136, WIN, NA, MapInA()); \
            else { wt_convert(F.lds, wave_, gw_, NGW_, lane, w_in_b + (size_t)(ll_ - 2) * D * NBQ, D, NBQ, WIN, NBQ, MapId()); if (ll_ == 2) wt_convert(F.lds, wave_, gw_, NGW_, lane, w_kv_shared, D, NKV, WIN + (size_t)NBQ * D, NKV, MapId()); } \
            wt_convert(F.lds, wave_, gw_, NGW_, lane, w_o + (size_t)ll_ * D * D, D, D, WO, D, MapId()); \
            wt_convert(F.lds, wave_, gw_, NGW_, lane, w_ffn_in + (size_t)ll_ * D * 2 * DFF, D, 2 * DFF, WFI, 2 * DFF, MapFfn()); \
            wt_convert(F.lds, wave_, gw_, NGW_, lane, w_ffn_out + (size_t)ll_ * DFF * D, DFF, D, WFO, D, MapId()); } while (0)
    PHASE_BEGIN(true, 0)
        for (int r = 2 * gw_; r < MT; r += 2 * NGW_) { const float* s0 = r < MP ? x_prompt + (size_t)r * D : (r < MR ? x_sample + (size_t)(r - MP) * D : nullptr);
            cvt_rows2<D>(s0, s0 ? s0 + D : nullptr, X + (size_t)r * D, X + (size_t)(r + 1) * D, lane); }
        for (int r = 2 * gw_; r < 1024; r += 2 * NGW_) cvt_rows2<D>(mem_prompt + (size_t)r * D, mem_prompt + (size_t)(r + 1) * D, MEMX + (size_t)r * D, MEMX + (size_t)(r + 1) * D, lane);
        for (int r = gw_; r < 4 * 8 * 256; r += NGW_) { const int l = r >> 11, b = (r >> 8) & 7, m = r & 255; const size_t dst = (size_t)((l * 12 + 4 + b) * 256 + m) * 512;
            cvt_row(cache_mem_k + (size_t)r * 512, MEMK + dst, 512, lane); }
        for (int it = gw_; it < 512; it += NGW_) { const int hdb = it & 3, mb = (it >> 2) & 3, b = (it >> 4) & 7, l = it >> 7, m = mb * 64 + lane;
            const float* src = cache_mem_v + (size_t)((l * 8 + b) * 256 + m) * 512 + hdb * 128; bf16* dst = MEMV + (size_t)((l * 12 + 4 + b) * 512 + hdb * 128) * 256 + m;
            for (int q4 = 0; q4 < 32; ++q4) { const f32x4 v = *(const f32x4*)(src + 4 * q4);
#pragma unroll
                for (int e = 0; e < 4; ++e) dst[(size_t)(4 * q4 + e) * 256] = (bf16)f2bf(v[e]); } }
        for (int r = gw_; r < 8 * 2048; r += NGW_) { const int b = r >> 11, s = r & 2047; const float* src = cache_sb_k + (size_t)r * 1536;
            f32x4 v[6];
#pragma unroll
            for (int q = 0; q < 6; ++q) v[q] = *(const f32x4*)(src + lane * 4 + 256 * q);
#pragma unroll
            for (int q = 0; q < 6; ++q) { const int j = lane * 4 + 256 * q;
                *(unsigned long long*)(SBKS + ((size_t)(b * 12 + (j >> 7)) * 2080 + s) * 128 + (j & 127)) = (unsigned long long)pk2(v[q].x, v[q].y) | ((unsigned long long)pk2(v[q].z, v[q].w) << 32); } }
        for (int it = gw_; it < 3072; it += NGW_) { const int cb = it % 12, sb_ = (it / 12) & 31, b = it / 384, s = sb_ * 64 + lane;
            const float* src = cache_sb_v + (size_t)(b * 2048 + s) * 1536 + cb * 128; bf16* dst = SBVS + ((size_t)(b * 12 + cb) * 65 + (s >> 5)) * 4096 + pg8::vtf_k(s & 31);
            for (int q8 = 0; q8 < 32; q8 += 8) { f32x4 v[8];
#pragma unroll
                for (int q = 0; q < 8; ++q) v[q] = *(const f32x4*)(src + 4 * (q8 + q));
#pragma unroll
                for (int q = 0; q < 8; ++q)
#pragma unroll
                    for (int e = 0; e < 4; ++e) dst[pg8::vtf_d(4 * (q8 + q) + e)] = (bf16)f2bf(v[q][e]); } }
        for (int l = 0; l < 4; ++l) wt_convert(F.lds, wave_, gw_, NGW_, lane, w_mem_kv + (size_t)l * D * 1024, D, 1024, WMEM + (size_t)l * 1024 * D, 1024, MapId());
        CONVERT_WEIGHTS(0);
    PHASE_END
    for (int l = 0; l < 4; ++l) {
        const bool LA = l < 2;
        const int ldp = LA ? NA : NBQ;
        PHASE_BEGIN(true, 2)
            if (!LA && (bid_ & 1)) { { SkBf16 E{PROJ, ldp}; skinny_gemm(bid_, G_, FRESH_TID(), wave_, F.lds + RING_OFF, X + (size_t)MP * D, D, WIN, D, ldp / 32, E); }
                if (l == 2) { SkKV E{out + O_SKS, out + O_SVS, SBKS, SBVS}; skinny_gemm(bid_, G_, FRESH_TID(), wave_, F.lds + RING_OFF, X + (size_t)MP * D, D, WIN + (size_t)NBQ * D, D, NKV / 32, E); } }
            { pg8::Gemm g{X, WIN, MP, ldp, D}; pg8::StaticOrder S; S.init(MP, ldp, G_, bid_); pg8::EpiBf16 E{PROJ, ldp};
              pg8::gemm_phase<pg8::EpiBf16, pg8::StaticOrder, true, true>(F.lds + RING_OFF, g, S, E, FRESH_TID()); }
            if (l == 0 && bid_ >= (G_ >> 1) && bid_ < (G_ >> 1) + 64) { pg8::Gemm g{MEMX, WMEM, 1024, 4096, D}; pg8::StaticOrder S; S.init(1024, 4096, 64, bid_ - (G_ >> 1));
              pg8::EpiMemKV E{out + O_MKP, out + O_MVP, MEMK, MEMV};
              pg8::gemm_phase<pg8::EpiMemKV, pg8::StaticOrder, true, true>(F.lds + RING_OFF, g, S, E, FRESH_TID()); }
            if (l == 2) { pg8::Gemm g{X, WIN + (size_t)NBQ * D, MP, NKV, D}; pg8::StaticOrder S; S.init(MP, NKV, G_, bid_);
              pg8::EpiKV E{out + O_SKP, out + O_SVP, out + O_SKS, out + O_SVS, KPB, VPB, SBKS, SBVS};
              pg8::gemm_phase<pg8::EpiKV, pg8::StaticOrder, true, true>(F.lds + RING_OFF, g, S, E, FRESH_TID()); }
            if (LA) { if (bid_ >= (G_ >> 1)) { SkBf16 E{PROJ, ldp}; skinny_gemm(bid_ - (G_ >> 1), G_ >> 1, FRESH_TID(), wave_, F.lds + RING_OFF, X + (size_t)MP * D, D, WIN, D, ldp / 32, E); } }
            else if (!(bid_ & 1))
            for (int skr = 0; skr < SK_REP; ++skr) { SkBf16 E{PROJ, ldp}; skinny_gemm(bid_, G_, FRESH_TID(), wave_, F.lds + RING_OFF, X + (size_t)MP * D, D, WIN, D, ldp / 32, E); }
            if (!(bid_ & 1))
            for (int skr = 0; skr < SK_REP; ++skr) if (l == 2) { SkKV E{out + O_SKS, out + O_SVS, SBKS, SBVS}; skinny_gemm(bid_, G_, FRESH_TID(), wave_, F.lds + RING_OFF, X + (size_t)MP * D, D, WIN + (size_t)NBQ * D, D, NKV / 32, E); }
        PHASE_END
        PHASE_BEGIN(LA, 3)
            gla_prep_intra(bid_, G_, tid, wave_, F.lds + RING_OFF, l, PROJ, w_gate_lr, b_gate, (unsigned char*)Y, OINT);
        PHASE_END
        PHASE_BEGIN(!LA, 11)
            {
#if defined(SB_MODE)
                for (int u = gw_; u < 12288; u += NGW_) { const int bh = u >> 8, qb = u & 255, b = bh / 12, h = bh % 12, t0 = 32 * qb; const size_t qo = (size_t)(b * SEQ + t0) * D + h * 128;
                    sb_attn<SB_MODE>(lane, F.lds + RING_OFF + wave_ * 16384, KPB + (size_t)bh * SEQ * 128, 128, VPB + (size_t)bh * SEQ * 128, 0, PROJ + qo, NBQ, OCAT + qo, t0, 32); }
#endif
                for (int sbr = 0; sbr < SB_REP; ++sbr)
                for (int u = gw_; u < 12288 + 96; u += NGW_) {
                    if (u < 12288) { const int bh = u >> 8, qb = u & 255, b = bh / 12, h = bh % 12, t0 = 32 * qb; const size_t qo = (size_t)(b * SEQ + t0) * D + h * 128;
                        sb_attn(lane, F.lds + RING_OFF + wave_ * 16384, KPB + (size_t)bh * SEQ * 128, 128, VPB + (size_t)bh * SEQ * 128, 0, PROJ + qo, NBQ, OCAT + qo, t0, 32); }
                    else { const int u2 = u - 12288, b = u2 / 12, h = u2 % 12; const size_t qo = (size_t)(MP + b * 16) * D + h * 128;
                        sb_attn(lane, F.lds + RING_OFF + wave_ * 16384, SBKS + (size_t)u2 * 2080 * 128, 128, SBVS + (size_t)u2 * 65 * 4096, 0, PROJ + qo, NBQ, OCAT + qo, 2048, 16); }
                }
            }
            __syncthreads();
            for (int mr = 0; mr < MEM_REP; ++mr)
            for (int wi = bid_; wi < 256 + 32; wi += G_) mem_attn_wg(wi, FRESH_TID(), wave_, F.lds + RING_OFF, l, PROJ, ldp, LA ? CQM : 1536, MEMK, MEMV, OCAT);
        PHASE_END
        PHASE_BEGIN(LA, 12)
            if (G_ == 256) { if (bid_ >= 144) { mem_attn_wg(bid_ - 144, FRESH_TID(), wave_, F.lds + RING_OFF, l, PROJ, ldp, CQM, MEMK, MEMV, OCAT); mem_attn_wg(bid_ - 144 + 112, FRESH_TID(), wave_, F.lds + RING_OFF, l, PROJ, ldp, CQM, MEMK, MEMV, OCAT); } }
            else for (int wi = bid_; wi < 256 + 32; wi += G_) mem_attn_wg(wi, FRESH_TID(), wave_, F.lds + RING_OFF, l, PROJ, ldp, CQM, MEMK, MEMV, OCAT);
            for (int wc = bid_; wc < 144; wc += G_) gla_chain<1>(wc, FRESH_TID(), wave_, F.lds + RING_OFF, l, (const unsigned char*)Y, state_gla, OINT, out, (float*)WMEM, (float*)MEMX);
            if (G_ == 256 && bid_ < 64) mem_attn_wg(224 + bid_, FRESH_TID(), wave_, F.lds + RING_OFF, l, PROJ, ldp, CQM, MEMK, MEMV, OCAT);
        PHASE_END
        PHASE_BEGIN(LA, 5)
            for (int wc = bid_; wc < 192 + 96; wc += G_) gla_chain<2>(wc, FRESH_TID(), wave_, F.lds + RING_OFF, l, (const unsigned char*)Y, state_gla, OINT, out, (float*)WMEM, (float*)MEMX, REP_CLS == 5 && rep_ == 0);
        PHASE_END
        PHASE_BEGIN(LA, 6)
            const float* gn = gla_norm_g + (size_t)l * 384;
            for (int row = gw_; row < MR; row += NGW_) {
                const float* op = OINT + (size_t)row * 1536 + 24 * lane; const bf16* gp = PROJ + (size_t)row * NA + CG + 24 * lane; const float* gnp = gn + 24 * (lane & 15);
                f32x4 ov[6]; v4u gv[3]; float ss = 0.f;
#pragma unroll
                for (int j = 0; j < 6; ++j) { ov[j] = *(const f32x4*)(op + 4 * j); ss += (ov[j].x * ov[j].x + ov[j].y * ov[j].y) + (ov[j].z * ov[j].z + ov[j].w * ov[j].w); }
#pragma unroll
                for (int j = 0; j < 3; ++j) gv[j] = *(const v4u*)(gp + 8 * j);
                ss += shx(ss, lane, 1); ss += shx(ss, lane, 2); ss += shx(ss, lane, 4); ss += shx(ss, lane, 8);
                const float r = 1.0f / sqrtf(ss * (1.0f / 384.0f) + RMS_EPS);
#pragma unroll
                for (int j = 0; j < 3; ++j) { const f32x4 n0 = *(const f32x4*)(gnp + 8 * j), n1 = *(const f32x4*)(gnp + 8 * j + 4); const f32x4 a = ov[2 * j], b = ov[2 * j + 1];
                    float gt[8]; gt[0] = pg8::bflo(gv[j].x); gt[1] = pg8::bfhi(gv[j].x); gt[2] = pg8::bflo(gv[j].y); gt[3] = pg8::bfhi(gv[j].y); gt[4] = pg8::bflo(gv[j].z); gt[5] = pg8::bfhi(gv[j].z); gt[6] = pg8::bflo(gv[j].w); gt[7] = pg8::bfhi(gv[j].w);
                    float o8[8];
#pragma unroll
                    for (int i = 0; i < 4; ++i) { o8[i] = a[i] * r * n0[i] * (gt[i] * __builtin_amdgcn_rcpf(1.0f + __expf(-gt[i]))); o8[4 + i] = b[i] * r * n1[i] * (gt[4 + i] * __builtin_amdgcn_rcpf(1.0f + __expf(-gt[4 + i]))); }
                    v4u o; o.x = pk2(o8[0], o8[1]); o.y = pk2(o8[2], o8[3]); o.z = pk2(o8[4], o8[5]); o.w = pk2(o8[6], o8[7]);
                    *(v4u*)(OCAT + (size_t)row * D + 24 * lane + 8 * j) = o; }
            }
        PHASE_END
        PHASE_BEGIN(true, 7)
            if (bid_ & 1) { SkRes Es{YB, X, DN_ALPHA}; skinny_gemm(bid_, G_, FRESH_TID(), wave_, F.lds + RING_OFF, OCAT + (size_t)MP * D, D, WO, D, D / 32, Es); }
            pg8::Gemm g{OCAT, WO, MP, D, D}; pg8::StaticOrder S; S.init(MP, D, G_, bid_); pg8::EpiRes E{YB, X, D, DN_ALPHA};
            pg8::gemm_phase<pg8::EpiRes, pg8::StaticOrder, true, true>(F.lds + RING_OFF, g, S, E, FRESH_TID());
            if (!(bid_ & 1))
            for (int skr = 0; skr < SK_REP; ++skr) { SkRes Es{YB, X, DN_ALPHA}; skinny_gemm(bid_, G_, FRESH_TID(), wave_, F.lds + RING_OFF, OCAT + (size_t)MP * D, D, WO, D, D / 32, Es); }
        PHASE_END
        PHASE_BEGIN(true, 8)
            const float* gg = ln1_g + (size_t)l * D; const float* bb = ln1_b + (size_t)l * D;
            for (int row = 2 * gw_; row < MR; row += 2 * NGW_) ln_two_rows<false>(lane, YB + (size_t)row * D, YB + (size_t)(row + 1) * D, gg, bb, X + (size_t)row * D, X + (size_t)(row + 1) * D, nullptr, nullptr);
        PHASE_END
        PHASE_BEGIN(true, 9)
            for (int dl = 0; dl < 3 * STAG * (bid_ >> 1 & 3); ++dl) __builtin_amdgcn_s_sleep(127);
            if (bid_ & 1) { SkSwiGLU Es{HB}; skinny_gemm(bid_, G_, FRESH_TID(), wave_, F.lds + RING_OFF, X + (size_t)MP * D, D, WFI, D, DFF / 16, Es); }
            pg8::Gemm g{X, WFI, MP, 2 * DFF, D}; pg8::StaticOrder S; S.init(MP, 2 * DFF, G_, bid_); pg8::EpiSwiGLU E{HB, DFF};
            pg8::gemm_phase<pg8::EpiSwiGLU, pg8::StaticOrder, true, true>(F.lds + RING_OFF, g, S, E, FRESH_TID());
            if (!(bid_ & 1))
            for (int skr = 0; skr < SK_REP; ++skr) { SkSwiGLU Es{HB}; skinny_gemm(bid_, G_, FRESH_TID(), wave_, F.lds + RING_OFF, X + (size_t)MP * D, D, WFI, D, DFF / 16, Es); }
        PHASE_END
        PHASE_BEGIN(true, 10)
            if (bid_ & 1) { SkRes Es{YB, X, DN_ALPHA}; skinny_gemm(bid_, G_, FRESH_TID(), wave_, F.lds + RING_OFF, HB + (size_t)MP * DFF, DFF, WFO, DFF, D / 32, Es); }
            pg8::Gemm g{HB, WFO, MP, D, DFF}; pg8::StaticOrder S; S.init(MP, D, G_, bid_); pg8::EpiRes E{YB, X, D, DN_ALPHA};
            pg8::gemm_phase<pg8::EpiRes, pg8::StaticOrder, true, true>(F.lds + RING_OFF, g, S, E, FRESH_TID());
            if (!(bid_ & 1))
            for (int skr = 0; skr < SK_REP; ++skr) { SkRes Es{YB, X, DN_ALPHA}; skinny_gemm(bid_, G_, FRESH_TID(), wave_, F.lds + RING_OFF, HB + (size_t)MP * DFF, DFF, WFO, DFF, D / 32, Es); }
        PHASE_END
        PHASE_BEGIN(true, 8)
            if (l < 3) CONVERT_WEIGHTS(l + 1);
            const float* gg = ln2_g + (size_t)l * D; const float* bb = ln2_b + (size_t)l * D;
            if (l == 3) { for (int row = 2 * gw_; row < MR; row += 2 * NGW_) { float* of = row < MP ? out + O_YP + (size_t)row * D : out + O_YS + (size_t)(row - MP) * D;
                ln_two_rows<true>(lane, YB + (size_t)row * D, YB + (size_t)(row + 1) * D, gg, bb, nullptr, nullptr, of, of + D); } }
            else for (int row = 2 * gw_; row < MR; row += 2 * NGW_) ln_two_rows<false>(lane, YB + (size_t)row * D, YB + (size_t)(row + 1) * D, gg, bb, X + (size_t)row * D, X + (size_t)(row + 1) * D, nullptr, nullptr);
        PHASE_END
    }
#if defined(DIAG_A)
    if (blockIdx.x == 0 && threadIdx.x == 0) { unsigned long long* dts = (unsigned long long*)(args.ws_ + 262144); dts[ph] = rt(); dts[63] = (unsigned long long)ph; }
#endif
#undef ws
#undef out
#undef X
#undef Y
#undef YB
#undef CONVERT_WEIGHTS
#undef PHASE_BEGIN
#undef PHASE_END
}

#if defined(DIAG_A)
__device__ const int diag_cls[40] = {0,0, 1,2,3,4,5,6,7,8,9,10,8, 1,2,3,4,5,6,7,8,9,10,8, 1,2,11,7,8,9,10,8, 1,2,11,7,8,9,10,8};
__global__ void diag_tail(float* o, const unsigned long long* dts) {
    __shared__ float dv[2];
    if (threadIdx.x == 0) { const int n = (int)dts[63]; unsigned long long sa = 0, sb = 0; for (int p = 0; p < n; ++p) { const unsigned long long d = dts[p + 1] - dts[p]; const int cl = diag_cls[p]; if (cl == DIAG_A) sa += d; if (cl == DIAG_B) sb += d; }
        dv[0] = (float)sa * 0.01f; dv[1] = (float)sb * 10.0f; }
    __syncthreads();
    for (int i = threadIdx.x; i < 262144; i += blockDim.x) o[O_YS + i] = dv[0];
    if (threadIdx.x == 0) o[O_YP] = dv[1];
}
#endif
#ifndef MK_PER_PHASE
#define MK_PER_PHASE 0
#endif
constexpr int N_PHASES = 1 + 2 * 10 + 2 * 7;
extern "C" void kernel_launch(void* const* d_in, const int* in_sizes, int n_in, void* d_out, int out_size, void* d_ws, size_t ws_size, hipStream_t stream) {
    static int grid = 0;
    if (grid == 0) {
        if (n_in != 22 || in_sizes[0] != MP * D || (size_t)out_size != O_END || ws_size < WS_END) { fprintf(stderr, "kernel_launch: unexpected shapes (n_in %d, in0 %d, out %d, ws %zu); nothing launched\n", n_in, n_in > 0 ? in_sizes[0] : -1, out_size, ws_size); grid = -1; return; }
        int dev = 0, cus = 0, per_cu = 0;
        if (hipGetDevice(&dev) != hipSuccess || hipDeviceGetAttribute(&cus, hipDeviceAttributeMultiprocessorCount, dev) != hipSuccess) { grid = -1; return; }
        if (hipFuncSetAttribute((const void*)mega, hipFuncAttributeMaxDynamicSharedMemorySize, LDS_BYTES) != hipSuccess) { fprintf(stderr, "kernel_launch: hipFuncSetAttribute failed\n"); grid = -1; return; }
        if (hipOccupancyMaxActiveBlocksPerMultiprocessor(&per_cu, (const void*)mega, NWAVES * 64, LDS_BYTES) != hipSuccess || per_cu < 1) fprintf(stderr, "kernel_launch: occupancy query reports %d\n", per_cu);
        (void)hipGetLastError();
        grid = cus;
    }
    if (grid < 0) return;
    if (hipMemsetAsync((char*)d_ws + WS_CTL, 0, CTL_ZERO_BYTES, stream) != hipSuccess) return;
    Args a{};
    for (int i = 0; i < 22; ++i) a.in[i] = (const float*)d_in[i];
    a.out_ = (float*)d_out; a.ws_ = (unsigned char*)d_ws;
#if MK_PER_PHASE
    for (int p = 0; p < N_PHASES; ++p) { a.ph_lo = p; a.ph_hi = p + 1; hipLaunchKernelGGL(mega, dim3(grid), dim3(NWAVES * 64), LDS_BYTES, stream, a); }
#else
    a.ph_lo = 0; a.ph_hi = N_PHASES; hipLaunchKernelGGL(mega, dim3(grid), dim3(NWAVES * 64), LDS_BYTES, stream, a);
#if defined(DIAG_A)
    hipLaunchKernelGGL(diag_tail, dim3(1), dim3(512), 0, stream, (float*)d_out, (const unsigned long long*)((unsigned char*)d_ws + 262144));
#endif
#endif
}
```

```cpp
#include <hip/hip_runtime.h>
#include <cstdio>
#include <cstdint>
namespace pg8 {
#define PG8_LAS __attribute__((address_space(3)))
typedef unsigned short bf16_t;
typedef short bf16x8 __attribute__((ext_vector_type(8)));
typedef float f32x4 __attribute__((ext_vector_type(4)));
typedef unsigned u32x4 __attribute__((ext_vector_type(4)));
constexpr int BM = 256, BK = 64, HALF = 128, HTB = HALF * BK * 2  , STAGE_BYTES = 8 * HTB, NXCD = 8, WGM = 4;

__host__ __device__ __forceinline__ int lds_byte(int r, int c) { const int st = (r >> 4) * 2 + (c >> 5), rr = r & 15, cc = c & 31, ob = rr * 64 + cc * 2; return st * 1024 + (ob ^ (((ob >> 9) & 1) << 5)); }
__host__ __device__ __forceinline__ void stage_rc(int b, int& R, int& C) { const int st = b / 1024, sb = b % 1024, swz = sb ^ (((sb >> 9) & 1) << 5); R = (st >> 1) * 16 + swz / 64; C = (st & 1) * 32 + (swz % 64) / 2; }
__host__ __device__ __forceinline__ int perm32(int rho) { const int n = rho >> 4, i = rho & 15; return 8 * (i >> 2) + 4 * n + (i & 3); }

struct Unit { int pm, pn; };
struct Gemm { const bf16_t* A; const bf16_t* Bt; int M, N, K; };

struct StaticOrder {
    int nM, nN, nwg, G, c;
    __host__ __device__ void init(int M, int N, int G_, int c_) { nM = M / BM; nN = N / BM; nwg = nM * nN; G = G_; c = c_; }
    __host__ __device__ bool next(int i, Unit& u) const {
        const long L = (long)i * G + c; if (L >= nwg) return false;
        int wgid = (int)L; { const int q = nwg / NXCD, r = nwg % NXCD, xcd = wgid % NXCD, off = wgid / NXCD; wgid = (xcd < r ? xcd * (q + 1) : r * (q + 1) + (xcd - r) * q) + off; }
        const int nig = WGM * nN, gid = wgid / nig, fm = gid * WGM, gsz = (nM - fm) < WGM ? (nM - fm) : WGM;
        u.pm = fm + ((wgid % nig) % gsz); u.pn = (wgid % nig) / gsz; return true;
    }
    __device__ __forceinline__ void a_ready(const Unit&) const {}
    __device__ __forceinline__ void done(const Unit&) const {}
};
__device__ __forceinline__ unsigned cvt_pk_bf16(float lo, float hi) { unsigned r; asm volatile("v_cvt_pk_bf16_f32 %0, %1, %2" : "=v"(r) : "v"(lo), "v"(hi)); return r; }
typedef float f32x2 __attribute__((ext_vector_type(2)));
typedef unsigned u32x2 __attribute__((ext_vector_type(2)));
__host__ __device__ __forceinline__ int vtf_d(int d) { return (d >> 5) * 1024 + (d & 31) * 8; }
__host__ __device__ __forceinline__ int vtf_k(int ks) { return (ks >> 4) * 512 + ((ks >> 2) & 1) * 256 + (ks & 3) + 4 * ((ks >> 3) & 1); }
__device__ __forceinline__ float bflo(unsigned w) { return __builtin_bit_cast(float, w << 16); }
__device__ __forceinline__ float bfhi(unsigned w) { return __builtin_bit_cast(float, w & 0xffff0000u); }
struct EpiBf16 {
    static constexpr bool PERM = true, AFTER_DRAIN = false;
    bf16_t* O; int ldc;
    __device__ __forceinline__ void operator()(const f32x4 (&acc)[2][2][4][2], const Unit& u, int wr, int wc, int fr, int fq) const {
        const int row0 = u.pm * BM + wr * 64 + fr, col0 = u.pn * BM + wc * 32 + 8 * fq;
#pragma unroll
        for (int ai = 0; ai < 2; ++ai)
#pragma unroll
            for (int m = 0; m < 4; ++m) { bf16_t* rowp = O + (size_t)(row0 + ai * HALF + m * 16) * ldc + col0;
#pragma unroll
                for (int bj = 0; bj < 2; ++bj) { const f32x4 v0 = acc[ai][bj][m][0], v1 = acc[ai][bj][m][1];
                    u32x4 w; w.x = cvt_pk_bf16(v0[0], v0[1]); w.y = cvt_pk_bf16(v0[2], v0[3]); w.z = cvt_pk_bf16(v1[0], v1[1]); w.w = cvt_pk_bf16(v1[2], v1[3]);
                    *(u32x4*)(rowp + bj * HALF) = w; } }
    }
};
struct EpiSwiGLU {
    static constexpr bool PERM = true, AFTER_DRAIN = false;
    bf16_t* Hh; int ldh;
    __device__ __forceinline__ float swi(float g, float up) const { return g * __builtin_amdgcn_rcpf(1.0f + __expf(-g)) * up; }
    __device__ __forceinline__ void operator()(const f32x4 (&acc)[2][2][4][2], const Unit& u, int wr, int wc, int fr, int fq) const {
        const int row0 = u.pm * BM + wr * 64 + fr, col0 = u.pn * HALF + wc * 32 + 8 * fq;
#pragma unroll
        for (int ai = 0; ai < 2; ++ai)
#pragma unroll
            for (int m = 0; m < 4; ++m) { bf16_t* rowp = Hh + (size_t)(row0 + ai * HALF + m * 16) * ldh + col0;
                const f32x4 g0 = acc[ai][0][m][0], g1 = acc[ai][0][m][1], u0 = acc[ai][1][m][0], u1 = acc[ai][1][m][1];
                u32x4 w; w.x = cvt_pk_bf16(swi(g0[0], u0[0]), swi(g0[1], u0[1])); w.y = cvt_pk_bf16(swi(g0[2], u0[2]), swi(g0[3], u0[3]));
                w.z = cvt_pk_bf16(swi(g1[0], u1[0]), swi(g1[1], u1[1])); w.w = cvt_pk_bf16(swi(g1[2], u1[2]), swi(g1[3], u1[3]));
                *(u32x4*)rowp = w; }
    }
};
struct EpiRes {
    static constexpr bool PERM = true, AFTER_DRAIN = false;
    bf16_t* Y; const bf16_t* X; int ldc; float alpha;
    __device__ __forceinline__ void operator()(const f32x4 (&acc)[2][2][4][2], const Unit& u, int wr, int wc, int fr, int fq) const {
        const int row0 = u.pm * BM + wr * 64 + fr, col0 = u.pn * BM + wc * 32 + 8 * fq;
        u32x4 xv[2][4][2];
#pragma unroll
        for (int ai = 0; ai < 2; ++ai)
#pragma unroll
            for (int m = 0; m < 4; ++m)
#pragma unroll
                for (int bj = 0; bj < 2; ++bj) xv[ai][m][bj] = *(const u32x4*)(X + (size_t)(row0 + ai * HALF + m * 16) * ldc + col0 + bj * HALF);
#pragma unroll
        for (int ai = 0; ai < 2; ++ai)
#pragma unroll
            for (int m = 0; m < 4; ++m) { const size_t ro = (size_t)(row0 + ai * HALF + m * 16) * ldc + col0;
#pragma unroll
                for (int bj = 0; bj < 2; ++bj) { const u32x4 x4 = xv[ai][m][bj]; const f32x4 a0 = acc[ai][bj][m][0], a1 = acc[ai][bj][m][1];
                    u32x4 w; w.x = cvt_pk_bf16(alpha * bflo(x4.x) + a0[0], alpha * bfhi(x4.x) + a0[1]); w.y = cvt_pk_bf16(alpha * bflo(x4.y) + a0[2], alpha * bfhi(x4.y) + a0[3]);
                    w.z = cvt_pk_bf16(alpha * bflo(x4.z) + a1[0], alpha * bfhi(x4.z) + a1[1]); w.w = cvt_pk_bf16(alpha * bflo(x4.w) + a1[2], alpha * bfhi(x4.w) + a1[3]);
                    *(u32x4*)(Y + ro + bj * HALF) = w; } }
    }
};
struct EpiKV {
    static constexpr bool PERM = false, AFTER_DRAIN = false;
    float *okp, *ovp, *oks, *ovs; bf16_t *kpb, *vpb, *ksb, *vsb;
    __device__ __forceinline__ void operator()(const f32x4 (&acc)[2][2][4][2], const Unit& u, int wr, int wc, int fr, int fq) const {
        const bool isv = u.pn >= 6; const int colt = (u.pn - (isv ? 6 : 0)) * BM + wc * 32 + 4 * fq, row0 = u.pm * BM + wr * 64 + fr;
        float* op = isv ? ovp : okp;
#pragma unroll
        for (int ai = 0; ai < 2; ++ai)
#pragma unroll
            for (int m = 0; m < 4; ++m) { const int row = row0 + ai * HALF + m * 16; float* fd;
                if (row < 32768) { fd = op + (size_t)row * 1536; } else continue;
                const int bq = row >> 13, sq = row & 8191;
#pragma unroll
                for (int bj = 0; bj < 2; ++bj)
#pragma unroll
                    for (int n = 0; n < 2; ++n) { const int c = colt + bj * HALF + n * 16; const f32x4 v = acc[ai][bj][m][n];
                        *(f32x4*)(fd + c) = v; const unsigned w0 = cvt_pk_bf16(v[0], v[1]), w1 = cvt_pk_bf16(v[2], v[3]);
                        const int hq = c >> 7, dq = c & 127;
                        if (!isv) { u32x2 w; w.x = w0; w.y = w1; *(u32x2*)(kpb + ((size_t)(bq * 12 + hq) * 8192 + sq) * 128 + dq) = w; }
                        else { bf16_t* vt = vpb + ((size_t)(bq * 12 + hq) * 256 + (sq >> 5)) * 4096 + vtf_d(dq) + vtf_k(sq & 31); vt[0] = (bf16_t)w0; vt[8] = (bf16_t)(w0 >> 16); vt[16] = (bf16_t)w1; vt[24] = (bf16_t)(w1 >> 16); } } }
    }
};
struct EpiMemKV {
    static constexpr bool PERM = false, AFTER_DRAIN = false;
    float *ok, *ov; bf16_t *kb, *vb;
    __device__ __forceinline__ void operator()(const f32x4 (&acc)[2][2][4][2], const Unit& u, int wr, int wc, int fr, int fq) const {
        const int l = u.pn >> 2, kv = (u.pn >> 1) & 1, hd0 = (u.pn & 1) * BM + wc * 32 + 4 * fq, row0 = u.pm * BM + wr * 64 + fr;
        float* fo = kv ? ov : ok; bf16_t* bo = kv ? vb : kb;
#pragma unroll
        for (int ai = 0; ai < 2; ++ai)
#pragma unroll
            for (int m = 0; m < 4; ++m) { const int row = row0 + ai * HALF + m * 16, b = row >> 8, mm = row & 255;
                float* fd = fo + (size_t)(l * 1024 + row) * 512; bf16_t* bd = bo + (size_t)((l * 12 + b) * 256 + mm) * 512;
#pragma unroll
                for (int bj = 0; bj < 2; ++bj)
#pragma unroll
                    for (int n = 0; n < 2; ++n) { const int c = hd0 + bj * HALF + n * 16; const f32x4 v = acc[ai][bj][m][n];
                        *(f32x4*)(fd + c) = v; const unsigned w0 = cvt_pk_bf16(v[0], v[1]), w1 = cvt_pk_bf16(v[2], v[3]);
                        if (!kv) { u32x2 w; w.x = w0; w.y = w1; *(u32x2*)(bd + c) = w; }
                        else { bf16_t* vt = vb + (size_t)((l * 12 + b) * 512 + c) * 256 + mm;
                            vt[0] = (bf16_t)w0; vt[256] = (bf16_t)(w0 >> 16); vt[512] = (bf16_t)w1; vt[768] = (bf16_t)(w1 >> 16); } } }
    }
};
template <class Epi, class Sched, bool ALIGN_EPI = false, bool SP2 = false>
__device__ __forceinline__ void gemm_phase(PG8_LAS unsigned char* lds, const Gemm g, const Sched& S, const Epi& E, int tid_in) {
    int tid_ = tid_in; asm volatile("" : "+v"(tid_));
    const int tid = tid_, wid = __builtin_amdgcn_readfirstlane(tid >> 6), lane = tid & 63, wr = wid >> 2, wc = wid & 3, fr = lane & 15, fq = lane >> 4;
    const int K = g.K, nt = K / BK;
    unsigned voffA[2], voffB[2];
#pragma unroll
    for (int i = 0; i < 2; ++i) { int R, C; stage_rc(tid * 16 + i * 8192, R, C); const int Rb = Epi::PERM ? ((R & ~31) + perm32(R & 31)) : R;
        voffA[i] = (unsigned)(R * K + C) * 2u; voffB[i] = (unsigned)(Rb * K + C) * 2u; }
    const size_t kstep = (size_t)(BK * 2);
    const size_t hstep = (size_t)HALF * K * 2;
    const size_t tstep = 2 * hstep;
    const unsigned ldsw = (unsigned)wid * 1024u;
    const int aoff = lds_byte(wr * 64 + fr, fq * 8), boff = lds_byte(wc * 32 + fr, fq * 8);
#define PG8_SA(b, h) (((b) * 2 + (h)) * HTB)
#define PG8_SB(b, h) ((4 + (b) * 2 + (h)) * HTB)
#define PG8_STAGE_X(bufoff, gbase, voff, aux) do { _Pragma("unroll") for (int _i = 0; _i < 2; ++_i) \
        __builtin_amdgcn_global_load_lds((const unsigned*)((const char*)(gbase) + (voff)[_i]), (PG8_LAS unsigned*)(lds + (bufoff) + ldsw + _i * 8192), 16, 0, aux); } while (0)
#ifndef PG8_B_AUX
#define PG8_B_AUX 0
#endif
#define PG8_STAGE(bufoff, gbase, voff) PG8_STAGE_X(bufoff, gbase, voff, 0)
#define PG8_LDA(dst, b, h) do { _Pragma("unroll") for (int m = 0; m < 4; ++m) _Pragma("unroll") for (int k = 0; k < 2; ++k) dst[m][k] = *(const PG8_LAS bf16x8*)(lds + PG8_SA(b, h) + aoff + m * 2048 + k * 1024); } while (0)
#define PG8_LDB(dst, b, h) do { _Pragma("unroll") for (int n = 0; n < 2; ++n) _Pragma("unroll") for (int k = 0; k < 2; ++k) dst[n][k] = *(const PG8_LAS bf16x8*)(lds + PG8_SB(b, h) + boff + n * 2048 + k * 1024); } while (0)
#define PG8_MMA(ai, bj, At, Bt) do { __builtin_amdgcn_s_setprio(1); _Pragma("unroll") for (int m = 0; m < 4; ++m) _Pragma("unroll") for (int n = 0; n < 2; ++n) _Pragma("unroll") for (int k = 0; k < 2; ++k) \
        acc[ai][bj][m][n] = __builtin_amdgcn_mfma_f32_16x16x32_bf16(Bt[n][k], At[m][k], acc[ai][bj][m][n], 0, 0, 0); __builtin_amdgcn_s_setprio(0); } while (0)
#define PG8_WAIT_V(n) asm volatile("s_waitcnt vmcnt(" #n ")" ::: "memory")
#define PG8_WAIT_L(n) asm volatile("s_waitcnt lgkmcnt(" #n ")" ::: "memory")
#define PG8_BAR __builtin_amdgcn_s_barrier()
#define PG8_SCHED __builtin_amdgcn_sched_barrier(0)
    Unit cur, nxt; int ui = 0;
    if (!S.next(0, cur)) return;
    f32x4 acc[2][2][4][2];
#pragma unroll
    for (int a = 0; a < 2; ++a)
#pragma unroll
        for (int b = 0; b < 2; ++b)
#pragma unroll
            for (int m = 0; m < 4; ++m)
#pragma unroll
                for (int n = 0; n < 2; ++n) acc[a][b][m][n] = (f32x4){0.f, 0.f, 0.f, 0.f};
    bf16x8 At[4][2], B0[2][2], B1[2][2];
    const char* cA = (const char*)g.A + (size_t)cur.pm * tstep; const char* cB = (const char*)g.Bt + (size_t)cur.pn * tstep;
    S.a_ready(cur);
    if constexpr (SP2) {
        PG8_STAGE_X(PG8_SB(0, 0), cB, voffB, PG8_B_AUX); PG8_STAGE_X(PG8_SB(0, 1), cB + hstep, voffB, PG8_B_AUX); PG8_STAGE(PG8_SA(0, 0), cA, voffA); PG8_STAGE(PG8_SA(0, 1), cA + hstep, voffA);
        if (wr == 1) PG8_BAR;
        PG8_WAIT_V(2); PG8_BAR;
        PG8_STAGE_X(PG8_SB(1, 0), cB + kstep, voffB, PG8_B_AUX); PG8_STAGE(PG8_SA(1, 0), cA + kstep, voffA); PG8_STAGE_X(PG8_SB(1, 1), cB + hstep + kstep, voffB, PG8_B_AUX);
        PG8_WAIT_V(6); PG8_BAR;
    } else {
        PG8_STAGE_X(PG8_SB(0, 0), cB, voffB, PG8_B_AUX); PG8_STAGE(PG8_SA(0, 0), cA, voffA); PG8_STAGE_X(PG8_SB(0, 1), cB + hstep, voffB, PG8_B_AUX); PG8_STAGE(PG8_SA(0, 1), cA + hstep, voffA);
        if (wr == 1) PG8_BAR;
        PG8_WAIT_V(4); PG8_BAR;
        PG8_STAGE_X(PG8_SB(1, 0), cB + kstep, voffB, PG8_B_AUX); PG8_STAGE(PG8_SA(1, 0), cA + kstep, voffA); PG8_STAGE_X(PG8_SB(1, 1), cB + hstep + kstep, voffB, PG8_B_AUX);
        PG8_WAIT_V(6); PG8_BAR;
    }
    for (;;) {
        const bool has_next = S.next(ui + 1, nxt);
        const char* nA = has_next ? (const char*)g.A + (size_t)nxt.pm * tstep : cA; const char* nB = has_next ? (const char*)g.Bt + (size_t)nxt.pn * tstep : cB;
        for (int t = 0; t < nt; t += 2) {
            const bool last = (t == nt - 2);
            const char* a1 = cA + (size_t)(t + 1) * kstep;
            const char* a2 = last ? nA : cA + (size_t)(t + 2) * kstep; const char* b2 = last ? nB : cB + (size_t)(t + 2) * kstep;
            const char* a3 = a2 + kstep; const char* b3 = b2 + kstep;
            if (last && has_next) S.a_ready(nxt);
            if constexpr (SP2) {
            PG8_LDB(B0, 0, 0); PG8_LDB(B1, 0, 1); PG8_SCHED; PG8_LDA(At, 0, 0); PG8_STAGE(PG8_SA(1, 1), a1 + hstep, voffA);
            PG8_WAIT_V(8); PG8_WAIT_L(0); PG8_BAR; PG8_MMA(0, 0, At, B0); PG8_MMA(0, 1, At, B1); PG8_BAR; PG8_SCHED;
            PG8_LDA(At, 0, 1); PG8_STAGE_X(PG8_SB(0, 0), b2, voffB, PG8_B_AUX); PG8_STAGE_X(PG8_SB(0, 1), b2 + hstep, voffB, PG8_B_AUX); PG8_STAGE(PG8_SA(0, 0), a2, voffA);
            PG8_WAIT_V(8); PG8_WAIT_L(0); PG8_BAR; PG8_MMA(1, 0, At, B0); PG8_MMA(1, 1, At, B1); PG8_BAR; PG8_SCHED;
            PG8_LDB(B0, 1, 0); PG8_LDB(B1, 1, 1); PG8_SCHED; PG8_LDA(At, 1, 0); PG8_STAGE(PG8_SA(0, 1), a2 + hstep, voffA);
            PG8_WAIT_V(8); PG8_WAIT_L(0); PG8_BAR; PG8_MMA(0, 0, At, B0); PG8_MMA(0, 1, At, B1); PG8_BAR; PG8_SCHED;
            PG8_LDA(At, 1, 1); PG8_STAGE_X(PG8_SB(1, 0), b3, voffB, PG8_B_AUX); PG8_STAGE_X(PG8_SB(1, 1), b3 + hstep, voffB, PG8_B_AUX); PG8_STAGE(PG8_SA(1, 0), a3, voffA);
            PG8_WAIT_V(8); PG8_WAIT_L(0); PG8_BAR; PG8_MMA(1, 0, At, B0); PG8_MMA(1, 1, At, B1); PG8_BAR; PG8_SCHED;
            } else {
            PG8_LDB(B0, 0, 0); PG8_SCHED; PG8_LDA(At, 0, 0); PG8_STAGE(PG8_SA(1, 1), a1 + hstep, voffA);
            PG8_WAIT_L(8); PG8_BAR; PG8_WAIT_L(0); PG8_MMA(0, 0, At, B0); PG8_BAR; PG8_SCHED;
            PG8_LDB(B1, 0, 1); PG8_STAGE_X(PG8_SB(0, 0), b2, voffB, PG8_B_AUX);
            PG8_BAR; PG8_WAIT_L(0); PG8_MMA(0, 1, At, B1); PG8_BAR;
            PG8_LDA(At, 0, 1); PG8_STAGE(PG8_SA(0, 0), a2, voffA);
            PG8_BAR; PG8_WAIT_L(0); PG8_MMA(1, 0, At, B0); PG8_BAR; PG8_SCHED;
            PG8_STAGE_X(PG8_SB(0, 1), b2 + hstep, voffB, PG8_B_AUX);
            PG8_WAIT_V(6); PG8_BAR; PG8_MMA(1, 1, At, B1); PG8_BAR;
            PG8_LDB(B0, 1, 0); PG8_SCHED; PG8_LDA(At, 1, 0); PG8_STAGE(PG8_SA(0, 1), a2 + hstep, voffA);
            PG8_WAIT_L(8); PG8_BAR; PG8_WAIT_L(0); PG8_MMA(0, 0, At, B0); PG8_BAR; PG8_SCHED;
            PG8_LDB(B1, 1, 1); PG8_STAGE_X(PG8_SB(1, 0), b3, voffB, PG8_B_AUX);
            PG8_BAR; PG8_WAIT_L(0); PG8_MMA(0, 1, At, B1); PG8_BAR;
            PG8_LDA(At, 1, 1); PG8_STAGE(PG8_SA(1, 0), a3, voffA);
            PG8_BAR; PG8_WAIT_L(0); PG8_MMA(1, 0, At, B0); PG8_BAR; PG8_SCHED;
            PG8_STAGE_X(PG8_SB(1, 1), b3 + hstep, voffB, PG8_B_AUX);
            PG8_WAIT_V(6); PG8_BAR; PG8_MMA(1, 1, At, B1); PG8_BAR;
            }
        }
        if constexpr (ALIGN_EPI) { if (wr == 0) PG8_BAR; }
        if constexpr (!Epi::AFTER_DRAIN) { E(acc, cur, wr, wc, fr, fq); S.done(cur); }
        if (!has_next) break;
#pragma unroll
        for (int a = 0; a < 2; ++a)
#pragma unroll
            for (int b = 0; b < 2; ++b)
#pragma unroll
                for (int m = 0; m < 4; ++m)
#pragma unroll
                    for (int n = 0; n < 2; ++n) acc[a][b][m][n] = (f32x4){0.f, 0.f, 0.f, 0.f};
        cur = nxt; cA = nA; cB = nB; ++ui;
        if constexpr (ALIGN_EPI) { if (wr == 1) PG8_BAR; }
    }
    PG8_WAIT_V(0);
    if constexpr (!ALIGN_EPI) { if (wr == 0) PG8_BAR; }
    PG8_BAR;
    if constexpr (Epi::AFTER_DRAIN) { E.fused(acc, cur, wr, wc, fr, fq, lds, wid, lane); S.done(cur); }
#undef PG8_SA
#undef PG8_SB
#undef PG8_STAGE
#undef PG8_STAGE_X
#undef PG8_LDA
#undef PG8_LDB
#undef PG8_MMA
#undef PG8_WAIT_V
#undef PG8_WAIT_L
#undef PG8_BAR
#undef PG8_SCHED
}
}
#define GAS __attribute__((address_space(1)))
#define LAS __attribute__((address_space(3)))
typedef unsigned short bf16;
typedef unsigned v4u __attribute__((ext_vector_type(4)));
typedef float f32x4 __attribute__((ext_vector_type(4)));
typedef short bf16x8 __attribute__((ext_vector_type(8)));
typedef GAS unsigned gu32;
typedef GAS unsigned long long gu64;
#define RLX_AGENT __ATOMIC_RELAXED, __HIP_MEMORY_SCOPE_AGENT
#define LDS_WAIT() asm volatile("s_waitcnt lgkmcnt(0)" ::: "memory")
#define VM_WAIT() asm volatile("s_waitcnt vmcnt(0)" ::: "memory")
__device__ __forceinline__ unsigned long long rt() { return __builtin_amdgcn_s_memrealtime(); }
__device__ __forceinline__ unsigned f2bf(float f) { unsigned u = __builtin_bit_cast(unsigned, f); return (u + 0x7fffu + ((u >> 16) & 1u)) >> 16; }
__device__ __forceinline__ unsigned pk2(float lo, float hi) { return f2bf(lo) | (f2bf(hi) << 16); }
#define XB_TMO      128
#define XB_XCNT(j)  (256  + 64 * (j))
#define XB_XSUB(j)  (1280 + 64 * (j))
#define XB_XGEN(j)  (2304 + 64 * (j))
#define XB_TOP      3328
#define XB_TOPGEN   3392
#define XCD_BAR_WORDS 3456
#define XB_SPIN_CAP (1u << 18)

__device__ __forceinline__ unsigned xb_ld(unsigned* p)              { return __hip_atomic_load(p, __ATOMIC_RELAXED, __HIP_MEMORY_SCOPE_AGENT); }
__device__ __forceinline__ unsigned xb_add(unsigned* p, unsigned v) { return __hip_atomic_fetch_add(p, v, __ATOMIC_RELAXED, __HIP_MEMORY_SCOPE_AGENT); }
__device__ __forceinline__ unsigned xb_xcc_id() { return (unsigned)__builtin_amdgcn_s_getreg((3 << 11) | 20) & 0xFu; }
#define XB_SPIN(cond, bar) do { unsigned _sp = 0; while (cond) { __builtin_amdgcn_s_sleep(1); \
    if ((++_sp & 255u) == 0u) { if (xb_ld(&(bar)[XB_TMO])) break; if (_sp > XB_SPIN_CAP) { atomicAdd(&(bar)[XB_TMO], 1u); break; } } } } while (0)

struct XcdBarrier {
    unsigned* bar; unsigned x;
    volatile LAS unsigned* st;
};

__device__ __forceinline__ XcdBarrier xcd_barrier_post(unsigned* bar, volatile LAS unsigned* st) {
    XcdBarrier b; b.bar = bar; b.x = xb_xcc_id(); b.st = st;
    if (threadIdx.x == 0) (void)xb_add(&bar[XB_XCNT(b.x)], 1u);
    return b;
}
__device__ __forceinline__ void xcd_barrier_complete(unsigned* bar, unsigned x, unsigned& nloc, unsigned& nx) {
    const unsigned G = gridDim.x * gridDim.y * gridDim.z;
    unsigned sum, cnt, mine, sp = 0u;
    for (;;) {
        sum = 0u; cnt = 0u; mine = 0u;
#pragma unroll
        for (unsigned j = 0; j < 16; ++j) { const unsigned c = xb_ld(&bar[XB_XCNT(j)]); sum += c; cnt += (c > 0u) ? 1u : 0u; mine = (j == x) ? c : mine; }
        if (sum == G) break;
        __builtin_amdgcn_s_sleep(1);
        if ((++sp & 255u) == 0u) { if (xb_ld(&bar[XB_TMO])) break; if (sp > XB_SPIN_CAP) { atomicAdd(&bar[XB_TMO], 1u); break; } }
    }
    nloc = mine > 0u ? mine : 1u; nx = cnt > 0u ? cnt : 1u;
}

__device__ __forceinline__ void xcd_barrier(const XcdBarrier& b) {
    asm volatile("s_waitcnt vmcnt(0)" ::: "memory");
    __syncthreads();
    if (threadIdx.x == 0) {
        unsigned* bar = b.bar;
        __builtin_amdgcn_s_waitcnt(0);
        unsigned nloc = b.st[0], nx = b.st[1];
        if (nloc == 0u) { xcd_barrier_complete(bar, b.x, nloc, nx); b.st[0] = nloc; b.st[1] = nx; }
        const unsigned old = xb_add(&bar[XB_XSUB(b.x)], 1u);
        const unsigned gen = old / nloc;
        if (old + 1u == (gen + 1u) * nloc) {
            __builtin_amdgcn_fence(__ATOMIC_RELEASE, "agent");
            asm volatile("s_waitcnt vmcnt(0)" ::: "memory");
            const unsigned og = xb_add(&bar[XB_TOP], 1u);
            const unsigned tg = og / nx;
            if (og + 1u == (tg + 1u) * nx) xb_add(&bar[XB_TOPGEN], 1u);
            else XB_SPIN(xb_ld(&bar[XB_TOPGEN]) == tg, bar);
            __builtin_amdgcn_fence(__ATOMIC_ACQUIRE, "agent");
            xb_add(&bar[XB_XGEN(b.x)], 1u);
            asm volatile("s_waitcnt vmcnt(0)" ::: "memory");
        } else {
            XB_SPIN(xb_ld(&bar[XB_XGEN(b.x)]) == gen, bar);
            __builtin_amdgcn_fence(__ATOMIC_ACQUIRE, "agent");
            asm volatile("s_waitcnt vmcnt(0)" ::: "memory");
        }
    }
    __syncthreads();
}
constexpr int NWAVES = 8;
constexpr int D = 2048, SEQ = 8192, MP = 32768, MS = 128, MR = 32896, MT = 33024;
constexpr int DFF = 5632, NA = 5376, NBQ = 2048, NKV = 3072;
constexpr int CQ = 0, CK = 768, CV = 1536, CG = 3072, CQM = 4608, CLR = 5120;
constexpr float DN_ALPHA = 1.6817928305074292f, LN_EPS = 1e-5f, RMS_EPS = 1e-6f;
constexpr float GLA_QSCALE = 0.07216878364870323f, HD_SCALE = 0.08838834764831845f;
constexpr size_t MiB = 1u << 20;
constexpr size_t WS_CTL = 0, CTL_ZERO_BYTES = 1 * MiB;
constexpr size_t WS_WIN = 1 * MiB, WS_WO = 22 * MiB, WS_WFI = 30 * MiB, WS_WFO = 74 * MiB, WS_WMEM = 96 * MiB, WS_MEMX = 112 * MiB, WS_MEMK = 116 * MiB, WS_MEMV = 128 * MiB;
constexpr size_t WS_X = 140 * MiB, WS_Y = 269 * MiB, WS_R1 = 527 * MiB, WS_OCAT = 882 * MiB, WS_SBKS = 1011 * MiB, WS_SBVS = 1060 * MiB, WS_END = 1109 * MiB;
static_assert(WS_WIN + (size_t)NA * D * 2 <= WS_WO && WS_WFI + (size_t)2 * DFF * D * 2 <= WS_WFO && WS_WFO + (size_t)D * DFF * 2 <= WS_WMEM, "weights map");
static_assert(WS_X + (size_t)MT * D * 2 <= WS_Y && WS_Y + (size_t)MT * D * 4 <= WS_R1 && WS_R1 + (size_t)MT * DFF * 2 <= WS_OCAT && WS_OCAT + (size_t)MT * D * 2 <= WS_SBKS, "activation map");
static_assert(WS_SBKS + (size_t)8 * 2064 * 1536 * 2 <= WS_SBVS && WS_SBVS + (size_t)8 * 2064 * 1536 * 2 <= WS_END, "sb sample map");
constexpr size_t O_YP = 0, O_YS = 67108864, O_GSP = 67371008, O_GSS = 69730304, O_SKP = 74448896, O_SVP = 124780544, O_SKS = 175112192, O_SVS = 175308800, O_MKP = 175505408, O_MVP = 177602560, O_END = 179699712;
constexpr int CW_BAR = 4096;
constexpr int RING_OFF = 0, RING_BYTES = 131072, LDSCTL_OFF = RING_BYTES, MISC_OFF = LDSCTL_OFF + 320, LDS_BYTES = 147456;

struct Args { const float* in[22]; float* out_; unsigned char* ws_; int ph_lo, ph_hi; };
struct Frame {
    LAS unsigned char* lds; volatile LAS unsigned* MISC; gu32* ctl;
    int tid, lane, wave, G, gw, NGW;
};
__device__ __forceinline__ float bf2f(bf16 h) { return __builtin_bit_cast(float, (unsigned)h << 16); }
__device__ __forceinline__ float shx(float v, int lane, int m) { return __builtin_bit_cast(float, __builtin_amdgcn_ds_bpermute((lane ^ m) << 2, __builtin_bit_cast(int, v))); }
__device__ __forceinline__ float wave_sum(float v, int lane) {
#pragma unroll
    for (int o = 1; o < 64; o <<= 1) v += shx(v, lane, o);
    return v;
}
__device__ __forceinline__ float wave_max(float v, int lane) {
#pragma unroll
    for (int o = 1; o < 64; o <<= 1) v = fmaxf(v, shx(v, lane, o));
    return v;
}
__device__ __forceinline__ void cvt_row(const float* src, bf16* dst, int n, int lane) {
    for (int j = lane * 4; j < n; j += 256) {
        f32x4 v = src ? *(const f32x4*)(src + j) : (f32x4){0.f, 0.f, 0.f, 0.f};
        unsigned long long w = (unsigned long long)pk2(v.x, v.y) | ((unsigned long long)pk2(v.z, v.w) << 32);
        *(unsigned long long*)(dst + j) = w;
    }
}
template <int N>
__device__ __forceinline__ void cvt_rows2(const float* s0, const float* s1, bf16* d0, bf16* d1, int lane) {
    f32x4 v0[N / 256], v1[N / 256];
#pragma unroll
    for (int j = 0; j < N / 256; ++j) { v0[j] = s0 ? *(const f32x4*)(s0 + lane * 4 + 256 * j) : (f32x4){0.f, 0.f, 0.f, 0.f}; v1[j] = s1 ? *(const f32x4*)(s1 + lane * 4 + 256 * j) : (f32x4){0.f, 0.f, 0.f, 0.f}; }
#pragma unroll
    for (int j = 0; j < N / 256; ++j) {
        *(unsigned long long*)(d0 + lane * 4 + 256 * j) = (unsigned long long)pk2(v0[j].x, v0[j].y) | ((unsigned long long)pk2(v0[j].z, v0[j].w) << 32);
        *(unsigned long long*)(d1 + lane * 4 + 256 * j) = (unsigned long long)pk2(v1[j].x, v1[j].y) | ((unsigned long long)pk2(v1[j].z, v1[j].w) << 32); }
}
__device__ __forceinline__ int fresh_lane() { int z = 0; asm volatile("" : "+s"(z)); return (int)__builtin_amdgcn_mbcnt_hi(~0u, __builtin_amdgcn_mbcnt_lo(~0u, (unsigned)z)); }
#define FRESH_TID() (wave_ * 64 + fresh_lane())
template <bool FINAL>
__device__ __forceinline__ void ln_two_rows(int lane, const bf16* y0, const bf16* y1, const float* gg, const float* bb, bf16* x0, bf16* x1, float* of0, float* of1) {
    v4u w[2][4];
#pragma unroll
    for (int j = 0; j < 4; ++j) { w[0][j] = ((const v4u*)y0)[lane + 64 * j]; w[1][j] = ((const v4u*)y1)[lane + 64 * j]; }
    float v[2][4][8]; float s[2] = {0.f, 0.f};
#pragma unroll
    for (int r = 0; r < 2; ++r)
#pragma unroll
        for (int j = 0; j < 4; ++j) { const v4u q = w[r][j]; v[r][j][0] = pg8::bflo(q.x); v[r][j][1] = pg8::bfhi(q.x); v[r][j][2] = pg8::bflo(q.y); v[r][j][3] = pg8::bfhi(q.y); v[r][j][4] = pg8::bflo(q.z); v[r][j][5] = pg8::bfhi(q.z); v[r][j][6] = pg8::bflo(q.w); v[r][j][7] = pg8::bfhi(q.w);
            s[r] += ((v[r][j][0] + v[r][j][1]) + (v[r][j][2] + v[r][j][3])) + ((v[r][j][4] + v[r][j][5]) + (v[r][j][6] + v[r][j][7])); }
    const float m0 = wave_sum(s[0], lane) * (1.f / D), m1 = wave_sum(s[1], lane) * (1.f / D); float q0 = 0.f, q1 = 0.f;
#pragma unroll
    for (int j = 0; j < 4; ++j)
#pragma unroll
        for (int i = 0; i < 8; ++i) { v[0][j][i] -= m0; q0 += v[0][j][i] * v[0][j][i]; v[1][j][i] -= m1; q1 += v[1][j][i] * v[1][j][i]; }
    const float rs[2] = {1.f / sqrtf(wave_sum(q0, lane) * (1.f / D) + LN_EPS), 1.f / sqrtf(wave_sum(q1, lane) * (1.f / D) + LN_EPS)};
#pragma unroll
    for (int j = 0; j < 4; ++j) { const int e0 = (lane + 64 * j) * 8; const f32x4 g0 = *(const f32x4*)(gg + e0), g1 = *(const f32x4*)(gg + e0 + 4), b0 = *(const f32x4*)(bb + e0), b1 = *(const f32x4*)(bb + e0 + 4);
#pragma unroll
        for (int r = 0; r < 2; ++r) { float o[8];
#pragma unroll
            for (int i = 0; i < 4; ++i) { o[i] = v[r][j][i] * rs[r] * g0[i] + b0[i]; o[4 + i] = v[r][j][4 + i] * rs[r] * g1[i] + b1[i]; }
            if (FINAL) { float* of = r ? of1 : of0; *(f32x4*)(of + e0) = (f32x4){o[0], o[1], o[2], o[3]}; *(f32x4*)(of + e0 + 4) = (f32x4){o[4], o[5], o[6], o[7]}; }
            else { v4u p; p.x = pk2(o[0], o[1]); p.y = pk2(o[2], o[3]); p.z = pk2(o[4], o[5]); p.w = pk2(o[6], o[7]); *(v4u*)((r ? x1 : x0) + e0) = p; } } }
}
struct MapId { __device__ __forceinline__ int operator()(int n) const { return n; } };
struct MapInA { __device__ __forceinline__ int operator()(int n) const { return n < 4608 ? n : (n < 5120 ? n + 16 : (n < 5136 ? n - 512 : -1)); } };
struct MapFfn { __device__ __forceinline__ int operator()(int n) const { const int t = n >> 8, r = n & 255; return r < 128 ? 128 * t + r : DFF + 128 * t + (r - 128); } };
template <class Map>
__device__ __forceinline__ void wt_convert(LAS unsigned char* ldsb, int wave, int gw, int NGW, int lane, const float* W, int K, int Nsrc, bf16* WT, int Ndst, Map map) {
    LAS float* scr = (LAS float*)(ldsb + RING_OFF + wave * 16384);
    const int nblk = Ndst / 64, nitems = (K / 64) * nblk, nq = lane & 15, kq = lane >> 4;
    for (int it = gw; it < nitems; it += NGW) {
        const int kb = it / nblk, nb = it % nblk, k0 = 64 * kb, n0 = 64 * nb;
        const int sc0 = map(n0 + 4 * nq), sc3 = map(n0 + 4 * nq + 3);
        const bool contig = sc0 >= 0 && sc3 == sc0 + 3;
        f32x4 v[16];
#pragma unroll
        for (int i = 0; i < 16; ++i) { const int kk = 4 * i + kq;
            if (contig) v[i] = *(const f32x4*)(W + (size_t)(k0 + kk) * Nsrc + sc0);
            else {
#pragma unroll
                for (int e = 0; e < 4; ++e) { const int sc = map(n0 + 4 * nq + e); v[i][e] = sc >= 0 ? W[(size_t)(k0 + kk) * Nsrc + sc] : 0.f; } } }
#pragma unroll
        for (int i = 0; i < 16; ++i) { const int kk = 4 * i + kq;
#pragma unroll
            for (int e = 0; e < 4; ++e) { const int n = 4 * nq + e; scr[n * 64 + (kk ^ n)] = v[i][e]; } }
        LDS_WAIT(); asm volatile("" ::: "memory");
        const int c = lane & 7;
#pragma unroll
        for (int j = 0; j < 8; ++j) { const int n = (lane >> 3) + 8 * j; const LAS float* s = scr + n * 64;
#define SWZ(i) s[(8 * c + (i)) ^ n]
            v4u o; o.x = pk2(SWZ(0), SWZ(1)); o.y = pk2(SWZ(2), SWZ(3)); o.z = pk2(SWZ(4), SWZ(5)); o.w = pk2(SWZ(6), SWZ(7));
#undef SWZ
            *(GAS v4u*)(WT + (size_t)(n0 + n) * K + k0 + 8 * c) = o; }
        LDS_WAIT(); asm volatile("" ::: "memory");
    }
}
__device__ __forceinline__ float softplus_f(float z) { return fmaxf(z, 0.f) + log1pf(__expf(-fabsf(z))); }

typedef short s16x4 __attribute__((ext_vector_type(4)));
typedef pg8::u32x2 u32x2;
typedef float f32x16 __attribute__((ext_vector_type(16)));
typedef __bf16 bf16x2_t __attribute__((ext_vector_type(2)));
typedef float f32x2_t __attribute__((ext_vector_type(2)));
__device__ __forceinline__ unsigned cvt2(float lo, float hi) { const f32x2_t v = {lo, hi}; const bf16x2_t b = __builtin_convertvector(v, bf16x2_t); return __builtin_bit_cast(unsigned, b); }
__device__ __forceinline__ bf16x8 pack8(const f32x4 a, const f32x4 b) { v4u p; p.x = cvt2(a[0], a[1]); p.y = cvt2(a[2], a[3]); p.z = cvt2(b[0], b[1]); p.w = cvt2(b[2], b[3]); return __builtin_bit_cast(bf16x8, p); }
__device__ __forceinline__ bf16x8 ld2x8(const bf16* p0, const bf16* p1) { const s16x4 a = *(const s16x4*)p0, b = *(const s16x4*)p1; return __builtin_shufflevector(a, b, 0, 1, 2, 3, 4, 5, 6, 7); }
__device__ __forceinline__ bf16x8 ld16(const bf16* p) { return *(const bf16x8*)p; }
#define MFMA16(a, b, c) __builtin_amdgcn_mfma_f32_16x16x32_bf16((a), (b), (c), 0, 0, 0)
#define MFMA32(a, b, c) __builtin_amdgcn_mfma_f32_32x32x16_bf16((a), (b), (c), 0, 0, 0)

constexpr int QIMG_LD = 200, KTIMG_LD = 68, PKG_Q = 0, PKG_KT = 25600, PKG_G = 51712, IMG_BYTES = 52480, PKG_K = 52480, PKG_VT = 77056, PKG_BYTES = 126208, N_PKG = 2048 + 32;
static_assert(64 * QIMG_LD * 2 == PKG_KT && PKG_KT + 192 * KTIMG_LD * 2 == PKG_G && PKG_G + 768 == IMG_BYTES && PKG_K + 24576 == PKG_VT && PKG_VT + 49152 == PKG_BYTES && IMG_BYTES % 16 == 0, "package map");

__device__ __forceinline__ float softplus_fast(float z) { return fmaxf(z, 0.f) + __logf(1.0f + __expf(-fabsf(z))); }
constexpr int GL_TOT = 0, GL_Q = 6144, GL_K = GL_Q + 64 * QIMG_LD * 2, GL_V = GL_K + 64 * QIMG_LD * 2, VL_LD = 68, GL_P = GL_V + 384 * VL_LD * 2, P_LD = 68, GL_END = GL_P + 64 * P_LD * 2;
static_assert(GL_END <= RING_BYTES && GL_Q % 16 == 0 && GL_K % 16 == 0 && GL_V % 8 == 0 && GL_P % 8 == 0, "gla_prep_intra LDS map");
__device__ __forceinline__ void gla_prep_intra(int bid, int G, int tid, int wave, LAS unsigned char* lds, int l, const bf16* PROJ, const float* w_gate_lr, const float* b_gate, unsigned char* PKG, float* OINT) {
    const int lane = tid & 63, fr = lane & 15, fq = lane >> 4;
    const float* w2 = w_gate_lr + (size_t)l * 16 * 768; const float* bg = b_gate + (size_t)l * 768;
    LAS float* tot = (LAS float*)(lds + GL_TOT);
    LAS bf16* QL = (LAS bf16*)(lds + GL_Q); LAS bf16* KL = (LAS bf16*)(lds + GL_K); LAS bf16* VL = (LAS bf16*)(lds + GL_V); LAS bf16* P = (LAS bf16*)(lds + GL_P);
    float w2c[3][16], bgc[3]; int cur_h = -1;
    for (int j = 0;; ++j) {
        int item;
        if (G == 256) { if (j < 8) item = ((((j >> 1) << 2) | (bid & 3)) << 7) | ((bid >> 2) + 64 * (j & 1)); else if (j == 8 && bid < 32) item = 2048 + bid; else break; }
        else { item = bid + j * G; if (item >= N_PKG) break; }
        int h, row0, T;
        if (item < 2048) { const int bh = item >> 7, ch = item & 127; h = bh & 3; row0 = (bh >> 2) * SEQ + ch * 64; T = 64; }
        else { const int i2 = item - 2048; h = i2 & 3; row0 = MP + (i2 >> 2) * 16; T = 16; }
        unsigned char* pk = PKG + (size_t)item * PKG_BYTES;
        bf16* Qt = (bf16*)(pk + PKG_Q); bf16* KT = (bf16*)(pk + PKG_KT); bf16* VT = (bf16*)(pk + PKG_VT); float* Gp = (float*)(pk + PKG_G);
        if (h != cur_h) { cur_h = h;
#pragma unroll
            for (int c = 0; c < 3; ++c) { const int d = h * 192 + lane + 64 * c; bgc[c] = bg[d];
#pragma unroll
                for (int r = 0; r < 16; ++r) w2c[c][r] = w2[r * 768 + d]; } }
        v4u l0[8], l1[8];
#pragma unroll
        for (int tt = 0; tt < 8; ++tt) { const int t = 8 * wave + tt; const bf16* prow = PROJ + (size_t)(row0 + (t < T ? t : T - 1)) * NA;
            l0[tt] = *(const v4u*)(prow + CLR); l1[tt] = *(const v4u*)(prow + CLR + 8); }
        float lc[8][3]; float run[3] = {0.f, 0.f, 0.f};
#pragma unroll
        for (int tt = 0; tt < 8; ++tt) { const bool ok = 8 * wave + tt < T;
            float lr[16]; lr[0] = pg8::bflo(l0[tt].x); lr[1] = pg8::bfhi(l0[tt].x); lr[2] = pg8::bflo(l0[tt].y); lr[3] = pg8::bfhi(l0[tt].y); lr[4] = pg8::bflo(l0[tt].z); lr[5] = pg8::bfhi(l0[tt].z); lr[6] = pg8::bflo(l0[tt].w); lr[7] = pg8::bfhi(l0[tt].w);
            lr[8] = pg8::bflo(l1[tt].x); lr[9] = pg8::bfhi(l1[tt].x); lr[10] = pg8::bflo(l1[tt].y); lr[11] = pg8::bfhi(l1[tt].y); lr[12] = pg8::bflo(l1[tt].z); lr[13] = pg8::bfhi(l1[tt].z); lr[14] = pg8::bflo(l1[tt].w); lr[15] = pg8::bfhi(l1[tt].w);
#pragma unroll
            for (int c = 0; c < 3; ++c) { float xg = bgc[c];
#pragma unroll
                for (int r = 0; r < 16; ++r) xg += lr[r] * w2c[c][r];
                run[c] += ok ? -softplus_fast(-xg) * (1.0f / 16.0f) : 0.f; lc[tt][c] = run[c]; } }
#pragma unroll
        for (int c = 0; c < 3; ++c) tot[wave * 192 + lane + 64 * c] = run[c];
        unsigned qv[8][3], kv[8][3];
#pragma unroll
        for (int tt = 0; tt < 8; ++tt) { const int t = 8 * wave + tt; const bf16* prow = PROJ + (size_t)(row0 + (t < T ? t : T - 1)) * NA + h * 192 + lane;
#pragma unroll
            for (int c = 0; c < 3; ++c) { qv[tt][c] = prow[CQ + 64 * c]; kv[tt][c] = prow[CK + 64 * c]; } }
        __syncthreads();
        float pre[3], all[3];
#pragma unroll
        for (int c = 0; c < 3; ++c) { pre[c] = 0.f; all[c] = 0.f;
#pragma unroll
            for (int w = 0; w < 8; ++w) { const float tv = tot[w * 192 + lane + 64 * c]; all[c] += tv; if (w < wave) pre[c] += tv; } }
        unsigned ktw[3][4];
#pragma unroll
        for (int tt = 0; tt < 8; ++tt) { const int t = 8 * wave + tt; const bool ok = t < T;
#pragma unroll
            for (int c = 0; c < 3; ++c) { const int dl = lane + 64 * c; const float bc = pre[c] + lc[tt][c]; const float eq = __expf(bc), ek = __expf(-bc);
                const unsigned qb = ok ? f2bf(bf2f((bf16)qv[tt][c]) * GLA_QSCALE * eq) : 0u, kb = ok ? f2bf(bf2f((bf16)kv[tt][c]) * ek) : 0u;
                Qt[t * QIMG_LD + dl] = (bf16)qb; QL[t * QIMG_LD + dl] = (bf16)qb; KL[t * QIMG_LD + dl] = (bf16)kb;
                if (tt & 1) ktw[c][tt >> 1] |= kb << 16; else ktw[c][tt >> 1] = kb; } }
#pragma unroll
        for (int c = 0; c < 3; ++c) { bf16* kp = KT + (size_t)(lane + 64 * c) * KTIMG_LD + 8 * wave; u32x2 o0, o1; o0.x = ktw[c][0]; o0.y = ktw[c][1]; o1.x = ktw[c][2]; o1.y = ktw[c][3]; *(u32x2*)kp = o0; *(u32x2*)(kp + 4) = o1; }
        if (wave == 0) {
#pragma unroll
            for (int c = 0; c < 3; ++c) Gp[lane + 64 * c] = __expf(all[c]); }
        unsigned vv[6][8];
#pragma unroll
        for (int tt = 0; tt < 8; ++tt) { const int t = 8 * wave + tt; const bf16* prow = PROJ + (size_t)(row0 + (t < T ? t : T - 1)) * NA + CV + h * 384 + lane;
#pragma unroll
            for (int c2 = 0; c2 < 6; ++c2) vv[c2][tt] = prow[64 * c2]; }
#pragma unroll
        for (int c2 = 0; c2 < 6; ++c2) { const bool ok0 = 8 * wave < T;
            u32x2 o0, o1; o0.x = ok0 ? vv[c2][0] | (vv[c2][1] << 16) : 0u; o0.y = ok0 ? vv[c2][2] | (vv[c2][3] << 16) : 0u; o1.x = ok0 ? vv[c2][4] | (vv[c2][5] << 16) : 0u; o1.y = ok0 ? vv[c2][6] | (vv[c2][7] << 16) : 0u;
            v4u o; o.x = o0.x; o.y = o0.y; o.z = o1.x; o.w = o1.y; *(v4u*)(VT + (size_t)(lane + 64 * c2) * 64 + 8 * wave) = o;
            LAS bf16* vl = VL + (lane + 64 * c2) * VL_LD + 8 * wave; *(LAS u32x2*)vl = o0; *(LAS u32x2*)(vl + 4) = o1; }
        __syncthreads();
        const int nvalid = T;
        bf16x8 va[3], vb[3];
#pragma unroll
        for (int k = 0; k < 3; ++k) { const LAS bf16* vr = VL + (16 * (3 * wave + k) + fr) * VL_LD + 4 * fq;
            const s16x4 x0 = *(const LAS s16x4*)vr, x1 = *(const LAS s16x4*)(vr + 16), x2 = *(const LAS s16x4*)(vr + 32), x3 = *(const LAS s16x4*)(vr + 48);
            va[k] = __builtin_shufflevector(x0, x1, 0, 1, 2, 3, 4, 5, 6, 7); vb[k] = __builtin_shufflevector(x2, x3, 0, 1, 2, 3, 4, 5, 6, 7); }
#pragma unroll
        for (int rep = 0; rep < 2; ++rep) {
            const int tl = wave + 8 * rep;
            if (tl < 10) {
                const int it = tl < 1 ? 0 : (tl < 3 ? 1 : (tl < 6 ? 2 : 3)), jt = tl - (it * (it + 1)) / 2;
                f32x4 at = {0.f, 0.f, 0.f, 0.f};
                const LAS bf16* qr = QL + (16 * it + fr) * QIMG_LD + 8 * fq; const LAS bf16* kr = KL + (16 * jt + fr) * QIMG_LD + 8 * fq;
#pragma unroll
                for (int s = 0; s < 6; ++s) at = MFMA16(*(const LAS bf16x8*)(kr + 32 * s), *(const LAS bf16x8*)(qr + 32 * s), at);
                if (it == jt) {
#pragma unroll
                    for (int jj = 0; jj < 4; ++jj) if (4 * fq + jj > fr) at[jj] = 0.f; }
                u32x2 w; w.x = cvt2(at[0], at[1]); w.y = cvt2(at[2], at[3]);
                *(LAS u32x2*)(P + (16 * it + fr) * P_LD + 16 * jt + 4 * fq) = w;
            } else if (tl == 10 || tl == 11) {
                const int it = tl == 10 ? 0 : 2, jt = tl == 10 ? 1 : 3; unsigned zz = 0u; asm volatile("" : "+v"(zz)); u32x2 z; z.x = zz; z.y = zz;
                *(LAS u32x2*)(P + (16 * it + fr) * P_LD + 16 * jt + 4 * fq) = z;
            }
        }
        __syncthreads();
#pragma unroll
        for (int it = 0; it < 4; ++it) {
            if (16 * it >= nvalid) break;
            const LAS bf16* pr = P + (16 * it + fr) * P_LD + 4 * fq;
            const s16x4 a0 = *(const LAS s16x4*)pr, a1 = *(const LAS s16x4*)(pr + 16);
            const bf16x8 pf0 = __builtin_shufflevector(a0, a1, 0, 1, 2, 3, 4, 5, 6, 7); bf16x8 pf1 = pf0;
            if (it >= 2) { const s16x4 b0 = *(const LAS s16x4*)(pr + 32), b1 = *(const LAS s16x4*)(pr + 48); pf1 = __builtin_shufflevector(b0, b1, 0, 1, 2, 3, 4, 5, 6, 7); }
#pragma unroll
            for (int k = 0; k < 3; ++k) { f32x4 o = {0.f, 0.f, 0.f, 0.f};
                o = MFMA16(va[k], pf0, o); if (it >= 2) o = MFMA16(vb[k], pf1, o);
                *(f32x4*)(OINT + (size_t)(row0 + 16 * it + fr) * 1536 + h * 384 + 16 * (3 * wave + k) + 4 * fq) = o; }
        }
        __syncthreads();
    }
}

template <int PASS>
__device__ __forceinline__ void gla_chain(int wc, int tid, int wave, LAS unsigned char* lds, int l, const unsigned char* PKG, const float* state_gla, float* OINT, float* out, float* SLOC, float* GSEG, bool dry = false) {
    const int lane = tid & 63, fr = lane & 15, fq = lane >> 4;
    int h, vb, bh, seg, item0, nsteps, row0, nvalid; const float* s0 = nullptr; float* sout = nullptr;
    if (PASS == 1) { bh = wc / 9; const int rem = wc % 9; vb = rem / 3; seg = rem % 3; h = bh & 3; item0 = bh * 128 + 32 * seg; nsteps = 32; row0 = 0; nvalid = 64; }
    else if (wc < 192) { bh = wc / 12; const int rem = wc % 12; vb = rem >> 2; seg = rem & 3; h = bh & 3; item0 = bh * 128 + 32 * seg; nsteps = 32; row0 = (bh >> 2) * SEQ + 2048 * seg; nvalid = 64;
        if (seg == 3) sout = out + O_GSP + (size_t)(l * 16 + bh) * 192 * 384; }
    else { const int c2 = wc - 192; bh = c2 / 3; vb = c2 % 3; seg = 0; h = bh & 3; item0 = 2048 + bh; nsteps = 1; row0 = MP + (bh >> 2) * 16; nvalid = 16; s0 = state_gla + (size_t)(l * 32 + bh) * 192 * 384; sout = out + O_GSS + (size_t)(l * 32 + bh) * 192 * 384; }
    const int v0 = vb * 128 + wave * 16;
#define GLA_WALK(p, step) do { (p) += (step); asm volatile("" : "+v"(p)); } while (0)
    f32x4 S[12];
    if (s0) { const float* p = s0 + (size_t)(4 * fq) * 384 + v0 + fr;
#pragma unroll
        for (int t = 0; t < 12; ++t) {
#pragma unroll
            for (int jj = 0; jj < 4; ++jj) { S[t][jj] = *p; GLA_WALK(p, 384); }
            GLA_WALK(p, 12 * 384); } }
    else {
#pragma unroll
        for (int t = 0; t < 12; ++t) S[t] = (f32x4){0.f, 0.f, 0.f, 0.f}; }
    if (PASS == 2 && wc < 192) {
        for (int j = 0; j < seg; ++j) { const float* gs = GSEG + (size_t)(bh * 3 + j) * 192 + 4 * fq; const float* p = SLOC + (size_t)((bh * 3 + vb) * 3 + j) * 192 * 128 + (size_t)(4 * fq) * 128 + wave * 16 + fr;
#pragma unroll
            for (int t = 0; t < 12; ++t) { const f32x4 g4 = *(const f32x4*)(gs + 16 * t);
#pragma unroll
                for (int jj = 0; jj < 4; ++jj) { S[t][jj] = g4[jj] * S[t][jj] + *p; GLA_WALK(p, 128); }
                GLA_WALK(p, 12 * 128); } }
    }
    f32x4 GP[PASS == 1 ? 12 : 1];
    if (PASS == 1) {
#pragma unroll
        for (int t = 0; t < 12; ++t) GP[t] = (f32x4){1.f, 1.f, 1.f, 1.f}; }
    constexpr int CH0 = PASS == 1 ? PKG_KT / 16 : 0, NCH = IMG_BYTES / 16, NLD = PASS == 1 ? 4 : 7;
    v4u pre[NLD]; bf16x8 vt[2], vtn[2]; f32x4 oin[4];
    { const unsigned char* pk = PKG + (size_t)item0 * PKG_BYTES;
      if (PASS == 2) {
#pragma unroll
        for (int it = 0; it < 4; ++it) { const int tl = 16 * it + fr; oin[it] = tl < nvalid ? *(const f32x4*)(OINT + (size_t)(row0 + tl) * 1536 + h * 384 + v0 + 4 * fq) : (f32x4){0.f, 0.f, 0.f, 0.f}; } }
#pragma unroll
      for (int k = 0; k < NLD; ++k) { const int ch = CH0 + tid + 512 * k; if (ch < NCH) pre[k] = *(const v4u*)(pk + (size_t)ch * 16); }
      const bf16* VT = (const bf16*)(pk + PKG_VT) + (size_t)(v0 + fr) * 64 + 4 * fq; vt[0] = ld2x8(VT, VT + 16); vt[1] = ld2x8(VT + 32, VT + 48);
#pragma unroll
      for (int k = 0; k < NLD; ++k) { const int ch = CH0 + tid + 512 * k; if (ch < NCH) *(LAS v4u*)(lds + (size_t)ch * 16) = pre[k]; }
      vtn[0] = vt[0]; vtn[1] = vt[1]; }
    __syncthreads();
    for (int n = 0; n < nsteps; ++n) {
        const LAS unsigned char* img = lds + (n & 1) * IMG_BYTES;
        const bool more = n + 1 < nsteps;
        if (more) { const unsigned char* pk = PKG + (size_t)(item0 + n + 1) * PKG_BYTES;
#pragma unroll
            for (int k = 0; k < NLD; ++k) { const int ch = CH0 + tid + 512 * k; if (ch < NCH) pre[k] = *(const v4u*)(pk + (size_t)ch * 16); }
            const bf16* VT = (const bf16*)(pk + PKG_VT) + (size_t)(v0 + fr) * 64 + 4 * fq; vtn[0] = ld2x8(VT, VT + 16); vtn[1] = ld2x8(VT + 32, VT + 48); }
        if (PASS == 2) {
            bf16x8 Sb[6];
#pragma unroll
            for (int s = 0; s < 6; ++s) Sb[s] = pack8(S[2 * s], S[2 * s + 1]);
#pragma unroll
            for (int it = 0; it < 4; ++it) {
                const LAS bf16* qr = (const LAS bf16*)(img + PKG_Q) + (16 * it + fr) * QIMG_LD + 4 * fq;
                f32x4 o = oin[it];
#pragma unroll
                for (int s = 0; s < 6; ++s) { const s16x4 a = *(const LAS s16x4*)(qr + 32 * s), b = *(const LAS s16x4*)(qr + 32 * s + 16);
                    o = MFMA16(Sb[s], __builtin_shufflevector(a, b, 0, 1, 2, 3, 4, 5, 6, 7), o); }
                const int tl = 16 * it + fr;
                if (tl < nvalid && !dry) *(f32x4*)(OINT + (size_t)(row0 + 64 * n + tl) * 1536 + h * 384 + v0 + 4 * fq) = o;
                __builtin_amdgcn_sched_barrier(0);
            }
            if (more) {
#pragma unroll
                for (int it = 0; it < 4; ++it) oin[it] = *(const f32x4*)(OINT + (size_t)(row0 + 64 * (n + 1) + 16 * it + fr) * 1536 + h * 384 + v0 + 4 * fq); }
        }
#pragma unroll
        for (int t = 0; t < 12; ++t) { const LAS bf16* kr = (const LAS bf16*)(img + PKG_KT) + (16 * t + fr) * KTIMG_LD + 4 * fq;
#pragma unroll
            for (int s2 = 0; s2 < 2; ++s2) { const s16x4 a = *(const LAS s16x4*)(kr + 32 * s2), b = *(const LAS s16x4*)(kr + 32 * s2 + 16);
                S[t] = MFMA16(__builtin_shufflevector(a, b, 0, 1, 2, 3, 4, 5, 6, 7), vt[s2], S[t]); }
            const f32x4 g4 = *(const LAS f32x4*)(img + PKG_G + (16 * t + 4 * fq) * 4);
            S[t] = S[t] * g4; if (PASS == 1) GP[t] = GP[t] * g4; if ((t & 3) == 3) __builtin_amdgcn_sched_barrier(0); }
        if (more) { LAS unsigned char* nimg = lds + ((n + 1) & 1) * IMG_BYTES;
#pragma unroll
            for (int k = 0; k < NLD; ++k) { const int ch = CH0 + tid + 512 * k; if (ch < NCH) *(LAS v4u*)(nimg + (size_t)ch * 16) = pre[k]; }
            vt[0] = vtn[0]; vt[1] = vtn[1]; }
        asm volatile("s_waitcnt lgkmcnt(0)" ::: "memory"); __builtin_amdgcn_s_barrier(); asm volatile("" ::: "memory");
    }
    if (PASS == 1) {
        float* p = SLOC + (size_t)((bh * 3 + vb) * 3 + seg) * 192 * 128 + (size_t)(4 * fq) * 128 + wave * 16 + fr;
#pragma unroll
        for (int t = 0; t < 12; ++t) {
#pragma unroll
            for (int jj = 0; jj < 4; ++jj) { *p = S[t][jj]; GLA_WALK(p, 128); }
            GLA_WALK(p, 12 * 128); }
        if (vb == 0 && wave == 0 && fr == 0) { float* gs = GSEG + (size_t)(bh * 3 + seg) * 192;
#pragma unroll
            for (int t = 0; t < 12; ++t) *(f32x4*)(gs + 16 * t + 4 * fq) = GP[t]; }
    } else if (sout) {
        float* p = sout + (size_t)(4 * fq) * 384 + v0 + fr;
#pragma unroll
        for (int t = 0; t < 12; ++t) {
#pragma unroll
            for (int jj = 0; jj < 4; ++jj) { *p = S[t][jj]; GLA_WALK(p, 384); }
            GLA_WALK(p, 12 * 384); }
    }
#undef GLA_WALK
}

__device__ __forceinline__ void mem_attn(int item, int lane, int l, const bf16* PROJ, int ldp, int cqm, const bf16* MEMK, const bf16* MEMVT, bf16* OCAT) {
    const int fr = lane & 15, fq = lane >> 4, tile = item >> 2, h = item & 3, r0 = tile * 16;
    const int bb = r0 < MP ? r0 / SEQ : 4 + ((r0 - MP) >> 4);
    const bf16* Kb = MEMK + (size_t)((l * 12 + bb) * 256) * 512 + h * 128; const bf16* Vt = MEMVT + (size_t)(((l * 12 + bb) * 4 + h) * 128) * 256;
    bf16x8 qf[4];
#pragma unroll
    for (int s = 0; s < 4; ++s) qf[s] = ld16(PROJ + (size_t)(r0 + fr) * ldp + cqm + h * 128 + 32 * s + 8 * fq);
    f32x4 st[16];
#pragma unroll
    for (int mt = 0; mt < 16; ++mt) { st[mt] = (f32x4){0.f, 0.f, 0.f, 0.f}; const bf16* kr = Kb + (size_t)(16 * mt + fr) * 512 + 8 * fq;
#pragma unroll
        for (int s = 0; s < 4; ++s) st[mt] = MFMA16(ld16(kr + 32 * s), qf[s], st[mt]); }
    float mx = -3.0e38f;
#pragma unroll
    for (int mt = 0; mt < 16; ++mt) mx = fmaxf(mx, fmaxf(fmaxf(st[mt][0], st[mt][1]), fmaxf(st[mt][2], st[mt][3])));
    mx = fmaxf(mx, shx(mx, lane, 16)); mx = fmaxf(mx, shx(mx, lane, 32));
    float sum = 0.f;
#pragma unroll
    for (int mt = 0; mt < 16; ++mt)
#pragma unroll
        for (int jj = 0; jj < 4; ++jj) { const float p = __expf((st[mt][jj] - mx) * HD_SCALE); st[mt][jj] = p; sum += p; }
    sum += shx(sum, lane, 16); sum += shx(sum, lane, 32);
    const float inv = 1.0f / sum;
    bf16x8 pf[8];
#pragma unroll
    for (int s = 0; s < 8; ++s) pf[s] = pack8(st[2 * s], st[2 * s + 1]);
#pragma unroll
    for (int dt = 0; dt < 8; ++dt) { f32x4 o = {0.f, 0.f, 0.f, 0.f}; const bf16* vr = Vt + (size_t)(16 * dt + fr) * 256 + 4 * fq;
#pragma unroll
        for (int s = 0; s < 8; ++s) o = MFMA16(ld2x8(vr + 32 * s, vr + 32 * s + 16), pf[s], o);
        u32x2 w; w.x = cvt2(o[0] * inv, o[1] * inv); w.y = cvt2(o[2] * inv, o[3] * inv);
        *(u32x2*)(OCAT + (size_t)(r0 + fr) * D + 1536 + h * 128 + 16 * dt + 4 * fq) = w; }
}

__device__ __forceinline__ void mem_attn_wg(int wi, int tid, int wave, LAS unsigned char* lds, int l, const bf16* PROJ, int ldp, int cqm, const bf16* MEMK, const bf16* MEMVT, bf16* OCAT) {
    const bool smp = wi >= 256; const int lane = tid & 63, fr = lane & 15, fq = lane >> 4, bh = smp ? (wi - 256) : (wi >> 4), sub = wi & 15, b = smp ? 4 + (bh >> 2) : (bh >> 2), h = bh & 3;
    const bf16* Kb = MEMK + (size_t)((l * 12 + b) * 256) * 512 + h * 128; const bf16* Vt = MEMVT + (size_t)(((l * 12 + b) * 4 + h) * 128) * 256;
#pragma unroll
    for (int k = 0; k < 8; ++k) { const int idx = tid + 512 * k, row = idx >> 4, c = idx & 15; *(LAS v4u*)(lds + row * 256 + ((c ^ (row & 15)) << 4)) = *(const v4u*)(Kb + (size_t)row * 512 + c * 8); }
#pragma unroll
    for (int k = 0; k < 8; ++k) { const int idx = tid + 512 * k, row = idx >> 5, c = idx & 31; *(LAS v4u*)(lds + 65536 + row * 512 + ((c ^ (2 * (row & 15))) << 4)) = *(const v4u*)(Vt + (size_t)row * 256 + c * 8); }
    __syncthreads();
    unsigned koff[4], voff[16];
#pragma unroll
    for (int s2 = 0; s2 < 4; ++s2) { koff[s2] = (unsigned)(fr * 256 + (((4 * s2 + fq) ^ fr) << 4)); asm volatile("" : "+v"(koff[s2])); }
#pragma unroll
    for (int s2 = 0; s2 < 8; ++s2) { const int p0 = 8 * s2 + fq, p1 = p0 + 4;
        voff[2 * s2] = (unsigned)(65536 + fr * 512 + ((((p0 >> 1) ^ (2 * fr)) << 4) | ((p0 & 1) << 3))); voff[2 * s2 + 1] = (unsigned)(65536 + fr * 512 + ((((p1 >> 1) ^ (2 * fr)) << 4) | ((p1 & 1) << 3)));
        asm volatile("" : "+v"(voff[2 * s2]), "+v"(voff[2 * s2 + 1])); }
    const int nblk = smp ? (wave == 0 ? 1 : 0) : 4;
#pragma unroll 1
    for (int blk = 0; blk < nblk; ++blk) {
        const int r0 = smp ? MP + (b - 4) * 16 : b * SEQ + sub * 512 + blk * 128 + wave * 16;
        bf16x8 qf[4];
#pragma unroll
        for (int s = 0; s < 4; ++s) qf[s] = ld16(PROJ + (size_t)(r0 + fr) * ldp + cqm + h * 128 + 32 * s + 8 * fq);
        f32x4 st[16];
#pragma unroll
        for (int mt = 0; mt < 16; ++mt) { st[mt] = (f32x4){0.f, 0.f, 0.f, 0.f};
#pragma unroll
            for (int s = 0; s < 4; ++s) st[mt] = MFMA16(*(const LAS bf16x8*)(lds + koff[s] + mt * 4096), qf[s], st[mt]);
            if ((mt & 3) == 3) __builtin_amdgcn_sched_barrier(0); }
        float mx = -3.0e38f;
#pragma unroll
        for (int mt = 0; mt < 16; ++mt) mx = fmaxf(mx, fmaxf(fmaxf(st[mt][0], st[mt][1]), fmaxf(st[mt][2], st[mt][3])));
        mx = fmaxf(mx, shx(mx, lane, 16)); mx = fmaxf(mx, shx(mx, lane, 32));
        float sum = 0.f;
#pragma unroll
        for (int mt = 0; mt < 16; ++mt)
#pragma unroll
            for (int jj = 0; jj < 4; ++jj) { const float p = __expf((st[mt][jj] - mx) * HD_SCALE); st[mt][jj] = p; sum += p; }
        sum += shx(sum, lane, 16); sum += shx(sum, lane, 32);
        const float inv = 1.0f / sum;
        bf16x8 pf[8];
#pragma unroll
        for (int s = 0; s < 8; ++s) pf[s] = pack8(st[2 * s], st[2 * s + 1]);
#pragma unroll
        for (int dt = 0; dt < 8; ++dt) { f32x4 o = {0.f, 0.f, 0.f, 0.f};
#pragma unroll
            for (int s = 0; s < 8; ++s) { const s16x4 a = *(const LAS s16x4*)(lds + voff[2 * s] + dt * 8192), bb = *(const LAS s16x4*)(lds + voff[2 * s + 1] + dt * 8192);
                o = MFMA16(__builtin_shufflevector(a, bb, 0, 1, 2, 3, 4, 5, 6, 7), pf[s], o); }
            u32x2 w; w.x = cvt2(o[0] * inv, o[1] * inv); w.y = cvt2(o[2] * inv, o[3] * inv);
            *(u32x2*)(OCAT + (size_t)(r0 + fr) * D + 1536 + h * 128 + 16 * dt + 4 * fq) = w;
            if (dt & 1) __builtin_amdgcn_sched_barrier(0); }
    }
    __syncthreads();
}

template <int MODE = 0>
__device__ __forceinline__ void sb_attn(int lane, LAS unsigned char* wlds, const bf16* Kp, int ldk, const bf16* VTp, int ldvt, const bf16* Qp, int ldq, bf16* Op, int t0, int nq) {
    const int r = lane & 31, hh = lane >> 5;
    LAS bf16x8* qs = (LAS bf16x8*)wlds + lane;
#pragma unroll
    for (int ks = 0; ks < 8; ++ks) qs[64 * ks] = ld16(Qp + (size_t)r * ldq + 16 * ks + 8 * hh);
    f32x16 oacc[4];
#pragma unroll
    for (int dt = 0; dt < 4; ++dt)
#pragma unroll
        for (int i = 0; i < 16; ++i) oacc[dt][i] = 0.f;
    float carry = 1.f;
    bf16x8 kf[8];
    { const bf16* kr = Kp + (size_t)(t0 + r) * ldk + 8 * hh;
#pragma unroll
      for (int ks = 0; ks < 8; ++ks) kf[ks] = ld16(kr + 16 * ks); }
    for (int s0 = t0; s0 >= 0; s0 -= 32) {
        bf16x8 vf[8];
#pragma unroll
        for (int k2 = 0; k2 < 2; ++k2)
#pragma unroll
            for (int dt = 0; dt < 4; ++dt) vf[4 * k2 + dt] = MODE == 3 ? qs[64 * dt] : ld16(VTp + (size_t)(s0 >> 5) * 4096 + ((dt * 2 + k2) * 64 + lane) * 8);
        f32x16 st;
#pragma unroll
        for (int i = 0; i < 16; ++i) st[i] = 0.f;
#pragma unroll
        for (int ks = 0; ks < 8; ++ks) st = MFMA32(kf[ks], qs[64 * ks], st);
        { const int sn = s0 >= 32 ? s0 - 32 : 0; const bf16* kr = Kp + (size_t)(sn + r) * ldk + 8 * hh;
#pragma unroll
          for (int ks = 0; ks < 8; ++ks) kf[ks] = ld16(kr + 16 * ks); }
        const bool diag = (s0 == t0);
        float lb[16], om[16];
#pragma unroll
        for (int i = 0; i < 16; ++i) { const float z = st[i] * HD_SCALE, e = __expf(-fabsf(z)), rr = __builtin_amdgcn_rcpf(1.0f + e), er = e * rr;
            lb[i] = z >= 0.f ? rr : er; om[i] = z >= 0.f ? er : rr;
            if (diag && !(((i & 3) + 8 * (i >> 2) + 4 * hh) < r)) { lb[i] = 0.f; om[i] = 1.f; } }
        float g[4], pgv[4];
#pragma unroll
        for (int m = 0; m < 4; ++m) { g[m] = (om[4 * m] * om[4 * m + 1]) * (om[4 * m + 2] * om[4 * m + 3]); pgv[m] = shx(g[m], lane, 32); }
        float R[4]; R[3] = 1.f; R[2] = g[3] * pgv[3]; R[1] = R[2] * (g[2] * pgv[2]); R[0] = R[1] * (g[1] * pgv[1]);
        const float total = R[0] * (g[0] * pgv[0]);
#pragma unroll
        for (int m = 0; m < 4; ++m) { const float suf = carry * R[m] * (hh == 0 ? pgv[m] : 1.f);
            const float t3 = suf, t2 = t3 * om[4 * m + 3], t1 = t2 * om[4 * m + 2], t0_ = t1 * om[4 * m + 1];
            lb[4 * m + 3] *= t3; lb[4 * m + 2] *= t2; lb[4 * m + 1] *= t1; lb[4 * m] *= t0_; }
        carry *= total;
#pragma unroll
        for (int k2 = 0; k2 < 2; ++k2) {
            v4u p; p.x = cvt2(lb[8 * k2], lb[8 * k2 + 1]); p.y = cvt2(lb[8 * k2 + 2], lb[8 * k2 + 3]); p.z = cvt2(lb[8 * k2 + 4], lb[8 * k2 + 5]); p.w = cvt2(lb[8 * k2 + 6], lb[8 * k2 + 7]);
            const bf16x8 wf = __builtin_bit_cast(bf16x8, p);
#pragma unroll
            for (int dt = 0; dt < 4; ++dt) { if (MODE != 3) oacc[dt] = MFMA32(vf[4 * k2 + dt], wf, oacc[dt]); else oacc[dt][0] += __builtin_bit_cast(float, (int)wf[0]) + __builtin_bit_cast(float, (int)vf[4 * k2 + dt][0]); }
        }
        if (MODE == 2 || __all((r >= nq) || (carry < 1.0e-37f))) break;
    }
    if (MODE != 0) { float sdry = 0.f;
#pragma unroll
        for (int dt = 0; dt < 4; ++dt)
#pragma unroll
            for (int i = 0; i < 16; ++i) sdry += oacc[dt][i];
        if (sdry == 1.2345e33f) Op[0] = 0; }
    else if (r < nq) {
#pragma unroll
        for (int dt = 0; dt < 4; ++dt)
#pragma unroll
            for (int g4 = 0; g4 < 4; ++g4) { u32x2 wv; wv.x = cvt2(oacc[dt][4 * g4], oacc[dt][4 * g4 + 1]); wv.y = cvt2(oacc[dt][4 * g4 + 2], oacc[dt][4 * g4 + 3]);
                *(u32x2*)(Op + (size_t)r * D + 32 * dt + 8 * g4 + 4 * hh) = wv; }
    }
    asm volatile("s_waitcnt lgkmcnt(0)" ::: "memory");
}

struct SkBf16 { bf16* O; int ldc;
    __device__ __forceinline__ int brow(int unit, int nb) const { return 32 * unit + 16 * nb; }
    __device__ __forceinline__ void store(int unit, const f32x4 a0, const f32x4 a1, int m, int fq) const { bf16* p = O + (size_t)(MP + m) * ldc + 32 * unit + 4 * fq;
        u32x2 w; w.x = cvt2(a0[0], a0[1]); w.y = cvt2(a0[2], a0[3]); *(u32x2*)p = w; w.x = cvt2(a1[0], a1[1]); w.y = cvt2(a1[2], a1[3]); *(u32x2*)(p + 16) = w; } };
struct SkRes { bf16* Yp; const bf16* Xp; float alpha;
    __device__ __forceinline__ int brow(int unit, int nb) const { return 32 * unit + 16 * nb; }
    __device__ __forceinline__ void one(size_t o, const f32x4 a) const { const u32x2 xv = *(const u32x2*)(Xp + o);
        f32x4 r; r[0] = alpha * pg8::bflo(xv.x); r[1] = alpha * pg8::bfhi(xv.x); r[2] = alpha * pg8::bflo(xv.y); r[3] = alpha * pg8::bfhi(xv.y); r = r + a; u32x2 w; w.x = cvt2(r[0], r[1]); w.y = cvt2(r[2], r[3]); *(u32x2*)(Yp + o) = w; }
    __device__ __forceinline__ void store(int unit, const f32x4 a0, const f32x4 a1, int m, int fq) const { const size_t o = (size_t)(MP + m) * D + 32 * unit + 4 * fq; one(o, a0); one(o + 16, a1); } };
struct SkKV { float *oks, *ovs; bf16 *ksb, *vsb;
    __device__ __forceinline__ int brow(int unit, int nb) const { return 32 * unit + 16 * nb; }
    __device__ __forceinline__ void one(int col, const f32x4 a, int m) const { const bool isv = col >= 1536; const int c = col - (isv ? 1536 : 0), b = m >> 4, t = m & 15;
        *(f32x4*)((isv ? ovs : oks) + (size_t)m * 1536 + c) = a; const unsigned w0 = cvt2(a[0], a[1]), w1 = cvt2(a[2], a[3]);
        const int hh_ = c >> 7, dd = c & 127;
        if (!isv) { u32x2 w; w.x = w0; w.y = w1; *(u32x2*)(ksb + ((size_t)(b * 12 + hh_) * 2080 + 2048 + t) * 128 + dd) = w; }
        else { bf16* vt = vsb + ((size_t)(b * 12 + hh_) * 65 + 64) * 4096 + pg8::vtf_d(dd) + pg8::vtf_k(t); vt[0] = (bf16)w0; vt[8] = (bf16)(w0 >> 16); vt[16] = (bf16)w1; vt[24] = (bf16)(w1 >> 16); } }
    __device__ __forceinline__ void store(int unit, const f32x4 a0, const f32x4 a1, int m, int fq) const { one(32 * unit + 4 * fq, a0, m); one(32 * unit + 16 + 4 * fq, a1, m); } };
struct SkSwiGLU { bf16* Hb;
    __device__ __forceinline__ int brow(int unit, int nb) const { const int c0 = 16 * unit; return (c0 >> 7) * 256 + (c0 & 127) + 128 * nb; }
    __device__ __forceinline__ void store(int unit, const f32x4 g, const f32x4 u, int m, int fq) const { float hv[4];
#pragma unroll
        for (int j = 0; j < 4; ++j) hv[j] = g[j] * __builtin_amdgcn_rcpf(1.0f + __expf(-g[j])) * u[j];
        u32x2 w; w.x = cvt2(hv[0], hv[1]); w.y = cvt2(hv[2], hv[3]); *(u32x2*)(Hb + (size_t)(MP + m) * DFF + 16 * unit + 4 * fq) = w; } };
template <class Epi>
__device__ __forceinline__ void skinny_gemm(int bid, int G, int tid, int wave, LAS unsigned char* lds, const bf16* A, int lda, const bf16* Bt, int K, int nunits, const Epi& E) {
    const int lane = tid & 63, fr = lane & 15, fq = lane >> 4, kw = K >> 3, nst = kw >> 5;
    LAS f32x4* red = (LAS f32x4*)lds;
    for (int item = bid; item < 4 * nunits; item += G) {
        const int unit = item >> 2, rg = item & 3;
        const bf16* ap = A + (size_t)(32 * rg + fr) * lda + wave * kw + 8 * fq;
        const bf16* bp0 = Bt + (size_t)(E.brow(unit, 0) + fr) * K + wave * kw + 8 * fq; const bf16* bp1 = Bt + (size_t)(E.brow(unit, 1) + fr) * K + wave * kw + 8 * fq;
        f32x4 acc[2][2];
#pragma unroll
        for (int nb = 0; nb < 2; ++nb)
#pragma unroll
            for (int rt = 0; rt < 2; ++rt) acc[nb][rt] = (f32x4){0.f, 0.f, 0.f, 0.f};
        bf16x8 a0[4][2], b0[4][2], a1[4][2], b1[4][2];
#define SK_LOAD(af, bfr, g) do { _Pragma("unroll") for (int q = 0; q < 4; ++q) { const int st = 4 * (g) + q; if (st < nst) { \
            af[q][0] = ld16(ap + 32 * st); af[q][1] = ld16(ap + (size_t)16 * lda + 32 * st); bfr[q][0] = ld16(bp0 + 32 * st); bfr[q][1] = ld16(bp1 + 32 * st); } } } while (0)
#define SK_MMA(af, bfr, g) do { _Pragma("unroll") for (int q = 0; q < 4; ++q) { if (4 * (g) + q < nst) { _Pragma("unroll") for (int rt = 0; rt < 2; ++rt) { \
            acc[0][rt] = MFMA16(bfr[q][0], af[q][rt], acc[0][rt]); acc[1][rt] = MFMA16(bfr[q][1], af[q][rt], acc[1][rt]); } } } } while (0)
        const int ng = (nst + 3) >> 2;
        SK_LOAD(a0, b0, 0);
#pragma unroll 1
        for (int g = 0; g < ng; g += 2) {
            if (g + 1 < ng) SK_LOAD(a1, b1, g + 1);
            __builtin_amdgcn_sched_barrier(0);
            SK_MMA(a0, b0, g);
            __builtin_amdgcn_sched_barrier(0);
            if (g + 2 < ng) SK_LOAD(a0, b0, g + 2);
            __builtin_amdgcn_sched_barrier(0);
            if (g + 1 < ng) SK_MMA(a1, b1, g + 1);
            __builtin_amdgcn_sched_barrier(0);
        }
#undef SK_LOAD
#undef SK_MMA
#pragma unroll
        for (int nb = 0; nb < 2; ++nb)
#pragma unroll
            for (int rt = 0; rt < 2; ++rt) red[((wave * 2 + nb) * 2 + rt) * 64 + lane] = acc[nb][rt];
        __syncthreads();
        if (wave < 2) {
            f32x4 s0 = {0.f, 0.f, 0.f, 0.f}, s1 = {0.f, 0.f, 0.f, 0.f};
#pragma unroll
            for (int ws = 0; ws < 8; ++ws) { s0 = s0 + red[((ws * 2 + 0) * 2 + wave) * 64 + lane]; s1 = s1 + red[((ws * 2 + 1) * 2 + wave) * 64 + lane]; }
            E.store(unit, s0, s1, 32 * rg + 16 * wave + fr, fq);
        }
        __syncthreads();
    }
}
#ifndef PH_MASK
#define PH_MASK 0xFFFF
#endif
__global__ void __launch_bounds__(NWAVES * 64, 2) mega(Args args) {
    extern __shared__ __attribute__((aligned(16))) unsigned char lds[];
    Frame F;
    F.lds = (LAS unsigned char*)lds; F.MISC = (volatile LAS unsigned*)(F.lds + MISC_OFF);
    F.tid = threadIdx.x; F.lane = F.tid & 63; F.wave = __builtin_amdgcn_readfirstlane(F.tid >> 6);
    F.G = gridDim.x; F.gw = blockIdx.x * NWAVES + F.wave; F.NGW = F.G * NWAVES;
    F.ctl = (gu32*)(args.ws_ + WS_CTL);
    for (int u = F.tid; u < (LDS_BYTES - LDSCTL_OFF) / 4; u += NWAVES * 64) ((LAS unsigned*)(F.lds + LDSCTL_OFF))[u] = 0u;
    __syncthreads();
    XcdBarrier bar = xcd_barrier_post((unsigned*)(F.ctl + CW_BAR), F.MISC + 8);
    const int lo = args.ph_lo, hi = args.ph_hi; int ph = 0;
#define KARGS ((const __attribute__((address_space(4))) Args*)__builtin_amdgcn_kernarg_segment_ptr())
#define ws (ka->ws_)
#define out (ka->out_)
#define x_prompt (ka->in[0])
#define x_sample (ka->in[1])
#define mem_prompt (ka->in[2])
#define state_gla (ka->in[3])
#define cache_sb_k (ka->in[4])
#define cache_sb_v (ka->in[5])
#define cache_mem_k (ka->in[6])
#define cache_mem_v (ka->in[7])
#define w_in_a (ka->in[8])
#define w_gate_lr (ka->in[9])
#define b_gate (ka->in[10])
#define gla_norm_g (ka->in[11])
#define w_in_b (ka->in[12])
#define w_kv_shared (ka->in[13])
#define w_mem_kv (ka->in[14])
#define w_o (ka->in[15])
#define ln1_g (ka->in[16])
#define ln1_b (ka->in[17])
#define ln2_g (ka->in[18])
#define ln2_b (ka->in[19])
#define w_ffn_in (ka->in[20])
#define w_ffn_out (ka->in[21])
#define WIN ((bf16*)(ws + WS_WIN))
#define WO ((bf16*)(ws + WS_WO))
#define WFI ((bf16*)(ws + WS_WFI))
#define WFO ((bf16*)(ws + WS_WFO))
#define WMEM ((bf16*)(ws + WS_WMEM))
#define MEMX ((bf16*)(ws + WS_MEMX))
#define MEMK ((bf16*)(ws + WS_MEMK))
#define MEMV ((bf16*)(ws + WS_MEMV))
#define X ((bf16*)(ws + WS_X))
#define Y ((float*)(ws + WS_Y))
#define YB ((bf16*)(ws + WS_Y))
#define PROJ ((bf16*)(ws + WS_R1))
#define HB ((bf16*)(ws + WS_R1))
#define OCAT ((bf16*)(ws + WS_OCAT))
#define SBKS ((bf16*)(ws + WS_SBKS))
#define SBVS ((bf16*)(ws + WS_SBVS))
#define OINT (out + O_YP)
#define KPB ((bf16*)(out + O_YP))
#define VPB (KPB + (size_t)MP * 1536)

#define PHASE_BEGIN(cond, cls) if (cond) { if (lo <= ph && ph < hi) { if (ph > lo) { xcd_barrier(bar); if (BAR_REP > 1) xcd_barrier(bar); } DIAG_STAMP(cls); for (int rep_ = 0; rep_ < (((cls) == REP_CLS) ? 2 : 1); ++rep_) { const __attribute__((address_space(4))) Args* ka = KARGS; asm volatile("" : "+s"(ka)); int z_ = 0, G_ = gridDim.x, bid_ = blockIdx.x, wave_ = F.wave; asm volatile("" : "+s"(z_), "+s"(G_), "+s"(bid_), "+s"(wave_)); const int lane = (int)__builtin_amdgcn_mbcnt_hi(~0u, __builtin_amdgcn_mbcnt_lo(~0u, (unsigned)z_)), tid = wave_ * 64 + lane, gw_ = bid_ * NWAVES + wave_, NGW_ = G_ * NWAVES;     (void)tid; (void)lane; (void)gw_; (void)NGW_;
#define PHASE_END } } ++ph; }
#ifndef REP_CLS
#define REP_CLS (-1)
#endif
#ifndef SK_REP
#define SK_REP 1
#endif
#ifndef MEM_REP
#define MEM_REP 1
#endif
#ifndef BAR_REP
#define BAR_REP 1
#endif
#ifndef STAG
#define STAG 0
#endif
#ifndef SB_REP
#define SB_REP 1
#endif
#if defined(DIAG_A)
#define DIAG_STAMP(cls) do { if (blockIdx.x == 0 && threadIdx.x == 0) { unsigned long long* dts = (unsigned long long*)(args.ws_ + 262144); dts[ph] = rt(); } } while (0)
#else
#define DIAG_STAMP(cls) do { } while (0)
#endif

#define CONVERT_WEIGHTS(LL) do { const int ll_ = (LL); \
            if (ll_ < 2) wt_convert(F.lds, wave_, gw_, NGW_, lane, w_in_a + (size_t)ll_ * D * 5136, D, 5136, WIN, NA, MapInA()); \
            else { wt_convert(F.lds, wave_, gw_, NGW_, lane, w_in_b + (size_t)(ll_ - 2) * D * NBQ, D, NBQ, WIN, NBQ, MapId()); if (ll_ == 2) wt_convert(F.lds, wave_, gw_, NGW_, lane, w_kv_shared, D, NKV, WIN + (size_t)NBQ * D, NKV, MapId()); } \
            wt_convert(F.lds, wave_, gw_, NGW_, lane, w_o + (size_t)ll_ * D * D, D, D, WO, D, MapId()); \
            wt_convert(F.lds, wave_, gw_, NGW_, lane, w_ffn_in + (size_t)ll_ * D * 2 * DFF, D, 2 * DFF, WFI, 2 * DFF, MapFfn()); \
            wt_convert(F.lds, wave_, gw_, NGW_, lane, w_ffn_out + (size_t)ll_ * DFF * D, DFF, D, WFO, D, MapId()); } while (0)
#define CONVERT_CACHE_K(W0, NW) do {         for (int r = (W0); r < 8 * 2048; r += (NW)) { const int b = r >> 11, s = r & 2047; const float* src = cache_sb_k + (size_t)r * 1536; \
            f32x4 v[6]; \
_Pragma("unroll") \
            for (int q = 0; q < 6; ++q) v[q] = *(const f32x4*)(src + lane * 4 + 256 * q); \
_Pragma("unroll") \
            for (int q = 0; q < 6; ++q) { const int j = lane * 4 + 256 * q; \
                *(unsigned long long*)(SBKS + ((size_t)(b * 12 + (j >> 7)) * 2080 + s) * 128 + (j & 127)) = (unsigned long long)pk2(v[q].x, v[q].y) | ((unsigned long long)pk2(v[q].z, v[q].w) << 32); } } } while (0)
#define CONVERT_CACHE_V(W0, NW) do {         for (int it = (W0); it < 3072; it += (NW)) { const int cb = it % 12, sb_ = (it / 12) & 31, b = it / 384, s = sb_ * 64 + lane; \
            const float* src = cache_sb_v + (size_t)(b * 2048 + s) * 1536 + cb * 128; bf16* dst = SBVS + ((size_t)(b * 12 + cb) * 65 + (s >> 5)) * 4096 + pg8::vtf_k(s & 31); \
            for (int q8 = 0; q8 < 32; q8 += 8) { f32x4 v[8]; \
_Pragma("unroll") \
                for (int q = 0; q < 8; ++q) v[q] = *(const f32x4*)(src + 4 * (q8 + q)); \
_Pragma("unroll") \
                for (int q = 0; q < 8; ++q) \
_Pragma("unroll") \
                    for (int e = 0; e < 4; ++e) dst[pg8::vtf_d(4 * (q8 + q) + e)] = (bf16)f2bf(v[q][e]); } } } while (0)
    PHASE_BEGIN(true, 0)
        for (int r = 2 * gw_; r < MT; r += 2 * NGW_) { const float* s0 = r < MP ? x_prompt + (size_t)r * D : (r < MR ? x_sample + (size_t)(r - MP) * D : nullptr);
            cvt_rows2<D>(s0, s0 ? s0 + D : nullptr, X + (size_t)r * D, X + (size_t)(r + 1) * D, lane); }
        for (int r = 2 * gw_; r < 1024; r += 2 * NGW_) cvt_rows2<D>(mem_prompt + (size_t)r * D, mem_prompt + (size_t)(r + 1) * D, MEMX + (size_t)r * D, MEMX + (size_t)(r + 1) * D, lane);
        for (int r = gw_; r < 4 * 8 * 256; r += NGW_) { const int l = r >> 11, b = (r >> 8) & 7, m = r & 255; const size_t dst = (size_t)((l * 12 + 4 + b) * 256 + m) * 512;
            cvt_row(cache_mem_k + (size_t)r * 512, MEMK + dst, 512, lane); }
        for (int it = gw_; it < 512; it += NGW_) { const int hdb = it & 3, mb = (it >> 2) & 3, b = (it >> 4) & 7, l = it >> 7, m = mb * 64 + lane;
            const float* src = cache_mem_v + (size_t)((l * 8 + b) * 256 + m) * 512 + hdb * 128; bf16* dst = MEMV + (size_t)((l * 12 + 4 + b) * 512 + hdb * 128) * 256 + m;
            for (int q4 = 0; q4 < 32; ++q4) { const f32x4 v = *(const f32x4*)(src + 4 * q4);
#pragma unroll
                for (int e = 0; e < 4; ++e) dst[(size_t)(4 * q4 + e) * 256] = (bf16)f2bf(v[e]); } }
        if (G_ != 256) { CONVERT_CACHE_K(gw_, NGW_); CONVERT_CACHE_V(gw_, NGW_); }
        for (int l = 0; l < 4; ++l) wt_convert(F.lds, wave_, gw_, NGW_, lane, w_mem_kv + (size_t)l * D * 1024, D, 1024, WMEM + (size_t)l * 1024 * D, 1024, MapId());
        CONVERT_WEIGHTS(0);
    PHASE_END
    for (int l = 0; l < 4; ++l) {
        const bool LA = l < 2;
        const int ldp = LA ? NA : NBQ;
        PHASE_BEGIN(true, 2)
            if (!LA && (bid_ & 1)) { { SkBf16 E{PROJ, ldp}; skinny_gemm(bid_, G_, FRESH_TID(), wave_, F.lds + RING_OFF, X + (size_t)MP * D, D, WIN, D, ldp / 32, E); }
                if (l == 2) { SkKV E{out + O_SKS, out + O_SVS, SBKS, SBVS}; skinny_gemm(bid_, G_, FRESH_TID(), wave_, F.lds + RING_OFF, X + (size_t)MP * D, D, WIN + (size_t)NBQ * D, D, NKV / 32, E); } }
            { pg8::Gemm g{X, WIN, MP, ldp, D}; pg8::StaticOrder S; S.init(MP, ldp, G_, bid_); pg8::EpiBf16 E{PROJ, ldp};
              pg8::gemm_phase<pg8::EpiBf16, pg8::StaticOrder, true, true>(F.lds + RING_OFF, g, S, E, FRESH_TID()); }
            if (l == 0 && bid_ >= (G_ >> 1) && bid_ < (G_ >> 1) + 64) { pg8::Gemm g{MEMX, WMEM, 1024, 4096, D}; pg8::StaticOrder S; S.init(1024, 4096, 64, bid_ - (G_ >> 1));
              pg8::EpiMemKV E{out + O_MKP, out + O_MVP, MEMK, MEMV};
              pg8::gemm_phase<pg8::EpiMemKV, pg8::StaticOrder, true, true>(F.lds + RING_OFF, g, S, E, FRESH_TID()); }
            if (l == 2) { pg8::Gemm g{X, WIN + (size_t)NBQ * D, MP, NKV, D}; pg8::StaticOrder S; S.init(MP, NKV, G_, bid_);
              pg8::EpiKV E{out + O_SKP, out + O_SVP, out + O_SKS, out + O_SVS, KPB, VPB, SBKS, SBVS};
              pg8::gemm_phase<pg8::EpiKV, pg8::StaticOrder, true, true>(F.lds + RING_OFF, g, S, E, FRESH_TID()); }
            if (LA) { if (bid_ >= (G_ >> 1)) { SkBf16 E{PROJ, ldp}; skinny_gemm(bid_ - (G_ >> 1), G_ >> 1, FRESH_TID(), wave_, F.lds + RING_OFF, X + (size_t)MP * D, D, WIN, D, ldp / 32, E); } }
            else if (!(bid_ & 1))
            for (int skr = 0; skr < SK_REP; ++skr) { SkBf16 E{PROJ, ldp}; skinny_gemm(bid_, G_, FRESH_TID(), wave_, F.lds + RING_OFF, X + (size_t)MP * D, D, WIN, D, ldp / 32, E); }
            if (!(bid_ & 1))
            for (int skr = 0; skr < SK_REP; ++skr) if (l == 2) { SkKV E{out + O_SKS, out + O_SVS, SBKS, SBVS}; skinny_gemm(bid_, G_, FRESH_TID(), wave_, F.lds + RING_OFF, X + (size_t)MP * D, D, WIN + (size_t)NBQ * D, D, NKV / 32, E); }
        PHASE_END
        PHASE_BEGIN(LA, 3)
            gla_prep_intra(bid_, G_, tid, wave_, F.lds + RING_OFF, l, PROJ, w_gate_lr, b_gate, (unsigned char*)Y, OINT);
        PHASE_END
        PHASE_BEGIN(!LA, 11)
            {
#if defined(SB_MODE)
                for (int u = gw_; u < 12288; u += NGW_) { const int bh = u >> 8, qb = u & 255, b = bh / 12, h = bh % 12, t0 = 32 * qb; const size_t qo = (size_t)(b * SEQ + t0) * D + h * 128;
                    sb_attn<SB_MODE>(lane, F.lds + RING_OFF + wave_ * 16384, KPB + (size_t)bh * SEQ * 128, 128, VPB + (size_t)bh * SEQ * 128, 0, PROJ + qo, NBQ, OCAT + qo, t0, 32); }
#endif
                for (int sbr = 0; sbr < SB_REP; ++sbr)
                for (int u = gw_; u < 12288 + 96; u += NGW_) {
                    if (u < 12288) { const int bh = u >> 8, qb = u & 255, b = bh / 12, h = bh % 12, t0 = 32 * qb; const size_t qo = (size_t)(b * SEQ + t0) * D + h * 128;
                        sb_attn(lane, F.lds + RING_OFF + wave_ * 16384, KPB + (size_t)bh * SEQ * 128, 128, VPB + (size_t)bh * SEQ * 128, 0, PROJ + qo, NBQ, OCAT + qo, t0, 32); }
                    else { const int u2 = u - 12288, b = u2 / 12, h = u2 % 12; const size_t qo = (size_t)(MP + b * 16) * D + h * 128;
                        sb_attn(lane, F.lds + RING_OFF + wave_ * 16384, SBKS + (size_t)u2 * 2080 * 128, 128, SBVS + (size_t)u2 * 65 * 4096, 0, PROJ + qo, NBQ, OCAT + qo, 2048, 16); }
                }
            }
            __syncthreads();
            for (int mr = 0; mr < MEM_REP; ++mr)
            for (int wi = bid_; wi < 256 + 32; wi += G_) mem_attn_wg(wi, FRESH_TID(), wave_, F.lds + RING_OFF, l, PROJ, ldp, LA ? CQM : 1536, MEMK, MEMV, OCAT);
        PHASE_END
        PHASE_BEGIN(LA, 12)
            if (G_ == 256) { if (bid_ >= 144) { mem_attn_wg(bid_ - 144, FRESH_TID(), wave_, F.lds + RING_OFF, l, PROJ, ldp, CQM, MEMK, MEMV, OCAT); mem_attn_wg(bid_ - 144 + 112, FRESH_TID(), wave_, F.lds + RING_OFF, l, PROJ, ldp, CQM, MEMK, MEMV, OCAT); } }
            else for (int wi = bid_; wi < 256 + 32; wi += G_) mem_attn_wg(wi, FRESH_TID(), wave_, F.lds + RING_OFF, l, PROJ, ldp, CQM, MEMK, MEMV, OCAT);
            for (int wc = bid_; wc < 144; wc += G_) gla_chain<1>(wc, FRESH_TID(), wave_, F.lds + RING_OFF, l, (const unsigned char*)Y, state_gla, OINT, out, (float*)WMEM, (float*)MEMX);
            if (G_ == 256 && bid_ < 64) mem_attn_wg(224 + bid_, FRESH_TID(), wave_, F.lds + RING_OFF, l, PROJ, ldp, CQM, MEMK, MEMV, OCAT);
        PHASE_END
        PHASE_BEGIN(LA, 5)
            if (G_ == 256 && bid_ >= 192) { const int lw = (bid_ - 192) * NWAVES + wave_; if (l == 0) CONVERT_CACHE_K(lw, 64 * NWAVES); else CONVERT_CACHE_V(lw, 64 * NWAVES); }
            for (int wc = bid_; wc < 192 + 96; wc += G_) gla_chain<2>(wc, FRESH_TID(), wave_, F.lds + RING_OFF, l, (const unsigned char*)Y, state_gla, OINT, out, (float*)WMEM, (float*)MEMX, REP_CLS == 5 && rep_ == 0);
        PHASE_END
        PHASE_BEGIN(LA, 6)
            const float* gn = gla_norm_g + (size_t)l * 384;
            for (int row = gw_; row < MR; row += NGW_) {
                const float* op = OINT + (size_t)row * 1536 + 24 * lane; const bf16* gp = PROJ + (size_t)row * NA + CG + 24 * lane; const float* gnp = gn + 24 * (lane & 15);
                f32x4 ov[6]; v4u gv[3]; float ss = 0.f;
#pragma unroll
                for (int j = 0; j < 6; ++j) { ov[j] = *(const f32x4*)(op + 4 * j); ss += (ov[j].x * ov[j].x + ov[j].y * ov[j].y) + (ov[j].z * ov[j].z + ov[j].w * ov[j].w); }
#pragma unroll
                for (int j = 0; j < 3; ++j) gv[j] = *(const v4u*)(gp + 8 * j);
                ss += shx(ss, lane, 1); ss += shx(ss, lane, 2); ss += shx(ss, lane, 4); ss += shx(ss, lane, 8);
                const float r = 1.0f / sqrtf(ss * (1.0f / 384.0f) + RMS_EPS);
#pragma unroll
                for (int j = 0; j < 3; ++j) { const f32x4 n0 = *(const f32x4*)(gnp + 8 * j), n1 = *(const f32x4*)(gnp + 8 * j + 4); const f32x4 a = ov[2 * j], b = ov[2 * j + 1];
                    float gt[8]; gt[0] = pg8::bflo(gv[j].x); gt[1] = pg8::bfhi(gv[j].x); gt[2] = pg8::bflo(gv[j].y); gt[3] = pg8::bfhi(gv[j].y); gt[4] = pg8::bflo(gv[j].z); gt[5] = pg8::bfhi(gv[j].z); gt[6] = pg8::bflo(gv[j].w); gt[7] = pg8::bfhi(gv[j].w);
                    float o8[8];
#pragma unroll
                    for (int i = 0; i < 4; ++i) { o8[i] = a[i] * r * n0[i] * (gt[i] * __builtin_amdgcn_rcpf(1.0f + __expf(-gt[i]))); o8[4 + i] = b[i] * r * n1[i] * (gt[4 + i] * __builtin_amdgcn_rcpf(1.0f + __expf(-gt[4 + i]))); }
                    v4u o; o.x = pk2(o8[0], o8[1]); o.y = pk2(o8[2], o8[3]); o.z = pk2(o8[4], o8[5]); o.w = pk2(o8[6], o8[7]);
                    *(v4u*)(OCAT + (size_t)row * D + 24 * lane + 8 * j) = o; }
            }
        PHASE_END
        PHASE_BEGIN(true, 7)
            if (bid_ & 1) { SkRes Es{YB, X, DN_ALPHA}; skinny_gemm(bid_, G_, FRESH_TID(), wave_, F.lds + RING_OFF, OCAT + (size_t)MP * D, D, WO, D, D / 32, Es); }
            pg8::Gemm g{OCAT, WO, MP, D, D}; pg8::StaticOrder S; S.init(MP, D, G_, bid_); pg8::EpiRes E{YB, X, D, DN_ALPHA};
            pg8::gemm_phase<pg8::EpiRes, pg8::StaticOrder, true, true>(F.lds + RING_OFF, g, S, E, FRESH_TID());
            if (!(bid_ & 1))
            for (int skr = 0; skr < SK_REP; ++skr) { SkRes Es{YB, X, DN_ALPHA}; skinny_gemm(bid_, G_, FRESH_TID(), wave_, F.lds + RING_OFF, OCAT + (size_t)MP * D, D, WO, D, D / 32, Es); }
        PHASE_END
        PHASE_BEGIN(true, 8)
            const float* gg = ln1_g + (size_t)l * D; const float* bb = ln1_b + (size_t)l * D;
            for (int row = 2 * gw_; row < MR; row += 2 * NGW_) ln_two_rows<false>(lane, YB + (size_t)row * D, YB + (size_t)(row + 1) * D, gg, bb, X + (size_t)row * D, X + (size_t)(row + 1) * D, nullptr, nullptr);
        PHASE_END
        PHASE_BEGIN(true, 9)
            for (int dl = 0; dl < 3 * STAG * (bid_ >> 1 & 3); ++dl) __builtin_amdgcn_s_sleep(127);
            if (bid_ & 1) { SkSwiGLU Es{HB}; skinny_gemm(bid_, G_, FRESH_TID(), wave_, F.lds + RING_OFF, X + (size_t)MP * D, D, WFI, D, DFF / 16, Es); }
            pg8::Gemm g{X, WFI, MP, 2 * DFF, D}; pg8::StaticOrder S; S.init(MP, 2 * DFF, G_, bid_); pg8::EpiSwiGLU E{HB, DFF};
            pg8::gemm_phase<pg8::EpiSwiGLU, pg8::StaticOrder, true, true>(F.lds + RING_OFF, g, S, E, FRESH_TID());
            if (!(bid_ & 1))
            for (int skr = 0; skr < SK_REP; ++skr) { SkSwiGLU Es{HB}; skinny_gemm(bid_, G_, FRESH_TID(), wave_, F.lds + RING_OFF, X + (size_t)MP * D, D, WFI, D, DFF / 16, Es); }
        PHASE_END
        PHASE_BEGIN(true, 10)
            if (bid_ & 1) { SkRes Es{YB, X, DN_ALPHA}; skinny_gemm(bid_, G_, FRESH_TID(), wave_, F.lds + RING_OFF, HB + (size_t)MP * DFF, DFF, WFO, DFF, D / 32, Es); }
            pg8::Gemm g{HB, WFO, MP, D, DFF}; pg8::StaticOrder S; S.init(MP, D, G_, bid_); pg8::EpiRes E{YB, X, D, DN_ALPHA};
            pg8::gemm_phase<pg8::EpiRes, pg8::StaticOrder, true, true>(F.lds + RING_OFF, g, S, E, FRESH_TID());
            if (!(bid_ & 1))
            for (int skr = 0; skr < SK_REP; ++skr) { SkRes Es{YB, X, DN_ALPHA}; skinny_gemm(bid_, G_, FRESH_TID(), wave_, F.lds + RING_OFF, HB + (size_t)MP * DFF, DFF, WFO, DFF, D / 32, Es); }
        PHASE_END
        PHASE_BEGIN(true, 8)
            if (l < 3) CONVERT_WEIGHTS(l + 1);
            const float* gg = ln2_g + (size_t)l * D; const float* bb = ln2_b + (size_t)l * D;
            if (l == 3) { for (int row = 2 * gw_; row < MR; row += 2 * NGW_) { float* of = row < MP ? out + O_YP + (size_t)row * D : out + O_YS + (size_t)(row - MP) * D;
                ln_two_rows<true>(lane, YB + (size_t)row * D, YB + (size_t)(row + 1) * D, gg, bb, nullptr, nullptr, of, of + D); } }
            else for (int row = 2 * gw_; row < MR; row += 2 * NGW_) ln_two_rows<false>(lane, YB + (size_t)row * D, YB + (size_t)(row + 1) * D, gg, bb, X + (size_t)row * D, X + (size_t)(row + 1) * D, nullptr, nullptr);
        PHASE_END
    }
#if defined(DIAG_A)
    if (blockIdx.x == 0 && threadIdx.x == 0) { unsigned long long* dts = (unsigned long long*)(args.ws_ + 262144); dts[ph] = rt(); dts[63] = (unsigned long long)ph; }
#endif
#undef ws
#undef out
#undef X
#undef Y
#undef YB
#undef CONVERT_WEIGHTS
#undef CONVERT_CACHE_K
#undef CONVERT_CACHE_V
#undef PHASE_BEGIN
#undef PHASE_END
}

#if defined(DIAG_A)
__device__ const int diag_cls[40] = {0,0, 1,2,3,4,5,6,7,8,9,10,8, 1,2,3,4,5,6,7,8,9,10,8, 1,2,11,7,8,9,10,8, 1,2,11,7,8,9,10,8};
__global__ void diag_tail(float* o, const unsigned long long* dts) {
    __shared__ float dv[2];
    if (threadIdx.x == 0) { const int n = (int)dts[63]; unsigned long long sa = 0, sb = 0; for (int p = 0; p < n; ++p) { const unsigned long long d = dts[p + 1] - dts[p]; const int cl = diag_cls[p]; if (cl == DIAG_A) sa += d; if (cl == DIAG_B) sb += d; }
        dv[0] = (float)sa * 0.01f; dv[1] = (float)sb * 10.0f; }
    __syncthreads();
    for (int i = threadIdx.x; i < 262144; i += blockDim.x) o[O_YS + i] = dv[0];
    if (threadIdx.x == 0) o[O_YP] = dv[1];
}
#endif
#ifndef MK_PER_PHASE
#define MK_PER_PHASE 0
#endif
constexpr int N_PHASES = 1 + 2 * 10 + 2 * 7;
extern "C" void kernel_launch(void* const* d_in, const int* in_sizes, int n_in, void* d_out, int out_size, void* d_ws, size_t ws_size, hipStream_t stream) {
    static int grid = 0;
    if (grid == 0) {
        if (n_in != 22 || in_sizes[0] != MP * D || (size_t)out_size != O_END || ws_size < WS_END) { fprintf(stderr, "kernel_launch: unexpected shapes (n_in %d, in0 %d, out %d, ws %zu); nothing launched\n", n_in, n_in > 0 ? in_sizes[0] : -1, out_size, ws_size); grid = -1; return; }
        int dev = 0, cus = 0, per_cu = 0;
        if (hipGetDevice(&dev) != hipSuccess || hipDeviceGetAttribute(&cus, hipDeviceAttributeMultiprocessorCount, dev) != hipSuccess) { grid = -1; return; }
        if (hipFuncSetAttribute((const void*)mega, hipFuncAttributeMaxDynamicSharedMemorySize, LDS_BYTES) != hipSuccess) { fprintf(stderr, "kernel_launch: hipFuncSetAttribute failed\n"); grid = -1; return; }
        if (hipOccupancyMaxActiveBlocksPerMultiprocessor(&per_cu, (const void*)mega, NWAVES * 64, LDS_BYTES) != hipSuccess || per_cu < 1) fprintf(stderr, "kernel_launch: occupancy query reports %d\n", per_cu);
        (void)hipGetLastError();
        grid = cus;
    }
    if (grid < 0) return;
    if (hipMemsetAsync((char*)d_ws + WS_CTL, 0, CTL_ZERO_BYTES, stream) != hipSuccess) return;
    Args a{};
    for (int i = 0; i < 22; ++i) a.in[i] = (const float*)d_in[i];
    a.out_ = (float*)d_out; a.ws_ = (unsigned char*)d_ws;
#if MK_PER_PHASE
    for (int p = 0; p < N_PHASES; ++p) { a.ph_lo = p; a.ph_hi = p + 1; hipLaunchKernelGGL(mega, dim3(grid), dim3(NWAVES * 64), LDS_BYTES, stream, a); }
#else
    a.ph_lo = 0; a.ph_hi = N_PHASES; hipLaunchKernelGGL(mega, dim3(grid), dim3(NWAVES * 64), LDS_BYTES, stream, a);
#if defined(DIAG_A)
    hipLaunchKernelGGL(diag_tail, dim3(1), dim3(512), 0, stream, (float*)d_out, (const unsigned long long*)((unsigned char*)d_ws + 262144));
#endif
#endif
}
```

```cpp
#include <hip/hip_runtime.h>
#include <cstdio>
#include <cstdint>
namespace pg8 {
#define PG8_LAS __attribute__((address_space(3)))
typedef unsigned short bf16_t;
typedef short bf16x8 __attribute__((ext_vector_type(8)));
typedef float f32x4 __attribute__((ext_vector_type(4)));
typedef unsigned u32x4 __attribute__((ext_vector_type(4)));
constexpr int BM = 256, BK = 64, HALF = 128, HTB = HALF * BK * 2  , STAGE_BYTES = 8 * HTB, NXCD = 8, WGM = 4;

__host__ __device__ __forceinline__ int lds_byte(int r, int c) { const int st = (r >> 4) * 2 + (c >> 5), rr = r & 15, cc = c & 31, ob = rr * 64 + cc * 2; return st * 1024 + (ob ^ (((ob >> 9) & 1) << 5)); }
__host__ __device__ __forceinline__ void stage_rc(int b, int& R, int& C) { const int st = b / 1024, sb = b % 1024, swz = sb ^ (((sb >> 9) & 1) << 5); R = (st >> 1) * 16 + swz / 64; C = (st & 1) * 32 + (swz % 64) / 2; }
__host__ __device__ __forceinline__ int perm32(int rho) { const int n = rho >> 4, i = rho & 15; return 8 * (i >> 2) + 4 * n + (i & 3); }

struct Unit { int pm, pn; };
struct Gemm { const bf16_t* A; const bf16_t* Bt; int M, N, K; };

struct StaticOrder {
    int nM, nN, nwg, G, c;
    __host__ __device__ void init(int M, int N, int G_, int c_) { nM = M / BM; nN = N / BM; nwg = nM * nN; G = G_; c = c_; }
    __host__ __device__ bool next(int i, Unit& u) const {
        const long L = (long)i * G + c; if (L >= nwg) return false;
        int wgid = (int)L; { const int q = nwg / NXCD, r = nwg % NXCD, xcd = wgid % NXCD, off = wgid / NXCD; wgid = (xcd < r ? xcd * (q + 1) : r * (q + 1) + (xcd - r) * q) + off; }
        const int nig = WGM * nN, gid = wgid / nig, fm = gid * WGM, gsz = (nM - fm) < WGM ? (nM - fm) : WGM;
        u.pm = fm + ((wgid % nig) % gsz); u.pn = (wgid % nig) / gsz; return true;
    }
    __device__ __forceinline__ void a_ready(const Unit&) const {}
    __device__ __forceinline__ void done(const Unit&) const {}
};
__device__ __forceinline__ unsigned cvt_pk_bf16(float lo, float hi) { unsigned r; asm volatile("v_cvt_pk_bf16_f32 %0, %1, %2" : "=v"(r) : "v"(lo), "v"(hi)); return r; }
typedef float f32x2 __attribute__((ext_vector_type(2)));
typedef unsigned u32x2 __attribute__((ext_vector_type(2)));
__host__ __device__ __forceinline__ int vtf_d(int d) { return (d >> 5) * 1024 + (d & 31) * 8; }
__host__ __device__ __forceinline__ int vtf_k(int ks) { return (ks >> 4) * 512 + ((ks >> 2) & 1) * 256 + (ks & 3) + 4 * ((ks >> 3) & 1); }
__device__ __forceinline__ float bflo(unsigned w) { return __builtin_bit_cast(float, w << 16); }
__device__ __forceinline__ float bfhi(unsigned w) { return __builtin_bit_cast(float, w & 0xffff0000u); }
struct EpiBf16 {
    static constexpr bool PERM = true, AFTER_DRAIN = false;
    bf16_t* O; int ldc;
    __device__ __forceinline__ void operator()(const f32x4 (&acc)[2][2][4][2], const Unit& u, int wr, int wc, int fr, int fq) const {
        const int row0 = u.pm * BM + wr * 64 + fr, col0 = u.pn * BM + wc * 32 + 8 * fq;
#pragma unroll
        for (int ai = 0; ai < 2; ++ai)
#pragma unroll
            for (int m = 0; m < 4; ++m) { bf16_t* rowp = O + (size_t)(row0 + ai * HALF + m * 16) * ldc + col0;
#pragma unroll
                for (int bj = 0; bj < 2; ++bj) { const f32x4 v0 = acc[ai][bj][m][0], v1 = acc[ai][bj][m][1];
                    u32x4 w; w.x = cvt_pk_bf16(v0[0], v0[1]); w.y = cvt_pk_bf16(v0[2], v0[3]); w.z = cvt_pk_bf16(v1[0], v1[1]); w.w = cvt_pk_bf16(v1[2], v1[3]);
                    *(u32x4*)(rowp + bj * HALF) = w; } }
    }
};
struct EpiSwiGLU {
    static constexpr bool PERM = true, AFTER_DRAIN = false;
    bf16_t* Hh; int ldh;
    __device__ __forceinline__ float swi(float g, float up) const { return g * __builtin_amdgcn_rcpf(1.0f + __expf(-g)) * up; }
    __device__ __forceinline__ void operator()(const f32x4 (&acc)[2][2][4][2], const Unit& u, int wr, int wc, int fr, int fq) const {
        const int row0 = u.pm * BM + wr * 64 + fr, col0 = u.pn * HALF + wc * 32 + 8 * fq;
#pragma unroll
        for (int ai = 0; ai < 2; ++ai)
#pragma unroll
            for (int m = 0; m < 4; ++m) { bf16_t* rowp = Hh + (size_t)(row0 + ai * HALF + m * 16) * ldh + col0;
                const f32x4 g0 = acc[ai][0][m][0], g1 = acc[ai][0][m][1], u0 = acc[ai][1][m][0], u1 = acc[ai][1][m][1];
                u32x4 w; w.x = cvt_pk_bf16(swi(g0[0], u0[0]), swi(g0[1], u0[1])); w.y = cvt_pk_bf16(swi(g0[2], u0[2]), swi(g0[3], u0[3]));
                w.z = cvt_pk_bf16(swi(g1[0], u1[0]), swi(g1[1], u1[1])); w.w = cvt_pk_bf16(swi(g1[2], u1[2]), swi(g1[3], u1[3]));
                *(u32x4*)rowp = w; }
    }
};
struct EpiRes {
    static constexpr bool PERM = true, AFTER_DRAIN = false;
    bf16_t* Y; const bf16_t* X; int ldc; float alpha;
    __device__ __forceinline__ void operator()(const f32x4 (&acc)[2][2][4][2], const Unit& u, int wr, int wc, int fr, int fq) const {
        const int row0 = u.pm * BM + wr * 64 + fr, col0 = u.pn * BM + wc * 32 + 8 * fq;
        u32x4 xv[2][4][2];
#pragma unroll
        for (int ai = 0; ai < 2; ++ai)
#pragma unroll
            for (int m = 0; m < 4; ++m)
#pragma unroll
                for (int bj = 0; bj < 2; ++bj) xv[ai][m][bj] = *(const u32x4*)(X + (size_t)(row0 + ai * HALF + m * 16) * ldc + col0 + bj * HALF);
#pragma unroll
        for (int ai = 0; ai < 2; ++ai)
#pragma unroll
            for (int m = 0; m < 4; ++m) { const size_t ro = (size_t)(row0 + ai * HALF + m * 16) * ldc + col0;
#pragma unroll
                for (int bj = 0; bj < 2; ++bj) { const u32x4 x4 = xv[ai][m][bj]; const f32x4 a0 = acc[ai][bj][m][0], a1 = acc[ai][bj][m][1];
                    u32x4 w; w.x = cvt_pk_bf16(alpha * bflo(x4.x) + a0[0], alpha * bfhi(x4.x) + a0[1]); w.y = cvt_pk_bf16(alpha * bflo(x4.y) + a0[2], alpha * bfhi(x4.y) + a0[3]);
                    w.z = cvt_pk_bf16(alpha * bflo(x4.z) + a1[0], alpha * bfhi(x4.z) + a1[1]); w.w = cvt_pk_bf16(alpha * bflo(x4.w) + a1[2], alpha * bfhi(x4.w) + a1[3]);
                    *(u32x4*)(Y + ro + bj * HALF) = w; } }
    }
};
struct EpiKV {
    static constexpr bool PERM = false, AFTER_DRAIN = false;
    float *okp, *ovp, *oks, *ovs; bf16_t *kpb, *vpb, *ksb, *vsb;
    __device__ __forceinline__ void operator()(const f32x4 (&acc)[2][2][4][2], const Unit& u, int wr, int wc, int fr, int fq) const {
        const bool isv = u.pn >= 6; const int colt = (u.pn - (isv ? 6 : 0)) * BM + wc * 32 + 4 * fq, row0 = u.pm * BM + wr * 64 + fr;
        float* op = isv ? ovp : okp;
#pragma unroll
        for (int ai = 0; ai < 2; ++ai)
#pragma unroll
            for (int m = 0; m < 4; ++m) { const int row = row0 + ai * HALF + m * 16; float* fd;
                if (row < 32768) { fd = op + (size_t)row * 1536; } else continue;
                const int bq = row >> 13, sq = row & 8191;
#pragma unroll
                for (int bj = 0; bj < 2; ++bj)
#pragma unroll
                    for (int n = 0; n < 2; ++n) { const int c = colt + bj * HALF + n * 16; const f32x4 v = acc[ai][bj][m][n];
                        *(f32x4*)(fd + c) = v; const unsigned w0 = cvt_pk_bf16(v[0], v[1]), w1 = cvt_pk_bf16(v[2], v[3]);
                        const int hq = c >> 7, dq = c & 127;
                        if (!isv) { u32x2 w; w.x = w0; w.y = w1; *(u32x2*)(kpb + ((size_t)(bq * 12 + hq) * 8192 + sq) * 128 + dq) = w; }
                        else { bf16_t* vt = vpb + ((size_t)(bq * 12 + hq) * 256 + (sq >> 5)) * 4096 + vtf_d(dq) + vtf_k(sq & 31); vt[0] = (bf16_t)w0; vt[8] = (bf16_t)(w0 >> 16); vt[16] = (bf16_t)w1; vt[24] = (bf16_t)(w1 >> 16); } } }
    }
};
struct EpiMemKV {
    static constexpr bool PERM = false, AFTER_DRAIN = false;
    float *ok, *ov; bf16_t *kb, *vb;
    __device__ __forceinline__ void operator()(const f32x4 (&acc)[2][2][4][2], const Unit& u, int wr, int wc, int fr, int fq) const {
        const int l = u.pn >> 2, kv = (u.pn >> 1) & 1, hd0 = (u.pn & 1) * BM + wc * 32 + 4 * fq, row0 = u.pm * BM + wr * 64 + fr;
        float* fo = kv ? ov : ok; bf16_t* bo = kv ? vb : kb;
#pragma unroll
        for (int ai = 0; ai < 2; ++ai)
#pragma unroll
            for (int m = 0; m < 4; ++m) { const int row = row0 + ai * HALF + m * 16, b = row >> 8, mm = row & 255;
                float* fd = fo + (size_t)(l * 1024 + row) * 512; bf16_t* bd = bo + (size_t)((l * 12 + b) * 256 + mm) * 512;
#pragma unroll
                for (int bj = 0; bj < 2; ++bj)
#pragma unroll
                    for (int n = 0; n < 2; ++n) { const int c = hd0 + bj * HALF + n * 16; const f32x4 v = acc[ai][bj][m][n];
                        *(f32x4*)(fd + c) = v; const unsigned w0 = cvt_pk_bf16(v[0], v[1]), w1 = cvt_pk_bf16(v[2], v[3]);
                        if (!kv) { u32x2 w; w.x = w0; w.y = w1; *(u32x2*)(bd + c) = w; }
                        else { bf16_t* vt = vb + (size_t)((l * 12 + b) * 512 + c) * 256 + mm;
                            vt[0] = (bf16_t)w0; vt[256] = (bf16_t)(w0 >> 16); vt[512] = (bf16_t)w1; vt[768] = (bf16_t)(w1 >> 16); } } }
    }
};
template <class Epi, class Sched, bool ALIGN_EPI = false, bool SP2 = false>
__device__ __forceinline__ void gemm_phase(PG8_LAS unsigned char* lds, const Gemm g, const Sched& S, const Epi& E, int tid_in) {
    int tid_ = tid_in; asm volatile("" : "+v"(tid_));
    const int tid = tid_, wid = __builtin_amdgcn_readfirstlane(tid >> 6), lane = tid & 63, wr = wid >> 2, wc = wid & 3, fr = lane & 15, fq = lane >> 4;
    const int K = g.K, nt = K / BK;
    unsigned voffA[2], voffB[2];
#pragma unroll
    for (int i = 0; i < 2; ++i) { int R, C; stage_rc(tid * 16 + i * 8192, R, C); const int Rb = Epi::PERM ? ((R & ~31) + perm32(R & 31)) : R;
        voffA[i] = (unsigned)(R * K + C) * 2u; voffB[i] = (unsigned)(Rb * K + C) * 2u; }
    const size_t kstep = (size_t)(BK * 2);
    const size_t hstep = (size_t)HALF * K * 2;
    const size_t tstep = 2 * hstep;
    const unsigned ldsw = (unsigned)wid * 1024u;
    const int aoff = lds_byte(wr * 64 + fr, fq * 8), boff = lds_byte(wc * 32 + fr, fq * 8);
#define PG8_SA(b, h) (((b) * 2 + (h)) * HTB)
#define PG8_SB(b, h) ((4 + (b) * 2 + (h)) * HTB)
#define PG8_STAGE_X(bufoff, gbase, voff, aux) do { _Pragma("unroll") for (int _i = 0; _i < 2; ++_i) \
        __builtin_amdgcn_global_load_lds((const unsigned*)((const char*)(gbase) + (voff)[_i]), (PG8_LAS unsigned*)(lds + (bufoff) + ldsw + _i * 8192), 16, 0, aux); } while (0)
#ifndef PG8_B_AUX
#define PG8_B_AUX 0
#endif
#define PG8_STAGE(bufoff, gbase, voff) PG8_STAGE_X(bufoff, gbase, voff, 0)
#define PG8_LDA(dst, b, h) do { _Pragma("unroll") for (int m = 0; m < 4; ++m) _Pragma("unroll") for (int k = 0; k < 2; ++k) dst[m][k] = *(const PG8_LAS bf16x8*)(lds + PG8_SA(b, h) + aoff + m * 2048 + k * 1024); } while (0)
#define PG8_LDB(dst, b, h) do { _Pragma("unroll") for (int n = 0; n < 2; ++n) _Pragma("unroll") for (int k = 0; k < 2; ++k) dst[n][k] = *(const PG8_LAS bf16x8*)(lds + PG8_SB(b, h) + boff + n * 2048 + k * 1024); } while (0)
#define PG8_MMA(ai, bj, At, Bt) do { __builtin_amdgcn_s_setprio(1); _Pragma("unroll") for (int m = 0; m < 4; ++m) _Pragma("unroll") for (int n = 0; n < 2; ++n) _Pragma("unroll") for (int k = 0; k < 2; ++k) \
        acc[ai][bj][m][n] = __builtin_amdgcn_mfma_f32_16x16x32_bf16(Bt[n][k], At[m][k], acc[ai][bj][m][n], 0, 0, 0); __builtin_amdgcn_s_setprio(0); } while (0)
#define PG8_WAIT_V(n) asm volatile("s_waitcnt vmcnt(" #n ")" ::: "memory")
#define PG8_WAIT_L(n) asm volatile("s_waitcnt lgkmcnt(" #n ")" ::: "memory")
#define PG8_BAR __builtin_amdgcn_s_barrier()
#define PG8_SCHED __builtin_amdgcn_sched_barrier(0)
    Unit cur, nxt; int ui = 0;
    if (!S.next(0, cur)) return;
    f32x4 acc[2][2][4][2];
#pragma unroll
    for (int a = 0; a < 2; ++a)
#pragma unroll
        for (int b = 0; b < 2; ++b)
#pragma unroll
            for (int m = 0; m < 4; ++m)
#pragma unroll
                for (int n = 0; n < 2; ++n) acc[a][b][m][n] = (f32x4){0.f, 0.f, 0.f, 0.f};
    bf16x8 At[4][2], B0[2][2], B1[2][2];
    const char* cA = (const char*)g.A + (size_t)cur.pm * tstep; const char* cB = (const char*)g.Bt + (size_t)cur.pn * tstep;
    S.a_ready(cur);
    if constexpr (SP2) {
        PG8_STAGE_X(PG8_SB(0, 0), cB, voffB, PG8_B_AUX); PG8_STAGE_X(PG8_SB(0, 1), cB + hstep, voffB, PG8_B_AUX); PG8_STAGE(PG8_SA(0, 0), cA, voffA); PG8_STAGE(PG8_SA(0, 1), cA + hstep, voffA);
        if (wr == 1) PG8_BAR;
        PG8_WAIT_V(2); PG8_BAR;
        PG8_STAGE_X(PG8_SB(1, 0), cB + kstep, voffB, PG8_B_AUX); PG8_STAGE(PG8_SA(1, 0), cA + kstep, voffA); PG8_STAGE_X(PG8_SB(1, 1), cB + hstep + kstep, voffB, PG8_B_AUX);
        PG8_WAIT_V(6); PG8_BAR;
    } else {
        PG8_STAGE_X(PG8_SB(0, 0), cB, voffB, PG8_B_AUX); PG8_STAGE(PG8_SA(0, 0), cA, voffA); PG8_STAGE_X(PG8_SB(0, 1), cB + hstep, voffB, PG8_B_AUX); PG8_STAGE(PG8_SA(0, 1), cA + hstep, voffA);
        if (wr == 1) PG8_BAR;
        PG8_WAIT_V(4); PG8_BAR;
        PG8_STAGE_X(PG8_SB(1, 0), cB + kstep, voffB, PG8_B_AUX); PG8_STAGE(PG8_SA(1, 0), cA + kstep, voffA); PG8_STAGE_X(PG8_SB(1, 1), cB + hstep + kstep, voffB, PG8_B_AUX);
        PG8_WAIT_V(6); PG8_BAR;
    }
    for (;;) {
        const bool has_next = S.next(ui + 1, nxt);
        const char* nA = has_next ? (const char*)g.A + (size_t)nxt.pm * tstep : cA; const char* nB = has_next ? (const char*)g.Bt + (size_t)nxt.pn * tstep : cB;
        for (int t = 0; t < nt; t += 2) {
            const bool last = (t == nt - 2);
            const char* a1 = cA + (size_t)(t + 1) * kstep;
            const char* a2 = last ? nA : cA + (size_t)(t + 2) * kstep; const char* b2 = last ? nB : cB + (size_t)(t + 2) * kstep;
            const char* a3 = a2 + kstep; const char* b3 = b2 + kstep;
            if (last && has_next) S.a_ready(nxt);
            if constexpr (SP2) {
            PG8_LDB(B0, 0, 0); PG8_LDB(B1, 0, 1); PG8_SCHED; PG8_LDA(At, 0, 0); PG8_STAGE(PG8_SA(1, 1), a1 + hstep, voffA);
            PG8_WAIT_V(8); PG8_WAIT_L(0); PG8_BAR; PG8_MMA(0, 0, At, B0); PG8_MMA(0, 1, At, B1); PG8_BAR; PG8_SCHED;
            PG8_LDA(At, 0, 1); PG8_STAGE_X(PG8_SB(0, 0), b2, voffB, PG8_B_AUX); PG8_STAGE_X(PG8_SB(0, 1), b2 + hstep, voffB, PG8_B_AUX); PG8_STAGE(PG8_SA(0, 0), a2, voffA);
            PG8_WAIT_V(8); PG8_WAIT_L(0); PG8_BAR; PG8_MMA(1, 0, At, B0); PG8_MMA(1, 1, At, B1); PG8_BAR; PG8_SCHED;
            PG8_LDB(B0, 1, 0); PG8_LDB(B1, 1, 1); PG8_SCHED; PG8_LDA(At, 1, 0); PG8_STAGE(PG8_SA(0, 1), a2 + hstep, voffA);
            PG8_WAIT_V(8); PG8_WAIT_L(0); PG8_BAR; PG8_MMA(0, 0, At, B0); PG8_MMA(0, 1, At, B1); PG8_BAR; PG8_SCHED;
            PG8_LDA(At, 1, 1); PG8_STAGE_X(PG8_SB(1, 0), b3, voffB, PG8_B_AUX); PG8_STAGE_X(PG8_SB(1, 1), b3 + hstep, voffB, PG8_B_AUX); PG8_STAGE(PG8_SA(1, 0), a3, voffA);
            PG8_WAIT_V(8); PG8_WAIT_L(0); PG8_BAR; PG8_MMA(1, 0, At, B0); PG8_MMA(1, 1, At, B1); PG8_BAR; PG8_SCHED;
            } else {
            PG8_LDB(B0, 0, 0); PG8_SCHED; PG8_LDA(At, 0, 0); PG8_STAGE(PG8_SA(1, 1), a1 + hstep, voffA);
            PG8_WAIT_L(8); PG8_BAR; PG8_WAIT_L(0); PG8_MMA(0, 0, At, B0); PG8_BAR; PG8_SCHED;
            PG8_LDB(B1, 0, 1); PG8_STAGE_X(PG8_SB(0, 0), b2, voffB, PG8_B_AUX);
            PG8_BAR; PG8_WAIT_L(0); PG8_MMA(0, 1, At, B1); PG8_BAR;
            PG8_LDA(At, 0, 1); PG8_STAGE(PG8_SA(0, 0), a2, voffA);
            PG8_BAR; PG8_WAIT_L(0); PG8_MMA(1, 0, At, B0); PG8_BAR; PG8_SCHED;
            PG8_STAGE_X(PG8_SB(0, 1), b2 + hstep, voffB, PG8_B_AUX);
            PG8_WAIT_V(6); PG8_BAR; PG8_MMA(1, 1, At, B1); PG8_BAR;
            PG8_LDB(B0, 1, 0); PG8_SCHED; PG8_LDA(At, 1, 0); PG8_STAGE(PG8_SA(0, 1), a2 + hstep, voffA);
            PG8_WAIT_L(8); PG8_BAR; PG8_WAIT_L(0); PG8_MMA(0, 0, At, B0); PG8_BAR; PG8_SCHED;
            PG8_LDB(B1, 1, 1); PG8_STAGE_X(PG8_SB(1, 0), b3, voffB, PG8_B_AUX);
            PG8_BAR; PG8_WAIT_L(0); PG8_MMA(0, 1, At, B1); PG8_BAR;
            PG8_LDA(At, 1, 1); PG8_STAGE(PG8_SA(1, 0), a3, voffA);
            PG8_BAR; PG8_WAIT_L(0); PG8_MMA(1, 0, At, B0); PG8_BAR; PG8_SCHED;
            PG8_STAGE_X(PG8_SB(1, 1), b3 + hstep, voffB, PG8_B_AUX);
            PG8_WAIT_V(6); PG8_BAR; PG8_MMA(1, 1, At, B1); PG8_BAR;
            }
        }
        if constexpr (ALIGN_EPI) { if (wr == 0) PG8_BAR; }
        if constexpr (!Epi::AFTER_DRAIN) { E(acc, cur, wr, wc, fr, fq); S.done(cur); }
        if (!has_next) break;
#pragma unroll
        for (int a = 0; a < 2; ++a)
#pragma unroll
            for (int b = 0; b < 2; ++b)
#pragma unroll
                for (int m = 0; m < 4; ++m)
#pragma unroll
                    for (int n = 0; n < 2; ++n) acc[a][b][m][n] = (f32x4){0.f, 0.f, 0.f, 0.f};
        cur = nxt; cA = nA; cB = nB; ++ui;
        if constexpr (ALIGN_EPI) { if (wr == 1) PG8_BAR; }
    }
    PG8_WAIT_V(0);
    if constexpr (!ALIGN_EPI) { if (wr == 0) PG8_BAR; }
    PG8_BAR;
    if constexpr (Epi::AFTER_DRAIN) { E.fused(acc, cur, wr, wc, fr, fq, lds, wid, lane); S.done(cur); }
#undef PG8_SA
#undef PG8_SB
#undef PG8_STAGE
#undef PG8_STAGE_X
#undef PG8_LDA
#undef PG8_LDB
#undef PG8_MMA
#undef PG8_WAIT_V
#undef PG8_WAIT_L
#undef PG8_BAR
#undef PG8_SCHED
}
}
#define GAS __attribute__((address_space(1)))
#define LAS __attribute__((address_space(3)))
typedef unsigned short bf16;
typedef unsigned v4u __attribute__((ext_vector_type(4)));
typedef float f32x4 __attribute__((ext_vector_type(4)));
typedef short bf16x8 __attribute__((ext_vector_type(8)));
typedef GAS unsigned gu32;
typedef GAS unsigned long long gu64;
#define RLX_AGENT __ATOMIC_RELAXED, __HIP_MEMORY_SCOPE_AGENT
#define LDS_WAIT() asm volatile("s_waitcnt lgkmcnt(0)" ::: "memory")
#define VM_WAIT() asm volatile("s_waitcnt vmcnt(0)" ::: "memory")
__device__ __forceinline__ unsigned long long rt() { return __builtin_amdgcn_s_memrealtime(); }
__device__ __forceinline__ unsigned f2bf(float f) { unsigned u = __builtin_bit_cast(unsigned, f); return (u + 0x7fffu + ((u >> 16) & 1u)) >> 16; }
__device__ __forceinline__ unsigned pk2(float lo, float hi) { return f2bf(lo) | (f2bf(hi) << 16); }
#define XB_TMO      128
#define XB_XCNT(j)  (256  + 64 * (j))
#define XB_XSUB(j)  (1280 + 64 * (j))
#define XB_XGEN(j)  (2304 + 64 * (j))
#define XB_TOP      3328
#define XB_TOPGEN   3392
#define XCD_BAR_WORDS 3456
#define XB_SPIN_CAP (1u << 18)

__device__ __forceinline__ unsigned xb_ld(unsigned* p)              { return __hip_atomic_load(p, __ATOMIC_RELAXED, __HIP_MEMORY_SCOPE_AGENT); }
__device__ __forceinline__ unsigned xb_add(unsigned* p, unsigned v) { return __hip_atomic_fetch_add(p, v, __ATOMIC_RELAXED, __HIP_MEMORY_SCOPE_AGENT); }
__device__ __forceinline__ unsigned xb_xcc_id() { return (unsigned)__builtin_amdgcn_s_getreg((3 << 11) | 20) & 0xFu; }
#define XB_SPIN(cond, bar) do { unsigned _sp = 0; while (cond) { __builtin_amdgcn_s_sleep(1); \
    if ((++_sp & 255u) == 0u) { if (xb_ld(&(bar)[XB_TMO])) break; if (_sp > XB_SPIN_CAP) { atomicAdd(&(bar)[XB_TMO], 1u); break; } } } } while (0)

struct XcdBarrier {
    unsigned* bar; unsigned x;
    volatile LAS unsigned* st;
};

__device__ __forceinline__ XcdBarrier xcd_barrier_post(unsigned* bar, volatile LAS unsigned* st) {
    XcdBarrier b; b.bar = bar; b.x = xb_xcc_id(); b.st = st;
    if (threadIdx.x == 0) (void)xb_add(&bar[XB_XCNT(b.x)], 1u);
    return b;
}
__device__ __forceinline__ void xcd_barrier_complete(unsigned* bar, unsigned x, unsigned& nloc, unsigned& nx) {
    const unsigned G = gridDim.x * gridDim.y * gridDim.z;
    unsigned sum, cnt, mine, sp = 0u;
    for (;;) {
        sum = 0u; cnt = 0u; mine = 0u;
#pragma unroll
        for (unsigned j = 0; j < 16; ++j) { const unsigned c = xb_ld(&bar[XB_XCNT(j)]); sum += c; cnt += (c > 0u) ? 1u : 0u; mine = (j == x) ? c : mine; }
        if (sum == G) break;
        __builtin_amdgcn_s_sleep(1);
        if ((++sp & 255u) == 0u) { if (xb_ld(&bar[XB_TMO])) break; if (sp > XB_SPIN_CAP) { atomicAdd(&bar[XB_TMO], 1u); break; } }
    }
    nloc = mine > 0u ? mine : 1u; nx = cnt > 0u ? cnt : 1u;
}

__device__ __forceinline__ void xcd_barrier(const XcdBarrier& b) {
    asm volatile("s_waitcnt vmcnt(0)" ::: "memory");
    __syncthreads();
    if (threadIdx.x == 0) {
        unsigned* bar = b.bar;
        __builtin_amdgcn_s_waitcnt(0);
        unsigned nloc = b.st[0], nx = b.st[1];
        if (nloc == 0u) { xcd_barrier_complete(bar, b.x, nloc, nx); b.st[0] = nloc; b.st[1] = nx; }
        const unsigned old = xb_add(&bar[XB_XSUB(b.x)], 1u);
        const unsigned gen = old / nloc;
        if (old + 1u == (gen + 1u) * nloc) {
            __builtin_amdgcn_fence(__ATOMIC_RELEASE, "agent");
            asm volatile("s_waitcnt vmcnt(0)" ::: "memory");
            const unsigned og = xb_add(&bar[XB_TOP], 1u);
            const unsigned tg = og / nx;
            if (og + 1u == (tg + 1u) * nx) xb_add(&bar[XB_TOPGEN], 1u);
            else XB_SPIN(xb_ld(&bar[XB_TOPGEN]) == tg, bar);
            __builtin_amdgcn_fence(__ATOMIC_ACQUIRE, "agent");
            xb_add(&bar[XB_XGEN(b.x)], 1u);
            asm volatile("s_waitcnt vmcnt(0)" ::: "memory");
        } else {
            XB_SPIN(xb_ld(&bar[XB_XGEN(b.x)]) == gen, bar);
            __builtin_amdgcn_fence(__ATOMIC_ACQUIRE, "agent");
            asm volatile("s_waitcnt vmcnt(0)" ::: "memory");
        }
    }
    __syncthreads();
}
constexpr int NWAVES = 8;
constexpr int D = 2048, SEQ = 8192, MP = 32768, MS = 128, MR = 32896, MT = 33024;
constexpr int DFF = 5632, NA = 5376, NBQ = 2048, NKV = 3072;
constexpr int CQ = 0, CK = 768, CV = 1536, CG = 3072, CQM = 4608, CLR = 5120;
constexpr float DN_ALPHA = 1.6817928305074292f, LN_EPS = 1e-5f, RMS_EPS = 1e-6f;
constexpr float GLA_QSCALE = 0.07216878364870323f, HD_SCALE = 0.08838834764831845f;
constexpr size_t MiB = 1u << 20;
constexpr size_t WS_CTL = 0, CTL_ZERO_BYTES = 1 * MiB;
constexpr size_t WS_WIN = 1 * MiB, WS_WO = 22 * MiB, WS_WFI = 30 * MiB, WS_WFO = 74 * MiB, WS_WMEM = 96 * MiB, WS_MEMX = 112 * MiB, WS_MEMK = 116 * MiB, WS_MEMV = 128 * MiB;
constexpr size_t WS_X = 140 * MiB, WS_Y = 269 * MiB, WS_R1 = 527 * MiB, WS_OCAT = 882 * MiB, WS_SBKS = 1011 * MiB, WS_SBVS = 1060 * MiB, WS_END = 1109 * MiB;
static_assert(WS_WIN + (size_t)NA * D * 2 <= WS_WO && WS_WFI + (size_t)2 * DFF * D * 2 <= WS_WFO && WS_WFO + (size_t)D * DFF * 2 <= WS_WMEM, "weights map");
static_assert(WS_X + (size_t)MT * D * 2 <= WS_Y && WS_Y + (size_t)MT * D * 4 <= WS_R1 && WS_R1 + (size_t)MT * DFF * 2 <= WS_OCAT && WS_OCAT + (size_t)MT * D * 2 <= WS_SBKS, "activation map");
static_assert(WS_SBKS + (size_t)8 * 2064 * 1536 * 2 <= WS_SBVS && WS_SBVS + (size_t)8 * 2064 * 1536 * 2 <= WS_END, "sb sample map");
constexpr size_t O_YP = 0, O_YS = 67108864, O_GSP = 67371008, O_GSS = 69730304, O_SKP = 74448896, O_SVP = 124780544, O_SKS = 175112192, O_SVS = 175308800, O_MKP = 175505408, O_MVP = 177602560, O_END = 179699712;
constexpr int CW_BAR = 4096;
constexpr int RING_OFF = 0, RING_BYTES = 131072, LDSCTL_OFF = RING_BYTES, MISC_OFF = LDSCTL_OFF + 320, LDS_BYTES = 147456;

struct Args { const float* in[22]; float* out_; unsigned char* ws_; int ph_lo, ph_hi; };
struct Frame {
    LAS unsigned char* lds; volatile LAS unsigned* MISC; gu32* ctl;
    int tid, lane, wave, G, gw, NGW;
};
__device__ __forceinline__ float bf2f(bf16 h) { return __builtin_bit_cast(float, (unsigned)h << 16); }
__device__ __forceinline__ float shx(float v, int lane, int m) { return __builtin_bit_cast(float, __builtin_amdgcn_ds_bpermute((lane ^ m) << 2, __builtin_bit_cast(int, v))); }
__device__ __forceinline__ float wave_sum(float v, int lane) {
#pragma unroll
    for (int o = 1; o < 64; o <<= 1) v += shx(v, lane, o);
    return v;
}
__device__ __forceinline__ float wave_max(float v, int lane) {
#pragma unroll
    for (int o = 1; o < 64; o <<= 1) v = fmaxf(v, shx(v, lane, o));
    return v;
}
__device__ __forceinline__ void cvt_row(const float* src, bf16* dst, int n, int lane) {
    for (int j = lane * 4; j < n; j += 256) {
        f32x4 v = src ? *(const f32x4*)(src + j) : (f32x4){0.f, 0.f, 0.f, 0.f};
        unsigned long long w = (unsigned long long)pk2(v.x, v.y) | ((unsigned long long)pk2(v.z, v.w) << 32);
        *(unsigned long long*)(dst + j) = w;
    }
}
template <int N>
__device__ __forceinline__ void cvt_rows2(const float* s0, const float* s1, bf16* d0, bf16* d1, int lane) {
    f32x4 v0[N / 256], v1[N / 256];
#pragma unroll
    for (int j = 0; j < N / 256; ++j) { v0[j] = s0 ? *(const f32x4*)(s0 + lane * 4 + 256 * j) : (f32x4){0.f, 0.f, 0.f, 0.f}; v1[j] = s1 ? *(const f32x4*)(s1 + lane * 4 + 256 * j) : (f32x4){0.f, 0.f, 0.f, 0.f}; }
#pragma unroll
    for (int j = 0; j < N / 256; ++j) {
        *(unsigned long long*)(d0 + lane * 4 + 256 * j) = (unsigned long long)pk2(v0[j].x, v0[j].y) | ((unsigned long long)pk2(v0[j].z, v0[j].w) << 32);
        *(unsigned long long*)(d1 + lane * 4 + 256 * j) = (unsigned long long)pk2(v1[j].x, v1[j].y) | ((unsigned long long)pk2(v1[j].z, v1[j].w) << 32); }
}
__device__ __forceinline__ int fresh_lane() { int z = 0; asm volatile("" : "+s"(z)); return (int)__builtin_amdgcn_mbcnt_hi(~0u, __builtin_amdgcn_mbcnt_lo(~0u, (unsigned)z)); }
#define FRESH_TID() (wave_ * 64 + fresh_lane())
template <bool FINAL>
__device__ __forceinline__ void ln_two_rows(int lane, const v4u (&w)[2][4], const float* gg, const float* bb, bf16* x0, bf16* x1, float* of0, float* of1) {
    float v[2][4][8]; float s[2] = {0.f, 0.f};
#pragma unroll
    for (int r = 0; r < 2; ++r)
#pragma unroll
        for (int j = 0; j < 4; ++j) { const v4u q = w[r][j]; v[r][j][0] = pg8::bflo(q.x); v[r][j][1] = pg8::bfhi(q.x); v[r][j][2] = pg8::bflo(q.y); v[r][j][3] = pg8::bfhi(q.y); v[r][j][4] = pg8::bflo(q.z); v[r][j][5] = pg8::bfhi(q.z); v[r][j][6] = pg8::bflo(q.w); v[r][j][7] = pg8::bfhi(q.w);
            s[r] += ((v[r][j][0] + v[r][j][1]) + (v[r][j][2] + v[r][j][3])) + ((v[r][j][4] + v[r][j][5]) + (v[r][j][6] + v[r][j][7])); }
    const float m0 = wave_sum(s[0], lane) * (1.f / D), m1 = wave_sum(s[1], lane) * (1.f / D); float q0 = 0.f, q1 = 0.f;
#pragma unroll
    for (int j = 0; j < 4; ++j)
#pragma unroll
        for (int i = 0; i < 8; ++i) { v[0][j][i] -= m0; q0 += v[0][j][i] * v[0][j][i]; v[1][j][i] -= m1; q1 += v[1][j][i] * v[1][j][i]; }
    const float rs[2] = {1.f / sqrtf(wave_sum(q0, lane) * (1.f / D) + LN_EPS), 1.f / sqrtf(wave_sum(q1, lane) * (1.f / D) + LN_EPS)};
#pragma unroll
    for (int j = 0; j < 4; ++j) { const int e0 = (lane + 64 * j) * 8; const f32x4 g0 = *(const f32x4*)(gg + e0), g1 = *(const f32x4*)(gg + e0 + 4), b0 = *(const f32x4*)(bb + e0), b1 = *(const f32x4*)(bb + e0 + 4);
#pragma unroll
        for (int r = 0; r < 2; ++r) { float o[8];
#pragma unroll
            for (int i = 0; i < 4; ++i) { o[i] = v[r][j][i] * rs[r] * g0[i] + b0[i]; o[4 + i] = v[r][j][4 + i] * rs[r] * g1[i] + b1[i]; }
            if (FINAL) { float* of = r ? of1 : of0; *(f32x4*)(of + e0) = (f32x4){o[0], o[1], o[2], o[3]}; *(f32x4*)(of + e0 + 4) = (f32x4){o[4], o[5], o[6], o[7]}; }
            else { v4u p; p.x = pk2(o[0], o[1]); p.y = pk2(o[2], o[3]); p.z = pk2(o[4], o[5]); p.w = pk2(o[6], o[7]); *(v4u*)((r ? x1 : x0) + e0) = p; } } }
}
template <bool FINAL, class OutF>
__device__ __forceinline__ void ln_rows(int lane, int gw, int NGW, const bf16* YBp, const float* gg, const float* bb, bf16* Xp, OutF outf) {
    const bool has_ex = gw < MR - MP; const int exrow = MP + gw; v4u ex[2][4];
    if (has_ex) {
#pragma unroll
        for (int j = 0; j < 4; ++j) ex[0][j] = ((const v4u*)(YBp + (size_t)exrow * D))[lane + 64 * j]; }
    __builtin_amdgcn_sched_barrier(0);
#pragma unroll 1
    for (int row = 2 * gw; row < MP; row += 2 * NGW) { v4u w[2][4];
#pragma unroll
        for (int j = 0; j < 4; ++j) { w[0][j] = ((const v4u*)(YBp + (size_t)row * D))[lane + 64 * j]; w[1][j] = ((const v4u*)(YBp + (size_t)(row + 1) * D))[lane + 64 * j]; }
        if (FINAL) { float* of = outf(row); ln_two_rows<true>(lane, w, gg, bb, nullptr, nullptr, of, of + D); }
        else ln_two_rows<false>(lane, w, gg, bb, Xp + (size_t)row * D, Xp + (size_t)(row + 1) * D, nullptr, nullptr); }
    if (has_ex) {
#pragma unroll
        for (int j = 0; j < 4; ++j) ex[1][j] = ex[0][j];
        if (FINAL) { float* of = outf(exrow); ln_two_rows<true>(lane, ex, gg, bb, nullptr, nullptr, of, of); }
        else ln_two_rows<false>(lane, ex, gg, bb, Xp + (size_t)exrow * D, Xp + (size_t)exrow * D, nullptr, nullptr); }
}
struct MapId { __device__ __forceinline__ int operator()(int n) const { return n; } };
struct MapInA { __device__ __forceinline__ int operator()(int n) const { return n < 4608 ? n : (n < 5120 ? n + 16 : (n < 5136 ? n - 512 : -1)); } };
struct MapFfn { __device__ __forceinline__ int operator()(int n) const { const int t = n >> 8, r = n & 255; return r < 128 ? 128 * t + r : DFF + 128 * t + (r - 128); } };
template <class Map>
__device__ __forceinline__ void wt_convert(LAS unsigned char* ldsb, int wave, int gw, int NGW, int lane, const float* W, int K, int Nsrc, bf16* WT, int Ndst, Map map) {
    LAS float* scr = (LAS float*)(ldsb + RING_OFF + wave * 16384);
    const int nblk = Ndst / 64, nitems = (K / 64) * nblk, nq = lane & 15, kq = lane >> 4;
    for (int it = gw; it < nitems; it += NGW) {
        const int kb = it / nblk, nb = it % nblk, k0 = 64 * kb, n0 = 64 * nb;
        const int sc0 = map(n0 + 4 * nq), sc3 = map(n0 + 4 * nq + 3);
        const bool contig = sc0 >= 0 && sc3 == sc0 + 3;
        f32x4 v[16];
#pragma unroll
        for (int i = 0; i < 16; ++i) { const int kk = 4 * i + kq;
            if (contig) v[i] = *(const f32x4*)(W + (size_t)(k0 + kk) * Nsrc + sc0);
            else {
#pragma unroll
                for (int e = 0; e < 4; ++e) { const int sc = map(n0 + 4 * nq + e); v[i][e] = sc >= 0 ? W[(size_t)(k0 + kk) * Nsrc + sc] : 0.f; } } }
#pragma unroll
        for (int i = 0; i < 16; ++i) { const int kk = 4 * i + kq;
#pragma unroll
            for (int e = 0; e < 4; ++e) { const int n = 4 * nq + e; scr[n * 64 + (kk ^ n)] = v[i][e]; } }
        LDS_WAIT(); asm volatile("" ::: "memory");
        const int c = lane & 7;
#pragma unroll
        for (int j = 0; j < 8; ++j) { const int n = (lane >> 3) + 8 * j; const LAS float* s = scr + n * 64;
#define SWZ(i) s[(8 * c + (i)) ^ n]
            v4u o; o.x = pk2(SWZ(0), SWZ(1)); o.y = pk2(SWZ(2), SWZ(3)); o.z = pk2(SWZ(4), SWZ(5)); o.w = pk2(SWZ(6), SWZ(7));
#undef SWZ
            *(GAS v4u*)(WT + (size_t)(n0 + n) * K + k0 + 8 * c) = o; }
        LDS_WAIT(); asm volatile("" ::: "memory");
    }
}
__device__ __forceinline__ float softplus_f(float z) { return fmaxf(z, 0.f) + log1pf(__expf(-fabsf(z))); }

typedef short s16x4 __attribute__((ext_vector_type(4)));
typedef pg8::u32x2 u32x2;
typedef float f32x16 __attribute__((ext_vector_type(16)));
typedef __bf16 bf16x2_t __attribute__((ext_vector_type(2)));
typedef float f32x2_t __attribute__((ext_vector_type(2)));
__device__ __forceinline__ unsigned cvt2(float lo, float hi) { const f32x2_t v = {lo, hi}; const bf16x2_t b = __builtin_convertvector(v, bf16x2_t); return __builtin_bit_cast(unsigned, b); }
__device__ __forceinline__ bf16x8 pack8(const f32x4 a, const f32x4 b) { v4u p; p.x = cvt2(a[0], a[1]); p.y = cvt2(a[2], a[3]); p.z = cvt2(b[0], b[1]); p.w = cvt2(b[2], b[3]); return __builtin_bit_cast(bf16x8, p); }
__device__ __forceinline__ bf16x8 ld2x8(const bf16* p0, const bf16* p1) { const s16x4 a = *(const s16x4*)p0, b = *(const s16x4*)p1; return __builtin_shufflevector(a, b, 0, 1, 2, 3, 4, 5, 6, 7); }
__device__ __forceinline__ bf16x8 ld16(const bf16* p) { return *(const bf16x8*)p; }
#define MFMA16(a, b, c) __builtin_amdgcn_mfma_f32_16x16x32_bf16((a), (b), (c), 0, 0, 0)
#define MFMA32(a, b, c) __builtin_amdgcn_mfma_f32_32x32x16_bf16((a), (b), (c), 0, 0, 0)

constexpr int QIMG_LD = 200, KTIMG_LD = 68, PKG_Q = 0, PKG_KT = 25600, PKG_G = 51712, IMG_BYTES = 52480, PKG_K = 52480, PKG_VT = 77056, PKG_BYTES = 126208, N_PKG = 2048 + 32;
static_assert(64 * QIMG_LD * 2 == PKG_KT && PKG_KT + 192 * KTIMG_LD * 2 == PKG_G && PKG_G + 768 == IMG_BYTES && PKG_K + 24576 == PKG_VT && PKG_VT + 49152 == PKG_BYTES && IMG_BYTES % 16 == 0, "package map");

__device__ __forceinline__ float softplus_fast(float z) { return fmaxf(z, 0.f) + __logf(1.0f + __expf(-fabsf(z))); }
constexpr int GL_TOT = 0, GL_Q = 6144, GL_K = GL_Q + 64 * QIMG_LD * 2, GL_V = GL_K + 64 * QIMG_LD * 2, VL_LD = 68, GL_P = GL_V + 384 * VL_LD * 2, P_LD = 68, GL_LRN = GL_P + 64 * P_LD * 2, GL_END = GL_LRN + 2048;
static_assert(GL_END <= RING_BYTES && GL_Q % 16 == 0 && GL_K % 16 == 0 && GL_V % 8 == 0 && GL_P % 8 == 0 && GL_LRN % 16 == 0 && MISC_OFF + 256 + 17 * 192 * 4 <= LDS_BYTES, "gla_prep_intra LDS map");
template <int MODE>
__device__ __forceinline__ void gla_prep_intra(int bid, int G, int tid, int wave, LAS unsigned char* lds, int l, const bf16* PROJ, const float* w_gate_lr, const float* b_gate, unsigned char* PKG, bf16* OINT) {
    const int lane = tid & 63, fr = lane & 15, fq = lane >> 4;
    const float* w2 = w_gate_lr + (size_t)l * 16 * 768; const float* bg = b_gate + (size_t)l * 768;
    LAS float* tot = (LAS float*)(lds + GL_TOT);
    LAS bf16* QL = (LAS bf16*)(lds + GL_Q); LAS bf16* KL = (LAS bf16*)(lds + GL_K); LAS bf16* VL = (LAS bf16*)(lds + GL_V); LAS bf16* P = (LAS bf16*)(lds + GL_P);
    LAS unsigned char* LRN = lds + GL_LRN;
    auto item_of = [&](int j) -> int {
        if (MODE == 1) return j < 8 ? ((((j >> 1) << 2) | (bid & 3)) << 7) | ((bid >> 2) + 64 * (j & 1)) : -1;
        if (MODE == 2) return j == 0 ? 2048 + bid : -1;
        const int it = bid + j * G; return it < N_PKG ? it : -1; };
    auto lr_dma = [&](int item) {
        if (wave < 2) { int row0, T; if (item < 2048) { row0 = ((item >> 7) >> 2) * SEQ + (item & 127) * 64; T = 64; } else { row0 = MP + ((item - 2048) >> 2) * 16; T = 16; }
            const int t = 32 * wave + (lane >> 1); const bf16* prow = PROJ + (size_t)(row0 + (t < T ? t : T - 1)) * NA + CLR + 8 * (lane & 1);
            __builtin_amdgcn_global_load_lds((const unsigned*)prow, (LAS unsigned*)(LRN + wave * 1024), 16, 0, 0); } };
    LAS float* W2L = (LAS float*)(lds + MISC_OFF + 256);
    int cur_h = -1;
    { const int i0 = item_of(0); if (i0 >= 0) lr_dma(i0); asm volatile("s_waitcnt vmcnt(0)" ::: "memory"); __syncthreads(); }
    for (int j = 0;; ++j) {
        const int item = item_of(j); if (item < 0) break;
        int h, row0, T;
        if (item < 2048) { const int bh = item >> 7, ch = item & 127; h = bh & 3; row0 = (bh >> 2) * SEQ + ch * 64; T = 64; }
        else { const int i2 = item - 2048; h = i2 & 3; row0 = MP + (i2 >> 2) * 16; T = 16; }
        unsigned char* pk = PKG + (size_t)item * PKG_BYTES;
        bf16* Qt = (bf16*)(pk + PKG_Q); bf16* KT = (bf16*)(pk + PKG_KT); bf16* VT = (bf16*)(pk + PKG_VT); float* Gp = (float*)(pk + PKG_G);
        if (h != cur_h) {
            if (cur_h >= 0) __syncthreads();
            cur_h = h;
            for (int i = tid; i < 17 * 192; i += 512) { const int r = i / 192, d = i - r * 192; W2L[i] = r < 16 ? w2[r * 768 + h * 192 + d] : bg[h * 192 + d]; }
            __syncthreads(); }
        float w2c[3][16], bgc[3];
#pragma unroll
        for (int c = 0; c < 3; ++c) { bgc[c] = W2L[16 * 192 + lane + 64 * c];
#pragma unroll
            for (int r = 0; r < 16; ++r) w2c[c][r] = W2L[r * 192 + lane + 64 * c]; }
        unsigned qv[8][3], kv[8][3];
#pragma unroll
        for (int tt = 0; tt < 8; ++tt) { const int t = 8 * wave + tt; const bf16* prow = PROJ + (size_t)(row0 + (t < T ? t : T - 1)) * NA + h * 192 + lane;
#pragma unroll
            for (int c = 0; c < 3; ++c) { qv[tt][c] = prow[CQ + 64 * c]; kv[tt][c] = prow[CK + 64 * c]; } }
        __builtin_amdgcn_sched_barrier(0);
        v4u l0[8], l1[8];
#pragma unroll
        for (int tt = 0; tt < 8; ++tt) { const LAS unsigned char* lp = LRN + (8 * wave + tt) * 32; l0[tt] = *(const LAS v4u*)lp; l1[tt] = *(const LAS v4u*)(lp + 16); }
        float lc[8][3]; float run[3] = {0.f, 0.f, 0.f};
#pragma unroll
        for (int tt = 0; tt < 8; ++tt) { const bool ok = 8 * wave + tt < T;
            float lr[16]; lr[0] = pg8::bflo(l0[tt].x); lr[1] = pg8::bfhi(l0[tt].x); lr[2] = pg8::bflo(l0[tt].y); lr[3] = pg8::bfhi(l0[tt].y); lr[4] = pg8::bflo(l0[tt].z); lr[5] = pg8::bfhi(l0[tt].z); lr[6] = pg8::bflo(l0[tt].w); lr[7] = pg8::bfhi(l0[tt].w);
            lr[8] = pg8::bflo(l1[tt].x); lr[9] = pg8::bfhi(l1[tt].x); lr[10] = pg8::bflo(l1[tt].y); lr[11] = pg8::bfhi(l1[tt].y); lr[12] = pg8::bflo(l1[tt].z); lr[13] = pg8::bfhi(l1[tt].z); lr[14] = pg8::bflo(l1[tt].w); lr[15] = pg8::bfhi(l1[tt].w);
#pragma unroll
            for (int c = 0; c < 3; ++c) { float xg = bgc[c];
#pragma unroll
                for (int r = 0; r < 16; ++r) xg += lr[r] * w2c[c][r];
                run[c] += ok ? -softplus_fast(-xg) * (1.0f / 16.0f) : 0.f; lc[tt][c] = run[c]; } }
#pragma unroll
        for (int c = 0; c < 3; ++c) tot[wave * 192 + lane + 64 * c] = run[c];
        __syncthreads();
        unsigned vv[6][8];
#pragma unroll
        for (int tt = 0; tt < 8; ++tt) { const int t = 8 * wave + tt; const bf16* prow = PROJ + (size_t)(row0 + (t < T ? t : T - 1)) * NA + CV + h * 384 + lane;
#pragma unroll
            for (int c2 = 0; c2 < 6; ++c2) vv[c2][tt] = prow[64 * c2]; }
        __builtin_amdgcn_sched_barrier(0);
        float pre[3], all[3];
#pragma unroll
        for (int c = 0; c < 3; ++c) { pre[c] = 0.f; all[c] = 0.f;
#pragma unroll
            for (int w = 0; w < 8; ++w) { const float tv = tot[w * 192 + lane + 64 * c]; all[c] += tv; if (w < wave) pre[c] += tv; } }
        unsigned ktw[3][4];
#pragma unroll
        for (int tt = 0; tt < 8; ++tt) { const int t = 8 * wave + tt; const bool ok = t < T;
#pragma unroll
            for (int c = 0; c < 3; ++c) { const int dl = lane + 64 * c; const float bc = pre[c] + lc[tt][c]; const float eq = __expf(bc), ek = __expf(-bc);
                const unsigned qb = ok ? f2bf(bf2f((bf16)qv[tt][c]) * GLA_QSCALE * eq) : 0u, kb = ok ? f2bf(bf2f((bf16)kv[tt][c]) * ek) : 0u;
                Qt[t * QIMG_LD + dl] = (bf16)qb; QL[t * QIMG_LD + dl] = (bf16)qb; KL[t * QIMG_LD + dl] = (bf16)kb;
                if (tt & 1) ktw[c][tt >> 1] |= kb << 16; else ktw[c][tt >> 1] = kb; } }
#pragma unroll
        for (int c = 0; c < 3; ++c) { bf16* kp = KT + (size_t)(lane + 64 * c) * KTIMG_LD + 8 * wave; u32x2 o0, o1; o0.x = ktw[c][0]; o0.y = ktw[c][1]; o1.x = ktw[c][2]; o1.y = ktw[c][3]; *(u32x2*)kp = o0; *(u32x2*)(kp + 4) = o1; }
        if (wave == 0) {
#pragma unroll
            for (int c = 0; c < 3; ++c) Gp[lane + 64 * c] = __expf(all[c]); }
#pragma unroll
        for (int c2 = 0; c2 < 6; ++c2) { const bool ok0 = 8 * wave < T;
            u32x2 o0, o1; o0.x = ok0 ? vv[c2][0] | (vv[c2][1] << 16) : 0u; o0.y = ok0 ? vv[c2][2] | (vv[c2][3] << 16) : 0u; o1.x = ok0 ? vv[c2][4] | (vv[c2][5] << 16) : 0u; o1.y = ok0 ? vv[c2][6] | (vv[c2][7] << 16) : 0u;
            v4u o; o.x = o0.x; o.y = o0.y; o.z = o1.x; o.w = o1.y; *(v4u*)(VT + (size_t)(lane + 64 * c2) * 64 + 8 * wave) = o;
            LAS bf16* vl = VL + (lane + 64 * c2) * VL_LD + 8 * wave; *(LAS u32x2*)vl = o0; *(LAS u32x2*)(vl + 4) = o1; }
        __syncthreads();
        { const int nx = item_of(j + 1); if (nx >= 0) lr_dma(nx); }
        const int nvalid = T;
        bf16x8 va[3], vb[3];
#pragma unroll
        for (int k = 0; k < 3; ++k) { const LAS bf16* vr = VL + (16 * (3 * wave + k) + fr) * VL_LD + 4 * fq;
            const s16x4 x0 = *(const LAS s16x4*)vr, x1 = *(const LAS s16x4*)(vr + 16), x2 = *(const LAS s16x4*)(vr + 32), x3 = *(const LAS s16x4*)(vr + 48);
            va[k] = __builtin_shufflevector(x0, x1, 0, 1, 2, 3, 4, 5, 6, 7); vb[k] = __builtin_shufflevector(x2, x3, 0, 1, 2, 3, 4, 5, 6, 7); }
#pragma unroll
        for (int rep = 0; rep < 2; ++rep) {
            const int tl = wave + 8 * rep;
            if (tl < 10) {
                const int it = tl < 1 ? 0 : (tl < 3 ? 1 : (tl < 6 ? 2 : 3)), jt = tl - (it * (it + 1)) / 2;
                f32x4 at = {0.f, 0.f, 0.f, 0.f};
                const LAS bf16* qr = QL + (16 * it + fr) * QIMG_LD + 8 * fq; const LAS bf16* kr = KL + (16 * jt + fr) * QIMG_LD + 8 * fq;
#pragma unroll
                for (int s = 0; s < 6; ++s) at = MFMA16(*(const LAS bf16x8*)(kr + 32 * s), *(const LAS bf16x8*)(qr + 32 * s), at);
                if (it == jt) {
#pragma unroll
                    for (int jj = 0; jj < 4; ++jj) if (4 * fq + jj > fr) at[jj] = 0.f; }
                u32x2 w; w.x = cvt2(at[0], at[1]); w.y = cvt2(at[2], at[3]);
                *(LAS u32x2*)(P + (16 * it + fr) * P_LD + 16 * jt + 4 * fq) = w;
            } else if (tl == 10 || tl == 11) {
                const int it = tl == 10 ? 0 : 2, jt = tl == 10 ? 1 : 3; unsigned zz = 0u; asm volatile("" : "+v"(zz)); u32x2 z; z.x = zz; z.y = zz;
                *(LAS u32x2*)(P + (16 * it + fr) * P_LD + 16 * jt + 4 * fq) = z;
            }
        }
        if (wave < 2) asm volatile("s_waitcnt vmcnt(0)" ::: "memory");
        __syncthreads();
#pragma unroll
        for (int it = 0; it < 4; ++it) {
            if (16 * it >= nvalid) break;
            const LAS bf16* pr = P + (16 * it + fr) * P_LD + 4 * fq;
            const s16x4 a0 = *(const LAS s16x4*)pr, a1 = *(const LAS s16x4*)(pr + 16);
            const bf16x8 pf0 = __builtin_shufflevector(a0, a1, 0, 1, 2, 3, 4, 5, 6, 7); bf16x8 pf1 = pf0;
            if (it >= 2) { const s16x4 b0 = *(const LAS s16x4*)(pr + 32), b1 = *(const LAS s16x4*)(pr + 48); pf1 = __builtin_shufflevector(b0, b1, 0, 1, 2, 3, 4, 5, 6, 7); }
#pragma unroll
            for (int k = 0; k < 3; ++k) { f32x4 o = {0.f, 0.f, 0.f, 0.f};
                o = MFMA16(va[k], pf0, o); if (it >= 2) o = MFMA16(vb[k], pf1, o);
                u32x2 ow; ow.x = cvt2(o[0], o[1]); ow.y = cvt2(o[2], o[3]); *(u32x2*)(OINT + (size_t)(row0 + 16 * it + fr) * 1536 + h * 384 + 16 * (3 * wave + k) + 4 * fq) = ow; }
        }
    }
}

__device__ __forceinline__ f32x4 ld_o4(const bf16* p) { const u32x2 w = *(const u32x2*)p; return (f32x4){pg8::bflo(w.x), pg8::bfhi(w.x), pg8::bflo(w.y), pg8::bfhi(w.y)}; }
template <int PASS>
__device__ __forceinline__ void gla_chain(int wc, int tid, int wave, LAS unsigned char* lds, int l, const unsigned char* PKG, const float* state_gla, bf16* OINT, float* out, float* SLOC, float* GSEG, bool dry = false) {
    const int lane = tid & 63, fr = lane & 15, fq = lane >> 4;
    int h, vb, bh, seg, item0, nsteps, row0, nvalid; const float* s0 = nullptr; float* sout = nullptr;
    if (PASS == 1) { bh = wc / 9; const int rem = wc % 9; vb = rem / 3; seg = rem % 3; h = bh & 3; item0 = bh * 128 + 32 * seg; nsteps = 32; row0 = 0; nvalid = 64; }
    else if (wc < 192) { bh = wc / 12; const int rem = wc % 12; vb = rem >> 2; seg = rem & 3; h = bh & 3; item0 = bh * 128 + 32 * seg; nsteps = 32; row0 = (bh >> 2) * SEQ + 2048 * seg; nvalid = 64;
        if (seg == 3) sout = out + O_GSP + (size_t)(l * 16 + bh) * 192 * 384; }
    else { const int c2 = wc - 192; bh = c2 / 3; vb = c2 % 3; seg = 0; h = bh & 3; item0 = 2048 + bh; nsteps = 1; row0 = MP + (bh >> 2) * 16; nvalid = 16; s0 = state_gla + (size_t)(l * 32 + bh) * 192 * 384; sout = out + O_GSS + (size_t)(l * 32 + bh) * 192 * 384; }
    const int v0 = vb * 128 + wave * 16;
#define GLA_WALK(p, step) do { (p) += (step); asm volatile("" : "+v"(p)); } while (0)
    f32x4 S[12];
    if (s0) { const float* p = s0 + (size_t)(4 * fq) * 384 + v0 + fr;
#pragma unroll
        for (int t = 0; t < 12; ++t) {
#pragma unroll
            for (int jj = 0; jj < 4; ++jj) { S[t][jj] = *p; GLA_WALK(p, 384); }
            GLA_WALK(p, 12 * 384); } }
    else {
#pragma unroll
        for (int t = 0; t < 12; ++t) S[t] = (f32x4){0.f, 0.f, 0.f, 0.f}; }
    if (PASS == 2 && wc < 192) {
        for (int j = 0; j < seg; ++j) { const float* gs = GSEG + (size_t)(bh * 3 + j) * 192 + 4 * fq; const float* p = SLOC + (size_t)((bh * 3 + vb) * 3 + j) * 192 * 128 + (size_t)(4 * fq) * 128 + wave * 16 + fr;
#pragma unroll
            for (int t = 0; t < 12; ++t) { const f32x4 g4 = *(const f32x4*)(gs + 16 * t);
#pragma unroll
                for (int jj = 0; jj < 4; ++jj) { S[t][jj] = g4[jj] * S[t][jj] + *p; GLA_WALK(p, 128); }
                GLA_WALK(p, 12 * 128); } }
    }
    f32x4 GP[PASS == 1 ? 12 : 1];
    if (PASS == 1) {
#pragma unroll
        for (int t = 0; t < 12; ++t) GP[t] = (f32x4){1.f, 1.f, 1.f, 1.f}; }
    constexpr int CH0 = PASS == 1 ? PKG_KT / 16 : 0, NCH = IMG_BYTES / 16, NLD = PASS == 1 ? 4 : 7;
    v4u pre[NLD]; bf16x8 vt[2], vtn[2]; f32x4 oin[4];
    { const unsigned char* pk = PKG + (size_t)item0 * PKG_BYTES;
      if (PASS == 2) {
#pragma unroll
        for (int it = 0; it < 4; ++it) { const int tl = 16 * it + fr; oin[it] = tl < nvalid ? ld_o4(OINT + (size_t)(row0 + tl) * 1536 + h * 384 + v0 + 4 * fq) : (f32x4){0.f, 0.f, 0.f, 0.f}; } }
#pragma unroll
      for (int k = 0; k < NLD; ++k) { const int ch = CH0 + tid + 512 * k; if (ch < NCH) pre[k] = *(const v4u*)(pk + (size_t)ch * 16); }
      const bf16* VT = (const bf16*)(pk + PKG_VT) + (size_t)(v0 + fr) * 64 + 4 * fq; vt[0] = ld2x8(VT, VT + 16); vt[1] = ld2x8(VT + 32, VT + 48);
#pragma unroll
      for (int k = 0; k < NLD; ++k) { const int ch = CH0 + tid + 512 * k; if (ch < NCH) *(LAS v4u*)(lds + (size_t)ch * 16) = pre[k]; }
      vtn[0] = vt[0]; vtn[1] = vt[1]; }
    __syncthreads();
    for (int n = 0; n < nsteps; ++n) {
        const LAS unsigned char* img = lds + (n & 1) * IMG_BYTES;
        const bool more = n + 1 < nsteps;
        if (more) { const unsigned char* pk = PKG + (size_t)(item0 + n + 1) * PKG_BYTES;
#pragma unroll
            for (int k = 0; k < NLD; ++k) { const int ch = CH0 + tid + 512 * k; if (ch < NCH) pre[k] = *(const v4u*)(pk + (size_t)ch * 16); }
            const bf16* VT = (const bf16*)(pk + PKG_VT) + (size_t)(v0 + fr) * 64 + 4 * fq; vtn[0] = ld2x8(VT, VT + 16); vtn[1] = ld2x8(VT + 32, VT + 48); }
        if (PASS == 2) {
            bf16x8 Sb[6];
#pragma unroll
            for (int s = 0; s < 6; ++s) Sb[s] = pack8(S[2 * s], S[2 * s + 1]);
#pragma unroll
            for (int it = 0; it < 4; ++it) {
                const LAS bf16* qr = (const LAS bf16*)(img + PKG_Q) + (16 * it + fr) * QIMG_LD + 4 * fq;
                f32x4 o = oin[it];
#pragma unroll
                for (int s = 0; s < 6; ++s) { const s16x4 a = *(const LAS s16x4*)(qr + 32 * s), b = *(const LAS s16x4*)(qr + 32 * s + 16);
                    o = MFMA16(Sb[s], __builtin_shufflevector(a, b, 0, 1, 2, 3, 4, 5, 6, 7), o); }
                const int tl = 16 * it + fr;
                if (tl < nvalid && !dry) { u32x2 ow; ow.x = cvt2(o[0], o[1]); ow.y = cvt2(o[2], o[3]); *(u32x2*)(OINT + (size_t)(row0 + 64 * n + tl) * 1536 + h * 384 + v0 + 4 * fq) = ow; }
                __builtin_amdgcn_sched_barrier(0);
            }
            if (more) {
#pragma unroll
                for (int it = 0; it < 4; ++it) oin[it] = ld_o4(OINT + (size_t)(row0 + 64 * (n + 1) + 16 * it + fr) * 1536 + h * 384 + v0 + 4 * fq); }
        }
#pragma unroll
        for (int t = 0; t < 12; ++t) { const LAS bf16* kr = (const LAS bf16*)(img + PKG_KT) + (16 * t + fr) * KTIMG_LD + 4 * fq;
#pragma unroll
            for (int s2 = 0; s2 < 2; ++s2) { const s16x4 a = *(const LAS s16x4*)(kr + 32 * s2), b = *(const LAS s16x4*)(kr + 32 * s2 + 16);
                S[t] = MFMA16(__builtin_shufflevector(a, b, 0, 1, 2, 3, 4, 5, 6, 7), vt[s2], S[t]); }
            const f32x4 g4 = *(const LAS f32x4*)(img + PKG_G + (16 * t + 4 * fq) * 4);
            S[t] = S[t] * g4; if (PASS == 1) GP[t] = GP[t] * g4; if ((t & 3) == 3) __builtin_amdgcn_sched_barrier(0); }
        if (more) { LAS unsigned char* nimg = lds + ((n + 1) & 1) * IMG_BYTES;
#pragma unroll
            for (int k = 0; k < NLD; ++k) { const int ch = CH0 + tid + 512 * k; if (ch < NCH) *(LAS v4u*)(nimg + (size_t)ch * 16) = pre[k]; }
            vt[0] = vtn[0]; vt[1] = vtn[1]; }
        asm volatile("s_waitcnt lgkmcnt(0)" ::: "memory"); __builtin_amdgcn_s_barrier(); asm volatile("" ::: "memory");
    }
    if (PASS == 1) {
        float* p = SLOC + (size_t)((bh * 3 + vb) * 3 + seg) * 192 * 128 + (size_t)(4 * fq) * 128 + wave * 16 + fr;
#pragma unroll
        for (int t = 0; t < 12; ++t) {
#pragma unroll
            for (int jj = 0; jj < 4; ++jj) { *p = S[t][jj]; GLA_WALK(p, 128); }
            GLA_WALK(p, 12 * 128); }
        if (vb == 0 && wave == 0 && fr == 0) { float* gs = GSEG + (size_t)(bh * 3 + seg) * 192;
#pragma unroll
            for (int t = 0; t < 12; ++t) *(f32x4*)(gs + 16 * t + 4 * fq) = GP[t]; }
    } else if (sout) {
        float* p = sout + (size_t)(4 * fq) * 384 + v0 + fr;
#pragma unroll
        for (int t = 0; t < 12; ++t) {
#pragma unroll
            for (int jj = 0; jj < 4; ++jj) { *p = S[t][jj]; GLA_WALK(p, 384); }
            GLA_WALK(p, 12 * 384); }
    }
#undef GLA_WALK
}

__device__ __forceinline__ void mem_attn(int item, int lane, int l, const bf16* PROJ, int ldp, int cqm, const bf16* MEMK, const bf16* MEMVT, bf16* OCAT) {
    const int fr = lane & 15, fq = lane >> 4, tile = item >> 2, h = item & 3, r0 = tile * 16;
    const int bb = r0 < MP ? r0 / SEQ : 4 + ((r0 - MP) >> 4);
    const bf16* Kb = MEMK + (size_t)((l * 12 + bb) * 256) * 512 + h * 128; const bf16* Vt = MEMVT + (size_t)(((l * 12 + bb) * 4 + h) * 128) * 256;
    bf16x8 qf[4];
#pragma unroll
    for (int s = 0; s < 4; ++s) qf[s] = ld16(PROJ + (size_t)(r0 + fr) * ldp + cqm + h * 128 + 32 * s + 8 * fq);
    f32x4 st[16];
#pragma unroll
    for (int mt = 0; mt < 16; ++mt) { st[mt] = (f32x4){0.f, 0.f, 0.f, 0.f}; const bf16* kr = Kb + (size_t)(16 * mt + fr) * 512 + 8 * fq;
#pragma unroll
        for (int s = 0; s < 4; ++s) st[mt] = MFMA16(ld16(kr + 32 * s), qf[s], st[mt]); }
    float mx = -3.0e38f;
#pragma unroll
    for (int mt = 0; mt < 16; ++mt) mx = fmaxf(mx, fmaxf(fmaxf(st[mt][0], st[mt][1]), fmaxf(st[mt][2], st[mt][3])));
    mx = fmaxf(mx, shx(mx, lane, 16)); mx = fmaxf(mx, shx(mx, lane, 32));
    float sum = 0.f;
#pragma unroll
    for (int mt = 0; mt < 16; ++mt)
#pragma unroll
        for (int jj = 0; jj < 4; ++jj) { const float p = __expf((st[mt][jj] - mx) * HD_SCALE); st[mt][jj] = p; sum += p; }
    sum += shx(sum, lane, 16); sum += shx(sum, lane, 32);
    const float inv = 1.0f / sum;
    bf16x8 pf[8];
#pragma unroll
    for (int s = 0; s < 8; ++s) pf[s] = pack8(st[2 * s], st[2 * s + 1]);
#pragma unroll
    for (int dt = 0; dt < 8; ++dt) { f32x4 o = {0.f, 0.f, 0.f, 0.f}; const bf16* vr = Vt + (size_t)(16 * dt + fr) * 256 + 4 * fq;
#pragma unroll
        for (int s = 0; s < 8; ++s) o = MFMA16(ld2x8(vr + 32 * s, vr + 32 * s + 16), pf[s], o);
        u32x2 w; w.x = cvt2(o[0] * inv, o[1] * inv); w.y = cvt2(o[2] * inv, o[3] * inv);
        *(u32x2*)(OCAT + (size_t)(r0 + fr) * D + 1536 + h * 128 + 16 * dt + 4 * fq) = w; }
}

__device__ __forceinline__ void mem_attn_wg(int wi, int tid, int wave, LAS unsigned char* lds, int l, const bf16* PROJ, int ldp, int cqm, const bf16* MEMK, const bf16* MEMVT, bf16* OCAT) {
    const bool smp = wi >= 256; const int lane = tid & 63, fr = lane & 15, fq = lane >> 4, bh = smp ? (wi - 256) : (wi >> 4), sub = wi & 15, b = smp ? 4 + (bh >> 2) : (bh >> 2), h = bh & 3;
    const bf16* Kb = MEMK + (size_t)((l * 12 + b) * 256) * 512 + h * 128; const bf16* Vt = MEMVT + (size_t)(((l * 12 + b) * 4 + h) * 128) * 256;
#pragma unroll
    for (int k = 0; k < 8; ++k) { const int idx = tid + 512 * k, row = idx >> 4, c = idx & 15; *(LAS v4u*)(lds + row * 256 + ((c ^ (row & 15)) << 4)) = *(const v4u*)(Kb + (size_t)row * 512 + c * 8); }
#pragma unroll
    for (int k = 0; k < 8; ++k) { const int idx = tid + 512 * k, row = idx >> 5, c = idx & 31; *(LAS v4u*)(lds + 65536 + row * 512 + ((c ^ (2 * (row & 15))) << 4)) = *(const v4u*)(Vt + (size_t)row * 256 + c * 8); }
    __syncthreads();
    unsigned koff[4], voff[16];
#pragma unroll
    for (int s2 = 0; s2 < 4; ++s2) { koff[s2] = (unsigned)(fr * 256 + (((4 * s2 + fq) ^ fr) << 4)); asm volatile("" : "+v"(koff[s2])); }
#pragma unroll
    for (int s2 = 0; s2 < 8; ++s2) { const int p0 = 8 * s2 + fq, p1 = p0 + 4;
        voff[2 * s2] = (unsigned)(65536 + fr * 512 + ((((p0 >> 1) ^ (2 * fr)) << 4) | ((p0 & 1) << 3))); voff[2 * s2 + 1] = (unsigned)(65536 + fr * 512 + ((((p1 >> 1) ^ (2 * fr)) << 4) | ((p1 & 1) << 3)));
        asm volatile("" : "+v"(voff[2 * s2]), "+v"(voff[2 * s2 + 1])); }
    const int nblk = smp ? (wave == 0 ? 1 : 0) : 4;
#pragma unroll 1
    for (int blk = 0; blk < nblk; ++blk) {
        const int r0 = smp ? MP + (b - 4) * 16 : b * SEQ + sub * 512 + blk * 128 + wave * 16;
        bf16x8 qf[4];
#pragma unroll
        for (int s = 0; s < 4; ++s) qf[s] = ld16(PROJ + (size_t)(r0 + fr) * ldp + cqm + h * 128 + 32 * s + 8 * fq);
        f32x4 st[16];
#pragma unroll
        for (int mt = 0; mt < 16; ++mt) { st[mt] = (f32x4){0.f, 0.f, 0.f, 0.f};
#pragma unroll
            for (int s = 0; s < 4; ++s) st[mt] = MFMA16(*(const LAS bf16x8*)(lds + koff[s] + mt * 4096), qf[s], st[mt]);
            if ((mt & 3) == 3) __builtin_amdgcn_sched_barrier(0); }
        float mx = -3.0e38f;
#pragma unroll
        for (int mt = 0; mt < 16; ++mt) mx = fmaxf(mx, fmaxf(fmaxf(st[mt][0], st[mt][1]), fmaxf(st[mt][2], st[mt][3])));
        mx = fmaxf(mx, shx(mx, lane, 16)); mx = fmaxf(mx, shx(mx, lane, 32));
        float sum = 0.f;
#pragma unroll
        for (int mt = 0; mt < 16; ++mt)
#pragma unroll
            for (int jj = 0; jj < 4; ++jj) { const float p = __expf((st[mt][jj] - mx) * HD_SCALE); st[mt][jj] = p; sum += p; }
        sum += shx(sum, lane, 16); sum += shx(sum, lane, 32);
        const float inv = 1.0f / sum;
        bf16x8 pf[8];
#pragma unroll
        for (int s = 0; s < 8; ++s) pf[s] = pack8(st[2 * s], st[2 * s + 1]);
#pragma unroll
        for (int dt = 0; dt < 8; ++dt) { f32x4 o = {0.f, 0.f, 0.f, 0.f};
#pragma unroll
            for (int s = 0; s < 8; ++s) { const s16x4 a = *(const LAS s16x4*)(lds + voff[2 * s] + dt * 8192), bb = *(const LAS s16x4*)(lds + voff[2 * s + 1] + dt * 8192);
                o = MFMA16(__builtin_shufflevector(a, bb, 0, 1, 2, 3, 4, 5, 6, 7), pf[s], o); }
            u32x2 w; w.x = cvt2(o[0] * inv, o[1] * inv); w.y = cvt2(o[2] * inv, o[3] * inv);
            *(u32x2*)(OCAT + (size_t)(r0 + fr) * D + 1536 + h * 128 + 16 * dt + 4 * fq) = w;
            if (dt & 1) __builtin_amdgcn_sched_barrier(0); }
    }
    __syncthreads();
}

template <int MODE = 0>
__device__ __forceinline__ void sb_attn(int lane, LAS unsigned char* wlds, const bf16* Kp, int ldk, const bf16* VTp, int ldvt, const bf16* Qp, int ldq, bf16* Op, int t0, int nq) {
    const int r = lane & 31, hh = lane >> 5;
    LAS bf16x8* qs = (LAS bf16x8*)wlds + lane;
#pragma unroll
    for (int ks = 0; ks < 8; ++ks) qs[64 * ks] = ld16(Qp + (size_t)r * ldq + 16 * ks + 8 * hh);
    f32x16 oacc[4];
#pragma unroll
    for (int dt = 0; dt < 4; ++dt)
#pragma unroll
        for (int i = 0; i < 16; ++i) oacc[dt][i] = 0.f;
    float carry = 1.f;
    bf16x8 kf[8];
    { const bf16* kr = Kp + (size_t)(t0 + r) * ldk + 8 * hh;
#pragma unroll
      for (int ks = 0; ks < 8; ++ks) kf[ks] = ld16(kr + 16 * ks); }
    for (int s0 = t0; s0 >= 0; s0 -= 32) {
        bf16x8 vf[8];
#pragma unroll
        for (int k2 = 0; k2 < 2; ++k2)
#pragma unroll
            for (int dt = 0; dt < 4; ++dt) vf[4 * k2 + dt] = MODE == 3 ? qs[64 * dt] : ld16(VTp + (size_t)(s0 >> 5) * 4096 + ((dt * 2 + k2) * 64 + lane) * 8);
        f32x16 st;
#pragma unroll
        for (int i = 0; i < 16; ++i) st[i] = 0.f;
#pragma unroll
        for (int ks = 0; ks < 8; ++ks) st = MFMA32(kf[ks], qs[64 * ks], st);
        { const int sn = s0 >= 32 ? s0 - 32 : 0; const bf16* kr = Kp + (size_t)(sn + r) * ldk + 8 * hh;
#pragma unroll
          for (int ks = 0; ks < 8; ++ks) kf[ks] = ld16(kr + 16 * ks); }
        const bool diag = (s0 == t0);
        float lb[16], om[16];
#pragma unroll
        for (int i = 0; i < 16; ++i) { const float z = st[i] * HD_SCALE, e = __expf(-fabsf(z)), rr = __builtin_amdgcn_rcpf(1.0f + e), er = e * rr;
            lb[i] = z >= 0.f ? rr : er; om[i] = z >= 0.f ? er : rr;
            if (diag && !(((i & 3) + 8 * (i >> 2) + 4 * hh) < r)) { lb[i] = 0.f; om[i] = 1.f; } }
        float g[4], pgv[4];
#pragma unroll
        for (int m = 0; m < 4; ++m) { g[m] = (om[4 * m] * om[4 * m + 1]) * (om[4 * m + 2] * om[4 * m + 3]); pgv[m] = shx(g[m], lane, 32); }
        float R[4]; R[3] = 1.f; R[2] = g[3] * pgv[3]; R[1] = R[2] * (g[2] * pgv[2]); R[0] = R[1] * (g[1] * pgv[1]);
        const float total = R[0] * (g[0] * pgv[0]);
#pragma unroll
        for (int m = 0; m < 4; ++m) { const float suf = carry * R[m] * (hh == 0 ? pgv[m] : 1.f);
            const float t3 = suf, t2 = t3 * om[4 * m + 3], t1 = t2 * om[4 * m + 2], t0_ = t1 * om[4 * m + 1];
            lb[4 * m + 3] *= t3; lb[4 * m + 2] *= t2; lb[4 * m + 1] *= t1; lb[4 * m] *= t0_; }
        carry *= total;
#pragma unroll
        for (int k2 = 0; k2 < 2; ++k2) {
            v4u p; p.x = cvt2(lb[8 * k2], lb[8 * k2 + 1]); p.y = cvt2(lb[8 * k2 + 2], lb[8 * k2 + 3]); p.z = cvt2(lb[8 * k2 + 4], lb[8 * k2 + 5]); p.w = cvt2(lb[8 * k2 + 6], lb[8 * k2 + 7]);
            const bf16x8 wf = __builtin_bit_cast(bf16x8, p);
#pragma unroll
            for (int dt = 0; dt < 4; ++dt) { if (MODE != 3) oacc[dt] = MFMA32(vf[4 * k2 + dt], wf, oacc[dt]); else oacc[dt][0] += __builtin_bit_cast(float, (int)wf[0]) + __builtin_bit_cast(float, (int)vf[4 * k2 + dt][0]); }
        }
        if (MODE == 2 || __all((r >= nq) || (carry < 1.0e-37f))) break;
    }
    if (MODE != 0) { float sdry = 0.f;
#pragma unroll
        for (int dt = 0; dt < 4; ++dt)
#pragma unroll
            for (int i = 0; i < 16; ++i) sdry += oacc[dt][i];
        if (sdry == 1.2345e33f) Op[0] = 0; }
    else if (r < nq) {
#pragma unroll
        for (int dt = 0; dt < 4; ++dt)
#pragma unroll
            for (int g4 = 0; g4 < 4; ++g4) { u32x2 wv; wv.x = cvt2(oacc[dt][4 * g4], oacc[dt][4 * g4 + 1]); wv.y = cvt2(oacc[dt][4 * g4 + 2], oacc[dt][4 * g4 + 3]);
                *(u32x2*)(Op + (size_t)r * D + 32 * dt + 8 * g4 + 4 * hh) = wv; }
    }
    asm volatile("s_waitcnt lgkmcnt(0)" ::: "memory");
}

struct SkBf16 { bf16* O; int ldc;
    __device__ __forceinline__ int brow(int unit, int nb) const { return 32 * unit + 16 * nb; }
    __device__ __forceinline__ void store(int unit, const f32x4 a0, const f32x4 a1, int m, int fq) const { bf16* p = O + (size_t)(MP + m) * ldc + 32 * unit + 4 * fq;
        u32x2 w; w.x = cvt2(a0[0], a0[1]); w.y = cvt2(a0[2], a0[3]); *(u32x2*)p = w; w.x = cvt2(a1[0], a1[1]); w.y = cvt2(a1[2], a1[3]); *(u32x2*)(p + 16) = w; } };
struct SkRes { bf16* Yp; const bf16* Xp; float alpha;
    __device__ __forceinline__ int brow(int unit, int nb) const { return 32 * unit + 16 * nb; }
    __device__ __forceinline__ void one(size_t o, const f32x4 a) const { const u32x2 xv = *(const u32x2*)(Xp + o);
        f32x4 r; r[0] = alpha * pg8::bflo(xv.x); r[1] = alpha * pg8::bfhi(xv.x); r[2] = alpha * pg8::bflo(xv.y); r[3] = alpha * pg8::bfhi(xv.y); r = r + a; u32x2 w; w.x = cvt2(r[0], r[1]); w.y = cvt2(r[2], r[3]); *(u32x2*)(Yp + o) = w; }
    __device__ __forceinline__ void store(int unit, const f32x4 a0, const f32x4 a1, int m, int fq) const { const size_t o = (size_t)(MP + m) * D + 32 * unit + 4 * fq; one(o, a0); one(o + 16, a1); } };
struct SkKV { float *oks, *ovs; bf16 *ksb, *vsb;
    __device__ __forceinline__ int brow(int unit, int nb) const { return 32 * unit + 16 * nb; }
    __device__ __forceinline__ void one(int col, const f32x4 a, int m) const { const bool isv = col >= 1536; const int c = col - (isv ? 1536 : 0), b = m >> 4, t = m & 15;
        *(f32x4*)((isv ? ovs : oks) + (size_t)m * 1536 + c) = a; const unsigned w0 = cvt2(a[0], a[1]), w1 = cvt2(a[2], a[3]);
        const int hh_ = c >> 7, dd = c & 127;
        if (!isv) { u32x2 w; w.x = w0; w.y = w1; *(u32x2*)(ksb + ((size_t)(b * 12 + hh_) * 2080 + 2048 + t) * 128 + dd) = w; }
        else { bf16* vt = vsb + ((size_t)(b * 12 + hh_) * 65 + 64) * 4096 + pg8::vtf_d(dd) + pg8::vtf_k(t); vt[0] = (bf16)w0; vt[8] = (bf16)(w0 >> 16); vt[16] = (bf16)w1; vt[24] = (bf16)(w1 >> 16); } }
    __device__ __forceinline__ void store(int unit, const f32x4 a0, const f32x4 a1, int m, int fq) const { one(32 * unit + 4 * fq, a0, m); one(32 * unit + 16 + 4 * fq, a1, m); } };
struct SkSwiGLU { bf16* Hb;
    __device__ __forceinline__ int brow(int unit, int nb) const { const int c0 = 16 * unit; return (c0 >> 7) * 256 + (c0 & 127) + 128 * nb; }
    __device__ __forceinline__ void store(int unit, const f32x4 g, const f32x4 u, int m, int fq) const { float hv[4];
#pragma unroll
        for (int j = 0; j < 4; ++j) hv[j] = g[j] * __builtin_amdgcn_rcpf(1.0f + __expf(-g[j])) * u[j];
        u32x2 w; w.x = cvt2(hv[0], hv[1]); w.y = cvt2(hv[2], hv[3]); *(u32x2*)(Hb + (size_t)(MP + m) * DFF + 16 * unit + 4 * fq) = w; } };
template <class Epi>
__device__ __forceinline__ void skinny_gemm(int bid, int G, int tid, int wave, LAS unsigned char* lds, const bf16* A, int lda, const bf16* Bt, int K, int nunits, const Epi& E) {
    const int lane = tid & 63, fr = lane & 15, fq = lane >> 4, kw = K >> 3, nst = kw >> 5;
    LAS f32x4* red = (LAS f32x4*)lds;
    for (int item = bid; item < 4 * nunits; item += G) {
        const int unit = item >> 2, rg = item & 3;
        const bf16* ap = A + (size_t)(32 * rg + fr) * lda + wave * kw + 8 * fq;
        const bf16* bp0 = Bt + (size_t)(E.brow(unit, 0) + fr) * K + wave * kw + 8 * fq; const bf16* bp1 = Bt + (size_t)(E.brow(unit, 1) + fr) * K + wave * kw + 8 * fq;
        f32x4 acc[2][2];
#pragma unroll
        for (int nb = 0; nb < 2; ++nb)
#pragma unroll
            for (int rt = 0; rt < 2; ++rt) acc[nb][rt] = (f32x4){0.f, 0.f, 0.f, 0.f};
        bf16x8 a0[4][2], b0[4][2], a1[4][2], b1[4][2];
#define SK_LOAD(af, bfr, g) do { _Pragma("unroll") for (int q = 0; q < 4; ++q) { const int st = 4 * (g) + q; if (st < nst) { \
            af[q][0] = ld16(ap + 32 * st); af[q][1] = ld16(ap + (size_t)16 * lda + 32 * st); bfr[q][0] = ld16(bp0 + 32 * st); bfr[q][1] = ld16(bp1 + 32 * st); } } } while (0)
#define SK_MMA(af, bfr, g) do { _Pragma("unroll") for (int q = 0; q < 4; ++q) { if (4 * (g) + q < nst) { _Pragma("unroll") for (int rt = 0; rt < 2; ++rt) { \
            acc[0][rt] = MFMA16(bfr[q][0], af[q][rt], acc[0][rt]); acc[1][rt] = MFMA16(bfr[q][1], af[q][rt], acc[1][rt]); } } } } while (0)
        const int ng = (nst + 3) >> 2;
        SK_LOAD(a0, b0, 0);
#pragma unroll 1
        for (int g = 0; g < ng; g += 2) {
            if (g + 1 < ng) SK_LOAD(a1, b1, g + 1);
            __builtin_amdgcn_sched_barrier(0);
            SK_MMA(a0, b0, g);
            __builtin_amdgcn_sched_barrier(0);
            if (g + 2 < ng) SK_LOAD(a0, b0, g + 2);
            __builtin_amdgcn_sched_barrier(0);
            if (g + 1 < ng) SK_MMA(a1, b1, g + 1);
            __builtin_amdgcn_sched_barrier(0);
        }
#undef SK_LOAD
#undef SK_MMA
#pragma unroll
        for (int nb = 0; nb < 2; ++nb)
#pragma unroll
            for (int rt = 0; rt < 2; ++rt) red[((wave * 2 + nb) * 2 + rt) * 64 + lane] = acc[nb][rt];
        __syncthreads();
        if (wave < 2) {
            f32x4 s0 = {0.f, 0.f, 0.f, 0.f}, s1 = {0.f, 0.f, 0.f, 0.f};
#pragma unroll
            for (int ws = 0; ws < 8; ++ws) { s0 = s0 + red[((ws * 2 + 0) * 2 + wave) * 64 + lane]; s1 = s1 + red[((ws * 2 + 1) * 2 + wave) * 64 + lane]; }
            E.store(unit, s0, s1, 32 * rg + 16 * wave + fr, fq);
        }
        __syncthreads();
    }
}
#ifndef PH_MASK
#define PH_MASK 0xFFFF
#endif
__global__ void __launch_bounds__(NWAVES * 64, 2) mega(Args args) {
    extern __shared__ __attribute__((aligned(16))) unsigned char lds[];
    Frame F;
    F.lds = (LAS unsigned char*)lds; F.MISC = (volatile LAS unsigned*)(F.lds + MISC_OFF);
    F.tid = threadIdx.x; F.lane = F.tid & 63; F.wave = __builtin_amdgcn_readfirstlane(F.tid >> 6);
    F.G = gridDim.x; F.gw = blockIdx.x * NWAVES + F.wave; F.NGW = F.G * NWAVES;
    F.ctl = (gu32*)(args.ws_ + WS_CTL);
    for (int u = F.tid; u < (LDS_BYTES - LDSCTL_OFF) / 4; u += NWAVES * 64) ((LAS unsigned*)(F.lds + LDSCTL_OFF))[u] = 0u;
    __syncthreads();
    XcdBarrier bar = xcd_barrier_post((unsigned*)(F.ctl + CW_BAR), F.MISC + 8);
    const int lo = args.ph_lo, hi = args.ph_hi; int ph = 0;
#define KARGS ((const __attribute__((address_space(4))) Args*)__builtin_amdgcn_kernarg_segment_ptr())
#define ws (ka->ws_)
#define out (ka->out_)
#define x_prompt (ka->in[0])
#define x_sample (ka->in[1])
#define mem_prompt (ka->in[2])
#define state_gla (ka->in[3])
#define cache_sb_k (ka->in[4])
#define cache_sb_v (ka->in[5])
#define cache_mem_k (ka->in[6])
#define cache_mem_v (ka->in[7])
#define w_in_a (ka->in[8])
#define w_gate_lr (ka->in[9])
#define b_gate (ka->in[10])
#define gla_norm_g (ka->in[11])
#define w_in_b (ka->in[12])
#define w_kv_shared (ka->in[13])
#define w_mem_kv (ka->in[14])
#define w_o (ka->in[15])
#define ln1_g (ka->in[16])
#define ln1_b (ka->in[17])
#define ln2_g (ka->in[18])
#define ln2_b (ka->in[19])
#define w_ffn_in (ka->in[20])
#define w_ffn_out (ka->in[21])
#define WIN ((bf16*)(ws + WS_WIN))
#define WO ((bf16*)(ws + WS_WO))
#define WFI ((bf16*)(ws + WS_WFI))
#define WFO ((bf16*)(ws + WS_WFO))
#define WMEM ((bf16*)(ws + WS_WMEM))
#define MEMX ((bf16*)(ws + WS_MEMX))
#define MEMK ((bf16*)(ws + WS_MEMK))
#define MEMV ((bf16*)(ws + WS_MEMV))
#define X ((bf16*)(ws + WS_X))
#define Y ((float*)(ws + WS_Y))
#define YB ((bf16*)(ws + WS_Y))
#define PROJ ((bf16*)(ws + WS_R1))
#define HB ((bf16*)(ws + WS_R1))
#define OCAT ((bf16*)(ws + WS_OCAT))
#define SBKS ((bf16*)(ws + WS_SBKS))
#define SBVS ((bf16*)(ws + WS_SBVS))
#define OINT ((bf16*)(out + O_YP))
#define KPB ((bf16*)(out + O_YP))
#define VPB (KPB + (size_t)MP * 1536)

#define PHASE_BEGIN(cond, cls) if (cond) { if (lo <= ph && ph < hi) { if (ph > lo) { xcd_barrier(bar); if (BAR_REP > 1) xcd_barrier(bar); } DIAG_STAMP(cls); for (int rep_ = 0; rep_ < (((cls) == REP_CLS) ? 2 : 1); ++rep_) { const __attribute__((address_space(4))) Args* ka = KARGS; asm volatile("" : "+s"(ka)); int z_ = 0, G_ = gridDim.x, bid_ = blockIdx.x, wave_ = F.wave; asm volatile("" : "+s"(z_), "+s"(G_), "+s"(bid_), "+s"(wave_)); const int lane = (int)__builtin_amdgcn_mbcnt_hi(~0u, __builtin_amdgcn_mbcnt_lo(~0u, (unsigned)z_)), tid = wave_ * 64 + lane, gw_ = bid_ * NWAVES + wave_, NGW_ = G_ * NWAVES;     (void)tid; (void)lane; (void)gw_; (void)NGW_;
#define PHASE_END } } ++ph; }
#ifndef REP_CLS
#define REP_CLS (-1)
#endif
#ifndef SK_REP
#define SK_REP 1
#endif
#ifndef MEM_REP
#define MEM_REP 1
#endif
#ifndef BAR_REP
#define BAR_REP 1
#endif
#ifndef STAG
#define STAG 0
#endif
#ifndef SB_REP
#define SB_REP 1
#endif
#if defined(DIAG_A)
#define DIAG_STAMP(cls) do { if (blockIdx.x == 0 && threadIdx.x == 0) { unsigned long long* dts = (unsigned long long*)(args.ws_ + 262144); dts[ph] = rt(); } } while (0)
#else
#define DIAG_STAMP(cls) do { } while (0)
#endif

#define CONVERT_WEIGHTS(LL) do { const int ll_ = (LL); \
            if (ll_ < 2) wt_convert(F.lds, wave_, gw_, NGW_, lane, w_in_a + (size_t)ll_ * D * 5136, D, 5136, WIN, NA, MapInA()); \
            else { wt_convert(F.lds, wave_, gw_, NGW_, lane, w_in_b + (size_t)(ll_ - 2) * D * NBQ, D, NBQ, WIN, NBQ, MapId()); if (ll_ == 2) wt_convert(F.lds, wave_, gw_, NGW_, lane, w_kv_shared, D, NKV, WIN + (size_t)NBQ * D, NKV, MapId()); } \
            wt_convert(F.lds, wave_, gw_, NGW_, lane, w_o + (size_t)ll_ * D * D, D, D, WO, D, MapId()); \
            wt_convert(F.lds, wave_, gw_, NGW_, lane, w_ffn_in + (size_t)ll_ * D * 2 * DFF, D, 2 * DFF, WFI, 2 * DFF, MapFfn()); \
            wt_convert(F.lds, wave_, gw_, NGW_, lane, w_ffn_out + (size_t)ll_ * DFF * D, DFF, D, WFO, D, MapId()); } while (0)
#define CONVERT_CACHE_K(W0, NW) do {         for (int r = (W0); r < 8 * 2048; r += (NW)) { const int b = r >> 11, s = r & 2047; const float* src = cache_sb_k + (size_t)r * 1536; \
            f32x4 v[6]; \
_Pragma("unroll") \
            for (int q = 0; q < 6; ++q) v[q] = *(const f32x4*)(src + lane * 4 + 256 * q); \
_Pragma("unroll") \
            for (int q = 0; q < 6; ++q) { const int j = lane * 4 + 256 * q; \
                *(unsigned long long*)(SBKS + ((size_t)(b * 12 + (j >> 7)) * 2080 + s) * 128 + (j & 127)) = (unsigned long long)pk2(v[q].x, v[q].y) | ((unsigned long long)pk2(v[q].z, v[q].w) << 32); } } } while (0)
#define CONVERT_CACHE_V(W0, NW) do {         for (int it = (W0); it < 3072; it += (NW)) { const int cb = it % 12, sb_ = (it / 12) & 31, b = it / 384, s = sb_ * 64 + lane; \
            const float* src = cache_sb_v + (size_t)(b * 2048 + s) * 1536 + cb * 128; bf16* dst = SBVS + ((size_t)(b * 12 + cb) * 65 + (s >> 5)) * 4096 + pg8::vtf_k(s & 31); \
            for (int q8 = 0; q8 < 32; q8 += 8) { f32x4 v[8]; \
_Pragma("unroll") \
                for (int q = 0; q < 8; ++q) v[q] = *(const f32x4*)(src + 4 * (q8 + q)); \
_Pragma("unroll") \
                for (int q = 0; q < 8; ++q) \
_Pragma("unroll") \
                    for (int e = 0; e < 4; ++e) dst[pg8::vtf_d(4 * (q8 + q) + e)] = (bf16)f2bf(v[q][e]); } } } while (0)
    PHASE_BEGIN(true, 0)
        for (int r = 2 * gw_; r < MT; r += 2 * NGW_) { const float* s0 = r < MP ? x_prompt + (size_t)r * D : (r < MR ? x_sample + (size_t)(r - MP) * D : nullptr);
            cvt_rows2<D>(s0, s0 ? s0 + D : nullptr, X + (size_t)r * D, X + (size_t)(r + 1) * D, lane); }
        for (int r = 2 * gw_; r < 1024; r += 2 * NGW_) cvt_rows2<D>(mem_prompt + (size_t)r * D, mem_prompt + (size_t)(r + 1) * D, MEMX + (size_t)r * D, MEMX + (size_t)(r + 1) * D, lane);
        for (int r = gw_; r < 4 * 8 * 256; r += NGW_) { const int l = r >> 11, b = (r >> 8) & 7, m = r & 255; const size_t dst = (size_t)((l * 12 + 4 + b) * 256 + m) * 512;
            cvt_row(cache_mem_k + (size_t)r * 512, MEMK + dst, 512, lane); }
        for (int it = gw_; it < 512; it += NGW_) { const int hdb = it & 3, mb = (it >> 2) & 3, b = (it >> 4) & 7, l = it >> 7, m = mb * 64 + lane;
            const float* src = cache_mem_v + (size_t)((l * 8 + b) * 256 + m) * 512 + hdb * 128; bf16* dst = MEMV + (size_t)((l * 12 + 4 + b) * 512 + hdb * 128) * 256 + m;
            for (int q4 = 0; q4 < 32; ++q4) { const f32x4 v = *(const f32x4*)(src + 4 * q4);
#pragma unroll
                for (int e = 0; e < 4; ++e) dst[(size_t)(4 * q4 + e) * 256] = (bf16)f2bf(v[e]); } }
        if (G_ != 256) { CONVERT_CACHE_K(gw_, NGW_); CONVERT_CACHE_V(gw_, NGW_); }
        for (int l = 0; l < 4; ++l) wt_convert(F.lds, wave_, gw_, NGW_, lane, w_mem_kv + (size_t)l * D * 1024, D, 1024, WMEM + (size_t)l * 1024 * D, 1024, MapId());
        CONVERT_WEIGHTS(0);
    PHASE_END
    for (int l = 0; l < 4; ++l) {
        const bool LA = l < 2;
        const int ldp = LA ? NA : NBQ;
        PHASE_BEGIN(true, 2)
            if (!LA && (bid_ & 1)) { { SkBf16 E{PROJ, ldp}; skinny_gemm(bid_, G_, FRESH_TID(), wave_, F.lds + RING_OFF, X + (size_t)MP * D, D, WIN, D, ldp / 32, E); }
                if (l == 2) { SkKV E{out + O_SKS, out + O_SVS, SBKS, SBVS}; skinny_gemm(bid_, G_, FRESH_TID(), wave_, F.lds + RING_OFF, X + (size_t)MP * D, D, WIN + (size_t)NBQ * D, D, NKV / 32, E); } }
            { pg8::Gemm g{X, WIN, MP, ldp, D}; pg8::StaticOrder S; S.init(MP, ldp, G_, bid_); pg8::EpiBf16 E{PROJ, ldp};
              pg8::gemm_phase<pg8::EpiBf16, pg8::StaticOrder, true, true>(F.lds + RING_OFF, g, S, E, FRESH_TID()); }
            if (l == 0 && bid_ >= (G_ >> 1) && bid_ < (G_ >> 1) + 64) { pg8::Gemm g{MEMX, WMEM, 1024, 4096, D}; pg8::StaticOrder S; S.init(1024, 4096, 64, bid_ - (G_ >> 1));
              pg8::EpiMemKV E{out + O_MKP, out + O_MVP, MEMK, MEMV};
              pg8::gemm_phase<pg8::EpiMemKV, pg8::StaticOrder, true, true>(F.lds + RING_OFF, g, S, E, FRESH_TID()); }
            if (l == 2) { pg8::Gemm g{X, WIN + (size_t)NBQ * D, MP, NKV, D}; pg8::StaticOrder S; S.init(MP, NKV, G_, bid_);
              pg8::EpiKV E{out + O_SKP, out + O_SVP, out + O_SKS, out + O_SVS, KPB, VPB, SBKS, SBVS};
              pg8::gemm_phase<pg8::EpiKV, pg8::StaticOrder, true, true>(F.lds + RING_OFF, g, S, E, FRESH_TID()); }
            if (LA) { if (bid_ >= (G_ >> 1)) { SkBf16 E{PROJ, ldp};
                    if (l == 0 && G_ == 256) {
                        const int ns = bid_ < 192 ? 2 : 8, s0 = bid_ < 192 ? bid_ - 128 : 128 + (bid_ - 192);
                        for (int m = 0; m < ns; ++m) skinny_gemm(s0 + 64 * m, 640, FRESH_TID(), wave_, F.lds + RING_OFF, X + (size_t)MP * D, D, WIN, D, ldp / 32, E); }
                    else skinny_gemm(bid_ - (G_ >> 1), G_ >> 1, FRESH_TID(), wave_, F.lds + RING_OFF, X + (size_t)MP * D, D, WIN, D, ldp / 32, E); } }
            else if (!(bid_ & 1))
            for (int skr = 0; skr < SK_REP; ++skr) { SkBf16 E{PROJ, ldp}; skinny_gemm(bid_, G_, FRESH_TID(), wave_, F.lds + RING_OFF, X + (size_t)MP * D, D, WIN, D, ldp / 32, E); }
            if (!(bid_ & 1))
            for (int skr = 0; skr < SK_REP; ++skr) if (l == 2) { SkKV E{out + O_SKS, out + O_SVS, SBKS, SBVS}; skinny_gemm(bid_, G_, FRESH_TID(), wave_, F.lds + RING_OFF, X + (size_t)MP * D, D, WIN + (size_t)NBQ * D, D, NKV / 32, E); }
        PHASE_END
        PHASE_BEGIN(LA, 3)
            if (G_ == 256) gla_prep_intra<1>(bid_, G_, tid, wave_, F.lds + RING_OFF, l, PROJ, w_gate_lr, b_gate, (unsigned char*)Y, OINT);
            else gla_prep_intra<0>(bid_, G_, tid, wave_, F.lds + RING_OFF, l, PROJ, w_gate_lr, b_gate, (unsigned char*)Y, OINT);
        PHASE_END
        PHASE_BEGIN(!LA, 11)
            {
#if defined(SB_MODE)
                for (int u = gw_; u < 12288; u += NGW_) { const int bh = u >> 8, qb = u & 255, b = bh / 12, h = bh % 12, t0 = 32 * qb; const size_t qo = (size_t)(b * SEQ + t0) * D + h * 128;
                    sb_attn<SB_MODE>(lane, F.lds + RING_OFF + wave_ * 16384, KPB + (size_t)bh * SEQ * 128, 128, VPB + (size_t)bh * SEQ * 128, 0, PROJ + qo, NBQ, OCAT + qo, t0, 32); }
#endif
                for (int sbr = 0; sbr < SB_REP; ++sbr)
                for (int u = gw_; u < 12288 + 96; u += NGW_) {
                    if (u < 12288) { const int bh = u >> 8, qb = u & 255, b = bh / 12, h = bh % 12, t0 = 32 * qb; const size_t qo = (size_t)(b * SEQ + t0) * D + h * 128;
                        sb_attn(lane, F.lds + RING_OFF + wave_ * 16384, KPB + (size_t)bh * SEQ * 128, 128, VPB + (size_t)bh * SEQ * 128, 0, PROJ + qo, NBQ, OCAT + qo, t0, 32); }
                    else { const int u2 = u - 12288, b = u2 / 12, h = u2 % 12; const size_t qo = (size_t)(MP + b * 16) * D + h * 128;
                        sb_attn(lane, F.lds + RING_OFF + wave_ * 16384, SBKS + (size_t)u2 * 2080 * 128, 128, SBVS + (size_t)u2 * 65 * 4096, 0, PROJ + qo, NBQ, OCAT + qo, 2048, 16); }
                }
            }
            __syncthreads();
            for (int mr = 0; mr < MEM_REP; ++mr)
            if (G_ == 256) {
                mem_attn_wg(bid_, FRESH_TID(), wave_, F.lds + RING_OFF, l, PROJ, ldp, LA ? CQM : 1536, MEMK, MEMV, OCAT);
                if (bid_ >= 224) mem_attn_wg(256 + bid_ - 224, FRESH_TID(), wave_, F.lds + RING_OFF, l, PROJ, ldp, LA ? CQM : 1536, MEMK, MEMV, OCAT); }
            else
            for (int wi = bid_; wi < 256 + 32; wi += G_) mem_attn_wg(wi, FRESH_TID(), wave_, F.lds + RING_OFF, l, PROJ, ldp, LA ? CQM : 1536, MEMK, MEMV, OCAT);
        PHASE_END
        PHASE_BEGIN(LA, 12)
            if (G_ == 256) { if (bid_ >= 144) { mem_attn_wg(bid_ - 144, FRESH_TID(), wave_, F.lds + RING_OFF, l, PROJ, ldp, CQM, MEMK, MEMV, OCAT); mem_attn_wg(bid_ - 144 + 112, FRESH_TID(), wave_, F.lds + RING_OFF, l, PROJ, ldp, CQM, MEMK, MEMV, OCAT); }
                    if (bid_ >= 224) { __syncthreads(); gla_prep_intra<2>(bid_ - 224, G_, FRESH_TID(), wave_, F.lds + RING_OFF, l, PROJ, w_gate_lr, b_gate, (unsigned char*)Y, OINT); } }
            else for (int wi = bid_; wi < 256 + 32; wi += G_) mem_attn_wg(wi, FRESH_TID(), wave_, F.lds + RING_OFF, l, PROJ, ldp, CQM, MEMK, MEMV, OCAT);
            for (int wc = bid_; wc < 144; wc += G_) gla_chain<1>(wc, FRESH_TID(), wave_, F.lds + RING_OFF, l, (const unsigned char*)Y, state_gla, OINT, out, (float*)WMEM, (float*)MEMX);
            if (G_ == 256 && bid_ < 64) mem_attn_wg(224 + bid_, FRESH_TID(), wave_, F.lds + RING_OFF, l, PROJ, ldp, CQM, MEMK, MEMV, OCAT);
        PHASE_END
        PHASE_BEGIN(LA, 5)
            if (G_ == 256 && bid_ >= 192) { const int lw = (bid_ - 192) * NWAVES + wave_; if (l == 0) CONVERT_CACHE_K(lw, 64 * NWAVES); else CONVERT_CACHE_V(lw, 64 * NWAVES); }
            for (int wc = bid_; wc < 192 + 96; wc += (G_ == 256 ? (bid_ >= 192 ? 64 : 4096) : G_)) gla_chain<2>(wc, FRESH_TID(), wave_, F.lds + RING_OFF, l, (const unsigned char*)Y, state_gla, OINT, out, (float*)WMEM, (float*)MEMX, REP_CLS == 5 && rep_ == 0);
        PHASE_END
        PHASE_BEGIN(LA, 6)
            const float* gn = gla_norm_g + (size_t)l * 384;
            for (int row = gw_; row < MR; row += NGW_) {
                const bf16* op = OINT + (size_t)row * 1536 + 24 * lane; const bf16* gp = PROJ + (size_t)row * NA + CG + 24 * lane; const float* gnp = gn + 24 * (lane & 15);
                f32x4 ov[6]; v4u gv[3]; float ss = 0.f;
#pragma unroll
                for (int j = 0; j < 3; ++j) { const v4u w = *(const v4u*)(op + 8 * j); ov[2 * j] = (f32x4){pg8::bflo(w.x), pg8::bfhi(w.x), pg8::bflo(w.y), pg8::bfhi(w.y)}; ov[2 * j + 1] = (f32x4){pg8::bflo(w.z), pg8::bfhi(w.z), pg8::bflo(w.w), pg8::bfhi(w.w)}; }
#pragma unroll
                for (int j = 0; j < 6; ++j) ss += (ov[j].x * ov[j].x + ov[j].y * ov[j].y) + (ov[j].z * ov[j].z + ov[j].w * ov[j].w);
#pragma unroll
                for (int j = 0; j < 3; ++j) gv[j] = *(const v4u*)(gp + 8 * j);
                ss += shx(ss, lane, 1); ss += shx(ss, lane, 2); ss += shx(ss, lane, 4); ss += shx(ss, lane, 8);
                const float r = 1.0f / sqrtf(ss * (1.0f / 384.0f) + RMS_EPS);
#pragma unroll
                for (int j = 0; j < 3; ++j) { const f32x4 n0 = *(const f32x4*)(gnp + 8 * j), n1 = *(const f32x4*)(gnp + 8 * j + 4); const f32x4 a = ov[2 * j], b = ov[2 * j + 1];
                    float gt[8]; gt[0] = pg8::bflo(gv[j].x); gt[1] = pg8::bfhi(gv[j].x); gt[2] = pg8::bflo(gv[j].y); gt[3] = pg8::bfhi(gv[j].y); gt[4] = pg8::bflo(gv[j].z); gt[5] = pg8::bfhi(gv[j].z); gt[6] = pg8::bflo(gv[j].w); gt[7] = pg8::bfhi(gv[j].w);
                    float o8[8];
#pragma unroll
                    for (int i = 0; i < 4; ++i) { o8[i] = a[i] * r * n0[i] * (gt[i] * __builtin_amdgcn_rcpf(1.0f + __expf(-gt[i]))); o8[4 + i] = b[i] * r * n1[i] * (gt[4 + i] * __builtin_amdgcn_rcpf(1.0f + __expf(-gt[4 + i]))); }
                    v4u o; o.x = pk2(o8[0], o8[1]); o.y = pk2(o8[2], o8[3]); o.z = pk2(o8[4], o8[5]); o.w = pk2(o8[6], o8[7]);
                    *(v4u*)(OCAT + (size_t)row * D + 24 * lane + 8 * j) = o; }
            }
        PHASE_END
        PHASE_BEGIN(true, 7)
            if (bid_ & 1) { SkRes Es{YB, X, DN_ALPHA}; skinny_gemm(bid_, G_, FRESH_TID(), wave_, F.lds + RING_OFF, OCAT + (size_t)MP * D, D, WO, D, D / 32, Es); }
            pg8::Gemm g{OCAT, WO, MP, D, D}; pg8::StaticOrder S; S.init(MP, D, G_, bid_); pg8::EpiRes E{YB, X, D, DN_ALPHA};
            pg8::gemm_phase<pg8::EpiRes, pg8::StaticOrder, true, true>(F.lds + RING_OFF, g, S, E, FRESH_TID());
            if (!(bid_ & 1))
            for (int skr = 0; skr < SK_REP; ++skr) { SkRes Es{YB, X, DN_ALPHA}; skinny_gemm(bid_, G_, FRESH_TID(), wave_, F.lds + RING_OFF, OCAT + (size_t)MP * D, D, WO, D, D / 32, Es); }
        PHASE_END
        PHASE_BEGIN(true, 8)
            const float* gg = ln1_g + (size_t)l * D; const float* bb = ln1_b + (size_t)l * D;
            ln_rows<false>(lane, gw_, NGW_, YB, gg, bb, X, [](int) -> float* { return nullptr; });
        PHASE_END
        PHASE_BEGIN(true, 9)
            for (int dl = 0; dl < 3 * STAG * (bid_ >> 1 & 3); ++dl) __builtin_amdgcn_s_sleep(127);
            if (bid_ & 1) { SkSwiGLU Es{HB}; skinny_gemm(bid_, G_, FRESH_TID(), wave_, F.lds + RING_OFF, X + (size_t)MP * D, D, WFI, D, DFF / 16, Es); }
            pg8::Gemm g{X, WFI, MP, 2 * DFF, D}; pg8::StaticOrder S; S.init(MP, 2 * DFF, G_, bid_); pg8::EpiSwiGLU E{HB, DFF};
            pg8::gemm_phase<pg8::EpiSwiGLU, pg8::StaticOrder, true, true>(F.lds + RING_OFF, g, S, E, FRESH_TID());
            if (!(bid_ & 1))
            for (int skr = 0; skr < SK_REP; ++skr) { SkSwiGLU Es{HB}; skinny_gemm(bid_, G_, FRESH_TID(), wave_, F.lds + RING_OFF, X + (size_t)MP * D, D, WFI, D, DFF / 16, Es); }
        PHASE_END
        PHASE_BEGIN(true, 10)
            if (bid_ & 1) { SkRes Es{YB, X, DN_ALPHA}; skinny_gemm(bid_, G_, FRESH_TID(), wave_, F.lds + RING_OFF, HB + (size_t)MP * DFF, DFF, WFO, DFF, D / 32, Es); }
            pg8::Gemm g{HB, WFO, MP, D, DFF}; pg8::StaticOrder S; S.init(MP, D, G_, bid_); pg8::EpiRes E{YB, X, D, DN_ALPHA};
            pg8::gemm_phase<pg8::EpiRes, pg8::StaticOrder, true, true>(F.lds + RING_OFF, g, S, E, FRESH_TID());
            if (!(bid_ & 1))
            for (int skr = 0; skr < SK_REP; ++skr) { SkRes Es{YB, X, DN_ALPHA}; skinny_gemm(bid_, G_, FRESH_TID(), wave_, F.lds + RING_OFF, HB + (size_t)MP * DFF, DFF, WFO, DFF, D / 32, Es); }
        PHASE_END
        PHASE_BEGIN(true, 8)
            if (l < 3) CONVERT_WEIGHTS(l + 1);
            const float* gg = ln2_g + (size_t)l * D; const float* bb = ln2_b + (size_t)l * D;
            if (l == 3) ln_rows<true>(lane, gw_, NGW_, YB, gg, bb, nullptr, [&](int row) -> float* { return row < MP ? out + O_YP + (size_t)row * D : out + O_YS + (size_t)(row - MP) * D; });
            else ln_rows<false>(lane, gw_, NGW_, YB, gg, bb, X, [](int) -> float* { return nullptr; });
        PHASE_END
    }
#if defined(DIAG_A)
    if (blockIdx.x == 0 && threadIdx.x == 0) { unsigned long long* dts = (unsigned long long*)(args.ws_ + 262144); dts[ph] = rt(); dts[63] = (unsigned long long)ph; }
#endif
#undef ws
#undef out
#undef X
#undef Y
#undef YB
#undef CONVERT_WEIGHTS
#undef CONVERT_CACHE_K
#undef CONVERT_CACHE_V
#undef PHASE_BEGIN
#undef PHASE_END
}

#if defined(DIAG_A)
__device__ const int diag_cls[40] = {0,0, 1,2,3,4,5,6,7,8,9,10,8, 1,2,3,4,5,6,7,8,9,10,8, 1,2,11,7,8,9,10,8, 1,2,11,7,8,9,10,8};
__global__ void diag_tail(float* o, const unsigned long long* dts) {
    __shared__ float dv[2];
    if (threadIdx.x == 0) { const int n = (int)dts[63]; unsigned long long sa = 0, sb = 0; for (int p = 0; p < n; ++p) { const unsigned long long d = dts[p + 1] - dts[p]; const int cl = diag_cls[p]; if (cl == DIAG_A) sa += d; if (cl == DIAG_B) sb += d; }
        dv[0] = (float)sa * 0.01f; dv[1] = (float)sb * 10.0f; }
    __syncthreads();
    for (int i = threadIdx.x; i < 262144; i += blockDim.x) o[O_YS + i] = dv[0];
    if (threadIdx.x == 0) o[O_YP] = dv[1];
}
#endif
#ifndef MK_PER_PHASE
#define MK_PER_PHASE 0
#endif
constexpr int N_PHASES = 1 + 2 * 10 + 2 * 7;
extern "C" void kernel_launch(void* const* d_in, const int* in_sizes, int n_in, void* d_out, int out_size, void* d_ws, size_t ws_size, hipStream_t stream) {
    static int grid = 0;
    if (grid == 0) {
        if (n_in != 22 || in_sizes[0] != MP * D || (size_t)out_size != O_END || ws_size < WS_END) { fprintf(stderr, "kernel_launch: unexpected shapes (n_in %d, in0 %d, out %d, ws %zu); nothing launched\n", n_in, n_in > 0 ? in_sizes[0] : -1, out_size, ws_size); grid = -1; return; }
        int dev = 0, cus = 0, per_cu = 0;
        if (hipGetDevice(&dev) != hipSuccess || hipDeviceGetAttribute(&cus, hipDeviceAttributeMultiprocessorCount, dev) != hipSuccess) { grid = -1; return; }
        if (hipFuncSetAttribute((const void*)mega, hipFuncAttributeMaxDynamicSharedMemorySize, LDS_BYTES) != hipSuccess) { fprintf(stderr, "kernel_launch: hipFuncSetAttribute failed\n"); grid = -1; return; }
        if (hipOccupancyMaxActiveBlocksPerMultiprocessor(&per_cu, (const void*)mega, NWAVES * 64, LDS_BYTES) != hipSuccess || per_cu < 1) fprintf(stderr, "kernel_launch: occupancy query reports %d\n", per_cu);
        (void)hipGetLastError();
        grid = cus;
    }
    if (grid < 0) return;
    if (hipMemsetAsync((char*)d_ws + WS_CTL, 0, CTL_ZERO_BYTES, stream) != hipSuccess) return;
    Args a{};
    for (int i = 0; i < 22; ++i) a.in[i] = (const float*)d_in[i];
    a.out_ = (float*)d_out; a.ws_ = (unsigned char*)d_ws;
#if MK_PER_PHASE
    for (int p = 0; p < N_PHASES; ++p) { a.ph_lo = p; a.ph_hi = p + 1; hipLaunchKernelGGL(mega, dim3(grid), dim3(NWAVES * 64), LDS_BYTES, stream, a); }
#else
    a.ph_lo = 0; a.ph_hi = N_PHASES; hipLaunchKernelGGL(mega, dim3(grid), dim3(NWAVES * 64), LDS_BYTES, stream, a);
#if defined(DIAG_A)
    hipLaunchKernelGGL(diag_tail, dim3(1), dim3(512), 0, stream, (float*)d_out, (const unsigned long long*)((unsigned char*)d_ws + 262144));
#endif
#endif
}
```

```cpp
#include <hip/hip_runtime.h>
#include <cstdio>
#include <cstdint>
namespace pg8 {
#define PG8_LAS __attribute__((address_space(3)))
typedef unsigned short bf16_t;
typedef short bf16x8 __attribute__((ext_vector_type(8)));
typedef float f32x4 __attribute__((ext_vector_type(4)));
typedef unsigned u32x4 __attribute__((ext_vector_type(4)));
constexpr int BM = 256, BK = 64, HALF = 128, HTB = HALF * BK * 2  , STAGE_BYTES = 8 * HTB, NXCD = 8, WGM = 4;

__host__ __device__ __forceinline__ int lds_byte(int r, int c) { const int st = (r >> 4) * 2 + (c >> 5), rr = r & 15, cc = c & 31, ob = rr * 64 + cc * 2; return st * 1024 + (ob ^ (((ob >> 9) & 1) << 5)); }
__host__ __device__ __forceinline__ void stage_rc(int b, int& R, int& C) { const int st = b / 1024, sb = b % 1024, swz = sb ^ (((sb >> 9) & 1) << 5); R = (st >> 1) * 16 + swz / 64; C = (st & 1) * 32 + (swz % 64) / 2; }
__host__ __device__ __forceinline__ int perm32(int rho) { const int n = rho >> 4, i = rho & 15; return 8 * (i >> 2) + 4 * n + (i & 3); }

struct Unit { int pm, pn; };
struct Gemm { const bf16_t* A; const bf16_t* Bt; int M, N, K; };

struct StaticOrder {
    int nM, nN, nwg, G, c;
    __host__ __device__ void init(int M, int N, int G_, int c_) { nM = M / BM; nN = N / BM; nwg = nM * nN; G = G_; c = c_; }
    __host__ __device__ bool next(int i, Unit& u) const {
        const long L = (long)i * G + c; if (L >= nwg) return false;
        int wgid = (int)L; { const int q = nwg / NXCD, r = nwg % NXCD, xcd = wgid % NXCD, off = wgid / NXCD; wgid = (xcd < r ? xcd * (q + 1) : r * (q + 1) + (xcd - r) * q) + off; }
        const int nig = WGM * nN, gid = wgid / nig, fm = gid * WGM, gsz = (nM - fm) < WGM ? (nM - fm) : WGM;
        u.pm = fm + ((wgid % nig) % gsz); u.pn = (wgid % nig) / gsz; return true;
    }
    __device__ __forceinline__ void a_ready(const Unit&) const {}
    __device__ __forceinline__ void done(const Unit&) const {}
};
__device__ __forceinline__ unsigned cvt_pk_bf16(float lo, float hi) { unsigned r; asm volatile("v_cvt_pk_bf16_f32 %0, %1, %2" : "=v"(r) : "v"(lo), "v"(hi)); return r; }
typedef float f32x2 __attribute__((ext_vector_type(2)));
typedef unsigned u32x2 __attribute__((ext_vector_type(2)));
__host__ __device__ __forceinline__ int vtf_d(int d) { return (d >> 5) * 1024 + (d & 31) * 8; }
__host__ __device__ __forceinline__ int vtf_k(int ks) { return (ks >> 4) * 512 + ((ks >> 2) & 1) * 256 + (ks & 3) + 4 * ((ks >> 3) & 1); }
__device__ __forceinline__ float bflo(unsigned w) { return __builtin_bit_cast(float, w << 16); }
__device__ __forceinline__ float bfhi(unsigned w) { return __builtin_bit_cast(float, w & 0xffff0000u); }
struct EpiBf16 {
    static constexpr bool PERM = true, AFTER_DRAIN = false;
    bf16_t* O; int ldc;
    __device__ __forceinline__ void operator()(const f32x4 (&acc)[2][2][4][2], const Unit& u, int wr, int wc, int fr, int fq) const {
        const int row0 = u.pm * BM + wr * 64 + fr, col0 = u.pn * BM + wc * 32 + 8 * fq;
#pragma unroll
        for (int ai = 0; ai < 2; ++ai)
#pragma unroll
            for (int m = 0; m < 4; ++m) { bf16_t* rowp = O + (size_t)(row0 + ai * HALF + m * 16) * ldc + col0;
#pragma unroll
                for (int bj = 0; bj < 2; ++bj) { const f32x4 v0 = acc[ai][bj][m][0], v1 = acc[ai][bj][m][1];
                    u32x4 w; w.x = cvt_pk_bf16(v0[0], v0[1]); w.y = cvt_pk_bf16(v0[2], v0[3]); w.z = cvt_pk_bf16(v1[0], v1[1]); w.w = cvt_pk_bf16(v1[2], v1[3]);
                    *(u32x4*)(rowp + bj * HALF) = w; } }
    }
};
struct EpiSwiGLU {
    static constexpr bool PERM = true, AFTER_DRAIN = false;
    bf16_t* Hh; int ldh;
    __device__ __forceinline__ float swi(float g, float up) const { return g * __builtin_amdgcn_rcpf(1.0f + __expf(-g)) * up; }
    __device__ __forceinline__ void operator()(const f32x4 (&acc)[2][2][4][2], const Unit& u, int wr, int wc, int fr, int fq) const {
        const int row0 = u.pm * BM + wr * 64 + fr, col0 = u.pn * HALF + wc * 32 + 8 * fq;
#pragma unroll
        for (int ai = 0; ai < 2; ++ai)
#pragma unroll
            for (int m = 0; m < 4; ++m) { bf16_t* rowp = Hh + (size_t)(row0 + ai * HALF + m * 16) * ldh + col0;
                const f32x4 g0 = acc[ai][0][m][0], g1 = acc[ai][0][m][1], u0 = acc[ai][1][m][0], u1 = acc[ai][1][m][1];
                u32x4 w; w.x = cvt_pk_bf16(swi(g0[0], u0[0]), swi(g0[1], u0[1])); w.y = cvt_pk_bf16(swi(g0[2], u0[2]), swi(g0[3], u0[3]));
                w.z = cvt_pk_bf16(swi(g1[0], u1[0]), swi(g1[1], u1[1])); w.w = cvt_pk_bf16(swi(g1[2], u1[2]), swi(g1[3], u1[3]));
                *(u32x4*)rowp = w; }
    }
};
struct EpiRes {
    static constexpr bool PERM = true, AFTER_DRAIN = false;
    bf16_t* Y; const bf16_t* X; int ldc; float alpha;
    __device__ __forceinline__ void operator()(const f32x4 (&acc)[2][2][4][2], const Unit& u, int wr, int wc, int fr, int fq) const {
        const int row0 = u.pm * BM + wr * 64 + fr, col0 = u.pn * BM + wc * 32 + 8 * fq;
        u32x4 xv[2][4][2];
#pragma unroll
        for (int ai = 0; ai < 2; ++ai)
#pragma unroll
            for (int m = 0; m < 4; ++m)
#pragma unroll
                for (int bj = 0; bj < 2; ++bj) xv[ai][m][bj] = *(const u32x4*)(X + (size_t)(row0 + ai * HALF + m * 16) * ldc + col0 + bj * HALF);
#pragma unroll
        for (int ai = 0; ai < 2; ++ai)
#pragma unroll
            for (int m = 0; m < 4; ++m) { const size_t ro = (size_t)(row0 + ai * HALF + m * 16) * ldc + col0;
#pragma unroll
                for (int bj = 0; bj < 2; ++bj) { const u32x4 x4 = xv[ai][m][bj]; const f32x4 a0 = acc[ai][bj][m][0], a1 = acc[ai][bj][m][1];
                    u32x4 w; w.x = cvt_pk_bf16(alpha * bflo(x4.x) + a0[0], alpha * bfhi(x4.x) + a0[1]); w.y = cvt_pk_bf16(alpha * bflo(x4.y) + a0[2], alpha * bfhi(x4.y) + a0[3]);
                    w.z = cvt_pk_bf16(alpha * bflo(x4.z) + a1[0], alpha * bfhi(x4.z) + a1[1]); w.w = cvt_pk_bf16(alpha * bflo(x4.w) + a1[2], alpha * bfhi(x4.w) + a1[3]);
                    *(u32x4*)(Y + ro + bj * HALF) = w; } }
    }
};
struct EpiKV {
    static constexpr bool PERM = false, AFTER_DRAIN = false;
    float *okp, *ovp, *oks, *ovs; bf16_t *kpb, *vpb, *ksb, *vsb;
    __device__ __forceinline__ void operator()(const f32x4 (&acc)[2][2][4][2], const Unit& u, int wr, int wc, int fr, int fq) const {
        const bool isv = u.pn >= 6; const int colt = (u.pn - (isv ? 6 : 0)) * BM + wc * 32 + 4 * fq, row0 = u.pm * BM + wr * 64 + fr;
        float* op = isv ? ovp : okp;
#pragma unroll
        for (int ai = 0; ai < 2; ++ai)
#pragma unroll
            for (int m = 0; m < 4; ++m) { const int row = row0 + ai * HALF + m * 16; float* fd;
                if (row < 32768) { fd = op + (size_t)row * 1536; } else continue;
                const int bq = row >> 13, sq = row & 8191;
#pragma unroll
                for (int bj = 0; bj < 2; ++bj)
#pragma unroll
                    for (int n = 0; n < 2; ++n) { const int c = colt + bj * HALF + n * 16; const f32x4 v = acc[ai][bj][m][n];
                        *(f32x4*)(fd + c) = v; const unsigned w0 = cvt_pk_bf16(v[0], v[1]), w1 = cvt_pk_bf16(v[2], v[3]);
                        const int hq = c >> 7, dq = c & 127;
                        if (!isv) { u32x2 w; w.x = w0; w.y = w1; *(u32x2*)(kpb + ((size_t)(bq * 12 + hq) * 8192 + sq) * 128 + dq) = w; }
                        else { bf16_t* vt = vpb + ((size_t)(bq * 12 + hq) * 256 + (sq >> 5)) * 4096 + vtf_d(dq) + vtf_k(sq & 31); vt[0] = (bf16_t)w0; vt[8] = (bf16_t)(w0 >> 16); vt[16] = (bf16_t)w1; vt[24] = (bf16_t)(w1 >> 16); } } }
    }
};
struct EpiMemKV {
    static constexpr bool PERM = false, AFTER_DRAIN = false;
    float *ok, *ov; bf16_t *kb, *vb;
    __device__ __forceinline__ void operator()(const f32x4 (&acc)[2][2][4][2], const Unit& u, int wr, int wc, int fr, int fq) const {
        const int l = u.pn >> 2, kv = (u.pn >> 1) & 1, hd0 = (u.pn & 1) * BM + wc * 32 + 4 * fq, row0 = u.pm * BM + wr * 64 + fr;
        float* fo = kv ? ov : ok; bf16_t* bo = kv ? vb : kb;
#pragma unroll
        for (int ai = 0; ai < 2; ++ai)
#pragma unroll
            for (int m = 0; m < 4; ++m) { const int row = row0 + ai * HALF + m * 16, b = row >> 8, mm = row & 255;
                float* fd = fo + (size_t)(l * 1024 + row) * 512; bf16_t* bd = bo + (size_t)((l * 12 + b) * 256 + mm) * 512;
#pragma unroll
                for (int bj = 0; bj < 2; ++bj)
#pragma unroll
                    for (int n = 0; n < 2; ++n) { const int c = hd0 + bj * HALF + n * 16; const f32x4 v = acc[ai][bj][m][n];
                        *(f32x4*)(fd + c) = v; const unsigned w0 = cvt_pk_bf16(v[0], v[1]), w1 = cvt_pk_bf16(v[2], v[3]);
                        if (!kv) { u32x2 w; w.x = w0; w.y = w1; *(u32x2*)(bd + c) = w; }
                        else { bf16_t* vt = vb + (size_t)((l * 12 + b) * 512 + c) * 256 + mm;
                            vt[0] = (bf16_t)w0; vt[256] = (bf16_t)(w0 >> 16); vt[512] = (bf16_t)w1; vt[768] = (bf16_t)(w1 >> 16); } } }
    }
};
template <class Epi, class Sched, bool ALIGN_EPI = false, bool SP2 = false>
__device__ __forceinline__ void gemm_phase(PG8_LAS unsigned char* lds, const Gemm g, const Sched& S, const Epi& E, int tid_in) {
    int tid_ = tid_in; asm volatile("" : "+v"(tid_));
    const int tid = tid_, wid = __builtin_amdgcn_readfirstlane(tid >> 6), lane = tid & 63, wr = wid >> 2, wc = wid & 3, fr = lane & 15, fq = lane >> 4;
    const int K = g.K, nt = K / BK;
    unsigned voffA[2], voffB[2];
#pragma unroll
    for (int i = 0; i < 2; ++i) { int R, C; stage_rc(tid * 16 + i * 8192, R, C); const int Rb = Epi::PERM ? ((R & ~31) + perm32(R & 31)) : R;
        voffA[i] = (unsigned)(R * K + C) * 2u; voffB[i] = (unsigned)(Rb * K + C) * 2u; }
    const size_t kstep = (size_t)(BK * 2);
    const size_t hstep = (size_t)HALF * K * 2;
    const size_t tstep = 2 * hstep;
    const unsigned ldsw = (unsigned)wid * 1024u;
    const int aoff = lds_byte(wr * 64 + fr, fq * 8), boff = lds_byte(wc * 32 + fr, fq * 8);
#define PG8_SA(b, h) (((b) * 2 + (h)) * HTB)
#define PG8_SB(b, h) ((4 + (b) * 2 + (h)) * HTB)
#define PG8_STAGE_X(bufoff, gbase, voff, aux) do { _Pragma("unroll") for (int _i = 0; _i < 2; ++_i) \
        __builtin_amdgcn_global_load_lds((const unsigned*)((const char*)(gbase) + (voff)[_i]), (PG8_LAS unsigned*)(lds + (bufoff) + ldsw + _i * 8192), 16, 0, aux); } while (0)
#ifndef PG8_B_AUX
#define PG8_B_AUX 0
#endif
#define PG8_STAGE(bufoff, gbase, voff) PG8_STAGE_X(bufoff, gbase, voff, 0)
#define PG8_LDA(dst, b, h) do { _Pragma("unroll") for (int m = 0; m < 4; ++m) _Pragma("unroll") for (int k = 0; k < 2; ++k) dst[m][k] = *(const PG8_LAS bf16x8*)(lds + PG8_SA(b, h) + aoff + m * 2048 + k * 1024); } while (0)
#define PG8_LDB(dst, b, h) do { _Pragma("unroll") for (int n = 0; n < 2; ++n) _Pragma("unroll") for (int k = 0; k < 2; ++k) dst[n][k] = *(const PG8_LAS bf16x8*)(lds + PG8_SB(b, h) + boff + n * 2048 + k * 1024); } while (0)
#define PG8_MMA(ai, bj, At, Bt) do { __builtin_amdgcn_s_setprio(1); _Pragma("unroll") for (int m = 0; m < 4; ++m) _Pragma("unroll") for (int n = 0; n < 2; ++n) _Pragma("unroll") for (int k = 0; k < 2; ++k) \
        acc[ai][bj][m][n] = __builtin_amdgcn_mfma_f32_16x16x32_bf16(Bt[n][k], At[m][k], acc[ai][bj][m][n], 0, 0, 0); __builtin_amdgcn_s_setprio(0); } while (0)
#define PG8_WAIT_V(n) asm volatile("s_waitcnt vmcnt(" #n ")" ::: "memory")
#define PG8_WAIT_L(n) asm volatile("s_waitcnt lgkmcnt(" #n ")" ::: "memory")
#define PG8_BAR __builtin_amdgcn_s_barrier()
#define PG8_SCHED __builtin_amdgcn_sched_barrier(0)
    Unit cur, nxt; int ui = 0;
    if (!S.next(0, cur)) return;
    f32x4 acc[2][2][4][2];
#pragma unroll
    for (int a = 0; a < 2; ++a)
#pragma unroll
        for (int b = 0; b < 2; ++b)
#pragma unroll
            for (int m = 0; m < 4; ++m)
#pragma unroll
                for (int n = 0; n < 2; ++n) acc[a][b][m][n] = (f32x4){0.f, 0.f, 0.f, 0.f};
    bf16x8 At[4][2], B0[2][2], B1[2][2];
    const char* cA = (const char*)g.A + (size_t)cur.pm * tstep; const char* cB = (const char*)g.Bt + (size_t)cur.pn * tstep;
    S.a_ready(cur);
    if constexpr (SP2) {
        PG8_STAGE_X(PG8_SB(0, 0), cB, voffB, PG8_B_AUX); PG8_STAGE_X(PG8_SB(0, 1), cB + hstep, voffB, PG8_B_AUX); PG8_STAGE(PG8_SA(0, 0), cA, voffA); PG8_STAGE(PG8_SA(0, 1), cA + hstep, voffA);
        if (wr == 1) PG8_BAR;
        PG8_WAIT_V(2); PG8_BAR;
        PG8_STAGE_X(PG8_SB(1, 0), cB + kstep, voffB, PG8_B_AUX); PG8_STAGE(PG8_SA(1, 0), cA + kstep, voffA); PG8_STAGE_X(PG8_SB(1, 1), cB + hstep + kstep, voffB, PG8_B_AUX);
        PG8_WAIT_V(6); PG8_BAR;
    } else {
        PG8_STAGE_X(PG8_SB(0, 0), cB, voffB, PG8_B_AUX); PG8_STAGE(PG8_SA(0, 0), cA, voffA); PG8_STAGE_X(PG8_SB(0, 1), cB + hstep, voffB, PG8_B_AUX); PG8_STAGE(PG8_SA(0, 1), cA + hstep, voffA);
        if (wr == 1) PG8_BAR;
        PG8_WAIT_V(4); PG8_BAR;
        PG8_STAGE_X(PG8_SB(1, 0), cB + kstep, voffB, PG8_B_AUX); PG8_STAGE(PG8_SA(1, 0), cA + kstep, voffA); PG8_STAGE_X(PG8_SB(1, 1), cB + hstep + kstep, voffB, PG8_B_AUX);
        PG8_WAIT_V(6); PG8_BAR;
    }
    for (;;) {
        const bool has_next = S.next(ui + 1, nxt);
        const char* nA = has_next ? (const char*)g.A + (size_t)nxt.pm * tstep : cA; const char* nB = has_next ? (const char*)g.Bt + (size_t)nxt.pn * tstep : cB;
        for (int t = 0; t < nt; t += 2) {
            const bool last = (t == nt - 2);
            const char* a1 = cA + (size_t)(t + 1) * kstep;
            const char* a2 = last ? nA : cA + (size_t)(t + 2) * kstep; const char* b2 = last ? nB : cB + (size_t)(t + 2) * kstep;
            const char* a3 = a2 + kstep; const char* b3 = b2 + kstep;
            if (last && has_next) S.a_ready(nxt);
            if constexpr (SP2) {
            PG8_LDB(B0, 0, 0); PG8_LDB(B1, 0, 1); PG8_SCHED; PG8_LDA(At, 0, 0); PG8_STAGE(PG8_SA(1, 1), a1 + hstep, voffA);
            PG8_WAIT_V(8); PG8_WAIT_L(0); PG8_BAR; PG8_MMA(0, 0, At, B0); PG8_MMA(0, 1, At, B1); PG8_BAR; PG8_SCHED;
            PG8_LDA(At, 0, 1); PG8_STAGE_X(PG8_SB(0, 0), b2, voffB, PG8_B_AUX); PG8_STAGE_X(PG8_SB(0, 1), b2 + hstep, voffB, PG8_B_AUX); PG8_STAGE(PG8_SA(0, 0), a2, voffA);
            PG8_WAIT_V(8); PG8_WAIT_L(0); PG8_BAR; PG8_MMA(1, 0, At, B0); PG8_MMA(1, 1, At, B1); PG8_BAR; PG8_SCHED;
            PG8_LDB(B0, 1, 0); PG8_LDB(B1, 1, 1); PG8_SCHED; PG8_LDA(At, 1, 0); PG8_STAGE(PG8_SA(0, 1), a2 + hstep, voffA);
            PG8_WAIT_V(8); PG8_WAIT_L(0); PG8_BAR; PG8_MMA(0, 0, At, B0); PG8_MMA(0, 1, At, B1); PG8_BAR; PG8_SCHED;
            PG8_LDA(At, 1, 1); PG8_STAGE_X(PG8_SB(1, 0), b3, voffB, PG8_B_AUX); PG8_STAGE_X(PG8_SB(1, 1), b3 + hstep, voffB, PG8_B_AUX); PG8_STAGE(PG8_SA(1, 0), a3, voffA);
            PG8_WAIT_V(8); PG8_WAIT_L(0); PG8_BAR; PG8_MMA(1, 0, At, B0); PG8_MMA(1, 1, At, B1); PG8_BAR; PG8_SCHED;
            } else {
            PG8_LDB(B0, 0, 0); PG8_SCHED; PG8_LDA(At, 0, 0); PG8_STAGE(PG8_SA(1, 1), a1 + hstep, voffA);
            PG8_WAIT_L(8); PG8_BAR; PG8_WAIT_L(0); PG8_MMA(0, 0, At, B0); PG8_BAR; PG8_SCHED;
            PG8_LDB(B1, 0, 1); PG8_STAGE_X(PG8_SB(0, 0), b2, voffB, PG8_B_AUX);
            PG8_BAR; PG8_WAIT_L(0); PG8_MMA(0, 1, At, B1); PG8_BAR;
            PG8_LDA(At, 0, 1); PG8_STAGE(PG8_SA(0, 0), a2, voffA);
            PG8_BAR; PG8_WAIT_L(0); PG8_MMA(1, 0, At, B0); PG8_BAR; PG8_SCHED;
            PG8_STAGE_X(PG8_SB(0, 1), b2 + hstep, voffB, PG8_B_AUX);
            PG8_WAIT_V(6); PG8_BAR; PG8_MMA(1, 1, At, B1); PG8_BAR;
            PG8_LDB(B0, 1, 0); PG8_SCHED; PG8_LDA(At, 1, 0); PG8_STAGE(PG8_SA(0, 1), a2 + hstep, voffA);
            PG8_WAIT_L(8); PG8_BAR; PG8_WAIT_L(0); PG8_MMA(0, 0, At, B0); PG8_BAR; PG8_SCHED;
            PG8_LDB(B1, 1, 1); PG8_STAGE_X(PG8_SB(1, 0), b3, voffB, PG8_B_AUX);
            PG8_BAR; PG8_WAIT_L(0); PG8_MMA(0, 1, At, B1); PG8_BAR;
            PG8_LDA(At, 1, 1); PG8_STAGE(PG8_SA(1, 0), a3, voffA);
            PG8_BAR; PG8_WAIT_L(0); PG8_MMA(1, 0, At, B0); PG8_BAR; PG8_SCHED;
            PG8_STAGE_X(PG8_SB(1, 1), b3 + hstep, voffB, PG8_B_AUX);
            PG8_WAIT_V(6); PG8_BAR; PG8_MMA(1, 1, At, B1); PG8_BAR;
            }
        }
        if constexpr (ALIGN_EPI) { if (wr == 0) PG8_BAR; }
        if constexpr (!Epi::AFTER_DRAIN) { E(acc, cur, wr, wc, fr, fq); S.done(cur); }
        if (!has_next) break;
#pragma unroll
        for (int a = 0; a < 2; ++a)
#pragma unroll
            for (int b = 0; b < 2; ++b)
#pragma unroll
                for (int m = 0; m < 4; ++m)
#pragma unroll
                    for (int n = 0; n < 2; ++n) acc[a][b][m][n] = (f32x4){0.f, 0.f, 0.f, 0.f};
        cur = nxt; cA = nA; cB = nB; ++ui;
        if constexpr (ALIGN_EPI) { if (wr == 1) PG8_BAR; }
    }
    PG8_WAIT_V(0);
    if constexpr (!ALIGN_EPI) { if (wr == 0) PG8_BAR; }
    PG8_BAR;
    if constexpr (Epi::AFTER_DRAIN) { E.fused(acc, cur, wr, wc, fr, fq, lds, wid, lane); S.done(cur); }
#undef PG8_SA
#undef PG8_SB
#undef PG8_STAGE
#undef PG8_STAGE_X
#undef PG8_LDA
#undef PG8_LDB
#undef PG8_MMA
#undef PG8_WAIT_V
#undef PG8_WAIT_L
#undef PG8_BAR
#undef PG8_SCHED
}
}
#define GAS __attribute__((address_space(1)))
#define LAS __attribute__((address_space(3)))
typedef unsigned short bf16;
typedef unsigned v4u __attribute__((ext_vector_type(4)));
typedef float f32x4 __attribute__((ext_vector_type(4)));
typedef short bf16x8 __attribute__((ext_vector_type(8)));
typedef GAS unsigned gu32;
typedef GAS unsigned long long gu64;
#define RLX_AGENT __ATOMIC_RELAXED, __HIP_MEMORY_SCOPE_AGENT
#define LDS_WAIT() asm volatile("s_waitcnt lgkmcnt(0)" ::: "memory")
#define VM_WAIT() asm volatile("s_waitcnt vmcnt(0)" ::: "memory")
__device__ __forceinline__ unsigned long long rt() { return __builtin_amdgcn_s_memrealtime(); }
__device__ __forceinline__ unsigned f2bf(float f) { unsigned u = __builtin_bit_cast(unsigned, f); return (u + 0x7fffu + ((u >> 16) & 1u)) >> 16; }
__device__ __forceinline__ unsigned pk2(float lo, float hi) { return f2bf(lo) | (f2bf(hi) << 16); }
#define XB_TMO      128
#define XB_XCNT(j)  (256  + 64 * (j))
#define XB_XSUB(j)  (1280 + 64 * (j))
#define XB_XGEN(j)  (2304 + 64 * (j))
#define XB_TOP      3328
#define XB_TOPGEN   3392
#define XCD_BAR_WORDS 3456
#define XB_SPIN_CAP (1u << 18)

__device__ __forceinline__ unsigned xb_ld(unsigned* p)              { return __hip_atomic_load(p, __ATOMIC_RELAXED, __HIP_MEMORY_SCOPE_AGENT); }
__device__ __forceinline__ unsigned xb_add(unsigned* p, unsigned v) { return __hip_atomic_fetch_add(p, v, __ATOMIC_RELAXED, __HIP_MEMORY_SCOPE_AGENT); }
__device__ __forceinline__ unsigned xb_xcc_id() { return (unsigned)__builtin_amdgcn_s_getreg((3 << 11) | 20) & 0xFu; }
#define XB_SPIN(cond, bar) do { unsigned _sp = 0; while (cond) { __builtin_amdgcn_s_sleep(1); \
    if ((++_sp & 255u) == 0u) { if (xb_ld(&(bar)[XB_TMO])) break; if (_sp > XB_SPIN_CAP) { atomicAdd(&(bar)[XB_TMO], 1u); break; } } } } while (0)

struct XcdBarrier {
    unsigned* bar; unsigned x;
    volatile LAS unsigned* st;
};

__device__ __forceinline__ XcdBarrier xcd_barrier_post(unsigned* bar, volatile LAS unsigned* st) {
    XcdBarrier b; b.bar = bar; b.x = xb_xcc_id(); b.st = st;
    if (threadIdx.x == 0) (void)xb_add(&bar[XB_XCNT(b.x)], 1u);
    return b;
}
__device__ __forceinline__ void xcd_barrier_complete(unsigned* bar, unsigned x, unsigned& nloc, unsigned& nx) {
    const unsigned G = gridDim.x * gridDim.y * gridDim.z;
    unsigned sum, cnt, mine, sp = 0u;
    for (;;) {
        sum = 0u; cnt = 0u; mine = 0u;
#pragma unroll
        for (unsigned j = 0; j < 16; ++j) { const unsigned c = xb_ld(&bar[XB_XCNT(j)]); sum += c; cnt += (c > 0u) ? 1u : 0u; mine = (j == x) ? c : mine; }
        if (sum == G) break;
        __builtin_amdgcn_s_sleep(1);
        if ((++sp & 255u) == 0u) { if (xb_ld(&bar[XB_TMO])) break; if (sp > XB_SPIN_CAP) { atomicAdd(&bar[XB_TMO], 1u); break; } }
    }
    nloc = mine > 0u ? mine : 1u; nx = cnt > 0u ? cnt : 1u;
}

__device__ __forceinline__ void xcd_barrier(const XcdBarrier& b) {
    asm volatile("s_waitcnt vmcnt(0)" ::: "memory");
    __syncthreads();
    if (threadIdx.x == 0) {
        unsigned* bar = b.bar;
        __builtin_amdgcn_s_waitcnt(0);
        unsigned nloc = b.st[0], nx = b.st[1];
        if (nloc == 0u) { xcd_barrier_complete(bar, b.x, nloc, nx); b.st[0] = nloc; b.st[1] = nx; }
        const unsigned old = xb_add(&bar[XB_XSUB(b.x)], 1u);
        const unsigned gen = old / nloc;
        if (old + 1u == (gen + 1u) * nloc) {
            __builtin_amdgcn_fence(__ATOMIC_RELEASE, "agent");
            asm volatile("s_waitcnt vmcnt(0)" ::: "memory");
            const unsigned og = xb_add(&bar[XB_TOP], 1u);
            const unsigned tg = og / nx;
            if (og + 1u == (tg + 1u) * nx) xb_add(&bar[XB_TOPGEN], 1u);
            else XB_SPIN(xb_ld(&bar[XB_TOPGEN]) == tg, bar);
            __builtin_amdgcn_fence(__ATOMIC_ACQUIRE, "agent");
            xb_add(&bar[XB_XGEN(b.x)], 1u);
            asm volatile("s_waitcnt vmcnt(0)" ::: "memory");
        } else {
            XB_SPIN(xb_ld(&bar[XB_XGEN(b.x)]) == gen, bar);
            __builtin_amdgcn_fence(__ATOMIC_ACQUIRE, "agent");
            asm volatile("s_waitcnt vmcnt(0)" ::: "memory");
        }
    }
    __syncthreads();
}
constexpr int NWAVES = 8;
constexpr int D = 2048, SEQ = 8192, MP = 32768, MS = 128, MR = 32896, MT = 33024;
constexpr int DFF = 5632, NA = 5376, NBQ = 2048, NKV = 3072;
constexpr int CQ = 0, CK = 768, CV = 1536, CG = 3072, CQM = 4608, CLR = 5120;
constexpr float DN_ALPHA = 1.6817928305074292f, LN_EPS = 1e-5f, RMS_EPS = 1e-6f;
constexpr float GLA_QSCALE = 0.07216878364870323f, HD_SCALE = 0.08838834764831845f;
constexpr size_t MiB = 1u << 20;
constexpr size_t WS_CTL = 0, CTL_ZERO_BYTES = 1 * MiB;
constexpr size_t WS_WIN = 1 * MiB, WS_WO = 22 * MiB, WS_WFI = 30 * MiB, WS_WFO = 74 * MiB, WS_WMEM = 96 * MiB, WS_MEMX = 112 * MiB, WS_MEMK = 116 * MiB, WS_MEMV = 128 * MiB;
constexpr size_t WS_X = 140 * MiB, WS_Y = 269 * MiB, WS_R1 = 527 * MiB, WS_OCAT = 882 * MiB, WS_SBKS = 1011 * MiB, WS_SBVS = 1060 * MiB, WS_END = 1109 * MiB;
static_assert(WS_WIN + (size_t)NA * D * 2 <= WS_WO && WS_WFI + (size_t)2 * DFF * D * 2 <= WS_WFO && WS_WFO + (size_t)D * DFF * 2 <= WS_WMEM, "weights map");
static_assert(WS_X + (size_t)MT * D * 2 <= WS_Y && WS_Y + (size_t)MT * D * 4 <= WS_R1 && WS_R1 + (size_t)MT * DFF * 2 <= WS_OCAT && WS_OCAT + (size_t)MT * D * 2 <= WS_SBKS, "activation map");
static_assert(WS_SBKS + (size_t)8 * 2064 * 1536 * 2 <= WS_SBVS && WS_SBVS + (size_t)8 * 2064 * 1536 * 2 <= WS_END, "sb sample map");
constexpr size_t O_YP = 0, O_YS = 67108864, O_GSP = 67371008, O_GSS = 69730304, O_SKP = 74448896, O_SVP = 124780544, O_SKS = 175112192, O_SVS = 175308800, O_MKP = 175505408, O_MVP = 177602560, O_END = 179699712;
constexpr int CW_BAR = 4096;
constexpr int RING_OFF = 0, RING_BYTES = 131072, LDSCTL_OFF = RING_BYTES, MISC_OFF = LDSCTL_OFF + 320, LDS_BYTES = 147456;

struct Args { const float* in[22]; float* out_; unsigned char* ws_; int ph_lo, ph_hi; };
struct Frame {
    LAS unsigned char* lds; volatile LAS unsigned* MISC; gu32* ctl;
    int tid, lane, wave, G, gw, NGW;
};
__device__ __forceinline__ float bf2f(bf16 h) { return __builtin_bit_cast(float, (unsigned)h << 16); }
__device__ __forceinline__ float shx(float v, int lane, int m) { return __builtin_bit_cast(float, __builtin_amdgcn_ds_bpermute((lane ^ m) << 2, __builtin_bit_cast(int, v))); }
__device__ __forceinline__ float wave_sum(float v, int lane) {
#pragma unroll
    for (int o = 1; o < 64; o <<= 1) v += shx(v, lane, o);
    return v;
}
__device__ __forceinline__ float wave_max(float v, int lane) {
#pragma unroll
    for (int o = 1; o < 64; o <<= 1) v = fmaxf(v, shx(v, lane, o));
    return v;
}
__device__ __forceinline__ void cvt_row(const float* src, bf16* dst, int n, int lane) {
    for (int j = lane * 4; j < n; j += 256) {
        f32x4 v = src ? *(const f32x4*)(src + j) : (f32x4){0.f, 0.f, 0.f, 0.f};
        unsigned long long w = (unsigned long long)pk2(v.x, v.y) | ((unsigned long long)pk2(v.z, v.w) << 32);
        *(unsigned long long*)(dst + j) = w;
    }
}
template <int N>
__device__ __forceinline__ void cvt_rows2(const float* s0, const float* s1, bf16* d0, bf16* d1, int lane) {
    f32x4 v0[N / 256], v1[N / 256];
#pragma unroll
    for (int j = 0; j < N / 256; ++j) { v0[j] = s0 ? *(const f32x4*)(s0 + lane * 4 + 256 * j) : (f32x4){0.f, 0.f, 0.f, 0.f}; v1[j] = s1 ? *(const f32x4*)(s1 + lane * 4 + 256 * j) : (f32x4){0.f, 0.f, 0.f, 0.f}; }
#pragma unroll
    for (int j = 0; j < N / 256; ++j) {
        *(unsigned long long*)(d0 + lane * 4 + 256 * j) = (unsigned long long)pk2(v0[j].x, v0[j].y) | ((unsigned long long)pk2(v0[j].z, v0[j].w) << 32);
        *(unsigned long long*)(d1 + lane * 4 + 256 * j) = (unsigned long long)pk2(v1[j].x, v1[j].y) | ((unsigned long long)pk2(v1[j].z, v1[j].w) << 32); }
}
__device__ __forceinline__ int fresh_lane() { int z = 0; asm volatile("" : "+s"(z)); return (int)__builtin_amdgcn_mbcnt_hi(~0u, __builtin_amdgcn_mbcnt_lo(~0u, (unsigned)z)); }
#define FRESH_TID() (wave_ * 64 + fresh_lane())
template <bool FINAL>
__device__ __forceinline__ void ln_two_rows(int lane, const v4u (&w)[2][4], const float* gg, const float* bb, bf16* x0, bf16* x1, float* of0, float* of1) {
    float v[2][4][8]; float s[2] = {0.f, 0.f};
#pragma unroll
    for (int r = 0; r < 2; ++r)
#pragma unroll
        for (int j = 0; j < 4; ++j) { const v4u q = w[r][j]; v[r][j][0] = pg8::bflo(q.x); v[r][j][1] = pg8::bfhi(q.x); v[r][j][2] = pg8::bflo(q.y); v[r][j][3] = pg8::bfhi(q.y); v[r][j][4] = pg8::bflo(q.z); v[r][j][5] = pg8::bfhi(q.z); v[r][j][6] = pg8::bflo(q.w); v[r][j][7] = pg8::bfhi(q.w);
            s[r] += ((v[r][j][0] + v[r][j][1]) + (v[r][j][2] + v[r][j][3])) + ((v[r][j][4] + v[r][j][5]) + (v[r][j][6] + v[r][j][7])); }
    const float m0 = wave_sum(s[0], lane) * (1.f / D), m1 = wave_sum(s[1], lane) * (1.f / D); float q0 = 0.f, q1 = 0.f;
#pragma unroll
    for (int j = 0; j < 4; ++j)
#pragma unroll
        for (int i = 0; i < 8; ++i) { v[0][j][i] -= m0; q0 += v[0][j][i] * v[0][j][i]; v[1][j][i] -= m1; q1 += v[1][j][i] * v[1][j][i]; }
    const float rs[2] = {1.f / sqrtf(wave_sum(q0, lane) * (1.f / D) + LN_EPS), 1.f / sqrtf(wave_sum(q1, lane) * (1.f / D) + LN_EPS)};
#pragma unroll
    for (int j = 0; j < 4; ++j) { const int e0 = (lane + 64 * j) * 8; const f32x4 g0 = *(const f32x4*)(gg + e0), g1 = *(const f32x4*)(gg + e0 + 4), b0 = *(const f32x4*)(bb + e0), b1 = *(const f32x4*)(bb + e0 + 4);
#pragma unroll
        for (int r = 0; r < 2; ++r) { float o[8];
#pragma unroll
            for (int i = 0; i < 4; ++i) { o[i] = v[r][j][i] * rs[r] * g0[i] + b0[i]; o[4 + i] = v[r][j][4 + i] * rs[r] * g1[i] + b1[i]; }
            if (FINAL) { float* of = r ? of1 : of0; *(f32x4*)(of + e0) = (f32x4){o[0], o[1], o[2], o[3]}; *(f32x4*)(of + e0 + 4) = (f32x4){o[4], o[5], o[6], o[7]}; }
            else { v4u p; p.x = pk2(o[0], o[1]); p.y = pk2(o[2], o[3]); p.z = pk2(o[4], o[5]); p.w = pk2(o[6], o[7]); *(v4u*)((r ? x1 : x0) + e0) = p; } } }
}
template <bool FINAL, class OutF>
__device__ __forceinline__ void ln_rows(int lane, int gw, int NGW, const bf16* YBp, const float* gg, const float* bb, bf16* Xp, OutF outf) {
    const bool has_ex = gw < MR - MP; const int exrow = MP + gw; v4u ex[2][4];
    if (has_ex) {
#pragma unroll
        for (int j = 0; j < 4; ++j) ex[0][j] = ((const v4u*)(YBp + (size_t)exrow * D))[lane + 64 * j]; }
    __builtin_amdgcn_sched_barrier(0);
#pragma unroll 1
    for (int row = 2 * gw; row < MP; row += 2 * NGW) { v4u w[2][4];
#pragma unroll
        for (int j = 0; j < 4; ++j) { w[0][j] = ((const v4u*)(YBp + (size_t)row * D))[lane + 64 * j]; w[1][j] = ((const v4u*)(YBp + (size_t)(row + 1) * D))[lane + 64 * j]; }
        if (FINAL) { float* of = outf(row); ln_two_rows<true>(lane, w, gg, bb, nullptr, nullptr, of, of + D); }
        else ln_two_rows<false>(lane, w, gg, bb, Xp + (size_t)row * D, Xp + (size_t)(row + 1) * D, nullptr, nullptr); }
    if (has_ex) {
#pragma unroll
        for (int j = 0; j < 4; ++j) ex[1][j] = ex[0][j];
        if (FINAL) { float* of = outf(exrow); ln_two_rows<true>(lane, ex, gg, bb, nullptr, nullptr, of, of); }
        else ln_two_rows<false>(lane, ex, gg, bb, Xp + (size_t)exrow * D, Xp + (size_t)exrow * D, nullptr, nullptr); }
}
struct MapId { __device__ __forceinline__ int operator()(int n) const { return n; } };
struct MapInA { __device__ __forceinline__ int operator()(int n) const { return n < 4608 ? n : (n < 5120 ? n + 16 : (n < 5136 ? n - 512 : -1)); } };
struct MapFfn { __device__ __forceinline__ int operator()(int n) const { const int t = n >> 8, r = n & 255; return r < 128 ? 128 * t + r : DFF + 128 * t + (r - 128); } };
template <class Map>
__device__ __forceinline__ void wt_convert(LAS unsigned char* ldsb, int wave, int gw, int NGW, int lane, const float* W, int K, int Nsrc, bf16* WT, int Ndst, Map map) {
    LAS float* scr = (LAS float*)(ldsb + RING_OFF + wave * 16384);
    const int nblk = Ndst / 64, nitems = (K / 64) * nblk, nq = lane & 15, kq = lane >> 4;
    for (int it = gw; it < nitems; it += NGW) {
        const int kb = it / nblk, nb = it % nblk, k0 = 64 * kb, n0 = 64 * nb;
        const int sc0 = map(n0 + 4 * nq), sc3 = map(n0 + 4 * nq + 3);
        const bool contig = sc0 >= 0 && sc3 == sc0 + 3;
        f32x4 v[16];
#pragma unroll
        for (int i = 0; i < 16; ++i) { const int kk = 4 * i + kq;
            if (contig) v[i] = *(const f32x4*)(W + (size_t)(k0 + kk) * Nsrc + sc0);
            else {
#pragma unroll
                for (int e = 0; e < 4; ++e) { const int sc = map(n0 + 4 * nq + e); v[i][e] = sc >= 0 ? W[(size_t)(k0 + kk) * Nsrc + sc] : 0.f; } } }
#pragma unroll
        for (int i = 0; i < 16; ++i) { const int kk = 4 * i + kq;
#pragma unroll
            for (int e = 0; e < 4; ++e) { const int n = 4 * nq + e; scr[n * 64 + (kk ^ n)] = v[i][e]; } }
        LDS_WAIT(); asm volatile("" ::: "memory");
        const int c = lane & 7;
#pragma unroll
        for (int j = 0; j < 8; ++j) { const int n = (lane >> 3) + 8 * j; const LAS float* s = scr + n * 64;
#define SWZ(i) s[(8 * c + (i)) ^ n]
            v4u o; o.x = pk2(SWZ(0), SWZ(1)); o.y = pk2(SWZ(2), SWZ(3)); o.z = pk2(SWZ(4), SWZ(5)); o.w = pk2(SWZ(6), SWZ(7));
#undef SWZ
            *(GAS v4u*)(WT + (size_t)(n0 + n) * K + k0 + 8 * c) = o; }
        LDS_WAIT(); asm volatile("" ::: "memory");
    }
}
__device__ __forceinline__ float softplus_f(float z) { return fmaxf(z, 0.f) + log1pf(__expf(-fabsf(z))); }

typedef short s16x4 __attribute__((ext_vector_type(4)));
typedef pg8::u32x2 u32x2;
typedef float f32x16 __attribute__((ext_vector_type(16)));
typedef __bf16 bf16x2_t __attribute__((ext_vector_type(2)));
typedef float f32x2_t __attribute__((ext_vector_type(2)));
__device__ __forceinline__ unsigned cvt2(float lo, float hi) { const f32x2_t v = {lo, hi}; const bf16x2_t b = __builtin_convertvector(v, bf16x2_t); return __builtin_bit_cast(unsigned, b); }
__device__ __forceinline__ bf16x8 pack8(const f32x4 a, const f32x4 b) { v4u p; p.x = cvt2(a[0], a[1]); p.y = cvt2(a[2], a[3]); p.z = cvt2(b[0], b[1]); p.w = cvt2(b[2], b[3]); return __builtin_bit_cast(bf16x8, p); }
__device__ __forceinline__ bf16x8 ld2x8(const bf16* p0, const bf16* p1) { const s16x4 a = *(const s16x4*)p0, b = *(const s16x4*)p1; return __builtin_shufflevector(a, b, 0, 1, 2, 3, 4, 5, 6, 7); }
__device__ __forceinline__ bf16x8 ld16(const bf16* p) { return *(const bf16x8*)p; }
#define MFMA16(a, b, c) __builtin_amdgcn_mfma_f32_16x16x32_bf16((a), (b), (c), 0, 0, 0)
#define MFMA32(a, b, c) __builtin_amdgcn_mfma_f32_32x32x16_bf16((a), (b), (c), 0, 0, 0)

constexpr int QIMG_LD = 200, KTIMG_LD = 68, PKG_Q = 0, PKG_KT = 25600, PKG_G = 51712, IMG_BYTES = 52480, PKG_K = 52480, PKG_VT = 77056, PKG_BYTES = 126208, N_PKG = 2048 + 32;
static_assert(64 * QIMG_LD * 2 == PKG_KT && PKG_KT + 192 * KTIMG_LD * 2 == PKG_G && PKG_G + 768 == IMG_BYTES && PKG_K + 24576 == PKG_VT && PKG_VT + 49152 == PKG_BYTES && IMG_BYTES % 16 == 0, "package map");

__device__ __forceinline__ float softplus_fast(float z) { return fmaxf(z, 0.f) + __logf(1.0f + __expf(-fabsf(z))); }
constexpr int GL_TOT = 0, GL_Q = 6144, GL_K = GL_Q + 64 * QIMG_LD * 2, GL_V = GL_K + 64 * QIMG_LD * 2, VL_LD = 68, GL_P = GL_V + 384 * VL_LD * 2, P_LD = 68, GL_LRN = GL_P + 64 * P_LD * 2, GL_END = GL_LRN + 2048;
static_assert(GL_END <= RING_BYTES && GL_Q % 16 == 0 && GL_K % 16 == 0 && GL_V % 8 == 0 && GL_P % 8 == 0 && GL_LRN % 16 == 0 && MISC_OFF + 256 + 17 * 192 * 4 <= LDS_BYTES, "gla_prep_intra LDS map");
template <int MODE>
__device__ __forceinline__ void gla_prep_intra(int bid, int G, int tid, int wave, LAS unsigned char* lds, int l, const bf16* PROJ, const float* w_gate_lr, const float* b_gate, unsigned char* PKG, bf16* OINT) {
    const int lane = tid & 63, fr = lane & 15, fq = lane >> 4;
    const float* w2 = w_gate_lr + (size_t)l * 16 * 768; const float* bg = b_gate + (size_t)l * 768;
    LAS float* tot = (LAS float*)(lds + GL_TOT);
    LAS bf16* QL = (LAS bf16*)(lds + GL_Q); LAS bf16* KL = (LAS bf16*)(lds + GL_K); LAS bf16* VL = (LAS bf16*)(lds + GL_V); LAS bf16* P = (LAS bf16*)(lds + GL_P);
    LAS unsigned char* LRN = lds + GL_LRN;
    auto item_of = [&](int j) -> int {
        if (MODE == 1) return j < 8 ? ((((j >> 1) << 2) | (bid & 3)) << 7) | ((bid >> 2) + 64 * (j & 1)) : -1;
        if (MODE == 2) return j == 0 ? 2048 + bid : -1;
        const int it = bid + j * G; return it < N_PKG ? it : -1; };
    auto lr_dma = [&](int item) {
        if (wave < 2) { int row0, T; if (item < 2048) { row0 = ((item >> 7) >> 2) * SEQ + (item & 127) * 64; T = 64; } else { row0 = MP + ((item - 2048) >> 2) * 16; T = 16; }
            const int t = 32 * wave + (lane >> 1); const bf16* prow = PROJ + (size_t)(row0 + (t < T ? t : T - 1)) * NA + CLR + 8 * (lane & 1);
            __builtin_amdgcn_global_load_lds((const unsigned*)prow, (LAS unsigned*)(LRN + wave * 1024), 16, 0, 0); } };
    LAS float* W2L = (LAS float*)(lds + MISC_OFF + 256);
    int cur_h = -1;
    { const int i0 = item_of(0); if (i0 >= 0) lr_dma(i0); asm volatile("s_waitcnt vmcnt(0)" ::: "memory"); __syncthreads(); }
    for (int j = 0;; ++j) {
        const int item = item_of(j); if (item < 0) break;
        int h, row0, T;
        if (item < 2048) { const int bh = item >> 7, ch = item & 127; h = bh & 3; row0 = (bh >> 2) * SEQ + ch * 64; T = 64; }
        else { const int i2 = item - 2048; h = i2 & 3; row0 = MP + (i2 >> 2) * 16; T = 16; }
        unsigned char* pk = PKG + (size_t)item * PKG_BYTES;
        bf16* Qt = (bf16*)(pk + PKG_Q); bf16* KT = (bf16*)(pk + PKG_KT); bf16* VT = (bf16*)(pk + PKG_VT); float* Gp = (float*)(pk + PKG_G);
        if (h != cur_h) {
            if (cur_h >= 0) __syncthreads();
            cur_h = h;
            for (int i = tid; i < 17 * 192; i += 512) { const int r = i / 192, d = i - r * 192; W2L[i] = r < 16 ? w2[r * 768 + h * 192 + d] : bg[h * 192 + d]; }
            __syncthreads(); }
        float w2c[3][16], bgc[3];
#pragma unroll
        for (int c = 0; c < 3; ++c) { bgc[c] = W2L[16 * 192 + lane + 64 * c];
#pragma unroll
            for (int r = 0; r < 16; ++r) w2c[c][r] = W2L[r * 192 + lane + 64 * c]; }
        unsigned qv[8][3], kv[8][3];
#pragma unroll
        for (int tt = 0; tt < 8; ++tt) { const int t = 8 * wave + tt; const bf16* prow = PROJ + (size_t)(row0 + (t < T ? t : T - 1)) * NA + h * 192 + lane;
#pragma unroll
            for (int c = 0; c < 3; ++c) { qv[tt][c] = prow[CQ + 64 * c]; kv[tt][c] = prow[CK + 64 * c]; } }
        __builtin_amdgcn_sched_barrier(0);
        v4u l0[8], l1[8];
#pragma unroll
        for (int tt = 0; tt < 8; ++tt) { const LAS unsigned char* lp = LRN + (8 * wave + tt) * 32; l0[tt] = *(const LAS v4u*)lp; l1[tt] = *(const LAS v4u*)(lp + 16); }
        float lc[8][3]; float run[3] = {0.f, 0.f, 0.f};
#pragma unroll
        for (int tt = 0; tt < 8; ++tt) { const bool ok = 8 * wave + tt < T;
            float lr[16]; lr[0] = pg8::bflo(l0[tt].x); lr[1] = pg8::bfhi(l0[tt].x); lr[2] = pg8::bflo(l0[tt].y); lr[3] = pg8::bfhi(l0[tt].y); lr[4] = pg8::bflo(l0[tt].z); lr[5] = pg8::bfhi(l0[tt].z); lr[6] = pg8::bflo(l0[tt].w); lr[7] = pg8::bfhi(l0[tt].w);
            lr[8] = pg8::bflo(l1[tt].x); lr[9] = pg8::bfhi(l1[tt].x); lr[10] = pg8::bflo(l1[tt].y); lr[11] = pg8::bfhi(l1[tt].y); lr[12] = pg8::bflo(l1[tt].z); lr[13] = pg8::bfhi(l1[tt].z); lr[14] = pg8::bflo(l1[tt].w); lr[15] = pg8::bfhi(l1[tt].w);
#pragma unroll
            for (int c = 0; c < 3; ++c) { float xg = bgc[c];
#pragma unroll
                for (int r = 0; r < 16; ++r) xg += lr[r] * w2c[c][r];
                run[c] += ok ? -softplus_fast(-xg) * (1.0f / 16.0f) : 0.f; lc[tt][c] = run[c]; } }
#pragma unroll
        for (int c = 0; c < 3; ++c) tot[wave * 192 + lane + 64 * c] = run[c];
        __syncthreads();
        unsigned vv[6][8];
#pragma unroll
        for (int tt = 0; tt < 8; ++tt) { const int t = 8 * wave + tt; const bf16* prow = PROJ + (size_t)(row0 + (t < T ? t : T - 1)) * NA + CV + h * 384 + lane;
#pragma unroll
            for (int c2 = 0; c2 < 6; ++c2) vv[c2][tt] = prow[64 * c2]; }
        __builtin_amdgcn_sched_barrier(0);
        float pre[3], all[3];
#pragma unroll
        for (int c = 0; c < 3; ++c) { pre[c] = 0.f; all[c] = 0.f;
#pragma unroll
            for (int w = 0; w < 8; ++w) { const float tv = tot[w * 192 + lane + 64 * c]; all[c] += tv; if (w < wave) pre[c] += tv; } }
        unsigned ktw[3][4];
#pragma unroll
        for (int tt = 0; tt < 8; ++tt) { const int t = 8 * wave + tt; const bool ok = t < T;
#pragma unroll
            for (int c = 0; c < 3; ++c) { const int dl = lane + 64 * c; const float bc = pre[c] + lc[tt][c]; const float eq = __expf(bc), ek = __expf(-bc);
                const unsigned qb = ok ? f2bf(bf2f((bf16)qv[tt][c]) * GLA_QSCALE * eq) : 0u, kb = ok ? f2bf(bf2f((bf16)kv[tt][c]) * ek) : 0u;
                Qt[t * QIMG_LD + dl] = (bf16)qb; QL[t * QIMG_LD + dl] = (bf16)qb; KL[t * QIMG_LD + dl] = (bf16)kb;
                if (tt & 1) ktw[c][tt >> 1] |= kb << 16; else ktw[c][tt >> 1] = kb; } }
#pragma unroll
        for (int c = 0; c < 3; ++c) { bf16* kp = KT + (size_t)(lane + 64 * c) * KTIMG_LD + 8 * wave; u32x2 o0, o1; o0.x = ktw[c][0]; o0.y = ktw[c][1]; o1.x = ktw[c][2]; o1.y = ktw[c][3]; *(u32x2*)kp = o0; *(u32x2*)(kp + 4) = o1; }
        if (wave == 0) {
#pragma unroll
            for (int c = 0; c < 3; ++c) Gp[lane + 64 * c] = __expf(all[c]); }
#pragma unroll
        for (int c2 = 0; c2 < 6; ++c2) { const bool ok0 = 8 * wave < T;
            u32x2 o0, o1; o0.x = ok0 ? vv[c2][0] | (vv[c2][1] << 16) : 0u; o0.y = ok0 ? vv[c2][2] | (vv[c2][3] << 16) : 0u; o1.x = ok0 ? vv[c2][4] | (vv[c2][5] << 16) : 0u; o1.y = ok0 ? vv[c2][6] | (vv[c2][7] << 16) : 0u;
            v4u o; o.x = o0.x; o.y = o0.y; o.z = o1.x; o.w = o1.y; *(v4u*)(VT + (size_t)(lane + 64 * c2) * 64 + 8 * wave) = o;
            LAS bf16* vl = VL + (lane + 64 * c2) * VL_LD + 8 * wave; *(LAS u32x2*)vl = o0; *(LAS u32x2*)(vl + 4) = o1; }
        __syncthreads();
        { const int nx = item_of(j + 1); if (nx >= 0) lr_dma(nx); }
        const int nvalid = T;
        bf16x8 va[3], vb[3];
#pragma unroll
        for (int k = 0; k < 3; ++k) { const LAS bf16* vr = VL + (16 * (3 * wave + k) + fr) * VL_LD + 4 * fq;
            const s16x4 x0 = *(const LAS s16x4*)vr, x1 = *(const LAS s16x4*)(vr + 16), x2 = *(const LAS s16x4*)(vr + 32), x3 = *(const LAS s16x4*)(vr + 48);
            va[k] = __builtin_shufflevector(x0, x1, 0, 1, 2, 3, 4, 5, 6, 7); vb[k] = __builtin_shufflevector(x2, x3, 0, 1, 2, 3, 4, 5, 6, 7); }
#pragma unroll
        for (int rep = 0; rep < 2; ++rep) {
            const int tl = wave + 8 * rep;
            if (tl < 10) {
                const int it = tl < 1 ? 0 : (tl < 3 ? 1 : (tl < 6 ? 2 : 3)), jt = tl - (it * (it + 1)) / 2;
                f32x4 at = {0.f, 0.f, 0.f, 0.f};
                const LAS bf16* qr = QL + (16 * it + fr) * QIMG_LD + 8 * fq; const LAS bf16* kr = KL + (16 * jt + fr) * QIMG_LD + 8 * fq;
#pragma unroll
                for (int s = 0; s < 6; ++s) at = MFMA16(*(const LAS bf16x8*)(kr + 32 * s), *(const LAS bf16x8*)(qr + 32 * s), at);
                if (it == jt) {
#pragma unroll
                    for (int jj = 0; jj < 4; ++jj) if (4 * fq + jj > fr) at[jj] = 0.f; }
                u32x2 w; w.x = cvt2(at[0], at[1]); w.y = cvt2(at[2], at[3]);
                *(LAS u32x2*)(P + (16 * it + fr) * P_LD + 16 * jt + 4 * fq) = w;
            } else if (tl == 10 || tl == 11) {
                const int it = tl == 10 ? 0 : 2, jt = tl == 10 ? 1 : 3; unsigned zz = 0u; asm volatile("" : "+v"(zz)); u32x2 z; z.x = zz; z.y = zz;
                *(LAS u32x2*)(P + (16 * it + fr) * P_LD + 16 * jt + 4 * fq) = z;
            }
        }
        if (wave < 2) asm volatile("s_waitcnt vmcnt(0)" ::: "memory");
        __syncthreads();
#pragma unroll
        for (int it = 0; it < 4; ++it) {
            if (16 * it >= nvalid) break;
            const LAS bf16* pr = P + (16 * it + fr) * P_LD + 4 * fq;
            const s16x4 a0 = *(const LAS s16x4*)pr, a1 = *(const LAS s16x4*)(pr + 16);
            const bf16x8 pf0 = __builtin_shufflevector(a0, a1, 0, 1, 2, 3, 4, 5, 6, 7); bf16x8 pf1 = pf0;
            if (it >= 2) { const s16x4 b0 = *(const LAS s16x4*)(pr + 32), b1 = *(const LAS s16x4*)(pr + 48); pf1 = __builtin_shufflevector(b0, b1, 0, 1, 2, 3, 4, 5, 6, 7); }
#pragma unroll
            for (int k = 0; k < 3; ++k) { f32x4 o = {0.f, 0.f, 0.f, 0.f};
                o = MFMA16(va[k], pf0, o); if (it >= 2) o = MFMA16(vb[k], pf1, o);
                u32x2 ow; ow.x = cvt2(o[0], o[1]); ow.y = cvt2(o[2], o[3]); *(u32x2*)(OINT + (size_t)(row0 + 16 * it + fr) * 1536 + h * 384 + 16 * (3 * wave + k) + 4 * fq) = ow; }
        }
    }
}

__device__ __forceinline__ f32x4 ld_o4(const bf16* p) { const u32x2 w = *(const u32x2*)p; return (f32x4){pg8::bflo(w.x), pg8::bfhi(w.x), pg8::bflo(w.y), pg8::bfhi(w.y)}; }
template <int PASS>
__device__ __forceinline__ void gla_chain(int wc, int tid, int wave, LAS unsigned char* lds, int l, const unsigned char* PKG, const float* state_gla, bf16* OINT, float* out, float* SLOC, float* GSEG, bool dry = false) {
    const int lane = tid & 63, fr = lane & 15, fq = lane >> 4;
    int h, vb, bh, seg, item0, nsteps, row0, nvalid; const float* s0 = nullptr; float* sout = nullptr;
    if (PASS == 1) { bh = wc / 9; const int rem = wc % 9; vb = rem / 3; seg = rem % 3; h = bh & 3; item0 = bh * 128 + 32 * seg; nsteps = 32; row0 = 0; nvalid = 64; }
    else if (wc < 192) { bh = wc / 12; const int rem = wc % 12; vb = rem >> 2; seg = rem & 3; h = bh & 3; item0 = bh * 128 + 32 * seg; nsteps = 32; row0 = (bh >> 2) * SEQ + 2048 * seg; nvalid = 64;
        if (seg == 3) sout = out + O_GSP + (size_t)(l * 16 + bh) * 192 * 384; }
    else { const int c2 = wc - 192; bh = c2 / 3; vb = c2 % 3; seg = 0; h = bh & 3; item0 = 2048 + bh; nsteps = 1; row0 = MP + (bh >> 2) * 16; nvalid = 16; s0 = state_gla + (size_t)(l * 32 + bh) * 192 * 384; sout = out + O_GSS + (size_t)(l * 32 + bh) * 192 * 384; }
    const int v0 = vb * 128 + wave * 16;
#define GLA_WALK(p, step) do { (p) += (step); asm volatile("" : "+v"(p)); } while (0)
    f32x4 S[12];
    if (s0) { const float* p = s0 + (size_t)(4 * fq) * 384 + v0 + fr;
#pragma unroll
        for (int t = 0; t < 12; ++t) {
#pragma unroll
            for (int jj = 0; jj < 4; ++jj) { S[t][jj] = *p; GLA_WALK(p, 384); }
            GLA_WALK(p, 12 * 384); } }
    else {
#pragma unroll
        for (int t = 0; t < 12; ++t) S[t] = (f32x4){0.f, 0.f, 0.f, 0.f}; }
    if (PASS == 2 && wc < 192) {
        for (int j = 0; j < seg; ++j) { const float* gs = GSEG + (size_t)(bh * 3 + j) * 192 + 4 * fq; const float* p = SLOC + (size_t)((bh * 3 + vb) * 3 + j) * 192 * 128 + (size_t)(4 * fq) * 128 + wave * 16 + fr;
#pragma unroll
            for (int t = 0; t < 12; ++t) { const f32x4 g4 = *(const f32x4*)(gs + 16 * t);
#pragma unroll
                for (int jj = 0; jj < 4; ++jj) { S[t][jj] = g4[jj] * S[t][jj] + *p; GLA_WALK(p, 128); }
                GLA_WALK(p, 12 * 128); } }
    }
    f32x4 GP[PASS == 1 ? 12 : 1];
    if (PASS == 1) {
#pragma unroll
        for (int t = 0; t < 12; ++t) GP[t] = (f32x4){1.f, 1.f, 1.f, 1.f}; }
    constexpr int CH0 = PASS == 1 ? PKG_KT / 16 : 0, NCH = IMG_BYTES / 16, NLD = PASS == 1 ? 4 : 7;
    v4u pre[NLD]; bf16x8 vt[2], vtn[2]; f32x4 oin[4];
    { const unsigned char* pk = PKG + (size_t)item0 * PKG_BYTES;
      if (PASS == 2) {
#pragma unroll
        for (int it = 0; it < 4; ++it) { const int tl = 16 * it + fr; oin[it] = tl < nvalid ? ld_o4(OINT + (size_t)(row0 + tl) * 1536 + h * 384 + v0 + 4 * fq) : (f32x4){0.f, 0.f, 0.f, 0.f}; } }
#pragma unroll
      for (int k = 0; k < NLD; ++k) { const int ch = CH0 + tid + 512 * k; if (ch < NCH) pre[k] = *(const v4u*)(pk + (size_t)ch * 16); }
      const bf16* VT = (const bf16*)(pk + PKG_VT) + (size_t)(v0 + fr) * 64 + 4 * fq; vt[0] = ld2x8(VT, VT + 16); vt[1] = ld2x8(VT + 32, VT + 48);
#pragma unroll
      for (int k = 0; k < NLD; ++k) { const int ch = CH0 + tid + 512 * k; if (ch < NCH) *(LAS v4u*)(lds + (size_t)ch * 16) = pre[k]; }
      vtn[0] = vt[0]; vtn[1] = vt[1]; }
    __syncthreads();
    for (int n = 0; n < nsteps; ++n) {
        const LAS unsigned char* img = lds + (n & 1) * IMG_BYTES;
        const bool more = n + 1 < nsteps;
        if (more) { const unsigned char* pk = PKG + (size_t)(item0 + n + 1) * PKG_BYTES;
#pragma unroll
            for (int k = 0; k < NLD; ++k) { const int ch = CH0 + tid + 512 * k; if (ch < NCH) pre[k] = *(const v4u*)(pk + (size_t)ch * 16); }
            const bf16* VT = (const bf16*)(pk + PKG_VT) + (size_t)(v0 + fr) * 64 + 4 * fq; vtn[0] = ld2x8(VT, VT + 16); vtn[1] = ld2x8(VT + 32, VT + 48); }
        if (PASS == 2) {
            bf16x8 Sb[6];
#pragma unroll
            for (int s = 0; s < 6; ++s) Sb[s] = pack8(S[2 * s], S[2 * s + 1]);
#pragma unroll
            for (int it = 0; it < 4; ++it) {
                const LAS bf16* qr = (const LAS bf16*)(img + PKG_Q) + (16 * it + fr) * QIMG_LD + 4 * fq;
                f32x4 o = oin[it];
#pragma unroll
                for (int s = 0; s < 6; ++s) { const s16x4 a = *(const LAS s16x4*)(qr + 32 * s), b = *(const LAS s16x4*)(qr + 32 * s + 16);
                    o = MFMA16(Sb[s], __builtin_shufflevector(a, b, 0, 1, 2, 3, 4, 5, 6, 7), o); }
                const int tl = 16 * it + fr;
                if (tl < nvalid && !dry) { u32x2 ow; ow.x = cvt2(o[0], o[1]); ow.y = cvt2(o[2], o[3]); *(u32x2*)(OINT + (size_t)(row0 + 64 * n + tl) * 1536 + h * 384 + v0 + 4 * fq) = ow; }
                __builtin_amdgcn_sched_barrier(0);
            }
            if (more) {
#pragma unroll
                for (int it = 0; it < 4; ++it) oin[it] = ld_o4(OINT + (size_t)(row0 + 64 * (n + 1) + 16 * it + fr) * 1536 + h * 384 + v0 + 4 * fq); }
        }
#pragma unroll
        for (int t = 0; t < 12; ++t) { const LAS bf16* kr = (const LAS bf16*)(img + PKG_KT) + (16 * t + fr) * KTIMG_LD + 4 * fq;
#pragma unroll
            for (int s2 = 0; s2 < 2; ++s2) { const s16x4 a = *(const LAS s16x4*)(kr + 32 * s2), b = *(const LAS s16x4*)(kr + 32 * s2 + 16);
                S[t] = MFMA16(__builtin_shufflevector(a, b, 0, 1, 2, 3, 4, 5, 6, 7), vt[s2], S[t]); }
            const f32x4 g4 = *(const LAS f32x4*)(img + PKG_G + (16 * t + 4 * fq) * 4);
            S[t] = S[t] * g4; if (PASS == 1) GP[t] = GP[t] * g4; if ((t & 3) == 3) __builtin_amdgcn_sched_barrier(0); }
        if (more) { LAS unsigned char* nimg = lds + ((n + 1) & 1) * IMG_BYTES;
#pragma unroll
            for (int k = 0; k < NLD; ++k) { const int ch = CH0 + tid + 512 * k; if (ch < NCH) *(LAS v4u*)(nimg + (size_t)ch * 16) = pre[k]; }
            vt[0] = vtn[0]; vt[1] = vtn[1]; }
        asm volatile("s_waitcnt lgkmcnt(0)" ::: "memory"); __builtin_amdgcn_s_barrier(); asm volatile("" ::: "memory");
    }
    if (PASS == 1) {
        float* p = SLOC + (size_t)((bh * 3 + vb) * 3 + seg) * 192 * 128 + (size_t)(4 * fq) * 128 + wave * 16 + fr;
#pragma unroll
        for (int t = 0; t < 12; ++t) {
#pragma unroll
            for (int jj = 0; jj < 4; ++jj) { *p = S[t][jj]; GLA_WALK(p, 128); }
            GLA_WALK(p, 12 * 128); }
        if (vb == 0 && wave == 0 && fr == 0) { float* gs = GSEG + (size_t)(bh * 3 + seg) * 192;
#pragma unroll
            for (int t = 0; t < 12; ++t) *(f32x4*)(gs + 16 * t + 4 * fq) = GP[t]; }
    } else if (sout) {
        float* p = sout + (size_t)(4 * fq) * 384 + v0 + fr;
#pragma unroll
        for (int t = 0; t < 12; ++t) {
#pragma unroll
            for (int jj = 0; jj < 4; ++jj) { *p = S[t][jj]; GLA_WALK(p, 384); }
            GLA_WALK(p, 12 * 384); }
    }
#undef GLA_WALK
}

__device__ __forceinline__ void mem_attn(int item, int lane, int l, const bf16* PROJ, int ldp, int cqm, const bf16* MEMK, const bf16* MEMVT, bf16* OCAT) {
    const int fr = lane & 15, fq = lane >> 4, tile = item >> 2, h = item & 3, r0 = tile * 16;
    const int bb = r0 < MP ? r0 / SEQ : 4 + ((r0 - MP) >> 4);
    const bf16* Kb = MEMK + (size_t)((l * 12 + bb) * 256) * 512 + h * 128; const bf16* Vt = MEMVT + (size_t)(((l * 12 + bb) * 4 + h) * 128) * 256;
    bf16x8 qf[4];
#pragma unroll
    for (int s = 0; s < 4; ++s) qf[s] = ld16(PROJ + (size_t)(r0 + fr) * ldp + cqm + h * 128 + 32 * s + 8 * fq);
    f32x4 st[16];
#pragma unroll
    for (int mt = 0; mt < 16; ++mt) { st[mt] = (f32x4){0.f, 0.f, 0.f, 0.f}; const bf16* kr = Kb + (size_t)(16 * mt + fr) * 512 + 8 * fq;
#pragma unroll
        for (int s = 0; s < 4; ++s) st[mt] = MFMA16(ld16(kr + 32 * s), qf[s], st[mt]); }
    float mx = -3.0e38f;
#pragma unroll
    for (int mt = 0; mt < 16; ++mt) mx = fmaxf(mx, fmaxf(fmaxf(st[mt][0], st[mt][1]), fmaxf(st[mt][2], st[mt][3])));
    mx = fmaxf(mx, shx(mx, lane, 16)); mx = fmaxf(mx, shx(mx, lane, 32));
    float sum = 0.f;
#pragma unroll
    for (int mt = 0; mt < 16; ++mt)
#pragma unroll
        for (int jj = 0; jj < 4; ++jj) { const float p = __expf((st[mt][jj] - mx) * HD_SCALE); st[mt][jj] = p; sum += p; }
    sum += shx(sum, lane, 16); sum += shx(sum, lane, 32);
    const float inv = 1.0f / sum;
    bf16x8 pf[8];
#pragma unroll
    for (int s = 0; s < 8; ++s) pf[s] = pack8(st[2 * s], st[2 * s + 1]);
#pragma unroll
    for (int dt = 0; dt < 8; ++dt) { f32x4 o = {0.f, 0.f, 0.f, 0.f}; const bf16* vr = Vt + (size_t)(16 * dt + fr) * 256 + 4 * fq;
#pragma unroll
        for (int s = 0; s < 8; ++s) o = MFMA16(ld2x8(vr + 32 * s, vr + 32 * s + 16), pf[s], o);
        u32x2 w; w.x = cvt2(o[0] * inv, o[1] * inv); w.y = cvt2(o[2] * inv, o[3] * inv);
        *(u32x2*)(OCAT + (size_t)(r0 + fr) * D + 1536 + h * 128 + 16 * dt + 4 * fq) = w; }
}

__device__ __forceinline__ void mem_attn_wg(int wi, int tid, int wave, LAS unsigned char* lds, int l, const bf16* PROJ, int ldp, int cqm, const bf16* MEMK, const bf16* MEMVT, bf16* OCAT) {
    const bool smp = wi >= 256; const int lane = tid & 63, fr = lane & 15, fq = lane >> 4, bh = smp ? (wi - 256) : (wi >> 4), sub = wi & 15, b = smp ? 4 + (bh >> 2) : (bh >> 2), h = bh & 3;
    const bf16* Kb = MEMK + (size_t)((l * 12 + b) * 256) * 512 + h * 128; const bf16* Vt = MEMVT + (size_t)(((l * 12 + b) * 4 + h) * 128) * 256;
#pragma unroll
    for (int k = 0; k < 8; ++k) { const int idx = tid + 512 * k, row = idx >> 4, c = idx & 15; *(LAS v4u*)(lds + row * 256 + ((c ^ (row & 15)) << 4)) = *(const v4u*)(Kb + (size_t)row * 512 + c * 8); }
#pragma unroll
    for (int k = 0; k < 8; ++k) { const int idx = tid + 512 * k, row = idx >> 5, c = idx & 31; *(LAS v4u*)(lds + 65536 + row * 512 + ((c ^ (2 * (row & 15))) << 4)) = *(const v4u*)(Vt + (size_t)row * 256 + c * 8); }
    __syncthreads();
    unsigned koff[4], voff[16];
#pragma unroll
    for (int s2 = 0; s2 < 4; ++s2) { koff[s2] = (unsigned)(fr * 256 + (((4 * s2 + fq) ^ fr) << 4)); asm volatile("" : "+v"(koff[s2])); }
#pragma unroll
    for (int s2 = 0; s2 < 8; ++s2) { const int p0 = 8 * s2 + fq, p1 = p0 + 4;
        voff[2 * s2] = (unsigned)(65536 + fr * 512 + ((((p0 >> 1) ^ (2 * fr)) << 4) | ((p0 & 1) << 3))); voff[2 * s2 + 1] = (unsigned)(65536 + fr * 512 + ((((p1 >> 1) ^ (2 * fr)) << 4) | ((p1 & 1) << 3)));
        asm volatile("" : "+v"(voff[2 * s2]), "+v"(voff[2 * s2 + 1])); }
    const int nblk = smp ? (wave == 0 ? 1 : 0) : 4;
#pragma unroll 1
    for (int blk = 0; blk < nblk; ++blk) {
        const int r0 = smp ? MP + (b - 4) * 16 : b * SEQ + sub * 512 + blk * 128 + wave * 16;
        bf16x8 qf[4];
#pragma unroll
        for (int s = 0; s < 4; ++s) qf[s] = ld16(PROJ + (size_t)(r0 + fr) * ldp + cqm + h * 128 + 32 * s + 8 * fq);
        f32x4 st[16];
#pragma unroll
        for (int mt = 0; mt < 16; ++mt) { st[mt] = (f32x4){0.f, 0.f, 0.f, 0.f};
#pragma unroll
            for (int s = 0; s < 4; ++s) st[mt] = MFMA16(*(const LAS bf16x8*)(lds + koff[s] + mt * 4096), qf[s], st[mt]);
            if ((mt & 3) == 3) __builtin_amdgcn_sched_barrier(0); }
        float mx = -3.0e38f;
#pragma unroll
        for (int mt = 0; mt < 16; ++mt) mx = fmaxf(mx, fmaxf(fmaxf(st[mt][0], st[mt][1]), fmaxf(st[mt][2], st[mt][3])));
        mx = fmaxf(mx, shx(mx, lane, 16)); mx = fmaxf(mx, shx(mx, lane, 32));
        float sum = 0.f;
#pragma unroll
        for (int mt = 0; mt < 16; ++mt)
#pragma unroll
            for (int jj = 0; jj < 4; ++jj) { const float p = __expf((st[mt][jj] - mx) * HD_SCALE); st[mt][jj] = p; sum += p; }
        sum += shx(sum, lane, 16); sum += shx(sum, lane, 32);
        const float inv = 1.0f / sum;
        bf16x8 pf[8];
#pragma unroll
        for (int s = 0; s < 8; ++s) pf[s] = pack8(st[2 * s], st[2 * s + 1]);
#pragma unroll
        for (int dt = 0; dt < 8; ++dt) { f32x4 o = {0.f, 0.f, 0.f, 0.f};
#pragma unroll
            for (int s = 0; s < 8; ++s) { const s16x4 a = *(const LAS s16x4*)(lds + voff[2 * s] + dt * 8192), bb = *(const LAS s16x4*)(lds + voff[2 * s + 1] + dt * 8192);
                o = MFMA16(__builtin_shufflevector(a, bb, 0, 1, 2, 3, 4, 5, 6, 7), pf[s], o); }
            u32x2 w; w.x = cvt2(o[0] * inv, o[1] * inv); w.y = cvt2(o[2] * inv, o[3] * inv);
            *(u32x2*)(OCAT + (size_t)(r0 + fr) * D + 1536 + h * 128 + 16 * dt + 4 * fq) = w;
            if (dt & 1) __builtin_amdgcn_sched_barrier(0); }
    }
    __syncthreads();
}

template <int MODE = 0>
__device__ __forceinline__ void sb_attn(int lane, LAS unsigned char* wlds, const bf16* Kp, int ldk, const bf16* VTp, int ldvt, const bf16* Qp, int ldq, bf16* Op, int t0, int nq) {
    const int r = lane & 31, hh = lane >> 5;
    LAS bf16x8* qs = (LAS bf16x8*)wlds + lane;
#pragma unroll
    for (int ks = 0; ks < 8; ++ks) qs[64 * ks] = ld16(Qp + (size_t)r * ldq + 16 * ks + 8 * hh);
    f32x16 oacc[4];
#pragma unroll
    for (int dt = 0; dt < 4; ++dt)
#pragma unroll
        for (int i = 0; i < 16; ++i) oacc[dt][i] = 0.f;
    float carry = 1.f;
    bf16x8 kf[8];
    { const bf16* kr = Kp + (size_t)(t0 + r) * ldk + 8 * hh;
#pragma unroll
      for (int ks = 0; ks < 8; ++ks) kf[ks] = ld16(kr + 16 * ks); }
    for (int s0 = t0; s0 >= 0; s0 -= 32) {
        bf16x8 vf[8];
#pragma unroll
        for (int k2 = 0; k2 < 2; ++k2)
#pragma unroll
            for (int dt = 0; dt < 4; ++dt) vf[4 * k2 + dt] = MODE == 3 ? qs[64 * dt] : ld16(VTp + (size_t)(s0 >> 5) * 4096 + ((dt * 2 + k2) * 64 + lane) * 8);
        f32x16 st;
#pragma unroll
        for (int i = 0; i < 16; ++i) st[i] = 0.f;
#pragma unroll
        for (int ks = 0; ks < 8; ++ks) st = MFMA32(kf[ks], qs[64 * ks], st);
        { const int sn = s0 >= 32 ? s0 - 32 : 0; const bf16* kr = Kp + (size_t)(sn + r) * ldk + 8 * hh;
#pragma unroll
          for (int ks = 0; ks < 8; ++ks) kf[ks] = ld16(kr + 16 * ks); }
        const bool diag = (s0 == t0);
        float lb[16], om[16];
#pragma unroll
        for (int i = 0; i < 16; ++i) { const float z = st[i] * HD_SCALE, e = __expf(-fabsf(z)), rr = __builtin_amdgcn_rcpf(1.0f + e), er = e * rr;
            lb[i] = z >= 0.f ? rr : er; om[i] = z >= 0.f ? er : rr;
            if (diag && !(((i & 3) + 8 * (i >> 2) + 4 * hh) < r)) { lb[i] = 0.f; om[i] = 1.f; } }
        float g[4], pgv[4];
#pragma unroll
        for (int m = 0; m < 4; ++m) { g[m] = (om[4 * m] * om[4 * m + 1]) * (om[4 * m + 2] * om[4 * m + 3]); pgv[m] = shx(g[m], lane, 32); }
        float R[4]; R[3] = 1.f; R[2] = g[3] * pgv[3]; R[1] = R[2] * (g[2] * pgv[2]); R[0] = R[1] * (g[1] * pgv[1]);
        const float total = R[0] * (g[0] * pgv[0]);
#pragma unroll
        for (int m = 0; m < 4; ++m) { const float suf = carry * R[m] * (hh == 0 ? pgv[m] : 1.f);
            const float t3 = suf, t2 = t3 * om[4 * m + 3], t1 = t2 * om[4 * m + 2], t0_ = t1 * om[4 * m + 1];
            lb[4 * m + 3] *= t3; lb[4 * m + 2] *= t2; lb[4 * m + 1] *= t1; lb[4 * m] *= t0_; }
        carry *= total;
#pragma unroll
        for (int k2 = 0; k2 < 2; ++k2) {
            v4u p; p.x = cvt2(lb[8 * k2], lb[8 * k2 + 1]); p.y = cvt2(lb[8 * k2 + 2], lb[8 * k2 + 3]); p.z = cvt2(lb[8 * k2 + 4], lb[8 * k2 + 5]); p.w = cvt2(lb[8 * k2 + 6], lb[8 * k2 + 7]);
            const bf16x8 wf = __builtin_bit_cast(bf16x8, p);
#pragma unroll
            for (int dt = 0; dt < 4; ++dt) { if (MODE != 3) oacc[dt] = MFMA32(vf[4 * k2 + dt], wf, oacc[dt]); else oacc[dt][0] += __builtin_bit_cast(float, (int)wf[0]) + __builtin_bit_cast(float, (int)vf[4 * k2 + dt][0]); }
        }
        if (MODE == 2 || __all((r >= nq) || (carry < 1.0e-37f))) break;
    }
    if (MODE != 0) { float sdry = 0.f;
#pragma unroll
        for (int dt = 0; dt < 4; ++dt)
#pragma unroll
            for (int i = 0; i < 16; ++i) sdry += oacc[dt][i];
        if (sdry == 1.2345e33f) Op[0] = 0; }
    else if (r < nq) {
#pragma unroll
        for (int dt = 0; dt < 4; ++dt)
#pragma unroll
            for (int g4 = 0; g4 < 4; ++g4) { u32x2 wv; wv.x = cvt2(oacc[dt][4 * g4], oacc[dt][4 * g4 + 1]); wv.y = cvt2(oacc[dt][4 * g4 + 2], oacc[dt][4 * g4 + 3]);
                *(u32x2*)(Op + (size_t)r * D + 32 * dt + 8 * g4 + 4 * hh) = wv; }
    }
    asm volatile("s_waitcnt lgkmcnt(0)" ::: "memory");
}

struct SkBf16 { bf16* O; int ldc;
    __device__ __forceinline__ int brow(int unit, int nb) const { return 32 * unit + 16 * nb; }
    __device__ __forceinline__ void store(int unit, const f32x4 a0, const f32x4 a1, int m, int fq) const { bf16* p = O + (size_t)(MP + m) * ldc + 32 * unit + 4 * fq;
        u32x2 w; w.x = cvt2(a0[0], a0[1]); w.y = cvt2(a0[2], a0[3]); *(u32x2*)p = w; w.x = cvt2(a1[0], a1[1]); w.y = cvt2(a1[2], a1[3]); *(u32x2*)(p + 16) = w; } };
struct SkRes { bf16* Yp; const bf16* Xp; float alpha;
    __device__ __forceinline__ int brow(int unit, int nb) const { return 32 * unit + 16 * nb; }
    __device__ __forceinline__ void one(size_t o, const f32x4 a) const { const u32x2 xv = *(const u32x2*)(Xp + o);
        f32x4 r; r[0] = alpha * pg8::bflo(xv.x); r[1] = alpha * pg8::bfhi(xv.x); r[2] = alpha * pg8::bflo(xv.y); r[3] = alpha * pg8::bfhi(xv.y); r = r + a; u32x2 w; w.x = cvt2(r[0], r[1]); w.y = cvt2(r[2], r[3]); *(u32x2*)(Yp + o) = w; }
    __device__ __forceinline__ void store(int unit, const f32x4 a0, const f32x4 a1, int m, int fq) const { const size_t o = (size_t)(MP + m) * D + 32 * unit + 4 * fq; one(o, a0); one(o + 16, a1); } };
struct SkKV { float *oks, *ovs; bf16 *ksb, *vsb;
    __device__ __forceinline__ int brow(int unit, int nb) const { return 32 * unit + 16 * nb; }
    __device__ __forceinline__ void one(int col, const f32x4 a, int m) const { const bool isv = col >= 1536; const int c = col - (isv ? 1536 : 0), b = m >> 4, t = m & 15;
        *(f32x4*)((isv ? ovs : oks) + (size_t)m * 1536 + c) = a; const unsigned w0 = cvt2(a[0], a[1]), w1 = cvt2(a[2], a[3]);
        const int hh_ = c >> 7, dd = c & 127;
        if (!isv) { u32x2 w; w.x = w0; w.y = w1; *(u32x2*)(ksb + ((size_t)(b * 12 + hh_) * 2080 + 2048 + t) * 128 + dd) = w; }
        else { bf16* vt = vsb + ((size_t)(b * 12 + hh_) * 65 + 64) * 4096 + pg8::vtf_d(dd) + pg8::vtf_k(t); vt[0] = (bf16)w0; vt[8] = (bf16)(w0 >> 16); vt[16] = (bf16)w1; vt[24] = (bf16)(w1 >> 16); } }
    __device__ __forceinline__ void store(int unit, const f32x4 a0, const f32x4 a1, int m, int fq) const { one(32 * unit + 4 * fq, a0, m); one(32 * unit + 16 + 4 * fq, a1, m); } };
struct SkSwiGLU { bf16* Hb;
    __device__ __forceinline__ int brow(int unit, int nb) const { const int c0 = 16 * unit; return (c0 >> 7) * 256 + (c0 & 127) + 128 * nb; }
    __device__ __forceinline__ void store(int unit, const f32x4 g, const f32x4 u, int m, int fq) const { float hv[4];
#pragma unroll
        for (int j = 0; j < 4; ++j) hv[j] = g[j] * __builtin_amdgcn_rcpf(1.0f + __expf(-g[j])) * u[j];
        u32x2 w; w.x = cvt2(hv[0], hv[1]); w.y = cvt2(hv[2], hv[3]); *(u32x2*)(Hb + (size_t)(MP + m) * DFF + 16 * unit + 4 * fq) = w; } };
template <class Epi>
__device__ __forceinline__ void skinny_gemm(int bid, int G, int tid, int wave, LAS unsigned char* lds, const bf16* A, int lda, const bf16* Bt, int K, int nunits, const Epi& E) {
    const int lane = tid & 63, fr = lane & 15, fq = lane >> 4, kw = K >> 3, nst = kw >> 5;
    LAS f32x4* red = (LAS f32x4*)lds;
    if (nst == 8 && (G & 3) == 0) {
        const int rg = bid & 3;
        bf16x8 af[8][2], bw[8][2];
        if (bid < 4 * nunits) { const bf16* ap = A + (size_t)(32 * rg + fr) * lda + wave * kw + 8 * fq;
#pragma unroll
            for (int st = 0; st < 8; ++st) { af[st][0] = ld16(ap + 32 * st); af[st][1] = ld16(ap + (size_t)16 * lda + 32 * st); } }
#pragma unroll 1
        for (int item = bid; item < 4 * nunits; item += G) {
            const int unit = item >> 2;
            const bf16* bp0 = Bt + (size_t)(E.brow(unit, 0) + fr) * K + wave * kw + 8 * fq; const bf16* bp1 = Bt + (size_t)(E.brow(unit, 1) + fr) * K + wave * kw + 8 * fq;
#pragma unroll
            for (int st = 0; st < 8; ++st) { bw[st][0] = ld16(bp0 + 32 * st); bw[st][1] = ld16(bp1 + 32 * st); }
            __builtin_amdgcn_sched_barrier(0);
            f32x4 acc[2][2];
#pragma unroll
            for (int nb = 0; nb < 2; ++nb)
#pragma unroll
                for (int rt = 0; rt < 2; ++rt) acc[nb][rt] = (f32x4){0.f, 0.f, 0.f, 0.f};
#pragma unroll
            for (int st = 0; st < 8; ++st)
#pragma unroll
                for (int rt = 0; rt < 2; ++rt) { acc[0][rt] = MFMA16(bw[st][0], af[st][rt], acc[0][rt]); acc[1][rt] = MFMA16(bw[st][1], af[st][rt], acc[1][rt]); }
#pragma unroll
            for (int nb = 0; nb < 2; ++nb)
#pragma unroll
                for (int rt = 0; rt < 2; ++rt) red[((wave * 2 + nb) * 2 + rt) * 64 + lane] = acc[nb][rt];
            __syncthreads();
            if (wave < 2) {
                f32x4 s0 = {0.f, 0.f, 0.f, 0.f}, s1 = {0.f, 0.f, 0.f, 0.f};
#pragma unroll
                for (int ws = 0; ws < 8; ++ws) { s0 = s0 + red[((ws * 2 + 0) * 2 + wave) * 64 + lane]; s1 = s1 + red[((ws * 2 + 1) * 2 + wave) * 64 + lane]; }
                E.store(unit, s0, s1, 32 * rg + 16 * wave + fr, fq);
            }
            __syncthreads();
        }
        return;
    }
    for (int item = bid; item < 4 * nunits; item += G) {
        const int unit = item >> 2, rg = item & 3;
        const bf16* ap = A + (size_t)(32 * rg + fr) * lda + wave * kw + 8 * fq;
        const bf16* bp0 = Bt + (size_t)(E.brow(unit, 0) + fr) * K + wave * kw + 8 * fq; const bf16* bp1 = Bt + (size_t)(E.brow(unit, 1) + fr) * K + wave * kw + 8 * fq;
        f32x4 acc[2][2];
#pragma unroll
        for (int nb = 0; nb < 2; ++nb)
#pragma unroll
            for (int rt = 0; rt < 2; ++rt) acc[nb][rt] = (f32x4){0.f, 0.f, 0.f, 0.f};
        bf16x8 a0[4][2], b0[4][2], a1[4][2], b1[4][2];
#define SK_LOAD(af, bfr, g) do { _Pragma("unroll") for (int q = 0; q < 4; ++q) { const int st = 4 * (g) + q; if (st < nst) { \
            af[q][0] = ld16(ap + 32 * st); af[q][1] = ld16(ap + (size_t)16 * lda + 32 * st); bfr[q][0] = ld16(bp0 + 32 * st); bfr[q][1] = ld16(bp1 + 32 * st); } } } while (0)
#define SK_MMA(af, bfr, g) do { _Pragma("unroll") for (int q = 0; q < 4; ++q) { if (4 * (g) + q < nst) { _Pragma("unroll") for (int rt = 0; rt < 2; ++rt) { \
            acc[0][rt] = MFMA16(bfr[q][0], af[q][rt], acc[0][rt]); acc[1][rt] = MFMA16(bfr[q][1], af[q][rt], acc[1][rt]); } } } } while (0)
        const int ng = (nst + 3) >> 2;
        SK_LOAD(a0, b0, 0);
#pragma unroll 1
        for (int g = 0; g < ng; g += 2) {
            if (g + 1 < ng) SK_LOAD(a1, b1, g + 1);
            __builtin_amdgcn_sched_barrier(0);
            SK_MMA(a0, b0, g);
            __builtin_amdgcn_sched_barrier(0);
            if (g + 2 < ng) SK_LOAD(a0, b0, g + 2);
            __builtin_amdgcn_sched_barrier(0);
            if (g + 1 < ng) SK_MMA(a1, b1, g + 1);
            __builtin_amdgcn_sched_barrier(0);
        }
#undef SK_LOAD
#undef SK_MMA
#pragma unroll
        for (int nb = 0; nb < 2; ++nb)
#pragma unroll
            for (int rt = 0; rt < 2; ++rt) red[((wave * 2 + nb) * 2 + rt) * 64 + lane] = acc[nb][rt];
        __syncthreads();
        if (wave < 2) {
            f32x4 s0 = {0.f, 0.f, 0.f, 0.f}, s1 = {0.f, 0.f, 0.f, 0.f};
#pragma unroll
            for (int ws = 0; ws < 8; ++ws) { s0 = s0 + red[((ws * 2 + 0) * 2 + wave) * 64 + lane]; s1 = s1 + red[((ws * 2 + 1) * 2 + wave) * 64 + lane]; }
            E.store(unit, s0, s1, 32 * rg + 16 * wave + fr, fq);
        }
        __syncthreads();
    }
}
#ifndef PH_MASK
#define PH_MASK 0xFFFF
#endif
__global__ void __launch_bounds__(NWAVES * 64, 2) mega(Args args) {
    extern __shared__ __attribute__((aligned(16))) unsigned char lds[];
    Frame F;
    F.lds = (LAS unsigned char*)lds; F.MISC = (volatile LAS unsigned*)(F.lds + MISC_OFF);
    F.tid = threadIdx.x; F.lane = F.tid & 63; F.wave = __builtin_amdgcn_readfirstlane(F.tid >> 6);
    F.G = gridDim.x; F.gw = blockIdx.x * NWAVES + F.wave; F.NGW = F.G * NWAVES;
    F.ctl = (gu32*)(args.ws_ + WS_CTL);
    for (int u = F.tid; u < (LDS_BYTES - LDSCTL_OFF) / 4; u += NWAVES * 64) ((LAS unsigned*)(F.lds + LDSCTL_OFF))[u] = 0u;
    __syncthreads();
    XcdBarrier bar = xcd_barrier_post((unsigned*)(F.ctl + CW_BAR), F.MISC + 8);
    const int lo = args.ph_lo, hi = args.ph_hi; int ph = 0;
#define KARGS ((const __attribute__((address_space(4))) Args*)__builtin_amdgcn_kernarg_segment_ptr())
#define ws (ka->ws_)
#define out (ka->out_)
#define x_prompt (ka->in[0])
#define x_sample (ka->in[1])
#define mem_prompt (ka->in[2])
#define state_gla (ka->in[3])
#define cache_sb_k (ka->in[4])
#define cache_sb_v (ka->in[5])
#define cache_mem_k (ka->in[6])
#define cache_mem_v (ka->in[7])
#define w_in_a (ka->in[8])
#define w_gate_lr (ka->in[9])
#define b_gate (ka->in[10])
#define gla_norm_g (ka->in[11])
#define w_in_b (ka->in[12])
#define w_kv_shared (ka->in[13])
#define w_mem_kv (ka->in[14])
#define w_o (ka->in[15])
#define ln1_g (ka->in[16])
#define ln1_b (ka->in[17])
#define ln2_g (ka->in[18])
#define ln2_b (ka->in[19])
#define w_ffn_in (ka->in[20])
#define w_ffn_out (ka->in[21])
#define WIN ((bf16*)(ws + WS_WIN))
#define WO ((bf16*)(ws + WS_WO))
#define WFI ((bf16*)(ws + WS_WFI))
#define WFO ((bf16*)(ws + WS_WFO))
#define WMEM ((bf16*)(ws + WS_WMEM))
#define MEMX ((bf16*)(ws + WS_MEMX))
#define MEMK ((bf16*)(ws + WS_MEMK))
#define MEMV ((bf16*)(ws + WS_MEMV))
#define X ((bf16*)(ws + WS_X))
#define Y ((float*)(ws + WS_Y))
#define YB ((bf16*)(ws + WS_Y))
#define PROJ ((bf16*)(ws + WS_R1))
#define HB ((bf16*)(ws + WS_R1))
#define OCAT ((bf16*)(ws + WS_OCAT))
#define SBKS ((bf16*)(ws + WS_SBKS))
#define SBVS ((bf16*)(ws + WS_SBVS))
#define OINT ((bf16*)(out + O_YP))
#define KPB ((bf16*)(out + O_YP))
#define VPB (KPB + (size_t)MP * 1536)

#define PHASE_BEGIN(cond, cls) if (cond) { if (lo <= ph && ph < hi) { if (ph > lo) { xcd_barrier(bar); if (BAR_REP > 1) xcd_barrier(bar); } DIAG_STAMP(cls); for (int rep_ = 0; rep_ < (((cls) == REP_CLS) ? 2 : 1); ++rep_) { const __attribute__((address_space(4))) Args* ka = KARGS; asm volatile("" : "+s"(ka)); int z_ = 0, G_ = gridDim.x, bid_ = blockIdx.x, wave_ = F.wave; asm volatile("" : "+s"(z_), "+s"(G_), "+s"(bid_), "+s"(wave_)); const int lane = (int)__builtin_amdgcn_mbcnt_hi(~0u, __builtin_amdgcn_mbcnt_lo(~0u, (unsigned)z_)), tid = wave_ * 64 + lane, gw_ = bid_ * NWAVES + wave_, NGW_ = G_ * NWAVES;     (void)tid; (void)lane; (void)gw_; (void)NGW_;
#define PHASE_END } } ++ph; }
#ifndef REP_CLS
#define REP_CLS (-1)
#endif
#ifndef SK_REP
#define SK_REP 1
#endif
#ifndef MEM_REP
#define MEM_REP 1
#endif
#ifndef BAR_REP
#define BAR_REP 1
#endif
#ifndef STAG
#define STAG 0
#endif
#ifndef SB_REP
#define SB_REP 1
#endif
#if defined(DIAG_A)
#define DIAG_STAMP(cls) do { if (blockIdx.x == 0 && threadIdx.x == 0) { unsigned long long* dts = (unsigned long long*)(args.ws_ + 262144); dts[ph] = rt(); } } while (0)
#else
#define DIAG_STAMP(cls) do { } while (0)
#endif

#define CONVERT_WEIGHTS(LL) do { const int ll_ = (LL); \
            if (ll_ < 2) wt_convert(F.lds, wave_, gw_, NGW_, lane, w_in_a + (size_t)ll_ * D * 5136, D, 5136, WIN, NA, MapInA()); \
            else { wt_convert(F.lds, wave_, gw_, NGW_, lane, w_in_b + (size_t)(ll_ - 2) * D * NBQ, D, NBQ, WIN, NBQ, MapId()); if (ll_ == 2) wt_convert(F.lds, wave_, gw_, NGW_, lane, w_kv_shared, D, NKV, WIN + (size_t)NBQ * D, NKV, MapId()); } \
            wt_convert(F.lds, wave_, gw_, NGW_, lane, w_o + (size_t)ll_ * D * D, D, D, WO, D, MapId()); \
            wt_convert(F.lds, wave_, gw_, NGW_, lane, w_ffn_in + (size_t)ll_ * D * 2 * DFF, D, 2 * DFF, WFI, 2 * DFF, MapFfn()); \
            wt_convert(F.lds, wave_, gw_, NGW_, lane, w_ffn_out + (size_t)ll_ * DFF * D, DFF, D, WFO, D, MapId()); } while (0)
#define CONVERT_CACHE_K(W0, NW) do {         for (int r = (W0); r < 8 * 2048; r += (NW)) { const int b = r >> 11, s = r & 2047; const float* src = cache_sb_k + (size_t)r * 1536; \
            f32x4 v[6]; \
_Pragma("unroll") \
            for (int q = 0; q < 6; ++q) v[q] = *(const f32x4*)(src + lane * 4 + 256 * q); \
_Pragma("unroll") \
            for (int q = 0; q < 6; ++q) { const int j = lane * 4 + 256 * q; \
                *(unsigned long long*)(SBKS + ((size_t)(b * 12 + (j >> 7)) * 2080 + s) * 128 + (j & 127)) = (unsigned long long)pk2(v[q].x, v[q].y) | ((unsigned long long)pk2(v[q].z, v[q].w) << 32); } } } while (0)
#define CONVERT_CACHE_V(W0, NW) do {         for (int it = (W0); it < 3072; it += (NW)) { const int cb = it % 12, sb_ = (it / 12) & 31, b = it / 384, s = sb_ * 64 + lane; \
            const float* src = cache_sb_v + (size_t)(b * 2048 + s) * 1536 + cb * 128; bf16* dst = SBVS + ((size_t)(b * 12 + cb) * 65 + (s >> 5)) * 4096 + pg8::vtf_k(s & 31); \
            for (int q8 = 0; q8 < 32; q8 += 8) { f32x4 v[8]; \
_Pragma("unroll") \
                for (int q = 0; q < 8; ++q) v[q] = *(const f32x4*)(src + 4 * (q8 + q)); \
_Pragma("unroll") \
                for (int q = 0; q < 8; ++q) \
_Pragma("unroll") \
                    for (int e = 0; e < 4; ++e) dst[pg8::vtf_d(4 * (q8 + q) + e)] = (bf16)f2bf(v[q][e]); } } } while (0)
    PHASE_BEGIN(true, 0)
        for (int r = 2 * gw_; r < MT; r += 2 * NGW_) { const float* s0 = r < MP ? x_prompt + (size_t)r * D : (r < MR ? x_sample + (size_t)(r - MP) * D : nullptr);
            cvt_rows2<D>(s0, s0 ? s0 + D : nullptr, X + (size_t)r * D, X + (size_t)(r + 1) * D, lane); }
        for (int r = 2 * gw_; r < 1024; r += 2 * NGW_) cvt_rows2<D>(mem_prompt + (size_t)r * D, mem_prompt + (size_t)(r + 1) * D, MEMX + (size_t)r * D, MEMX + (size_t)(r + 1) * D, lane);
        for (int r = gw_; r < 4 * 8 * 256; r += NGW_) { const int l = r >> 11, b = (r >> 8) & 7, m = r & 255; const size_t dst = (size_t)((l * 12 + 4 + b) * 256 + m) * 512;
            cvt_row(cache_mem_k + (size_t)r * 512, MEMK + dst, 512, lane); }
        for (int it = gw_; it < 512; it += NGW_) { const int hdb = it & 3, mb = (it >> 2) & 3, b = (it >> 4) & 7, l = it >> 7, m = mb * 64 + lane;
            const float* src = cache_mem_v + (size_t)((l * 8 + b) * 256 + m) * 512 + hdb * 128; bf16* dst = MEMV + (size_t)((l * 12 + 4 + b) * 512 + hdb * 128) * 256 + m;
            for (int q4 = 0; q4 < 32; ++q4) { const f32x4 v = *(const f32x4*)(src + 4 * q4);
#pragma unroll
                for (int e = 0; e < 4; ++e) dst[(size_t)(4 * q4 + e) * 256] = (bf16)f2bf(v[e]); } }
        if (G_ != 256) { CONVERT_CACHE_K(gw_, NGW_); CONVERT_CACHE_V(gw_, NGW_); }
        for (int l = 0; l < 4; ++l) wt_convert(F.lds, wave_, gw_, NGW_, lane, w_mem_kv + (size_t)l * D * 1024, D, 1024, WMEM + (size_t)l * 1024 * D, 1024, MapId());
        CONVERT_WEIGHTS(0);
    PHASE_END
    for (int l = 0; l < 4; ++l) {
        const bool LA = l < 2;
        const int ldp = LA ? NA : NBQ;
        PHASE_BEGIN(true, 2)
            if (!LA && (bid_ & 1)) { { SkBf16 E{PROJ, ldp}; skinny_gemm(bid_, G_, FRESH_TID(), wave_, F.lds + RING_OFF, X + (size_t)MP * D, D, WIN, D, ldp / 32, E); }
                if (l == 2) { SkKV E{out + O_SKS, out + O_SVS, SBKS, SBVS}; skinny_gemm(bid_, G_, FRESH_TID(), wave_, F.lds + RING_OFF, X + (size_t)MP * D, D, WIN + (size_t)NBQ * D, D, NKV / 32, E); } }
            { pg8::Gemm g{X, WIN, MP, ldp, D}; pg8::StaticOrder S; S.init(MP, ldp, G_, bid_); pg8::EpiBf16 E{PROJ, ldp};
              pg8::gemm_phase<pg8::EpiBf16, pg8::StaticOrder, true, true>(F.lds + RING_OFF, g, S, E, FRESH_TID()); }
            if (l == 0 && bid_ >= (G_ >> 1) && bid_ < (G_ >> 1) + 64) { pg8::Gemm g{MEMX, WMEM, 1024, 4096, D}; pg8::StaticOrder S; S.init(1024, 4096, 64, bid_ - (G_ >> 1));
              pg8::EpiMemKV E{out + O_MKP, out + O_MVP, MEMK, MEMV};
              pg8::gemm_phase<pg8::EpiMemKV, pg8::StaticOrder, true, true>(F.lds + RING_OFF, g, S, E, FRESH_TID()); }
            if (l == 2) { pg8::Gemm g{X, WIN + (size_t)NBQ * D, MP, NKV, D}; pg8::StaticOrder S; S.init(MP, NKV, G_, bid_);
              pg8::EpiKV E{out + O_SKP, out + O_SVP, out + O_SKS, out + O_SVS, KPB, VPB, SBKS, SBVS};
              pg8::gemm_phase<pg8::EpiKV, pg8::StaticOrder, true, true>(F.lds + RING_OFF, g, S, E, FRESH_TID()); }
            if (LA) { if (bid_ >= (G_ >> 1)) { SkBf16 E{PROJ, ldp};
                    if (l == 0 && G_ == 256) {
                        const int ns = bid_ < 192 ? 2 : 8, s0 = bid_ < 192 ? bid_ - 128 : 128 + (bid_ - 192);
                        for (int m = 0; m < ns; ++m) skinny_gemm(s0 + 64 * m, 640, FRESH_TID(), wave_, F.lds + RING_OFF, X + (size_t)MP * D, D, WIN, D, ldp / 32, E); }
                    else skinny_gemm(bid_ - (G_ >> 1), G_ >> 1, FRESH_TID(), wave_, F.lds + RING_OFF, X + (size_t)MP * D, D, WIN, D, ldp / 32, E); } }
            else if (!(bid_ & 1))
            for (int skr = 0; skr < SK_REP; ++skr) { SkBf16 E{PROJ, ldp}; skinny_gemm(bid_, G_, FRESH_TID(), wave_, F.lds + RING_OFF, X + (size_t)MP * D, D, WIN, D, ldp / 32, E); }
            if (!(bid_ & 1))
            for (int skr = 0; skr < SK_REP; ++skr) if (l == 2) { SkKV E{out + O_SKS, out + O_SVS, SBKS, SBVS}; skinny_gemm(bid_, G_, FRESH_TID(), wave_, F.lds + RING_OFF, X + (size_t)MP * D, D, WIN + (size_t)NBQ * D, D, NKV / 32, E); }
        PHASE_END
        PHASE_BEGIN(LA, 3)
            if (G_ == 256) gla_prep_intra<1>(bid_, G_, tid, wave_, F.lds + RING_OFF, l, PROJ, w_gate_lr, b_gate, (unsigned char*)Y, OINT);
            else gla_prep_intra<0>(bid_, G_, tid, wave_, F.lds + RING_OFF, l, PROJ, w_gate_lr, b_gate, (unsigned char*)Y, OINT);
        PHASE_END
        PHASE_BEGIN(!LA, 11)
            {
#if defined(SB_MODE)
                for (int u = gw_; u < 12288; u += NGW_) { const int bh = u >> 8, qb = u & 255, b = bh / 12, h = bh % 12, t0 = 32 * qb; const size_t qo = (size_t)(b * SEQ + t0) * D + h * 128;
                    sb_attn<SB_MODE>(lane, F.lds + RING_OFF + wave_ * 16384, KPB + (size_t)bh * SEQ * 128, 128, VPB + (size_t)bh * SEQ * 128, 0, PROJ + qo, NBQ, OCAT + qo, t0, 32); }
#endif
                for (int sbr = 0; sbr < SB_REP; ++sbr)
                for (int u = gw_; u < 12288 + 96; u += NGW_) {
                    if (u < 12288) { const int bh = u >> 8, qb = u & 255, b = bh / 12, h = bh % 12, t0 = 32 * qb; const size_t qo = (size_t)(b * SEQ + t0) * D + h * 128;
                        sb_attn(lane, F.lds + RING_OFF + wave_ * 16384, KPB + (size_t)bh * SEQ * 128, 128, VPB + (size_t)bh * SEQ * 128, 0, PROJ + qo, NBQ, OCAT + qo, t0, 32); }
                    else { const int u2 = u - 12288, b = u2 / 12, h = u2 % 12; const size_t qo = (size_t)(MP + b * 16) * D + h * 128;
                        sb_attn(lane, F.lds + RING_OFF + wave_ * 16384, SBKS + (size_t)u2 * 2080 * 128, 128, SBVS + (size_t)u2 * 65 * 4096, 0, PROJ + qo, NBQ, OCAT + qo, 2048, 16); }
                }
            }
            __syncthreads();
            for (int mr = 0; mr < MEM_REP; ++mr)
            if (G_ == 256) {
                mem_attn_wg(bid_, FRESH_TID(), wave_, F.lds + RING_OFF, l, PROJ, ldp, LA ? CQM : 1536, MEMK, MEMV, OCAT);
                if (bid_ >= 224) mem_attn_wg(256 + bid_ - 224, FRESH_TID(), wave_, F.lds + RING_OFF, l, PROJ, ldp, LA ? CQM : 1536, MEMK, MEMV, OCAT); }
            else
            for (int wi = bid_; wi < 256 + 32; wi += G_) mem_attn_wg(wi, FRESH_TID(), wave_, F.lds + RING_OFF, l, PROJ, ldp, LA ? CQM : 1536, MEMK, MEMV, OCAT);
        PHASE_END
        PHASE_BEGIN(LA, 12)
            if (G_ == 256) { if (bid_ >= 144) { mem_attn_wg(bid_ - 144, FRESH_TID(), wave_, F.lds + RING_OFF, l, PROJ, ldp, CQM, MEMK, MEMV, OCAT); mem_attn_wg(bid_ - 144 + 112, FRESH_TID(), wave_, F.lds + RING_OFF, l, PROJ, ldp, CQM, MEMK, MEMV, OCAT); }
                    if (bid_ >= 224) { __syncthreads(); gla_prep_intra<2>(bid_ - 224, G_, FRESH_TID(), wave_, F.lds + RING_OFF, l, PROJ, w_gate_lr, b_gate, (unsigned char*)Y, OINT); } }
            else for (int wi = bid_; wi < 256 + 32; wi += G_) mem_attn_wg(wi, FRESH_TID(), wave_, F.lds + RING_OFF, l, PROJ, ldp, CQM, MEMK, MEMV, OCAT);
            for (int wc = bid_; wc < 144; wc += G_) gla_chain<1>(wc, FRESH_TID(), wave_, F.lds + RING_OFF, l, (const unsigned char*)Y, state_gla, OINT, out, (float*)WMEM, (float*)MEMX);
            if (G_ == 256 && bid_ < 64) mem_attn_wg(224 + bid_, FRESH_TID(), wave_, F.lds + RING_OFF, l, PROJ, ldp, CQM, MEMK, MEMV, OCAT);
        PHASE_END
        PHASE_BEGIN(LA, 5)
            if (G_ == 256 && bid_ >= 192) { const int lw = (bid_ - 192) * NWAVES + wave_; if (l == 0) CONVERT_CACHE_K(lw, 64 * NWAVES); else CONVERT_CACHE_V(lw, 64 * NWAVES); }
            for (int wc = bid_; wc < 192 + 96; wc += G_) gla_chain<2>(wc, FRESH_TID(), wave_, F.lds + RING_OFF, l, (const unsigned char*)Y, state_gla, OINT, out, (float*)WMEM, (float*)MEMX, REP_CLS == 5 && rep_ == 0);
        PHASE_END
        PHASE_BEGIN(LA, 6)
            const float* gn = gla_norm_g + (size_t)l * 384;
            for (int row = gw_; row < MR; row += NGW_) {
                const bf16* op = OINT + (size_t)row * 1536 + 24 * lane; const bf16* gp = PROJ + (size_t)row * NA + CG + 24 * lane; const float* gnp = gn + 24 * (lane & 15);
                f32x4 ov[6]; v4u gv[3]; float ss = 0.f;
#pragma unroll
                for (int j = 0; j < 3; ++j) { const v4u w = *(const v4u*)(op + 8 * j); ov[2 * j] = (f32x4){pg8::bflo(w.x), pg8::bfhi(w.x), pg8::bflo(w.y), pg8::bfhi(w.y)}; ov[2 * j + 1] = (f32x4){pg8::bflo(w.z), pg8::bfhi(w.z), pg8::bflo(w.w), pg8::bfhi(w.w)}; }
#pragma unroll
                for (int j = 0; j < 6; ++j) ss += (ov[j].x * ov[j].x + ov[j].y * ov[j].y) + (ov[j].z * ov[j].z + ov[j].w * ov[j].w);
#pragma unroll
                for (int j = 0; j < 3; ++j) gv[j] = *(const v4u*)(gp + 8 * j);
                ss += shx(ss, lane, 1); ss += shx(ss, lane, 2); ss += shx(ss, lane, 4); ss += shx(ss, lane, 8);
                const float r = 1.0f / sqrtf(ss * (1.0f / 384.0f) + RMS_EPS);
#pragma unroll
                for (int j = 0; j < 3; ++j) { const f32x4 n0 = *(const f32x4*)(gnp + 8 * j), n1 = *(const f32x4*)(gnp + 8 * j + 4); const f32x4 a = ov[2 * j], b = ov[2 * j + 1];
                    float gt[8]; gt[0] = pg8::bflo(gv[j].x); gt[1] = pg8::bfhi(gv[j].x); gt[2] = pg8::bflo(gv[j].y); gt[3] = pg8::bfhi(gv[j].y); gt[4] = pg8::bflo(gv[j].z); gt[5] = pg8::bfhi(gv[j].z); gt[6] = pg8::bflo(gv[j].w); gt[7] = pg8::bfhi(gv[j].w);
                    float o8[8];
#pragma unroll
                    for (int i = 0; i < 4; ++i) { o8[i] = a[i] * r * n0[i] * (gt[i] * __builtin_amdgcn_rcpf(1.0f + __expf(-gt[i]))); o8[4 + i] = b[i] * r * n1[i] * (gt[4 + i] * __builtin_amdgcn_rcpf(1.0f + __expf(-gt[4 + i]))); }
                    v4u o; o.x = pk2(o8[0], o8[1]); o.y = pk2(o8[2], o8[3]); o.z = pk2(o8[4], o8[5]); o.w = pk2(o8[6], o8[7]);
                    *(v4u*)(OCAT + (size_t)row * D + 24 * lane + 8 * j) = o; }
            }
        PHASE_END
        PHASE_BEGIN(true, 7)
            if (bid_ & 1) { SkRes Es{YB, X, DN_ALPHA}; skinny_gemm(bid_, G_, FRESH_TID(), wave_, F.lds + RING_OFF, OCAT + (size_t)MP * D, D, WO, D, D / 32, Es); }
            pg8::Gemm g{OCAT, WO, MP, D, D}; pg8::StaticOrder S; S.init(MP, D, G_, bid_); pg8::EpiRes E{YB, X, D, DN_ALPHA};
            pg8::gemm_phase<pg8::EpiRes, pg8::StaticOrder, true, true>(F.lds + RING_OFF, g, S, E, FRESH_TID());
            if (!(bid_ & 1))
            for (int skr = 0; skr < SK_REP; ++skr) { SkRes Es{YB, X, DN_ALPHA}; skinny_gemm(bid_, G_, FRESH_TID(), wave_, F.lds + RING_OFF, OCAT + (size_t)MP * D, D, WO, D, D / 32, Es); }
        PHASE_END
        PHASE_BEGIN(true, 8)
            const float* gg = ln1_g + (size_t)l * D; const float* bb = ln1_b + (size_t)l * D;
            ln_rows<false>(lane, gw_, NGW_, YB, gg, bb, X, [](int) -> float* { return nullptr; });
        PHASE_END
        PHASE_BEGIN(true, 9)
            for (int dl = 0; dl < 3 * STAG * (bid_ >> 1 & 3); ++dl) __builtin_amdgcn_s_sleep(127);
            if (bid_ & 1) { SkSwiGLU Es{HB}; skinny_gemm(bid_, G_, FRESH_TID(), wave_, F.lds + RING_OFF, X + (size_t)MP * D, D, WFI, D, DFF / 16, Es); }
            pg8::Gemm g{X, WFI, MP, 2 * DFF, D}; pg8::StaticOrder S; S.init(MP, 2 * DFF, G_, bid_); pg8::EpiSwiGLU E{HB, DFF};
            pg8::gemm_phase<pg8::EpiSwiGLU, pg8::StaticOrder, true, true>(F.lds + RING_OFF, g, S, E, FRESH_TID());
            if (!(bid_ & 1))
            for (int skr = 0; skr < SK_REP; ++skr) { SkSwiGLU Es{HB}; skinny_gemm(bid_, G_, FRESH_TID(), wave_, F.lds + RING_OFF, X + (size_t)MP * D, D, WFI, D, DFF / 16, Es); }
        PHASE_END
        PHASE_BEGIN(true, 10)
            if (bid_ & 1) { SkRes Es{YB, X, DN_ALPHA}; skinny_gemm(bid_, G_, FRESH_TID(), wave_, F.lds + RING_OFF, HB + (size_t)MP * DFF, DFF, WFO, DFF, D / 32, Es); }
            pg8::Gemm g{HB, WFO, MP, D, DFF}; pg8::StaticOrder S; S.init(MP, D, G_, bid_); pg8::EpiRes E{YB, X, D, DN_ALPHA};
            pg8::gemm_phase<pg8::EpiRes, pg8::StaticOrder, true, true>(F.lds + RING_OFF, g, S, E, FRESH_TID());
            if (!(bid_ & 1))
            for (int skr = 0; skr < SK_REP; ++skr) { SkRes Es{YB, X, DN_ALPHA}; skinny_gemm(bid_, G_, FRESH_TID(), wave_, F.lds + RING_OFF, HB + (size_t)MP * DFF, DFF, WFO, DFF, D / 32, Es); }
        PHASE_END
        PHASE_BEGIN(true, 8)
            if (l < 3) CONVERT_WEIGHTS(l + 1);
            const float* gg = ln2_g + (size_t)l * D; const float* bb = ln2_b + (size_t)l * D;
            if (l == 3) ln_rows<true>(lane, gw_, NGW_, YB, gg, bb, nullptr, [&](int row) -> float* { return row < MP ? out + O_YP + (size_t)row * D : out + O_YS + (size_t)(row - MP) * D; });
            else ln_rows<false>(lane, gw_, NGW_, YB, gg, bb, X, [](int) -> float* { return nullptr; });
        PHASE_END
    }
#if defined(DIAG_A)
    if (blockIdx.x == 0 && threadIdx.x == 0) { unsigned long long* dts = (unsigned long long*)(args.ws_ + 262144); dts[ph] = rt(); dts[63] = (unsigned long long)ph; }
#endif
#undef ws
#undef out
#undef X
#undef Y
#undef YB
#undef CONVERT_WEIGHTS
#undef CONVERT_CACHE_K
#undef CONVERT_CACHE_V
#undef PHASE_BEGIN
#undef PHASE_END
}

#if defined(DIAG_A)
__device__ const int diag_cls[40] = {0,0, 1,2,3,4,5,6,7,8,9,10,8, 1,2,3,4,5,6,7,8,9,10,8, 1,2,11,7,8,9,10,8, 1,2,11,7,8,9,10,8};
__global__ void diag_tail(float* o, const unsigned long long* dts) {
    __shared__ float dv[2];
    if (threadIdx.x == 0) { const int n = (int)dts[63]; unsigned long long sa = 0, sb = 0; for (int p = 0; p < n; ++p) { const unsigned long long d = dts[p + 1] - dts[p]; const int cl = diag_cls[p]; if (cl == DIAG_A) sa += d; if (cl == DIAG_B) sb += d; }
        dv[0] = (float)sa * 0.01f; dv[1] = (float)sb * 10.0f; }
    __syncthreads();
    for (int i = threadIdx.x; i < 262144; i += blockDim.x) o[O_YS + i] = dv[0];
    if (threadIdx.x == 0) o[O_YP] = dv[1];
}
#endif
#ifndef MK_PER_PHASE
#define MK_PER_PHASE 0
#endif
constexpr int N_PHASES = 1 + 2 * 10 + 2 * 7;
extern "C" void kernel_launch(void* const* d_in, const int* in_sizes, int n_in, void* d_out, int out_size, void* d_ws, size_t ws_size, hipStream_t stream) {
    static int grid = 0;
    if (grid == 0) {
        if (n_in != 22 || in_sizes[0] != MP * D || (size_t)out_size != O_END || ws_size < WS_END) { fprintf(stderr, "kernel_launch: unexpected shapes (n_in %d, in0 %d, out %d, ws %zu); nothing launched\n", n_in, n_in > 0 ? in_sizes[0] : -1, out_size, ws_size); grid = -1; return; }
        int dev = 0, cus = 0, per_cu = 0;
        if (hipGetDevice(&dev) != hipSuccess || hipDeviceGetAttribute(&cus, hipDeviceAttributeMultiprocessorCount, dev) != hipSuccess) { grid = -1; return; }
        if (hipFuncSetAttribute((const void*)mega, hipFuncAttributeMaxDynamicSharedMemorySize, LDS_BYTES) != hipSuccess) { fprintf(stderr, "kernel_launch: hipFuncSetAttribute failed\n"); grid = -1; return; }
        if (hipOccupancyMaxActiveBlocksPerMultiprocessor(&per_cu, (const void*)mega, NWAVES * 64, LDS_BYTES) != hipSuccess || per_cu < 1) fprintf(stderr, "kernel_launch: occupancy query reports %d\n", per_cu);
        (void)hipGetLastError();
        grid = cus;
    }
    if (grid < 0) return;
    if (hipMemsetAsync((char*)d_ws + WS_CTL, 0, CTL_ZERO_BYTES, stream) != hipSuccess) return;
    Args a{};
    for (int i = 0; i < 22; ++i) a.in[i] = (const float*)d_in[i];
    a.out_ = (float*)d_out; a.ws_ = (unsigned char*)d_ws;
#if MK_PER_PHASE
    for (int p = 0; p < N_PHASES; ++p) { a.ph_lo = p; a.ph_hi = p + 1; hipLaunchKernelGGL(mega, dim3(grid), dim3(NWAVES * 64), LDS_BYTES, stream, a); }
#else
    a.ph_lo = 0; a.ph_hi = N_PHASES; hipLaunchKernelGGL(mega, dim3(grid), dim3(NWAVES * 64), LDS_BYTES, stream, a);
#if defined(DIAG_A)
    hipLaunchKernelGGL(diag_tail, dim3(1), dim3(512), 0, stream, (float*)d_out, (const unsigned long long*)((unsigned char*)d_ws + 262144));
#endif
#endif
}
```

```cpp
#include <hip/hip_runtime.h>
#include <cstdio>
#include <cstdint>
namespace pg8 {
#define PG8_LAS __attribute__((address_space(3)))
typedef unsigned short bf16_t;
typedef short bf16x8 __attribute__((ext_vector_type(8)));
typedef float f32x4 __attribute__((ext_vector_type(4)));
typedef unsigned u32x4 __attribute__((ext_vector_type(4)));
constexpr int BM = 256, BK = 64, HALF = 128, HTB = HALF * BK * 2  , STAGE_BYTES = 8 * HTB, NXCD = 8, WGM = 4;

__host__ __device__ __forceinline__ int lds_byte(int r, int c) { const int st = (r >> 4) * 2 + (c >> 5), rr = r & 15, cc = c & 31, ob = rr * 64 + cc * 2; return st * 1024 + (ob ^ (((ob >> 9) & 1) << 5)); }
__host__ __device__ __forceinline__ void stage_rc(int b, int& R, int& C) { const int st = b / 1024, sb = b % 1024, swz = sb ^ (((sb >> 9) & 1) << 5); R = (st >> 1) * 16 + swz / 64; C = (st & 1) * 32 + (swz % 64) / 2; }
__host__ __device__ __forceinline__ int perm32(int rho) { const int n = rho >> 4, i = rho & 15; return 8 * (i >> 2) + 4 * n + (i & 3); }

struct Unit { int pm, pn; };
struct Gemm { const bf16_t* A; const bf16_t* Bt; int M, N, K; };

struct StaticOrder {
    int nM, nN, nwg, G, c;
    __host__ __device__ void init(int M, int N, int G_, int c_) { nM = M / BM; nN = N / BM; nwg = nM * nN; G = G_; c = c_; }
    __host__ __device__ bool next(int i, Unit& u) const {
        const long L = (long)i * G + c; if (L >= nwg) return false;
        int wgid = (int)L; { const int q = nwg / NXCD, r = nwg % NXCD, xcd = wgid % NXCD, off = wgid / NXCD; wgid = (xcd < r ? xcd * (q + 1) : r * (q + 1) + (xcd - r) * q) + off; }
        const int nig = WGM * nN, gid = wgid / nig, fm = gid * WGM, gsz = (nM - fm) < WGM ? (nM - fm) : WGM;
        u.pm = fm + ((wgid % nig) % gsz); u.pn = (wgid % nig) / gsz; return true;
    }
    __device__ __forceinline__ void a_ready(const Unit&) const {}
    __device__ __forceinline__ void done(const Unit&) const {}
};
__device__ __forceinline__ unsigned cvt_pk_bf16(float lo, float hi) { unsigned r; asm volatile("v_cvt_pk_bf16_f32 %0, %1, %2" : "=v"(r) : "v"(lo), "v"(hi)); return r; }
typedef float f32x2 __attribute__((ext_vector_type(2)));
typedef unsigned u32x2 __attribute__((ext_vector_type(2)));
__host__ __device__ __forceinline__ int vtf_d(int d) { return (d >> 5) * 1024 + (d & 31) * 8; }
__host__ __device__ __forceinline__ int vtf_k(int ks) { return (ks >> 4) * 512 + ((ks >> 2) & 1) * 256 + (ks & 3) + 4 * ((ks >> 3) & 1); }
__device__ __forceinline__ float bflo(unsigned w) { return __builtin_bit_cast(float, w << 16); }
__device__ __forceinline__ float bfhi(unsigned w) { return __builtin_bit_cast(float, w & 0xffff0000u); }
struct EpiBf16 {
    static constexpr bool PERM = true, AFTER_DRAIN = false;
    bf16_t* O; int ldc;
    __device__ __forceinline__ void operator()(const f32x4 (&acc)[2][2][4][2], const Unit& u, int wr, int wc, int fr, int fq) const {
        const int row0 = u.pm * BM + wr * 64 + fr, col0 = u.pn * BM + wc * 32 + 8 * fq;
#pragma unroll
        for (int ai = 0; ai < 2; ++ai)
#pragma unroll
            for (int m = 0; m < 4; ++m) { bf16_t* rowp = O + (size_t)(row0 + ai * HALF + m * 16) * ldc + col0;
#pragma unroll
                for (int bj = 0; bj < 2; ++bj) { const f32x4 v0 = acc[ai][bj][m][0], v1 = acc[ai][bj][m][1];
                    u32x4 w; w.x = cvt_pk_bf16(v0[0], v0[1]); w.y = cvt_pk_bf16(v0[2], v0[3]); w.z = cvt_pk_bf16(v1[0], v1[1]); w.w = cvt_pk_bf16(v1[2], v1[3]);
                    *(u32x4*)(rowp + bj * HALF) = w; } }
    }
};
struct EpiSwiGLU {
    static constexpr bool PERM = true, AFTER_DRAIN = false;
    bf16_t* Hh; int ldh;
    __device__ __forceinline__ float swi(float g, float up) const { return g * __builtin_amdgcn_rcpf(1.0f + __expf(-g)) * up; }
    __device__ __forceinline__ void operator()(const f32x4 (&acc)[2][2][4][2], const Unit& u, int wr, int wc, int fr, int fq) const {
        const int row0 = u.pm * BM + wr * 64 + fr, col0 = u.pn * HALF + wc * 32 + 8 * fq;
#pragma unroll
        for (int ai = 0; ai < 2; ++ai)
#pragma unroll
            for (int m = 0; m < 4; ++m) { bf16_t* rowp = Hh + (size_t)(row0 + ai * HALF + m * 16) * ldh + col0;
                const f32x4 g0 = acc[ai][0][m][0], g1 = acc[ai][0][m][1], u0 = acc[ai][1][m][0], u1 = acc[ai][1][m][1];
                u32x4 w; w.x = cvt_pk_bf16(swi(g0[0], u0[0]), swi(g0[1], u0[1])); w.y = cvt_pk_bf16(swi(g0[2], u0[2]), swi(g0[3], u0[3]));
                w.z = cvt_pk_bf16(swi(g1[0], u1[0]), swi(g1[1], u1[1])); w.w = cvt_pk_bf16(swi(g1[2], u1[2]), swi(g1[3], u1[3]));
                *(u32x4*)rowp = w; }
    }
};
struct EpiRes {
    static constexpr bool PERM = true, AFTER_DRAIN = false;
    bf16_t* Y; const bf16_t* X; int ldc; float alpha;
    __device__ __forceinline__ void operator()(const f32x4 (&acc)[2][2][4][2], const Unit& u, int wr, int wc, int fr, int fq) const {
        const int row0 = u.pm * BM + wr * 64 + fr, col0 = u.pn * BM + wc * 32 + 8 * fq;
        u32x4 xv[2][4][2];
#pragma unroll
        for (int ai = 0; ai < 2; ++ai)
#pragma unroll
            for (int m = 0; m < 4; ++m)
#pragma unroll
                for (int bj = 0; bj < 2; ++bj) xv[ai][m][bj] = *(const u32x4*)(X + (size_t)(row0 + ai * HALF + m * 16) * ldc + col0 + bj * HALF);
#pragma unroll
        for (int ai = 0; ai < 2; ++ai)
#pragma unroll
            for (int m = 0; m < 4; ++m) { const size_t ro = (size_t)(row0 + ai * HALF + m * 16) * ldc + col0;
#pragma unroll
                for (int bj = 0; bj < 2; ++bj) { const u32x4 x4 = xv[ai][m][bj]; const f32x4 a0 = acc[ai][bj][m][0], a1 = acc[ai][bj][m][1];
                    u32x4 w; w.x = cvt_pk_bf16(alpha * bflo(x4.x) + a0[0], alpha * bfhi(x4.x) + a0[1]); w.y = cvt_pk_bf16(alpha * bflo(x4.y) + a0[2], alpha * bfhi(x4.y) + a0[3]);
                    w.z = cvt_pk_bf16(alpha * bflo(x4.z) + a1[0], alpha * bfhi(x4.z) + a1[1]); w.w = cvt_pk_bf16(alpha * bflo(x4.w) + a1[2], alpha * bfhi(x4.w) + a1[3]);
                    *(u32x4*)(Y + ro + bj * HALF) = w; } }
    }
};
struct EpiKV {
    static constexpr bool PERM = false, AFTER_DRAIN = false;
    float *okp, *ovp, *oks, *ovs; bf16_t *kpb, *vpb, *ksb, *vsb;
    __device__ __forceinline__ void operator()(const f32x4 (&acc)[2][2][4][2], const Unit& u, int wr, int wc, int fr, int fq) const {
        const bool isv = u.pn >= 6; const int colt = (u.pn - (isv ? 6 : 0)) * BM + wc * 32 + 4 * fq, row0 = u.pm * BM + wr * 64 + fr;
        float* op = isv ? ovp : okp;
#pragma unroll
        for (int ai = 0; ai < 2; ++ai)
#pragma unroll
            for (int m = 0; m < 4; ++m) { const int row = row0 + ai * HALF + m * 16; float* fd;
                if (row < 32768) { fd = op + (size_t)row * 1536; } else continue;
                const int bq = row >> 13, sq = row & 8191;
#pragma unroll
                for (int bj = 0; bj < 2; ++bj)
#pragma unroll
                    for (int n = 0; n < 2; ++n) { const int c = colt + bj * HALF + n * 16; const f32x4 v = acc[ai][bj][m][n];
                        *(f32x4*)(fd + c) = v; const unsigned w0 = cvt_pk_bf16(v[0], v[1]), w1 = cvt_pk_bf16(v[2], v[3]);
                        const int hq = c >> 7, dq = c & 127;
                        if (!isv) { u32x2 w; w.x = w0; w.y = w1; *(u32x2*)(kpb + ((size_t)(bq * 12 + hq) * 8192 + sq) * 128 + dq) = w; }
                        else { bf16_t* vt = vpb + ((size_t)(bq * 12 + hq) * 256 + (sq >> 5)) * 4096 + vtf_d(dq) + vtf_k(sq & 31); vt[0] = (bf16_t)w0; vt[8] = (bf16_t)(w0 >> 16); vt[16] = (bf16_t)w1; vt[24] = (bf16_t)(w1 >> 16); } } }
    }
};
struct EpiMemKV {
    static constexpr bool PERM = false, AFTER_DRAIN = false;
    float *ok, *ov; bf16_t *kb, *vb;
    __device__ __forceinline__ void operator()(const f32x4 (&acc)[2][2][4][2], const Unit& u, int wr, int wc, int fr, int fq) const {
        const int l = u.pn >> 2, kv = (u.pn >> 1) & 1, hd0 = (u.pn & 1) * BM + wc * 32 + 4 * fq, row0 = u.pm * BM + wr * 64 + fr;
        float* fo = kv ? ov : ok; bf16_t* bo = kv ? vb : kb;
#pragma unroll
        for (int ai = 0; ai < 2; ++ai)
#pragma unroll
            for (int m = 0; m < 4; ++m) { const int row = row0 + ai * HALF + m * 16, b = row >> 8, mm = row & 255;
                float* fd = fo + (size_t)(l * 1024 + row) * 512; bf16_t* bd = bo + (size_t)((l * 12 + b) * 256 + mm) * 512;
#pragma unroll
                for (int bj = 0; bj < 2; ++bj)
#pragma unroll
                    for (int n = 0; n < 2; ++n) { const int c = hd0 + bj * HALF + n * 16; const f32x4 v = acc[ai][bj][m][n];
                        *(f32x4*)(fd + c) = v; const unsigned w0 = cvt_pk_bf16(v[0], v[1]), w1 = cvt_pk_bf16(v[2], v[3]);
                        if (!kv) { u32x2 w; w.x = w0; w.y = w1; *(u32x2*)(bd + c) = w; }
                        else { bf16_t* vt = vb + (size_t)((l * 12 + b) * 512 + c) * 256 + mm;
                            vt[0] = (bf16_t)w0; vt[256] = (bf16_t)(w0 >> 16); vt[512] = (bf16_t)w1; vt[768] = (bf16_t)(w1 >> 16); } } }
    }
};
template <class Epi, class Sched, bool ALIGN_EPI = false, bool SP2 = false>
__device__ __forceinline__ void gemm_phase(PG8_LAS unsigned char* lds, const Gemm g, const Sched& S, const Epi& E, int tid_in) {
    int tid_ = tid_in; asm volatile("" : "+v"(tid_));
    const int tid = tid_, wid = __builtin_amdgcn_readfirstlane(tid >> 6), lane = tid & 63, wr = wid >> 2, wc = wid & 3, fr = lane & 15, fq = lane >> 4;
    const int K = g.K, nt = K / BK;
    unsigned voffA[2], voffB[2];
#pragma unroll
    for (int i = 0; i < 2; ++i) { int R, C; stage_rc(tid * 16 + i * 8192, R, C); const int Rb = Epi::PERM ? ((R & ~31) + perm32(R & 31)) : R;
        voffA[i] = (unsigned)(R * K + C) * 2u; voffB[i] = (unsigned)(Rb * K + C) * 2u; }
    const size_t kstep = (size_t)(BK * 2);
    const size_t hstep = (size_t)HALF * K * 2;
    const size_t tstep = 2 * hstep;
    const unsigned ldsw = (unsigned)wid * 1024u;
    const int aoff = lds_byte(wr * 64 + fr, fq * 8), boff = lds_byte(wc * 32 + fr, fq * 8);
#define PG8_SA(b, h) (((b) * 2 + (h)) * HTB)
#define PG8_SB(b, h) ((4 + (b) * 2 + (h)) * HTB)
#define PG8_STAGE_X(bufoff, gbase, voff, aux) do { _Pragma("unroll") for (int _i = 0; _i < 2; ++_i) \
        __builtin_amdgcn_global_load_lds((const unsigned*)((const char*)(gbase) + (voff)[_i]), (PG8_LAS unsigned*)(lds + (bufoff) + ldsw + _i * 8192), 16, 0, aux); } while (0)
#ifndef PG8_B_AUX
#define PG8_B_AUX 0
#endif
#define PG8_STAGE(bufoff, gbase, voff) PG8_STAGE_X(bufoff, gbase, voff, 0)
#define PG8_LDA(dst, b, h) do { _Pragma("unroll") for (int m = 0; m < 4; ++m) _Pragma("unroll") for (int k = 0; k < 2; ++k) dst[m][k] = *(const PG8_LAS bf16x8*)(lds + PG8_SA(b, h) + aoff + m * 2048 + k * 1024); } while (0)
#define PG8_LDB(dst, b, h) do { _Pragma("unroll") for (int n = 0; n < 2; ++n) _Pragma("unroll") for (int k = 0; k < 2; ++k) dst[n][k] = *(const PG8_LAS bf16x8*)(lds + PG8_SB(b, h) + boff + n * 2048 + k * 1024); } while (0)
#define PG8_MMA(ai, bj, At, Bt) do { __builtin_amdgcn_s_setprio(1); _Pragma("unroll") for (int m = 0; m < 4; ++m) _Pragma("unroll") for (int n = 0; n < 2; ++n) _Pragma("unroll") for (int k = 0; k < 2; ++k) \
        acc[ai][bj][m][n] = __builtin_amdgcn_mfma_f32_16x16x32_bf16(Bt[n][k], At[m][k], acc[ai][bj][m][n], 0, 0, 0); __builtin_amdgcn_s_setprio(0); } while (0)
#define PG8_WAIT_V(n) asm volatile("s_waitcnt vmcnt(" #n ")" ::: "memory")
#define PG8_WAIT_L(n) asm volatile("s_waitcnt lgkmcnt(" #n ")" ::: "memory")
#define PG8_BAR __builtin_amdgcn_s_barrier()
#define PG8_SCHED __builtin_amdgcn_sched_barrier(0)
    Unit cur, nxt; int ui = 0;
    if (!S.next(0, cur)) return;
    f32x4 acc[2][2][4][2];
#pragma unroll
    for (int a = 0; a < 2; ++a)
#pragma unroll
        for (int b = 0; b < 2; ++b)
#pragma unroll
            for (int m = 0; m < 4; ++m)
#pragma unroll
                for (int n = 0; n < 2; ++n) acc[a][b][m][n] = (f32x4){0.f, 0.f, 0.f, 0.f};
    bf16x8 At[4][2], B0[2][2], B1[2][2];
    const char* cA = (const char*)g.A + (size_t)cur.pm * tstep; const char* cB = (const char*)g.Bt + (size_t)cur.pn * tstep;
    S.a_ready(cur);
    if constexpr (SP2) {
        PG8_STAGE_X(PG8_SB(0, 0), cB, voffB, PG8_B_AUX); PG8_STAGE_X(PG8_SB(0, 1), cB + hstep, voffB, PG8_B_AUX); PG8_STAGE(PG8_SA(0, 0), cA, voffA); PG8_STAGE(PG8_SA(0, 1), cA + hstep, voffA);
        if (wr == 1) PG8_BAR;
        PG8_WAIT_V(2); PG8_BAR;
        PG8_STAGE_X(PG8_SB(1, 0), cB + kstep, voffB, PG8_B_AUX); PG8_STAGE(PG8_SA(1, 0), cA + kstep, voffA); PG8_STAGE_X(PG8_SB(1, 1), cB + hstep + kstep, voffB, PG8_B_AUX);
        PG8_WAIT_V(6); PG8_BAR;
    } else {
        PG8_STAGE_X(PG8_SB(0, 0), cB, voffB, PG8_B_AUX); PG8_STAGE(PG8_SA(0, 0), cA, voffA); PG8_STAGE_X(PG8_SB(0, 1), cB + hstep, voffB, PG8_B_AUX); PG8_STAGE(PG8_SA(0, 1), cA + hstep, voffA);
        if (wr == 1) PG8_BAR;
        PG8_WAIT_V(4); PG8_BAR;
        PG8_STAGE_X(PG8_SB(1, 0), cB + kstep, voffB, PG8_B_AUX); PG8_STAGE(PG8_SA(1, 0), cA + kstep, voffA); PG8_STAGE_X(PG8_SB(1, 1), cB + hstep + kstep, voffB, PG8_B_AUX);
        PG8_WAIT_V(6); PG8_BAR;
    }
    for (;;) {
        const bool has_next = S.next(ui + 1, nxt);
        const char* nA = has_next ? (const char*)g.A + (size_t)nxt.pm * tstep : cA; const char* nB = has_next ? (const char*)g.Bt + (size_t)nxt.pn * tstep : cB;
        for (int t = 0; t < nt; t += 2) {
            const bool last = (t == nt - 2);
            const char* a1 = cA + (size_t)(t + 1) * kstep;
            const char* a2 = last ? nA : cA + (size_t)(t + 2) * kstep; const char* b2 = last ? nB : cB + (size_t)(t + 2) * kstep;
            const char* a3 = a2 + kstep; const char* b3 = b2 + kstep;
            if (last && has_next) S.a_ready(nxt);
            if constexpr (SP2) {
            PG8_LDB(B0, 0, 0); PG8_LDB(B1, 0, 1); PG8_SCHED; PG8_LDA(At, 0, 0); PG8_STAGE(PG8_SA(1, 1), a1 + hstep, voffA);
            PG8_WAIT_V(8); PG8_WAIT_L(0); PG8_BAR; PG8_MMA(0, 0, At, B0); PG8_MMA(0, 1, At, B1); PG8_BAR; PG8_SCHED;
            PG8_LDA(At, 0, 1); PG8_STAGE_X(PG8_SB(0, 0), b2, voffB, PG8_B_AUX); PG8_STAGE_X(PG8_SB(0, 1), b2 + hstep, voffB, PG8_B_AUX); PG8_STAGE(PG8_SA(0, 0), a2, voffA);
            PG8_WAIT_V(8); PG8_WAIT_L(0); PG8_BAR; PG8_MMA(1, 0, At, B0); PG8_MMA(1, 1, At, B1); PG8_BAR; PG8_SCHED;
            PG8_LDB(B0, 1, 0); PG8_LDB(B1, 1, 1); PG8_SCHED; PG8_LDA(At, 1, 0); PG8_STAGE(PG8_SA(0, 1), a2 + hstep, voffA);
            PG8_WAIT_V(8); PG8_WAIT_L(0); PG8_BAR; PG8_MMA(0, 0, At, B0); PG8_MMA(0, 1, At, B1); PG8_BAR; PG8_SCHED;
            PG8_LDA(At, 1, 1); PG8_STAGE_X(PG8_SB(1, 0), b3, voffB, PG8_B_AUX); PG8_STAGE_X(PG8_SB(1, 1), b3 + hstep, voffB, PG8_B_AUX); PG8_STAGE(PG8_SA(1, 0), a3, voffA);
            PG8_WAIT_V(8); PG8_WAIT_L(0); PG8_BAR; PG8_MMA(1, 0, At, B0); PG8_MMA(1, 1, At, B1); PG8_BAR; PG8_SCHED;
            } else {
            PG8_LDB(B0, 0, 0); PG8_SCHED; PG8_LDA(At, 0, 0); PG8_STAGE(PG8_SA(1, 1), a1 + hstep, voffA);
            PG8_WAIT_L(8); PG8_BAR; PG8_WAIT_L(0); PG8_MMA(0, 0, At, B0); PG8_BAR; PG8_SCHED;
            PG8_LDB(B1, 0, 1); PG8_STAGE_X(PG8_SB(0, 0), b2, voffB, PG8_B_AUX);
            PG8_BAR; PG8_WAIT_L(0); PG8_MMA(0, 1, At, B1); PG8_BAR;
            PG8_LDA(At, 0, 1); PG8_STAGE(PG8_SA(0, 0), a2, voffA);
            PG8_BAR; PG8_WAIT_L(0); PG8_MMA(1, 0, At, B0); PG8_BAR; PG8_SCHED;
            PG8_STAGE_X(PG8_SB(0, 1), b2 + hstep, voffB, PG8_B_AUX);
            PG8_WAIT_V(6); PG8_BAR; PG8_MMA(1, 1, At, B1); PG8_BAR;
            PG8_LDB(B0, 1, 0); PG8_SCHED; PG8_LDA(At, 1, 0); PG8_STAGE(PG8_SA(0, 1), a2 + hstep, voffA);
            PG8_WAIT_L(8); PG8_BAR; PG8_WAIT_L(0); PG8_MMA(0, 0, At, B0); PG8_BAR; PG8_SCHED;
            PG8_LDB(B1, 1, 1); PG8_STAGE_X(PG8_SB(1, 0), b3, voffB, PG8_B_AUX);
            PG8_BAR; PG8_WAIT_L(0); PG8_MMA(0, 1, At, B1); PG8_BAR;
            PG8_LDA(At, 1, 1); PG8_STAGE(PG8_SA(1, 0), a3, voffA);
            PG8_BAR; PG8_WAIT_L(0); PG8_MMA(1, 0, At, B0); PG8_BAR; PG8_SCHED;
            PG8_STAGE_X(PG8_SB(1, 1), b3 + hstep, voffB, PG8_B_AUX);
            PG8_WAIT_V(6); PG8_BAR; PG8_MMA(1, 1, At, B1); PG8_BAR;
            }
        }
        if constexpr (ALIGN_EPI) { if (wr == 0) PG8_BAR; }
        if constexpr (!Epi::AFTER_DRAIN) { E(acc, cur, wr, wc, fr, fq); S.done(cur); }
        if (!has_next) break;
#pragma unroll
        for (int a = 0; a < 2; ++a)
#pragma unroll
            for (int b = 0; b < 2; ++b)
#pragma unroll
                for (int m = 0; m < 4; ++m)
#pragma unroll
                    for (int n = 0; n < 2; ++n) acc[a][b][m][n] = (f32x4){0.f, 0.f, 0.f, 0.f};
        cur = nxt; cA = nA; cB = nB; ++ui;
        if constexpr (ALIGN_EPI) { if (wr == 1) PG8_BAR; }
    }
    PG8_WAIT_V(0);
    if constexpr (!ALIGN_EPI) { if (wr == 0) PG8_BAR; }
    PG8_BAR;
    if constexpr (Epi::AFTER_DRAIN) { E.fused(acc, cur, wr, wc, fr, fq, lds, wid, lane); S.done(cur); }
#undef PG8_SA
#undef PG8_SB
#undef PG8_STAGE
#undef PG8_STAGE_X
#undef PG8_LDA
#undef PG8_LDB
#undef PG8_MMA
#undef PG8_WAIT_V
#undef PG8_WAIT_L
#undef PG8_BAR
#undef PG8_SCHED
}
}
#define GAS __attribute__((address_space(1)))
#define LAS __attribute__((address_space(3)))
typedef unsigned short bf16;
typedef unsigned v4u __attribute__((ext_vector_type(4)));
typedef float f32x4 __attribute__((ext_vector_type(4)));
typedef short bf16x8 __attribute__((ext_vector_type(8)));
typedef GAS unsigned gu32;
typedef GAS unsigned long long gu64;
#define RLX_AGENT __ATOMIC_RELAXED, __HIP_MEMORY_SCOPE_AGENT
#define LDS_WAIT() asm volatile("s_waitcnt lgkmcnt(0)" ::: "memory")
#define VM_WAIT() asm volatile("s_waitcnt vmcnt(0)" ::: "memory")
__device__ __forceinline__ unsigned long long rt() { return __builtin_amdgcn_s_memrealtime(); }
__device__ __forceinline__ unsigned f2bf(float f) { unsigned u = __builtin_bit_cast(unsigned, f); return (u + 0x7fffu + ((u >> 16) & 1u)) >> 16; }
__device__ __forceinline__ unsigned pk2(float lo, float hi) { return f2bf(lo) | (f2bf(hi) << 16); }
#define XB_TMO      128
#define XB_XCNT(j)  (256  + 64 * (j))
#define XB_XSUB(j)  (1280 + 64 * (j))
#define XB_XGEN(j)  (2304 + 64 * (j))
#define XB_TOP      3328
#define XB_TOPGEN   3392
#define XCD_BAR_WORDS 3456
#define XB_SPIN_CAP (1u << 18)

__device__ __forceinline__ unsigned xb_ld(unsigned* p)              { return __hip_atomic_load(p, __ATOMIC_RELAXED, __HIP_MEMORY_SCOPE_AGENT); }
__device__ __forceinline__ unsigned xb_add(unsigned* p, unsigned v) { return __hip_atomic_fetch_add(p, v, __ATOMIC_RELAXED, __HIP_MEMORY_SCOPE_AGENT); }
__device__ __forceinline__ unsigned xb_xcc_id() { return (unsigned)__builtin_amdgcn_s_getreg((3 << 11) | 20) & 0xFu; }
#define XB_SPIN(cond, bar) do { unsigned _sp = 0; while (cond) { __builtin_amdgcn_s_sleep(1); \
    if ((++_sp & 255u) == 0u) { if (xb_ld(&(bar)[XB_TMO])) break; if (_sp > XB_SPIN_CAP) { atomicAdd(&(bar)[XB_TMO], 1u); break; } } } } while (0)

struct XcdBarrier {
    unsigned* bar; unsigned x;
    volatile LAS unsigned* st;
};

__device__ __forceinline__ XcdBarrier xcd_barrier_post(unsigned* bar, volatile LAS unsigned* st) {
    XcdBarrier b; b.bar = bar; b.x = xb_xcc_id(); b.st = st;
    if (threadIdx.x == 0) (void)xb_add(&bar[XB_XCNT(b.x)], 1u);
    return b;
}
__device__ __forceinline__ void xcd_barrier_complete(unsigned* bar, unsigned x, unsigned& nloc, unsigned& nx) {
    const unsigned G = gridDim.x * gridDim.y * gridDim.z;
    unsigned sum, cnt, mine, sp = 0u;
    for (;;) {
        sum = 0u; cnt = 0u; mine = 0u;
#pragma unroll
        for (unsigned j = 0; j < 16; ++j) { const unsigned c = xb_ld(&bar[XB_XCNT(j)]); sum += c; cnt += (c > 0u) ? 1u : 0u; mine = (j == x) ? c : mine; }
        if (sum == G) break;
        __builtin_amdgcn_s_sleep(1);
        if ((++sp & 255u) == 0u) { if (xb_ld(&bar[XB_TMO])) break; if (sp > XB_SPIN_CAP) { atomicAdd(&bar[XB_TMO], 1u); break; } }
    }
    nloc = mine > 0u ? mine : 1u; nx = cnt > 0u ? cnt : 1u;
}

__device__ __forceinline__ void xcd_barrier(const XcdBarrier& b) {
    asm volatile("s_waitcnt vmcnt(0)" ::: "memory");
    __syncthreads();
    if (threadIdx.x == 0) {
        unsigned* bar = b.bar;
        __builtin_amdgcn_s_waitcnt(0);
        unsigned nloc = b.st[0], nx = b.st[1];
        if (nloc == 0u) { xcd_barrier_complete(bar, b.x, nloc, nx); b.st[0] = nloc; b.st[1] = nx; }
        const unsigned old = xb_add(&bar[XB_XSUB(b.x)], 1u);
        const unsigned gen = old / nloc;
        if (old + 1u == (gen + 1u) * nloc) {
            __builtin_amdgcn_fence(__ATOMIC_RELEASE, "agent");
            asm volatile("s_waitcnt vmcnt(0)" ::: "memory");
            const unsigned og = xb_add(&bar[XB_TOP], 1u);
            const unsigned tg = og / nx;
            if (og + 1u == (tg + 1u) * nx) xb_add(&bar[XB_TOPGEN], 1u);
            else XB_SPIN(xb_ld(&bar[XB_TOPGEN]) == tg, bar);
            __builtin_amdgcn_fence(__ATOMIC_ACQUIRE, "agent");
            xb_add(&bar[XB_XGEN(b.x)], 1u);
            asm volatile("s_waitcnt vmcnt(0)" ::: "memory");
        } else {
            XB_SPIN(xb_ld(&bar[XB_XGEN(b.x)]) == gen, bar);
            __builtin_amdgcn_fence(__ATOMIC_ACQUIRE, "agent");
            asm volatile("s_waitcnt vmcnt(0)" ::: "memory");
        }
    }
    __syncthreads();
}
constexpr int NWAVES = 8;
constexpr int D = 2048, SEQ = 8192, MP = 32768, MS = 128, MR = 32896, MT = 33024;
constexpr int DFF = 5632, NA = 5376, NBQ = 2048, NKV = 3072;
constexpr int CQ = 0, CK = 768, CV = 1536, CG = 3072, CQM = 4608, CLR = 5120;
constexpr float DN_ALPHA = 1.6817928305074292f, LN_EPS = 1e-5f, RMS_EPS = 1e-6f;
constexpr float GLA_QSCALE = 0.07216878364870323f, HD_SCALE = 0.08838834764831845f;
constexpr size_t MiB = 1u << 20;
constexpr size_t WS_CTL = 0, CTL_ZERO_BYTES = 1 * MiB;
constexpr size_t WS_WIN = 1 * MiB, WS_WO = 22 * MiB, WS_WFI = 30 * MiB, WS_WFO = 74 * MiB, WS_WMEM = 96 * MiB, WS_MEMX = 112 * MiB, WS_MEMK = 116 * MiB, WS_MEMV = 128 * MiB;
constexpr size_t WS_X = 140 * MiB, WS_Y = 269 * MiB, WS_R1 = 527 * MiB, WS_OCAT = 882 * MiB, WS_SBKS = 1011 * MiB, WS_SBVS = 1060 * MiB, WS_END = 1109 * MiB;
static_assert(WS_WIN + (size_t)NA * D * 2 <= WS_WO && WS_WFI + (size_t)2 * DFF * D * 2 <= WS_WFO && WS_WFO + (size_t)D * DFF * 2 <= WS_WMEM, "weights map");
static_assert(WS_X + (size_t)MT * D * 2 <= WS_Y && WS_Y + (size_t)MT * D * 4 <= WS_R1 && WS_R1 + (size_t)MT * DFF * 2 <= WS_OCAT && WS_OCAT + (size_t)MT * D * 2 <= WS_SBKS, "activation map");
static_assert(WS_SBKS + (size_t)8 * 2064 * 1536 * 2 <= WS_SBVS && WS_SBVS + (size_t)8 * 2064 * 1536 * 2 <= WS_END, "sb sample map");
constexpr size_t O_YP = 0, O_YS = 67108864, O_GSP = 67371008, O_GSS = 69730304, O_SKP = 74448896, O_SVP = 124780544, O_SKS = 175112192, O_SVS = 175308800, O_MKP = 175505408, O_MVP = 177602560, O_END = 179699712;
constexpr int CW_BAR = 4096;
constexpr int RING_OFF = 0, RING_BYTES = 131072, LDSCTL_OFF = RING_BYTES, MISC_OFF = LDSCTL_OFF + 320, LDS_BYTES = 147456;

struct Args { const float* in[22]; float* out_; unsigned char* ws_; int ph_lo, ph_hi; };
struct Frame {
    LAS unsigned char* lds; volatile LAS unsigned* MISC; gu32* ctl;
    int tid, lane, wave, G, gw, NGW;
};
__device__ __forceinline__ float bf2f(bf16 h) { return __builtin_bit_cast(float, (unsigned)h << 16); }
__device__ __forceinline__ float shx(float v, int lane, int m) { return __builtin_bit_cast(float, __builtin_amdgcn_ds_bpermute((lane ^ m) << 2, __builtin_bit_cast(int, v))); }
__device__ __forceinline__ float wave_sum(float v, int lane) {
#pragma unroll
    for (int o = 1; o < 64; o <<= 1) v += shx(v, lane, o);
    return v;
}
__device__ __forceinline__ float wave_max(float v, int lane) {
#pragma unroll
    for (int o = 1; o < 64; o <<= 1) v = fmaxf(v, shx(v, lane, o));
    return v;
}
__device__ __forceinline__ void cvt_row(const float* src, bf16* dst, int n, int lane) {
    for (int j = lane * 4; j < n; j += 256) {
        f32x4 v = src ? *(const f32x4*)(src + j) : (f32x4){0.f, 0.f, 0.f, 0.f};
        unsigned long long w = (unsigned long long)pk2(v.x, v.y) | ((unsigned long long)pk2(v.z, v.w) << 32);
        *(unsigned long long*)(dst + j) = w;
    }
}
template <int N>
__device__ __forceinline__ void cvt_rows2(const float* s0, const float* s1, bf16* d0, bf16* d1, int lane) {
    f32x4 v0[N / 256], v1[N / 256];
#pragma unroll
    for (int j = 0; j < N / 256; ++j) { v0[j] = s0 ? *(const f32x4*)(s0 + lane * 4 + 256 * j) : (f32x4){0.f, 0.f, 0.f, 0.f}; v1[j] = s1 ? *(const f32x4*)(s1 + lane * 4 + 256 * j) : (f32x4){0.f, 0.f, 0.f, 0.f}; }
#pragma unroll
    for (int j = 0; j < N / 256; ++j) {
        *(unsigned long long*)(d0 + lane * 4 + 256 * j) = (unsigned long long)pk2(v0[j].x, v0[j].y) | ((unsigned long long)pk2(v0[j].z, v0[j].w) << 32);
        *(unsigned long long*)(d1 + lane * 4 + 256 * j) = (unsigned long long)pk2(v1[j].x, v1[j].y) | ((unsigned long long)pk2(v1[j].z, v1[j].w) << 32); }
}
__device__ __forceinline__ int fresh_lane() { int z = 0; asm volatile("" : "+s"(z)); return (int)__builtin_amdgcn_mbcnt_hi(~0u, __builtin_amdgcn_mbcnt_lo(~0u, (unsigned)z)); }
#define FRESH_TID() (wave_ * 64 + fresh_lane())
template <bool FINAL>
__device__ __forceinline__ void ln_two_rows(int lane, const v4u (&w)[2][4], const float* gg, const float* bb, bf16* x0, bf16* x1, float* of0, float* of1) {
    float v[2][4][8]; float s[2] = {0.f, 0.f};
#pragma unroll
    for (int r = 0; r < 2; ++r)
#pragma unroll
        for (int j = 0; j < 4; ++j) { const v4u q = w[r][j]; v[r][j][0] = pg8::bflo(q.x); v[r][j][1] = pg8::bfhi(q.x); v[r][j][2] = pg8::bflo(q.y); v[r][j][3] = pg8::bfhi(q.y); v[r][j][4] = pg8::bflo(q.z); v[r][j][5] = pg8::bfhi(q.z); v[r][j][6] = pg8::bflo(q.w); v[r][j][7] = pg8::bfhi(q.w);
            s[r] += ((v[r][j][0] + v[r][j][1]) + (v[r][j][2] + v[r][j][3])) + ((v[r][j][4] + v[r][j][5]) + (v[r][j][6] + v[r][j][7])); }
    const float m0 = wave_sum(s[0], lane) * (1.f / D), m1 = wave_sum(s[1], lane) * (1.f / D); float q0 = 0.f, q1 = 0.f;
#pragma unroll
    for (int j = 0; j < 4; ++j)
#pragma unroll
        for (int i = 0; i < 8; ++i) { v[0][j][i] -= m0; q0 += v[0][j][i] * v[0][j][i]; v[1][j][i] -= m1; q1 += v[1][j][i] * v[1][j][i]; }
    const float rs[2] = {1.f / sqrtf(wave_sum(q0, lane) * (1.f / D) + LN_EPS), 1.f / sqrtf(wave_sum(q1, lane) * (1.f / D) + LN_EPS)};
#pragma unroll
    for (int j = 0; j < 4; ++j) { const int e0 = (lane + 64 * j) * 8; const f32x4 g0 = *(const f32x4*)(gg + e0), g1 = *(const f32x4*)(gg + e0 + 4), b0 = *(const f32x4*)(bb + e0), b1 = *(const f32x4*)(bb + e0 + 4);
#pragma unroll
        for (int r = 0; r < 2; ++r) { float o[8];
#pragma unroll
            for (int i = 0; i < 4; ++i) { o[i] = v[r][j][i] * rs[r] * g0[i] + b0[i]; o[4 + i] = v[r][j][4 + i] * rs[r] * g1[i] + b1[i]; }
            if (FINAL) { float* of = r ? of1 : of0; *(f32x4*)(of + e0) = (f32x4){o[0], o[1], o[2], o[3]}; *(f32x4*)(of + e0 + 4) = (f32x4){o[4], o[5], o[6], o[7]}; }
            else { v4u p; p.x = pk2(o[0], o[1]); p.y = pk2(o[2], o[3]); p.z = pk2(o[4], o[5]); p.w = pk2(o[6], o[7]); *(v4u*)((r ? x1 : x0) + e0) = p; } } }
}
template <bool FINAL, class OutF>
__device__ __forceinline__ void ln_rows(int lane, int gw, int NGW, const bf16* YBp, const float* gg, const float* bb, bf16* Xp, OutF outf) {
    const bool has_ex = gw < MR - MP; const int exrow = MP + gw; v4u ex[2][4];
    if (has_ex) {
#pragma unroll
        for (int j = 0; j < 4; ++j) ex[0][j] = ((const v4u*)(YBp + (size_t)exrow * D))[lane + 64 * j]; }
    __builtin_amdgcn_sched_barrier(0);
#pragma unroll 1
    for (int row = 2 * gw; row < MP; row += 2 * NGW) { v4u w[2][4];
#pragma unroll
        for (int j = 0; j < 4; ++j) { w[0][j] = ((const v4u*)(YBp + (size_t)row * D))[lane + 64 * j]; w[1][j] = ((const v4u*)(YBp + (size_t)(row + 1) * D))[lane + 64 * j]; }
        if (FINAL) { float* of = outf(row); ln_two_rows<true>(lane, w, gg, bb, nullptr, nullptr, of, of + D); }
        else ln_two_rows<false>(lane, w, gg, bb, Xp + (size_t)row * D, Xp + (size_t)(row + 1) * D, nullptr, nullptr); }
    if (has_ex) {
#pragma unroll
        for (int j = 0; j < 4; ++j) ex[1][j] = ex[0][j];
        if (FINAL) { float* of = outf(exrow); ln_two_rows<true>(lane, ex, gg, bb, nullptr, nullptr, of, of); }
        else ln_two_rows<false>(lane, ex, gg, bb, Xp + (size_t)exrow * D, Xp + (size_t)exrow * D, nullptr, nullptr); }
}
struct MapId { __device__ __forceinline__ int operator()(int n) const { return n; } };
struct MapInA { __device__ __forceinline__ int operator()(int n) const { return n < 4608 ? n : (n < 5120 ? n + 16 : (n < 5136 ? n - 512 : -1)); } };
struct MapFfn { __device__ __forceinline__ int operator()(int n) const { const int t = n >> 8, r = n & 255; return r < 128 ? 128 * t + r : DFF + 128 * t + (r - 128); } };
template <class Map>
__device__ __forceinline__ void wt_convert(LAS unsigned char* ldsb, int wave, int gw, int NGW, int lane, const float* W, int K, int Nsrc, bf16* WT, int Ndst, Map map) {
    LAS float* scr = (LAS float*)(ldsb + RING_OFF + wave * 16384);
    const int nblk = Ndst / 64, nitems = (K / 64) * nblk, nq = lane & 15, kq = lane >> 4;
    for (int it = gw; it < nitems; it += NGW) {
        const int kb = it / nblk, nb = it % nblk, k0 = 64 * kb, n0 = 64 * nb;
        const int sc0 = map(n0 + 4 * nq), sc3 = map(n0 + 4 * nq + 3);
        const bool contig = sc0 >= 0 && sc3 == sc0 + 3;
        f32x4 v[16];
#pragma unroll
        for (int i = 0; i < 16; ++i) { const int kk = 4 * i + kq;
            if (contig) v[i] = *(const f32x4*)(W + (size_t)(k0 + kk) * Nsrc + sc0);
            else {
#pragma unroll
                for (int e = 0; e < 4; ++e) { const int sc = map(n0 + 4 * nq + e); v[i][e] = sc >= 0 ? W[(size_t)(k0 + kk) * Nsrc + sc] : 0.f; } } }
#pragma unroll
        for (int i = 0; i < 16; ++i) { const int kk = 4 * i + kq;
#pragma unroll
            for (int e = 0; e < 4; ++e) { const int n = 4 * nq + e; scr[n * 64 + (kk ^ n)] = v[i][e]; } }
        LDS_WAIT(); asm volatile("" ::: "memory");
        const int c = lane & 7;
#pragma unroll
        for (int j = 0; j < 8; ++j) { const int n = (lane >> 3) + 8 * j; const LAS float* s = scr + n * 64;
#define SWZ(i) s[(8 * c + (i)) ^ n]
            v4u o; o.x = pk2(SWZ(0), SWZ(1)); o.y = pk2(SWZ(2), SWZ(3)); o.z = pk2(SWZ(4), SWZ(5)); o.w = pk2(SWZ(6), SWZ(7));
#undef SWZ
            *(GAS v4u*)(WT + (size_t)(n0 + n) * K + k0 + 8 * c) = o; }
        LDS_WAIT(); asm volatile("" ::: "memory");
    }
}
__device__ __forceinline__ float softplus_f(float z) { return fmaxf(z, 0.f) + log1pf(__expf(-fabsf(z))); }

typedef short s16x4 __attribute__((ext_vector_type(4)));
typedef pg8::u32x2 u32x2;
typedef float f32x16 __attribute__((ext_vector_type(16)));
typedef __bf16 bf16x2_t __attribute__((ext_vector_type(2)));
typedef float f32x2_t __attribute__((ext_vector_type(2)));
__device__ __forceinline__ unsigned cvt2(float lo, float hi) { const f32x2_t v = {lo, hi}; const bf16x2_t b = __builtin_convertvector(v, bf16x2_t); return __builtin_bit_cast(unsigned, b); }
__device__ __forceinline__ bf16x8 pack8(const f32x4 a, const f32x4 b) { v4u p; p.x = cvt2(a[0], a[1]); p.y = cvt2(a[2], a[3]); p.z = cvt2(b[0], b[1]); p.w = cvt2(b[2], b[3]); return __builtin_bit_cast(bf16x8, p); }
__device__ __forceinline__ bf16x8 ld2x8(const bf16* p0, const bf16* p1) { const s16x4 a = *(const s16x4*)p0, b = *(const s16x4*)p1; return __builtin_shufflevector(a, b, 0, 1, 2, 3, 4, 5, 6, 7); }
__device__ __forceinline__ bf16x8 ld16(const bf16* p) { return *(const bf16x8*)p; }
#define MFMA16(a, b, c) __builtin_amdgcn_mfma_f32_16x16x32_bf16((a), (b), (c), 0, 0, 0)
#define MFMA32(a, b, c) __builtin_amdgcn_mfma_f32_32x32x16_bf16((a), (b), (c), 0, 0, 0)

constexpr int QIMG_LD = 200, KTIMG_LD = 68, PKG_Q = 0, PKG_KT = 25600, PKG_G = 51712, IMG_BYTES = 52480, PKG_K = 52480, PKG_VT = 77056, PKG_BYTES = 126208, N_PKG = 2048 + 32;
static_assert(64 * QIMG_LD * 2 == PKG_KT && PKG_KT + 192 * KTIMG_LD * 2 == PKG_G && PKG_G + 768 == IMG_BYTES && PKG_K + 24576 == PKG_VT && PKG_VT + 49152 == PKG_BYTES && IMG_BYTES % 16 == 0, "package map");

__device__ __forceinline__ float softplus_fast(float z) { return fmaxf(z, 0.f) + __logf(1.0f + __expf(-fabsf(z))); }
constexpr int GL_TOT = 0, GL_Q = 6144, GL_K = GL_Q + 64 * QIMG_LD * 2, GL_V = GL_K + 64 * QIMG_LD * 2, VL_LD = 68, GL_P = GL_V + 384 * VL_LD * 2, P_LD = 68, GL_LRN = GL_P + 64 * P_LD * 2, GL_END = GL_LRN + 2048;
static_assert(GL_END <= RING_BYTES && GL_Q % 16 == 0 && GL_K % 16 == 0 && GL_V % 8 == 0 && GL_P % 8 == 0 && GL_LRN % 16 == 0 && MISC_OFF + 256 + 17 * 192 * 4 <= LDS_BYTES, "gla_prep_intra LDS map");
template <int MODE>
__device__ __forceinline__ void gla_prep_intra(int bid, int G, int tid, int wave, LAS unsigned char* lds, int l, const bf16* PROJ, const float* w_gate_lr, const float* b_gate, unsigned char* PKG, bf16* OINT) {
    const int lane = tid & 63, fr = lane & 15, fq = lane >> 4;
    const float* w2 = w_gate_lr + (size_t)l * 16 * 768; const float* bg = b_gate + (size_t)l * 768;
    LAS float* tot = (LAS float*)(lds + GL_TOT);
    LAS bf16* QL = (LAS bf16*)(lds + GL_Q); LAS bf16* KL = (LAS bf16*)(lds + GL_K); LAS bf16* VL = (LAS bf16*)(lds + GL_V); LAS bf16* P = (LAS bf16*)(lds + GL_P);
    LAS unsigned char* LRN = lds + GL_LRN;
    auto item_of = [&](int j) -> int {
        if (MODE == 1) return j < 8 ? ((((j >> 1) << 2) | (bid & 3)) << 7) | ((bid >> 2) + 64 * (j & 1)) : -1;
        if (MODE == 2) return j == 0 ? 2048 + bid : -1;
        const int it = bid + j * G; return it < N_PKG ? it : -1; };
    auto lr_dma = [&](int item) {
        if (wave < 2) { int row0, T; if (item < 2048) { row0 = ((item >> 7) >> 2) * SEQ + (item & 127) * 64; T = 64; } else { row0 = MP + ((item - 2048) >> 2) * 16; T = 16; }
            const int t = 32 * wave + (lane >> 1); const bf16* prow = PROJ + (size_t)(row0 + (t < T ? t : T - 1)) * NA + CLR + 8 * (lane & 1);
            __builtin_amdgcn_global_load_lds((const unsigned*)prow, (LAS unsigned*)(LRN + wave * 1024), 16, 0, 0); } };
    LAS float* W2L = (LAS float*)(lds + MISC_OFF + 256);
    int cur_h = -1;
    { const int i0 = item_of(0); if (i0 >= 0) lr_dma(i0); asm volatile("s_waitcnt vmcnt(0)" ::: "memory"); __syncthreads(); }
    for (int j = 0;; ++j) {
        const int item = item_of(j); if (item < 0) break;
        int h, row0, T;
        if (item < 2048) { const int bh = item >> 7, ch = item & 127; h = bh & 3; row0 = (bh >> 2) * SEQ + ch * 64; T = 64; }
        else { const int i2 = item - 2048; h = i2 & 3; row0 = MP + (i2 >> 2) * 16; T = 16; }
        unsigned char* pk = PKG + (size_t)item * PKG_BYTES;
        bf16* Qt = (bf16*)(pk + PKG_Q); bf16* KT = (bf16*)(pk + PKG_KT); bf16* VT = (bf16*)(pk + PKG_VT); float* Gp = (float*)(pk + PKG_G);
        if (h != cur_h) {
            if (cur_h >= 0) __syncthreads();
            cur_h = h;
            for (int i = tid; i < 17 * 192; i += 512) { const int r = i / 192, d = i - r * 192; W2L[i] = r < 16 ? w2[r * 768 + h * 192 + d] : bg[h * 192 + d]; }
            __syncthreads(); }
        float w2c[3][16], bgc[3];
#pragma unroll
        for (int c = 0; c < 3; ++c) { bgc[c] = W2L[16 * 192 + lane + 64 * c];
#pragma unroll
            for (int r = 0; r < 16; ++r) w2c[c][r] = W2L[r * 192 + lane + 64 * c]; }
        unsigned qv[8][3], kv[8][3];
#pragma unroll
        for (int tt = 0; tt < 8; ++tt) { const int t = 8 * wave + tt; const bf16* prow = PROJ + (size_t)(row0 + (t < T ? t : T - 1)) * NA + h * 192 + lane;
#pragma unroll
            for (int c = 0; c < 3; ++c) { qv[tt][c] = prow[CQ + 64 * c]; kv[tt][c] = prow[CK + 64 * c]; } }
        __builtin_amdgcn_sched_barrier(0);
        v4u l0[8], l1[8];
#pragma unroll
        for (int tt = 0; tt < 8; ++tt) { const LAS unsigned char* lp = LRN + (8 * wave + tt) * 32; l0[tt] = *(const LAS v4u*)lp; l1[tt] = *(const LAS v4u*)(lp + 16); }
        float lc[8][3]; float run[3] = {0.f, 0.f, 0.f};
#pragma unroll
        for (int tt = 0; tt < 8; ++tt) { const bool ok = 8 * wave + tt < T;
            float lr[16]; lr[0] = pg8::bflo(l0[tt].x); lr[1] = pg8::bfhi(l0[tt].x); lr[2] = pg8::bflo(l0[tt].y); lr[3] = pg8::bfhi(l0[tt].y); lr[4] = pg8::bflo(l0[tt].z); lr[5] = pg8::bfhi(l0[tt].z); lr[6] = pg8::bflo(l0[tt].w); lr[7] = pg8::bfhi(l0[tt].w);
            lr[8] = pg8::bflo(l1[tt].x); lr[9] = pg8::bfhi(l1[tt].x); lr[10] = pg8::bflo(l1[tt].y); lr[11] = pg8::bfhi(l1[tt].y); lr[12] = pg8::bflo(l1[tt].z); lr[13] = pg8::bfhi(l1[tt].z); lr[14] = pg8::bflo(l1[tt].w); lr[15] = pg8::bfhi(l1[tt].w);
#pragma unroll
            for (int c = 0; c < 3; ++c) { float xg = bgc[c];
#pragma unroll
                for (int r = 0; r < 16; ++r) xg += lr[r] * w2c[c][r];
                run[c] += ok ? -softplus_fast(-xg) * (1.0f / 16.0f) : 0.f; lc[tt][c] = run[c]; } }
#pragma unroll
        for (int c = 0; c < 3; ++c) tot[wave * 192 + lane + 64 * c] = run[c];
        __syncthreads();
        unsigned vv[6][8];
#pragma unroll
        for (int tt = 0; tt < 8; ++tt) { const int t = 8 * wave + tt; const bf16* prow = PROJ + (size_t)(row0 + (t < T ? t : T - 1)) * NA + CV + h * 384 + lane;
#pragma unroll
            for (int c2 = 0; c2 < 6; ++c2) vv[c2][tt] = prow[64 * c2]; }
        __builtin_amdgcn_sched_barrier(0);
        float pre[3], all[3];
#pragma unroll
        for (int c = 0; c < 3; ++c) { pre[c] = 0.f; all[c] = 0.f;
#pragma unroll
            for (int w = 0; w < 8; ++w) { const float tv = tot[w * 192 + lane + 64 * c]; all[c] += tv; if (w < wave) pre[c] += tv; } }
        unsigned ktw[3][4];
#pragma unroll
        for (int tt = 0; tt < 8; ++tt) { const int t = 8 * wave + tt; const bool ok = t < T;
#pragma unroll
            for (int c = 0; c < 3; ++c) { const int dl = lane + 64 * c; const float bc = pre[c] + lc[tt][c]; const float eq = __expf(bc), ek = __expf(-bc);
                const unsigned qb = ok ? f2bf(bf2f((bf16)qv[tt][c]) * GLA_QSCALE * eq) : 0u, kb = ok ? f2bf(bf2f((bf16)kv[tt][c]) * ek) : 0u;
                Qt[t * QIMG_LD + dl] = (bf16)qb; QL[t * QIMG_LD + dl] = (bf16)qb; KL[t * QIMG_LD + dl] = (bf16)kb;
                if (tt & 1) ktw[c][tt >> 1] |= kb << 16; else ktw[c][tt >> 1] = kb; } }
#pragma unroll
        for (int c = 0; c < 3; ++c) { bf16* kp = KT + (size_t)(lane + 64 * c) * KTIMG_LD + 8 * wave; u32x2 o0, o1; o0.x = ktw[c][0]; o0.y = ktw[c][1]; o1.x = ktw[c][2]; o1.y = ktw[c][3]; *(u32x2*)kp = o0; *(u32x2*)(kp + 4) = o1; }
        if (wave == 0) {
#pragma unroll
            for (int c = 0; c < 3; ++c) Gp[lane + 64 * c] = __expf(all[c]); }
#pragma unroll
        for (int c2 = 0; c2 < 6; ++c2) { const bool ok0 = 8 * wave < T;
            u32x2 o0, o1; o0.x = ok0 ? vv[c2][0] | (vv[c2][1] << 16) : 0u; o0.y = ok0 ? vv[c2][2] | (vv[c2][3] << 16) : 0u; o1.x = ok0 ? vv[c2][4] | (vv[c2][5] << 16) : 0u; o1.y = ok0 ? vv[c2][6] | (vv[c2][7] << 16) : 0u;
            v4u o; o.x = o0.x; o.y = o0.y; o.z = o1.x; o.w = o1.y; *(v4u*)(VT + (size_t)(lane + 64 * c2) * 64 + 8 * wave) = o;
            LAS bf16* vl = VL + (lane + 64 * c2) * VL_LD + 8 * wave; *(LAS u32x2*)vl = o0; *(LAS u32x2*)(vl + 4) = o1; }
        __syncthreads();
        { const int nx = item_of(j + 1); if (nx >= 0) lr_dma(nx); }
        const int nvalid = T;
        bf16x8 va[3], vb[3];
#pragma unroll
        for (int k = 0; k < 3; ++k) { const LAS bf16* vr = VL + (16 * (3 * wave + k) + fr) * VL_LD + 4 * fq;
            const s16x4 x0 = *(const LAS s16x4*)vr, x1 = *(const LAS s16x4*)(vr + 16), x2 = *(const LAS s16x4*)(vr + 32), x3 = *(const LAS s16x4*)(vr + 48);
            va[k] = __builtin_shufflevector(x0, x1, 0, 1, 2, 3, 4, 5, 6, 7); vb[k] = __builtin_shufflevector(x2, x3, 0, 1, 2, 3, 4, 5, 6, 7); }
#pragma unroll
        for (int rep = 0; rep < 2; ++rep) {
            const int tl = wave + 8 * rep;
            if (tl < 10) {
                const int it = tl < 1 ? 0 : (tl < 3 ? 1 : (tl < 6 ? 2 : 3)), jt = tl - (it * (it + 1)) / 2;
                f32x4 at = {0.f, 0.f, 0.f, 0.f};
                const LAS bf16* qr = QL + (16 * it + fr) * QIMG_LD + 8 * fq; const LAS bf16* kr = KL + (16 * jt + fr) * QIMG_LD + 8 * fq;
#pragma unroll
                for (int s = 0; s < 6; ++s) at = MFMA16(*(const LAS bf16x8*)(kr + 32 * s), *(const LAS bf16x8*)(qr + 32 * s), at);
                if (it == jt) {
#pragma unroll
                    for (int jj = 0; jj < 4; ++jj) if (4 * fq + jj > fr) at[jj] = 0.f; }
                u32x2 w; w.x = cvt2(at[0], at[1]); w.y = cvt2(at[2], at[3]);
                *(LAS u32x2*)(P + (16 * it + fr) * P_LD + 16 * jt + 4 * fq) = w;
            } else if (tl == 10 || tl == 11) {
                const int it = tl == 10 ? 0 : 2, jt = tl == 10 ? 1 : 3; unsigned zz = 0u; asm volatile("" : "+v"(zz)); u32x2 z; z.x = zz; z.y = zz;
                *(LAS u32x2*)(P + (16 * it + fr) * P_LD + 16 * jt + 4 * fq) = z;
            }
        }
        if (wave < 2) asm volatile("s_waitcnt vmcnt(0)" ::: "memory");
        __syncthreads();
#pragma unroll
        for (int it = 0; it < 4; ++it) {
            if (16 * it >= nvalid) break;
            const LAS bf16* pr = P + (16 * it + fr) * P_LD + 4 * fq;
            const s16x4 a0 = *(const LAS s16x4*)pr, a1 = *(const LAS s16x4*)(pr + 16);
            const bf16x8 pf0 = __builtin_shufflevector(a0, a1, 0, 1, 2, 3, 4, 5, 6, 7); bf16x8 pf1 = pf0;
            if (it >= 2) { const s16x4 b0 = *(const LAS s16x4*)(pr + 32), b1 = *(const LAS s16x4*)(pr + 48); pf1 = __builtin_shufflevector(b0, b1, 0, 1, 2, 3, 4, 5, 6, 7); }
#pragma unroll
            for (int k = 0; k < 3; ++k) { f32x4 o = {0.f, 0.f, 0.f, 0.f};
                o = MFMA16(va[k], pf0, o); if (it >= 2) o = MFMA16(vb[k], pf1, o);
                u32x2 ow; ow.x = cvt2(o[0], o[1]); ow.y = cvt2(o[2], o[3]); *(u32x2*)(OINT + (size_t)(row0 + 16 * it + fr) * 1536 + h * 384 + 16 * (3 * wave + k) + 4 * fq) = ow; }
        }
    }
}

__device__ __forceinline__ f32x4 ld_o4(const bf16* p) { const u32x2 w = *(const u32x2*)p; return (f32x4){pg8::bflo(w.x), pg8::bfhi(w.x), pg8::bflo(w.y), pg8::bfhi(w.y)}; }
template <int PASS>
__device__ __forceinline__ void gla_chain(int wc, int tid, int wave, LAS unsigned char* lds, int l, const unsigned char* PKG, const float* state_gla, bf16* OINT, float* out, float* SLOC, float* GSEG, bool dry = false) {
    const int lane = tid & 63, fr = lane & 15, fq = lane >> 4;
    int h, vb, bh, seg, item0, nsteps, row0, nvalid; const float* s0 = nullptr; float* sout = nullptr;
    if (PASS == 1) { bh = wc / 9; const int rem = wc % 9; vb = rem / 3; seg = rem % 3; h = bh & 3; item0 = bh * 128 + 32 * seg; nsteps = 32; row0 = 0; nvalid = 64; }
    else if (wc < 192) { bh = wc / 12; const int rem = wc % 12; vb = rem >> 2; seg = rem & 3; h = bh & 3; item0 = bh * 128 + 32 * seg; nsteps = 32; row0 = (bh >> 2) * SEQ + 2048 * seg; nvalid = 64;
        if (seg == 3) sout = out + O_GSP + (size_t)(l * 16 + bh) * 192 * 384; }
    else { const int c2 = wc - 192; bh = c2 / 3; vb = c2 % 3; seg = 0; h = bh & 3; item0 = 2048 + bh; nsteps = 1; row0 = MP + (bh >> 2) * 16; nvalid = 16; s0 = state_gla + (size_t)(l * 32 + bh) * 192 * 384; sout = out + O_GSS + (size_t)(l * 32 + bh) * 192 * 384; }
    const int v0 = vb * 128 + wave * 16;
#define GLA_WALK(p, step) do { (p) += (step); asm volatile("" : "+v"(p)); } while (0)
    f32x4 S[12];
    if (s0) { const float* p = s0 + (size_t)(4 * fq) * 384 + v0 + fr;
#pragma unroll
        for (int t = 0; t < 12; ++t) {
#pragma unroll
            for (int jj = 0; jj < 4; ++jj) { S[t][jj] = *p; GLA_WALK(p, 384); }
            GLA_WALK(p, 12 * 384); } }
    else {
#pragma unroll
        for (int t = 0; t < 12; ++t) S[t] = (f32x4){0.f, 0.f, 0.f, 0.f}; }
    if (PASS == 2 && wc < 192) {
        for (int j = 0; j < seg; ++j) { const float* gs = GSEG + (size_t)(bh * 3 + j) * 192 + 4 * fq; const float* p = SLOC + (size_t)((bh * 3 + vb) * 3 + j) * 192 * 128 + (size_t)(4 * fq) * 128 + wave * 16 + fr;
#pragma unroll
            for (int t = 0; t < 12; ++t) { const f32x4 g4 = *(const f32x4*)(gs + 16 * t);
#pragma unroll
                for (int jj = 0; jj < 4; ++jj) { S[t][jj] = g4[jj] * S[t][jj] + *p; GLA_WALK(p, 128); }
                GLA_WALK(p, 12 * 128); } }
    }
    f32x4 GP[PASS == 1 ? 12 : 1];
    if (PASS == 1) {
#pragma unroll
        for (int t = 0; t < 12; ++t) GP[t] = (f32x4){1.f, 1.f, 1.f, 1.f}; }
    constexpr int CH0 = PASS == 1 ? PKG_KT / 16 : 0, NCH = IMG_BYTES / 16, NLD = PASS == 1 ? 4 : 7;
    v4u pre[NLD]; bf16x8 vt[2], vtn[2]; f32x4 oin[4];
    { const unsigned char* pk = PKG + (size_t)item0 * PKG_BYTES;
      if (PASS == 2) {
#pragma unroll
        for (int it = 0; it < 4; ++it) { const int tl = 16 * it + fr; oin[it] = tl < nvalid ? ld_o4(OINT + (size_t)(row0 + tl) * 1536 + h * 384 + v0 + 4 * fq) : (f32x4){0.f, 0.f, 0.f, 0.f}; } }
#pragma unroll
      for (int k = 0; k < NLD; ++k) { const int ch = CH0 + tid + 512 * k; if (ch < NCH) pre[k] = *(const v4u*)(pk + (size_t)ch * 16); }
      const bf16* VT = (const bf16*)(pk + PKG_VT) + (size_t)(v0 + fr) * 64 + 4 * fq; vt[0] = ld2x8(VT, VT + 16); vt[1] = ld2x8(VT + 32, VT + 48);
#pragma unroll
      for (int k = 0; k < NLD; ++k) { const int ch = CH0 + tid + 512 * k; if (ch < NCH) *(LAS v4u*)(lds + (size_t)ch * 16) = pre[k]; }
      vtn[0] = vt[0]; vtn[1] = vt[1]; }
    __syncthreads();
    for (int n = 0; n < nsteps; ++n) {
        const LAS unsigned char* img = lds + (n & 1) * IMG_BYTES;
        const bool more = n + 1 < nsteps;
        if (more) { const unsigned char* pk = PKG + (size_t)(item0 + n + 1) * PKG_BYTES;
#pragma unroll
            for (int k = 0; k < NLD; ++k) { const int ch = CH0 + tid + 512 * k; if (ch < NCH) pre[k] = *(const v4u*)(pk + (size_t)ch * 16); }
            const bf16* VT = (const bf16*)(pk + PKG_VT) + (size_t)(v0 + fr) * 64 + 4 * fq; vtn[0] = ld2x8(VT, VT + 16); vtn[1] = ld2x8(VT + 32, VT + 48); }
        if (PASS == 2) {
            bf16x8 Sb[6];
#pragma unroll
            for (int s = 0; s < 6; ++s) Sb[s] = pack8(S[2 * s], S[2 * s + 1]);
#pragma unroll
            for (int it = 0; it < 4; ++it) {
                const LAS bf16* qr = (const LAS bf16*)(img + PKG_Q) + (16 * it + fr) * QIMG_LD + 4 * fq;
                f32x4 o = oin[it];
#pragma unroll
                for (int s = 0; s < 6; ++s) { const s16x4 a = *(const LAS s16x4*)(qr + 32 * s), b = *(const LAS s16x4*)(qr + 32 * s + 16);
                    o = MFMA16(Sb[s], __builtin_shufflevector(a, b, 0, 1, 2, 3, 4, 5, 6, 7), o); }
                const int tl = 16 * it + fr;
                if (tl < nvalid && !dry) { u32x2 ow; ow.x = cvt2(o[0], o[1]); ow.y = cvt2(o[2], o[3]); *(u32x2*)(OINT + (size_t)(row0 + 64 * n + tl) * 1536 + h * 384 + v0 + 4 * fq) = ow; }
                __builtin_amdgcn_sched_barrier(0);
            }
            if (more) {
#pragma unroll
                for (int it = 0; it < 4; ++it) oin[it] = ld_o4(OINT + (size_t)(row0 + 64 * (n + 1) + 16 * it + fr) * 1536 + h * 384 + v0 + 4 * fq); }
        }
#pragma unroll
        for (int t = 0; t < 12; ++t) { const LAS bf16* kr = (const LAS bf16*)(img + PKG_KT) + (16 * t + fr) * KTIMG_LD + 4 * fq;
#pragma unroll
            for (int s2 = 0; s2 < 2; ++s2) { const s16x4 a = *(const LAS s16x4*)(kr + 32 * s2), b = *(const LAS s16x4*)(kr + 32 * s2 + 16);
                S[t] = MFMA16(__builtin_shufflevector(a, b, 0, 1, 2, 3, 4, 5, 6, 7), vt[s2], S[t]); }
            const f32x4 g4 = *(const LAS f32x4*)(img + PKG_G + (16 * t + 4 * fq) * 4);
            S[t] = S[t] * g4; if (PASS == 1) GP[t] = GP[t] * g4; if ((t & 3) == 3) __builtin_amdgcn_sched_barrier(0); }
        if (more) { LAS unsigned char* nimg = lds + ((n + 1) & 1) * IMG_BYTES;
#pragma unroll
            for (int k = 0; k < NLD; ++k) { const int ch = CH0 + tid + 512 * k; if (ch < NCH) *(LAS v4u*)(nimg + (size_t)ch * 16) = pre[k]; }
            vt[0] = vtn[0]; vt[1] = vtn[1]; }
        asm volatile("s_waitcnt lgkmcnt(0)" ::: "memory"); __builtin_amdgcn_s_barrier(); asm volatile("" ::: "memory");
    }
    if (PASS == 1) {
        float* p = SLOC + (size_t)((bh * 3 + vb) * 3 + seg) * 192 * 128 + (size_t)(4 * fq) * 128 + wave * 16 + fr;
#pragma unroll
        for (int t = 0; t < 12; ++t) {
#pragma unroll
            for (int jj = 0; jj < 4; ++jj) { *p = S[t][jj]; GLA_WALK(p, 128); }
            GLA_WALK(p, 12 * 128); }
        if (vb == 0 && wave == 0 && fr == 0) { float* gs = GSEG + (size_t)(bh * 3 + seg) * 192;
#pragma unroll
            for (int t = 0; t < 12; ++t) *(f32x4*)(gs + 16 * t + 4 * fq) = GP[t]; }
    } else if (sout) {
        float* p = sout + (size_t)(4 * fq) * 384 + v0 + fr;
#pragma unroll
        for (int t = 0; t < 12; ++t) {
#pragma unroll
            for (int jj = 0; jj < 4; ++jj) { *p = S[t][jj]; GLA_WALK(p, 384); }
            GLA_WALK(p, 12 * 384); }
    }
#undef GLA_WALK
}

__device__ __forceinline__ void mem_attn(int item, int lane, int l, const bf16* PROJ, int ldp, int cqm, const bf16* MEMK, const bf16* MEMVT, bf16* OCAT) {
    const int fr = lane & 15, fq = lane >> 4, tile = item >> 2, h = item & 3, r0 = tile * 16;
    const int bb = r0 < MP ? r0 / SEQ : 4 + ((r0 - MP) >> 4);
    const bf16* Kb = MEMK + (size_t)((l * 12 + bb) * 256) * 512 + h * 128; const bf16* Vt = MEMVT + (size_t)(((l * 12 + bb) * 4 + h) * 128) * 256;
    bf16x8 qf[4];
#pragma unroll
    for (int s = 0; s < 4; ++s) qf[s] = ld16(PROJ + (size_t)(r0 + fr) * ldp + cqm + h * 128 + 32 * s + 8 * fq);
    f32x4 st[16];
#pragma unroll
    for (int mt = 0; mt < 16; ++mt) { st[mt] = (f32x4){0.f, 0.f, 0.f, 0.f}; const bf16* kr = Kb + (size_t)(16 * mt + fr) * 512 + 8 * fq;
#pragma unroll
        for (int s = 0; s < 4; ++s) st[mt] = MFMA16(ld16(kr + 32 * s), qf[s], st[mt]); }
    float mx = -3.0e38f;
#pragma unroll
    for (int mt = 0; mt < 16; ++mt) mx = fmaxf(mx, fmaxf(fmaxf(st[mt][0], st[mt][1]), fmaxf(st[mt][2], st[mt][3])));
    mx = fmaxf(mx, shx(mx, lane, 16)); mx = fmaxf(mx, shx(mx, lane, 32));
    float sum = 0.f;
#pragma unroll
    for (int mt = 0; mt < 16; ++mt)
#pragma unroll
        for (int jj = 0; jj < 4; ++jj) { const float p = __expf((st[mt][jj] - mx) * HD_SCALE); st[mt][jj] = p; sum += p; }
    sum += shx(sum, lane, 16); sum += shx(sum, lane, 32);
    const float inv = 1.0f / sum;
    bf16x8 pf[8];
#pragma unroll
    for (int s = 0; s < 8; ++s) pf[s] = pack8(st[2 * s], st[2 * s + 1]);
#pragma unroll
    for (int dt = 0; dt < 8; ++dt) { f32x4 o = {0.f, 0.f, 0.f, 0.f}; const bf16* vr = Vt + (size_t)(16 * dt + fr) * 256 + 4 * fq;
#pragma unroll
        for (int s = 0; s < 8; ++s) o = MFMA16(ld2x8(vr + 32 * s, vr + 32 * s + 16), pf[s], o);
        u32x2 w; w.x = cvt2(o[0] * inv, o[1] * inv); w.y = cvt2(o[2] * inv, o[3] * inv);
        *(u32x2*)(OCAT + (size_t)(r0 + fr) * D + 1536 + h * 128 + 16 * dt + 4 * fq) = w; }
}

__device__ __forceinline__ void mem_attn_wg(int wi, int tid, int wave, LAS unsigned char* lds, int l, const bf16* PROJ, int ldp, int cqm, const bf16* MEMK, const bf16* MEMVT, bf16* OCAT) {
    const bool smp = wi >= 256; const int lane = tid & 63, fr = lane & 15, fq = lane >> 4, bh = smp ? (wi - 256) : (wi >> 4), sub = wi & 15, b = smp ? 4 + (bh >> 2) : (bh >> 2), h = bh & 3;
    const bf16* Kb = MEMK + (size_t)((l * 12 + b) * 256) * 512 + h * 128; const bf16* Vt = MEMVT + (size_t)(((l * 12 + b) * 4 + h) * 128) * 256;
#pragma unroll
    for (int k = 0; k < 8; ++k) { const int idx = tid + 512 * k, row = idx >> 4, c = idx & 15; *(LAS v4u*)(lds + row * 256 + ((c ^ (row & 15)) << 4)) = *(const v4u*)(Kb + (size_t)row * 512 + c * 8); }
#pragma unroll
    for (int k = 0; k < 8; ++k) { const int idx = tid + 512 * k, row = idx >> 5, c = idx & 31; *(LAS v4u*)(lds + 65536 + row * 512 + ((c ^ (2 * (row & 15))) << 4)) = *(const v4u*)(Vt + (size_t)row * 256 + c * 8); }
    __syncthreads();
    unsigned koff[4], voff[16];
#pragma unroll
    for (int s2 = 0; s2 < 4; ++s2) { koff[s2] = (unsigned)(fr * 256 + (((4 * s2 + fq) ^ fr) << 4)); asm volatile("" : "+v"(koff[s2])); }
#pragma unroll
    for (int s2 = 0; s2 < 8; ++s2) { const int p0 = 8 * s2 + fq, p1 = p0 + 4;
        voff[2 * s2] = (unsigned)(65536 + fr * 512 + ((((p0 >> 1) ^ (2 * fr)) << 4) | ((p0 & 1) << 3))); voff[2 * s2 + 1] = (unsigned)(65536 + fr * 512 + ((((p1 >> 1) ^ (2 * fr)) << 4) | ((p1 & 1) << 3)));
        asm volatile("" : "+v"(voff[2 * s2]), "+v"(voff[2 * s2 + 1])); }
    const int nblk = smp ? (wave == 0 ? 1 : 0) : 4;
#pragma unroll 1
    for (int blk = 0; blk < nblk; ++blk) {
        const int r0 = smp ? MP + (b - 4) * 16 : b * SEQ + sub * 512 + blk * 128 + wave * 16;
        bf16x8 qf[4];
#pragma unroll
        for (int s = 0; s < 4; ++s) qf[s] = ld16(PROJ + (size_t)(r0 + fr) * ldp + cqm + h * 128 + 32 * s + 8 * fq);
        f32x4 st[16];
#pragma unroll
        for (int mt = 0; mt < 16; ++mt) { st[mt] = (f32x4){0.f, 0.f, 0.f, 0.f};
#pragma unroll
            for (int s = 0; s < 4; ++s) st[mt] = MFMA16(*(const LAS bf16x8*)(lds + koff[s] + mt * 4096), qf[s], st[mt]);
            if ((mt & 3) == 3) __builtin_amdgcn_sched_barrier(0); }
        float mx = -3.0e38f;
#pragma unroll
        for (int mt = 0; mt < 16; ++mt) mx = fmaxf(mx, fmaxf(fmaxf(st[mt][0], st[mt][1]), fmaxf(st[mt][2], st[mt][3])));
        mx = fmaxf(mx, shx(mx, lane, 16)); mx = fmaxf(mx, shx(mx, lane, 32));
        float sum = 0.f;
#pragma unroll
        for (int mt = 0; mt < 16; ++mt)
#pragma unroll
            for (int jj = 0; jj < 4; ++jj) { const float p = __expf((st[mt][jj] - mx) * HD_SCALE); st[mt][jj] = p; sum += p; }
        sum += shx(sum, lane, 16); sum += shx(sum, lane, 32);
        const float inv = 1.0f / sum;
        bf16x8 pf[8];
#pragma unroll
        for (int s = 0; s < 8; ++s) pf[s] = pack8(st[2 * s], st[2 * s + 1]);
#pragma unroll
        for (int dt = 0; dt < 8; ++dt) { f32x4 o = {0.f, 0.f, 0.f, 0.f};
#pragma unroll
            for (int s = 0; s < 8; ++s) { const s16x4 a = *(const LAS s16x4*)(lds + voff[2 * s] + dt * 8192), bb = *(const LAS s16x4*)(lds + voff[2 * s + 1] + dt * 8192);
                o = MFMA16(__builtin_shufflevector(a, bb, 0, 1, 2, 3, 4, 5, 6, 7), pf[s], o); }
            u32x2 w; w.x = cvt2(o[0] * inv, o[1] * inv); w.y = cvt2(o[2] * inv, o[3] * inv);
            *(u32x2*)(OCAT + (size_t)(r0 + fr) * D + 1536 + h * 128 + 16 * dt + 4 * fq) = w;
            if (dt & 1) __builtin_amdgcn_sched_barrier(0); }
    }
    __syncthreads();
}

template <int MODE = 0>
__device__ __forceinline__ void sb_attn(int lane, LAS unsigned char* wlds, const bf16* Kp, int ldk, const bf16* VTp, int ldvt, const bf16* Qp, int ldq, bf16* Op, int t0, int nq) {
    const int r = lane & 31, hh = lane >> 5;
    LAS bf16x8* qs = (LAS bf16x8*)wlds + lane;
#pragma unroll
    for (int ks = 0; ks < 8; ++ks) qs[64 * ks] = ld16(Qp + (size_t)r * ldq + 16 * ks + 8 * hh);
    f32x16 oacc[4];
#pragma unroll
    for (int dt = 0; dt < 4; ++dt)
#pragma unroll
        for (int i = 0; i < 16; ++i) oacc[dt][i] = 0.f;
    float carry = 1.f;
    bf16x8 kf[8];
    { const bf16* kr = Kp + (size_t)(t0 + r) * ldk + 8 * hh;
#pragma unroll
      for (int ks = 0; ks < 8; ++ks) kf[ks] = ld16(kr + 16 * ks); }
    for (int s0 = t0; s0 >= 0; s0 -= 32) {
        bf16x8 vf[8];
#pragma unroll
        for (int k2 = 0; k2 < 2; ++k2)
#pragma unroll
            for (int dt = 0; dt < 4; ++dt) vf[4 * k2 + dt] = MODE == 3 ? qs[64 * dt] : ld16(VTp + (size_t)(s0 >> 5) * 4096 + ((dt * 2 + k2) * 64 + lane) * 8);
        f32x16 st;
#pragma unroll
        for (int i = 0; i < 16; ++i) st[i] = 0.f;
#pragma unroll
        for (int ks = 0; ks < 8; ++ks) st = MFMA32(kf[ks], qs[64 * ks], st);
        { const int sn = s0 >= 32 ? s0 - 32 : 0; const bf16* kr = Kp + (size_t)(sn + r) * ldk + 8 * hh;
#pragma unroll
          for (int ks = 0; ks < 8; ++ks) kf[ks] = ld16(kr + 16 * ks); }
        const bool diag = (s0 == t0);
        float lb[16], om[16];
#pragma unroll
        for (int i = 0; i < 16; ++i) { const float z = st[i] * HD_SCALE, e = __expf(-fabsf(z)), rr = __builtin_amdgcn_rcpf(1.0f + e), er = e * rr;
            lb[i] = z >= 0.f ? rr : er; om[i] = z >= 0.f ? er : rr;
            if (diag && !(((i & 3) + 8 * (i >> 2) + 4 * hh) < r)) { lb[i] = 0.f; om[i] = 1.f; } }
        float g[4], pgv[4];
#pragma unroll
        for (int m = 0; m < 4; ++m) { g[m] = (om[4 * m] * om[4 * m + 1]) * (om[4 * m + 2] * om[4 * m + 3]); pgv[m] = shx(g[m], lane, 32); }
        float R[4]; R[3] = 1.f; R[2] = g[3] * pgv[3]; R[1] = R[2] * (g[2] * pgv[2]); R[0] = R[1] * (g[1] * pgv[1]);
        const float total = R[0] * (g[0] * pgv[0]);
#pragma unroll
        for (int m = 0; m < 4; ++m) { const float suf = carry * R[m] * (hh == 0 ? pgv[m] : 1.f);
            const float t3 = suf, t2 = t3 * om[4 * m + 3], t1 = t2 * om[4 * m + 2], t0_ = t1 * om[4 * m + 1];
            lb[4 * m + 3] *= t3; lb[4 * m + 2] *= t2; lb[4 * m + 1] *= t1; lb[4 * m] *= t0_; }
        carry *= total;
#pragma unroll
        for (int k2 = 0; k2 < 2; ++k2) {
            v4u p; p.x = cvt2(lb[8 * k2], lb[8 * k2 + 1]); p.y = cvt2(lb[8 * k2 + 2], lb[8 * k2 + 3]); p.z = cvt2(lb[8 * k2 + 4], lb[8 * k2 + 5]); p.w = cvt2(lb[8 * k2 + 6], lb[8 * k2 + 7]);
            const bf16x8 wf = __builtin_bit_cast(bf16x8, p);
#pragma unroll
            for (int dt = 0; dt < 4; ++dt) { if (MODE != 3) oacc[dt] = MFMA32(vf[4 * k2 + dt], wf, oacc[dt]); else oacc[dt][0] += __builtin_bit_cast(float, (int)wf[0]) + __builtin_bit_cast(float, (int)vf[4 * k2 + dt][0]); }
        }
        if (MODE == 2 || __all((r >= nq) || (carry < 1.0e-37f))) break;
    }
    if (MODE != 0) { float sdry = 0.f;
#pragma unroll
        for (int dt = 0; dt < 4; ++dt)
#pragma unroll
            for (int i = 0; i < 16; ++i) sdry += oacc[dt][i];
        if (sdry == 1.2345e33f) Op[0] = 0; }
    else if (r < nq) {
#pragma unroll
        for (int dt = 0; dt < 4; ++dt)
#pragma unroll
            for (int g4 = 0; g4 < 4; ++g4) { u32x2 wv; wv.x = cvt2(oacc[dt][4 * g4], oacc[dt][4 * g4 + 1]); wv.y = cvt2(oacc[dt][4 * g4 + 2], oacc[dt][4 * g4 + 3]);
                *(u32x2*)(Op + (size_t)r * D + 32 * dt + 8 * g4 + 4 * hh) = wv; }
    }
    asm volatile("s_waitcnt lgkmcnt(0)" ::: "memory");
}

struct SkBf16 { bf16* O; int ldc;
    __device__ __forceinline__ int brow(int unit, int nb) const { return 32 * unit + 16 * nb; }
    __device__ __forceinline__ void store(int unit, const f32x4 a0, const f32x4 a1, int m, int fq) const { bf16* p = O + (size_t)(MP + m) * ldc + 32 * unit + 4 * fq;
        u32x2 w; w.x = cvt2(a0[0], a0[1]); w.y = cvt2(a0[2], a0[3]); *(u32x2*)p = w; w.x = cvt2(a1[0], a1[1]); w.y = cvt2(a1[2], a1[3]); *(u32x2*)(p + 16) = w; } };
struct SkRes { bf16* Yp; const bf16* Xp; float alpha;
    __device__ __forceinline__ int brow(int unit, int nb) const { return 32 * unit + 16 * nb; }
    __device__ __forceinline__ void one(size_t o, const f32x4 a) const { const u32x2 xv = *(const u32x2*)(Xp + o);
        f32x4 r; r[0] = alpha * pg8::bflo(xv.x); r[1] = alpha * pg8::bfhi(xv.x); r[2] = alpha * pg8::bflo(xv.y); r[3] = alpha * pg8::bfhi(xv.y); r = r + a; u32x2 w; w.x = cvt2(r[0], r[1]); w.y = cvt2(r[2], r[3]); *(u32x2*)(Yp + o) = w; }
    __device__ __forceinline__ void store(int unit, const f32x4 a0, const f32x4 a1, int m, int fq) const { const size_t o = (size_t)(MP + m) * D + 32 * unit + 4 * fq; one(o, a0); one(o + 16, a1); } };
struct SkKV { float *oks, *ovs; bf16 *ksb, *vsb;
    __device__ __forceinline__ int brow(int unit, int nb) const { return 32 * unit + 16 * nb; }
    __device__ __forceinline__ void one(int col, const f32x4 a, int m) const { const bool isv = col >= 1536; const int c = col - (isv ? 1536 : 0), b = m >> 4, t = m & 15;
        *(f32x4*)((isv ? ovs : oks) + (size_t)m * 1536 + c) = a; const unsigned w0 = cvt2(a[0], a[1]), w1 = cvt2(a[2], a[3]);
        const int hh_ = c >> 7, dd = c & 127;
        if (!isv) { u32x2 w; w.x = w0; w.y = w1; *(u32x2*)(ksb + ((size_t)(b * 12 + hh_) * 2080 + 2048 + t) * 128 + dd) = w; }
        else { bf16* vt = vsb + ((size_t)(b * 12 + hh_) * 65 + 64) * 4096 + pg8::vtf_d(dd) + pg8::vtf_k(t); vt[0] = (bf16)w0; vt[8] = (bf16)(w0 >> 16); vt[16] = (bf16)w1; vt[24] = (bf16)(w1 >> 16); } }
    __device__ __forceinline__ void store(int unit, const f32x4 a0, const f32x4 a1, int m, int fq) const { one(32 * unit + 4 * fq, a0, m); one(32 * unit + 16 + 4 * fq, a1, m); } };
struct SkSwiGLU { bf16* Hb;
    __device__ __forceinline__ int brow(int unit, int nb) const { const int c0 = 16 * unit; return (c0 >> 7) * 256 + (c0 & 127) + 128 * nb; }
    __device__ __forceinline__ void store(int unit, const f32x4 g, const f32x4 u, int m, int fq) const { float hv[4];
#pragma unroll
        for (int j = 0; j < 4; ++j) hv[j] = g[j] * __builtin_amdgcn_rcpf(1.0f + __expf(-g[j])) * u[j];
        u32x2 w; w.x = cvt2(hv[0], hv[1]); w.y = cvt2(hv[2], hv[3]); *(u32x2*)(Hb + (size_t)(MP + m) * DFF + 16 * unit + 4 * fq) = w; } };
template <class Epi>
__device__ __forceinline__ void skinny_gemm(int bid, int G, int tid, int wave, LAS unsigned char* lds, const bf16* A, int lda, const bf16* Bt, int K, int nunits, const Epi& E) {
    const int lane = tid & 63, fr = lane & 15, fq = lane >> 4, kw = K >> 3, nst = kw >> 5;
    LAS f32x4* red = (LAS f32x4*)lds;
    if (nst == 8 && (G & 3) == 0) {
        const int rg = bid & 3;
        bf16x8 af[8][2], bw[8][2];
        if (bid < 4 * nunits) { const bf16* ap = A + (size_t)(32 * rg + fr) * lda + wave * kw + 8 * fq;
#pragma unroll
            for (int st = 0; st < 8; ++st) { af[st][0] = ld16(ap + 32 * st); af[st][1] = ld16(ap + (size_t)16 * lda + 32 * st); } }
#define SK_BLOAD(it_) do { const int u_ = (it_) >> 2; const bf16* bp0 = Bt + (size_t)(E.brow(u_, 0) + fr) * K + wave * kw + 8 * fq; const bf16* bp1 = Bt + (size_t)(E.brow(u_, 1) + fr) * K + wave * kw + 8 * fq; \
            _Pragma("unroll") for (int st = 0; st < 8; ++st) { bw[st][0] = ld16(bp0 + 32 * st); bw[st][1] = ld16(bp1 + 32 * st); } } while (0)
        if (bid < 4 * nunits) SK_BLOAD(bid);
#pragma unroll 1
        for (int item = bid; item < 4 * nunits; item += G) {
            const int unit = item >> 2;
            f32x4 acc[2][2];
#pragma unroll
            for (int nb = 0; nb < 2; ++nb)
#pragma unroll
                for (int rt = 0; rt < 2; ++rt) acc[nb][rt] = (f32x4){0.f, 0.f, 0.f, 0.f};
#pragma unroll
            for (int st = 0; st < 8; ++st)
#pragma unroll
                for (int rt = 0; rt < 2; ++rt) { acc[0][rt] = MFMA16(bw[st][0], af[st][rt], acc[0][rt]); acc[1][rt] = MFMA16(bw[st][1], af[st][rt], acc[1][rt]); }
            __builtin_amdgcn_sched_barrier(0);
            if (item + G < 4 * nunits) SK_BLOAD(item + G);
            __builtin_amdgcn_sched_barrier(0);
#pragma unroll
            for (int nb = 0; nb < 2; ++nb)
#pragma unroll
                for (int rt = 0; rt < 2; ++rt) red[((wave * 2 + nb) * 2 + rt) * 64 + lane] = acc[nb][rt];
            __syncthreads();
            if (wave < 2) {
                f32x4 s0 = {0.f, 0.f, 0.f, 0.f}, s1 = {0.f, 0.f, 0.f, 0.f};
#pragma unroll
                for (int ws = 0; ws < 8; ++ws) { s0 = s0 + red[((ws * 2 + 0) * 2 + wave) * 64 + lane]; s1 = s1 + red[((ws * 2 + 1) * 2 + wave) * 64 + lane]; }
                E.store(unit, s0, s1, 32 * rg + 16 * wave + fr, fq);
            }
            __syncthreads();
        }
#undef SK_BLOAD
        return;
    }
    for (int item = bid; item < 4 * nunits; item += G) {
        const int unit = item >> 2, rg = item & 3;
        const bf16* ap = A + (size_t)(32 * rg + fr) * lda + wave * kw + 8 * fq;
        const bf16* bp0 = Bt + (size_t)(E.brow(unit, 0) + fr) * K + wave * kw + 8 * fq; const bf16* bp1 = Bt + (size_t)(E.brow(unit, 1) + fr) * K + wave * kw + 8 * fq;
        f32x4 acc[2][2];
#pragma unroll
        for (int nb = 0; nb < 2; ++nb)
#pragma unroll
            for (int rt = 0; rt < 2; ++rt) acc[nb][rt] = (f32x4){0.f, 0.f, 0.f, 0.f};
        bf16x8 a0[4][2], b0[4][2], a1[4][2], b1[4][2];
#define SK_LOAD(af, bfr, g) do { _Pragma("unroll") for (int q = 0; q < 4; ++q) { const int st = 4 * (g) + q; if (st < nst) { \
            af[q][0] = ld16(ap + 32 * st); af[q][1] = ld16(ap + (size_t)16 * lda + 32 * st); bfr[q][0] = ld16(bp0 + 32 * st); bfr[q][1] = ld16(bp1 + 32 * st); } } } while (0)
#define SK_MMA(af, bfr, g) do { _Pragma("unroll") for (int q = 0; q < 4; ++q) { if (4 * (g) + q < nst) { _Pragma("unroll") for (int rt = 0; rt < 2; ++rt) { \
            acc[0][rt] = MFMA16(bfr[q][0], af[q][rt], acc[0][rt]); acc[1][rt] = MFMA16(bfr[q][1], af[q][rt], acc[1][rt]); } } } } while (0)
        const int ng = (nst + 3) >> 2;
        SK_LOAD(a0, b0, 0);
#pragma unroll 1
        for (int g = 0; g < ng; g += 2) {
            if (g + 1 < ng) SK_LOAD(a1, b1, g + 1);
            __builtin_amdgcn_sched_barrier(0);
            SK_MMA(a0, b0, g);
            __builtin_amdgcn_sched_barrier(0);
            if (g + 2 < ng) SK_LOAD(a0, b0, g + 2);
            __builtin_amdgcn_sched_barrier(0);
            if (g + 1 < ng) SK_MMA(a1, b1, g + 1);
            __builtin_amdgcn_sched_barrier(0);
        }
#undef SK_LOAD
#undef SK_MMA
#pragma unroll
        for (int nb = 0; nb < 2; ++nb)
#pragma unroll
            for (int rt = 0; rt < 2; ++rt) red[((wave * 2 + nb) * 2 + rt) * 64 + lane] = acc[nb][rt];
        __syncthreads();
        if (wave < 2) {
            f32x4 s0 = {0.f, 0.f, 0.f, 0.f}, s1 = {0.f, 0.f, 0.f, 0.f};
#pragma unroll
            for (int ws = 0; ws < 8; ++ws) { s0 = s0 + red[((ws * 2 + 0) * 2 + wave) * 64 + lane]; s1 = s1 + red[((ws * 2 + 1) * 2 + wave) * 64 + lane]; }
            E.store(unit, s0, s1, 32 * rg + 16 * wave + fr, fq);
        }
        __syncthreads();
    }
}
#ifndef PH_MASK
#define PH_MASK 0xFFFF
#endif
__global__ void __launch_bounds__(NWAVES * 64, 2) mega(Args args) {
    extern __shared__ __attribute__((aligned(16))) unsigned char lds[];
    Frame F;
    F.lds = (LAS unsigned char*)lds; F.MISC = (volatile LAS unsigned*)(F.lds + MISC_OFF);
    F.tid = threadIdx.x; F.lane = F.tid & 63; F.wave = __builtin_amdgcn_readfirstlane(F.tid >> 6);
    F.G = gridDim.x; F.gw = blockIdx.x * NWAVES + F.wave; F.NGW = F.G * NWAVES;
    F.ctl = (gu32*)(args.ws_ + WS_CTL);
    for (int u = F.tid; u < (LDS_BYTES - LDSCTL_OFF) / 4; u += NWAVES * 64) ((LAS unsigned*)(F.lds + LDSCTL_OFF))[u] = 0u;
    __syncthreads();
    XcdBarrier bar = xcd_barrier_post((unsigned*)(F.ctl + CW_BAR), F.MISC + 8);
    const int lo = args.ph_lo, hi = args.ph_hi; int ph = 0;
#define KARGS ((const __attribute__((address_space(4))) Args*)__builtin_amdgcn_kernarg_segment_ptr())
#define ws (ka->ws_)
#define out (ka->out_)
#define x_prompt (ka->in[0])
#define x_sample (ka->in[1])
#define mem_prompt (ka->in[2])
#define state_gla (ka->in[3])
#define cache_sb_k (ka->in[4])
#define cache_sb_v (ka->in[5])
#define cache_mem_k (ka->in[6])
#define cache_mem_v (ka->in[7])
#define w_in_a (ka->in[8])
#define w_gate_lr (ka->in[9])
#define b_gate (ka->in[10])
#define gla_norm_g (ka->in[11])
#define w_in_b (ka->in[12])
#define w_kv_shared (ka->in[13])
#define w_mem_kv (ka->in[14])
#define w_o (ka->in[15])
#define ln1_g (ka->in[16])
#define ln1_b (ka->in[17])
#define ln2_g (ka->in[18])
#define ln2_b (ka->in[19])
#define w_ffn_in (ka->in[20])
#define w_ffn_out (ka->in[21])
#define WIN ((bf16*)(ws + WS_WIN))
#define WO ((bf16*)(ws + WS_WO))
#define WFI ((bf16*)(ws + WS_WFI))
#define WFO ((bf16*)(ws + WS_WFO))
#define WMEM ((bf16*)(ws + WS_WMEM))
#define MEMX ((bf16*)(ws + WS_MEMX))
#define MEMK ((bf16*)(ws + WS_MEMK))
#define MEMV ((bf16*)(ws + WS_MEMV))
#define X ((bf16*)(ws + WS_X))
#define Y ((float*)(ws + WS_Y))
#define YB ((bf16*)(ws + WS_Y))
#define PROJ ((bf16*)(ws + WS_R1))
#define HB ((bf16*)(ws + WS_R1))
#define OCAT ((bf16*)(ws + WS_OCAT))
#define SBKS ((bf16*)(ws + WS_SBKS))
#define SBVS ((bf16*)(ws + WS_SBVS))
#define OINT ((bf16*)(out + O_YP))
#define KPB ((bf16*)(out + O_YP))
#define VPB (KPB + (size_t)MP * 1536)

#define PHASE_BEGIN(cond, cls) if (cond) { if (lo <= ph && ph < hi) { if (ph > lo) { xcd_barrier(bar); if (BAR_REP > 1) xcd_barrier(bar); } DIAG_STAMP(cls); for (int rep_ = 0; rep_ < (((cls) == REP_CLS) ? 2 : 1); ++rep_) { const __attribute__((address_space(4))) Args* ka = KARGS; asm volatile("" : "+s"(ka)); int z_ = 0, G_ = gridDim.x, bid_ = blockIdx.x, wave_ = F.wave; asm volatile("" : "+s"(z_), "+s"(G_), "+s"(bid_), "+s"(wave_)); const int lane = (int)__builtin_amdgcn_mbcnt_hi(~0u, __builtin_amdgcn_mbcnt_lo(~0u, (unsigned)z_)), tid = wave_ * 64 + lane, gw_ = bid_ * NWAVES + wave_, NGW_ = G_ * NWAVES;     (void)tid; (void)lane; (void)gw_; (void)NGW_;
#define PHASE_END } } ++ph; }
#ifndef REP_CLS
#define REP_CLS (-1)
#endif
#ifndef SK_REP
#define SK_REP 1
#endif
#ifndef MEM_REP
#define MEM_REP 1
#endif
#ifndef BAR_REP
#define BAR_REP 1
#endif
#ifndef STAG
#define STAG 0
#endif
#ifndef SB_REP
#define SB_REP 1
#endif
#if defined(DIAG_A)
#define DIAG_STAMP(cls) do { if (blockIdx.x == 0 && threadIdx.x == 0) { unsigned long long* dts = (unsigned long long*)(args.ws_ + 262144); dts[ph] = rt(); } } while (0)
#else
#define DIAG_STAMP(cls) do { } while (0)
#endif

#define CONVERT_WEIGHTS(LL) do { const int ll_ = (LL); \
            if (ll_ < 2) wt_convert(F.lds, wave_, gw_, NGW_, lane, w_in_a + (size_t)ll_ * D * 5136, D, 5136, WIN, NA, MapInA()); \
            else { wt_convert(F.lds, wave_, gw_, NGW_, lane, w_in_b + (size_t)(ll_ - 2) * D * NBQ, D, NBQ, WIN, NBQ, MapId()); if (ll_ == 2) wt_convert(F.lds, wave_, gw_, NGW_, lane, w_kv_shared, D, NKV, WIN + (size_t)NBQ * D, NKV, MapId()); } \
            wt_convert(F.lds, wave_, gw_, NGW_, lane, w_o + (size_t)ll_ * D * D, D, D, WO, D, MapId()); \
            wt_convert(F.lds, wave_, gw_, NGW_, lane, w_ffn_in + (size_t)ll_ * D * 2 * DFF, D, 2 * DFF, WFI, 2 * DFF, MapFfn()); \
            wt_convert(F.lds, wave_, gw_, NGW_, lane, w_ffn_out + (size_t)ll_ * DFF * D, DFF, D, WFO, D, MapId()); } while (0)
#define CONVERT_CACHE_K(W0, NW) do {         for (int r = (W0); r < 8 * 2048; r += (NW)) { const int b = r >> 11, s = r & 2047; const float* src = cache_sb_k + (size_t)r * 1536; \
            f32x4 v[6]; \
_Pragma("unroll") \
            for (int q = 0; q < 6; ++q) v[q] = *(const f32x4*)(src + lane * 4 + 256 * q); \
_Pragma("unroll") \
            for (int q = 0; q < 6; ++q) { const int j = lane * 4 + 256 * q; \
                *(unsigned long long*)(SBKS + ((size_t)(b * 12 + (j >> 7)) * 2080 + s) * 128 + (j & 127)) = (unsigned long long)pk2(v[q].x, v[q].y) | ((unsigned long long)pk2(v[q].z, v[q].w) << 32); } } } while (0)
#define CONVERT_CACHE_V(W0, NW) do {         for (int it = (W0); it < 3072; it += (NW)) { const int cb = it % 12, sb_ = (it / 12) & 31, b = it / 384, s = sb_ * 64 + lane; \
            const float* src = cache_sb_v + (size_t)(b * 2048 + s) * 1536 + cb * 128; bf16* dst = SBVS + ((size_t)(b * 12 + cb) * 65 + (s >> 5)) * 4096 + pg8::vtf_k(s & 31); \
            for (int q8 = 0; q8 < 32; q8 += 8) { f32x4 v[8]; \
_Pragma("unroll") \
                for (int q = 0; q < 8; ++q) v[q] = *(const f32x4*)(src + 4 * (q8 + q)); \
_Pragma("unroll") \
                for (int q = 0; q < 8; ++q) \
_Pragma("unroll") \
                    for (int e = 0; e < 4; ++e) dst[pg8::vtf_d(4 * (q8 + q) + e)] = (bf16)f2bf(v[q][e]); } } } while (0)
    PHASE_BEGIN(true, 0)
        for (int r = 2 * gw_; r < MT; r += 2 * NGW_) { const float* s0 = r < MP ? x_prompt + (size_t)r * D : (r < MR ? x_sample + (size_t)(r - MP) * D : nullptr);
            cvt_rows2<D>(s0, s0 ? s0 + D : nullptr, X + (size_t)r * D, X + (size_t)(r + 1) * D, lane); }
        for (int r = 2 * gw_; r < 1024; r += 2 * NGW_) cvt_rows2<D>(mem_prompt + (size_t)r * D, mem_prompt + (size_t)(r + 1) * D, MEMX + (size_t)r * D, MEMX + (size_t)(r + 1) * D, lane);
        for (int r = gw_; r < 4 * 8 * 256; r += NGW_) { const int l = r >> 11, b = (r >> 8) & 7, m = r & 255; const size_t dst = (size_t)((l * 12 + 4 + b) * 256 + m) * 512;
            cvt_row(cache_mem_k + (size_t)r * 512, MEMK + dst, 512, lane); }
        for (int it = gw_; it < 512; it += NGW_) { const int hdb = it & 3, mb = (it >> 2) & 3, b = (it >> 4) & 7, l = it >> 7, m = mb * 64 + lane;
            const float* src = cache_mem_v + (size_t)((l * 8 + b) * 256 + m) * 512 + hdb * 128; bf16* dst = MEMV + (size_t)((l * 12 + 4 + b) * 512 + hdb * 128) * 256 + m;
            for (int q4 = 0; q4 < 32; ++q4) { const f32x4 v = *(const f32x4*)(src + 4 * q4);
#pragma unroll
                for (int e = 0; e < 4; ++e) dst[(size_t)(4 * q4 + e) * 256] = (bf16)f2bf(v[e]); } }
        if (G_ != 256) { CONVERT_CACHE_K(gw_, NGW_); CONVERT_CACHE_V(gw_, NGW_); }
        for (int l = 0; l < 4; ++l) wt_convert(F.lds, wave_, gw_, NGW_, lane, w_mem_kv + (size_t)l * D * 1024, D, 1024, WMEM + (size_t)l * 1024 * D, 1024, MapId());
        CONVERT_WEIGHTS(0);
    PHASE_END
    for (int l = 0; l < 4; ++l) {
        const bool LA = l < 2;
        const int ldp = LA ? NA : NBQ;
        PHASE_BEGIN(true, 2)
            if (!LA && (bid_ & 1)) { { SkBf16 E{PROJ, ldp}; skinny_gemm(bid_, G_, FRESH_TID(), wave_, F.lds + RING_OFF, X + (size_t)MP * D, D, WIN, D, ldp / 32, E); }
                if (l == 2) { SkKV E{out + O_SKS, out + O_SVS, SBKS, SBVS}; skinny_gemm(bid_, G_, FRESH_TID(), wave_, F.lds + RING_OFF, X + (size_t)MP * D, D, WIN + (size_t)NBQ * D, D, NKV / 32, E); } }
            { pg8::Gemm g{X, WIN, MP, ldp, D}; pg8::StaticOrder S; S.init(MP, ldp, G_, bid_); pg8::EpiBf16 E{PROJ, ldp};
              pg8::gemm_phase<pg8::EpiBf16, pg8::StaticOrder, true, true>(F.lds + RING_OFF, g, S, E, FRESH_TID()); }
            if (l == 0 && bid_ >= (G_ >> 1) && bid_ < (G_ >> 1) + 64) { pg8::Gemm g{MEMX, WMEM, 1024, 4096, D}; pg8::StaticOrder S; S.init(1024, 4096, 64, bid_ - (G_ >> 1));
              pg8::EpiMemKV E{out + O_MKP, out + O_MVP, MEMK, MEMV};
              pg8::gemm_phase<pg8::EpiMemKV, pg8::StaticOrder, true, true>(F.lds + RING_OFF, g, S, E, FRESH_TID()); }
            if (l == 2) { pg8::Gemm g{X, WIN + (size_t)NBQ * D, MP, NKV, D}; pg8::StaticOrder S; S.init(MP, NKV, G_, bid_);
              pg8::EpiKV E{out + O_SKP, out + O_SVP, out + O_SKS, out + O_SVS, KPB, VPB, SBKS, SBVS};
              pg8::gemm_phase<pg8::EpiKV, pg8::StaticOrder, true, true>(F.lds + RING_OFF, g, S, E, FRESH_TID()); }
            if (LA) { if (bid_ >= (G_ >> 1)) { SkBf16 E{PROJ, ldp};
                    if (l == 0 && G_ == 256) {
                        const int ns = bid_ < 192 ? 2 : 8, s0 = bid_ < 192 ? bid_ - 128 : 128 + (bid_ - 192);
                        for (int m = 0; m < ns; ++m) skinny_gemm(s0 + 64 * m, 640, FRESH_TID(), wave_, F.lds + RING_OFF, X + (size_t)MP * D, D, WIN, D, ldp / 32, E); }
                    else skinny_gemm(bid_ - (G_ >> 1), G_ >> 1, FRESH_TID(), wave_, F.lds + RING_OFF, X + (size_t)MP * D, D, WIN, D, ldp / 32, E); } }
            else if (!(bid_ & 1))
            for (int skr = 0; skr < SK_REP; ++skr) { SkBf16 E{PROJ, ldp}; skinny_gemm(bid_, G_, FRESH_TID(), wave_, F.lds + RING_OFF, X + (size_t)MP * D, D, WIN, D, ldp / 32, E); }
            if (!(bid_ & 1))
            for (int skr = 0; skr < SK_REP; ++skr) if (l == 2) { SkKV E{out + O_SKS, out + O_SVS, SBKS, SBVS}; skinny_gemm(bid_, G_, FRESH_TID(), wave_, F.lds + RING_OFF, X + (size_t)MP * D, D, WIN + (size_t)NBQ * D, D, NKV / 32, E); }
        PHASE_END
        PHASE_BEGIN(LA, 3)
            if (G_ == 256) gla_prep_intra<1>(bid_, G_, tid, wave_, F.lds + RING_OFF, l, PROJ, w_gate_lr, b_gate, (unsigned char*)Y, OINT);
            else gla_prep_intra<0>(bid_, G_, tid, wave_, F.lds + RING_OFF, l, PROJ, w_gate_lr, b_gate, (unsigned char*)Y, OINT);
        PHASE_END
        PHASE_BEGIN(!LA, 11)
            {
#if defined(SB_MODE)
                for (int u = gw_; u < 12288; u += NGW_) { const int bh = u >> 8, qb = u & 255, b = bh / 12, h = bh % 12, t0 = 32 * qb; const size_t qo = (size_t)(b * SEQ + t0) * D + h * 128;
                    sb_attn<SB_MODE>(lane, F.lds + RING_OFF + wave_ * 16384, KPB + (size_t)bh * SEQ * 128, 128, VPB + (size_t)bh * SEQ * 128, 0, PROJ + qo, NBQ, OCAT + qo, t0, 32); }
#endif
                for (int sbr = 0; sbr < SB_REP; ++sbr)
                for (int u = gw_; u < 12288 + 96; u += NGW_) {
                    if (u < 12288) { const int bh = u >> 8, qb = u & 255, b = bh / 12, h = bh % 12, t0 = 32 * qb; const size_t qo = (size_t)(b * SEQ + t0) * D + h * 128;
                        sb_attn(lane, F.lds + RING_OFF + wave_ * 16384, KPB + (size_t)bh * SEQ * 128, 128, VPB + (size_t)bh * SEQ * 128, 0, PROJ + qo, NBQ, OCAT + qo, t0, 32); }
                    else { const int u2 = u - 12288, b = u2 / 12, h = u2 % 12; const size_t qo = (size_t)(MP + b * 16) * D + h * 128;
                        sb_attn(lane, F.lds + RING_OFF + wave_ * 16384, SBKS + (size_t)u2 * 2080 * 128, 128, SBVS + (size_t)u2 * 65 * 4096, 0, PROJ + qo, NBQ, OCAT + qo, 2048, 16); }
                }
            }
            __syncthreads();
            for (int mr = 0; mr < MEM_REP; ++mr)
            if (G_ == 256) {
                mem_attn_wg(bid_, FRESH_TID(), wave_, F.lds + RING_OFF, l, PROJ, ldp, LA ? CQM : 1536, MEMK, MEMV, OCAT);
                if (bid_ >= 224) mem_attn_wg(256 + bid_ - 224, FRESH_TID(), wave_, F.lds + RING_OFF, l, PROJ, ldp, LA ? CQM : 1536, MEMK, MEMV, OCAT); }
            else
            for (int wi = bid_; wi < 256 + 32; wi += G_) mem_attn_wg(wi, FRESH_TID(), wave_, F.lds + RING_OFF, l, PROJ, ldp, LA ? CQM : 1536, MEMK, MEMV, OCAT);
        PHASE_END
        PHASE_BEGIN(LA, 12)
            if (G_ == 256) { if (bid_ >= 144) { mem_attn_wg(bid_ - 144, FRESH_TID(), wave_, F.lds + RING_OFF, l, PROJ, ldp, CQM, MEMK, MEMV, OCAT); mem_attn_wg(bid_ - 144 + 112, FRESH_TID(), wave_, F.lds + RING_OFF, l, PROJ, ldp, CQM, MEMK, MEMV, OCAT); }
                    if (bid_ >= 224) { __syncthreads(); gla_prep_intra<2>(bid_ - 224, G_, FRESH_TID(), wave_, F.lds + RING_OFF, l, PROJ, w_gate_lr, b_gate, (unsigned char*)Y, OINT); } }
            else for (int wi = bid_; wi < 256 + 32; wi += G_) mem_attn_wg(wi, FRESH_TID(), wave_, F.lds + RING_OFF, l, PROJ, ldp, CQM, MEMK, MEMV, OCAT);
            for (int wc = bid_; wc < 144; wc += G_) gla_chain<1>(wc, FRESH_TID(), wave_, F.lds + RING_OFF, l, (const unsigned char*)Y, state_gla, OINT, out, (float*)WMEM, (float*)MEMX);
            if (G_ == 256 && bid_ < 64) mem_attn_wg(224 + bid_, FRESH_TID(), wave_, F.lds + RING_OFF, l, PROJ, ldp, CQM, MEMK, MEMV, OCAT);
        PHASE_END
        PHASE_BEGIN(LA, 5)
            if (G_ == 256 && bid_ >= 192) { const int lw = (bid_ - 192) * NWAVES + wave_; if (l == 0) CONVERT_CACHE_K(lw, 64 * NWAVES); else CONVERT_CACHE_V(lw, 64 * NWAVES); }
            for (int wc = bid_; wc < 192 + 96; wc += G_) gla_chain<2>(wc, FRESH_TID(), wave_, F.lds + RING_OFF, l, (const unsigned char*)Y, state_gla, OINT, out, (float*)WMEM, (float*)MEMX, REP_CLS == 5 && rep_ == 0);
        PHASE_END
        PHASE_BEGIN(LA, 6)
            const float* gn = gla_norm_g + (size_t)l * 384;
            for (int row = gw_; row < MR; row += NGW_) {
                const bf16* op = OINT + (size_t)row * 1536 + 24 * lane; const bf16* gp = PROJ + (size_t)row * NA + CG + 24 * lane; const float* gnp = gn + 24 * (lane & 15);
                f32x4 ov[6]; v4u gv[3]; float ss = 0.f;
#pragma unroll
                for (int j = 0; j < 3; ++j) { const v4u w = *(const v4u*)(op + 8 * j); ov[2 * j] = (f32x4){pg8::bflo(w.x), pg8::bfhi(w.x), pg8::bflo(w.y), pg8::bfhi(w.y)}; ov[2 * j + 1] = (f32x4){pg8::bflo(w.z), pg8::bfhi(w.z), pg8::bflo(w.w), pg8::bfhi(w.w)}; }
#pragma unroll
                for (int j = 0; j < 6; ++j) ss += (ov[j].x * ov[j].x + ov[j].y * ov[j].y) + (ov[j].z * ov[j].z + ov[j].w * ov[j].w);
#pragma unroll
                for (int j = 0; j < 3; ++j) gv[j] = *(const v4u*)(gp + 8 * j);
                ss += shx(ss, lane, 1); ss += shx(ss, lane, 2); ss += shx(ss, lane, 4); ss += shx(ss, lane, 8);
                const float r = 1.0f / sqrtf(ss * (1.0f / 384.0f) + RMS_EPS);
#pragma unroll
                for (int j = 0; j < 3; ++j) { const f32x4 n0 = *(const f32x4*)(gnp + 8 * j), n1 = *(const f32x4*)(gnp + 8 * j + 4); const f32x4 a = ov[2 * j], b = ov[2 * j + 1];
                    float gt[8]; gt[0] = pg8::bflo(gv[j].x); gt[1] = pg8::bfhi(gv[j].x); gt[2] = pg8::bflo(gv[j].y); gt[3] = pg8::bfhi(gv[j].y); gt[4] = pg8::bflo(gv[j].z); gt[5] = pg8::bfhi(gv[j].z); gt[6] = pg8::bflo(gv[j].w); gt[7] = pg8::bfhi(gv[j].w);
                    float o8[8];
#pragma unroll
                    for (int i = 0; i < 4; ++i) { o8[i] = a[i] * r * n0[i] * (gt[i] * __builtin_amdgcn_rcpf(1.0f + __expf(-gt[i]))); o8[4 + i] = b[i] * r * n1[i] * (gt[4 + i] * __builtin_amdgcn_rcpf(1.0f + __expf(-gt[4 + i]))); }
                    v4u o; o.x = pk2(o8[0], o8[1]); o.y = pk2(o8[2], o8[3]); o.z = pk2(o8[4], o8[5]); o.w = pk2(o8[6], o8[7]);
                    *(v4u*)(OCAT + (size_t)row * D + 24 * lane + 8 * j) = o; }
            }
        PHASE_END
        PHASE_BEGIN(true, 7)
            if (bid_ & 1) { SkRes Es{YB, X, DN_ALPHA}; skinny_gemm(bid_, G_, FRESH_TID(), wave_, F.lds + RING_OFF, OCAT + (size_t)MP * D, D, WO, D, D / 32, Es); }
            pg8::Gemm g{OCAT, WO, MP, D, D}; pg8::StaticOrder S; S.init(MP, D, G_, bid_); pg8::EpiRes E{YB, X, D, DN_ALPHA};
            pg8::gemm_phase<pg8::EpiRes, pg8::StaticOrder, true, true>(F.lds + RING_OFF, g, S, E, FRESH_TID());
            if (!(bid_ & 1))
            for (int skr = 0; skr < SK_REP; ++skr) { SkRes Es{YB, X, DN_ALPHA}; skinny_gemm(bid_, G_, FRESH_TID(), wave_, F.lds + RING_OFF, OCAT + (size_t)MP * D, D, WO, D, D / 32, Es); }
        PHASE_END
        PHASE_BEGIN(true, 8)
            const float* gg = ln1_g + (size_t)l * D; const float* bb = ln1_b + (size_t)l * D;
            ln_rows<false>(lane, gw_, NGW_, YB, gg, bb, X, [](int) -> float* { return nullptr; });
        PHASE_END
        PHASE_BEGIN(true, 9)
            for (int dl = 0; dl < 3 * STAG * (bid_ >> 1 & 3); ++dl) __builtin_amdgcn_s_sleep(127);
            if (bid_ & 1) { SkSwiGLU Es{HB}; skinny_gemm(bid_, G_, FRESH_TID(), wave_, F.lds + RING_OFF, X + (size_t)MP * D, D, WFI, D, DFF / 16, Es); }
            pg8::Gemm g{X, WFI, MP, 2 * DFF, D}; pg8::StaticOrder S; S.init(MP, 2 * DFF, G_, bid_); pg8::EpiSwiGLU E{HB, DFF};
            pg8::gemm_phase<pg8::EpiSwiGLU, pg8::StaticOrder, true, true>(F.lds + RING_OFF, g, S, E, FRESH_TID());
            if (!(bid_ & 1))
            for (int skr = 0; skr < SK_REP; ++skr) { SkSwiGLU Es{HB}; skinny_gemm(bid_, G_, FRESH_TID(), wave_, F.lds + RING_OFF, X + (size_t)MP * D, D, WFI, D, DFF / 16, Es); }
        PHASE_END
        PHASE_BEGIN(true, 10)
            if (bid_ & 1) { SkRes Es{YB, X, DN_ALPHA}; skinny_gemm(bid_, G_, FRESH_TID(), wave_, F.lds + RING_OFF, HB + (size_t)MP * DFF, DFF, WFO, DFF, D / 32, Es); }
            pg8::Gemm g{HB, WFO, MP, D, DFF}; pg8::StaticOrder S; S.init(MP, D, G_, bid_); pg8::EpiRes E{YB, X, D, DN_ALPHA};
            pg8::gemm_phase<pg8::EpiRes, pg8::StaticOrder, true, true>(F.lds + RING_OFF, g, S, E, FRESH_TID());
            if (!(bid_ & 1))
            for (int skr = 0; skr < SK_REP; ++skr) { SkRes Es{YB, X, DN_ALPHA}; skinny_gemm(bid_, G_, FRESH_TID(), wave_, F.lds + RING_OFF, HB + (size_t)MP * DFF, DFF, WFO, DFF, D / 32, Es); }
        PHASE_END
        PHASE_BEGIN(true, 8)
            if (l < 3) CONVERT_WEIGHTS(l + 1);
            const float* gg = ln2_g + (size_t)l * D; const float* bb = ln2_b + (size_t)l * D;
            if (l == 3) ln_rows<true>(lane, gw_, NGW_, YB, gg, bb, nullptr, [&](int row) -> float* { return row < MP ? out + O_YP + (size_t)row * D : out + O_YS + (size_t)(row - MP) * D; });
            else ln_rows<false>(lane, gw_, NGW_, YB, gg, bb, X, [](int) -> float* { return nullptr; });
        PHASE_END
    }
#if defined(DIAG_A)
    if (blockIdx.x == 0 && threadIdx.x == 0) { unsigned long long* dts = (unsigned long long*)(args.ws_ + 262144); dts[ph] = rt(); dts[63] = (unsigned long long)ph; }
#endif
#undef ws
#undef out
#undef X
#undef Y
#undef YB
#undef CONVERT_WEIGHTS
#undef CONVERT_CACHE_K
#undef CONVERT_CACHE_V
#undef PHASE_BEGIN
#undef PHASE_END
}

#if defined(DIAG_A)
__device__ const int diag_cls[40] = {0,0, 1,2,3,4,5,6,7,8,9,10,8, 1,2,3,4,5,6,7,8,9,10,8, 1,2,11,7,8,9,10,8, 1,2,11,7,8,9,10,8};
__global__ void diag_tail(float* o, const unsigned long long* dts) {
    __shared__ float dv[2];
    if (threadIdx.x == 0) { const int n = (int)dts[63]; unsigned long long sa = 0, sb = 0; for (int p = 0; p < n; ++p) { const unsigned long long d = dts[p + 1] - dts[p]; const int cl = diag_cls[p]; if (cl == DIAG_A) sa += d; if (cl == DIAG_B) sb += d; }
        dv[0] = (float)sa * 0.01f; dv[1] = (float)sb * 10.0f; }
    __syncthreads();
    for (int i = threadIdx.x; i < 262144; i += blockDim.x) o[O_YS + i] = dv[0];
    if (threadIdx.x == 0) o[O_YP] = dv[1];
}
#endif
#ifndef MK_PER_PHASE
#define MK_PER_PHASE 0
#endif
constexpr int N_PHASES = 1 + 2 * 10 + 2 * 7;
extern "C" void kernel_launch(void* const* d_in, const int* in_sizes, int n_in, void* d_out, int out_size, void* d_ws, size_t ws_size, hipStream_t stream) {
    static int grid = 0;
    if (grid == 0) {
        if (n_in != 22 || in_sizes[0] != MP * D || (size_t)out_size != O_END || ws_size < WS_END) { fprintf(stderr, "kernel_launch: unexpected shapes (n_in %d, in0 %d, out %d, ws %zu); nothing launched\n", n_in, n_in > 0 ? in_sizes[0] : -1, out_size, ws_size); grid = -1; return; }
        int dev = 0, cus = 0, per_cu = 0;
        if (hipGetDevice(&dev) != hipSuccess || hipDeviceGetAttribute(&cus, hipDeviceAttributeMultiprocessorCount, dev) != hipSuccess) { grid = -1; return; }
        if (hipFuncSetAttribute((const void*)mega, hipFuncAttributeMaxDynamicSharedMemorySize, LDS_BYTES) != hipSuccess) { fprintf(stderr, "kernel_launch: hipFuncSetAttribute failed\n"); grid = -1; return; }
        if (hipOccupancyMaxActiveBlocksPerMultiprocessor(&per_cu, (const void*)mega, NWAVES * 64, LDS_BYTES) != hipSuccess || per_cu < 1) fprintf(stderr, "kernel_launch: occupancy query reports %d\n", per_cu);
        (void)hipGetLastError();
        grid = cus;
    }
    if (grid < 0) return;
    if (hipMemsetAsync((char*)d_ws + WS_CTL, 0, CTL_ZERO_BYTES, stream) != hipSuccess) return;
    Args a{};
    for (int i = 0; i < 22; ++i) a.in[i] = (const float*)d_in[i];
    a.out_ = (float*)d_out; a.ws_ = (unsigned char*)d_ws;
#if MK_PER_PHASE
    for (int p = 0; p < N_PHASES; ++p) { a.ph_lo = p; a.ph_hi = p + 1; hipLaunchKernelGGL(mega, dim3(grid), dim3(NWAVES * 64), LDS_BYTES, stream, a); }
#else
    a.ph_lo = 0; a.ph_hi = N_PHASES; hipLaunchKernelGGL(mega, dim3(grid), dim3(NWAVES * 64), LDS_BYTES, stream, a);
#if defined(DIAG_A)
    hipLaunchKernelGGL(diag_tail, dim3(1), dim3(512), 0, stream, (float*)d_out, (const unsigned long long*)((unsigned char*)d_ws + 262144));
#endif
#endif
}
```

```cpp
#include <hip/hip_runtime.h>
#include <cstdio>
#include <cstdint>
namespace pg8 {
#define PG8_LAS __attribute__((address_space(3)))
typedef unsigned short bf16_t;
typedef short bf16x8 __attribute__((ext_vector_type(8)));
typedef float f32x4 __attribute__((ext_vector_type(4)));
typedef unsigned u32x4 __attribute__((ext_vector_type(4)));
constexpr int BM = 256, BK = 64, HALF = 128, HTB = HALF * BK * 2  , STAGE_BYTES = 8 * HTB, NXCD = 8, WGM = 4;

__host__ __device__ __forceinline__ int lds_byte(int r, int c) { const int st = (r >> 4) * 2 + (c >> 5), rr = r & 15, cc = c & 31, ob = rr * 64 + cc * 2; return st * 1024 + (ob ^ (((ob >> 9) & 1) << 5)); }
__host__ __device__ __forceinline__ void stage_rc(int b, int& R, int& C) { const int st = b / 1024, sb = b % 1024, swz = sb ^ (((sb >> 9) & 1) << 5); R = (st >> 1) * 16 + swz / 64; C = (st & 1) * 32 + (swz % 64) / 2; }
__host__ __device__ __forceinline__ int perm32(int rho) { const int n = rho >> 4, i = rho & 15; return 8 * (i >> 2) + 4 * n + (i & 3); }

struct Unit { int pm, pn; };
struct Gemm { const bf16_t* A; const bf16_t* Bt; int M, N, K; };

struct StaticOrder {
    int nM, nN, nwg, G, c;
    __host__ __device__ void init(int M, int N, int G_, int c_) { nM = M / BM; nN = N / BM; nwg = nM * nN; G = G_; c = c_; }
    __host__ __device__ bool next(int i, Unit& u) const {
        const long L = (long)i * G + c; if (L >= nwg) return false;
        int wgid = (int)L; { const int q = nwg / NXCD, r = nwg % NXCD, xcd = wgid % NXCD, off = wgid / NXCD; wgid = (xcd < r ? xcd * (q + 1) : r * (q + 1) + (xcd - r) * q) + off; }
        const int nig = WGM * nN, gid = wgid / nig, fm = gid * WGM, gsz = (nM - fm) < WGM ? (nM - fm) : WGM;
        u.pm = fm + ((wgid % nig) % gsz); u.pn = (wgid % nig) / gsz; return true;
    }
    __device__ __forceinline__ void a_ready(const Unit&) const {}
    __device__ __forceinline__ void done(const Unit&) const {}
};
__device__ __forceinline__ unsigned cvt_pk_bf16(float lo, float hi) { unsigned r; asm volatile("v_cvt_pk_bf16_f32 %0, %1, %2" : "=v"(r) : "v"(lo), "v"(hi)); return r; }
typedef float f32x2 __attribute__((ext_vector_type(2)));
typedef unsigned u32x2 __attribute__((ext_vector_type(2)));
__host__ __device__ __forceinline__ int vtf_d(int d) { return (d >> 5) * 1024 + (d & 31) * 8; }
__host__ __device__ __forceinline__ int vtf_k(int ks) { return (ks >> 4) * 512 + ((ks >> 2) & 1) * 256 + (ks & 3) + 4 * ((ks >> 3) & 1); }
__device__ __forceinline__ float bflo(unsigned w) { return __builtin_bit_cast(float, w << 16); }
__device__ __forceinline__ float bfhi(unsigned w) { return __builtin_bit_cast(float, w & 0xffff0000u); }
struct EpiBf16 {
    static constexpr bool PERM = true, AFTER_DRAIN = false;
    bf16_t* O; int ldc;
    __device__ __forceinline__ void operator()(const f32x4 (&acc)[2][2][4][2], const Unit& u, int wr, int wc, int fr, int fq) const {
        const int row0 = u.pm * BM + wr * 64 + fr, col0 = u.pn * BM + wc * 32 + 8 * fq;
#pragma unroll
        for (int ai = 0; ai < 2; ++ai)
#pragma unroll
            for (int m = 0; m < 4; ++m) { bf16_t* rowp = O + (size_t)(row0 + ai * HALF + m * 16) * ldc + col0;
#pragma unroll
                for (int bj = 0; bj < 2; ++bj) { const f32x4 v0 = acc[ai][bj][m][0], v1 = acc[ai][bj][m][1];
                    u32x4 w; w.x = cvt_pk_bf16(v0[0], v0[1]); w.y = cvt_pk_bf16(v0[2], v0[3]); w.z = cvt_pk_bf16(v1[0], v1[1]); w.w = cvt_pk_bf16(v1[2], v1[3]);
                    *(u32x4*)(rowp + bj * HALF) = w; } }
    }
};
struct EpiSwiGLU {
    static constexpr bool PERM = true, AFTER_DRAIN = false;
    bf16_t* Hh; int ldh;
    __device__ __forceinline__ float swi(float g, float up) const { return g * __builtin_amdgcn_rcpf(1.0f + __expf(-g)) * up; }
    __device__ __forceinline__ void operator()(const f32x4 (&acc)[2][2][4][2], const Unit& u, int wr, int wc, int fr, int fq) const {
        const int row0 = u.pm * BM + wr * 64 + fr, col0 = u.pn * HALF + wc * 32 + 8 * fq;
#pragma unroll
        for (int ai = 0; ai < 2; ++ai)
#pragma unroll
            for (int m = 0; m < 4; ++m) { bf16_t* rowp = Hh + (size_t)(row0 + ai * HALF + m * 16) * ldh + col0;
                const f32x4 g0 = acc[ai][0][m][0], g1 = acc[ai][0][m][1], u0 = acc[ai][1][m][0], u1 = acc[ai][1][m][1];
                u32x4 w; w.x = cvt_pk_bf16(swi(g0[0], u0[0]), swi(g0[1], u0[1])); w.y = cvt_pk_bf16(swi(g0[2], u0[2]), swi(g0[3], u0[3]));
                w.z = cvt_pk_bf16(swi(g1[0], u1[0]), swi(g1[1], u1[1])); w.w = cvt_pk_bf16(swi(g1[2], u1[2]), swi(g1[3], u1[3]));
                *(u32x4*)rowp = w; }
    }
};
struct EpiRes {
    static constexpr bool PERM = true, AFTER_DRAIN = false;
    bf16_t* Y; const bf16_t* X; int ldc; float alpha;
    __device__ __forceinline__ void operator()(const f32x4 (&acc)[2][2][4][2], const Unit& u, int wr, int wc, int fr, int fq) const {
        const int row0 = u.pm * BM + wr * 64 + fr, col0 = u.pn * BM + wc * 32 + 8 * fq;
        u32x4 xv[2][4][2];
#pragma unroll
        for (int ai = 0; ai < 2; ++ai)
#pragma unroll
            for (int m = 0; m < 4; ++m)
#pragma unroll
                for (int bj = 0; bj < 2; ++bj) xv[ai][m][bj] = *(const u32x4*)(X + (size_t)(row0 + ai * HALF + m * 16) * ldc + col0 + bj * HALF);
#pragma unroll
        for (int ai = 0; ai < 2; ++ai)
#pragma unroll
            for (int m = 0; m < 4; ++m) { const size_t ro = (size_t)(row0 + ai * HALF + m * 16) * ldc + col0;
#pragma unroll
                for (int bj = 0; bj < 2; ++bj) { const u32x4 x4 = xv[ai][m][bj]; const f32x4 a0 = acc[ai][bj][m][0], a1 = acc[ai][bj][m][1];
                    u32x4 w; w.x = cvt_pk_bf16(alpha * bflo(x4.x) + a0[0], alpha * bfhi(x4.x) + a0[1]); w.y = cvt_pk_bf16(alpha * bflo(x4.y) + a0[2], alpha * bfhi(x4.y) + a0[3]);
                    w.z = cvt_pk_bf16(alpha * bflo(x4.z) + a1[0], alpha * bfhi(x4.z) + a1[1]); w.w = cvt_pk_bf16(alpha * bflo(x4.w) + a1[2], alpha * bfhi(x4.w) + a1[3]);
                    *(u32x4*)(Y + ro + bj * HALF) = w; } }
    }
};
struct EpiKV {
    static constexpr bool PERM = false, AFTER_DRAIN = false;
    float *okp, *ovp, *oks, *ovs; bf16_t *kpb, *vpb, *ksb, *vsb;
    __device__ __forceinline__ void operator()(const f32x4 (&acc)[2][2][4][2], const Unit& u, int wr, int wc, int fr, int fq) const {
        const bool isv = u.pn >= 6; const int colt = (u.pn - (isv ? 6 : 0)) * BM + wc * 32 + 4 * fq, row0 = u.pm * BM + wr * 64 + fr;
        float* op = isv ? ovp : okp;
#pragma unroll
        for (int ai = 0; ai < 2; ++ai)
#pragma unroll
            for (int m = 0; m < 4; ++m) { const int row = row0 + ai * HALF + m * 16; float* fd;
                if (row < 32768) { fd = op + (size_t)row * 1536; } else continue;
                const int bq = row >> 13, sq = row & 8191;
#pragma unroll
                for (int bj = 0; bj < 2; ++bj)
#pragma unroll
                    for (int n = 0; n < 2; ++n) { const int c = colt + bj * HALF + n * 16; const f32x4 v = acc[ai][bj][m][n];
                        *(f32x4*)(fd + c) = v; const unsigned w0 = cvt_pk_bf16(v[0], v[1]), w1 = cvt_pk_bf16(v[2], v[3]);
                        const int hq = c >> 7, dq = c & 127;
                        if (!isv) { u32x2 w; w.x = w0; w.y = w1; *(u32x2*)(kpb + ((size_t)(bq * 12 + hq) * 8192 + sq) * 128 + dq) = w; }
                        else { bf16_t* vt = vpb + ((size_t)(bq * 12 + hq) * 256 + (sq >> 5)) * 4096 + vtf_d(dq) + vtf_k(sq & 31); vt[0] = (bf16_t)w0; vt[8] = (bf16_t)(w0 >> 16); vt[16] = (bf16_t)w1; vt[24] = (bf16_t)(w1 >> 16); } } }
    }
};
struct EpiMemKV {
    static constexpr bool PERM = false, AFTER_DRAIN = false;
    float *ok, *ov; bf16_t *kb, *vb;
    __device__ __forceinline__ void operator()(const f32x4 (&acc)[2][2][4][2], const Unit& u, int wr, int wc, int fr, int fq) const {
        const int l = u.pn >> 2, kv = (u.pn >> 1) & 1, hd0 = (u.pn & 1) * BM + wc * 32 + 4 * fq, row0 = u.pm * BM + wr * 64 + fr;
        float* fo = kv ? ov : ok; bf16_t* bo = kv ? vb : kb;
#pragma unroll
        for (int ai = 0; ai < 2; ++ai)
#pragma unroll
            for (int m = 0; m < 4; ++m) { const int row = row0 + ai * HALF + m * 16, b = row >> 8, mm = row & 255;
                float* fd = fo + (size_t)(l * 1024 + row) * 512; bf16_t* bd = bo + (size_t)((l * 12 + b) * 256 + mm) * 512;
#pragma unroll
                for (int bj = 0; bj < 2; ++bj)
#pragma unroll
                    for (int n = 0; n < 2; ++n) { const int c = hd0 + bj * HALF + n * 16; const f32x4 v = acc[ai][bj][m][n];
                        *(f32x4*)(fd + c) = v; const unsigned w0 = cvt_pk_bf16(v[0], v[1]), w1 = cvt_pk_bf16(v[2], v[3]);
                        if (!kv) { u32x2 w; w.x = w0; w.y = w1; *(u32x2*)(bd + c) = w; }
                        else { bf16_t* vt = vb + (size_t)((l * 12 + b) * 512 + c) * 256 + mm;
                            vt[0] = (bf16_t)w0; vt[256] = (bf16_t)(w0 >> 16); vt[512] = (bf16_t)w1; vt[768] = (bf16_t)(w1 >> 16); } } }
    }
};
template <class Epi, class Sched, bool ALIGN_EPI = false, bool SP2 = false>
__device__ __forceinline__ void gemm_phase(PG8_LAS unsigned char* lds, const Gemm g, const Sched& S, const Epi& E, int tid_in) {
    int tid_ = tid_in; asm volatile("" : "+v"(tid_));
    const int tid = tid_, wid = __builtin_amdgcn_readfirstlane(tid >> 6), lane = tid & 63, wr = wid >> 2, wc = wid & 3, fr = lane & 15, fq = lane >> 4;
    const int K = g.K, nt = K / BK;
    unsigned voffA[2], voffB[2];
#pragma unroll
    for (int i = 0; i < 2; ++i) { int R, C; stage_rc(tid * 16 + i * 8192, R, C); const int Rb = Epi::PERM ? ((R & ~31) + perm32(R & 31)) : R;
        voffA[i] = (unsigned)(R * K + C) * 2u; voffB[i] = (unsigned)(Rb * K + C) * 2u; }
    const size_t kstep = (size_t)(BK * 2);
    const size_t hstep = (size_t)HALF * K * 2;
    const size_t tstep = 2 * hstep;
    const unsigned ldsw = (unsigned)wid * 1024u;
    const int aoff = lds_byte(wr * 64 + fr, fq * 8), boff = lds_byte(wc * 32 + fr, fq * 8);
#define PG8_SA(b, h) (((b) * 2 + (h)) * HTB)
#define PG8_SB(b, h) ((4 + (b) * 2 + (h)) * HTB)
#define PG8_STAGE_X(bufoff, gbase, voff, aux) do { _Pragma("unroll") for (int _i = 0; _i < 2; ++_i) \
        __builtin_amdgcn_global_load_lds((const unsigned*)((const char*)(gbase) + (voff)[_i]), (PG8_LAS unsigned*)(lds + (bufoff) + ldsw + _i * 8192), 16, 0, aux); } while (0)
#ifndef PG8_B_AUX
#define PG8_B_AUX 0
#endif
#define PG8_STAGE(bufoff, gbase, voff) PG8_STAGE_X(bufoff, gbase, voff, 0)
#define PG8_LDA(dst, b, h) do { _Pragma("unroll") for (int m = 0; m < 4; ++m) _Pragma("unroll") for (int k = 0; k < 2; ++k) dst[m][k] = *(const PG8_LAS bf16x8*)(lds + PG8_SA(b, h) + aoff + m * 2048 + k * 1024); } while (0)
#define PG8_LDB(dst, b, h) do { _Pragma("unroll") for (int n = 0; n < 2; ++n) _Pragma("unroll") for (int k = 0; k < 2; ++k) dst[n][k] = *(const PG8_LAS bf16x8*)(lds + PG8_SB(b, h) + boff + n * 2048 + k * 1024); } while (0)
#define PG8_MMA(ai, bj, At, Bt) do { __builtin_amdgcn_s_setprio(1); _Pragma("unroll") for (int m = 0; m < 4; ++m) _Pragma("unroll") for (int n = 0; n < 2; ++n) _Pragma("unroll") for (int k = 0; k < 2; ++k) \
        acc[ai][bj][m][n] = __builtin_amdgcn_mfma_f32_16x16x32_bf16(Bt[n][k], At[m][k], acc[ai][bj][m][n], 0, 0, 0); __builtin_amdgcn_s_setprio(0); } while (0)
#define PG8_WAIT_V(n) asm volatile("s_waitcnt vmcnt(" #n ")" ::: "memory")
#define PG8_WAIT_L(n) asm volatile("s_waitcnt lgkmcnt(" #n ")" ::: "memory")
#define PG8_BAR __builtin_amdgcn_s_barrier()
#define PG8_SCHED __builtin_amdgcn_sched_barrier(0)
    Unit cur, nxt; int ui = 0;
    if (!S.next(0, cur)) return;
    f32x4 acc[2][2][4][2];
#pragma unroll
    for (int a = 0; a < 2; ++a)
#pragma unroll
        for (int b = 0; b < 2; ++b)
#pragma unroll
            for (int m = 0; m < 4; ++m)
#pragma unroll
                for (int n = 0; n < 2; ++n) acc[a][b][m][n] = (f32x4){0.f, 0.f, 0.f, 0.f};
    bf16x8 At[4][2], B0[2][2], B1[2][2];
    const char* cA = (const char*)g.A + (size_t)cur.pm * tstep; const char* cB = (const char*)g.Bt + (size_t)cur.pn * tstep;
    S.a_ready(cur);
    if constexpr (SP2) {
        PG8_STAGE_X(PG8_SB(0, 0), cB, voffB, PG8_B_AUX); PG8_STAGE_X(PG8_SB(0, 1), cB + hstep, voffB, PG8_B_AUX); PG8_STAGE(PG8_SA(0, 0), cA, voffA); PG8_STAGE(PG8_SA(0, 1), cA + hstep, voffA);
        if (wr == 1) PG8_BAR;
        PG8_WAIT_V(2); PG8_BAR;
        PG8_STAGE_X(PG8_SB(1, 0), cB + kstep, voffB, PG8_B_AUX); PG8_STAGE(PG8_SA(1, 0), cA + kstep, voffA); PG8_STAGE_X(PG8_SB(1, 1), cB + hstep + kstep, voffB, PG8_B_AUX);
        PG8_WAIT_V(6); PG8_BAR;
    } else {
        PG8_STAGE_X(PG8_SB(0, 0), cB, voffB, PG8_B_AUX); PG8_STAGE(PG8_SA(0, 0), cA, voffA); PG8_STAGE_X(PG8_SB(0, 1), cB + hstep, voffB, PG8_B_AUX); PG8_STAGE(PG8_SA(0, 1), cA + hstep, voffA);
        if (wr == 1) PG8_BAR;
        PG8_WAIT_V(4); PG8_BAR;
        PG8_STAGE_X(PG8_SB(1, 0), cB + kstep, voffB, PG8_B_AUX); PG8_STAGE(PG8_SA(1, 0), cA + kstep, voffA); PG8_STAGE_X(PG8_SB(1, 1), cB + hstep + kstep, voffB, PG8_B_AUX);
        PG8_WAIT_V(6); PG8_BAR;
    }
    for (;;) {
        const bool has_next = S.next(ui + 1, nxt);
        const char* nA = has_next ? (const char*)g.A + (size_t)nxt.pm * tstep : cA; const char* nB = has_next ? (const char*)g.Bt + (size_t)nxt.pn * tstep : cB;
        for (int t = 0; t < nt; t += 2) {
            const bool last = (t == nt - 2);
            const char* a1 = cA + (size_t)(t + 1) * kstep;
            const char* a2 = last ? nA : cA + (size_t)(t + 2) * kstep; const char* b2 = last ? nB : cB + (size_t)(t + 2) * kstep;
            const char* a3 = a2 + kstep; const char* b3 = b2 + kstep;
            if (last && has_next) S.a_ready(nxt);
            if constexpr (SP2) {
            PG8_LDB(B0, 0, 0); PG8_LDB(B1, 0, 1); PG8_SCHED; PG8_LDA(At, 0, 0); PG8_STAGE(PG8_SA(1, 1), a1 + hstep, voffA);
            PG8_WAIT_V(8); PG8_WAIT_L(0); PG8_BAR; PG8_MMA(0, 0, At, B0); PG8_MMA(0, 1, At, B1); PG8_BAR; PG8_SCHED;
            PG8_LDA(At, 0, 1); PG8_STAGE_X(PG8_SB(0, 0), b2, voffB, PG8_B_AUX); PG8_STAGE_X(PG8_SB(0, 1), b2 + hstep, voffB, PG8_B_AUX); PG8_STAGE(PG8_SA(0, 0), a2, voffA);
            PG8_WAIT_V(8); PG8_WAIT_L(0); PG8_BAR; PG8_MMA(1, 0, At, B0); PG8_MMA(1, 1, At, B1); PG8_BAR; PG8_SCHED;
            PG8_LDB(B0, 1, 0); PG8_LDB(B1, 1, 1); PG8_SCHED; PG8_LDA(At, 1, 0); PG8_STAGE(PG8_SA(0, 1), a2 + hstep, voffA);
            PG8_WAIT_V(8); PG8_WAIT_L(0); PG8_BAR; PG8_MMA(0, 0, At, B0); PG8_MMA(0, 1, At, B1); PG8_BAR; PG8_SCHED;
            PG8_LDA(At, 1, 1); PG8_STAGE_X(PG8_SB(1, 0), b3, voffB, PG8_B_AUX); PG8_STAGE_X(PG8_SB(1, 1), b3 + hstep, voffB, PG8_B_AUX); PG8_STAGE(PG8_SA(1, 0), a3, voffA);
            PG8_WAIT_V(8); PG8_WAIT_L(0); PG8_BAR; PG8_MMA(1, 0, At, B0); PG8_MMA(1, 1, At, B1); PG8_BAR; PG8_SCHED;
            } else {
            PG8_LDB(B0, 0, 0); PG8_SCHED; PG8_LDA(At, 0, 0); PG8_STAGE(PG8_SA(1, 1), a1 + hstep, voffA);
            PG8_WAIT_L(8); PG8_BAR; PG8_WAIT_L(0); PG8_MMA(0, 0, At, B0); PG8_BAR; PG8_SCHED;
            PG8_LDB(B1, 0, 1); PG8_STAGE_X(PG8_SB(0, 0), b2, voffB, PG8_B_AUX);
            PG8_BAR; PG8_WAIT_L(0); PG8_MMA(0, 1, At, B1); PG8_BAR;
            PG8_LDA(At, 0, 1); PG8_STAGE(PG8_SA(0, 0), a2, voffA);
            PG8_BAR; PG8_WAIT_L(0); PG8_MMA(1, 0, At, B0); PG8_BAR; PG8_SCHED;
            PG8_STAGE_X(PG8_SB(0, 1), b2 + hstep, voffB, PG8_B_AUX);
            PG8_WAIT_V(6); PG8_BAR; PG8_MMA(1, 1, At, B1); PG8_BAR;
            PG8_LDB(B0, 1, 0); PG8_SCHED; PG8_LDA(At, 1, 0); PG8_STAGE(PG8_SA(0, 1), a2 + hstep, voffA);
            PG8_WAIT_L(8); PG8_BAR; PG8_WAIT_L(0); PG8_MMA(0, 0, At, B0); PG8_BAR; PG8_SCHED;
            PG8_LDB(B1, 1, 1); PG8_STAGE_X(PG8_SB(1, 0), b3, voffB, PG8_B_AUX);
            PG8_BAR; PG8_WAIT_L(0); PG8_MMA(0, 1, At, B1); PG8_BAR;
            PG8_LDA(At, 1, 1); PG8_STAGE(PG8_SA(1, 0), a3, voffA);
            PG8_BAR; PG8_WAIT_L(0); PG8_MMA(1, 0, At, B0); PG8_BAR; PG8_SCHED;
            PG8_STAGE_X(PG8_SB(1, 1), b3 + hstep, voffB, PG8_B_AUX);
            PG8_WAIT_V(6); PG8_BAR; PG8_MMA(1, 1, At, B1); PG8_BAR;
            }
        }
        if constexpr (ALIGN_EPI) { if (wr == 0) PG8_BAR; }
        if constexpr (!Epi::AFTER_DRAIN) { E(acc, cur, wr, wc, fr, fq); S.done(cur); }
        if (!has_next) break;
#pragma unroll
        for (int a = 0; a < 2; ++a)
#pragma unroll
            for (int b = 0; b < 2; ++b)
#pragma unroll
                for (int m = 0; m < 4; ++m)
#pragma unroll
                    for (int n = 0; n < 2; ++n) acc[a][b][m][n] = (f32x4){0.f, 0.f, 0.f, 0.f};
        cur = nxt; cA = nA; cB = nB; ++ui;
        if constexpr (ALIGN_EPI) { if (wr == 1) PG8_BAR; }
    }
    PG8_WAIT_V(0);
    if constexpr (!ALIGN_EPI) { if (wr == 0) PG8_BAR; }
    PG8_BAR;
    if constexpr (Epi::AFTER_DRAIN) { E.fused(acc, cur, wr, wc, fr, fq, lds, wid, lane); S.done(cur); }
#undef PG8_SA
#undef PG8_SB
#undef PG8_STAGE
#undef PG8_STAGE_X
#undef PG8_LDA
#undef PG8_LDB
#undef PG8_MMA
#undef PG8_WAIT_V
#undef PG8_WAIT_L
#undef PG8_BAR
#undef PG8_SCHED
}
}
#define GAS __attribute__((address_space(1)))
#define LAS __attribute__((address_space(3)))
typedef unsigned short bf16;
typedef unsigned v4u __attribute__((ext_vector_type(4)));
typedef float f32x4 __attribute__((ext_vector_type(4)));
typedef short bf16x8 __attribute__((ext_vector_type(8)));
typedef GAS unsigned gu32;
typedef GAS unsigned long long gu64;
#define RLX_AGENT __ATOMIC_RELAXED, __HIP_MEMORY_SCOPE_AGENT
#define LDS_WAIT() asm volatile("s_waitcnt lgkmcnt(0)" ::: "memory")
#define VM_WAIT() asm volatile("s_waitcnt vmcnt(0)" ::: "memory")
__device__ __forceinline__ unsigned long long rt() { return __builtin_amdgcn_s_memrealtime(); }
__device__ __forceinline__ unsigned f2bf(float f) { unsigned u = __builtin_bit_cast(unsigned, f); return (u + 0x7fffu + ((u >> 16) & 1u)) >> 16; }
__device__ __forceinline__ unsigned pk2(float lo, float hi) { return f2bf(lo) | (f2bf(hi) << 16); }
#define XB_TMO      128
#define XB_XCNT(j)  (256  + 64 * (j))
#define XB_XSUB(j)  (1280 + 64 * (j))
#define XB_XGEN(j)  (2304 + 64 * (j))
#define XB_TOP      3328
#define XB_TOPGEN   3392
#define XCD_BAR_WORDS 3456
#define XB_SPIN_CAP (1u << 18)

__device__ __forceinline__ unsigned xb_ld(unsigned* p)              { return __hip_atomic_load(p, __ATOMIC_RELAXED, __HIP_MEMORY_SCOPE_AGENT); }
__device__ __forceinline__ unsigned xb_add(unsigned* p, unsigned v) { return __hip_atomic_fetch_add(p, v, __ATOMIC_RELAXED, __HIP_MEMORY_SCOPE_AGENT); }
__device__ __forceinline__ unsigned xb_xcc_id() { return (unsigned)__builtin_amdgcn_s_getreg((3 << 11) | 20) & 0xFu; }
#define XB_SPIN(cond, bar) do { unsigned _sp = 0; while (cond) { __builtin_amdgcn_s_sleep(1); \
    if ((++_sp & 255u) == 0u) { if (xb_ld(&(bar)[XB_TMO])) break; if (_sp > XB_SPIN_CAP) { atomicAdd(&(bar)[XB_TMO], 1u); break; } } } } while (0)

struct XcdBarrier {
    unsigned* bar; unsigned x;
    volatile LAS unsigned* st;
};

__device__ __forceinline__ XcdBarrier xcd_barrier_post(unsigned* bar, volatile LAS unsigned* st) {
    XcdBarrier b; b.bar = bar; b.x = xb_xcc_id(); b.st = st;
    if (threadIdx.x == 0) (void)xb_add(&bar[XB_XCNT(b.x)], 1u);
    return b;
}
__device__ __forceinline__ void xcd_barrier_complete(unsigned* bar, unsigned x, unsigned& nloc, unsigned& nx) {
    const unsigned G = gridDim.x * gridDim.y * gridDim.z;
    unsigned sum, cnt, mine, sp = 0u;
    for (;;) {
        sum = 0u; cnt = 0u; mine = 0u;
#pragma unroll
        for (unsigned j = 0; j < 16; ++j) { const unsigned c = xb_ld(&bar[XB_XCNT(j)]); sum += c; cnt += (c > 0u) ? 1u : 0u; mine = (j == x) ? c : mine; }
        if (sum == G) break;
        __builtin_amdgcn_s_sleep(1);
        if ((++sp & 255u) == 0u) { if (xb_ld(&bar[XB_TMO])) break; if (sp > XB_SPIN_CAP) { atomicAdd(&bar[XB_TMO], 1u); break; } }
    }
    nloc = mine > 0u ? mine : 1u; nx = cnt > 0u ? cnt : 1u;
}

__device__ __forceinline__ void xcd_barrier(const XcdBarrier& b) {
    asm volatile("s_waitcnt vmcnt(0)" ::: "memory");
    __syncthreads();
    if (threadIdx.x == 0) {
        unsigned* bar = b.bar;
        __builtin_amdgcn_s_waitcnt(0);
        unsigned nloc = b.st[0], nx = b.st[1];
        if (nloc == 0u) { xcd_barrier_complete(bar, b.x, nloc, nx); b.st[0] = nloc; b.st[1] = nx; }
        const unsigned old = xb_add(&bar[XB_XSUB(b.x)], 1u);
        const unsigned gen = old / nloc;
        if (old + 1u == (gen + 1u) * nloc) {
            __builtin_amdgcn_fence(__ATOMIC_RELEASE, "agent");
            asm volatile("s_waitcnt vmcnt(0)" ::: "memory");
            const unsigned og = xb_add(&bar[XB_TOP], 1u);
            const unsigned tg = og / nx;
            if (og + 1u == (tg + 1u) * nx) xb_add(&bar[XB_TOPGEN], 1u);
            else XB_SPIN(xb_ld(&bar[XB_TOPGEN]) == tg, bar);
            __builtin_amdgcn_fence(__ATOMIC_ACQUIRE, "agent");
            xb_add(&bar[XB_XGEN(b.x)], 1u);
            asm volatile("s_waitcnt vmcnt(0)" ::: "memory");
        } else {
            XB_SPIN(xb_ld(&bar[XB_XGEN(b.x)]) == gen, bar);
            __builtin_amdgcn_fence(__ATOMIC_ACQUIRE, "agent");
            asm volatile("s_waitcnt vmcnt(0)" ::: "memory");
        }
    }
    __syncthreads();
}
constexpr int NWAVES = 8;
constexpr int D = 2048, SEQ = 8192, MP = 32768, MS = 128, MR = 32896, MT = 33024;
constexpr int DFF = 5632, NA = 5376, NBQ = 2048, NKV = 3072;
constexpr int CQ = 0, CK = 768, CV = 1536, CG = 3072, CQM = 4608, CLR = 5120;
constexpr float DN_ALPHA = 1.6817928305074292f, LN_EPS = 1e-5f, RMS_EPS = 1e-6f;
constexpr float GLA_QSCALE = 0.07216878364870323f, HD_SCALE = 0.08838834764831845f;
constexpr size_t MiB = 1u << 20;
constexpr size_t WS_CTL = 0, CTL_ZERO_BYTES = 1 * MiB;
constexpr size_t WS_WIN = 1 * MiB, WS_WO = 22 * MiB, WS_WFI = 30 * MiB, WS_WFO = 74 * MiB, WS_WMEM = 96 * MiB, WS_MEMX = 112 * MiB, WS_MEMK = 116 * MiB, WS_MEMV = 128 * MiB;
constexpr size_t WS_X = 140 * MiB, WS_Y = 269 * MiB, WS_R1 = 527 * MiB, WS_OCAT = 882 * MiB, WS_SBKS = 1011 * MiB, WS_SBVS = 1060 * MiB, WS_END = 1109 * MiB;
static_assert(WS_WIN + (size_t)NA * D * 2 <= WS_WO && WS_WFI + (size_t)2 * DFF * D * 2 <= WS_WFO && WS_WFO + (size_t)D * DFF * 2 <= WS_WMEM, "weights map");
static_assert(WS_X + (size_t)MT * D * 2 <= WS_Y && WS_Y + (size_t)MT * D * 4 <= WS_R1 && WS_R1 + (size_t)MT * DFF * 2 <= WS_OCAT && WS_OCAT + (size_t)MT * D * 2 <= WS_SBKS, "activation map");
static_assert(WS_SBKS + (size_t)8 * 2064 * 1536 * 2 <= WS_SBVS && WS_SBVS + (size_t)8 * 2064 * 1536 * 2 <= WS_END, "sb sample map");
constexpr size_t O_YP = 0, O_YS = 67108864, O_GSP = 67371008, O_GSS = 69730304, O_SKP = 74448896, O_SVP = 124780544, O_SKS = 175112192, O_SVS = 175308800, O_MKP = 175505408, O_MVP = 177602560, O_END = 179699712;
constexpr int CW_BAR = 4096;
constexpr int RING_OFF = 0, RING_BYTES = 131072, LDSCTL_OFF = RING_BYTES, MISC_OFF = LDSCTL_OFF + 320, LDS_BYTES = 147456;

struct Args { const float* in[22]; float* out_; unsigned char* ws_; int ph_lo, ph_hi; };
struct Frame {
    LAS unsigned char* lds; volatile LAS unsigned* MISC; gu32* ctl;
    int tid, lane, wave, G, gw, NGW;
};
__device__ __forceinline__ float bf2f(bf16 h) { return __builtin_bit_cast(float, (unsigned)h << 16); }
__device__ __forceinline__ float shx(float v, int lane, int m) { return __builtin_bit_cast(float, __builtin_amdgcn_ds_bpermute((lane ^ m) << 2, __builtin_bit_cast(int, v))); }
__device__ __forceinline__ float wave_sum(float v, int lane) {
#pragma unroll
    for (int o = 1; o < 64; o <<= 1) v += shx(v, lane, o);
    return v;
}
__device__ __forceinline__ float wave_max(float v, int lane) {
#pragma unroll
    for (int o = 1; o < 64; o <<= 1) v = fmaxf(v, shx(v, lane, o));
    return v;
}
__device__ __forceinline__ void cvt_row(const float* src, bf16* dst, int n, int lane) {
    for (int j = lane * 4; j < n; j += 256) {
        f32x4 v = src ? *(const f32x4*)(src + j) : (f32x4){0.f, 0.f, 0.f, 0.f};
        unsigned long long w = (unsigned long long)pk2(v.x, v.y) | ((unsigned long long)pk2(v.z, v.w) << 32);
        *(unsigned long long*)(dst + j) = w;
    }
}
template <int N>
__device__ __forceinline__ void cvt_rows2(const float* s0, const float* s1, bf16* d0, bf16* d1, int lane) {
    f32x4 v0[N / 256], v1[N / 256];
#pragma unroll
    for (int j = 0; j < N / 256; ++j) { v0[j] = s0 ? *(const f32x4*)(s0 + lane * 4 + 256 * j) : (f32x4){0.f, 0.f, 0.f, 0.f}; v1[j] = s1 ? *(const f32x4*)(s1 + lane * 4 + 256 * j) : (f32x4){0.f, 0.f, 0.f, 0.f}; }
#pragma unroll
    for (int j = 0; j < N / 256; ++j) {
        *(unsigned long long*)(d0 + lane * 4 + 256 * j) = (unsigned long long)pk2(v0[j].x, v0[j].y) | ((unsigned long long)pk2(v0[j].z, v0[j].w) << 32);
        *(unsigned long long*)(d1 + lane * 4 + 256 * j) = (unsigned long long)pk2(v1[j].x, v1[j].y) | ((unsigned long long)pk2(v1[j].z, v1[j].w) << 32); }
}
__device__ __forceinline__ int fresh_lane() { int z = 0; asm volatile("" : "+s"(z)); return (int)__builtin_amdgcn_mbcnt_hi(~0u, __builtin_amdgcn_mbcnt_lo(~0u, (unsigned)z)); }
#define FRESH_TID() (wave_ * 64 + fresh_lane())
template <bool FINAL>
__device__ __forceinline__ void ln_two_rows(int lane, const v4u (&w)[2][4], const float* gg, const float* bb, bf16* x0, bf16* x1, float* of0, float* of1) {
    float v[2][4][8]; float s[2] = {0.f, 0.f};
#pragma unroll
    for (int r = 0; r < 2; ++r)
#pragma unroll
        for (int j = 0; j < 4; ++j) { const v4u q = w[r][j]; v[r][j][0] = pg8::bflo(q.x); v[r][j][1] = pg8::bfhi(q.x); v[r][j][2] = pg8::bflo(q.y); v[r][j][3] = pg8::bfhi(q.y); v[r][j][4] = pg8::bflo(q.z); v[r][j][5] = pg8::bfhi(q.z); v[r][j][6] = pg8::bflo(q.w); v[r][j][7] = pg8::bfhi(q.w);
            s[r] += ((v[r][j][0] + v[r][j][1]) + (v[r][j][2] + v[r][j][3])) + ((v[r][j][4] + v[r][j][5]) + (v[r][j][6] + v[r][j][7])); }
    const float m0 = wave_sum(s[0], lane) * (1.f / D), m1 = wave_sum(s[1], lane) * (1.f / D); float q0 = 0.f, q1 = 0.f;
#pragma unroll
    for (int j = 0; j < 4; ++j)
#pragma unroll
        for (int i = 0; i < 8; ++i) { v[0][j][i] -= m0; q0 += v[0][j][i] * v[0][j][i]; v[1][j][i] -= m1; q1 += v[1][j][i] * v[1][j][i]; }
    const float rs[2] = {1.f / sqrtf(wave_sum(q0, lane) * (1.f / D) + LN_EPS), 1.f / sqrtf(wave_sum(q1, lane) * (1.f / D) + LN_EPS)};
#pragma unroll
    for (int j = 0; j < 4; ++j) { const int e0 = (lane + 64 * j) * 8; const f32x4 g0 = *(const f32x4*)(gg + e0), g1 = *(const f32x4*)(gg + e0 + 4), b0 = *(const f32x4*)(bb + e0), b1 = *(const f32x4*)(bb + e0 + 4);
#pragma unroll
        for (int r = 0; r < 2; ++r) { float o[8];
#pragma unroll
            for (int i = 0; i < 4; ++i) { o[i] = v[r][j][i] * rs[r] * g0[i] + b0[i]; o[4 + i] = v[r][j][4 + i] * rs[r] * g1[i] + b1[i]; }
            if (FINAL) { float* of = r ? of1 : of0; *(f32x4*)(of + e0) = (f32x4){o[0], o[1], o[2], o[3]}; *(f32x4*)(of + e0 + 4) = (f32x4){o[4], o[5], o[6], o[7]}; }
            else { v4u p; p.x = pk2(o[0], o[1]); p.y = pk2(o[2], o[3]); p.z = pk2(o[4], o[5]); p.w = pk2(o[6], o[7]); *(v4u*)((r ? x1 : x0) + e0) = p; } } }
}
template <bool FINAL, class OutF>
__device__ __forceinline__ void ln_rows(int lane, int gw, int NGW, const bf16* YBp, const float* gg, const float* bb, bf16* Xp, OutF outf) {
    const bool has_ex = gw < MR - MP; const int exrow = MP + gw; v4u ex[2][4];
    if (has_ex) {
#pragma unroll
        for (int j = 0; j < 4; ++j) ex[0][j] = ((const v4u*)(YBp + (size_t)exrow * D))[lane + 64 * j]; }
    __builtin_amdgcn_sched_barrier(0);
#pragma unroll 1
    for (int row = 2 * gw; row < MP; row += 2 * NGW) { v4u w[2][4];
#pragma unroll
        for (int j = 0; j < 4; ++j) { w[0][j] = ((const v4u*)(YBp + (size_t)row * D))[lane + 64 * j]; w[1][j] = ((const v4u*)(YBp + (size_t)(row + 1) * D))[lane + 64 * j]; }
        if (FINAL) { float* of = outf(row); ln_two_rows<true>(lane, w, gg, bb, nullptr, nullptr, of, of + D); }
        else ln_two_rows<false>(lane, w, gg, bb, Xp + (size_t)row * D, Xp + (size_t)(row + 1) * D, nullptr, nullptr); }
    if (has_ex) {
#pragma unroll
        for (int j = 0; j < 4; ++j) ex[1][j] = ex[0][j];
        if (FINAL) { float* of = outf(exrow); ln_two_rows<true>(lane, ex, gg, bb, nullptr, nullptr, of, of); }
        else ln_two_rows<false>(lane, ex, gg, bb, Xp + (size_t)exrow * D, Xp + (size_t)exrow * D, nullptr, nullptr); }
}
struct MapId { __device__ __forceinline__ int operator()(int n) const { return n; } };
struct MapInA { __device__ __forceinline__ int operator()(int n) const { return n < 4608 ? n : (n < 5120 ? n + 16 : (n < 5136 ? n - 512 : -1)); } };
struct MapFfn { __device__ __forceinline__ int operator()(int n) const { const int t = n >> 8, r = n & 255; return r < 128 ? 128 * t + r : DFF + 128 * t + (r - 128); } };
template <class Map>
__device__ __forceinline__ void wt_convert(LAS unsigned char* ldsb, int wave, int gw, int NGW, int lane, const float* W, int K, int Nsrc, bf16* WT, int Ndst, Map map) {
    LAS float* scr = (LAS float*)(ldsb + RING_OFF + wave * 16384);
    const int nblk = Ndst / 64, nitems = (K / 64) * nblk, nq = lane & 15, kq = lane >> 4;
    for (int it = gw; it < nitems; it += NGW) {
        const int kb = it / nblk, nb = it % nblk, k0 = 64 * kb, n0 = 64 * nb;
        const int sc0 = map(n0 + 4 * nq), sc3 = map(n0 + 4 * nq + 3);
        const bool contig = sc0 >= 0 && sc3 == sc0 + 3;
        f32x4 v[16];
#pragma unroll
        for (int i = 0; i < 16; ++i) { const int kk = 4 * i + kq;
            if (contig) v[i] = *(const f32x4*)(W + (size_t)(k0 + kk) * Nsrc + sc0);
            else {
#pragma unroll
                for (int e = 0; e < 4; ++e) { const int sc = map(n0 + 4 * nq + e); v[i][e] = sc >= 0 ? W[(size_t)(k0 + kk) * Nsrc + sc] : 0.f; } } }
#pragma unroll
        for (int i = 0; i < 16; ++i) { const int kk = 4 * i + kq;
#pragma unroll
            for (int e = 0; e < 4; ++e) { const int n = 4 * nq + e; scr[n * 64 + (kk ^ n)] = v[i][e]; } }
        LDS_WAIT(); asm volatile("" ::: "memory");
        const int c = lane & 7;
#pragma unroll
        for (int j = 0; j < 8; ++j) { const int n = (lane >> 3) + 8 * j; const LAS float* s = scr + n * 64;
#define SWZ(i) s[(8 * c + (i)) ^ n]
            v4u o; o.x = pk2(SWZ(0), SWZ(1)); o.y = pk2(SWZ(2), SWZ(3)); o.z = pk2(SWZ(4), SWZ(5)); o.w = pk2(SWZ(6), SWZ(7));
#undef SWZ
            *(GAS v4u*)(WT + (size_t)(n0 + n) * K + k0 + 8 * c) = o; }
        LDS_WAIT(); asm volatile("" ::: "memory");
    }
}
__device__ __forceinline__ float softplus_f(float z) { return fmaxf(z, 0.f) + log1pf(__expf(-fabsf(z))); }

typedef short s16x4 __attribute__((ext_vector_type(4)));
typedef pg8::u32x2 u32x2;
typedef float f32x16 __attribute__((ext_vector_type(16)));
typedef __bf16 bf16x2_t __attribute__((ext_vector_type(2)));
typedef float f32x2_t __attribute__((ext_vector_type(2)));
__device__ __forceinline__ unsigned cvt2(float lo, float hi) { const f32x2_t v = {lo, hi}; const bf16x2_t b = __builtin_convertvector(v, bf16x2_t); return __builtin_bit_cast(unsigned, b); }
__device__ __forceinline__ bf16x8 pack8(const f32x4 a, const f32x4 b) { v4u p; p.x = cvt2(a[0], a[1]); p.y = cvt2(a[2], a[3]); p.z = cvt2(b[0], b[1]); p.w = cvt2(b[2], b[3]); return __builtin_bit_cast(bf16x8, p); }
__device__ __forceinline__ bf16x8 ld2x8(const bf16* p0, const bf16* p1) { const s16x4 a = *(const s16x4*)p0, b = *(const s16x4*)p1; return __builtin_shufflevector(a, b, 0, 1, 2, 3, 4, 5, 6, 7); }
__device__ __forceinline__ bf16x8 ld16(const bf16* p) { return *(const bf16x8*)p; }
#define MFMA16(a, b, c) __builtin_amdgcn_mfma_f32_16x16x32_bf16((a), (b), (c), 0, 0, 0)
#define MFMA32(a, b, c) __builtin_amdgcn_mfma_f32_32x32x16_bf16((a), (b), (c), 0, 0, 0)

constexpr int QIMG_LD = 200, KTIMG_LD = 68, PKG_Q = 0, PKG_KT = 25600, PKG_G = 51712, IMG_BYTES = 52480, PKG_K = 52480, PKG_VT = 77056, PKG_BYTES = 126208, N_PKG = 2048 + 32;
static_assert(64 * QIMG_LD * 2 == PKG_KT && PKG_KT + 192 * KTIMG_LD * 2 == PKG_G && PKG_G + 768 == IMG_BYTES && PKG_K + 24576 == PKG_VT && PKG_VT + 49152 == PKG_BYTES && IMG_BYTES % 16 == 0, "package map");

__device__ __forceinline__ float softplus_fast(float z) { return fmaxf(z, 0.f) + __logf(1.0f + __expf(-fabsf(z))); }
constexpr int GL_TOT = 0, GL_Q = 6144, GL_K = GL_Q + 64 * QIMG_LD * 2, GL_V = GL_K + 64 * QIMG_LD * 2, VL_LD = 68, GL_P = GL_V + 384 * VL_LD * 2, P_LD = 68, GL_LRN = GL_P + 64 * P_LD * 2, GL_END = GL_LRN + 2048;
static_assert(GL_END <= RING_BYTES && GL_Q % 16 == 0 && GL_K % 16 == 0 && GL_V % 8 == 0 && GL_P % 8 == 0 && GL_LRN % 16 == 0 && MISC_OFF + 256 + 17 * 192 * 4 <= LDS_BYTES, "gla_prep_intra LDS map");
template <int MODE>
__device__ __forceinline__ void gla_prep_intra(int bid, int G, int tid, int wave, LAS unsigned char* lds, int l, const bf16* PROJ, const float* w_gate_lr, const float* b_gate, unsigned char* PKG, bf16* OINT) {
    const int lane = tid & 63, fr = lane & 15, fq = lane >> 4;
    const float* w2 = w_gate_lr + (size_t)l * 16 * 768; const float* bg = b_gate + (size_t)l * 768;
    LAS float* tot = (LAS float*)(lds + GL_TOT);
    LAS bf16* QL = (LAS bf16*)(lds + GL_Q); LAS bf16* KL = (LAS bf16*)(lds + GL_K); LAS bf16* VL = (LAS bf16*)(lds + GL_V); LAS bf16* P = (LAS bf16*)(lds + GL_P);
    LAS unsigned char* LRN = lds + GL_LRN;
    auto item_of = [&](int j) -> int {
        if (MODE == 1) return j < 8 ? ((((j >> 1) << 2) | (bid & 3)) << 7) | ((bid >> 2) + 64 * (j & 1)) : -1;
        if (MODE == 2) return j == 0 ? 2048 + bid : -1;
        const int it = bid + j * G; return it < N_PKG ? it : -1; };
    auto lr_dma = [&](int item) {
        if (wave < 2) { int row0, T; if (item < 2048) { row0 = ((item >> 7) >> 2) * SEQ + (item & 127) * 64; T = 64; } else { row0 = MP + ((item - 2048) >> 2) * 16; T = 16; }
            const int t = 32 * wave + (lane >> 1); const bf16* prow = PROJ + (size_t)(row0 + (t < T ? t : T - 1)) * NA + CLR + 8 * (lane & 1);
            __builtin_amdgcn_global_load_lds((const unsigned*)prow, (LAS unsigned*)(LRN + wave * 1024), 16, 0, 0); } };
    LAS float* W2L = (LAS float*)(lds + MISC_OFF + 256);
    int cur_h = -1;
    { const int i0 = item_of(0); if (i0 >= 0) lr_dma(i0); asm volatile("s_waitcnt vmcnt(0)" ::: "memory"); __syncthreads(); }
    for (int j = 0;; ++j) {
        const int item = item_of(j); if (item < 0) break;
        int h, row0, T;
        if (item < 2048) { const int bh = item >> 7, ch = item & 127; h = bh & 3; row0 = (bh >> 2) * SEQ + ch * 64; T = 64; }
        else { const int i2 = item - 2048; h = i2 & 3; row0 = MP + (i2 >> 2) * 16; T = 16; }
        unsigned char* pk = PKG + (size_t)item * PKG_BYTES;
        bf16* Qt = (bf16*)(pk + PKG_Q); bf16* KT = (bf16*)(pk + PKG_KT); bf16* VT = (bf16*)(pk + PKG_VT); float* Gp = (float*)(pk + PKG_G);
        if (h != cur_h) {
            if (cur_h >= 0) __syncthreads();
            cur_h = h;
            for (int i = tid; i < 17 * 192; i += 512) { const int r = i / 192, d = i - r * 192; W2L[i] = r < 16 ? w2[r * 768 + h * 192 + d] : bg[h * 192 + d]; }
            __syncthreads(); }
        float w2c[3][16], bgc[3];
#pragma unroll
        for (int c = 0; c < 3; ++c) { bgc[c] = W2L[16 * 192 + lane + 64 * c];
#pragma unroll
            for (int r = 0; r < 16; ++r) w2c[c][r] = W2L[r * 192 + lane + 64 * c]; }
        unsigned qv[8][3], kv[8][3];
#pragma unroll
        for (int tt = 0; tt < 8; ++tt) { const int t = 8 * wave + tt; const bf16* prow = PROJ + (size_t)(row0 + (t < T ? t : T - 1)) * NA + h * 192 + lane;
#pragma unroll
            for (int c = 0; c < 3; ++c) { qv[tt][c] = prow[CQ + 64 * c]; kv[tt][c] = prow[CK + 64 * c]; } }
        __builtin_amdgcn_sched_barrier(0);
        v4u l0[8], l1[8];
#pragma unroll
        for (int tt = 0; tt < 8; ++tt) { const LAS unsigned char* lp = LRN + (8 * wave + tt) * 32; l0[tt] = *(const LAS v4u*)lp; l1[tt] = *(const LAS v4u*)(lp + 16); }
        float lc[8][3]; float run[3] = {0.f, 0.f, 0.f};
#pragma unroll
        for (int tt = 0; tt < 8; ++tt) { const bool ok = 8 * wave + tt < T;
            float lr[16]; lr[0] = pg8::bflo(l0[tt].x); lr[1] = pg8::bfhi(l0[tt].x); lr[2] = pg8::bflo(l0[tt].y); lr[3] = pg8::bfhi(l0[tt].y); lr[4] = pg8::bflo(l0[tt].z); lr[5] = pg8::bfhi(l0[tt].z); lr[6] = pg8::bflo(l0[tt].w); lr[7] = pg8::bfhi(l0[tt].w);
            lr[8] = pg8::bflo(l1[tt].x); lr[9] = pg8::bfhi(l1[tt].x); lr[10] = pg8::bflo(l1[tt].y); lr[11] = pg8::bfhi(l1[tt].y); lr[12] = pg8::bflo(l1[tt].z); lr[13] = pg8::bfhi(l1[tt].z); lr[14] = pg8::bflo(l1[tt].w); lr[15] = pg8::bfhi(l1[tt].w);
#pragma unroll
            for (int c = 0; c < 3; ++c) { float xg = bgc[c];
#pragma unroll
                for (int r = 0; r < 16; ++r) xg += lr[r] * w2c[c][r];
                run[c] += ok ? -softplus_fast(-xg) * (1.0f / 16.0f) : 0.f; lc[tt][c] = run[c]; } }
#pragma unroll
        for (int c = 0; c < 3; ++c) tot[wave * 192 + lane + 64 * c] = run[c];
        __syncthreads();
        unsigned vv[6][8];
#pragma unroll
        for (int tt = 0; tt < 8; ++tt) { const int t = 8 * wave + tt; const bf16* prow = PROJ + (size_t)(row0 + (t < T ? t : T - 1)) * NA + CV + h * 384 + lane;
#pragma unroll
            for (int c2 = 0; c2 < 6; ++c2) vv[c2][tt] = prow[64 * c2]; }
        __builtin_amdgcn_sched_barrier(0);
        float pre[3], all[3];
#pragma unroll
        for (int c = 0; c < 3; ++c) { pre[c] = 0.f; all[c] = 0.f;
#pragma unroll
            for (int w = 0; w < 8; ++w) { const float tv = tot[w * 192 + lane + 64 * c]; all[c] += tv; if (w < wave) pre[c] += tv; } }
        unsigned ktw[3][4];
#pragma unroll
        for (int tt = 0; tt < 8; ++tt) { const int t = 8 * wave + tt; const bool ok = t < T;
#pragma unroll
            for (int c = 0; c < 3; ++c) { const int dl = lane + 64 * c; const float bc = pre[c] + lc[tt][c]; const float eq = __expf(bc), ek = __expf(-bc);
                const unsigned qb = ok ? f2bf(bf2f((bf16)qv[tt][c]) * GLA_QSCALE * eq) : 0u, kb = ok ? f2bf(bf2f((bf16)kv[tt][c]) * ek) : 0u;
                Qt[t * QIMG_LD + dl] = (bf16)qb; QL[t * QIMG_LD + dl] = (bf16)qb; KL[t * QIMG_LD + dl] = (bf16)kb;
                if (tt & 1) ktw[c][tt >> 1] |= kb << 16; else ktw[c][tt >> 1] = kb; } }
#pragma unroll
        for (int c = 0; c < 3; ++c) { bf16* kp = KT + (size_t)(lane + 64 * c) * KTIMG_LD + 8 * wave; u32x2 o0, o1; o0.x = ktw[c][0]; o0.y = ktw[c][1]; o1.x = ktw[c][2]; o1.y = ktw[c][3]; *(u32x2*)kp = o0; *(u32x2*)(kp + 4) = o1; }
        if (wave == 0) {
#pragma unroll
            for (int c = 0; c < 3; ++c) Gp[lane + 64 * c] = __expf(all[c]); }
#pragma unroll
        for (int c2 = 0; c2 < 6; ++c2) { const bool ok0 = 8 * wave < T;
            u32x2 o0, o1; o0.x = ok0 ? vv[c2][0] | (vv[c2][1] << 16) : 0u; o0.y = ok0 ? vv[c2][2] | (vv[c2][3] << 16) : 0u; o1.x = ok0 ? vv[c2][4] | (vv[c2][5] << 16) : 0u; o1.y = ok0 ? vv[c2][6] | (vv[c2][7] << 16) : 0u;
            v4u o; o.x = o0.x; o.y = o0.y; o.z = o1.x; o.w = o1.y; *(v4u*)(VT + (size_t)(lane + 64 * c2) * 64 + 8 * wave) = o;
            LAS bf16* vl = VL + (lane + 64 * c2) * VL_LD + 8 * wave; *(LAS u32x2*)vl = o0; *(LAS u32x2*)(vl + 4) = o1; }
        __syncthreads();
        { const int nx = item_of(j + 1); if (nx >= 0) lr_dma(nx); }
        const int nvalid = T;
        bf16x8 va[3], vb[3];
#pragma unroll
        for (int k = 0; k < 3; ++k) { const LAS bf16* vr = VL + (16 * (3 * wave + k) + fr) * VL_LD + 4 * fq;
            const s16x4 x0 = *(const LAS s16x4*)vr, x1 = *(const LAS s16x4*)(vr + 16), x2 = *(const LAS s16x4*)(vr + 32), x3 = *(const LAS s16x4*)(vr + 48);
            va[k] = __builtin_shufflevector(x0, x1, 0, 1, 2, 3, 4, 5, 6, 7); vb[k] = __builtin_shufflevector(x2, x3, 0, 1, 2, 3, 4, 5, 6, 7); }
#pragma unroll
        for (int rep = 0; rep < 2; ++rep) {
            const int tl = wave + 8 * rep;
            if (tl < 10) {
                const int it = tl < 1 ? 0 : (tl < 3 ? 1 : (tl < 6 ? 2 : 3)), jt = tl - (it * (it + 1)) / 2;
                f32x4 at = {0.f, 0.f, 0.f, 0.f};
                const LAS bf16* qr = QL + (16 * it + fr) * QIMG_LD + 8 * fq; const LAS bf16* kr = KL + (16 * jt + fr) * QIMG_LD + 8 * fq;
#pragma unroll
                for (int s = 0; s < 6; ++s) at = MFMA16(*(const LAS bf16x8*)(kr + 32 * s), *(const LAS bf16x8*)(qr + 32 * s), at);
                if (it == jt) {
#pragma unroll
                    for (int jj = 0; jj < 4; ++jj) if (4 * fq + jj > fr) at[jj] = 0.f; }
                u32x2 w; w.x = cvt2(at[0], at[1]); w.y = cvt2(at[2], at[3]);
                *(LAS u32x2*)(P + (16 * it + fr) * P_LD + 16 * jt + 4 * fq) = w;
            } else if (tl == 10 || tl == 11) {
                const int it = tl == 10 ? 0 : 2, jt = tl == 10 ? 1 : 3; unsigned zz = 0u; asm volatile("" : "+v"(zz)); u32x2 z; z.x = zz; z.y = zz;
                *(LAS u32x2*)(P + (16 * it + fr) * P_LD + 16 * jt + 4 * fq) = z;
            }
        }
        if (wave < 2) asm volatile("s_waitcnt vmcnt(0)" ::: "memory");
        __syncthreads();
#pragma unroll
        for (int it = 0; it < 4; ++it) {
            if (16 * it >= nvalid) break;
            const LAS bf16* pr = P + (16 * it + fr) * P_LD + 4 * fq;
            const s16x4 a0 = *(const LAS s16x4*)pr, a1 = *(const LAS s16x4*)(pr + 16);
            const bf16x8 pf0 = __builtin_shufflevector(a0, a1, 0, 1, 2, 3, 4, 5, 6, 7); bf16x8 pf1 = pf0;
            if (it >= 2) { const s16x4 b0 = *(const LAS s16x4*)(pr + 32), b1 = *(const LAS s16x4*)(pr + 48); pf1 = __builtin_shufflevector(b0, b1, 0, 1, 2, 3, 4, 5, 6, 7); }
#pragma unroll
            for (int k = 0; k < 3; ++k) { f32x4 o = {0.f, 0.f, 0.f, 0.f};
                o = MFMA16(va[k], pf0, o); if (it >= 2) o = MFMA16(vb[k], pf1, o);
                u32x2 ow; ow.x = cvt2(o[0], o[1]); ow.y = cvt2(o[2], o[3]); *(u32x2*)(OINT + (size_t)(row0 + 16 * it + fr) * 1536 + h * 384 + 16 * (3 * wave + k) + 4 * fq) = ow; }
        }
    }
}

__device__ __forceinline__ f32x4 ld_o4(const bf16* p) { const u32x2 w = *(const u32x2*)p; return (f32x4){pg8::bflo(w.x), pg8::bfhi(w.x), pg8::bflo(w.y), pg8::bfhi(w.y)}; }
template <int PASS>
__device__ __forceinline__ void gla_chain(int wc, int tid, int wave, LAS unsigned char* lds, int l, const unsigned char* PKG, const float* state_gla, bf16* OINT, float* out, float* SLOC, float* GSEG, bool dry = false) {
    const int lane = tid & 63, fr = lane & 15, fq = lane >> 4;
    int h, vb, bh, seg, item0, nsteps, row0, nvalid; const float* s0 = nullptr; float* sout = nullptr;
    if (PASS == 1) { bh = wc / 9; const int rem = wc % 9; vb = rem / 3; seg = rem % 3; h = bh & 3; item0 = bh * 128 + 32 * seg; nsteps = 32; row0 = 0; nvalid = 64; }
    else if (wc < 192) { bh = wc / 12; const int rem = wc % 12; vb = rem >> 2; seg = rem & 3; h = bh & 3; item0 = bh * 128 + 32 * seg; nsteps = 32; row0 = (bh >> 2) * SEQ + 2048 * seg; nvalid = 64;
        if (seg == 3) sout = out + O_GSP + (size_t)(l * 16 + bh) * 192 * 384; }
    else { const int c2 = wc - 192; bh = c2 / 3; vb = c2 % 3; seg = 0; h = bh & 3; item0 = 2048 + bh; nsteps = 1; row0 = MP + (bh >> 2) * 16; nvalid = 16; s0 = state_gla + (size_t)(l * 32 + bh) * 192 * 384; sout = out + O_GSS + (size_t)(l * 32 + bh) * 192 * 384; }
    const int v0 = vb * 128 + wave * 16;
#define GLA_WALK(p, step) do { (p) += (step); asm volatile("" : "+v"(p)); } while (0)
    f32x4 S[12];
    if (s0) { const float* p = s0 + (size_t)(4 * fq) * 384 + v0 + fr;
#pragma unroll
        for (int t = 0; t < 12; ++t) {
#pragma unroll
            for (int jj = 0; jj < 4; ++jj) { S[t][jj] = *p; GLA_WALK(p, 384); }
            GLA_WALK(p, 12 * 384); } }
    else {
#pragma unroll
        for (int t = 0; t < 12; ++t) S[t] = (f32x4){0.f, 0.f, 0.f, 0.f}; }
    if (PASS == 2 && wc < 192) {
        for (int j = 0; j < seg; ++j) { const float* gs = GSEG + (size_t)(bh * 3 + j) * 192 + 4 * fq; const float* p = SLOC + (size_t)((bh * 3 + vb) * 3 + j) * 192 * 128 + (size_t)(4 * fq) * 128 + wave * 16 + fr;
#pragma unroll
            for (int t = 0; t < 12; ++t) { const f32x4 g4 = *(const f32x4*)(gs + 16 * t);
#pragma unroll
                for (int jj = 0; jj < 4; ++jj) { S[t][jj] = g4[jj] * S[t][jj] + *p; GLA_WALK(p, 128); }
                GLA_WALK(p, 12 * 128); } }
    }
    f32x4 GP[PASS == 1 ? 12 : 1];
    if (PASS == 1) {
#pragma unroll
        for (int t = 0; t < 12; ++t) GP[t] = (f32x4){1.f, 1.f, 1.f, 1.f}; }
    constexpr int CH0 = PASS == 1 ? PKG_KT / 16 : 0, NCH = IMG_BYTES / 16, NLD = PASS == 1 ? 4 : 7;
    v4u pre[NLD]; bf16x8 vt[2], vtn[2]; f32x4 oin[4];
    { const unsigned char* pk = PKG + (size_t)item0 * PKG_BYTES;
      if (PASS == 2) {
#pragma unroll
        for (int it = 0; it < 4; ++it) { const int tl = 16 * it + fr; oin[it] = tl < nvalid ? ld_o4(OINT + (size_t)(row0 + tl) * 1536 + h * 384 + v0 + 4 * fq) : (f32x4){0.f, 0.f, 0.f, 0.f}; } }
#pragma unroll
      for (int k = 0; k < NLD; ++k) { const int ch = CH0 + tid + 512 * k; if (ch < NCH) pre[k] = *(const v4u*)(pk + (size_t)ch * 16); }
      const bf16* VT = (const bf16*)(pk + PKG_VT) + (size_t)(v0 + fr) * 64 + 4 * fq; vt[0] = ld2x8(VT, VT + 16); vt[1] = ld2x8(VT + 32, VT + 48);
#pragma unroll
      for (int k = 0; k < NLD; ++k) { const int ch = CH0 + tid + 512 * k; if (ch < NCH) *(LAS v4u*)(lds + (size_t)ch * 16) = pre[k]; }
      vtn[0] = vt[0]; vtn[1] = vt[1]; }
    __syncthreads();
    for (int n = 0; n < nsteps; ++n) {
        const LAS unsigned char* img = lds + (n & 1) * IMG_BYTES;
        const bool more = n + 1 < nsteps;
        if (more) { const unsigned char* pk = PKG + (size_t)(item0 + n + 1) * PKG_BYTES;
#pragma unroll
            for (int k = 0; k < NLD; ++k) { const int ch = CH0 + tid + 512 * k; if (ch < NCH) pre[k] = *(const v4u*)(pk + (size_t)ch * 16); }
            const bf16* VT = (const bf16*)(pk + PKG_VT) + (size_t)(v0 + fr) * 64 + 4 * fq; vtn[0] = ld2x8(VT, VT + 16); vtn[1] = ld2x8(VT + 32, VT + 48); }
        if (PASS == 2) {
            bf16x8 Sb[6];
#pragma unroll
            for (int s = 0; s < 6; ++s) Sb[s] = pack8(S[2 * s], S[2 * s + 1]);
#pragma unroll
            for (int it = 0; it < 4; ++it) {
                const LAS bf16* qr = (const LAS bf16*)(img + PKG_Q) + (16 * it + fr) * QIMG_LD + 4 * fq;
                f32x4 o = oin[it];
#pragma unroll
                for (int s = 0; s < 6; ++s) { const s16x4 a = *(const LAS s16x4*)(qr + 32 * s), b = *(const LAS s16x4*)(qr + 32 * s + 16);
                    o = MFMA16(Sb[s], __builtin_shufflevector(a, b, 0, 1, 2, 3, 4, 5, 6, 7), o); }
                const int tl = 16 * it + fr;
                if (tl < nvalid && !dry) { u32x2 ow; ow.x = cvt2(o[0], o[1]); ow.y = cvt2(o[2], o[3]); *(u32x2*)(OINT + (size_t)(row0 + 64 * n + tl) * 1536 + h * 384 + v0 + 4 * fq) = ow; }
                __builtin_amdgcn_sched_barrier(0);
            }
            if (more) {
#pragma unroll
                for (int it = 0; it < 4; ++it) oin[it] = ld_o4(OINT + (size_t)(row0 + 64 * (n + 1) + 16 * it + fr) * 1536 + h * 384 + v0 + 4 * fq); }
        }
#pragma unroll
        for (int t = 0; t < 12; ++t) { const LAS bf16* kr = (const LAS bf16*)(img + PKG_KT) + (16 * t + fr) * KTIMG_LD + 4 * fq;
#pragma unroll
            for (int s2 = 0; s2 < 2; ++s2) { const s16x4 a = *(const LAS s16x4*)(kr + 32 * s2), b = *(const LAS s16x4*)(kr + 32 * s2 + 16);
                S[t] = MFMA16(__builtin_shufflevector(a, b, 0, 1, 2, 3, 4, 5, 6, 7), vt[s2], S[t]); }
            const f32x4 g4 = *(const LAS f32x4*)(img + PKG_G + (16 * t + 4 * fq) * 4);
            S[t] = S[t] * g4; if (PASS == 1) GP[t] = GP[t] * g4; if ((t & 3) == 3) __builtin_amdgcn_sched_barrier(0); }
        if (more) { LAS unsigned char* nimg = lds + ((n + 1) & 1) * IMG_BYTES;
#pragma unroll
            for (int k = 0; k < NLD; ++k) { const int ch = CH0 + tid + 512 * k; if (ch < NCH) *(LAS v4u*)(nimg + (size_t)ch * 16) = pre[k]; }
            vt[0] = vtn[0]; vt[1] = vtn[1]; }
        asm volatile("s_waitcnt lgkmcnt(0)" ::: "memory"); __builtin_amdgcn_s_barrier(); asm volatile("" ::: "memory");
    }
    if (PASS == 1) {
        float* p = SLOC + (size_t)((bh * 3 + vb) * 3 + seg) * 192 * 128 + (size_t)(4 * fq) * 128 + wave * 16 + fr;
#pragma unroll
        for (int t = 0; t < 12; ++t) {
#pragma unroll
            for (int jj = 0; jj < 4; ++jj) { *p = S[t][jj]; GLA_WALK(p, 128); }
            GLA_WALK(p, 12 * 128); }
        if (vb == 0 && wave == 0 && fr == 0) { float* gs = GSEG + (size_t)(bh * 3 + seg) * 192;
#pragma unroll
            for (int t = 0; t < 12; ++t) *(f32x4*)(gs + 16 * t + 4 * fq) = GP[t]; }
    } else if (sout) {
        float* p = sout + (size_t)(4 * fq) * 384 + v0 + fr;
#pragma unroll
        for (int t = 0; t < 12; ++t) {
#pragma unroll
            for (int jj = 0; jj < 4; ++jj) { *p = S[t][jj]; GLA_WALK(p, 384); }
            GLA_WALK(p, 12 * 384); }
    }
#undef GLA_WALK
}

__device__ __forceinline__ void mem_attn(int item, int lane, int l, const bf16* PROJ, int ldp, int cqm, const bf16* MEMK, const bf16* MEMVT, bf16* OCAT) {
    const int fr = lane & 15, fq = lane >> 4, tile = item >> 2, h = item & 3, r0 = tile * 16;
    const int bb = r0 < MP ? r0 / SEQ : 4 + ((r0 - MP) >> 4);
    const bf16* Kb = MEMK + (size_t)((l * 12 + bb) * 256) * 512 + h * 128; const bf16* Vt = MEMVT + (size_t)(((l * 12 + bb) * 4 + h) * 128) * 256;
    bf16x8 qf[4];
#pragma unroll
    for (int s = 0; s < 4; ++s) qf[s] = ld16(PROJ + (size_t)(r0 + fr) * ldp + cqm + h * 128 + 32 * s + 8 * fq);
    f32x4 st[16];
#pragma unroll
    for (int mt = 0; mt < 16; ++mt) { st[mt] = (f32x4){0.f, 0.f, 0.f, 0.f}; const bf16* kr = Kb + (size_t)(16 * mt + fr) * 512 + 8 * fq;
#pragma unroll
        for (int s = 0; s < 4; ++s) st[mt] = MFMA16(ld16(kr + 32 * s), qf[s], st[mt]); }
    float mx = -3.0e38f;
#pragma unroll
    for (int mt = 0; mt < 16; ++mt) mx = fmaxf(mx, fmaxf(fmaxf(st[mt][0], st[mt][1]), fmaxf(st[mt][2], st[mt][3])));
    mx = fmaxf(mx, shx(mx, lane, 16)); mx = fmaxf(mx, shx(mx, lane, 32));
    float sum = 0.f;
#pragma unroll
    for (int mt = 0; mt < 16; ++mt)
#pragma unroll
        for (int jj = 0; jj < 4; ++jj) { const float p = __expf((st[mt][jj] - mx) * HD_SCALE); st[mt][jj] = p; sum += p; }
    sum += shx(sum, lane, 16); sum += shx(sum, lane, 32);
    const float inv = 1.0f / sum;
    bf16x8 pf[8];
#pragma unroll
    for (int s = 0; s < 8; ++s) pf[s] = pack8(st[2 * s], st[2 * s + 1]);
#pragma unroll
    for (int dt = 0; dt < 8; ++dt) { f32x4 o = {0.f, 0.f, 0.f, 0.f}; const bf16* vr = Vt + (size_t)(16 * dt + fr) * 256 + 4 * fq;
#pragma unroll
        for (int s = 0; s < 8; ++s) o = MFMA16(ld2x8(vr + 32 * s, vr + 32 * s + 16), pf[s], o);
        u32x2 w; w.x = cvt2(o[0] * inv, o[1] * inv); w.y = cvt2(o[2] * inv, o[3] * inv);
        *(u32x2*)(OCAT + (size_t)(r0 + fr) * D + 1536 + h * 128 + 16 * dt + 4 * fq) = w; }
}

__device__ __forceinline__ void mem_attn_wg(int wi, int tid, int wave, LAS unsigned char* lds, int l, const bf16* PROJ, int ldp, int cqm, const bf16* MEMK, const bf16* MEMVT, bf16* OCAT) {
    const bool smp = wi >= 256; const int lane = tid & 63, fr = lane & 15, fq = lane >> 4, bh = smp ? (wi - 256) : (wi >> 4), sub = wi & 15, b = smp ? 4 + (bh >> 2) : (bh >> 2), h = bh & 3;
    const bf16* Kb = MEMK + (size_t)((l * 12 + b) * 256) * 512 + h * 128; const bf16* Vt = MEMVT + (size_t)(((l * 12 + b) * 4 + h) * 128) * 256;
#pragma unroll
    for (int k = 0; k < 8; ++k) { const int idx = tid + 512 * k, row = idx >> 4, c = idx & 15; *(LAS v4u*)(lds + row * 256 + ((c ^ (row & 15)) << 4)) = *(const v4u*)(Kb + (size_t)row * 512 + c * 8); }
#pragma unroll
    for (int k = 0; k < 8; ++k) { const int idx = tid + 512 * k, row = idx >> 5, c = idx & 31; *(LAS v4u*)(lds + 65536 + row * 512 + ((c ^ (2 * (row & 15))) << 4)) = *(const v4u*)(Vt + (size_t)row * 256 + c * 8); }
    __syncthreads();
    unsigned koff[4], voff[16];
#pragma unroll
    for (int s2 = 0; s2 < 4; ++s2) { koff[s2] = (unsigned)(fr * 256 + (((4 * s2 + fq) ^ fr) << 4)); asm volatile("" : "+v"(koff[s2])); }
#pragma unroll
    for (int s2 = 0; s2 < 8; ++s2) { const int p0 = 8 * s2 + fq, p1 = p0 + 4;
        voff[2 * s2] = (unsigned)(65536 + fr * 512 + ((((p0 >> 1) ^ (2 * fr)) << 4) | ((p0 & 1) << 3))); voff[2 * s2 + 1] = (unsigned)(65536 + fr * 512 + ((((p1 >> 1) ^ (2 * fr)) << 4) | ((p1 & 1) << 3)));
        asm volatile("" : "+v"(voff[2 * s2]), "+v"(voff[2 * s2 + 1])); }
    const int nblk = smp ? (wave == 0 ? 1 : 0) : 4;
#pragma unroll 1
    for (int blk = 0; blk < nblk; ++blk) {
        const int r0 = smp ? MP + (b - 4) * 16 : b * SEQ + sub * 512 + blk * 128 + wave * 16;
        bf16x8 qf[4];
#pragma unroll
        for (int s = 0; s < 4; ++s) qf[s] = ld16(PROJ + (size_t)(r0 + fr) * ldp + cqm + h * 128 + 32 * s + 8 * fq);
        f32x4 st[16];
#pragma unroll
        for (int mt = 0; mt < 16; ++mt) { st[mt] = (f32x4){0.f, 0.f, 0.f, 0.f};
#pragma unroll
            for (int s = 0; s < 4; ++s) st[mt] = MFMA16(*(const LAS bf16x8*)(lds + koff[s] + mt * 4096), qf[s], st[mt]);
            if ((mt & 3) == 3) __builtin_amdgcn_sched_barrier(0); }
        float mx = -3.0e38f;
#pragma unroll
        for (int mt = 0; mt < 16; ++mt) mx = fmaxf(mx, fmaxf(fmaxf(st[mt][0], st[mt][1]), fmaxf(st[mt][2], st[mt][3])));
        mx = fmaxf(mx, shx(mx, lane, 16)); mx = fmaxf(mx, shx(mx, lane, 32));
        float sum = 0.f;
#pragma unroll
        for (int mt = 0; mt < 16; ++mt)
#pragma unroll
            for (int jj = 0; jj < 4; ++jj) { const float p = __expf((st[mt][jj] - mx) * HD_SCALE); st[mt][jj] = p; sum += p; }
        sum += shx(sum, lane, 16); sum += shx(sum, lane, 32);
        const float inv = 1.0f / sum;
        bf16x8 pf[8];
#pragma unroll
        for (int s = 0; s < 8; ++s) pf[s] = pack8(st[2 * s], st[2 * s + 1]);
#pragma unroll
        for (int dt = 0; dt < 8; ++dt) { f32x4 o = {0.f, 0.f, 0.f, 0.f};
#pragma unroll
            for (int s = 0; s < 8; ++s) { const s16x4 a = *(const LAS s16x4*)(lds + voff[2 * s] + dt * 8192), bb = *(const LAS s16x4*)(lds + voff[2 * s + 1] + dt * 8192);
                o = MFMA16(__builtin_shufflevector(a, bb, 0, 1, 2, 3, 4, 5, 6, 7), pf[s], o); }
            u32x2 w; w.x = cvt2(o[0] * inv, o[1] * inv); w.y = cvt2(o[2] * inv, o[3] * inv);
            *(u32x2*)(OCAT + (size_t)(r0 + fr) * D + 1536 + h * 128 + 16 * dt + 4 * fq) = w;
            if (dt & 1) __builtin_amdgcn_sched_barrier(0); }
    }
    __syncthreads();
}

template <int MODE = 0>
__device__ __forceinline__ void sb_attn(int lane, LAS unsigned char* wlds, const bf16* Kp, int ldk, const bf16* VTp, int ldvt, const bf16* Qp, int ldq, bf16* Op, int t0, int nq) {
    const int r = lane & 31, hh = lane >> 5;
    LAS bf16x8* qs = (LAS bf16x8*)wlds + lane;
#pragma unroll
    for (int ks = 0; ks < 8; ++ks) qs[64 * ks] = ld16(Qp + (size_t)r * ldq + 16 * ks + 8 * hh);
    f32x16 oacc[4];
#pragma unroll
    for (int dt = 0; dt < 4; ++dt)
#pragma unroll
        for (int i = 0; i < 16; ++i) oacc[dt][i] = 0.f;
    float carry = 1.f;
    bf16x8 kf[8];
    { const bf16* kr = Kp + (size_t)(t0 + r) * ldk + 8 * hh;
#pragma unroll
      for (int ks = 0; ks < 8; ++ks) kf[ks] = ld16(kr + 16 * ks); }
    for (int s0 = t0; s0 >= 0; s0 -= 32) {
        bf16x8 vf[8];
#pragma unroll
        for (int k2 = 0; k2 < 2; ++k2)
#pragma unroll
            for (int dt = 0; dt < 4; ++dt) vf[4 * k2 + dt] = MODE == 3 ? qs[64 * dt] : ld16(VTp + (size_t)(s0 >> 5) * 4096 + ((dt * 2 + k2) * 64 + lane) * 8);
        f32x16 st;
#pragma unroll
        for (int i = 0; i < 16; ++i) st[i] = 0.f;
#pragma unroll
        for (int ks = 0; ks < 8; ++ks) st = MFMA32(kf[ks], qs[64 * ks], st);
        { const int sn = s0 >= 32 ? s0 - 32 : 0; const bf16* kr = Kp + (size_t)(sn + r) * ldk + 8 * hh;
#pragma unroll
          for (int ks = 0; ks < 8; ++ks) kf[ks] = ld16(kr + 16 * ks); }
        const bool diag = (s0 == t0);
        float lb[16], om[16];
#pragma unroll
        for (int i = 0; i < 16; ++i) { const float z = st[i] * HD_SCALE, e = __expf(-fabsf(z)), rr = __builtin_amdgcn_rcpf(1.0f + e), er = e * rr;
            lb[i] = z >= 0.f ? rr : er; om[i] = z >= 0.f ? er : rr;
            if (diag && !(((i & 3) + 8 * (i >> 2) + 4 * hh) < r)) { lb[i] = 0.f; om[i] = 1.f; } }
        float g[4], pgv[4];
#pragma unroll
        for (int m = 0; m < 4; ++m) { g[m] = (om[4 * m] * om[4 * m + 1]) * (om[4 * m + 2] * om[4 * m + 3]); pgv[m] = shx(g[m], lane, 32); }
        float R[4]; R[3] = 1.f; R[2] = g[3] * pgv[3]; R[1] = R[2] * (g[2] * pgv[2]); R[0] = R[1] * (g[1] * pgv[1]);
        const float total = R[0] * (g[0] * pgv[0]);
#pragma unroll
        for (int m = 0; m < 4; ++m) { const float suf = carry * R[m] * (hh == 0 ? pgv[m] : 1.f);
            const float t3 = suf, t2 = t3 * om[4 * m + 3], t1 = t2 * om[4 * m + 2], t0_ = t1 * om[4 * m + 1];
            lb[4 * m + 3] *= t3; lb[4 * m + 2] *= t2; lb[4 * m + 1] *= t1; lb[4 * m] *= t0_; }
        carry *= total;
#pragma unroll
        for (int k2 = 0; k2 < 2; ++k2) {
            v4u p; p.x = cvt2(lb[8 * k2], lb[8 * k2 + 1]); p.y = cvt2(lb[8 * k2 + 2], lb[8 * k2 + 3]); p.z = cvt2(lb[8 * k2 + 4], lb[8 * k2 + 5]); p.w = cvt2(lb[8 * k2 + 6], lb[8 * k2 + 7]);
            const bf16x8 wf = __builtin_bit_cast(bf16x8, p);
#pragma unroll
            for (int dt = 0; dt < 4; ++dt) { if (MODE != 3) oacc[dt] = MFMA32(vf[4 * k2 + dt], wf, oacc[dt]); else oacc[dt][0] += __builtin_bit_cast(float, (int)wf[0]) + __builtin_bit_cast(float, (int)vf[4 * k2 + dt][0]); }
        }
        if (MODE == 2 || __all((r >= nq) || (carry < 1.0e-37f))) break;
    }
    if (MODE != 0) { float sdry = 0.f;
#pragma unroll
        for (int dt = 0; dt < 4; ++dt)
#pragma unroll
            for (int i = 0; i < 16; ++i) sdry += oacc[dt][i];
        if (sdry == 1.2345e33f) Op[0] = 0; }
    else if (r < nq) {
#pragma unroll
        for (int dt = 0; dt < 4; ++dt)
#pragma unroll
            for (int g4 = 0; g4 < 4; ++g4) { u32x2 wv; wv.x = cvt2(oacc[dt][4 * g4], oacc[dt][4 * g4 + 1]); wv.y = cvt2(oacc[dt][4 * g4 + 2], oacc[dt][4 * g4 + 3]);
                *(u32x2*)(Op + (size_t)r * D + 32 * dt + 8 * g4 + 4 * hh) = wv; }
    }
    asm volatile("s_waitcnt lgkmcnt(0)" ::: "memory");
}

struct SkBf16 { bf16* O; int ldc;
    __device__ __forceinline__ int brow(int unit, int nb) const { return 32 * unit + 16 * nb; }
    __device__ __forceinline__ void store(int unit, const f32x4 a0, const f32x4 a1, int m, int fq) const { bf16* p = O + (size_t)(MP + m) * ldc + 32 * unit + 4 * fq;
        u32x2 w; w.x = cvt2(a0[0], a0[1]); w.y = cvt2(a0[2], a0[3]); *(u32x2*)p = w; w.x = cvt2(a1[0], a1[1]); w.y = cvt2(a1[2], a1[3]); *(u32x2*)(p + 16) = w; } };
struct SkRes { bf16* Yp; const bf16* Xp; float alpha;
    __device__ __forceinline__ int brow(int unit, int nb) const { return 32 * unit + 16 * nb; }
    __device__ __forceinline__ void one(size_t o, const f32x4 a) const { const u32x2 xv = *(const u32x2*)(Xp + o);
        f32x4 r; r[0] = alpha * pg8::bflo(xv.x); r[1] = alpha * pg8::bfhi(xv.x); r[2] = alpha * pg8::bflo(xv.y); r[3] = alpha * pg8::bfhi(xv.y); r = r + a; u32x2 w; w.x = cvt2(r[0], r[1]); w.y = cvt2(r[2], r[3]); *(u32x2*)(Yp + o) = w; }
    __device__ __forceinline__ void store(int unit, const f32x4 a0, const f32x4 a1, int m, int fq) const { const size_t o = (size_t)(MP + m) * D + 32 * unit + 4 * fq; one(o, a0); one(o + 16, a1); } };
struct SkKV { float *oks, *ovs; bf16 *ksb, *vsb;
    __device__ __forceinline__ int brow(int unit, int nb) const { return 32 * unit + 16 * nb; }
    __device__ __forceinline__ void one(int col, const f32x4 a, int m) const { const bool isv = col >= 1536; const int c = col - (isv ? 1536 : 0), b = m >> 4, t = m & 15;
        *(f32x4*)((isv ? ovs : oks) + (size_t)m * 1536 + c) = a; const unsigned w0 = cvt2(a[0], a[1]), w1 = cvt2(a[2], a[3]);
        const int hh_ = c >> 7, dd = c & 127;
        if (!isv) { u32x2 w; w.x = w0; w.y = w1; *(u32x2*)(ksb + ((size_t)(b * 12 + hh_) * 2080 + 2048 + t) * 128 + dd) = w; }
        else { bf16* vt = vsb + ((size_t)(b * 12 + hh_) * 65 + 64) * 4096 + pg8::vtf_d(dd) + pg8::vtf_k(t); vt[0] = (bf16)w0; vt[8] = (bf16)(w0 >> 16); vt[16] = (bf16)w1; vt[24] = (bf16)(w1 >> 16); } }
    __device__ __forceinline__ void store(int unit, const f32x4 a0, const f32x4 a1, int m, int fq) const { one(32 * unit + 4 * fq, a0, m); one(32 * unit + 16 + 4 * fq, a1, m); } };
struct SkSwiGLU { bf16* Hb;
    __device__ __forceinline__ int brow(int unit, int nb) const { const int c0 = 16 * unit; return (c0 >> 7) * 256 + (c0 & 127) + 128 * nb; }
    __device__ __forceinline__ void store(int unit, const f32x4 g, const f32x4 u, int m, int fq) const { float hv[4];
#pragma unroll
        for (int j = 0; j < 4; ++j) hv[j] = g[j] * __builtin_amdgcn_rcpf(1.0f + __expf(-g[j])) * u[j];
        u32x2 w; w.x = cvt2(hv[0], hv[1]); w.y = cvt2(hv[2], hv[3]); *(u32x2*)(Hb + (size_t)(MP + m) * DFF + 16 * unit + 4 * fq) = w; } };
template <class Epi>
__device__ __forceinline__ void skinny_gemm(int bid, int G, int tid, int wave, LAS unsigned char* lds, const bf16* A, int lda, const bf16* Bt, int K, int nunits, const Epi& E) {
    const int lane = tid & 63, fr = lane & 15, fq = lane >> 4, kw = K >> 3, nst = kw >> 5;
    LAS f32x4* red = (LAS f32x4*)lds;
    if (nst == 8 && (G & 3) == 0) {
        const int rg = bid & 3;
        bf16x8 af[8][2], bw[8][2];
        if (bid < 4 * nunits) { const bf16* ap = A + (size_t)(32 * rg + fr) * lda + wave * kw + 8 * fq;
#pragma unroll
            for (int st = 0; st < 8; ++st) { af[st][0] = ld16(ap + 32 * st); af[st][1] = ld16(ap + (size_t)16 * lda + 32 * st); } }
#define SK_BLOAD(it_) do { const int u_ = (it_) >> 2; const bf16* bp0 = Bt + (size_t)(E.brow(u_, 0) + fr) * K + wave * kw + 8 * fq; const bf16* bp1 = Bt + (size_t)(E.brow(u_, 1) + fr) * K + wave * kw + 8 * fq; \
            _Pragma("unroll") for (int st = 0; st < 8; ++st) { bw[st][0] = ld16(bp0 + 32 * st); bw[st][1] = ld16(bp1 + 32 * st); } } while (0)
        if (bid < 4 * nunits) SK_BLOAD(bid);
        int par = 0;
#pragma unroll 1
        for (int item = bid; item < 4 * nunits; item += G) {
            const int unit = item >> 2; LAS f32x4* redp = red + par * 2048;
            f32x4 acc[2][2];
#pragma unroll
            for (int nb = 0; nb < 2; ++nb)
#pragma unroll
                for (int rt = 0; rt < 2; ++rt) acc[nb][rt] = (f32x4){0.f, 0.f, 0.f, 0.f};
#pragma unroll
            for (int st = 0; st < 8; ++st)
#pragma unroll
                for (int rt = 0; rt < 2; ++rt) { acc[0][rt] = MFMA16(bw[st][0], af[st][rt], acc[0][rt]); acc[1][rt] = MFMA16(bw[st][1], af[st][rt], acc[1][rt]); }
            __builtin_amdgcn_sched_barrier(0);
            if (item + G < 4 * nunits) SK_BLOAD(item + G);
            __builtin_amdgcn_sched_barrier(0);
#pragma unroll
            for (int nb = 0; nb < 2; ++nb)
#pragma unroll
                for (int rt = 0; rt < 2; ++rt) redp[((wave * 2 + nb) * 2 + rt) * 64 + lane] = acc[nb][rt];
            asm volatile("s_waitcnt lgkmcnt(0)" ::: "memory"); __builtin_amdgcn_s_barrier(); asm volatile("" ::: "memory");
            if (wave < 2) {
                f32x4 s0 = {0.f, 0.f, 0.f, 0.f}, s1 = {0.f, 0.f, 0.f, 0.f};
#pragma unroll
                for (int ws = 0; ws < 8; ++ws) { s0 = s0 + redp[((ws * 2 + 0) * 2 + wave) * 64 + lane]; s1 = s1 + redp[((ws * 2 + 1) * 2 + wave) * 64 + lane]; }
                E.store(unit, s0, s1, 32 * rg + 16 * wave + fr, fq);
            }
            par ^= 1;
        }
        __syncthreads();
#undef SK_BLOAD
        return;
    }
    for (int item = bid; item < 4 * nunits; item += G) {
        const int unit = item >> 2, rg = item & 3;
        const bf16* ap = A + (size_t)(32 * rg + fr) * lda + wave * kw + 8 * fq;
        const bf16* bp0 = Bt + (size_t)(E.brow(unit, 0) + fr) * K + wave * kw + 8 * fq; const bf16* bp1 = Bt + (size_t)(E.brow(unit, 1) + fr) * K + wave * kw + 8 * fq;
        f32x4 acc[2][2];
#pragma unroll
        for (int nb = 0; nb < 2; ++nb)
#pragma unroll
            for (int rt = 0; rt < 2; ++rt) acc[nb][rt] = (f32x4){0.f, 0.f, 0.f, 0.f};
        bf16x8 a0[4][2], b0[4][2], a1[4][2], b1[4][2];
#define SK_LOAD(af, bfr, g) do { _Pragma("unroll") for (int q = 0; q < 4; ++q) { const int st = 4 * (g) + q; if (st < nst) { \
            af[q][0] = ld16(ap + 32 * st); af[q][1] = ld16(ap + (size_t)16 * lda + 32 * st); bfr[q][0] = ld16(bp0 + 32 * st); bfr[q][1] = ld16(bp1 + 32 * st); } } } while (0)
#define SK_MMA(af, bfr, g) do { _Pragma("unroll") for (int q = 0; q < 4; ++q) { if (4 * (g) + q < nst) { _Pragma("unroll") for (int rt = 0; rt < 2; ++rt) { \
            acc[0][rt] = MFMA16(bfr[q][0], af[q][rt], acc[0][rt]); acc[1][rt] = MFMA16(bfr[q][1], af[q][rt], acc[1][rt]); } } } } while (0)
        const int ng = (nst + 3) >> 2;
        SK_LOAD(a0, b0, 0);
#pragma unroll 1
        for (int g = 0; g < ng; g += 2) {
            if (g + 1 < ng) SK_LOAD(a1, b1, g + 1);
            __builtin_amdgcn_sched_barrier(0);
            SK_MMA(a0, b0, g);
            __builtin_amdgcn_sched_barrier(0);
            if (g + 2 < ng) SK_LOAD(a0, b0, g + 2);
            __builtin_amdgcn_sched_barrier(0);
            if (g + 1 < ng) SK_MMA(a1, b1, g + 1);
            __builtin_amdgcn_sched_barrier(0);
        }
#undef SK_LOAD
#undef SK_MMA
#pragma unroll
        for (int nb = 0; nb < 2; ++nb)
#pragma unroll
            for (int rt = 0; rt < 2; ++rt) red[((wave * 2 + nb) * 2 + rt) * 64 + lane] = acc[nb][rt];
        __syncthreads();
        if (wave < 2) {
            f32x4 s0 = {0.f, 0.f, 0.f, 0.f}, s1 = {0.f, 0.f, 0.f, 0.f};
#pragma unroll
            for (int ws = 0; ws < 8; ++ws) { s0 = s0 + red[((ws * 2 + 0) * 2 + wave) * 64 + lane]; s1 = s1 + red[((ws * 2 + 1) * 2 + wave) * 64 + lane]; }
            E.store(unit, s0, s1, 32 * rg + 16 * wave + fr, fq);
        }
        __syncthreads();
    }
}
#ifndef PH_MASK
#define PH_MASK 0xFFFF
#endif
__global__ void __launch_bounds__(NWAVES * 64, 2) mega(Args args) {
    extern __shared__ __attribute__((aligned(16))) unsigned char lds[];
    Frame F;
    F.lds = (LAS unsigned char*)lds; F.MISC = (volatile LAS unsigned*)(F.lds + MISC_OFF);
    F.tid = threadIdx.x; F.lane = F.tid & 63; F.wave = __builtin_amdgcn_readfirstlane(F.tid >> 6);
    F.G = gridDim.x; F.gw = blockIdx.x * NWAVES + F.wave; F.NGW = F.G * NWAVES;
    F.ctl = (gu32*)(args.ws_ + WS_CTL);
    for (int u = F.tid; u < (LDS_BYTES - LDSCTL_OFF) / 4; u += NWAVES * 64) ((LAS unsigned*)(F.lds + LDSCTL_OFF))[u] = 0u;
    __syncthreads();
    XcdBarrier bar = xcd_barrier_post((unsigned*)(F.ctl + CW_BAR), F.MISC + 8);
    const int lo = args.ph_lo, hi = args.ph_hi; int ph = 0;
#define KARGS ((const __attribute__((address_space(4))) Args*)__builtin_amdgcn_kernarg_segment_ptr())
#define ws (ka->ws_)
#define out (ka->out_)
#define x_prompt (ka->in[0])
#define x_sample (ka->in[1])
#define mem_prompt (ka->in[2])
#define state_gla (ka->in[3])
#define cache_sb_k (ka->in[4])
#define cache_sb_v (ka->in[5])
#define cache_mem_k (ka->in[6])
#define cache_mem_v (ka->in[7])
#define w_in_a (ka->in[8])
#define w_gate_lr (ka->in[9])
#define b_gate (ka->in[10])
#define gla_norm_g (ka->in[11])
#define w_in_b (ka->in[12])
#define w_kv_shared (ka->in[13])
#define w_mem_kv (ka->in[14])
#define w_o (ka->in[15])
#define ln1_g (ka->in[16])
#define ln1_b (ka->in[17])
#define ln2_g (ka->in[18])
#define ln2_b (ka->in[19])
#define w_ffn_in (ka->in[20])
#define w_ffn_out (ka->in[21])
#define WIN ((bf16*)(ws + WS_WIN))
#define WO ((bf16*)(ws + WS_WO))
#define WFI ((bf16*)(ws + WS_WFI))
#define WFO ((bf16*)(ws + WS_WFO))
#define WMEM ((bf16*)(ws + WS_WMEM))
#define MEMX ((bf16*)(ws + WS_MEMX))
#define MEMK ((bf16*)(ws + WS_MEMK))
#define MEMV ((bf16*)(ws + WS_MEMV))
#define X ((bf16*)(ws + WS_X))
#define Y ((float*)(ws + WS_Y))
#define YB ((bf16*)(ws + WS_Y))
#define PROJ ((bf16*)(ws + WS_R1))
#define HB ((bf16*)(ws + WS_R1))
#define OCAT ((bf16*)(ws + WS_OCAT))
#define SBKS ((bf16*)(ws + WS_SBKS))
#define SBVS ((bf16*)(ws + WS_SBVS))
#define OINT ((bf16*)(out + O_YP))
#define KPB ((bf16*)(out + O_YP))
#define VPB (KPB + (size_t)MP * 1536)

#define PHASE_BEGIN(cond, cls) if (cond) { if (lo <= ph && ph < hi) { if (ph > lo) { xcd_barrier(bar); if (BAR_REP > 1) xcd_barrier(bar); } DIAG_STAMP(cls); for (int rep_ = 0; rep_ < (((cls) == REP_CLS) ? 2 : 1); ++rep_) { const __attribute__((address_space(4))) Args* ka = KARGS; asm volatile("" : "+s"(ka)); int z_ = 0, G_ = gridDim.x, bid_ = blockIdx.x, wave_ = F.wave; asm volatile("" : "+s"(z_), "+s"(G_), "+s"(bid_), "+s"(wave_)); const int lane = (int)__builtin_amdgcn_mbcnt_hi(~0u, __builtin_amdgcn_mbcnt_lo(~0u, (unsigned)z_)), tid = wave_ * 64 + lane, gw_ = bid_ * NWAVES + wave_, NGW_ = G_ * NWAVES;     (void)tid; (void)lane; (void)gw_; (void)NGW_;
#define PHASE_END } } ++ph; }
#ifndef REP_CLS
#define REP_CLS (-1)
#endif
#ifndef SK_REP
#define SK_REP 1
#endif
#ifndef MEM_REP
#define MEM_REP 1
#endif
#ifndef BAR_REP
#define BAR_REP 1
#endif
#ifndef STAG
#define STAG 0
#endif
#ifndef SB_REP
#define SB_REP 1
#endif
#if defined(DIAG_A)
#define DIAG_STAMP(cls) do { if (blockIdx.x == 0 && threadIdx.x == 0) { unsigned long long* dts = (unsigned long long*)(args.ws_ + 262144); dts[ph] = rt(); } } while (0)
#else
#define DIAG_STAMP(cls) do { } while (0)
#endif

#define CONVERT_WEIGHTS(LL) do { const int ll_ = (LL); \
            if (ll_ < 2) wt_convert(F.lds, wave_, gw_, NGW_, lane, w_in_a + (size_t)ll_ * D * 5136, D, 5136, WIN, NA, MapInA()); \
            else { wt_convert(F.lds, wave_, gw_, NGW_, lane, w_in_b + (size_t)(ll_ - 2) * D * NBQ, D, NBQ, WIN, NBQ, MapId()); if (ll_ == 2) wt_convert(F.lds, wave_, gw_, NGW_, lane, w_kv_shared, D, NKV, WIN + (size_t)NBQ * D, NKV, MapId()); } \
            wt_convert(F.lds, wave_, gw_, NGW_, lane, w_o + (size_t)ll_ * D * D, D, D, WO, D, MapId()); \
            wt_convert(F.lds, wave_, gw_, NGW_, lane, w_ffn_in + (size_t)ll_ * D * 2 * DFF, D, 2 * DFF, WFI, 2 * DFF, MapFfn()); \
            wt_convert(F.lds, wave_, gw_, NGW_, lane, w_ffn_out + (size_t)ll_ * DFF * D, DFF, D, WFO, D, MapId()); } while (0)
#define CONVERT_CACHE_K(W0, NW) do {         for (int r = (W0); r < 8 * 2048; r += (NW)) { const int b = r >> 11, s = r & 2047; const float* src = cache_sb_k + (size_t)r * 1536; \
            f32x4 v[6]; \
_Pragma("unroll") \
            for (int q = 0; q < 6; ++q) v[q] = *(const f32x4*)(src + lane * 4 + 256 * q); \
_Pragma("unroll") \
            for (int q = 0; q < 6; ++q) { const int j = lane * 4 + 256 * q; \
                *(unsigned long long*)(SBKS + ((size_t)(b * 12 + (j >> 7)) * 2080 + s) * 128 + (j & 127)) = (unsigned long long)pk2(v[q].x, v[q].y) | ((unsigned long long)pk2(v[q].z, v[q].w) << 32); } } } while (0)
#define CONVERT_CACHE_V(W0, NW) do {         for (int it = (W0); it < 3072; it += (NW)) { const int cb = it % 12, sb_ = (it / 12) & 31, b = it / 384, s = sb_ * 64 + lane; \
            const float* src = cache_sb_v + (size_t)(b * 2048 + s) * 1536 + cb * 128; bf16* dst = SBVS + ((size_t)(b * 12 + cb) * 65 + (s >> 5)) * 4096 + pg8::vtf_k(s & 31); \
            for (int q8 = 0; q8 < 32; q8 += 8) { f32x4 v[8]; \
_Pragma("unroll") \
                for (int q = 0; q < 8; ++q) v[q] = *(const f32x4*)(src + 4 * (q8 + q)); \
_Pragma("unroll") \
                for (int q = 0; q < 8; ++q) \
_Pragma("unroll") \
                    for (int e = 0; e < 4; ++e) dst[pg8::vtf_d(4 * (q8 + q) + e)] = (bf16)f2bf(v[q][e]); } } } while (0)
    PHASE_BEGIN(true, 0)
        for (int r = 2 * gw_; r < MT; r += 2 * NGW_) { const float* s0 = r < MP ? x_prompt + (size_t)r * D : (r < MR ? x_sample + (size_t)(r - MP) * D : nullptr);
            cvt_rows2<D>(s0, s0 ? s0 + D : nullptr, X + (size_t)r * D, X + (size_t)(r + 1) * D, lane); }
        for (int r = 2 * gw_; r < 1024; r += 2 * NGW_) cvt_rows2<D>(mem_prompt + (size_t)r * D, mem_prompt + (size_t)(r + 1) * D, MEMX + (size_t)r * D, MEMX + (size_t)(r + 1) * D, lane);
        for (int r = gw_; r < 4 * 8 * 256; r += NGW_) { const int l = r >> 11, b = (r >> 8) & 7, m = r & 255; const size_t dst = (size_t)((l * 12 + 4 + b) * 256 + m) * 512;
            cvt_row(cache_mem_k + (size_t)r * 512, MEMK + dst, 512, lane); }
        for (int it = gw_; it < 512; it += NGW_) { const int hdb = it & 3, mb = (it >> 2) & 3, b = (it >> 4) & 7, l = it >> 7, m = mb * 64 + lane;
            const float* src = cache_mem_v + (size_t)((l * 8 + b) * 256 + m) * 512 + hdb * 128; bf16* dst = MEMV + (size_t)((l * 12 + 4 + b) * 512 + hdb * 128) * 256 + m;
            for (int q4 = 0; q4 < 32; ++q4) { const f32x4 v = *(const f32x4*)(src + 4 * q4);
#pragma unroll
                for (int e = 0; e < 4; ++e) dst[(size_t)(4 * q4 + e) * 256] = (bf16)f2bf(v[e]); } }
        if (G_ != 256) { CONVERT_CACHE_K(gw_, NGW_); CONVERT_CACHE_V(gw_, NGW_); }
        for (int l = 0; l < 4; ++l) wt_convert(F.lds, wave_, gw_, NGW_, lane, w_mem_kv + (size_t)l * D * 1024, D, 1024, WMEM + (size_t)l * 1024 * D, 1024, MapId());
        CONVERT_WEIGHTS(0);
    PHASE_END
    for (int l = 0; l < 4; ++l) {
        const bool LA = l < 2;
        const int ldp = LA ? NA : NBQ;
        PHASE_BEGIN(true, 2)
            if (!LA && (bid_ & 1)) { { SkBf16 E{PROJ, ldp}; skinny_gemm(bid_, G_, FRESH_TID(), wave_, F.lds + RING_OFF, X + (size_t)MP * D, D, WIN, D, ldp / 32, E); }
                if (l == 2) { SkKV E{out + O_SKS, out + O_SVS, SBKS, SBVS}; skinny_gemm(bid_, G_, FRESH_TID(), wave_, F.lds + RING_OFF, X + (size_t)MP * D, D, WIN + (size_t)NBQ * D, D, NKV / 32, E); } }
            { pg8::Gemm g{X, WIN, MP, ldp, D}; pg8::StaticOrder S; S.init(MP, ldp, G_, bid_); pg8::EpiBf16 E{PROJ, ldp};
              pg8::gemm_phase<pg8::EpiBf16, pg8::StaticOrder, true, true>(F.lds + RING_OFF, g, S, E, FRESH_TID()); }
            if (l == 0 && bid_ >= (G_ >> 1) && bid_ < (G_ >> 1) + 64) { pg8::Gemm g{MEMX, WMEM, 1024, 4096, D}; pg8::StaticOrder S; S.init(1024, 4096, 64, bid_ - (G_ >> 1));
              pg8::EpiMemKV E{out + O_MKP, out + O_MVP, MEMK, MEMV};
              pg8::gemm_phase<pg8::EpiMemKV, pg8::StaticOrder, true, true>(F.lds + RING_OFF, g, S, E, FRESH_TID()); }
            if (l == 2) { pg8::Gemm g{X, WIN + (size_t)NBQ * D, MP, NKV, D}; pg8::StaticOrder S; S.init(MP, NKV, G_, bid_);
              pg8::EpiKV E{out + O_SKP, out + O_SVP, out + O_SKS, out + O_SVS, KPB, VPB, SBKS, SBVS};
              pg8::gemm_phase<pg8::EpiKV, pg8::StaticOrder, true, true>(F.lds + RING_OFF, g, S, E, FRESH_TID()); }
            if (LA) { if (bid_ >= (G_ >> 1)) { SkBf16 E{PROJ, ldp};
                    if (l == 0 && G_ == 256) {
                        const int ns = bid_ < 192 ? 2 : 8, s0 = bid_ < 192 ? bid_ - 128 : 128 + (bid_ - 192);
                        for (int m = 0; m < ns; ++m) skinny_gemm(s0 + 64 * m, 640, FRESH_TID(), wave_, F.lds + RING_OFF, X + (size_t)MP * D, D, WIN, D, ldp / 32, E); }
                    else skinny_gemm(bid_ - (G_ >> 1), G_ >> 1, FRESH_TID(), wave_, F.lds + RING_OFF, X + (size_t)MP * D, D, WIN, D, ldp / 32, E); } }
            else if (!(bid_ & 1))
            for (int skr = 0; skr < SK_REP; ++skr) { SkBf16 E{PROJ, ldp}; skinny_gemm(bid_, G_, FRESH_TID(), wave_, F.lds + RING_OFF, X + (size_t)MP * D, D, WIN, D, ldp / 32, E); }
            if (!(bid_ & 1))
            for (int skr = 0; skr < SK_REP; ++skr) if (l == 2) { SkKV E{out + O_SKS, out + O_SVS, SBKS, SBVS}; skinny_gemm(bid_, G_, FRESH_TID(), wave_, F.lds + RING_OFF, X + (size_t)MP * D, D, WIN + (size_t)NBQ * D, D, NKV / 32, E); }
        PHASE_END
        PHASE_BEGIN(LA, 3)
            if (G_ == 256) gla_prep_intra<1>(bid_, G_, tid, wave_, F.lds + RING_OFF, l, PROJ, w_gate_lr, b_gate, (unsigned char*)Y, OINT);
            else gla_prep_intra<0>(bid_, G_, tid, wave_, F.lds + RING_OFF, l, PROJ, w_gate_lr, b_gate, (unsigned char*)Y, OINT);
        PHASE_END
        PHASE_BEGIN(!LA, 11)
            {
#if defined(SB_MODE)
                for (int u = gw_; u < 12288; u += NGW_) { const int bh = u >> 8, qb = u & 255, b = bh / 12, h = bh % 12, t0 = 32 * qb; const size_t qo = (size_t)(b * SEQ + t0) * D + h * 128;
                    sb_attn<SB_MODE>(lane, F.lds + RING_OFF + wave_ * 16384, KPB + (size_t)bh * SEQ * 128, 128, VPB + (size_t)bh * SEQ * 128, 0, PROJ + qo, NBQ, OCAT + qo, t0, 32); }
#endif
                for (int sbr = 0; sbr < SB_REP; ++sbr)
                for (int u = gw_; u < 12288 + 96; u += NGW_) {
                    if (u < 12288) { const int bh = u >> 8, qb = u & 255, b = bh / 12, h = bh % 12, t0 = 32 * qb; const size_t qo = (size_t)(b * SEQ + t0) * D + h * 128;
                        sb_attn(lane, F.lds + RING_OFF + wave_ * 16384, KPB + (size_t)bh * SEQ * 128, 128, VPB + (size_t)bh * SEQ * 128, 0, PROJ + qo, NBQ, OCAT + qo, t0, 32); }
                    else { const int u2 = u - 12288, b = u2 / 12, h = u2 % 12; const size_t qo = (size_t)(MP + b * 16) * D + h * 128;
                        sb_attn(lane, F.lds + RING_OFF + wave_ * 16384, SBKS + (size_t)u2 * 2080 * 128, 128, SBVS + (size_t)u2 * 65 * 4096, 0, PROJ + qo, NBQ, OCAT + qo, 2048, 16); }
                }
            }
            __syncthreads();
            for (int mr = 0; mr < MEM_REP; ++mr)
            if (G_ == 256) {
                mem_attn_wg(bid_, FRESH_TID(), wave_, F.lds + RING_OFF, l, PROJ, ldp, LA ? CQM : 1536, MEMK, MEMV, OCAT);
                if (bid_ >= 224) mem_attn_wg(256 + bid_ - 224, FRESH_TID(), wave_, F.lds + RING_OFF, l, PROJ, ldp, LA ? CQM : 1536, MEMK, MEMV, OCAT); }
            else
            for (int wi = bid_; wi < 256 + 32; wi += G_) mem_attn_wg(wi, FRESH_TID(), wave_, F.lds + RING_OFF, l, PROJ, ldp, LA ? CQM : 1536, MEMK, MEMV, OCAT);
        PHASE_END
        PHASE_BEGIN(LA, 12)
            if (G_ == 256) { if (bid_ >= 144) { mem_attn_wg(bid_ - 144, FRESH_TID(), wave_, F.lds + RING_OFF, l, PROJ, ldp, CQM, MEMK, MEMV, OCAT); mem_attn_wg(bid_ - 144 + 112, FRESH_TID(), wave_, F.lds + RING_OFF, l, PROJ, ldp, CQM, MEMK, MEMV, OCAT); }
                    if (bid_ >= 224) { __syncthreads(); gla_prep_intra<2>(bid_ - 224, G_, FRESH_TID(), wave_, F.lds + RING_OFF, l, PROJ, w_gate_lr, b_gate, (unsigned char*)Y, OINT); } }
            else for (int wi = bid_; wi < 256 + 32; wi += G_) mem_attn_wg(wi, FRESH_TID(), wave_, F.lds + RING_OFF, l, PROJ, ldp, CQM, MEMK, MEMV, OCAT);
            for (int wc = bid_; wc < 144; wc += G_) gla_chain<1>(wc, FRESH_TID(), wave_, F.lds + RING_OFF, l, (const unsigned char*)Y, state_gla, OINT, out, (float*)WMEM, (float*)MEMX);
            if (G_ == 256 && bid_ < 64) mem_attn_wg(224 + bid_, FRESH_TID(), wave_, F.lds + RING_OFF, l, PROJ, ldp, CQM, MEMK, MEMV, OCAT);
        PHASE_END
        PHASE_BEGIN(LA, 5)
            if (G_ == 256 && bid_ >= 192) { const int lw = (bid_ - 192) * NWAVES + wave_; if (l == 0) CONVERT_CACHE_K(lw, 64 * NWAVES); else CONVERT_CACHE_V(lw, 64 * NWAVES); }
            for (int wc = bid_; wc < 192 + 96; wc += G_) gla_chain<2>(wc, FRESH_TID(), wave_, F.lds + RING_OFF, l, (const unsigned char*)Y, state_gla, OINT, out, (float*)WMEM, (float*)MEMX, REP_CLS == 5 && rep_ == 0);
        PHASE_END
        PHASE_BEGIN(LA, 6)
            const float* gn = gla_norm_g + (size_t)l * 384;
            for (int row = gw_; row < MR; row += NGW_) {
                const bf16* op = OINT + (size_t)row * 1536 + 24 * lane; const bf16* gp = PROJ + (size_t)row * NA + CG + 24 * lane; const float* gnp = gn + 24 * (lane & 15);
                f32x4 ov[6]; v4u gv[3]; float ss = 0.f;
#pragma unroll
                for (int j = 0; j < 3; ++j) { const v4u w = *(const v4u*)(op + 8 * j); ov[2 * j] = (f32x4){pg8::bflo(w.x), pg8::bfhi(w.x), pg8::bflo(w.y), pg8::bfhi(w.y)}; ov[2 * j + 1] = (f32x4){pg8::bflo(w.z), pg8::bfhi(w.z), pg8::bflo(w.w), pg8::bfhi(w.w)}; }
#pragma unroll
                for (int j = 0; j < 6; ++j) ss += (ov[j].x * ov[j].x + ov[j].y * ov[j].y) + (ov[j].z * ov[j].z + ov[j].w * ov[j].w);
#pragma unroll
                for (int j = 0; j < 3; ++j) gv[j] = *(const v4u*)(gp + 8 * j);
                ss += shx(ss, lane, 1); ss += shx(ss, lane, 2); ss += shx(ss, lane, 4); ss += shx(ss, lane, 8);
                const float r = 1.0f / sqrtf(ss * (1.0f / 384.0f) + RMS_EPS);
#pragma unroll
                for (int j = 0; j < 3; ++j) { const f32x4 n0 = *(const f32x4*)(gnp + 8 * j), n1 = *(const f32x4*)(gnp + 8 * j + 4); const f32x4 a = ov[2 * j], b = ov[2 * j + 1];
                    float gt[8]; gt[0] = pg8::bflo(gv[j].x); gt[1] = pg8::bfhi(gv[j].x); gt[2] = pg8::bflo(gv[j].y); gt[3] = pg8::bfhi(gv[j].y); gt[4] = pg8::bflo(gv[j].z); gt[5] = pg8::bfhi(gv[j].z); gt[6] = pg8::bflo(gv[j].w); gt[7] = pg8::bfhi(gv[j].w);
                    float o8[8];
#pragma unroll
                    for (int i = 0; i < 4; ++i) { o8[i] = a[i] * r * n0[i] * (gt[i] * __builtin_amdgcn_rcpf(1.0f + __expf(-gt[i]))); o8[4 + i] = b[i] * r * n1[i] * (gt[4 + i] * __builtin_amdgcn_rcpf(1.0f + __expf(-gt[4 + i]))); }
                    v4u o; o.x = pk2(o8[0], o8[1]); o.y = pk2(o8[2], o8[3]); o.z = pk2(o8[4], o8[5]); o.w = pk2(o8[6], o8[7]);
                    *(v4u*)(OCAT + (size_t)row * D + 24 * lane + 8 * j) = o; }
            }
        PHASE_END
        PHASE_BEGIN(true, 7)
            if (bid_ & 1) { SkRes Es{YB, X, DN_ALPHA}; skinny_gemm(bid_, G_, FRESH_TID(), wave_, F.lds + RING_OFF, OCAT + (size_t)MP * D, D, WO, D, D / 32, Es); }
            pg8::Gemm g{OCAT, WO, MP, D, D}; pg8::StaticOrder S; S.init(MP, D, G_, bid_); pg8::EpiRes E{YB, X, D, DN_ALPHA};
            pg8::gemm_phase<pg8::EpiRes, pg8::StaticOrder, true, true>(F.lds + RING_OFF, g, S, E, FRESH_TID());
            if (!(bid_ & 1))
            for (int skr = 0; skr < SK_REP; ++skr) { SkRes Es{YB, X, DN_ALPHA}; skinny_gemm(bid_, G_, FRESH_TID(), wave_, F.lds + RING_OFF, OCAT + (size_t)MP * D, D, WO, D, D / 32, Es); }
        PHASE_END
        PHASE_BEGIN(true, 8)
            const float* gg = ln1_g + (size_t)l * D; const float* bb = ln1_b + (size_t)l * D;
            ln_rows<false>(lane, gw_, NGW_, YB, gg, bb, X, [](int) -> float* { return nullptr; });
        PHASE_END
        PHASE_BEGIN(true, 9)
            for (int dl = 0; dl < 3 * STAG * (bid_ >> 1 & 3); ++dl) __builtin_amdgcn_s_sleep(127);
            if (bid_ & 1) { SkSwiGLU Es{HB}; skinny_gemm(bid_, G_, FRESH_TID(), wave_, F.lds + RING_OFF, X + (size_t)MP * D, D, WFI, D, DFF / 16, Es); }
            pg8::Gemm g{X, WFI, MP, 2 * DFF, D}; pg8::StaticOrder S; S.init(MP, 2 * DFF, G_, bid_); pg8::EpiSwiGLU E{HB, DFF};
            pg8::gemm_phase<pg8::EpiSwiGLU, pg8::StaticOrder, true, true>(F.lds + RING_OFF, g, S, E, FRESH_TID());
            if (!(bid_ & 1))
            for (int skr = 0; skr < SK_REP; ++skr) { SkSwiGLU Es{HB}; skinny_gemm(bid_, G_, FRESH_TID(), wave_, F.lds + RING_OFF, X + (size_t)MP * D, D, WFI, D, DFF / 16, Es); }
        PHASE_END
        PHASE_BEGIN(true, 10)
            if (bid_ & 1) { SkRes Es{YB, X, DN_ALPHA}; skinny_gemm(bid_, G_, FRESH_TID(), wave_, F.lds + RING_OFF, HB + (size_t)MP * DFF, DFF, WFO, DFF, D / 32, Es); }
            pg8::Gemm g{HB, WFO, MP, D, DFF}; pg8::StaticOrder S; S.init(MP, D, G_, bid_); pg8::EpiRes E{YB, X, D, DN_ALPHA};
            pg8::gemm_phase<pg8::EpiRes, pg8::StaticOrder, true, true>(F.lds + RING_OFF, g, S, E, FRESH_TID());
            if (!(bid_ & 1))
            for (int skr = 0; skr < SK_REP; ++skr) { SkRes Es{YB, X, DN_ALPHA}; skinny_gemm(bid_, G_, FRESH_TID(), wave_, F.lds + RING_OFF, HB + (size_t)MP * DFF, DFF, WFO, DFF, D / 32, Es); }
        PHASE_END
        PHASE_BEGIN(true, 8)
            if (l < 3) CONVERT_WEIGHTS(l + 1);
            const float* gg = ln2_g + (size_t)l * D; const float* bb = ln2_b + (size_t)l * D;
            if (l == 3) ln_rows<true>(lane, gw_, NGW_, YB, gg, bb, nullptr, [&](int row) -> float* { return row < MP ? out + O_YP + (size_t)row * D : out + O_YS + (size_t)(row - MP) * D; });
            else ln_rows<false>(lane, gw_, NGW_, YB, gg, bb, X, [](int) -> float* { return nullptr; });
        PHASE_END
    }
#if defined(DIAG_A)
    if (blockIdx.x == 0 && threadIdx.x == 0) { unsigned long long* dts = (unsigned long long*)(args.ws_ + 262144); dts[ph] = rt(); dts[63] = (unsigned long long)ph; }
#endif
#undef ws
#undef out
#undef X
#undef Y
#undef YB
#undef CONVERT_WEIGHTS
#undef CONVERT_CACHE_K
#undef CONVERT_CACHE_V
#undef PHASE_BEGIN
#undef PHASE_END
}

#if defined(DIAG_A)
__device__ const int diag_cls[40] = {0,0, 1,2,3,4,5,6,7,8,9,10,8, 1,2,3,4,5,6,7,8,9,10,8, 1,2,11,7,8,9,10,8, 1,2,11,7,8,9,10,8};
__global__ void diag_tail(float* o, const unsigned long long* dts) {
    __shared__ float dv[2];
    if (threadIdx.x == 0) { const int n = (int)dts[63]; unsigned long long sa = 0, sb = 0; for (int p = 0; p < n; ++p) { const unsigned long long d = dts[p + 1] - dts[p]; const int cl = diag_cls[p]; if (cl == DIAG_A) sa += d; if (cl == DIAG_B) sb += d; }
        dv[0] = (float)sa * 0.01f; dv[1] = (float)sb * 10.0f; }
    __syncthreads();
    for (int i = threadIdx.x; i < 262144; i += blockDim.x) o[O_YS + i] = dv[0];
    if (threadIdx.x == 0) o[O_YP] = dv[1];
}
#endif
#ifndef MK_PER_PHASE
#define MK_PER_PHASE 0
#endif
constexpr int N_PHASES = 1 + 2 * 10 + 2 * 7;
extern "C" void kernel_launch(void* const* d_in, const int* in_sizes, int n_in, void* d_out, int out_size, void* d_ws, size_t ws_size, hipStream_t stream) {
    static int grid = 0;
    if (grid == 0) {
        if (n_in != 22 || in_sizes[0] != MP * D || (size_t)out_size != O_END || ws_size < WS_END) { fprintf(stderr, "kernel_launch: unexpected shapes (n_in %d, in0 %d, out %d, ws %zu); nothing launched\n", n_in, n_in > 0 ? in_sizes[0] : -1, out_size, ws_size); grid = -1; return; }
        int dev = 0, cus = 0, per_cu = 0;
        if (hipGetDevice(&dev) != hipSuccess || hipDeviceGetAttribute(&cus, hipDeviceAttributeMultiprocessorCount, dev) != hipSuccess) { grid = -1; return; }
        if (hipFuncSetAttribute((const void*)mega, hipFuncAttributeMaxDynamicSharedMemorySize, LDS_BYTES) != hipSuccess) { fprintf(stderr, "kernel_launch: hipFuncSetAttribute failed\n"); grid = -1; return; }
        if (hipOccupancyMaxActiveBlocksPerMultiprocessor(&per_cu, (const void*)mega, NWAVES * 64, LDS_BYTES) != hipSuccess || per_cu < 1) fprintf(stderr, "kernel_launch: occupancy query reports %d\n", per_cu);
        (void)hipGetLastError();
        grid = cus;
    }
    if (grid < 0) return;
    if (hipMemsetAsync((char*)d_ws + WS_CTL, 0, CTL_ZERO_BYTES, stream) != hipSuccess) return;
    Args a{};
    for (int i = 0; i < 22; ++i) a.in[i] = (const float*)d_in[i];
    a.out_ = (float*)d_out; a.ws_ = (unsigned char*)d_ws;
#if MK_PER_PHASE
    for (int p = 0; p < N_PHASES; ++p) { a.ph_lo = p; a.ph_hi = p + 1; hipLaunchKernelGGL(mega, dim3(grid), dim3(NWAVES * 64), LDS_BYTES, stream, a); }
#else
    a.ph_lo = 0; a.ph_hi = N_PHASES; hipLaunchKernelGGL(mega, dim3(grid), dim3(NWAVES * 64), LDS_BYTES, stream, a);
#if defined(DIAG_A)
    hipLaunchKernelGGL(diag_tail, dim3(1), dim3(512), 0, stream, (float*)d_out, (const unsigned long long*)((unsigned char*)d_ws + 262144));
#endif
#endif
}
```

```cpp
#include <hip/hip_runtime.h>
#include <cstdio>
#include <cstdint>
namespace pg8 {
#define PG8_LAS __attribute__((address_space(3)))
typedef unsigned short bf16_t;
typedef short bf16x8 __attribute__((ext_vector_type(8)));
typedef float f32x4 __attribute__((ext_vector_type(4)));
typedef unsigned u32x4 __attribute__((ext_vector_type(4)));
constexpr int BM = 256, BK = 64, HALF = 128, HTB = HALF * BK * 2  , STAGE_BYTES = 8 * HTB, NXCD = 8, WGM = 4;

__host__ __device__ __forceinline__ int lds_byte(int r, int c) { const int st = (r >> 4) * 2 + (c >> 5), rr = r & 15, cc = c & 31, ob = rr * 64 + cc * 2; return st * 1024 + (ob ^ (((ob >> 9) & 1) << 5)); }
__host__ __device__ __forceinline__ void stage_rc(int b, int& R, int& C) { const int st = b / 1024, sb = b % 1024, swz = sb ^ (((sb >> 9) & 1) << 5); R = (st >> 1) * 16 + swz / 64; C = (st & 1) * 32 + (swz % 64) / 2; }
__host__ __device__ __forceinline__ int perm32(int rho) { const int n = rho >> 4, i = rho & 15; return 8 * (i >> 2) + 4 * n + (i & 3); }

struct Unit { int pm, pn; };
struct Gemm { const bf16_t* A; const bf16_t* Bt; int M, N, K; };

struct StaticOrder {
    int nM, nN, nwg, G, c;
    __host__ __device__ void init(int M, int N, int G_, int c_) { nM = M / BM; nN = N / BM; nwg = nM * nN; G = G_; c = c_; }
    __host__ __device__ bool next(int i, Unit& u) const {
        const long L = (long)i * G + c; if (L >= nwg) return false;
        int wgid = (int)L; { const int q = nwg / NXCD, r = nwg % NXCD, xcd = wgid % NXCD, off = wgid / NXCD; wgid = (xcd < r ? xcd * (q + 1) : r * (q + 1) + (xcd - r) * q) + off; }
        const int nig = WGM * nN, gid = wgid / nig, fm = gid * WGM, gsz = (nM - fm) < WGM ? (nM - fm) : WGM;
        u.pm = fm + ((wgid % nig) % gsz); u.pn = (wgid % nig) / gsz; return true;
    }
    __device__ __forceinline__ void a_ready(const Unit&) const {}
    __device__ __forceinline__ void done(const Unit&) const {}
};
__device__ __forceinline__ unsigned cvt_pk_bf16(float lo, float hi) { unsigned r; asm volatile("v_cvt_pk_bf16_f32 %0, %1, %2" : "=v"(r) : "v"(lo), "v"(hi)); return r; }
typedef float f32x2 __attribute__((ext_vector_type(2)));
typedef unsigned u32x2 __attribute__((ext_vector_type(2)));
__host__ __device__ __forceinline__ int vtf_d(int d) { return (d >> 5) * 1024 + (d & 31) * 8; }
__host__ __device__ __forceinline__ int vtf_k(int ks) { return (ks >> 4) * 512 + ((ks >> 2) & 1) * 256 + (ks & 3) + 4 * ((ks >> 3) & 1); }
__device__ __forceinline__ float bflo(unsigned w) { return __builtin_bit_cast(float, w << 16); }
__device__ __forceinline__ float bfhi(unsigned w) { return __builtin_bit_cast(float, w & 0xffff0000u); }
struct EpiBf16 {
    static constexpr bool PERM = true, AFTER_DRAIN = false;
    bf16_t* O; int ldc;
    __device__ __forceinline__ void operator()(const f32x4 (&acc)[2][2][4][2], const Unit& u, int wr, int wc, int fr, int fq) const {
        const int row0 = u.pm * BM + wr * 64 + fr, col0 = u.pn * BM + wc * 32 + 8 * fq;
#pragma unroll
        for (int ai = 0; ai < 2; ++ai)
#pragma unroll
            for (int m = 0; m < 4; ++m) { bf16_t* rowp = O + (size_t)(row0 + ai * HALF + m * 16) * ldc + col0;
#pragma unroll
                for (int bj = 0; bj < 2; ++bj) { const f32x4 v0 = acc[ai][bj][m][0], v1 = acc[ai][bj][m][1];
                    u32x4 w; w.x = cvt_pk_bf16(v0[0], v0[1]); w.y = cvt_pk_bf16(v0[2], v0[3]); w.z = cvt_pk_bf16(v1[0], v1[1]); w.w = cvt_pk_bf16(v1[2], v1[3]);
                    *(u32x4*)(rowp + bj * HALF) = w; } }
    }
};
struct EpiSwiGLU {
    static constexpr bool PERM = true, AFTER_DRAIN = false;
    bf16_t* Hh; int ldh;
    __device__ __forceinline__ float swi(float g, float up) const { return g * __builtin_amdgcn_rcpf(1.0f + __expf(-g)) * up; }
    __device__ __forceinline__ void operator()(const f32x4 (&acc)[2][2][4][2], const Unit& u, int wr, int wc, int fr, int fq) const {
        const int row0 = u.pm * BM + wr * 64 + fr, col0 = u.pn * HALF + wc * 32 + 8 * fq;
#pragma unroll
        for (int ai = 0; ai < 2; ++ai)
#pragma unroll
            for (int m = 0; m < 4; ++m) { bf16_t* rowp = Hh + (size_t)(row0 + ai * HALF + m * 16) * ldh + col0;
                const f32x4 g0 = acc[ai][0][m][0], g1 = acc[ai][0][m][1], u0 = acc[ai][1][m][0], u1 = acc[ai][1][m][1];
                u32x4 w; w.x = cvt_pk_bf16(swi(g0[0], u0[0]), swi(g0[1], u0[1])); w.y = cvt_pk_bf16(swi(g0[2], u0[2]), swi(g0[3], u0[3]));
                w.z = cvt_pk_bf16(swi(g1[0], u1[0]), swi(g1[1], u1[1])); w.w = cvt_pk_bf16(swi(g1[2], u1[2]), swi(g1[3], u1[3]));
                *(u32x4*)rowp = w; }
    }
};
struct EpiRes {
    static constexpr bool PERM = true, AFTER_DRAIN = false;
    bf16_t* Y; const bf16_t* X; int ldc; float alpha;
    __device__ __forceinline__ void operator()(const f32x4 (&acc)[2][2][4][2], const Unit& u, int wr, int wc, int fr, int fq) const {
        const int row0 = u.pm * BM + wr * 64 + fr, col0 = u.pn * BM + wc * 32 + 8 * fq;
        u32x4 xv[2][4][2];
#pragma unroll
        for (int ai = 0; ai < 2; ++ai)
#pragma unroll
            for (int m = 0; m < 4; ++m)
#pragma unroll
                for (int bj = 0; bj < 2; ++bj) xv[ai][m][bj] = *(const u32x4*)(X + (size_t)(row0 + ai * HALF + m * 16) * ldc + col0 + bj * HALF);
#pragma unroll
        for (int ai = 0; ai < 2; ++ai)
#pragma unroll
            for (int m = 0; m < 4; ++m) { const size_t ro = (size_t)(row0 + ai * HALF + m * 16) * ldc + col0;
#pragma unroll
                for (int bj = 0; bj < 2; ++bj) { const u32x4 x4 = xv[ai][m][bj]; const f32x4 a0 = acc[ai][bj][m][0], a1 = acc[ai][bj][m][1];
                    u32x4 w; w.x = cvt_pk_bf16(alpha * bflo(x4.x) + a0[0], alpha * bfhi(x4.x) + a0[1]); w.y = cvt_pk_bf16(alpha * bflo(x4.y) + a0[2], alpha * bfhi(x4.y) + a0[3]);
                    w.z = cvt_pk_bf16(alpha * bflo(x4.z) + a1[0], alpha * bfhi(x4.z) + a1[1]); w.w = cvt_pk_bf16(alpha * bflo(x4.w) + a1[2], alpha * bfhi(x4.w) + a1[3]);
                    *(u32x4*)(Y + ro + bj * HALF) = w; } }
    }
};
struct EpiKV {
    static constexpr bool PERM = false, AFTER_DRAIN = false;
    float *okp, *ovp, *oks, *ovs; bf16_t *kpb, *vpb, *ksb, *vsb;
    __device__ __forceinline__ void operator()(const f32x4 (&acc)[2][2][4][2], const Unit& u, int wr, int wc, int fr, int fq) const {
        const bool isv = u.pn >= 6; const int colt = (u.pn - (isv ? 6 : 0)) * BM + wc * 32 + 4 * fq, row0 = u.pm * BM + wr * 64 + fr;
        float* op = isv ? ovp : okp;
#pragma unroll
        for (int ai = 0; ai < 2; ++ai)
#pragma unroll
            for (int m = 0; m < 4; ++m) { const int row = row0 + ai * HALF + m * 16; float* fd;
                if (row < 32768) { fd = op + (size_t)row * 1536; } else continue;
                const int bq = row >> 13, sq = row & 8191;
#pragma unroll
                for (int bj = 0; bj < 2; ++bj)
#pragma unroll
                    for (int n = 0; n < 2; ++n) { const int c = colt + bj * HALF + n * 16; const f32x4 v = acc[ai][bj][m][n];
                        *(f32x4*)(fd + c) = v; const unsigned w0 = cvt_pk_bf16(v[0], v[1]), w1 = cvt_pk_bf16(v[2], v[3]);
                        const int hq = c >> 7, dq = c & 127;
                        if (!isv) { u32x2 w; w.x = w0; w.y = w1; *(u32x2*)(kpb + ((size_t)(bq * 12 + hq) * 8192 + sq) * 128 + dq) = w; }
                        else { bf16_t* vt = vpb + ((size_t)(bq * 12 + hq) * 256 + (sq >> 5)) * 4096 + vtf_d(dq) + vtf_k(sq & 31); vt[0] = (bf16_t)w0; vt[8] = (bf16_t)(w0 >> 16); vt[16] = (bf16_t)w1; vt[24] = (bf16_t)(w1 >> 16); } } }
    }
};
struct EpiMemKV {
    static constexpr bool PERM = false, AFTER_DRAIN = false;
    float *ok, *ov; bf16_t *kb, *vb;
    __device__ __forceinline__ void operator()(const f32x4 (&acc)[2][2][4][2], const Unit& u, int wr, int wc, int fr, int fq) const {
        const int l = u.pn >> 2, kv = (u.pn >> 1) & 1, hd0 = (u.pn & 1) * BM + wc * 32 + 4 * fq, row0 = u.pm * BM + wr * 64 + fr;
        float* fo = kv ? ov : ok; bf16_t* bo = kv ? vb : kb;
#pragma unroll
        for (int ai = 0; ai < 2; ++ai)
#pragma unroll
            for (int m = 0; m < 4; ++m) { const int row = row0 + ai * HALF + m * 16, b = row >> 8, mm = row & 255;
                float* fd = fo + (size_t)(l * 1024 + row) * 512; bf16_t* bd = bo + (size_t)((l * 12 + b) * 256 + mm) * 512;
#pragma unroll
                for (int bj = 0; bj < 2; ++bj)
#pragma unroll
                    for (int n = 0; n < 2; ++n) { const int c = hd0 + bj * HALF + n * 16; const f32x4 v = acc[ai][bj][m][n];
                        *(f32x4*)(fd + c) = v; const unsigned w0 = cvt_pk_bf16(v[0], v[1]), w1 = cvt_pk_bf16(v[2], v[3]);
                        if (!kv) { u32x2 w; w.x = w0; w.y = w1; *(u32x2*)(bd + c) = w; }
                        else { bf16_t* vt = vb + (size_t)((l * 12 + b) * 512 + c) * 256 + mm;
                            vt[0] = (bf16_t)w0; vt[256] = (bf16_t)(w0 >> 16); vt[512] = (bf16_t)w1; vt[768] = (bf16_t)(w1 >> 16); } } }
    }
};
template <class Epi, class Sched, bool ALIGN_EPI = false, bool SP2 = false>
__device__ __forceinline__ void gemm_phase(PG8_LAS unsigned char* lds, const Gemm g, const Sched& S, const Epi& E, int tid_in) {
    int tid_ = tid_in; asm volatile("" : "+v"(tid_));
    const int tid = tid_, wid = __builtin_amdgcn_readfirstlane(tid >> 6), lane = tid & 63, wr = wid >> 2, wc = wid & 3, fr = lane & 15, fq = lane >> 4;
    const int K = g.K, nt = K / BK;
    unsigned voffA[2], voffB[2];
#pragma unroll
    for (int i = 0; i < 2; ++i) { int R, C; stage_rc(tid * 16 + i * 8192, R, C); const int Rb = Epi::PERM ? ((R & ~31) + perm32(R & 31)) : R;
        voffA[i] = (unsigned)(R * K + C) * 2u; voffB[i] = (unsigned)(Rb * K + C) * 2u; }
    const size_t kstep = (size_t)(BK * 2);
    const size_t hstep = (size_t)HALF * K * 2;
    const size_t tstep = 2 * hstep;
    const unsigned ldsw = (unsigned)wid * 1024u;
    const int aoff = lds_byte(wr * 64 + fr, fq * 8), boff = lds_byte(wc * 32 + fr, fq * 8);
#define PG8_SA(b, h) (((b) * 2 + (h)) * HTB)
#define PG8_SB(b, h) ((4 + (b) * 2 + (h)) * HTB)
#define PG8_STAGE_X(bufoff, gbase, voff, aux) do { _Pragma("unroll") for (int _i = 0; _i < 2; ++_i) \
        __builtin_amdgcn_global_load_lds((const unsigned*)((const char*)(gbase) + (voff)[_i]), (PG8_LAS unsigned*)(lds + (bufoff) + ldsw + _i * 8192), 16, 0, aux); } while (0)
#ifndef PG8_B_AUX
#define PG8_B_AUX 0
#endif
#define PG8_STAGE(bufoff, gbase, voff) PG8_STAGE_X(bufoff, gbase, voff, 0)
#define PG8_LDA(dst, b, h) do { _Pragma("unroll") for (int m = 0; m < 4; ++m) _Pragma("unroll") for (int k = 0; k < 2; ++k) dst[m][k] = *(const PG8_LAS bf16x8*)(lds + PG8_SA(b, h) + aoff + m * 2048 + k * 1024); } while (0)
#define PG8_LDB(dst, b, h) do { _Pragma("unroll") for (int n = 0; n < 2; ++n) _Pragma("unroll") for (int k = 0; k < 2; ++k) dst[n][k] = *(const PG8_LAS bf16x8*)(lds + PG8_SB(b, h) + boff + n * 2048 + k * 1024); } while (0)
#define PG8_MMA(ai, bj, At, Bt) do { __builtin_amdgcn_s_setprio(1); _Pragma("unroll") for (int m = 0; m < 4; ++m) _Pragma("unroll") for (int n = 0; n < 2; ++n) _Pragma("unroll") for (int k = 0; k < 2; ++k) \
        acc[ai][bj][m][n] = __builtin_amdgcn_mfma_f32_16x16x32_bf16(Bt[n][k], At[m][k], acc[ai][bj][m][n], 0, 0, 0); __builtin_amdgcn_s_setprio(0); } while (0)
#define PG8_WAIT_V(n) asm volatile("s_waitcnt vmcnt(" #n ")" ::: "memory")
#define PG8_WAIT_L(n) asm volatile("s_waitcnt lgkmcnt(" #n ")" ::: "memory")
#define PG8_BAR __builtin_amdgcn_s_barrier()
#define PG8_SCHED __builtin_amdgcn_sched_barrier(0)
    Unit cur, nxt; int ui = 0;
    if (!S.next(0, cur)) return;
    f32x4 acc[2][2][4][2];
#pragma unroll
    for (int a = 0; a < 2; ++a)
#pragma unroll
        for (int b = 0; b < 2; ++b)
#pragma unroll
            for (int m = 0; m < 4; ++m)
#pragma unroll
                for (int n = 0; n < 2; ++n) acc[a][b][m][n] = (f32x4){0.f, 0.f, 0.f, 0.f};
    bf16x8 At[4][2], B0[2][2], B1[2][2];
    const char* cA = (const char*)g.A + (size_t)cur.pm * tstep; const char* cB = (const char*)g.Bt + (size_t)cur.pn * tstep;
    S.a_ready(cur);
    if constexpr (SP2) {
        PG8_STAGE_X(PG8_SB(0, 0), cB, voffB, PG8_B_AUX); PG8_STAGE_X(PG8_SB(0, 1), cB + hstep, voffB, PG8_B_AUX); PG8_STAGE(PG8_SA(0, 0), cA, voffA); PG8_STAGE(PG8_SA(0, 1), cA + hstep, voffA);
        if (wr == 1) PG8_BAR;
        PG8_WAIT_V(2); PG8_BAR;
        PG8_STAGE_X(PG8_SB(1, 0), cB + kstep, voffB, PG8_B_AUX); PG8_STAGE(PG8_SA(1, 0), cA + kstep, voffA); PG8_STAGE_X(PG8_SB(1, 1), cB + hstep + kstep, voffB, PG8_B_AUX);
        PG8_WAIT_V(6); PG8_BAR;
    } else {
        PG8_STAGE_X(PG8_SB(0, 0), cB, voffB, PG8_B_AUX); PG8_STAGE(PG8_SA(0, 0), cA, voffA); PG8_STAGE_X(PG8_SB(0, 1), cB + hstep, voffB, PG8_B_AUX); PG8_STAGE(PG8_SA(0, 1), cA + hstep, voffA);
        if (wr == 1) PG8_BAR;
        PG8_WAIT_V(4); PG8_BAR;
        PG8_STAGE_X(PG8_SB(1, 0), cB + kstep, voffB, PG8_B_AUX); PG8_STAGE(PG8_SA(1, 0), cA + kstep, voffA); PG8_STAGE_X(PG8_SB(1, 1), cB + hstep + kstep, voffB, PG8_B_AUX);
        PG8_WAIT_V(6); PG8_BAR;
    }
    for (;;) {
        const bool has_next = S.next(ui + 1, nxt);
        const char* nA = has_next ? (const char*)g.A + (size_t)nxt.pm * tstep : cA; const char* nB = has_next ? (const char*)g.Bt + (size_t)nxt.pn * tstep : cB;
        for (int t = 0; t < nt; t += 2) {
            const bool last = (t == nt - 2);
            const char* a1 = cA + (size_t)(t + 1) * kstep;
            const char* a2 = last ? nA : cA + (size_t)(t + 2) * kstep; const char* b2 = last ? nB : cB + (size_t)(t + 2) * kstep;
            const char* a3 = a2 + kstep; const char* b3 = b2 + kstep;
            if (last && has_next) S.a_ready(nxt);
            if constexpr (SP2) {
            PG8_LDB(B0, 0, 0); PG8_LDB(B1, 0, 1); PG8_SCHED; PG8_LDA(At, 0, 0); PG8_STAGE(PG8_SA(1, 1), a1 + hstep, voffA);
            PG8_WAIT_V(8); PG8_WAIT_L(0); PG8_BAR; PG8_MMA(0, 0, At, B0); PG8_MMA(0, 1, At, B1); PG8_BAR; PG8_SCHED;
            PG8_LDA(At, 0, 1); PG8_STAGE_X(PG8_SB(0, 0), b2, voffB, PG8_B_AUX); PG8_STAGE_X(PG8_SB(0, 1), b2 + hstep, voffB, PG8_B_AUX); PG8_STAGE(PG8_SA(0, 0), a2, voffA);
            PG8_WAIT_V(8); PG8_WAIT_L(0); PG8_BAR; PG8_MMA(1, 0, At, B0); PG8_MMA(1, 1, At, B1); PG8_BAR; PG8_SCHED;
            PG8_LDB(B0, 1, 0); PG8_LDB(B1, 1, 1); PG8_SCHED; PG8_LDA(At, 1, 0); PG8_STAGE(PG8_SA(0, 1), a2 + hstep, voffA);
            PG8_WAIT_V(8); PG8_WAIT_L(0); PG8_BAR; PG8_MMA(0, 0, At, B0); PG8_MMA(0, 1, At, B1); PG8_BAR; PG8_SCHED;
            PG8_LDA(At, 1, 1); PG8_STAGE_X(PG8_SB(1, 0), b3, voffB, PG8_B_AUX); PG8_STAGE_X(PG8_SB(1, 1), b3 + hstep, voffB, PG8_B_AUX); PG8_STAGE(PG8_SA(1, 0), a3, voffA);
            PG8_WAIT_V(8); PG8_WAIT_L(0); PG8_BAR; PG8_MMA(1, 0, At, B0); PG8_MMA(1, 1, At, B1); PG8_BAR; PG8_SCHED;
            } else {
            PG8_LDB(B0, 0, 0); PG8_SCHED; PG8_LDA(At, 0, 0); PG8_STAGE(PG8_SA(1, 1), a1 + hstep, voffA);
            PG8_WAIT_L(8); PG8_BAR; PG8_WAIT_L(0); PG8_MMA(0, 0, At, B0); PG8_BAR; PG8_SCHED;
            PG8_LDB(B1, 0, 1); PG8_STAGE_X(PG8_SB(0, 0), b2, voffB, PG8_B_AUX);
            PG8_BAR; PG8_WAIT_L(0); PG8_MMA(0, 1, At, B1); PG8_BAR;
            PG8_LDA(At, 0, 1); PG8_STAGE(PG8_SA(0, 0), a2, voffA);
            PG8_BAR; PG8_WAIT_L(0); PG8_MMA(1, 0, At, B0); PG8_BAR; PG8_SCHED;
            PG8_STAGE_X(PG8_SB(0, 1), b2 + hstep, voffB, PG8_B_AUX);
            PG8_WAIT_V(6); PG8_BAR; PG8_MMA(1, 1, At, B1); PG8_BAR;
            PG8_LDB(B0, 1, 0); PG8_SCHED; PG8_LDA(At, 1, 0); PG8_STAGE(PG8_SA(0, 1), a2 + hstep, voffA);
            PG8_WAIT_L(8); PG8_BAR; PG8_WAIT_L(0); PG8_MMA(0, 0, At, B0); PG8_BAR; PG8_SCHED;
            PG8_LDB(B1, 1, 1); PG8_STAGE_X(PG8_SB(1, 0), b3, voffB, PG8_B_AUX);
            PG8_BAR; PG8_WAIT_L(0); PG8_MMA(0, 1, At, B1); PG8_BAR;
            PG8_LDA(At, 1, 1); PG8_STAGE(PG8_SA(1, 0), a3, voffA);
            PG8_BAR; PG8_WAIT_L(0); PG8_MMA(1, 0, At, B0); PG8_BAR; PG8_SCHED;
            PG8_STAGE_X(PG8_SB(1, 1), b3 + hstep, voffB, PG8_B_AUX);
            PG8_WAIT_V(6); PG8_BAR; PG8_MMA(1, 1, At, B1); PG8_BAR;
            }
        }
        if constexpr (ALIGN_EPI) { if (wr == 0) PG8_BAR; }
        if constexpr (!Epi::AFTER_DRAIN) { E(acc, cur, wr, wc, fr, fq); S.done(cur); }
        if (!has_next) break;
#pragma unroll
        for (int a = 0; a < 2; ++a)
#pragma unroll
            for (int b = 0; b < 2; ++b)
#pragma unroll
                for (int m = 0; m < 4; ++m)
#pragma unroll
                    for (int n = 0; n < 2; ++n) acc[a][b][m][n] = (f32x4){0.f, 0.f, 0.f, 0.f};
        cur = nxt; cA = nA; cB = nB; ++ui;
        if constexpr (ALIGN_EPI) { if (wr == 1) PG8_BAR; }
    }
    PG8_WAIT_V(0);
    if constexpr (!ALIGN_EPI) { if (wr == 0) PG8_BAR; }
    PG8_BAR;
    if constexpr (Epi::AFTER_DRAIN) { E.fused(acc, cur, wr, wc, fr, fq, lds, wid, lane); S.done(cur); }
#undef PG8_SA
#undef PG8_SB
#undef PG8_STAGE
#undef PG8_STAGE_X
#undef PG8_LDA
#undef PG8_LDB
#undef PG8_MMA
#undef PG8_WAIT_V
#undef PG8_WAIT_L
#undef PG8_BAR
#undef PG8_SCHED
}
}
#define GAS __attribute__((address_space(1)))
#define LAS __attribute__((address_space(3)))
typedef unsigned short bf16;
typedef unsigned v4u __attribute__((ext_vector_type(4)));
typedef float f32x4 __attribute__((ext_vector_type(4)));
typedef short bf16x8 __attribute__((ext_vector_type(8)));
typedef GAS unsigned gu32;
typedef GAS unsigned long long gu64;
#define RLX_AGENT __ATOMIC_RELAXED, __HIP_MEMORY_SCOPE_AGENT
#define LDS_WAIT() asm volatile("s_waitcnt lgkmcnt(0)" ::: "memory")
#define VM_WAIT() asm volatile("s_waitcnt vmcnt(0)" ::: "memory")
__device__ __forceinline__ unsigned long long rt() { return __builtin_amdgcn_s_memrealtime(); }
__device__ __forceinline__ unsigned f2bf(float f) { unsigned u = __builtin_bit_cast(unsigned, f); return (u + 0x7fffu + ((u >> 16) & 1u)) >> 16; }
__device__ __forceinline__ unsigned pk2(float lo, float hi) { return f2bf(lo) | (f2bf(hi) << 16); }
#define XB_TMO      128
#define XB_XCNT(j)  (256  + 64 * (j))
#define XB_XSUB(j)  (1280 + 64 * (j))
#define XB_XGEN(j)  (2304 + 64 * (j))
#define XB_TOP      3328
#define XB_TOPGEN   3392
#define XCD_BAR_WORDS 3456
#define XB_SPIN_CAP (1u << 18)

__device__ __forceinline__ unsigned xb_ld(unsigned* p)              { return __hip_atomic_load(p, __ATOMIC_RELAXED, __HIP_MEMORY_SCOPE_AGENT); }
__device__ __forceinline__ unsigned xb_add(unsigned* p, unsigned v) { return __hip_atomic_fetch_add(p, v, __ATOMIC_RELAXED, __HIP_MEMORY_SCOPE_AGENT); }
__device__ __forceinline__ unsigned xb_xcc_id() { return (unsigned)__builtin_amdgcn_s_getreg((3 << 11) | 20) & 0xFu; }
#define XB_SPIN(cond, bar) do { unsigned _sp = 0; while (cond) { __builtin_amdgcn_s_sleep(1); \
    if ((++_sp & 255u) == 0u) { if (xb_ld(&(bar)[XB_TMO])) break; if (_sp > XB_SPIN_CAP) { atomicAdd(&(bar)[XB_TMO], 1u); break; } } } } while (0)

struct XcdBarrier {
    unsigned* bar; unsigned x;
    volatile LAS unsigned* st;
};

__device__ __forceinline__ XcdBarrier xcd_barrier_post(unsigned* bar, volatile LAS unsigned* st) {
    XcdBarrier b; b.bar = bar; b.x = xb_xcc_id(); b.st = st;
    if (threadIdx.x == 0) (void)xb_add(&bar[XB_XCNT(b.x)], 1u);
    return b;
}
__device__ __forceinline__ void xcd_barrier_complete(unsigned* bar, unsigned x, unsigned& nloc, unsigned& nx) {
    const unsigned G = gridDim.x * gridDim.y * gridDim.z;
    unsigned sum, cnt, mine, sp = 0u;
    for (;;) {
        sum = 0u; cnt = 0u; mine = 0u;
#pragma unroll
        for (unsigned j = 0; j < 16; ++j) { const unsigned c = xb_ld(&bar[XB_XCNT(j)]); sum += c; cnt += (c > 0u) ? 1u : 0u; mine = (j == x) ? c : mine; }
        if (sum == G) break;
        __builtin_amdgcn_s_sleep(1);
        if ((++sp & 255u) == 0u) { if (xb_ld(&bar[XB_TMO])) break; if (sp > XB_SPIN_CAP) { atomicAdd(&bar[XB_TMO], 1u); break; } }
    }
    nloc = mine > 0u ? mine : 1u; nx = cnt > 0u ? cnt : 1u;
}

__device__ __forceinline__ void xcd_barrier(const XcdBarrier& b) {
    asm volatile("s_waitcnt vmcnt(0)" ::: "memory");
    __syncthreads();
    if (threadIdx.x == 0) {
        unsigned* bar = b.bar;
        __builtin_amdgcn_s_waitcnt(0);
        unsigned nloc = b.st[0], nx = b.st[1];
        if (nloc == 0u) { xcd_barrier_complete(bar, b.x, nloc, nx); b.st[0] = nloc; b.st[1] = nx; }
        const unsigned old = xb_add(&bar[XB_XSUB(b.x)], 1u);
        const unsigned gen = old / nloc;
        if (old + 1u == (gen + 1u) * nloc) {
            __builtin_amdgcn_fence(__ATOMIC_RELEASE, "agent");
            asm volatile("s_waitcnt vmcnt(0)" ::: "memory");
            const unsigned og = xb_add(&bar[XB_TOP], 1u);
            const unsigned tg = og / nx;
            if (og + 1u == (tg + 1u) * nx) xb_add(&bar[XB_TOPGEN], 1u);
            else XB_SPIN(xb_ld(&bar[XB_TOPGEN]) == tg, bar);
            __builtin_amdgcn_fence(__ATOMIC_ACQUIRE, "agent");
            xb_add(&bar[XB_XGEN(b.x)], 1u);
            asm volatile("s_waitcnt vmcnt(0)" ::: "memory");
        } else {
            XB_SPIN(xb_ld(&bar[XB_XGEN(b.x)]) == gen, bar);
            __builtin_amdgcn_fence(__ATOMIC_ACQUIRE, "agent");
            asm volatile("s_waitcnt vmcnt(0)" ::: "memory");
        }
    }
    __syncthreads();
}
constexpr int NWAVES = 8;
constexpr int D = 2048, SEQ = 8192, MP = 32768, MS = 128, MR = 32896, MT = 33024;
constexpr int DFF = 5632, NA = 5376, NBQ = 2048, NKV = 3072;
constexpr int CQ = 0, CK = 768, CV = 1536, CG = 3072, CQM = 4608, CLR = 5120;
constexpr float DN_ALPHA = 1.6817928305074292f, LN_EPS = 1e-5f, RMS_EPS = 1e-6f;
constexpr float GLA_QSCALE = 0.07216878364870323f, HD_SCALE = 0.08838834764831845f;
constexpr size_t MiB = 1u << 20;
constexpr size_t WS_CTL = 0, CTL_ZERO_BYTES = 1 * MiB;
constexpr size_t WS_WIN = 1 * MiB, WS_WO = 22 * MiB, WS_WFI = 30 * MiB, WS_WFO = 74 * MiB, WS_WMEM = 96 * MiB, WS_MEMX = 112 * MiB, WS_MEMK = 116 * MiB, WS_MEMV = 128 * MiB;
constexpr size_t WS_X = 140 * MiB, WS_Y = 269 * MiB, WS_R1 = 527 * MiB, WS_OCAT = 882 * MiB, WS_SBKS = 1011 * MiB, WS_SBVS = 1060 * MiB, WS_END = 1109 * MiB;
static_assert(WS_WIN + (size_t)NA * D * 2 <= WS_WO && WS_WFI + (size_t)2 * DFF * D * 2 <= WS_WFO && WS_WFO + (size_t)D * DFF * 2 <= WS_WMEM, "weights map");
static_assert(WS_X + (size_t)MT * D * 2 <= WS_Y && WS_Y + (size_t)MT * D * 4 <= WS_R1 && WS_R1 + (size_t)MT * DFF * 2 <= WS_OCAT && WS_OCAT + (size_t)MT * D * 2 <= WS_SBKS, "activation map");
static_assert(WS_SBKS + (size_t)8 * 2064 * 1536 * 2 <= WS_SBVS && WS_SBVS + (size_t)8 * 2064 * 1536 * 2 <= WS_END, "sb sample map");
constexpr size_t O_YP = 0, O_YS = 67108864, O_GSP = 67371008, O_GSS = 69730304, O_SKP = 74448896, O_SVP = 124780544, O_SKS = 175112192, O_SVS = 175308800, O_MKP = 175505408, O_MVP = 177602560, O_END = 179699712;
constexpr int CW_BAR = 4096;
constexpr int RING_OFF = 0, RING_BYTES = 131072, LDSCTL_OFF = RING_BYTES, MISC_OFF = LDSCTL_OFF + 320, LDS_BYTES = 147456;

struct Args { const float* in[22]; float* out_; unsigned char* ws_; int ph_lo, ph_hi; };
struct Frame {
    LAS unsigned char* lds; volatile LAS unsigned* MISC; gu32* ctl;
    int tid, lane, wave, G, gw, NGW;
};
__device__ __forceinline__ float bf2f(bf16 h) { return __builtin_bit_cast(float, (unsigned)h << 16); }
__device__ __forceinline__ float shx(float v, int lane, int m) { return __builtin_bit_cast(float, __builtin_amdgcn_ds_bpermute((lane ^ m) << 2, __builtin_bit_cast(int, v))); }
__device__ __forceinline__ float wave_sum(float v, int lane) {
#pragma unroll
    for (int o = 1; o < 64; o <<= 1) v += shx(v, lane, o);
    return v;
}
__device__ __forceinline__ float wave_max(float v, int lane) {
#pragma unroll
    for (int o = 1; o < 64; o <<= 1) v = fmaxf(v, shx(v, lane, o));
    return v;
}
__device__ __forceinline__ void cvt_row(const float* src, bf16* dst, int n, int lane) {
    for (int j = lane * 4; j < n; j += 256) {
        f32x4 v = src ? *(const f32x4*)(src + j) : (f32x4){0.f, 0.f, 0.f, 0.f};
        unsigned long long w = (unsigned long long)pk2(v.x, v.y) | ((unsigned long long)pk2(v.z, v.w) << 32);
        *(unsigned long long*)(dst + j) = w;
    }
}
template <int N>
__device__ __forceinline__ void cvt_rows2(const float* s0, const float* s1, bf16* d0, bf16* d1, int lane) {
    f32x4 v0[N / 256], v1[N / 256];
#pragma unroll
    for (int j = 0; j < N / 256; ++j) { v0[j] = s0 ? *(const f32x4*)(s0 + lane * 4 + 256 * j) : (f32x4){0.f, 0.f, 0.f, 0.f}; v1[j] = s1 ? *(const f32x4*)(s1 + lane * 4 + 256 * j) : (f32x4){0.f, 0.f, 0.f, 0.f}; }
#pragma unroll
    for (int j = 0; j < N / 256; ++j) {
        *(unsigned long long*)(d0 + lane * 4 + 256 * j) = (unsigned long long)pk2(v0[j].x, v0[j].y) | ((unsigned long long)pk2(v0[j].z, v0[j].w) << 32);
        *(unsigned long long*)(d1 + lane * 4 + 256 * j) = (unsigned long long)pk2(v1[j].x, v1[j].y) | ((unsigned long long)pk2(v1[j].z, v1[j].w) << 32); }
}
__device__ __forceinline__ int fresh_lane() { int z = 0; asm volatile("" : "+s"(z)); return (int)__builtin_amdgcn_mbcnt_hi(~0u, __builtin_amdgcn_mbcnt_lo(~0u, (unsigned)z)); }
#define FRESH_TID() (wave_ * 64 + fresh_lane())
template <bool FINAL>
__device__ __forceinline__ void ln_two_rows(int lane, const v4u (&w)[2][4], const float* gg, const float* bb, bf16* x0, bf16* x1, float* of0, float* of1) {
    float v[2][4][8]; float s[2] = {0.f, 0.f};
#pragma unroll
    for (int r = 0; r < 2; ++r)
#pragma unroll
        for (int j = 0; j < 4; ++j) { const v4u q = w[r][j]; v[r][j][0] = pg8::bflo(q.x); v[r][j][1] = pg8::bfhi(q.x); v[r][j][2] = pg8::bflo(q.y); v[r][j][3] = pg8::bfhi(q.y); v[r][j][4] = pg8::bflo(q.z); v[r][j][5] = pg8::bfhi(q.z); v[r][j][6] = pg8::bflo(q.w); v[r][j][7] = pg8::bfhi(q.w);
            s[r] += ((v[r][j][0] + v[r][j][1]) + (v[r][j][2] + v[r][j][3])) + ((v[r][j][4] + v[r][j][5]) + (v[r][j][6] + v[r][j][7])); }
    const float m0 = wave_sum(s[0], lane) * (1.f / D), m1 = wave_sum(s[1], lane) * (1.f / D); float q0 = 0.f, q1 = 0.f;
#pragma unroll
    for (int j = 0; j < 4; ++j)
#pragma unroll
        for (int i = 0; i < 8; ++i) { v[0][j][i] -= m0; q0 += v[0][j][i] * v[0][j][i]; v[1][j][i] -= m1; q1 += v[1][j][i] * v[1][j][i]; }
    const float rs[2] = {1.f / sqrtf(wave_sum(q0, lane) * (1.f / D) + LN_EPS), 1.f / sqrtf(wave_sum(q1, lane) * (1.f / D) + LN_EPS)};
#pragma unroll
    for (int j = 0; j < 4; ++j) { const int e0 = (lane + 64 * j) * 8; const f32x4 g0 = *(const f32x4*)(gg + e0), g1 = *(const f32x4*)(gg + e0 + 4), b0 = *(const f32x4*)(bb + e0), b1 = *(const f32x4*)(bb + e0 + 4);
#pragma unroll
        for (int r = 0; r < 2; ++r) { float o[8];
#pragma unroll
            for (int i = 0; i < 4; ++i) { o[i] = v[r][j][i] * rs[r] * g0[i] + b0[i]; o[4 + i] = v[r][j][4 + i] * rs[r] * g1[i] + b1[i]; }
            if (FINAL) { float* of = r ? of1 : of0; *(f32x4*)(of + e0) = (f32x4){o[0], o[1], o[2], o[3]}; *(f32x4*)(of + e0 + 4) = (f32x4){o[4], o[5], o[6], o[7]}; }
            else { v4u p; p.x = pk2(o[0], o[1]); p.y = pk2(o[2], o[3]); p.z = pk2(o[4], o[5]); p.w = pk2(o[6], o[7]); *(v4u*)((r ? x1 : x0) + e0) = p; } } }
}
template <bool FINAL, class OutF>
__device__ __forceinline__ void ln_rows(int lane, int gw, int NGW, const bf16* YBp, const float* gg, const float* bb, bf16* Xp, OutF outf) {
    const bool has_ex = gw < MR - MP; const int exrow = MP + gw; v4u ex[2][4];
    if (has_ex) {
#pragma unroll
        for (int j = 0; j < 4; ++j) ex[0][j] = ((const v4u*)(YBp + (size_t)exrow * D))[lane + 64 * j]; }
    __builtin_amdgcn_sched_barrier(0);
#pragma unroll 1
    for (int row = 2 * gw; row < MP; row += 2 * NGW) { v4u w[2][4];
#pragma unroll
        for (int j = 0; j < 4; ++j) { w[0][j] = ((const v4u*)(YBp + (size_t)row * D))[lane + 64 * j]; w[1][j] = ((const v4u*)(YBp + (size_t)(row + 1) * D))[lane + 64 * j]; }
        if (FINAL) { float* of = outf(row); ln_two_rows<true>(lane, w, gg, bb, nullptr, nullptr, of, of + D); }
        else ln_two_rows<false>(lane, w, gg, bb, Xp + (size_t)row * D, Xp + (size_t)(row + 1) * D, nullptr, nullptr); }
    if (has_ex) {
#pragma unroll
        for (int j = 0; j < 4; ++j) ex[1][j] = ex[0][j];
        if (FINAL) { float* of = outf(exrow); ln_two_rows<true>(lane, ex, gg, bb, nullptr, nullptr, of, of); }
        else ln_two_rows<false>(lane, ex, gg, bb, Xp + (size_t)exrow * D, Xp + (size_t)exrow * D, nullptr, nullptr); }
}
struct MapId { __device__ __forceinline__ int operator()(int n) const { return n; } };
struct MapInA { __device__ __forceinline__ int operator()(int n) const { return n < 4608 ? n : (n < 5120 ? n + 16 : (n < 5136 ? n - 512 : -1)); } };
struct MapFfn { __device__ __forceinline__ int operator()(int n) const { const int t = n >> 8, r = n & 255; return r < 128 ? 128 * t + r : DFF + 128 * t + (r - 128); } };
template <class Map>
__device__ __forceinline__ void wt_convert(LAS unsigned char* ldsb, int wave, int gw, int NGW, int lane, const float* W, int K, int Nsrc, bf16* WT, int Ndst, Map map) {
    LAS float* scr = (LAS float*)(ldsb + RING_OFF + wave * 16384);
    const int nblk = Ndst / 64, nitems = (K / 64) * nblk, nq = lane & 15, kq = lane >> 4;
    for (int it = gw; it < nitems; it += NGW) {
        const int kb = it / nblk, nb = it % nblk, k0 = 64 * kb, n0 = 64 * nb;
        const int sc0 = map(n0 + 4 * nq), sc3 = map(n0 + 4 * nq + 3);
        const bool contig = sc0 >= 0 && sc3 == sc0 + 3;
        f32x4 v[16];
#pragma unroll
        for (int i = 0; i < 16; ++i) { const int kk = 4 * i + kq;
            if (contig) v[i] = *(const f32x4*)(W + (size_t)(k0 + kk) * Nsrc + sc0);
            else {
#pragma unroll
                for (int e = 0; e < 4; ++e) { const int sc = map(n0 + 4 * nq + e); v[i][e] = sc >= 0 ? W[(size_t)(k0 + kk) * Nsrc + sc] : 0.f; } } }
#pragma unroll
        for (int i = 0; i < 16; ++i) { const int kk = 4 * i + kq;
#pragma unroll
            for (int e = 0; e < 4; ++e) { const int n = 4 * nq + e; scr[n * 64 + (kk ^ n)] = v[i][e]; } }
        LDS_WAIT(); asm volatile("" ::: "memory");
        const int c = lane & 7;
#pragma unroll
        for (int j = 0; j < 8; ++j) { const int n = (lane >> 3) + 8 * j; const LAS float* s = scr + n * 64;
#define SWZ(i) s[(8 * c + (i)) ^ n]
            v4u o; o.x = pk2(SWZ(0), SWZ(1)); o.y = pk2(SWZ(2), SWZ(3)); o.z = pk2(SWZ(4), SWZ(5)); o.w = pk2(SWZ(6), SWZ(7));
#undef SWZ
            *(GAS v4u*)(WT + (size_t)(n0 + n) * K + k0 + 8 * c) = o; }
        LDS_WAIT(); asm volatile("" ::: "memory");
    }
}
__device__ __forceinline__ float softplus_f(float z) { return fmaxf(z, 0.f) + log1pf(__expf(-fabsf(z))); }

typedef short s16x4 __attribute__((ext_vector_type(4)));
typedef pg8::u32x2 u32x2;
typedef float f32x16 __attribute__((ext_vector_type(16)));
typedef __bf16 bf16x2_t __attribute__((ext_vector_type(2)));
typedef float f32x2_t __attribute__((ext_vector_type(2)));
__device__ __forceinline__ unsigned cvt2(float lo, float hi) { const f32x2_t v = {lo, hi}; const bf16x2_t b = __builtin_convertvector(v, bf16x2_t); return __builtin_bit_cast(unsigned, b); }
__device__ __forceinline__ bf16x8 pack8(const f32x4 a, const f32x4 b) { v4u p; p.x = cvt2(a[0], a[1]); p.y = cvt2(a[2], a[3]); p.z = cvt2(b[0], b[1]); p.w = cvt2(b[2], b[3]); return __builtin_bit_cast(bf16x8, p); }
__device__ __forceinline__ bf16x8 ld2x8(const bf16* p0, const bf16* p1) { const s16x4 a = *(const s16x4*)p0, b = *(const s16x4*)p1; return __builtin_shufflevector(a, b, 0, 1, 2, 3, 4, 5, 6, 7); }
__device__ __forceinline__ bf16x8 ld16(const bf16* p) { return *(const bf16x8*)p; }
#define MFMA16(a, b, c) __builtin_amdgcn_mfma_f32_16x16x32_bf16((a), (b), (c), 0, 0, 0)
#define MFMA32(a, b, c) __builtin_amdgcn_mfma_f32_32x32x16_bf16((a), (b), (c), 0, 0, 0)

constexpr int QIMG_LD = 200, KTIMG_LD = 68, PKG_Q = 0, PKG_KT = 25600, PKG_G = 51712, IMG_BYTES = 52480, PKG_K = 52480, PKG_VT = 77056, PKG_BYTES = 126208, N_PKG = 2048 + 32;
static_assert(64 * QIMG_LD * 2 == PKG_KT && PKG_KT + 192 * KTIMG_LD * 2 == PKG_G && PKG_G + 768 == IMG_BYTES && PKG_K + 24576 == PKG_VT && PKG_VT + 49152 == PKG_BYTES && IMG_BYTES % 16 == 0, "package map");

__device__ __forceinline__ float softplus_fast(float z) { return fmaxf(z, 0.f) + __logf(1.0f + __expf(-fabsf(z))); }
constexpr int GL_TOT = 0, GL_Q = 6144, GL_K = GL_Q + 64 * QIMG_LD * 2, GL_V = GL_K + 64 * QIMG_LD * 2, VL_LD = 68, GL_P = GL_V + 384 * VL_LD * 2, P_LD = 68, GL_LRN = GL_P + 64 * P_LD * 2, GL_END = GL_LRN + 2048;
static_assert(GL_END <= RING_BYTES && GL_Q % 16 == 0 && GL_K % 16 == 0 && GL_V % 8 == 0 && GL_P % 8 == 0 && GL_LRN % 16 == 0 && MISC_OFF + 256 + 17 * 192 * 4 <= LDS_BYTES, "gla_prep_intra LDS map");
template <int MODE>
__device__ __forceinline__ void gla_prep_intra(int bid, int G, int tid, int wave, LAS unsigned char* lds, int l, const bf16* PROJ, const float* w_gate_lr, const float* b_gate, unsigned char* PKG, bf16* OINT) {
    const int lane = tid & 63, fr = lane & 15, fq = lane >> 4;
    const float* w2 = w_gate_lr + (size_t)l * 16 * 768; const float* bg = b_gate + (size_t)l * 768;
    LAS float* tot = (LAS float*)(lds + GL_TOT);
    LAS bf16* QL = (LAS bf16*)(lds + GL_Q); LAS bf16* KL = (LAS bf16*)(lds + GL_K); LAS bf16* VL = (LAS bf16*)(lds + GL_V); LAS bf16* P = (LAS bf16*)(lds + GL_P);
    LAS unsigned char* LRN = lds + GL_LRN;
    auto item_of = [&](int j) -> int {
        if (MODE == 1) return j < 8 ? ((((j >> 1) << 2) | (bid & 3)) << 7) | ((bid >> 2) + 64 * (j & 1)) : -1;
        if (MODE == 2) return j == 0 ? 2048 + bid : -1;
        const int it = bid + j * G; return it < N_PKG ? it : -1; };
    auto lr_dma = [&](int item) {
        if (wave < 2) { int row0, T; if (item < 2048) { row0 = ((item >> 7) >> 2) * SEQ + (item & 127) * 64; T = 64; } else { row0 = MP + ((item - 2048) >> 2) * 16; T = 16; }
            const int t = 32 * wave + (lane >> 1); const bf16* prow = PROJ + (size_t)(row0 + (t < T ? t : T - 1)) * NA + CLR + 8 * (lane & 1);
            __builtin_amdgcn_global_load_lds((const unsigned*)prow, (LAS unsigned*)(LRN + wave * 1024), 16, 0, 0); } };
    LAS float* W2L = (LAS float*)(lds + MISC_OFF + 256);
    int cur_h = -1;
    { const int i0 = item_of(0); if (i0 >= 0) lr_dma(i0); asm volatile("s_waitcnt vmcnt(0)" ::: "memory"); __syncthreads(); }
    for (int j = 0;; ++j) {
        const int item = item_of(j); if (item < 0) break;
        int h, row0, T;
        if (item < 2048) { const int bh = item >> 7, ch = item & 127; h = bh & 3; row0 = (bh >> 2) * SEQ + ch * 64; T = 64; }
        else { const int i2 = item - 2048; h = i2 & 3; row0 = MP + (i2 >> 2) * 16; T = 16; }
        unsigned char* pk = PKG + (size_t)item * PKG_BYTES;
        bf16* Qt = (bf16*)(pk + PKG_Q); bf16* KT = (bf16*)(pk + PKG_KT); bf16* VT = (bf16*)(pk + PKG_VT); float* Gp = (float*)(pk + PKG_G);
        if (h != cur_h) {
            if (cur_h >= 0) __syncthreads();
            cur_h = h;
            for (int i = tid; i < 17 * 192; i += 512) { const int r = i / 192, d = i - r * 192; W2L[i] = r < 16 ? w2[r * 768 + h * 192 + d] : bg[h * 192 + d]; }
            __syncthreads(); }
        float w2c[3][16], bgc[3];
#pragma unroll
        for (int c = 0; c < 3; ++c) { bgc[c] = W2L[16 * 192 + lane + 64 * c];
#pragma unroll
            for (int r = 0; r < 16; ++r) w2c[c][r] = W2L[r * 192 + lane + 64 * c]; }
        unsigned qv[8][3], kv[8][3];
#pragma unroll
        for (int tt = 0; tt < 8; ++tt) { const int t = 8 * wave + tt; const bf16* prow = PROJ + (size_t)(row0 + (t < T ? t : T - 1)) * NA + h * 192 + lane;
#pragma unroll
            for (int c = 0; c < 3; ++c) { qv[tt][c] = prow[CQ + 64 * c]; kv[tt][c] = prow[CK + 64 * c]; } }
        __builtin_amdgcn_sched_barrier(0);
        v4u l0[8], l1[8];
#pragma unroll
        for (int tt = 0; tt < 8; ++tt) { const LAS unsigned char* lp = LRN + (8 * wave + tt) * 32; l0[tt] = *(const LAS v4u*)lp; l1[tt] = *(const LAS v4u*)(lp + 16); }
        float lc[8][3]; float run[3] = {0.f, 0.f, 0.f};
#pragma unroll
        for (int tt = 0; tt < 8; ++tt) { const bool ok = 8 * wave + tt < T;
            float lr[16]; lr[0] = pg8::bflo(l0[tt].x); lr[1] = pg8::bfhi(l0[tt].x); lr[2] = pg8::bflo(l0[tt].y); lr[3] = pg8::bfhi(l0[tt].y); lr[4] = pg8::bflo(l0[tt].z); lr[5] = pg8::bfhi(l0[tt].z); lr[6] = pg8::bflo(l0[tt].w); lr[7] = pg8::bfhi(l0[tt].w);
            lr[8] = pg8::bflo(l1[tt].x); lr[9] = pg8::bfhi(l1[tt].x); lr[10] = pg8::bflo(l1[tt].y); lr[11] = pg8::bfhi(l1[tt].y); lr[12] = pg8::bflo(l1[tt].z); lr[13] = pg8::bfhi(l1[tt].z); lr[14] = pg8::bflo(l1[tt].w); lr[15] = pg8::bfhi(l1[tt].w);
#pragma unroll
            for (int c = 0; c < 3; ++c) { float xg = bgc[c];
#pragma unroll
                for (int r = 0; r < 16; ++r) xg += lr[r] * w2c[c][r];
                run[c] += ok ? -softplus_fast(-xg) * (1.0f / 16.0f) : 0.f; lc[tt][c] = run[c]; } }
#pragma unroll
        for (int c = 0; c < 3; ++c) tot[wave * 192 + lane + 64 * c] = run[c];
        __syncthreads();
        unsigned vv[6][8];
#pragma unroll
        for (int tt = 0; tt < 8; ++tt) { const int t = 8 * wave + tt; const bf16* prow = PROJ + (size_t)(row0 + (t < T ? t : T - 1)) * NA + CV + h * 384 + lane;
#pragma unroll
            for (int c2 = 0; c2 < 6; ++c2) vv[c2][tt] = prow[64 * c2]; }
        __builtin_amdgcn_sched_barrier(0);
        float pre[3], all[3];
#pragma unroll
        for (int c = 0; c < 3; ++c) { pre[c] = 0.f; all[c] = 0.f;
#pragma unroll
            for (int w = 0; w < 8; ++w) { const float tv = tot[w * 192 + lane + 64 * c]; all[c] += tv; if (w < wave) pre[c] += tv; } }
        unsigned ktw[3][4];
#pragma unroll
        for (int tt = 0; tt < 8; ++tt) { const int t = 8 * wave + tt; const bool ok = t < T;
#pragma unroll
            for (int c = 0; c < 3; ++c) { const int dl = lane + 64 * c; const float bc = pre[c] + lc[tt][c]; const float eq = __expf(bc), ek = __expf(-bc);
                const unsigned qb = ok ? f2bf(bf2f((bf16)qv[tt][c]) * GLA_QSCALE * eq) : 0u, kb = ok ? f2bf(bf2f((bf16)kv[tt][c]) * ek) : 0u;
                Qt[t * QIMG_LD + dl] = (bf16)qb; QL[t * QIMG_LD + dl] = (bf16)qb; KL[t * QIMG_LD + dl] = (bf16)kb;
                if (tt & 1) ktw[c][tt >> 1] |= kb << 16; else ktw[c][tt >> 1] = kb; } }
#pragma unroll
        for (int c = 0; c < 3; ++c) { bf16* kp = KT + (size_t)(lane + 64 * c) * KTIMG_LD + 8 * wave; u32x2 o0, o1; o0.x = ktw[c][0]; o0.y = ktw[c][1]; o1.x = ktw[c][2]; o1.y = ktw[c][3]; *(u32x2*)kp = o0; *(u32x2*)(kp + 4) = o1; }
        if (wave == 0) {
#pragma unroll
            for (int c = 0; c < 3; ++c) Gp[lane + 64 * c] = __expf(all[c]); }
#pragma unroll
        for (int c2 = 0; c2 < 6; ++c2) { const bool ok0 = 8 * wave < T;
            u32x2 o0, o1; o0.x = ok0 ? vv[c2][0] | (vv[c2][1] << 16) : 0u; o0.y = ok0 ? vv[c2][2] | (vv[c2][3] << 16) : 0u; o1.x = ok0 ? vv[c2][4] | (vv[c2][5] << 16) : 0u; o1.y = ok0 ? vv[c2][6] | (vv[c2][7] << 16) : 0u;
            v4u o; o.x = o0.x; o.y = o0.y; o.z = o1.x; o.w = o1.y; *(v4u*)(VT + (size_t)(lane + 64 * c2) * 64 + 8 * wave) = o;
            LAS bf16* vl = VL + (lane + 64 * c2) * VL_LD + 8 * wave; *(LAS u32x2*)vl = o0; *(LAS u32x2*)(vl + 4) = o1; }
        __syncthreads();
        { const int nx = item_of(j + 1); if (nx >= 0) lr_dma(nx); }
        const int nvalid = T;
        bf16x8 va[3], vb[3];
#pragma unroll
        for (int k = 0; k < 3; ++k) { const LAS bf16* vr = VL + (16 * (3 * wave + k) + fr) * VL_LD + 4 * fq;
            const s16x4 x0 = *(const LAS s16x4*)vr, x1 = *(const LAS s16x4*)(vr + 16), x2 = *(const LAS s16x4*)(vr + 32), x3 = *(const LAS s16x4*)(vr + 48);
            va[k] = __builtin_shufflevector(x0, x1, 0, 1, 2, 3, 4, 5, 6, 7); vb[k] = __builtin_shufflevector(x2, x3, 0, 1, 2, 3, 4, 5, 6, 7); }
#pragma unroll
        for (int rep = 0; rep < 2; ++rep) {
            const int tl = wave + 8 * rep;
            if (tl < 10) {
                const int it = tl < 1 ? 0 : (tl < 3 ? 1 : (tl < 6 ? 2 : 3)), jt = tl - (it * (it + 1)) / 2;
                f32x4 at = {0.f, 0.f, 0.f, 0.f};
                const LAS bf16* qr = QL + (16 * it + fr) * QIMG_LD + 8 * fq; const LAS bf16* kr = KL + (16 * jt + fr) * QIMG_LD + 8 * fq;
#pragma unroll
                for (int s = 0; s < 6; ++s) at = MFMA16(*(const LAS bf16x8*)(kr + 32 * s), *(const LAS bf16x8*)(qr + 32 * s), at);
                if (it == jt) {
#pragma unroll
                    for (int jj = 0; jj < 4; ++jj) if (4 * fq + jj > fr) at[jj] = 0.f; }
                u32x2 w; w.x = cvt2(at[0], at[1]); w.y = cvt2(at[2], at[3]);
                *(LAS u32x2*)(P + (16 * it + fr) * P_LD + 16 * jt + 4 * fq) = w;
            } else if (tl == 10 || tl == 11) {
                const int it = tl == 10 ? 0 : 2, jt = tl == 10 ? 1 : 3; unsigned zz = 0u; asm volatile("" : "+v"(zz)); u32x2 z; z.x = zz; z.y = zz;
                *(LAS u32x2*)(P + (16 * it + fr) * P_LD + 16 * jt + 4 * fq) = z;
            }
        }
        if (wave < 2) asm volatile("s_waitcnt vmcnt(0)" ::: "memory");
        __syncthreads();
#pragma unroll
        for (int it = 0; it < 4; ++it) {
            if (16 * it >= nvalid) break;
            const LAS bf16* pr = P + (16 * it + fr) * P_LD + 4 * fq;
            const s16x4 a0 = *(const LAS s16x4*)pr, a1 = *(const LAS s16x4*)(pr + 16);
            const bf16x8 pf0 = __builtin_shufflevector(a0, a1, 0, 1, 2, 3, 4, 5, 6, 7); bf16x8 pf1 = pf0;
            if (it >= 2) { const s16x4 b0 = *(const LAS s16x4*)(pr + 32), b1 = *(const LAS s16x4*)(pr + 48); pf1 = __builtin_shufflevector(b0, b1, 0, 1, 2, 3, 4, 5, 6, 7); }
#pragma unroll
            for (int k = 0; k < 3; ++k) { f32x4 o = {0.f, 0.f, 0.f, 0.f};
                o = MFMA16(va[k], pf0, o); if (it >= 2) o = MFMA16(vb[k], pf1, o);
                u32x2 ow; ow.x = cvt2(o[0], o[1]); ow.y = cvt2(o[2], o[3]); *(u32x2*)(OINT + (size_t)(row0 + 16 * it + fr) * 1536 + h * 384 + 16 * (3 * wave + k) + 4 * fq) = ow; }
        }
    }
}

__device__ __forceinline__ f32x4 ld_o4(const bf16* p) { const u32x2 w = *(const u32x2*)p; return (f32x4){pg8::bflo(w.x), pg8::bfhi(w.x), pg8::bflo(w.y), pg8::bfhi(w.y)}; }
template <int PASS>
__device__ __forceinline__ void gla_chain(int wc, int tid, int wave, LAS unsigned char* lds, int l, const unsigned char* PKG, const float* state_gla, bf16* OINT, float* out, float* SLOC, float* GSEG, bool dry = false) {
    const int lane = tid & 63, fr = lane & 15, fq = lane >> 4;
    int h, vb, bh, seg, item0, nsteps, row0, nvalid; const float* s0 = nullptr; float* sout = nullptr;
    if (PASS == 1) { bh = wc / 9; const int rem = wc % 9; vb = rem / 3; seg = rem % 3; h = bh & 3; item0 = bh * 128 + 32 * seg; nsteps = 32; row0 = 0; nvalid = 64; }
    else if (wc < 192) { bh = wc / 12; const int rem = wc % 12; vb = rem >> 2; seg = rem & 3; h = bh & 3; item0 = bh * 128 + 32 * seg; nsteps = 32; row0 = (bh >> 2) * SEQ + 2048 * seg; nvalid = 64;
        if (seg == 3) sout = out + O_GSP + (size_t)(l * 16 + bh) * 192 * 384; }
    else { const int c2 = wc - 192; bh = c2 / 3; vb = c2 % 3; seg = 0; h = bh & 3; item0 = 2048 + bh; nsteps = 1; row0 = MP + (bh >> 2) * 16; nvalid = 16; s0 = state_gla + (size_t)(l * 32 + bh) * 192 * 384; sout = out + O_GSS + (size_t)(l * 32 + bh) * 192 * 384; }
    const int v0 = vb * 128 + wave * 16;
#define GLA_WALK(p, step) do { (p) += (step); asm volatile("" : "+v"(p)); } while (0)
    f32x4 S[12];
    if (s0) { const float* p = s0 + (size_t)(4 * fq) * 384 + v0 + fr;
#pragma unroll
        for (int t = 0; t < 12; ++t) {
#pragma unroll
            for (int jj = 0; jj < 4; ++jj) { S[t][jj] = *p; GLA_WALK(p, 384); }
            GLA_WALK(p, 12 * 384); } }
    else {
#pragma unroll
        for (int t = 0; t < 12; ++t) S[t] = (f32x4){0.f, 0.f, 0.f, 0.f}; }
    if (PASS == 2 && wc < 192) {
        for (int j = 0; j < seg; ++j) { const float* gs = GSEG + (size_t)(bh * 3 + j) * 192 + 4 * fq; const float* p = SLOC + (size_t)((bh * 3 + vb) * 3 + j) * 192 * 128 + (size_t)(4 * fq) * 128 + wave * 16 + fr;
#pragma unroll
            for (int t = 0; t < 12; ++t) { const f32x4 g4 = *(const f32x4*)(gs + 16 * t);
#pragma unroll
                for (int jj = 0; jj < 4; ++jj) { S[t][jj] = g4[jj] * S[t][jj] + *p; GLA_WALK(p, 128); }
                GLA_WALK(p, 12 * 128); } }
    }
    f32x4 GP[PASS == 1 ? 12 : 1];
    if (PASS == 1) {
#pragma unroll
        for (int t = 0; t < 12; ++t) GP[t] = (f32x4){1.f, 1.f, 1.f, 1.f}; }
    constexpr int CH0 = PASS == 1 ? PKG_KT / 16 : 0, NCH = IMG_BYTES / 16, NLD = PASS == 1 ? 4 : 7;
    v4u pre[NLD]; bf16x8 vt[2], vtn[2]; f32x4 oin[4];
    { const unsigned char* pk = PKG + (size_t)item0 * PKG_BYTES;
      if (PASS == 2) {
#pragma unroll
        for (int it = 0; it < 4; ++it) { const int tl = 16 * it + fr; oin[it] = tl < nvalid ? ld_o4(OINT + (size_t)(row0 + tl) * 1536 + h * 384 + v0 + 4 * fq) : (f32x4){0.f, 0.f, 0.f, 0.f}; } }
#pragma unroll
      for (int k = 0; k < NLD; ++k) { const int ch = CH0 + tid + 512 * k; if (ch < NCH) pre[k] = *(const v4u*)(pk + (size_t)ch * 16); }
      const bf16* VT = (const bf16*)(pk + PKG_VT) + (size_t)(v0 + fr) * 64 + 4 * fq; vt[0] = ld2x8(VT, VT + 16); vt[1] = ld2x8(VT + 32, VT + 48);
#pragma unroll
      for (int k = 0; k < NLD; ++k) { const int ch = CH0 + tid + 512 * k; if (ch < NCH) *(LAS v4u*)(lds + (size_t)ch * 16) = pre[k]; }
      vtn[0] = vt[0]; vtn[1] = vt[1]; }
    __syncthreads();
    for (int n = 0; n < nsteps; ++n) {
        const LAS unsigned char* img = lds + (n & 1) * IMG_BYTES;
        const bool more = n + 1 < nsteps;
        if (more) { const unsigned char* pk = PKG + (size_t)(item0 + n + 1) * PKG_BYTES;
#pragma unroll
            for (int k = 0; k < NLD; ++k) { const int ch = CH0 + tid + 512 * k; if (ch < NCH) pre[k] = *(const v4u*)(pk + (size_t)ch * 16); }
            const bf16* VT = (const bf16*)(pk + PKG_VT) + (size_t)(v0 + fr) * 64 + 4 * fq; vtn[0] = ld2x8(VT, VT + 16); vtn[1] = ld2x8(VT + 32, VT + 48); }
        if (PASS == 2) {
            bf16x8 Sb[6];
#pragma unroll
            for (int s = 0; s < 6; ++s) Sb[s] = pack8(S[2 * s], S[2 * s + 1]);
#pragma unroll
            for (int it = 0; it < 4; ++it) {
                const LAS bf16* qr = (const LAS bf16*)(img + PKG_Q) + (16 * it + fr) * QIMG_LD + 4 * fq;
                f32x4 o = oin[it];
#pragma unroll
                for (int s = 0; s < 6; ++s) { const s16x4 a = *(const LAS s16x4*)(qr + 32 * s), b = *(const LAS s16x4*)(qr + 32 * s + 16);
                    o = MFMA16(Sb[s], __builtin_shufflevector(a, b, 0, 1, 2, 3, 4, 5, 6, 7), o); }
                const int tl = 16 * it + fr;
                if (tl < nvalid && !dry) { u32x2 ow; ow.x = cvt2(o[0], o[1]); ow.y = cvt2(o[2], o[3]); *(u32x2*)(OINT + (size_t)(row0 + 64 * n + tl) * 1536 + h * 384 + v0 + 4 * fq) = ow; }
                __builtin_amdgcn_sched_barrier(0);
            }
            if (more) {
#pragma unroll
                for (int it = 0; it < 4; ++it) oin[it] = ld_o4(OINT + (size_t)(row0 + 64 * (n + 1) + 16 * it + fr) * 1536 + h * 384 + v0 + 4 * fq); }
        }
#pragma unroll
        for (int t = 0; t < 12; ++t) { const LAS bf16* kr = (const LAS bf16*)(img + PKG_KT) + (16 * t + fr) * KTIMG_LD + 4 * fq;
#pragma unroll
            for (int s2 = 0; s2 < 2; ++s2) { const s16x4 a = *(const LAS s16x4*)(kr + 32 * s2), b = *(const LAS s16x4*)(kr + 32 * s2 + 16);
                S[t] = MFMA16(__builtin_shufflevector(a, b, 0, 1, 2, 3, 4, 5, 6, 7), vt[s2], S[t]); }
            const f32x4 g4 = *(const LAS f32x4*)(img + PKG_G + (16 * t + 4 * fq) * 4);
            S[t] = S[t] * g4; if (PASS == 1) GP[t] = GP[t] * g4; if ((t & 3) == 3) __builtin_amdgcn_sched_barrier(0); }
        if (more) { LAS unsigned char* nimg = lds + ((n + 1) & 1) * IMG_BYTES;
#pragma unroll
            for (int k = 0; k < NLD; ++k) { const int ch = CH0 + tid + 512 * k; if (ch < NCH) *(LAS v4u*)(nimg + (size_t)ch * 16) = pre[k]; }
            vt[0] = vtn[0]; vt[1] = vtn[1]; }
        asm volatile("s_waitcnt lgkmcnt(0)" ::: "memory"); __builtin_amdgcn_s_barrier(); asm volatile("" ::: "memory");
    }
    if (PASS == 1) {
        float* p = SLOC + (size_t)((bh * 3 + vb) * 3 + seg) * 192 * 128 + (size_t)(4 * fq) * 128 + wave * 16 + fr;
#pragma unroll
        for (int t = 0; t < 12; ++t) {
#pragma unroll
            for (int jj = 0; jj < 4; ++jj) { *p = S[t][jj]; GLA_WALK(p, 128); }
            GLA_WALK(p, 12 * 128); }
        if (vb == 0 && wave == 0 && fr == 0) { float* gs = GSEG + (size_t)(bh * 3 + seg) * 192;
#pragma unroll
            for (int t = 0; t < 12; ++t) *(f32x4*)(gs + 16 * t + 4 * fq) = GP[t]; }
    } else if (sout) {
        float* p = sout + (size_t)(4 * fq) * 384 + v0 + fr;
#pragma unroll
        for (int t = 0; t < 12; ++t) {
#pragma unroll
            for (int jj = 0; jj < 4; ++jj) { *p = S[t][jj]; GLA_WALK(p, 384); }
            GLA_WALK(p, 12 * 384); }
    }
#undef GLA_WALK
}

__device__ __forceinline__ void mem_attn(int item, int lane, int l, const bf16* PROJ, int ldp, int cqm, const bf16* MEMK, const bf16* MEMVT, bf16* OCAT) {
    const int fr = lane & 15, fq = lane >> 4, tile = item >> 2, h = item & 3, r0 = tile * 16;
    const int bb = r0 < MP ? r0 / SEQ : 4 + ((r0 - MP) >> 4);
    const bf16* Kb = MEMK + (size_t)((l * 12 + bb) * 256) * 512 + h * 128; const bf16* Vt = MEMVT + (size_t)(((l * 12 + bb) * 4 + h) * 128) * 256;
    bf16x8 qf[4];
#pragma unroll
    for (int s = 0; s < 4; ++s) qf[s] = ld16(PROJ + (size_t)(r0 + fr) * ldp + cqm + h * 128 + 32 * s + 8 * fq);
    f32x4 st[16];
#pragma unroll
    for (int mt = 0; mt < 16; ++mt) { st[mt] = (f32x4){0.f, 0.f, 0.f, 0.f}; const bf16* kr = Kb + (size_t)(16 * mt + fr) * 512 + 8 * fq;
#pragma unroll
        for (int s = 0; s < 4; ++s) st[mt] = MFMA16(ld16(kr + 32 * s), qf[s], st[mt]); }
    float mx = -3.0e38f;
#pragma unroll
    for (int mt = 0; mt < 16; ++mt) mx = fmaxf(mx, fmaxf(fmaxf(st[mt][0], st[mt][1]), fmaxf(st[mt][2], st[mt][3])));
    mx = fmaxf(mx, shx(mx, lane, 16)); mx = fmaxf(mx, shx(mx, lane, 32));
    float sum = 0.f;
#pragma unroll
    for (int mt = 0; mt < 16; ++mt)
#pragma unroll
        for (int jj = 0; jj < 4; ++jj) { const float p = __expf((st[mt][jj] - mx) * HD_SCALE); st[mt][jj] = p; sum += p; }
    sum += shx(sum, lane, 16); sum += shx(sum, lane, 32);
    const float inv = 1.0f / sum;
    bf16x8 pf[8];
#pragma unroll
    for (int s = 0; s < 8; ++s) pf[s] = pack8(st[2 * s], st[2 * s + 1]);
#pragma unroll
    for (int dt = 0; dt < 8; ++dt) { f32x4 o = {0.f, 0.f, 0.f, 0.f}; const bf16* vr = Vt + (size_t)(16 * dt + fr) * 256 + 4 * fq;
#pragma unroll
        for (int s = 0; s < 8; ++s) o = MFMA16(ld2x8(vr + 32 * s, vr + 32 * s + 16), pf[s], o);
        u32x2 w; w.x = cvt2(o[0] * inv, o[1] * inv); w.y = cvt2(o[2] * inv, o[3] * inv);
        *(u32x2*)(OCAT + (size_t)(r0 + fr) * D + 1536 + h * 128 + 16 * dt + 4 * fq) = w; }
}

__device__ __forceinline__ void mem_attn_wg(int wi, int tid, int wave, LAS unsigned char* lds, int l, const bf16* PROJ, int ldp, int cqm, const bf16* MEMK, const bf16* MEMVT, bf16* OCAT) {
    const bool smp = wi >= 256; const int lane = tid & 63, fr = lane & 15, fq = lane >> 4, bh = smp ? (wi - 256) : (wi >> 4), sub = wi & 15, b = smp ? 4 + (bh >> 2) : (bh >> 2), h = bh & 3;
    const bf16* Kb = MEMK + (size_t)((l * 12 + b) * 256) * 512 + h * 128; const bf16* Vt = MEMVT + (size_t)(((l * 12 + b) * 4 + h) * 128) * 256;
#pragma unroll
    for (int k = 0; k < 8; ++k) { const int idx = tid + 512 * k, row = idx >> 4, c = idx & 15; *(LAS v4u*)(lds + row * 256 + ((c ^ (row & 15)) << 4)) = *(const v4u*)(Kb + (size_t)row * 512 + c * 8); }
#pragma unroll
    for (int k = 0; k < 8; ++k) { const int idx = tid + 512 * k, row = idx >> 5, c = idx & 31; *(LAS v4u*)(lds + 65536 + row * 512 + ((c ^ (2 * (row & 15))) << 4)) = *(const v4u*)(Vt + (size_t)row * 256 + c * 8); }
    __syncthreads();
    unsigned koff[4], voff[16];
#pragma unroll
    for (int s2 = 0; s2 < 4; ++s2) { koff[s2] = (unsigned)(fr * 256 + (((4 * s2 + fq) ^ fr) << 4)); asm volatile("" : "+v"(koff[s2])); }
#pragma unroll
    for (int s2 = 0; s2 < 8; ++s2) { const int p0 = 8 * s2 + fq, p1 = p0 + 4;
        voff[2 * s2] = (unsigned)(65536 + fr * 512 + ((((p0 >> 1) ^ (2 * fr)) << 4) | ((p0 & 1) << 3))); voff[2 * s2 + 1] = (unsigned)(65536 + fr * 512 + ((((p1 >> 1) ^ (2 * fr)) << 4) | ((p1 & 1) << 3)));
        asm volatile("" : "+v"(voff[2 * s2]), "+v"(voff[2 * s2 + 1])); }
    const int nblk = smp ? (wave == 0 ? 1 : 0) : 4;
#pragma unroll 1
    for (int blk = 0; blk < nblk; ++blk) {
        const int r0 = smp ? MP + (b - 4) * 16 : b * SEQ + sub * 512 + blk * 128 + wave * 16;
        bf16x8 qf[4];
#pragma unroll
        for (int s = 0; s < 4; ++s) qf[s] = ld16(PROJ + (size_t)(r0 + fr) * ldp + cqm + h * 128 + 32 * s + 8 * fq);
        f32x4 st[16];
#pragma unroll
        for (int mt = 0; mt < 16; ++mt) { st[mt] = (f32x4){0.f, 0.f, 0.f, 0.f};
#pragma unroll
            for (int s = 0; s < 4; ++s) st[mt] = MFMA16(*(const LAS bf16x8*)(lds + koff[s] + mt * 4096), qf[s], st[mt]);
            if ((mt & 3) == 3) __builtin_amdgcn_sched_barrier(0); }
        float mx = -3.0e38f;
#pragma unroll
        for (int mt = 0; mt < 16; ++mt) mx = fmaxf(mx, fmaxf(fmaxf(st[mt][0], st[mt][1]), fmaxf(st[mt][2], st[mt][3])));
        mx = fmaxf(mx, shx(mx, lane, 16)); mx = fmaxf(mx, shx(mx, lane, 32));
        float sum = 0.f;
#pragma unroll
        for (int mt = 0; mt < 16; ++mt)
#pragma unroll
            for (int jj = 0; jj < 4; ++jj) { const float p = __expf((st[mt][jj] - mx) * HD_SCALE); st[mt][jj] = p; sum += p; }
        sum += shx(sum, lane, 16); sum += shx(sum, lane, 32);
        const float inv = 1.0f / sum;
        bf16x8 pf[8];
#pragma unroll
        for (int s = 0; s < 8; ++s) pf[s] = pack8(st[2 * s], st[2 * s + 1]);
#pragma unroll
        for (int dt = 0; dt < 8; ++dt) { f32x4 o = {0.f, 0.f, 0.f, 0.f};
#pragma unroll
            for (int s = 0; s < 8; ++s) { const s16x4 a = *(const LAS s16x4*)(lds + voff[2 * s] + dt * 8192), bb = *(const LAS s16x4*)(lds + voff[2 * s + 1] + dt * 8192);
                o = MFMA16(__builtin_shufflevector(a, bb, 0, 1, 2, 3, 4, 5, 6, 7), pf[s], o); }
            u32x2 w; w.x = cvt2(o[0] * inv, o[1] * inv); w.y = cvt2(o[2] * inv, o[3] * inv);
            *(u32x2*)(OCAT + (size_t)(r0 + fr) * D + 1536 + h * 128 + 16 * dt + 4 * fq) = w;
            if (dt & 1) __builtin_amdgcn_sched_barrier(0); }
    }
    __syncthreads();
}

template <int MODE = 0>
__device__ __forceinline__ void sb_attn(int lane, LAS unsigned char* wlds, const bf16* Kp, int ldk, const bf16* VTp, int ldvt, const bf16* Qp, int ldq, bf16* Op, int t0, int nq) {
    const int r = lane & 31, hh = lane >> 5;
    LAS bf16x8* qs = (LAS bf16x8*)wlds + lane;
#pragma unroll
    for (int ks = 0; ks < 8; ++ks) qs[64 * ks] = ld16(Qp + (size_t)r * ldq + 16 * ks + 8 * hh);
    f32x16 oacc[4];
#pragma unroll
    for (int dt = 0; dt < 4; ++dt)
#pragma unroll
        for (int i = 0; i < 16; ++i) oacc[dt][i] = 0.f;
    float carry = 1.f;
    bf16x8 kf[8];
    { const bf16* kr = Kp + (size_t)(t0 + r) * ldk + 8 * hh;
#pragma unroll
      for (int ks = 0; ks < 8; ++ks) kf[ks] = ld16(kr + 16 * ks); }
    for (int s0 = t0; s0 >= 0; s0 -= 32) {
        bf16x8 vf[8];
#pragma unroll
        for (int k2 = 0; k2 < 2; ++k2)
#pragma unroll
            for (int dt = 0; dt < 4; ++dt) vf[4 * k2 + dt] = MODE == 3 ? qs[64 * dt] : ld16(VTp + (size_t)(s0 >> 5) * 4096 + ((dt * 2 + k2) * 64 + lane) * 8);
        f32x16 st;
#pragma unroll
        for (int i = 0; i < 16; ++i) st[i] = 0.f;
#pragma unroll
        for (int ks = 0; ks < 8; ++ks) st = MFMA32(kf[ks], qs[64 * ks], st);
        { const int sn = s0 >= 32 ? s0 - 32 : 0; const bf16* kr = Kp + (size_t)(sn + r) * ldk + 8 * hh;
#pragma unroll
          for (int ks = 0; ks < 8; ++ks) kf[ks] = ld16(kr + 16 * ks); }
        const bool diag = (s0 == t0);
        float lb[16], om[16];
#pragma unroll
        for (int i = 0; i < 16; ++i) { const float z = st[i] * HD_SCALE, e = __expf(-fabsf(z)), rr = __builtin_amdgcn_rcpf(1.0f + e), er = e * rr;
            lb[i] = z >= 0.f ? rr : er; om[i] = z >= 0.f ? er : rr;
            if (diag && !(((i & 3) + 8 * (i >> 2) + 4 * hh) < r)) { lb[i] = 0.f; om[i] = 1.f; } }
        float g[4], pgv[4];
#pragma unroll
        for (int m = 0; m < 4; ++m) { g[m] = (om[4 * m] * om[4 * m + 1]) * (om[4 * m + 2] * om[4 * m + 3]); pgv[m] = shx(g[m], lane, 32); }
        float R[4]; R[3] = 1.f; R[2] = g[3] * pgv[3]; R[1] = R[2] * (g[2] * pgv[2]); R[0] = R[1] * (g[1] * pgv[1]);
        const float total = R[0] * (g[0] * pgv[0]);
#pragma unroll
        for (int m = 0; m < 4; ++m) { const float suf = carry * R[m] * (hh == 0 ? pgv[m] : 1.f);
            const float t3 = suf, t2 = t3 * om[4 * m + 3], t1 = t2 * om[4 * m + 2], t0_ = t1 * om[4 * m + 1];
            lb[4 * m + 3] *= t3; lb[4 * m + 2] *= t2; lb[4 * m + 1] *= t1; lb[4 * m] *= t0_; }
        carry *= total;
#pragma unroll
        for (int k2 = 0; k2 < 2; ++k2) {
            v4u p; p.x = cvt2(lb[8 * k2], lb[8 * k2 + 1]); p.y = cvt2(lb[8 * k2 + 2], lb[8 * k2 + 3]); p.z = cvt2(lb[8 * k2 + 4], lb[8 * k2 + 5]); p.w = cvt2(lb[8 * k2 + 6], lb[8 * k2 + 7]);
            const bf16x8 wf = __builtin_bit_cast(bf16x8, p);
#pragma unroll
            for (int dt = 0; dt < 4; ++dt) { if (MODE != 3) oacc[dt] = MFMA32(vf[4 * k2 + dt], wf, oacc[dt]); else oacc[dt][0] += __builtin_bit_cast(float, (int)wf[0]) + __builtin_bit_cast(float, (int)vf[4 * k2 + dt][0]); }
        }
        if (MODE == 2 || __all((r >= nq) || (carry < 1.0e-37f))) break;
    }
    if (MODE != 0) { float sdry = 0.f;
#pragma unroll
        for (int dt = 0; dt < 4; ++dt)
#pragma unroll
            for (int i = 0; i < 16; ++i) sdry += oacc[dt][i];
        if (sdry == 1.2345e33f) Op[0] = 0; }
    else if (r < nq) {
#pragma unroll
        for (int dt = 0; dt < 4; ++dt)
#pragma unroll
            for (int g4 = 0; g4 < 4; ++g4) { u32x2 wv; wv.x = cvt2(oacc[dt][4 * g4], oacc[dt][4 * g4 + 1]); wv.y = cvt2(oacc[dt][4 * g4 + 2], oacc[dt][4 * g4 + 3]);
                *(u32x2*)(Op + (size_t)r * D + 32 * dt + 8 * g4 + 4 * hh) = wv; }
    }
    asm volatile("s_waitcnt lgkmcnt(0)" ::: "memory");
}

struct SkBf16 { bf16* O; int ldc;
    __device__ __forceinline__ int brow(int unit, int nb) const { return 32 * unit + 16 * nb; }
    __device__ __forceinline__ void store(int unit, const f32x4 a0, const f32x4 a1, int m, int fq) const { bf16* p = O + (size_t)(MP + m) * ldc + 32 * unit + 4 * fq;
        u32x2 w; w.x = cvt2(a0[0], a0[1]); w.y = cvt2(a0[2], a0[3]); *(u32x2*)p = w; w.x = cvt2(a1[0], a1[1]); w.y = cvt2(a1[2], a1[3]); *(u32x2*)(p + 16) = w; } };
struct SkRes { bf16* Yp; const bf16* Xp; float alpha;
    __device__ __forceinline__ int brow(int unit, int nb) const { return 32 * unit + 16 * nb; }
    __device__ __forceinline__ void one(size_t o, const f32x4 a) const { const u32x2 xv = *(const u32x2*)(Xp + o);
        f32x4 r; r[0] = alpha * pg8::bflo(xv.x); r[1] = alpha * pg8::bfhi(xv.x); r[2] = alpha * pg8::bflo(xv.y); r[3] = alpha * pg8::bfhi(xv.y); r = r + a; u32x2 w; w.x = cvt2(r[0], r[1]); w.y = cvt2(r[2], r[3]); *(u32x2*)(Yp + o) = w; }
    __device__ __forceinline__ void store(int unit, const f32x4 a0, const f32x4 a1, int m, int fq) const { const size_t o = (size_t)(MP + m) * D + 32 * unit + 4 * fq; one(o, a0); one(o + 16, a1); } };
struct SkKV { float *oks, *ovs; bf16 *ksb, *vsb;
    __device__ __forceinline__ int brow(int unit, int nb) const { return 32 * unit + 16 * nb; }
    __device__ __forceinline__ void one(int col, const f32x4 a, int m) const { const bool isv = col >= 1536; const int c = col - (isv ? 1536 : 0), b = m >> 4, t = m & 15;
        *(f32x4*)((isv ? ovs : oks) + (size_t)m * 1536 + c) = a; const unsigned w0 = cvt2(a[0], a[1]), w1 = cvt2(a[2], a[3]);
        const int hh_ = c >> 7, dd = c & 127;
        if (!isv) { u32x2 w; w.x = w0; w.y = w1; *(u32x2*)(ksb + ((size_t)(b * 12 + hh_) * 2080 + 2048 + t) * 128 + dd) = w; }
        else { bf16* vt = vsb + ((size_t)(b * 12 + hh_) * 65 + 64) * 4096 + pg8::vtf_d(dd) + pg8::vtf_k(t); vt[0] = (bf16)w0; vt[8] = (bf16)(w0 >> 16); vt[16] = (bf16)w1; vt[24] = (bf16)(w1 >> 16); } }
    __device__ __forceinline__ void store(int unit, const f32x4 a0, const f32x4 a1, int m, int fq) const { one(32 * unit + 4 * fq, a0, m); one(32 * unit + 16 + 4 * fq, a1, m); } };
struct SkSwiGLU { bf16* Hb;
    __device__ __forceinline__ int brow(int unit, int nb) const { const int c0 = 16 * unit; return (c0 >> 7) * 256 + (c0 & 127) + 128 * nb; }
    __device__ __forceinline__ void store(int unit, const f32x4 g, const f32x4 u, int m, int fq) const { float hv[4];
#pragma unroll
        for (int j = 0; j < 4; ++j) hv[j] = g[j] * __builtin_amdgcn_rcpf(1.0f + __expf(-g[j])) * u[j];
        u32x2 w; w.x = cvt2(hv[0], hv[1]); w.y = cvt2(hv[2], hv[3]); *(u32x2*)(Hb + (size_t)(MP + m) * DFF + 16 * unit + 4 * fq) = w; } };
template <class Epi>
__device__ __forceinline__ void skinny_gemm(int bid, int G, int tid, int wave, LAS unsigned char* lds, const bf16* A, int lda, const bf16* Bt, int K, int nunits, const Epi& E) {
    const int lane = tid & 63, fr = lane & 15, fq = lane >> 4, kw = K >> 3, nst = kw >> 5;
    LAS f32x4* red = (LAS f32x4*)lds;
    if (nst == 8 && (G & 3) == 0) {
        const int rg = bid & 3;
        bf16x8 af[8][2], bw[8][2];
        if (bid < 4 * nunits) { const bf16* ap = A + (size_t)(32 * rg + fr) * lda + wave * kw + 8 * fq;
#pragma unroll
            for (int st = 0; st < 8; ++st) { af[st][0] = ld16(ap + 32 * st); af[st][1] = ld16(ap + (size_t)16 * lda + 32 * st); } }
#define SK_BLOAD(it_) do { const int u_ = (it_) >> 2; const bf16* bp0 = Bt + (size_t)(E.brow(u_, 0) + fr) * K + wave * kw + 8 * fq; const bf16* bp1 = Bt + (size_t)(E.brow(u_, 1) + fr) * K + wave * kw + 8 * fq; \
            _Pragma("unroll") for (int st = 0; st < 8; ++st) { bw[st][0] = ld16(bp0 + 32 * st); bw[st][1] = ld16(bp1 + 32 * st); } } while (0)
        if (bid < 4 * nunits) SK_BLOAD(bid);
        int par = 0;
#pragma unroll 1
        for (int item = bid; item < 4 * nunits; item += G) {
            const int unit = item >> 2; LAS f32x4* redp = red + par * 2048;
            f32x4 acc[2][2];
#pragma unroll
            for (int nb = 0; nb < 2; ++nb)
#pragma unroll
                for (int rt = 0; rt < 2; ++rt) acc[nb][rt] = (f32x4){0.f, 0.f, 0.f, 0.f};
#pragma unroll
            for (int st = 0; st < 8; ++st)
#pragma unroll
                for (int rt = 0; rt < 2; ++rt) { acc[0][rt] = MFMA16(bw[st][0], af[st][rt], acc[0][rt]); acc[1][rt] = MFMA16(bw[st][1], af[st][rt], acc[1][rt]); }
            __builtin_amdgcn_sched_barrier(0);
            if (item + G < 4 * nunits) SK_BLOAD(item + G);
            __builtin_amdgcn_sched_barrier(0);
#pragma unroll
            for (int nb = 0; nb < 2; ++nb)
#pragma unroll
                for (int rt = 0; rt < 2; ++rt) redp[((wave * 2 + nb) * 2 + rt) * 64 + lane] = acc[nb][rt];
            asm volatile("s_waitcnt lgkmcnt(0)" ::: "memory"); __builtin_amdgcn_s_barrier(); asm volatile("" ::: "memory");
            if (wave < 2) {
                f32x4 s0 = {0.f, 0.f, 0.f, 0.f}, s1 = {0.f, 0.f, 0.f, 0.f};
#pragma unroll
                for (int ws = 0; ws < 8; ++ws) { s0 = s0 + redp[((ws * 2 + 0) * 2 + wave) * 64 + lane]; s1 = s1 + redp[((ws * 2 + 1) * 2 + wave) * 64 + lane]; }
                E.store(unit, s0, s1, 32 * rg + 16 * wave + fr, fq);
            }
            par ^= 1;
        }
        __syncthreads();
#undef SK_BLOAD
        return;
    }
    for (int item = bid; item < 4 * nunits; item += G) {
        const int unit = item >> 2, rg = item & 3;
        const bf16* ap = A + (size_t)(32 * rg + fr) * lda + wave * kw + 8 * fq;
        const bf16* bp0 = Bt + (size_t)(E.brow(unit, 0) + fr) * K + wave * kw + 8 * fq; const bf16* bp1 = Bt + (size_t)(E.brow(unit, 1) + fr) * K + wave * kw + 8 * fq;
        f32x4 acc[2][2];
#pragma unroll
        for (int nb = 0; nb < 2; ++nb)
#pragma unroll
            for (int rt = 0; rt < 2; ++rt) acc[nb][rt] = (f32x4){0.f, 0.f, 0.f, 0.f};
        bf16x8 a0[4][2], b0[4][2], a1[4][2], b1[4][2];
#define SK_LOAD(af, bfr, g) do { _Pragma("unroll") for (int q = 0; q < 4; ++q) { const int st = 4 * (g) + q; if (st < nst) { \
            af[q][0] = ld16(ap + 32 * st); af[q][1] = ld16(ap + (size_t)16 * lda + 32 * st); bfr[q][0] = ld16(bp0 + 32 * st); bfr[q][1] = ld16(bp1 + 32 * st); } } } while (0)
#define SK_MMA(af, bfr, g) do { _Pragma("unroll") for (int q = 0; q < 4; ++q) { if (4 * (g) + q < nst) { _Pragma("unroll") for (int rt = 0; rt < 2; ++rt) { \
            acc[0][rt] = MFMA16(bfr[q][0], af[q][rt], acc[0][rt]); acc[1][rt] = MFMA16(bfr[q][1], af[q][rt], acc[1][rt]); } } } } while (0)
        const int ng = (nst + 3) >> 2;
        SK_LOAD(a0, b0, 0);
#pragma unroll 1
        for (int g = 0; g < ng; g += 2) {
            if (g + 1 < ng) SK_LOAD(a1, b1, g + 1);
            __builtin_amdgcn_sched_barrier(0);
            SK_MMA(a0, b0, g);
            __builtin_amdgcn_sched_barrier(0);
            if (g + 2 < ng) SK_LOAD(a0, b0, g + 2);
            __builtin_amdgcn_sched_barrier(0);
            if (g + 1 < ng) SK_MMA(a1, b1, g + 1);
            __builtin_amdgcn_sched_barrier(0);
        }
#undef SK_LOAD
#undef SK_MMA
#pragma unroll
        for (int nb = 0; nb < 2; ++nb)
#pragma unroll
            for (int rt = 0; rt < 2; ++rt) red[((wave * 2 + nb) * 2 + rt) * 64 + lane] = acc[nb][rt];
        __syncthreads();
        if (wave < 2) {
            f32x4 s0 = {0.f, 0.f, 0.f, 0.f}, s1 = {0.f, 0.f, 0.f, 0.f};
#pragma unroll
            for (int ws = 0; ws < 8; ++ws) { s0 = s0 + red[((ws * 2 + 0) * 2 + wave) * 64 + lane]; s1 = s1 + red[((ws * 2 + 1) * 2 + wave) * 64 + lane]; }
            E.store(unit, s0, s1, 32 * rg + 16 * wave + fr, fq);
        }
        __syncthreads();
    }
}
#ifndef PH_MASK
#define PH_MASK 0xFFFF
#endif
__global__ void __launch_bounds__(NWAVES * 64, 2) mega(Args args) {
    extern __shared__ __attribute__((aligned(16))) unsigned char lds[];
    Frame F;
    F.lds = (LAS unsigned char*)lds; F.MISC = (volatile LAS unsigned*)(F.lds + MISC_OFF);
    F.tid = threadIdx.x; F.lane = F.tid & 63; F.wave = __builtin_amdgcn_readfirstlane(F.tid >> 6);
    F.G = gridDim.x; F.gw = blockIdx.x * NWAVES + F.wave; F.NGW = F.G * NWAVES;
    F.ctl = (gu32*)(args.ws_ + WS_CTL);
    for (int u = F.tid; u < (LDS_BYTES - LDSCTL_OFF) / 4; u += NWAVES * 64) ((LAS unsigned*)(F.lds + LDSCTL_OFF))[u] = 0u;
    __syncthreads();
    XcdBarrier bar = xcd_barrier_post((unsigned*)(F.ctl + CW_BAR), F.MISC + 8);
    const int lo = args.ph_lo, hi = args.ph_hi; int ph = 0;
#define KARGS ((const __attribute__((address_space(4))) Args*)__builtin_amdgcn_kernarg_segment_ptr())
#define ws (ka->ws_)
#define out (ka->out_)
#define x_prompt (ka->in[0])
#define x_sample (ka->in[1])
#define mem_prompt (ka->in[2])
#define state_gla (ka->in[3])
#define cache_sb_k (ka->in[4])
#define cache_sb_v (ka->in[5])
#define cache_mem_k (ka->in[6])
#define cache_mem_v (ka->in[7])
#define w_in_a (ka->in[8])
#define w_gate_lr (ka->in[9])
#define b_gate (ka->in[10])
#define gla_norm_g (ka->in[11])
#define w_in_b (ka->in[12])
#define w_kv_shared (ka->in[13])
#define w_mem_kv (ka->in[14])
#define w_o (ka->in[15])
#define ln1_g (ka->in[16])
#define ln1_b (ka->in[17])
#define ln2_g (ka->in[18])
#define ln2_b (ka->in[19])
#define w_ffn_in (ka->in[20])
#define w_ffn_out (ka->in[21])
#define WIN ((bf16*)(ws + WS_WIN))
#define WO ((bf16*)(ws + WS_WO))
#define WFI ((bf16*)(ws + WS_WFI))
#define WFO ((bf16*)(ws + WS_WFO))
#define WMEM ((bf16*)(ws + WS_WMEM))
#define MEMX ((bf16*)(ws + WS_MEMX))
#define MEMK ((bf16*)(ws + WS_MEMK))
#define MEMV ((bf16*)(ws + WS_MEMV))
#define X ((bf16*)(ws + WS_X))
#define Y ((float*)(ws + WS_Y))
#define YB ((bf16*)(ws + WS_Y))
#define PROJ ((bf16*)(ws + WS_R1))
#define HB ((bf16*)(ws + WS_R1))
#define OCAT ((bf16*)(ws + WS_OCAT))
#define SBKS ((bf16*)(ws + WS_SBKS))
#define SBVS ((bf16*)(ws + WS_SBVS))
#define OINT ((bf16*)(out + O_YP))
#define KPB ((bf16*)(out + O_YP))
#define VPB (KPB + (size_t)MP * 1536)

#define PHASE_BEGIN(cond, cls) if (cond) { if (lo <= ph && ph < hi) { if (ph > lo) { xcd_barrier(bar); if (BAR_REP > 1) xcd_barrier(bar); } DIAG_STAMP(cls); for (int rep_ = 0; rep_ < (((cls) == REP_CLS) ? 2 : 1); ++rep_) { const __attribute__((address_space(4))) Args* ka = KARGS; asm volatile("" : "+s"(ka)); int z_ = 0, G_ = gridDim.x, bid_ = blockIdx.x, wave_ = F.wave; asm volatile("" : "+s"(z_), "+s"(G_), "+s"(bid_), "+s"(wave_)); const int lane = (int)__builtin_amdgcn_mbcnt_hi(~0u, __builtin_amdgcn_mbcnt_lo(~0u, (unsigned)z_)), tid = wave_ * 64 + lane, gw_ = bid_ * NWAVES + wave_, NGW_ = G_ * NWAVES;     (void)tid; (void)lane; (void)gw_; (void)NGW_;
#define PHASE_END } } ++ph; }
#ifndef REP_CLS
#define REP_CLS (-1)
#endif
#ifndef SK_REP
#define SK_REP 1
#endif
#ifndef MEM_REP
#define MEM_REP 1
#endif
#ifndef BAR_REP
#define BAR_REP 1
#endif
#ifndef STAG
#define STAG 0
#endif
#ifndef SB_REP
#define SB_REP 1
#endif
#if defined(DIAG_A)
#define DIAG_STAMP(cls) do { if (blockIdx.x == 0 && threadIdx.x == 0) { unsigned long long* dts = (unsigned long long*)(args.ws_ + 262144); dts[ph] = rt(); } } while (0)
#else
#define DIAG_STAMP(cls) do { } while (0)
#endif

#define CONVERT_WEIGHTS(LL) do { const int ll_ = (LL); \
            if (ll_ < 2) wt_convert(F.lds, wave_, gw_, NGW_, lane, w_in_a + (size_t)ll_ * D * 5136, D, 5136, WIN, NA, MapInA()); \
            else { wt_convert(F.lds, wave_, gw_, NGW_, lane, w_in_b + (size_t)(ll_ - 2) * D * NBQ, D, NBQ, WIN, NBQ, MapId()); if (ll_ == 2) wt_convert(F.lds, wave_, gw_, NGW_, lane, w_kv_shared, D, NKV, WIN + (size_t)NBQ * D, NKV, MapId()); } \
            wt_convert(F.lds, wave_, gw_, NGW_, lane, w_o + (size_t)ll_ * D * D, D, D, WO, D, MapId()); \
            wt_convert(F.lds, wave_, gw_, NGW_, lane, w_ffn_in + (size_t)ll_ * D * 2 * DFF, D, 2 * DFF, WFI, 2 * DFF, MapFfn()); \
            wt_convert(F.lds, wave_, gw_, NGW_, lane, w_ffn_out + (size_t)ll_ * DFF * D, DFF, D, WFO, D, MapId()); } while (0)
#define CONVERT_CACHE_K(W0, NW) do {         for (int r = (W0); r < 8 * 2048; r += (NW)) { const int b = r >> 11, s = r & 2047; const float* src = cache_sb_k + (size_t)r * 1536; \
            f32x4 v[6]; \
_Pragma("unroll") \
            for (int q = 0; q < 6; ++q) v[q] = *(const f32x4*)(src + lane * 4 + 256 * q); \
_Pragma("unroll") \
            for (int q = 0; q < 6; ++q) { const int j = lane * 4 + 256 * q; \
                *(unsigned long long*)(SBKS + ((size_t)(b * 12 + (j >> 7)) * 2080 + s) * 128 + (j & 127)) = (unsigned long long)pk2(v[q].x, v[q].y) | ((unsigned long long)pk2(v[q].z, v[q].w) << 32); } } } while (0)
#define CONVERT_CACHE_V(W0, NW) do {         for (int it = (W0); it < 3072; it += (NW)) { const int cb = it % 12, sb_ = (it / 12) & 31, b = it / 384, s = sb_ * 64 + lane; \
            const float* src = cache_sb_v + (size_t)(b * 2048 + s) * 1536 + cb * 128; bf16* dst = SBVS + ((size_t)(b * 12 + cb) * 65 + (s >> 5)) * 4096 + pg8::vtf_k(s & 31); \
            for (int q8 = 0; q8 < 32; q8 += 8) { f32x4 v[8]; \
_Pragma("unroll") \
                for (int q = 0; q < 8; ++q) v[q] = *(const f32x4*)(src + 4 * (q8 + q)); \
_Pragma("unroll") \
                for (int q = 0; q < 8; ++q) \
_Pragma("unroll") \
                    for (int e = 0; e < 4; ++e) dst[pg8::vtf_d(4 * (q8 + q) + e)] = (bf16)f2bf(v[q][e]); } } } while (0)
    PHASE_BEGIN(true, 0)
        for (int r = 2 * gw_; r < MT; r += 2 * NGW_) { const float* s0 = r < MP ? x_prompt + (size_t)r * D : (r < MR ? x_sample + (size_t)(r - MP) * D : nullptr);
            cvt_rows2<D>(s0, s0 ? s0 + D : nullptr, X + (size_t)r * D, X + (size_t)(r + 1) * D, lane); }
        for (int r = 2 * gw_; r < 1024; r += 2 * NGW_) cvt_rows2<D>(mem_prompt + (size_t)r * D, mem_prompt + (size_t)(r + 1) * D, MEMX + (size_t)r * D, MEMX + (size_t)(r + 1) * D, lane);
        for (int r = gw_; r < 4 * 8 * 256; r += NGW_) { const int l = r >> 11, b = (r >> 8) & 7, m = r & 255; const size_t dst = (size_t)((l * 12 + 4 + b) * 256 + m) * 512;
            cvt_row(cache_mem_k + (size_t)r * 512, MEMK + dst, 512, lane); }
        for (int it = gw_; it < 512; it += NGW_) { const int hdb = it & 3, mb = (it >> 2) & 3, b = (it >> 4) & 7, l = it >> 7, m = mb * 64 + lane;
            const float* src = cache_mem_v + (size_t)((l * 8 + b) * 256 + m) * 512 + hdb * 128; bf16* dst = MEMV + (size_t)((l * 12 + 4 + b) * 512 + hdb * 128) * 256 + m;
            for (int q4 = 0; q4 < 32; ++q4) { const f32x4 v = *(const f32x4*)(src + 4 * q4);
#pragma unroll
                for (int e = 0; e < 4; ++e) dst[(size_t)(4 * q4 + e) * 256] = (bf16)f2bf(v[e]); } }
        if (G_ != 256) { CONVERT_CACHE_K(gw_, NGW_); CONVERT_CACHE_V(gw_, NGW_); }
        for (int l = 0; l < 4; ++l) wt_convert(F.lds, wave_, gw_, NGW_, lane, w_mem_kv + (size_t)l * D * 1024, D, 1024, WMEM + (size_t)l * 1024 * D, 1024, MapId());
        CONVERT_WEIGHTS(0);
    PHASE_END
    for (int l = 0; l < 4; ++l) {
        const bool LA = l < 2;
        const int ldp = LA ? NA : NBQ;
        PHASE_BEGIN(true, 2)
            if (!LA && (bid_ & 1)) { { SkBf16 E{PROJ, ldp}; skinny_gemm(bid_, G_, FRESH_TID(), wave_, F.lds + RING_OFF, X + (size_t)MP * D, D, WIN, D, ldp / 32, E); }
                if (l == 2) { SkKV E{out + O_SKS, out + O_SVS, SBKS, SBVS}; skinny_gemm(bid_, G_, FRESH_TID(), wave_, F.lds + RING_OFF, X + (size_t)MP * D, D, WIN + (size_t)NBQ * D, D, NKV / 32, E); } }
            { pg8::Gemm g{X, WIN, MP, ldp, D}; pg8::StaticOrder S; S.init(MP, ldp, G_, bid_); pg8::EpiBf16 E{PROJ, ldp};
              pg8::gemm_phase<pg8::EpiBf16, pg8::StaticOrder, true, true>(F.lds + RING_OFF, g, S, E, FRESH_TID()); }
            if (l == 0 && bid_ >= (G_ >> 1) && bid_ < (G_ >> 1) + 64) { pg8::Gemm g{MEMX, WMEM, 1024, 4096, D}; pg8::StaticOrder S; S.init(1024, 4096, 64, bid_ - (G_ >> 1));
              pg8::EpiMemKV E{out + O_MKP, out + O_MVP, MEMK, MEMV};
              pg8::gemm_phase<pg8::EpiMemKV, pg8::StaticOrder, true, true>(F.lds + RING_OFF, g, S, E, FRESH_TID()); }
            if (l == 2) { pg8::Gemm g{X, WIN + (size_t)NBQ * D, MP, NKV, D}; pg8::StaticOrder S; S.init(MP, NKV, G_, bid_);
              pg8::EpiKV E{out + O_SKP, out + O_SVP, out + O_SKS, out + O_SVS, KPB, VPB, SBKS, SBVS};
              pg8::gemm_phase<pg8::EpiKV, pg8::StaticOrder, true, true>(F.lds + RING_OFF, g, S, E, FRESH_TID()); }
            if (LA) { if (bid_ >= (G_ >> 1)) { SkBf16 E{PROJ, ldp};
                    if (l == 0 && G_ == 256) {
                        if (bid_ >= 192) skinny_gemm(bid_ - 192, 64, FRESH_TID(), wave_, F.lds + RING_OFF, X + (size_t)MP * D, D, WIN, D, ldp / 32, E); }
                    else skinny_gemm(bid_ - (G_ >> 1), G_ >> 1, FRESH_TID(), wave_, F.lds + RING_OFF, X + (size_t)MP * D, D, WIN, D, ldp / 32, E); } }
            else if (!(bid_ & 1))
            for (int skr = 0; skr < SK_REP; ++skr) { SkBf16 E{PROJ, ldp}; skinny_gemm(bid_, G_, FRESH_TID(), wave_, F.lds + RING_OFF, X + (size_t)MP * D, D, WIN, D, ldp / 32, E); }
            if (!(bid_ & 1))
            for (int skr = 0; skr < SK_REP; ++skr) if (l == 2) { SkKV E{out + O_SKS, out + O_SVS, SBKS, SBVS}; skinny_gemm(bid_, G_, FRESH_TID(), wave_, F.lds + RING_OFF, X + (size_t)MP * D, D, WIN + (size_t)NBQ * D, D, NKV / 32, E); }
        PHASE_END
        PHASE_BEGIN(LA, 3)
            if (G_ == 256) gla_prep_intra<1>(bid_, G_, tid, wave_, F.lds + RING_OFF, l, PROJ, w_gate_lr, b_gate, (unsigned char*)Y, OINT);
            else gla_prep_intra<0>(bid_, G_, tid, wave_, F.lds + RING_OFF, l, PROJ, w_gate_lr, b_gate, (unsigned char*)Y, OINT);
        PHASE_END
        PHASE_BEGIN(!LA, 11)
            {
#if defined(SB_MODE)
                for (int u = gw_; u < 12288; u += NGW_) { const int bh = u >> 8, qb = u & 255, b = bh / 12, h = bh % 12, t0 = 32 * qb; const size_t qo = (size_t)(b * SEQ + t0) * D + h * 128;
                    sb_attn<SB_MODE>(lane, F.lds + RING_OFF + wave_ * 16384, KPB + (size_t)bh * SEQ * 128, 128, VPB + (size_t)bh * SEQ * 128, 0, PROJ + qo, NBQ, OCAT + qo, t0, 32); }
#endif
                for (int sbr = 0; sbr < SB_REP; ++sbr)
                for (int u = gw_; u < 12288 + 96; u += NGW_) {
                    if (u < 12288) { const int bh = u >> 8, qb = u & 255, b = bh / 12, h = bh % 12, t0 = 32 * qb; const size_t qo = (size_t)(b * SEQ + t0) * D + h * 128;
                        sb_attn(lane, F.lds + RING_OFF + wave_ * 16384, KPB + (size_t)bh * SEQ * 128, 128, VPB + (size_t)bh * SEQ * 128, 0, PROJ + qo, NBQ, OCAT + qo, t0, 32); }
                    else { const int u2 = u - 12288, b = u2 / 12, h = u2 % 12; const size_t qo = (size_t)(MP + b * 16) * D + h * 128;
                        sb_attn(lane, F.lds + RING_OFF + wave_ * 16384, SBKS + (size_t)u2 * 2080 * 128, 128, SBVS + (size_t)u2 * 65 * 4096, 0, PROJ + qo, NBQ, OCAT + qo, 2048, 16); }
                }
            }
            __syncthreads();
            for (int mr = 0; mr < MEM_REP; ++mr)
            if (G_ == 256) {
                mem_attn_wg(bid_, FRESH_TID(), wave_, F.lds + RING_OFF, l, PROJ, ldp, LA ? CQM : 1536, MEMK, MEMV, OCAT);
                if (bid_ >= 224) mem_attn_wg(256 + bid_ - 224, FRESH_TID(), wave_, F.lds + RING_OFF, l, PROJ, ldp, LA ? CQM : 1536, MEMK, MEMV, OCAT); }
            else
            for (int wi = bid_; wi < 256 + 32; wi += G_) mem_attn_wg(wi, FRESH_TID(), wave_, F.lds + RING_OFF, l, PROJ, ldp, LA ? CQM : 1536, MEMK, MEMV, OCAT);
        PHASE_END
        PHASE_BEGIN(LA, 12)
            if (G_ == 256) { if (bid_ >= 144) { mem_attn_wg(bid_ - 144, FRESH_TID(), wave_, F.lds + RING_OFF, l, PROJ, ldp, CQM, MEMK, MEMV, OCAT); mem_attn_wg(bid_ - 144 + 112, FRESH_TID(), wave_, F.lds + RING_OFF, l, PROJ, ldp, CQM, MEMK, MEMV, OCAT); }
                    if (bid_ >= 224) { __syncthreads(); gla_prep_intra<2>(bid_ - 224, G_, FRESH_TID(), wave_, F.lds + RING_OFF, l, PROJ, w_gate_lr, b_gate, (unsigned char*)Y, OINT); } }
            else for (int wi = bid_; wi < 256 + 32; wi += G_) mem_attn_wg(wi, FRESH_TID(), wave_, F.lds + RING_OFF, l, PROJ, ldp, CQM, MEMK, MEMV, OCAT);
            for (int wc = bid_; wc < 144; wc += G_) gla_chain<1>(wc, FRESH_TID(), wave_, F.lds + RING_OFF, l, (const unsigned char*)Y, state_gla, OINT, out, (float*)WMEM, (float*)MEMX);
            if (G_ == 256 && bid_ < 64) mem_attn_wg(224 + bid_, FRESH_TID(), wave_, F.lds + RING_OFF, l, PROJ, ldp, CQM, MEMK, MEMV, OCAT);
        PHASE_END
        PHASE_BEGIN(LA, 5)
            if (G_ == 256 && bid_ >= 192) { const int lw = (bid_ - 192) * NWAVES + wave_; if (l == 0) CONVERT_CACHE_K(lw, 64 * NWAVES); else CONVERT_CACHE_V(lw, 64 * NWAVES); }
            for (int wc = bid_; wc < 192 + 96; wc += G_) gla_chain<2>(wc, FRESH_TID(), wave_, F.lds + RING_OFF, l, (const unsigned char*)Y, state_gla, OINT, out, (float*)WMEM, (float*)MEMX, REP_CLS == 5 && rep_ == 0);
        PHASE_END
        PHASE_BEGIN(LA, 6)
            const float* gn = gla_norm_g + (size_t)l * 384;
            for (int row = gw_; row < MR; row += NGW_) {
                const bf16* op = OINT + (size_t)row * 1536 + 24 * lane; const bf16* gp = PROJ + (size_t)row * NA + CG + 24 * lane; const float* gnp = gn + 24 * (lane & 15);
                f32x4 ov[6]; v4u gv[3]; float ss = 0.f;
#pragma unroll
                for (int j = 0; j < 3; ++j) { const v4u w = *(const v4u*)(op + 8 * j); ov[2 * j] = (f32x4){pg8::bflo(w.x), pg8::bfhi(w.x), pg8::bflo(w.y), pg8::bfhi(w.y)}; ov[2 * j + 1] = (f32x4){pg8::bflo(w.z), pg8::bfhi(w.z), pg8::bflo(w.w), pg8::bfhi(w.w)}; }
#pragma unroll
                for (int j = 0; j < 6; ++j) ss += (ov[j].x * ov[j].x + ov[j].y * ov[j].y) + (ov[j].z * ov[j].z + ov[j].w * ov[j].w);
#pragma unroll
                for (int j = 0; j < 3; ++j) gv[j] = *(const v4u*)(gp + 8 * j);
                ss += shx(ss, lane, 1); ss += shx(ss, lane, 2); ss += shx(ss, lane, 4); ss += shx(ss, lane, 8);
                const float r = 1.0f / sqrtf(ss * (1.0f / 384.0f) + RMS_EPS);
#pragma unroll
                for (int j = 0; j < 3; ++j) { const f32x4 n0 = *(const f32x4*)(gnp + 8 * j), n1 = *(const f32x4*)(gnp + 8 * j + 4); const f32x4 a = ov[2 * j], b = ov[2 * j + 1];
                    float gt[8]; gt[0] = pg8::bflo(gv[j].x); gt[1] = pg8::bfhi(gv[j].x); gt[2] = pg8::bflo(gv[j].y); gt[3] = pg8::bfhi(gv[j].y); gt[4] = pg8::bflo(gv[j].z); gt[5] = pg8::bfhi(gv[j].z); gt[6] = pg8::bflo(gv[j].w); gt[7] = pg8::bfhi(gv[j].w);
                    float o8[8];
#pragma unroll
                    for (int i = 0; i < 4; ++i) { o8[i] = a[i] * r * n0[i] * (gt[i] * __builtin_amdgcn_rcpf(1.0f + __expf(-gt[i]))); o8[4 + i] = b[i] * r * n1[i] * (gt[4 + i] * __builtin_amdgcn_rcpf(1.0f + __expf(-gt[4 + i]))); }
                    v4u o; o.x = pk2(o8[0], o8[1]); o.y = pk2(o8[2], o8[3]); o.z = pk2(o8[4], o8[5]); o.w = pk2(o8[6], o8[7]);
                    *(v4u*)(OCAT + (size_t)row * D + 24 * lane + 8 * j) = o; }
            }
        PHASE_END
        PHASE_BEGIN(true, 7)
            if (bid_ & 1) { SkRes Es{YB, X, DN_ALPHA}; skinny_gemm(bid_, G_, FRESH_TID(), wave_, F.lds + RING_OFF, OCAT + (size_t)MP * D, D, WO, D, D / 32, Es); }
            pg8::Gemm g{OCAT, WO, MP, D, D}; pg8::StaticOrder S; S.init(MP, D, G_, bid_); pg8::EpiRes E{YB, X, D, DN_ALPHA};
            pg8::gemm_phase<pg8::EpiRes, pg8::StaticOrder, true, true>(F.lds + RING_OFF, g, S, E, FRESH_TID());
            if (!(bid_ & 1))
            for (int skr = 0; skr < SK_REP; ++skr) { SkRes Es{YB, X, DN_ALPHA}; skinny_gemm(bid_, G_, FRESH_TID(), wave_, F.lds + RING_OFF, OCAT + (size_t)MP * D, D, WO, D, D / 32, Es); }
        PHASE_END
        PHASE_BEGIN(true, 8)
            const float* gg = ln1_g + (size_t)l * D; const float* bb = ln1_b + (size_t)l * D;
            ln_rows<false>(lane, gw_, NGW_, YB, gg, bb, X, [](int) -> float* { return nullptr; });
        PHASE_END
        PHASE_BEGIN(true, 9)
            for (int dl = 0; dl < 3 * STAG * (bid_ >> 1 & 3); ++dl) __builtin_amdgcn_s_sleep(127);
            if (bid_ & 1) { SkSwiGLU Es{HB}; skinny_gemm(bid_, G_, FRESH_TID(), wave_, F.lds + RING_OFF, X + (size_t)MP * D, D, WFI, D, DFF / 16, Es); }
            pg8::Gemm g{X, WFI, MP, 2 * DFF, D}; pg8::StaticOrder S; S.init(MP, 2 * DFF, G_, bid_); pg8::EpiSwiGLU E{HB, DFF};
            pg8::gemm_phase<pg8::EpiSwiGLU, pg8::StaticOrder, true, true>(F.lds + RING_OFF, g, S, E, FRESH_TID());
            if (!(bid_ & 1))
            for (int skr = 0; skr < SK_REP; ++skr) { SkSwiGLU Es{HB}; skinny_gemm(bid_, G_, FRESH_TID(), wave_, F.lds + RING_OFF, X + (size_t)MP * D, D, WFI, D, DFF / 16, Es); }
        PHASE_END
        PHASE_BEGIN(true, 10)
            if (bid_ & 1) { SkRes Es{YB, X, DN_ALPHA}; skinny_gemm(bid_, G_, FRESH_TID(), wave_, F.lds + RING_OFF, HB + (size_t)MP * DFF, DFF, WFO, DFF, D / 32, Es); }
            pg8::Gemm g{HB, WFO, MP, D, DFF}; pg8::StaticOrder S; S.init(MP, D, G_, bid_); pg8::EpiRes E{YB, X, D, DN_ALPHA};
            pg8::gemm_phase<pg8::EpiRes, pg8::StaticOrder, true, true>(F.lds + RING_OFF, g, S, E, FRESH_TID());
            if (!(bid_ & 1))
            for (int skr = 0; skr < SK_REP; ++skr) { SkRes Es{YB, X, DN_ALPHA}; skinny_gemm(bid_, G_, FRESH_TID(), wave_, F.lds + RING_OFF, HB + (size_t)MP * DFF, DFF, WFO, DFF, D / 32, Es); }
        PHASE_END
        PHASE_BEGIN(true, 8)
            if (l < 3) CONVERT_WEIGHTS(l + 1);
            const float* gg = ln2_g + (size_t)l * D; const float* bb = ln2_b + (size_t)l * D;
            if (l == 3) ln_rows<true>(lane, gw_, NGW_, YB, gg, bb, nullptr, [&](int row) -> float* { return row < MP ? out + O_YP + (size_t)row * D : out + O_YS + (size_t)(row - MP) * D; });
            else ln_rows<false>(lane, gw_, NGW_, YB, gg, bb, X, [](int) -> float* { return nullptr; });
        PHASE_END
    }
#if defined(DIAG_A)
    if (blockIdx.x == 0 && threadIdx.x == 0) { unsigned long long* dts = (unsigned long long*)(args.ws_ + 262144); dts[ph] = rt(); dts[63] = (unsigned long long)ph; }
#endif
#undef ws
#undef out
#undef X
#undef Y
#undef YB
#undef CONVERT_WEIGHTS
#undef CONVERT_CACHE_K
#undef CONVERT_CACHE_V
#undef PHASE_BEGIN
#undef PHASE_END
}

#if defined(DIAG_A)
__device__ const int diag_cls[40] = {0,0, 1,2,3,4,5,6,7,8,9,10,8, 1,2,3,4,5,6,7,8,9,10,8, 1,2,11,7,8,9,10,8, 1,2,11,7,8,9,10,8};
__global__ void diag_tail(float* o, const unsigned long long* dts) {
    __shared__ float dv[2];
    if (threadIdx.x == 0) { const int n = (int)dts[63]; unsigned long long sa = 0, sb = 0; for (int p = 0; p < n; ++p) { const unsigned long long d = dts[p + 1] - dts[p]; const int cl = diag_cls[p]; if (cl == DIAG_A) sa += d; if (cl == DIAG_B) sb += d; }
        dv[0] = (float)sa * 0.01f; dv[1] = (float)sb * 10.0f; }
    __syncthreads();
    for (int i = threadIdx.x; i < 262144; i += blockDim.x) o[O_YS + i] = dv[0];
    if (threadIdx.x == 0) o[O_YP] = dv[1];
}
#endif
#ifndef MK_PER_PHASE
#define MK_PER_PHASE 0
#endif
constexpr int N_PHASES = 1 + 2 * 10 + 2 * 7;
extern "C" void kernel_launch(void* const* d_in, const int* in_sizes, int n_in, void* d_out, int out_size, void* d_ws, size_t ws_size, hipStream_t stream) {
    static int grid = 0;
    if (grid == 0) {
        if (n_in != 22 || in_sizes[0] != MP * D || (size_t)out_size != O_END || ws_size < WS_END) { fprintf(stderr, "kernel_launch: unexpected shapes (n_in %d, in0 %d, out %d, ws %zu); nothing launched\n", n_in, n_in > 0 ? in_sizes[0] : -1, out_size, ws_size); grid = -1; return; }
        int dev = 0, cus = 0, per_cu = 0;
        if (hipGetDevice(&dev) != hipSuccess || hipDeviceGetAttribute(&cus, hipDeviceAttributeMultiprocessorCount, dev) != hipSuccess) { grid = -1; return; }
        if (hipFuncSetAttribute((const void*)mega, hipFuncAttributeMaxDynamicSharedMemorySize, LDS_BYTES) != hipSuccess) { fprintf(stderr, "kernel_launch: hipFuncSetAttribute failed\n"); grid = -1; return; }
        if (hipOccupancyMaxActiveBlocksPerMultiprocessor(&per_cu, (const void*)mega, NWAVES * 64, LDS_BYTES) != hipSuccess || per_cu < 1) fprintf(stderr, "kernel_launch: occupancy query reports %d\n", per_cu);
        (void)hipGetLastError();
        grid = cus;
    }
    if (grid < 0) return;
    if (hipMemsetAsync((char*)d_ws + WS_CTL, 0, CTL_ZERO_BYTES, stream) != hipSuccess) return;
    Args a{};
    for (int i = 0; i < 22; ++i) a.in[i] = (const float*)d_in[i];
    a.out_ = (float*)d_out; a.ws_ = (unsigned char*)d_ws;
#if MK_PER_PHASE
    for (int p = 0; p < N_PHASES; ++p) { a.ph_lo = p; a.ph_hi = p + 1; hipLaunchKernelGGL(mega, dim3(grid), dim3(NWAVES * 64), LDS_BYTES, stream, a); }
#else
    a.ph_lo = 0; a.ph_hi = N_PHASES; hipLaunchKernelGGL(mega, dim3(grid), dim3(NWAVES * 64), LDS_BYTES, stream, a);
#if defined(DIAG_A)
    hipLaunchKernelGGL(diag_tail, dim3(1), dim3(512), 0, stream, (float*)d_out, (const unsigned long long*)((unsigned char*)d_ws + 262144));
#endif
#endif
}
```
